# Optimizing an MI355X kernel written in HIP

```python
import jax, jax.numpy as jnp
from jax import lax
import numpy as np

D_MODEL = 1024
BATCH = 16
SEQ = 256
DEPTH = 4
DEC_BATCH = 4
DEC_SEQ = 1024
PAST_LEN = 256

GRID_W = 64
N_MIXERS = 3
N_MLA = (DEPTH + 2) // N_MIXERS
N_CONV = (DEPTH + 1) // N_MIXERS
N_SSD = DEPTH // N_MIXERS

MLA_HEADS = 16
QK_NOPE = 64
QK_ROPE = 32
QK_DIM = QK_NOPE + QK_ROPE
V_HEAD = 64
Q_LORA = 384
KV_LORA = 256
ROPE_AXIS = QK_ROPE // 2
ROPE_BASE = 10000.0
Q_BLOCK = 128

CONV_WIDTH = 31

SSD_INNER = 2 * D_MODEL
SSD_HEADDIM = 64
SSD_HEADS = SSD_INNER // SSD_HEADDIM
SSD_GROUPS = 4
SSD_STATE = 128
SSD_CONV = 5
SSD_CONV_DIM = SSD_INNER + 2 * SSD_GROUPS * SSD_STATE
SSD_IN_DIM = SSD_INNER + SSD_CONV_DIM + 2 * SSD_HEADS
CHUNK = 128

FFN_HIDDEN = ((8 * D_MODEL + 3 * 256 - 1) // (3 * 256)) * 256
EPS = 1e-6

kernel_name = 'hybrid_mla_conformer_ssd_diffusion_step'


def rmsnorm(x, g):
    x32 = x.astype(jnp.float32)
    y = x32 * lax.rsqrt(jnp.mean(x32 * x32, axis=-1, keepdims=True) + EPS)
    return (y * g.astype(jnp.float32)).astype(x.dtype)


def layernorm(x, g, b):
    x32 = x.astype(jnp.float32)
    xc = x32 - jnp.mean(x32, axis=-1, keepdims=True)
    y = xc * lax.rsqrt(jnp.mean(xc * xc, axis=-1, keepdims=True) + EPS)
    return (y * g.astype(jnp.float32) + b.astype(jnp.float32)).astype(x.dtype)


def adaln(cond, w, b):
    return jnp.split(jax.nn.silu(cond) @ w + b, 6, axis=-1)


def modulate(h, shift, scale):
    return h * (1 + scale) + shift


def swiglu(h, w_in, w_out):
    a, u = jnp.split(h @ w_in, 2, axis=-1)
    return (jax.nn.silu(a) * u) @ w_out


def axial_angles(n_tok):
    rows = n_tok // GRID_W
    row = jnp.repeat(jnp.arange(rows, dtype=jnp.float32), GRID_W)
    col = jnp.tile(jnp.arange(GRID_W, dtype=jnp.float32), rows)
    inv = ROPE_BASE ** (-jnp.arange(0, ROPE_AXIS, 2, dtype=jnp.float32) / ROPE_AXIS)
    return row[:, None] * inv, col[:, None] * inv


def rotate_half(x, ang):
    m = ang.shape[-1]
    cos = jnp.cos(ang)[:, None, :].astype(x.dtype)
    sin = jnp.sin(ang)[:, None, :].astype(x.dtype)
    x1, x2 = x[..., :m], x[..., m:]
    return jnp.concatenate([x1 * cos - x2 * sin, x2 * cos + x1 * sin], axis=-1)


def axial_rope(x, ang_r, ang_c):
    pe = x[..., QK_NOPE:]
    return jnp.concatenate([x[..., :QK_NOPE], rotate_half(pe[..., :ROPE_AXIS], ang_r),
                            rotate_half(pe[..., ROPE_AXIS:], ang_c)], axis=-1)


def attention(q, k, v):
    b, tq, h, dk = q.shape
    scale = dk ** -0.5
    qb = q.reshape(b, tq // Q_BLOCK, Q_BLOCK, h, dk).transpose(1, 0, 2, 3, 4)

    def block(qi):
        s = jnp.einsum('bqhd,bkhd->bhqk', qi, k).astype(jnp.float32) * scale
        p = jax.nn.softmax(s, axis=-1).astype(v.dtype)
        return jnp.einsum('bhqk,bkhd->bqhd', p, v)

    o = lax.map(block, qb)
    return o.transpose(1, 0, 2, 3, 4).reshape(b, tq, h, v.shape[-1])


def mla_queries(h, w_dq, g_q, w_uq, g_qn):
    b, t, _ = h.shape
    q = (rmsnorm(h @ w_dq, g_q) @ w_uq).reshape(b, t, MLA_HEADS, QK_DIM)
    return rmsnorm(q, g_qn)


def mla_kv_latent(h, w_dkv, g_kv):
    kv = h @ w_dkv
    return rmsnorm(kv[..., :KV_LORA], g_kv), kv[..., KV_LORA:]


def mla_keys_values(ckv, kpe, w_ukv, g_kn):
    b, s, _ = ckv.shape
    kv = (ckv @ w_ukv).reshape(b, s, MLA_HEADS, QK_NOPE + V_HEAD)
    k_pe = jnp.broadcast_to(kpe[:, :, None, :], (b, s, MLA_HEADS, QK_ROPE))
    k = jnp.concatenate([kv[..., :QK_NOPE], k_pe], axis=-1)
    return rmsnorm(k, g_kn), kv[..., QK_NOPE:]


def mla_output(q, k, v, w_o):
    b, t = q.shape[:2]
    return attention(q, k, v).reshape(b, t, MLA_HEADS * V_HEAD) @ w_o


def mla_context(h, w_dq, g_q, w_uq, w_dkv, g_kv, w_ukv, g_qn, g_kn, w_o):
    q = mla_queries(h, w_dq, g_q, w_uq, g_qn)
    ckv, kpe = mla_kv_latent(h, w_dkv, g_kv)
    k, v = mla_keys_values(ckv, kpe, w_ukv, g_kn)
    return mla_output(q, k, v, w_o), ckv, kpe


def mla_latent(h, ckv_ctx, kpe_ctx, ang_r, ang_c, w_dq, g_q, w_uq, w_dkv, g_kv, w_ukv, g_qn, g_kn, w_o):
    q = axial_rope(mla_queries(h, w_dq, g_q, w_uq, g_qn), ang_r, ang_c)
    ckv, kpe = mla_kv_latent(h, w_dkv, g_kv)
    k_l, v_l = mla_keys_values(ckv, kpe, w_ukv, g_kn)
    k_l = axial_rope(k_l, ang_r, ang_c)
    k_c, v_c = mla_keys_values(ckv_ctx, kpe_ctx, w_ukv, g_kn)
    k = jnp.concatenate([k_c, k_l], axis=1)
    v = jnp.concatenate([v_c, v_l], axis=1)
    return mla_output(q, k, v, w_o)


def depthwise_conv(x, w, b):
    pad = (w.shape[0] - 1) // 2
    y = lax.conv_general_dilated(x, w[:, None, :], window_strides=(1,), padding=[(pad, pad)],
                                 dimension_numbers=('NWC', 'WIO', 'NWC'),
                                 feature_group_count=x.shape[-1])
    return y + b


def conv_module(h, w_pw1, b_pw1, w_dw, b_dw, g_ln, b_ln, w_pw2, b_pw2):
    a, g = jnp.split(h @ w_pw1 + b_pw1, 2, axis=-1)
    u = a * jax.nn.sigmoid(g)
    u = jax.nn.silu(layernorm(depthwise_conv(u, w_dw, b_dw), g_ln, b_ln))
    return u @ w_pw2 + b_pw2


def ssd_scan(x, dt, a, bm, cm, d_skip, h0):
    f32 = jnp.float32
    b, L, H, P = x.shape
    G, N = bm.shape[-2:]
    R = H // G
    nc = L // CHUNK
    xr = x.astype(f32).reshape(b, nc, CHUNK, G, R, P)
    dtr = dt.reshape(b, nc, CHUNK, G, R)
    br = bm.astype(f32).reshape(b, nc, CHUNK, G, N)
    cr = cm.astype(f32).reshape(b, nc, CHUNK, G, N)
    a_cum = jnp.cumsum(dtr * a.reshape(G, R), axis=2)
    xdt = xr * dtr[..., None]
    ac = jnp.moveaxis(a_cum, 2, -1)
    seg = ac[..., :, None] - ac[..., None, :]
    lower = jnp.tril(jnp.ones((CHUNK, CHUNK), dtype=bool))
    lmat = jnp.exp(jnp.where(lower, seg, -jnp.inf))
    cb = jnp.einsum('bcign,bcjgn->bcgij', cr, br)
    y_diag = jnp.einsum('bcgrij,bcjgrp->bcigrp', cb[:, :, :, None] * lmat, xdt)
    decay_in = jnp.exp(a_cum[:, :, -1:] - a_cum)
    states = jnp.einsum('bcjgn,bcjgrp->bcgrpn', br, xdt * decay_in[..., None])
    chunk_decay = jnp.exp(a_cum[:, :, -1])

    def step(hc, inp):
        st, dec = inp
        return hc * dec[..., None, None] + st, hc

    h_fin, h_prev = lax.scan(step, h0.astype(f32).reshape(b, G, R, P, N),
                             (jnp.moveaxis(states, 1, 0), jnp.moveaxis(chunk_decay, 1, 0)))
    h_prev = jnp.moveaxis(h_prev, 0, 1)
    y_off = jnp.einsum('bcign,bcgrpn->bcigrp', cr, h_prev) * jnp.exp(a_cum)[..., None]
    y = y_diag + y_off + xr * d_skip.astype(f32).reshape(G, R)[..., None]
    return y.reshape(b, L, H, P).astype(x.dtype), h_fin.reshape(b, H, P, N).astype(x.dtype)


def ssd_mixer(h, h0, w_in, w_conv, b_conv, dt_bias, a_log, d_skip, g_norm, w_out):
    b, t, _ = h.shape
    zxbcdt = h @ w_in
    z = zxbcdt[..., :SSD_INNER]
    xbc = jax.nn.silu(depthwise_conv(zxbcdt[..., SSD_INNER:SSD_INNER + SSD_CONV_DIM], w_conv, b_conv))
    dt_raw = zxbcdt[..., SSD_INNER + SSD_CONV_DIM:].reshape(b, t, 2, SSD_HEADS).astype(jnp.float32)
    gn = SSD_GROUPS * SSD_STATE
    x = xbc[..., :SSD_INNER].reshape(b, t, SSD_HEADS, SSD_HEADDIM)
    bm = xbc[..., SSD_INNER:SSD_INNER + gn].reshape(b, t, SSD_GROUPS, SSD_STATE)
    cm = xbc[..., SSD_INNER + gn:].reshape(b, t, SSD_GROUPS, SSD_STATE)
    dt = jax.nn.softplus(dt_raw + dt_bias.astype(jnp.float32))
    a = -jnp.exp(a_log.astype(jnp.float32))
    flip = lambda u: jnp.flip(u, axis=1)
    y_f, s_f = ssd_scan(x, dt[:, :, 0], a[0], bm, cm, d_skip[0], h0[:, 0])
    y_b, s_b = ssd_scan(flip(x), flip(dt[:, :, 1]), a[1], flip(bm), flip(cm), d_skip[1], h0[:, 1])
    y = (y_f + flip(y_b)).reshape(b, t, SSD_INNER)
    yz = (y * jax.nn.silu(z)).reshape(b, t, SSD_GROUPS, SSD_INNER // SSD_GROUPS)
    y = rmsnorm(yz, g_norm.reshape(SSD_GROUPS, SSD_INNER // SSD_GROUPS)).reshape(b, t, SSD_INNER)
    return y @ w_out, jnp.stack([s_f, s_b], axis=1)


def setup_inputs(seed: int = 0) -> dict:
    key = jax.random.key(seed)
    ks = iter(jax.random.split(key, 48))
    f32 = jnp.float32
    D = D_MODEL

    def nrm(shape, scale=1.0):
        return jax.random.normal(next(ks), shape, f32) * scale

    def gain(shape):
        return 1.0 + nrm(shape, 0.05)

    dt0 = jnp.exp(jax.random.uniform(next(ks), (N_SSD, 2, SSD_HEADS), f32,
                                     minval=np.log(0.001), maxval=np.log(0.1)))
    return {
        'x_prompt': nrm((BATCH, SEQ, D)),
        'x_sample': nrm((DEC_BATCH, DEC_SEQ, D)),
        'cache_ckv': nrm((DEC_BATCH, N_MLA, PAST_LEN, KV_LORA)),
        'cache_kpe': nrm((DEC_BATCH, N_MLA, PAST_LEN, QK_ROPE)),
        'state_ssm': nrm((DEC_BATCH, N_SSD, 2, SSD_HEADS, SSD_HEADDIM, SSD_STATE), 0.1),
        'c': nrm((DEC_BATCH, D)),
        'c_ctx': nrm((D,)),
        'w_ada': nrm((DEPTH, D, 6 * D), 0.5 * D ** -0.5),
        'b_ada': nrm((DEPTH, 6 * D), 0.02),
        'g_norm1': gain((DEPTH, D)),
        'g_norm2': gain((DEPTH, D)),
        'mla_w_dq': nrm((N_MLA, D, Q_LORA), D ** -0.5),
        'mla_g_q': gain((N_MLA, Q_LORA)),
        'mla_w_uq': nrm((N_MLA, Q_LORA, MLA_HEADS * QK_DIM), Q_LORA ** -0.5),
        'mla_w_dkv': nrm((N_MLA, D, KV_LORA + QK_ROPE), D ** -0.5),
        'mla_g_kv': gain((N_MLA, KV_LORA)),
        'mla_w_ukv': nrm((N_MLA, KV_LORA, MLA_HEADS * (QK_NOPE + V_HEAD)), KV_LORA ** -0.5),
        'mla_g_qn': gain((N_MLA, QK_DIM)),
        'mla_g_kn': gain((N_MLA, QK_DIM)),
        'mla_w_o': nrm((N_MLA, MLA_HEADS * V_HEAD, D), (MLA_HEADS * V_HEAD) ** -0.5),
        'cv_w_pw1': nrm((N_CONV, D, 2 * D), D ** -0.5),
        'cv_b_pw1': nrm((N_CONV, 2 * D), 0.02),
        'cv_w_dw': nrm((N_CONV, CONV_WIDTH, D), CONV_WIDTH ** -0.5),
        'cv_b_dw': nrm((N_CONV, D), 0.02),
        'cv_g_ln': gain((N_CONV, D)),
        'cv_b_ln': nrm((N_CONV, D), 0.02),
        'cv_w_pw2': nrm((N_CONV, D, D), D ** -0.5),
        'cv_b_pw2': nrm((N_CONV, D), 0.02),
        'ssd_w_in': nrm((N_SSD, D, SSD_IN_DIM), D ** -0.5),
        'ssd_w_conv': nrm((N_SSD, SSD_CONV, SSD_CONV_DIM), SSD_CONV ** -0.5),
        'ssd_b_conv': nrm((N_SSD, SSD_CONV_DIM), 0.02),
        'ssd_dt_bias': dt0 + jnp.log(-jnp.expm1(-dt0)),
        'ssd_a_log': jnp.log(jax.random.uniform(next(ks), (N_SSD, 2, SSD_HEADS), f32, minval=1.0, maxval=16.0)),
        'ssd_d': gain((N_SSD, 2, SSD_HEADS)),
        'ssd_g_norm': gain((N_SSD, SSD_INNER)),
        'ssd_w_out': nrm((N_SSD, SSD_INNER, D), SSD_INNER ** -0.5),
        'ffn_w_in': nrm((DEPTH, D, 2 * FFN_HIDDEN), D ** -0.5),
        'ffn_w_out': nrm((DEPTH, FFN_HIDDEN, D), FFN_HIDDEN ** -0.5),
    }


def reference(x_prompt, x_sample, cache_ckv, cache_kpe, state_ssm, c, c_ctx,
              w_ada, b_ada, g_norm1, g_norm2,
              mla_w_dq, mla_g_q, mla_w_uq, mla_w_dkv, mla_g_kv, mla_w_ukv, mla_g_qn, mla_g_kn, mla_w_o,
              cv_w_pw1, cv_b_pw1, cv_w_dw, cv_b_dw, cv_g_ln, cv_b_ln, cv_w_pw2, cv_b_pw2,
              ssd_w_in, ssd_w_conv, ssd_b_conv, ssd_dt_bias, ssd_a_log, ssd_d, ssd_g_norm, ssd_w_out,
              ffn_w_in, ffn_w_out):
    ang_r, ang_c = axial_angles(x_sample.shape[1])
    cond_ctx = c_ctx[None, None, :]
    cond_lat = c[:, None, :]
    xp, xs = x_prompt, x_sample
    ckv_list, kpe_list, ssm_list = [], [], []
    for i in range(DEPTH):
        kind, j = i % N_MIXERS, i // N_MIXERS
        p_sh1, p_sc1, p_g1, p_sh2, p_sc2, p_g2 = adaln(cond_ctx, w_ada[i], b_ada[i])
        s_sh1, s_sc1, s_g1, s_sh2, s_sc2, s_g2 = adaln(cond_lat, w_ada[i], b_ada[i])
        hp = modulate(rmsnorm(xp, g_norm1[i]), p_sh1, p_sc1)
        hs = modulate(rmsnorm(xs, g_norm1[i]), s_sh1, s_sc1)
        if kind == 0:
            mw = (mla_w_dq[j], mla_g_q[j], mla_w_uq[j], mla_w_dkv[j], mla_g_kv[j],
                  mla_w_ukv[j], mla_g_qn[j], mla_g_kn[j], mla_w_o[j])
            op, ckv, kpe = mla_context(hp, *mw)
            os_ = mla_latent(hs, cache_ckv[:, j], cache_kpe[:, j], ang_r, ang_c, *mw)
            ckv_list.append(ckv)
            kpe_list.append(kpe)
        elif kind == 1:
            cw = (cv_w_pw1[j], cv_b_pw1[j], cv_w_dw[j], cv_b_dw[j], cv_g_ln[j], cv_b_ln[j],
                  cv_w_pw2[j], cv_b_pw2[j])
            op = conv_module(hp, *cw)
            os_ = conv_module(hs, *cw)
        else:
            sw = (ssd_w_in[j], ssd_w_conv[j], ssd_b_conv[j], ssd_dt_bias[j], ssd_a_log[j],
                  ssd_d[j], ssd_g_norm[j], ssd_w_out[j])
            h0 = jnp.zeros((xp.shape[0], 2, SSD_HEADS, SSD_HEADDIM, SSD_STATE), xp.dtype)
            op, st = ssd_mixer(hp, h0, *sw)
            os_, _ = ssd_mixer(hs, state_ssm[:, j], *sw)
            ssm_list.append(st)
        xp = xp + p_g1 * op
        xs = xs + s_g1 * os_
        hp = modulate(rmsnorm(xp, g_norm2[i]), p_sh2, p_sc2)
        hs = modulate(rmsnorm(xs, g_norm2[i]), s_sh2, s_sc2)
        xp = xp + p_g2 * swiglu(hp, ffn_w_in[i], ffn_w_out[i])
        xs = xs + s_g2 * swiglu(hs, ffn_w_in[i], ffn_w_out[i])
    new_ckv = jnp.stack(ckv_list, axis=1)
    new_kpe = jnp.stack(kpe_list, axis=1)
    new_ssm = jnp.stack(ssm_list, axis=1)
    return (xp, xs, new_ckv, new_kpe, new_ssm)
```

```cpp
#include <hip/hip_runtime.h>
#include <cstdint>
#include <cstdio>

constexpr int DM = 1024, T = 8192, TP = 4096;
constexpr int NCTX = 1024;
constexpr int QL = 384, KVL = 256, ROPE = 32, NOPE = 64, QKD = 96, VH = 64, NH = 16;
constexpr int FFH = 2816;
constexpr int SSI = 2048, SSH = 32, SSP = 64, SSN = 128, SSG = 4, SSCD = 3072, SSIN = 5184;
constexpr float EPS = 1e-6f;
constexpr size_t OUT_YP = 0, OUT_CKV = 8388608, OUT_KPE = 10485760, OUT_SSM = 10747904;

__device__ __forceinline__ int cond_of_row(int r) { return r < TP ? 0 : 1 + ((r - TP) >> 10); }
__device__ __forceinline__ void row_pos(int r, int& t, int& L) { if (r < TP) { t = r & 255; L = 256; } else { t = (r - TP) & 1023; L = 1024; } }
__device__ __forceinline__ float silu_f(float x) { return x / (1.f + expf(-x)); }
__device__ __forceinline__ float sigmoid_f(float x) { return 1.f / (1.f + expf(-x)); }
__device__ __forceinline__ float softplus_f(float x) { return fmaxf(x, 0.f) + log1pf(expf(-fabsf(x))); }
__device__ __forceinline__ float wave_sum(float v) {
#pragma unroll
    for (int o = 1; o < 64; o <<= 1) v += __shfl_xor(v, o);
    return v;
}

__global__ void __launch_bounds__(256) nk_adaln(const float* __restrict__ c, const float* __restrict__ cctx, const float* __restrict__ w, const float* __restrict__ b, float* __restrict__ mods) {
    __shared__ float s[5][DM];
    const int l = blockIdx.y, n = blockIdx.x * 256 + threadIdx.x;
    for (int i = threadIdx.x; i < 5 * DM; i += 256) { const int cc = i / DM, k = i % DM; const float v = cc == 0 ? cctx[k] : c[(cc - 1) * DM + k]; s[cc][k] = silu_f(v); }
    __syncthreads();
    const float* W = w + (size_t)l * DM * 6144;
    float acc[5] = {0.f, 0.f, 0.f, 0.f, 0.f};
    for (int k = 0; k < DM; ++k) { const float wv = W[(size_t)k * 6144 + n];
#pragma unroll
        for (int cc = 0; cc < 5; ++cc) acc[cc] += s[cc][k] * wv; }
#pragma unroll
    for (int cc = 0; cc < 5; ++cc) mods[((size_t)l * 5 + cc) * 6144 + n] = acc[cc] + b[l * 6144 + n];
}

__global__ void __launch_bounds__(256) nk_copy_x(const float* __restrict__ xp, const float* __restrict__ xs, float* __restrict__ x) {
    const size_t i = (size_t)blockIdx.x * 256 + threadIdx.x;
    const size_t half = (size_t)TP * DM / 4;
    ((float4*)x)[i] = i < half ? ((const float4*)xp)[i] : ((const float4*)xs)[i - half];
}

__global__ void __launch_bounds__(256) nk_normmod(const float* __restrict__ x, const float* __restrict__ g, const float* __restrict__ mods_l, int sh_off, int sc_off, float* __restrict__ h) {
    const int row = blockIdx.x * 4 + (threadIdx.x >> 6), lane = threadIdx.x & 63;
    const float* xr = x + (size_t)row * DM; float v[16]; float ss = 0.f;
#pragma unroll
    for (int i = 0; i < 16; ++i) { v[i] = xr[lane + 64 * i]; ss += v[i] * v[i]; }
    ss = wave_sum(ss); const float r = rsqrtf(ss * (1.f / DM) + EPS);
    const float* m = mods_l + (size_t)cond_of_row(row) * 6144;
#pragma unroll
    for (int i = 0; i < 16; ++i) { const int k = lane + 64 * i; h[(size_t)row * DM + k] = v[i] * r * g[k] * (1.f + m[sc_off + k]) + m[sh_off + k]; }
}

template <int GLU>
__global__ void __launch_bounds__(256) nk_gemm(const float* __restrict__ A, int lda, const float* __restrict__ B, int ldb, float* __restrict__ C, int ldc, int M, int N, int K, const float* __restrict__ bias) {
    __shared__ float As[16][65], Bs[16][65], Us[16][65];
    const int tx = threadIdx.x & 15, ty = threadIdx.x >> 4, m0 = blockIdx.y * 64, n0 = blockIdx.x * 64;
    float acc[4][4] = {}, acu[4][4] = {};
    for (int k0 = 0; k0 < K; k0 += 16) {
        for (int i = threadIdx.x; i < 1024; i += 256) { const int r = i >> 4, kk = i & 15; As[kk][r] = A[(size_t)(m0 + r) * lda + k0 + kk]; }
        for (int i = threadIdx.x; i < 1024; i += 256) { const int kk = i >> 6, cc = i & 63; const bool ok = n0 + cc < N; Bs[kk][cc] = ok ? B[(size_t)(k0 + kk) * ldb + n0 + cc] : 0.f;
            if (GLU) Us[kk][cc] = ok ? B[(size_t)(k0 + kk) * ldb + N + n0 + cc] : 0.f; }
        __syncthreads();
#pragma unroll
        for (int kk = 0; kk < 16; ++kk) { float a[4], b[4], u[4];
#pragma unroll
            for (int i = 0; i < 4; ++i) { a[i] = As[kk][ty * 4 + i]; b[i] = Bs[kk][tx * 4 + i]; u[i] = GLU ? Us[kk][tx * 4 + i] : 0.f; }
#pragma unroll
            for (int i = 0; i < 4; ++i)
#pragma unroll
                for (int j = 0; j < 4; ++j) { acc[i][j] += a[i] * b[j]; if (GLU) acu[i][j] += a[i] * u[j]; } }
        __syncthreads();
    }
#pragma unroll
    for (int i = 0; i < 4; ++i)
#pragma unroll
        for (int j = 0; j < 4; ++j) { const int n = n0 + tx * 4 + j; if (n < N) {
            float v = acc[i][j] + (bias ? bias[n] : 0.f);
            if (GLU) { const float u = acu[i][j] + (bias ? bias[N + n] : 0.f); v = GLU == 1 ? silu_f(v) * u : v * sigmoid_f(u); }
            C[(size_t)(m0 + ty * 4 + i) * ldc + n] = v; } }
}

__global__ void __launch_bounds__(256) nk_resid(float* __restrict__ x, const float* __restrict__ o, const float* __restrict__ mods_l, int g_off) {
    const size_t i = (size_t)blockIdx.x * 256 + threadIdx.x; const int row = (int)(i >> 10), k = (int)(i & 1023);
    x[i] += mods_l[(size_t)cond_of_row(row) * 6144 + g_off + k] * o[i];
}

__global__ void __launch_bounds__(256) nk_mla_fin1(const float* __restrict__ latq, const float* __restrict__ latkv, const float* __restrict__ gq, const float* __restrict__ gkv,
                                                   const float* __restrict__ cache_ckv_j  , float* __restrict__ qn, float* __restrict__ ckv, float* __restrict__ out, int j) {
    const int row = blockIdx.x * 4 + (threadIdx.x >> 6), lane = threadIdx.x & 63;
    if (row >= T) { const int b = (row - T) >> 8, s = (row - T) & 255;
#pragma unroll
        for (int i = 0; i < 4; ++i) ckv[(size_t)row * KVL + lane + 64 * i] = cache_ckv_j[((size_t)b * 2 * 256 + s) * 256 + lane + 64 * i];
        return; }
    float v[6]; float ss = 0.f;
#pragma unroll
    for (int i = 0; i < 6; ++i) { v[i] = latq[(size_t)row * QL + lane + 64 * i]; ss += v[i] * v[i]; }
    ss = wave_sum(ss); float r = rsqrtf(ss * (1.f / QL) + EPS);
#pragma unroll
    for (int i = 0; i < 6; ++i) qn[(size_t)row * QL + lane + 64 * i] = v[i] * r * gq[lane + 64 * i];
    ss = 0.f;
#pragma unroll
    for (int i = 0; i < 4; ++i) { v[i] = latkv[(size_t)row * 288 + lane + 64 * i]; ss += v[i] * v[i]; }
    ss = wave_sum(ss); r = rsqrtf(ss * (1.f / KVL) + EPS);
#pragma unroll
    for (int i = 0; i < 4; ++i) { const float c = v[i] * r * gkv[lane + 64 * i]; ckv[(size_t)row * KVL + lane + 64 * i] = c;
        if (row < TP) out[OUT_CKV + (((size_t)(row >> 8) * 2 + j) * 256 + (row & 255)) * 256 + lane + 64 * i] = c; }
    if (row < TP && lane < 32) out[OUT_KPE + (((size_t)(row >> 8) * 2 + j) * 256 + (row & 255)) * 32 + lane] = latkv[(size_t)row * 288 + 256 + lane];
}

__device__ __forceinline__ float rope_inv(int i) { return i == 0 ? 1.f : i == 1 ? 0.31622776601683794f : i == 2 ? 0.1f : i == 3 ? 0.031622776601683794f : i == 4 ? 0.01f : i == 5 ? 0.0031622776601683794f : i == 6 ? 0.001f : 0.00031622776601683794f; }
__device__ __forceinline__ void rope32(float* pe, int t) {
    const int rr = t >> 6, cc = t & 63;
#pragma unroll
    for (int i = 0; i < 8; ++i) {
        const float inv = rope_inv(i);
        float a = (float)rr * inv, s = sinf(a), c = cosf(a);
        float x1 = pe[i], x2 = pe[i + 8]; pe[i] = x1 * c - x2 * s; pe[i + 8] = x2 * c + x1 * s;
        a = (float)cc * inv; s = sinf(a); c = cosf(a);
        x1 = pe[16 + i]; x2 = pe[24 + i]; pe[16 + i] = x1 * c - x2 * s; pe[24 + i] = x2 * c + x1 * s;
    }
}
__global__ void __launch_bounds__(256) nk_mla_fin2(const float* __restrict__ qraw, const float* __restrict__ kvraw, const float* __restrict__ latkv, const float* __restrict__ cache_kpe_j,
                                                   const float* __restrict__ gqn, const float* __restrict__ gkn, float* __restrict__ Q, float* __restrict__ K) {
    const int idx = blockIdx.x * 256 + threadIdx.x, row = idx >> 4, h = idx & 15;
    const bool latent = row >= TP && row < T; const int tl = (row - TP) & 1023;
    if (row < T) {
        float q[96]; float ss = 0.f;
#pragma unroll
        for (int d = 0; d < 96; ++d) { q[d] = qraw[(size_t)row * 1536 + h * 96 + d]; ss += q[d] * q[d]; }
        const float r = rsqrtf(ss * (1.f / 96) + EPS);
#pragma unroll
        for (int d = 0; d < 96; ++d) q[d] = q[d] * r * gqn[d];
        if (latent) rope32(q + 64, tl);
#pragma unroll
        for (int d = 0; d < 96; ++d) Q[((size_t)row * 16 + h) * 96 + d] = q[d];
    }
    float k[96]; float ss = 0.f;
#pragma unroll
    for (int d = 0; d < 64; ++d) { k[d] = kvraw[(size_t)row * 2048 + h * 128 + d]; ss += k[d] * k[d]; }
#pragma unroll
    for (int d = 0; d < 32; ++d) { k[64 + d] = row < T ? latkv[(size_t)row * 288 + 256 + d] : cache_kpe_j[((size_t)((row - T) >> 8) * 2 * 256 + ((row - T) & 255)) * 32 + d]; ss += k[64 + d] * k[64 + d]; }
    const float r = rsqrtf(ss * (1.f / 96) + EPS);
#pragma unroll
    for (int d = 0; d < 96; ++d) k[d] = k[d] * r * gkn[d];
    if (latent) rope32(k + 64, tl);
#pragma unroll
    for (int d = 0; d < 96; ++d) K[((size_t)row * 16 + h) * 96 + d] = k[d];
}

__global__ void __launch_bounds__(64) nk_attn(const float* __restrict__ Q, const float* __restrict__ K, const float* __restrict__ KV  , float* __restrict__ O) {
    __shared__ float Ks[32][96], Vs[32][64];
    const int h = blockIdx.y, row = blockIdx.x * 64 + threadIdx.x;
    float q[96];
#pragma unroll
    for (int d = 0; d < 96; ++d) q[d] = Q[((size_t)row * 16 + h) * 96 + d];
    float o[64];
#pragma unroll
    for (int d = 0; d < 64; ++d) o[d] = 0.f;
    float m = -INFINITY, l = 0.f;
    int nkeys, kbase0, kbase1, n0;
    const int r0 = blockIdx.x * 64;
    if (r0 < TP) { nkeys = 256; n0 = 256; kbase0 = r0 & ~255; kbase1 = 0; }
    else { const int b = (r0 - TP) >> 10; nkeys = 1280; n0 = 256; kbase0 = T + b * 256; kbase1 = TP + b * 1024; }
    const float scale = rsqrtf(96.f);
    for (int k0 = 0; k0 < nkeys; k0 += 32) {
        __syncthreads();
        for (int i = threadIdx.x; i < 32 * 96; i += 64) { const int kk = i / 96, d = i % 96; const int key = k0 + kk; const int kr = key < n0 ? kbase0 + key : kbase1 + key - n0; Ks[kk][d] = K[((size_t)kr * 16 + h) * 96 + d]; }
        for (int i = threadIdx.x; i < 32 * 64; i += 64) { const int kk = i / 64, d = i % 64; const int key = k0 + kk; const int kr = key < n0 ? kbase0 + key : kbase1 + key - n0; Vs[kk][d] = KV[(size_t)kr * 2048 + h * 128 + 64 + d]; }
        __syncthreads();
        for (int kk = 0; kk < 32; ++kk) {
            float s = 0.f;
#pragma unroll
            for (int d = 0; d < 96; ++d) s += q[d] * Ks[kk][d];
            s *= scale;
            const float mn = fmaxf(m, s), a = expf(m - mn), p = expf(s - mn);
            l = l * a + p;
#pragma unroll
            for (int d = 0; d < 64; ++d) o[d] = o[d] * a + p * Vs[kk][d];
            m = mn;
        }
    }
    const float il = 1.f / l;
#pragma unroll
    for (int d = 0; d < 64; ++d) O[(size_t)row * DM + h * 64 + d] = o[d] * il;
}

__global__ void __launch_bounds__(256) nk_dwconv_ln(const float* __restrict__ u, const float* __restrict__ wdw, const float* __restrict__ bdw, const float* __restrict__ gln, const float* __restrict__ bln, float* __restrict__ v) {
    const int row = blockIdx.x * 4 + (threadIdx.x >> 6), lane = threadIdx.x & 63;
    int t, L; row_pos(row, t, L);
    float y[16]; float s = 0.f;
#pragma unroll
    for (int i = 0; i < 16; ++i) { const int c = lane + 64 * i; float a = bdw[c];
        for (int k = 0; k < 31; ++k) { const int tt = t + k - 15; if (tt >= 0 && tt < L) a += u[(size_t)(row + k - 15) * DM + c] * wdw[k * DM + c]; }
        y[i] = a; s += a; }
    const float mean = wave_sum(s) * (1.f / DM); float q = 0.f;
#pragma unroll
    for (int i = 0; i < 16; ++i) { y[i] -= mean; q += y[i] * y[i]; }
    const float r = rsqrtf(wave_sum(q) * (1.f / DM) + EPS);
#pragma unroll
    for (int i = 0; i < 16; ++i) { const int c = lane + 64 * i; v[(size_t)row * DM + c] = silu_f(y[i] * r * gln[c] + bln[c]); }
}

__global__ void __launch_bounds__(256) nk_ssd_conv(const float* __restrict__ xpre  , const float* __restrict__ dtraw  , const float* __restrict__ wc, const float* __restrict__ bc, const float* __restrict__ dtb, float* __restrict__ xbc, float* __restrict__ dt) {
    const size_t i = (size_t)blockIdx.x * 256 + threadIdx.x; const int row = (int)(i / 3136), c = (int)(i % 3136);
    int t, L; row_pos(row, t, L);
    if (c < SSCD) { float a = bc[c];
#pragma unroll
        for (int k = 0; k < 5; ++k) { const int tt = t + k - 2; if (tt >= 0 && tt < L) a += xpre[(size_t)(row + k - 2) * SSCD + c] * wc[k * SSCD + c]; }
        xbc[(size_t)row * SSCD + c] = silu_f(a);
    } else { const int e = c - SSCD; dt[(size_t)row * 64 + e] = softplus_f(dtraw[(size_t)row * 64 + e] + dtb[e]); }
}
__global__ void __launch_bounds__(64) nk_ssd_scan(const float* __restrict__ xbc, const float* __restrict__ dt, const float* __restrict__ alog, const float* __restrict__ dsk, const float* __restrict__ st0  ,
                                                  float* __restrict__ y  , float* __restrict__ out, int dir) {
    const int h = blockIdx.x, seq = blockIdx.y, p = threadIdx.x, g = h >> 3;
    int r0, L; if (seq < 16) { r0 = seq * 256; L = 256; } else { r0 = TP + (seq - 16) * 1024; L = 1024; }
    const float a = -expf(alog[dir * 32 + h]), dd = dsk[dir * 32 + h];
    float hs[128];
    if (seq < 16) {
#pragma unroll
        for (int n = 0; n < 128; ++n) hs[n] = 0.f;
    } else { const float* s0 = st0 + ((((size_t)(seq - 16) * 2 + dir) * 32 + h) * 64 + p) * 128;
#pragma unroll
        for (int n = 0; n < 128; ++n) hs[n] = s0[n]; }
    for (int s = 0; s < L; ++s) {
        const int row = r0 + (dir == 0 ? s : L - 1 - s);
        const float dtv = dt[(size_t)row * 64 + dir * 32 + h], da = expf(dtv * a), xv = xbc[(size_t)row * SSCD + h * 64 + p], dtx = dtv * xv;
        const float* Bp = xbc + (size_t)row * SSCD + SSI + g * 128; const float* Cp = Bp + 512;
        float acc = 0.f;
#pragma unroll
        for (int n = 0; n < 128; ++n) { hs[n] = hs[n] * da + dtx * Bp[n]; acc += Cp[n] * hs[n]; }
        float* yp = y + (size_t)row * SSI + h * 64 + p; const float yv = acc + xv * dd; *yp = dir == 0 ? yv : *yp + yv;
    }
    if (seq < 16) { float* o = out + OUT_SSM + ((((size_t)seq * 2 + dir) * 32 + h) * 64 + p) * 128;
#pragma unroll
        for (int n = 0; n < 128; ++n) o[n] = hs[n]; }
}
__global__ void __launch_bounds__(256) nk_ssd_gate(const float* __restrict__ y, const float* __restrict__ z  , const float* __restrict__ gn, float* __restrict__ yn) {
    const int row = blockIdx.x * 4 + (threadIdx.x >> 6), lane = threadIdx.x & 63;
#pragma unroll
    for (int g = 0; g < 4; ++g) { float v[8]; float ss = 0.f;
#pragma unroll
        for (int i = 0; i < 8; ++i) { const int c = g * 512 + lane + 64 * i; v[i] = y[(size_t)row * SSI + c] * silu_f(z[(size_t)row * SSI + c]); ss += v[i] * v[i]; }
        const float r = rsqrtf(wave_sum(ss) * (1.f / 512) + EPS);
#pragma unroll
        for (int i = 0; i < 8; ++i) { const int c = g * 512 + lane + 64 * i; yn[(size_t)row * SSI + c] = v[i] * r * gn[c]; } }
}

struct In {
    const float *x_prompt, *x_sample, *cache_ckv, *cache_kpe, *state_ssm, *c, *c_ctx, *w_ada, *b_ada, *g_norm1, *g_norm2,
        *mla_w_dq, *mla_g_q, *mla_w_uq, *mla_w_dkv, *mla_g_kv, *mla_w_ukv, *mla_g_qn, *mla_g_kn, *mla_w_o,
        *cv_w_pw1, *cv_b_pw1, *cv_w_dw, *cv_b_dw, *cv_g_ln, *cv_b_ln, *cv_w_pw2, *cv_b_pw2,
        *ssd_w_in, *ssd_w_conv, *ssd_b_conv, *ssd_dt_bias, *ssd_a_log, *ssd_d, *ssd_g_norm, *ssd_w_out, *ffn_w_in, *ffn_w_out;
};

template <int GLU>
static void ngemm(hipStream_t s, const float* A, int lda, const float* B, int ldb, float* C, int ldc, int M, int N, int K, const float* bias) {
    nk_gemm<GLU><<<dim3((N + 63) / 64, M / 64), 256, 0, s>>>(A, lda, B, ldb, C, ldc, M, N, K, bias);
}

static void naive_forward(const In& I, float* out, float* ws, hipStream_t s) {
    size_t off = 0; auto take = [&](size_t n) { float* p = ws + off; off += (n + 255) & ~(size_t)255; return p; };
    float* mods = take(4 * 5 * 6144);
    float* h = take((size_t)T * DM);
    float* t2 = take((size_t)T * DM);
    float* latkv = take((size_t)T * 288);
    float* qn = take((size_t)T * QL);
    float* ckv = take((size_t)(T + NCTX) * KVL);
    float* dtb = take((size_t)T * 64);
    float* dtraw = take((size_t)T * 64);
    float* arena = ws + off;
    float* latq = arena; float* qraw = latq + (size_t)T * QL; float* kvraw = qraw + (size_t)T * 1536; float* Qb = kvraw + (size_t)(T + NCTX) * 2048; float* Kb = Qb + (size_t)T * 1536;
    float* t1 = arena;
    float* zb = arena; float* xpre = zb + (size_t)T * SSI; float* xbc = xpre + (size_t)T * SSCD; float* yb = xpre;
    float* x = out + OUT_YP;
    nk_adaln<<<dim3(24, 4), 256, 0, s>>>(I.c, I.c_ctx, I.w_ada, I.b_ada, mods);
    nk_copy_x<<<T * DM / 4 / 256, 256, 0, s>>>(I.x_prompt, I.x_sample, x);
    for (int i = 0; i < 4; ++i) {
        const int kind = i % 3, j = i / 3; const float* ml = mods + (size_t)i * 5 * 6144;
        nk_normmod<<<T / 4, 256, 0, s>>>(x, I.g_norm1 + i * DM, ml, 0, 1024, h);
        if (kind == 0) {
            ngemm<0>(s, h, DM, I.mla_w_dq + (size_t)j * DM * QL, QL, latq, QL, T, QL, DM, nullptr);
            ngemm<0>(s, h, DM, I.mla_w_dkv + (size_t)j * DM * 288, 288, latkv, 288, T, 288, DM, nullptr);
            nk_mla_fin1<<<(T + NCTX) / 4, 256, 0, s>>>(latq, latkv, I.mla_g_q + j * QL, I.mla_g_kv + j * KVL, I.cache_ckv + (size_t)j * 65536, qn, ckv, out, j);
            ngemm<0>(s, qn, QL, I.mla_w_uq + (size_t)j * QL * 1536, 1536, qraw, 1536, T, 1536, QL, nullptr);
            ngemm<0>(s, ckv, KVL, I.mla_w_ukv + (size_t)j * KVL * 2048, 2048, kvraw, 2048, T + NCTX, 2048, KVL, nullptr);
            nk_mla_fin2<<<(T + NCTX) * 16 / 256, 256, 0, s>>>(qraw, kvraw, latkv, I.cache_kpe + (size_t)j * 8192, I.mla_g_qn + j * 96, I.mla_g_kn + j * 96, Qb, Kb);
            nk_attn<<<dim3(T / 64, 16), 64, 0, s>>>(Qb, Kb, kvraw, h);
            ngemm<0>(s, h, DM, I.mla_w_o + (size_t)j * DM * DM, DM, t2, DM, T, DM, DM, nullptr);
        } else if (kind == 1) {
            ngemm<2>(s, h, DM, I.cv_w_pw1, 2048, t1, DM, T, DM, DM, I.cv_b_pw1);
            nk_dwconv_ln<<<T / 4, 256, 0, s>>>(t1, I.cv_w_dw, I.cv_b_dw, I.cv_g_ln, I.cv_b_ln, h);
            ngemm<0>(s, h, DM, I.cv_w_pw2, DM, t2, DM, T, DM, DM, I.cv_b_pw2);
        } else {
            ngemm<0>(s, h, DM, I.ssd_w_in, SSIN, zb, SSI, T, SSI, DM, nullptr);
            ngemm<0>(s, h, DM, I.ssd_w_in + SSI, SSIN, xpre, SSCD, T, SSCD, DM, nullptr);
            ngemm<0>(s, h, DM, I.ssd_w_in + SSI + SSCD, SSIN, dtraw, 64, T, 64, DM, nullptr);
            nk_ssd_conv<<<T * 3136 / 256, 256, 0, s>>>(xpre, dtraw, I.ssd_w_conv, I.ssd_b_conv, I.ssd_dt_bias, xbc, dtb);
            nk_ssd_scan<<<dim3(32, 20), 64, 0, s>>>(xbc, dtb, I.ssd_a_log, I.ssd_d, I.state_ssm, yb, out, 0);
            nk_ssd_scan<<<dim3(32, 20), 64, 0, s>>>(xbc, dtb, I.ssd_a_log, I.ssd_d, I.state_ssm, yb, out, 1);
            nk_ssd_gate<<<T / 4, 256, 0, s>>>(yb, zb, I.ssd_g_norm, xbc);
            ngemm<0>(s, xbc, SSI, I.ssd_w_out, DM, t2, DM, T, DM, SSI, nullptr);
        }
        nk_resid<<<T * DM / 256, 256, 0, s>>>(x, t2, ml, 2048);
        nk_normmod<<<T / 4, 256, 0, s>>>(x, I.g_norm2 + i * DM, ml, 3072, 4096, h);
        ngemm<1>(s, h, DM, I.ffn_w_in + (size_t)i * DM * 5632, 5632, t1, FFH, T, FFH, DM, nullptr);
        ngemm<0>(s, t1, FFH, I.ffn_w_out + (size_t)i * FFH * DM, DM, t2, DM, T, DM, FFH, nullptr);
        nk_resid<<<T * DM / 256, 256, 0, s>>>(x, t2, ml, 5120);
    }
}

extern "C" void kernel_launch(void* const* d_in, const int* in_sizes, int n_in, void* d_out, int out_size, void* d_ws, size_t ws_size, hipStream_t stream) {
    In I;
    const float** p = (const float**)&I;
    for (int i = 0; i < 38; ++i) p[i] = (const float*)d_in[i];
    naive_forward(I, (float*)d_out, (float*)d_ws, stream);
}
```

```cpp
#include <hip/hip_runtime.h>
#include <cstdint>
#include <cstdio>

constexpr int DM = 1024, T = 8192, TP = 4096;
constexpr int NCTX = 1024;
constexpr int QL = 384, KVL = 256, ROPE = 32, NOPE = 64, QKD = 96, VH = 64, NH = 16;
constexpr int FFH = 2816;
constexpr int SSI = 2048, SSH = 32, SSP = 64, SSN = 128, SSG = 4, SSCD = 3072, SSIN = 5184;
constexpr float EPS = 1e-6f;
constexpr size_t OUT_YP = 0, OUT_CKV = 8388608, OUT_KPE = 10485760, OUT_SSM = 10747904;

__device__ __forceinline__ int cond_of_row(int r) { return r < TP ? 0 : 1 + ((r - TP) >> 10); }
__device__ __forceinline__ void row_pos(int r, int& t, int& L) { if (r < TP) { t = r & 255; L = 256; } else { t = (r - TP) & 1023; L = 1024; } }
__device__ __forceinline__ float silu_f(float x) { return x / (1.f + expf(-x)); }
__device__ __forceinline__ float sigmoid_f(float x) { return 1.f / (1.f + expf(-x)); }
__device__ __forceinline__ float softplus_f(float x) { return fmaxf(x, 0.f) + log1pf(expf(-fabsf(x))); }
__device__ __forceinline__ float wave_sum(float v) {
#pragma unroll
    for (int o = 1; o < 64; o <<= 1) v += __shfl_xor(v, o);
    return v;
}

__global__ void __launch_bounds__(256) nk_adaln(const float* __restrict__ c, const float* __restrict__ cctx, const float* __restrict__ w, const float* __restrict__ b, float* __restrict__ mods) {
    __shared__ float s[5][DM];
    const int l = blockIdx.y, n = blockIdx.x * 256 + threadIdx.x;
    for (int i = threadIdx.x; i < 5 * DM; i += 256) { const int cc = i / DM, k = i % DM; const float v = cc == 0 ? cctx[k] : c[(cc - 1) * DM + k]; s[cc][k] = silu_f(v); }
    __syncthreads();
    const float* W = w + (size_t)l * DM * 6144;
    float acc[5] = {0.f, 0.f, 0.f, 0.f, 0.f};
    for (int k = 0; k < DM; ++k) { const float wv = W[(size_t)k * 6144 + n];
#pragma unroll
        for (int cc = 0; cc < 5; ++cc) acc[cc] += s[cc][k] * wv; }
#pragma unroll
    for (int cc = 0; cc < 5; ++cc) mods[((size_t)l * 5 + cc) * 6144 + n] = acc[cc] + b[l * 6144 + n];
}

__global__ void __launch_bounds__(256) nk_copy_x(const float* __restrict__ xp, const float* __restrict__ xs, float* __restrict__ x) {
    const size_t i = (size_t)blockIdx.x * 256 + threadIdx.x;
    const size_t half = (size_t)TP * DM / 4;
    ((float4*)x)[i] = i < half ? ((const float4*)xp)[i] : ((const float4*)xs)[i - half];
}

__global__ void __launch_bounds__(256) nk_normmod(const float* __restrict__ x, const float* __restrict__ g, const float* __restrict__ mods_l, int sh_off, int sc_off, float* __restrict__ h) {
    const int row = blockIdx.x * 4 + (threadIdx.x >> 6), lane = threadIdx.x & 63;
    const float* xr = x + (size_t)row * DM; float v[16]; float ss = 0.f;
#pragma unroll
    for (int i = 0; i < 16; ++i) { v[i] = xr[lane + 64 * i]; ss += v[i] * v[i]; }
    ss = wave_sum(ss); const float r = rsqrtf(ss * (1.f / DM) + EPS);
    const float* m = mods_l + (size_t)cond_of_row(row) * 6144;
#pragma unroll
    for (int i = 0; i < 16; ++i) { const int k = lane + 64 * i; h[(size_t)row * DM + k] = v[i] * r * g[k] * (1.f + m[sc_off + k]) + m[sh_off + k]; }
}

template <int GLU>
__global__ void __launch_bounds__(256) nk_gemm(const float* __restrict__ A, int lda, const float* __restrict__ B, int ldb, float* __restrict__ C, int ldc, int M, int N, int K, const float* __restrict__ bias) {
    __shared__ float As[16][65], Bs[16][65], Us[16][65];
    const int tx = threadIdx.x & 15, ty = threadIdx.x >> 4, m0 = blockIdx.y * 64, n0 = blockIdx.x * 64;
    float acc[4][4] = {}, acu[4][4] = {};
    for (int k0 = 0; k0 < K; k0 += 16) {
        for (int i = threadIdx.x; i < 1024; i += 256) { const int r = i >> 4, kk = i & 15; As[kk][r] = A[(size_t)(m0 + r) * lda + k0 + kk]; }
        for (int i = threadIdx.x; i < 1024; i += 256) { const int kk = i >> 6, cc = i & 63; const bool ok = n0 + cc < N; Bs[kk][cc] = ok ? B[(size_t)(k0 + kk) * ldb + n0 + cc] : 0.f;
            if (GLU) Us[kk][cc] = ok ? B[(size_t)(k0 + kk) * ldb + N + n0 + cc] : 0.f; }
        __syncthreads();
#pragma unroll
        for (int kk = 0; kk < 16; ++kk) { float a[4], b[4], u[4];
#pragma unroll
            for (int i = 0; i < 4; ++i) { a[i] = As[kk][ty * 4 + i]; b[i] = Bs[kk][tx * 4 + i]; u[i] = GLU ? Us[kk][tx * 4 + i] : 0.f; }
#pragma unroll
            for (int i = 0; i < 4; ++i)
#pragma unroll
                for (int j = 0; j < 4; ++j) { acc[i][j] += a[i] * b[j]; if (GLU) acu[i][j] += a[i] * u[j]; } }
        __syncthreads();
    }
#pragma unroll
    for (int i = 0; i < 4; ++i)
#pragma unroll
        for (int j = 0; j < 4; ++j) { const int n = n0 + tx * 4 + j; if (n < N) {
            float v = acc[i][j] + (bias ? bias[n] : 0.f);
            if (GLU) { const float u = acu[i][j] + (bias ? bias[N + n] : 0.f); v = GLU == 1 ? silu_f(v) * u : v * sigmoid_f(u); }
            C[(size_t)(m0 + ty * 4 + i) * ldc + n] = v; } }
}

__global__ void __launch_bounds__(256) nk_resid(float* __restrict__ x, const float* __restrict__ o, const float* __restrict__ mods_l, int g_off) {
    const size_t i = (size_t)blockIdx.x * 256 + threadIdx.x; const int row = (int)(i >> 10), k = (int)(i & 1023);
    x[i] += mods_l[(size_t)cond_of_row(row) * 6144 + g_off + k] * o[i];
}

__global__ void __launch_bounds__(256) nk_mla_fin1(const float* __restrict__ latq, const float* __restrict__ latkv, const float* __restrict__ gq, const float* __restrict__ gkv,
                                                   const float* __restrict__ cache_ckv_j  , float* __restrict__ qn, float* __restrict__ ckv, float* __restrict__ out, int j) {
    const int row = blockIdx.x * 4 + (threadIdx.x >> 6), lane = threadIdx.x & 63;
    if (row >= T) { const int b = (row - T) >> 8, s = (row - T) & 255;
#pragma unroll
        for (int i = 0; i < 4; ++i) ckv[(size_t)row * KVL + lane + 64 * i] = cache_ckv_j[((size_t)b * 2 * 256 + s) * 256 + lane + 64 * i];
        return; }
    float v[6]; float ss = 0.f;
#pragma unroll
    for (int i = 0; i < 6; ++i) { v[i] = latq[(size_t)row * QL + lane + 64 * i]; ss += v[i] * v[i]; }
    ss = wave_sum(ss); float r = rsqrtf(ss * (1.f / QL) + EPS);
#pragma unroll
    for (int i = 0; i < 6; ++i) qn[(size_t)row * QL + lane + 64 * i] = v[i] * r * gq[lane + 64 * i];
    ss = 0.f;
#pragma unroll
    for (int i = 0; i < 4; ++i) { v[i] = latkv[(size_t)row * 288 + lane + 64 * i]; ss += v[i] * v[i]; }
    ss = wave_sum(ss); r = rsqrtf(ss * (1.f / KVL) + EPS);
#pragma unroll
    for (int i = 0; i < 4; ++i) { const float c = v[i] * r * gkv[lane + 64 * i]; ckv[(size_t)row * KVL + lane + 64 * i] = c;
        if (row < TP) out[OUT_CKV + (((size_t)(row >> 8) * 2 + j) * 256 + (row & 255)) * 256 + lane + 64 * i] = c; }
    if (row < TP && lane < 32) out[OUT_KPE + (((size_t)(row >> 8) * 2 + j) * 256 + (row & 255)) * 32 + lane] = latkv[(size_t)row * 288 + 256 + lane];
}

__device__ __forceinline__ float rope_inv(int i) { return i == 0 ? 1.f : i == 1 ? 0.31622776601683794f : i == 2 ? 0.1f : i == 3 ? 0.031622776601683794f : i == 4 ? 0.01f : i == 5 ? 0.0031622776601683794f : i == 6 ? 0.001f : 0.00031622776601683794f; }
__device__ __forceinline__ void rope32(float* pe, int t) {
    const int rr = t >> 6, cc = t & 63;
#pragma unroll
    for (int i = 0; i < 8; ++i) {
        const float inv = rope_inv(i);
        float a = (float)rr * inv, s = sinf(a), c = cosf(a);
        float x1 = pe[i], x2 = pe[i + 8]; pe[i] = x1 * c - x2 * s; pe[i + 8] = x2 * c + x1 * s;
        a = (float)cc * inv; s = sinf(a); c = cosf(a);
        x1 = pe[16 + i]; x2 = pe[24 + i]; pe[16 + i] = x1 * c - x2 * s; pe[24 + i] = x2 * c + x1 * s;
    }
}
__global__ void __launch_bounds__(256) nk_mla_fin2(const float* __restrict__ qraw, const float* __restrict__ kvraw, const float* __restrict__ latkv, const float* __restrict__ cache_kpe_j,
                                                   const float* __restrict__ gqn, const float* __restrict__ gkn, float* __restrict__ Q, float* __restrict__ K) {
    const int idx = blockIdx.x * 256 + threadIdx.x, row = idx >> 4, h = idx & 15;
    const bool latent = row >= TP && row < T; const int tl = (row - TP) & 1023;
    if (row < T) {
        float q[96]; float ss = 0.f;
#pragma unroll
        for (int d = 0; d < 96; ++d) { q[d] = qraw[(size_t)row * 1536 + h * 96 + d]; ss += q[d] * q[d]; }
        const float r = rsqrtf(ss * (1.f / 96) + EPS);
#pragma unroll
        for (int d = 0; d < 96; ++d) q[d] = q[d] * r * gqn[d];
        if (latent) rope32(q + 64, tl);
#pragma unroll
        for (int d = 0; d < 96; ++d) Q[((size_t)row * 16 + h) * 96 + d] = q[d];
    }
    float k[96]; float ss = 0.f;
#pragma unroll
    for (int d = 0; d < 64; ++d) { k[d] = kvraw[(size_t)row * 2048 + h * 128 + d]; ss += k[d] * k[d]; }
#pragma unroll
    for (int d = 0; d < 32; ++d) { k[64 + d] = row < T ? latkv[(size_t)row * 288 + 256 + d] : cache_kpe_j[((size_t)((row - T) >> 8) * 2 * 256 + ((row - T) & 255)) * 32 + d]; ss += k[64 + d] * k[64 + d]; }
    const float r = rsqrtf(ss * (1.f / 96) + EPS);
#pragma unroll
    for (int d = 0; d < 96; ++d) k[d] = k[d] * r * gkn[d];
    if (latent) rope32(k + 64, tl);
#pragma unroll
    for (int d = 0; d < 96; ++d) K[((size_t)row * 16 + h) * 96 + d] = k[d];
}

__global__ void __launch_bounds__(64) nk_attn(const float* __restrict__ Q, const float* __restrict__ K, const float* __restrict__ KV  , float* __restrict__ O) {
    __shared__ float Ks[32][96], Vs[32][64];
    const int h = blockIdx.y, row = blockIdx.x * 64 + threadIdx.x;
    float q[96];
#pragma unroll
    for (int d = 0; d < 96; ++d) q[d] = Q[((size_t)row * 16 + h) * 96 + d];
    float o[64];
#pragma unroll
    for (int d = 0; d < 64; ++d) o[d] = 0.f;
    float m = -INFINITY, l = 0.f;
    int nkeys, kbase0, kbase1, n0;
    const int r0 = blockIdx.x * 64;
    if (r0 < TP) { nkeys = 256; n0 = 256; kbase0 = r0 & ~255; kbase1 = 0; }
    else { const int b = (r0 - TP) >> 10; nkeys = 1280; n0 = 256; kbase0 = T + b * 256; kbase1 = TP + b * 1024; }
    const float scale = rsqrtf(96.f);
    for (int k0 = 0; k0 < nkeys; k0 += 32) {
        __syncthreads();
        for (int i = threadIdx.x; i < 32 * 96; i += 64) { const int kk = i / 96, d = i % 96; const int key = k0 + kk; const int kr = key < n0 ? kbase0 + key : kbase1 + key - n0; Ks[kk][d] = K[((size_t)kr * 16 + h) * 96 + d]; }
        for (int i = threadIdx.x; i < 32 * 64; i += 64) { const int kk = i / 64, d = i % 64; const int key = k0 + kk; const int kr = key < n0 ? kbase0 + key : kbase1 + key - n0; Vs[kk][d] = KV[(size_t)kr * 2048 + h * 128 + 64 + d]; }
        __syncthreads();
        for (int kk = 0; kk < 32; ++kk) {
            float s = 0.f;
#pragma unroll
            for (int d = 0; d < 96; ++d) s += q[d] * Ks[kk][d];
            s *= scale;
            const float mn = fmaxf(m, s), a = expf(m - mn), p = expf(s - mn);
            l = l * a + p;
#pragma unroll
            for (int d = 0; d < 64; ++d) o[d] = o[d] * a + p * Vs[kk][d];
            m = mn;
        }
    }
    const float il = 1.f / l;
#pragma unroll
    for (int d = 0; d < 64; ++d) O[(size_t)row * DM + h * 64 + d] = o[d] * il;
}

__global__ void __launch_bounds__(256) nk_dwconv_ln(const float* __restrict__ u, const float* __restrict__ wdw, const float* __restrict__ bdw, const float* __restrict__ gln, const float* __restrict__ bln, float* __restrict__ v) {
    const int row = blockIdx.x * 4 + (threadIdx.x >> 6), lane = threadIdx.x & 63;
    int t, L; row_pos(row, t, L);
    float y[16]; float s = 0.f;
#pragma unroll
    for (int i = 0; i < 16; ++i) { const int c = lane + 64 * i; float a = bdw[c];
        for (int k = 0; k < 31; ++k) { const int tt = t + k - 15; if (tt >= 0 && tt < L) a += u[(size_t)(row + k - 15) * DM + c] * wdw[k * DM + c]; }
        y[i] = a; s += a; }
    const float mean = wave_sum(s) * (1.f / DM); float q = 0.f;
#pragma unroll
    for (int i = 0; i < 16; ++i) { y[i] -= mean; q += y[i] * y[i]; }
    const float r = rsqrtf(wave_sum(q) * (1.f / DM) + EPS);
#pragma unroll
    for (int i = 0; i < 16; ++i) { const int c = lane + 64 * i; v[(size_t)row * DM + c] = silu_f(y[i] * r * gln[c] + bln[c]); }
}

__global__ void __launch_bounds__(256) nk_ssd_conv(const float* __restrict__ xpre  , const float* __restrict__ dtraw  , const float* __restrict__ wc, const float* __restrict__ bc, const float* __restrict__ dtb, float* __restrict__ xbc, float* __restrict__ dt) {
    const size_t i = (size_t)blockIdx.x * 256 + threadIdx.x; const int row = (int)(i / 3136), c = (int)(i % 3136);
    int t, L; row_pos(row, t, L);
    if (c < SSCD) { float a = bc[c];
#pragma unroll
        for (int k = 0; k < 5; ++k) { const int tt = t + k - 2; if (tt >= 0 && tt < L) a += xpre[(size_t)(row + k - 2) * SSCD + c] * wc[k * SSCD + c]; }
        xbc[(size_t)row * SSCD + c] = silu_f(a);
    } else { const int e = c - SSCD; dt[(size_t)row * 64 + e] = softplus_f(dtraw[(size_t)row * 64 + e] + dtb[e]); }
}
__global__ void __launch_bounds__(64) nk_ssd_scan(const float* __restrict__ xbc, const float* __restrict__ dt, const float* __restrict__ alog, const float* __restrict__ dsk, const float* __restrict__ st0  ,
                                                  float* __restrict__ y  , float* __restrict__ out, int dir) {
    const int h = blockIdx.x, seq = blockIdx.y, p = threadIdx.x, g = h >> 3;
    int r0, L; if (seq < 16) { r0 = seq * 256; L = 256; } else { r0 = TP + (seq - 16) * 1024; L = 1024; }
    const float a = -expf(alog[dir * 32 + h]), dd = dsk[dir * 32 + h];
    float hs[128];
    if (seq < 16) {
#pragma unroll
        for (int n = 0; n < 128; ++n) hs[n] = 0.f;
    } else { const float* s0 = st0 + ((((size_t)(seq - 16) * 2 + dir) * 32 + h) * 64 + p) * 128;
#pragma unroll
        for (int n = 0; n < 128; ++n) hs[n] = s0[n]; }
    for (int s = 0; s < L; ++s) {
        const int row = r0 + (dir == 0 ? s : L - 1 - s);
        const float dtv = dt[(size_t)row * 64 + dir * 32 + h], da = expf(dtv * a), xv = xbc[(size_t)row * SSCD + h * 64 + p], dtx = dtv * xv;
        const float* Bp = xbc + (size_t)row * SSCD + SSI + g * 128; const float* Cp = Bp + 512;
        float acc = 0.f;
#pragma unroll
        for (int n = 0; n < 128; ++n) { hs[n] = hs[n] * da + dtx * Bp[n]; acc += Cp[n] * hs[n]; }
        float* yp = y + (size_t)row * SSI + h * 64 + p; const float yv = acc + xv * dd; *yp = dir == 0 ? yv : *yp + yv;
    }
    if (seq < 16) { float* o = out + OUT_SSM + ((((size_t)seq * 2 + dir) * 32 + h) * 64 + p) * 128;
#pragma unroll
        for (int n = 0; n < 128; ++n) o[n] = hs[n]; }
}
__global__ void __launch_bounds__(256) nk_ssd_gate(const float* __restrict__ y, const float* __restrict__ z  , const float* __restrict__ gn, float* __restrict__ yn) {
    const int row = blockIdx.x * 4 + (threadIdx.x >> 6), lane = threadIdx.x & 63;
#pragma unroll
    for (int g = 0; g < 4; ++g) { float v[8]; float ss = 0.f;
#pragma unroll
        for (int i = 0; i < 8; ++i) { const int c = g * 512 + lane + 64 * i; v[i] = y[(size_t)row * SSI + c] * silu_f(z[(size_t)row * SSI + c]); ss += v[i] * v[i]; }
        const float r = rsqrtf(wave_sum(ss) * (1.f / 512) + EPS);
#pragma unroll
        for (int i = 0; i < 8; ++i) { const int c = g * 512 + lane + 64 * i; yn[(size_t)row * SSI + c] = v[i] * r * gn[c]; } }
}

struct In {
    const float *x_prompt, *x_sample, *cache_ckv, *cache_kpe, *state_ssm, *c, *c_ctx, *w_ada, *b_ada, *g_norm1, *g_norm2,
        *mla_w_dq, *mla_g_q, *mla_w_uq, *mla_w_dkv, *mla_g_kv, *mla_w_ukv, *mla_g_qn, *mla_g_kn, *mla_w_o,
        *cv_w_pw1, *cv_b_pw1, *cv_w_dw, *cv_b_dw, *cv_g_ln, *cv_b_ln, *cv_w_pw2, *cv_b_pw2,
        *ssd_w_in, *ssd_w_conv, *ssd_b_conv, *ssd_dt_bias, *ssd_a_log, *ssd_d, *ssd_g_norm, *ssd_w_out, *ffn_w_in, *ffn_w_out;
};

template <int GLU>
static void ngemm(hipStream_t s, const float* A, int lda, const float* B, int ldb, float* C, int ldc, int M, int N, int K, const float* bias) {
    nk_gemm<GLU><<<dim3((N + 63) / 64, M / 64), 256, 0, s>>>(A, lda, B, ldb, C, ldc, M, N, K, bias);
}

static void naive_forward(const In& I, float* out, float* ws, hipStream_t s, int start_sub) {
    size_t off = 0; auto take = [&](size_t n) { float* p = ws + off; off += (n + 255) & ~(size_t)255; return p; };
    float* mods = take(4 * 5 * 6144);
    float* h = take((size_t)T * DM);
    float* t2 = take((size_t)T * DM);
    float* latkv = take((size_t)T * 288);
    float* qn = take((size_t)T * QL);
    float* ckv = take((size_t)(T + NCTX) * KVL);
    float* dtb = take((size_t)T * 64);
    float* dtraw = take((size_t)T * 64);
    float* arena = ws + off;
    float* latq = arena; float* qraw = latq + (size_t)T * QL; float* kvraw = qraw + (size_t)T * 1536; float* Qb = kvraw + (size_t)(T + NCTX) * 2048; float* Kb = Qb + (size_t)T * 1536;
    float* t1 = arena;
    float* zb = arena; float* xpre = zb + (size_t)T * SSI; float* xbc = xpre + (size_t)T * SSCD; float* yb = xpre;
    float* x = out + OUT_YP;
    nk_adaln<<<dim3(24, 4), 256, 0, s>>>(I.c, I.c_ctx, I.w_ada, I.b_ada, mods);
    if (start_sub == 0) nk_copy_x<<<T * DM / 4 / 256, 256, 0, s>>>(I.x_prompt, I.x_sample, x);
    for (int i = start_sub / 2; i < 4; ++i) {
        const int kind = i % 3, j = i / 3; const float* ml = mods + (size_t)i * 5 * 6144;
        if (2 * i >= start_sub) {
        nk_normmod<<<T / 4, 256, 0, s>>>(x, I.g_norm1 + i * DM, ml, 0, 1024, h);
        if (kind == 0) {
            ngemm<0>(s, h, DM, I.mla_w_dq + (size_t)j * DM * QL, QL, latq, QL, T, QL, DM, nullptr);
            ngemm<0>(s, h, DM, I.mla_w_dkv + (size_t)j * DM * 288, 288, latkv, 288, T, 288, DM, nullptr);
            nk_mla_fin1<<<(T + NCTX) / 4, 256, 0, s>>>(latq, latkv, I.mla_g_q + j * QL, I.mla_g_kv + j * KVL, I.cache_ckv + (size_t)j * 65536, qn, ckv, out, j);
            ngemm<0>(s, qn, QL, I.mla_w_uq + (size_t)j * QL * 1536, 1536, qraw, 1536, T, 1536, QL, nullptr);
            ngemm<0>(s, ckv, KVL, I.mla_w_ukv + (size_t)j * KVL * 2048, 2048, kvraw, 2048, T + NCTX, 2048, KVL, nullptr);
            nk_mla_fin2<<<(T + NCTX) * 16 / 256, 256, 0, s>>>(qraw, kvraw, latkv, I.cache_kpe + (size_t)j * 8192, I.mla_g_qn + j * 96, I.mla_g_kn + j * 96, Qb, Kb);
            nk_attn<<<dim3(T / 64, 16), 64, 0, s>>>(Qb, Kb, kvraw, h);
            ngemm<0>(s, h, DM, I.mla_w_o + (size_t)j * DM * DM, DM, t2, DM, T, DM, DM, nullptr);
        } else if (kind == 1) {
            ngemm<2>(s, h, DM, I.cv_w_pw1, 2048, t1, DM, T, DM, DM, I.cv_b_pw1);
            nk_dwconv_ln<<<T / 4, 256, 0, s>>>(t1, I.cv_w_dw, I.cv_b_dw, I.cv_g_ln, I.cv_b_ln, h);
            ngemm<0>(s, h, DM, I.cv_w_pw2, DM, t2, DM, T, DM, DM, I.cv_b_pw2);
        } else {
            ngemm<0>(s, h, DM, I.ssd_w_in, SSIN, zb, SSI, T, SSI, DM, nullptr);
            ngemm<0>(s, h, DM, I.ssd_w_in + SSI, SSIN, xpre, SSCD, T, SSCD, DM, nullptr);
            ngemm<0>(s, h, DM, I.ssd_w_in + SSI + SSCD, SSIN, dtraw, 64, T, 64, DM, nullptr);
            nk_ssd_conv<<<T * 3136 / 256, 256, 0, s>>>(xpre, dtraw, I.ssd_w_conv, I.ssd_b_conv, I.ssd_dt_bias, xbc, dtb);
            nk_ssd_scan<<<dim3(32, 20), 64, 0, s>>>(xbc, dtb, I.ssd_a_log, I.ssd_d, I.state_ssm, yb, out, 0);
            nk_ssd_scan<<<dim3(32, 20), 64, 0, s>>>(xbc, dtb, I.ssd_a_log, I.ssd_d, I.state_ssm, yb, out, 1);
            nk_ssd_gate<<<T / 4, 256, 0, s>>>(yb, zb, I.ssd_g_norm, xbc);
            ngemm<0>(s, xbc, SSI, I.ssd_w_out, DM, t2, DM, T, DM, SSI, nullptr);
        }
        nk_resid<<<T * DM / 256, 256, 0, s>>>(x, t2, ml, 2048);
        }
        nk_normmod<<<T / 4, 256, 0, s>>>(x, I.g_norm2 + i * DM, ml, 3072, 4096, h);
        ngemm<1>(s, h, DM, I.ffn_w_in + (size_t)i * DM * 5632, 5632, t1, FFH, T, FFH, DM, nullptr);
        ngemm<0>(s, t1, FFH, I.ffn_w_out + (size_t)i * FFH * DM, DM, t2, DM, T, DM, FFH, nullptr);
        nk_resid<<<T * DM / 256, 256, 0, s>>>(x, t2, ml, 5120);
    }
}


__device__ __forceinline__ int olane() { int l; asm volatile("v_mbcnt_lo_u32_b32 %0, -1, 0\n\tv_mbcnt_hi_u32_b32 %0, -1, %0" : "=v"(l)); return l; }
__device__ __forceinline__ int obid() { int b = blockIdx.x; asm volatile("" : "+s"(b)); return b; }
namespace pg8 {
#define PG8_LAS __attribute__((address_space(3)))
typedef unsigned short bf16_t;
typedef short bf16x8 __attribute__((ext_vector_type(8)));
typedef float f32x4 __attribute__((ext_vector_type(4)));
typedef unsigned u32x4 __attribute__((ext_vector_type(4)));
constexpr int BM = 256, BK = 64, HALF = 128, HTB = HALF * BK * 2  , STAGE_BYTES = 8 * HTB, NXCD = 8, WGM = 8;

__host__ __device__ __forceinline__ int lds_byte(int r, int c) { const int st = (r >> 4) * 2 + (c >> 5), rr = r & 15, cc = c & 31, ob = rr * 64 + cc * 2; return st * 1024 + (ob ^ (((ob >> 9) & 1) << 5)); }
__host__ __device__ __forceinline__ void stage_rc(int b, int& R, int& C) { const int st = b / 1024, sb = b % 1024, swz = sb ^ (((sb >> 9) & 1) << 5); R = (st >> 1) * 16 + swz / 64; C = (st & 1) * 32 + (swz % 64) / 2; }
__host__ __device__ __forceinline__ int perm32(int rho) { const int n = rho >> 4, i = rho & 15; return 8 * (i >> 2) + 4 * n + (i & 3); }

struct Unit { int pm, pn; };
struct Gemm { const bf16_t* A; const bf16_t* Bt; int M, N, K; };

struct StaticOrder {
    int nM, nN, nwg, G, c;
    __host__ __device__ void init(int M, int N, int G_, int c_) { nM = M / BM; nN = N / BM; nwg = nM * nN; G = G_; c = c_; }
    __host__ __device__ bool next(int i, Unit& u) const {
        const long L = (long)i * G + c; if (L >= nwg) return false;
        int wgid = (int)L; { const int q = nwg / NXCD, r = nwg % NXCD, xcd = wgid % NXCD, off = wgid / NXCD; wgid = (xcd < r ? xcd * (q + 1) : r * (q + 1) + (xcd - r) * q) + off; }
        const int nig = WGM * nN, gid = wgid / nig, fm = gid * WGM, gsz = (nM - fm) < WGM ? (nM - fm) : WGM;
        u.pm = fm + ((wgid % nig) % gsz); u.pn = (wgid % nig) / gsz; return true;
    }
    __device__ __forceinline__ void a_ready(const Unit&) const {}
    __device__ __forceinline__ void done(const Unit&) const {}
};
__device__ __forceinline__ unsigned cvt_pk_bf16(float lo, float hi) { unsigned r; asm volatile("v_cvt_pk_bf16_f32 %0, %1, %2" : "=v"(r) : "v"(lo), "v"(hi)); return r; }
typedef unsigned u32x2 __attribute__((ext_vector_type(2)));
__device__ __forceinline__ float fast_sigmoid(float x) { return __builtin_amdgcn_rcpf(1.f + __builtin_amdgcn_exp2f(-1.4426950408889634f * x)); }

struct EpiF32 {
    static constexpr bool PERM = false, AFTER_DRAIN = false;
    float* C; int ldc;
    __device__ __forceinline__ void operator()(const f32x4 (&acc)[2][2][4][2], const Unit& u, int wr_, int wc_, int fr_, int fq_) const {
        const int t_ = olane(), wr = wr_, wc = wc_, fr = t_ & 15, fq = t_ >> 4; (void)fr_; (void)fq_;
        const int row0 = u.pm * BM + wr * 64 + fr, col0 = u.pn * BM + wc * 32 + 4 * fq;
#pragma unroll
        for (int ai = 0; ai < 2; ++ai)
#pragma unroll
            for (int m = 0; m < 4; ++m) { float* rowp = C + (size_t)(row0 + ai * HALF + m * 16) * ldc + col0;
#pragma unroll
                for (int bj = 0; bj < 2; ++bj)
#pragma unroll
                    for (int n = 0; n < 2; ++n) *(f32x4*)(rowp + bj * HALF + n * 16) = acc[ai][bj][m][n]; }
    }
};
struct EpiBf16P {
    static constexpr bool PERM = true, AFTER_DRAIN = false;
    bf16_t* O; int ldc;
    __device__ __forceinline__ void operator()(const f32x4 (&acc)[2][2][4][2], const Unit& u, int wr_, int wc_, int fr_, int fq_) const {
        const int t_ = olane(), wr = wr_, wc = wc_, fr = t_ & 15, fq = t_ >> 4; (void)fr_; (void)fq_;
        const int row0 = u.pm * BM + wr * 64 + fr, col0 = u.pn * BM + wc * 32 + 8 * fq;
#pragma unroll
        for (int ai = 0; ai < 2; ++ai)
#pragma unroll
            for (int m = 0; m < 4; ++m) { bf16_t* rowp = O + (size_t)(row0 + ai * HALF + m * 16) * ldc + col0;
#pragma unroll
                for (int bj = 0; bj < 2; ++bj) { const f32x4 v0 = acc[ai][bj][m][0], v1 = acc[ai][bj][m][1]; u32x4 w;
                    w.x = cvt_pk_bf16(v0[0], v0[1]); w.y = cvt_pk_bf16(v0[2], v0[3]); w.z = cvt_pk_bf16(v1[0], v1[1]); w.w = cvt_pk_bf16(v1[2], v1[3]);
                    *(u32x4*)(rowp + bj * HALF) = w; } }
    }
};
struct EpiSsdIn {
    static constexpr bool PERM = true, AFTER_DRAIN = false;
    bf16_t* Z; bf16_t* XP; float* DT;
    __device__ __forceinline__ void operator()(const f32x4 (&acc)[2][2][4][2], const Unit& u, int wr_, int wc_, int fr_, int fq_) const {
        const int t_ = olane(), wr = wr_, wc = wc_, fr = t_ & 15, fq = t_ >> 4; (void)fr_; (void)fq_;
        const int row0 = u.pm * BM + wr * 64 + fr;
        if (u.pn < 20) {
            bf16_t* base = u.pn < 8 ? Z : XP; const int ld = u.pn < 8 ? 2048 : 3072, colt = (u.pn < 8 ? u.pn : u.pn - 8) * BM, col0 = colt + wc * 32 + 8 * fq;
#pragma unroll
            for (int ai = 0; ai < 2; ++ai)
#pragma unroll
                for (int m = 0; m < 4; ++m) { bf16_t* rowp = base + (size_t)(row0 + ai * HALF + m * 16) * ld + col0;
#pragma unroll
                    for (int bj = 0; bj < 2; ++bj) { const f32x4 v0 = acc[ai][bj][m][0], v1 = acc[ai][bj][m][1]; u32x4 w;
                        w.x = cvt_pk_bf16(v0[0], v0[1]); w.y = cvt_pk_bf16(v0[2], v0[3]); w.z = cvt_pk_bf16(v1[0], v1[1]); w.w = cvt_pk_bf16(v1[2], v1[3]);
                        *(u32x4*)(rowp + bj * HALF) = w; } }
        } else if (wc < 2) {
#pragma unroll
            for (int ai = 0; ai < 2; ++ai)
#pragma unroll
                for (int m = 0; m < 4; ++m) { float* rp = DT + (size_t)(row0 + ai * HALF + m * 16) * 64 + wc * 32 + 8 * fq;
                    *(f32x4*)rp = acc[ai][0][m][0]; *(f32x4*)(rp + 4) = acc[ai][0][m][1]; }
        }
    }
};
template <int MODE> struct EpiGlu {
    static constexpr bool PERM = false, AFTER_DRAIN = false;
    bf16_t* O; int ldo; const float* bias; int H;
    __device__ __forceinline__ void operator()(const f32x4 (&acc)[2][2][4][2], const Unit& u, int wr_, int wc_, int fr_, int fq_) const {
        const int t_ = olane(), wr = wr_, wc = wc_, fr = t_ & 15, fq = t_ >> 4; (void)fr_; (void)fq_;
        const int row0 = u.pm * BM + wr * 64 + fr;
#pragma unroll
        for (int bj = 0; bj < 2; ++bj) {
            const int f0 = 16 * (8 * u.pn + 4 * bj + wc) + 4 * fq;
            f32x4 ba = (f32x4){0.f, 0.f, 0.f, 0.f}, bu = ba;
            if (MODE == 1) { ba = *(const f32x4*)(bias + f0); bu = *(const f32x4*)(bias + H + f0); }
#pragma unroll
            for (int ai = 0; ai < 2; ++ai)
#pragma unroll
                for (int m = 0; m < 4; ++m) { const f32x4 a = acc[ai][bj][m][0] + ba, g = acc[ai][bj][m][1] + bu; float o[4];
#pragma unroll
                    for (int j = 0; j < 4; ++j) o[j] = MODE == 0 ? a[j] * fast_sigmoid(a[j]) * g[j] : a[j] * fast_sigmoid(g[j]);
                    u32x2 w; w.x = cvt_pk_bf16(o[0], o[1]); w.y = cvt_pk_bf16(o[2], o[3]);
                    *(u32x2*)(O + (size_t)(row0 + ai * HALF + m * 16) * ldo + f0) = w; }
        }
    }
};
struct EpiResid {
    static constexpr bool PERM = false, AFTER_DRAIN = false;
    const float* xlo; const float* xhi; float* xout; const float* mods_l; int g_off; const float* bias;
    __device__ __forceinline__ void operator()(const f32x4 (&acc)[2][2][4][2], const Unit& u, int wr_, int wc_, int fr_, int fq_) const {
        const int t_ = olane(), wr = wr_, wc = wc_, fr = t_ & 15, fq = t_ >> 4; (void)fr_; (void)fq_;
        const int cond = u.pm < 16 ? 0 : 1 + ((u.pm - 16) >> 2);
        const float* gate = mods_l + (size_t)cond * 6144 + g_off; const float* xin = u.pm < 16 ? xlo : xhi;
        const int row0 = u.pm * BM + wr * 64 + fr, col0 = u.pn * BM + wc * 32 + 4 * fq;
#pragma unroll
        for (int bj = 0; bj < 2; ++bj)
#pragma unroll
            for (int n = 0; n < 2; ++n) { const int c = col0 + bj * HALF + n * 16; const f32x4 g4 = *(const f32x4*)(gate + c);
                const f32x4 b4 = bias ? *(const f32x4*)(bias + c) : (f32x4){0.f, 0.f, 0.f, 0.f};
#pragma unroll
                for (int ai = 0; ai < 2; ++ai)
#pragma unroll
                    for (int m = 0; m < 4; ++m) { const size_t off = (size_t)(row0 + ai * HALF + m * 16) * 1024 + c;
                        const f32x4 xo = *(const f32x4*)(xin + off); *(f32x4*)(xout + off) = xo + g4 * (acc[ai][bj][m][n] + b4); } }
    }
};

template <class Epi, class Sched, bool ALIGN_EPI = false, bool SP2 = false>
__device__ __forceinline__ void gemm_phase(PG8_LAS unsigned char* lds, const Gemm g, const Sched& S, const Epi& E, const int wave_in) {
    const int tid = wave_in * 64 + olane(), wid = __builtin_amdgcn_readfirstlane(tid >> 6), lane = tid & 63, wr = wid >> 2, wc = wid & 3, fr = lane & 15, fq = lane >> 4;
    const int K = g.K, nt = K / BK;
    unsigned voffA[2], voffB[2];
#pragma unroll
    for (int i = 0; i < 2; ++i) { int R, C; stage_rc(tid * 16 + i * 8192, R, C); const int Rb = Epi::PERM ? ((R & ~31) + perm32(R & 31)) : R;
        voffA[i] = (unsigned)(R * K + C) * 2u; voffB[i] = (unsigned)(Rb * K + C) * 2u; }
    const size_t kstep = (size_t)(BK * 2);
    const size_t hstep = (size_t)HALF * K * 2;
    const size_t tstep = 2 * hstep;
    const unsigned ldsw = (unsigned)wid * 1024u;
    const int aoff = lds_byte(wr * 64 + fr, fq * 8), boff = lds_byte(wc * 32 + fr, fq * 8);
#define PG8_SA(b, h) (((b) * 2 + (h)) * HTB)
#define PG8_SB(b, h) ((4 + (b) * 2 + (h)) * HTB)
#define PG8_STAGE(bufoff, gbase, voff) do { _Pragma("unroll") for (int _i = 0; _i < 2; ++_i) \
        __builtin_amdgcn_global_load_lds((const unsigned*)((const char*)(gbase) + (voff)[_i]), (PG8_LAS unsigned*)(lds + (bufoff) + ldsw + _i * 8192), 16, 0, 0); } while (0)
#define PG8_LDA(dst, b, h) do { _Pragma("unroll") for (int m = 0; m < 4; ++m) _Pragma("unroll") for (int k = 0; k < 2; ++k) dst[m][k] = *(const PG8_LAS bf16x8*)(lds + PG8_SA(b, h) + aoff + m * 2048 + k * 1024); } while (0)
#define PG8_LDB(dst, b, h) do { _Pragma("unroll") for (int n = 0; n < 2; ++n) _Pragma("unroll") for (int k = 0; k < 2; ++k) dst[n][k] = *(const PG8_LAS bf16x8*)(lds + PG8_SB(b, h) + boff + n * 2048 + k * 1024); } while (0)
#define PG8_MMA(ai, bj, At, Bt) do { __builtin_amdgcn_s_setprio(1); _Pragma("unroll") for (int m = 0; m < 4; ++m) _Pragma("unroll") for (int n = 0; n < 2; ++n) _Pragma("unroll") for (int k = 0; k < 2; ++k) \
        acc[ai][bj][m][n] = __builtin_amdgcn_mfma_f32_16x16x32_bf16(Bt[n][k], At[m][k], acc[ai][bj][m][n], 0, 0, 0); __builtin_amdgcn_s_setprio(0); } while (0)
#define PG8_WAIT_V(n) asm volatile("s_waitcnt vmcnt(" #n ")" ::: "memory")
#define PG8_WAIT_L(n) asm volatile("s_waitcnt lgkmcnt(" #n ")" ::: "memory")
#define PG8_BAR __builtin_amdgcn_s_barrier()
#define PG8_SCHED __builtin_amdgcn_sched_barrier(0)
    Unit cur, nxt; int ui = 0;
    if (!S.next(0, cur)) return;
    f32x4 acc[2][2][4][2];
#pragma unroll
    for (int a = 0; a < 2; ++a)
#pragma unroll
        for (int b = 0; b < 2; ++b)
#pragma unroll
            for (int m = 0; m < 4; ++m)
#pragma unroll
                for (int n = 0; n < 2; ++n) acc[a][b][m][n] = (f32x4){0.f, 0.f, 0.f, 0.f};
    bf16x8 At[4][2], B0[2][2], B1[2][2];
    const char* cA = (const char*)g.A + (size_t)cur.pm * tstep; const char* cB = (const char*)g.Bt + (size_t)cur.pn * tstep;
    S.a_ready(cur);
    if constexpr (SP2) {
        PG8_STAGE(PG8_SB(0, 0), cB, voffB); PG8_STAGE(PG8_SB(0, 1), cB + hstep, voffB); PG8_STAGE(PG8_SA(0, 0), cA, voffA); PG8_STAGE(PG8_SA(0, 1), cA + hstep, voffA);
        if (wr == 1) PG8_BAR;
        PG8_WAIT_V(2); PG8_BAR;
        PG8_STAGE(PG8_SB(1, 0), cB + kstep, voffB); PG8_STAGE(PG8_SA(1, 0), cA + kstep, voffA); PG8_STAGE(PG8_SB(1, 1), cB + hstep + kstep, voffB);
        PG8_WAIT_V(6); PG8_BAR;
    } else {
        PG8_STAGE(PG8_SB(0, 0), cB, voffB); PG8_STAGE(PG8_SA(0, 0), cA, voffA); PG8_STAGE(PG8_SB(0, 1), cB + hstep, voffB); PG8_STAGE(PG8_SA(0, 1), cA + hstep, voffA);
        if (wr == 1) PG8_BAR;
        PG8_WAIT_V(4); PG8_BAR;
        PG8_STAGE(PG8_SB(1, 0), cB + kstep, voffB); PG8_STAGE(PG8_SA(1, 0), cA + kstep, voffA); PG8_STAGE(PG8_SB(1, 1), cB + hstep + kstep, voffB);
        PG8_WAIT_V(6); PG8_BAR;
    }
    for (;;) {
        const bool has_next = S.next(ui + 1, nxt);
        const char* nA = has_next ? (const char*)g.A + (size_t)nxt.pm * tstep : cA; const char* nB = has_next ? (const char*)g.Bt + (size_t)nxt.pn * tstep : cB;
        for (int t = 0; t < nt; t += 2) {
            const bool last = (t == nt - 2);
            const char* a1 = cA + (size_t)(t + 1) * kstep;
            const char* a2 = last ? nA : cA + (size_t)(t + 2) * kstep; const char* b2 = last ? nB : cB + (size_t)(t + 2) * kstep;
            const char* a3 = a2 + kstep; const char* b3 = b2 + kstep;
            if (last && has_next) S.a_ready(nxt);
            if constexpr (SP2) {
            PG8_LDB(B0, 0, 0); PG8_LDB(B1, 0, 1); PG8_SCHED; PG8_LDA(At, 0, 0); PG8_STAGE(PG8_SA(1, 1), a1 + hstep, voffA);
            PG8_WAIT_V(8); PG8_WAIT_L(0); PG8_BAR; PG8_MMA(0, 0, At, B0); PG8_MMA(0, 1, At, B1); PG8_BAR; PG8_SCHED;
            PG8_LDA(At, 0, 1); PG8_STAGE(PG8_SB(0, 0), b2, voffB); PG8_STAGE(PG8_SB(0, 1), b2 + hstep, voffB); PG8_STAGE(PG8_SA(0, 0), a2, voffA);
            PG8_WAIT_V(8); PG8_WAIT_L(0); PG8_BAR; PG8_MMA(1, 0, At, B0); PG8_MMA(1, 1, At, B1); PG8_BAR; PG8_SCHED;
            PG8_LDB(B0, 1, 0); PG8_LDB(B1, 1, 1); PG8_SCHED; PG8_LDA(At, 1, 0); PG8_STAGE(PG8_SA(0, 1), a2 + hstep, voffA);
            PG8_WAIT_V(8); PG8_WAIT_L(0); PG8_BAR; PG8_MMA(0, 0, At, B0); PG8_MMA(0, 1, At, B1); PG8_BAR; PG8_SCHED;
            PG8_LDA(At, 1, 1); PG8_STAGE(PG8_SB(1, 0), b3, voffB); PG8_STAGE(PG8_SB(1, 1), b3 + hstep, voffB); PG8_STAGE(PG8_SA(1, 0), a3, voffA);
            PG8_WAIT_V(8); PG8_WAIT_L(0); PG8_BAR; PG8_MMA(1, 0, At, B0); PG8_MMA(1, 1, At, B1); PG8_BAR; PG8_SCHED;
            } else {
            PG8_LDB(B0, 0, 0); PG8_SCHED; PG8_LDA(At, 0, 0); PG8_STAGE(PG8_SA(1, 1), a1 + hstep, voffA);
            PG8_WAIT_L(8); PG8_BAR; PG8_WAIT_L(0); PG8_MMA(0, 0, At, B0); PG8_BAR; PG8_SCHED;
            PG8_LDB(B1, 0, 1); PG8_STAGE(PG8_SB(0, 0), b2, voffB);
            PG8_BAR; PG8_WAIT_L(0); PG8_MMA(0, 1, At, B1); PG8_BAR;
            PG8_LDA(At, 0, 1); PG8_STAGE(PG8_SA(0, 0), a2, voffA);
            PG8_BAR; PG8_WAIT_L(0); PG8_MMA(1, 0, At, B0); PG8_BAR; PG8_SCHED;
            PG8_STAGE(PG8_SB(0, 1), b2 + hstep, voffB);
            PG8_WAIT_V(6); PG8_BAR; PG8_MMA(1, 1, At, B1); PG8_BAR;
            PG8_LDB(B0, 1, 0); PG8_SCHED; PG8_LDA(At, 1, 0); PG8_STAGE(PG8_SA(0, 1), a2 + hstep, voffA);
            PG8_WAIT_L(8); PG8_BAR; PG8_WAIT_L(0); PG8_MMA(0, 0, At, B0); PG8_BAR; PG8_SCHED;
            PG8_LDB(B1, 1, 1); PG8_STAGE(PG8_SB(1, 0), b3, voffB);
            PG8_BAR; PG8_WAIT_L(0); PG8_MMA(0, 1, At, B1); PG8_BAR;
            PG8_LDA(At, 1, 1); PG8_STAGE(PG8_SA(1, 0), a3, voffA);
            PG8_BAR; PG8_WAIT_L(0); PG8_MMA(1, 0, At, B0); PG8_BAR; PG8_SCHED;
            PG8_STAGE(PG8_SB(1, 1), b3 + hstep, voffB);
            PG8_WAIT_V(6); PG8_BAR; PG8_MMA(1, 1, At, B1); PG8_BAR;
            }
        }
        if constexpr (ALIGN_EPI) { if (wr == 0) PG8_BAR; }
        if constexpr (!Epi::AFTER_DRAIN) { E(acc, cur, wr, wc, fr, fq); S.done(cur); }
        if (!has_next) break;
#pragma unroll
        for (int a = 0; a < 2; ++a)
#pragma unroll
            for (int b = 0; b < 2; ++b)
#pragma unroll
                for (int m = 0; m < 4; ++m)
#pragma unroll
                    for (int n = 0; n < 2; ++n) acc[a][b][m][n] = (f32x4){0.f, 0.f, 0.f, 0.f};
        cur = nxt; cA = nA; cB = nB; ++ui;
        if constexpr (ALIGN_EPI) { if (wr == 1) PG8_BAR; }
    }
    PG8_WAIT_V(0);
    if constexpr (!ALIGN_EPI) { if (wr == 0) PG8_BAR; }
    PG8_BAR;
    if constexpr (Epi::AFTER_DRAIN) { E.fused(acc, cur, wr, wc, fr, fq, lds, wid, lane); S.done(cur); }
#undef PG8_SA
#undef PG8_SB
#undef PG8_STAGE
#undef PG8_LDA
#undef PG8_LDB
#undef PG8_MMA
#undef PG8_WAIT_V
#undef PG8_WAIT_L
#undef PG8_BAR
#undef PG8_SCHED
}
}
constexpr int NWAVES = 8, NTHR = 512;
constexpr size_t MiB = 1u << 20;
constexpr size_t WS_CTL = 0, CTL_ZERO_BYTES = 1 * MiB;
constexpr size_t WS_MODS = 256 * 1024;
constexpr size_t WS_ROPE = 1 * MiB;
constexpr size_t WS_W = 2 * MiB;
constexpr size_t W_MLA = WS_W, MLA_WB = 5898240;
constexpr size_t MW_CAT = 0, MW_UQ = 1572864, MW_UKV = 2752512, MW_O = 3801088;
constexpr size_t W_CV1 = WS_W + 2 * MLA_WB, W_CV2 = W_CV1 + 4 * MiB;
constexpr size_t W_SSI = W_CV2 + 2 * MiB, W_SSO = W_SSI + 11010048;
constexpr size_t W_FF = W_SSO + 4 * MiB, FF_WB = 17301504, FW_IN = 0, FW_OUT = 11534336;
static_assert(W_FF + 4 * FF_WB <= 102 * MiB, "weights region");
constexpr size_t WS_H = 102 * MiB;
constexpr size_t WS_CKV = 118 * MiB, CKV_B = (size_t)(T + NCTX) * KVL * 2;
constexpr size_t WS_AR = 128 * MiB;
constexpr size_t A_LAT = WS_AR, A_QN = A_LAT + 24 * MiB, A_QRAW = A_QN + 6 * MiB, A_KVRAW = A_QRAW + 24 * MiB, A_QB = A_KVRAW + 36 * MiB, A_KB = A_QB + 24 * MiB, A_AO = A_KB + 27 * MiB;
constexpr size_t A_U = WS_AR, A_V = A_U + 16 * MiB;
constexpr size_t A_Z = WS_AR, A_XPRE = A_Z + 32 * MiB, A_DTRAW = A_XPRE + 48 * MiB, A_XBC = A_DTRAW + 2 * MiB, A_DT = A_XBC + 48 * MiB, A_Y = A_DT + 2 * MiB, A_YN = A_XPRE;
constexpr size_t A_ACT = WS_AR + 200 * MiB;
static_assert(A_AO + 16 * MiB <= A_ACT && A_Y + 64 * MiB <= A_ACT && A_ACT + 44 * MiB <= 384 * MiB, "arena map");
constexpr int CW_BAR = 4096;
constexpr int LDS_BYTES = 163840, RING_BYTES = 131072, MISC_OFF = 163840 - 256;

#define GAS __attribute__((address_space(1)))
#define LAS __attribute__((address_space(3)))
typedef unsigned short bf16;
typedef unsigned v4u __attribute__((ext_vector_type(4)));
typedef unsigned v2u __attribute__((ext_vector_type(2)));
typedef float v4f __attribute__((ext_vector_type(4)));
typedef float v2f __attribute__((ext_vector_type(2)));
typedef GAS unsigned gu32;
#define LDS_WAIT() asm volatile("s_waitcnt lgkmcnt(0)" ::: "memory")
#define VM_WAIT() asm volatile("s_waitcnt vmcnt(0)" ::: "memory")
__device__ __forceinline__ unsigned f2bf(float f) { unsigned u = __builtin_bit_cast(unsigned, f); return (u + 0x7fffu + ((u >> 16) & 1u)) >> 16; }
__device__ __forceinline__ unsigned pk2(float lo, float hi) { return f2bf(lo) | (f2bf(hi) << 16); }
__device__ __forceinline__ float bflo(unsigned u) { return __builtin_bit_cast(float, u << 16); }
__device__ __forceinline__ float bfhi(unsigned u) { return __builtin_bit_cast(float, u & 0xffff0000u); }
__device__ __forceinline__ float bf2f(bf16 b) { return __builtin_bit_cast(float, (unsigned)b << 16); }

#define XB_TMO      128
#define XB_XCNT(j)  (256  + 64 * (j))
#define XB_XSUB(j)  (1280 + 64 * (j))
#define XB_XGEN(j)  (2304 + 64 * (j))
#define XB_TOP      3328
#define XB_TOPGEN   3392
#define XCD_BAR_WORDS 3456
#define XB_SPIN_CAP (1u << 18)

__device__ __forceinline__ unsigned xb_ld(unsigned* p)              { return __hip_atomic_load(p, __ATOMIC_RELAXED, __HIP_MEMORY_SCOPE_AGENT); }
__device__ __forceinline__ unsigned xb_add(unsigned* p, unsigned v) { return __hip_atomic_fetch_add(p, v, __ATOMIC_RELAXED, __HIP_MEMORY_SCOPE_AGENT); }
__device__ __forceinline__ unsigned xb_xcc_id() { return (unsigned)__builtin_amdgcn_s_getreg((3 << 11) | 20) & 0xFu; }
#define XB_SPIN(cond, bar) do { unsigned _sp = 0; while (cond) { __builtin_amdgcn_s_sleep(1); \
    if ((++_sp & 255u) == 0u) { if (xb_ld(&(bar)[XB_TMO])) break; if (_sp > XB_SPIN_CAP) { atomicAdd(&(bar)[XB_TMO], 1u); break; } } } } while (0)

struct XcdBarrier {
    unsigned* bar; unsigned x;
    volatile LAS unsigned* st;
};

__device__ __forceinline__ XcdBarrier xcd_barrier_post(unsigned* bar, volatile LAS unsigned* st) {
    XcdBarrier b; b.bar = bar; b.x = xb_xcc_id(); b.st = st;
    if (threadIdx.x == 0) (void)xb_add(&bar[XB_XCNT(b.x)], 1u);
    return b;
}
__device__ __forceinline__ void xcd_barrier_complete(unsigned* bar, unsigned x, unsigned& nloc, unsigned& nx) {
    const unsigned G = gridDim.x * gridDim.y * gridDim.z;
    unsigned sum, cnt, mine, sp = 0u;
    for (;;) {
        sum = 0u; cnt = 0u; mine = 0u;
#pragma unroll
        for (unsigned j = 0; j < 16; ++j) { const unsigned c = xb_ld(&bar[XB_XCNT(j)]); sum += c; cnt += (c > 0u) ? 1u : 0u; mine = (j == x) ? c : mine; }
        if (sum == G) break;
        __builtin_amdgcn_s_sleep(1);
        if ((++sp & 255u) == 0u) { if (xb_ld(&bar[XB_TMO])) break; if (sp > XB_SPIN_CAP) { atomicAdd(&bar[XB_TMO], 1u); break; } }
    }
    nloc = mine > 0u ? mine : 1u; nx = cnt > 0u ? cnt : 1u;
}

__device__ __forceinline__ void xcd_barrier(const XcdBarrier& b) {
    asm volatile("s_waitcnt vmcnt(0)" ::: "memory");
    __syncthreads();
    if (threadIdx.x == 0) {
        unsigned* bar = b.bar;
        __builtin_amdgcn_s_waitcnt(0);
        unsigned nloc = b.st[0], nx = b.st[1];
        if (nloc == 0u) { xcd_barrier_complete(bar, b.x, nloc, nx); b.st[0] = nloc; b.st[1] = nx; }
        const unsigned old = xb_add(&bar[XB_XSUB(b.x)], 1u);
        const unsigned gen = old / nloc;
        if (old + 1u == (gen + 1u) * nloc) {
            __builtin_amdgcn_fence(__ATOMIC_RELEASE, "agent");
            asm volatile("s_waitcnt vmcnt(0)" ::: "memory");
            const unsigned og = xb_add(&bar[XB_TOP], 1u);
            const unsigned tg = og / nx;
            if (og + 1u == (tg + 1u) * nx) xb_add(&bar[XB_TOPGEN], 1u);
            else XB_SPIN(xb_ld(&bar[XB_TOPGEN]) == tg, bar);
            __builtin_amdgcn_fence(__ATOMIC_ACQUIRE, "agent");
            xb_add(&bar[XB_XGEN(b.x)], 1u);
            asm volatile("s_waitcnt vmcnt(0)" ::: "memory");
        } else {
            XB_SPIN(xb_ld(&bar[XB_XGEN(b.x)]) == gen, bar);
            __builtin_amdgcn_fence(__ATOMIC_ACQUIRE, "agent");
            asm volatile("s_waitcnt vmcnt(0)" ::: "memory");
        }
    }
    __syncthreads();
}

struct Frame {
    LAS unsigned char* lds; int tid, lane, wave, vcu, G, gw, NGW, bx;
    volatile LAS unsigned* PT;
};
constexpr int PT_OUT = 38, PT_WS = 39;
__device__ __forceinline__ const float* ldp(volatile LAS unsigned* PT, int k) {
    const unsigned lo = __builtin_amdgcn_readfirstlane(PT[2 * k]), hi = __builtin_amdgcn_readfirstlane(PT[2 * k + 1]);
    return (const float*)(((unsigned long long)hi << 32) | lo);
}
#define INP(k) ldp(F.PT, (k))
#define WSP ((unsigned char*)ldp(F.PT, PT_WS))
#define OUTP ((float*)ldp(F.PT, PT_OUT))
enum InIdx { I_XP = 0, I_XS, I_CCKV, I_CKPE, I_SSM, I_C, I_CCTX, I_WADA, I_BADA, I_GN1, I_GN2, I_WDQ, I_GQ, I_WUQ, I_WDKV, I_GKV, I_WUKV, I_GQN, I_GKN, I_WO,
             I_CVW1, I_CVB1, I_CVWD, I_CVBD, I_CVGL, I_CVBL, I_CVW2, I_CVB2, I_SSWI, I_SSWC, I_SSBC, I_SSDTB, I_SSAL, I_SSD, I_SSGN, I_SSWO, I_FFWI, I_FFWO };
__device__ __forceinline__ float shx(float v, int lane, int o) { return __builtin_bit_cast(float, __builtin_amdgcn_ds_bpermute((lane ^ o) << 2, __builtin_bit_cast(int, v))); }
__device__ __forceinline__ float wsum(float v, int lane) {
#pragma unroll
    for (int o = 1; o < 64; o <<= 1) v += shx(v, lane, o);
    return v;
}
constexpr float QSCALE = 0.10206207261596577f * 1.4426950408889634f;

__device__ __forceinline__ void p0_transpose_item(const float* W, int K, int N, bf16* WT, int mode, int H, int row_off, LAS float* scr, int item, int lane) {
    const int nblk = N / 32, kb = item / nblk, nb = item % nblk, k0 = 64 * kb, n0 = 32 * nb;
#pragma unroll 8
    for (int i = 0; i < 32; ++i) { const int kk = 2 * i + (lane >> 5); scr[kk * 33 + (lane & 31)] = W[(size_t)(k0 + kk) * N + n0 + (lane & 31)]; }
    LDS_WAIT(); asm volatile("" ::: "memory");
    const int c = lane & 7;
#pragma unroll
    for (int j = 0; j < 4; ++j) { const int n = (lane >> 3) + 8 * j, col = n0 + n; const LAS float* s = scr + (8 * c) * 33 + n;
        int drow;
        if (mode == 0) drow = row_off + col;
        else { const int f = col < H ? col : col - H; drow = 32 * (f >> 4) + (f & 15) + (col < H ? 0 : 16); }
        v4u o; o.x = pk2(s[0 * 33], s[1 * 33]); o.y = pk2(s[2 * 33], s[3 * 33]); o.z = pk2(s[4 * 33], s[5 * 33]); o.w = pk2(s[6 * 33], s[7 * 33]);
        *(GAS v4u*)(WT + (size_t)drow * K + k0 + 8 * c) = o; }
    LDS_WAIT(); asm volatile("" ::: "memory");
}
__device__ __forceinline__ void p0_job(int q, int& inp, size_t& soff, int& K, int& N, size_t& doff, int& mode, int& H, int& roff) {
    mode = 0; H = 0; roff = 0; soff = 0;
    if (q < 10) { const int j = q / 5, t = q % 5; const size_t wb = W_MLA + (size_t)j * MLA_WB;
        if (t == 0) { inp = I_WDQ; soff = (size_t)j * 1024 * 384; K = 1024; N = 384; doff = wb + MW_CAT; }
        else if (t == 1) { inp = I_WDKV; soff = (size_t)j * 1024 * 288; K = 1024; N = 288; doff = wb + MW_CAT; roff = 384; }
        else if (t == 2) { inp = I_WUQ; soff = (size_t)j * 384 * 1536; K = 384; N = 1536; doff = wb + MW_UQ; }
        else if (t == 3) { inp = I_WUKV; soff = (size_t)j * 256 * 2048; K = 256; N = 2048; doff = wb + MW_UKV; }
        else { inp = I_WO; soff = (size_t)j * 1024 * 1024; K = 1024; N = 1024; doff = wb + MW_O; } }
    else if (q == 10) { inp = I_CVW1; K = 1024; N = 2048; doff = W_CV1; mode = 1; H = 1024; }
    else if (q == 11) { inp = I_CVW2; K = 1024; N = 1024; doff = W_CV2; }
    else if (q == 12) { inp = I_SSWI; K = 1024; N = 5184; doff = W_SSI; }
    else if (q == 13) { inp = I_SSWO; K = 2048; N = 1024; doff = W_SSO; }
    else { const int l = (q - 14) >> 1, t = (q - 14) & 1;
        if (t == 0) { inp = I_FFWI; soff = (size_t)l * 1024 * 5632; K = 1024; N = 5632; doff = W_FF + (size_t)l * FF_WB + FW_IN; mode = 1; H = 2816; }
        else { inp = I_FFWO; soff = (size_t)l * 2816 * 1024; K = 2816; N = 1024; doff = W_FF + (size_t)l * FF_WB + FW_OUT; } }
}
constexpr int P0_NITEMS = 2 * ((1024 / 64) * (384 / 32) + (1024 / 64) * (288 / 32) + (384 / 64) * (1536 / 32) + (256 / 64) * (2048 / 32) + (1024 / 64) * (1024 / 32))
                        + (1024 / 64) * (2048 / 32) + (1024 / 64) * (1024 / 32) + (1024 / 64) * (5184 / 32) + (2048 / 64) * (1024 / 32)
                        + 4 * ((1024 / 64) * (5632 / 32) + (2816 / 64) * (1024 / 32));
__device__ __forceinline__ void p0_prologue(Frame& F) {
    unsigned char* ws = WSP;
    LAS float* s = (LAS float*)F.lds;
    for (int i = F.tid; i < 5 * 1024; i += NTHR) { const int cc = i >> 10, k = i & 1023; const float v = cc == 0 ? INP(I_CCTX)[k] : INP(I_C)[(cc - 1) * 1024 + k]; s[i] = v / (1.f + expf(-v)); }
    __syncthreads();
    float* mods = (float*)(ws + WS_MODS);
    for (int it = F.bx; it < 768; it += F.G) {
        const int l = it / 192, r = it % 192, cb = r / 16, ks = r % 16, n = cb * 512 + F.tid;
        const float* W = INP(I_WADA) + (size_t)l * 1024 * 6144 + (size_t)(ks * 64) * 6144 + n;
        float acc[5] = {0.f, 0.f, 0.f, 0.f, 0.f};
#pragma unroll 16
        for (int k = 0; k < 64; ++k) { const float wv = W[(size_t)k * 6144];
#pragma unroll
            for (int cc = 0; cc < 5; ++cc) acc[cc] += s[cc * 1024 + ks * 64 + k] * wv; }
        const float bb = ks == 0 ? INP(I_BADA)[l * 6144 + n] : 0.f;
#pragma unroll
        for (int cc = 0; cc < 5; ++cc) atomicAdd(&mods[((size_t)l * 5 + cc) * 6144 + n], acc[cc] + bb);
    }
    __syncthreads();
    LAS float* scr = (LAS float*)(F.lds + F.wave * 8448);
    for (int it = F.gw; it < P0_NITEMS; it += F.NGW) {
        int r = it, inp = 0, K = 64, N = 32, mode = 0, H = 0, roff = 0; size_t soff = 0, doff = 0;
#pragma unroll 1
        for (int q = 0; q < 22; ++q) { p0_job(q, inp, soff, K, N, doff, mode, H, roff); const int ni = (K / 64) * (N / 32); if (r < ni) break; r -= ni; }
        p0_transpose_item(INP(inp) + soff, K, N, (bf16*)(ws + doff), mode, H, roff, scr, r, F.lane);
    }
    for (int it = F.gw; it < 384; it += F.NGW) {
        bf16* rowp = it < 192 ? (bf16*)(ws + W_MLA + (it / 96) * MLA_WB + MW_CAT) + (size_t)(672 + it % 96) * 1024 : (bf16*)(ws + W_SSI) + (size_t)(5184 + it - 192) * 1024;
        const v4u z = {0u, 0u, 0u, 0u}; ((GAS v4u*)rowp)[F.lane] = z; ((GAS v4u*)rowp)[64 + F.lane] = z;
    }
    for (int it = F.gw; it < 2048; it += F.NGW) {
        const int j = it >> 10, rr = it & 1023, b = rr >> 8, sq = rr & 255;
        const v4f v = ((const GAS v4f*)(INP(I_CCKV) + (((size_t)b * 2 + j) * 256 + sq) * 256))[F.lane];
        v2u o; o.x = pk2(v.x, v.y); o.y = pk2(v.z, v.w);
        ((GAS v2u*)((bf16*)(ws + WS_CKV + j * CKV_B) + (size_t)(T + rr) * 256))[F.lane] = o;
    }
    if (F.bx == 0) for (int i = F.tid; i < 640; i += NTHR) { const int pos = i >> 3, fi = i & 7; const float p = (float)(pos < 16 ? pos : pos - 16);
        const float a = p * rope_inv(fi); float* tab = (float*)(ws + WS_ROPE); tab[2 * i] = cosf(a); tab[2 * i + 1] = sinf(a); }
}

__device__ __forceinline__ void rp_normmod(Frame& F, const float* xlo, const float* xhi, const float* g, const float* mods_l, int sh_off, int sc_off, bf16* h) {
    for (int row = F.gw; row < T; row += F.NGW) {
        const GAS v4f* xr = (const GAS v4f*)((row < TP ? xlo : xhi) + (size_t)row * 1024) + F.lane;
        v4f v[4]; float ss = 0.f;
#pragma unroll
        for (int j = 0; j < 4; ++j) { v[j] = xr[64 * j]; ss += (v[j].x * v[j].x + v[j].y * v[j].y) + (v[j].z * v[j].z + v[j].w * v[j].w); }
        const float r = rsqrtf(wsum(ss, F.lane) * (1.f / 1024) + EPS);
        const float* m = mods_l + (size_t)cond_of_row(row) * 6144;
#pragma unroll
        for (int j = 0; j < 4; ++j) { const int c = 4 * F.lane + 256 * j;
            const v4f g4 = *(const v4f*)(g + c), sc = *(const v4f*)(m + sc_off + c), sh = *(const v4f*)(m + sh_off + c);
            const v4f o = v[j] * r * g4 * (sc + 1.f) + sh; v2u w; w.x = pk2(o.x, o.y); w.y = pk2(o.z, o.w);
            *(GAS v2u*)(h + (size_t)row * 1024 + c) = w; }
    }
}
__device__ __forceinline__ void rp_mla_fin1(Frame& F, const float* lat, const float* gq, const float* gkv, bf16* qn, bf16* ckv, float* out, int j) {
    for (int row = F.gw; row < T; row += F.NGW) {
        const float* lr = lat + (size_t)row * 768;
        v2f q[3]; float ss = 0.f;
#pragma unroll
        for (int i = 0; i < 3; ++i) { q[i] = *(const GAS v2f*)(lr + 2 * F.lane + 128 * i); ss += q[i].x * q[i].x + q[i].y * q[i].y; }
        float r = rsqrtf(wsum(ss, F.lane) * (1.f / 384) + EPS);
#pragma unroll
        for (int i = 0; i < 3; ++i) { const int c = 2 * F.lane + 128 * i; *(GAS unsigned*)(qn + (size_t)row * 384 + c) = pk2(q[i].x * r * gq[c], q[i].y * r * gq[c + 1]); }
        v2f k[2]; ss = 0.f;
#pragma unroll
        for (int i = 0; i < 2; ++i) { k[i] = *(const GAS v2f*)(lr + 384 + 2 * F.lane + 128 * i); ss += k[i].x * k[i].x + k[i].y * k[i].y; }
        r = rsqrtf(wsum(ss, F.lane) * (1.f / 256) + EPS);
#pragma unroll
        for (int i = 0; i < 2; ++i) { const int c = 2 * F.lane + 128 * i; const float c0 = k[i].x * r * gkv[c], c1 = k[i].y * r * gkv[c + 1];
            *(GAS unsigned*)(ckv + (size_t)row * 256 + c) = pk2(c0, c1);
            if (row < TP) { v2f o; o.x = c0; o.y = c1; *(GAS v2f*)(out + OUT_CKV + (((size_t)(row >> 8) * 2 + j) * 256 + (row & 255)) * 256 + c) = o; } }
        if (row < TP && F.lane < 32) out[OUT_KPE + (((size_t)(row >> 8) * 2 + j) * 256 + (row & 255)) * 32 + F.lane] = lr[640 + F.lane];
    }
}
__device__ __forceinline__ void rope32_tab(float* pe, int t, const float* tab) {
    const v2f* tr = (const v2f*)tab + (t >> 6) * 8; const v2f* tc = (const v2f*)tab + (16 + (t & 63)) * 8;
#pragma unroll
    for (int i = 0; i < 8; ++i) {
        v2f cs = tr[i]; float x1 = pe[i], x2 = pe[i + 8]; pe[i] = x1 * cs.x - x2 * cs.y; pe[i + 8] = x2 * cs.x + x1 * cs.y;
        cs = tc[i]; x1 = pe[16 + i]; x2 = pe[24 + i]; pe[16 + i] = x1 * cs.x - x2 * cs.y; pe[24 + i] = x2 * cs.x + x1 * cs.y;
    }
}
__device__ __forceinline__ void ld8(const bf16* p, float* d) { const v4u w = *(const GAS v4u*)p; d[0] = bflo(w.x); d[1] = bfhi(w.x); d[2] = bflo(w.y); d[3] = bfhi(w.y); d[4] = bflo(w.z); d[5] = bfhi(w.z); d[6] = bflo(w.w); d[7] = bfhi(w.w); }
__device__ __forceinline__ void st8(bf16* p, const float* d) { v4u w; w.x = pk2(d[0], d[1]); w.y = pk2(d[2], d[3]); w.z = pk2(d[4], d[5]); w.w = pk2(d[6], d[7]); *(GAS v4u*)p = w; }
__device__ __forceinline__ void rp_mla_fin2(Frame& F, const bf16* qraw, const bf16* kvraw, const float* lat, const float* ckpe_j, const float* gqn, const float* gkn, const float* tab, bf16* Q, bf16* K) {
    for (int idx = F.bx * NTHR + F.tid; idx < T * 32; idx += F.G * NTHR) {
        const int row = idx >> 5, hd = (idx >> 1) & 15, hf = idx & 1; const bool latent = row >= TP; const int tl = (row - TP) & 1023;
        float v[48]; float ss = 0.f;
#pragma unroll
        for (int i = 0; i < 6; ++i) ld8(qraw + (size_t)row * 1536 + hd * 96 + hf * 48 + 8 * i, v + 8 * i);
#pragma unroll
        for (int d = 0; d < 48; ++d) ss += v[d] * v[d];
        ss += shx(ss, F.lane, 1);
        const float r = rsqrtf(ss * (1.f / 96) + EPS) * QSCALE;
#pragma unroll
        for (int d = 0; d < 48; ++d) v[d] = v[d] * r * gqn[hf * 48 + d];
        if (latent && hf) rope32_tab(v + 16, tl, tab);
#pragma unroll
        for (int i = 0; i < 6; ++i) st8(Q + ((size_t)row * 16 + hd) * 96 + hf * 48 + 8 * i, v + 8 * i);
    }
    asm volatile("" ::: "memory");
    for (int idx = F.bx * NTHR + F.tid; idx < (T + NCTX) * 32; idx += F.G * NTHR) {
        const int row = idx >> 5, hd = (idx >> 1) & 15, hf = idx & 1; const bool latent = row >= TP && row < T; const int tl = (row - TP) & 1023;
        float v[48]; float ss = 0.f;
        if (hf == 0) {
#pragma unroll
            for (int i = 0; i < 6; ++i) ld8(kvraw + (size_t)row * 2048 + hd * 128 + 8 * i, v + 8 * i);
        } else {
#pragma unroll
            for (int i = 0; i < 2; ++i) ld8(kvraw + (size_t)row * 2048 + hd * 128 + 48 + 8 * i, v + 8 * i);
            const float* kp = row < T ? lat + (size_t)row * 768 + 640 : ckpe_j + ((size_t)((row - T) >> 8) * 2 * 256 + ((row - T) & 255)) * 32;
#pragma unroll
            for (int i = 0; i < 8; ++i) { const v4f p4 = *(const GAS v4f*)(kp + 4 * i); v[16 + 4 * i] = p4.x; v[17 + 4 * i] = p4.y; v[18 + 4 * i] = p4.z; v[19 + 4 * i] = p4.w; }
        }
#pragma unroll
        for (int d = 0; d < 48; ++d) ss += v[d] * v[d];
        ss += shx(ss, F.lane, 1);
        const float r = rsqrtf(ss * (1.f / 96) + EPS);
#pragma unroll
        for (int d = 0; d < 48; ++d) v[d] = v[d] * r * gkn[hf * 48 + d];
        if (latent && hf) rope32_tab(v + 16, tl, tab);
#pragma unroll
        for (int i = 0; i < 6; ++i) st8(K + ((size_t)row * 16 + hd) * 96 + hf * 48 + 8 * i, v + 8 * i);
    }
}
__device__ __forceinline__ void rp_dwconv(Frame& F, const bf16* u, const float* wdw, const float* bdw, const float* gln, const float* bln, bf16* vout) {
    for (int row = F.gw; row < T; row += F.NGW) {
        int t, L; row_pos(row, t, L);
        float y[16];
#pragma unroll
        for (int hseg = 0; hseg < 2; ++hseg) { const int c0 = 512 * hseg + 8 * F.lane;
#pragma unroll
            for (int i = 0; i < 8; ++i) y[8 * hseg + i] = bdw[c0 + i];
            for (int k = 0; k < 31; ++k) { const int tt = t + k - 15; if (tt < 0 || tt >= L) continue;
                float uu[8]; ld8(u + (size_t)(row + k - 15) * 1024 + c0, uu);
                const v4f w0 = *(const GAS v4f*)(wdw + k * 1024 + c0), w1 = *(const GAS v4f*)(wdw + k * 1024 + c0 + 4);
                y[8 * hseg + 0] += uu[0] * w0.x; y[8 * hseg + 1] += uu[1] * w0.y; y[8 * hseg + 2] += uu[2] * w0.z; y[8 * hseg + 3] += uu[3] * w0.w;
                y[8 * hseg + 4] += uu[4] * w1.x; y[8 * hseg + 5] += uu[5] * w1.y; y[8 * hseg + 6] += uu[6] * w1.z; y[8 * hseg + 7] += uu[7] * w1.w; } }
        float s = 0.f;
#pragma unroll
        for (int i = 0; i < 16; ++i) s += y[i];
        const float mean = wsum(s, F.lane) * (1.f / 1024); float q = 0.f;
#pragma unroll
        for (int i = 0; i < 16; ++i) { y[i] -= mean; q += y[i] * y[i]; }
        const float r = rsqrtf(wsum(q, F.lane) * (1.f / 1024) + EPS);
#pragma unroll
        for (int hseg = 0; hseg < 2; ++hseg) { const int c0 = 512 * hseg + 8 * F.lane; float o[8];
#pragma unroll
            for (int i = 0; i < 8; ++i) { const float z = y[8 * hseg + i] * r * gln[c0 + i] + bln[c0 + i]; o[i] = z / (1.f + __expf(-z)); }
            st8(vout + (size_t)row * 1024 + c0, o); }
    }
}
__device__ __forceinline__ void rp_ssd_conv(Frame& F, const bf16* xpre, const float* dtraw, const float* wc, const float* bc, const float* dtb, bf16* xbc, float* dt) {
    for (int idx = F.bx * NTHR + F.tid; idx < T * 392; idx += F.G * NTHR) {
        const int row = idx / 392, cg = idx % 392;
        if (cg < 384) { const int c0 = 8 * cg; int t, L; row_pos(row, t, L);
            float a[8];
#pragma unroll
            for (int i = 0; i < 8; ++i) a[i] = bc[c0 + i];
#pragma unroll
            for (int k = 0; k < 5; ++k) { const int tt = t + k - 2; if (tt < 0 || tt >= L) continue;
                float xx[8]; ld8(xpre + (size_t)(row + k - 2) * 3072 + c0, xx);
#pragma unroll
                for (int i = 0; i < 8; ++i) a[i] += xx[i] * wc[k * 3072 + c0 + i]; }
#pragma unroll
            for (int i = 0; i < 8; ++i) a[i] = a[i] / (1.f + __expf(-a[i]));
            st8(xbc + (size_t)row * 3072 + c0, a);
        } else { const int e0 = 8 * (cg - 384);
#pragma unroll
            for (int i = 0; i < 8; ++i) dt[(size_t)row * 64 + e0 + i] = softplus_f(dtraw[(size_t)row * 64 + e0 + i] + dtb[e0 + i]); }
    }
}
__device__ __forceinline__ void rp_ssd_gate(Frame& F, const float* y, const bf16* z, const float* gn, bf16* yn) {
    for (int row = F.gw; row < T; row += F.NGW) {
#pragma unroll
        for (int g = 0; g < 4; ++g) { const int c0 = g * 512 + 8 * F.lane; float zz[8], v[8]; ld8(z + (size_t)row * 2048 + c0, zz);
            const v4f y0 = *(const GAS v4f*)(y + (size_t)row * 2048 + c0), y1 = *(const GAS v4f*)(y + (size_t)row * 2048 + c0 + 4);
            v[0] = y0.x; v[1] = y0.y; v[2] = y0.z; v[3] = y0.w; v[4] = y1.x; v[5] = y1.y; v[6] = y1.z; v[7] = y1.w; float ss = 0.f;
#pragma unroll
            for (int i = 0; i < 8; ++i) { v[i] = v[i] * zz[i] / (1.f + __expf(-zz[i])); ss += v[i] * v[i]; }
            const float r = rsqrtf(wsum(ss, F.lane) * (1.f / 512) + EPS);
#pragma unroll
            for (int i = 0; i < 8; ++i) v[i] = v[i] * r * gn[c0 + i];
            st8(yn + (size_t)row * 2048 + c0, v); }
    }
}

__device__ __forceinline__ void ph_attn_slow(Frame& F, const bf16* Q, const bf16* K, const bf16* KV, bf16* AO) {
    for (int idx = F.bx * NTHR + F.tid; idx < T * 32; idx += F.G * NTHR) {
        const int row = idx >> 5, hd = (idx >> 1) & 15, dh = idx & 1;
        float q[96], o[32];
#pragma unroll
        for (int i = 0; i < 12; ++i) ld8(Q + ((size_t)row * 16 + hd) * 96 + 8 * i, q + 8 * i);
#pragma unroll
        for (int d = 0; d < 32; ++d) o[d] = 0.f;
        float m = -INFINITY, l = 0.f;
        int nkeys, kb0, kb1;
        if (row < TP) { nkeys = 256; kb0 = row & ~255; kb1 = 0; } else { const int b = (row - TP) >> 10; nkeys = 1280; kb0 = T + b * 256; kb1 = TP + b * 1024; }
        for (int key = 0; key < nkeys; ++key) { const int kr = key < 256 ? kb0 + key : kb1 + key - 256;
            float kk[8]; float s = 0.f;
#pragma unroll
            for (int i = 0; i < 12; ++i) { if ((i & 3) == 0) asm volatile("" ::: "memory"); ld8(K + ((size_t)kr * 16 + hd) * 96 + 8 * i, kk);
#pragma unroll
                for (int e = 0; e < 8; ++e) s += q[8 * i + e] * kk[e]; }
            const float mn = fmaxf(m, s), a = exp2f(m - mn), p = exp2f(s - mn); l = l * a + p; m = mn;
#pragma unroll
            for (int i = 0; i < 4; ++i) { ld8(KV + (size_t)kr * 2048 + hd * 128 + 64 + dh * 32 + 8 * i, kk);
#pragma unroll
                for (int e = 0; e < 8; ++e) o[8 * i + e] = o[8 * i + e] * a + p * kk[e]; } }
        const float il = 1.f / l;
#pragma unroll
        for (int d = 0; d < 32; ++d) o[d] *= il;
#pragma unroll
        for (int i = 0; i < 4; ++i) st8(AO + (size_t)row * 1024 + hd * 64 + dh * 32 + 8 * i, o + 8 * i);
    }
}
__device__ __forceinline__ void ph_scan_slow(Frame& F, const bf16* xbc, const float* dt, const float* alog, const float* dsk, const float* st0, float* y, float* out) {
    for (int it = F.gw; it < 20 * 32 * 2; it += F.NGW) {
        const int seq = it >> 6, hd = (it >> 1) & 31, g = hd >> 3, p = (it & 1) * 32 + (F.lane & 31), nh = F.lane >> 5;
        int r0, L; if (seq < 16) { r0 = seq * 256; L = 256; } else { r0 = TP + (seq - 16) * 1024; L = 1024; }
#pragma unroll 1
        for (int dir = 0; dir < 2; ++dir) {
            const float a = -expf(alog[dir * 32 + hd]), dd = dsk[dir * 32 + hd];
            float hs[64];
#pragma unroll
            for (int n = 0; n < 64; ++n) hs[n] = 0.f;
            if (seq >= 16) { const float* s0 = st0 + ((((size_t)(seq - 16) * 2 + dir) * 32 + hd) * 64 + p) * 128 + nh * 64;
#pragma unroll
                for (int n4 = 0; n4 < 16; ++n4) { const v4f t4 = *(const GAS v4f*)(s0 + 4 * n4); hs[4 * n4] = t4.x; hs[4 * n4 + 1] = t4.y; hs[4 * n4 + 2] = t4.z; hs[4 * n4 + 3] = t4.w; } }
#pragma unroll 1
            for (int s = 0; s < L; ++s) {
                const int row = r0 + (dir == 0 ? s : L - 1 - s);
                const float dtv = dt[(size_t)row * 64 + dir * 32 + hd], da = expf(dtv * a), xv = bf2f(xbc[(size_t)row * 3072 + hd * 64 + p]), dtx = dtv * xv;
                const bf16* Bp = xbc + (size_t)row * 3072 + 2048 + g * 128 + nh * 64; const bf16* Cp = Bp + 512;
                float acc = 0.f;
#pragma unroll
                for (int n8 = 0; n8 < 8; ++n8) { float bb[8], cc[8]; if ((n8 & 1) == 0) asm volatile("" ::: "memory"); ld8(Bp + 8 * n8, bb); ld8(Cp + 8 * n8, cc);
#pragma unroll
                    for (int e = 0; e < 8; ++e) { hs[8 * n8 + e] = hs[8 * n8 + e] * da + dtx * bb[e]; acc += cc[e] * hs[8 * n8 + e]; } }
                acc += shx(acc, F.lane, 32);
                if (nh == 0) { float* yp = y + (size_t)row * 2048 + hd * 64 + p; const float yv = acc + xv * dd; *yp = dir == 0 ? yv : *yp + yv; }
            }
            if (seq < 16) { float* o = out + OUT_SSM + ((((size_t)seq * 2 + dir) * 32 + hd) * 64 + p) * 128 + nh * 64;
#pragma unroll
                for (int n4 = 0; n4 < 16; ++n4) { v4f t4; t4.x = hs[4 * n4]; t4.y = hs[4 * n4 + 1]; t4.z = hs[4 * n4 + 2]; t4.w = hs[4 * n4 + 3]; *(GAS v4f*)(o + 4 * n4) = t4; } }
        }
    }
}

constexpr int NPHASE = 37;
enum Op { OP_P0, OP_NORM1, OP_G_LAT, OP_FIN1, OP_G_QKV, OP_FIN2, OP_ATTN, OP_G_WO, OP_NORM2, OP_G_FF1, OP_G_FF2, OP_G_PW1, OP_DWCONV, OP_G_PW2, OP_G_SSI, OP_SSCONV, OP_SCAN, OP_GATE, OP_G_SSO };
__device__ __forceinline__ void phase_decode(int ph, int& layer, int& op) {
    if (ph == 0) { layer = 0; op = OP_P0; return; }
    int r;
    if (ph <= 10) { layer = 0; r = ph - 1; } else if (ph <= 17) { layer = 1; r = ph - 11; } else if (ph <= 26) { layer = 2; r = ph - 18; } else { layer = 3; r = ph - 27; }
    const int kind = layer % 3;
    if (kind == 0) { op = r == 0 ? OP_NORM1 : r == 1 ? OP_G_LAT : r == 2 ? OP_FIN1 : r == 3 ? OP_G_QKV : r == 4 ? OP_FIN2 : r == 5 ? OP_ATTN : r == 6 ? OP_G_WO : r == 7 ? OP_NORM2 : r == 8 ? OP_G_FF1 : OP_G_FF2; }
    else if (kind == 1) { op = r == 0 ? OP_NORM1 : r == 1 ? OP_G_PW1 : r == 2 ? OP_DWCONV : r == 3 ? OP_G_PW2 : r == 4 ? OP_NORM2 : r == 5 ? OP_G_FF1 : OP_G_FF2; }
    else { op = r == 0 ? OP_NORM1 : r == 1 ? OP_G_SSI : r == 2 ? OP_SSCONV : r == 3 ? OP_SCAN : r == 4 ? OP_GATE : r == 5 ? OP_G_SSO : r == 6 ? OP_NORM2 : r == 7 ? OP_G_FF1 : OP_G_FF2; }
}
struct MArgs { const float* in[38]; float* out; unsigned char* ws; int ph_lo, ph_hi; };
constexpr int PTAB_OFF = MISC_OFF - 512;
__global__ void __launch_bounds__(NTHR, 2) mega_fwd(MArgs args) {
    extern __shared__ __attribute__((aligned(16))) unsigned char lds_raw[];
    LAS unsigned char* lds = (LAS unsigned char*)lds_raw;
    volatile LAS unsigned* PT0 = (volatile LAS unsigned*)(lds + PTAB_OFF);
    volatile LAS unsigned* MISC = (volatile LAS unsigned*)(lds + MISC_OFF);
    { const int t0 = threadIdx.x;
      if (t0 < 40) { const unsigned long long p = t0 < 38 ? (unsigned long long)args.in[t0] : t0 == 38 ? (unsigned long long)args.out : (unsigned long long)args.ws;
          PT0[2 * t0] = (unsigned)p; PT0[2 * t0 + 1] = (unsigned)(p >> 32); }
      if (t0 < 64) MISC[t0] = 0u; }
    __syncthreads();
    XcdBarrier bar = xcd_barrier_post((unsigned*)((unsigned char*)ldp(PT0, PT_WS) + WS_CTL) + CW_BAR, MISC + 8);
    const int wave0 = __builtin_amdgcn_readfirstlane(threadIdx.x >> 6);
    const int ph_hi = args.ph_hi;
    for (int ph = args.ph_lo; ph < ph_hi; ++ph) {
        Frame F;
        { int w = wave0; asm volatile("" : "+s"(w)); F.wave = w; }
        F.lds = lds; F.lane = olane(); F.tid = F.wave * 64 + F.lane;
        const int bx = obid();
        F.G = gridDim.x; F.vcu = (F.G % 8 == 0) ? (bx % 8) * (F.G / 8) + bx / 8 : bx;
        F.gw = F.vcu * NWAVES + F.wave; F.NGW = F.G * NWAVES; F.PT = PT0; F.bx = bx;
        int layer, op; phase_decode(ph, layer, op);
        const int j = layer / 3;
        switch (op) {
        case OP_P0: p0_prologue(F); break;
        case OP_NORM1: { unsigned char* ws = WSP; float* x = OUTP; const float* xlo = layer == 0 ? INP(I_XP) : x; const float* xhi = layer == 0 ? INP(I_XS) - (size_t)TP * 1024 : x;
            rp_normmod(F, xlo, xhi, INP(I_GN1) + layer * 1024, (const float*)(ws + WS_MODS) + (size_t)layer * 5 * 6144, 0, 1024, (bf16*)(ws + WS_H)); } break;
        case OP_NORM2: { unsigned char* ws = WSP; float* x = OUTP;
            rp_normmod(F, x, x, INP(I_GN2) + layer * 1024, (const float*)(ws + WS_MODS) + (size_t)layer * 5 * 6144, 3072, 4096, (bf16*)(ws + WS_H)); } break;
        case OP_G_LAT: { unsigned char* ws = WSP; pg8::Gemm g{(const bf16*)(ws + WS_H), (const bf16*)(ws + W_MLA + j * MLA_WB + MW_CAT), T, 768, 1024}; pg8::StaticOrder S; S.init(T, 768, F.G, F.bx);
            pg8::EpiF32 E{(float*)(ws + A_LAT), 768}; pg8::gemm_phase<pg8::EpiF32, pg8::StaticOrder, true, true>(F.lds, g, S, E, F.wave); } break;
        case OP_FIN1: { unsigned char* ws = WSP; rp_mla_fin1(F, (const float*)(ws + A_LAT), INP(I_GQ) + j * 384, INP(I_GKV) + j * 256, (bf16*)(ws + A_QN), (bf16*)(ws + WS_CKV + j * CKV_B), OUTP, j); } break;
        case OP_G_QKV: {
#pragma unroll 1
            for (int w = 0; w < 2; ++w) {
                unsigned char* ws = WSP; unsigned char* wm = ws + W_MLA + j * MLA_WB;
                pg8::Gemm g = w == 0 ? pg8::Gemm{(const bf16*)(ws + A_QN), (const bf16*)(wm + MW_UQ), T, 1536, 384} : pg8::Gemm{(const bf16*)(ws + WS_CKV + j * CKV_B), (const bf16*)(wm + MW_UKV), T + NCTX, 2048, 256};
                pg8::StaticOrder S; S.init(g.M, g.N, F.G, w == 0 ? F.bx : (int)((F.bx + 64) % F.G));
                pg8::EpiBf16P E{w == 0 ? (bf16*)(ws + A_QRAW) : (bf16*)(ws + A_KVRAW), g.N};
                pg8::gemm_phase<pg8::EpiBf16P, pg8::StaticOrder, true, true>(F.lds, g, S, E, F.wave);
            } } break;
        case OP_FIN2: { unsigned char* ws = WSP; rp_mla_fin2(F, (const bf16*)(ws + A_QRAW), (const bf16*)(ws + A_KVRAW), (const float*)(ws + A_LAT), INP(I_CKPE) + (size_t)j * 8192, INP(I_GQN) + j * 96, INP(I_GKN) + j * 96,
                                                        (const float*)(ws + WS_ROPE), (bf16*)(ws + A_QB), (bf16*)(ws + A_KB)); } break;
        case OP_ATTN: { unsigned char* ws = WSP; ph_attn_slow(F, (const bf16*)(ws + A_QB), (const bf16*)(ws + A_KB), (const bf16*)(ws + A_KVRAW), (bf16*)(ws + A_AO)); } break;
        case OP_G_WO: case OP_G_PW2: case OP_G_SSO: case OP_G_FF2: {
            unsigned char* ws = WSP; float* x = OUTP;
            const float* rlo = (layer == 0 && op != OP_G_FF2) ? INP(I_XP) : x; const float* rhi = (layer == 0 && op != OP_G_FF2) ? INP(I_XS) - (size_t)TP * 1024 : x;
            pg8::Gemm g; const float* bias = nullptr; int goff = 2048;
            if (op == OP_G_WO) g = pg8::Gemm{(const bf16*)(ws + A_AO), (const bf16*)(ws + W_MLA + j * MLA_WB + MW_O), T, 1024, 1024};
            else if (op == OP_G_PW2) { g = pg8::Gemm{(const bf16*)(ws + A_V), (const bf16*)(ws + W_CV2), T, 1024, 1024}; bias = INP(I_CVB2); }
            else if (op == OP_G_SSO) g = pg8::Gemm{(const bf16*)(ws + A_YN), (const bf16*)(ws + W_SSO), T, 1024, 2048};
            else { g = pg8::Gemm{(const bf16*)(ws + A_ACT), (const bf16*)(ws + W_FF + layer * FF_WB + FW_OUT), T, 1024, 2816}; goff = 5120; }
            pg8::StaticOrder S; S.init(T, 1024, F.G, F.bx);
            pg8::EpiResid E{rlo, rhi, x, (const float*)(ws + WS_MODS) + (size_t)layer * 5 * 6144, goff, bias};
            pg8::gemm_phase<pg8::EpiResid, pg8::StaticOrder, true, true>(F.lds, g, S, E, F.wave); } break;
        case OP_G_FF1: { unsigned char* ws = WSP; pg8::Gemm g{(const bf16*)(ws + WS_H), (const bf16*)(ws + W_FF + layer * FF_WB + FW_IN), T, 5632, 1024}; pg8::StaticOrder S; S.init(T, 5632, F.G, F.bx);
            pg8::EpiGlu<0> E{(bf16*)(ws + A_ACT), 2816, nullptr, 2816}; pg8::gemm_phase<pg8::EpiGlu<0>, pg8::StaticOrder, true, true>(F.lds, g, S, E, F.wave); } break;
        case OP_G_PW1: { unsigned char* ws = WSP; pg8::Gemm g{(const bf16*)(ws + WS_H), (const bf16*)(ws + W_CV1), T, 2048, 1024}; pg8::StaticOrder S; S.init(T, 2048, F.G, F.bx);
            pg8::EpiGlu<1> E{(bf16*)(ws + A_U), 1024, INP(I_CVB1), 1024}; pg8::gemm_phase<pg8::EpiGlu<1>, pg8::StaticOrder, true, true>(F.lds, g, S, E, F.wave); } break;
        case OP_DWCONV: { unsigned char* ws = WSP; rp_dwconv(F, (const bf16*)(ws + A_U), INP(I_CVWD), INP(I_CVBD), INP(I_CVGL), INP(I_CVBL), (bf16*)(ws + A_V)); } break;
        case OP_G_SSI: { unsigned char* ws = WSP; pg8::Gemm g{(const bf16*)(ws + WS_H), (const bf16*)(ws + W_SSI), T, 5376, 1024}; pg8::StaticOrder S; S.init(T, 5376, F.G, F.bx);
            pg8::EpiSsdIn E{(bf16*)(ws + A_Z), (bf16*)(ws + A_XPRE), (float*)(ws + A_DTRAW)}; pg8::gemm_phase<pg8::EpiSsdIn, pg8::StaticOrder, true, true>(F.lds, g, S, E, F.wave); } break;
        case OP_SSCONV: { unsigned char* ws = WSP; rp_ssd_conv(F, (const bf16*)(ws + A_XPRE), (const float*)(ws + A_DTRAW), INP(I_SSWC), INP(I_SSBC), INP(I_SSDTB), (bf16*)(ws + A_XBC), (float*)(ws + A_DT)); } break;
        case OP_SCAN: { unsigned char* ws = WSP; ph_scan_slow(F, (const bf16*)(ws + A_XBC), (const float*)(ws + A_DT), INP(I_SSAL), INP(I_SSD), INP(I_SSM), (float*)(ws + A_Y), OUTP); } break;
        case OP_GATE: { unsigned char* ws = WSP; rp_ssd_gate(F, (const float*)(ws + A_Y), (const bf16*)(ws + A_Z), INP(I_SSGN), (bf16*)(ws + A_YN)); } break;
        default: break;
        }
        if (ph + 1 < ph_hi) xcd_barrier(bar);
    }
}

#ifndef MK_PHASES
#define MK_PHASES 37
#endif
#ifndef MK_PER_PHASE
#define MK_PER_PHASE 0
#endif
static int sub_after_phases(int p) { return p >= 37 ? 8 : p >= 34 ? 7 : p >= 27 ? 6 : p >= 24 ? 5 : p >= 18 ? 4 : p >= 15 ? 3 : p >= 11 ? 2 : p >= 8 ? 1 : 0; }
extern "C" void kernel_launch(void* const* d_in, const int* in_sizes, int n_in, void* d_out, int out_size, void* d_ws, size_t ws_size, hipStream_t stream) {
    static int grid = 0;
    if (grid == 0) {
        int dev = 0, cus = 0;
        if (hipGetDevice(&dev) != hipSuccess || hipDeviceGetAttribute(&cus, hipDeviceAttributeMultiprocessorCount, dev) != hipSuccess) { fprintf(stderr, "kernel_launch: device query failed\n"); grid = -1; return; }
        if (hipFuncSetAttribute((const void*)mega_fwd, hipFuncAttributeMaxDynamicSharedMemorySize, LDS_BYTES) != hipSuccess) { fprintf(stderr, "kernel_launch: hipFuncSetAttribute failed\n"); grid = -1; return; }
        (void)hipGetLastError();
        grid = cus;
    }
    if (grid < 0) return;
    In I; const float** p = (const float**)&I;
    for (int i = 0; i < 38; ++i) p[i] = (const float*)d_in[i];
    (void)hipMemsetAsync((char*)d_ws + WS_CTL, 0, CTL_ZERO_BYTES, stream);
    MArgs a{};
    for (int i = 0; i < 38; ++i) a.in[i] = (const float*)d_in[i];
    a.out = (float*)d_out; a.ws = (unsigned char*)d_ws;
    const int nph = MK_PHASES;
    if (MK_PER_PHASE) { for (int ph = 0; ph < nph; ++ph) { a.ph_lo = ph; a.ph_hi = ph + 1; hipLaunchKernelGGL(mega_fwd, dim3(grid), dim3(NTHR), LDS_BYTES, stream, a); } }
    else { a.ph_lo = 0; a.ph_hi = nph; hipLaunchKernelGGL(mega_fwd, dim3(grid), dim3(NTHR), LDS_BYTES, stream, a); }
    const int sub = sub_after_phases(nph);
    if (sub < 8) naive_forward(I, (float*)d_out, (float*)d_ws, stream, sub);
}
```

```cpp
#include <hip/hip_runtime.h>
#include <cstdint>
#include <cstdio>

constexpr int DM = 1024, T = 8192, TP = 4096;
constexpr int NCTX = 1024;
constexpr int QL = 384, KVL = 256, ROPE = 32, NOPE = 64, QKD = 96, VH = 64, NH = 16;
constexpr int FFH = 2816;
constexpr int SSI = 2048, SSH = 32, SSP = 64, SSN = 128, SSG = 4, SSCD = 3072, SSIN = 5184;
constexpr float EPS = 1e-6f;
constexpr size_t OUT_YP = 0, OUT_CKV = 8388608, OUT_KPE = 10485760, OUT_SSM = 10747904;

__device__ __forceinline__ int cond_of_row(int r) { return r < TP ? 0 : 1 + ((r - TP) >> 10); }
__device__ __forceinline__ void row_pos(int r, int& t, int& L) { if (r < TP) { t = r & 255; L = 256; } else { t = (r - TP) & 1023; L = 1024; } }
__device__ __forceinline__ float silu_f(float x) { return x / (1.f + expf(-x)); }
__device__ __forceinline__ float sigmoid_f(float x) { return 1.f / (1.f + expf(-x)); }
__device__ __forceinline__ float softplus_f(float x) { return fmaxf(x, 0.f) + log1pf(expf(-fabsf(x))); }
__device__ __forceinline__ float wave_sum(float v) {
#pragma unroll
    for (int o = 1; o < 64; o <<= 1) v += __shfl_xor(v, o);
    return v;
}

__global__ void __launch_bounds__(256) nk_adaln(const float* __restrict__ c, const float* __restrict__ cctx, const float* __restrict__ w, const float* __restrict__ b, float* __restrict__ mods) {
    __shared__ float s[5][DM];
    const int l = blockIdx.y, n = blockIdx.x * 256 + threadIdx.x;
    for (int i = threadIdx.x; i < 5 * DM; i += 256) { const int cc = i / DM, k = i % DM; const float v = cc == 0 ? cctx[k] : c[(cc - 1) * DM + k]; s[cc][k] = silu_f(v); }
    __syncthreads();
    const float* W = w + (size_t)l * DM * 6144;
    float acc[5] = {0.f, 0.f, 0.f, 0.f, 0.f};
    for (int k = 0; k < DM; ++k) { const float wv = W[(size_t)k * 6144 + n];
#pragma unroll
        for (int cc = 0; cc < 5; ++cc) acc[cc] += s[cc][k] * wv; }
#pragma unroll
    for (int cc = 0; cc < 5; ++cc) mods[((size_t)l * 5 + cc) * 6144 + n] = acc[cc] + b[l * 6144 + n];
}

__global__ void __launch_bounds__(256) nk_copy_x(const float* __restrict__ xp, const float* __restrict__ xs, float* __restrict__ x) {
    const size_t i = (size_t)blockIdx.x * 256 + threadIdx.x;
    const size_t half = (size_t)TP * DM / 4;
    ((float4*)x)[i] = i < half ? ((const float4*)xp)[i] : ((const float4*)xs)[i - half];
}

__global__ void __launch_bounds__(256) nk_normmod(const float* __restrict__ x, const float* __restrict__ g, const float* __restrict__ mods_l, int sh_off, int sc_off, float* __restrict__ h) {
    const int row = blockIdx.x * 4 + (threadIdx.x >> 6), lane = threadIdx.x & 63;
    const float* xr = x + (size_t)row * DM; float v[16]; float ss = 0.f;
#pragma unroll
    for (int i = 0; i < 16; ++i) { v[i] = xr[lane + 64 * i]; ss += v[i] * v[i]; }
    ss = wave_sum(ss); const float r = rsqrtf(ss * (1.f / DM) + EPS);
    const float* m = mods_l + (size_t)cond_of_row(row) * 6144;
#pragma unroll
    for (int i = 0; i < 16; ++i) { const int k = lane + 64 * i; h[(size_t)row * DM + k] = v[i] * r * g[k] * (1.f + m[sc_off + k]) + m[sh_off + k]; }
}

template <int GLU>
__global__ void __launch_bounds__(256) nk_gemm(const float* __restrict__ A, int lda, const float* __restrict__ B, int ldb, float* __restrict__ C, int ldc, int M, int N, int K, const float* __restrict__ bias) {
    __shared__ float As[16][65], Bs[16][65], Us[16][65];
    const int tx = threadIdx.x & 15, ty = threadIdx.x >> 4, m0 = blockIdx.y * 64, n0 = blockIdx.x * 64;
    float acc[4][4] = {}, acu[4][4] = {};
    for (int k0 = 0; k0 < K; k0 += 16) {
        for (int i = threadIdx.x; i < 1024; i += 256) { const int r = i >> 4, kk = i & 15; As[kk][r] = A[(size_t)(m0 + r) * lda + k0 + kk]; }
        for (int i = threadIdx.x; i < 1024; i += 256) { const int kk = i >> 6, cc = i & 63; const bool ok = n0 + cc < N; Bs[kk][cc] = ok ? B[(size_t)(k0 + kk) * ldb + n0 + cc] : 0.f;
            if (GLU) Us[kk][cc] = ok ? B[(size_t)(k0 + kk) * ldb + N + n0 + cc] : 0.f; }
        __syncthreads();
#pragma unroll
        for (int kk = 0; kk < 16; ++kk) { float a[4], b[4], u[4];
#pragma unroll
            for (int i = 0; i < 4; ++i) { a[i] = As[kk][ty * 4 + i]; b[i] = Bs[kk][tx * 4 + i]; u[i] = GLU ? Us[kk][tx * 4 + i] : 0.f; }
#pragma unroll
            for (int i = 0; i < 4; ++i)
#pragma unroll
                for (int j = 0; j < 4; ++j) { acc[i][j] += a[i] * b[j]; if (GLU) acu[i][j] += a[i] * u[j]; } }
        __syncthreads();
    }
#pragma unroll
    for (int i = 0; i < 4; ++i)
#pragma unroll
        for (int j = 0; j < 4; ++j) { const int n = n0 + tx * 4 + j; if (n < N) {
            float v = acc[i][j] + (bias ? bias[n] : 0.f);
            if (GLU) { const float u = acu[i][j] + (bias ? bias[N + n] : 0.f); v = GLU == 1 ? silu_f(v) * u : v * sigmoid_f(u); }
            C[(size_t)(m0 + ty * 4 + i) * ldc + n] = v; } }
}

__global__ void __launch_bounds__(256) nk_resid(float* __restrict__ x, const float* __restrict__ o, const float* __restrict__ mods_l, int g_off) {
    const size_t i = (size_t)blockIdx.x * 256 + threadIdx.x; const int row = (int)(i >> 10), k = (int)(i & 1023);
    x[i] += mods_l[(size_t)cond_of_row(row) * 6144 + g_off + k] * o[i];
}

__global__ void __launch_bounds__(256) nk_mla_fin1(const float* __restrict__ latq, const float* __restrict__ latkv, const float* __restrict__ gq, const float* __restrict__ gkv,
                                                   const float* __restrict__ cache_ckv_j  , float* __restrict__ qn, float* __restrict__ ckv, float* __restrict__ out, int j) {
    const int row = blockIdx.x * 4 + (threadIdx.x >> 6), lane = threadIdx.x & 63;
    if (row >= T) { const int b = (row - T) >> 8, s = (row - T) & 255;
#pragma unroll
        for (int i = 0; i < 4; ++i) ckv[(size_t)row * KVL + lane + 64 * i] = cache_ckv_j[((size_t)b * 2 * 256 + s) * 256 + lane + 64 * i];
        return; }
    float v[6]; float ss = 0.f;
#pragma unroll
    for (int i = 0; i < 6; ++i) { v[i] = latq[(size_t)row * QL + lane + 64 * i]; ss += v[i] * v[i]; }
    ss = wave_sum(ss); float r = rsqrtf(ss * (1.f / QL) + EPS);
#pragma unroll
    for (int i = 0; i < 6; ++i) qn[(size_t)row * QL + lane + 64 * i] = v[i] * r * gq[lane + 64 * i];
    ss = 0.f;
#pragma unroll
    for (int i = 0; i < 4; ++i) { v[i] = latkv[(size_t)row * 288 + lane + 64 * i]; ss += v[i] * v[i]; }
    ss = wave_sum(ss); r = rsqrtf(ss * (1.f / KVL) + EPS);
#pragma unroll
    for (int i = 0; i < 4; ++i) { const float c = v[i] * r * gkv[lane + 64 * i]; ckv[(size_t)row * KVL + lane + 64 * i] = c;
        if (row < TP) out[OUT_CKV + (((size_t)(row >> 8) * 2 + j) * 256 + (row & 255)) * 256 + lane + 64 * i] = c; }
    if (row < TP && lane < 32) out[OUT_KPE + (((size_t)(row >> 8) * 2 + j) * 256 + (row & 255)) * 32 + lane] = latkv[(size_t)row * 288 + 256 + lane];
}

__device__ __forceinline__ float rope_inv(int i) { return i == 0 ? 1.f : i == 1 ? 0.31622776601683794f : i == 2 ? 0.1f : i == 3 ? 0.031622776601683794f : i == 4 ? 0.01f : i == 5 ? 0.0031622776601683794f : i == 6 ? 0.001f : 0.00031622776601683794f; }
__device__ __forceinline__ void rope32(float* pe, int t) {
    const int rr = t >> 6, cc = t & 63;
#pragma unroll
    for (int i = 0; i < 8; ++i) {
        const float inv = rope_inv(i);
        float a = (float)rr * inv, s = sinf(a), c = cosf(a);
        float x1 = pe[i], x2 = pe[i + 8]; pe[i] = x1 * c - x2 * s; pe[i + 8] = x2 * c + x1 * s;
        a = (float)cc * inv; s = sinf(a); c = cosf(a);
        x1 = pe[16 + i]; x2 = pe[24 + i]; pe[16 + i] = x1 * c - x2 * s; pe[24 + i] = x2 * c + x1 * s;
    }
}
__global__ void __launch_bounds__(256) nk_mla_fin2(const float* __restrict__ qraw, const float* __restrict__ kvraw, const float* __restrict__ latkv, const float* __restrict__ cache_kpe_j,
                                                   const float* __restrict__ gqn, const float* __restrict__ gkn, float* __restrict__ Q, float* __restrict__ K) {
    const int idx = blockIdx.x * 256 + threadIdx.x, row = idx >> 4, h = idx & 15;
    const bool latent = row >= TP && row < T; const int tl = (row - TP) & 1023;
    if (row < T) {
        float q[96]; float ss = 0.f;
#pragma unroll
        for (int d = 0; d < 96; ++d) { q[d] = qraw[(size_t)row * 1536 + h * 96 + d]; ss += q[d] * q[d]; }
        const float r = rsqrtf(ss * (1.f / 96) + EPS);
#pragma unroll
        for (int d = 0; d < 96; ++d) q[d] = q[d] * r * gqn[d];
        if (latent) rope32(q + 64, tl);
#pragma unroll
        for (int d = 0; d < 96; ++d) Q[((size_t)row * 16 + h) * 96 + d] = q[d];
    }
    float k[96]; float ss = 0.f;
#pragma unroll
    for (int d = 0; d < 64; ++d) { k[d] = kvraw[(size_t)row * 2048 + h * 128 + d]; ss += k[d] * k[d]; }
#pragma unroll
    for (int d = 0; d < 32; ++d) { k[64 + d] = row < T ? latkv[(size_t)row * 288 + 256 + d] : cache_kpe_j[((size_t)((row - T) >> 8) * 2 * 256 + ((row - T) & 255)) * 32 + d]; ss += k[64 + d] * k[64 + d]; }
    const float r = rsqrtf(ss * (1.f / 96) + EPS);
#pragma unroll
    for (int d = 0; d < 96; ++d) k[d] = k[d] * r * gkn[d];
    if (latent) rope32(k + 64, tl);
#pragma unroll
    for (int d = 0; d < 96; ++d) K[((size_t)row * 16 + h) * 96 + d] = k[d];
}

__global__ void __launch_bounds__(64) nk_attn(const float* __restrict__ Q, const float* __restrict__ K, const float* __restrict__ KV  , float* __restrict__ O) {
    __shared__ float Ks[32][96], Vs[32][64];
    const int h = blockIdx.y, row = blockIdx.x * 64 + threadIdx.x;
    float q[96];
#pragma unroll
    for (int d = 0; d < 96; ++d) q[d] = Q[((size_t)row * 16 + h) * 96 + d];
    float o[64];
#pragma unroll
    for (int d = 0; d < 64; ++d) o[d] = 0.f;
    float m = -INFINITY, l = 0.f;
    int nkeys, kbase0, kbase1, n0;
    const int r0 = blockIdx.x * 64;
    if (r0 < TP) { nkeys = 256; n0 = 256; kbase0 = r0 & ~255; kbase1 = 0; }
    else { const int b = (r0 - TP) >> 10; nkeys = 1280; n0 = 256; kbase0 = T + b * 256; kbase1 = TP + b * 1024; }
    const float scale = rsqrtf(96.f);
    for (int k0 = 0; k0 < nkeys; k0 += 32) {
        __syncthreads();
        for (int i = threadIdx.x; i < 32 * 96; i += 64) { const int kk = i / 96, d = i % 96; const int key = k0 + kk; const int kr = key < n0 ? kbase0 + key : kbase1 + key - n0; Ks[kk][d] = K[((size_t)kr * 16 + h) * 96 + d]; }
        for (int i = threadIdx.x; i < 32 * 64; i += 64) { const int kk = i / 64, d = i % 64; const int key = k0 + kk; const int kr = key < n0 ? kbase0 + key : kbase1 + key - n0; Vs[kk][d] = KV[(size_t)kr * 2048 + h * 128 + 64 + d]; }
        __syncthreads();
        for (int kk = 0; kk < 32; ++kk) {
            float s = 0.f;
#pragma unroll
            for (int d = 0; d < 96; ++d) s += q[d] * Ks[kk][d];
            s *= scale;
            const float mn = fmaxf(m, s), a = expf(m - mn), p = expf(s - mn);
            l = l * a + p;
#pragma unroll
            for (int d = 0; d < 64; ++d) o[d] = o[d] * a + p * Vs[kk][d];
            m = mn;
        }
    }
    const float il = 1.f / l;
#pragma unroll
    for (int d = 0; d < 64; ++d) O[(size_t)row * DM + h * 64 + d] = o[d] * il;
}

__global__ void __launch_bounds__(256) nk_dwconv_ln(const float* __restrict__ u, const float* __restrict__ wdw, const float* __restrict__ bdw, const float* __restrict__ gln, const float* __restrict__ bln, float* __restrict__ v) {
    const int row = blockIdx.x * 4 + (threadIdx.x >> 6), lane = threadIdx.x & 63;
    int t, L; row_pos(row, t, L);
    float y[16]; float s = 0.f;
#pragma unroll
    for (int i = 0; i < 16; ++i) { const int c = lane + 64 * i; float a = bdw[c];
        for (int k = 0; k < 31; ++k) { const int tt = t + k - 15; if (tt >= 0 && tt < L) a += u[(size_t)(row + k - 15) * DM + c] * wdw[k * DM + c]; }
        y[i] = a; s += a; }
    const float mean = wave_sum(s) * (1.f / DM); float q = 0.f;
#pragma unroll
    for (int i = 0; i < 16; ++i) { y[i] -= mean; q += y[i] * y[i]; }
    const float r = rsqrtf(wave_sum(q) * (1.f / DM) + EPS);
#pragma unroll
    for (int i = 0; i < 16; ++i) { const int c = lane + 64 * i; v[(size_t)row * DM + c] = silu_f(y[i] * r * gln[c] + bln[c]); }
}

__global__ void __launch_bounds__(256) nk_ssd_conv(const float* __restrict__ xpre  , const float* __restrict__ dtraw  , const float* __restrict__ wc, const float* __restrict__ bc, const float* __restrict__ dtb, float* __restrict__ xbc, float* __restrict__ dt) {
    const size_t i = (size_t)blockIdx.x * 256 + threadIdx.x; const int row = (int)(i / 3136), c = (int)(i % 3136);
    int t, L; row_pos(row, t, L);
    if (c < SSCD) { float a = bc[c];
#pragma unroll
        for (int k = 0; k < 5; ++k) { const int tt = t + k - 2; if (tt >= 0 && tt < L) a += xpre[(size_t)(row + k - 2) * SSCD + c] * wc[k * SSCD + c]; }
        xbc[(size_t)row * SSCD + c] = silu_f(a);
    } else { const int e = c - SSCD; dt[(size_t)row * 64 + e] = softplus_f(dtraw[(size_t)row * 64 + e] + dtb[e]); }
}
__global__ void __launch_bounds__(64) nk_ssd_scan(const float* __restrict__ xbc, const float* __restrict__ dt, const float* __restrict__ alog, const float* __restrict__ dsk, const float* __restrict__ st0  ,
                                                  float* __restrict__ y  , float* __restrict__ out, int dir) {
    const int h = blockIdx.x, seq = blockIdx.y, p = threadIdx.x, g = h >> 3;
    int r0, L; if (seq < 16) { r0 = seq * 256; L = 256; } else { r0 = TP + (seq - 16) * 1024; L = 1024; }
    const float a = -expf(alog[dir * 32 + h]), dd = dsk[dir * 32 + h];
    float hs[128];
    if (seq < 16) {
#pragma unroll
        for (int n = 0; n < 128; ++n) hs[n] = 0.f;
    } else { const float* s0 = st0 + ((((size_t)(seq - 16) * 2 + dir) * 32 + h) * 64 + p) * 128;
#pragma unroll
        for (int n = 0; n < 128; ++n) hs[n] = s0[n]; }
    for (int s = 0; s < L; ++s) {
        const int row = r0 + (dir == 0 ? s : L - 1 - s);
        const float dtv = dt[(size_t)row * 64 + dir * 32 + h], da = expf(dtv * a), xv = xbc[(size_t)row * SSCD + h * 64 + p], dtx = dtv * xv;
        const float* Bp = xbc + (size_t)row * SSCD + SSI + g * 128; const float* Cp = Bp + 512;
        float acc = 0.f;
#pragma unroll
        for (int n = 0; n < 128; ++n) { hs[n] = hs[n] * da + dtx * Bp[n]; acc += Cp[n] * hs[n]; }
        float* yp = y + (size_t)row * SSI + h * 64 + p; const float yv = acc + xv * dd; *yp = dir == 0 ? yv : *yp + yv;
    }
    if (seq < 16) { float* o = out + OUT_SSM + ((((size_t)seq * 2 + dir) * 32 + h) * 64 + p) * 128;
#pragma unroll
        for (int n = 0; n < 128; ++n) o[n] = hs[n]; }
}
__global__ void __launch_bounds__(256) nk_ssd_gate(const float* __restrict__ y, const float* __restrict__ z  , const float* __restrict__ gn, float* __restrict__ yn) {
    const int row = blockIdx.x * 4 + (threadIdx.x >> 6), lane = threadIdx.x & 63;
#pragma unroll
    for (int g = 0; g < 4; ++g) { float v[8]; float ss = 0.f;
#pragma unroll
        for (int i = 0; i < 8; ++i) { const int c = g * 512 + lane + 64 * i; v[i] = y[(size_t)row * SSI + c] * silu_f(z[(size_t)row * SSI + c]); ss += v[i] * v[i]; }
        const float r = rsqrtf(wave_sum(ss) * (1.f / 512) + EPS);
#pragma unroll
        for (int i = 0; i < 8; ++i) { const int c = g * 512 + lane + 64 * i; yn[(size_t)row * SSI + c] = v[i] * r * gn[c]; } }
}

struct In {
    const float *x_prompt, *x_sample, *cache_ckv, *cache_kpe, *state_ssm, *c, *c_ctx, *w_ada, *b_ada, *g_norm1, *g_norm2,
        *mla_w_dq, *mla_g_q, *mla_w_uq, *mla_w_dkv, *mla_g_kv, *mla_w_ukv, *mla_g_qn, *mla_g_kn, *mla_w_o,
        *cv_w_pw1, *cv_b_pw1, *cv_w_dw, *cv_b_dw, *cv_g_ln, *cv_b_ln, *cv_w_pw2, *cv_b_pw2,
        *ssd_w_in, *ssd_w_conv, *ssd_b_conv, *ssd_dt_bias, *ssd_a_log, *ssd_d, *ssd_g_norm, *ssd_w_out, *ffn_w_in, *ffn_w_out;
};

template <int GLU>
static void ngemm(hipStream_t s, const float* A, int lda, const float* B, int ldb, float* C, int ldc, int M, int N, int K, const float* bias) {
    nk_gemm<GLU><<<dim3((N + 63) / 64, M / 64), 256, 0, s>>>(A, lda, B, ldb, C, ldc, M, N, K, bias);
}

static void naive_forward(const In& I, float* out, float* ws, hipStream_t s, int start_sub) {
    size_t off = 0; auto take = [&](size_t n) { float* p = ws + off; off += (n + 255) & ~(size_t)255; return p; };
    float* mods = take(4 * 5 * 6144);
    float* h = take((size_t)T * DM);
    float* t2 = take((size_t)T * DM);
    float* latkv = take((size_t)T * 288);
    float* qn = take((size_t)T * QL);
    float* ckv = take((size_t)(T + NCTX) * KVL);
    float* dtb = take((size_t)T * 64);
    float* dtraw = take((size_t)T * 64);
    float* arena = ws + off;
    float* latq = arena; float* qraw = latq + (size_t)T * QL; float* kvraw = qraw + (size_t)T * 1536; float* Qb = kvraw + (size_t)(T + NCTX) * 2048; float* Kb = Qb + (size_t)T * 1536;
    float* t1 = arena;
    float* zb = arena; float* xpre = zb + (size_t)T * SSI; float* xbc = xpre + (size_t)T * SSCD; float* yb = xpre;
    float* x = out + OUT_YP;
    nk_adaln<<<dim3(24, 4), 256, 0, s>>>(I.c, I.c_ctx, I.w_ada, I.b_ada, mods);
    if (start_sub == 0) nk_copy_x<<<T * DM / 4 / 256, 256, 0, s>>>(I.x_prompt, I.x_sample, x);
    for (int i = start_sub / 2; i < 4; ++i) {
        const int kind = i % 3, j = i / 3; const float* ml = mods + (size_t)i * 5 * 6144;
        if (2 * i >= start_sub) {
        nk_normmod<<<T / 4, 256, 0, s>>>(x, I.g_norm1 + i * DM, ml, 0, 1024, h);
        if (kind == 0) {
            ngemm<0>(s, h, DM, I.mla_w_dq + (size_t)j * DM * QL, QL, latq, QL, T, QL, DM, nullptr);
            ngemm<0>(s, h, DM, I.mla_w_dkv + (size_t)j * DM * 288, 288, latkv, 288, T, 288, DM, nullptr);
            nk_mla_fin1<<<(T + NCTX) / 4, 256, 0, s>>>(latq, latkv, I.mla_g_q + j * QL, I.mla_g_kv + j * KVL, I.cache_ckv + (size_t)j * 65536, qn, ckv, out, j);
            ngemm<0>(s, qn, QL, I.mla_w_uq + (size_t)j * QL * 1536, 1536, qraw, 1536, T, 1536, QL, nullptr);
            ngemm<0>(s, ckv, KVL, I.mla_w_ukv + (size_t)j * KVL * 2048, 2048, kvraw, 2048, T + NCTX, 2048, KVL, nullptr);
            nk_mla_fin2<<<(T + NCTX) * 16 / 256, 256, 0, s>>>(qraw, kvraw, latkv, I.cache_kpe + (size_t)j * 8192, I.mla_g_qn + j * 96, I.mla_g_kn + j * 96, Qb, Kb);
            nk_attn<<<dim3(T / 64, 16), 64, 0, s>>>(Qb, Kb, kvraw, h);
            ngemm<0>(s, h, DM, I.mla_w_o + (size_t)j * DM * DM, DM, t2, DM, T, DM, DM, nullptr);
        } else if (kind == 1) {
            ngemm<2>(s, h, DM, I.cv_w_pw1, 2048, t1, DM, T, DM, DM, I.cv_b_pw1);
            nk_dwconv_ln<<<T / 4, 256, 0, s>>>(t1, I.cv_w_dw, I.cv_b_dw, I.cv_g_ln, I.cv_b_ln, h);
            ngemm<0>(s, h, DM, I.cv_w_pw2, DM, t2, DM, T, DM, DM, I.cv_b_pw2);
        } else {
            ngemm<0>(s, h, DM, I.ssd_w_in, SSIN, zb, SSI, T, SSI, DM, nullptr);
            ngemm<0>(s, h, DM, I.ssd_w_in + SSI, SSIN, xpre, SSCD, T, SSCD, DM, nullptr);
            ngemm<0>(s, h, DM, I.ssd_w_in + SSI + SSCD, SSIN, dtraw, 64, T, 64, DM, nullptr);
            nk_ssd_conv<<<T * 3136 / 256, 256, 0, s>>>(xpre, dtraw, I.ssd_w_conv, I.ssd_b_conv, I.ssd_dt_bias, xbc, dtb);
            nk_ssd_scan<<<dim3(32, 20), 64, 0, s>>>(xbc, dtb, I.ssd_a_log, I.ssd_d, I.state_ssm, yb, out, 0);
            nk_ssd_scan<<<dim3(32, 20), 64, 0, s>>>(xbc, dtb, I.ssd_a_log, I.ssd_d, I.state_ssm, yb, out, 1);
            nk_ssd_gate<<<T / 4, 256, 0, s>>>(yb, zb, I.ssd_g_norm, xbc);
            ngemm<0>(s, xbc, SSI, I.ssd_w_out, DM, t2, DM, T, DM, SSI, nullptr);
        }
        nk_resid<<<T * DM / 256, 256, 0, s>>>(x, t2, ml, 2048);
        }
        nk_normmod<<<T / 4, 256, 0, s>>>(x, I.g_norm2 + i * DM, ml, 3072, 4096, h);
        ngemm<1>(s, h, DM, I.ffn_w_in + (size_t)i * DM * 5632, 5632, t1, FFH, T, FFH, DM, nullptr);
        ngemm<0>(s, t1, FFH, I.ffn_w_out + (size_t)i * FFH * DM, DM, t2, DM, T, DM, FFH, nullptr);
        nk_resid<<<T * DM / 256, 256, 0, s>>>(x, t2, ml, 5120);
    }
}


__device__ __forceinline__ int olane() { int l; asm volatile("v_mbcnt_lo_u32_b32 %0, -1, 0\n\tv_mbcnt_hi_u32_b32 %0, -1, %0" : "=v"(l)); return l; }
__device__ __forceinline__ int obid() { int b = blockIdx.x; asm volatile("" : "+s"(b)); return b; }
namespace pg8 {
#define PG8_LAS __attribute__((address_space(3)))
typedef unsigned short bf16_t;
typedef short bf16x8 __attribute__((ext_vector_type(8)));
typedef float f32x4 __attribute__((ext_vector_type(4)));
typedef unsigned u32x4 __attribute__((ext_vector_type(4)));
constexpr int BM = 256, BK = 64, HALF = 128, HTB = HALF * BK * 2  , STAGE_BYTES = 8 * HTB, NXCD = 8, WGM = 8;

__host__ __device__ __forceinline__ int lds_byte(int r, int c) { const int st = (r >> 4) * 2 + (c >> 5), rr = r & 15, cc = c & 31, ob = rr * 64 + cc * 2; return st * 1024 + (ob ^ (((ob >> 9) & 1) << 5)); }
__host__ __device__ __forceinline__ void stage_rc(int b, int& R, int& C) { const int st = b / 1024, sb = b % 1024, swz = sb ^ (((sb >> 9) & 1) << 5); R = (st >> 1) * 16 + swz / 64; C = (st & 1) * 32 + (swz % 64) / 2; }
__host__ __device__ __forceinline__ int perm32(int rho) { const int n = rho >> 4, i = rho & 15; return 8 * (i >> 2) + 4 * n + (i & 3); }

struct Unit { int pm, pn; };
struct Gemm { const bf16_t* A; const bf16_t* Bt; int M, N, K; };

struct StaticOrder {
    int nM, nN, nwg, G, c;
    __host__ __device__ void init(int M, int N, int G_, int c_) { nM = M / BM; nN = N / BM; nwg = nM * nN; G = G_; c = c_; }
    __host__ __device__ bool next(int i, Unit& u) const {
        const long L = (long)i * G + c; if (L >= nwg) return false;
        int wgid = (int)L; { const int q = nwg / NXCD, r = nwg % NXCD, xcd = wgid % NXCD, off = wgid / NXCD; wgid = (xcd < r ? xcd * (q + 1) : r * (q + 1) + (xcd - r) * q) + off; }
        const int nig = WGM * nN, gid = wgid / nig, fm = gid * WGM, gsz = (nM - fm) < WGM ? (nM - fm) : WGM;
        u.pm = fm + ((wgid % nig) % gsz); u.pn = (wgid % nig) / gsz; return true;
    }
    __device__ __forceinline__ void a_ready(const Unit&) const {}
    __device__ __forceinline__ void done(const Unit&) const {}
};
__device__ __forceinline__ unsigned cvt_pk_bf16(float lo, float hi) { unsigned r; asm volatile("v_cvt_pk_bf16_f32 %0, %1, %2" : "=v"(r) : "v"(lo), "v"(hi)); return r; }
typedef unsigned u32x2 __attribute__((ext_vector_type(2)));
__device__ __forceinline__ float fast_sigmoid(float x) { return __builtin_amdgcn_rcpf(1.f + __builtin_amdgcn_exp2f(-1.4426950408889634f * x)); }

struct EpiF32 {
    static constexpr bool PERM = false, AFTER_DRAIN = false;
    float* C; int ldc;
    __device__ __forceinline__ void operator()(const f32x4 (&acc)[2][2][4][2], const Unit& u, int wr_, int wc_, int fr_, int fq_) const {
        const int t_ = olane(), wr = wr_, wc = wc_, fr = t_ & 15, fq = t_ >> 4; (void)fr_; (void)fq_;
        const int row0 = u.pm * BM + wr * 64 + fr, col0 = u.pn * BM + wc * 32 + 4 * fq;
#pragma unroll
        for (int ai = 0; ai < 2; ++ai)
#pragma unroll
            for (int m = 0; m < 4; ++m) { float* rowp = C + (size_t)(row0 + ai * HALF + m * 16) * ldc + col0;
#pragma unroll
                for (int bj = 0; bj < 2; ++bj)
#pragma unroll
                    for (int n = 0; n < 2; ++n) *(f32x4*)(rowp + bj * HALF + n * 16) = acc[ai][bj][m][n]; }
    }
};
struct EpiBf16P {
    static constexpr bool PERM = true, AFTER_DRAIN = false;
    bf16_t* O; int ldc;
    __device__ __forceinline__ void operator()(const f32x4 (&acc)[2][2][4][2], const Unit& u, int wr_, int wc_, int fr_, int fq_) const {
        const int t_ = olane(), wr = wr_, wc = wc_, fr = t_ & 15, fq = t_ >> 4; (void)fr_; (void)fq_;
        const int row0 = u.pm * BM + wr * 64 + fr, col0 = u.pn * BM + wc * 32 + 8 * fq;
#pragma unroll
        for (int ai = 0; ai < 2; ++ai)
#pragma unroll
            for (int m = 0; m < 4; ++m) { bf16_t* rowp = O + (size_t)(row0 + ai * HALF + m * 16) * ldc + col0;
#pragma unroll
                for (int bj = 0; bj < 2; ++bj) { const f32x4 v0 = acc[ai][bj][m][0], v1 = acc[ai][bj][m][1]; u32x4 w;
                    w.x = cvt_pk_bf16(v0[0], v0[1]); w.y = cvt_pk_bf16(v0[2], v0[3]); w.z = cvt_pk_bf16(v1[0], v1[1]); w.w = cvt_pk_bf16(v1[2], v1[3]);
                    *(u32x4*)(rowp + bj * HALF) = w; } }
    }
};
struct EpiSsdIn {
    static constexpr bool PERM = true, AFTER_DRAIN = false;
    bf16_t* Z; bf16_t* XP; float* DT;
    __device__ __forceinline__ void operator()(const f32x4 (&acc)[2][2][4][2], const Unit& u, int wr_, int wc_, int fr_, int fq_) const {
        const int t_ = olane(), wr = wr_, wc = wc_, fr = t_ & 15, fq = t_ >> 4; (void)fr_; (void)fq_;
        const int row0 = u.pm * BM + wr * 64 + fr;
        if (u.pn < 20) {
            bf16_t* base = u.pn < 8 ? Z : XP; const int ld = u.pn < 8 ? 2048 : 3072, colt = (u.pn < 8 ? u.pn : u.pn - 8) * BM, col0 = colt + wc * 32 + 8 * fq;
#pragma unroll
            for (int ai = 0; ai < 2; ++ai)
#pragma unroll
                for (int m = 0; m < 4; ++m) { bf16_t* rowp = base + (size_t)(row0 + ai * HALF + m * 16) * ld + col0;
#pragma unroll
                    for (int bj = 0; bj < 2; ++bj) { const f32x4 v0 = acc[ai][bj][m][0], v1 = acc[ai][bj][m][1]; u32x4 w;
                        w.x = cvt_pk_bf16(v0[0], v0[1]); w.y = cvt_pk_bf16(v0[2], v0[3]); w.z = cvt_pk_bf16(v1[0], v1[1]); w.w = cvt_pk_bf16(v1[2], v1[3]);
                        *(u32x4*)(rowp + bj * HALF) = w; } }
        } else if (wc < 2) {
#pragma unroll
            for (int ai = 0; ai < 2; ++ai)
#pragma unroll
                for (int m = 0; m < 4; ++m) { float* rp = DT + (size_t)(row0 + ai * HALF + m * 16) * 64 + wc * 32 + 8 * fq;
                    *(f32x4*)rp = acc[ai][0][m][0]; *(f32x4*)(rp + 4) = acc[ai][0][m][1]; }
        }
    }
};
template <int MODE> struct EpiGlu {
    static constexpr bool PERM = false, AFTER_DRAIN = false;
    bf16_t* O; int ldo; const float* bias; int H;
    __device__ __forceinline__ void operator()(const f32x4 (&acc)[2][2][4][2], const Unit& u, int wr_, int wc_, int fr_, int fq_) const {
        const int t_ = olane(), wr = wr_, wc = wc_, fr = t_ & 15, fq = t_ >> 4; (void)fr_; (void)fq_;
        const int row0 = u.pm * BM + wr * 64 + fr;
#pragma unroll
        for (int bj = 0; bj < 2; ++bj) {
            const int f0 = 16 * (8 * u.pn + 4 * bj + wc) + 4 * fq;
            f32x4 ba = (f32x4){0.f, 0.f, 0.f, 0.f}, bu = ba;
            if (MODE == 1) { ba = *(const f32x4*)(bias + f0); bu = *(const f32x4*)(bias + H + f0); }
#pragma unroll
            for (int ai = 0; ai < 2; ++ai)
#pragma unroll
                for (int m = 0; m < 4; ++m) { const f32x4 a = acc[ai][bj][m][0] + ba, g = acc[ai][bj][m][1] + bu; float o[4];
#pragma unroll
                    for (int j = 0; j < 4; ++j) o[j] = MODE == 0 ? a[j] * fast_sigmoid(a[j]) * g[j] : a[j] * fast_sigmoid(g[j]);
                    u32x2 w; w.x = cvt_pk_bf16(o[0], o[1]); w.y = cvt_pk_bf16(o[2], o[3]);
                    *(u32x2*)(O + (size_t)(row0 + ai * HALF + m * 16) * ldo + f0) = w; }
        }
    }
};
struct EpiResid {
    static constexpr bool PERM = false, AFTER_DRAIN = false;
    const float* xlo; const float* xhi; float* xout; const float* mods_l; int g_off; const float* bias;
    __device__ __forceinline__ void operator()(const f32x4 (&acc)[2][2][4][2], const Unit& u, int wr_, int wc_, int fr_, int fq_) const {
        const int t_ = olane(), wr = wr_, wc = wc_, fr = t_ & 15, fq = t_ >> 4; (void)fr_; (void)fq_;
        const int cond = u.pm < 16 ? 0 : 1 + ((u.pm - 16) >> 2);
        const float* gate = mods_l + (size_t)cond * 6144 + g_off; const float* xin = u.pm < 16 ? xlo : xhi;
        const int row0 = u.pm * BM + wr * 64 + fr, col0 = u.pn * BM + wc * 32 + 4 * fq;
#pragma unroll
        for (int bj = 0; bj < 2; ++bj)
#pragma unroll
            for (int n = 0; n < 2; ++n) { const int c = col0 + bj * HALF + n * 16; const f32x4 g4 = *(const f32x4*)(gate + c);
                const f32x4 b4 = bias ? *(const f32x4*)(bias + c) : (f32x4){0.f, 0.f, 0.f, 0.f};
#pragma unroll
                for (int ai = 0; ai < 2; ++ai)
#pragma unroll
                    for (int m = 0; m < 4; ++m) { const size_t off = (size_t)(row0 + ai * HALF + m * 16) * 1024 + c;
                        const f32x4 xo = *(const f32x4*)(xin + off); *(f32x4*)(xout + off) = xo + g4 * (acc[ai][bj][m][n] + b4); } }
    }
};

template <class Epi, class Sched, bool ALIGN_EPI = false, bool SP2 = false>
__device__ __forceinline__ void gemm_phase(PG8_LAS unsigned char* lds, const Gemm g, const Sched& S, const Epi& E, const int wave_in) {
    const int tid = wave_in * 64 + olane(), wid = __builtin_amdgcn_readfirstlane(tid >> 6), lane = tid & 63, wr = wid >> 2, wc = wid & 3, fr = lane & 15, fq = lane >> 4;
    const int K = g.K, nt = K / BK;
    unsigned voffA[2], voffB[2];
#pragma unroll
    for (int i = 0; i < 2; ++i) { int R, C; stage_rc(tid * 16 + i * 8192, R, C); const int Rb = Epi::PERM ? ((R & ~31) + perm32(R & 31)) : R;
        voffA[i] = (unsigned)(R * K + C) * 2u; voffB[i] = (unsigned)(Rb * K + C) * 2u; }
    const size_t kstep = (size_t)(BK * 2);
    const size_t hstep = (size_t)HALF * K * 2;
    const size_t tstep = 2 * hstep;
    const unsigned ldsw = (unsigned)wid * 1024u;
    const int aoff = lds_byte(wr * 64 + fr, fq * 8), boff = lds_byte(wc * 32 + fr, fq * 8);
#define PG8_SA(b, h) (((b) * 2 + (h)) * HTB)
#define PG8_SB(b, h) ((4 + (b) * 2 + (h)) * HTB)
#define PG8_STAGE(bufoff, gbase, voff) do { _Pragma("unroll") for (int _i = 0; _i < 2; ++_i) \
        __builtin_amdgcn_global_load_lds((const unsigned*)((const char*)(gbase) + (voff)[_i]), (PG8_LAS unsigned*)(lds + (bufoff) + ldsw + _i * 8192), 16, 0, 0); } while (0)
#define PG8_LDA(dst, b, h) do { _Pragma("unroll") for (int m = 0; m < 4; ++m) _Pragma("unroll") for (int k = 0; k < 2; ++k) dst[m][k] = *(const PG8_LAS bf16x8*)(lds + PG8_SA(b, h) + aoff + m * 2048 + k * 1024); } while (0)
#define PG8_LDB(dst, b, h) do { _Pragma("unroll") for (int n = 0; n < 2; ++n) _Pragma("unroll") for (int k = 0; k < 2; ++k) dst[n][k] = *(const PG8_LAS bf16x8*)(lds + PG8_SB(b, h) + boff + n * 2048 + k * 1024); } while (0)
#define PG8_MMA(ai, bj, At, Bt) do { __builtin_amdgcn_s_setprio(1); _Pragma("unroll") for (int m = 0; m < 4; ++m) _Pragma("unroll") for (int n = 0; n < 2; ++n) _Pragma("unroll") for (int k = 0; k < 2; ++k) \
        acc[ai][bj][m][n] = __builtin_amdgcn_mfma_f32_16x16x32_bf16(Bt[n][k], At[m][k], acc[ai][bj][m][n], 0, 0, 0); __builtin_amdgcn_s_setprio(0); } while (0)
#define PG8_WAIT_V(n) asm volatile("s_waitcnt vmcnt(" #n ")" ::: "memory")
#define PG8_WAIT_L(n) asm volatile("s_waitcnt lgkmcnt(" #n ")" ::: "memory")
#define PG8_BAR __builtin_amdgcn_s_barrier()
#define PG8_SCHED __builtin_amdgcn_sched_barrier(0)
    Unit cur, nxt; int ui = 0;
    if (!S.next(0, cur)) return;
    f32x4 acc[2][2][4][2];
#pragma unroll
    for (int a = 0; a < 2; ++a)
#pragma unroll
        for (int b = 0; b < 2; ++b)
#pragma unroll
            for (int m = 0; m < 4; ++m)
#pragma unroll
                for (int n = 0; n < 2; ++n) acc[a][b][m][n] = (f32x4){0.f, 0.f, 0.f, 0.f};
    bf16x8 At[4][2], B0[2][2], B1[2][2];
    const char* cA = (const char*)g.A + (size_t)cur.pm * tstep; const char* cB = (const char*)g.Bt + (size_t)cur.pn * tstep;
    S.a_ready(cur);
    if constexpr (SP2) {
        PG8_STAGE(PG8_SB(0, 0), cB, voffB); PG8_STAGE(PG8_SB(0, 1), cB + hstep, voffB); PG8_STAGE(PG8_SA(0, 0), cA, voffA); PG8_STAGE(PG8_SA(0, 1), cA + hstep, voffA);
        if (wr == 1) PG8_BAR;
        PG8_WAIT_V(2); PG8_BAR;
        PG8_STAGE(PG8_SB(1, 0), cB + kstep, voffB); PG8_STAGE(PG8_SA(1, 0), cA + kstep, voffA); PG8_STAGE(PG8_SB(1, 1), cB + hstep + kstep, voffB);
        PG8_WAIT_V(6); PG8_BAR;
    } else {
        PG8_STAGE(PG8_SB(0, 0), cB, voffB); PG8_STAGE(PG8_SA(0, 0), cA, voffA); PG8_STAGE(PG8_SB(0, 1), cB + hstep, voffB); PG8_STAGE(PG8_SA(0, 1), cA + hstep, voffA);
        if (wr == 1) PG8_BAR;
        PG8_WAIT_V(4); PG8_BAR;
        PG8_STAGE(PG8_SB(1, 0), cB + kstep, voffB); PG8_STAGE(PG8_SA(1, 0), cA + kstep, voffA); PG8_STAGE(PG8_SB(1, 1), cB + hstep + kstep, voffB);
        PG8_WAIT_V(6); PG8_BAR;
    }
    for (;;) {
        const bool has_next = S.next(ui + 1, nxt);
        const char* nA = has_next ? (const char*)g.A + (size_t)nxt.pm * tstep : cA; const char* nB = has_next ? (const char*)g.Bt + (size_t)nxt.pn * tstep : cB;
        for (int t = 0; t < nt; t += 2) {
            const bool last = (t == nt - 2);
            const char* a1 = cA + (size_t)(t + 1) * kstep;
            const char* a2 = last ? nA : cA + (size_t)(t + 2) * kstep; const char* b2 = last ? nB : cB + (size_t)(t + 2) * kstep;
            const char* a3 = a2 + kstep; const char* b3 = b2 + kstep;
            if (last && has_next) S.a_ready(nxt);
            if constexpr (SP2) {
            PG8_LDB(B0, 0, 0); PG8_LDB(B1, 0, 1); PG8_SCHED; PG8_LDA(At, 0, 0); PG8_STAGE(PG8_SA(1, 1), a1 + hstep, voffA);
            PG8_WAIT_V(8); PG8_WAIT_L(0); PG8_BAR; PG8_MMA(0, 0, At, B0); PG8_MMA(0, 1, At, B1); PG8_BAR; PG8_SCHED;
            PG8_LDA(At, 0, 1); PG8_STAGE(PG8_SB(0, 0), b2, voffB); PG8_STAGE(PG8_SB(0, 1), b2 + hstep, voffB); PG8_STAGE(PG8_SA(0, 0), a2, voffA);
            PG8_WAIT_V(8); PG8_WAIT_L(0); PG8_BAR; PG8_MMA(1, 0, At, B0); PG8_MMA(1, 1, At, B1); PG8_BAR; PG8_SCHED;
            PG8_LDB(B0, 1, 0); PG8_LDB(B1, 1, 1); PG8_SCHED; PG8_LDA(At, 1, 0); PG8_STAGE(PG8_SA(0, 1), a2 + hstep, voffA);
            PG8_WAIT_V(8); PG8_WAIT_L(0); PG8_BAR; PG8_MMA(0, 0, At, B0); PG8_MMA(0, 1, At, B1); PG8_BAR; PG8_SCHED;
            PG8_LDA(At, 1, 1); PG8_STAGE(PG8_SB(1, 0), b3, voffB); PG8_STAGE(PG8_SB(1, 1), b3 + hstep, voffB); PG8_STAGE(PG8_SA(1, 0), a3, voffA);
            PG8_WAIT_V(8); PG8_WAIT_L(0); PG8_BAR; PG8_MMA(1, 0, At, B0); PG8_MMA(1, 1, At, B1); PG8_BAR; PG8_SCHED;
            } else {
            PG8_LDB(B0, 0, 0); PG8_SCHED; PG8_LDA(At, 0, 0); PG8_STAGE(PG8_SA(1, 1), a1 + hstep, voffA);
            PG8_WAIT_L(8); PG8_BAR; PG8_WAIT_L(0); PG8_MMA(0, 0, At, B0); PG8_BAR; PG8_SCHED;
            PG8_LDB(B1, 0, 1); PG8_STAGE(PG8_SB(0, 0), b2, voffB);
            PG8_BAR; PG8_WAIT_L(0); PG8_MMA(0, 1, At, B1); PG8_BAR;
            PG8_LDA(At, 0, 1); PG8_STAGE(PG8_SA(0, 0), a2, voffA);
            PG8_BAR; PG8_WAIT_L(0); PG8_MMA(1, 0, At, B0); PG8_BAR; PG8_SCHED;
            PG8_STAGE(PG8_SB(0, 1), b2 + hstep, voffB);
            PG8_WAIT_V(6); PG8_BAR; PG8_MMA(1, 1, At, B1); PG8_BAR;
            PG8_LDB(B0, 1, 0); PG8_SCHED; PG8_LDA(At, 1, 0); PG8_STAGE(PG8_SA(0, 1), a2 + hstep, voffA);
            PG8_WAIT_L(8); PG8_BAR; PG8_WAIT_L(0); PG8_MMA(0, 0, At, B0); PG8_BAR; PG8_SCHED;
            PG8_LDB(B1, 1, 1); PG8_STAGE(PG8_SB(1, 0), b3, voffB);
            PG8_BAR; PG8_WAIT_L(0); PG8_MMA(0, 1, At, B1); PG8_BAR;
            PG8_LDA(At, 1, 1); PG8_STAGE(PG8_SA(1, 0), a3, voffA);
            PG8_BAR; PG8_WAIT_L(0); PG8_MMA(1, 0, At, B0); PG8_BAR; PG8_SCHED;
            PG8_STAGE(PG8_SB(1, 1), b3 + hstep, voffB);
            PG8_WAIT_V(6); PG8_BAR; PG8_MMA(1, 1, At, B1); PG8_BAR;
            }
        }
        if constexpr (ALIGN_EPI) { if (wr == 0) PG8_BAR; }
        if constexpr (!Epi::AFTER_DRAIN) { E(acc, cur, wr, wc, fr, fq); S.done(cur); }
        if (!has_next) break;
#pragma unroll
        for (int a = 0; a < 2; ++a)
#pragma unroll
            for (int b = 0; b < 2; ++b)
#pragma unroll
                for (int m = 0; m < 4; ++m)
#pragma unroll
                    for (int n = 0; n < 2; ++n) acc[a][b][m][n] = (f32x4){0.f, 0.f, 0.f, 0.f};
        cur = nxt; cA = nA; cB = nB; ++ui;
        if constexpr (ALIGN_EPI) { if (wr == 1) PG8_BAR; }
    }
    PG8_WAIT_V(0);
    if constexpr (!ALIGN_EPI) { if (wr == 0) PG8_BAR; }
    PG8_BAR;
    if constexpr (Epi::AFTER_DRAIN) { E.fused(acc, cur, wr, wc, fr, fq, lds, wid, lane); S.done(cur); }
#undef PG8_SA
#undef PG8_SB
#undef PG8_STAGE
#undef PG8_LDA
#undef PG8_LDB
#undef PG8_MMA
#undef PG8_WAIT_V
#undef PG8_WAIT_L
#undef PG8_BAR
#undef PG8_SCHED
}
}
constexpr int NWAVES = 8, NTHR = 512;
constexpr size_t MiB = 1u << 20;
constexpr size_t WS_CTL = 0, CTL_ZERO_BYTES = 1 * MiB;
constexpr size_t WS_MODS = 256 * 1024;
constexpr size_t WS_ROPE = 1 * MiB;
constexpr size_t WS_W = 2 * MiB;
constexpr size_t W_MLA = WS_W, MLA_WB = 5898240;
constexpr size_t MW_CAT = 0, MW_UQ = 1572864, MW_UKV = 2752512, MW_O = 3801088;
constexpr size_t W_CV1 = WS_W + 2 * MLA_WB, W_CV2 = W_CV1 + 4 * MiB;
constexpr size_t W_SSI = W_CV2 + 2 * MiB, W_SSO = W_SSI + 11010048;
constexpr size_t W_FF = W_SSO + 4 * MiB, FF_WB = 17301504, FW_IN = 0, FW_OUT = 11534336;
static_assert(W_FF + 4 * FF_WB <= 102 * MiB, "weights region");
constexpr size_t WS_H = 102 * MiB;
constexpr size_t WS_CKV = 118 * MiB, CKV_B = (size_t)(T + NCTX) * KVL * 2;
constexpr size_t WS_AR = 128 * MiB;
constexpr size_t A_LAT = WS_AR, A_QN = A_LAT + 24 * MiB, A_QRAW = A_QN + 6 * MiB, A_KVRAW = A_QRAW + 24 * MiB, A_QB = A_KVRAW + 36 * MiB, A_KB = A_QB + 24 * MiB, A_AO = A_KB + 27 * MiB;
constexpr size_t A_U = WS_AR, A_V = A_U + 16 * MiB;
constexpr size_t A_Z = WS_AR, A_XPRE = A_Z + 32 * MiB, A_DTRAW = A_XPRE + 48 * MiB, A_XBC = A_DTRAW + 2 * MiB, A_DT = A_XBC + 48 * MiB, A_Y = A_DT + 2 * MiB, A_YN = A_XPRE;
constexpr size_t A_ACT = WS_AR + 200 * MiB;
static_assert(A_AO + 16 * MiB <= A_ACT && A_Y + 64 * MiB <= A_ACT && A_ACT + 44 * MiB <= 384 * MiB, "arena map");
constexpr int CW_BAR = 4096;
constexpr int LDS_BYTES = 163840, RING_BYTES = 131072, MISC_OFF = 163840 - 256;

#define GAS __attribute__((address_space(1)))
#define LAS __attribute__((address_space(3)))
typedef unsigned short bf16;
typedef unsigned v4u __attribute__((ext_vector_type(4)));
typedef unsigned v2u __attribute__((ext_vector_type(2)));
typedef float v4f __attribute__((ext_vector_type(4)));
typedef float v2f __attribute__((ext_vector_type(2)));
typedef GAS unsigned gu32;
#define LDS_WAIT() asm volatile("s_waitcnt lgkmcnt(0)" ::: "memory")
#define VM_WAIT() asm volatile("s_waitcnt vmcnt(0)" ::: "memory")
__device__ __forceinline__ unsigned f2bf(float f) { unsigned u = __builtin_bit_cast(unsigned, f); return (u + 0x7fffu + ((u >> 16) & 1u)) >> 16; }
__device__ __forceinline__ unsigned pk2(float lo, float hi) { return f2bf(lo) | (f2bf(hi) << 16); }
__device__ __forceinline__ float bflo(unsigned u) { return __builtin_bit_cast(float, u << 16); }
__device__ __forceinline__ float bfhi(unsigned u) { return __builtin_bit_cast(float, u & 0xffff0000u); }
__device__ __forceinline__ float bf2f(bf16 b) { return __builtin_bit_cast(float, (unsigned)b << 16); }

#define XB_TMO      128
#define XB_XCNT(j)  (256  + 64 * (j))
#define XB_XSUB(j)  (1280 + 64 * (j))
#define XB_XGEN(j)  (2304 + 64 * (j))
#define XB_TOP      3328
#define XB_TOPGEN   3392
#define XCD_BAR_WORDS 3456
#define XB_SPIN_CAP (1u << 18)

__device__ __forceinline__ unsigned xb_ld(unsigned* p)              { return __hip_atomic_load(p, __ATOMIC_RELAXED, __HIP_MEMORY_SCOPE_AGENT); }
__device__ __forceinline__ unsigned xb_add(unsigned* p, unsigned v) { return __hip_atomic_fetch_add(p, v, __ATOMIC_RELAXED, __HIP_MEMORY_SCOPE_AGENT); }
__device__ __forceinline__ unsigned xb_xcc_id() { return (unsigned)__builtin_amdgcn_s_getreg((3 << 11) | 20) & 0xFu; }
#define XB_SPIN(cond, bar) do { unsigned _sp = 0; while (cond) { __builtin_amdgcn_s_sleep(1); \
    if ((++_sp & 255u) == 0u) { if (xb_ld(&(bar)[XB_TMO])) break; if (_sp > XB_SPIN_CAP) { atomicAdd(&(bar)[XB_TMO], 1u); break; } } } } while (0)

struct XcdBarrier {
    unsigned* bar; unsigned x;
    volatile LAS unsigned* st;
};

__device__ __forceinline__ XcdBarrier xcd_barrier_post(unsigned* bar, volatile LAS unsigned* st) {
    XcdBarrier b; b.bar = bar; b.x = xb_xcc_id(); b.st = st;
    if (threadIdx.x == 0) (void)xb_add(&bar[XB_XCNT(b.x)], 1u);
    return b;
}
__device__ __forceinline__ void xcd_barrier_complete(unsigned* bar, unsigned x, unsigned& nloc, unsigned& nx) {
    const unsigned G = gridDim.x * gridDim.y * gridDim.z;
    unsigned sum, cnt, mine, sp = 0u;
    for (;;) {
        sum = 0u; cnt = 0u; mine = 0u;
#pragma unroll
        for (unsigned j = 0; j < 16; ++j) { const unsigned c = xb_ld(&bar[XB_XCNT(j)]); sum += c; cnt += (c > 0u) ? 1u : 0u; mine = (j == x) ? c : mine; }
        if (sum == G) break;
        __builtin_amdgcn_s_sleep(1);
        if ((++sp & 255u) == 0u) { if (xb_ld(&bar[XB_TMO])) break; if (sp > XB_SPIN_CAP) { atomicAdd(&bar[XB_TMO], 1u); break; } }
    }
    nloc = mine > 0u ? mine : 1u; nx = cnt > 0u ? cnt : 1u;
}

__device__ __forceinline__ void xcd_barrier(const XcdBarrier& b) {
    asm volatile("s_waitcnt vmcnt(0)" ::: "memory");
    __syncthreads();
    if (threadIdx.x == 0) {
        unsigned* bar = b.bar;
        __builtin_amdgcn_s_waitcnt(0);
        unsigned nloc = b.st[0], nx = b.st[1];
        if (nloc == 0u) { xcd_barrier_complete(bar, b.x, nloc, nx); b.st[0] = nloc; b.st[1] = nx; }
        const unsigned old = xb_add(&bar[XB_XSUB(b.x)], 1u);
        const unsigned gen = old / nloc;
        if (old + 1u == (gen + 1u) * nloc) {
            __builtin_amdgcn_fence(__ATOMIC_RELEASE, "agent");
            asm volatile("s_waitcnt vmcnt(0)" ::: "memory");
            const unsigned og = xb_add(&bar[XB_TOP], 1u);
            const unsigned tg = og / nx;
            if (og + 1u == (tg + 1u) * nx) xb_add(&bar[XB_TOPGEN], 1u);
            else XB_SPIN(xb_ld(&bar[XB_TOPGEN]) == tg, bar);
            __builtin_amdgcn_fence(__ATOMIC_ACQUIRE, "agent");
            xb_add(&bar[XB_XGEN(b.x)], 1u);
            asm volatile("s_waitcnt vmcnt(0)" ::: "memory");
        } else {
            XB_SPIN(xb_ld(&bar[XB_XGEN(b.x)]) == gen, bar);
            __builtin_amdgcn_fence(__ATOMIC_ACQUIRE, "agent");
            asm volatile("s_waitcnt vmcnt(0)" ::: "memory");
        }
    }
    __syncthreads();
}

struct Frame {
    LAS unsigned char* lds; int tid, lane, wave, vcu, G, gw, NGW, bx;
    volatile LAS unsigned* PT;
};
constexpr int PT_OUT = 38, PT_WS = 39;
__device__ __forceinline__ const float* ldp(volatile LAS unsigned* PT, int k) {
    const unsigned lo = __builtin_amdgcn_readfirstlane(PT[2 * k]), hi = __builtin_amdgcn_readfirstlane(PT[2 * k + 1]);
    return (const float*)(((unsigned long long)hi << 32) | lo);
}
#define INP(k) ldp(F.PT, (k))
#define WSP ((unsigned char*)ldp(F.PT, PT_WS))
#define OUTP ((float*)ldp(F.PT, PT_OUT))
enum InIdx { I_XP = 0, I_XS, I_CCKV, I_CKPE, I_SSM, I_C, I_CCTX, I_WADA, I_BADA, I_GN1, I_GN2, I_WDQ, I_GQ, I_WUQ, I_WDKV, I_GKV, I_WUKV, I_GQN, I_GKN, I_WO,
             I_CVW1, I_CVB1, I_CVWD, I_CVBD, I_CVGL, I_CVBL, I_CVW2, I_CVB2, I_SSWI, I_SSWC, I_SSBC, I_SSDTB, I_SSAL, I_SSD, I_SSGN, I_SSWO, I_FFWI, I_FFWO };
__device__ __forceinline__ float shx(float v, int lane, int o) { return __builtin_bit_cast(float, __builtin_amdgcn_ds_bpermute((lane ^ o) << 2, __builtin_bit_cast(int, v))); }
__device__ __forceinline__ float wsum(float v, int lane) {
#pragma unroll
    for (int o = 1; o < 64; o <<= 1) v += shx(v, lane, o);
    return v;
}
constexpr float QSCALE = 0.10206207261596577f * 1.4426950408889634f;

__device__ __forceinline__ void p0_transpose_item(const float* W, int K, int N, bf16* WT, int mode, int H, int row_off, LAS float* scr, int item, int lane) {
    const int nblk = N / 32, kb = item / nblk, nb = item % nblk, k0 = 64 * kb, n0 = 32 * nb;
#pragma unroll 8
    for (int i = 0; i < 32; ++i) { const int kk = 2 * i + (lane >> 5); scr[kk * 33 + (lane & 31)] = W[(size_t)(k0 + kk) * N + n0 + (lane & 31)]; }
    LDS_WAIT(); asm volatile("" ::: "memory");
    const int c = lane & 7;
#pragma unroll
    for (int j = 0; j < 4; ++j) { const int n = (lane >> 3) + 8 * j, col = n0 + n; const LAS float* s = scr + (8 * c) * 33 + n;
        int drow;
        if (mode == 0) drow = row_off + col;
        else { const int f = col < H ? col : col - H; drow = 32 * (f >> 4) + (f & 15) + (col < H ? 0 : 16); }
        v4u o; o.x = pk2(s[0 * 33], s[1 * 33]); o.y = pk2(s[2 * 33], s[3 * 33]); o.z = pk2(s[4 * 33], s[5 * 33]); o.w = pk2(s[6 * 33], s[7 * 33]);
        *(GAS v4u*)(WT + (size_t)drow * K + k0 + 8 * c) = o; }
    LDS_WAIT(); asm volatile("" ::: "memory");
}
__device__ __forceinline__ void p0_job(int q, int& inp, size_t& soff, int& K, int& N, size_t& doff, int& mode, int& H, int& roff) {
    mode = 0; H = 0; roff = 0; soff = 0;
    if (q < 10) { const int j = q / 5, t = q % 5; const size_t wb = W_MLA + (size_t)j * MLA_WB;
        if (t == 0) { inp = I_WDQ; soff = (size_t)j * 1024 * 384; K = 1024; N = 384; doff = wb + MW_CAT; }
        else if (t == 1) { inp = I_WDKV; soff = (size_t)j * 1024 * 288; K = 1024; N = 288; doff = wb + MW_CAT; roff = 384; }
        else if (t == 2) { inp = I_WUQ; soff = (size_t)j * 384 * 1536; K = 384; N = 1536; doff = wb + MW_UQ; }
        else if (t == 3) { inp = I_WUKV; soff = (size_t)j * 256 * 2048; K = 256; N = 2048; doff = wb + MW_UKV; }
        else { inp = I_WO; soff = (size_t)j * 1024 * 1024; K = 1024; N = 1024; doff = wb + MW_O; } }
    else if (q == 10) { inp = I_CVW1; K = 1024; N = 2048; doff = W_CV1; mode = 1; H = 1024; }
    else if (q == 11) { inp = I_CVW2; K = 1024; N = 1024; doff = W_CV2; }
    else if (q == 12) { inp = I_SSWI; K = 1024; N = 5184; doff = W_SSI; }
    else if (q == 13) { inp = I_SSWO; K = 2048; N = 1024; doff = W_SSO; }
    else { const int l = (q - 14) >> 1, t = (q - 14) & 1;
        if (t == 0) { inp = I_FFWI; soff = (size_t)l * 1024 * 5632; K = 1024; N = 5632; doff = W_FF + (size_t)l * FF_WB + FW_IN; mode = 1; H = 2816; }
        else { inp = I_FFWO; soff = (size_t)l * 2816 * 1024; K = 2816; N = 1024; doff = W_FF + (size_t)l * FF_WB + FW_OUT; } }
}
constexpr int P0_NITEMS = 2 * ((1024 / 64) * (384 / 32) + (1024 / 64) * (288 / 32) + (384 / 64) * (1536 / 32) + (256 / 64) * (2048 / 32) + (1024 / 64) * (1024 / 32))
                        + (1024 / 64) * (2048 / 32) + (1024 / 64) * (1024 / 32) + (1024 / 64) * (5184 / 32) + (2048 / 64) * (1024 / 32)
                        + 4 * ((1024 / 64) * (5632 / 32) + (2816 / 64) * (1024 / 32));
__device__ __forceinline__ void p0_prologue(Frame& F) {
    unsigned char* ws = WSP;
    LAS float* s = (LAS float*)F.lds;
    for (int i = F.tid; i < 5 * 1024; i += NTHR) { const int cc = i >> 10, k = i & 1023; const float v = cc == 0 ? INP(I_CCTX)[k] : INP(I_C)[(cc - 1) * 1024 + k]; s[i] = v / (1.f + expf(-v)); }
    __syncthreads();
    float* mods = (float*)(ws + WS_MODS);
    for (int it = F.bx; it < 768; it += F.G) {
        const int l = it / 192, r = it % 192, cb = r / 16, ks = r % 16, n = cb * 512 + F.tid;
        const float* W = INP(I_WADA) + (size_t)l * 1024 * 6144 + (size_t)(ks * 64) * 6144 + n;
        float acc[5] = {0.f, 0.f, 0.f, 0.f, 0.f};
#pragma unroll 16
        for (int k = 0; k < 64; ++k) { const float wv = W[(size_t)k * 6144];
#pragma unroll
            for (int cc = 0; cc < 5; ++cc) acc[cc] += s[cc * 1024 + ks * 64 + k] * wv; }
        const float bb = ks == 0 ? INP(I_BADA)[l * 6144 + n] : 0.f;
#pragma unroll
        for (int cc = 0; cc < 5; ++cc) atomicAdd(&mods[((size_t)l * 5 + cc) * 6144 + n], acc[cc] + bb);
    }
    __syncthreads();
    LAS float* scr = (LAS float*)(F.lds + F.wave * 8448);
    for (int it = F.gw; it < P0_NITEMS; it += F.NGW) {
        int r = it, inp = 0, K = 64, N = 32, mode = 0, H = 0, roff = 0; size_t soff = 0, doff = 0;
#pragma unroll 1
        for (int q = 0; q < 22; ++q) { p0_job(q, inp, soff, K, N, doff, mode, H, roff); const int ni = (K / 64) * (N / 32); if (r < ni) break; r -= ni; }
        p0_transpose_item(INP(inp) + soff, K, N, (bf16*)(ws + doff), mode, H, roff, scr, r, F.lane);
    }
    for (int it = F.gw; it < 384; it += F.NGW) {
        bf16* rowp = it < 192 ? (bf16*)(ws + W_MLA + (it / 96) * MLA_WB + MW_CAT) + (size_t)(672 + it % 96) * 1024 : (bf16*)(ws + W_SSI) + (size_t)(5184 + it - 192) * 1024;
        const v4u z = {0u, 0u, 0u, 0u}; ((GAS v4u*)rowp)[F.lane] = z; ((GAS v4u*)rowp)[64 + F.lane] = z;
    }
    for (int it = F.gw; it < 2048; it += F.NGW) {
        const int j = it >> 10, rr = it & 1023, b = rr >> 8, sq = rr & 255;
        const v4f v = ((const GAS v4f*)(INP(I_CCKV) + (((size_t)b * 2 + j) * 256 + sq) * 256))[F.lane];
        v2u o; o.x = pk2(v.x, v.y); o.y = pk2(v.z, v.w);
        ((GAS v2u*)((bf16*)(ws + WS_CKV + j * CKV_B) + (size_t)(T + rr) * 256))[F.lane] = o;
    }
    if (F.bx == 0) for (int i = F.tid; i < 640; i += NTHR) { const int pos = i >> 3, fi = i & 7; const float p = (float)(pos < 16 ? pos : pos - 16);
        const float a = p * rope_inv(fi); float* tab = (float*)(ws + WS_ROPE); tab[2 * i] = cosf(a); tab[2 * i + 1] = sinf(a); }
}

__device__ __forceinline__ void rp_normmod(Frame& F, const float* xlo, const float* xhi, const float* g, const float* mods_l, int sh_off, int sc_off, bf16* h) {
    for (int row = F.gw; row < T; row += F.NGW) {
        const GAS v4f* xr = (const GAS v4f*)((row < TP ? xlo : xhi) + (size_t)row * 1024) + F.lane;
        v4f v[4]; float ss = 0.f;
#pragma unroll
        for (int j = 0; j < 4; ++j) { v[j] = xr[64 * j]; ss += (v[j].x * v[j].x + v[j].y * v[j].y) + (v[j].z * v[j].z + v[j].w * v[j].w); }
        const float r = rsqrtf(wsum(ss, F.lane) * (1.f / 1024) + EPS);
        const float* m = mods_l + (size_t)cond_of_row(row) * 6144;
#pragma unroll
        for (int j = 0; j < 4; ++j) { const int c = 4 * F.lane + 256 * j;
            const v4f g4 = *(const v4f*)(g + c), sc = *(const v4f*)(m + sc_off + c), sh = *(const v4f*)(m + sh_off + c);
            const v4f o = v[j] * r * g4 * (sc + 1.f) + sh; v2u w; w.x = pk2(o.x, o.y); w.y = pk2(o.z, o.w);
            *(GAS v2u*)(h + (size_t)row * 1024 + c) = w; }
    }
}
__device__ __forceinline__ void rp_mla_fin1(Frame& F, const float* lat, const float* gq, const float* gkv, bf16* qn, bf16* ckv, float* out, int j) {
    for (int row = F.gw; row < T; row += F.NGW) {
        const float* lr = lat + (size_t)row * 768;
        v2f q[3]; float ss = 0.f;
#pragma unroll
        for (int i = 0; i < 3; ++i) { q[i] = *(const GAS v2f*)(lr + 2 * F.lane + 128 * i); ss += q[i].x * q[i].x + q[i].y * q[i].y; }
        float r = rsqrtf(wsum(ss, F.lane) * (1.f / 384) + EPS);
#pragma unroll
        for (int i = 0; i < 3; ++i) { const int c = 2 * F.lane + 128 * i; *(GAS unsigned*)(qn + (size_t)row * 384 + c) = pk2(q[i].x * r * gq[c], q[i].y * r * gq[c + 1]); }
        v2f k[2]; ss = 0.f;
#pragma unroll
        for (int i = 0; i < 2; ++i) { k[i] = *(const GAS v2f*)(lr + 384 + 2 * F.lane + 128 * i); ss += k[i].x * k[i].x + k[i].y * k[i].y; }
        r = rsqrtf(wsum(ss, F.lane) * (1.f / 256) + EPS);
#pragma unroll
        for (int i = 0; i < 2; ++i) { const int c = 2 * F.lane + 128 * i; const float c0 = k[i].x * r * gkv[c], c1 = k[i].y * r * gkv[c + 1];
            *(GAS unsigned*)(ckv + (size_t)row * 256 + c) = pk2(c0, c1);
            if (row < TP) { v2f o; o.x = c0; o.y = c1; *(GAS v2f*)(out + OUT_CKV + (((size_t)(row >> 8) * 2 + j) * 256 + (row & 255)) * 256 + c) = o; } }
        if (row < TP && F.lane < 32) out[OUT_KPE + (((size_t)(row >> 8) * 2 + j) * 256 + (row & 255)) * 32 + F.lane] = lr[640 + F.lane];
    }
}
__device__ __forceinline__ void rope32_tab(float* pe, int t, const float* tab) {
    const v2f* tr = (const v2f*)tab + (t >> 6) * 8; const v2f* tc = (const v2f*)tab + (16 + (t & 63)) * 8;
#pragma unroll
    for (int i = 0; i < 8; ++i) {
        v2f cs = tr[i]; float x1 = pe[i], x2 = pe[i + 8]; pe[i] = x1 * cs.x - x2 * cs.y; pe[i + 8] = x2 * cs.x + x1 * cs.y;
        cs = tc[i]; x1 = pe[16 + i]; x2 = pe[24 + i]; pe[16 + i] = x1 * cs.x - x2 * cs.y; pe[24 + i] = x2 * cs.x + x1 * cs.y;
    }
}
__device__ __forceinline__ void ld8(const bf16* p, float* d) { const v4u w = *(const GAS v4u*)p; d[0] = bflo(w.x); d[1] = bfhi(w.x); d[2] = bflo(w.y); d[3] = bfhi(w.y); d[4] = bflo(w.z); d[5] = bfhi(w.z); d[6] = bflo(w.w); d[7] = bfhi(w.w); }
__device__ __forceinline__ void st8(bf16* p, const float* d) { v4u w; w.x = pk2(d[0], d[1]); w.y = pk2(d[2], d[3]); w.z = pk2(d[4], d[5]); w.w = pk2(d[6], d[7]); *(GAS v4u*)p = w; }
__device__ __forceinline__ void rp_mla_fin2(Frame& F, const bf16* qraw, const bf16* kvraw, const float* lat, const float* ckpe_j, const float* gqn, const float* gkn, const float* tab, bf16* Q, bf16* K) {
    for (int idx = F.bx * NTHR + F.tid; idx < T * 32; idx += F.G * NTHR) {
        const int row = idx >> 5, hd = (idx >> 1) & 15, hf = idx & 1; const bool latent = row >= TP; const int tl = (row - TP) & 1023;
        float v[48]; float ss = 0.f;
#pragma unroll
        for (int i = 0; i < 6; ++i) ld8(qraw + (size_t)row * 1536 + hd * 96 + hf * 48 + 8 * i, v + 8 * i);
#pragma unroll
        for (int d = 0; d < 48; ++d) ss += v[d] * v[d];
        ss += shx(ss, F.lane, 1);
        const float r = rsqrtf(ss * (1.f / 96) + EPS) * QSCALE;
#pragma unroll
        for (int d = 0; d < 48; ++d) v[d] = v[d] * r * gqn[hf * 48 + d];
        if (latent && hf) rope32_tab(v + 16, tl, tab);
#pragma unroll
        for (int i = 0; i < 6; ++i) st8(Q + ((size_t)row * 16 + hd) * 96 + hf * 48 + 8 * i, v + 8 * i);
    }
    asm volatile("" ::: "memory");
    for (int idx = F.bx * NTHR + F.tid; idx < (T + NCTX) * 32; idx += F.G * NTHR) {
        const int row = idx >> 5, hd = (idx >> 1) & 15, hf = idx & 1; const bool latent = row >= TP && row < T; const int tl = (row - TP) & 1023;
        float v[48]; float ss = 0.f;
        if (hf == 0) {
#pragma unroll
            for (int i = 0; i < 6; ++i) ld8(kvraw + (size_t)row * 2048 + hd * 128 + 8 * i, v + 8 * i);
        } else {
#pragma unroll
            for (int i = 0; i < 2; ++i) ld8(kvraw + (size_t)row * 2048 + hd * 128 + 48 + 8 * i, v + 8 * i);
            const float* kp = row < T ? lat + (size_t)row * 768 + 640 : ckpe_j + ((size_t)((row - T) >> 8) * 2 * 256 + ((row - T) & 255)) * 32;
#pragma unroll
            for (int i = 0; i < 8; ++i) { const v4f p4 = *(const GAS v4f*)(kp + 4 * i); v[16 + 4 * i] = p4.x; v[17 + 4 * i] = p4.y; v[18 + 4 * i] = p4.z; v[19 + 4 * i] = p4.w; }
        }
#pragma unroll
        for (int d = 0; d < 48; ++d) ss += v[d] * v[d];
        ss += shx(ss, F.lane, 1);
        const float r = rsqrtf(ss * (1.f / 96) + EPS);
#pragma unroll
        for (int d = 0; d < 48; ++d) v[d] = v[d] * r * gkn[hf * 48 + d];
        if (latent && hf) rope32_tab(v + 16, tl, tab);
#pragma unroll
        for (int i = 0; i < 6; ++i) st8(K + ((size_t)row * 16 + hd) * 96 + hf * 48 + 8 * i, v + 8 * i);
    }
}
__device__ __forceinline__ void rp_dwconv(Frame& F, const bf16* u, const float* wdw, const float* bdw, const float* gln, const float* bln, bf16* vout) {
    for (int row = F.gw; row < T; row += F.NGW) {
        int t, L; row_pos(row, t, L);
        float y[16];
#pragma unroll
        for (int hseg = 0; hseg < 2; ++hseg) { const int c0 = 512 * hseg + 8 * F.lane;
#pragma unroll
            for (int i = 0; i < 8; ++i) y[8 * hseg + i] = bdw[c0 + i];
            for (int k = 0; k < 31; ++k) { const int tt = t + k - 15; if (tt < 0 || tt >= L) continue;
                float uu[8]; ld8(u + (size_t)(row + k - 15) * 1024 + c0, uu);
                const v4f w0 = *(const GAS v4f*)(wdw + k * 1024 + c0), w1 = *(const GAS v4f*)(wdw + k * 1024 + c0 + 4);
                y[8 * hseg + 0] += uu[0] * w0.x; y[8 * hseg + 1] += uu[1] * w0.y; y[8 * hseg + 2] += uu[2] * w0.z; y[8 * hseg + 3] += uu[3] * w0.w;
                y[8 * hseg + 4] += uu[4] * w1.x; y[8 * hseg + 5] += uu[5] * w1.y; y[8 * hseg + 6] += uu[6] * w1.z; y[8 * hseg + 7] += uu[7] * w1.w; } }
        float s = 0.f;
#pragma unroll
        for (int i = 0; i < 16; ++i) s += y[i];
        const float mean = wsum(s, F.lane) * (1.f / 1024); float q = 0.f;
#pragma unroll
        for (int i = 0; i < 16; ++i) { y[i] -= mean; q += y[i] * y[i]; }
        const float r = rsqrtf(wsum(q, F.lane) * (1.f / 1024) + EPS);
#pragma unroll
        for (int hseg = 0; hseg < 2; ++hseg) { const int c0 = 512 * hseg + 8 * F.lane; float o[8];
#pragma unroll
            for (int i = 0; i < 8; ++i) { const float z = y[8 * hseg + i] * r * gln[c0 + i] + bln[c0 + i]; o[i] = z / (1.f + __expf(-z)); }
            st8(vout + (size_t)row * 1024 + c0, o); }
    }
}
__device__ __forceinline__ void rp_ssd_conv(Frame& F, const bf16* xpre, const float* dtraw, const float* wc, const float* bc, const float* dtb, bf16* xbc, float* dt) {
    for (int idx = F.bx * NTHR + F.tid; idx < T * 392; idx += F.G * NTHR) {
        const int row = idx / 392, cg = idx % 392;
        if (cg < 384) { const int c0 = 8 * cg; int t, L; row_pos(row, t, L);
            float a[8];
#pragma unroll
            for (int i = 0; i < 8; ++i) a[i] = bc[c0 + i];
#pragma unroll
            for (int k = 0; k < 5; ++k) { const int tt = t + k - 2; if (tt < 0 || tt >= L) continue;
                float xx[8]; ld8(xpre + (size_t)(row + k - 2) * 3072 + c0, xx);
#pragma unroll
                for (int i = 0; i < 8; ++i) a[i] += xx[i] * wc[k * 3072 + c0 + i]; }
#pragma unroll
            for (int i = 0; i < 8; ++i) a[i] = a[i] / (1.f + __expf(-a[i]));
            st8(xbc + (size_t)row * 3072 + c0, a);
        } else { const int e0 = 8 * (cg - 384);
#pragma unroll
            for (int i = 0; i < 8; ++i) dt[(size_t)row * 64 + e0 + i] = softplus_f(dtraw[(size_t)row * 64 + e0 + i] + dtb[e0 + i]); }
    }
}
__device__ __forceinline__ void rp_ssd_gate(Frame& F, const float* y, const bf16* z, const float* gn, bf16* yn) {
    for (int row = F.gw; row < T; row += F.NGW) {
#pragma unroll
        for (int g = 0; g < 4; ++g) { const int c0 = g * 512 + 8 * F.lane; float zz[8], v[8]; ld8(z + (size_t)row * 2048 + c0, zz);
            const v4f y0 = *(const GAS v4f*)(y + (size_t)row * 2048 + c0), y1 = *(const GAS v4f*)(y + (size_t)row * 2048 + c0 + 4);
            v[0] = y0.x; v[1] = y0.y; v[2] = y0.z; v[3] = y0.w; v[4] = y1.x; v[5] = y1.y; v[6] = y1.z; v[7] = y1.w; float ss = 0.f;
#pragma unroll
            for (int i = 0; i < 8; ++i) { v[i] = v[i] * zz[i] / (1.f + __expf(-zz[i])); ss += v[i] * v[i]; }
            const float r = rsqrtf(wsum(ss, F.lane) * (1.f / 512) + EPS);
#pragma unroll
            for (int i = 0; i < 8; ++i) v[i] = v[i] * r * gn[c0 + i];
            st8(yn + (size_t)row * 2048 + c0, v); }
    }
}

typedef short a_bf16x8 __attribute__((ext_vector_type(8)));
typedef short a_s16x4 __attribute__((ext_vector_type(4)));
typedef float a_f32x16 __attribute__((ext_vector_type(16)));
typedef float a_f32x2 __attribute__((ext_vector_type(2))); typedef __bf16 a_bf16x2 __attribute__((ext_vector_type(2)));
__device__ __forceinline__ unsigned a_cvtpk(float lo, float hi) { a_f32x2 v = {lo, hi}; a_bf16x2 b = __builtin_convertvector(v, a_bf16x2); return __builtin_bit_cast(unsigned, b); }
__device__ __forceinline__ a_s16x4 a_vtr(const LAS unsigned char* p) { return __builtin_bit_cast(a_s16x4, __builtin_amdgcn_ds_read_tr16_b64_v4i16((LAS a_s16x4*)p)); }
constexpr int AT_KS = 208, AT_VS = 192, AT_KB = 64 * AT_KS, AT_VB = 64 * AT_VS, AT_VOFF = 2 * AT_KB;
__device__ __forceinline__ void ph_attn(Frame& F, const bf16* Q, const bf16* K, const bf16* KV, bf16* AO) {
    const int lane = F.lane, r32 = lane & 31, hi = lane >> 5, wave = F.wave, tid = F.tid;
    LAS unsigned char* lds = F.lds;
    const int kr_a = tid / 12, kp_a = tid % 12, kr_b = (tid + 512) / 12, kp_b = (tid + 512) % 12, vr = tid >> 3, vp = tid & 7;
    const bool has_b = tid < 256;
    for (int uu = F.vcu; uu < 512; uu += F.G) {
        int head, q0, NT, kbase_ctx, kbase_lat;
        if (uu < 256) { const int seq = uu >> 4; head = uu & 15; q0 = seq * 256; NT = 4; kbase_ctx = seq * 256; kbase_lat = 0; }
        else { const int u2 = uu - 256, b = u2 >> 6, qb = u2 & 3; head = (u2 >> 2) & 15; q0 = TP + b * 1024 + qb * 256; NT = 20; kbase_ctx = T + b * 256; kbase_lat = TP + b * 1024; }
        a_bf16x8 qf[6];
        { const bf16* qp = Q + ((size_t)(q0 + wave * 32 + r32) * 16 + head) * 96 + hi * 8;
#pragma unroll
          for (int s = 0; s < 6; ++s) qf[s] = *(const GAS a_bf16x8*)(qp + 16 * s); }
        a_f32x16 o0, o1;
#pragma unroll
        for (int r = 0; r < 16; ++r) { o0[r] = 0.f; o1[r] = 0.f; }
        float m = -INFINITY, l = 0.f;
        v4u ka, kb2, vv;
#define AT_LOAD(t) do { const int kr0_ = (t) < 4 ? kbase_ctx + 64 * (t) : kbase_lat + 64 * ((t) - 4); \
            ka = *(const GAS v4u*)(K + ((size_t)(kr0_ + kr_a) * 16 + head) * 96 + kp_a * 8); \
            if (has_b) kb2 = *(const GAS v4u*)(K + ((size_t)(kr0_ + kr_b) * 16 + head) * 96 + kp_b * 8); \
            vv = *(const GAS v4u*)(KV + (size_t)(kr0_ + vr) * 2048 + head * 128 + 64 + vp * 8); } while (0)
#define AT_STORE(buf) do { *(LAS v4u*)(lds + (buf) * AT_KB + kr_a * AT_KS + kp_a * 16) = ka; \
            if (has_b) *(LAS v4u*)(lds + (buf) * AT_KB + kr_b * AT_KS + kp_b * 16) = kb2; \
            *(LAS v4u*)(lds + AT_VOFF + (buf) * AT_VB + vr * AT_VS + vp * 16) = vv; } while (0)
        AT_LOAD(0); AT_STORE(0);
        __syncthreads();
        for (int t = 0; t < NT; ++t) {
            const int buf = t & 1;
            if (t + 1 < NT) AT_LOAD(t + 1);
            a_f32x16 p0, p1;
#pragma unroll
            for (int r = 0; r < 16; ++r) { p0[r] = 0.f; p1[r] = 0.f; }
            { const LAS unsigned char* kp = lds + buf * AT_KB + r32 * AT_KS + hi * 16;
#pragma unroll
              for (int s = 0; s < 6; ++s) { const a_bf16x8 a0 = *(const LAS a_bf16x8*)(kp + 32 * s), a1 = *(const LAS a_bf16x8*)(kp + 32 * AT_KS + 32 * s);
                  p0 = __builtin_amdgcn_mfma_f32_32x32x16_bf16(a0, qf[s], p0, 0, 0, 0); p1 = __builtin_amdgcn_mfma_f32_32x32x16_bf16(a1, qf[s], p1, 0, 0, 0); } }
            float mx = fmaxf(p0[0], p1[0]);
#pragma unroll
            for (int r = 1; r < 16; ++r) mx = fmaxf(mx, fmaxf(p0[r], p1[r]));
            mx = fmaxf(mx, shx(mx, lane, 32));
            const float mn = fmaxf(m, mx), alpha = __builtin_amdgcn_exp2f(m - mn); m = mn;
            float ps = 0.f;
#pragma unroll
            for (int r = 0; r < 16; ++r) { p0[r] = __builtin_amdgcn_exp2f(p0[r] - mn); p1[r] = __builtin_amdgcn_exp2f(p1[r] - mn); ps += p0[r] + p1[r]; }
            l = l * alpha + ps;
#pragma unroll
            for (int r = 0; r < 16; ++r) { o0[r] *= alpha; o1[r] *= alpha; }
            v4u pw[4];
            pw[0] = (v4u){a_cvtpk(p0[0], p0[1]), a_cvtpk(p0[2], p0[3]), a_cvtpk(p0[4], p0[5]), a_cvtpk(p0[6], p0[7])};
            pw[1] = (v4u){a_cvtpk(p0[8], p0[9]), a_cvtpk(p0[10], p0[11]), a_cvtpk(p0[12], p0[13]), a_cvtpk(p0[14], p0[15])};
            pw[2] = (v4u){a_cvtpk(p1[0], p1[1]), a_cvtpk(p1[2], p1[3]), a_cvtpk(p1[4], p1[5]), a_cvtpk(p1[6], p1[7])};
            pw[3] = (v4u){a_cvtpk(p1[8], p1[9]), a_cvtpk(p1[10], p1[11]), a_cvtpk(p1[12], p1[13]), a_cvtpk(p1[14], p1[15])};
            { const LAS unsigned char* vp0 = lds + AT_VOFF + buf * AT_VB + (4 * hi + ((lane & 15) >> 2)) * AT_VS + (16 * ((lane >> 4) & 1) + 4 * (lane & 3)) * 2;
#pragma unroll
              for (int bs = 0; bs < 4; ++bs) {
                  const LAS unsigned char* vq = vp0 + (16 * bs) * AT_VS;
                  const a_s16x4 l0 = a_vtr(vq), h0 = a_vtr(vq + 8 * AT_VS), l1 = a_vtr(vq + 64), h1 = a_vtr(vq + 8 * AT_VS + 64);
                  const a_bf16x8 v0 = (a_bf16x8){l0[0], l0[1], l0[2], l0[3], h0[0], h0[1], h0[2], h0[3]}, v1 = (a_bf16x8){l1[0], l1[1], l1[2], l1[3], h1[0], h1[1], h1[2], h1[3]};
                  const a_bf16x8 pb = __builtin_bit_cast(a_bf16x8, pw[bs]);
                  o0 = __builtin_amdgcn_mfma_f32_32x32x16_bf16(v0, pb, o0, 0, 0, 0); o1 = __builtin_amdgcn_mfma_f32_32x32x16_bf16(v1, pb, o1, 0, 0, 0); } }
            if (t + 1 < NT) AT_STORE(buf ^ 1);
            __syncthreads();
        }
#undef AT_LOAD
#undef AT_STORE
        l += shx(l, lane, 32);
        const float il = 1.f / l;
        bf16* op = AO + (size_t)(q0 + wave * 32 + r32) * 1024 + head * 64 + 4 * hi;
#pragma unroll
        for (int g4 = 0; g4 < 4; ++g4) {
            v2u w0; w0.x = a_cvtpk(o0[4 * g4] * il, o0[4 * g4 + 1] * il); w0.y = a_cvtpk(o0[4 * g4 + 2] * il, o0[4 * g4 + 3] * il); *(GAS v2u*)(op + 8 * g4) = w0;
            v2u w1; w1.x = a_cvtpk(o1[4 * g4] * il, o1[4 * g4 + 1] * il); w1.y = a_cvtpk(o1[4 * g4 + 2] * il, o1[4 * g4 + 3] * il); *(GAS v2u*)(op + 32 + 8 * g4) = w1; }
    }
}
__device__ __forceinline__ void ph_scan_slow(Frame& F, const bf16* xbc, const float* dt, const float* alog, const float* dsk, const float* st0, float* y, float* out) {
    for (int it = F.gw; it < 20 * 32 * 2; it += F.NGW) {
        const int seq = it >> 6, hd = (it >> 1) & 31, g = hd >> 3, p = (it & 1) * 32 + (F.lane & 31), nh = F.lane >> 5;
        int r0, L; if (seq < 16) { r0 = seq * 256; L = 256; } else { r0 = TP + (seq - 16) * 1024; L = 1024; }
#pragma unroll 1
        for (int dir = 0; dir < 2; ++dir) {
            const float a = -expf(alog[dir * 32 + hd]), dd = dsk[dir * 32 + hd];
            float hs[64];
#pragma unroll
            for (int n = 0; n < 64; ++n) hs[n] = 0.f;
            if (seq >= 16) { const float* s0 = st0 + ((((size_t)(seq - 16) * 2 + dir) * 32 + hd) * 64 + p) * 128 + nh * 64;
#pragma unroll
                for (int n4 = 0; n4 < 16; ++n4) { const v4f t4 = *(const GAS v4f*)(s0 + 4 * n4); hs[4 * n4] = t4.x; hs[4 * n4 + 1] = t4.y; hs[4 * n4 + 2] = t4.z; hs[4 * n4 + 3] = t4.w; } }
#pragma unroll 1
            for (int s = 0; s < L; ++s) {
                const int row = r0 + (dir == 0 ? s : L - 1 - s);
                const float dtv = dt[(size_t)row * 64 + dir * 32 + hd], da = expf(dtv * a), xv = bf2f(xbc[(size_t)row * 3072 + hd * 64 + p]), dtx = dtv * xv;
                const bf16* Bp = xbc + (size_t)row * 3072 + 2048 + g * 128 + nh * 64; const bf16* Cp = Bp + 512;
                float acc = 0.f;
#pragma unroll
                for (int n8 = 0; n8 < 8; ++n8) { float bb[8], cc[8]; if ((n8 & 1) == 0) asm volatile("" ::: "memory"); ld8(Bp + 8 * n8, bb); ld8(Cp + 8 * n8, cc);
#pragma unroll
                    for (int e = 0; e < 8; ++e) { hs[8 * n8 + e] = hs[8 * n8 + e] * da + dtx * bb[e]; acc += cc[e] * hs[8 * n8 + e]; } }
                acc += shx(acc, F.lane, 32);
                if (nh == 0) { float* yp = y + (size_t)row * 2048 + hd * 64 + p; const float yv = acc + xv * dd; *yp = dir == 0 ? yv : *yp + yv; }
            }
            if (seq < 16) { float* o = out + OUT_SSM + ((((size_t)seq * 2 + dir) * 32 + hd) * 64 + p) * 128 + nh * 64;
#pragma unroll
                for (int n4 = 0; n4 < 16; ++n4) { v4f t4; t4.x = hs[4 * n4]; t4.y = hs[4 * n4 + 1]; t4.z = hs[4 * n4 + 2]; t4.w = hs[4 * n4 + 3]; *(GAS v4f*)(o + 4 * n4) = t4; } }
        }
    }
}

constexpr int NPHASE = 37;
enum Op { OP_P0, OP_NORM1, OP_G_LAT, OP_FIN1, OP_G_QKV, OP_FIN2, OP_ATTN, OP_G_WO, OP_NORM2, OP_G_FF1, OP_G_FF2, OP_G_PW1, OP_DWCONV, OP_G_PW2, OP_G_SSI, OP_SSCONV, OP_SCAN, OP_GATE, OP_G_SSO };
__device__ __forceinline__ void phase_decode(int ph, int& layer, int& op) {
    if (ph == 0) { layer = 0; op = OP_P0; return; }
    int r;
    if (ph <= 10) { layer = 0; r = ph - 1; } else if (ph <= 17) { layer = 1; r = ph - 11; } else if (ph <= 26) { layer = 2; r = ph - 18; } else { layer = 3; r = ph - 27; }
    const int kind = layer % 3;
    if (kind == 0) { op = r == 0 ? OP_NORM1 : r == 1 ? OP_G_LAT : r == 2 ? OP_FIN1 : r == 3 ? OP_G_QKV : r == 4 ? OP_FIN2 : r == 5 ? OP_ATTN : r == 6 ? OP_G_WO : r == 7 ? OP_NORM2 : r == 8 ? OP_G_FF1 : OP_G_FF2; }
    else if (kind == 1) { op = r == 0 ? OP_NORM1 : r == 1 ? OP_G_PW1 : r == 2 ? OP_DWCONV : r == 3 ? OP_G_PW2 : r == 4 ? OP_NORM2 : r == 5 ? OP_G_FF1 : OP_G_FF2; }
    else { op = r == 0 ? OP_NORM1 : r == 1 ? OP_G_SSI : r == 2 ? OP_SSCONV : r == 3 ? OP_SCAN : r == 4 ? OP_GATE : r == 5 ? OP_G_SSO : r == 6 ? OP_NORM2 : r == 7 ? OP_G_FF1 : OP_G_FF2; }
}
struct MArgs { const float* in[38]; float* out; unsigned char* ws; int ph_lo, ph_hi; };
constexpr int PTAB_OFF = MISC_OFF - 512;
__global__ void __launch_bounds__(NTHR, 2) mega_fwd(MArgs args) {
    extern __shared__ __attribute__((aligned(16))) unsigned char lds_raw[];
    LAS unsigned char* lds = (LAS unsigned char*)lds_raw;
    volatile LAS unsigned* PT0 = (volatile LAS unsigned*)(lds + PTAB_OFF);
    volatile LAS unsigned* MISC = (volatile LAS unsigned*)(lds + MISC_OFF);
    { const int t0 = threadIdx.x;
      if (t0 < 40) { const unsigned long long p = t0 < 38 ? (unsigned long long)args.in[t0] : t0 == 38 ? (unsigned long long)args.out : (unsigned long long)args.ws;
          PT0[2 * t0] = (unsigned)p; PT0[2 * t0 + 1] = (unsigned)(p >> 32); }
      if (t0 < 64) MISC[t0] = 0u; }
    __syncthreads();
    XcdBarrier bar = xcd_barrier_post((unsigned*)((unsigned char*)ldp(PT0, PT_WS) + WS_CTL) + CW_BAR, MISC + 8);
    const int wave0 = __builtin_amdgcn_readfirstlane(threadIdx.x >> 6);
    const int ph_hi = args.ph_hi;
    for (int ph = args.ph_lo; ph < ph_hi; ++ph) {
        Frame F;
        { int w = wave0; asm volatile("" : "+s"(w)); F.wave = w; }
        F.lds = lds; F.lane = olane(); F.tid = F.wave * 64 + F.lane;
        const int bx = obid();
        F.G = gridDim.x; F.vcu = (F.G % 8 == 0) ? (bx % 8) * (F.G / 8) + bx / 8 : bx;
        F.gw = F.vcu * NWAVES + F.wave; F.NGW = F.G * NWAVES; F.PT = PT0; F.bx = bx;
        int layer, op; phase_decode(ph, layer, op);
        const int j = layer / 3;
        switch (op) {
        case OP_P0: p0_prologue(F); break;
        case OP_NORM1: { unsigned char* ws = WSP; float* x = OUTP; const float* xlo = layer == 0 ? INP(I_XP) : x; const float* xhi = layer == 0 ? INP(I_XS) - (size_t)TP * 1024 : x;
            rp_normmod(F, xlo, xhi, INP(I_GN1) + layer * 1024, (const float*)(ws + WS_MODS) + (size_t)layer * 5 * 6144, 0, 1024, (bf16*)(ws + WS_H)); } break;
        case OP_NORM2: { unsigned char* ws = WSP; float* x = OUTP;
            rp_normmod(F, x, x, INP(I_GN2) + layer * 1024, (const float*)(ws + WS_MODS) + (size_t)layer * 5 * 6144, 3072, 4096, (bf16*)(ws + WS_H)); } break;
        case OP_G_LAT: { unsigned char* ws = WSP; pg8::Gemm g{(const bf16*)(ws + WS_H), (const bf16*)(ws + W_MLA + j * MLA_WB + MW_CAT), T, 768, 1024}; pg8::StaticOrder S; S.init(T, 768, F.G, F.bx);
            pg8::EpiF32 E{(float*)(ws + A_LAT), 768}; pg8::gemm_phase<pg8::EpiF32, pg8::StaticOrder, true, true>(F.lds, g, S, E, F.wave); } break;
        case OP_FIN1: { unsigned char* ws = WSP; rp_mla_fin1(F, (const float*)(ws + A_LAT), INP(I_GQ) + j * 384, INP(I_GKV) + j * 256, (bf16*)(ws + A_QN), (bf16*)(ws + WS_CKV + j * CKV_B), OUTP, j); } break;
        case OP_G_QKV: {
#pragma unroll 1
            for (int w = 0; w < 2; ++w) {
                unsigned char* ws = WSP; unsigned char* wm = ws + W_MLA + j * MLA_WB;
                pg8::Gemm g = w == 0 ? pg8::Gemm{(const bf16*)(ws + A_QN), (const bf16*)(wm + MW_UQ), T, 1536, 384} : pg8::Gemm{(const bf16*)(ws + WS_CKV + j * CKV_B), (const bf16*)(wm + MW_UKV), T + NCTX, 2048, 256};
                pg8::StaticOrder S; S.init(g.M, g.N, F.G, w == 0 ? F.bx : (int)((F.bx + 64) % F.G));
                pg8::EpiBf16P E{w == 0 ? (bf16*)(ws + A_QRAW) : (bf16*)(ws + A_KVRAW), g.N};
                pg8::gemm_phase<pg8::EpiBf16P, pg8::StaticOrder, true, true>(F.lds, g, S, E, F.wave);
            } } break;
        case OP_FIN2: { unsigned char* ws = WSP; rp_mla_fin2(F, (const bf16*)(ws + A_QRAW), (const bf16*)(ws + A_KVRAW), (const float*)(ws + A_LAT), INP(I_CKPE) + (size_t)j * 8192, INP(I_GQN) + j * 96, INP(I_GKN) + j * 96,
                                                        (const float*)(ws + WS_ROPE), (bf16*)(ws + A_QB), (bf16*)(ws + A_KB)); } break;
        case OP_ATTN: { unsigned char* ws = WSP; ph_attn(F, (const bf16*)(ws + A_QB), (const bf16*)(ws + A_KB), (const bf16*)(ws + A_KVRAW), (bf16*)(ws + A_AO)); } break;
        case OP_G_WO: case OP_G_PW2: case OP_G_SSO: case OP_G_FF2: {
            unsigned char* ws = WSP; float* x = OUTP;
            const float* rlo = (layer == 0 && op != OP_G_FF2) ? INP(I_XP) : x; const float* rhi = (layer == 0 && op != OP_G_FF2) ? INP(I_XS) - (size_t)TP * 1024 : x;
            pg8::Gemm g; const float* bias = nullptr; int goff = 2048;
            if (op == OP_G_WO) g = pg8::Gemm{(const bf16*)(ws + A_AO), (const bf16*)(ws + W_MLA + j * MLA_WB + MW_O), T, 1024, 1024};
            else if (op == OP_G_PW2) { g = pg8::Gemm{(const bf16*)(ws + A_V), (const bf16*)(ws + W_CV2), T, 1024, 1024}; bias = INP(I_CVB2); }
            else if (op == OP_G_SSO) g = pg8::Gemm{(const bf16*)(ws + A_YN), (const bf16*)(ws + W_SSO), T, 1024, 2048};
            else { g = pg8::Gemm{(const bf16*)(ws + A_ACT), (const bf16*)(ws + W_FF + layer * FF_WB + FW_OUT), T, 1024, 2816}; goff = 5120; }
            pg8::StaticOrder S; S.init(T, 1024, F.G, F.bx);
            pg8::EpiResid E{rlo, rhi, x, (const float*)(ws + WS_MODS) + (size_t)layer * 5 * 6144, goff, bias};
            pg8::gemm_phase<pg8::EpiResid, pg8::StaticOrder, true, true>(F.lds, g, S, E, F.wave); } break;
        case OP_G_FF1: { unsigned char* ws = WSP; pg8::Gemm g{(const bf16*)(ws + WS_H), (const bf16*)(ws + W_FF + layer * FF_WB + FW_IN), T, 5632, 1024}; pg8::StaticOrder S; S.init(T, 5632, F.G, F.bx);
            pg8::EpiGlu<0> E{(bf16*)(ws + A_ACT), 2816, nullptr, 2816}; pg8::gemm_phase<pg8::EpiGlu<0>, pg8::StaticOrder, true, true>(F.lds, g, S, E, F.wave); } break;
        case OP_G_PW1: { unsigned char* ws = WSP; pg8::Gemm g{(const bf16*)(ws + WS_H), (const bf16*)(ws + W_CV1), T, 2048, 1024}; pg8::StaticOrder S; S.init(T, 2048, F.G, F.bx);
            pg8::EpiGlu<1> E{(bf16*)(ws + A_U), 1024, INP(I_CVB1), 1024}; pg8::gemm_phase<pg8::EpiGlu<1>, pg8::StaticOrder, true, true>(F.lds, g, S, E, F.wave); } break;
        case OP_DWCONV: { unsigned char* ws = WSP; rp_dwconv(F, (const bf16*)(ws + A_U), INP(I_CVWD), INP(I_CVBD), INP(I_CVGL), INP(I_CVBL), (bf16*)(ws + A_V)); } break;
        case OP_G_SSI: { unsigned char* ws = WSP; pg8::Gemm g{(const bf16*)(ws + WS_H), (const bf16*)(ws + W_SSI), T, 5376, 1024}; pg8::StaticOrder S; S.init(T, 5376, F.G, F.bx);
            pg8::EpiSsdIn E{(bf16*)(ws + A_Z), (bf16*)(ws + A_XPRE), (float*)(ws + A_DTRAW)}; pg8::gemm_phase<pg8::EpiSsdIn, pg8::StaticOrder, true, true>(F.lds, g, S, E, F.wave); } break;
        case OP_SSCONV: { unsigned char* ws = WSP; rp_ssd_conv(F, (const bf16*)(ws + A_XPRE), (const float*)(ws + A_DTRAW), INP(I_SSWC), INP(I_SSBC), INP(I_SSDTB), (bf16*)(ws + A_XBC), (float*)(ws + A_DT)); } break;
        case OP_SCAN: { unsigned char* ws = WSP; ph_scan_slow(F, (const bf16*)(ws + A_XBC), (const float*)(ws + A_DT), INP(I_SSAL), INP(I_SSD), INP(I_SSM), (float*)(ws + A_Y), OUTP); } break;
        case OP_GATE: { unsigned char* ws = WSP; rp_ssd_gate(F, (const float*)(ws + A_Y), (const bf16*)(ws + A_Z), INP(I_SSGN), (bf16*)(ws + A_YN)); } break;
        default: break;
        }
        if (ph + 1 < ph_hi) xcd_barrier(bar);
    }
}

#ifndef MK_PHASES
#define MK_PHASES 37
#endif
#ifndef MK_PER_PHASE
#define MK_PER_PHASE 0
#endif
static int sub_after_phases(int p) { return p >= 37 ? 8 : p >= 34 ? 7 : p >= 27 ? 6 : p >= 24 ? 5 : p >= 18 ? 4 : p >= 15 ? 3 : p >= 11 ? 2 : p >= 8 ? 1 : 0; }
extern "C" void kernel_launch(void* const* d_in, const int* in_sizes, int n_in, void* d_out, int out_size, void* d_ws, size_t ws_size, hipStream_t stream) {
    static int grid = 0;
    if (grid == 0) {
        int dev = 0, cus = 0;
        if (hipGetDevice(&dev) != hipSuccess || hipDeviceGetAttribute(&cus, hipDeviceAttributeMultiprocessorCount, dev) != hipSuccess) { fprintf(stderr, "kernel_launch: device query failed\n"); grid = -1; return; }
        if (hipFuncSetAttribute((const void*)mega_fwd, hipFuncAttributeMaxDynamicSharedMemorySize, LDS_BYTES) != hipSuccess) { fprintf(stderr, "kernel_launch: hipFuncSetAttribute failed\n"); grid = -1; return; }
        (void)hipGetLastError();
        grid = cus;
    }
    if (grid < 0) return;
    In I; const float** p = (const float**)&I;
    for (int i = 0; i < 38; ++i) p[i] = (const float*)d_in[i];
    (void)hipMemsetAsync((char*)d_ws + WS_CTL, 0, CTL_ZERO_BYTES, stream);
    MArgs a{};
    for (int i = 0; i < 38; ++i) a.in[i] = (const float*)d_in[i];
    a.out = (float*)d_out; a.ws = (unsigned char*)d_ws;
    const int nph = MK_PHASES;
    if (MK_PER_PHASE) { for (int ph = 0; ph < nph; ++ph) { a.ph_lo = ph; a.ph_hi = ph + 1; hipLaunchKernelGGL(mega_fwd, dim3(grid), dim3(NTHR), LDS_BYTES, stream, a); } }
    else { a.ph_lo = 0; a.ph_hi = nph; hipLaunchKernelGGL(mega_fwd, dim3(grid), dim3(NTHR), LDS_BYTES, stream, a); }
    const int sub = sub_after_phases(nph);
    if (sub < 8) naive_forward(I, (float*)d_out, (float*)d_ws, stream, sub);
}
```

```cpp
#include <hip/hip_runtime.h>
#include <cstdint>
#include <cstdio>

constexpr int DM = 1024, T = 8192, TP = 4096;
constexpr int NCTX = 1024;
constexpr int QL = 384, KVL = 256, ROPE = 32, NOPE = 64, QKD = 96, VH = 64, NH = 16;
constexpr int FFH = 2816;
constexpr int SSI = 2048, SSH = 32, SSP = 64, SSN = 128, SSG = 4, SSCD = 3072, SSIN = 5184;
constexpr float EPS = 1e-6f;
constexpr size_t OUT_YP = 0, OUT_CKV = 8388608, OUT_KPE = 10485760, OUT_SSM = 10747904;

__device__ __forceinline__ int cond_of_row(int r) { return r < TP ? 0 : 1 + ((r - TP) >> 10); }
__device__ __forceinline__ void row_pos(int r, int& t, int& L) { if (r < TP) { t = r & 255; L = 256; } else { t = (r - TP) & 1023; L = 1024; } }
__device__ __forceinline__ float silu_f(float x) { return x / (1.f + expf(-x)); }
__device__ __forceinline__ float sigmoid_f(float x) { return 1.f / (1.f + expf(-x)); }
__device__ __forceinline__ float softplus_f(float x) { return fmaxf(x, 0.f) + log1pf(expf(-fabsf(x))); }
__device__ __forceinline__ float wave_sum(float v) {
#pragma unroll
    for (int o = 1; o < 64; o <<= 1) v += __shfl_xor(v, o);
    return v;
}

__global__ void __launch_bounds__(256) nk_adaln(const float* __restrict__ c, const float* __restrict__ cctx, const float* __restrict__ w, const float* __restrict__ b, float* __restrict__ mods) {
    __shared__ float s[5][DM];
    const int l = blockIdx.y, n = blockIdx.x * 256 + threadIdx.x;
    for (int i = threadIdx.x; i < 5 * DM; i += 256) { const int cc = i / DM, k = i % DM; const float v = cc == 0 ? cctx[k] : c[(cc - 1) * DM + k]; s[cc][k] = silu_f(v); }
    __syncthreads();
    const float* W = w + (size_t)l * DM * 6144;
    float acc[5] = {0.f, 0.f, 0.f, 0.f, 0.f};
    for (int k = 0; k < DM; ++k) { const float wv = W[(size_t)k * 6144 + n];
#pragma unroll
        for (int cc = 0; cc < 5; ++cc) acc[cc] += s[cc][k] * wv; }
#pragma unroll
    for (int cc = 0; cc < 5; ++cc) mods[((size_t)l * 5 + cc) * 6144 + n] = acc[cc] + b[l * 6144 + n];
}

__global__ void __launch_bounds__(256) nk_copy_x(const float* __restrict__ xp, const float* __restrict__ xs, float* __restrict__ x) {
    const size_t i = (size_t)blockIdx.x * 256 + threadIdx.x;
    const size_t half = (size_t)TP * DM / 4;
    ((float4*)x)[i] = i < half ? ((const float4*)xp)[i] : ((const float4*)xs)[i - half];
}

__global__ void __launch_bounds__(256) nk_normmod(const float* __restrict__ x, const float* __restrict__ g, const float* __restrict__ mods_l, int sh_off, int sc_off, float* __restrict__ h) {
    const int row = blockIdx.x * 4 + (threadIdx.x >> 6), lane = threadIdx.x & 63;
    const float* xr = x + (size_t)row * DM; float v[16]; float ss = 0.f;
#pragma unroll
    for (int i = 0; i < 16; ++i) { v[i] = xr[lane + 64 * i]; ss += v[i] * v[i]; }
    ss = wave_sum(ss); const float r = rsqrtf(ss * (1.f / DM) + EPS);
    const float* m = mods_l + (size_t)cond_of_row(row) * 6144;
#pragma unroll
    for (int i = 0; i < 16; ++i) { const int k = lane + 64 * i; h[(size_t)row * DM + k] = v[i] * r * g[k] * (1.f + m[sc_off + k]) + m[sh_off + k]; }
}

template <int GLU>
__global__ void __launch_bounds__(256) nk_gemm(const float* __restrict__ A, int lda, const float* __restrict__ B, int ldb, float* __restrict__ C, int ldc, int M, int N, int K, const float* __restrict__ bias) {
    __shared__ float As[16][65], Bs[16][65], Us[16][65];
    const int tx = threadIdx.x & 15, ty = threadIdx.x >> 4, m0 = blockIdx.y * 64, n0 = blockIdx.x * 64;
    float acc[4][4] = {}, acu[4][4] = {};
    for (int k0 = 0; k0 < K; k0 += 16) {
        for (int i = threadIdx.x; i < 1024; i += 256) { const int r = i >> 4, kk = i & 15; As[kk][r] = A[(size_t)(m0 + r) * lda + k0 + kk]; }
        for (int i = threadIdx.x; i < 1024; i += 256) { const int kk = i >> 6, cc = i & 63; const bool ok = n0 + cc < N; Bs[kk][cc] = ok ? B[(size_t)(k0 + kk) * ldb + n0 + cc] : 0.f;
            if (GLU) Us[kk][cc] = ok ? B[(size_t)(k0 + kk) * ldb + N + n0 + cc] : 0.f; }
        __syncthreads();
#pragma unroll
        for (int kk = 0; kk < 16; ++kk) { float a[4], b[4], u[4];
#pragma unroll
            for (int i = 0; i < 4; ++i) { a[i] = As[kk][ty * 4 + i]; b[i] = Bs[kk][tx * 4 + i]; u[i] = GLU ? Us[kk][tx * 4 + i] : 0.f; }
#pragma unroll
            for (int i = 0; i < 4; ++i)
#pragma unroll
                for (int j = 0; j < 4; ++j) { acc[i][j] += a[i] * b[j]; if (GLU) acu[i][j] += a[i] * u[j]; } }
        __syncthreads();
    }
#pragma unroll
    for (int i = 0; i < 4; ++i)
#pragma unroll
        for (int j = 0; j < 4; ++j) { const int n = n0 + tx * 4 + j; if (n < N) {
            float v = acc[i][j] + (bias ? bias[n] : 0.f);
            if (GLU) { const float u = acu[i][j] + (bias ? bias[N + n] : 0.f); v = GLU == 1 ? silu_f(v) * u : v * sigmoid_f(u); }
            C[(size_t)(m0 + ty * 4 + i) * ldc + n] = v; } }
}

__global__ void __launch_bounds__(256) nk_resid(float* __restrict__ x, const float* __restrict__ o, const float* __restrict__ mods_l, int g_off) {
    const size_t i = (size_t)blockIdx.x * 256 + threadIdx.x; const int row = (int)(i >> 10), k = (int)(i & 1023);
    x[i] += mods_l[(size_t)cond_of_row(row) * 6144 + g_off + k] * o[i];
}

__global__ void __launch_bounds__(256) nk_mla_fin1(const float* __restrict__ latq, const float* __restrict__ latkv, const float* __restrict__ gq, const float* __restrict__ gkv,
                                                   const float* __restrict__ cache_ckv_j  , float* __restrict__ qn, float* __restrict__ ckv, float* __restrict__ out, int j) {
    const int row = blockIdx.x * 4 + (threadIdx.x >> 6), lane = threadIdx.x & 63;
    if (row >= T) { const int b = (row - T) >> 8, s = (row - T) & 255;
#pragma unroll
        for (int i = 0; i < 4; ++i) ckv[(size_t)row * KVL + lane + 64 * i] = cache_ckv_j[((size_t)b * 2 * 256 + s) * 256 + lane + 64 * i];
        return; }
    float v[6]; float ss = 0.f;
#pragma unroll
    for (int i = 0; i < 6; ++i) { v[i] = latq[(size_t)row * QL + lane + 64 * i]; ss += v[i] * v[i]; }
    ss = wave_sum(ss); float r = rsqrtf(ss * (1.f / QL) + EPS);
#pragma unroll
    for (int i = 0; i < 6; ++i) qn[(size_t)row * QL + lane + 64 * i] = v[i] * r * gq[lane + 64 * i];
    ss = 0.f;
#pragma unroll
    for (int i = 0; i < 4; ++i) { v[i] = latkv[(size_t)row * 288 + lane + 64 * i]; ss += v[i] * v[i]; }
    ss = wave_sum(ss); r = rsqrtf(ss * (1.f / KVL) + EPS);
#pragma unroll
    for (int i = 0; i < 4; ++i) { const float c = v[i] * r * gkv[lane + 64 * i]; ckv[(size_t)row * KVL + lane + 64 * i] = c;
        if (row < TP) out[OUT_CKV + (((size_t)(row >> 8) * 2 + j) * 256 + (row & 255)) * 256 + lane + 64 * i] = c; }
    if (row < TP && lane < 32) out[OUT_KPE + (((size_t)(row >> 8) * 2 + j) * 256 + (row & 255)) * 32 + lane] = latkv[(size_t)row * 288 + 256 + lane];
}

__device__ __forceinline__ float rope_inv(int i) { return i == 0 ? 1.f : i == 1 ? 0.31622776601683794f : i == 2 ? 0.1f : i == 3 ? 0.031622776601683794f : i == 4 ? 0.01f : i == 5 ? 0.0031622776601683794f : i == 6 ? 0.001f : 0.00031622776601683794f; }
__device__ __forceinline__ void rope32(float* pe, int t) {
    const int rr = t >> 6, cc = t & 63;
#pragma unroll
    for (int i = 0; i < 8; ++i) {
        const float inv = rope_inv(i);
        float a = (float)rr * inv, s = sinf(a), c = cosf(a);
        float x1 = pe[i], x2 = pe[i + 8]; pe[i] = x1 * c - x2 * s; pe[i + 8] = x2 * c + x1 * s;
        a = (float)cc * inv; s = sinf(a); c = cosf(a);
        x1 = pe[16 + i]; x2 = pe[24 + i]; pe[16 + i] = x1 * c - x2 * s; pe[24 + i] = x2 * c + x1 * s;
    }
}
__global__ void __launch_bounds__(256) nk_mla_fin2(const float* __restrict__ qraw, const float* __restrict__ kvraw, const float* __restrict__ latkv, const float* __restrict__ cache_kpe_j,
                                                   const float* __restrict__ gqn, const float* __restrict__ gkn, float* __restrict__ Q, float* __restrict__ K) {
    const int idx = blockIdx.x * 256 + threadIdx.x, row = idx >> 4, h = idx & 15;
    const bool latent = row >= TP && row < T; const int tl = (row - TP) & 1023;
    if (row < T) {
        float q[96]; float ss = 0.f;
#pragma unroll
        for (int d = 0; d < 96; ++d) { q[d] = qraw[(size_t)row * 1536 + h * 96 + d]; ss += q[d] * q[d]; }
        const float r = rsqrtf(ss * (1.f / 96) + EPS);
#pragma unroll
        for (int d = 0; d < 96; ++d) q[d] = q[d] * r * gqn[d];
        if (latent) rope32(q + 64, tl);
#pragma unroll
        for (int d = 0; d < 96; ++d) Q[((size_t)row * 16 + h) * 96 + d] = q[d];
    }
    float k[96]; float ss = 0.f;
#pragma unroll
    for (int d = 0; d < 64; ++d) { k[d] = kvraw[(size_t)row * 2048 + h * 128 + d]; ss += k[d] * k[d]; }
#pragma unroll
    for (int d = 0; d < 32; ++d) { k[64 + d] = row < T ? latkv[(size_t)row * 288 + 256 + d] : cache_kpe_j[((size_t)((row - T) >> 8) * 2 * 256 + ((row - T) & 255)) * 32 + d]; ss += k[64 + d] * k[64 + d]; }
    const float r = rsqrtf(ss * (1.f / 96) + EPS);
#pragma unroll
    for (int d = 0; d < 96; ++d) k[d] = k[d] * r * gkn[d];
    if (latent) rope32(k + 64, tl);
#pragma unroll
    for (int d = 0; d < 96; ++d) K[((size_t)row * 16 + h) * 96 + d] = k[d];
}

__global__ void __launch_bounds__(64) nk_attn(const float* __restrict__ Q, const float* __restrict__ K, const float* __restrict__ KV  , float* __restrict__ O) {
    __shared__ float Ks[32][96], Vs[32][64];
    const int h = blockIdx.y, row = blockIdx.x * 64 + threadIdx.x;
    float q[96];
#pragma unroll
    for (int d = 0; d < 96; ++d) q[d] = Q[((size_t)row * 16 + h) * 96 + d];
    float o[64];
#pragma unroll
    for (int d = 0; d < 64; ++d) o[d] = 0.f;
    float m = -INFINITY, l = 0.f;
    int nkeys, kbase0, kbase1, n0;
    const int r0 = blockIdx.x * 64;
    if (r0 < TP) { nkeys = 256; n0 = 256; kbase0 = r0 & ~255; kbase1 = 0; }
    else { const int b = (r0 - TP) >> 10; nkeys = 1280; n0 = 256; kbase0 = T + b * 256; kbase1 = TP + b * 1024; }
    const float scale = rsqrtf(96.f);
    for (int k0 = 0; k0 < nkeys; k0 += 32) {
        __syncthreads();
        for (int i = threadIdx.x; i < 32 * 96; i += 64) { const int kk = i / 96, d = i % 96; const int key = k0 + kk; const int kr = key < n0 ? kbase0 + key : kbase1 + key - n0; Ks[kk][d] = K[((size_t)kr * 16 + h) * 96 + d]; }
        for (int i = threadIdx.x; i < 32 * 64; i += 64) { const int kk = i / 64, d = i % 64; const int key = k0 + kk; const int kr = key < n0 ? kbase0 + key : kbase1 + key - n0; Vs[kk][d] = KV[(size_t)kr * 2048 + h * 128 + 64 + d]; }
        __syncthreads();
        for (int kk = 0; kk < 32; ++kk) {
            float s = 0.f;
#pragma unroll
            for (int d = 0; d < 96; ++d) s += q[d] * Ks[kk][d];
            s *= scale;
            const float mn = fmaxf(m, s), a = expf(m - mn), p = expf(s - mn);
            l = l * a + p;
#pragma unroll
            for (int d = 0; d < 64; ++d) o[d] = o[d] * a + p * Vs[kk][d];
            m = mn;
        }
    }
    const float il = 1.f / l;
#pragma unroll
    for (int d = 0; d < 64; ++d) O[(size_t)row * DM + h * 64 + d] = o[d] * il;
}

__global__ void __launch_bounds__(256) nk_dwconv_ln(const float* __restrict__ u, const float* __restrict__ wdw, const float* __restrict__ bdw, const float* __restrict__ gln, const float* __restrict__ bln, float* __restrict__ v) {
    const int row = blockIdx.x * 4 + (threadIdx.x >> 6), lane = threadIdx.x & 63;
    int t, L; row_pos(row, t, L);
    float y[16]; float s = 0.f;
#pragma unroll
    for (int i = 0; i < 16; ++i) { const int c = lane + 64 * i; float a = bdw[c];
        for (int k = 0; k < 31; ++k) { const int tt = t + k - 15; if (tt >= 0 && tt < L) a += u[(size_t)(row + k - 15) * DM + c] * wdw[k * DM + c]; }
        y[i] = a; s += a; }
    const float mean = wave_sum(s) * (1.f / DM); float q = 0.f;
#pragma unroll
    for (int i = 0; i < 16; ++i) { y[i] -= mean; q += y[i] * y[i]; }
    const float r = rsqrtf(wave_sum(q) * (1.f / DM) + EPS);
#pragma unroll
    for (int i = 0; i < 16; ++i) { const int c = lane + 64 * i; v[(size_t)row * DM + c] = silu_f(y[i] * r * gln[c] + bln[c]); }
}

__global__ void __launch_bounds__(256) nk_ssd_conv(const float* __restrict__ xpre  , const float* __restrict__ dtraw  , const float* __restrict__ wc, const float* __restrict__ bc, const float* __restrict__ dtb, float* __restrict__ xbc, float* __restrict__ dt) {
    const size_t i = (size_t)blockIdx.x * 256 + threadIdx.x; const int row = (int)(i / 3136), c = (int)(i % 3136);
    int t, L; row_pos(row, t, L);
    if (c < SSCD) { float a = bc[c];
#pragma unroll
        for (int k = 0; k < 5; ++k) { const int tt = t + k - 2; if (tt >= 0 && tt < L) a += xpre[(size_t)(row + k - 2) * SSCD + c] * wc[k * SSCD + c]; }
        xbc[(size_t)row * SSCD + c] = silu_f(a);
    } else { const int e = c - SSCD; dt[(size_t)row * 64 + e] = softplus_f(dtraw[(size_t)row * 64 + e] + dtb[e]); }
}
__global__ void __launch_bounds__(64) nk_ssd_scan(const float* __restrict__ xbc, const float* __restrict__ dt, const float* __restrict__ alog, const float* __restrict__ dsk, const float* __restrict__ st0  ,
                                                  float* __restrict__ y  , float* __restrict__ out, int dir) {
    const int h = blockIdx.x, seq = blockIdx.y, p = threadIdx.x, g = h >> 3;
    int r0, L; if (seq < 16) { r0 = seq * 256; L = 256; } else { r0 = TP + (seq - 16) * 1024; L = 1024; }
    const float a = -expf(alog[dir * 32 + h]), dd = dsk[dir * 32 + h];
    float hs[128];
    if (seq < 16) {
#pragma unroll
        for (int n = 0; n < 128; ++n) hs[n] = 0.f;
    } else { const float* s0 = st0 + ((((size_t)(seq - 16) * 2 + dir) * 32 + h) * 64 + p) * 128;
#pragma unroll
        for (int n = 0; n < 128; ++n) hs[n] = s0[n]; }
    for (int s = 0; s < L; ++s) {
        const int row = r0 + (dir == 0 ? s : L - 1 - s);
        const float dtv = dt[(size_t)row * 64 + dir * 32 + h], da = expf(dtv * a), xv = xbc[(size_t)row * SSCD + h * 64 + p], dtx = dtv * xv;
        const float* Bp = xbc + (size_t)row * SSCD + SSI + g * 128; const float* Cp = Bp + 512;
        float acc = 0.f;
#pragma unroll
        for (int n = 0; n < 128; ++n) { hs[n] = hs[n] * da + dtx * Bp[n]; acc += Cp[n] * hs[n]; }
        float* yp = y + (size_t)row * SSI + h * 64 + p; const float yv = acc + xv * dd; *yp = dir == 0 ? yv : *yp + yv;
    }
    if (seq < 16) { float* o = out + OUT_SSM + ((((size_t)seq * 2 + dir) * 32 + h) * 64 + p) * 128;
#pragma unroll
        for (int n = 0; n < 128; ++n) o[n] = hs[n]; }
}
__global__ void __launch_bounds__(256) nk_ssd_gate(const float* __restrict__ y, const float* __restrict__ z  , const float* __restrict__ gn, float* __restrict__ yn) {
    const int row = blockIdx.x * 4 + (threadIdx.x >> 6), lane = threadIdx.x & 63;
#pragma unroll
    for (int g = 0; g < 4; ++g) { float v[8]; float ss = 0.f;
#pragma unroll
        for (int i = 0; i < 8; ++i) { const int c = g * 512 + lane + 64 * i; v[i] = y[(size_t)row * SSI + c] * silu_f(z[(size_t)row * SSI + c]); ss += v[i] * v[i]; }
        const float r = rsqrtf(wave_sum(ss) * (1.f / 512) + EPS);
#pragma unroll
        for (int i = 0; i < 8; ++i) { const int c = g * 512 + lane + 64 * i; yn[(size_t)row * SSI + c] = v[i] * r * gn[c]; } }
}

struct In {
    const float *x_prompt, *x_sample, *cache_ckv, *cache_kpe, *state_ssm, *c, *c_ctx, *w_ada, *b_ada, *g_norm1, *g_norm2,
        *mla_w_dq, *mla_g_q, *mla_w_uq, *mla_w_dkv, *mla_g_kv, *mla_w_ukv, *mla_g_qn, *mla_g_kn, *mla_w_o,
        *cv_w_pw1, *cv_b_pw1, *cv_w_dw, *cv_b_dw, *cv_g_ln, *cv_b_ln, *cv_w_pw2, *cv_b_pw2,
        *ssd_w_in, *ssd_w_conv, *ssd_b_conv, *ssd_dt_bias, *ssd_a_log, *ssd_d, *ssd_g_norm, *ssd_w_out, *ffn_w_in, *ffn_w_out;
};

template <int GLU>
static void ngemm(hipStream_t s, const float* A, int lda, const float* B, int ldb, float* C, int ldc, int M, int N, int K, const float* bias) {
    nk_gemm<GLU><<<dim3((N + 63) / 64, M / 64), 256, 0, s>>>(A, lda, B, ldb, C, ldc, M, N, K, bias);
}

static void naive_forward(const In& I, float* out, float* ws, hipStream_t s, int start_sub) {
    size_t off = 0; auto take = [&](size_t n) { float* p = ws + off; off += (n + 255) & ~(size_t)255; return p; };
    float* mods = take(4 * 5 * 6144);
    float* h = take((size_t)T * DM);
    float* t2 = take((size_t)T * DM);
    float* latkv = take((size_t)T * 288);
    float* qn = take((size_t)T * QL);
    float* ckv = take((size_t)(T + NCTX) * KVL);
    float* dtb = take((size_t)T * 64);
    float* dtraw = take((size_t)T * 64);
    float* arena = ws + off;
    float* latq = arena; float* qraw = latq + (size_t)T * QL; float* kvraw = qraw + (size_t)T * 1536; float* Qb = kvraw + (size_t)(T + NCTX) * 2048; float* Kb = Qb + (size_t)T * 1536;
    float* t1 = arena;
    float* zb = arena; float* xpre = zb + (size_t)T * SSI; float* xbc = xpre + (size_t)T * SSCD; float* yb = xpre;
    float* x = out + OUT_YP;
    nk_adaln<<<dim3(24, 4), 256, 0, s>>>(I.c, I.c_ctx, I.w_ada, I.b_ada, mods);
    if (start_sub == 0) nk_copy_x<<<T * DM / 4 / 256, 256, 0, s>>>(I.x_prompt, I.x_sample, x);
    for (int i = start_sub / 2; i < 4; ++i) {
        const int kind = i % 3, j = i / 3; const float* ml = mods + (size_t)i * 5 * 6144;
        if (2 * i >= start_sub) {
        nk_normmod<<<T / 4, 256, 0, s>>>(x, I.g_norm1 + i * DM, ml, 0, 1024, h);
        if (kind == 0) {
            ngemm<0>(s, h, DM, I.mla_w_dq + (size_t)j * DM * QL, QL, latq, QL, T, QL, DM, nullptr);
            ngemm<0>(s, h, DM, I.mla_w_dkv + (size_t)j * DM * 288, 288, latkv, 288, T, 288, DM, nullptr);
            nk_mla_fin1<<<(T + NCTX) / 4, 256, 0, s>>>(latq, latkv, I.mla_g_q + j * QL, I.mla_g_kv + j * KVL, I.cache_ckv + (size_t)j * 65536, qn, ckv, out, j);
            ngemm<0>(s, qn, QL, I.mla_w_uq + (size_t)j * QL * 1536, 1536, qraw, 1536, T, 1536, QL, nullptr);
            ngemm<0>(s, ckv, KVL, I.mla_w_ukv + (size_t)j * KVL * 2048, 2048, kvraw, 2048, T + NCTX, 2048, KVL, nullptr);
            nk_mla_fin2<<<(T + NCTX) * 16 / 256, 256, 0, s>>>(qraw, kvraw, latkv, I.cache_kpe + (size_t)j * 8192, I.mla_g_qn + j * 96, I.mla_g_kn + j * 96, Qb, Kb);
            nk_attn<<<dim3(T / 64, 16), 64, 0, s>>>(Qb, Kb, kvraw, h);
            ngemm<0>(s, h, DM, I.mla_w_o + (size_t)j * DM * DM, DM, t2, DM, T, DM, DM, nullptr);
        } else if (kind == 1) {
            ngemm<2>(s, h, DM, I.cv_w_pw1, 2048, t1, DM, T, DM, DM, I.cv_b_pw1);
            nk_dwconv_ln<<<T / 4, 256, 0, s>>>(t1, I.cv_w_dw, I.cv_b_dw, I.cv_g_ln, I.cv_b_ln, h);
            ngemm<0>(s, h, DM, I.cv_w_pw2, DM, t2, DM, T, DM, DM, I.cv_b_pw2);
        } else {
            ngemm<0>(s, h, DM, I.ssd_w_in, SSIN, zb, SSI, T, SSI, DM, nullptr);
            ngemm<0>(s, h, DM, I.ssd_w_in + SSI, SSIN, xpre, SSCD, T, SSCD, DM, nullptr);
            ngemm<0>(s, h, DM, I.ssd_w_in + SSI + SSCD, SSIN, dtraw, 64, T, 64, DM, nullptr);
            nk_ssd_conv<<<T * 3136 / 256, 256, 0, s>>>(xpre, dtraw, I.ssd_w_conv, I.ssd_b_conv, I.ssd_dt_bias, xbc, dtb);
            nk_ssd_scan<<<dim3(32, 20), 64, 0, s>>>(xbc, dtb, I.ssd_a_log, I.ssd_d, I.state_ssm, yb, out, 0);
            nk_ssd_scan<<<dim3(32, 20), 64, 0, s>>>(xbc, dtb, I.ssd_a_log, I.ssd_d, I.state_ssm, yb, out, 1);
            nk_ssd_gate<<<T / 4, 256, 0, s>>>(yb, zb, I.ssd_g_norm, xbc);
            ngemm<0>(s, xbc, SSI, I.ssd_w_out, DM, t2, DM, T, DM, SSI, nullptr);
        }
        nk_resid<<<T * DM / 256, 256, 0, s>>>(x, t2, ml, 2048);
        }
        nk_normmod<<<T / 4, 256, 0, s>>>(x, I.g_norm2 + i * DM, ml, 3072, 4096, h);
        ngemm<1>(s, h, DM, I.ffn_w_in + (size_t)i * DM * 5632, 5632, t1, FFH, T, FFH, DM, nullptr);
        ngemm<0>(s, t1, FFH, I.ffn_w_out + (size_t)i * FFH * DM, DM, t2, DM, T, DM, FFH, nullptr);
        nk_resid<<<T * DM / 256, 256, 0, s>>>(x, t2, ml, 5120);
    }
}


__device__ __forceinline__ int olane() { int l; asm volatile("v_mbcnt_lo_u32_b32 %0, -1, 0\n\tv_mbcnt_hi_u32_b32 %0, -1, %0" : "=v"(l)); return l; }
__device__ __forceinline__ int obid() { int b = blockIdx.x; asm volatile("" : "+s"(b)); return b; }
namespace pg8 {
#define PG8_LAS __attribute__((address_space(3)))
typedef unsigned short bf16_t;
typedef short bf16x8 __attribute__((ext_vector_type(8)));
typedef float f32x4 __attribute__((ext_vector_type(4)));
typedef unsigned u32x4 __attribute__((ext_vector_type(4)));
constexpr int BM = 256, BK = 64, HALF = 128, HTB = HALF * BK * 2  , STAGE_BYTES = 8 * HTB, NXCD = 8, WGM = 8;

__host__ __device__ __forceinline__ int lds_byte(int r, int c) { const int st = (r >> 4) * 2 + (c >> 5), rr = r & 15, cc = c & 31, ob = rr * 64 + cc * 2; return st * 1024 + (ob ^ (((ob >> 9) & 1) << 5)); }
__host__ __device__ __forceinline__ void stage_rc(int b, int& R, int& C) { const int st = b / 1024, sb = b % 1024, swz = sb ^ (((sb >> 9) & 1) << 5); R = (st >> 1) * 16 + swz / 64; C = (st & 1) * 32 + (swz % 64) / 2; }
__host__ __device__ __forceinline__ int perm32(int rho) { const int n = rho >> 4, i = rho & 15; return 8 * (i >> 2) + 4 * n + (i & 3); }

struct Unit { int pm, pn; };
struct Gemm { const bf16_t* A; const bf16_t* Bt; int M, N, K; };

struct StaticOrder {
    int nM, nN, nwg, G, c;
    __host__ __device__ void init(int M, int N, int G_, int c_) { nM = M / BM; nN = N / BM; nwg = nM * nN; G = G_; c = c_; }
    __host__ __device__ bool next(int i, Unit& u) const {
        const long L = (long)i * G + c; if (L >= nwg) return false;
        int wgid = (int)L; { const int q = nwg / NXCD, r = nwg % NXCD, xcd = wgid % NXCD, off = wgid / NXCD; wgid = (xcd < r ? xcd * (q + 1) : r * (q + 1) + (xcd - r) * q) + off; }
        const int nig = WGM * nN, gid = wgid / nig, fm = gid * WGM, gsz = (nM - fm) < WGM ? (nM - fm) : WGM;
        u.pm = fm + ((wgid % nig) % gsz); u.pn = (wgid % nig) / gsz; return true;
    }
    __device__ __forceinline__ void a_ready(const Unit&) const {}
    __device__ __forceinline__ void done(const Unit&) const {}
};
__device__ __forceinline__ unsigned cvt_pk_bf16(float lo, float hi) { unsigned r; asm volatile("v_cvt_pk_bf16_f32 %0, %1, %2" : "=v"(r) : "v"(lo), "v"(hi)); return r; }
typedef unsigned u32x2 __attribute__((ext_vector_type(2)));
__device__ __forceinline__ float fast_sigmoid(float x) { return __builtin_amdgcn_rcpf(1.f + __builtin_amdgcn_exp2f(-1.4426950408889634f * x)); }

struct EpiF32 {
    static constexpr bool PERM = false, AFTER_DRAIN = false;
    float* C; int ldc;
    __device__ __forceinline__ void operator()(const f32x4 (&acc)[2][2][4][2], const Unit& u, int wr_, int wc_, int fr_, int fq_) const {
        const int t_ = olane(), wr = wr_, wc = wc_, fr = t_ & 15, fq = t_ >> 4; (void)fr_; (void)fq_;
        const int row0 = u.pm * BM + wr * 64 + fr, col0 = u.pn * BM + wc * 32 + 4 * fq;
#pragma unroll
        for (int ai = 0; ai < 2; ++ai)
#pragma unroll
            for (int m = 0; m < 4; ++m) { float* rowp = C + (size_t)(row0 + ai * HALF + m * 16) * ldc + col0;
#pragma unroll
                for (int bj = 0; bj < 2; ++bj)
#pragma unroll
                    for (int n = 0; n < 2; ++n) *(f32x4*)(rowp + bj * HALF + n * 16) = acc[ai][bj][m][n]; }
    }
};
struct EpiBf16P {
    static constexpr bool PERM = true, AFTER_DRAIN = false;
    bf16_t* O; int ldc;
    __device__ __forceinline__ void operator()(const f32x4 (&acc)[2][2][4][2], const Unit& u, int wr_, int wc_, int fr_, int fq_) const {
        const int t_ = olane(), wr = wr_, wc = wc_, fr = t_ & 15, fq = t_ >> 4; (void)fr_; (void)fq_;
        const int row0 = u.pm * BM + wr * 64 + fr, col0 = u.pn * BM + wc * 32 + 8 * fq;
#pragma unroll
        for (int ai = 0; ai < 2; ++ai)
#pragma unroll
            for (int m = 0; m < 4; ++m) { bf16_t* rowp = O + (size_t)(row0 + ai * HALF + m * 16) * ldc + col0;
#pragma unroll
                for (int bj = 0; bj < 2; ++bj) { const f32x4 v0 = acc[ai][bj][m][0], v1 = acc[ai][bj][m][1]; u32x4 w;
                    w.x = cvt_pk_bf16(v0[0], v0[1]); w.y = cvt_pk_bf16(v0[2], v0[3]); w.z = cvt_pk_bf16(v1[0], v1[1]); w.w = cvt_pk_bf16(v1[2], v1[3]);
                    *(u32x4*)(rowp + bj * HALF) = w; } }
    }
};
struct EpiSsdIn {
    static constexpr bool PERM = true, AFTER_DRAIN = false;
    bf16_t* Z; bf16_t* XP; float* DT;
    __device__ __forceinline__ void operator()(const f32x4 (&acc)[2][2][4][2], const Unit& u, int wr_, int wc_, int fr_, int fq_) const {
        const int t_ = olane(), wr = wr_, wc = wc_, fr = t_ & 15, fq = t_ >> 4; (void)fr_; (void)fq_;
        const int row0 = u.pm * BM + wr * 64 + fr;
        if (u.pn < 20) {
            bf16_t* base = u.pn < 8 ? Z : XP; const int ld = u.pn < 8 ? 2048 : 3072, colt = (u.pn < 8 ? u.pn : u.pn - 8) * BM, col0 = colt + wc * 32 + 8 * fq;
#pragma unroll
            for (int ai = 0; ai < 2; ++ai)
#pragma unroll
                for (int m = 0; m < 4; ++m) { bf16_t* rowp = base + (size_t)(row0 + ai * HALF + m * 16) * ld + col0;
#pragma unroll
                    for (int bj = 0; bj < 2; ++bj) { const f32x4 v0 = acc[ai][bj][m][0], v1 = acc[ai][bj][m][1]; u32x4 w;
                        w.x = cvt_pk_bf16(v0[0], v0[1]); w.y = cvt_pk_bf16(v0[2], v0[3]); w.z = cvt_pk_bf16(v1[0], v1[1]); w.w = cvt_pk_bf16(v1[2], v1[3]);
                        *(u32x4*)(rowp + bj * HALF) = w; } }
        } else if (wc < 2) {
#pragma unroll
            for (int ai = 0; ai < 2; ++ai)
#pragma unroll
                for (int m = 0; m < 4; ++m) { float* rp = DT + (size_t)(row0 + ai * HALF + m * 16) * 64 + wc * 32 + 8 * fq;
                    *(f32x4*)rp = acc[ai][0][m][0]; *(f32x4*)(rp + 4) = acc[ai][0][m][1]; }
        }
    }
};
template <int MODE> struct EpiGlu {
    static constexpr bool PERM = false, AFTER_DRAIN = false;
    bf16_t* O; int ldo; const float* bias; int H;
    __device__ __forceinline__ void operator()(const f32x4 (&acc)[2][2][4][2], const Unit& u, int wr_, int wc_, int fr_, int fq_) const {
        const int t_ = olane(), wr = wr_, wc = wc_, fr = t_ & 15, fq = t_ >> 4; (void)fr_; (void)fq_;
        const int row0 = u.pm * BM + wr * 64 + fr;
#pragma unroll
        for (int bj = 0; bj < 2; ++bj) {
            const int f0 = 16 * (8 * u.pn + 4 * bj + wc) + 4 * fq;
            f32x4 ba = (f32x4){0.f, 0.f, 0.f, 0.f}, bu = ba;
            if (MODE == 1) { ba = *(const f32x4*)(bias + f0); bu = *(const f32x4*)(bias + H + f0); }
#pragma unroll
            for (int ai = 0; ai < 2; ++ai)
#pragma unroll
                for (int m = 0; m < 4; ++m) { const f32x4 a = acc[ai][bj][m][0] + ba, g = acc[ai][bj][m][1] + bu; float o[4];
#pragma unroll
                    for (int j = 0; j < 4; ++j) o[j] = MODE == 0 ? a[j] * fast_sigmoid(a[j]) * g[j] : a[j] * fast_sigmoid(g[j]);
                    u32x2 w; w.x = cvt_pk_bf16(o[0], o[1]); w.y = cvt_pk_bf16(o[2], o[3]);
                    *(u32x2*)(O + (size_t)(row0 + ai * HALF + m * 16) * ldo + f0) = w; }
        }
    }
};
struct EpiResid {
    static constexpr bool PERM = false, AFTER_DRAIN = false;
    const float* xlo; const float* xhi; float* xout; const float* mods_l; int g_off; const float* bias;
    __device__ __forceinline__ void operator()(const f32x4 (&acc)[2][2][4][2], const Unit& u, int wr_, int wc_, int fr_, int fq_) const {
        const int t_ = olane(), wr = wr_, wc = wc_, fr = t_ & 15, fq = t_ >> 4; (void)fr_; (void)fq_;
        const int cond = u.pm < 16 ? 0 : 1 + ((u.pm - 16) >> 2);
        const float* gate = mods_l + (size_t)cond * 6144 + g_off; const float* xin = u.pm < 16 ? xlo : xhi;
        const int row0 = u.pm * BM + wr * 64 + fr, col0 = u.pn * BM + wc * 32 + 4 * fq;
#pragma unroll
        for (int bj = 0; bj < 2; ++bj)
#pragma unroll
            for (int n = 0; n < 2; ++n) { const int c = col0 + bj * HALF + n * 16; const f32x4 g4 = *(const f32x4*)(gate + c);
                const f32x4 b4 = bias ? *(const f32x4*)(bias + c) : (f32x4){0.f, 0.f, 0.f, 0.f};
#pragma unroll
                for (int ai = 0; ai < 2; ++ai)
#pragma unroll
                    for (int m = 0; m < 4; ++m) { const size_t off = (size_t)(row0 + ai * HALF + m * 16) * 1024 + c;
                        const f32x4 xo = *(const f32x4*)(xin + off); *(f32x4*)(xout + off) = xo + g4 * (acc[ai][bj][m][n] + b4); } }
    }
};

template <class Epi, class Sched, bool ALIGN_EPI = false, bool SP2 = false>
__device__ __forceinline__ void gemm_phase(PG8_LAS unsigned char* lds, const Gemm g, const Sched& S, const Epi& E, const int wave_in) {
    const int tid = wave_in * 64 + olane(), wid = __builtin_amdgcn_readfirstlane(tid >> 6), lane = tid & 63, wr = wid >> 2, wc = wid & 3, fr = lane & 15, fq = lane >> 4;
    const int K = g.K, nt = K / BK;
    unsigned voffA[2], voffB[2];
#pragma unroll
    for (int i = 0; i < 2; ++i) { int R, C; stage_rc(tid * 16 + i * 8192, R, C); const int Rb = Epi::PERM ? ((R & ~31) + perm32(R & 31)) : R;
        voffA[i] = (unsigned)(R * K + C) * 2u; voffB[i] = (unsigned)(Rb * K + C) * 2u; }
    const size_t kstep = (size_t)(BK * 2);
    const size_t hstep = (size_t)HALF * K * 2;
    const size_t tstep = 2 * hstep;
    const unsigned ldsw = (unsigned)wid * 1024u;
    const int aoff = lds_byte(wr * 64 + fr, fq * 8), boff = lds_byte(wc * 32 + fr, fq * 8);
#define PG8_SA(b, h) (((b) * 2 + (h)) * HTB)
#define PG8_SB(b, h) ((4 + (b) * 2 + (h)) * HTB)
#define PG8_STAGE(bufoff, gbase, voff) do { _Pragma("unroll") for (int _i = 0; _i < 2; ++_i) \
        __builtin_amdgcn_global_load_lds((const unsigned*)((const char*)(gbase) + (voff)[_i]), (PG8_LAS unsigned*)(lds + (bufoff) + ldsw + _i * 8192), 16, 0, 0); } while (0)
#define PG8_LDA(dst, b, h) do { _Pragma("unroll") for (int m = 0; m < 4; ++m) _Pragma("unroll") for (int k = 0; k < 2; ++k) dst[m][k] = *(const PG8_LAS bf16x8*)(lds + PG8_SA(b, h) + aoff + m * 2048 + k * 1024); } while (0)
#define PG8_LDB(dst, b, h) do { _Pragma("unroll") for (int n = 0; n < 2; ++n) _Pragma("unroll") for (int k = 0; k < 2; ++k) dst[n][k] = *(const PG8_LAS bf16x8*)(lds + PG8_SB(b, h) + boff + n * 2048 + k * 1024); } while (0)
#define PG8_MMA(ai, bj, At, Bt) do { __builtin_amdgcn_s_setprio(1); _Pragma("unroll") for (int m = 0; m < 4; ++m) _Pragma("unroll") for (int n = 0; n < 2; ++n) _Pragma("unroll") for (int k = 0; k < 2; ++k) \
        acc[ai][bj][m][n] = __builtin_amdgcn_mfma_f32_16x16x32_bf16(Bt[n][k], At[m][k], acc[ai][bj][m][n], 0, 0, 0); __builtin_amdgcn_s_setprio(0); } while (0)
#define PG8_WAIT_V(n) asm volatile("s_waitcnt vmcnt(" #n ")" ::: "memory")
#define PG8_WAIT_L(n) asm volatile("s_waitcnt lgkmcnt(" #n ")" ::: "memory")
#define PG8_BAR __builtin_amdgcn_s_barrier()
#define PG8_SCHED __builtin_amdgcn_sched_barrier(0)
    Unit cur, nxt; int ui = 0;
    if (!S.next(0, cur)) return;
    f32x4 acc[2][2][4][2];
#pragma unroll
    for (int a = 0; a < 2; ++a)
#pragma unroll
        for (int b = 0; b < 2; ++b)
#pragma unroll
            for (int m = 0; m < 4; ++m)
#pragma unroll
                for (int n = 0; n < 2; ++n) acc[a][b][m][n] = (f32x4){0.f, 0.f, 0.f, 0.f};
    bf16x8 At[4][2], B0[2][2], B1[2][2];
    const char* cA = (const char*)g.A + (size_t)cur.pm * tstep; const char* cB = (const char*)g.Bt + (size_t)cur.pn * tstep;
    S.a_ready(cur);
    if constexpr (SP2) {
        PG8_STAGE(PG8_SB(0, 0), cB, voffB); PG8_STAGE(PG8_SB(0, 1), cB + hstep, voffB); PG8_STAGE(PG8_SA(0, 0), cA, voffA); PG8_STAGE(PG8_SA(0, 1), cA + hstep, voffA);
        if (wr == 1) PG8_BAR;
        PG8_WAIT_V(2); PG8_BAR;
        PG8_STAGE(PG8_SB(1, 0), cB + kstep, voffB); PG8_STAGE(PG8_SA(1, 0), cA + kstep, voffA); PG8_STAGE(PG8_SB(1, 1), cB + hstep + kstep, voffB);
        PG8_WAIT_V(6); PG8_BAR;
    } else {
        PG8_STAGE(PG8_SB(0, 0), cB, voffB); PG8_STAGE(PG8_SA(0, 0), cA, voffA); PG8_STAGE(PG8_SB(0, 1), cB + hstep, voffB); PG8_STAGE(PG8_SA(0, 1), cA + hstep, voffA);
        if (wr == 1) PG8_BAR;
        PG8_WAIT_V(4); PG8_BAR;
        PG8_STAGE(PG8_SB(1, 0), cB + kstep, voffB); PG8_STAGE(PG8_SA(1, 0), cA + kstep, voffA); PG8_STAGE(PG8_SB(1, 1), cB + hstep + kstep, voffB);
        PG8_WAIT_V(6); PG8_BAR;
    }
    for (;;) {
        const bool has_next = S.next(ui + 1, nxt);
        const char* nA = has_next ? (const char*)g.A + (size_t)nxt.pm * tstep : cA; const char* nB = has_next ? (const char*)g.Bt + (size_t)nxt.pn * tstep : cB;
        for (int t = 0; t < nt; t += 2) {
            const bool last = (t == nt - 2);
            const char* a1 = cA + (size_t)(t + 1) * kstep;
            const char* a2 = last ? nA : cA + (size_t)(t + 2) * kstep; const char* b2 = last ? nB : cB + (size_t)(t + 2) * kstep;
            const char* a3 = a2 + kstep; const char* b3 = b2 + kstep;
            if (last && has_next) S.a_ready(nxt);
            if constexpr (SP2) {
            PG8_LDB(B0, 0, 0); PG8_LDB(B1, 0, 1); PG8_SCHED; PG8_LDA(At, 0, 0); PG8_STAGE(PG8_SA(1, 1), a1 + hstep, voffA);
            PG8_WAIT_V(8); PG8_WAIT_L(0); PG8_BAR; PG8_MMA(0, 0, At, B0); PG8_MMA(0, 1, At, B1); PG8_BAR; PG8_SCHED;
            PG8_LDA(At, 0, 1); PG8_STAGE(PG8_SB(0, 0), b2, voffB); PG8_STAGE(PG8_SB(0, 1), b2 + hstep, voffB); PG8_STAGE(PG8_SA(0, 0), a2, voffA);
            PG8_WAIT_V(8); PG8_WAIT_L(0); PG8_BAR; PG8_MMA(1, 0, At, B0); PG8_MMA(1, 1, At, B1); PG8_BAR; PG8_SCHED;
            PG8_LDB(B0, 1, 0); PG8_LDB(B1, 1, 1); PG8_SCHED; PG8_LDA(At, 1, 0); PG8_STAGE(PG8_SA(0, 1), a2 + hstep, voffA);
            PG8_WAIT_V(8); PG8_WAIT_L(0); PG8_BAR; PG8_MMA(0, 0, At, B0); PG8_MMA(0, 1, At, B1); PG8_BAR; PG8_SCHED;
            PG8_LDA(At, 1, 1); PG8_STAGE(PG8_SB(1, 0), b3, voffB); PG8_STAGE(PG8_SB(1, 1), b3 + hstep, voffB); PG8_STAGE(PG8_SA(1, 0), a3, voffA);
            PG8_WAIT_V(8); PG8_WAIT_L(0); PG8_BAR; PG8_MMA(1, 0, At, B0); PG8_MMA(1, 1, At, B1); PG8_BAR; PG8_SCHED;
            } else {
            PG8_LDB(B0, 0, 0); PG8_SCHED; PG8_LDA(At, 0, 0); PG8_STAGE(PG8_SA(1, 1), a1 + hstep, voffA);
            PG8_WAIT_L(8); PG8_BAR; PG8_WAIT_L(0); PG8_MMA(0, 0, At, B0); PG8_BAR; PG8_SCHED;
            PG8_LDB(B1, 0, 1); PG8_STAGE(PG8_SB(0, 0), b2, voffB);
            PG8_BAR; PG8_WAIT_L(0); PG8_MMA(0, 1, At, B1); PG8_BAR;
            PG8_LDA(At, 0, 1); PG8_STAGE(PG8_SA(0, 0), a2, voffA);
            PG8_BAR; PG8_WAIT_L(0); PG8_MMA(1, 0, At, B0); PG8_BAR; PG8_SCHED;
            PG8_STAGE(PG8_SB(0, 1), b2 + hstep, voffB);
            PG8_WAIT_V(6); PG8_BAR; PG8_MMA(1, 1, At, B1); PG8_BAR;
            PG8_LDB(B0, 1, 0); PG8_SCHED; PG8_LDA(At, 1, 0); PG8_STAGE(PG8_SA(0, 1), a2 + hstep, voffA);
            PG8_WAIT_L(8); PG8_BAR; PG8_WAIT_L(0); PG8_MMA(0, 0, At, B0); PG8_BAR; PG8_SCHED;
            PG8_LDB(B1, 1, 1); PG8_STAGE(PG8_SB(1, 0), b3, voffB);
            PG8_BAR; PG8_WAIT_L(0); PG8_MMA(0, 1, At, B1); PG8_BAR;
            PG8_LDA(At, 1, 1); PG8_STAGE(PG8_SA(1, 0), a3, voffA);
            PG8_BAR; PG8_WAIT_L(0); PG8_MMA(1, 0, At, B0); PG8_BAR; PG8_SCHED;
            PG8_STAGE(PG8_SB(1, 1), b3 + hstep, voffB);
            PG8_WAIT_V(6); PG8_BAR; PG8_MMA(1, 1, At, B1); PG8_BAR;
            }
        }
        if constexpr (ALIGN_EPI) { if (wr == 0) PG8_BAR; }
        if constexpr (!Epi::AFTER_DRAIN) { E(acc, cur, wr, wc, fr, fq); S.done(cur); }
        if (!has_next) break;
#pragma unroll
        for (int a = 0; a < 2; ++a)
#pragma unroll
            for (int b = 0; b < 2; ++b)
#pragma unroll
                for (int m = 0; m < 4; ++m)
#pragma unroll
                    for (int n = 0; n < 2; ++n) acc[a][b][m][n] = (f32x4){0.f, 0.f, 0.f, 0.f};
        cur = nxt; cA = nA; cB = nB; ++ui;
        if constexpr (ALIGN_EPI) { if (wr == 1) PG8_BAR; }
    }
    PG8_WAIT_V(0);
    if constexpr (!ALIGN_EPI) { if (wr == 0) PG8_BAR; }
    PG8_BAR;
    if constexpr (Epi::AFTER_DRAIN) { E.fused(acc, cur, wr, wc, fr, fq, lds, wid, lane); S.done(cur); }
#undef PG8_SA
#undef PG8_SB
#undef PG8_STAGE
#undef PG8_LDA
#undef PG8_LDB
#undef PG8_MMA
#undef PG8_WAIT_V
#undef PG8_WAIT_L
#undef PG8_BAR
#undef PG8_SCHED
}
}
constexpr int NWAVES = 8, NTHR = 512;
constexpr size_t MiB = 1u << 20;
constexpr size_t WS_CTL = 0, CTL_ZERO_BYTES = 1 * MiB;
constexpr size_t WS_MODS = 256 * 1024;
constexpr size_t WS_ROPE = 1 * MiB;
constexpr size_t WS_W = 2 * MiB;
constexpr size_t W_MLA = WS_W, MLA_WB = 5898240;
constexpr size_t MW_CAT = 0, MW_UQ = 1572864, MW_UKV = 2752512, MW_O = 3801088;
constexpr size_t W_CV1 = WS_W + 2 * MLA_WB, W_CV2 = W_CV1 + 4 * MiB;
constexpr size_t W_SSI = W_CV2 + 2 * MiB, W_SSO = W_SSI + 11010048;
constexpr size_t W_FF = W_SSO + 4 * MiB, FF_WB = 17301504, FW_IN = 0, FW_OUT = 11534336;
static_assert(W_FF + 4 * FF_WB <= 102 * MiB, "weights region");
constexpr size_t WS_H = 102 * MiB;
constexpr size_t WS_CKV = 118 * MiB, CKV_B = (size_t)(T + NCTX) * KVL * 2;
constexpr size_t WS_AR = 128 * MiB;
constexpr size_t A_LAT = WS_AR, A_QN = A_LAT + 24 * MiB, A_QRAW = A_QN + 6 * MiB, A_KVRAW = A_QRAW + 24 * MiB, A_QB = A_KVRAW + 36 * MiB, A_KB = A_QB + 24 * MiB, A_AO = A_KB + 27 * MiB;
constexpr size_t A_U = WS_AR, A_V = A_U + 16 * MiB;
constexpr size_t A_Z = WS_AR, A_XPRE = A_Z + 32 * MiB, A_DTRAW = A_XPRE + 48 * MiB, A_XBC = A_DTRAW + 2 * MiB, A_DT = A_XBC + 48 * MiB, A_Y = A_DT + 2 * MiB, A_YN = A_XPRE;
constexpr size_t A_ACT = WS_AR + 200 * MiB;
static_assert(A_AO + 16 * MiB <= A_ACT && A_Y + 64 * MiB <= A_ACT && A_ACT + 44 * MiB <= 384 * MiB, "arena map");
constexpr int CW_BAR = 4096;
constexpr int LDS_BYTES = 163840, RING_BYTES = 131072, MISC_OFF = 163840 - 256, PTAB_OFF_C = MISC_OFF - 512;

#define GAS __attribute__((address_space(1)))
#define LAS __attribute__((address_space(3)))
typedef unsigned short bf16;
typedef unsigned v4u __attribute__((ext_vector_type(4)));
typedef unsigned v2u __attribute__((ext_vector_type(2)));
typedef float v4f __attribute__((ext_vector_type(4)));
typedef float v2f __attribute__((ext_vector_type(2)));
typedef GAS unsigned gu32;
#define LDS_WAIT() asm volatile("s_waitcnt lgkmcnt(0)" ::: "memory")
#define VM_WAIT() asm volatile("s_waitcnt vmcnt(0)" ::: "memory")
__device__ __forceinline__ unsigned f2bf(float f) { unsigned u = __builtin_bit_cast(unsigned, f); return (u + 0x7fffu + ((u >> 16) & 1u)) >> 16; }
__device__ __forceinline__ unsigned pk2(float lo, float hi) { return f2bf(lo) | (f2bf(hi) << 16); }
__device__ __forceinline__ float bflo(unsigned u) { return __builtin_bit_cast(float, u << 16); }
__device__ __forceinline__ float bfhi(unsigned u) { return __builtin_bit_cast(float, u & 0xffff0000u); }
__device__ __forceinline__ float bf2f(bf16 b) { return __builtin_bit_cast(float, (unsigned)b << 16); }

#define XB_TMO      128
#define XB_XCNT(j)  (256  + 64 * (j))
#define XB_XSUB(j)  (1280 + 64 * (j))
#define XB_XGEN(j)  (2304 + 64 * (j))
#define XB_TOP      3328
#define XB_TOPGEN   3392
#define XCD_BAR_WORDS 3456
#define XB_SPIN_CAP (1u << 18)

__device__ __forceinline__ unsigned xb_ld(unsigned* p)              { return __hip_atomic_load(p, __ATOMIC_RELAXED, __HIP_MEMORY_SCOPE_AGENT); }
__device__ __forceinline__ unsigned xb_add(unsigned* p, unsigned v) { return __hip_atomic_fetch_add(p, v, __ATOMIC_RELAXED, __HIP_MEMORY_SCOPE_AGENT); }
__device__ __forceinline__ unsigned xb_xcc_id() { return (unsigned)__builtin_amdgcn_s_getreg((3 << 11) | 20) & 0xFu; }
#define XB_SPIN(cond, bar) do { unsigned _sp = 0; while (cond) { __builtin_amdgcn_s_sleep(1); \
    if ((++_sp & 255u) == 0u) { if (xb_ld(&(bar)[XB_TMO])) break; if (_sp > XB_SPIN_CAP) { atomicAdd(&(bar)[XB_TMO], 1u); break; } } } } while (0)

struct XcdBarrier {
    unsigned* bar; unsigned x;
    volatile LAS unsigned* st;
};

__device__ __forceinline__ XcdBarrier xcd_barrier_post(unsigned* bar, volatile LAS unsigned* st) {
    XcdBarrier b; b.bar = bar; b.x = xb_xcc_id(); b.st = st;
    if (threadIdx.x == 0) (void)xb_add(&bar[XB_XCNT(b.x)], 1u);
    return b;
}
__device__ __forceinline__ void xcd_barrier_complete(unsigned* bar, unsigned x, unsigned& nloc, unsigned& nx) {
    const unsigned G = gridDim.x * gridDim.y * gridDim.z;
    unsigned sum, cnt, mine, sp = 0u;
    for (;;) {
        sum = 0u; cnt = 0u; mine = 0u;
#pragma unroll
        for (unsigned j = 0; j < 16; ++j) { const unsigned c = xb_ld(&bar[XB_XCNT(j)]); sum += c; cnt += (c > 0u) ? 1u : 0u; mine = (j == x) ? c : mine; }
        if (sum == G) break;
        __builtin_amdgcn_s_sleep(1);
        if ((++sp & 255u) == 0u) { if (xb_ld(&bar[XB_TMO])) break; if (sp > XB_SPIN_CAP) { atomicAdd(&bar[XB_TMO], 1u); break; } }
    }
    nloc = mine > 0u ? mine : 1u; nx = cnt > 0u ? cnt : 1u;
}

__device__ __forceinline__ void xcd_barrier(const XcdBarrier& b) {
    asm volatile("s_waitcnt vmcnt(0)" ::: "memory");
    __syncthreads();
    if (threadIdx.x == 0) {
        unsigned* bar = b.bar;
        __builtin_amdgcn_s_waitcnt(0);
        unsigned nloc = b.st[0], nx = b.st[1];
        if (nloc == 0u) { xcd_barrier_complete(bar, b.x, nloc, nx); b.st[0] = nloc; b.st[1] = nx; }
        const unsigned old = xb_add(&bar[XB_XSUB(b.x)], 1u);
        const unsigned gen = old / nloc;
        if (old + 1u == (gen + 1u) * nloc) {
            __builtin_amdgcn_fence(__ATOMIC_RELEASE, "agent");
            asm volatile("s_waitcnt vmcnt(0)" ::: "memory");
            const unsigned og = xb_add(&bar[XB_TOP], 1u);
            const unsigned tg = og / nx;
            if (og + 1u == (tg + 1u) * nx) xb_add(&bar[XB_TOPGEN], 1u);
            else XB_SPIN(xb_ld(&bar[XB_TOPGEN]) == tg, bar);
            __builtin_amdgcn_fence(__ATOMIC_ACQUIRE, "agent");
            xb_add(&bar[XB_XGEN(b.x)], 1u);
            asm volatile("s_waitcnt vmcnt(0)" ::: "memory");
        } else {
            XB_SPIN(xb_ld(&bar[XB_XGEN(b.x)]) == gen, bar);
            __builtin_amdgcn_fence(__ATOMIC_ACQUIRE, "agent");
            asm volatile("s_waitcnt vmcnt(0)" ::: "memory");
        }
    }
    __syncthreads();
}

struct Frame {
    LAS unsigned char* lds; int tid, lane, wave, vcu, G, gw, NGW, bx;
    volatile LAS unsigned* PT;
};
constexpr int PT_OUT = 38, PT_WS = 39;
__device__ __forceinline__ const float* ldp(volatile LAS unsigned* PT, int k) {
    const unsigned lo = __builtin_amdgcn_readfirstlane(PT[2 * k]), hi = __builtin_amdgcn_readfirstlane(PT[2 * k + 1]);
    return (const float*)(((unsigned long long)hi << 32) | lo);
}
#define INP(k) ldp(F.PT, (k))
#define WSP ((unsigned char*)ldp(F.PT, PT_WS))
#define OUTP ((float*)ldp(F.PT, PT_OUT))
enum InIdx { I_XP = 0, I_XS, I_CCKV, I_CKPE, I_SSM, I_C, I_CCTX, I_WADA, I_BADA, I_GN1, I_GN2, I_WDQ, I_GQ, I_WUQ, I_WDKV, I_GKV, I_WUKV, I_GQN, I_GKN, I_WO,
             I_CVW1, I_CVB1, I_CVWD, I_CVBD, I_CVGL, I_CVBL, I_CVW2, I_CVB2, I_SSWI, I_SSWC, I_SSBC, I_SSDTB, I_SSAL, I_SSD, I_SSGN, I_SSWO, I_FFWI, I_FFWO };
__device__ __forceinline__ float shx(float v, int lane, int o) { return __builtin_bit_cast(float, __builtin_amdgcn_ds_bpermute((lane ^ o) << 2, __builtin_bit_cast(int, v))); }
__device__ __forceinline__ float wsum(float v, int lane) {
#pragma unroll
    for (int o = 1; o < 64; o <<= 1) v += shx(v, lane, o);
    return v;
}
constexpr float QSCALE = 0.10206207261596577f * 1.4426950408889634f;

__device__ __forceinline__ void p0_transpose_item(const float* W, int K, int N, bf16* WT, int mode, int H, int row_off, LAS float* scr, int item, int lane) {
    const int nblk = N / 32, kb = item / nblk, nb = item % nblk, k0 = 64 * kb, n0 = 32 * nb;
#pragma unroll 8
    for (int i = 0; i < 32; ++i) { const int kk = 2 * i + (lane >> 5); scr[kk * 33 + (lane & 31)] = W[(size_t)(k0 + kk) * N + n0 + (lane & 31)]; }
    LDS_WAIT(); asm volatile("" ::: "memory");
    const int c = lane & 7;
#pragma unroll
    for (int j = 0; j < 4; ++j) { const int n = (lane >> 3) + 8 * j, col = n0 + n; const LAS float* s = scr + (8 * c) * 33 + n;
        int drow;
        if (mode == 0) drow = row_off + col;
        else { const int f = col < H ? col : col - H; drow = 32 * (f >> 4) + (f & 15) + (col < H ? 0 : 16); }
        v4u o; o.x = pk2(s[0 * 33], s[1 * 33]); o.y = pk2(s[2 * 33], s[3 * 33]); o.z = pk2(s[4 * 33], s[5 * 33]); o.w = pk2(s[6 * 33], s[7 * 33]);
        *(GAS v4u*)(WT + (size_t)drow * K + k0 + 8 * c) = o; }
    LDS_WAIT(); asm volatile("" ::: "memory");
}
__device__ __forceinline__ void p0_job(int q, int& inp, size_t& soff, int& K, int& N, size_t& doff, int& mode, int& H, int& roff) {
    mode = 0; H = 0; roff = 0; soff = 0;
    if (q < 10) { const int j = q / 5, t = q % 5; const size_t wb = W_MLA + (size_t)j * MLA_WB;
        if (t == 0) { inp = I_WDQ; soff = (size_t)j * 1024 * 384; K = 1024; N = 384; doff = wb + MW_CAT; }
        else if (t == 1) { inp = I_WDKV; soff = (size_t)j * 1024 * 288; K = 1024; N = 288; doff = wb + MW_CAT; roff = 384; }
        else if (t == 2) { inp = I_WUQ; soff = (size_t)j * 384 * 1536; K = 384; N = 1536; doff = wb + MW_UQ; }
        else if (t == 3) { inp = I_WUKV; soff = (size_t)j * 256 * 2048; K = 256; N = 2048; doff = wb + MW_UKV; }
        else { inp = I_WO; soff = (size_t)j * 1024 * 1024; K = 1024; N = 1024; doff = wb + MW_O; } }
    else if (q == 10) { inp = I_CVW1; K = 1024; N = 2048; doff = W_CV1; mode = 1; H = 1024; }
    else if (q == 11) { inp = I_CVW2; K = 1024; N = 1024; doff = W_CV2; }
    else if (q == 12) { inp = I_SSWI; K = 1024; N = 5184; doff = W_SSI; }
    else if (q == 13) { inp = I_SSWO; K = 2048; N = 1024; doff = W_SSO; }
    else { const int l = (q - 14) >> 1, t = (q - 14) & 1;
        if (t == 0) { inp = I_FFWI; soff = (size_t)l * 1024 * 5632; K = 1024; N = 5632; doff = W_FF + (size_t)l * FF_WB + FW_IN; mode = 1; H = 2816; }
        else { inp = I_FFWO; soff = (size_t)l * 2816 * 1024; K = 2816; N = 1024; doff = W_FF + (size_t)l * FF_WB + FW_OUT; } }
}
constexpr int P0_NITEMS = 2 * ((1024 / 64) * (384 / 32) + (1024 / 64) * (288 / 32) + (384 / 64) * (1536 / 32) + (256 / 64) * (2048 / 32) + (1024 / 64) * (1024 / 32))
                        + (1024 / 64) * (2048 / 32) + (1024 / 64) * (1024 / 32) + (1024 / 64) * (5184 / 32) + (2048 / 64) * (1024 / 32)
                        + 4 * ((1024 / 64) * (5632 / 32) + (2816 / 64) * (1024 / 32));
__device__ __forceinline__ void p0_prologue(Frame& F) {
    unsigned char* ws = WSP;
    LAS float* s = (LAS float*)F.lds;
    for (int i = F.tid; i < 5 * 1024; i += NTHR) { const int cc = i >> 10, k = i & 1023; const float v = cc == 0 ? INP(I_CCTX)[k] : INP(I_C)[(cc - 1) * 1024 + k]; s[i] = v / (1.f + expf(-v)); }
    __syncthreads();
    float* mods = (float*)(ws + WS_MODS);
    for (int it = F.bx; it < 768; it += F.G) {
        const int l = it / 192, r = it % 192, cb = r / 16, ks = r % 16, n = cb * 512 + F.tid;
        const float* W = INP(I_WADA) + (size_t)l * 1024 * 6144 + (size_t)(ks * 64) * 6144 + n;
        float acc[5] = {0.f, 0.f, 0.f, 0.f, 0.f};
#pragma unroll 16
        for (int k = 0; k < 64; ++k) { const float wv = W[(size_t)k * 6144];
#pragma unroll
            for (int cc = 0; cc < 5; ++cc) acc[cc] += s[cc * 1024 + ks * 64 + k] * wv; }
        const float bb = ks == 0 ? INP(I_BADA)[l * 6144 + n] : 0.f;
#pragma unroll
        for (int cc = 0; cc < 5; ++cc) atomicAdd(&mods[((size_t)l * 5 + cc) * 6144 + n], acc[cc] + bb);
    }
    __syncthreads();
    LAS float* scr = (LAS float*)(F.lds + F.wave * 8448);
    for (int it = F.gw; it < P0_NITEMS; it += F.NGW) {
        int r = it, inp = 0, K = 64, N = 32, mode = 0, H = 0, roff = 0; size_t soff = 0, doff = 0;
#pragma unroll 1
        for (int q = 0; q < 22; ++q) { p0_job(q, inp, soff, K, N, doff, mode, H, roff); const int ni = (K / 64) * (N / 32); if (r < ni) break; r -= ni; }
        p0_transpose_item(INP(inp) + soff, K, N, (bf16*)(ws + doff), mode, H, roff, scr, r, F.lane);
    }
    for (int it = F.gw; it < 384; it += F.NGW) {
        bf16* rowp = it < 192 ? (bf16*)(ws + W_MLA + (it / 96) * MLA_WB + MW_CAT) + (size_t)(672 + it % 96) * 1024 : (bf16*)(ws + W_SSI) + (size_t)(5184 + it - 192) * 1024;
        const v4u z = {0u, 0u, 0u, 0u}; ((GAS v4u*)rowp)[F.lane] = z; ((GAS v4u*)rowp)[64 + F.lane] = z;
    }
    for (int it = F.gw; it < 2048; it += F.NGW) {
        const int j = it >> 10, rr = it & 1023, b = rr >> 8, sq = rr & 255;
        const v4f v = ((const GAS v4f*)(INP(I_CCKV) + (((size_t)b * 2 + j) * 256 + sq) * 256))[F.lane];
        v2u o; o.x = pk2(v.x, v.y); o.y = pk2(v.z, v.w);
        ((GAS v2u*)((bf16*)(ws + WS_CKV + j * CKV_B) + (size_t)(T + rr) * 256))[F.lane] = o;
    }
    if (F.bx == 0) for (int i = F.tid; i < 640; i += NTHR) { const int pos = i >> 3, fi = i & 7; const float p = (float)(pos < 16 ? pos : pos - 16);
        const float a = p * rope_inv(fi); float* tab = (float*)(ws + WS_ROPE); tab[2 * i] = cosf(a); tab[2 * i + 1] = sinf(a); }
}

__device__ __forceinline__ void rp_normmod(Frame& F, const float* xlo, const float* xhi, const float* g, const float* mods_l, int sh_off, int sc_off, bf16* h) {
    for (int row = F.gw; row < T; row += F.NGW) {
        const GAS v4f* xr = (const GAS v4f*)((row < TP ? xlo : xhi) + (size_t)row * 1024) + F.lane;
        v4f v[4]; float ss = 0.f;
#pragma unroll
        for (int j = 0; j < 4; ++j) { v[j] = xr[64 * j]; ss += (v[j].x * v[j].x + v[j].y * v[j].y) + (v[j].z * v[j].z + v[j].w * v[j].w); }
        const float r = rsqrtf(wsum(ss, F.lane) * (1.f / 1024) + EPS);
        const float* m = mods_l + (size_t)cond_of_row(row) * 6144;
#pragma unroll
        for (int j = 0; j < 4; ++j) { const int c = 4 * F.lane + 256 * j;
            const v4f g4 = *(const v4f*)(g + c), sc = *(const v4f*)(m + sc_off + c), sh = *(const v4f*)(m + sh_off + c);
            const v4f o = v[j] * r * g4 * (sc + 1.f) + sh; v2u w; w.x = pk2(o.x, o.y); w.y = pk2(o.z, o.w);
            *(GAS v2u*)(h + (size_t)row * 1024 + c) = w; }
    }
}
__device__ __forceinline__ void rp_mla_fin1(Frame& F, const float* lat, const float* gq, const float* gkv, bf16* qn, bf16* ckv, float* out, int j) {
    for (int row = F.gw; row < T; row += F.NGW) {
        const float* lr = lat + (size_t)row * 768;
        v2f q[3]; float ss = 0.f;
#pragma unroll
        for (int i = 0; i < 3; ++i) { q[i] = *(const GAS v2f*)(lr + 2 * F.lane + 128 * i); ss += q[i].x * q[i].x + q[i].y * q[i].y; }
        float r = rsqrtf(wsum(ss, F.lane) * (1.f / 384) + EPS);
#pragma unroll
        for (int i = 0; i < 3; ++i) { const int c = 2 * F.lane + 128 * i; *(GAS unsigned*)(qn + (size_t)row * 384 + c) = pk2(q[i].x * r * gq[c], q[i].y * r * gq[c + 1]); }
        v2f k[2]; ss = 0.f;
#pragma unroll
        for (int i = 0; i < 2; ++i) { k[i] = *(const GAS v2f*)(lr + 384 + 2 * F.lane + 128 * i); ss += k[i].x * k[i].x + k[i].y * k[i].y; }
        r = rsqrtf(wsum(ss, F.lane) * (1.f / 256) + EPS);
#pragma unroll
        for (int i = 0; i < 2; ++i) { const int c = 2 * F.lane + 128 * i; const float c0 = k[i].x * r * gkv[c], c1 = k[i].y * r * gkv[c + 1];
            *(GAS unsigned*)(ckv + (size_t)row * 256 + c) = pk2(c0, c1);
            if (row < TP) { v2f o; o.x = c0; o.y = c1; *(GAS v2f*)(out + OUT_CKV + (((size_t)(row >> 8) * 2 + j) * 256 + (row & 255)) * 256 + c) = o; } }
        if (row < TP && F.lane < 32) out[OUT_KPE + (((size_t)(row >> 8) * 2 + j) * 256 + (row & 255)) * 32 + F.lane] = lr[640 + F.lane];
    }
}
__device__ __forceinline__ void rope32_tab(float* pe, int t, const float* tab) {
    const v2f* tr = (const v2f*)tab + (t >> 6) * 8; const v2f* tc = (const v2f*)tab + (16 + (t & 63)) * 8;
#pragma unroll
    for (int i = 0; i < 8; ++i) {
        v2f cs = tr[i]; float x1 = pe[i], x2 = pe[i + 8]; pe[i] = x1 * cs.x - x2 * cs.y; pe[i + 8] = x2 * cs.x + x1 * cs.y;
        cs = tc[i]; x1 = pe[16 + i]; x2 = pe[24 + i]; pe[16 + i] = x1 * cs.x - x2 * cs.y; pe[24 + i] = x2 * cs.x + x1 * cs.y;
    }
}
__device__ __forceinline__ void ld8(const bf16* p, float* d) { const v4u w = *(const GAS v4u*)p; d[0] = bflo(w.x); d[1] = bfhi(w.x); d[2] = bflo(w.y); d[3] = bfhi(w.y); d[4] = bflo(w.z); d[5] = bfhi(w.z); d[6] = bflo(w.w); d[7] = bfhi(w.w); }
__device__ __forceinline__ void st8(bf16* p, const float* d) { v4u w; w.x = pk2(d[0], d[1]); w.y = pk2(d[2], d[3]); w.z = pk2(d[4], d[5]); w.w = pk2(d[6], d[7]); *(GAS v4u*)p = w; }
__device__ __forceinline__ void rp_mla_fin2(Frame& F, const bf16* qraw, const bf16* kvraw, const float* lat, const float* ckpe_j, const float* gqn, const float* gkn, const float* tab, bf16* Q, bf16* K) {
    for (int idx = F.bx * NTHR + F.tid; idx < T * 32; idx += F.G * NTHR) {
        const int row = idx >> 5, hd = (idx >> 1) & 15, hf = idx & 1; const bool latent = row >= TP; const int tl = (row - TP) & 1023;
        float v[48]; float ss = 0.f;
#pragma unroll
        for (int i = 0; i < 6; ++i) ld8(qraw + (size_t)row * 1536 + hd * 96 + hf * 48 + 8 * i, v + 8 * i);
#pragma unroll
        for (int d = 0; d < 48; ++d) ss += v[d] * v[d];
        ss += shx(ss, F.lane, 1);
        const float r = rsqrtf(ss * (1.f / 96) + EPS) * QSCALE;
#pragma unroll
        for (int d = 0; d < 48; ++d) v[d] = v[d] * r * gqn[hf * 48 + d];
        if (latent && hf) rope32_tab(v + 16, tl, tab);
#pragma unroll
        for (int i = 0; i < 6; ++i) st8(Q + ((size_t)row * 16 + hd) * 96 + hf * 48 + 8 * i, v + 8 * i);
    }
    asm volatile("" ::: "memory");
    for (int idx = F.bx * NTHR + F.tid; idx < (T + NCTX) * 32; idx += F.G * NTHR) {
        const int row = idx >> 5, hd = (idx >> 1) & 15, hf = idx & 1; const bool latent = row >= TP && row < T; const int tl = (row - TP) & 1023;
        float v[48]; float ss = 0.f;
        if (hf == 0) {
#pragma unroll
            for (int i = 0; i < 6; ++i) ld8(kvraw + (size_t)row * 2048 + hd * 128 + 8 * i, v + 8 * i);
        } else {
#pragma unroll
            for (int i = 0; i < 2; ++i) ld8(kvraw + (size_t)row * 2048 + hd * 128 + 48 + 8 * i, v + 8 * i);
            const float* kp = row < T ? lat + (size_t)row * 768 + 640 : ckpe_j + ((size_t)((row - T) >> 8) * 2 * 256 + ((row - T) & 255)) * 32;
#pragma unroll
            for (int i = 0; i < 8; ++i) { const v4f p4 = *(const GAS v4f*)(kp + 4 * i); v[16 + 4 * i] = p4.x; v[17 + 4 * i] = p4.y; v[18 + 4 * i] = p4.z; v[19 + 4 * i] = p4.w; }
        }
#pragma unroll
        for (int d = 0; d < 48; ++d) ss += v[d] * v[d];
        ss += shx(ss, F.lane, 1);
        const float r = rsqrtf(ss * (1.f / 96) + EPS);
#pragma unroll
        for (int d = 0; d < 48; ++d) v[d] = v[d] * r * gkn[hf * 48 + d];
        if (latent && hf) rope32_tab(v + 16, tl, tab);
#pragma unroll
        for (int i = 0; i < 6; ++i) st8(K + ((size_t)row * 16 + hd) * 96 + hf * 48 + 8 * i, v + 8 * i);
    }
}
__device__ __forceinline__ void rp_dwconv(Frame& F, const bf16* u, const float* wdw, const float* bdw, const float* gln, const float* bln, bf16* vout) {
    for (int row = F.gw; row < T; row += F.NGW) {
        int t, L; row_pos(row, t, L);
        float y[16];
#pragma unroll
        for (int hseg = 0; hseg < 2; ++hseg) { const int c0 = 512 * hseg + 8 * F.lane;
#pragma unroll
            for (int i = 0; i < 8; ++i) y[8 * hseg + i] = bdw[c0 + i];
            for (int k = 0; k < 31; ++k) { const int tt = t + k - 15; if (tt < 0 || tt >= L) continue;
                float uu[8]; ld8(u + (size_t)(row + k - 15) * 1024 + c0, uu);
                const v4f w0 = *(const GAS v4f*)(wdw + k * 1024 + c0), w1 = *(const GAS v4f*)(wdw + k * 1024 + c0 + 4);
                y[8 * hseg + 0] += uu[0] * w0.x; y[8 * hseg + 1] += uu[1] * w0.y; y[8 * hseg + 2] += uu[2] * w0.z; y[8 * hseg + 3] += uu[3] * w0.w;
                y[8 * hseg + 4] += uu[4] * w1.x; y[8 * hseg + 5] += uu[5] * w1.y; y[8 * hseg + 6] += uu[6] * w1.z; y[8 * hseg + 7] += uu[7] * w1.w; } }
        float s = 0.f;
#pragma unroll
        for (int i = 0; i < 16; ++i) s += y[i];
        const float mean = wsum(s, F.lane) * (1.f / 1024); float q = 0.f;
#pragma unroll
        for (int i = 0; i < 16; ++i) { y[i] -= mean; q += y[i] * y[i]; }
        const float r = rsqrtf(wsum(q, F.lane) * (1.f / 1024) + EPS);
#pragma unroll
        for (int hseg = 0; hseg < 2; ++hseg) { const int c0 = 512 * hseg + 8 * F.lane; float o[8];
#pragma unroll
            for (int i = 0; i < 8; ++i) { const float z = y[8 * hseg + i] * r * gln[c0 + i] + bln[c0 + i]; o[i] = z / (1.f + __expf(-z)); }
            st8(vout + (size_t)row * 1024 + c0, o); }
    }
}
__device__ __forceinline__ void rp_ssd_conv(Frame& F, const bf16* xpre, const float* dtraw, const float* wc, const float* bc, const float* dtb, bf16* xbc, float* dt) {
    for (int idx = F.bx * NTHR + F.tid; idx < T * 392; idx += F.G * NTHR) {
        const int row = idx / 392, cg = idx % 392;
        if (cg < 384) { const int c0 = 8 * cg; int t, L; row_pos(row, t, L);
            float a[8];
#pragma unroll
            for (int i = 0; i < 8; ++i) a[i] = bc[c0 + i];
#pragma unroll
            for (int k = 0; k < 5; ++k) { const int tt = t + k - 2; if (tt < 0 || tt >= L) continue;
                float xx[8]; ld8(xpre + (size_t)(row + k - 2) * 3072 + c0, xx);
#pragma unroll
                for (int i = 0; i < 8; ++i) a[i] += xx[i] * wc[k * 3072 + c0 + i]; }
#pragma unroll
            for (int i = 0; i < 8; ++i) a[i] = a[i] / (1.f + __expf(-a[i]));
            st8(xbc + (size_t)row * 3072 + c0, a);
        } else { const int e0 = 8 * (cg - 384);
#pragma unroll
            for (int i = 0; i < 8; ++i) dt[(size_t)row * 64 + e0 + i] = softplus_f(dtraw[(size_t)row * 64 + e0 + i] + dtb[e0 + i]); }
    }
}
__device__ __forceinline__ void rp_ssd_gate(Frame& F, const float* y, const bf16* z, const float* gn, bf16* yn) {
    for (int row = F.gw; row < T; row += F.NGW) {
#pragma unroll
        for (int g = 0; g < 4; ++g) { const int c0 = g * 512 + 8 * F.lane; float zz[8], v[8]; ld8(z + (size_t)row * 2048 + c0, zz);
            const v4f y0 = *(const GAS v4f*)(y + (size_t)row * 2048 + c0), y1 = *(const GAS v4f*)(y + (size_t)row * 2048 + c0 + 4);
            v[0] = y0.x; v[1] = y0.y; v[2] = y0.z; v[3] = y0.w; v[4] = y1.x; v[5] = y1.y; v[6] = y1.z; v[7] = y1.w; float ss = 0.f;
#pragma unroll
            for (int i = 0; i < 8; ++i) { v[i] = v[i] * zz[i] / (1.f + __expf(-zz[i])); ss += v[i] * v[i]; }
            const float r = rsqrtf(wsum(ss, F.lane) * (1.f / 512) + EPS);
#pragma unroll
            for (int i = 0; i < 8; ++i) v[i] = v[i] * r * gn[c0 + i];
            st8(yn + (size_t)row * 2048 + c0, v); }
    }
}

typedef short a_bf16x8 __attribute__((ext_vector_type(8)));
typedef short a_s16x4 __attribute__((ext_vector_type(4)));
typedef float a_f32x16 __attribute__((ext_vector_type(16)));
typedef float a_f32x2 __attribute__((ext_vector_type(2))); typedef __bf16 a_bf16x2 __attribute__((ext_vector_type(2)));
__device__ __forceinline__ unsigned a_cvtpk(float lo, float hi) { a_f32x2 v = {lo, hi}; a_bf16x2 b = __builtin_convertvector(v, a_bf16x2); return __builtin_bit_cast(unsigned, b); }
__device__ __forceinline__ a_s16x4 a_vtr(const LAS unsigned char* p) { return __builtin_bit_cast(a_s16x4, __builtin_amdgcn_ds_read_tr16_b64_v4i16((LAS a_s16x4*)p)); }
constexpr int AT_KS = 208, AT_VS = 192, AT_KB = 64 * AT_KS, AT_VB = 64 * AT_VS, AT_VOFF = 2 * AT_KB;
__device__ __forceinline__ void ph_attn(Frame& F, const bf16* Q, const bf16* K, const bf16* KV, bf16* AO) {
    const int lane = F.lane, r32 = lane & 31, hi = lane >> 5, wave = F.wave, tid = F.tid;
    LAS unsigned char* lds = F.lds;
    const int kr_a = tid / 12, kp_a = tid % 12, kr_b = (tid + 512) / 12, kp_b = (tid + 512) % 12, vr = tid >> 3, vp = tid & 7;
    const bool has_b = tid < 256;
    for (int uu = F.vcu; uu < 512; uu += F.G) {
        int head, q0, NT, kbase_ctx, kbase_lat;
        if (uu < 256) { const int seq = uu >> 4; head = uu & 15; q0 = seq * 256; NT = 4; kbase_ctx = seq * 256; kbase_lat = 0; }
        else { const int u2 = uu - 256, b = u2 >> 6, qb = u2 & 3; head = (u2 >> 2) & 15; q0 = TP + b * 1024 + qb * 256; NT = 20; kbase_ctx = T + b * 256; kbase_lat = TP + b * 1024; }
        a_bf16x8 qf[6];
        { const bf16* qp = Q + ((size_t)(q0 + wave * 32 + r32) * 16 + head) * 96 + hi * 8;
#pragma unroll
          for (int s = 0; s < 6; ++s) qf[s] = *(const GAS a_bf16x8*)(qp + 16 * s); }
        a_f32x16 o0, o1;
#pragma unroll
        for (int r = 0; r < 16; ++r) { o0[r] = 0.f; o1[r] = 0.f; }
        float m = -INFINITY, l = 0.f;
        v4u ka, kb2, vv;
#define AT_LOAD(t) do { const int kr0_ = (t) < 4 ? kbase_ctx + 64 * (t) : kbase_lat + 64 * ((t) - 4); \
            ka = *(const GAS v4u*)(K + ((size_t)(kr0_ + kr_a) * 16 + head) * 96 + kp_a * 8); \
            if (has_b) kb2 = *(const GAS v4u*)(K + ((size_t)(kr0_ + kr_b) * 16 + head) * 96 + kp_b * 8); \
            vv = *(const GAS v4u*)(KV + (size_t)(kr0_ + vr) * 2048 + head * 128 + 64 + vp * 8); } while (0)
#define AT_STORE(buf) do { *(LAS v4u*)(lds + (buf) * AT_KB + kr_a * AT_KS + kp_a * 16) = ka; \
            if (has_b) *(LAS v4u*)(lds + (buf) * AT_KB + kr_b * AT_KS + kp_b * 16) = kb2; \
            *(LAS v4u*)(lds + AT_VOFF + (buf) * AT_VB + vr * AT_VS + vp * 16) = vv; } while (0)
        AT_LOAD(0); AT_STORE(0);
        __syncthreads();
        for (int t = 0; t < NT; ++t) {
            const int buf = t & 1;
            if (t + 1 < NT) AT_LOAD(t + 1);
            a_f32x16 p0, p1;
#pragma unroll
            for (int r = 0; r < 16; ++r) { p0[r] = 0.f; p1[r] = 0.f; }
            { const LAS unsigned char* kp = lds + buf * AT_KB + r32 * AT_KS + hi * 16;
#pragma unroll
              for (int s = 0; s < 6; ++s) { const a_bf16x8 a0 = *(const LAS a_bf16x8*)(kp + 32 * s), a1 = *(const LAS a_bf16x8*)(kp + 32 * AT_KS + 32 * s);
                  p0 = __builtin_amdgcn_mfma_f32_32x32x16_bf16(a0, qf[s], p0, 0, 0, 0); p1 = __builtin_amdgcn_mfma_f32_32x32x16_bf16(a1, qf[s], p1, 0, 0, 0); } }
            float mx = fmaxf(p0[0], p1[0]);
#pragma unroll
            for (int r = 1; r < 16; ++r) mx = fmaxf(mx, fmaxf(p0[r], p1[r]));
            mx = fmaxf(mx, shx(mx, lane, 32));
            const float mn = fmaxf(m, mx), alpha = __builtin_amdgcn_exp2f(m - mn); m = mn;
            float ps = 0.f;
#pragma unroll
            for (int r = 0; r < 16; ++r) { p0[r] = __builtin_amdgcn_exp2f(p0[r] - mn); p1[r] = __builtin_amdgcn_exp2f(p1[r] - mn); ps += p0[r] + p1[r]; }
            l = l * alpha + ps;
#pragma unroll
            for (int r = 0; r < 16; ++r) { o0[r] *= alpha; o1[r] *= alpha; }
            v4u pw[4];
            pw[0] = (v4u){a_cvtpk(p0[0], p0[1]), a_cvtpk(p0[2], p0[3]), a_cvtpk(p0[4], p0[5]), a_cvtpk(p0[6], p0[7])};
            pw[1] = (v4u){a_cvtpk(p0[8], p0[9]), a_cvtpk(p0[10], p0[11]), a_cvtpk(p0[12], p0[13]), a_cvtpk(p0[14], p0[15])};
            pw[2] = (v4u){a_cvtpk(p1[0], p1[1]), a_cvtpk(p1[2], p1[3]), a_cvtpk(p1[4], p1[5]), a_cvtpk(p1[6], p1[7])};
            pw[3] = (v4u){a_cvtpk(p1[8], p1[9]), a_cvtpk(p1[10], p1[11]), a_cvtpk(p1[12], p1[13]), a_cvtpk(p1[14], p1[15])};
            { const LAS unsigned char* vp0 = lds + AT_VOFF + buf * AT_VB + (4 * hi + ((lane & 15) >> 2)) * AT_VS + (16 * ((lane >> 4) & 1) + 4 * (lane & 3)) * 2;
#pragma unroll
              for (int bs = 0; bs < 4; ++bs) {
                  const LAS unsigned char* vq = vp0 + (16 * bs) * AT_VS;
                  const a_s16x4 l0 = a_vtr(vq), h0 = a_vtr(vq + 8 * AT_VS), l1 = a_vtr(vq + 64), h1 = a_vtr(vq + 8 * AT_VS + 64);
                  const a_bf16x8 v0 = (a_bf16x8){l0[0], l0[1], l0[2], l0[3], h0[0], h0[1], h0[2], h0[3]}, v1 = (a_bf16x8){l1[0], l1[1], l1[2], l1[3], h1[0], h1[1], h1[2], h1[3]};
                  const a_bf16x8 pb = __builtin_bit_cast(a_bf16x8, pw[bs]);
                  o0 = __builtin_amdgcn_mfma_f32_32x32x16_bf16(v0, pb, o0, 0, 0, 0); o1 = __builtin_amdgcn_mfma_f32_32x32x16_bf16(v1, pb, o1, 0, 0, 0); } }
            if (t + 1 < NT) AT_STORE(buf ^ 1);
            __syncthreads();
        }
#undef AT_LOAD
#undef AT_STORE
        l += shx(l, lane, 32);
        const float il = 1.f / l;
        bf16* op = AO + (size_t)(q0 + wave * 32 + r32) * 1024 + head * 64 + 4 * hi;
#pragma unroll
        for (int g4 = 0; g4 < 4; ++g4) {
            v2u w0; w0.x = a_cvtpk(o0[4 * g4] * il, o0[4 * g4 + 1] * il); w0.y = a_cvtpk(o0[4 * g4 + 2] * il, o0[4 * g4 + 3] * il); *(GAS v2u*)(op + 8 * g4) = w0;
            v2u w1; w1.x = a_cvtpk(o1[4 * g4] * il, o1[4 * g4 + 1] * il); w1.y = a_cvtpk(o1[4 * g4 + 2] * il, o1[4 * g4 + 3] * il); *(GAS v2u*)(op + 32 + 8 * g4) = w1; }
    }
}
constexpr int SC_ST = 272, SC_XS = 144;
constexpr int SC_C = 0, SC_B = 128 * SC_ST, SC_M = 2 * 128 * SC_ST, SC_H = 3 * 128 * SC_ST, SC_X = SC_H + 64 * SC_ST, SC_XW = SC_X + 128 * SC_XS, SC_ARR = SC_XW + 128 * SC_XS;
static_assert(SC_ARR + 4 * 128 * 4 + 16 <= PTAB_OFF_C, "scan LDS map");
__device__ __forceinline__ int a_crow(int r, int hi) { return (r & 3) + 8 * (r >> 2) + 4 * hi; }
__device__ __forceinline__ void ph_scan(Frame& F, const bf16* xbc, const float* dt, const float* alog, const float* dsk, const float* st0, float* y, float* out) {
    const int lane = F.lane, r32 = lane & 31, hi = lane >> 5, wave = F.wave, tid = F.tid;
    LAS unsigned char* lds = F.lds;
    LAS float* acum = (LAS float*)(lds + SC_ARR); LAS float* wj = acum + 128; LAS float* ei = acum + 256; LAS float* dtj = acum + 384; LAS float* misc = acum + 512;
    const int q4 = (lane & 15) >> 2, gg = (lane >> 4) & 1, p4 = lane & 3;
    const int ib = wave >> 1, pb = wave & 1, nb = wave >> 1;
    for (int slot = F.vcu; slot < 256; slot += F.G) {
        const int nitem = slot < 128 ? 1 : 4;
#pragma unroll 1
        for (int ii = 0; ii < nitem; ++ii) {
            int seq, hd;
            if (slot < 128) { seq = 16 + (slot >> 5); hd = slot & 31; } else { const int pi = 4 * (slot - 128) + ii; seq = pi >> 5; hd = pi & 31; }
            const int g = hd >> 3, r0 = seq < 16 ? seq * 256 : TP + (seq - 16) * 1024, nc = seq < 16 ? 2 : 8;
#pragma unroll 1
            for (int dir = 0; dir < 2; ++dir) {
                const float aa = -expf(alog[dir * 32 + hd]), dd = dsk[dir * 32 + hd];
                a_f32x16 hacc;
                if (seq < 16) {
#pragma unroll
                    for (int r = 0; r < 16; ++r) hacc[r] = 0.f;
                } else { const float* s0 = st0 + ((((size_t)(seq - 16) * 2 + dir) * 32 + hd) * 64 + 32 * pb + r32) * 128 + 32 * nb + 4 * hi;
#pragma unroll
                    for (int g4 = 0; g4 < 4; ++g4) { const v4f t4 = *(const GAS v4f*)(s0 + 8 * g4); hacc[4 * g4] = t4.x; hacc[4 * g4 + 1] = t4.y; hacc[4 * g4 + 2] = t4.z; hacc[4 * g4 + 3] = t4.w; } }
#pragma unroll
                for (int g4 = 0; g4 < 4; ++g4) { v2u w; w.x = a_cvtpk(hacc[4 * g4], hacc[4 * g4 + 1]); w.y = a_cvtpk(hacc[4 * g4 + 2], hacc[4 * g4 + 3]);
                    *(LAS v2u*)(lds + SC_H + (32 * pb + r32) * SC_ST + (32 * nb + 8 * g4 + 4 * hi) * 2) = w; }
#pragma unroll 1
                for (int cc = 0; cc < nc; ++cc) {
                    const int c = dir == 0 ? cc : nc - 1 - cc, row0 = r0 + c * 128;
                    __syncthreads();
                    v4u cr[4], br[4], xr[2];
#pragma unroll
                    for (int k = 0; k < 4; ++k) { const int q = tid + 512 * k, rr = q >> 4, pp = q & 15;
                        cr[k] = *(const GAS v4u*)(xbc + (size_t)(row0 + rr) * 3072 + 2560 + g * 128 + pp * 8); br[k] = *(const GAS v4u*)(xbc + (size_t)(row0 + rr) * 3072 + 2048 + g * 128 + pp * 8); }
#pragma unroll
                    for (int k = 0; k < 2; ++k) { const int q = tid + 512 * k, rr = q >> 3, pp = q & 7; xr[k] = *(const GAS v4u*)(xbc + (size_t)(row0 + rr) * 3072 + hd * 64 + pp * 8); }
                    if (wave == 0) {
                        const int i0 = dir == 0 ? lane : 127 - lane, i1 = dir == 0 ? lane + 64 : 63 - lane;
                        const float d0 = dt[(size_t)(row0 + i0) * 64 + dir * 32 + hd], d1 = dt[(size_t)(row0 + i1) * 64 + dir * 32 + hd];
                        float s0 = d0 * aa, s1 = d1 * aa;
#pragma unroll
                        for (int o = 1; o < 64; o <<= 1) { const float u0 = __builtin_bit_cast(float, __builtin_amdgcn_ds_bpermute((lane - o) << 2, __builtin_bit_cast(int, s0))), u1 = __builtin_bit_cast(float, __builtin_amdgcn_ds_bpermute((lane - o) << 2, __builtin_bit_cast(int, s1)));
                            if (lane >= o) { s0 += u0; s1 += u1; } }
                        const float tot0 = __builtin_bit_cast(float, __builtin_amdgcn_readlane(__builtin_bit_cast(int, s0), 63)); s1 += tot0;
                        const float last = __builtin_bit_cast(float, __builtin_amdgcn_readlane(__builtin_bit_cast(int, s1), 63));
                        acum[i0] = s0; acum[i1] = s1; dtj[i0] = d0; dtj[i1] = d1;
                        wj[i0] = d0 * expf(last - s0); wj[i1] = d1 * expf(last - s1); ei[i0] = expf(s0); ei[i1] = expf(s1);
                        if (lane == 0) misc[0] = expf(last);
                    }
                    __syncthreads();
#pragma unroll
                    for (int k = 0; k < 4; ++k) { const int q = tid + 512 * k, rr = q >> 4, pp = q & 15; *(LAS v4u*)(lds + SC_C + rr * SC_ST + pp * 16) = cr[k]; *(LAS v4u*)(lds + SC_B + rr * SC_ST + pp * 16) = br[k]; }
#pragma unroll
                    for (int k = 0; k < 2; ++k) { const int q = tid + 512 * k, rr = q >> 3, pp = q & 7; *(LAS v4u*)(lds + SC_X + rr * SC_XS + pp * 16) = xr[k];
                        const float w = wj[rr]; v4u s; s.x = a_cvtpk(bflo(xr[k].x) * w, bfhi(xr[k].x) * w); s.y = a_cvtpk(bflo(xr[k].y) * w, bfhi(xr[k].y) * w); s.z = a_cvtpk(bflo(xr[k].z) * w, bfhi(xr[k].z) * w); s.w = a_cvtpk(bflo(xr[k].w) * w, bfhi(xr[k].w) * w);
                        *(LAS v4u*)(lds + SC_XW + rr * SC_XS + pp * 16) = s; }
                    __syncthreads();
#pragma unroll 1
                    for (int tt = 0; tt < 2; ++tt) {
                        const int tl = 2 * wave + tt, jb = tl >> 2, ibg = tl & 3;
                        const bool dead = dir == 0 ? jb > ibg : jb < ibg;
                        a_f32x16 gt;
#pragma unroll
                        for (int r = 0; r < 16; ++r) gt[r] = 0.f;
                        if (!dead) {
                            const LAS unsigned char* ap = lds + SC_B + (32 * jb + r32) * SC_ST + hi * 16; const LAS unsigned char* bp = lds + SC_C + (32 * ibg + r32) * SC_ST + hi * 16;
#pragma unroll
                            for (int s = 0; s < 8; ++s) gt = __builtin_amdgcn_mfma_f32_32x32x16_bf16(*(const LAS a_bf16x8*)(ap + 32 * s), *(const LAS a_bf16x8*)(bp + 32 * s), gt, 0, 0, 0);
                            const int i = 32 * ibg + r32; const float ai = acum[i];
#pragma unroll
                            for (int r = 0; r < 16; ++r) { const int j = 32 * jb + a_crow(r, hi); const bool keep = dir == 0 ? j <= i : j >= i;
                                const float e = __builtin_amdgcn_exp2f(fminf(ai - acum[j], 0.f) * 1.4426950408889634f) * dtj[j];
                                gt[r] = keep ? gt[r] * e + (j == i ? dd : 0.f) : 0.f; }
                        }
#pragma unroll
                        for (int g4 = 0; g4 < 4; ++g4) { v2u w; w.x = a_cvtpk(gt[4 * g4], gt[4 * g4 + 1]); w.y = a_cvtpk(gt[4 * g4 + 2], gt[4 * g4 + 3]);
                            *(LAS v2u*)(lds + SC_M + (32 * ibg + r32) * SC_ST + (32 * jb + 8 * g4 + 4 * hi) * 2) = w; }
                    }
                    a_f32x16 yo;
#pragma unroll
                    for (int r = 0; r < 16; ++r) yo[r] = 0.f;
                    { const LAS unsigned char* ap = lds + SC_C + (32 * ib + r32) * SC_ST + hi * 16; const LAS unsigned char* bp = lds + SC_H + (32 * pb + r32) * SC_ST + hi * 16;
#pragma unroll
                      for (int s = 0; s < 8; ++s) yo = __builtin_amdgcn_mfma_f32_32x32x16_bf16(*(const LAS a_bf16x8*)(ap + 32 * s), *(const LAS a_bf16x8*)(bp + 32 * s), yo, 0, 0, 0); }
                    __syncthreads();
                    a_f32x16 yd;
#pragma unroll
                    for (int r = 0; r < 16; ++r) yd[r] = 0.f;
                    { const LAS unsigned char* ap = lds + SC_M + (32 * ib + r32) * SC_ST + hi * 16; const LAS unsigned char* xp = lds + SC_X + (8 * hi + q4) * SC_XS + (32 * pb + 16 * gg + 4 * p4) * 2;
#pragma unroll
                      for (int s = 0; s < 8; ++s) { const a_s16x4 l0 = a_vtr(xp + (16 * s) * SC_XS), h0 = a_vtr(xp + (16 * s + 4) * SC_XS);
                          const a_bf16x8 xb = (a_bf16x8){l0[0], l0[1], l0[2], l0[3], h0[0], h0[1], h0[2], h0[3]};
                          yd = __builtin_amdgcn_mfma_f32_32x32x16_bf16(*(const LAS a_bf16x8*)(ap + 32 * s), xb, yd, 0, 0, 0); } }
                    { float* yp = y + (size_t)(row0 + 32 * ib) * 2048 + hd * 64 + 32 * pb + r32;
#pragma unroll
                      for (int r = 0; r < 16; ++r) { const int i = a_crow(r, hi); const float v = yd[r] + ei[32 * ib + i] * yo[r]; float* p = yp + (size_t)i * 2048; *p = dir == 0 ? v : *p + v; } }
                    { const float dec = misc[0];
#pragma unroll
                      for (int r = 0; r < 16; ++r) hacc[r] *= dec;
                      const LAS unsigned char* bq = lds + SC_B + (8 * hi + q4) * SC_ST + (32 * nb + 16 * gg + 4 * p4) * 2; const LAS unsigned char* xq = lds + SC_XW + (8 * hi + q4) * SC_XS + (32 * pb + 16 * gg + 4 * p4) * 2;
#pragma unroll
                      for (int s = 0; s < 8; ++s) { const a_s16x4 bl = a_vtr(bq + (16 * s) * SC_ST), bh = a_vtr(bq + (16 * s + 4) * SC_ST), xl = a_vtr(xq + (16 * s) * SC_XS), xh = a_vtr(xq + (16 * s + 4) * SC_XS);
                          const a_bf16x8 av = (a_bf16x8){bl[0], bl[1], bl[2], bl[3], bh[0], bh[1], bh[2], bh[3]}, bv = (a_bf16x8){xl[0], xl[1], xl[2], xl[3], xh[0], xh[1], xh[2], xh[3]};
                          hacc = __builtin_amdgcn_mfma_f32_32x32x16_bf16(av, bv, hacc, 0, 0, 0); } }
#pragma unroll
                    for (int g4 = 0; g4 < 4; ++g4) { v2u w; w.x = a_cvtpk(hacc[4 * g4], hacc[4 * g4 + 1]); w.y = a_cvtpk(hacc[4 * g4 + 2], hacc[4 * g4 + 3]);
                        *(LAS v2u*)(lds + SC_H + (32 * pb + r32) * SC_ST + (32 * nb + 8 * g4 + 4 * hi) * 2) = w; }
                }
                if (seq < 16) { float* o = out + OUT_SSM + ((((size_t)seq * 2 + dir) * 32 + hd) * 64 + 32 * pb + r32) * 128 + 32 * nb + 4 * hi;
#pragma unroll
                    for (int g4 = 0; g4 < 4; ++g4) { v4f t4; t4.x = hacc[4 * g4]; t4.y = hacc[4 * g4 + 1]; t4.z = hacc[4 * g4 + 2]; t4.w = hacc[4 * g4 + 3]; *(GAS v4f*)(o + 8 * g4) = t4; } }
            }
        }
    }
    __syncthreads();
}

constexpr int NPHASE = 37;
enum Op { OP_P0, OP_NORM1, OP_G_LAT, OP_FIN1, OP_G_QKV, OP_FIN2, OP_ATTN, OP_G_WO, OP_NORM2, OP_G_FF1, OP_G_FF2, OP_G_PW1, OP_DWCONV, OP_G_PW2, OP_G_SSI, OP_SSCONV, OP_SCAN, OP_GATE, OP_G_SSO };
__device__ __forceinline__ void phase_decode(int ph, int& layer, int& op) {
    if (ph == 0) { layer = 0; op = OP_P0; return; }
    int r;
    if (ph <= 10) { layer = 0; r = ph - 1; } else if (ph <= 17) { layer = 1; r = ph - 11; } else if (ph <= 26) { layer = 2; r = ph - 18; } else { layer = 3; r = ph - 27; }
    const int kind = layer % 3;
    if (kind == 0) { op = r == 0 ? OP_NORM1 : r == 1 ? OP_G_LAT : r == 2 ? OP_FIN1 : r == 3 ? OP_G_QKV : r == 4 ? OP_FIN2 : r == 5 ? OP_ATTN : r == 6 ? OP_G_WO : r == 7 ? OP_NORM2 : r == 8 ? OP_G_FF1 : OP_G_FF2; }
    else if (kind == 1) { op = r == 0 ? OP_NORM1 : r == 1 ? OP_G_PW1 : r == 2 ? OP_DWCONV : r == 3 ? OP_G_PW2 : r == 4 ? OP_NORM2 : r == 5 ? OP_G_FF1 : OP_G_FF2; }
    else { op = r == 0 ? OP_NORM1 : r == 1 ? OP_G_SSI : r == 2 ? OP_SSCONV : r == 3 ? OP_SCAN : r == 4 ? OP_GATE : r == 5 ? OP_G_SSO : r == 6 ? OP_NORM2 : r == 7 ? OP_G_FF1 : OP_G_FF2; }
}
struct MArgs { const float* in[38]; float* out; unsigned char* ws; int ph_lo, ph_hi; };
constexpr int PTAB_OFF = PTAB_OFF_C;
__global__ void __launch_bounds__(NTHR, 2) mega_fwd(MArgs args) {
    extern __shared__ __attribute__((aligned(16))) unsigned char lds_raw[];
    LAS unsigned char* lds = (LAS unsigned char*)lds_raw;
    volatile LAS unsigned* PT0 = (volatile LAS unsigned*)(lds + PTAB_OFF);
    volatile LAS unsigned* MISC = (volatile LAS unsigned*)(lds + MISC_OFF);
    { const int t0 = threadIdx.x;
      if (t0 < 40) { const unsigned long long p = t0 < 38 ? (unsigned long long)args.in[t0] : t0 == 38 ? (unsigned long long)args.out : (unsigned long long)args.ws;
          PT0[2 * t0] = (unsigned)p; PT0[2 * t0 + 1] = (unsigned)(p >> 32); }
      if (t0 < 64) MISC[t0] = 0u; }
    __syncthreads();
    XcdBarrier bar = xcd_barrier_post((unsigned*)((unsigned char*)ldp(PT0, PT_WS) + WS_CTL) + CW_BAR, MISC + 8);
    const int wave0 = __builtin_amdgcn_readfirstlane(threadIdx.x >> 6);
    const int ph_hi = args.ph_hi;
    for (int ph = args.ph_lo; ph < ph_hi; ++ph) {
        Frame F;
        { int w = wave0; asm volatile("" : "+s"(w)); F.wave = w; }
        F.lds = lds; F.lane = olane(); F.tid = F.wave * 64 + F.lane;
        const int bx = obid();
        F.G = gridDim.x; F.vcu = (F.G % 8 == 0) ? (bx % 8) * (F.G / 8) + bx / 8 : bx;
        F.gw = F.vcu * NWAVES + F.wave; F.NGW = F.G * NWAVES; F.PT = PT0; F.bx = bx;
        int layer, op; phase_decode(ph, layer, op);
        const int j = layer / 3;
        switch (op) {
        case OP_P0: p0_prologue(F); break;
        case OP_NORM1: { unsigned char* ws = WSP; float* x = OUTP; const float* xlo = layer == 0 ? INP(I_XP) : x; const float* xhi = layer == 0 ? INP(I_XS) - (size_t)TP * 1024 : x;
            rp_normmod(F, xlo, xhi, INP(I_GN1) + layer * 1024, (const float*)(ws + WS_MODS) + (size_t)layer * 5 * 6144, 0, 1024, (bf16*)(ws + WS_H)); } break;
        case OP_NORM2: { unsigned char* ws = WSP; float* x = OUTP;
            rp_normmod(F, x, x, INP(I_GN2) + layer * 1024, (const float*)(ws + WS_MODS) + (size_t)layer * 5 * 6144, 3072, 4096, (bf16*)(ws + WS_H)); } break;
        case OP_G_LAT: { unsigned char* ws = WSP; pg8::Gemm g{(const bf16*)(ws + WS_H), (const bf16*)(ws + W_MLA + j * MLA_WB + MW_CAT), T, 768, 1024}; pg8::StaticOrder S; S.init(T, 768, F.G, F.bx);
            pg8::EpiF32 E{(float*)(ws + A_LAT), 768}; pg8::gemm_phase<pg8::EpiF32, pg8::StaticOrder, true, true>(F.lds, g, S, E, F.wave); } break;
        case OP_FIN1: { unsigned char* ws = WSP; rp_mla_fin1(F, (const float*)(ws + A_LAT), INP(I_GQ) + j * 384, INP(I_GKV) + j * 256, (bf16*)(ws + A_QN), (bf16*)(ws + WS_CKV + j * CKV_B), OUTP, j); } break;
        case OP_G_QKV: {
#pragma unroll 1
            for (int w = 0; w < 2; ++w) {
                unsigned char* ws = WSP; unsigned char* wm = ws + W_MLA + j * MLA_WB;
                pg8::Gemm g = w == 0 ? pg8::Gemm{(const bf16*)(ws + A_QN), (const bf16*)(wm + MW_UQ), T, 1536, 384} : pg8::Gemm{(const bf16*)(ws + WS_CKV + j * CKV_B), (const bf16*)(wm + MW_UKV), T + NCTX, 2048, 256};
                pg8::StaticOrder S; S.init(g.M, g.N, F.G, w == 0 ? F.bx : (int)((F.bx + 64) % F.G));
                pg8::EpiBf16P E{w == 0 ? (bf16*)(ws + A_QRAW) : (bf16*)(ws + A_KVRAW), g.N};
                pg8::gemm_phase<pg8::EpiBf16P, pg8::StaticOrder, true, true>(F.lds, g, S, E, F.wave);
            } } break;
        case OP_FIN2: { unsigned char* ws = WSP; rp_mla_fin2(F, (const bf16*)(ws + A_QRAW), (const bf16*)(ws + A_KVRAW), (const float*)(ws + A_LAT), INP(I_CKPE) + (size_t)j * 8192, INP(I_GQN) + j * 96, INP(I_GKN) + j * 96,
                                                        (const float*)(ws + WS_ROPE), (bf16*)(ws + A_QB), (bf16*)(ws + A_KB)); } break;
        case OP_ATTN: { unsigned char* ws = WSP; ph_attn(F, (const bf16*)(ws + A_QB), (const bf16*)(ws + A_KB), (const bf16*)(ws + A_KVRAW), (bf16*)(ws + A_AO)); } break;
        case OP_G_WO: case OP_G_PW2: case OP_G_SSO: case OP_G_FF2: {
            unsigned char* ws = WSP; float* x = OUTP;
            const float* rlo = (layer == 0 && op != OP_G_FF2) ? INP(I_XP) : x; const float* rhi = (layer == 0 && op != OP_G_FF2) ? INP(I_XS) - (size_t)TP * 1024 : x;
            pg8::Gemm g; const float* bias = nullptr; int goff = 2048;
            if (op == OP_G_WO) g = pg8::Gemm{(const bf16*)(ws + A_AO), (const bf16*)(ws + W_MLA + j * MLA_WB + MW_O), T, 1024, 1024};
            else if (op == OP_G_PW2) { g = pg8::Gemm{(const bf16*)(ws + A_V), (const bf16*)(ws + W_CV2), T, 1024, 1024}; bias = INP(I_CVB2); }
            else if (op == OP_G_SSO) g = pg8::Gemm{(const bf16*)(ws + A_YN), (const bf16*)(ws + W_SSO), T, 1024, 2048};
            else { g = pg8::Gemm{(const bf16*)(ws + A_ACT), (const bf16*)(ws + W_FF + layer * FF_WB + FW_OUT), T, 1024, 2816}; goff = 5120; }
            pg8::StaticOrder S; S.init(T, 1024, F.G, F.bx);
            pg8::EpiResid E{rlo, rhi, x, (const float*)(ws + WS_MODS) + (size_t)layer * 5 * 6144, goff, bias};
            pg8::gemm_phase<pg8::EpiResid, pg8::StaticOrder, true, true>(F.lds, g, S, E, F.wave); } break;
        case OP_G_FF1: { unsigned char* ws = WSP; pg8::Gemm g{(const bf16*)(ws + WS_H), (const bf16*)(ws + W_FF + layer * FF_WB + FW_IN), T, 5632, 1024}; pg8::StaticOrder S; S.init(T, 5632, F.G, F.bx);
            pg8::EpiGlu<0> E{(bf16*)(ws + A_ACT), 2816, nullptr, 2816}; pg8::gemm_phase<pg8::EpiGlu<0>, pg8::StaticOrder, true, true>(F.lds, g, S, E, F.wave); } break;
        case OP_G_PW1: { unsigned char* ws = WSP; pg8::Gemm g{(const bf16*)(ws + WS_H), (const bf16*)(ws + W_CV1), T, 2048, 1024}; pg8::StaticOrder S; S.init(T, 2048, F.G, F.bx);
            pg8::EpiGlu<1> E{(bf16*)(ws + A_U), 1024, INP(I_CVB1), 1024}; pg8::gemm_phase<pg8::EpiGlu<1>, pg8::StaticOrder, true, true>(F.lds, g, S, E, F.wave); } break;
        case OP_DWCONV: { unsigned char* ws = WSP; rp_dwconv(F, (const bf16*)(ws + A_U), INP(I_CVWD), INP(I_CVBD), INP(I_CVGL), INP(I_CVBL), (bf16*)(ws + A_V)); } break;
        case OP_G_SSI: { unsigned char* ws = WSP; pg8::Gemm g{(const bf16*)(ws + WS_H), (const bf16*)(ws + W_SSI), T, 5376, 1024}; pg8::StaticOrder S; S.init(T, 5376, F.G, F.bx);
            pg8::EpiSsdIn E{(bf16*)(ws + A_Z), (bf16*)(ws + A_XPRE), (float*)(ws + A_DTRAW)}; pg8::gemm_phase<pg8::EpiSsdIn, pg8::StaticOrder, true, true>(F.lds, g, S, E, F.wave); } break;
        case OP_SSCONV: { unsigned char* ws = WSP; rp_ssd_conv(F, (const bf16*)(ws + A_XPRE), (const float*)(ws + A_DTRAW), INP(I_SSWC), INP(I_SSBC), INP(I_SSDTB), (bf16*)(ws + A_XBC), (float*)(ws + A_DT)); } break;
        case OP_SCAN: { unsigned char* ws = WSP; ph_scan(F, (const bf16*)(ws + A_XBC), (const float*)(ws + A_DT), INP(I_SSAL), INP(I_SSD), INP(I_SSM), (float*)(ws + A_Y), OUTP); } break;
        case OP_GATE: { unsigned char* ws = WSP; rp_ssd_gate(F, (const float*)(ws + A_Y), (const bf16*)(ws + A_Z), INP(I_SSGN), (bf16*)(ws + A_YN)); } break;
        default: break;
        }
        if (ph + 1 < ph_hi) xcd_barrier(bar);
    }
}

#ifndef MK_PHASES
#define MK_PHASES 37
#endif
#ifndef MK_PER_PHASE
#define MK_PER_PHASE 0
#endif
static int sub_after_phases(int p) { return p >= 37 ? 8 : p >= 34 ? 7 : p >= 27 ? 6 : p >= 24 ? 5 : p >= 18 ? 4 : p >= 15 ? 3 : p >= 11 ? 2 : p >= 8 ? 1 : 0; }
extern "C" void kernel_launch(void* const* d_in, const int* in_sizes, int n_in, void* d_out, int out_size, void* d_ws, size_t ws_size, hipStream_t stream) {
    static int grid = 0;
    if (grid == 0) {
        int dev = 0, cus = 0;
        if (hipGetDevice(&dev) != hipSuccess || hipDeviceGetAttribute(&cus, hipDeviceAttributeMultiprocessorCount, dev) != hipSuccess) { fprintf(stderr, "kernel_launch: device query failed\n"); grid = -1; return; }
        if (hipFuncSetAttribute((const void*)mega_fwd, hipFuncAttributeMaxDynamicSharedMemorySize, LDS_BYTES) != hipSuccess) { fprintf(stderr, "kernel_launch: hipFuncSetAttribute failed\n"); grid = -1; return; }
        (void)hipGetLastError();
        grid = cus;
    }
    if (grid < 0) return;
    In I; const float** p = (const float**)&I;
    for (int i = 0; i < 38; ++i) p[i] = (const float*)d_in[i];
    (void)hipMemsetAsync((char*)d_ws + WS_CTL, 0, CTL_ZERO_BYTES, stream);
    MArgs a{};
    for (int i = 0; i < 38; ++i) a.in[i] = (const float*)d_in[i];
    a.out = (float*)d_out; a.ws = (unsigned char*)d_ws;
    const int nph = MK_PHASES;
    if (MK_PER_PHASE) { for (int ph = 0; ph < nph; ++ph) { a.ph_lo = ph; a.ph_hi = ph + 1; hipLaunchKernelGGL(mega_fwd, dim3(grid), dim3(NTHR), LDS_BYTES, stream, a); } }
    else { a.ph_lo = 0; a.ph_hi = nph; hipLaunchKernelGGL(mega_fwd, dim3(grid), dim3(NTHR), LDS_BYTES, stream, a); }
    const int sub = sub_after_phases(nph);
    if (sub < 8) naive_forward(I, (float*)d_out, (float*)d_ws, stream, sub);
}
```

```cpp
#include <hip/hip_runtime.h>
#include <cstdint>
#include <cstdio>

constexpr int DM = 1024, T = 8192, TP = 4096;
constexpr int NCTX = 1024;
constexpr int QL = 384, KVL = 256, ROPE = 32, NOPE = 64, QKD = 96, VH = 64, NH = 16;
constexpr int FFH = 2816;
constexpr int SSI = 2048, SSH = 32, SSP = 64, SSN = 128, SSG = 4, SSCD = 3072, SSIN = 5184;
constexpr float EPS = 1e-6f;
constexpr size_t OUT_YP = 0, OUT_CKV = 8388608, OUT_KPE = 10485760, OUT_SSM = 10747904;

__device__ __forceinline__ int cond_of_row(int r) { return r < TP ? 0 : 1 + ((r - TP) >> 10); }
__device__ __forceinline__ void row_pos(int r, int& t, int& L) { if (r < TP) { t = r & 255; L = 256; } else { t = (r - TP) & 1023; L = 1024; } }
__device__ __forceinline__ float silu_f(float x) { return x / (1.f + expf(-x)); }
__device__ __forceinline__ float sigmoid_f(float x) { return 1.f / (1.f + expf(-x)); }
__device__ __forceinline__ float softplus_f(float x) { return fmaxf(x, 0.f) + log1pf(expf(-fabsf(x))); }
__device__ __forceinline__ float wave_sum(float v) {
#pragma unroll
    for (int o = 1; o < 64; o <<= 1) v += __shfl_xor(v, o);
    return v;
}

__global__ void __launch_bounds__(256) nk_adaln(const float* __restrict__ c, const float* __restrict__ cctx, const float* __restrict__ w, const float* __restrict__ b, float* __restrict__ mods) {
    __shared__ float s[5][DM];
    const int l = blockIdx.y, n = blockIdx.x * 256 + threadIdx.x;
    for (int i = threadIdx.x; i < 5 * DM; i += 256) { const int cc = i / DM, k = i % DM; const float v = cc == 0 ? cctx[k] : c[(cc - 1) * DM + k]; s[cc][k] = silu_f(v); }
    __syncthreads();
    const float* W = w + (size_t)l * DM * 6144;
    float acc[5] = {0.f, 0.f, 0.f, 0.f, 0.f};
    for (int k = 0; k < DM; ++k) { const float wv = W[(size_t)k * 6144 + n];
#pragma unroll
        for (int cc = 0; cc < 5; ++cc) acc[cc] += s[cc][k] * wv; }
#pragma unroll
    for (int cc = 0; cc < 5; ++cc) mods[((size_t)l * 5 + cc) * 6144 + n] = acc[cc] + b[l * 6144 + n];
}

__global__ void __launch_bounds__(256) nk_copy_x(const float* __restrict__ xp, const float* __restrict__ xs, float* __restrict__ x) {
    const size_t i = (size_t)blockIdx.x * 256 + threadIdx.x;
    const size_t half = (size_t)TP * DM / 4;
    ((float4*)x)[i] = i < half ? ((const float4*)xp)[i] : ((const float4*)xs)[i - half];
}

__global__ void __launch_bounds__(256) nk_normmod(const float* __restrict__ x, const float* __restrict__ g, const float* __restrict__ mods_l, int sh_off, int sc_off, float* __restrict__ h) {
    const int row = blockIdx.x * 4 + (threadIdx.x >> 6), lane = threadIdx.x & 63;
    const float* xr = x + (size_t)row * DM; float v[16]; float ss = 0.f;
#pragma unroll
    for (int i = 0; i < 16; ++i) { v[i] = xr[lane + 64 * i]; ss += v[i] * v[i]; }
    ss = wave_sum(ss); const float r = rsqrtf(ss * (1.f / DM) + EPS);
    const float* m = mods_l + (size_t)cond_of_row(row) * 6144;
#pragma unroll
    for (int i = 0; i < 16; ++i) { const int k = lane + 64 * i; h[(size_t)row * DM + k] = v[i] * r * g[k] * (1.f + m[sc_off + k]) + m[sh_off + k]; }
}

template <int GLU>
__global__ void __launch_bounds__(256) nk_gemm(const float* __restrict__ A, int lda, const float* __restrict__ B, int ldb, float* __restrict__ C, int ldc, int M, int N, int K, const float* __restrict__ bias) {
    __shared__ float As[16][65], Bs[16][65], Us[16][65];
    const int tx = threadIdx.x & 15, ty = threadIdx.x >> 4, m0 = blockIdx.y * 64, n0 = blockIdx.x * 64;
    float acc[4][4] = {}, acu[4][4] = {};
    for (int k0 = 0; k0 < K; k0 += 16) {
        for (int i = threadIdx.x; i < 1024; i += 256) { const int r = i >> 4, kk = i & 15; As[kk][r] = A[(size_t)(m0 + r) * lda + k0 + kk]; }
        for (int i = threadIdx.x; i < 1024; i += 256) { const int kk = i >> 6, cc = i & 63; const bool ok = n0 + cc < N; Bs[kk][cc] = ok ? B[(size_t)(k0 + kk) * ldb + n0 + cc] : 0.f;
            if (GLU) Us[kk][cc] = ok ? B[(size_t)(k0 + kk) * ldb + N + n0 + cc] : 0.f; }
        __syncthreads();
#pragma unroll
        for (int kk = 0; kk < 16; ++kk) { float a[4], b[4], u[4];
#pragma unroll
            for (int i = 0; i < 4; ++i) { a[i] = As[kk][ty * 4 + i]; b[i] = Bs[kk][tx * 4 + i]; u[i] = GLU ? Us[kk][tx * 4 + i] : 0.f; }
#pragma unroll
            for (int i = 0; i < 4; ++i)
#pragma unroll
                for (int j = 0; j < 4; ++j) { acc[i][j] += a[i] * b[j]; if (GLU) acu[i][j] += a[i] * u[j]; } }
        __syncthreads();
    }
#pragma unroll
    for (int i = 0; i < 4; ++i)
#pragma unroll
        for (int j = 0; j < 4; ++j) { const int n = n0 + tx * 4 + j; if (n < N) {
            float v = acc[i][j] + (bias ? bias[n] : 0.f);
            if (GLU) { const float u = acu[i][j] + (bias ? bias[N + n] : 0.f); v = GLU == 1 ? silu_f(v) * u : v * sigmoid_f(u); }
            C[(size_t)(m0 + ty * 4 + i) * ldc + n] = v; } }
}

__global__ void __launch_bounds__(256) nk_resid(float* __restrict__ x, const float* __restrict__ o, const float* __restrict__ mods_l, int g_off) {
    const size_t i = (size_t)blockIdx.x * 256 + threadIdx.x; const int row = (int)(i >> 10), k = (int)(i & 1023);
    x[i] += mods_l[(size_t)cond_of_row(row) * 6144 + g_off + k] * o[i];
}

__global__ void __launch_bounds__(256) nk_mla_fin1(const float* __restrict__ latq, const float* __restrict__ latkv, const float* __restrict__ gq, const float* __restrict__ gkv,
                                                   const float* __restrict__ cache_ckv_j  , float* __restrict__ qn, float* __restrict__ ckv, float* __restrict__ out, int j) {
    const int row = blockIdx.x * 4 + (threadIdx.x >> 6), lane = threadIdx.x & 63;
    if (row >= T) { const int b = (row - T) >> 8, s = (row - T) & 255;
#pragma unroll
        for (int i = 0; i < 4; ++i) ckv[(size_t)row * KVL + lane + 64 * i] = cache_ckv_j[((size_t)b * 2 * 256 + s) * 256 + lane + 64 * i];
        return; }
    float v[6]; float ss = 0.f;
#pragma unroll
    for (int i = 0; i < 6; ++i) { v[i] = latq[(size_t)row * QL + lane + 64 * i]; ss += v[i] * v[i]; }
    ss = wave_sum(ss); float r = rsqrtf(ss * (1.f / QL) + EPS);
#pragma unroll
    for (int i = 0; i < 6; ++i) qn[(size_t)row * QL + lane + 64 * i] = v[i] * r * gq[lane + 64 * i];
    ss = 0.f;
#pragma unroll
    for (int i = 0; i < 4; ++i) { v[i] = latkv[(size_t)row * 288 + lane + 64 * i]; ss += v[i] * v[i]; }
    ss = wave_sum(ss); r = rsqrtf(ss * (1.f / KVL) + EPS);
#pragma unroll
    for (int i = 0; i < 4; ++i) { const float c = v[i] * r * gkv[lane + 64 * i]; ckv[(size_t)row * KVL + lane + 64 * i] = c;
        if (row < TP) out[OUT_CKV + (((size_t)(row >> 8) * 2 + j) * 256 + (row & 255)) * 256 + lane + 64 * i] = c; }
    if (row < TP && lane < 32) out[OUT_KPE + (((size_t)(row >> 8) * 2 + j) * 256 + (row & 255)) * 32 + lane] = latkv[(size_t)row * 288 + 256 + lane];
}

__device__ __forceinline__ float rope_inv(int i) { return i == 0 ? 1.f : i == 1 ? 0.31622776601683794f : i == 2 ? 0.1f : i == 3 ? 0.031622776601683794f : i == 4 ? 0.01f : i == 5 ? 0.0031622776601683794f : i == 6 ? 0.001f : 0.00031622776601683794f; }
__device__ __forceinline__ void rope32(float* pe, int t) {
    const int rr = t >> 6, cc = t & 63;
#pragma unroll
    for (int i = 0; i < 8; ++i) {
        const float inv = rope_inv(i);
        float a = (float)rr * inv, s = sinf(a), c = cosf(a);
        float x1 = pe[i], x2 = pe[i + 8]; pe[i] = x1 * c - x2 * s; pe[i + 8] = x2 * c + x1 * s;
        a = (float)cc * inv; s = sinf(a); c = cosf(a);
        x1 = pe[16 + i]; x2 = pe[24 + i]; pe[16 + i] = x1 * c - x2 * s; pe[24 + i] = x2 * c + x1 * s;
    }
}
__global__ void __launch_bounds__(256) nk_mla_fin2(const float* __restrict__ qraw, const float* __restrict__ kvraw, const float* __restrict__ latkv, const float* __restrict__ cache_kpe_j,
                                                   const float* __restrict__ gqn, const float* __restrict__ gkn, float* __restrict__ Q, float* __restrict__ K) {
    const int idx = blockIdx.x * 256 + threadIdx.x, row = idx >> 4, h = idx & 15;
    const bool latent = row >= TP && row < T; const int tl = (row - TP) & 1023;
    if (row < T) {
        float q[96]; float ss = 0.f;
#pragma unroll
        for (int d = 0; d < 96; ++d) { q[d] = qraw[(size_t)row * 1536 + h * 96 + d]; ss += q[d] * q[d]; }
        const float r = rsqrtf(ss * (1.f / 96) + EPS);
#pragma unroll
        for (int d = 0; d < 96; ++d) q[d] = q[d] * r * gqn[d];
        if (latent) rope32(q + 64, tl);
#pragma unroll
        for (int d = 0; d < 96; ++d) Q[((size_t)row * 16 + h) * 96 + d] = q[d];
    }
    float k[96]; float ss = 0.f;
#pragma unroll
    for (int d = 0; d < 64; ++d) { k[d] = kvraw[(size_t)row * 2048 + h * 128 + d]; ss += k[d] * k[d]; }
#pragma unroll
    for (int d = 0; d < 32; ++d) { k[64 + d] = row < T ? latkv[(size_t)row * 288 + 256 + d] : cache_kpe_j[((size_t)((row - T) >> 8) * 2 * 256 + ((row - T) & 255)) * 32 + d]; ss += k[64 + d] * k[64 + d]; }
    const float r = rsqrtf(ss * (1.f / 96) + EPS);
#pragma unroll
    for (int d = 0; d < 96; ++d) k[d] = k[d] * r * gkn[d];
    if (latent) rope32(k + 64, tl);
#pragma unroll
    for (int d = 0; d < 96; ++d) K[((size_t)row * 16 + h) * 96 + d] = k[d];
}

__global__ void __launch_bounds__(64) nk_attn(const float* __restrict__ Q, const float* __restrict__ K, const float* __restrict__ KV  , float* __restrict__ O) {
    __shared__ float Ks[32][96], Vs[32][64];
    const int h = blockIdx.y, row = blockIdx.x * 64 + threadIdx.x;
    float q[96];
#pragma unroll
    for (int d = 0; d < 96; ++d) q[d] = Q[((size_t)row * 16 + h) * 96 + d];
    float o[64];
#pragma unroll
    for (int d = 0; d < 64; ++d) o[d] = 0.f;
    float m = -INFINITY, l = 0.f;
    int nkeys, kbase0, kbase1, n0;
    const int r0 = blockIdx.x * 64;
    if (r0 < TP) { nkeys = 256; n0 = 256; kbase0 = r0 & ~255; kbase1 = 0; }
    else { const int b = (r0 - TP) >> 10; nkeys = 1280; n0 = 256; kbase0 = T + b * 256; kbase1 = TP + b * 1024; }
    const float scale = rsqrtf(96.f);
    for (int k0 = 0; k0 < nkeys; k0 += 32) {
        __syncthreads();
        for (int i = threadIdx.x; i < 32 * 96; i += 64) { const int kk = i / 96, d = i % 96; const int key = k0 + kk; const int kr = key < n0 ? kbase0 + key : kbase1 + key - n0; Ks[kk][d] = K[((size_t)kr * 16 + h) * 96 + d]; }
        for (int i = threadIdx.x; i < 32 * 64; i += 64) { const int kk = i / 64, d = i % 64; const int key = k0 + kk; const int kr = key < n0 ? kbase0 + key : kbase1 + key - n0; Vs[kk][d] = KV[(size_t)kr * 2048 + h * 128 + 64 + d]; }
        __syncthreads();
        for (int kk = 0; kk < 32; ++kk) {
            float s = 0.f;
#pragma unroll
            for (int d = 0; d < 96; ++d) s += q[d] * Ks[kk][d];
            s *= scale;
            const float mn = fmaxf(m, s), a = expf(m - mn), p = expf(s - mn);
            l = l * a + p;
#pragma unroll
            for (int d = 0; d < 64; ++d) o[d] = o[d] * a + p * Vs[kk][d];
            m = mn;
        }
    }
    const float il = 1.f / l;
#pragma unroll
    for (int d = 0; d < 64; ++d) O[(size_t)row * DM + h * 64 + d] = o[d] * il;
}

__global__ void __launch_bounds__(256) nk_dwconv_ln(const float* __restrict__ u, const float* __restrict__ wdw, const float* __restrict__ bdw, const float* __restrict__ gln, const float* __restrict__ bln, float* __restrict__ v) {
    const int row = blockIdx.x * 4 + (threadIdx.x >> 6), lane = threadIdx.x & 63;
    int t, L; row_pos(row, t, L);
    float y[16]; float s = 0.f;
#pragma unroll
    for (int i = 0; i < 16; ++i) { const int c = lane + 64 * i; float a = bdw[c];
        for (int k = 0; k < 31; ++k) { const int tt = t + k - 15; if (tt >= 0 && tt < L) a += u[(size_t)(row + k - 15) * DM + c] * wdw[k * DM + c]; }
        y[i] = a; s += a; }
    const float mean = wave_sum(s) * (1.f / DM); float q = 0.f;
#pragma unroll
    for (int i = 0; i < 16; ++i) { y[i] -= mean; q += y[i] * y[i]; }
    const float r = rsqrtf(wave_sum(q) * (1.f / DM) + EPS);
#pragma unroll
    for (int i = 0; i < 16; ++i) { const int c = lane + 64 * i; v[(size_t)row * DM + c] = silu_f(y[i] * r * gln[c] + bln[c]); }
}

__global__ void __launch_bounds__(256) nk_ssd_conv(const float* __restrict__ xpre  , const float* __restrict__ dtraw  , const float* __restrict__ wc, const float* __restrict__ bc, const float* __restrict__ dtb, float* __restrict__ xbc, float* __restrict__ dt) {
    const size_t i = (size_t)blockIdx.x * 256 + threadIdx.x; const int row = (int)(i / 3136), c = (int)(i % 3136);
    int t, L; row_pos(row, t, L);
    if (c < SSCD) { float a = bc[c];
#pragma unroll
        for (int k = 0; k < 5; ++k) { const int tt = t + k - 2; if (tt >= 0 && tt < L) a += xpre[(size_t)(row + k - 2) * SSCD + c] * wc[k * SSCD + c]; }
        xbc[(size_t)row * SSCD + c] = silu_f(a);
    } else { const int e = c - SSCD; dt[(size_t)row * 64 + e] = softplus_f(dtraw[(size_t)row * 64 + e] + dtb[e]); }
}
__global__ void __launch_bounds__(64) nk_ssd_scan(const float* __restrict__ xbc, const float* __restrict__ dt, const float* __restrict__ alog, const float* __restrict__ dsk, const float* __restrict__ st0  ,
                                                  float* __restrict__ y  , float* __restrict__ out, int dir) {
    const int h = blockIdx.x, seq = blockIdx.y, p = threadIdx.x, g = h >> 3;
    int r0, L; if (seq < 16) { r0 = seq * 256; L = 256; } else { r0 = TP + (seq - 16) * 1024; L = 1024; }
    const float a = -expf(alog[dir * 32 + h]), dd = dsk[dir * 32 + h];
    float hs[128];
    if (seq < 16) {
#pragma unroll
        for (int n = 0; n < 128; ++n) hs[n] = 0.f;
    } else { const float* s0 = st0 + ((((size_t)(seq - 16) * 2 + dir) * 32 + h) * 64 + p) * 128;
#pragma unroll
        for (int n = 0; n < 128; ++n) hs[n] = s0[n]; }
    for (int s = 0; s < L; ++s) {
        const int row = r0 + (dir == 0 ? s : L - 1 - s);
        const float dtv = dt[(size_t)row * 64 + dir * 32 + h], da = expf(dtv * a), xv = xbc[(size_t)row * SSCD + h * 64 + p], dtx = dtv * xv;
        const float* Bp = xbc + (size_t)row * SSCD + SSI + g * 128; const float* Cp = Bp + 512;
        float acc = 0.f;
#pragma unroll
        for (int n = 0; n < 128; ++n) { hs[n] = hs[n] * da + dtx * Bp[n]; acc += Cp[n] * hs[n]; }
        float* yp = y + (size_t)row * SSI + h * 64 + p; const float yv = acc + xv * dd; *yp = dir == 0 ? yv : *yp + yv;
    }
    if (seq < 16) { float* o = out + OUT_SSM + ((((size_t)seq * 2 + dir) * 32 + h) * 64 + p) * 128;
#pragma unroll
        for (int n = 0; n < 128; ++n) o[n] = hs[n]; }
}
__global__ void __launch_bounds__(256) nk_ssd_gate(const float* __restrict__ y, const float* __restrict__ z  , const float* __restrict__ gn, float* __restrict__ yn) {
    const int row = blockIdx.x * 4 + (threadIdx.x >> 6), lane = threadIdx.x & 63;
#pragma unroll
    for (int g = 0; g < 4; ++g) { float v[8]; float ss = 0.f;
#pragma unroll
        for (int i = 0; i < 8; ++i) { const int c = g * 512 + lane + 64 * i; v[i] = y[(size_t)row * SSI + c] * silu_f(z[(size_t)row * SSI + c]); ss += v[i] * v[i]; }
        const float r = rsqrtf(wave_sum(ss) * (1.f / 512) + EPS);
#pragma unroll
        for (int i = 0; i < 8; ++i) { const int c = g * 512 + lane + 64 * i; yn[(size_t)row * SSI + c] = v[i] * r * gn[c]; } }
}

struct In {
    const float *x_prompt, *x_sample, *cache_ckv, *cache_kpe, *state_ssm, *c, *c_ctx, *w_ada, *b_ada, *g_norm1, *g_norm2,
        *mla_w_dq, *mla_g_q, *mla_w_uq, *mla_w_dkv, *mla_g_kv, *mla_w_ukv, *mla_g_qn, *mla_g_kn, *mla_w_o,
        *cv_w_pw1, *cv_b_pw1, *cv_w_dw, *cv_b_dw, *cv_g_ln, *cv_b_ln, *cv_w_pw2, *cv_b_pw2,
        *ssd_w_in, *ssd_w_conv, *ssd_b_conv, *ssd_dt_bias, *ssd_a_log, *ssd_d, *ssd_g_norm, *ssd_w_out, *ffn_w_in, *ffn_w_out;
};

template <int GLU>
static void ngemm(hipStream_t s, const float* A, int lda, const float* B, int ldb, float* C, int ldc, int M, int N, int K, const float* bias) {
    nk_gemm<GLU><<<dim3((N + 63) / 64, M / 64), 256, 0, s>>>(A, lda, B, ldb, C, ldc, M, N, K, bias);
}

static void naive_forward(const In& I, float* out, float* ws, hipStream_t s, int start_sub) {
    size_t off = 0; auto take = [&](size_t n) { float* p = ws + off; off += (n + 255) & ~(size_t)255; return p; };
    float* mods = take(4 * 5 * 6144);
    float* h = take((size_t)T * DM);
    float* t2 = take((size_t)T * DM);
    float* latkv = take((size_t)T * 288);
    float* qn = take((size_t)T * QL);
    float* ckv = take((size_t)(T + NCTX) * KVL);
    float* dtb = take((size_t)T * 64);
    float* dtraw = take((size_t)T * 64);
    float* arena = ws + off;
    float* latq = arena; float* qraw = latq + (size_t)T * QL; float* kvraw = qraw + (size_t)T * 1536; float* Qb = kvraw + (size_t)(T + NCTX) * 2048; float* Kb = Qb + (size_t)T * 1536;
    float* t1 = arena;
    float* zb = arena; float* xpre = zb + (size_t)T * SSI; float* xbc = xpre + (size_t)T * SSCD; float* yb = xpre;
    float* x = out + OUT_YP;
    nk_adaln<<<dim3(24, 4), 256, 0, s>>>(I.c, I.c_ctx, I.w_ada, I.b_ada, mods);
    if (start_sub == 0) nk_copy_x<<<T * DM / 4 / 256, 256, 0, s>>>(I.x_prompt, I.x_sample, x);
    for (int i = start_sub / 2; i < 4; ++i) {
        const int kind = i % 3, j = i / 3; const float* ml = mods + (size_t)i * 5 * 6144;
        if (2 * i >= start_sub) {
        nk_normmod<<<T / 4, 256, 0, s>>>(x, I.g_norm1 + i * DM, ml, 0, 1024, h);
        if (kind == 0) {
            ngemm<0>(s, h, DM, I.mla_w_dq + (size_t)j * DM * QL, QL, latq, QL, T, QL, DM, nullptr);
            ngemm<0>(s, h, DM, I.mla_w_dkv + (size_t)j * DM * 288, 288, latkv, 288, T, 288, DM, nullptr);
            nk_mla_fin1<<<(T + NCTX) / 4, 256, 0, s>>>(latq, latkv, I.mla_g_q + j * QL, I.mla_g_kv + j * KVL, I.cache_ckv + (size_t)j * 65536, qn, ckv, out, j);
            ngemm<0>(s, qn, QL, I.mla_w_uq + (size_t)j * QL * 1536, 1536, qraw, 1536, T, 1536, QL, nullptr);
            ngemm<0>(s, ckv, KVL, I.mla_w_ukv + (size_t)j * KVL * 2048, 2048, kvraw, 2048, T + NCTX, 2048, KVL, nullptr);
            nk_mla_fin2<<<(T + NCTX) * 16 / 256, 256, 0, s>>>(qraw, kvraw, latkv, I.cache_kpe + (size_t)j * 8192, I.mla_g_qn + j * 96, I.mla_g_kn + j * 96, Qb, Kb);
            nk_attn<<<dim3(T / 64, 16), 64, 0, s>>>(Qb, Kb, kvraw, h);
            ngemm<0>(s, h, DM, I.mla_w_o + (size_t)j * DM * DM, DM, t2, DM, T, DM, DM, nullptr);
        } else if (kind == 1) {
            ngemm<2>(s, h, DM, I.cv_w_pw1, 2048, t1, DM, T, DM, DM, I.cv_b_pw1);
            nk_dwconv_ln<<<T / 4, 256, 0, s>>>(t1, I.cv_w_dw, I.cv_b_dw, I.cv_g_ln, I.cv_b_ln, h);
            ngemm<0>(s, h, DM, I.cv_w_pw2, DM, t2, DM, T, DM, DM, I.cv_b_pw2);
        } else {
            ngemm<0>(s, h, DM, I.ssd_w_in, SSIN, zb, SSI, T, SSI, DM, nullptr);
            ngemm<0>(s, h, DM, I.ssd_w_in + SSI, SSIN, xpre, SSCD, T, SSCD, DM, nullptr);
            ngemm<0>(s, h, DM, I.ssd_w_in + SSI + SSCD, SSIN, dtraw, 64, T, 64, DM, nullptr);
            nk_ssd_conv<<<T * 3136 / 256, 256, 0, s>>>(xpre, dtraw, I.ssd_w_conv, I.ssd_b_conv, I.ssd_dt_bias, xbc, dtb);
            nk_ssd_scan<<<dim3(32, 20), 64, 0, s>>>(xbc, dtb, I.ssd_a_log, I.ssd_d, I.state_ssm, yb, out, 0);
            nk_ssd_scan<<<dim3(32, 20), 64, 0, s>>>(xbc, dtb, I.ssd_a_log, I.ssd_d, I.state_ssm, yb, out, 1);
            nk_ssd_gate<<<T / 4, 256, 0, s>>>(yb, zb, I.ssd_g_norm, xbc);
            ngemm<0>(s, xbc, SSI, I.ssd_w_out, DM, t2, DM, T, DM, SSI, nullptr);
        }
        nk_resid<<<T * DM / 256, 256, 0, s>>>(x, t2, ml, 2048);
        }
        nk_normmod<<<T / 4, 256, 0, s>>>(x, I.g_norm2 + i * DM, ml, 3072, 4096, h);
        ngemm<1>(s, h, DM, I.ffn_w_in + (size_t)i * DM * 5632, 5632, t1, FFH, T, FFH, DM, nullptr);
        ngemm<0>(s, t1, FFH, I.ffn_w_out + (size_t)i * FFH * DM, DM, t2, DM, T, DM, FFH, nullptr);
        nk_resid<<<T * DM / 256, 256, 0, s>>>(x, t2, ml, 5120);
    }
}


__device__ __forceinline__ int olane() { int l; asm volatile("v_mbcnt_lo_u32_b32 %0, -1, 0\n\tv_mbcnt_hi_u32_b32 %0, -1, %0" : "=v"(l)); return l; }
__device__ __forceinline__ int obid() { int b = blockIdx.x; asm volatile("" : "+s"(b)); return b; }
namespace pg8 {
#define PG8_LAS __attribute__((address_space(3)))
typedef unsigned short bf16_t;
typedef short bf16x8 __attribute__((ext_vector_type(8)));
typedef float f32x4 __attribute__((ext_vector_type(4)));
typedef unsigned u32x4 __attribute__((ext_vector_type(4)));
constexpr int BM = 256, BK = 64, HALF = 128, HTB = HALF * BK * 2  , STAGE_BYTES = 8 * HTB, NXCD = 8, WGM = 8;

__host__ __device__ __forceinline__ int lds_byte(int r, int c) { const int st = (r >> 4) * 2 + (c >> 5), rr = r & 15, cc = c & 31, ob = rr * 64 + cc * 2; return st * 1024 + (ob ^ (((ob >> 9) & 1) << 5)); }
__host__ __device__ __forceinline__ void stage_rc(int b, int& R, int& C) { const int st = b / 1024, sb = b % 1024, swz = sb ^ (((sb >> 9) & 1) << 5); R = (st >> 1) * 16 + swz / 64; C = (st & 1) * 32 + (swz % 64) / 2; }
__host__ __device__ __forceinline__ int perm32(int rho) { const int n = rho >> 4, i = rho & 15; return 8 * (i >> 2) + 4 * n + (i & 3); }

struct Unit { int pm, pn; };
struct Gemm { const bf16_t* A; const bf16_t* Bt; int M, N, K; };

struct StaticOrder {
    int nM, nN, nwg, G, c;
    __host__ __device__ void init(int M, int N, int G_, int c_) { nM = M / BM; nN = N / BM; nwg = nM * nN; G = G_; c = c_; }
    __host__ __device__ bool next(int i, Unit& u) const {
        const long L = (long)i * G + c; if (L >= nwg) return false;
        int wgid = (int)L; { const int q = nwg / NXCD, r = nwg % NXCD, xcd = wgid % NXCD, off = wgid / NXCD; wgid = (xcd < r ? xcd * (q + 1) : r * (q + 1) + (xcd - r) * q) + off; }
        const int nig = WGM * nN, gid = wgid / nig, fm = gid * WGM, gsz = (nM - fm) < WGM ? (nM - fm) : WGM;
        u.pm = fm + ((wgid % nig) % gsz); u.pn = (wgid % nig) / gsz; return true;
    }
    __device__ __forceinline__ void a_ready(const Unit&) const {}
    __device__ __forceinline__ void done(const Unit&) const {}
};
__device__ __forceinline__ unsigned cvt_pk_bf16(float lo, float hi) { unsigned r; asm volatile("v_cvt_pk_bf16_f32 %0, %1, %2" : "=v"(r) : "v"(lo), "v"(hi)); return r; }
typedef unsigned u32x2 __attribute__((ext_vector_type(2)));
__device__ __forceinline__ float fast_sigmoid(float x) { return __builtin_amdgcn_rcpf(1.f + __builtin_amdgcn_exp2f(-1.4426950408889634f * x)); }

template <int NBJ> struct EpiF32 {
    static constexpr bool PERM = false, AFTER_DRAIN = false;
    float* C; int ldc;
    __device__ __forceinline__ void operator()(const f32x4 (&acc)[2][2][4][2], const Unit& u, int wr_, int wc_, int fr_, int fq_) const {
        const int t_ = olane(), wr = wr_, wc = wc_, fr = t_ & 15, fq = t_ >> 4; (void)fr_; (void)fq_;
        const int row0 = u.pm * BM + wr * 64 + fr, col0 = u.pn * (HALF * NBJ) + wc * 32 + 4 * fq;
#pragma unroll
        for (int ai = 0; ai < 2; ++ai)
#pragma unroll
            for (int m = 0; m < 4; ++m) { float* rowp = C + (size_t)(row0 + ai * HALF + m * 16) * ldc + col0;
#pragma unroll
                for (int bj = 0; bj < NBJ; ++bj)
#pragma unroll
                    for (int n = 0; n < 2; ++n) *(f32x4*)(rowp + bj * HALF + n * 16) = acc[ai][bj][m][n]; }
    }
};
struct EpiBf16P {
    static constexpr bool PERM = true, AFTER_DRAIN = false;
    bf16_t* O; int ldc;
    __device__ __forceinline__ void operator()(const f32x4 (&acc)[2][2][4][2], const Unit& u, int wr_, int wc_, int fr_, int fq_) const {
        const int t_ = olane(), wr = wr_, wc = wc_, fr = t_ & 15, fq = t_ >> 4; (void)fr_; (void)fq_;
        const int row0 = u.pm * BM + wr * 64 + fr, col0 = u.pn * BM + wc * 32 + 8 * fq;
#pragma unroll
        for (int ai = 0; ai < 2; ++ai)
#pragma unroll
            for (int m = 0; m < 4; ++m) { bf16_t* rowp = O + (size_t)(row0 + ai * HALF + m * 16) * ldc + col0;
#pragma unroll
                for (int bj = 0; bj < 2; ++bj) { const f32x4 v0 = acc[ai][bj][m][0], v1 = acc[ai][bj][m][1]; u32x4 w;
                    w.x = cvt_pk_bf16(v0[0], v0[1]); w.y = cvt_pk_bf16(v0[2], v0[3]); w.z = cvt_pk_bf16(v1[0], v1[1]); w.w = cvt_pk_bf16(v1[2], v1[3]);
                    *(u32x4*)(rowp + bj * HALF) = w; } }
    }
};
struct EpiSsdIn {
    static constexpr bool PERM = true, AFTER_DRAIN = false;
    bf16_t* Z; bf16_t* XP; float* DT;
    __device__ __forceinline__ void operator()(const f32x4 (&acc)[2][2][4][2], const Unit& u, int wr_, int wc_, int fr_, int fq_) const {
        const int t_ = olane(), wr = wr_, wc = wc_, fr = t_ & 15, fq = t_ >> 4; (void)fr_; (void)fq_;
        const int row0 = u.pm * BM + wr * 64 + fr;
        if (u.pn < 20) {
            bf16_t* base = u.pn < 8 ? Z : XP; const int ld = u.pn < 8 ? 2048 : 3072, colt = (u.pn < 8 ? u.pn : u.pn - 8) * BM, col0 = colt + wc * 32 + 8 * fq;
#pragma unroll
            for (int ai = 0; ai < 2; ++ai)
#pragma unroll
                for (int m = 0; m < 4; ++m) { bf16_t* rowp = base + (size_t)(row0 + ai * HALF + m * 16) * ld + col0;
#pragma unroll
                    for (int bj = 0; bj < 2; ++bj) { const f32x4 v0 = acc[ai][bj][m][0], v1 = acc[ai][bj][m][1]; u32x4 w;
                        w.x = cvt_pk_bf16(v0[0], v0[1]); w.y = cvt_pk_bf16(v0[2], v0[3]); w.z = cvt_pk_bf16(v1[0], v1[1]); w.w = cvt_pk_bf16(v1[2], v1[3]);
                        *(u32x4*)(rowp + bj * HALF) = w; } }
        } else if (wc < 2) {
#pragma unroll
            for (int ai = 0; ai < 2; ++ai)
#pragma unroll
                for (int m = 0; m < 4; ++m) { float* rp = DT + (size_t)(row0 + ai * HALF + m * 16) * 64 + wc * 32 + 8 * fq;
                    *(f32x4*)rp = acc[ai][0][m][0]; *(f32x4*)(rp + 4) = acc[ai][0][m][1]; }
        }
    }
};
template <int MODE> struct EpiGlu {
    static constexpr bool PERM = false, AFTER_DRAIN = false;
    bf16_t* O; int ldo; const float* bias; int H;
    __device__ __forceinline__ void operator()(const f32x4 (&acc)[2][2][4][2], const Unit& u, int wr_, int wc_, int fr_, int fq_) const {
        const int t_ = olane(), wr = wr_, wc = wc_, fr = t_ & 15, fq = t_ >> 4; (void)fr_; (void)fq_;
        const int row0 = u.pm * BM + wr * 64 + fr;
#pragma unroll
        for (int bj = 0; bj < 2; ++bj) {
            const int f0 = 16 * (8 * u.pn + 4 * bj + wc) + 4 * fq;
            f32x4 ba = (f32x4){0.f, 0.f, 0.f, 0.f}, bu = ba;
            if (MODE == 1) { ba = *(const f32x4*)(bias + f0); bu = *(const f32x4*)(bias + H + f0); }
#pragma unroll
            for (int ai = 0; ai < 2; ++ai)
#pragma unroll
                for (int m = 0; m < 4; ++m) { const f32x4 a = acc[ai][bj][m][0] + ba, g = acc[ai][bj][m][1] + bu; float o[4];
#pragma unroll
                    for (int j = 0; j < 4; ++j) o[j] = MODE == 0 ? a[j] * fast_sigmoid(a[j]) * g[j] : a[j] * fast_sigmoid(g[j]);
                    u32x2 w; w.x = cvt_pk_bf16(o[0], o[1]); w.y = cvt_pk_bf16(o[2], o[3]);
                    *(u32x2*)(O + (size_t)(row0 + ai * HALF + m * 16) * ldo + f0) = w; }
        }
    }
};
template <int NBJ> struct EpiResid {
    static constexpr bool PERM = false, AFTER_DRAIN = false;
    const float* xlo; const float* xhi; float* xout; const float* mods_l; int g_off; const float* bias;
    __device__ __forceinline__ void operator()(const f32x4 (&acc)[2][2][4][2], const Unit& u, int wr_, int wc_, int fr_, int fq_) const {
        const int t_ = olane(), wr = wr_, wc = wc_, fr = t_ & 15, fq = t_ >> 4; (void)fr_; (void)fq_;
        const int cond = u.pm < 16 ? 0 : 1 + ((u.pm - 16) >> 2);
        const float* gate = mods_l + (size_t)cond * 6144 + g_off; const float* xin = u.pm < 16 ? xlo : xhi;
        const int row0 = u.pm * BM + wr * 64 + fr, col0 = u.pn * (HALF * NBJ) + wc * 32 + 4 * fq;
#pragma unroll
        for (int bj = 0; bj < NBJ; ++bj)
#pragma unroll
            for (int n = 0; n < 2; ++n) { const int c = col0 + bj * HALF + n * 16; const f32x4 g4 = *(const f32x4*)(gate + c);
                const f32x4 b4 = bias ? *(const f32x4*)(bias + c) : (f32x4){0.f, 0.f, 0.f, 0.f};
#pragma unroll
                for (int ai = 0; ai < 2; ++ai)
#pragma unroll
                    for (int m = 0; m < 4; ++m) { const size_t off = (size_t)(row0 + ai * HALF + m * 16) * 1024 + c;
                        const f32x4 xo = *(const f32x4*)(xin + off); *(f32x4*)(xout + off) = xo + g4 * (acc[ai][bj][m][n] + b4); } }
    }
};

template <class Epi, class Sched, bool ALIGN_EPI = false, bool SP2 = false, bool HALFN = false>
__device__ __forceinline__ void gemm_phase(PG8_LAS unsigned char* lds, const Gemm g, const Sched& S, const Epi& E, const int wave_in) {
    const int tid = wave_in * 64 + olane(), wid = __builtin_amdgcn_readfirstlane(tid >> 6), lane = tid & 63, wr = wid >> 2, wc = wid & 3, fr = lane & 15, fq = lane >> 4;
    const int K = g.K, nt = K / BK;
    unsigned voffA[2], voffB[2];
#pragma unroll
    for (int i = 0; i < 2; ++i) { int R, C; stage_rc(tid * 16 + i * 8192, R, C); const int Rb = Epi::PERM ? ((R & ~31) + perm32(R & 31)) : R;
        voffA[i] = (unsigned)(R * K + C) * 2u; voffB[i] = (unsigned)(Rb * K + C) * 2u; }
    const size_t kstep = (size_t)(BK * 2);
    const size_t hstep = (size_t)HALF * K * 2;
    const size_t tstep = 2 * hstep;
    const size_t bstep = HALFN ? hstep : tstep;
    static_assert(!HALFN || SP2, "HALFN is written for the SP2 loop only");
    const unsigned ldsw = (unsigned)wid * 1024u;
    const int aoff = lds_byte(wr * 64 + fr, fq * 8), boff = lds_byte(wc * 32 + fr, fq * 8);
#define PG8_SA(b, h) (((b) * 2 + (h)) * HTB)
#define PG8_SB(b, h) ((4 + (b) * 2 + (h)) * HTB)
#define PG8_STAGE(bufoff, gbase, voff) do { _Pragma("unroll") for (int _i = 0; _i < 2; ++_i) \
        __builtin_amdgcn_global_load_lds((const unsigned*)((const char*)(gbase) + (voff)[_i]), (PG8_LAS unsigned*)(lds + (bufoff) + ldsw + _i * 8192), 16, 0, 0); } while (0)
#define PG8_LDA(dst, b, h) do { _Pragma("unroll") for (int m = 0; m < 4; ++m) _Pragma("unroll") for (int k = 0; k < 2; ++k) dst[m][k] = *(const PG8_LAS bf16x8*)(lds + PG8_SA(b, h) + aoff + m * 2048 + k * 1024); } while (0)
#define PG8_LDB(dst, b, h) do { _Pragma("unroll") for (int n = 0; n < 2; ++n) _Pragma("unroll") for (int k = 0; k < 2; ++k) dst[n][k] = *(const PG8_LAS bf16x8*)(lds + PG8_SB(b, h) + boff + n * 2048 + k * 1024); } while (0)
#define PG8_MMA(ai, bj, At, Bt) do { __builtin_amdgcn_s_setprio(1); _Pragma("unroll") for (int m = 0; m < 4; ++m) _Pragma("unroll") for (int n = 0; n < 2; ++n) _Pragma("unroll") for (int k = 0; k < 2; ++k) \
        acc[ai][bj][m][n] = __builtin_amdgcn_mfma_f32_16x16x32_bf16(Bt[n][k], At[m][k], acc[ai][bj][m][n], 0, 0, 0); __builtin_amdgcn_s_setprio(0); } while (0)
#define PG8_WAIT_V(n) asm volatile("s_waitcnt vmcnt(" #n ")" ::: "memory")
#define PG8_WAIT_L(n) asm volatile("s_waitcnt lgkmcnt(" #n ")" ::: "memory")
#define PG8_BAR __builtin_amdgcn_s_barrier()
#define PG8_SCHED __builtin_amdgcn_sched_barrier(0)
    Unit cur, nxt; int ui = 0;
    if (!S.next(0, cur)) return;
    f32x4 acc[2][2][4][2];
#pragma unroll
    for (int a = 0; a < 2; ++a)
#pragma unroll
        for (int b = 0; b < 2; ++b)
#pragma unroll
            for (int m = 0; m < 4; ++m)
#pragma unroll
                for (int n = 0; n < 2; ++n) acc[a][b][m][n] = (f32x4){0.f, 0.f, 0.f, 0.f};
    bf16x8 At[4][2], B0[2][2], B1[2][2];
    const char* cA = (const char*)g.A + (size_t)cur.pm * tstep; const char* cB = (const char*)g.Bt + (size_t)cur.pn * bstep;
    S.a_ready(cur);
    if constexpr (HALFN) {
        PG8_STAGE(PG8_SB(0, 0), cB, voffB); PG8_STAGE(PG8_SA(0, 0), cA, voffA); PG8_STAGE(PG8_SA(0, 1), cA + hstep, voffA);
        if (wr == 1) PG8_BAR;
        PG8_WAIT_V(2); PG8_BAR;
        PG8_STAGE(PG8_SB(1, 0), cB + kstep, voffB); PG8_STAGE(PG8_SA(1, 0), cA + kstep, voffA);
        PG8_WAIT_V(4); PG8_BAR;
    } else if constexpr (SP2) {
        PG8_STAGE(PG8_SB(0, 0), cB, voffB); PG8_STAGE(PG8_SB(0, 1), cB + hstep, voffB); PG8_STAGE(PG8_SA(0, 0), cA, voffA); PG8_STAGE(PG8_SA(0, 1), cA + hstep, voffA);
        if (wr == 1) PG8_BAR;
        PG8_WAIT_V(2); PG8_BAR;
        PG8_STAGE(PG8_SB(1, 0), cB + kstep, voffB); PG8_STAGE(PG8_SA(1, 0), cA + kstep, voffA); PG8_STAGE(PG8_SB(1, 1), cB + hstep + kstep, voffB);
        PG8_WAIT_V(6); PG8_BAR;
    } else {
        PG8_STAGE(PG8_SB(0, 0), cB, voffB); PG8_STAGE(PG8_SA(0, 0), cA, voffA); PG8_STAGE(PG8_SB(0, 1), cB + hstep, voffB); PG8_STAGE(PG8_SA(0, 1), cA + hstep, voffA);
        if (wr == 1) PG8_BAR;
        PG8_WAIT_V(4); PG8_BAR;
        PG8_STAGE(PG8_SB(1, 0), cB + kstep, voffB); PG8_STAGE(PG8_SA(1, 0), cA + kstep, voffA); PG8_STAGE(PG8_SB(1, 1), cB + hstep + kstep, voffB);
        PG8_WAIT_V(6); PG8_BAR;
    }
    for (;;) {
        const bool has_next = S.next(ui + 1, nxt);
        const char* nA = has_next ? (const char*)g.A + (size_t)nxt.pm * tstep : cA; const char* nB = has_next ? (const char*)g.Bt + (size_t)nxt.pn * bstep : cB;
        for (int t = 0; t < nt; t += 2) {
            const bool last = (t == nt - 2);
            const char* a1 = cA + (size_t)(t + 1) * kstep;
            const char* a2 = last ? nA : cA + (size_t)(t + 2) * kstep; const char* b2 = last ? nB : cB + (size_t)(t + 2) * kstep;
            const char* a3 = a2 + kstep; const char* b3 = b2 + kstep;
            if (last && has_next) S.a_ready(nxt);
            if constexpr (HALFN) {
            PG8_LDB(B0, 0, 0); PG8_SCHED; PG8_LDA(At, 0, 0); PG8_STAGE(PG8_SA(1, 1), a1 + hstep, voffA);
            PG8_WAIT_V(6); PG8_WAIT_L(0); PG8_BAR; PG8_MMA(0, 0, At, B0); PG8_BAR; PG8_SCHED;
            PG8_LDA(At, 0, 1); PG8_STAGE(PG8_SB(0, 0), b2, voffB); PG8_STAGE(PG8_SA(0, 0), a2, voffA);
            PG8_WAIT_V(6); PG8_WAIT_L(0); PG8_BAR; PG8_MMA(1, 0, At, B0); PG8_BAR; PG8_SCHED;
            PG8_LDB(B0, 1, 0); PG8_SCHED; PG8_LDA(At, 1, 0); PG8_STAGE(PG8_SA(0, 1), a2 + hstep, voffA);
            PG8_WAIT_V(6); PG8_WAIT_L(0); PG8_BAR; PG8_MMA(0, 0, At, B0); PG8_BAR; PG8_SCHED;
            PG8_LDA(At, 1, 1); PG8_STAGE(PG8_SB(1, 0), b3, voffB); PG8_STAGE(PG8_SA(1, 0), a3, voffA);
            PG8_WAIT_V(6); PG8_WAIT_L(0); PG8_BAR; PG8_MMA(1, 0, At, B0); PG8_BAR; PG8_SCHED;
            } else if constexpr (SP2) {
            PG8_LDB(B0, 0, 0); PG8_LDB(B1, 0, 1); PG8_SCHED; PG8_LDA(At, 0, 0); PG8_STAGE(PG8_SA(1, 1), a1 + hstep, voffA);
            PG8_WAIT_V(8); PG8_WAIT_L(0); PG8_BAR; PG8_MMA(0, 0, At, B0); PG8_MMA(0, 1, At, B1); PG8_BAR; PG8_SCHED;
            PG8_LDA(At, 0, 1); PG8_STAGE(PG8_SB(0, 0), b2, voffB); PG8_STAGE(PG8_SB(0, 1), b2 + hstep, voffB); PG8_STAGE(PG8_SA(0, 0), a2, voffA);
            PG8_WAIT_V(8); PG8_WAIT_L(0); PG8_BAR; PG8_MMA(1, 0, At, B0); PG8_MMA(1, 1, At, B1); PG8_BAR; PG8_SCHED;
            PG8_LDB(B0, 1, 0); PG8_LDB(B1, 1, 1); PG8_SCHED; PG8_LDA(At, 1, 0); PG8_STAGE(PG8_SA(0, 1), a2 + hstep, voffA);
            PG8_WAIT_V(8); PG8_WAIT_L(0); PG8_BAR; PG8_MMA(0, 0, At, B0); PG8_MMA(0, 1, At, B1); PG8_BAR; PG8_SCHED;
            PG8_LDA(At, 1, 1); PG8_STAGE(PG8_SB(1, 0), b3, voffB); PG8_STAGE(PG8_SB(1, 1), b3 + hstep, voffB); PG8_STAGE(PG8_SA(1, 0), a3, voffA);
            PG8_WAIT_V(8); PG8_WAIT_L(0); PG8_BAR; PG8_MMA(1, 0, At, B0); PG8_MMA(1, 1, At, B1); PG8_BAR; PG8_SCHED;
            } else {
            PG8_LDB(B0, 0, 0); PG8_SCHED; PG8_LDA(At, 0, 0); PG8_STAGE(PG8_SA(1, 1), a1 + hstep, voffA);
            PG8_WAIT_L(8); PG8_BAR; PG8_WAIT_L(0); PG8_MMA(0, 0, At, B0); PG8_BAR; PG8_SCHED;
            PG8_LDB(B1, 0, 1); PG8_STAGE(PG8_SB(0, 0), b2, voffB);
            PG8_BAR; PG8_WAIT_L(0); PG8_MMA(0, 1, At, B1); PG8_BAR;
            PG8_LDA(At, 0, 1); PG8_STAGE(PG8_SA(0, 0), a2, voffA);
            PG8_BAR; PG8_WAIT_L(0); PG8_MMA(1, 0, At, B0); PG8_BAR; PG8_SCHED;
            PG8_STAGE(PG8_SB(0, 1), b2 + hstep, voffB);
            PG8_WAIT_V(6); PG8_BAR; PG8_MMA(1, 1, At, B1); PG8_BAR;
            PG8_LDB(B0, 1, 0); PG8_SCHED; PG8_LDA(At, 1, 0); PG8_STAGE(PG8_SA(0, 1), a2 + hstep, voffA);
            PG8_WAIT_L(8); PG8_BAR; PG8_WAIT_L(0); PG8_MMA(0, 0, At, B0); PG8_BAR; PG8_SCHED;
            PG8_LDB(B1, 1, 1); PG8_STAGE(PG8_SB(1, 0), b3, voffB);
            PG8_BAR; PG8_WAIT_L(0); PG8_MMA(0, 1, At, B1); PG8_BAR;
            PG8_LDA(At, 1, 1); PG8_STAGE(PG8_SA(1, 0), a3, voffA);
            PG8_BAR; PG8_WAIT_L(0); PG8_MMA(1, 0, At, B0); PG8_BAR; PG8_SCHED;
            PG8_STAGE(PG8_SB(1, 1), b3 + hstep, voffB);
            PG8_WAIT_V(6); PG8_BAR; PG8_MMA(1, 1, At, B1); PG8_BAR;
            }
        }
        if constexpr (ALIGN_EPI) { if (wr == 0) PG8_BAR; }
        if constexpr (!Epi::AFTER_DRAIN) { E(acc, cur, wr, wc, fr, fq); S.done(cur); }
        if (!has_next) break;
#pragma unroll
        for (int a = 0; a < 2; ++a)
#pragma unroll
            for (int b = 0; b < 2; ++b)
#pragma unroll
                for (int m = 0; m < 4; ++m)
#pragma unroll
                    for (int n = 0; n < 2; ++n) acc[a][b][m][n] = (f32x4){0.f, 0.f, 0.f, 0.f};
        cur = nxt; cA = nA; cB = nB; ++ui;
        if constexpr (ALIGN_EPI) { if (wr == 1) PG8_BAR; }
    }
    PG8_WAIT_V(0);
    if constexpr (!ALIGN_EPI) { if (wr == 0) PG8_BAR; }
    PG8_BAR;
    if constexpr (Epi::AFTER_DRAIN) { E.fused(acc, cur, wr, wc, fr, fq, lds, wid, lane); S.done(cur); }
#undef PG8_SA
#undef PG8_SB
#undef PG8_STAGE
#undef PG8_LDA
#undef PG8_LDB
#undef PG8_MMA
#undef PG8_WAIT_V
#undef PG8_WAIT_L
#undef PG8_BAR
#undef PG8_SCHED
}
}
constexpr int NWAVES = 8, NTHR = 512;
constexpr size_t MiB = 1u << 20;
constexpr size_t WS_CTL = 0, CTL_ZERO_BYTES = 1 * MiB;
constexpr size_t WS_MODS = 256 * 1024;
constexpr size_t WS_ROPE = 1 * MiB;
constexpr size_t WS_W = 2 * MiB;
constexpr size_t W_MLA = WS_W, MLA_WB = 5898240;
constexpr size_t MW_CAT = 0, MW_UQ = 1572864, MW_UKV = 2752512, MW_O = 3801088;
constexpr size_t W_CV1 = WS_W + 2 * MLA_WB, W_CV2 = W_CV1 + 4 * MiB;
constexpr size_t W_SSI = W_CV2 + 2 * MiB, W_SSO = W_SSI + 11010048;
constexpr size_t W_FF = W_SSO + 4 * MiB, FF_WB = 17301504, FW_IN = 0, FW_OUT = 11534336;
static_assert(W_FF + 4 * FF_WB <= 102 * MiB, "weights region");
constexpr size_t WS_H = 102 * MiB;
constexpr size_t WS_CKV = 118 * MiB, CKV_B = (size_t)(T + NCTX) * KVL * 2;
constexpr size_t WS_AR = 128 * MiB;
constexpr size_t A_LAT = WS_AR, A_QN = A_LAT + 24 * MiB, A_QRAW = A_QN + 6 * MiB, A_KVRAW = A_QRAW + 24 * MiB, A_QB = A_KVRAW + 36 * MiB, A_KB = A_QB + 24 * MiB, A_AO = A_KB + 27 * MiB;
constexpr size_t A_U = WS_AR, A_V = A_U + 16 * MiB;
constexpr size_t A_Z = WS_AR, A_XPRE = A_Z + 32 * MiB, A_DTRAW = A_XPRE + 48 * MiB, A_XBC = A_DTRAW + 2 * MiB, A_DT = A_XBC + 48 * MiB, A_Y = A_DT + 2 * MiB, A_YN = A_XPRE;
constexpr size_t A_ACT = WS_AR + 200 * MiB;
static_assert(A_AO + 16 * MiB <= A_ACT && A_Y + 64 * MiB <= A_ACT && A_ACT + 44 * MiB <= 384 * MiB, "arena map");
constexpr int CW_BAR = 4096;
constexpr int LDS_BYTES = 163840, RING_BYTES = 131072, MISC_OFF = 163840 - 256, PTAB_OFF_C = MISC_OFF - 512;

#define GAS __attribute__((address_space(1)))
#define LAS __attribute__((address_space(3)))
typedef unsigned short bf16;
typedef unsigned v4u __attribute__((ext_vector_type(4)));
typedef unsigned v2u __attribute__((ext_vector_type(2)));
typedef float v4f __attribute__((ext_vector_type(4)));
typedef float v2f __attribute__((ext_vector_type(2)));
typedef GAS unsigned gu32;
#define LDS_WAIT() asm volatile("s_waitcnt lgkmcnt(0)" ::: "memory")
#define VM_WAIT() asm volatile("s_waitcnt vmcnt(0)" ::: "memory")
__device__ __forceinline__ unsigned f2bf(float f) { unsigned u = __builtin_bit_cast(unsigned, f); return (u + 0x7fffu + ((u >> 16) & 1u)) >> 16; }
__device__ __forceinline__ unsigned pk2(float lo, float hi) { return f2bf(lo) | (f2bf(hi) << 16); }
__device__ __forceinline__ float bflo(unsigned u) { return __builtin_bit_cast(float, u << 16); }
__device__ __forceinline__ float bfhi(unsigned u) { return __builtin_bit_cast(float, u & 0xffff0000u); }
__device__ __forceinline__ float bf2f(bf16 b) { return __builtin_bit_cast(float, (unsigned)b << 16); }

#define XB_TMO      128
#define XB_XCNT(j)  (256  + 64 * (j))
#define XB_XSUB(j)  (1280 + 64 * (j))
#define XB_XGEN(j)  (2304 + 64 * (j))
#define XB_TOP      3328
#define XB_TOPGEN   3392
#define XCD_BAR_WORDS 3456
#define XB_SPIN_CAP (1u << 18)

__device__ __forceinline__ unsigned xb_ld(unsigned* p)              { return __hip_atomic_load(p, __ATOMIC_RELAXED, __HIP_MEMORY_SCOPE_AGENT); }
__device__ __forceinline__ unsigned xb_add(unsigned* p, unsigned v) { return __hip_atomic_fetch_add(p, v, __ATOMIC_RELAXED, __HIP_MEMORY_SCOPE_AGENT); }
__device__ __forceinline__ unsigned xb_xcc_id() { return (unsigned)__builtin_amdgcn_s_getreg((3 << 11) | 20) & 0xFu; }
#define XB_SPIN(cond, bar) do { unsigned _sp = 0; while (cond) { __builtin_amdgcn_s_sleep(1); \
    if ((++_sp & 255u) == 0u) { if (xb_ld(&(bar)[XB_TMO])) break; if (_sp > XB_SPIN_CAP) { atomicAdd(&(bar)[XB_TMO], 1u); break; } } } } while (0)

struct XcdBarrier {
    unsigned* bar; unsigned x;
    volatile LAS unsigned* st;
};

__device__ __forceinline__ XcdBarrier xcd_barrier_post(unsigned* bar, volatile LAS unsigned* st) {
    XcdBarrier b; b.bar = bar; b.x = xb_xcc_id(); b.st = st;
    if (threadIdx.x == 0) (void)xb_add(&bar[XB_XCNT(b.x)], 1u);
    return b;
}
__device__ __forceinline__ void xcd_barrier_complete(unsigned* bar, unsigned x, unsigned& nloc, unsigned& nx) {
    const unsigned G = gridDim.x * gridDim.y * gridDim.z;
    unsigned sum, cnt, mine, sp = 0u;
    for (;;) {
        sum = 0u; cnt = 0u; mine = 0u;
#pragma unroll
        for (unsigned j = 0; j < 16; ++j) { const unsigned c = xb_ld(&bar[XB_XCNT(j)]); sum += c; cnt += (c > 0u) ? 1u : 0u; mine = (j == x) ? c : mine; }
        if (sum == G) break;
        __builtin_amdgcn_s_sleep(1);
        if ((++sp & 255u) == 0u) { if (xb_ld(&bar[XB_TMO])) break; if (sp > XB_SPIN_CAP) { atomicAdd(&bar[XB_TMO], 1u); break; } }
    }
    nloc = mine > 0u ? mine : 1u; nx = cnt > 0u ? cnt : 1u;
}

__device__ __forceinline__ void xcd_barrier(const XcdBarrier& b) {
    asm volatile("s_waitcnt vmcnt(0)" ::: "memory");
    __syncthreads();
    if (threadIdx.x == 0) {
        unsigned* bar = b.bar;
        __builtin_amdgcn_s_waitcnt(0);
        unsigned nloc = b.st[0], nx = b.st[1];
        if (nloc == 0u) { xcd_barrier_complete(bar, b.x, nloc, nx); b.st[0] = nloc; b.st[1] = nx; }
        const unsigned old = xb_add(&bar[XB_XSUB(b.x)], 1u);
        const unsigned gen = old / nloc;
        if (old + 1u == (gen + 1u) * nloc) {
            __builtin_amdgcn_fence(__ATOMIC_RELEASE, "agent");
            asm volatile("s_waitcnt vmcnt(0)" ::: "memory");
            const unsigned og = xb_add(&bar[XB_TOP], 1u);
            const unsigned tg = og / nx;
            if (og + 1u == (tg + 1u) * nx) xb_add(&bar[XB_TOPGEN], 1u);
            else XB_SPIN(xb_ld(&bar[XB_TOPGEN]) == tg, bar);
            __builtin_amdgcn_fence(__ATOMIC_ACQUIRE, "agent");
            xb_add(&bar[XB_XGEN(b.x)], 1u);
            asm volatile("s_waitcnt vmcnt(0)" ::: "memory");
        } else {
            XB_SPIN(xb_ld(&bar[XB_XGEN(b.x)]) == gen, bar);
            __builtin_amdgcn_fence(__ATOMIC_ACQUIRE, "agent");
            asm volatile("s_waitcnt vmcnt(0)" ::: "memory");
        }
    }
    __syncthreads();
}

struct Frame {
    LAS unsigned char* lds; int tid, lane, wave, vcu, G, gw, NGW, bx;
    volatile LAS unsigned* PT;
};
constexpr int PT_OUT = 38, PT_WS = 39;
__device__ __forceinline__ const float* ldp(volatile LAS unsigned* PT, int k) {
    const unsigned lo = __builtin_amdgcn_readfirstlane(PT[2 * k]), hi = __builtin_amdgcn_readfirstlane(PT[2 * k + 1]);
    return (const float*)(((unsigned long long)hi << 32) | lo);
}
#define INP(k) ldp(F.PT, (k))
#define WSP ((unsigned char*)ldp(F.PT, PT_WS))
#define OUTP ((float*)ldp(F.PT, PT_OUT))
enum InIdx { I_XP = 0, I_XS, I_CCKV, I_CKPE, I_SSM, I_C, I_CCTX, I_WADA, I_BADA, I_GN1, I_GN2, I_WDQ, I_GQ, I_WUQ, I_WDKV, I_GKV, I_WUKV, I_GQN, I_GKN, I_WO,
             I_CVW1, I_CVB1, I_CVWD, I_CVBD, I_CVGL, I_CVBL, I_CVW2, I_CVB2, I_SSWI, I_SSWC, I_SSBC, I_SSDTB, I_SSAL, I_SSD, I_SSGN, I_SSWO, I_FFWI, I_FFWO };
__device__ __forceinline__ float shx(float v, int lane, int o) { return __builtin_bit_cast(float, __builtin_amdgcn_ds_bpermute((lane ^ o) << 2, __builtin_bit_cast(int, v))); }
__device__ __forceinline__ float wsum(float v, int lane) {
#pragma unroll
    for (int o = 1; o < 64; o <<= 1) v += shx(v, lane, o);
    return v;
}
constexpr float QSCALE = 0.10206207261596577f * 1.4426950408889634f;

__device__ __forceinline__ void p0_transpose_item(const float* W, int K, int N, bf16* WT, int mode, int H, int row_off, LAS float* scr, int item, int lane) {
    const int nblk = N / 32, kb = item / nblk, nb = item % nblk, k0 = 64 * kb, n0 = 32 * nb;
#pragma unroll 8
    for (int i = 0; i < 32; ++i) { const int kk = 2 * i + (lane >> 5); scr[kk * 33 + (lane & 31)] = W[(size_t)(k0 + kk) * N + n0 + (lane & 31)]; }
    LDS_WAIT(); asm volatile("" ::: "memory");
    const int c = lane & 7;
#pragma unroll
    for (int j = 0; j < 4; ++j) { const int n = (lane >> 3) + 8 * j, col = n0 + n; const LAS float* s = scr + (8 * c) * 33 + n;
        int drow;
        if (mode == 0) drow = row_off + col;
        else { const int f = col < H ? col : col - H; drow = 32 * (f >> 4) + (f & 15) + (col < H ? 0 : 16); }
        v4u o; o.x = pk2(s[0 * 33], s[1 * 33]); o.y = pk2(s[2 * 33], s[3 * 33]); o.z = pk2(s[4 * 33], s[5 * 33]); o.w = pk2(s[6 * 33], s[7 * 33]);
        *(GAS v4u*)(WT + (size_t)drow * K + k0 + 8 * c) = o; }
    LDS_WAIT(); asm volatile("" ::: "memory");
}
__device__ __forceinline__ void p0_job(int q, int& inp, size_t& soff, int& K, int& N, size_t& doff, int& mode, int& H, int& roff) {
    mode = 0; H = 0; roff = 0; soff = 0;
    if (q < 10) { const int j = q / 5, t = q % 5; const size_t wb = W_MLA + (size_t)j * MLA_WB;
        if (t == 0) { inp = I_WDQ; soff = (size_t)j * 1024 * 384; K = 1024; N = 384; doff = wb + MW_CAT; }
        else if (t == 1) { inp = I_WDKV; soff = (size_t)j * 1024 * 288; K = 1024; N = 288; doff = wb + MW_CAT; roff = 384; }
        else if (t == 2) { inp = I_WUQ; soff = (size_t)j * 384 * 1536; K = 384; N = 1536; doff = wb + MW_UQ; }
        else if (t == 3) { inp = I_WUKV; soff = (size_t)j * 256 * 2048; K = 256; N = 2048; doff = wb + MW_UKV; }
        else { inp = I_WO; soff = (size_t)j * 1024 * 1024; K = 1024; N = 1024; doff = wb + MW_O; } }
    else if (q == 10) { inp = I_CVW1; K = 1024; N = 2048; doff = W_CV1; mode = 1; H = 1024; }
    else if (q == 11) { inp = I_CVW2; K = 1024; N = 1024; doff = W_CV2; }
    else if (q == 12) { inp = I_SSWI; K = 1024; N = 5184; doff = W_SSI; }
    else if (q == 13) { inp = I_SSWO; K = 2048; N = 1024; doff = W_SSO; }
    else { const int l = (q - 14) >> 1, t = (q - 14) & 1;
        if (t == 0) { inp = I_FFWI; soff = (size_t)l * 1024 * 5632; K = 1024; N = 5632; doff = W_FF + (size_t)l * FF_WB + FW_IN; mode = 1; H = 2816; }
        else { inp = I_FFWO; soff = (size_t)l * 2816 * 1024; K = 2816; N = 1024; doff = W_FF + (size_t)l * FF_WB + FW_OUT; } }
}
constexpr int P0_NITEMS = 2 * ((1024 / 64) * (384 / 32) + (1024 / 64) * (288 / 32) + (384 / 64) * (1536 / 32) + (256 / 64) * (2048 / 32) + (1024 / 64) * (1024 / 32))
                        + (1024 / 64) * (2048 / 32) + (1024 / 64) * (1024 / 32) + (1024 / 64) * (5184 / 32) + (2048 / 64) * (1024 / 32)
                        + 4 * ((1024 / 64) * (5632 / 32) + (2816 / 64) * (1024 / 32));
__device__ __forceinline__ void p0_prologue(Frame& F) {
    unsigned char* ws = WSP;
    LAS float* s = (LAS float*)F.lds;
    for (int i = F.tid; i < 5 * 1024; i += NTHR) { const int cc = i >> 10, k = i & 1023; const float v = cc == 0 ? INP(I_CCTX)[k] : INP(I_C)[(cc - 1) * 1024 + k]; s[i] = v / (1.f + expf(-v)); }
    __syncthreads();
    float* mods = (float*)(ws + WS_MODS);
    for (int it = F.bx; it < 768; it += F.G) {
        const int l = it / 192, r = it % 192, cb = r / 16, ks = r % 16, n = cb * 512 + F.tid;
        const float* W = INP(I_WADA) + (size_t)l * 1024 * 6144 + (size_t)(ks * 64) * 6144 + n;
        float acc[5] = {0.f, 0.f, 0.f, 0.f, 0.f};
#pragma unroll 16
        for (int k = 0; k < 64; ++k) { const float wv = W[(size_t)k * 6144];
#pragma unroll
            for (int cc = 0; cc < 5; ++cc) acc[cc] += s[cc * 1024 + ks * 64 + k] * wv; }
        const float bb = ks == 0 ? INP(I_BADA)[l * 6144 + n] : 0.f;
#pragma unroll
        for (int cc = 0; cc < 5; ++cc) atomicAdd(&mods[((size_t)l * 5 + cc) * 6144 + n], acc[cc] + bb);
    }
    __syncthreads();
    LAS float* scr = (LAS float*)(F.lds + F.wave * 8448);
    for (int it = F.gw; it < P0_NITEMS; it += F.NGW) {
        int r = it, inp = 0, K = 64, N = 32, mode = 0, H = 0, roff = 0; size_t soff = 0, doff = 0;
#pragma unroll 1
        for (int q = 0; q < 22; ++q) { p0_job(q, inp, soff, K, N, doff, mode, H, roff); const int ni = (K / 64) * (N / 32); if (r < ni) break; r -= ni; }
        p0_transpose_item(INP(inp) + soff, K, N, (bf16*)(ws + doff), mode, H, roff, scr, r, F.lane);
    }
    for (int it = F.gw; it < 384; it += F.NGW) {
        bf16* rowp = it < 192 ? (bf16*)(ws + W_MLA + (it / 96) * MLA_WB + MW_CAT) + (size_t)(672 + it % 96) * 1024 : (bf16*)(ws + W_SSI) + (size_t)(5184 + it - 192) * 1024;
        const v4u z = {0u, 0u, 0u, 0u}; ((GAS v4u*)rowp)[F.lane] = z; ((GAS v4u*)rowp)[64 + F.lane] = z;
    }
    for (int it = F.gw; it < 2048; it += F.NGW) {
        const int j = it >> 10, rr = it & 1023, b = rr >> 8, sq = rr & 255;
        const v4f v = ((const GAS v4f*)(INP(I_CCKV) + (((size_t)b * 2 + j) * 256 + sq) * 256))[F.lane];
        v2u o; o.x = pk2(v.x, v.y); o.y = pk2(v.z, v.w);
        ((GAS v2u*)((bf16*)(ws + WS_CKV + j * CKV_B) + (size_t)(T + rr) * 256))[F.lane] = o;
    }
    if (F.bx == 0) for (int i = F.tid; i < 640; i += NTHR) { const int pos = i >> 3, fi = i & 7; const float p = (float)(pos < 16 ? pos : pos - 16);
        const float a = p * rope_inv(fi); float* tab = (float*)(ws + WS_ROPE); tab[2 * i] = cosf(a); tab[2 * i + 1] = sinf(a); }
}

__device__ __forceinline__ void rp_normmod(Frame& F, const float* xlo, const float* xhi, const float* g, const float* mods_l, int sh_off, int sc_off, bf16* h) {
    for (int base = F.gw; base < T; base += 4 * F.NGW) {
        v4f v[4][4]; float ss[4]; int rows[4];
#pragma unroll
        for (int k = 0; k < 4; ++k) { const int row = base + k * F.NGW; rows[k] = row < T ? row : base;
            const GAS v4f* xr = (const GAS v4f*)((rows[k] < TP ? xlo : xhi) + (size_t)rows[k] * 1024) + F.lane;
#pragma unroll
            for (int j = 0; j < 4; ++j) v[k][j] = xr[64 * j]; }
#pragma unroll
        for (int k = 0; k < 4; ++k) { float s = 0.f;
#pragma unroll
            for (int j = 0; j < 4; ++j) s += (v[k][j].x * v[k][j].x + v[k][j].y * v[k][j].y) + (v[k][j].z * v[k][j].z + v[k][j].w * v[k][j].w);
            ss[k] = s; }
#pragma unroll
        for (int o = 1; o < 64; o <<= 1) {
#pragma unroll
            for (int k = 0; k < 4; ++k) ss[k] += shx(ss[k], F.lane, o); }
#pragma unroll
        for (int j = 0; j < 4; ++j) { const int c = 4 * F.lane + 256 * j; const v4f g4 = *(const GAS v4f*)(g + c);
#pragma unroll
            for (int k = 0; k < 4; ++k) { const float r = rsqrtf(ss[k] * (1.f / 1024) + EPS); const float* m = mods_l + (size_t)cond_of_row(rows[k]) * 6144;
                const v4f sc = *(const GAS v4f*)(m + sc_off + c), sh = *(const GAS v4f*)(m + sh_off + c);
                const v4f o = v[k][j] * r * g4 * (sc + 1.f) + sh; v2u w; w.x = pk2(o.x, o.y); w.y = pk2(o.z, o.w);
                *(GAS v2u*)(h + (size_t)rows[k] * 1024 + c) = w; } }
    }
}
__device__ __forceinline__ void rp_mla_fin1(Frame& F, const float* lat, const float* gq, const float* gkv, bf16* qn, bf16* ckv, float* out, int j) {
    for (int row = F.gw; row < T; row += F.NGW) {
        const float* lr = lat + (size_t)row * 768;
        v2f q[3]; float ss = 0.f;
#pragma unroll
        for (int i = 0; i < 3; ++i) { q[i] = *(const GAS v2f*)(lr + 2 * F.lane + 128 * i); ss += q[i].x * q[i].x + q[i].y * q[i].y; }
        float r = rsqrtf(wsum(ss, F.lane) * (1.f / 384) + EPS);
#pragma unroll
        for (int i = 0; i < 3; ++i) { const int c = 2 * F.lane + 128 * i; *(GAS unsigned*)(qn + (size_t)row * 384 + c) = pk2(q[i].x * r * gq[c], q[i].y * r * gq[c + 1]); }
        v2f k[2]; ss = 0.f;
#pragma unroll
        for (int i = 0; i < 2; ++i) { k[i] = *(const GAS v2f*)(lr + 384 + 2 * F.lane + 128 * i); ss += k[i].x * k[i].x + k[i].y * k[i].y; }
        r = rsqrtf(wsum(ss, F.lane) * (1.f / 256) + EPS);
#pragma unroll
        for (int i = 0; i < 2; ++i) { const int c = 2 * F.lane + 128 * i; const float c0 = k[i].x * r * gkv[c], c1 = k[i].y * r * gkv[c + 1];
            *(GAS unsigned*)(ckv + (size_t)row * 256 + c) = pk2(c0, c1);
            if (row < TP) { v2f o; o.x = c0; o.y = c1; *(GAS v2f*)(out + OUT_CKV + (((size_t)(row >> 8) * 2 + j) * 256 + (row & 255)) * 256 + c) = o; } }
        if (row < TP && F.lane < 32) out[OUT_KPE + (((size_t)(row >> 8) * 2 + j) * 256 + (row & 255)) * 32 + F.lane] = lr[640 + F.lane];
    }
}
__device__ __forceinline__ void rope32_tab(float* pe, int t, const float* tab) {
    const v2f* tr = (const v2f*)tab + (t >> 6) * 8; const v2f* tc = (const v2f*)tab + (16 + (t & 63)) * 8;
#pragma unroll
    for (int i = 0; i < 8; ++i) {
        v2f cs = tr[i]; float x1 = pe[i], x2 = pe[i + 8]; pe[i] = x1 * cs.x - x2 * cs.y; pe[i + 8] = x2 * cs.x + x1 * cs.y;
        cs = tc[i]; x1 = pe[16 + i]; x2 = pe[24 + i]; pe[16 + i] = x1 * cs.x - x2 * cs.y; pe[24 + i] = x2 * cs.x + x1 * cs.y;
    }
}
__device__ __forceinline__ void ld8(const bf16* p, float* d) { const v4u w = *(const GAS v4u*)p; d[0] = bflo(w.x); d[1] = bfhi(w.x); d[2] = bflo(w.y); d[3] = bfhi(w.y); d[4] = bflo(w.z); d[5] = bfhi(w.z); d[6] = bflo(w.w); d[7] = bfhi(w.w); }
__device__ __forceinline__ void st8(bf16* p, const float* d) { v4u w; w.x = pk2(d[0], d[1]); w.y = pk2(d[2], d[3]); w.z = pk2(d[4], d[5]); w.w = pk2(d[6], d[7]); *(GAS v4u*)p = w; }
__device__ __forceinline__ void rp_mla_fin2(Frame& F, const bf16* qraw, const bf16* kvraw, const float* lat, const float* ckpe_j, const float* gqn, const float* gkn, const float* tab, bf16* Q, bf16* K) {
    for (int idx = F.bx * NTHR + F.tid; idx < T * 32; idx += F.G * NTHR) {
        const int row = idx >> 5, hd = (idx >> 1) & 15, hf = idx & 1; const bool latent = row >= TP; const int tl = (row - TP) & 1023;
        float v[48]; float ss = 0.f;
#pragma unroll
        for (int i = 0; i < 6; ++i) ld8(qraw + (size_t)row * 1536 + hd * 96 + hf * 48 + 8 * i, v + 8 * i);
#pragma unroll
        for (int d = 0; d < 48; ++d) ss += v[d] * v[d];
        ss += shx(ss, F.lane, 1);
        const float r = rsqrtf(ss * (1.f / 96) + EPS) * QSCALE;
#pragma unroll
        for (int d = 0; d < 48; ++d) v[d] = v[d] * r * gqn[hf * 48 + d];
        if (latent && hf) rope32_tab(v + 16, tl, tab);
#pragma unroll
        for (int i = 0; i < 6; ++i) st8(Q + ((size_t)row * 16 + hd) * 96 + hf * 48 + 8 * i, v + 8 * i);
    }
    asm volatile("" ::: "memory");
    for (int idx = F.bx * NTHR + F.tid; idx < (T + NCTX) * 32; idx += F.G * NTHR) {
        const int row = idx >> 5, hd = (idx >> 1) & 15, hf = idx & 1; const bool latent = row >= TP && row < T; const int tl = (row - TP) & 1023;
        float v[48]; float ss = 0.f;
        if (hf == 0) {
#pragma unroll
            for (int i = 0; i < 6; ++i) ld8(kvraw + (size_t)row * 2048 + hd * 128 + 8 * i, v + 8 * i);
        } else {
#pragma unroll
            for (int i = 0; i < 2; ++i) ld8(kvraw + (size_t)row * 2048 + hd * 128 + 48 + 8 * i, v + 8 * i);
            const float* kp = row < T ? lat + (size_t)row * 768 + 640 : ckpe_j + ((size_t)((row - T) >> 8) * 2 * 256 + ((row - T) & 255)) * 32;
#pragma unroll
            for (int i = 0; i < 8; ++i) { const v4f p4 = *(const GAS v4f*)(kp + 4 * i); v[16 + 4 * i] = p4.x; v[17 + 4 * i] = p4.y; v[18 + 4 * i] = p4.z; v[19 + 4 * i] = p4.w; }
        }
#pragma unroll
        for (int d = 0; d < 48; ++d) ss += v[d] * v[d];
        ss += shx(ss, F.lane, 1);
        const float r = rsqrtf(ss * (1.f / 96) + EPS);
#pragma unroll
        for (int d = 0; d < 48; ++d) v[d] = v[d] * r * gkn[hf * 48 + d];
        if (latent && hf) rope32_tab(v + 16, tl, tab);
#pragma unroll
        for (int i = 0; i < 6; ++i) st8(K + ((size_t)row * 16 + hd) * 96 + hf * 48 + 8 * i, v + 8 * i);
    }
}
__device__ __forceinline__ void rp_dwconv(Frame& F, const bf16* u, const float* wdw, const float* bdw, const float* gln, const float* bln, bf16* vout) {
    LAS float* red = (LAS float*)F.lds;
    const int c = 2 * F.tid;
    for (int it = F.vcu; it < T / 16; it += F.G) {
        const int row0 = 16 * it; int t0, L; row_pos(row0, t0, L);
        v2f w[31];
#pragma unroll
        for (int k = 0; k < 31; ++k) w[k] = *(const GAS v2f*)(wdw + k * 1024 + c);
        const v2f bb = *(const GAS v2f*)(bdw + c);
        float y0[16], y1[16];
#pragma unroll
        for (int r = 0; r < 16; ++r) { y0[r] = bb.x; y1[r] = bb.y; }
#pragma unroll
        for (int rr = 0; rr < 46; ++rr) {
            const int tt = t0 - 15 + rr; unsigned pk = 0u;
            if (tt >= 0 && tt < L) pk = *(const GAS unsigned*)(u + (size_t)(row0 - 15 + rr) * 1024 + c);
            const float u0 = bflo(pk), u1 = bfhi(pk);
#pragma unroll
            for (int k = 0; k < 31; ++k) { const int r = rr - k; if (r >= 0 && r < 16) { y0[r] += u0 * w[k].x; y1[r] += u1 * w[k].y; } }
        }
        float s[16];
#pragma unroll
        for (int r = 0; r < 16; ++r) s[r] = y0[r] + y1[r];
#pragma unroll
        for (int o = 1; o < 64; o <<= 1) {
#pragma unroll
            for (int r = 0; r < 16; ++r) s[r] += shx(s[r], F.lane, o); }
        __syncthreads();
        if (F.lane < 16) { float v = s[0];
#pragma unroll
            for (int r = 1; r < 16; ++r) v = F.lane == r ? s[r] : v;
            red[F.wave * 16 + F.lane] = v; }
        __syncthreads();
        float mean[16];
#pragma unroll
        for (int r = 0; r < 16; ++r) { float m = 0.f;
#pragma unroll
            for (int wv = 0; wv < 8; ++wv) m += red[wv * 16 + r];
            mean[r] = m * (1.f / 1024); }
#pragma unroll
        for (int r = 0; r < 16; ++r) { y0[r] -= mean[r]; y1[r] -= mean[r]; s[r] = y0[r] * y0[r] + y1[r] * y1[r]; }
#pragma unroll
        for (int o = 1; o < 64; o <<= 1) {
#pragma unroll
            for (int r = 0; r < 16; ++r) s[r] += shx(s[r], F.lane, o); }
        __syncthreads();
        if (F.lane < 16) { float v = s[0];
#pragma unroll
            for (int r = 1; r < 16; ++r) v = F.lane == r ? s[r] : v;
            red[F.wave * 16 + F.lane] = v; }
        __syncthreads();
        const v2f gg = *(const GAS v2f*)(gln + c), bl = *(const GAS v2f*)(bln + c);
#pragma unroll
        for (int r = 0; r < 16; ++r) { float q = 0.f;
#pragma unroll
            for (int wv = 0; wv < 8; ++wv) q += red[wv * 16 + r];
            const float rs = rsqrtf(q * (1.f / 1024) + EPS);
            const float z0 = y0[r] * rs * gg.x + bl.x, z1 = y1[r] * rs * gg.y + bl.y;
            *(GAS unsigned*)(vout + (size_t)(row0 + r) * 1024 + c) = pk2(z0 / (1.f + __expf(-z0)), z1 / (1.f + __expf(-z1))); }
    }
    __syncthreads();
}
__device__ __forceinline__ void rp_ssd_conv(Frame& F, const bf16* xpre, const float* dtraw, const float* wc, const float* bc, const float* dtb, bf16* xbc, float* dt) {
    for (int idx = F.bx * NTHR + F.tid; idx < (T / 32) * 384; idx += F.G * NTHR) {
        const int seg = idx / 384, cg = idx - seg * 384, c0 = 8 * cg, row0 = 32 * seg; int t0, L; row_pos(row0, t0, L);
        float w[5][8], bias[8];
#pragma unroll
        for (int k = 0; k < 5; ++k) { const v4f a = *(const GAS v4f*)(wc + k * 3072 + c0), b2 = *(const GAS v4f*)(wc + k * 3072 + c0 + 4);
            w[k][0] = a.x; w[k][1] = a.y; w[k][2] = a.z; w[k][3] = a.w; w[k][4] = b2.x; w[k][5] = b2.y; w[k][6] = b2.z; w[k][7] = b2.w; }
        { const v4f a = *(const GAS v4f*)(bc + c0), b2 = *(const GAS v4f*)(bc + c0 + 4); bias[0] = a.x; bias[1] = a.y; bias[2] = a.z; bias[3] = a.w; bias[4] = b2.x; bias[5] = b2.y; bias[6] = b2.z; bias[7] = b2.w; }
        float win[5][8];
#pragma unroll
        for (int k = 0; k < 4; ++k) { const int tt = t0 + k - 2;
            if (tt >= 0 && tt < L) ld8(xpre + (size_t)(row0 + k - 2) * 3072 + c0, win[k + 1]);
            else {
#pragma unroll
                for (int i = 0; i < 8; ++i) win[k + 1][i] = 0.f; } }
#pragma unroll 4
        for (int r = 0; r < 32; ++r) {
#pragma unroll
            for (int k = 0; k < 4; ++k)
#pragma unroll
                for (int i = 0; i < 8; ++i) win[k][i] = win[k + 1][i];
            const int tt = t0 + r + 2;
            if (tt < L) ld8(xpre + (size_t)(row0 + r + 2) * 3072 + c0, win[4]);
            else {
#pragma unroll
                for (int i = 0; i < 8; ++i) win[4][i] = 0.f; }
            float a[8];
#pragma unroll
            for (int i = 0; i < 8; ++i) { float v = bias[i];
#pragma unroll
                for (int k = 0; k < 5; ++k) v += win[k][i] * w[k][i];
                a[i] = v / (1.f + __expf(-v)); }
            st8(xbc + (size_t)(row0 + r) * 3072 + c0, a);
        }
    }
    for (int idx = F.bx * NTHR + F.tid; idx < T * 16; idx += F.G * NTHR) {
        const int row = idx >> 4, e0 = 4 * (idx & 15); const v4f r4 = *(const GAS v4f*)(dtraw + (size_t)row * 64 + e0), b4 = *(const GAS v4f*)(dtb + e0);
        v4f o; o.x = softplus_f(r4.x + b4.x); o.y = softplus_f(r4.y + b4.y); o.z = softplus_f(r4.z + b4.z); o.w = softplus_f(r4.w + b4.w);
        *(GAS v4f*)(dt + (size_t)row * 64 + e0) = o; }
}
__device__ __forceinline__ void rp_ssd_gate(Frame& F, const float* y, const bf16* z, const float* gn, bf16* yn) {
    for (int row = F.gw; row < T; row += F.NGW) {
#pragma unroll
        for (int g = 0; g < 4; ++g) { const int c0 = g * 512 + 8 * F.lane; float zz[8], v[8]; ld8(z + (size_t)row * 2048 + c0, zz);
            const v4f y0 = *(const GAS v4f*)(y + (size_t)row * 2048 + c0), y1 = *(const GAS v4f*)(y + (size_t)row * 2048 + c0 + 4);
            v[0] = y0.x; v[1] = y0.y; v[2] = y0.z; v[3] = y0.w; v[4] = y1.x; v[5] = y1.y; v[6] = y1.z; v[7] = y1.w; float ss = 0.f;
#pragma unroll
            for (int i = 0; i < 8; ++i) { v[i] = v[i] * zz[i] / (1.f + __expf(-zz[i])); ss += v[i] * v[i]; }
            const float r = rsqrtf(wsum(ss, F.lane) * (1.f / 512) + EPS);
#pragma unroll
            for (int i = 0; i < 8; ++i) v[i] = v[i] * r * gn[c0 + i];
            st8(yn + (size_t)row * 2048 + c0, v); }
    }
}

typedef short a_bf16x8 __attribute__((ext_vector_type(8)));
typedef short a_s16x4 __attribute__((ext_vector_type(4)));
typedef float a_f32x16 __attribute__((ext_vector_type(16)));
typedef float a_f32x2 __attribute__((ext_vector_type(2))); typedef __bf16 a_bf16x2 __attribute__((ext_vector_type(2)));
__device__ __forceinline__ unsigned a_cvtpk(float lo, float hi) { a_f32x2 v = {lo, hi}; a_bf16x2 b = __builtin_convertvector(v, a_bf16x2); return __builtin_bit_cast(unsigned, b); }
__device__ __forceinline__ a_s16x4 a_vtr(const LAS unsigned char* p) { return __builtin_bit_cast(a_s16x4, __builtin_amdgcn_ds_read_tr16_b64_v4i16((LAS a_s16x4*)p)); }
constexpr int AT_KS = 208, AT_VS = 192, AT_KB = 64 * AT_KS, AT_VB = 64 * AT_VS, AT_VOFF = 2 * AT_KB;
__device__ __forceinline__ void ph_attn(Frame& F, const bf16* Q, const bf16* K, const bf16* KV, bf16* AO) {
    const int lane = F.lane, r32 = lane & 31, hi = lane >> 5, wave = F.wave, tid = F.tid;
    LAS unsigned char* lds = F.lds;
    const int kr_a = tid / 12, kp_a = tid % 12, kr_b = (tid + 512) / 12, kp_b = (tid + 512) % 12, vr = tid >> 3, vp = tid & 7;
    const bool has_b = tid < 256;
    for (int uu = F.vcu; uu < 512; uu += F.G) {
        int head, q0, NT, kbase_ctx, kbase_lat;
        if (uu < 256) { const int seq = uu >> 4; head = uu & 15; q0 = seq * 256; NT = 4; kbase_ctx = seq * 256; kbase_lat = 0; }
        else { const int u2 = uu - 256, b = u2 >> 6, qb = u2 & 3; head = (u2 >> 2) & 15; q0 = TP + b * 1024 + qb * 256; NT = 20; kbase_ctx = T + b * 256; kbase_lat = TP + b * 1024; }
        a_bf16x8 qf[6];
        { const bf16* qp = Q + ((size_t)(q0 + wave * 32 + r32) * 16 + head) * 96 + hi * 8;
#pragma unroll
          for (int s = 0; s < 6; ++s) qf[s] = *(const GAS a_bf16x8*)(qp + 16 * s); }
        a_f32x16 o0, o1;
#pragma unroll
        for (int r = 0; r < 16; ++r) { o0[r] = 0.f; o1[r] = 0.f; }
        float m = -INFINITY, l = 0.f;
        v4u ka, kb2, vv;
#define AT_LOAD(t) do { const int kr0_ = (t) < 4 ? kbase_ctx + 64 * (t) : kbase_lat + 64 * ((t) - 4); \
            ka = *(const GAS v4u*)(K + ((size_t)(kr0_ + kr_a) * 16 + head) * 96 + kp_a * 8); \
            if (has_b) kb2 = *(const GAS v4u*)(K + ((size_t)(kr0_ + kr_b) * 16 + head) * 96 + kp_b * 8); \
            vv = *(const GAS v4u*)(KV + (size_t)(kr0_ + vr) * 2048 + head * 128 + 64 + vp * 8); } while (0)
#define AT_STORE(buf) do { *(LAS v4u*)(lds + (buf) * AT_KB + kr_a * AT_KS + kp_a * 16) = ka; \
            if (has_b) *(LAS v4u*)(lds + (buf) * AT_KB + kr_b * AT_KS + kp_b * 16) = kb2; \
            *(LAS v4u*)(lds + AT_VOFF + (buf) * AT_VB + vr * AT_VS + vp * 16) = vv; } while (0)
        AT_LOAD(0); AT_STORE(0);
        __syncthreads();
        for (int t = 0; t < NT; ++t) {
            const int buf = t & 1;
            if (t + 1 < NT) AT_LOAD(t + 1);
            a_f32x16 p0, p1;
#pragma unroll
            for (int r = 0; r < 16; ++r) { p0[r] = 0.f; p1[r] = 0.f; }
            { const LAS unsigned char* kp = lds + buf * AT_KB + r32 * AT_KS + hi * 16;
#pragma unroll
              for (int s = 0; s < 6; ++s) { const a_bf16x8 a0 = *(const LAS a_bf16x8*)(kp + 32 * s), a1 = *(const LAS a_bf16x8*)(kp + 32 * AT_KS + 32 * s);
                  p0 = __builtin_amdgcn_mfma_f32_32x32x16_bf16(a0, qf[s], p0, 0, 0, 0); p1 = __builtin_amdgcn_mfma_f32_32x32x16_bf16(a1, qf[s], p1, 0, 0, 0); } }
            float mx = fmaxf(p0[0], p1[0]);
#pragma unroll
            for (int r = 1; r < 16; ++r) mx = fmaxf(mx, fmaxf(p0[r], p1[r]));
            mx = fmaxf(mx, shx(mx, lane, 32));
            const float mn = fmaxf(m, mx), alpha = __builtin_amdgcn_exp2f(m - mn); m = mn;
            float ps = 0.f;
#pragma unroll
            for (int r = 0; r < 16; ++r) { p0[r] = __builtin_amdgcn_exp2f(p0[r] - mn); p1[r] = __builtin_amdgcn_exp2f(p1[r] - mn); ps += p0[r] + p1[r]; }
            l = l * alpha + ps;
#pragma unroll
            for (int r = 0; r < 16; ++r) { o0[r] *= alpha; o1[r] *= alpha; }
            v4u pw[4];
            pw[0] = (v4u){a_cvtpk(p0[0], p0[1]), a_cvtpk(p0[2], p0[3]), a_cvtpk(p0[4], p0[5]), a_cvtpk(p0[6], p0[7])};
            pw[1] = (v4u){a_cvtpk(p0[8], p0[9]), a_cvtpk(p0[10], p0[11]), a_cvtpk(p0[12], p0[13]), a_cvtpk(p0[14], p0[15])};
            pw[2] = (v4u){a_cvtpk(p1[0], p1[1]), a_cvtpk(p1[2], p1[3]), a_cvtpk(p1[4], p1[5]), a_cvtpk(p1[6], p1[7])};
            pw[3] = (v4u){a_cvtpk(p1[8], p1[9]), a_cvtpk(p1[10], p1[11]), a_cvtpk(p1[12], p1[13]), a_cvtpk(p1[14], p1[15])};
            { const LAS unsigned char* vp0 = lds + AT_VOFF + buf * AT_VB + (4 * hi + ((lane & 15) >> 2)) * AT_VS + (16 * ((lane >> 4) & 1) + 4 * (lane & 3)) * 2;
#pragma unroll
              for (int bs = 0; bs < 4; ++bs) {
                  const LAS unsigned char* vq = vp0 + (16 * bs) * AT_VS;
                  const a_s16x4 l0 = a_vtr(vq), h0 = a_vtr(vq + 8 * AT_VS), l1 = a_vtr(vq + 64), h1 = a_vtr(vq + 8 * AT_VS + 64);
                  const a_bf16x8 v0 = (a_bf16x8){l0[0], l0[1], l0[2], l0[3], h0[0], h0[1], h0[2], h0[3]}, v1 = (a_bf16x8){l1[0], l1[1], l1[2], l1[3], h1[0], h1[1], h1[2], h1[3]};
                  const a_bf16x8 pb = __builtin_bit_cast(a_bf16x8, pw[bs]);
                  o0 = __builtin_amdgcn_mfma_f32_32x32x16_bf16(v0, pb, o0, 0, 0, 0); o1 = __builtin_amdgcn_mfma_f32_32x32x16_bf16(v1, pb, o1, 0, 0, 0); } }
            if (t + 1 < NT) AT_STORE(buf ^ 1);
            __syncthreads();
        }
#undef AT_LOAD
#undef AT_STORE
        l += shx(l, lane, 32);
        const float il = 1.f / l;
        bf16* op = AO + (size_t)(q0 + wave * 32 + r32) * 1024 + head * 64 + 4 * hi;
#pragma unroll
        for (int g4 = 0; g4 < 4; ++g4) {
            v2u w0; w0.x = a_cvtpk(o0[4 * g4] * il, o0[4 * g4 + 1] * il); w0.y = a_cvtpk(o0[4 * g4 + 2] * il, o0[4 * g4 + 3] * il); *(GAS v2u*)(op + 8 * g4) = w0;
            v2u w1; w1.x = a_cvtpk(o1[4 * g4] * il, o1[4 * g4 + 1] * il); w1.y = a_cvtpk(o1[4 * g4 + 2] * il, o1[4 * g4 + 3] * il); *(GAS v2u*)(op + 32 + 8 * g4) = w1; }
    }
}
constexpr int SC_ST = 272, SC_XS = 144;
constexpr int SC_C = 0, SC_B = 128 * SC_ST, SC_M = 2 * 128 * SC_ST, SC_H = 3 * 128 * SC_ST, SC_X = SC_H + 64 * SC_ST, SC_XW = SC_X + 128 * SC_XS, SC_ARR = SC_XW + 128 * SC_XS;
static_assert(SC_ARR + 4 * 128 * 4 + 16 <= PTAB_OFF_C, "scan LDS map");
__device__ __forceinline__ int a_crow(int r, int hi) { return (r & 3) + 8 * (r >> 2) + 4 * hi; }
__device__ __forceinline__ void ph_scan(Frame& F, const bf16* xbc, const float* dt, const float* alog, const float* dsk, const float* st0, float* y, float* out) {
    const int lane = F.lane, r32 = lane & 31, hi = lane >> 5, wave = F.wave, tid = F.tid;
    LAS unsigned char* lds = F.lds;
    LAS float* acum = (LAS float*)(lds + SC_ARR); LAS float* wj = acum + 128; LAS float* ei = acum + 256; LAS float* dtj = acum + 384; LAS float* misc = acum + 512;
    const int q4 = (lane & 15) >> 2, gg = (lane >> 4) & 1, p4 = lane & 3;
    const int ib = wave >> 1, pb = wave & 1, nb = wave >> 1;
    for (int slot = F.vcu; slot < 256; slot += F.G) {
        const int nitem = slot < 128 ? 1 : 4;
#pragma unroll 1
        for (int ii = 0; ii < nitem; ++ii) {
            int seq, hd;
            if (slot < 128) { seq = 16 + (slot >> 5); hd = slot & 31; } else { const int pi = 4 * (slot - 128) + ii; seq = pi >> 5; hd = pi & 31; }
            const int g = hd >> 3, r0 = seq < 16 ? seq * 256 : TP + (seq - 16) * 1024, nc = seq < 16 ? 2 : 8;
#pragma unroll 1
            for (int dir = 0; dir < 2; ++dir) {
                const float aa = -expf(alog[dir * 32 + hd]), dd = dsk[dir * 32 + hd];
                a_f32x16 hacc;
                if (seq < 16) {
#pragma unroll
                    for (int r = 0; r < 16; ++r) hacc[r] = 0.f;
                } else { const float* s0 = st0 + ((((size_t)(seq - 16) * 2 + dir) * 32 + hd) * 64 + 32 * pb + r32) * 128 + 32 * nb + 4 * hi;
#pragma unroll
                    for (int g4 = 0; g4 < 4; ++g4) { const v4f t4 = *(const GAS v4f*)(s0 + 8 * g4); hacc[4 * g4] = t4.x; hacc[4 * g4 + 1] = t4.y; hacc[4 * g4 + 2] = t4.z; hacc[4 * g4 + 3] = t4.w; } }
#pragma unroll
                for (int g4 = 0; g4 < 4; ++g4) { v2u w; w.x = a_cvtpk(hacc[4 * g4], hacc[4 * g4 + 1]); w.y = a_cvtpk(hacc[4 * g4 + 2], hacc[4 * g4 + 3]);
                    *(LAS v2u*)(lds + SC_H + (32 * pb + r32) * SC_ST + (32 * nb + 8 * g4 + 4 * hi) * 2) = w; }
#pragma unroll 1
                for (int cc = 0; cc < nc; ++cc) {
                    const int c = dir == 0 ? cc : nc - 1 - cc, row0 = r0 + c * 128;
                    __syncthreads();
                    v4u cr[4], br[4], xr[2];
#pragma unroll
                    for (int k = 0; k < 4; ++k) { const int q = tid + 512 * k, rr = q >> 4, pp = q & 15;
                        cr[k] = *(const GAS v4u*)(xbc + (size_t)(row0 + rr) * 3072 + 2560 + g * 128 + pp * 8); br[k] = *(const GAS v4u*)(xbc + (size_t)(row0 + rr) * 3072 + 2048 + g * 128 + pp * 8); }
#pragma unroll
                    for (int k = 0; k < 2; ++k) { const int q = tid + 512 * k, rr = q >> 3, pp = q & 7; xr[k] = *(const GAS v4u*)(xbc + (size_t)(row0 + rr) * 3072 + hd * 64 + pp * 8); }
                    if (wave == 0) {
                        const int i0 = dir == 0 ? lane : 127 - lane, i1 = dir == 0 ? lane + 64 : 63 - lane;
                        const float d0 = dt[(size_t)(row0 + i0) * 64 + dir * 32 + hd], d1 = dt[(size_t)(row0 + i1) * 64 + dir * 32 + hd];
                        float s0 = d0 * aa, s1 = d1 * aa;
#pragma unroll
                        for (int o = 1; o < 64; o <<= 1) { const float u0 = __builtin_bit_cast(float, __builtin_amdgcn_ds_bpermute((lane - o) << 2, __builtin_bit_cast(int, s0))), u1 = __builtin_bit_cast(float, __builtin_amdgcn_ds_bpermute((lane - o) << 2, __builtin_bit_cast(int, s1)));
                            if (lane >= o) { s0 += u0; s1 += u1; } }
                        const float tot0 = __builtin_bit_cast(float, __builtin_amdgcn_readlane(__builtin_bit_cast(int, s0), 63)); s1 += tot0;
                        const float last = __builtin_bit_cast(float, __builtin_amdgcn_readlane(__builtin_bit_cast(int, s1), 63));
                        acum[i0] = s0; acum[i1] = s1; dtj[i0] = d0; dtj[i1] = d1;
                        wj[i0] = d0 * expf(last - s0); wj[i1] = d1 * expf(last - s1); ei[i0] = expf(s0); ei[i1] = expf(s1);
                        if (lane == 0) misc[0] = expf(last);
                    }
                    __syncthreads();
#pragma unroll
                    for (int k = 0; k < 4; ++k) { const int q = tid + 512 * k, rr = q >> 4, pp = q & 15; *(LAS v4u*)(lds + SC_C + rr * SC_ST + pp * 16) = cr[k]; *(LAS v4u*)(lds + SC_B + rr * SC_ST + pp * 16) = br[k]; }
#pragma unroll
                    for (int k = 0; k < 2; ++k) { const int q = tid + 512 * k, rr = q >> 3, pp = q & 7; *(LAS v4u*)(lds + SC_X + rr * SC_XS + pp * 16) = xr[k];
                        const float w = wj[rr]; v4u s; s.x = a_cvtpk(bflo(xr[k].x) * w, bfhi(xr[k].x) * w); s.y = a_cvtpk(bflo(xr[k].y) * w, bfhi(xr[k].y) * w); s.z = a_cvtpk(bflo(xr[k].z) * w, bfhi(xr[k].z) * w); s.w = a_cvtpk(bflo(xr[k].w) * w, bfhi(xr[k].w) * w);
                        *(LAS v4u*)(lds + SC_XW + rr * SC_XS + pp * 16) = s; }
                    __syncthreads();
#pragma unroll 1
                    for (int tt = 0; tt < 2; ++tt) {
                        const int tl = 2 * wave + tt, jb = tl >> 2, ibg = tl & 3;
                        const bool dead = dir == 0 ? jb > ibg : jb < ibg;
                        a_f32x16 gt;
#pragma unroll
                        for (int r = 0; r < 16; ++r) gt[r] = 0.f;
                        if (!dead) {
                            const LAS unsigned char* ap = lds + SC_B + (32 * jb + r32) * SC_ST + hi * 16; const LAS unsigned char* bp = lds + SC_C + (32 * ibg + r32) * SC_ST + hi * 16;
#pragma unroll
                            for (int s = 0; s < 8; ++s) gt = __builtin_amdgcn_mfma_f32_32x32x16_bf16(*(const LAS a_bf16x8*)(ap + 32 * s), *(const LAS a_bf16x8*)(bp + 32 * s), gt, 0, 0, 0);
                            const int i = 32 * ibg + r32; const float ai = acum[i];
#pragma unroll
                            for (int r = 0; r < 16; ++r) { const int j = 32 * jb + a_crow(r, hi); const bool keep = dir == 0 ? j <= i : j >= i;
                                const float e = __builtin_amdgcn_exp2f(fminf(ai - acum[j], 0.f) * 1.4426950408889634f) * dtj[j];
                                gt[r] = keep ? gt[r] * e + (j == i ? dd : 0.f) : 0.f; }
                        }
#pragma unroll
                        for (int g4 = 0; g4 < 4; ++g4) { v2u w; w.x = a_cvtpk(gt[4 * g4], gt[4 * g4 + 1]); w.y = a_cvtpk(gt[4 * g4 + 2], gt[4 * g4 + 3]);
                            *(LAS v2u*)(lds + SC_M + (32 * ibg + r32) * SC_ST + (32 * jb + 8 * g4 + 4 * hi) * 2) = w; }
                    }
                    a_f32x16 yo;
#pragma unroll
                    for (int r = 0; r < 16; ++r) yo[r] = 0.f;
                    { const LAS unsigned char* ap = lds + SC_C + (32 * ib + r32) * SC_ST + hi * 16; const LAS unsigned char* bp = lds + SC_H + (32 * pb + r32) * SC_ST + hi * 16;
#pragma unroll
                      for (int s = 0; s < 8; ++s) yo = __builtin_amdgcn_mfma_f32_32x32x16_bf16(*(const LAS a_bf16x8*)(ap + 32 * s), *(const LAS a_bf16x8*)(bp + 32 * s), yo, 0, 0, 0); }
                    __syncthreads();
                    a_f32x16 yd;
#pragma unroll
                    for (int r = 0; r < 16; ++r) yd[r] = 0.f;
                    { const LAS unsigned char* ap = lds + SC_M + (32 * ib + r32) * SC_ST + hi * 16; const LAS unsigned char* xp = lds + SC_X + (8 * hi + q4) * SC_XS + (32 * pb + 16 * gg + 4 * p4) * 2;
#pragma unroll
                      for (int s = 0; s < 8; ++s) { const a_s16x4 l0 = a_vtr(xp + (16 * s) * SC_XS), h0 = a_vtr(xp + (16 * s + 4) * SC_XS);
                          const a_bf16x8 xb = (a_bf16x8){l0[0], l0[1], l0[2], l0[3], h0[0], h0[1], h0[2], h0[3]};
                          yd = __builtin_amdgcn_mfma_f32_32x32x16_bf16(*(const LAS a_bf16x8*)(ap + 32 * s), xb, yd, 0, 0, 0); } }
                    { float* yp = y + (size_t)(row0 + 32 * ib) * 2048 + hd * 64 + 32 * pb + r32;
#pragma unroll
                      for (int r = 0; r < 16; ++r) { const int i = a_crow(r, hi); const float v = yd[r] + ei[32 * ib + i] * yo[r]; float* p = yp + (size_t)i * 2048; *p = dir == 0 ? v : *p + v; } }
                    { const float dec = misc[0];
#pragma unroll
                      for (int r = 0; r < 16; ++r) hacc[r] *= dec;
                      const LAS unsigned char* bq = lds + SC_B + (8 * hi + q4) * SC_ST + (32 * nb + 16 * gg + 4 * p4) * 2; const LAS unsigned char* xq = lds + SC_XW + (8 * hi + q4) * SC_XS + (32 * pb + 16 * gg + 4 * p4) * 2;
#pragma unroll
                      for (int s = 0; s < 8; ++s) { const a_s16x4 bl = a_vtr(bq + (16 * s) * SC_ST), bh = a_vtr(bq + (16 * s + 4) * SC_ST), xl = a_vtr(xq + (16 * s) * SC_XS), xh = a_vtr(xq + (16 * s + 4) * SC_XS);
                          const a_bf16x8 av = (a_bf16x8){bl[0], bl[1], bl[2], bl[3], bh[0], bh[1], bh[2], bh[3]}, bv = (a_bf16x8){xl[0], xl[1], xl[2], xl[3], xh[0], xh[1], xh[2], xh[3]};
                          hacc = __builtin_amdgcn_mfma_f32_32x32x16_bf16(av, bv, hacc, 0, 0, 0); } }
#pragma unroll
                    for (int g4 = 0; g4 < 4; ++g4) { v2u w; w.x = a_cvtpk(hacc[4 * g4], hacc[4 * g4 + 1]); w.y = a_cvtpk(hacc[4 * g4 + 2], hacc[4 * g4 + 3]);
                        *(LAS v2u*)(lds + SC_H + (32 * pb + r32) * SC_ST + (32 * nb + 8 * g4 + 4 * hi) * 2) = w; }
                }
                if (seq < 16) { float* o = out + OUT_SSM + ((((size_t)seq * 2 + dir) * 32 + hd) * 64 + 32 * pb + r32) * 128 + 32 * nb + 4 * hi;
#pragma unroll
                    for (int g4 = 0; g4 < 4; ++g4) { v4f t4; t4.x = hacc[4 * g4]; t4.y = hacc[4 * g4 + 1]; t4.z = hacc[4 * g4 + 2]; t4.w = hacc[4 * g4 + 3]; *(GAS v4f*)(o + 8 * g4) = t4; } }
            }
        }
    }
    __syncthreads();
}

constexpr int NPHASE = 37;
enum Op { OP_P0, OP_NORM1, OP_G_LAT, OP_FIN1, OP_G_QKV, OP_FIN2, OP_ATTN, OP_G_WO, OP_NORM2, OP_G_FF1, OP_G_FF2, OP_G_PW1, OP_DWCONV, OP_G_PW2, OP_G_SSI, OP_SSCONV, OP_SCAN, OP_GATE, OP_G_SSO };
__device__ __forceinline__ void phase_decode(int ph, int& layer, int& op) {
    if (ph == 0) { layer = 0; op = OP_P0; return; }
    int r;
    if (ph <= 10) { layer = 0; r = ph - 1; } else if (ph <= 17) { layer = 1; r = ph - 11; } else if (ph <= 26) { layer = 2; r = ph - 18; } else { layer = 3; r = ph - 27; }
    const int kind = layer % 3;
    if (kind == 0) { op = r == 0 ? OP_NORM1 : r == 1 ? OP_G_LAT : r == 2 ? OP_FIN1 : r == 3 ? OP_G_QKV : r == 4 ? OP_FIN2 : r == 5 ? OP_ATTN : r == 6 ? OP_G_WO : r == 7 ? OP_NORM2 : r == 8 ? OP_G_FF1 : OP_G_FF2; }
    else if (kind == 1) { op = r == 0 ? OP_NORM1 : r == 1 ? OP_G_PW1 : r == 2 ? OP_DWCONV : r == 3 ? OP_G_PW2 : r == 4 ? OP_NORM2 : r == 5 ? OP_G_FF1 : OP_G_FF2; }
    else { op = r == 0 ? OP_NORM1 : r == 1 ? OP_G_SSI : r == 2 ? OP_SSCONV : r == 3 ? OP_SCAN : r == 4 ? OP_GATE : r == 5 ? OP_G_SSO : r == 6 ? OP_NORM2 : r == 7 ? OP_G_FF1 : OP_G_FF2; }
}
#ifndef MK_REPEAT_MASK
#define MK_REPEAT_MASK 0u
#endif
#ifndef MK_DOUBLE_BAR
#define MK_DOUBLE_BAR 0
#endif
struct MArgs { const float* in[38]; float* out; unsigned char* ws; int ph_lo, ph_hi; };
constexpr int PTAB_OFF = PTAB_OFF_C;
__global__ void __launch_bounds__(NTHR, 2) mega_fwd(MArgs args) {
    extern __shared__ __attribute__((aligned(16))) unsigned char lds_raw[];
    LAS unsigned char* lds = (LAS unsigned char*)lds_raw;
    volatile LAS unsigned* PT0 = (volatile LAS unsigned*)(lds + PTAB_OFF);
    volatile LAS unsigned* MISC = (volatile LAS unsigned*)(lds + MISC_OFF);
    { const int t0 = threadIdx.x;
      if (t0 < 40) { const unsigned long long p = t0 < 38 ? (unsigned long long)args.in[t0] : t0 == 38 ? (unsigned long long)args.out : (unsigned long long)args.ws;
          PT0[2 * t0] = (unsigned)p; PT0[2 * t0 + 1] = (unsigned)(p >> 32); }
      if (t0 < 64) MISC[t0] = 0u; }
    __syncthreads();
    XcdBarrier bar = xcd_barrier_post((unsigned*)((unsigned char*)ldp(PT0, PT_WS) + WS_CTL) + CW_BAR, MISC + 8);
    const int wave0 = __builtin_amdgcn_readfirstlane(threadIdx.x >> 6);
    const int ph_hi = args.ph_hi; bool redo_ = false;
    for (int ph = args.ph_lo; ph < ph_hi; ++ph) {
        Frame F;
        { int w = wave0; asm volatile("" : "+s"(w)); F.wave = w; }
        F.lds = lds; F.lane = olane(); F.tid = F.wave * 64 + F.lane;
        const int bx = obid();
        F.G = gridDim.x; F.vcu = (F.G % 8 == 0) ? (bx % 8) * (F.G / 8) + bx / 8 : bx;
        F.gw = F.vcu * NWAVES + F.wave; F.NGW = F.G * NWAVES; F.PT = PT0; F.bx = bx;
        int layer, op; phase_decode(ph, layer, op);
        const int j = layer / 3;
        switch (op) {
        case OP_P0: p0_prologue(F); break;
        case OP_NORM1: { unsigned char* ws = WSP; float* x = OUTP; const float* xlo = layer == 0 ? INP(I_XP) : x; const float* xhi = layer == 0 ? INP(I_XS) - (size_t)TP * 1024 : x;
            rp_normmod(F, xlo, xhi, INP(I_GN1) + layer * 1024, (const float*)(ws + WS_MODS) + (size_t)layer * 5 * 6144, 0, 1024, (bf16*)(ws + WS_H)); } break;
        case OP_NORM2: { unsigned char* ws = WSP; float* x = OUTP;
            rp_normmod(F, x, x, INP(I_GN2) + layer * 1024, (const float*)(ws + WS_MODS) + (size_t)layer * 5 * 6144, 3072, 4096, (bf16*)(ws + WS_H)); } break;
        case OP_G_LAT: { unsigned char* ws = WSP; pg8::Gemm g{(const bf16*)(ws + WS_H), (const bf16*)(ws + W_MLA + j * MLA_WB + MW_CAT), T, 768, 1024}; pg8::StaticOrder S; S.init(T, 2 * 768, F.G, F.bx);
            pg8::EpiF32<1> E{(float*)(ws + A_LAT), 768}; pg8::gemm_phase<pg8::EpiF32<1>, pg8::StaticOrder, true, true, true>(F.lds, g, S, E, F.wave); } break;
        case OP_FIN1: { unsigned char* ws = WSP; rp_mla_fin1(F, (const float*)(ws + A_LAT), INP(I_GQ) + j * 384, INP(I_GKV) + j * 256, (bf16*)(ws + A_QN), (bf16*)(ws + WS_CKV + j * CKV_B), OUTP, j); } break;
        case OP_G_QKV: {
#pragma unroll 1
            for (int w = 0; w < 2; ++w) {
                unsigned char* ws = WSP; unsigned char* wm = ws + W_MLA + j * MLA_WB;
                pg8::Gemm g = w == 0 ? pg8::Gemm{(const bf16*)(ws + A_QN), (const bf16*)(wm + MW_UQ), T, 1536, 384} : pg8::Gemm{(const bf16*)(ws + WS_CKV + j * CKV_B), (const bf16*)(wm + MW_UKV), T + NCTX, 2048, 256};
                pg8::StaticOrder S; S.init(g.M, g.N, F.G, w == 0 ? F.bx : (int)((F.bx + 64) % F.G));
                pg8::EpiBf16P E{w == 0 ? (bf16*)(ws + A_QRAW) : (bf16*)(ws + A_KVRAW), g.N};
                pg8::gemm_phase<pg8::EpiBf16P, pg8::StaticOrder, true, true>(F.lds, g, S, E, F.wave);
            } } break;
        case OP_FIN2: { unsigned char* ws = WSP; rp_mla_fin2(F, (const bf16*)(ws + A_QRAW), (const bf16*)(ws + A_KVRAW), (const float*)(ws + A_LAT), INP(I_CKPE) + (size_t)j * 8192, INP(I_GQN) + j * 96, INP(I_GKN) + j * 96,
                                                        (const float*)(ws + WS_ROPE), (bf16*)(ws + A_QB), (bf16*)(ws + A_KB)); } break;
        case OP_ATTN: { unsigned char* ws = WSP; ph_attn(F, (const bf16*)(ws + A_QB), (const bf16*)(ws + A_KB), (const bf16*)(ws + A_KVRAW), (bf16*)(ws + A_AO)); } break;
        case OP_G_WO: case OP_G_PW2: case OP_G_SSO: case OP_G_FF2: {
            unsigned char* ws = WSP; float* x = OUTP;
            const float* rlo = (layer == 0 && op != OP_G_FF2) ? INP(I_XP) : x; const float* rhi = (layer == 0 && op != OP_G_FF2) ? INP(I_XS) - (size_t)TP * 1024 : x;
            pg8::Gemm g; const float* bias = nullptr; int goff = 2048;
            if (op == OP_G_WO) g = pg8::Gemm{(const bf16*)(ws + A_AO), (const bf16*)(ws + W_MLA + j * MLA_WB + MW_O), T, 1024, 1024};
            else if (op == OP_G_PW2) { g = pg8::Gemm{(const bf16*)(ws + A_V), (const bf16*)(ws + W_CV2), T, 1024, 1024}; bias = INP(I_CVB2); }
            else if (op == OP_G_SSO) g = pg8::Gemm{(const bf16*)(ws + A_YN), (const bf16*)(ws + W_SSO), T, 1024, 2048};
            else { g = pg8::Gemm{(const bf16*)(ws + A_ACT), (const bf16*)(ws + W_FF + layer * FF_WB + FW_OUT), T, 1024, 2816}; goff = 5120; }
            pg8::StaticOrder S; S.init(T, 2 * 1024, F.G, F.bx);
            pg8::EpiResid<1> E{rlo, rhi, x, (const float*)(ws + WS_MODS) + (size_t)layer * 5 * 6144, goff, bias};
            pg8::gemm_phase<pg8::EpiResid<1>, pg8::StaticOrder, true, true, true>(F.lds, g, S, E, F.wave); } break;
        case OP_G_FF1: { unsigned char* ws = WSP; pg8::Gemm g{(const bf16*)(ws + WS_H), (const bf16*)(ws + W_FF + layer * FF_WB + FW_IN), T, 5632, 1024}; pg8::StaticOrder S; S.init(T, 5632, F.G, F.bx);
            pg8::EpiGlu<0> E{(bf16*)(ws + A_ACT), 2816, nullptr, 2816}; pg8::gemm_phase<pg8::EpiGlu<0>, pg8::StaticOrder, true, true>(F.lds, g, S, E, F.wave); } break;
        case OP_G_PW1: { unsigned char* ws = WSP; pg8::Gemm g{(const bf16*)(ws + WS_H), (const bf16*)(ws + W_CV1), T, 2048, 1024}; pg8::StaticOrder S; S.init(T, 2048, F.G, F.bx);
            pg8::EpiGlu<1> E{(bf16*)(ws + A_U), 1024, INP(I_CVB1), 1024}; pg8::gemm_phase<pg8::EpiGlu<1>, pg8::StaticOrder, true, true>(F.lds, g, S, E, F.wave); } break;
        case OP_DWCONV: { unsigned char* ws = WSP; rp_dwconv(F, (const bf16*)(ws + A_U), INP(I_CVWD), INP(I_CVBD), INP(I_CVGL), INP(I_CVBL), (bf16*)(ws + A_V)); } break;
        case OP_G_SSI: { unsigned char* ws = WSP; pg8::Gemm g{(const bf16*)(ws + WS_H), (const bf16*)(ws + W_SSI), T, 5376, 1024}; pg8::StaticOrder S; S.init(T, 5376, F.G, F.bx);
            pg8::EpiSsdIn E{(bf16*)(ws + A_Z), (bf16*)(ws + A_XPRE), (float*)(ws + A_DTRAW)}; pg8::gemm_phase<pg8::EpiSsdIn, pg8::StaticOrder, true, true>(F.lds, g, S, E, F.wave); } break;
        case OP_SSCONV: { unsigned char* ws = WSP; rp_ssd_conv(F, (const bf16*)(ws + A_XPRE), (const float*)(ws + A_DTRAW), INP(I_SSWC), INP(I_SSBC), INP(I_SSDTB), (bf16*)(ws + A_XBC), (float*)(ws + A_DT)); } break;
        case OP_SCAN: { unsigned char* ws = WSP; ph_scan(F, (const bf16*)(ws + A_XBC), (const float*)(ws + A_DT), INP(I_SSAL), INP(I_SSD), INP(I_SSM), (float*)(ws + A_Y), OUTP); } break;
        case OP_GATE: { unsigned char* ws = WSP; rp_ssd_gate(F, (const float*)(ws + A_Y), (const bf16*)(ws + A_Z), INP(I_SSGN), (bf16*)(ws + A_YN)); } break;
        default: break;
        }
        if (MK_REPEAT_MASK != 0u) { if (!redo_ && ((MK_REPEAT_MASK >> op) & 1u)) { redo_ = true; xcd_barrier(bar); --ph; continue; } redo_ = false; }
        if (ph + 1 < ph_hi) { xcd_barrier(bar); if (MK_DOUBLE_BAR) xcd_barrier(bar); }
    }
}

#ifndef MK_PHASES
#define MK_PHASES 37
#endif
#ifndef MK_PER_PHASE
#define MK_PER_PHASE 0
#endif
static int sub_after_phases(int p) { return p >= 37 ? 8 : p >= 34 ? 7 : p >= 27 ? 6 : p >= 24 ? 5 : p >= 18 ? 4 : p >= 15 ? 3 : p >= 11 ? 2 : p >= 8 ? 1 : 0; }
extern "C" void kernel_launch(void* const* d_in, const int* in_sizes, int n_in, void* d_out, int out_size, void* d_ws, size_t ws_size, hipStream_t stream) {
    static int grid = 0;
    if (grid == 0) {
        int dev = 0, cus = 0;
        if (hipGetDevice(&dev) != hipSuccess || hipDeviceGetAttribute(&cus, hipDeviceAttributeMultiprocessorCount, dev) != hipSuccess) { fprintf(stderr, "kernel_launch: device query failed\n"); grid = -1; return; }
        if (hipFuncSetAttribute((const void*)mega_fwd, hipFuncAttributeMaxDynamicSharedMemorySize, LDS_BYTES) != hipSuccess) { fprintf(stderr, "kernel_launch: hipFuncSetAttribute failed\n"); grid = -1; return; }
        (void)hipGetLastError();
        grid = cus;
    }
    if (grid < 0) return;
    In I; const float** p = (const float**)&I;
    for (int i = 0; i < 38; ++i) p[i] = (const float*)d_in[i];
    (void)hipMemsetAsync((char*)d_ws + WS_CTL, 0, CTL_ZERO_BYTES, stream);
    MArgs a{};
    for (int i = 0; i < 38; ++i) a.in[i] = (const float*)d_in[i];
    a.out = (float*)d_out; a.ws = (unsigned char*)d_ws;
    const int nph = MK_PHASES;
    if (MK_PER_PHASE) { for (int ph = 0; ph < nph; ++ph) { a.ph_lo = ph; a.ph_hi = ph + 1; hipLaunchKernelGGL(mega_fwd, dim3(grid), dim3(NTHR), LDS_BYTES, stream, a); } }
    else { a.ph_lo = 0; a.ph_hi = nph; hipLaunchKernelGGL(mega_fwd, dim3(grid), dim3(NTHR), LDS_BYTES, stream, a); }
    const int sub = sub_after_phases(nph);
    if (sub < 8) naive_forward(I, (float*)d_out, (float*)d_ws, stream, sub);
}
```

```cpp
#include <hip/hip_runtime.h>
#include <cstdint>
#include <cstdio>

constexpr int DM = 1024, T = 8192, TP = 4096;
constexpr int NCTX = 1024;
constexpr int QL = 384, KVL = 256, ROPE = 32, NOPE = 64, QKD = 96, VH = 64, NH = 16;
constexpr int FFH = 2816;
constexpr int SSI = 2048, SSH = 32, SSP = 64, SSN = 128, SSG = 4, SSCD = 3072, SSIN = 5184;
constexpr float EPS = 1e-6f;
constexpr size_t OUT_YP = 0, OUT_CKV = 8388608, OUT_KPE = 10485760, OUT_SSM = 10747904;

__device__ __forceinline__ int cond_of_row(int r) { return r < TP ? 0 : 1 + ((r - TP) >> 10); }
__device__ __forceinline__ void row_pos(int r, int& t, int& L) { if (r < TP) { t = r & 255; L = 256; } else { t = (r - TP) & 1023; L = 1024; } }
__device__ __forceinline__ float silu_f(float x) { return x / (1.f + expf(-x)); }
__device__ __forceinline__ float sigmoid_f(float x) { return 1.f / (1.f + expf(-x)); }
__device__ __forceinline__ float softplus_f(float x) { return fmaxf(x, 0.f) + log1pf(expf(-fabsf(x))); }
__device__ __forceinline__ float wave_sum(float v) {
#pragma unroll
    for (int o = 1; o < 64; o <<= 1) v += __shfl_xor(v, o);
    return v;
}

__global__ void __launch_bounds__(256) nk_adaln(const float* __restrict__ c, const float* __restrict__ cctx, const float* __restrict__ w, const float* __restrict__ b, float* __restrict__ mods) {
    __shared__ float s[5][DM];
    const int l = blockIdx.y, n = blockIdx.x * 256 + threadIdx.x;
    for (int i = threadIdx.x; i < 5 * DM; i += 256) { const int cc = i / DM, k = i % DM; const float v = cc == 0 ? cctx[k] : c[(cc - 1) * DM + k]; s[cc][k] = silu_f(v); }
    __syncthreads();
    const float* W = w + (size_t)l * DM * 6144;
    float acc[5] = {0.f, 0.f, 0.f, 0.f, 0.f};
    for (int k = 0; k < DM; ++k) { const float wv = W[(size_t)k * 6144 + n];
#pragma unroll
        for (int cc = 0; cc < 5; ++cc) acc[cc] += s[cc][k] * wv; }
#pragma unroll
    for (int cc = 0; cc < 5; ++cc) mods[((size_t)l * 5 + cc) * 6144 + n] = acc[cc] + b[l * 6144 + n];
}

__global__ void __launch_bounds__(256) nk_copy_x(const float* __restrict__ xp, const float* __restrict__ xs, float* __restrict__ x) {
    const size_t i = (size_t)blockIdx.x * 256 + threadIdx.x;
    const size_t half = (size_t)TP * DM / 4;
    ((float4*)x)[i] = i < half ? ((const float4*)xp)[i] : ((const float4*)xs)[i - half];
}

__global__ void __launch_bounds__(256) nk_normmod(const float* __restrict__ x, const float* __restrict__ g, const float* __restrict__ mods_l, int sh_off, int sc_off, float* __restrict__ h) {
    const int row = blockIdx.x * 4 + (threadIdx.x >> 6), lane = threadIdx.x & 63;
    const float* xr = x + (size_t)row * DM; float v[16]; float ss = 0.f;
#pragma unroll
    for (int i = 0; i < 16; ++i) { v[i] = xr[lane + 64 * i]; ss += v[i] * v[i]; }
    ss = wave_sum(ss); const float r = rsqrtf(ss * (1.f / DM) + EPS);
    const float* m = mods_l + (size_t)cond_of_row(row) * 6144;
#pragma unroll
    for (int i = 0; i < 16; ++i) { const int k = lane + 64 * i; h[(size_t)row * DM + k] = v[i] * r * g[k] * (1.f + m[sc_off + k]) + m[sh_off + k]; }
}

template <int GLU>
__global__ void __launch_bounds__(256) nk_gemm(const float* __restrict__ A, int lda, const float* __restrict__ B, int ldb, float* __restrict__ C, int ldc, int M, int N, int K, const float* __restrict__ bias) {
    __shared__ float As[16][65], Bs[16][65], Us[16][65];
    const int tx = threadIdx.x & 15, ty = threadIdx.x >> 4, m0 = blockIdx.y * 64, n0 = blockIdx.x * 64;
    float acc[4][4] = {}, acu[4][4] = {};
    for (int k0 = 0; k0 < K; k0 += 16) {
        for (int i = threadIdx.x; i < 1024; i += 256) { const int r = i >> 4, kk = i & 15; As[kk][r] = A[(size_t)(m0 + r) * lda + k0 + kk]; }
        for (int i = threadIdx.x; i < 1024; i += 256) { const int kk = i >> 6, cc = i & 63; const bool ok = n0 + cc < N; Bs[kk][cc] = ok ? B[(size_t)(k0 + kk) * ldb + n0 + cc] : 0.f;
            if (GLU) Us[kk][cc] = ok ? B[(size_t)(k0 + kk) * ldb + N + n0 + cc] : 0.f; }
        __syncthreads();
#pragma unroll
        for (int kk = 0; kk < 16; ++kk) { float a[4], b[4], u[4];
#pragma unroll
            for (int i = 0; i < 4; ++i) { a[i] = As[kk][ty * 4 + i]; b[i] = Bs[kk][tx * 4 + i]; u[i] = GLU ? Us[kk][tx * 4 + i] : 0.f; }
#pragma unroll
            for (int i = 0; i < 4; ++i)
#pragma unroll
                for (int j = 0; j < 4; ++j) { acc[i][j] += a[i] * b[j]; if (GLU) acu[i][j] += a[i] * u[j]; } }
        __syncthreads();
    }
#pragma unroll
    for (int i = 0; i < 4; ++i)
#pragma unroll
        for (int j = 0; j < 4; ++j) { const int n = n0 + tx * 4 + j; if (n < N) {
            float v = acc[i][j] + (bias ? bias[n] : 0.f);
            if (GLU) { const float u = acu[i][j] + (bias ? bias[N + n] : 0.f); v = GLU == 1 ? silu_f(v) * u : v * sigmoid_f(u); }
            C[(size_t)(m0 + ty * 4 + i) * ldc + n] = v; } }
}

__global__ void __launch_bounds__(256) nk_resid(float* __restrict__ x, const float* __restrict__ o, const float* __restrict__ mods_l, int g_off) {
    const size_t i = (size_t)blockIdx.x * 256 + threadIdx.x; const int row = (int)(i >> 10), k = (int)(i & 1023);
    x[i] += mods_l[(size_t)cond_of_row(row) * 6144 + g_off + k] * o[i];
}

__global__ void __launch_bounds__(256) nk_mla_fin1(const float* __restrict__ latq, const float* __restrict__ latkv, const float* __restrict__ gq, const float* __restrict__ gkv,
                                                   const float* __restrict__ cache_ckv_j  , float* __restrict__ qn, float* __restrict__ ckv, float* __restrict__ out, int j) {
    const int row = blockIdx.x * 4 + (threadIdx.x >> 6), lane = threadIdx.x & 63;
    if (row >= T) { const int b = (row - T) >> 8, s = (row - T) & 255;
#pragma unroll
        for (int i = 0; i < 4; ++i) ckv[(size_t)row * KVL + lane + 64 * i] = cache_ckv_j[((size_t)b * 2 * 256 + s) * 256 + lane + 64 * i];
        return; }
    float v[6]; float ss = 0.f;
#pragma unroll
    for (int i = 0; i < 6; ++i) { v[i] = latq[(size_t)row * QL + lane + 64 * i]; ss += v[i] * v[i]; }
    ss = wave_sum(ss); float r = rsqrtf(ss * (1.f / QL) + EPS);
#pragma unroll
    for (int i = 0; i < 6; ++i) qn[(size_t)row * QL + lane + 64 * i] = v[i] * r * gq[lane + 64 * i];
    ss = 0.f;
#pragma unroll
    for (int i = 0; i < 4; ++i) { v[i] = latkv[(size_t)row * 288 + lane + 64 * i]; ss += v[i] * v[i]; }
    ss = wave_sum(ss); r = rsqrtf(ss * (1.f / KVL) + EPS);
#pragma unroll
    for (int i = 0; i < 4; ++i) { const float c = v[i] * r * gkv[lane + 64 * i]; ckv[(size_t)row * KVL + lane + 64 * i] = c;
        if (row < TP) out[OUT_CKV + (((size_t)(row >> 8) * 2 + j) * 256 + (row & 255)) * 256 + lane + 64 * i] = c; }
    if (row < TP && lane < 32) out[OUT_KPE + (((size_t)(row >> 8) * 2 + j) * 256 + (row & 255)) * 32 + lane] = latkv[(size_t)row * 288 + 256 + lane];
}

__device__ __forceinline__ float rope_inv(int i) { return i == 0 ? 1.f : i == 1 ? 0.31622776601683794f : i == 2 ? 0.1f : i == 3 ? 0.031622776601683794f : i == 4 ? 0.01f : i == 5 ? 0.0031622776601683794f : i == 6 ? 0.001f : 0.00031622776601683794f; }
__device__ __forceinline__ void rope32(float* pe, int t) {
    const int rr = t >> 6, cc = t & 63;
#pragma unroll
    for (int i = 0; i < 8; ++i) {
        const float inv = rope_inv(i);
        float a = (float)rr * inv, s = sinf(a), c = cosf(a);
        float x1 = pe[i], x2 = pe[i + 8]; pe[i] = x1 * c - x2 * s; pe[i + 8] = x2 * c + x1 * s;
        a = (float)cc * inv; s = sinf(a); c = cosf(a);
        x1 = pe[16 + i]; x2 = pe[24 + i]; pe[16 + i] = x1 * c - x2 * s; pe[24 + i] = x2 * c + x1 * s;
    }
}
__global__ void __launch_bounds__(256) nk_mla_fin2(const float* __restrict__ qraw, const float* __restrict__ kvraw, const float* __restrict__ latkv, const float* __restrict__ cache_kpe_j,
                                                   const float* __restrict__ gqn, const float* __restrict__ gkn, float* __restrict__ Q, float* __restrict__ K) {
    const int idx = blockIdx.x * 256 + threadIdx.x, row = idx >> 4, h = idx & 15;
    const bool latent = row >= TP && row < T; const int tl = (row - TP) & 1023;
    if (row < T) {
        float q[96]; float ss = 0.f;
#pragma unroll
        for (int d = 0; d < 96; ++d) { q[d] = qraw[(size_t)row * 1536 + h * 96 + d]; ss += q[d] * q[d]; }
        const float r = rsqrtf(ss * (1.f / 96) + EPS);
#pragma unroll
        for (int d = 0; d < 96; ++d) q[d] = q[d] * r * gqn[d];
        if (latent) rope32(q + 64, tl);
#pragma unroll
        for (int d = 0; d < 96; ++d) Q[((size_t)row * 16 + h) * 96 + d] = q[d];
    }
    float k[96]; float ss = 0.f;
#pragma unroll
    for (int d = 0; d < 64; ++d) { k[d] = kvraw[(size_t)row * 2048 + h * 128 + d]; ss += k[d] * k[d]; }
#pragma unroll
    for (int d = 0; d < 32; ++d) { k[64 + d] = row < T ? latkv[(size_t)row * 288 + 256 + d] : cache_kpe_j[((size_t)((row - T) >> 8) * 2 * 256 + ((row - T) & 255)) * 32 + d]; ss += k[64 + d] * k[64 + d]; }
    const float r = rsqrtf(ss * (1.f / 96) + EPS);
#pragma unroll
    for (int d = 0; d < 96; ++d) k[d] = k[d] * r * gkn[d];
    if (latent) rope32(k + 64, tl);
#pragma unroll
    for (int d = 0; d < 96; ++d) K[((size_t)row * 16 + h) * 96 + d] = k[d];
}

__global__ void __launch_bounds__(64) nk_attn(const float* __restrict__ Q, const float* __restrict__ K, const float* __restrict__ KV  , float* __restrict__ O) {
    __shared__ float Ks[32][96], Vs[32][64];
    const int h = blockIdx.y, row = blockIdx.x * 64 + threadIdx.x;
    float q[96];
#pragma unroll
    for (int d = 0; d < 96; ++d) q[d] = Q[((size_t)row * 16 + h) * 96 + d];
    float o[64];
#pragma unroll
    for (int d = 0; d < 64; ++d) o[d] = 0.f;
    float m = -INFINITY, l = 0.f;
    int nkeys, kbase0, kbase1, n0;
    const int r0 = blockIdx.x * 64;
    if (r0 < TP) { nkeys = 256; n0 = 256; kbase0 = r0 & ~255; kbase1 = 0; }
    else { const int b = (r0 - TP) >> 10; nkeys = 1280; n0 = 256; kbase0 = T + b * 256; kbase1 = TP + b * 1024; }
    const float scale = rsqrtf(96.f);
    for (int k0 = 0; k0 < nkeys; k0 += 32) {
        __syncthreads();
        for (int i = threadIdx.x; i < 32 * 96; i += 64) { const int kk = i / 96, d = i % 96; const int key = k0 + kk; const int kr = key < n0 ? kbase0 + key : kbase1 + key - n0; Ks[kk][d] = K[((size_t)kr * 16 + h) * 96 + d]; }
        for (int i = threadIdx.x; i < 32 * 64; i += 64) { const int kk = i / 64, d = i % 64; const int key = k0 + kk; const int kr = key < n0 ? kbase0 + key : kbase1 + key - n0; Vs[kk][d] = KV[(size_t)kr * 2048 + h * 128 + 64 + d]; }
        __syncthreads();
        for (int kk = 0; kk < 32; ++kk) {
            float s = 0.f;
#pragma unroll
            for (int d = 0; d < 96; ++d) s += q[d] * Ks[kk][d];
            s *= scale;
            const float mn = fmaxf(m, s), a = expf(m - mn), p = expf(s - mn);
            l = l * a + p;
#pragma unroll
            for (int d = 0; d < 64; ++d) o[d] = o[d] * a + p * Vs[kk][d];
            m = mn;
        }
    }
    const float il = 1.f / l;
#pragma unroll
    for (int d = 0; d < 64; ++d) O[(size_t)row * DM + h * 64 + d] = o[d] * il;
}

__global__ void __launch_bounds__(256) nk_dwconv_ln(const float* __restrict__ u, const float* __restrict__ wdw, const float* __restrict__ bdw, const float* __restrict__ gln, const float* __restrict__ bln, float* __restrict__ v) {
    const int row = blockIdx.x * 4 + (threadIdx.x >> 6), lane = threadIdx.x & 63;
    int t, L; row_pos(row, t, L);
    float y[16]; float s = 0.f;
#pragma unroll
    for (int i = 0; i < 16; ++i) { const int c = lane + 64 * i; float a = bdw[c];
        for (int k = 0; k < 31; ++k) { const int tt = t + k - 15; if (tt >= 0 && tt < L) a += u[(size_t)(row + k - 15) * DM + c] * wdw[k * DM + c]; }
        y[i] = a; s += a; }
    const float mean = wave_sum(s) * (1.f / DM); float q = 0.f;
#pragma unroll
    for (int i = 0; i < 16; ++i) { y[i] -= mean; q += y[i] * y[i]; }
    const float r = rsqrtf(wave_sum(q) * (1.f / DM) + EPS);
#pragma unroll
    for (int i = 0; i < 16; ++i) { const int c = lane + 64 * i; v[(size_t)row * DM + c] = silu_f(y[i] * r * gln[c] + bln[c]); }
}

__global__ void __launch_bounds__(256) nk_ssd_conv(const float* __restrict__ xpre  , const float* __restrict__ dtraw  , const float* __restrict__ wc, const float* __restrict__ bc, const float* __restrict__ dtb, float* __restrict__ xbc, float* __restrict__ dt) {
    const size_t i = (size_t)blockIdx.x * 256 + threadIdx.x; const int row = (int)(i / 3136), c = (int)(i % 3136);
    int t, L; row_pos(row, t, L);
    if (c < SSCD) { float a = bc[c];
#pragma unroll
        for (int k = 0; k < 5; ++k) { const int tt = t + k - 2; if (tt >= 0 && tt < L) a += xpre[(size_t)(row + k - 2) * SSCD + c] * wc[k * SSCD + c]; }
        xbc[(size_t)row * SSCD + c] = silu_f(a);
    } else { const int e = c - SSCD; dt[(size_t)row * 64 + e] = softplus_f(dtraw[(size_t)row * 64 + e] + dtb[e]); }
}
__global__ void __launch_bounds__(64) nk_ssd_scan(const float* __restrict__ xbc, const float* __restrict__ dt, const float* __restrict__ alog, const float* __restrict__ dsk, const float* __restrict__ st0  ,
                                                  float* __restrict__ y  , float* __restrict__ out, int dir) {
    const int h = blockIdx.x, seq = blockIdx.y, p = threadIdx.x, g = h >> 3;
    int r0, L; if (seq < 16) { r0 = seq * 256; L = 256; } else { r0 = TP + (seq - 16) * 1024; L = 1024; }
    const float a = -expf(alog[dir * 32 + h]), dd = dsk[dir * 32 + h];
    float hs[128];
    if (seq < 16) {
#pragma unroll
        for (int n = 0; n < 128; ++n) hs[n] = 0.f;
    } else { const float* s0 = st0 + ((((size_t)(seq - 16) * 2 + dir) * 32 + h) * 64 + p) * 128;
#pragma unroll
        for (int n = 0; n < 128; ++n) hs[n] = s0[n]; }
    for (int s = 0; s < L; ++s) {
        const int row = r0 + (dir == 0 ? s : L - 1 - s);
        const float dtv = dt[(size_t)row * 64 + dir * 32 + h], da = expf(dtv * a), xv = xbc[(size_t)row * SSCD + h * 64 + p], dtx = dtv * xv;
        const float* Bp = xbc + (size_t)row * SSCD + SSI + g * 128; const float* Cp = Bp + 512;
        float acc = 0.f;
#pragma unroll
        for (int n = 0; n < 128; ++n) { hs[n] = hs[n] * da + dtx * Bp[n]; acc += Cp[n] * hs[n]; }
        float* yp = y + (size_t)row * SSI + h * 64 + p; const float yv = acc + xv * dd; *yp = dir == 0 ? yv : *yp + yv;
    }
    if (seq < 16) { float* o = out + OUT_SSM + ((((size_t)seq * 2 + dir) * 32 + h) * 64 + p) * 128;
#pragma unroll
        for (int n = 0; n < 128; ++n) o[n] = hs[n]; }
}
__global__ void __launch_bounds__(256) nk_ssd_gate(const float* __restrict__ y, const float* __restrict__ z  , const float* __restrict__ gn, float* __restrict__ yn) {
    const int row = blockIdx.x * 4 + (threadIdx.x >> 6), lane = threadIdx.x & 63;
#pragma unroll
    for (int g = 0; g < 4; ++g) { float v[8]; float ss = 0.f;
#pragma unroll
        for (int i = 0; i < 8; ++i) { const int c = g * 512 + lane + 64 * i; v[i] = y[(size_t)row * SSI + c] * silu_f(z[(size_t)row * SSI + c]); ss += v[i] * v[i]; }
        const float r = rsqrtf(wave_sum(ss) * (1.f / 512) + EPS);
#pragma unroll
        for (int i = 0; i < 8; ++i) { const int c = g * 512 + lane + 64 * i; yn[(size_t)row * SSI + c] = v[i] * r * gn[c]; } }
}

struct In {
    const float *x_prompt, *x_sample, *cache_ckv, *cache_kpe, *state_ssm, *c, *c_ctx, *w_ada, *b_ada, *g_norm1, *g_norm2,
        *mla_w_dq, *mla_g_q, *mla_w_uq, *mla_w_dkv, *mla_g_kv, *mla_w_ukv, *mla_g_qn, *mla_g_kn, *mla_w_o,
        *cv_w_pw1, *cv_b_pw1, *cv_w_dw, *cv_b_dw, *cv_g_ln, *cv_b_ln, *cv_w_pw2, *cv_b_pw2,
        *ssd_w_in, *ssd_w_conv, *ssd_b_conv, *ssd_dt_bias, *ssd_a_log, *ssd_d, *ssd_g_norm, *ssd_w_out, *ffn_w_in, *ffn_w_out;
};

template <int GLU>
static void ngemm(hipStream_t s, const float* A, int lda, const float* B, int ldb, float* C, int ldc, int M, int N, int K, const float* bias) {
    nk_gemm<GLU><<<dim3((N + 63) / 64, M / 64), 256, 0, s>>>(A, lda, B, ldb, C, ldc, M, N, K, bias);
}

static void naive_forward(const In& I, float* out, float* ws, hipStream_t s, int start_sub) {
    size_t off = 0; auto take = [&](size_t n) { float* p = ws + off; off += (n + 255) & ~(size_t)255; return p; };
    float* mods = take(4 * 5 * 6144);
    float* h = take((size_t)T * DM);
    float* t2 = take((size_t)T * DM);
    float* latkv = take((size_t)T * 288);
    float* qn = take((size_t)T * QL);
    float* ckv = take((size_t)(T + NCTX) * KVL);
    float* dtb = take((size_t)T * 64);
    float* dtraw = take((size_t)T * 64);
    float* arena = ws + off;
    float* latq = arena; float* qraw = latq + (size_t)T * QL; float* kvraw = qraw + (size_t)T * 1536; float* Qb = kvraw + (size_t)(T + NCTX) * 2048; float* Kb = Qb + (size_t)T * 1536;
    float* t1 = arena;
    float* zb = arena; float* xpre = zb + (size_t)T * SSI; float* xbc = xpre + (size_t)T * SSCD; float* yb = xpre;
    float* x = out + OUT_YP;
    nk_adaln<<<dim3(24, 4), 256, 0, s>>>(I.c, I.c_ctx, I.w_ada, I.b_ada, mods);
    if (start_sub == 0) nk_copy_x<<<T * DM / 4 / 256, 256, 0, s>>>(I.x_prompt, I.x_sample, x);
    for (int i = start_sub / 2; i < 4; ++i) {
        const int kind = i % 3, j = i / 3; const float* ml = mods + (size_t)i * 5 * 6144;
        if (2 * i >= start_sub) {
        nk_normmod<<<T / 4, 256, 0, s>>>(x, I.g_norm1 + i * DM, ml, 0, 1024, h);
        if (kind == 0) {
            ngemm<0>(s, h, DM, I.mla_w_dq + (size_t)j * DM * QL, QL, latq, QL, T, QL, DM, nullptr);
            ngemm<0>(s, h, DM, I.mla_w_dkv + (size_t)j * DM * 288, 288, latkv, 288, T, 288, DM, nullptr);
            nk_mla_fin1<<<(T + NCTX) / 4, 256, 0, s>>>(latq, latkv, I.mla_g_q + j * QL, I.mla_g_kv + j * KVL, I.cache_ckv + (size_t)j * 65536, qn, ckv, out, j);
            ngemm<0>(s, qn, QL, I.mla_w_uq + (size_t)j * QL * 1536, 1536, qraw, 1536, T, 1536, QL, nullptr);
            ngemm<0>(s, ckv, KVL, I.mla_w_ukv + (size_t)j * KVL * 2048, 2048, kvraw, 2048, T + NCTX, 2048, KVL, nullptr);
            nk_mla_fin2<<<(T + NCTX) * 16 / 256, 256, 0, s>>>(qraw, kvraw, latkv, I.cache_kpe + (size_t)j * 8192, I.mla_g_qn + j * 96, I.mla_g_kn + j * 96, Qb, Kb);
            nk_attn<<<dim3(T / 64, 16), 64, 0, s>>>(Qb, Kb, kvraw, h);
            ngemm<0>(s, h, DM, I.mla_w_o + (size_t)j * DM * DM, DM, t2, DM, T, DM, DM, nullptr);
        } else if (kind == 1) {
            ngemm<2>(s, h, DM, I.cv_w_pw1, 2048, t1, DM, T, DM, DM, I.cv_b_pw1);
            nk_dwconv_ln<<<T / 4, 256, 0, s>>>(t1, I.cv_w_dw, I.cv_b_dw, I.cv_g_ln, I.cv_b_ln, h);
            ngemm<0>(s, h, DM, I.cv_w_pw2, DM, t2, DM, T, DM, DM, I.cv_b_pw2);
        } else {
            ngemm<0>(s, h, DM, I.ssd_w_in, SSIN, zb, SSI, T, SSI, DM, nullptr);
            ngemm<0>(s, h, DM, I.ssd_w_in + SSI, SSIN, xpre, SSCD, T, SSCD, DM, nullptr);
            ngemm<0>(s, h, DM, I.ssd_w_in + SSI + SSCD, SSIN, dtraw, 64, T, 64, DM, nullptr);
            nk_ssd_conv<<<T * 3136 / 256, 256, 0, s>>>(xpre, dtraw, I.ssd_w_conv, I.ssd_b_conv, I.ssd_dt_bias, xbc, dtb);
            nk_ssd_scan<<<dim3(32, 20), 64, 0, s>>>(xbc, dtb, I.ssd_a_log, I.ssd_d, I.state_ssm, yb, out, 0);
            nk_ssd_scan<<<dim3(32, 20), 64, 0, s>>>(xbc, dtb, I.ssd_a_log, I.ssd_d, I.state_ssm, yb, out, 1);
            nk_ssd_gate<<<T / 4, 256, 0, s>>>(yb, zb, I.ssd_g_norm, xbc);
            ngemm<0>(s, xbc, SSI, I.ssd_w_out, DM, t2, DM, T, DM, SSI, nullptr);
        }
        nk_resid<<<T * DM / 256, 256, 0, s>>>(x, t2, ml, 2048);
        }
        nk_normmod<<<T / 4, 256, 0, s>>>(x, I.g_norm2 + i * DM, ml, 3072, 4096, h);
        ngemm<1>(s, h, DM, I.ffn_w_in + (size_t)i * DM * 5632, 5632, t1, FFH, T, FFH, DM, nullptr);
        ngemm<0>(s, t1, FFH, I.ffn_w_out + (size_t)i * FFH * DM, DM, t2, DM, T, DM, FFH, nullptr);
        nk_resid<<<T * DM / 256, 256, 0, s>>>(x, t2, ml, 5120);
    }
}


__device__ __forceinline__ int olane() { int l; asm volatile("v_mbcnt_lo_u32_b32 %0, -1, 0\n\tv_mbcnt_hi_u32_b32 %0, -1, %0" : "=v"(l)); return l; }
__device__ __forceinline__ int obid() { int b = blockIdx.x; asm volatile("" : "+s"(b)); return b; }
namespace pg8 {
#define PG8_LAS __attribute__((address_space(3)))
typedef unsigned short bf16_t;
typedef short bf16x8 __attribute__((ext_vector_type(8)));
typedef float f32x4 __attribute__((ext_vector_type(4)));
typedef unsigned u32x4 __attribute__((ext_vector_type(4)));
constexpr int BM = 256, BK = 64, HALF = 128, HTB = HALF * BK * 2  , STAGE_BYTES = 8 * HTB, NXCD = 8, WGM = 8;

__host__ __device__ __forceinline__ int lds_byte(int r, int c) { const int st = (r >> 4) * 2 + (c >> 5), rr = r & 15, cc = c & 31, ob = rr * 64 + cc * 2; return st * 1024 + (ob ^ (((ob >> 9) & 1) << 5)); }
__host__ __device__ __forceinline__ void stage_rc(int b, int& R, int& C) { const int st = b / 1024, sb = b % 1024, swz = sb ^ (((sb >> 9) & 1) << 5); R = (st >> 1) * 16 + swz / 64; C = (st & 1) * 32 + (swz % 64) / 2; }
__host__ __device__ __forceinline__ int perm32(int rho) { const int n = rho >> 4, i = rho & 15; return 8 * (i >> 2) + 4 * n + (i & 3); }

struct Unit { int pm, pn; };
struct Gemm { const bf16_t* A; const bf16_t* Bt; int M, N, K; };

struct StaticOrder {
    int nM, nN, nwg, G, c;
    __host__ __device__ void init(int M, int N, int G_, int c_) { nM = M / BM; nN = N / BM; nwg = nM * nN; G = G_; c = c_; }
    __host__ __device__ bool next(int i, Unit& u) const {
        const long L = (long)i * G + c; if (L >= nwg) return false;
        int wgid = (int)L; { const int q = nwg / NXCD, r = nwg % NXCD, xcd = wgid % NXCD, off = wgid / NXCD; wgid = (xcd < r ? xcd * (q + 1) : r * (q + 1) + (xcd - r) * q) + off; }
        const int nig = WGM * nN, gid = wgid / nig, fm = gid * WGM, gsz = (nM - fm) < WGM ? (nM - fm) : WGM;
        u.pm = fm + ((wgid % nig) % gsz); u.pn = (wgid % nig) / gsz; return true;
    }
    __device__ __forceinline__ void a_ready(const Unit&) const {}
    __device__ __forceinline__ void done(const Unit&) const {}
};
__device__ __forceinline__ unsigned cvt_pk_bf16(float lo, float hi) { unsigned r; asm volatile("v_cvt_pk_bf16_f32 %0, %1, %2" : "=v"(r) : "v"(lo), "v"(hi)); return r; }
typedef unsigned u32x2 __attribute__((ext_vector_type(2)));
#ifndef MK_WT
#define MK_WT 0
#endif
__device__ __forceinline__ void st16(void* p, u32x4 v) { if (MK_WT) asm volatile("global_store_dwordx4 %0, %1, off sc1\n\ts_nop 1" :: "v"(p), "v"(v) : "memory"); else *(u32x4*)p = v; }
__device__ __forceinline__ void st16f(void* p, f32x4 v) { if (MK_WT) asm volatile("global_store_dwordx4 %0, %1, off sc1\n\ts_nop 1" :: "v"(p), "v"(v) : "memory"); else *(f32x4*)p = v; }
__device__ __forceinline__ void st8(void* p, u32x2 v) { if (MK_WT) asm volatile("global_store_dwordx2 %0, %1, off sc1\n\ts_nop 1" :: "v"(p), "v"(v) : "memory"); else *(u32x2*)p = v; }
__device__ __forceinline__ float fast_sigmoid(float x) { return __builtin_amdgcn_rcpf(1.f + __builtin_amdgcn_exp2f(-1.4426950408889634f * x)); }

constexpr int SW_LD = 5632;
__device__ __forceinline__ int cond_of_pm(int pm) { return pm < 16 ? 0 : 1 + ((pm - 16) >> 2); }
template <int NBJ> struct EpiF32 {
    static constexpr bool PERM = false, AFTER_DRAIN = false;
    float* C; int ldc; const float* rstat; const float* sw;
    __device__ __forceinline__ void operator()(const f32x4 (&acc)[2][2][4][2], const Unit& u, int wr_, int wc_, int fr_, int fq_) const {
        const int t_ = olane(), wr = wr_, wc = wc_, fr = t_ & 15, fq = t_ >> 4; (void)fr_; (void)fq_;
        const int row0 = u.pm * BM + wr * 64 + fr, col0 = u.pn * (HALF * NBJ) + wc * 32 + 4 * fq;
#pragma unroll
        for (int ai = 0; ai < 2; ++ai)
#pragma unroll
            for (int m = 0; m < 4; ++m) { float* rowp = C + (size_t)(row0 + ai * HALF + m * 16) * ldc + col0;
                const float rs = rstat ? rsqrtf(rstat[row0 + ai * HALF + m * 16] * (1.f / 1024) + 1e-6f) : 1.f; const float* swp = sw ? sw + (size_t)cond_of_pm(u.pm) * SW_LD + col0 : nullptr;
#pragma unroll
                for (int bj = 0; bj < NBJ; ++bj)
#pragma unroll
                    for (int n = 0; n < 2; ++n) { f32x4 v = acc[ai][bj][m][n] * rs; if (swp) v += *(const f32x4*)(swp + bj * HALF + n * 16); st16f(rowp + bj * HALF + n * 16, v); } }
    }
};
struct EpiBf16P {
    static constexpr bool PERM = true, AFTER_DRAIN = false;
    bf16_t* O; int ldc;
    __device__ __forceinline__ void operator()(const f32x4 (&acc)[2][2][4][2], const Unit& u, int wr_, int wc_, int fr_, int fq_) const {
        const int t_ = olane(), wr = wr_, wc = wc_, fr = t_ & 15, fq = t_ >> 4; (void)fr_; (void)fq_;
        const int row0 = u.pm * BM + wr * 64 + fr, col0 = u.pn * BM + wc * 32 + 8 * fq;
#pragma unroll
        for (int ai = 0; ai < 2; ++ai)
#pragma unroll
            for (int m = 0; m < 4; ++m) { bf16_t* rowp = O + (size_t)(row0 + ai * HALF + m * 16) * ldc + col0;
#pragma unroll
                for (int bj = 0; bj < 2; ++bj) { const f32x4 v0 = acc[ai][bj][m][0], v1 = acc[ai][bj][m][1]; u32x4 w;
                    w.x = cvt_pk_bf16(v0[0], v0[1]); w.y = cvt_pk_bf16(v0[2], v0[3]); w.z = cvt_pk_bf16(v1[0], v1[1]); w.w = cvt_pk_bf16(v1[2], v1[3]);
                    st16(rowp + bj * HALF, w); } }
    }
};
struct EpiSsdIn {
    static constexpr bool PERM = true, AFTER_DRAIN = false;
    bf16_t* Z; bf16_t* XP; float* DT; const float* rstat; const float* sw;
    __device__ __forceinline__ void operator()(const f32x4 (&acc)[2][2][4][2], const Unit& u, int wr_, int wc_, int fr_, int fq_) const {
        const int t_ = olane(), wr = wr_, wc = wc_, fr = t_ & 15, fq = t_ >> 4; (void)fr_; (void)fq_;
        const int row0 = u.pm * BM + wr * 64 + fr;
        const float* swp = sw + (size_t)cond_of_pm(u.pm) * SW_LD + u.pn * BM + wc * 32 + 8 * fq;
        if (u.pn < 20) {
            bf16_t* base = u.pn < 8 ? Z : XP; const int ld = u.pn < 8 ? 2048 : 3072, colt = (u.pn < 8 ? u.pn : u.pn - 8) * BM, col0 = colt + wc * 32 + 8 * fq;
#pragma unroll
            for (int ai = 0; ai < 2; ++ai)
#pragma unroll
                for (int m = 0; m < 4; ++m) { bf16_t* rowp = base + (size_t)(row0 + ai * HALF + m * 16) * ld + col0;
                    const float rs = rsqrtf(rstat[row0 + ai * HALF + m * 16] * (1.f / 1024) + 1e-6f);
#pragma unroll
                    for (int bj = 0; bj < 2; ++bj) { const f32x4 v0 = acc[ai][bj][m][0] * rs + *(const f32x4*)(swp + bj * HALF), v1 = acc[ai][bj][m][1] * rs + *(const f32x4*)(swp + bj * HALF + 4); u32x4 w;
                        w.x = cvt_pk_bf16(v0[0], v0[1]); w.y = cvt_pk_bf16(v0[2], v0[3]); w.z = cvt_pk_bf16(v1[0], v1[1]); w.w = cvt_pk_bf16(v1[2], v1[3]);
                        st16(rowp + bj * HALF, w); } }
        } else if (wc < 2) {
#pragma unroll
            for (int ai = 0; ai < 2; ++ai)
#pragma unroll
                for (int m = 0; m < 4; ++m) { float* rp = DT + (size_t)(row0 + ai * HALF + m * 16) * 64 + wc * 32 + 8 * fq;
                    const float rs = rsqrtf(rstat[row0 + ai * HALF + m * 16] * (1.f / 1024) + 1e-6f);
                    st16f(rp, acc[ai][0][m][0] * rs + *(const f32x4*)swp); st16f(rp + 4, acc[ai][0][m][1] * rs + *(const f32x4*)(swp + 4)); }
        }
    }
};
template <int MODE> struct EpiGlu {
    static constexpr bool PERM = false, AFTER_DRAIN = false;
    bf16_t* O; int ldo; const float* bias; int H; const float* rstat; const float* sw;
    __device__ __forceinline__ void operator()(const f32x4 (&acc)[2][2][4][2], const Unit& u, int wr_, int wc_, int fr_, int fq_) const {
        const int t_ = olane(), wr = wr_, wc = wc_, fr = t_ & 15, fq = t_ >> 4; (void)fr_; (void)fq_;
        const int row0 = u.pm * BM + wr * 64 + fr;
#pragma unroll
        for (int bj = 0; bj < 2; ++bj) {
            const int f0 = 16 * (8 * u.pn + 4 * bj + wc) + 4 * fq;
            f32x4 ba = (f32x4){0.f, 0.f, 0.f, 0.f}, bu = ba;
            if (MODE == 1) { ba = *(const f32x4*)(bias + f0); bu = *(const f32x4*)(bias + H + f0); }
            { const float* swp = sw + (size_t)cond_of_pm(u.pm) * SW_LD + u.pn * BM + bj * HALF + wc * 32 + 4 * fq; ba += *(const f32x4*)swp; bu += *(const f32x4*)(swp + 16); }
#pragma unroll
            for (int ai = 0; ai < 2; ++ai)
#pragma unroll
                for (int m = 0; m < 4; ++m) { const float rs = rsqrtf(rstat[row0 + ai * HALF + m * 16] * (1.f / 1024) + 1e-6f);
                    const f32x4 a = acc[ai][bj][m][0] * rs + ba, g = acc[ai][bj][m][1] * rs + bu; float o[4];
#pragma unroll
                    for (int j = 0; j < 4; ++j) o[j] = MODE == 0 ? a[j] * fast_sigmoid(a[j]) * g[j] : a[j] * fast_sigmoid(g[j]);
                    u32x2 w; w.x = cvt_pk_bf16(o[0], o[1]); w.y = cvt_pk_bf16(o[2], o[3]);
                    st8(O + (size_t)(row0 + ai * HALF + m * 16) * ldo + f0, w); }
        }
    }
};
template <int NBJ> struct EpiResid {
    static constexpr bool PERM = false, AFTER_DRAIN = false;
    const float* xlo; const float* xhi; float* xout; const float* mods_l; int g_off; const float* bias;
    bf16_t* XG; const float* GT; float* stat;
    __device__ __forceinline__ void operator()(const f32x4 (&acc)[2][2][4][2], const Unit& u, int wr_, int wc_, int fr_, int fq_) const {
        const int t_ = olane(), wr = wr_, wc = wc_, fr = t_ & 15, fq = t_ >> 4; (void)fr_; (void)fq_;
        const int cond = u.pm < 16 ? 0 : 1 + ((u.pm - 16) >> 2);
        const float* gate = mods_l + (size_t)cond * 6144 + g_off; const float* xin = u.pm < 16 ? xlo : xhi;
        const int row0 = u.pm * BM + wr * 64 + fr, col0 = u.pn * (HALF * NBJ) + wc * 32 + 4 * fq;
        float ss[2][4];
#pragma unroll
        for (int ai = 0; ai < 2; ++ai)
#pragma unroll
            for (int m = 0; m < 4; ++m) ss[ai][m] = 0.f;
        const float* gt = XG ? GT + (size_t)cond * 1024 : nullptr;
#pragma unroll
        for (int bj = 0; bj < NBJ; ++bj)
#pragma unroll
            for (int n = 0; n < 2; ++n) { const int c = col0 + bj * HALF + n * 16; const f32x4 g4 = *(const f32x4*)(gate + c);
                const f32x4 b4 = bias ? *(const f32x4*)(bias + c) : (f32x4){0.f, 0.f, 0.f, 0.f};
                f32x4 G4 = (f32x4){0.f, 0.f, 0.f, 0.f}; if (XG) G4 = *(const f32x4*)(gt + c);
#pragma unroll
                for (int ai = 0; ai < 2; ++ai)
#pragma unroll
                    for (int m = 0; m < 4; ++m) { const size_t off = (size_t)(row0 + ai * HALF + m * 16) * 1024 + c;
                        const f32x4 xo = *(const f32x4*)(xin + off); const f32x4 xn = xo + g4 * (acc[ai][bj][m][n] + b4); st16f(xout + off, xn);
                        if (XG) { const f32x4 xg = xn * G4; u32x2 w; w.x = cvt_pk_bf16(xg[0], xg[1]); w.y = cvt_pk_bf16(xg[2], xg[3]); st8(XG + off, w);
                            ss[ai][m] += (xn[0] * xn[0] + xn[1] * xn[1]) + (xn[2] * xn[2] + xn[3] * xn[3]); } } }
        if (XG) {
#pragma unroll
            for (int ai = 0; ai < 2; ++ai)
#pragma unroll
                for (int m = 0; m < 4; ++m) { float s = ss[ai][m];
                    s += __builtin_bit_cast(float, __builtin_amdgcn_ds_bpermute((t_ ^ 16) << 2, __builtin_bit_cast(int, s)));
                    s += __builtin_bit_cast(float, __builtin_amdgcn_ds_bpermute((t_ ^ 32) << 2, __builtin_bit_cast(int, s)));
                    if (fq == 0) atomicAdd(stat + row0 + ai * HALF + m * 16, s); }
        }
    }
};
template <class Epi, class Sched, bool ALIGN_EPI = false, bool SP2 = false, bool HALFN = false>
__device__ __forceinline__ void gemm_phase(PG8_LAS unsigned char* lds, const Gemm g, const Sched& S, const Epi& E, const int wave_in) {
    const int tid = wave_in * 64 + olane(), wid = __builtin_amdgcn_readfirstlane(tid >> 6), lane = tid & 63, wr = wid >> 2, wc = wid & 3, fr = lane & 15, fq = lane >> 4;
    const int K = g.K, nt = K / BK;
    unsigned voffA[2], voffB[2];
#pragma unroll
    for (int i = 0; i < 2; ++i) { int R, C; stage_rc(tid * 16 + i * 8192, R, C); const int Rb = Epi::PERM ? ((R & ~31) + perm32(R & 31)) : R;
        voffA[i] = (unsigned)(R * K + C) * 2u; voffB[i] = (unsigned)(Rb * K + C) * 2u; }
    const size_t kstep = (size_t)(BK * 2);
    const size_t hstep = (size_t)HALF * K * 2;
    const size_t tstep = 2 * hstep;
    const size_t bstep = HALFN ? hstep : tstep;
    static_assert(!HALFN || SP2, "HALFN is written for the SP2 loop only");
    const unsigned ldsw = (unsigned)wid * 1024u;
    const int aoff = lds_byte(wr * 64 + fr, fq * 8), boff = lds_byte(wc * 32 + fr, fq * 8);
#define PG8_SA(b, h) (((b) * 2 + (h)) * HTB)
#define PG8_SB(b, h) ((4 + (b) * 2 + (h)) * HTB)
#define PG8_STAGE(bufoff, gbase, voff) do { _Pragma("unroll") for (int _i = 0; _i < 2; ++_i) \
        __builtin_amdgcn_global_load_lds((const unsigned*)((const char*)(gbase) + (voff)[_i]), (PG8_LAS unsigned*)(lds + (bufoff) + ldsw + _i * 8192), 16, 0, 0); } while (0)
#define PG8_LDA(dst, b, h) do { _Pragma("unroll") for (int m = 0; m < 4; ++m) _Pragma("unroll") for (int k = 0; k < 2; ++k) dst[m][k] = *(const PG8_LAS bf16x8*)(lds + PG8_SA(b, h) + aoff + m * 2048 + k * 1024); } while (0)
#define PG8_LDB(dst, b, h) do { _Pragma("unroll") for (int n = 0; n < 2; ++n) _Pragma("unroll") for (int k = 0; k < 2; ++k) dst[n][k] = *(const PG8_LAS bf16x8*)(lds + PG8_SB(b, h) + boff + n * 2048 + k * 1024); } while (0)
#define PG8_MMA(ai, bj, At, Bt) do { __builtin_amdgcn_s_setprio(1); _Pragma("unroll") for (int m = 0; m < 4; ++m) _Pragma("unroll") for (int n = 0; n < 2; ++n) _Pragma("unroll") for (int k = 0; k < 2; ++k) \
        acc[ai][bj][m][n] = __builtin_amdgcn_mfma_f32_16x16x32_bf16(Bt[n][k], At[m][k], acc[ai][bj][m][n], 0, 0, 0); __builtin_amdgcn_s_setprio(0); } while (0)
#define PG8_WAIT_V(n) asm volatile("s_waitcnt vmcnt(" #n ")" ::: "memory")
#define PG8_WAIT_L(n) asm volatile("s_waitcnt lgkmcnt(" #n ")" ::: "memory")
#define PG8_BAR __builtin_amdgcn_s_barrier()
#define PG8_SCHED __builtin_amdgcn_sched_barrier(0)
    Unit cur, nxt; int ui = 0;
    if (!S.next(0, cur)) return;
    f32x4 acc[2][2][4][2];
#pragma unroll
    for (int a = 0; a < 2; ++a)
#pragma unroll
        for (int b = 0; b < 2; ++b)
#pragma unroll
            for (int m = 0; m < 4; ++m)
#pragma unroll
                for (int n = 0; n < 2; ++n) acc[a][b][m][n] = (f32x4){0.f, 0.f, 0.f, 0.f};
    bf16x8 At[4][2], B0[2][2], B1[2][2];
    const char* cA = (const char*)g.A + (size_t)cur.pm * tstep; const char* cB = (const char*)g.Bt + (size_t)cur.pn * bstep;
    S.a_ready(cur);
    if constexpr (HALFN) {
        PG8_STAGE(PG8_SB(0, 0), cB, voffB); PG8_STAGE(PG8_SA(0, 0), cA, voffA); PG8_STAGE(PG8_SA(0, 1), cA + hstep, voffA);
        if (wr == 1) PG8_BAR;
        PG8_WAIT_V(2); PG8_BAR;
        PG8_STAGE(PG8_SB(1, 0), cB + kstep, voffB); PG8_STAGE(PG8_SA(1, 0), cA + kstep, voffA);
        PG8_WAIT_V(4); PG8_BAR;
    } else if constexpr (SP2) {
        PG8_STAGE(PG8_SB(0, 0), cB, voffB); PG8_STAGE(PG8_SB(0, 1), cB + hstep, voffB); PG8_STAGE(PG8_SA(0, 0), cA, voffA); PG8_STAGE(PG8_SA(0, 1), cA + hstep, voffA);
        if (wr == 1) PG8_BAR;
        PG8_WAIT_V(2); PG8_BAR;
        PG8_STAGE(PG8_SB(1, 0), cB + kstep, voffB); PG8_STAGE(PG8_SA(1, 0), cA + kstep, voffA); PG8_STAGE(PG8_SB(1, 1), cB + hstep + kstep, voffB);
        PG8_WAIT_V(6); PG8_BAR;
    } else {
        PG8_STAGE(PG8_SB(0, 0), cB, voffB); PG8_STAGE(PG8_SA(0, 0), cA, voffA); PG8_STAGE(PG8_SB(0, 1), cB + hstep, voffB); PG8_STAGE(PG8_SA(0, 1), cA + hstep, voffA);
        if (wr == 1) PG8_BAR;
        PG8_WAIT_V(4); PG8_BAR;
        PG8_STAGE(PG8_SB(1, 0), cB + kstep, voffB); PG8_STAGE(PG8_SA(1, 0), cA + kstep, voffA); PG8_STAGE(PG8_SB(1, 1), cB + hstep + kstep, voffB);
        PG8_WAIT_V(6); PG8_BAR;
    }
    for (;;) {
        const bool has_next = S.next(ui + 1, nxt);
        const char* nA = has_next ? (const char*)g.A + (size_t)nxt.pm * tstep : cA; const char* nB = has_next ? (const char*)g.Bt + (size_t)nxt.pn * bstep : cB;
        for (int t = 0; t < nt; t += 2) {
            const bool last = (t == nt - 2);
            const char* a1 = cA + (size_t)(t + 1) * kstep;
            const char* a2 = last ? nA : cA + (size_t)(t + 2) * kstep; const char* b2 = last ? nB : cB + (size_t)(t + 2) * kstep;
            const char* a3 = a2 + kstep; const char* b3 = b2 + kstep;
            if (last && has_next) S.a_ready(nxt);
            if constexpr (HALFN) {
            PG8_LDB(B0, 0, 0); PG8_SCHED; PG8_LDA(At, 0, 0); PG8_STAGE(PG8_SA(1, 1), a1 + hstep, voffA);
            PG8_WAIT_V(6); PG8_WAIT_L(0); PG8_BAR; PG8_MMA(0, 0, At, B0); PG8_BAR; PG8_SCHED;
            PG8_LDA(At, 0, 1); PG8_STAGE(PG8_SB(0, 0), b2, voffB); PG8_STAGE(PG8_SA(0, 0), a2, voffA);
            PG8_WAIT_V(6); PG8_WAIT_L(0); PG8_BAR; PG8_MMA(1, 0, At, B0); PG8_BAR; PG8_SCHED;
            PG8_LDB(B0, 1, 0); PG8_SCHED; PG8_LDA(At, 1, 0); PG8_STAGE(PG8_SA(0, 1), a2 + hstep, voffA);
            PG8_WAIT_V(6); PG8_WAIT_L(0); PG8_BAR; PG8_MMA(0, 0, At, B0); PG8_BAR; PG8_SCHED;
            PG8_LDA(At, 1, 1); PG8_STAGE(PG8_SB(1, 0), b3, voffB); PG8_STAGE(PG8_SA(1, 0), a3, voffA);
            PG8_WAIT_V(6); PG8_WAIT_L(0); PG8_BAR; PG8_MMA(1, 0, At, B0); PG8_BAR; PG8_SCHED;
            } else if constexpr (SP2) {
            PG8_LDB(B0, 0, 0); PG8_LDB(B1, 0, 1); PG8_SCHED; PG8_LDA(At, 0, 0); PG8_STAGE(PG8_SA(1, 1), a1 + hstep, voffA);
            PG8_WAIT_V(8); PG8_WAIT_L(0); PG8_BAR; PG8_MMA(0, 0, At, B0); PG8_MMA(0, 1, At, B1); PG8_BAR; PG8_SCHED;
            PG8_LDA(At, 0, 1); PG8_STAGE(PG8_SB(0, 0), b2, voffB); PG8_STAGE(PG8_SB(0, 1), b2 + hstep, voffB); PG8_STAGE(PG8_SA(0, 0), a2, voffA);
            PG8_WAIT_V(8); PG8_WAIT_L(0); PG8_BAR; PG8_MMA(1, 0, At, B0); PG8_MMA(1, 1, At, B1); PG8_BAR; PG8_SCHED;
            PG8_LDB(B0, 1, 0); PG8_LDB(B1, 1, 1); PG8_SCHED; PG8_LDA(At, 1, 0); PG8_STAGE(PG8_SA(0, 1), a2 + hstep, voffA);
            PG8_WAIT_V(8); PG8_WAIT_L(0); PG8_BAR; PG8_MMA(0, 0, At, B0); PG8_MMA(0, 1, At, B1); PG8_BAR; PG8_SCHED;
            PG8_LDA(At, 1, 1); PG8_STAGE(PG8_SB(1, 0), b3, voffB); PG8_STAGE(PG8_SB(1, 1), b3 + hstep, voffB); PG8_STAGE(PG8_SA(1, 0), a3, voffA);
            PG8_WAIT_V(8); PG8_WAIT_L(0); PG8_BAR; PG8_MMA(1, 0, At, B0); PG8_MMA(1, 1, At, B1); PG8_BAR; PG8_SCHED;
            } else {
            PG8_LDB(B0, 0, 0); PG8_SCHED; PG8_LDA(At, 0, 0); PG8_STAGE(PG8_SA(1, 1), a1 + hstep, voffA);
            PG8_WAIT_L(8); PG8_BAR; PG8_WAIT_L(0); PG8_MMA(0, 0, At, B0); PG8_BAR; PG8_SCHED;
            PG8_LDB(B1, 0, 1); PG8_STAGE(PG8_SB(0, 0), b2, voffB);
            PG8_BAR; PG8_WAIT_L(0); PG8_MMA(0, 1, At, B1); PG8_BAR;
            PG8_LDA(At, 0, 1); PG8_STAGE(PG8_SA(0, 0), a2, voffA);
            PG8_BAR; PG8_WAIT_L(0); PG8_MMA(1, 0, At, B0); PG8_BAR; PG8_SCHED;
            PG8_STAGE(PG8_SB(0, 1), b2 + hstep, voffB);
            PG8_WAIT_V(6); PG8_BAR; PG8_MMA(1, 1, At, B1); PG8_BAR;
            PG8_LDB(B0, 1, 0); PG8_SCHED; PG8_LDA(At, 1, 0); PG8_STAGE(PG8_SA(0, 1), a2 + hstep, voffA);
            PG8_WAIT_L(8); PG8_BAR; PG8_WAIT_L(0); PG8_MMA(0, 0, At, B0); PG8_BAR; PG8_SCHED;
            PG8_LDB(B1, 1, 1); PG8_STAGE(PG8_SB(1, 0), b3, voffB);
            PG8_BAR; PG8_WAIT_L(0); PG8_MMA(0, 1, At, B1); PG8_BAR;
            PG8_LDA(At, 1, 1); PG8_STAGE(PG8_SA(1, 0), a3, voffA);
            PG8_BAR; PG8_WAIT_L(0); PG8_MMA(1, 0, At, B0); PG8_BAR; PG8_SCHED;
            PG8_STAGE(PG8_SB(1, 1), b3 + hstep, voffB);
            PG8_WAIT_V(6); PG8_BAR; PG8_MMA(1, 1, At, B1); PG8_BAR;
            }
        }
        if constexpr (ALIGN_EPI) { if (wr == 0) PG8_BAR; }
        if constexpr (!Epi::AFTER_DRAIN) { E(acc, cur, wr, wc, fr, fq); S.done(cur); }
        if (!has_next) break;
#pragma unroll
        for (int a = 0; a < 2; ++a)
#pragma unroll
            for (int b = 0; b < 2; ++b)
#pragma unroll
                for (int m = 0; m < 4; ++m)
#pragma unroll
                    for (int n = 0; n < 2; ++n) acc[a][b][m][n] = (f32x4){0.f, 0.f, 0.f, 0.f};
        cur = nxt; cA = nA; cB = nB; ++ui;
        if constexpr (ALIGN_EPI) { if (wr == 1) PG8_BAR; }
    }
    PG8_WAIT_V(0);
    if constexpr (!ALIGN_EPI) { if (wr == 0) PG8_BAR; }
    PG8_BAR;
    if constexpr (Epi::AFTER_DRAIN) { E.fused(acc, cur, wr, wc, fr, fq, lds, wid, lane); S.done(cur); }
#undef PG8_SA
#undef PG8_SB
#undef PG8_STAGE
#undef PG8_LDA
#undef PG8_LDB
#undef PG8_MMA
#undef PG8_WAIT_V
#undef PG8_WAIT_L
#undef PG8_BAR
#undef PG8_SCHED
}
}
constexpr int NWAVES = 8, NTHR = 512;
constexpr size_t MiB = 1u << 20;
constexpr size_t WS_CTL = 0, CTL_ZERO_BYTES = 1 * MiB;
constexpr size_t WS_MODS = 256 * 1024;
constexpr size_t WS_STAT = 768 * 1024;
constexpr size_t WS_SW = 372 * MiB, WS_GT = 374 * MiB;
constexpr size_t WS_ROPE = 1 * MiB;
constexpr size_t WS_W = 2 * MiB;
constexpr size_t W_MLA = WS_W, MLA_WB = 5898240;
constexpr size_t MW_CAT = 0, MW_UQ = 1572864, MW_UKV = 2752512, MW_O = 3801088;
constexpr size_t W_CV1 = WS_W + 2 * MLA_WB, W_CV2 = W_CV1 + 4 * MiB;
constexpr size_t W_SSI = W_CV2 + 2 * MiB, W_SSO = W_SSI + 11010048;
constexpr size_t W_FF = W_SSO + 4 * MiB, FF_WB = 17301504, FW_IN = 0, FW_OUT = 11534336;
static_assert(W_FF + 4 * FF_WB <= 102 * MiB, "weights region");
constexpr size_t WS_H = 102 * MiB;
constexpr size_t WS_CKV = 118 * MiB, CKV_B = (size_t)(T + NCTX) * KVL * 2;
constexpr size_t WS_AR = 128 * MiB;
constexpr size_t A_LAT = WS_AR, A_QN = A_LAT + 24 * MiB, A_QRAW = A_QN + 6 * MiB, A_KVRAW = A_QRAW + 24 * MiB, A_QB = A_KVRAW + 36 * MiB, A_KB = A_QB + 24 * MiB, A_AO = A_KB + 27 * MiB;
constexpr size_t A_U = WS_AR, A_V = A_U + 16 * MiB;
constexpr size_t A_Z = WS_AR, A_XPRE = A_Z + 32 * MiB, A_DTRAW = A_XPRE + 48 * MiB, A_XBC = A_DTRAW + 2 * MiB, A_DT = A_XBC + 48 * MiB, A_Y = A_DT + 2 * MiB, A_YN = A_XPRE, A_ACUM = A_Y + 64 * MiB;
constexpr size_t A_ACT = WS_AR + 200 * MiB;
static_assert(A_AO + 16 * MiB <= A_ACT && A_ACUM + 2 * MiB <= A_ACT && A_ACT + 44 * MiB <= 384 * MiB, "arena map");
constexpr int CW_BAR = 4096;
constexpr int LDS_BYTES = 163840, RING_BYTES = 131072, MISC_OFF = 163840 - 256, PTAB_OFF_C = MISC_OFF - 512;

#define GAS __attribute__((address_space(1)))
#define LAS __attribute__((address_space(3)))
typedef unsigned short bf16;
typedef unsigned v4u __attribute__((ext_vector_type(4)));
typedef unsigned v2u __attribute__((ext_vector_type(2)));
typedef float v4f __attribute__((ext_vector_type(4)));
typedef float v2f __attribute__((ext_vector_type(2)));
typedef GAS unsigned gu32;
#define LDS_WAIT() asm volatile("s_waitcnt lgkmcnt(0)" ::: "memory")
#define LDS_BARRIER() do { asm volatile("s_waitcnt lgkmcnt(0)" ::: "memory"); __builtin_amdgcn_s_barrier(); asm volatile("" ::: "memory"); } while (0)
#define VM_WAIT() asm volatile("s_waitcnt vmcnt(0)" ::: "memory")
__device__ __forceinline__ unsigned f2bf(float f) { unsigned u = __builtin_bit_cast(unsigned, f); return (u + 0x7fffu + ((u >> 16) & 1u)) >> 16; }
__device__ __forceinline__ unsigned pk2(float lo, float hi) { return f2bf(lo) | (f2bf(hi) << 16); }
__device__ __forceinline__ float bflo(unsigned u) { return __builtin_bit_cast(float, u << 16); }
__device__ __forceinline__ float bfhi(unsigned u) { return __builtin_bit_cast(float, u & 0xffff0000u); }
__device__ __forceinline__ float bf2f(bf16 b) { return __builtin_bit_cast(float, (unsigned)b << 16); }

#define XB_TMO      128
#define XB_XCNT(j)  (256  + 64 * (j))
#define XB_XSUB(j)  (1280 + 64 * (j))
#define XB_XGEN(j)  (2304 + 64 * (j))
#define XB_TOP      3328
#define XB_TOPGEN   3392
#define XCD_BAR_WORDS 3456
#define XB_SPIN_CAP (1u << 18)

__device__ __forceinline__ unsigned xb_ld(unsigned* p)              { return __hip_atomic_load(p, __ATOMIC_RELAXED, __HIP_MEMORY_SCOPE_AGENT); }
__device__ __forceinline__ unsigned xb_add(unsigned* p, unsigned v) { return __hip_atomic_fetch_add(p, v, __ATOMIC_RELAXED, __HIP_MEMORY_SCOPE_AGENT); }
__device__ __forceinline__ unsigned xb_xcc_id() { return (unsigned)__builtin_amdgcn_s_getreg((3 << 11) | 20) & 0xFu; }
#define XB_SPIN(cond, bar) do { unsigned _sp = 0; while (cond) { __builtin_amdgcn_s_sleep(1); \
    if ((++_sp & 255u) == 0u) { if (xb_ld(&(bar)[XB_TMO])) break; if (_sp > XB_SPIN_CAP) { atomicAdd(&(bar)[XB_TMO], 1u); break; } } } } while (0)

struct XcdBarrier {
    unsigned* bar; unsigned x;
    volatile LAS unsigned* st;
};

__device__ __forceinline__ XcdBarrier xcd_barrier_post(unsigned* bar, volatile LAS unsigned* st) {
    XcdBarrier b; b.bar = bar; b.x = xb_xcc_id(); b.st = st;
    if (threadIdx.x == 0) (void)xb_add(&bar[XB_XCNT(b.x)], 1u);
    return b;
}
__device__ __forceinline__ void xcd_barrier_complete(unsigned* bar, unsigned x, unsigned& nloc, unsigned& nx) {
    const unsigned G = gridDim.x * gridDim.y * gridDim.z;
    unsigned sum, cnt, mine, sp = 0u;
    for (;;) {
        sum = 0u; cnt = 0u; mine = 0u;
#pragma unroll
        for (unsigned j = 0; j < 16; ++j) { const unsigned c = xb_ld(&bar[XB_XCNT(j)]); sum += c; cnt += (c > 0u) ? 1u : 0u; mine = (j == x) ? c : mine; }
        if (sum == G) break;
        __builtin_amdgcn_s_sleep(1);
        if ((++sp & 255u) == 0u) { if (xb_ld(&bar[XB_TMO])) break; if (sp > XB_SPIN_CAP) { atomicAdd(&bar[XB_TMO], 1u); break; } }
    }
    nloc = mine > 0u ? mine : 1u; nx = cnt > 0u ? cnt : 1u;
}

__device__ __forceinline__ void xcd_barrier(const XcdBarrier& b) {
    asm volatile("s_waitcnt vmcnt(0)" ::: "memory");
    __syncthreads();
    if (threadIdx.x == 0) {
        unsigned* bar = b.bar;
        __builtin_amdgcn_s_waitcnt(0);
        unsigned nloc = b.st[0], nx = b.st[1];
        if (nloc == 0u) { xcd_barrier_complete(bar, b.x, nloc, nx); b.st[0] = nloc; b.st[1] = nx; }
        const unsigned old = xb_add(&bar[XB_XSUB(b.x)], 1u);
        const unsigned gen = old / nloc;
        if (old + 1u == (gen + 1u) * nloc) {
            __builtin_amdgcn_fence(__ATOMIC_RELEASE, "agent");
            asm volatile("s_waitcnt vmcnt(0)" ::: "memory");
            const unsigned og = xb_add(&bar[XB_TOP], 1u);
            const unsigned tg = og / nx;
            if (og + 1u == (tg + 1u) * nx) xb_add(&bar[XB_TOPGEN], 1u);
            else XB_SPIN(xb_ld(&bar[XB_TOPGEN]) == tg, bar);
            __builtin_amdgcn_fence(__ATOMIC_ACQUIRE, "agent");
            xb_add(&bar[XB_XGEN(b.x)], 1u);
            asm volatile("s_waitcnt vmcnt(0)" ::: "memory");
        } else {
            XB_SPIN(xb_ld(&bar[XB_XGEN(b.x)]) == gen, bar);
            __builtin_amdgcn_fence(__ATOMIC_ACQUIRE, "agent");
            asm volatile("s_waitcnt vmcnt(0)" ::: "memory");
        }
    }
    __syncthreads();
}

struct Frame {
    LAS unsigned char* lds; int tid, lane, wave, vcu, G, gw, NGW, bx;
    volatile LAS unsigned* PT;
};
constexpr int PT_OUT = 38, PT_WS = 39;
__device__ __forceinline__ const float* ldp(volatile LAS unsigned* PT, int k) {
    const unsigned lo = __builtin_amdgcn_readfirstlane(PT[2 * k]), hi = __builtin_amdgcn_readfirstlane(PT[2 * k + 1]);
    return (const float*)(((unsigned long long)hi << 32) | lo);
}
#define INP(k) ldp(F.PT, (k))
#define WSP ((unsigned char*)ldp(F.PT, PT_WS))
#define OUTP ((float*)ldp(F.PT, PT_OUT))
enum InIdx { I_XP = 0, I_XS, I_CCKV, I_CKPE, I_SSM, I_C, I_CCTX, I_WADA, I_BADA, I_GN1, I_GN2, I_WDQ, I_GQ, I_WUQ, I_WDKV, I_GKV, I_WUKV, I_GQN, I_GKN, I_WO,
             I_CVW1, I_CVB1, I_CVWD, I_CVBD, I_CVGL, I_CVBL, I_CVW2, I_CVB2, I_SSWI, I_SSWC, I_SSBC, I_SSDTB, I_SSAL, I_SSD, I_SSGN, I_SSWO, I_FFWI, I_FFWO };
__device__ __forceinline__ float shx(float v, int lane, int o) { return __builtin_bit_cast(float, __builtin_amdgcn_ds_bpermute((lane ^ o) << 2, __builtin_bit_cast(int, v))); }
__device__ __forceinline__ float wsum(float v, int lane) {
#pragma unroll
    for (int o = 1; o < 64; o <<= 1) v += shx(v, lane, o);
    return v;
}
constexpr float QSCALE = 0.10206207261596577f * 1.4426950408889634f;

struct P0Item { const float* W; bf16* WT; int K, N, mode, H, roff, k0, n0; };
__device__ __forceinline__ void p0_item_load(const P0Item& J, int lane, v4f (&t)[8]) {
#pragma unroll
    for (int i = 0; i < 8; ++i) t[i] = *(const GAS v4f*)(J.W + (size_t)(J.k0 + 8 * i + (lane >> 3)) * J.N + J.n0 + 4 * (lane & 7));
}
__device__ __forceinline__ void p0_item_finish(const P0Item& J, int lane, const v4f (&t)[8], LAS float* scr) {
#pragma unroll
    for (int i = 0; i < 8; ++i) { LAS float* d = scr + (8 * i + (lane >> 3)) * 33 + 4 * (lane & 7); d[0] = t[i].x; d[1] = t[i].y; d[2] = t[i].z; d[3] = t[i].w; }
    LDS_WAIT(); asm volatile("" ::: "memory");
    const int c = lane & 7;
#pragma unroll
    for (int j = 0; j < 4; ++j) { const int n = (lane >> 3) + 8 * j, col = J.n0 + n; const LAS float* s = scr + (8 * c) * 33 + n;
        int drow;
        if (J.mode == 0) drow = J.roff + col;
        else { const int f = col < J.H ? col : col - J.H; drow = 32 * (f >> 4) + (f & 15) + (col < J.H ? 0 : 16); }
        v4u o; o.x = pk2(s[0 * 33], s[1 * 33]); o.y = pk2(s[2 * 33], s[3 * 33]); o.z = pk2(s[4 * 33], s[5 * 33]); o.w = pk2(s[6 * 33], s[7 * 33]);
        *(GAS v4u*)(J.WT + (size_t)drow * J.K + J.k0 + 8 * c) = o; }
    LDS_WAIT(); asm volatile("" ::: "memory");
}
__device__ __forceinline__ void p0_job(int q, int& inp, size_t& soff, int& K, int& N, size_t& doff, int& mode, int& H, int& roff) {
    mode = 0; H = 0; roff = 0; soff = 0;
    if (q < 10) { const int j = q / 5, t = q % 5; const size_t wb = W_MLA + (size_t)j * MLA_WB;
        if (t == 0) { inp = I_WDQ; soff = (size_t)j * 1024 * 384; K = 1024; N = 384; doff = wb + MW_CAT; }
        else if (t == 1) { inp = I_WDKV; soff = (size_t)j * 1024 * 288; K = 1024; N = 288; doff = wb + MW_CAT; roff = 384; }
        else if (t == 2) { inp = I_WUQ; soff = (size_t)j * 384 * 1536; K = 384; N = 1536; doff = wb + MW_UQ; }
        else if (t == 3) { inp = I_WUKV; soff = (size_t)j * 256 * 2048; K = 256; N = 2048; doff = wb + MW_UKV; }
        else { inp = I_WO; soff = (size_t)j * 1024 * 1024; K = 1024; N = 1024; doff = wb + MW_O; } }
    else if (q == 10) { inp = I_CVW1; K = 1024; N = 2048; doff = W_CV1; mode = 1; H = 1024; }
    else if (q == 11) { inp = I_CVW2; K = 1024; N = 1024; doff = W_CV2; }
    else if (q == 12) { inp = I_SSWI; K = 1024; N = 5184; doff = W_SSI; }
    else if (q == 13) { inp = I_SSWO; K = 2048; N = 1024; doff = W_SSO; }
    else { const int l = (q - 14) >> 1, t = (q - 14) & 1;
        if (t == 0) { inp = I_FFWI; soff = (size_t)l * 1024 * 5632; K = 1024; N = 5632; doff = W_FF + (size_t)l * FF_WB + FW_IN; mode = 1; H = 2816; }
        else { inp = I_FFWO; soff = (size_t)l * 2816 * 1024; K = 2816; N = 1024; doff = W_FF + (size_t)l * FF_WB + FW_OUT; } }
}
constexpr int P0_NITEMS = 2 * ((1024 / 64) * (384 / 32) + (1024 / 64) * (288 / 32) + (384 / 64) * (1536 / 32) + (256 / 64) * (2048 / 32) + (1024 / 64) * (1024 / 32))
                        + (1024 / 64) * (2048 / 32) + (1024 / 64) * (1024 / 32) + (1024 / 64) * (5184 / 32) + (2048 / 64) * (1024 / 32)
                        + 4 * ((1024 / 64) * (5632 / 32) + (2816 / 64) * (1024 / 32));
__device__ __forceinline__ void p0_prologue(Frame& F) {
    unsigned char* ws = WSP;
    LAS float* s = (LAS float*)F.lds;
    for (int i = F.tid; i < 5 * 1024; i += NTHR) { const int cc = i >> 10, k = i & 1023; const float v = cc == 0 ? INP(I_CCTX)[k] : INP(I_C)[(cc - 1) * 1024 + k]; s[i] = v / (1.f + expf(-v)); }
    __syncthreads();
    float* mods = (float*)(ws + WS_MODS);
    for (int it = F.bx; it < 192; it += F.G) {
        const int l = it / 48, r = it % 48, cb = r / 16, ks = r % 16, n = cb * 2048 + 4 * F.tid;
        const float* W = INP(I_WADA) + (size_t)l * 1024 * 6144 + (size_t)(ks * 64) * 6144 + n;
        v4f acc[5];
#pragma unroll
        for (int cc = 0; cc < 5; ++cc) acc[cc] = (v4f){0.f, 0.f, 0.f, 0.f};
#pragma unroll 1
        for (int kb = 0; kb < 64; kb += 16) {
            v4f wv[16];
#pragma unroll
            for (int k = 0; k < 16; ++k) wv[k] = *(const GAS v4f*)(W + (size_t)(kb + k) * 6144);
#pragma unroll
            for (int k = 0; k < 16; ++k)
#pragma unroll
                for (int cc = 0; cc < 5; ++cc) acc[cc] += wv[k] * s[cc * 1024 + ks * 64 + kb + k];
        }
        LAS float* tbl = s + 5 * 1024;
        __syncthreads();
#pragma unroll
        for (int cc = 0; cc < 5; ++cc) *(LAS v4f*)(tbl + cc * 2048 + 4 * F.tid) = acc[cc];
        __syncthreads();
        const float* bp = INP(I_BADA) + l * 6144 + cb * 2048;
#pragma unroll
        for (int q = 0; q < 4; ++q) { const int col = q * 512 + F.tid; const float bb = ks == 0 ? bp[col] : 0.f;
#pragma unroll
            for (int cc = 0; cc < 5; ++cc) atomicAdd(&mods[((size_t)l * 5 + cc) * 6144 + cb * 2048 + col], tbl[cc * 2048 + col] + bb); }
    }
    __syncthreads();
    LAS float* scr = (LAS float*)(F.lds + F.wave * 8448);
    for (int it = F.gw; it < P0_NITEMS; it += 2 * F.NGW) {
        P0Item J[2]; bool have1 = it + F.NGW < P0_NITEMS;
#pragma unroll
        for (int e = 0; e < 2; ++e) {
            int r = e == 0 ? it : (have1 ? it + F.NGW : it), inp = 0, K = 64, N = 32, mode = 0, H = 0, roff = 0; size_t soff = 0, doff = 0;
#pragma unroll 1
            for (int q = 0; q < 22; ++q) { p0_job(q, inp, soff, K, N, doff, mode, H, roff); const int ni = (K / 64) * (N / 32); if (r < ni) break; r -= ni; }
            const int nblk = N / 32;
            J[e].W = INP(inp) + soff; J[e].WT = (bf16*)(ws + doff); J[e].K = K; J[e].N = N; J[e].mode = mode; J[e].H = H; J[e].roff = roff; J[e].k0 = 64 * (r / nblk); J[e].n0 = 32 * (r % nblk);
        }
        v4f t0[8], t1[8];
        p0_item_load(J[0], F.lane, t0); p0_item_load(J[1], F.lane, t1);
        p0_item_finish(J[0], F.lane, t0, scr);
        if (have1) p0_item_finish(J[1], F.lane, t1, scr);
    }
    for (int it = F.gw; it < 384; it += F.NGW) {
        bf16* rowp = it < 192 ? (bf16*)(ws + W_MLA + (it / 96) * MLA_WB + MW_CAT) + (size_t)(672 + it % 96) * 1024 : (bf16*)(ws + W_SSI) + (size_t)(5184 + it - 192) * 1024;
        const v4u z = {0u, 0u, 0u, 0u}; ((GAS v4u*)rowp)[F.lane] = z; ((GAS v4u*)rowp)[64 + F.lane] = z;
    }
    for (int it = F.gw; it < 2048; it += F.NGW) {
        const int j = it >> 10, rr = it & 1023, b = rr >> 8, sq = rr & 255;
        const v4f v = ((const GAS v4f*)(INP(I_CCKV) + (((size_t)b * 2 + j) * 256 + sq) * 256))[F.lane];
        v2u o; o.x = pk2(v.x, v.y); o.y = pk2(v.z, v.w);
        ((GAS v2u*)((bf16*)(ws + WS_CKV + j * CKV_B) + (size_t)(T + rr) * 256))[F.lane] = o;
    }
    if (F.bx == 0) for (int i = F.tid; i < 640; i += NTHR) { const int pos = i >> 3, fi = i & 7; const float p = (float)(pos < 16 ? pos : pos - 16);
        const float a = p * rope_inv(fi); float* tab = (float*)(ws + WS_ROPE); tab[2 * i] = cosf(a); tab[2 * i + 1] = sinf(a); }
}

__device__ __forceinline__ void rp_normmod(Frame& F, const float* xlo, const float* xhi, const float* g, const float* mods_l, int sh_off, int sc_off, bf16* h) {
    for (int base = F.gw; base < T; base += 4 * F.NGW) {
        v4f v[4][4]; float ss[4]; int rows[4];
#pragma unroll
        for (int k = 0; k < 4; ++k) { const int row = base + k * F.NGW; rows[k] = row < T ? row : base;
            const GAS v4f* xr = (const GAS v4f*)((rows[k] < TP ? xlo : xhi) + (size_t)rows[k] * 1024) + F.lane;
#pragma unroll
            for (int j = 0; j < 4; ++j) v[k][j] = xr[64 * j]; }
#pragma unroll
        for (int k = 0; k < 4; ++k) { float s = 0.f;
#pragma unroll
            for (int j = 0; j < 4; ++j) s += (v[k][j].x * v[k][j].x + v[k][j].y * v[k][j].y) + (v[k][j].z * v[k][j].z + v[k][j].w * v[k][j].w);
            ss[k] = s; }
#pragma unroll
        for (int o = 1; o < 64; o <<= 1) {
#pragma unroll
            for (int k = 0; k < 4; ++k) ss[k] += shx(ss[k], F.lane, o); }
#pragma unroll
        for (int j = 0; j < 4; ++j) { const int c = 4 * F.lane + 256 * j; const v4f g4 = *(const GAS v4f*)(g + c);
#pragma unroll
            for (int k = 0; k < 4; ++k) { const float r = rsqrtf(ss[k] * (1.f / 1024) + EPS); const float* m = mods_l + (size_t)cond_of_row(rows[k]) * 6144;
                const v4f sc = *(const GAS v4f*)(m + sc_off + c), sh = *(const GAS v4f*)(m + sh_off + c);
                const v4f o = v[k][j] * r * g4 * (sc + 1.f) + sh; v2u w; w.x = pk2(o.x, o.y); w.y = pk2(o.z, o.w);
                *(GAS v2u*)(h + (size_t)rows[k] * 1024 + c) = w; } }
    }
}
__device__ __forceinline__ void rp_mla_fin1(Frame& F, const float* lat, const float* gq, const float* gkv, bf16* qn, bf16* ckv, float* out, int j) {
    for (int row = F.gw; row < T; row += F.NGW) {
        const float* lr = lat + (size_t)row * 768;
        v2f q[3]; float ss = 0.f;
#pragma unroll
        for (int i = 0; i < 3; ++i) { q[i] = *(const GAS v2f*)(lr + 2 * F.lane + 128 * i); ss += q[i].x * q[i].x + q[i].y * q[i].y; }
        float r = rsqrtf(wsum(ss, F.lane) * (1.f / 384) + EPS);
#pragma unroll
        for (int i = 0; i < 3; ++i) { const int c = 2 * F.lane + 128 * i; *(GAS unsigned*)(qn + (size_t)row * 384 + c) = pk2(q[i].x * r * gq[c], q[i].y * r * gq[c + 1]); }
        v2f k[2]; ss = 0.f;
#pragma unroll
        for (int i = 0; i < 2; ++i) { k[i] = *(const GAS v2f*)(lr + 384 + 2 * F.lane + 128 * i); ss += k[i].x * k[i].x + k[i].y * k[i].y; }
        r = rsqrtf(wsum(ss, F.lane) * (1.f / 256) + EPS);
#pragma unroll
        for (int i = 0; i < 2; ++i) { const int c = 2 * F.lane + 128 * i; const float c0 = k[i].x * r * gkv[c], c1 = k[i].y * r * gkv[c + 1];
            *(GAS unsigned*)(ckv + (size_t)row * 256 + c) = pk2(c0, c1);
            if (row < TP) { v2f o; o.x = c0; o.y = c1; *(GAS v2f*)(out + OUT_CKV + (((size_t)(row >> 8) * 2 + j) * 256 + (row & 255)) * 256 + c) = o; } }
        if (row < TP && F.lane < 32) out[OUT_KPE + (((size_t)(row >> 8) * 2 + j) * 256 + (row & 255)) * 32 + F.lane] = lr[640 + F.lane];
    }
}
__device__ __forceinline__ void rope32_tab(float* pe, int t, const float* tab) {
    const v2f* tr = (const v2f*)tab + (t >> 6) * 8; const v2f* tc = (const v2f*)tab + (16 + (t & 63)) * 8;
#pragma unroll
    for (int i = 0; i < 8; ++i) {
        v2f cs = tr[i]; float x1 = pe[i], x2 = pe[i + 8]; pe[i] = x1 * cs.x - x2 * cs.y; pe[i + 8] = x2 * cs.x + x1 * cs.y;
        cs = tc[i]; x1 = pe[16 + i]; x2 = pe[24 + i]; pe[16 + i] = x1 * cs.x - x2 * cs.y; pe[24 + i] = x2 * cs.x + x1 * cs.y;
    }
}
__device__ __forceinline__ void ld8(const bf16* p, float* d) { const v4u w = *(const GAS v4u*)p; d[0] = bflo(w.x); d[1] = bfhi(w.x); d[2] = bflo(w.y); d[3] = bfhi(w.y); d[4] = bflo(w.z); d[5] = bfhi(w.z); d[6] = bflo(w.w); d[7] = bfhi(w.w); }
__device__ __forceinline__ void st8(bf16* p, const float* d) { v4u w; w.x = pk2(d[0], d[1]); w.y = pk2(d[2], d[3]); w.z = pk2(d[4], d[5]); w.w = pk2(d[6], d[7]); *(GAS v4u*)p = w; }
__device__ __forceinline__ void rp_tables(Frame& F) {
    unsigned char* ws = WSP; const float* mods = (const float*)(ws + WS_MODS); float* GTb = (float*)(ws + WS_GT); float* SWb = (float*)(ws + WS_SW);
    for (int idx = F.bx * NTHR + F.tid; idx < 8 * 5 * 1024; idx += F.G * NTHR) {
        const int s = idx / 5120, r = idx % 5120, c = r >> 10, k = r & 1023, layer = s >> 1;
        const float g = (s & 1) ? INP(I_GN2)[layer * 1024 + k] : INP(I_GN1)[layer * 1024 + k];
        GTb[idx] = g * (1.f + mods[((size_t)layer * 5 + c) * 6144 + ((s & 1) ? 4096 : 1024) + k]);
    }
    constexpr int NR1 = 5632, NR2 = 2048, NR4 = 5376, NR6 = 768;
    constexpr int TOT = 4 * NR1 + NR2 + NR4 + NR6;
    for (int it = F.gw; it < TOT / 4; it += F.NGW) {
        int s, n; const bf16* Wt; const int i4 = 4 * it;
        if (i4 < 4 * NR1) { const int l = i4 / NR1; n = i4 % NR1; s = 2 * l + 1; Wt = (const bf16*)(ws + W_FF + (size_t)l * FF_WB + FW_IN); }
        else if (i4 < 4 * NR1 + NR2) { n = i4 - 4 * NR1; s = 2; Wt = (const bf16*)(ws + W_CV1); }
        else if (i4 < 4 * NR1 + NR2 + NR4) { n = i4 - 4 * NR1 - NR2; s = 4; Wt = (const bf16*)(ws + W_SSI); }
        else { n = i4 - 4 * NR1 - NR2 - NR4; s = 6; Wt = (const bf16*)(ws + W_MLA + MLA_WB + MW_CAT); }
        const int layer = s >> 1, shoff = (s & 1) ? 3072 : 0;
        v4u wr[4][2];
#pragma unroll
        for (int r = 0; r < 4; ++r) { wr[r][0] = *(const GAS v4u*)(Wt + (size_t)(n + r) * 1024 + 16 * F.lane); wr[r][1] = *(const GAS v4u*)(Wt + (size_t)(n + r) * 1024 + 16 * F.lane + 8); }
        float acc[4][5];
#pragma unroll
        for (int r = 0; r < 4; ++r)
#pragma unroll
            for (int c = 0; c < 5; ++c) acc[r][c] = 0.f;
#pragma unroll
        for (int c = 0; c < 5; ++c) { const float* sp = mods + ((size_t)layer * 5 + c) * 6144 + shoff + 16 * F.lane;
            const v4f s0 = *(const GAS v4f*)sp, s1 = *(const GAS v4f*)(sp + 4), s2 = *(const GAS v4f*)(sp + 8), s3 = *(const GAS v4f*)(sp + 12);
#pragma unroll
            for (int r = 0; r < 4; ++r) { const v4u a = wr[r][0], b2 = wr[r][1];
                acc[r][c] = (s0.x * bflo(a.x) + s0.y * bfhi(a.x) + s0.z * bflo(a.y) + s0.w * bfhi(a.y)) + (s1.x * bflo(a.z) + s1.y * bfhi(a.z) + s1.z * bflo(a.w) + s1.w * bfhi(a.w))
                          + (s2.x * bflo(b2.x) + s2.y * bfhi(b2.x) + s2.z * bflo(b2.y) + s2.w * bfhi(b2.y)) + (s3.x * bflo(b2.z) + s3.y * bfhi(b2.z) + s3.z * bflo(b2.w) + s3.w * bfhi(b2.w)); } }
#pragma unroll
        for (int o = 1; o < 64; o <<= 1) {
#pragma unroll
            for (int r = 0; r < 4; ++r)
#pragma unroll
                for (int c = 0; c < 5; ++c) acc[r][c] += shx(acc[r][c], F.lane, o); }
        if (F.lane < 20) { const int r = F.lane / 5, c = F.lane % 5; float v = 0.f;
#pragma unroll
            for (int rr = 0; rr < 4; ++rr)
#pragma unroll
                for (int cc = 0; cc < 5; ++cc) v = (rr == r && cc == c) ? acc[rr][cc] : v;
            SWb[((size_t)s * 5 + c) * 5632 + n + r] = v; }
    }
}
__device__ __forceinline__ void rp_mla_fin2(Frame& F, const bf16* qraw, const bf16* kvraw, const float* lat, const float* ckpe_j, const float* gqn, const float* gkn, const float* tab, bf16* Q, bf16* K) {
    for (int idx = F.bx * NTHR + F.tid; idx < T * 32; idx += F.G * NTHR) {
        const int row = idx >> 5, hd = (idx >> 1) & 15, hf = idx & 1; const bool latent = row >= TP; const int tl = (row - TP) & 1023;
        float v[48]; float ss = 0.f;
#pragma unroll
        for (int i = 0; i < 6; ++i) ld8(qraw + (size_t)row * 1536 + hd * 96 + hf * 48 + 8 * i, v + 8 * i);
#pragma unroll
        for (int d = 0; d < 48; ++d) ss += v[d] * v[d];
        ss += shx(ss, F.lane, 1);
        const float r = rsqrtf(ss * (1.f / 96) + EPS) * QSCALE;
#pragma unroll
        for (int d = 0; d < 48; ++d) v[d] = v[d] * r * gqn[hf * 48 + d];
        if (latent && hf) rope32_tab(v + 16, tl, tab);
#pragma unroll
        for (int i = 0; i < 6; ++i) st8(Q + ((size_t)row * 16 + hd) * 96 + hf * 48 + 8 * i, v + 8 * i);
    }
    asm volatile("" ::: "memory");
    for (int idx = F.bx * NTHR + F.tid; idx < (T + NCTX) * 32; idx += F.G * NTHR) {
        const int row = idx >> 5, hd = (idx >> 1) & 15, hf = idx & 1; const bool latent = row >= TP && row < T; const int tl = (row - TP) & 1023;
        float v[48]; float ss = 0.f;
        if (hf == 0) {
#pragma unroll
            for (int i = 0; i < 6; ++i) ld8(kvraw + (size_t)row * 2048 + hd * 128 + 8 * i, v + 8 * i);
        } else {
#pragma unroll
            for (int i = 0; i < 2; ++i) ld8(kvraw + (size_t)row * 2048 + hd * 128 + 48 + 8 * i, v + 8 * i);
            const float* kp = row < T ? lat + (size_t)row * 768 + 640 : ckpe_j + ((size_t)((row - T) >> 8) * 2 * 256 + ((row - T) & 255)) * 32;
#pragma unroll
            for (int i = 0; i < 8; ++i) { const v4f p4 = *(const GAS v4f*)(kp + 4 * i); v[16 + 4 * i] = p4.x; v[17 + 4 * i] = p4.y; v[18 + 4 * i] = p4.z; v[19 + 4 * i] = p4.w; }
        }
#pragma unroll
        for (int d = 0; d < 48; ++d) ss += v[d] * v[d];
        ss += shx(ss, F.lane, 1);
        const float r = rsqrtf(ss * (1.f / 96) + EPS);
#pragma unroll
        for (int d = 0; d < 48; ++d) v[d] = v[d] * r * gkn[hf * 48 + d];
        if (latent && hf) rope32_tab(v + 16, tl, tab);
#pragma unroll
        for (int i = 0; i < 6; ++i) st8(K + ((size_t)row * 16 + hd) * 96 + hf * 48 + 8 * i, v + 8 * i);
    }
}
__device__ __forceinline__ void rp_dwconv(Frame& F, const bf16* u, const float* wdw, const float* bdw, const float* gln, const float* bln, bf16* vout) {
    LAS float* red = (LAS float*)F.lds;
    const int c = 2 * F.tid;
    for (int it = F.vcu; it < T / 16; it += F.G) {
        const int row0 = 16 * it; int t0, L; row_pos(row0, t0, L);
        v2f w[31];
#pragma unroll
        for (int k = 0; k < 31; ++k) w[k] = *(const GAS v2f*)(wdw + k * 1024 + c);
        const v2f bb = *(const GAS v2f*)(bdw + c);
        float y0[16], y1[16];
#pragma unroll
        for (int r = 0; r < 16; ++r) { y0[r] = bb.x; y1[r] = bb.y; }
#pragma unroll
        for (int rr = 0; rr < 46; ++rr) {
            const int tt = t0 - 15 + rr; unsigned pk = 0u;
            if (tt >= 0 && tt < L) pk = *(const GAS unsigned*)(u + (size_t)(row0 - 15 + rr) * 1024 + c);
            const float u0 = bflo(pk), u1 = bfhi(pk);
#pragma unroll
            for (int k = 0; k < 31; ++k) { const int r = rr - k; if (r >= 0 && r < 16) { y0[r] += u0 * w[k].x; y1[r] += u1 * w[k].y; } }
        }
        float s[16];
#pragma unroll
        for (int r = 0; r < 16; ++r) s[r] = y0[r] + y1[r];
#pragma unroll
        for (int o = 1; o < 64; o <<= 1) {
#pragma unroll
            for (int r = 0; r < 16; ++r) s[r] += shx(s[r], F.lane, o); }
        __syncthreads();
        if (F.lane < 16) { float v = s[0];
#pragma unroll
            for (int r = 1; r < 16; ++r) v = F.lane == r ? s[r] : v;
            red[F.wave * 16 + F.lane] = v; }
        __syncthreads();
        float mean[16];
#pragma unroll
        for (int r = 0; r < 16; ++r) { float m = 0.f;
#pragma unroll
            for (int wv = 0; wv < 8; ++wv) m += red[wv * 16 + r];
            mean[r] = m * (1.f / 1024); }
#pragma unroll
        for (int r = 0; r < 16; ++r) { y0[r] -= mean[r]; y1[r] -= mean[r]; s[r] = y0[r] * y0[r] + y1[r] * y1[r]; }
#pragma unroll
        for (int o = 1; o < 64; o <<= 1) {
#pragma unroll
            for (int r = 0; r < 16; ++r) s[r] += shx(s[r], F.lane, o); }
        __syncthreads();
        if (F.lane < 16) { float v = s[0];
#pragma unroll
            for (int r = 1; r < 16; ++r) v = F.lane == r ? s[r] : v;
            red[F.wave * 16 + F.lane] = v; }
        __syncthreads();
        const v2f gg = *(const GAS v2f*)(gln + c), bl = *(const GAS v2f*)(bln + c);
#pragma unroll
        for (int r = 0; r < 16; ++r) { float q = 0.f;
#pragma unroll
            for (int wv = 0; wv < 8; ++wv) q += red[wv * 16 + r];
            const float rs = rsqrtf(q * (1.f / 1024) + EPS);
            const float z0 = y0[r] * rs * gg.x + bl.x, z1 = y1[r] * rs * gg.y + bl.y;
            *(GAS unsigned*)(vout + (size_t)(row0 + r) * 1024 + c) = pk2(z0 / (1.f + __expf(-z0)), z1 / (1.f + __expf(-z1))); }
    }
    __syncthreads();
}
__device__ __forceinline__ void rp_ssd_conv(Frame& F, const bf16* xpre, const float* dtraw, const float* wc, const float* bc, const float* dtb, const float* alog, bf16* xbc, float* dt, float* acum) {
    for (int idx = F.bx * NTHR + F.tid; idx < (T / 32) * 384; idx += F.G * NTHR) {
        const int seg = idx / 384, cg = idx - seg * 384, c0 = 8 * cg, row0 = 32 * seg; int t0, L; row_pos(row0, t0, L);
        float w[5][8], bias[8];
#pragma unroll
        for (int k = 0; k < 5; ++k) { const v4f a = *(const GAS v4f*)(wc + k * 3072 + c0), b2 = *(const GAS v4f*)(wc + k * 3072 + c0 + 4);
            w[k][0] = a.x; w[k][1] = a.y; w[k][2] = a.z; w[k][3] = a.w; w[k][4] = b2.x; w[k][5] = b2.y; w[k][6] = b2.z; w[k][7] = b2.w; }
        { const v4f a = *(const GAS v4f*)(bc + c0), b2 = *(const GAS v4f*)(bc + c0 + 4); bias[0] = a.x; bias[1] = a.y; bias[2] = a.z; bias[3] = a.w; bias[4] = b2.x; bias[5] = b2.y; bias[6] = b2.z; bias[7] = b2.w; }
        float win[5][8];
#pragma unroll
        for (int k = 0; k < 4; ++k) { const int tt = t0 + k - 2;
            if (tt >= 0 && tt < L) ld8(xpre + (size_t)(row0 + k - 2) * 3072 + c0, win[k + 1]);
            else {
#pragma unroll
                for (int i = 0; i < 8; ++i) win[k + 1][i] = 0.f; } }
#pragma unroll 4
        for (int r = 0; r < 32; ++r) {
#pragma unroll
            for (int k = 0; k < 4; ++k)
#pragma unroll
                for (int i = 0; i < 8; ++i) win[k][i] = win[k + 1][i];
            const int tt = t0 + r + 2;
            if (tt < L) ld8(xpre + (size_t)(row0 + r + 2) * 3072 + c0, win[4]);
            else {
#pragma unroll
                for (int i = 0; i < 8; ++i) win[4][i] = 0.f; }
            float a[8];
#pragma unroll
            for (int i = 0; i < 8; ++i) { float v = bias[i];
#pragma unroll
                for (int k = 0; k < 5; ++k) v += win[k][i] * w[k][i];
                a[i] = v / (1.f + __expf(-v)); }
            st8(xbc + (size_t)(row0 + r) * 3072 + c0, a);
        }
    }
    for (int it = F.gw; it < 64 * 64; it += F.NGW) {
        const int ch = it >> 6, e = it & 63, dir = e >> 5, row0 = 128 * ch, lane = F.lane;
        const float aa = -expf(alog[e]), bb = dtb[e];
        const int i0 = dir == 0 ? lane : 127 - lane, i1 = dir == 0 ? lane + 64 : 63 - lane;
        const float d0 = softplus_f(dtraw[(size_t)(row0 + i0) * 64 + e] + bb), d1 = softplus_f(dtraw[(size_t)(row0 + i1) * 64 + e] + bb);
        float s0 = d0 * aa, s1 = d1 * aa;
#pragma unroll
        for (int o = 1; o < 64; o <<= 1) { const float u0 = __builtin_bit_cast(float, __builtin_amdgcn_ds_bpermute((lane - o) << 2, __builtin_bit_cast(int, s0))), u1 = __builtin_bit_cast(float, __builtin_amdgcn_ds_bpermute((lane - o) << 2, __builtin_bit_cast(int, s1)));
            if (lane >= o) { s0 += u0; s1 += u1; } }
        s1 += __builtin_bit_cast(float, __builtin_amdgcn_readlane(__builtin_bit_cast(int, s0), 63));
        dt[(size_t)(row0 + i0) * 64 + e] = d0; dt[(size_t)(row0 + i1) * 64 + e] = d1;
        acum[(size_t)(row0 + i0) * 64 + e] = s0; acum[(size_t)(row0 + i1) * 64 + e] = s1;
    }
}
__device__ __forceinline__ void rp_ssd_gate(Frame& F, const float* y, const bf16* z, const float* gn, bf16* yn) {
    for (int row = F.gw; row < T; row += F.NGW) {
#pragma unroll
        for (int g = 0; g < 4; ++g) { const int c0 = g * 512 + 8 * F.lane; float zz[8], v[8]; ld8(z + (size_t)row * 2048 + c0, zz);
            const v4f y0 = *(const GAS v4f*)(y + (size_t)row * 2048 + c0), y1 = *(const GAS v4f*)(y + (size_t)row * 2048 + c0 + 4);
            v[0] = y0.x; v[1] = y0.y; v[2] = y0.z; v[3] = y0.w; v[4] = y1.x; v[5] = y1.y; v[6] = y1.z; v[7] = y1.w; float ss = 0.f;
#pragma unroll
            for (int i = 0; i < 8; ++i) { v[i] = v[i] * zz[i] / (1.f + __expf(-zz[i])); ss += v[i] * v[i]; }
            const float r = rsqrtf(wsum(ss, F.lane) * (1.f / 512) + EPS);
#pragma unroll
            for (int i = 0; i < 8; ++i) v[i] = v[i] * r * gn[c0 + i];
            st8(yn + (size_t)row * 2048 + c0, v); }
    }
}

typedef short a_bf16x8 __attribute__((ext_vector_type(8)));
typedef short a_s16x4 __attribute__((ext_vector_type(4)));
typedef float a_f32x16 __attribute__((ext_vector_type(16)));
typedef float a_f32x2 __attribute__((ext_vector_type(2))); typedef __bf16 a_bf16x2 __attribute__((ext_vector_type(2)));
__device__ __forceinline__ unsigned a_cvtpk(float lo, float hi) { a_f32x2 v = {lo, hi}; a_bf16x2 b = __builtin_convertvector(v, a_bf16x2); return __builtin_bit_cast(unsigned, b); }
__device__ __forceinline__ a_s16x4 a_vtr(const LAS unsigned char* p) { return __builtin_bit_cast(a_s16x4, __builtin_amdgcn_ds_read_tr16_b64_v4i16((LAS a_s16x4*)p)); }
constexpr int AT_KS = 208, AT_VS = 192, AT_KB = 64 * AT_KS, AT_VB = 64 * AT_VS, AT_VOFF = 2 * AT_KB;
__device__ __forceinline__ void at_tile(LAS unsigned char* lds, int buf, int lane, const a_bf16x8 (&qf)[6], a_f32x16& o0, a_f32x16& o1, float& m, float& l) {
    const int r32 = lane & 31, hi = lane >> 5;
    a_f32x16 p0, p1;
#pragma unroll
    for (int r = 0; r < 16; ++r) { p0[r] = 0.f; p1[r] = 0.f; }
    { const LAS unsigned char* kp = lds + buf * AT_KB + r32 * AT_KS + hi * 16;
#pragma unroll
      for (int s = 0; s < 6; ++s) { const a_bf16x8 a0 = *(const LAS a_bf16x8*)(kp + 32 * s), a1 = *(const LAS a_bf16x8*)(kp + 32 * AT_KS + 32 * s);
          p0 = __builtin_amdgcn_mfma_f32_32x32x16_bf16(a0, qf[s], p0, 0, 0, 0); p1 = __builtin_amdgcn_mfma_f32_32x32x16_bf16(a1, qf[s], p1, 0, 0, 0); } }
    float mx = fmaxf(p0[0], p1[0]);
#pragma unroll
    for (int r = 1; r < 16; ++r) mx = fmaxf(mx, fmaxf(p0[r], p1[r]));
    mx = fmaxf(mx, shx(mx, lane, 32));
    const float mn = fmaxf(m, mx), alpha = __builtin_amdgcn_exp2f(m - mn); m = mn;
    float ps = 0.f;
#pragma unroll
    for (int r = 0; r < 16; ++r) { p0[r] = __builtin_amdgcn_exp2f(p0[r] - mn); p1[r] = __builtin_amdgcn_exp2f(p1[r] - mn); ps += p0[r] + p1[r]; }
    l = l * alpha + ps;
#pragma unroll
    for (int r = 0; r < 16; ++r) { o0[r] *= alpha; o1[r] *= alpha; }
    v4u pw[4];
    pw[0] = (v4u){a_cvtpk(p0[0], p0[1]), a_cvtpk(p0[2], p0[3]), a_cvtpk(p0[4], p0[5]), a_cvtpk(p0[6], p0[7])};
    pw[1] = (v4u){a_cvtpk(p0[8], p0[9]), a_cvtpk(p0[10], p0[11]), a_cvtpk(p0[12], p0[13]), a_cvtpk(p0[14], p0[15])};
    pw[2] = (v4u){a_cvtpk(p1[0], p1[1]), a_cvtpk(p1[2], p1[3]), a_cvtpk(p1[4], p1[5]), a_cvtpk(p1[6], p1[7])};
    pw[3] = (v4u){a_cvtpk(p1[8], p1[9]), a_cvtpk(p1[10], p1[11]), a_cvtpk(p1[12], p1[13]), a_cvtpk(p1[14], p1[15])};
    const LAS unsigned char* vp0 = lds + AT_VOFF + buf * AT_VB + (4 * hi + ((lane & 15) >> 2)) * AT_VS + (16 * ((lane >> 4) & 1) + 4 * (lane & 3)) * 2;
#pragma unroll
    for (int bs = 0; bs < 4; ++bs) {
        const LAS unsigned char* vq = vp0 + (16 * bs) * AT_VS;
        const a_s16x4 l0 = a_vtr(vq), h0 = a_vtr(vq + 8 * AT_VS), l1 = a_vtr(vq + 64), h1 = a_vtr(vq + 8 * AT_VS + 64);
        const a_bf16x8 v0 = (a_bf16x8){l0[0], l0[1], l0[2], l0[3], h0[0], h0[1], h0[2], h0[3]}, v1 = (a_bf16x8){l1[0], l1[1], l1[2], l1[3], h1[0], h1[1], h1[2], h1[3]};
        const a_bf16x8 pb = __builtin_bit_cast(a_bf16x8, pw[bs]);
        o0 = __builtin_amdgcn_mfma_f32_32x32x16_bf16(v0, pb, o0, 0, 0, 0); o1 = __builtin_amdgcn_mfma_f32_32x32x16_bf16(v1, pb, o1, 0, 0, 0); }
}
__device__ __forceinline__ void ph_attn(Frame& F, const bf16* Q, const bf16* K, const bf16* KV, bf16* AO) {
    const int lane = F.lane, r32 = lane & 31, hi = lane >> 5, wave = F.wave, tid = F.tid;
    LAS unsigned char* lds = F.lds;
    const int kr_a = tid / 12, kp_a = tid % 12, kr_b = (tid + 512) / 12, kp_b = (tid + 512) % 12, vr = tid >> 3, vp = tid & 7;
    const bool has_b = tid < 256;
    for (int uu = F.vcu; uu < 512; uu += F.G) {
        int head, q0, NT, kbase_ctx, kbase_lat;
        if (uu < 256) { const int seq = uu >> 4; head = uu & 15; q0 = seq * 256; NT = 4; kbase_ctx = seq * 256; kbase_lat = 0; }
        else { const int u2 = uu - 256, b = u2 >> 6, qb = u2 & 3; head = (u2 >> 2) & 15; q0 = TP + b * 1024 + qb * 256; NT = 20; kbase_ctx = T + b * 256; kbase_lat = TP + b * 1024; }
        a_bf16x8 qf[6];
        { const bf16* qp = Q + ((size_t)(q0 + wave * 32 + r32) * 16 + head) * 96 + hi * 8;
#pragma unroll
          for (int s = 0; s < 6; ++s) qf[s] = *(const GAS a_bf16x8*)(qp + 16 * s); }
        a_f32x16 o0, o1;
#pragma unroll
        for (int r = 0; r < 16; ++r) { o0[r] = 0.f; o1[r] = 0.f; }
        float m = -INFINITY, l = 0.f;
        v4u ka0, kb0, vv0, ka1, kb1, vv1;
#define AT_LOAD(t, KA, KB2, VV) do { const int kr0_ = (t) < 4 ? kbase_ctx + 64 * (t) : kbase_lat + 64 * ((t) - 4); \
            KA = *(const GAS v4u*)(K + ((size_t)(kr0_ + kr_a) * 16 + head) * 96 + kp_a * 8); \
            if (has_b) KB2 = *(const GAS v4u*)(K + ((size_t)(kr0_ + kr_b) * 16 + head) * 96 + kp_b * 8); \
            VV = *(const GAS v4u*)(KV + (size_t)(kr0_ + vr) * 2048 + head * 128 + 64 + vp * 8); } while (0)
#define AT_STORE(buf, KA, KB2, VV) do { *(LAS v4u*)(lds + (buf) * AT_KB + kr_a * AT_KS + kp_a * 16) = KA; \
            if (has_b) *(LAS v4u*)(lds + (buf) * AT_KB + kr_b * AT_KS + kp_b * 16) = KB2; \
            *(LAS v4u*)(lds + AT_VOFF + (buf) * AT_VB + vr * AT_VS + vp * 16) = VV; } while (0)
        AT_LOAD(0, ka0, kb0, vv0); AT_LOAD(1, ka1, kb1, vv1);
        AT_STORE(0, ka0, kb0, vv0);
        LDS_BARRIER();
#pragma unroll 1
        for (int t = 0; t < NT; t += 2) {
            if (t + 2 < NT) AT_LOAD(t + 2, ka0, kb0, vv0);
            at_tile(lds, 0, lane, qf, o0, o1, m, l);
            AT_STORE(1, ka1, kb1, vv1);
            LDS_BARRIER();
            if (t + 3 < NT) AT_LOAD(t + 3, ka1, kb1, vv1);
            at_tile(lds, 1, lane, qf, o0, o1, m, l);
            if (t + 2 < NT) AT_STORE(0, ka0, kb0, vv0);
            LDS_BARRIER();
        }
#undef AT_LOAD
#undef AT_STORE
        l += shx(l, lane, 32);
        const float il = 1.f / l;
        bf16* op = AO + (size_t)(q0 + wave * 32 + r32) * 1024 + head * 64 + 4 * hi;
#pragma unroll
        for (int g4 = 0; g4 < 4; ++g4) {
            v2u w0; w0.x = a_cvtpk(o0[4 * g4] * il, o0[4 * g4 + 1] * il); w0.y = a_cvtpk(o0[4 * g4 + 2] * il, o0[4 * g4 + 3] * il); *(GAS v2u*)(op + 8 * g4) = w0;
            v2u w1; w1.x = a_cvtpk(o1[4 * g4] * il, o1[4 * g4 + 1] * il); w1.y = a_cvtpk(o1[4 * g4 + 2] * il, o1[4 * g4 + 3] * il); *(GAS v2u*)(op + 32 + 8 * g4) = w1; }
    }
}
constexpr int SC_ST = 272, SC_XS = 144;
constexpr int SC_C = 0, SC_B = 128 * SC_ST, SC_M = 2 * 128 * SC_ST, SC_H = 3 * 128 * SC_ST, SC_X = SC_H + 64 * SC_ST, SC_XW = SC_X + 128 * SC_XS, SC_ARR = SC_XW + 128 * SC_XS;
static_assert(SC_ARR + 4 * 128 * 4 + 16 <= PTAB_OFF_C, "scan LDS map");
__device__ __forceinline__ int a_crow(int r, int hi) { return (r & 3) + 8 * (r >> 2) + 4 * hi; }
__device__ __forceinline__ void ph_scan(Frame& F, const bf16* xbc, const float* dt, const float* acg, const float* dsk, const float* st0, float* y, float* out) {
    const int lane = F.lane, r32 = lane & 31, hi = lane >> 5, wave = F.wave, tid = F.tid;
    LAS unsigned char* lds = F.lds;
    LAS float* acum = (LAS float*)(lds + SC_ARR); LAS float* wj = acum + 128; LAS float* ei = acum + 256; LAS float* dtj = acum + 384; LAS float* misc = acum + 512;
    const int q4 = (lane & 15) >> 2, gg = (lane >> 4) & 1, p4 = lane & 3;
    const int ib = wave >> 1, pb = wave & 1, nb = wave >> 1;
    for (int slot = F.vcu; slot < 256; slot += F.G) {
        const int nitem = slot < 128 ? 1 : 4;
#pragma unroll 1
        for (int ii = 0; ii < nitem; ++ii) {
            int seq, hd;
            if (slot < 128) { seq = 16 + (slot >> 5); hd = slot & 31; } else { const int pi = 4 * (slot - 128) + ii; seq = pi >> 5; hd = pi & 31; }
            const int g = hd >> 3, r0 = seq < 16 ? seq * 256 : TP + (seq - 16) * 1024, nc = seq < 16 ? 2 : 8;
#pragma unroll 1
            for (int dir = 0; dir < 2; ++dir) {
                const float dd = dsk[dir * 32 + hd];
                a_f32x16 hacc;
                if (seq < 16) {
#pragma unroll
                    for (int r = 0; r < 16; ++r) hacc[r] = 0.f;
                } else { const float* s0 = st0 + ((((size_t)(seq - 16) * 2 + dir) * 32 + hd) * 64 + 32 * pb + r32) * 128 + 32 * nb + 4 * hi;
#pragma unroll
                    for (int g4 = 0; g4 < 4; ++g4) { const v4f t4 = *(const GAS v4f*)(s0 + 8 * g4); hacc[4 * g4] = t4.x; hacc[4 * g4 + 1] = t4.y; hacc[4 * g4 + 2] = t4.z; hacc[4 * g4 + 3] = t4.w; } }
#pragma unroll
                for (int g4 = 0; g4 < 4; ++g4) { v2u w; w.x = a_cvtpk(hacc[4 * g4], hacc[4 * g4 + 1]); w.y = a_cvtpk(hacc[4 * g4 + 2], hacc[4 * g4 + 3]);
                    *(LAS v2u*)(lds + SC_H + (32 * pb + r32) * SC_ST + (32 * nb + 8 * g4 + 4 * hi) * 2) = w; }
                v4u cr[4], br[4], xr[2];
#define SC_GLOAD(c_) do { const int row0_ = r0 + (c_) * 128; \
                    _Pragma("unroll") for (int k = 0; k < 4; ++k) { const int q = tid + 512 * k, rr = q >> 4, pp = q & 15; \
                        cr[k] = *(const GAS v4u*)(xbc + (size_t)(row0_ + rr) * 3072 + 2560 + g * 128 + pp * 8); br[k] = *(const GAS v4u*)(xbc + (size_t)(row0_ + rr) * 3072 + 2048 + g * 128 + pp * 8); } \
                    _Pragma("unroll") for (int k = 0; k < 2; ++k) { const int q = tid + 512 * k, rr = q >> 3, pp = q & 7; xr[k] = *(const GAS v4u*)(xbc + (size_t)(row0_ + rr) * 3072 + hd * 64 + pp * 8); } } while (0)
                SC_GLOAD(dir == 0 ? 0 : nc - 1);
#pragma unroll 1
                for (int cc = 0; cc < nc; ++cc) {
                    const int c = dir == 0 ? cc : nc - 1 - cc, row0 = r0 + c * 128;
                    const int e = dir * 32 + hd;
                    const float last = acg[(size_t)(row0 + (dir == 0 ? 127 : 0)) * 64 + e];
                    LDS_BARRIER();
                    if (tid < 128) { const float ac = acg[(size_t)(row0 + tid) * 64 + e], dv = dt[(size_t)(row0 + tid) * 64 + e];
                        acum[tid] = ac; dtj[tid] = dv; ei[tid] = __expf(ac); if (tid == 0) misc[0] = __expf(last); }
#pragma unroll
                    for (int k = 0; k < 4; ++k) { const int q = tid + 512 * k, rr = q >> 4, pp = q & 15; *(LAS v4u*)(lds + SC_C + rr * SC_ST + pp * 16) = cr[k]; *(LAS v4u*)(lds + SC_B + rr * SC_ST + pp * 16) = br[k]; }
#pragma unroll
                    for (int k = 0; k < 2; ++k) { const int q = tid + 512 * k, rr = q >> 3, pp = q & 7; *(LAS v4u*)(lds + SC_X + rr * SC_XS + pp * 16) = xr[k];
                        const float w = dt[(size_t)(row0 + rr) * 64 + e] * __expf(last - acg[(size_t)(row0 + rr) * 64 + e]);
                        v4u s; s.x = a_cvtpk(bflo(xr[k].x) * w, bfhi(xr[k].x) * w); s.y = a_cvtpk(bflo(xr[k].y) * w, bfhi(xr[k].y) * w); s.z = a_cvtpk(bflo(xr[k].z) * w, bfhi(xr[k].z) * w); s.w = a_cvtpk(bflo(xr[k].w) * w, bfhi(xr[k].w) * w);
                        *(LAS v4u*)(lds + SC_XW + rr * SC_XS + pp * 16) = s; }
                    if (cc + 1 < nc) SC_GLOAD(dir == 0 ? cc + 1 : nc - 2 - cc);
                    LDS_BARRIER();
#pragma unroll 1
                    for (int tt = 0; tt < 2; ++tt) {
                        const int tl = 2 * wave + tt, jb = tl >> 2, ibg = tl & 3;
                        const bool dead = dir == 0 ? jb > ibg : jb < ibg;
                        a_f32x16 gt;
#pragma unroll
                        for (int r = 0; r < 16; ++r) gt[r] = 0.f;
                        if (!dead) {
                            const LAS unsigned char* ap = lds + SC_B + (32 * jb + r32) * SC_ST + hi * 16; const LAS unsigned char* bp = lds + SC_C + (32 * ibg + r32) * SC_ST + hi * 16;
#pragma unroll
                            for (int s = 0; s < 8; ++s) gt = __builtin_amdgcn_mfma_f32_32x32x16_bf16(*(const LAS a_bf16x8*)(ap + 32 * s), *(const LAS a_bf16x8*)(bp + 32 * s), gt, 0, 0, 0);
                            const int i = 32 * ibg + r32; const float ai = acum[i];
#pragma unroll
                            for (int r = 0; r < 16; ++r) { const int j = 32 * jb + a_crow(r, hi); const bool keep = dir == 0 ? j <= i : j >= i;
                                const float e = __builtin_amdgcn_exp2f(fminf(ai - acum[j], 0.f) * 1.4426950408889634f) * dtj[j];
                                gt[r] = keep ? gt[r] * e + (j == i ? dd : 0.f) : 0.f; }
                        }
#pragma unroll
                        for (int g4 = 0; g4 < 4; ++g4) { v2u w; w.x = a_cvtpk(gt[4 * g4], gt[4 * g4 + 1]); w.y = a_cvtpk(gt[4 * g4 + 2], gt[4 * g4 + 3]);
                            *(LAS v2u*)(lds + SC_M + (32 * ibg + r32) * SC_ST + (32 * jb + 8 * g4 + 4 * hi) * 2) = w; }
                    }
                    a_f32x16 yo;
#pragma unroll
                    for (int r = 0; r < 16; ++r) yo[r] = 0.f;
                    { const LAS unsigned char* ap = lds + SC_C + (32 * ib + r32) * SC_ST + hi * 16; const LAS unsigned char* bp = lds + SC_H + (32 * pb + r32) * SC_ST + hi * 16;
#pragma unroll
                      for (int s = 0; s < 8; ++s) yo = __builtin_amdgcn_mfma_f32_32x32x16_bf16(*(const LAS a_bf16x8*)(ap + 32 * s), *(const LAS a_bf16x8*)(bp + 32 * s), yo, 0, 0, 0); }
                    LDS_BARRIER();
                    a_f32x16 yd;
#pragma unroll
                    for (int r = 0; r < 16; ++r) yd[r] = 0.f;
                    { const LAS unsigned char* ap = lds + SC_M + (32 * ib + r32) * SC_ST + hi * 16; const LAS unsigned char* xp = lds + SC_X + (8 * hi + q4) * SC_XS + (32 * pb + 16 * gg + 4 * p4) * 2;
#pragma unroll
                      for (int s = 0; s < 8; ++s) { const a_s16x4 l0 = a_vtr(xp + (16 * s) * SC_XS), h0 = a_vtr(xp + (16 * s + 4) * SC_XS);
                          const a_bf16x8 xb = (a_bf16x8){l0[0], l0[1], l0[2], l0[3], h0[0], h0[1], h0[2], h0[3]};
                          yd = __builtin_amdgcn_mfma_f32_32x32x16_bf16(*(const LAS a_bf16x8*)(ap + 32 * s), xb, yd, 0, 0, 0); } }
                    { float* yp = y + (size_t)(row0 + 32 * ib) * 2048 + hd * 64 + 32 * pb + r32;
#pragma unroll
                      for (int r = 0; r < 16; ++r) { const int i = a_crow(r, hi); const float v = yd[r] + ei[32 * ib + i] * yo[r]; float* p = yp + (size_t)i * 2048; *p = dir == 0 ? v : *p + v; } }
                    { const float dec = misc[0];
#pragma unroll
                      for (int r = 0; r < 16; ++r) hacc[r] *= dec;
                      const LAS unsigned char* bq = lds + SC_B + (8 * hi + q4) * SC_ST + (32 * nb + 16 * gg + 4 * p4) * 2; const LAS unsigned char* xq = lds + SC_XW + (8 * hi + q4) * SC_XS + (32 * pb + 16 * gg + 4 * p4) * 2;
#pragma unroll
                      for (int s = 0; s < 8; ++s) { const a_s16x4 bl = a_vtr(bq + (16 * s) * SC_ST), bh = a_vtr(bq + (16 * s + 4) * SC_ST), xl = a_vtr(xq + (16 * s) * SC_XS), xh = a_vtr(xq + (16 * s + 4) * SC_XS);
                          const a_bf16x8 av = (a_bf16x8){bl[0], bl[1], bl[2], bl[3], bh[0], bh[1], bh[2], bh[3]}, bv = (a_bf16x8){xl[0], xl[1], xl[2], xl[3], xh[0], xh[1], xh[2], xh[3]};
                          hacc = __builtin_amdgcn_mfma_f32_32x32x16_bf16(av, bv, hacc, 0, 0, 0); } }
#pragma unroll
                    for (int g4 = 0; g4 < 4; ++g4) { v2u w; w.x = a_cvtpk(hacc[4 * g4], hacc[4 * g4 + 1]); w.y = a_cvtpk(hacc[4 * g4 + 2], hacc[4 * g4 + 3]);
                        *(LAS v2u*)(lds + SC_H + (32 * pb + r32) * SC_ST + (32 * nb + 8 * g4 + 4 * hi) * 2) = w; }
                }
                if (seq < 16) { float* o = out + OUT_SSM + ((((size_t)seq * 2 + dir) * 32 + hd) * 64 + 32 * pb + r32) * 128 + 32 * nb + 4 * hi;
#pragma unroll
                    for (int g4 = 0; g4 < 4; ++g4) { v4f t4; t4.x = hacc[4 * g4]; t4.y = hacc[4 * g4 + 1]; t4.z = hacc[4 * g4 + 2]; t4.w = hacc[4 * g4 + 3]; *(GAS v4f*)(o + 8 * g4) = t4; } }
            }
        }
    }
#undef SC_GLOAD
    LDS_BARRIER();
}

constexpr int NPHASE = 30;
enum Op { OP_P0, OP_NORM1, OP_G_LAT, OP_FIN1, OP_G_QKV, OP_FIN2, OP_ATTN, OP_G_WO, OP_NORM2, OP_G_FF1, OP_G_FF2, OP_G_PW1, OP_DWCONV, OP_G_PW2, OP_G_SSI, OP_SSCONV, OP_SCAN, OP_GATE, OP_G_SSO };
__device__ __forceinline__ void phase_decode(int ph, int& layer, int& op) {
    if (ph == 0) { layer = 0; op = OP_P0; return; }
    if (ph <= 9) { layer = 0; const int r = ph - 1; op = r == 0 ? OP_NORM1 : r == 1 ? OP_G_LAT : r == 2 ? OP_FIN1 : r == 3 ? OP_G_QKV : r == 4 ? OP_FIN2 : r == 5 ? OP_ATTN : r == 6 ? OP_G_WO : r == 7 ? OP_G_FF1 : OP_G_FF2; }
    else if (ph <= 14) { layer = 1; const int r = ph - 10; op = r == 0 ? OP_G_PW1 : r == 1 ? OP_DWCONV : r == 2 ? OP_G_PW2 : r == 3 ? OP_G_FF1 : OP_G_FF2; }
    else if (ph <= 21) { layer = 2; const int r = ph - 15; op = r == 0 ? OP_G_SSI : r == 1 ? OP_SSCONV : r == 2 ? OP_SCAN : r == 3 ? OP_GATE : r == 4 ? OP_G_SSO : r == 5 ? OP_G_FF1 : OP_G_FF2; }
    else { layer = 3; const int r = ph - 22; op = r == 0 ? OP_G_LAT : r == 1 ? OP_FIN1 : r == 2 ? OP_G_QKV : r == 3 ? OP_FIN2 : r == 4 ? OP_ATTN : r == 5 ? OP_G_WO : r == 6 ? OP_G_FF1 : OP_G_FF2; }
}
#ifndef MK_REPEAT_MASK
#define MK_REPEAT_MASK 0u
#endif
#ifndef MK_DOUBLE_BAR
#define MK_DOUBLE_BAR 0
#endif
struct MArgs { const float* in[38]; float* out; unsigned char* ws; int ph_lo, ph_hi; };
constexpr int PTAB_OFF = PTAB_OFF_C;
__global__ void __launch_bounds__(NTHR, 2) mega_fwd(MArgs args) {
    extern __shared__ __attribute__((aligned(16))) unsigned char lds_raw[];
    LAS unsigned char* lds = (LAS unsigned char*)lds_raw;
    volatile LAS unsigned* PT0 = (volatile LAS unsigned*)(lds + PTAB_OFF);
    volatile LAS unsigned* MISC = (volatile LAS unsigned*)(lds + MISC_OFF);
    { const int t0 = threadIdx.x;
      if (t0 < 40) { const unsigned long long p = t0 < 38 ? (unsigned long long)args.in[t0] : t0 == 38 ? (unsigned long long)args.out : (unsigned long long)args.ws;
          PT0[2 * t0] = (unsigned)p; PT0[2 * t0 + 1] = (unsigned)(p >> 32); }
      if (t0 < 64) MISC[t0] = 0u; }
    __syncthreads();
    XcdBarrier bar = xcd_barrier_post((unsigned*)((unsigned char*)ldp(PT0, PT_WS) + WS_CTL) + CW_BAR, MISC + 8);
    const int wave0 = __builtin_amdgcn_readfirstlane(threadIdx.x >> 6);
    const int ph_hi = args.ph_hi; bool redo_ = false;
    for (int ph = args.ph_lo; ph < ph_hi; ++ph) {
        Frame F;
        { int w = wave0; asm volatile("" : "+s"(w)); F.wave = w; }
        F.lds = lds; F.lane = olane(); F.tid = F.wave * 64 + F.lane;
        const int bx = obid();
        F.G = gridDim.x; F.vcu = (F.G % 8 == 0) ? (bx % 8) * (F.G / 8) + bx / 8 : bx;
        F.gw = F.vcu * NWAVES + F.wave; F.NGW = F.G * NWAVES; F.PT = PT0; F.bx = bx;
        int layer, op; phase_decode(ph, layer, op);
        const int j = layer / 3;
        switch (op) {
        case OP_P0: p0_prologue(F); break;
        case OP_NORM1: { unsigned char* ws = WSP; float* x = OUTP; const float* xlo = layer == 0 ? INP(I_XP) : x; const float* xhi = layer == 0 ? INP(I_XS) - (size_t)TP * 1024 : x;
            rp_normmod(F, xlo, xhi, INP(I_GN1) + layer * 1024, (const float*)(ws + WS_MODS) + (size_t)layer * 5 * 6144, 0, 1024, (bf16*)(ws + WS_H)); rp_tables(F); } break;
        case OP_NORM2: { unsigned char* ws = WSP; float* x = OUTP;
            rp_normmod(F, x, x, INP(I_GN2) + layer * 1024, (const float*)(ws + WS_MODS) + (size_t)layer * 5 * 6144, 3072, 4096, (bf16*)(ws + WS_H)); } break;
        case OP_G_LAT: { unsigned char* ws = WSP; pg8::Gemm g{(const bf16*)(ws + WS_H), (const bf16*)(ws + W_MLA + j * MLA_WB + MW_CAT), T, 768, 1024}; pg8::StaticOrder S; S.init(T, 2 * 768, F.G, F.bx);
            const int s_ = 2 * layer; pg8::EpiF32<1> E{(float*)(ws + A_LAT), 768, layer == 0 ? nullptr : (const float*)(ws + WS_STAT) + s_ * 8192, layer == 0 ? nullptr : (const float*)(ws + WS_SW) + (size_t)s_ * 5 * 5632}; pg8::gemm_phase<pg8::EpiF32<1>, pg8::StaticOrder, true, true, true>(F.lds, g, S, E, F.wave); } break;
        case OP_FIN1: { unsigned char* ws = WSP; rp_mla_fin1(F, (const float*)(ws + A_LAT), INP(I_GQ) + j * 384, INP(I_GKV) + j * 256, (bf16*)(ws + A_QN), (bf16*)(ws + WS_CKV + j * CKV_B), OUTP, j); } break;
        case OP_G_QKV: {
#pragma unroll 1
            for (int w = 0; w < 2; ++w) {
                unsigned char* ws = WSP; unsigned char* wm = ws + W_MLA + j * MLA_WB;
                pg8::Gemm g = w == 0 ? pg8::Gemm{(const bf16*)(ws + A_QN), (const bf16*)(wm + MW_UQ), T, 1536, 384} : pg8::Gemm{(const bf16*)(ws + WS_CKV + j * CKV_B), (const bf16*)(wm + MW_UKV), T + NCTX, 2048, 256};
                pg8::StaticOrder S; S.init(g.M, g.N, F.G, w == 0 ? F.bx : (int)((F.bx + 64) % F.G));
                pg8::EpiBf16P E{w == 0 ? (bf16*)(ws + A_QRAW) : (bf16*)(ws + A_KVRAW), g.N};
                pg8::gemm_phase<pg8::EpiBf16P, pg8::StaticOrder, true, true>(F.lds, g, S, E, F.wave);
            } } break;
        case OP_FIN2: { unsigned char* ws = WSP; rp_mla_fin2(F, (const bf16*)(ws + A_QRAW), (const bf16*)(ws + A_KVRAW), (const float*)(ws + A_LAT), INP(I_CKPE) + (size_t)j * 8192, INP(I_GQN) + j * 96, INP(I_GKN) + j * 96,
                                                        (const float*)(ws + WS_ROPE), (bf16*)(ws + A_QB), (bf16*)(ws + A_KB)); } break;
        case OP_ATTN: { unsigned char* ws = WSP; ph_attn(F, (const bf16*)(ws + A_QB), (const bf16*)(ws + A_KB), (const bf16*)(ws + A_KVRAW), (bf16*)(ws + A_AO)); } break;
        case OP_G_WO: case OP_G_PW2: case OP_G_SSO: case OP_G_FF2: {
            unsigned char* ws = WSP; float* x = OUTP;
            const float* rlo = (layer == 0 && op != OP_G_FF2) ? INP(I_XP) : x; const float* rhi = (layer == 0 && op != OP_G_FF2) ? INP(I_XS) - (size_t)TP * 1024 : x;
            pg8::Gemm g; const float* bias = nullptr; int goff = 2048;
            if (op == OP_G_WO) g = pg8::Gemm{(const bf16*)(ws + A_AO), (const bf16*)(ws + W_MLA + j * MLA_WB + MW_O), T, 1024, 1024};
            else if (op == OP_G_PW2) { g = pg8::Gemm{(const bf16*)(ws + A_V), (const bf16*)(ws + W_CV2), T, 1024, 1024}; bias = INP(I_CVB2); }
            else if (op == OP_G_SSO) g = pg8::Gemm{(const bf16*)(ws + A_YN), (const bf16*)(ws + W_SSO), T, 1024, 2048};
            else { g = pg8::Gemm{(const bf16*)(ws + A_ACT), (const bf16*)(ws + W_FF + layer * FF_WB + FW_OUT), T, 1024, 2816}; goff = 5120; }
            pg8::StaticOrder S; S.init(T, 2 * 1024, F.G, F.bx);
            float* xdst = x;
            if (MK_REPEAT_MASK != 0u && !redo_ && ((MK_REPEAT_MASK >> op) & 1u)) xdst = (float*)(ws + WS_AR + 160 * MiB);
            const int sn_ = 2 * layer + (op == OP_G_FF2 ? 2 : 1);
            pg8::EpiResid<1> E{rlo, rhi, xdst, (const float*)(ws + WS_MODS) + (size_t)layer * 5 * 6144, goff, bias,
                               sn_ < 8 ? (bf16*)(ws + WS_H) : nullptr, (const float*)(ws + WS_GT) + (size_t)(sn_ & 7) * 5 * 1024, (float*)(ws + WS_STAT) + (sn_ & 7) * 8192};
            pg8::gemm_phase<pg8::EpiResid<1>, pg8::StaticOrder, true, true, true>(F.lds, g, S, E, F.wave); } break;
        case OP_G_FF1: { unsigned char* ws = WSP; pg8::Gemm g{(const bf16*)(ws + WS_H), (const bf16*)(ws + W_FF + layer * FF_WB + FW_IN), T, 5632, 1024}; pg8::StaticOrder S; S.init(T, 5632, F.G, F.bx);
            const int s_ = 2 * layer + 1; pg8::EpiGlu<0> E{(bf16*)(ws + A_ACT), 2816, nullptr, 2816, (const float*)(ws + WS_STAT) + s_ * 8192, (const float*)(ws + WS_SW) + (size_t)s_ * 5 * 5632}; pg8::gemm_phase<pg8::EpiGlu<0>, pg8::StaticOrder, true, true>(F.lds, g, S, E, F.wave); } break;
        case OP_G_PW1: { unsigned char* ws = WSP; pg8::Gemm g{(const bf16*)(ws + WS_H), (const bf16*)(ws + W_CV1), T, 2048, 1024}; pg8::StaticOrder S; S.init(T, 2048, F.G, F.bx);
            const int s_ = 2 * layer; pg8::EpiGlu<1> E{(bf16*)(ws + A_U), 1024, INP(I_CVB1), 1024, (const float*)(ws + WS_STAT) + s_ * 8192, (const float*)(ws + WS_SW) + (size_t)s_ * 5 * 5632}; pg8::gemm_phase<pg8::EpiGlu<1>, pg8::StaticOrder, true, true>(F.lds, g, S, E, F.wave); } break;
        case OP_DWCONV: { unsigned char* ws = WSP; rp_dwconv(F, (const bf16*)(ws + A_U), INP(I_CVWD), INP(I_CVBD), INP(I_CVGL), INP(I_CVBL), (bf16*)(ws + A_V)); } break;
        case OP_G_SSI: { unsigned char* ws = WSP; pg8::Gemm g{(const bf16*)(ws + WS_H), (const bf16*)(ws + W_SSI), T, 5376, 1024}; pg8::StaticOrder S; S.init(T, 5376, F.G, F.bx);
            const int s_ = 2 * layer; pg8::EpiSsdIn E{(bf16*)(ws + A_Z), (bf16*)(ws + A_XPRE), (float*)(ws + A_DTRAW), (const float*)(ws + WS_STAT) + s_ * 8192, (const float*)(ws + WS_SW) + (size_t)s_ * 5 * 5632}; pg8::gemm_phase<pg8::EpiSsdIn, pg8::StaticOrder, true, true>(F.lds, g, S, E, F.wave); } break;
        case OP_SSCONV: { unsigned char* ws = WSP; rp_ssd_conv(F, (const bf16*)(ws + A_XPRE), (const float*)(ws + A_DTRAW), INP(I_SSWC), INP(I_SSBC), INP(I_SSDTB), INP(I_SSAL), (bf16*)(ws + A_XBC), (float*)(ws + A_DT), (float*)(ws + A_ACUM)); } break;
        case OP_SCAN: { unsigned char* ws = WSP; ph_scan(F, (const bf16*)(ws + A_XBC), (const float*)(ws + A_DT), (const float*)(ws + A_ACUM), INP(I_SSD), INP(I_SSM), (float*)(ws + A_Y), OUTP); } break;
        case OP_GATE: { unsigned char* ws = WSP; rp_ssd_gate(F, (const float*)(ws + A_Y), (const bf16*)(ws + A_Z), INP(I_SSGN), (bf16*)(ws + A_YN)); } break;
        default: break;
        }
        if (MK_REPEAT_MASK != 0u) { if (!redo_ && ((MK_REPEAT_MASK >> op) & 1u)) { redo_ = true; xcd_barrier(bar); --ph; continue; } redo_ = false; }
        if (ph + 1 < ph_hi) { xcd_barrier(bar); if (MK_DOUBLE_BAR) xcd_barrier(bar); }
    }
}

#ifndef MK_PHASES
#define MK_PHASES 30
#endif
#ifndef MK_PER_PHASE
#define MK_PER_PHASE 0
#endif
static int sub_after_phases(int p) { return p >= 30 ? 8 : 0; }
extern "C" void kernel_launch(void* const* d_in, const int* in_sizes, int n_in, void* d_out, int out_size, void* d_ws, size_t ws_size, hipStream_t stream) {
    static int grid = 0;
    if (grid == 0) {
        int dev = 0, cus = 0;
        if (hipGetDevice(&dev) != hipSuccess || hipDeviceGetAttribute(&cus, hipDeviceAttributeMultiprocessorCount, dev) != hipSuccess) { fprintf(stderr, "kernel_launch: device query failed\n"); grid = -1; return; }
        if (hipFuncSetAttribute((const void*)mega_fwd, hipFuncAttributeMaxDynamicSharedMemorySize, LDS_BYTES) != hipSuccess) { fprintf(stderr, "kernel_launch: hipFuncSetAttribute failed\n"); grid = -1; return; }
        (void)hipGetLastError();
        grid = cus;
    }
    if (grid < 0) return;
    In I; const float** p = (const float**)&I;
    for (int i = 0; i < 38; ++i) p[i] = (const float*)d_in[i];
    (void)hipMemsetAsync((char*)d_ws + WS_CTL, 0, CTL_ZERO_BYTES, stream);
    MArgs a{};
    for (int i = 0; i < 38; ++i) a.in[i] = (const float*)d_in[i];
    a.out = (float*)d_out; a.ws = (unsigned char*)d_ws;
    const int nph = MK_PHASES;
    if (MK_PER_PHASE) { for (int ph = 0; ph < nph; ++ph) { a.ph_lo = ph; a.ph_hi = ph + 1; hipLaunchKernelGGL(mega_fwd, dim3(grid), dim3(NTHR), LDS_BYTES, stream, a); } }
    else { a.ph_lo = 0; a.ph_hi = nph; hipLaunchKernelGGL(mega_fwd, dim3(grid), dim3(NTHR), LDS_BYTES, stream, a); }
    const int sub = sub_after_phases(nph);
    if (sub < 8) naive_forward(I, (float*)d_out, (float*)d_ws, stream, sub);
}
```

```cpp
#include <hip/hip_runtime.h>
#include <cstdint>
#include <cstdio>

constexpr int DM = 1024, T = 8192, TP = 4096;
constexpr int NCTX = 1024;
constexpr int QL = 384, KVL = 256, ROPE = 32, NOPE = 64, QKD = 96, VH = 64, NH = 16;
constexpr int FFH = 2816;
constexpr int SSI = 2048, SSH = 32, SSP = 64, SSN = 128, SSG = 4, SSCD = 3072, SSIN = 5184;
constexpr float EPS = 1e-6f;
constexpr size_t OUT_YP = 0, OUT_CKV = 8388608, OUT_KPE = 10485760, OUT_SSM = 10747904;

__device__ __forceinline__ int cond_of_row(int r) { return r < TP ? 0 : 1 + ((r - TP) >> 10); }
__device__ __forceinline__ void row_pos(int r, int& t, int& L) { if (r < TP) { t = r & 255; L = 256; } else { t = (r - TP) & 1023; L = 1024; } }
__device__ __forceinline__ float softplus_f(float x) { return fmaxf(x, 0.f) + log1pf(expf(-fabsf(x))); }

__device__ __forceinline__ float rope_inv(int i) { return i == 0 ? 1.f : i == 1 ? 0.31622776601683794f : i == 2 ? 0.1f : i == 3 ? 0.031622776601683794f : i == 4 ? 0.01f : i == 5 ? 0.0031622776601683794f : i == 6 ? 0.001f : 0.00031622776601683794f; }

__device__ __forceinline__ int olane() { int l; asm volatile("v_mbcnt_lo_u32_b32 %0, -1, 0\n\tv_mbcnt_hi_u32_b32 %0, -1, %0" : "=v"(l)); return l; }
__device__ __forceinline__ int obid() { int b = blockIdx.x; asm volatile("" : "+s"(b)); return b; }
namespace pg8 {
#define PG8_LAS __attribute__((address_space(3)))
typedef unsigned short bf16_t;
typedef short bf16x8 __attribute__((ext_vector_type(8)));
typedef float f32x4 __attribute__((ext_vector_type(4)));
typedef unsigned u32x4 __attribute__((ext_vector_type(4)));
constexpr int BM = 256, BK = 64, HALF = 128, HTB = HALF * BK * 2  , STAGE_BYTES = 8 * HTB, NXCD = 8, WGM = 8;

__host__ __device__ __forceinline__ int lds_byte(int r, int c) { const int st = (r >> 4) * 2 + (c >> 5), rr = r & 15, cc = c & 31, ob = rr * 64 + cc * 2; return st * 1024 + (ob ^ (((ob >> 9) & 1) << 5)); }
__host__ __device__ __forceinline__ void stage_rc(int b, int& R, int& C) { const int st = b / 1024, sb = b % 1024, swz = sb ^ (((sb >> 9) & 1) << 5); R = (st >> 1) * 16 + swz / 64; C = (st & 1) * 32 + (swz % 64) / 2; }
__host__ __device__ __forceinline__ int perm32(int rho) { const int n = rho >> 4, i = rho & 15; return 8 * (i >> 2) + 4 * n + (i & 3); }

struct Unit { int pm, pn; };
struct Gemm { const bf16_t* A; const bf16_t* Bt; int M, N, K; };

struct StaticOrder {
    int nM, nN, nwg, G, c;
    __host__ __device__ void init(int M, int N, int G_, int c_) { nM = M / BM; nN = N / BM; nwg = nM * nN; G = G_; c = c_; }
    __host__ __device__ bool next(int i, Unit& u) const {
        const long L = (long)i * G + c; if (L >= nwg) return false;
        int wgid = (int)L; { const int q = nwg / NXCD, r = nwg % NXCD, xcd = wgid % NXCD, off = wgid / NXCD; wgid = (xcd < r ? xcd * (q + 1) : r * (q + 1) + (xcd - r) * q) + off; }
        const int nig = WGM * nN, gid = wgid / nig, fm = gid * WGM, gsz = (nM - fm) < WGM ? (nM - fm) : WGM;
        u.pm = fm + ((wgid % nig) % gsz); u.pn = (wgid % nig) / gsz; return true;
    }
    __device__ __forceinline__ void a_ready(const Unit&) const {}
    __device__ __forceinline__ void done(const Unit&) const {}
};
__device__ __forceinline__ unsigned cvt_pk_bf16(float lo, float hi) { unsigned r; asm volatile("v_cvt_pk_bf16_f32 %0, %1, %2" : "=v"(r) : "v"(lo), "v"(hi)); return r; }
typedef unsigned u32x2 __attribute__((ext_vector_type(2)));
__device__ __forceinline__ void st16(void* p, u32x4 v) { *(u32x4*)p = v; }
__device__ __forceinline__ void st16f(void* p, f32x4 v) { *(f32x4*)p = v; }
__device__ __forceinline__ void st8(void* p, u32x2 v) { *(u32x2*)p = v; }
__device__ __forceinline__ float fast_sigmoid(float x) { return __builtin_amdgcn_rcpf(1.f + __builtin_amdgcn_exp2f(-1.4426950408889634f * x)); }

constexpr int SW_LD = 5632;
__device__ __forceinline__ int cond_of_pm(int pm) { return pm < 16 ? 0 : 1 + ((pm - 16) >> 2); }
template <int NBJ> struct EpiF32 {
    static constexpr bool PERM = false, AFTER_DRAIN = false;
    float* C; int ldc; const float* rstat; const float* sw;
    __device__ __forceinline__ void operator()(const f32x4 (&acc)[2][2][4][2], const Unit& u, int wr_, int wc_, int fr_, int fq_) const {
        const int t_ = olane(), wr = wr_, wc = wc_, fr = t_ & 15, fq = t_ >> 4; (void)fr_; (void)fq_;
        const int row0 = u.pm * BM + wr * 64 + fr, col0 = u.pn * (HALF * NBJ) + wc * 32 + 4 * fq;
#pragma unroll
        for (int ai = 0; ai < 2; ++ai)
#pragma unroll
            for (int m = 0; m < 4; ++m) { float* rowp = C + (size_t)(row0 + ai * HALF + m * 16) * ldc + col0;
                const float rs = rstat ? rsqrtf(rstat[row0 + ai * HALF + m * 16] * (1.f / 1024) + 1e-6f) : 1.f; const float* swp = sw ? sw + (size_t)cond_of_pm(u.pm) * SW_LD + col0 : nullptr;
#pragma unroll
                for (int bj = 0; bj < NBJ; ++bj)
#pragma unroll
                    for (int n = 0; n < 2; ++n) { f32x4 v = acc[ai][bj][m][n] * rs; if (swp) v += *(const f32x4*)(swp + bj * HALF + n * 16); st16f(rowp + bj * HALF + n * 16, v); } }
    }
};
struct EpiBf16P {
    static constexpr bool PERM = true, AFTER_DRAIN = false;
    bf16_t* O; int ldc;
    __device__ __forceinline__ void operator()(const f32x4 (&acc)[2][2][4][2], const Unit& u, int wr_, int wc_, int fr_, int fq_) const {
        const int t_ = olane(), wr = wr_, wc = wc_, fr = t_ & 15, fq = t_ >> 4; (void)fr_; (void)fq_;
        const int row0 = u.pm * BM + wr * 64 + fr, col0 = u.pn * BM + wc * 32 + 8 * fq;
#pragma unroll
        for (int ai = 0; ai < 2; ++ai)
#pragma unroll
            for (int m = 0; m < 4; ++m) { bf16_t* rowp = O + (size_t)(row0 + ai * HALF + m * 16) * ldc + col0;
#pragma unroll
                for (int bj = 0; bj < 2; ++bj) { const f32x4 v0 = acc[ai][bj][m][0], v1 = acc[ai][bj][m][1]; u32x4 w;
                    w.x = cvt_pk_bf16(v0[0], v0[1]); w.y = cvt_pk_bf16(v0[2], v0[3]); w.z = cvt_pk_bf16(v1[0], v1[1]); w.w = cvt_pk_bf16(v1[2], v1[3]);
                    st16(rowp + bj * HALF, w); } }
    }
};
struct EpiSsdIn {
    static constexpr bool PERM = true, AFTER_DRAIN = false;
    bf16_t* Z; bf16_t* XP; float* DT; const float* rstat; const float* sw;
    __device__ __forceinline__ void operator()(const f32x4 (&acc)[2][2][4][2], const Unit& u, int wr_, int wc_, int fr_, int fq_) const {
        const int t_ = olane(), wr = wr_, wc = wc_, fr = t_ & 15, fq = t_ >> 4; (void)fr_; (void)fq_;
        const int row0 = u.pm * BM + wr * 64 + fr;
        const float* swp = sw + (size_t)cond_of_pm(u.pm) * SW_LD + u.pn * BM + wc * 32 + 8 * fq;
        if (u.pn < 20) {
            bf16_t* base = u.pn < 8 ? Z : XP; const int ld = u.pn < 8 ? 2048 : 3072, colt = (u.pn < 8 ? u.pn : u.pn - 8) * BM, col0 = colt + wc * 32 + 8 * fq;
#pragma unroll
            for (int ai = 0; ai < 2; ++ai)
#pragma unroll
                for (int m = 0; m < 4; ++m) { bf16_t* rowp = base + (size_t)(row0 + ai * HALF + m * 16) * ld + col0;
                    const float rs = rsqrtf(rstat[row0 + ai * HALF + m * 16] * (1.f / 1024) + 1e-6f);
#pragma unroll
                    for (int bj = 0; bj < 2; ++bj) { const f32x4 v0 = acc[ai][bj][m][0] * rs + *(const f32x4*)(swp + bj * HALF), v1 = acc[ai][bj][m][1] * rs + *(const f32x4*)(swp + bj * HALF + 4); u32x4 w;
                        w.x = cvt_pk_bf16(v0[0], v0[1]); w.y = cvt_pk_bf16(v0[2], v0[3]); w.z = cvt_pk_bf16(v1[0], v1[1]); w.w = cvt_pk_bf16(v1[2], v1[3]);
                        st16(rowp + bj * HALF, w); } }
        } else if (wc < 2) {
#pragma unroll
            for (int ai = 0; ai < 2; ++ai)
#pragma unroll
                for (int m = 0; m < 4; ++m) { float* rp = DT + (size_t)(row0 + ai * HALF + m * 16) * 64 + wc * 32 + 8 * fq;
                    const float rs = rsqrtf(rstat[row0 + ai * HALF + m * 16] * (1.f / 1024) + 1e-6f);
                    st16f(rp, acc[ai][0][m][0] * rs + *(const f32x4*)swp); st16f(rp + 4, acc[ai][0][m][1] * rs + *(const f32x4*)(swp + 4)); }
        }
    }
};
template <int MODE> struct EpiGlu {
    static constexpr bool PERM = false, AFTER_DRAIN = false;
    bf16_t* O; int ldo; const float* bias; int H; const float* rstat; const float* sw;
    __device__ __forceinline__ void operator()(const f32x4 (&acc)[2][2][4][2], const Unit& u, int wr_, int wc_, int fr_, int fq_) const {
        const int t_ = olane(), wr = wr_, wc = wc_, fr = t_ & 15, fq = t_ >> 4; (void)fr_; (void)fq_;
        const int row0 = u.pm * BM + wr * 64 + fr;
#pragma unroll
        for (int bj = 0; bj < 2; ++bj) {
            const int f0 = 16 * (8 * u.pn + 4 * bj + wc) + 4 * fq;
            f32x4 ba = (f32x4){0.f, 0.f, 0.f, 0.f}, bu = ba;
            if (MODE == 1) { ba = *(const f32x4*)(bias + f0); bu = *(const f32x4*)(bias + H + f0); }
            { const float* swp = sw + (size_t)cond_of_pm(u.pm) * SW_LD + u.pn * BM + bj * HALF + wc * 32 + 4 * fq; ba += *(const f32x4*)swp; bu += *(const f32x4*)(swp + 16); }
#pragma unroll
            for (int ai = 0; ai < 2; ++ai)
#pragma unroll
                for (int m = 0; m < 4; ++m) { const float rs = rsqrtf(rstat[row0 + ai * HALF + m * 16] * (1.f / 1024) + 1e-6f);
                    const f32x4 a = acc[ai][bj][m][0] * rs + ba, g = acc[ai][bj][m][1] * rs + bu; float o[4];
#pragma unroll
                    for (int j = 0; j < 4; ++j) o[j] = MODE == 0 ? a[j] * fast_sigmoid(a[j]) * g[j] : a[j] * fast_sigmoid(g[j]);
                    u32x2 w; w.x = cvt_pk_bf16(o[0], o[1]); w.y = cvt_pk_bf16(o[2], o[3]);
                    st8(O + (size_t)(row0 + ai * HALF + m * 16) * ldo + f0, w); }
        }
    }
};
template <int NBJ> struct EpiResid {
    static constexpr bool PERM = false, AFTER_DRAIN = false;
    const float* xlo; const float* xhi; float* xout; const float* mods_l; int g_off; const float* bias;
    bf16_t* XG; const float* GT; float* stat;
    __device__ __forceinline__ void operator()(const f32x4 (&acc)[2][2][4][2], const Unit& u, int wr_, int wc_, int fr_, int fq_) const {
        const int t_ = olane(), wr = wr_, wc = wc_, fr = t_ & 15, fq = t_ >> 4; (void)fr_; (void)fq_;
        const int cond = u.pm < 16 ? 0 : 1 + ((u.pm - 16) >> 2);
        const float* gate = mods_l + (size_t)cond * 6144 + g_off; const float* xin = u.pm < 16 ? xlo : xhi;
        const int row0 = u.pm * BM + wr * 64 + fr, col0 = u.pn * (HALF * NBJ) + wc * 32 + 4 * fq;
        float ss[2][4];
#pragma unroll
        for (int ai = 0; ai < 2; ++ai)
#pragma unroll
            for (int m = 0; m < 4; ++m) ss[ai][m] = 0.f;
        const float* gt = XG ? GT + (size_t)cond * 1024 : nullptr;
#pragma unroll
        for (int bj = 0; bj < NBJ; ++bj)
#pragma unroll
            for (int n = 0; n < 2; ++n) { const int c = col0 + bj * HALF + n * 16; const f32x4 g4 = *(const f32x4*)(gate + c);
                const f32x4 b4 = bias ? *(const f32x4*)(bias + c) : (f32x4){0.f, 0.f, 0.f, 0.f};
                f32x4 G4 = (f32x4){0.f, 0.f, 0.f, 0.f}; if (XG) G4 = *(const f32x4*)(gt + c);
#pragma unroll
                for (int ai = 0; ai < 2; ++ai)
#pragma unroll
                    for (int m = 0; m < 4; ++m) { const size_t off = (size_t)(row0 + ai * HALF + m * 16) * 1024 + c;
                        const f32x4 xo = *(const f32x4*)(xin + off); const f32x4 xn = xo + g4 * (acc[ai][bj][m][n] + b4); st16f(xout + off, xn);
                        if (XG) { const f32x4 xg = xn * G4; u32x2 w; w.x = cvt_pk_bf16(xg[0], xg[1]); w.y = cvt_pk_bf16(xg[2], xg[3]); st8(XG + off, w);
                            ss[ai][m] += (xn[0] * xn[0] + xn[1] * xn[1]) + (xn[2] * xn[2] + xn[3] * xn[3]); } } }
        if (XG) {
#pragma unroll
            for (int ai = 0; ai < 2; ++ai)
#pragma unroll
                for (int m = 0; m < 4; ++m) { float s = ss[ai][m];
                    s += __builtin_bit_cast(float, __builtin_amdgcn_ds_bpermute((t_ ^ 16) << 2, __builtin_bit_cast(int, s)));
                    s += __builtin_bit_cast(float, __builtin_amdgcn_ds_bpermute((t_ ^ 32) << 2, __builtin_bit_cast(int, s)));
                    if (fq == 0) atomicAdd(stat + row0 + ai * HALF + m * 16, s); }
        }
    }
};
template <class Epi, class Sched, bool ALIGN_EPI = false, bool SP2 = false, bool HALFN = false>
__device__ __forceinline__ void gemm_phase(PG8_LAS unsigned char* lds, const Gemm g, const Sched& S, const Epi& E, const int wave_in) {
    const int tid = wave_in * 64 + olane(), wid = __builtin_amdgcn_readfirstlane(tid >> 6), lane = tid & 63, wr = wid >> 2, wc = wid & 3, fr = lane & 15, fq = lane >> 4;
    const int K = g.K, nt = K / BK;
    unsigned voffA[2], voffB[2];
#pragma unroll
    for (int i = 0; i < 2; ++i) { int R, C; stage_rc(tid * 16 + i * 8192, R, C); const int Rb = Epi::PERM ? ((R & ~31) + perm32(R & 31)) : R;
        voffA[i] = (unsigned)(R * K + C) * 2u; voffB[i] = (unsigned)(Rb * K + C) * 2u; }
    const size_t kstep = (size_t)(BK * 2);
    const size_t hstep = (size_t)HALF * K * 2;
    const size_t tstep = 2 * hstep;
    const size_t bstep = HALFN ? hstep : tstep;
    static_assert(!HALFN || SP2, "HALFN is written for the SP2 loop only");
    const unsigned ldsw = (unsigned)wid * 1024u;
    const int aoff = lds_byte(wr * 64 + fr, fq * 8), boff = lds_byte(wc * 32 + fr, fq * 8);
#define PG8_SA(b, h) (((b) * 2 + (h)) * HTB)
#define PG8_SB(b, h) ((4 + (b) * 2 + (h)) * HTB)
#define PG8_STAGE(bufoff, gbase, voff) do { _Pragma("unroll") for (int _i = 0; _i < 2; ++_i) \
        __builtin_amdgcn_global_load_lds((const unsigned*)((const char*)(gbase) + (voff)[_i]), (PG8_LAS unsigned*)(lds + (bufoff) + ldsw + _i * 8192), 16, 0, 0); } while (0)
#define PG8_LDA(dst, b, h) do { _Pragma("unroll") for (int m = 0; m < 4; ++m) _Pragma("unroll") for (int k = 0; k < 2; ++k) dst[m][k] = *(const PG8_LAS bf16x8*)(lds + PG8_SA(b, h) + aoff + m * 2048 + k * 1024); } while (0)
#define PG8_LDB(dst, b, h) do { _Pragma("unroll") for (int n = 0; n < 2; ++n) _Pragma("unroll") for (int k = 0; k < 2; ++k) dst[n][k] = *(const PG8_LAS bf16x8*)(lds + PG8_SB(b, h) + boff + n * 2048 + k * 1024); } while (0)
#define PG8_MMA(ai, bj, At, Bt) do { __builtin_amdgcn_s_setprio(1); _Pragma("unroll") for (int m = 0; m < 4; ++m) _Pragma("unroll") for (int n = 0; n < 2; ++n) _Pragma("unroll") for (int k = 0; k < 2; ++k) \
        acc[ai][bj][m][n] = __builtin_amdgcn_mfma_f32_16x16x32_bf16(Bt[n][k], At[m][k], acc[ai][bj][m][n], 0, 0, 0); __builtin_amdgcn_s_setprio(0); } while (0)
#define PG8_WAIT_V(n) asm volatile("s_waitcnt vmcnt(" #n ")" ::: "memory")
#define PG8_WAIT_L(n) asm volatile("s_waitcnt lgkmcnt(" #n ")" ::: "memory")
#define PG8_BAR __builtin_amdgcn_s_barrier()
#define PG8_SCHED __builtin_amdgcn_sched_barrier(0)
    Unit cur, nxt; int ui = 0;
    if (!S.next(0, cur)) return;
    f32x4 acc[2][2][4][2];
#pragma unroll
    for (int a = 0; a < 2; ++a)
#pragma unroll
        for (int b = 0; b < 2; ++b)
#pragma unroll
            for (int m = 0; m < 4; ++m)
#pragma unroll
                for (int n = 0; n < 2; ++n) acc[a][b][m][n] = (f32x4){0.f, 0.f, 0.f, 0.f};
    bf16x8 At[4][2], B0[2][2], B1[2][2];
    const char* cA = (const char*)g.A + (size_t)cur.pm * tstep; const char* cB = (const char*)g.Bt + (size_t)cur.pn * bstep;
    S.a_ready(cur);
    if constexpr (HALFN) {
        PG8_STAGE(PG8_SB(0, 0), cB, voffB); PG8_STAGE(PG8_SA(0, 0), cA, voffA); PG8_STAGE(PG8_SA(0, 1), cA + hstep, voffA);
        if (wr == 1) PG8_BAR;
        PG8_WAIT_V(2); PG8_BAR;
        PG8_STAGE(PG8_SB(1, 0), cB + kstep, voffB); PG8_STAGE(PG8_SA(1, 0), cA + kstep, voffA);
        PG8_WAIT_V(4); PG8_BAR;
    } else if constexpr (SP2) {
        PG8_STAGE(PG8_SB(0, 0), cB, voffB); PG8_STAGE(PG8_SB(0, 1), cB + hstep, voffB); PG8_STAGE(PG8_SA(0, 0), cA, voffA); PG8_STAGE(PG8_SA(0, 1), cA + hstep, voffA);
        if (wr == 1) PG8_BAR;
        PG8_WAIT_V(2); PG8_BAR;
        PG8_STAGE(PG8_SB(1, 0), cB + kstep, voffB); PG8_STAGE(PG8_SA(1, 0), cA + kstep, voffA); PG8_STAGE(PG8_SB(1, 1), cB + hstep + kstep, voffB);
        PG8_WAIT_V(6); PG8_BAR;
    } else {
        PG8_STAGE(PG8_SB(0, 0), cB, voffB); PG8_STAGE(PG8_SA(0, 0), cA, voffA); PG8_STAGE(PG8_SB(0, 1), cB + hstep, voffB); PG8_STAGE(PG8_SA(0, 1), cA + hstep, voffA);
        if (wr == 1) PG8_BAR;
        PG8_WAIT_V(4); PG8_BAR;
        PG8_STAGE(PG8_SB(1, 0), cB + kstep, voffB); PG8_STAGE(PG8_SA(1, 0), cA + kstep, voffA); PG8_STAGE(PG8_SB(1, 1), cB + hstep + kstep, voffB);
        PG8_WAIT_V(6); PG8_BAR;
    }
    for (;;) {
        const bool has_next = S.next(ui + 1, nxt);
        const char* nA = has_next ? (const char*)g.A + (size_t)nxt.pm * tstep : cA; const char* nB = has_next ? (const char*)g.Bt + (size_t)nxt.pn * bstep : cB;
        for (int t = 0; t < nt; t += 2) {
            const bool last = (t == nt - 2);
            const char* a1 = cA + (size_t)(t + 1) * kstep;
            const char* a2 = last ? nA : cA + (size_t)(t + 2) * kstep; const char* b2 = last ? nB : cB + (size_t)(t + 2) * kstep;
            const char* a3 = a2 + kstep; const char* b3 = b2 + kstep;
            if (last && has_next) S.a_ready(nxt);
            if constexpr (HALFN) {
            PG8_LDB(B0, 0, 0); PG8_SCHED; PG8_LDA(At, 0, 0); PG8_STAGE(PG8_SA(1, 1), a1 + hstep, voffA);
            PG8_WAIT_V(6); PG8_WAIT_L(0); PG8_BAR; PG8_MMA(0, 0, At, B0); PG8_BAR; PG8_SCHED;
            PG8_LDA(At, 0, 1); PG8_STAGE(PG8_SB(0, 0), b2, voffB); PG8_STAGE(PG8_SA(0, 0), a2, voffA);
            PG8_WAIT_V(6); PG8_WAIT_L(0); PG8_BAR; PG8_MMA(1, 0, At, B0); PG8_BAR; PG8_SCHED;
            PG8_LDB(B0, 1, 0); PG8_SCHED; PG8_LDA(At, 1, 0); PG8_STAGE(PG8_SA(0, 1), a2 + hstep, voffA);
            PG8_WAIT_V(6); PG8_WAIT_L(0); PG8_BAR; PG8_MMA(0, 0, At, B0); PG8_BAR; PG8_SCHED;
            PG8_LDA(At, 1, 1); PG8_STAGE(PG8_SB(1, 0), b3, voffB); PG8_STAGE(PG8_SA(1, 0), a3, voffA);
            PG8_WAIT_V(6); PG8_WAIT_L(0); PG8_BAR; PG8_MMA(1, 0, At, B0); PG8_BAR; PG8_SCHED;
            } else if constexpr (SP2) {
            PG8_LDB(B0, 0, 0); PG8_LDB(B1, 0, 1); PG8_SCHED; PG8_LDA(At, 0, 0); PG8_STAGE(PG8_SA(1, 1), a1 + hstep, voffA);
            PG8_WAIT_V(8); PG8_WAIT_L(0); PG8_BAR; PG8_MMA(0, 0, At, B0); PG8_MMA(0, 1, At, B1); PG8_BAR; PG8_SCHED;
            PG8_LDA(At, 0, 1); PG8_STAGE(PG8_SB(0, 0), b2, voffB); PG8_STAGE(PG8_SB(0, 1), b2 + hstep, voffB); PG8_STAGE(PG8_SA(0, 0), a2, voffA);
            PG8_WAIT_V(8); PG8_WAIT_L(0); PG8_BAR; PG8_MMA(1, 0, At, B0); PG8_MMA(1, 1, At, B1); PG8_BAR; PG8_SCHED;
            PG8_LDB(B0, 1, 0); PG8_LDB(B1, 1, 1); PG8_SCHED; PG8_LDA(At, 1, 0); PG8_STAGE(PG8_SA(0, 1), a2 + hstep, voffA);
            PG8_WAIT_V(8); PG8_WAIT_L(0); PG8_BAR; PG8_MMA(0, 0, At, B0); PG8_MMA(0, 1, At, B1); PG8_BAR; PG8_SCHED;
            PG8_LDA(At, 1, 1); PG8_STAGE(PG8_SB(1, 0), b3, voffB); PG8_STAGE(PG8_SB(1, 1), b3 + hstep, voffB); PG8_STAGE(PG8_SA(1, 0), a3, voffA);
            PG8_WAIT_V(8); PG8_WAIT_L(0); PG8_BAR; PG8_MMA(1, 0, At, B0); PG8_MMA(1, 1, At, B1); PG8_BAR; PG8_SCHED;
            } else {
            PG8_LDB(B0, 0, 0); PG8_SCHED; PG8_LDA(At, 0, 0); PG8_STAGE(PG8_SA(1, 1), a1 + hstep, voffA);
            PG8_WAIT_L(8); PG8_BAR; PG8_WAIT_L(0); PG8_MMA(0, 0, At, B0); PG8_BAR; PG8_SCHED;
            PG8_LDB(B1, 0, 1); PG8_STAGE(PG8_SB(0, 0), b2, voffB);
            PG8_BAR; PG8_WAIT_L(0); PG8_MMA(0, 1, At, B1); PG8_BAR;
            PG8_LDA(At, 0, 1); PG8_STAGE(PG8_SA(0, 0), a2, voffA);
            PG8_BAR; PG8_WAIT_L(0); PG8_MMA(1, 0, At, B0); PG8_BAR; PG8_SCHED;
            PG8_STAGE(PG8_SB(0, 1), b2 + hstep, voffB);
            PG8_WAIT_V(6); PG8_BAR; PG8_MMA(1, 1, At, B1); PG8_BAR;
            PG8_LDB(B0, 1, 0); PG8_SCHED; PG8_LDA(At, 1, 0); PG8_STAGE(PG8_SA(0, 1), a2 + hstep, voffA);
            PG8_WAIT_L(8); PG8_BAR; PG8_WAIT_L(0); PG8_MMA(0, 0, At, B0); PG8_BAR; PG8_SCHED;
            PG8_LDB(B1, 1, 1); PG8_STAGE(PG8_SB(1, 0), b3, voffB);
            PG8_BAR; PG8_WAIT_L(0); PG8_MMA(0, 1, At, B1); PG8_BAR;
            PG8_LDA(At, 1, 1); PG8_STAGE(PG8_SA(1, 0), a3, voffA);
            PG8_BAR; PG8_WAIT_L(0); PG8_MMA(1, 0, At, B0); PG8_BAR; PG8_SCHED;
            PG8_STAGE(PG8_SB(1, 1), b3 + hstep, voffB);
            PG8_WAIT_V(6); PG8_BAR; PG8_MMA(1, 1, At, B1); PG8_BAR;
            }
        }
        if constexpr (ALIGN_EPI) { if (wr == 0) PG8_BAR; }
        if constexpr (!Epi::AFTER_DRAIN) { E(acc, cur, wr, wc, fr, fq); S.done(cur); }
        if (!has_next) break;
#pragma unroll
        for (int a = 0; a < 2; ++a)
#pragma unroll
            for (int b = 0; b < 2; ++b)
#pragma unroll
                for (int m = 0; m < 4; ++m)
#pragma unroll
                    for (int n = 0; n < 2; ++n) acc[a][b][m][n] = (f32x4){0.f, 0.f, 0.f, 0.f};
        cur = nxt; cA = nA; cB = nB; ++ui;
        if constexpr (ALIGN_EPI) { if (wr == 1) PG8_BAR; }
    }
    PG8_WAIT_V(0);
    if constexpr (!ALIGN_EPI) { if (wr == 0) PG8_BAR; }
    PG8_BAR;
    if constexpr (Epi::AFTER_DRAIN) { E.fused(acc, cur, wr, wc, fr, fq, lds, wid, lane); S.done(cur); }
#undef PG8_SA
#undef PG8_SB
#undef PG8_STAGE
#undef PG8_LDA
#undef PG8_LDB
#undef PG8_MMA
#undef PG8_WAIT_V
#undef PG8_WAIT_L
#undef PG8_BAR
#undef PG8_SCHED
}
}
constexpr int NWAVES = 8, NTHR = 512;
constexpr size_t MiB = 1u << 20;
constexpr size_t WS_CTL = 0, CTL_ZERO_BYTES = 1 * MiB;
constexpr size_t WS_MODS = 256 * 1024;
constexpr size_t WS_STAT = 768 * 1024;
constexpr size_t WS_SW = 372 * MiB, WS_GT = 374 * MiB;
constexpr size_t WS_ROPE = 1 * MiB;
constexpr size_t WS_W = 2 * MiB;
constexpr size_t W_MLA = WS_W, MLA_WB = 5898240;
constexpr size_t MW_CAT = 0, MW_UQ = 1572864, MW_UKV = 2752512, MW_O = 3801088;
constexpr size_t W_CV1 = WS_W + 2 * MLA_WB, W_CV2 = W_CV1 + 4 * MiB;
constexpr size_t W_SSI = W_CV2 + 2 * MiB, W_SSO = W_SSI + 11010048;
constexpr size_t W_FF = W_SSO + 4 * MiB, FF_WB = 17301504, FW_IN = 0, FW_OUT = 11534336;
static_assert(W_FF + 4 * FF_WB <= 102 * MiB, "weights region");
constexpr size_t WS_H = 102 * MiB;
constexpr size_t WS_CKV = 118 * MiB, CKV_B = (size_t)(T + NCTX) * KVL * 2;
constexpr size_t WS_AR = 128 * MiB;
constexpr size_t A_LAT = WS_AR, A_QN = A_LAT + 24 * MiB, A_QRAW = A_QN + 6 * MiB, A_KVRAW = A_QRAW + 24 * MiB, A_QB = A_KVRAW + 36 * MiB, A_KB = A_QB + 24 * MiB, A_AO = A_KB + 27 * MiB;
constexpr size_t A_U = WS_AR, A_V = A_U + 16 * MiB;
constexpr size_t A_Z = WS_AR, A_XPRE = A_Z + 32 * MiB, A_DTRAW = A_XPRE + 48 * MiB, A_XBC = A_DTRAW + 2 * MiB, A_DT = A_XBC + 48 * MiB, A_Y = A_DT + 2 * MiB, A_YN = A_XPRE, A_ACUM = A_Y + 64 * MiB;
constexpr size_t A_ACT = WS_AR + 200 * MiB;
static_assert(A_AO + 16 * MiB <= A_ACT && A_ACUM + 2 * MiB <= A_ACT && A_ACT + 44 * MiB <= 384 * MiB, "arena map");
constexpr int CW_BAR = 4096;
constexpr int LDS_BYTES = 163840, RING_BYTES = 131072, MISC_OFF = 163840 - 256, PTAB_OFF_C = MISC_OFF - 512;

#define GAS __attribute__((address_space(1)))
#define LAS __attribute__((address_space(3)))
typedef unsigned short bf16;
typedef unsigned v4u __attribute__((ext_vector_type(4)));
typedef unsigned v2u __attribute__((ext_vector_type(2)));
typedef float v4f __attribute__((ext_vector_type(4)));
typedef float v2f __attribute__((ext_vector_type(2)));
typedef GAS unsigned gu32;
#define LDS_WAIT() asm volatile("s_waitcnt lgkmcnt(0)" ::: "memory")
#define LDS_BARRIER() do { asm volatile("s_waitcnt lgkmcnt(0)" ::: "memory"); __builtin_amdgcn_s_barrier(); asm volatile("" ::: "memory"); } while (0)
#define VM_WAIT() asm volatile("s_waitcnt vmcnt(0)" ::: "memory")
__device__ __forceinline__ unsigned f2bf(float f) { unsigned u = __builtin_bit_cast(unsigned, f); return (u + 0x7fffu + ((u >> 16) & 1u)) >> 16; }
__device__ __forceinline__ unsigned pk2(float lo, float hi) { return f2bf(lo) | (f2bf(hi) << 16); }
__device__ __forceinline__ float bflo(unsigned u) { return __builtin_bit_cast(float, u << 16); }
__device__ __forceinline__ float bfhi(unsigned u) { return __builtin_bit_cast(float, u & 0xffff0000u); }
__device__ __forceinline__ float bf2f(bf16 b) { return __builtin_bit_cast(float, (unsigned)b << 16); }

#define XB_TMO      128
#define XB_XCNT(j)  (256  + 64 * (j))
#define XB_XSUB(j)  (1280 + 64 * (j))
#define XB_XGEN(j)  (2304 + 64 * (j))
#define XB_TOP      3328
#define XB_TOPGEN   3392
#define XCD_BAR_WORDS 3456
#define XB_SPIN_CAP (1u << 18)

__device__ __forceinline__ unsigned xb_ld(unsigned* p)              { return __hip_atomic_load(p, __ATOMIC_RELAXED, __HIP_MEMORY_SCOPE_AGENT); }
__device__ __forceinline__ unsigned xb_add(unsigned* p, unsigned v) { return __hip_atomic_fetch_add(p, v, __ATOMIC_RELAXED, __HIP_MEMORY_SCOPE_AGENT); }
__device__ __forceinline__ unsigned xb_xcc_id() { return (unsigned)__builtin_amdgcn_s_getreg((3 << 11) | 20) & 0xFu; }
#define XB_SPIN(cond, bar) do { unsigned _sp = 0; while (cond) { __builtin_amdgcn_s_sleep(1); \
    if ((++_sp & 255u) == 0u) { if (xb_ld(&(bar)[XB_TMO])) break; if (_sp > XB_SPIN_CAP) { atomicAdd(&(bar)[XB_TMO], 1u); break; } } } } while (0)

struct XcdBarrier {
    unsigned* bar; unsigned x;
    volatile LAS unsigned* st;
};

__device__ __forceinline__ XcdBarrier xcd_barrier_post(unsigned* bar, volatile LAS unsigned* st) {
    XcdBarrier b; b.bar = bar; b.x = xb_xcc_id(); b.st = st;
    if (threadIdx.x == 0) (void)xb_add(&bar[XB_XCNT(b.x)], 1u);
    return b;
}
__device__ __forceinline__ void xcd_barrier_complete(unsigned* bar, unsigned x, unsigned& nloc, unsigned& nx) {
    const unsigned G = gridDim.x * gridDim.y * gridDim.z;
    unsigned sum, cnt, mine, sp = 0u;
    for (;;) {
        sum = 0u; cnt = 0u; mine = 0u;
#pragma unroll
        for (unsigned j = 0; j < 16; ++j) { const unsigned c = xb_ld(&bar[XB_XCNT(j)]); sum += c; cnt += (c > 0u) ? 1u : 0u; mine = (j == x) ? c : mine; }
        if (sum == G) break;
        __builtin_amdgcn_s_sleep(1);
        if ((++sp & 255u) == 0u) { if (xb_ld(&bar[XB_TMO])) break; if (sp > XB_SPIN_CAP) { atomicAdd(&bar[XB_TMO], 1u); break; } }
    }
    nloc = mine > 0u ? mine : 1u; nx = cnt > 0u ? cnt : 1u;
}

__device__ __forceinline__ void xcd_barrier(const XcdBarrier& b) {
    asm volatile("s_waitcnt vmcnt(0)" ::: "memory");
    __syncthreads();
    if (threadIdx.x == 0) {
        unsigned* bar = b.bar;
        __builtin_amdgcn_s_waitcnt(0);
        unsigned nloc = b.st[0], nx = b.st[1];
        if (nloc == 0u) { xcd_barrier_complete(bar, b.x, nloc, nx); b.st[0] = nloc; b.st[1] = nx; }
        const unsigned old = xb_add(&bar[XB_XSUB(b.x)], 1u);
        const unsigned gen = old / nloc;
        if (old + 1u == (gen + 1u) * nloc) {
            __builtin_amdgcn_fence(__ATOMIC_RELEASE, "agent");
            asm volatile("s_waitcnt vmcnt(0)" ::: "memory");
            const unsigned og = xb_add(&bar[XB_TOP], 1u);
            const unsigned tg = og / nx;
            if (og + 1u == (tg + 1u) * nx) xb_add(&bar[XB_TOPGEN], 1u);
            else XB_SPIN(xb_ld(&bar[XB_TOPGEN]) == tg, bar);
            __builtin_amdgcn_fence(__ATOMIC_ACQUIRE, "agent");
            xb_add(&bar[XB_XGEN(b.x)], 1u);
            asm volatile("s_waitcnt vmcnt(0)" ::: "memory");
        } else {
            XB_SPIN(xb_ld(&bar[XB_XGEN(b.x)]) == gen, bar);
            __builtin_amdgcn_fence(__ATOMIC_ACQUIRE, "agent");
            asm volatile("s_waitcnt vmcnt(0)" ::: "memory");
        }
    }
    __syncthreads();
}

struct Frame {
    LAS unsigned char* lds; int tid, lane, wave, vcu, G, gw, NGW, bx;
    volatile LAS unsigned* PT;
};
constexpr int PT_OUT = 38, PT_WS = 39;
__device__ __forceinline__ const float* ldp(volatile LAS unsigned* PT, int k) {
    const unsigned lo = __builtin_amdgcn_readfirstlane(PT[2 * k]), hi = __builtin_amdgcn_readfirstlane(PT[2 * k + 1]);
    return (const float*)(((unsigned long long)hi << 32) | lo);
}
#define INP(k) ldp(F.PT, (k))
#define WSP ((unsigned char*)ldp(F.PT, PT_WS))
#define OUTP ((float*)ldp(F.PT, PT_OUT))
enum InIdx { I_XP = 0, I_XS, I_CCKV, I_CKPE, I_SSM, I_C, I_CCTX, I_WADA, I_BADA, I_GN1, I_GN2, I_WDQ, I_GQ, I_WUQ, I_WDKV, I_GKV, I_WUKV, I_GQN, I_GKN, I_WO,
             I_CVW1, I_CVB1, I_CVWD, I_CVBD, I_CVGL, I_CVBL, I_CVW2, I_CVB2, I_SSWI, I_SSWC, I_SSBC, I_SSDTB, I_SSAL, I_SSD, I_SSGN, I_SSWO, I_FFWI, I_FFWO };
__device__ __forceinline__ float shx(float v, int lane, int o) { return __builtin_bit_cast(float, __builtin_amdgcn_ds_bpermute((lane ^ o) << 2, __builtin_bit_cast(int, v))); }
__device__ __forceinline__ float wsum(float v, int lane) {
#pragma unroll
    for (int o = 1; o < 64; o <<= 1) v += shx(v, lane, o);
    return v;
}
constexpr float QSCALE = 0.10206207261596577f * 1.4426950408889634f;

struct P0Item { const float* W; bf16* WT; int K, N, mode, H, roff, k0, n0; };
__device__ __forceinline__ void p0_item_load(const P0Item& J, int lane, v4f (&t)[8]) {
#pragma unroll
    for (int i = 0; i < 8; ++i) t[i] = *(const GAS v4f*)(J.W + (size_t)(J.k0 + 8 * i + (lane >> 3)) * J.N + J.n0 + 4 * (lane & 7));
}
__device__ __forceinline__ void p0_item_finish(const P0Item& J, int lane, const v4f (&t)[8], LAS float* scr) {
#pragma unroll
    for (int i = 0; i < 8; ++i) { LAS float* d = scr + (8 * i + (lane >> 3)) * 33 + 4 * (lane & 7); d[0] = t[i].x; d[1] = t[i].y; d[2] = t[i].z; d[3] = t[i].w; }
    LDS_WAIT(); asm volatile("" ::: "memory");
    const int c = lane & 7;
#pragma unroll
    for (int j = 0; j < 4; ++j) { const int n = (lane >> 3) + 8 * j, col = J.n0 + n; const LAS float* s = scr + (8 * c) * 33 + n;
        int drow;
        if (J.mode == 0) drow = J.roff + col;
        else { const int f = col < J.H ? col : col - J.H; drow = 32 * (f >> 4) + (f & 15) + (col < J.H ? 0 : 16); }
        v4u o; o.x = pk2(s[0 * 33], s[1 * 33]); o.y = pk2(s[2 * 33], s[3 * 33]); o.z = pk2(s[4 * 33], s[5 * 33]); o.w = pk2(s[6 * 33], s[7 * 33]);
        *(GAS v4u*)(J.WT + (size_t)drow * J.K + J.k0 + 8 * c) = o; }
    LDS_WAIT(); asm volatile("" ::: "memory");
}
__device__ __forceinline__ void p0_job(int q, int& inp, size_t& soff, int& K, int& N, size_t& doff, int& mode, int& H, int& roff) {
    mode = 0; H = 0; roff = 0; soff = 0;
    if (q < 10) { const int j = q / 5, t = q % 5; const size_t wb = W_MLA + (size_t)j * MLA_WB;
        if (t == 0) { inp = I_WDQ; soff = (size_t)j * 1024 * 384; K = 1024; N = 384; doff = wb + MW_CAT; }
        else if (t == 1) { inp = I_WDKV; soff = (size_t)j * 1024 * 288; K = 1024; N = 288; doff = wb + MW_CAT; roff = 384; }
        else if (t == 2) { inp = I_WUQ; soff = (size_t)j * 384 * 1536; K = 384; N = 1536; doff = wb + MW_UQ; }
        else if (t == 3) { inp = I_WUKV; soff = (size_t)j * 256 * 2048; K = 256; N = 2048; doff = wb + MW_UKV; }
        else { inp = I_WO; soff = (size_t)j * 1024 * 1024; K = 1024; N = 1024; doff = wb + MW_O; } }
    else if (q == 10) { inp = I_CVW1; K = 1024; N = 2048; doff = W_CV1; mode = 1; H = 1024; }
    else if (q == 11) { inp = I_CVW2; K = 1024; N = 1024; doff = W_CV2; }
    else if (q == 12) { inp = I_SSWI; K = 1024; N = 5184; doff = W_SSI; }
    else if (q == 13) { inp = I_SSWO; K = 2048; N = 1024; doff = W_SSO; }
    else { const int l = (q - 14) >> 1, t = (q - 14) & 1;
        if (t == 0) { inp = I_FFWI; soff = (size_t)l * 1024 * 5632; K = 1024; N = 5632; doff = W_FF + (size_t)l * FF_WB + FW_IN; mode = 1; H = 2816; }
        else { inp = I_FFWO; soff = (size_t)l * 2816 * 1024; K = 2816; N = 1024; doff = W_FF + (size_t)l * FF_WB + FW_OUT; } }
}
constexpr int P0_NITEMS = 2 * ((1024 / 64) * (384 / 32) + (1024 / 64) * (288 / 32) + (384 / 64) * (1536 / 32) + (256 / 64) * (2048 / 32) + (1024 / 64) * (1024 / 32))
                        + (1024 / 64) * (2048 / 32) + (1024 / 64) * (1024 / 32) + (1024 / 64) * (5184 / 32) + (2048 / 64) * (1024 / 32)
                        + 4 * ((1024 / 64) * (5632 / 32) + (2816 / 64) * (1024 / 32));
__device__ __forceinline__ void p0_prologue(Frame& F) {
    unsigned char* ws = WSP;
    LAS float* s = (LAS float*)F.lds;
    for (int i = F.tid; i < 5 * 1024; i += NTHR) { const int cc = i >> 10, k = i & 1023; const float v = cc == 0 ? INP(I_CCTX)[k] : INP(I_C)[(cc - 1) * 1024 + k]; s[i] = v / (1.f + expf(-v)); }
    __syncthreads();
    float* mods = (float*)(ws + WS_MODS);
    for (int it = F.bx; it < 192; it += F.G) {
        const int l = it / 48, r = it % 48, cb = r / 16, ks = r % 16, n = cb * 2048 + 4 * F.tid;
        const float* W = INP(I_WADA) + (size_t)l * 1024 * 6144 + (size_t)(ks * 64) * 6144 + n;
        v4f acc[5];
#pragma unroll
        for (int cc = 0; cc < 5; ++cc) acc[cc] = (v4f){0.f, 0.f, 0.f, 0.f};
#pragma unroll 1
        for (int kb = 0; kb < 64; kb += 16) {
            v4f wv[16];
#pragma unroll
            for (int k = 0; k < 16; ++k) wv[k] = *(const GAS v4f*)(W + (size_t)(kb + k) * 6144);
#pragma unroll
            for (int k = 0; k < 16; ++k)
#pragma unroll
                for (int cc = 0; cc < 5; ++cc) acc[cc] += wv[k] * s[cc * 1024 + ks * 64 + kb + k];
        }
        LAS float* tbl = s + 5 * 1024;
        __syncthreads();
#pragma unroll
        for (int cc = 0; cc < 5; ++cc) *(LAS v4f*)(tbl + cc * 2048 + 4 * F.tid) = acc[cc];
        __syncthreads();
        const float* bp = INP(I_BADA) + l * 6144 + cb * 2048;
#pragma unroll
        for (int q = 0; q < 4; ++q) { const int col = q * 512 + F.tid; const float bb = ks == 0 ? bp[col] : 0.f;
#pragma unroll
            for (int cc = 0; cc < 5; ++cc) atomicAdd(&mods[((size_t)l * 5 + cc) * 6144 + cb * 2048 + col], tbl[cc * 2048 + col] + bb); }
    }
    __syncthreads();
    LAS float* scr = (LAS float*)(F.lds + F.wave * 8448);
    for (int it = F.gw; it < P0_NITEMS; it += 2 * F.NGW) {
        P0Item J[2]; bool have1 = it + F.NGW < P0_NITEMS;
#pragma unroll
        for (int e = 0; e < 2; ++e) {
            int r = e == 0 ? it : (have1 ? it + F.NGW : it), inp = 0, K = 64, N = 32, mode = 0, H = 0, roff = 0; size_t soff = 0, doff = 0;
#pragma unroll 1
            for (int q = 0; q < 22; ++q) { p0_job(q, inp, soff, K, N, doff, mode, H, roff); const int ni = (K / 64) * (N / 32); if (r < ni) break; r -= ni; }
            const int nblk = N / 32;
            J[e].W = INP(inp) + soff; J[e].WT = (bf16*)(ws + doff); J[e].K = K; J[e].N = N; J[e].mode = mode; J[e].H = H; J[e].roff = roff; J[e].k0 = 64 * (r / nblk); J[e].n0 = 32 * (r % nblk);
        }
        v4f t0[8], t1[8];
        p0_item_load(J[0], F.lane, t0); p0_item_load(J[1], F.lane, t1);
        p0_item_finish(J[0], F.lane, t0, scr);
        if (have1) p0_item_finish(J[1], F.lane, t1, scr);
    }
    for (int it = F.gw; it < 384; it += F.NGW) {
        bf16* rowp = it < 192 ? (bf16*)(ws + W_MLA + (it / 96) * MLA_WB + MW_CAT) + (size_t)(672 + it % 96) * 1024 : (bf16*)(ws + W_SSI) + (size_t)(5184 + it - 192) * 1024;
        const v4u z = {0u, 0u, 0u, 0u}; ((GAS v4u*)rowp)[F.lane] = z; ((GAS v4u*)rowp)[64 + F.lane] = z;
    }
    for (int it = F.gw; it < 2048; it += F.NGW) {
        const int j = it >> 10, rr = it & 1023, b = rr >> 8, sq = rr & 255;
        const v4f v = ((const GAS v4f*)(INP(I_CCKV) + (((size_t)b * 2 + j) * 256 + sq) * 256))[F.lane];
        v2u o; o.x = pk2(v.x, v.y); o.y = pk2(v.z, v.w);
        ((GAS v2u*)((bf16*)(ws + WS_CKV + j * CKV_B) + (size_t)(T + rr) * 256))[F.lane] = o;
    }
    if (F.bx == 0) for (int i = F.tid; i < 640; i += NTHR) { const int pos = i >> 3, fi = i & 7; const float p = (float)(pos < 16 ? pos : pos - 16);
        const float a = p * rope_inv(fi); float* tab = (float*)(ws + WS_ROPE); tab[2 * i] = cosf(a); tab[2 * i + 1] = sinf(a); }
}

__device__ __forceinline__ void rp_normmod(Frame& F, const float* xlo, const float* xhi, const float* g, const float* mods_l, int sh_off, int sc_off, bf16* h) {
    for (int base = F.gw; base < T; base += 4 * F.NGW) {
        v4f v[4][4]; float ss[4]; int rows[4];
#pragma unroll
        for (int k = 0; k < 4; ++k) { const int row = base + k * F.NGW; rows[k] = row < T ? row : base;
            const GAS v4f* xr = (const GAS v4f*)((rows[k] < TP ? xlo : xhi) + (size_t)rows[k] * 1024) + F.lane;
#pragma unroll
            for (int j = 0; j < 4; ++j) v[k][j] = xr[64 * j]; }
#pragma unroll
        for (int k = 0; k < 4; ++k) { float s = 0.f;
#pragma unroll
            for (int j = 0; j < 4; ++j) s += (v[k][j].x * v[k][j].x + v[k][j].y * v[k][j].y) + (v[k][j].z * v[k][j].z + v[k][j].w * v[k][j].w);
            ss[k] = s; }
#pragma unroll
        for (int o = 1; o < 64; o <<= 1) {
#pragma unroll
            for (int k = 0; k < 4; ++k) ss[k] += shx(ss[k], F.lane, o); }
#pragma unroll
        for (int j = 0; j < 4; ++j) { const int c = 4 * F.lane + 256 * j; const v4f g4 = *(const GAS v4f*)(g + c);
#pragma unroll
            for (int k = 0; k < 4; ++k) { const float r = rsqrtf(ss[k] * (1.f / 1024) + EPS); const float* m = mods_l + (size_t)cond_of_row(rows[k]) * 6144;
                const v4f sc = *(const GAS v4f*)(m + sc_off + c), sh = *(const GAS v4f*)(m + sh_off + c);
                const v4f o = v[k][j] * r * g4 * (sc + 1.f) + sh; v2u w; w.x = pk2(o.x, o.y); w.y = pk2(o.z, o.w);
                *(GAS v2u*)(h + (size_t)rows[k] * 1024 + c) = w; } }
    }
}
__device__ __forceinline__ void rp_mla_fin1(Frame& F, const float* lat, const float* gq, const float* gkv, bf16* qn, bf16* ckv, float* out, int j) {
    for (int row = F.gw; row < T; row += F.NGW) {
        const float* lr = lat + (size_t)row * 768;
        v2f q[3]; float ss = 0.f;
#pragma unroll
        for (int i = 0; i < 3; ++i) { q[i] = *(const GAS v2f*)(lr + 2 * F.lane + 128 * i); ss += q[i].x * q[i].x + q[i].y * q[i].y; }
        float r = rsqrtf(wsum(ss, F.lane) * (1.f / 384) + EPS);
#pragma unroll
        for (int i = 0; i < 3; ++i) { const int c = 2 * F.lane + 128 * i; *(GAS unsigned*)(qn + (size_t)row * 384 + c) = pk2(q[i].x * r * gq[c], q[i].y * r * gq[c + 1]); }
        v2f k[2]; ss = 0.f;
#pragma unroll
        for (int i = 0; i < 2; ++i) { k[i] = *(const GAS v2f*)(lr + 384 + 2 * F.lane + 128 * i); ss += k[i].x * k[i].x + k[i].y * k[i].y; }
        r = rsqrtf(wsum(ss, F.lane) * (1.f / 256) + EPS);
#pragma unroll
        for (int i = 0; i < 2; ++i) { const int c = 2 * F.lane + 128 * i; const float c0 = k[i].x * r * gkv[c], c1 = k[i].y * r * gkv[c + 1];
            *(GAS unsigned*)(ckv + (size_t)row * 256 + c) = pk2(c0, c1);
            if (row < TP) { v2f o; o.x = c0; o.y = c1; *(GAS v2f*)(out + OUT_CKV + (((size_t)(row >> 8) * 2 + j) * 256 + (row & 255)) * 256 + c) = o; } }
        if (row < TP && F.lane < 32) out[OUT_KPE + (((size_t)(row >> 8) * 2 + j) * 256 + (row & 255)) * 32 + F.lane] = lr[640 + F.lane];
    }
}
__device__ __forceinline__ void rope32_tab(float* pe, int t, const float* tab) {
    const v2f* tr = (const v2f*)tab + (t >> 6) * 8; const v2f* tc = (const v2f*)tab + (16 + (t & 63)) * 8;
#pragma unroll
    for (int i = 0; i < 8; ++i) {
        v2f cs = tr[i]; float x1 = pe[i], x2 = pe[i + 8]; pe[i] = x1 * cs.x - x2 * cs.y; pe[i + 8] = x2 * cs.x + x1 * cs.y;
        cs = tc[i]; x1 = pe[16 + i]; x2 = pe[24 + i]; pe[16 + i] = x1 * cs.x - x2 * cs.y; pe[24 + i] = x2 * cs.x + x1 * cs.y;
    }
}
__device__ __forceinline__ void ld8(const bf16* p, float* d) { const v4u w = *(const GAS v4u*)p; d[0] = bflo(w.x); d[1] = bfhi(w.x); d[2] = bflo(w.y); d[3] = bfhi(w.y); d[4] = bflo(w.z); d[5] = bfhi(w.z); d[6] = bflo(w.w); d[7] = bfhi(w.w); }
__device__ __forceinline__ void st8(bf16* p, const float* d) { v4u w; w.x = pk2(d[0], d[1]); w.y = pk2(d[2], d[3]); w.z = pk2(d[4], d[5]); w.w = pk2(d[6], d[7]); *(GAS v4u*)p = w; }
__device__ __forceinline__ void rp_tables(Frame& F) {
    unsigned char* ws = WSP; const float* mods = (const float*)(ws + WS_MODS); float* GTb = (float*)(ws + WS_GT); float* SWb = (float*)(ws + WS_SW);
    for (int idx = F.bx * NTHR + F.tid; idx < 8 * 5 * 1024; idx += F.G * NTHR) {
        const int s = idx / 5120, r = idx % 5120, c = r >> 10, k = r & 1023, layer = s >> 1;
        const float g = (s & 1) ? INP(I_GN2)[layer * 1024 + k] : INP(I_GN1)[layer * 1024 + k];
        GTb[idx] = g * (1.f + mods[((size_t)layer * 5 + c) * 6144 + ((s & 1) ? 4096 : 1024) + k]);
    }
    constexpr int NR1 = 5632, NR2 = 2048, NR4 = 5376, NR6 = 768;
    constexpr int TOT = 4 * NR1 + NR2 + NR4 + NR6;
    for (int it = F.gw; it < TOT / 4; it += F.NGW) {
        int s, n; const bf16* Wt; const int i4 = 4 * it;
        if (i4 < 4 * NR1) { const int l = i4 / NR1; n = i4 % NR1; s = 2 * l + 1; Wt = (const bf16*)(ws + W_FF + (size_t)l * FF_WB + FW_IN); }
        else if (i4 < 4 * NR1 + NR2) { n = i4 - 4 * NR1; s = 2; Wt = (const bf16*)(ws + W_CV1); }
        else if (i4 < 4 * NR1 + NR2 + NR4) { n = i4 - 4 * NR1 - NR2; s = 4; Wt = (const bf16*)(ws + W_SSI); }
        else { n = i4 - 4 * NR1 - NR2 - NR4; s = 6; Wt = (const bf16*)(ws + W_MLA + MLA_WB + MW_CAT); }
        const int layer = s >> 1, shoff = (s & 1) ? 3072 : 0;
        v4u wr[4][2];
#pragma unroll
        for (int r = 0; r < 4; ++r) { wr[r][0] = *(const GAS v4u*)(Wt + (size_t)(n + r) * 1024 + 16 * F.lane); wr[r][1] = *(const GAS v4u*)(Wt + (size_t)(n + r) * 1024 + 16 * F.lane + 8); }
        float acc[4][5];
#pragma unroll
        for (int r = 0; r < 4; ++r)
#pragma unroll
            for (int c = 0; c < 5; ++c) acc[r][c] = 0.f;
#pragma unroll
        for (int c = 0; c < 5; ++c) { const float* sp = mods + ((size_t)layer * 5 + c) * 6144 + shoff + 16 * F.lane;
            const v4f s0 = *(const GAS v4f*)sp, s1 = *(const GAS v4f*)(sp + 4), s2 = *(const GAS v4f*)(sp + 8), s3 = *(const GAS v4f*)(sp + 12);
#pragma unroll
            for (int r = 0; r < 4; ++r) { const v4u a = wr[r][0], b2 = wr[r][1];
                acc[r][c] = (s0.x * bflo(a.x) + s0.y * bfhi(a.x) + s0.z * bflo(a.y) + s0.w * bfhi(a.y)) + (s1.x * bflo(a.z) + s1.y * bfhi(a.z) + s1.z * bflo(a.w) + s1.w * bfhi(a.w))
                          + (s2.x * bflo(b2.x) + s2.y * bfhi(b2.x) + s2.z * bflo(b2.y) + s2.w * bfhi(b2.y)) + (s3.x * bflo(b2.z) + s3.y * bfhi(b2.z) + s3.z * bflo(b2.w) + s3.w * bfhi(b2.w)); } }
#pragma unroll
        for (int o = 1; o < 64; o <<= 1) {
#pragma unroll
            for (int r = 0; r < 4; ++r)
#pragma unroll
                for (int c = 0; c < 5; ++c) acc[r][c] += shx(acc[r][c], F.lane, o); }
        if (F.lane < 20) { const int r = F.lane / 5, c = F.lane % 5; float v = 0.f;
#pragma unroll
            for (int rr = 0; rr < 4; ++rr)
#pragma unroll
                for (int cc = 0; cc < 5; ++cc) v = (rr == r && cc == c) ? acc[rr][cc] : v;
            SWb[((size_t)s * 5 + c) * 5632 + n + r] = v; }
    }
}
__device__ __forceinline__ void rp_mla_fin2(Frame& F, const bf16* qraw, const bf16* kvraw, const float* lat, const float* ckpe_j, const float* gqn, const float* gkn, const float* tab, bf16* Q, bf16* K) {
    for (int idx = F.bx * NTHR + F.tid; idx < T * 32; idx += F.G * NTHR) {
        const int row = idx >> 5, hd = (idx >> 1) & 15, hf = idx & 1; const bool latent = row >= TP; const int tl = (row - TP) & 1023;
        float v[48]; float ss = 0.f;
#pragma unroll
        for (int i = 0; i < 6; ++i) ld8(qraw + (size_t)row * 1536 + hd * 96 + hf * 48 + 8 * i, v + 8 * i);
#pragma unroll
        for (int d = 0; d < 48; ++d) ss += v[d] * v[d];
        ss += shx(ss, F.lane, 1);
        const float r = rsqrtf(ss * (1.f / 96) + EPS) * QSCALE;
#pragma unroll
        for (int d = 0; d < 48; ++d) v[d] = v[d] * r * gqn[hf * 48 + d];
        if (latent && hf) rope32_tab(v + 16, tl, tab);
#pragma unroll
        for (int i = 0; i < 6; ++i) st8(Q + ((size_t)row * 16 + hd) * 96 + hf * 48 + 8 * i, v + 8 * i);
    }
    asm volatile("" ::: "memory");
    for (int idx = F.bx * NTHR + F.tid; idx < (T + NCTX) * 32; idx += F.G * NTHR) {
        const int row = idx >> 5, hd = (idx >> 1) & 15, hf = idx & 1; const bool latent = row >= TP && row < T; const int tl = (row - TP) & 1023;
        float v[48]; float ss = 0.f;
        if (hf == 0) {
#pragma unroll
            for (int i = 0; i < 6; ++i) ld8(kvraw + (size_t)row * 2048 + hd * 128 + 8 * i, v + 8 * i);
        } else {
#pragma unroll
            for (int i = 0; i < 2; ++i) ld8(kvraw + (size_t)row * 2048 + hd * 128 + 48 + 8 * i, v + 8 * i);
            const float* kp = row < T ? lat + (size_t)row * 768 + 640 : ckpe_j + ((size_t)((row - T) >> 8) * 2 * 256 + ((row - T) & 255)) * 32;
#pragma unroll
            for (int i = 0; i < 8; ++i) { const v4f p4 = *(const GAS v4f*)(kp + 4 * i); v[16 + 4 * i] = p4.x; v[17 + 4 * i] = p4.y; v[18 + 4 * i] = p4.z; v[19 + 4 * i] = p4.w; }
        }
#pragma unroll
        for (int d = 0; d < 48; ++d) ss += v[d] * v[d];
        ss += shx(ss, F.lane, 1);
        const float r = rsqrtf(ss * (1.f / 96) + EPS);
#pragma unroll
        for (int d = 0; d < 48; ++d) v[d] = v[d] * r * gkn[hf * 48 + d];
        if (latent && hf) rope32_tab(v + 16, tl, tab);
#pragma unroll
        for (int i = 0; i < 6; ++i) st8(K + ((size_t)row * 16 + hd) * 96 + hf * 48 + 8 * i, v + 8 * i);
    }
}
__device__ __forceinline__ void rp_dwconv(Frame& F, const bf16* u, const float* wdw, const float* bdw, const float* gln, const float* bln, bf16* vout) {
    LAS float* red = (LAS float*)F.lds;
    const int c = 2 * F.tid;
    for (int it = F.vcu; it < T / 16; it += F.G) {
        const int row0 = 16 * it; int t0, L; row_pos(row0, t0, L);
        v2f w[31];
#pragma unroll
        for (int k = 0; k < 31; ++k) w[k] = *(const GAS v2f*)(wdw + k * 1024 + c);
        const v2f bb = *(const GAS v2f*)(bdw + c);
        float y0[16], y1[16];
#pragma unroll
        for (int r = 0; r < 16; ++r) { y0[r] = bb.x; y1[r] = bb.y; }
#pragma unroll
        for (int rr = 0; rr < 46; ++rr) {
            const int tt = t0 - 15 + rr; unsigned pk = 0u;
            if (tt >= 0 && tt < L) pk = *(const GAS unsigned*)(u + (size_t)(row0 - 15 + rr) * 1024 + c);
            const float u0 = bflo(pk), u1 = bfhi(pk);
#pragma unroll
            for (int k = 0; k < 31; ++k) { const int r = rr - k; if (r >= 0 && r < 16) { y0[r] += u0 * w[k].x; y1[r] += u1 * w[k].y; } }
        }
        float s[16];
#pragma unroll
        for (int r = 0; r < 16; ++r) s[r] = y0[r] + y1[r];
#pragma unroll
        for (int o = 1; o < 64; o <<= 1) {
#pragma unroll
            for (int r = 0; r < 16; ++r) s[r] += shx(s[r], F.lane, o); }
        __syncthreads();
        if (F.lane < 16) { float v = s[0];
#pragma unroll
            for (int r = 1; r < 16; ++r) v = F.lane == r ? s[r] : v;
            red[F.wave * 16 + F.lane] = v; }
        __syncthreads();
        float mean[16];
#pragma unroll
        for (int r = 0; r < 16; ++r) { float m = 0.f;
#pragma unroll
            for (int wv = 0; wv < 8; ++wv) m += red[wv * 16 + r];
            mean[r] = m * (1.f / 1024); }
#pragma unroll
        for (int r = 0; r < 16; ++r) { y0[r] -= mean[r]; y1[r] -= mean[r]; s[r] = y0[r] * y0[r] + y1[r] * y1[r]; }
#pragma unroll
        for (int o = 1; o < 64; o <<= 1) {
#pragma unroll
            for (int r = 0; r < 16; ++r) s[r] += shx(s[r], F.lane, o); }
        __syncthreads();
        if (F.lane < 16) { float v = s[0];
#pragma unroll
            for (int r = 1; r < 16; ++r) v = F.lane == r ? s[r] : v;
            red[F.wave * 16 + F.lane] = v; }
        __syncthreads();
        const v2f gg = *(const GAS v2f*)(gln + c), bl = *(const GAS v2f*)(bln + c);
#pragma unroll
        for (int r = 0; r < 16; ++r) { float q = 0.f;
#pragma unroll
            for (int wv = 0; wv < 8; ++wv) q += red[wv * 16 + r];
            const float rs = rsqrtf(q * (1.f / 1024) + EPS);
            const float z0 = y0[r] * rs * gg.x + bl.x, z1 = y1[r] * rs * gg.y + bl.y;
            *(GAS unsigned*)(vout + (size_t)(row0 + r) * 1024 + c) = pk2(z0 / (1.f + __expf(-z0)), z1 / (1.f + __expf(-z1))); }
    }
    __syncthreads();
}
__device__ __forceinline__ void rp_ssd_conv(Frame& F, const bf16* xpre, const float* dtraw, const float* wc, const float* bc, const float* dtb, const float* alog, bf16* xbc, float* dt, float* acum) {
    for (int idx = F.bx * NTHR + F.tid; idx < (T / 32) * 384; idx += F.G * NTHR) {
        const int seg = idx / 384, cg = idx - seg * 384, c0 = 8 * cg, row0 = 32 * seg; int t0, L; row_pos(row0, t0, L);
        float w[5][8], bias[8];
#pragma unroll
        for (int k = 0; k < 5; ++k) { const v4f a = *(const GAS v4f*)(wc + k * 3072 + c0), b2 = *(const GAS v4f*)(wc + k * 3072 + c0 + 4);
            w[k][0] = a.x; w[k][1] = a.y; w[k][2] = a.z; w[k][3] = a.w; w[k][4] = b2.x; w[k][5] = b2.y; w[k][6] = b2.z; w[k][7] = b2.w; }
        { const v4f a = *(const GAS v4f*)(bc + c0), b2 = *(const GAS v4f*)(bc + c0 + 4); bias[0] = a.x; bias[1] = a.y; bias[2] = a.z; bias[3] = a.w; bias[4] = b2.x; bias[5] = b2.y; bias[6] = b2.z; bias[7] = b2.w; }
        float win[5][8];
#pragma unroll
        for (int k = 0; k < 4; ++k) { const int tt = t0 + k - 2;
            if (tt >= 0 && tt < L) ld8(xpre + (size_t)(row0 + k - 2) * 3072 + c0, win[k + 1]);
            else {
#pragma unroll
                for (int i = 0; i < 8; ++i) win[k + 1][i] = 0.f; } }
#pragma unroll 4
        for (int r = 0; r < 32; ++r) {
#pragma unroll
            for (int k = 0; k < 4; ++k)
#pragma unroll
                for (int i = 0; i < 8; ++i) win[k][i] = win[k + 1][i];
            const int tt = t0 + r + 2;
            if (tt < L) ld8(xpre + (size_t)(row0 + r + 2) * 3072 + c0, win[4]);
            else {
#pragma unroll
                for (int i = 0; i < 8; ++i) win[4][i] = 0.f; }
            float a[8];
#pragma unroll
            for (int i = 0; i < 8; ++i) { float v = bias[i];
#pragma unroll
                for (int k = 0; k < 5; ++k) v += win[k][i] * w[k][i];
                a[i] = v / (1.f + __expf(-v)); }
            st8(xbc + (size_t)(row0 + r) * 3072 + c0, a);
        }
    }
    for (int it = F.gw; it < 64 * 64; it += F.NGW) {
        const int ch = it >> 6, e = it & 63, dir = e >> 5, row0 = 128 * ch, lane = F.lane;
        const float aa = -expf(alog[e]), bb = dtb[e];
        const int i0 = dir == 0 ? lane : 127 - lane, i1 = dir == 0 ? lane + 64 : 63 - lane;
        const float d0 = softplus_f(dtraw[(size_t)(row0 + i0) * 64 + e] + bb), d1 = softplus_f(dtraw[(size_t)(row0 + i1) * 64 + e] + bb);
        float s0 = d0 * aa, s1 = d1 * aa;
#pragma unroll
        for (int o = 1; o < 64; o <<= 1) { const float u0 = __builtin_bit_cast(float, __builtin_amdgcn_ds_bpermute((lane - o) << 2, __builtin_bit_cast(int, s0))), u1 = __builtin_bit_cast(float, __builtin_amdgcn_ds_bpermute((lane - o) << 2, __builtin_bit_cast(int, s1)));
            if (lane >= o) { s0 += u0; s1 += u1; } }
        s1 += __builtin_bit_cast(float, __builtin_amdgcn_readlane(__builtin_bit_cast(int, s0), 63));
        dt[(size_t)(row0 + i0) * 64 + e] = d0; dt[(size_t)(row0 + i1) * 64 + e] = d1;
        acum[(size_t)(row0 + i0) * 64 + e] = s0; acum[(size_t)(row0 + i1) * 64 + e] = s1;
    }
}
__device__ __forceinline__ void rp_ssd_gate(Frame& F, const bf16* y, const bf16* z, const float* gn, bf16* yn) {
    for (int row = F.gw; row < T; row += F.NGW) {
#pragma unroll
        for (int g = 0; g < 4; ++g) { const int c0 = g * 512 + 8 * F.lane; float zz[8], v[8]; ld8(z + (size_t)row * 2048 + c0, zz);
            float yb[8]; ld8(y + (size_t)row * 2048 + c0, v); ld8(y + (size_t)(T + row) * 2048 + c0, yb);
#pragma unroll
            for (int i = 0; i < 8; ++i) v[i] += yb[i];
            float ss = 0.f;
#pragma unroll
            for (int i = 0; i < 8; ++i) { v[i] = v[i] * zz[i] / (1.f + __expf(-zz[i])); ss += v[i] * v[i]; }
            const float r = rsqrtf(wsum(ss, F.lane) * (1.f / 512) + EPS);
#pragma unroll
            for (int i = 0; i < 8; ++i) v[i] = v[i] * r * gn[c0 + i];
            st8(yn + (size_t)row * 2048 + c0, v); }
    }
}

typedef short a_bf16x8 __attribute__((ext_vector_type(8)));
typedef short a_s16x4 __attribute__((ext_vector_type(4)));
typedef float a_f32x16 __attribute__((ext_vector_type(16)));
typedef float a_f32x2 __attribute__((ext_vector_type(2))); typedef __bf16 a_bf16x2 __attribute__((ext_vector_type(2)));
__device__ __forceinline__ unsigned a_cvtpk(float lo, float hi) { a_f32x2 v = {lo, hi}; a_bf16x2 b = __builtin_convertvector(v, a_bf16x2); return __builtin_bit_cast(unsigned, b); }
__device__ __forceinline__ a_s16x4 a_vtr(const LAS unsigned char* p) { return __builtin_bit_cast(a_s16x4, __builtin_amdgcn_ds_read_tr16_b64_v4i16((LAS a_s16x4*)p)); }
constexpr int AT_KS = 208, AT_VS = 192, AT_KB = 64 * AT_KS, AT_VB = 64 * AT_VS, AT_VOFF = 2 * AT_KB;
__device__ __forceinline__ void at_tile(Frame& F, LAS unsigned char* lds, int buf, int lane, const a_bf16x8 (&qf)[6], a_f32x16& o0, a_f32x16& o1, float& m, float& l) {
    const int r32 = lane & 31, hi = lane >> 5;
    a_f32x16 p0, p1;
#pragma unroll
    for (int r = 0; r < 16; ++r) { p0[r] = 0.f; p1[r] = 0.f; }
    { const LAS unsigned char* kp = lds + buf * AT_KB + r32 * AT_KS + hi * 16;
#pragma unroll
      for (int s = 0; s < 6; ++s) { const a_bf16x8 a0 = *(const LAS a_bf16x8*)(kp + 32 * s), a1 = *(const LAS a_bf16x8*)(kp + 32 * AT_KS + 32 * s);
          p0 = __builtin_amdgcn_mfma_f32_32x32x16_bf16(a0, qf[s], p0, 0, 0, 0); p1 = __builtin_amdgcn_mfma_f32_32x32x16_bf16(a1, qf[s], p1, 0, 0, 0); } }

    float mx = fmaxf(p0[0], p1[0]);
#pragma unroll
    for (int r = 1; r < 16; ++r) mx = fmaxf(mx, fmaxf(p0[r], p1[r]));
    mx = fmaxf(mx, shx(mx, lane, 32));
    const float mn = fmaxf(m, mx), alpha = __builtin_amdgcn_exp2f(m - mn); m = mn;
    float ps = 0.f;
#pragma unroll
    for (int r = 0; r < 16; ++r) { p0[r] = __builtin_amdgcn_exp2f(p0[r] - mn); p1[r] = __builtin_amdgcn_exp2f(p1[r] - mn); ps += p0[r] + p1[r]; }
    l = l * alpha + ps;
#pragma unroll
    for (int r = 0; r < 16; ++r) { o0[r] *= alpha; o1[r] *= alpha; }
    v4u pw[4];
    pw[0] = (v4u){a_cvtpk(p0[0], p0[1]), a_cvtpk(p0[2], p0[3]), a_cvtpk(p0[4], p0[5]), a_cvtpk(p0[6], p0[7])};
    pw[1] = (v4u){a_cvtpk(p0[8], p0[9]), a_cvtpk(p0[10], p0[11]), a_cvtpk(p0[12], p0[13]), a_cvtpk(p0[14], p0[15])};
    pw[2] = (v4u){a_cvtpk(p1[0], p1[1]), a_cvtpk(p1[2], p1[3]), a_cvtpk(p1[4], p1[5]), a_cvtpk(p1[6], p1[7])};
    pw[3] = (v4u){a_cvtpk(p1[8], p1[9]), a_cvtpk(p1[10], p1[11]), a_cvtpk(p1[12], p1[13]), a_cvtpk(p1[14], p1[15])};

    const LAS unsigned char* vp0 = lds + AT_VOFF + buf * AT_VB + (4 * hi + ((lane & 15) >> 2)) * AT_VS + (16 * ((lane >> 4) & 1) + 4 * (lane & 3)) * 2;
    a_s16x4 vl0[4], vh0[4], vl1[4], vh1[4];
#pragma unroll
    for (int bs = 0; bs < 4; ++bs) { const LAS unsigned char* vq = vp0 + (16 * bs) * AT_VS; vl0[bs] = a_vtr(vq); vh0[bs] = a_vtr(vq + 8 * AT_VS); vl1[bs] = a_vtr(vq + 64); vh1[bs] = a_vtr(vq + 8 * AT_VS + 64); }
#pragma unroll
    for (int bs = 0; bs < 4; ++bs) {
        const a_bf16x8 v0 = (a_bf16x8){vl0[bs][0], vl0[bs][1], vl0[bs][2], vl0[bs][3], vh0[bs][0], vh0[bs][1], vh0[bs][2], vh0[bs][3]}, v1 = (a_bf16x8){vl1[bs][0], vl1[bs][1], vl1[bs][2], vl1[bs][3], vh1[bs][0], vh1[bs][1], vh1[bs][2], vh1[bs][3]};
        const a_bf16x8 pb = __builtin_bit_cast(a_bf16x8, pw[bs]);
        o0 = __builtin_amdgcn_mfma_f32_32x32x16_bf16(v0, pb, o0, 0, 0, 0); o1 = __builtin_amdgcn_mfma_f32_32x32x16_bf16(v1, pb, o1, 0, 0, 0); }
}
__device__ __forceinline__ void ph_attn(Frame& F, const bf16* Q, const bf16* K, const bf16* KV, bf16* AO) {
    const int lane = F.lane, r32 = lane & 31, hi = lane >> 5, wave = F.wave, tid = F.tid;
    LAS unsigned char* lds = F.lds;
    const int kr_a = tid / 12, kp_a = tid % 12, kr_b = (tid + 512) / 12, kp_b = (tid + 512) % 12, vr = tid >> 3, vp = tid & 7;
    const bool has_b = tid < 256;
    for (int uu = F.vcu; uu < 512; uu += F.G) {
        int head, q0, NT, kbase_ctx, kbase_lat;
        if (uu < 256) { const int seq = uu >> 4; head = uu & 15; q0 = seq * 256; NT = 4; kbase_ctx = seq * 256; kbase_lat = 0; }
        else { const int u2 = uu - 256, b = u2 >> 6, qb = u2 & 3; head = (u2 >> 2) & 15; q0 = TP + b * 1024 + qb * 256; NT = 20; kbase_ctx = T + b * 256; kbase_lat = TP + b * 1024; }
        a_bf16x8 qf[6];
        { const bf16* qp = Q + ((size_t)(q0 + wave * 32 + r32) * 16 + head) * 96 + hi * 8;
#pragma unroll
          for (int s = 0; s < 6; ++s) qf[s] = *(const GAS a_bf16x8*)(qp + 16 * s); }
        a_f32x16 o0, o1;
#pragma unroll
        for (int r = 0; r < 16; ++r) { o0[r] = 0.f; o1[r] = 0.f; }
        float m = -INFINITY, l = 0.f;
        v4u ka0, kb0, vv0, ka1, kb1, vv1;
#define AT_LOAD(t, KA, KB2, VV) do { const int kr0_ = (t) < 4 ? kbase_ctx + 64 * (t) : kbase_lat + 64 * ((t) - 4); \
            KA = *(const GAS v4u*)(K + ((size_t)(kr0_ + kr_a) * 16 + head) * 96 + kp_a * 8); \
            if (has_b) KB2 = *(const GAS v4u*)(K + ((size_t)(kr0_ + kr_b) * 16 + head) * 96 + kp_b * 8); \
            VV = *(const GAS v4u*)(KV + (size_t)(kr0_ + vr) * 2048 + head * 128 + 64 + vp * 8); } while (0)
#define AT_STORE(buf, KA, KB2, VV) do { *(LAS v4u*)(lds + (buf) * AT_KB + kr_a * AT_KS + kp_a * 16) = KA; \
            if (has_b) *(LAS v4u*)(lds + (buf) * AT_KB + kr_b * AT_KS + kp_b * 16) = KB2; \
            *(LAS v4u*)(lds + AT_VOFF + (buf) * AT_VB + vr * AT_VS + vp * 16) = VV; } while (0)
        AT_LOAD(0, ka0, kb0, vv0); AT_LOAD(1, ka1, kb1, vv1);
        AT_STORE(0, ka0, kb0, vv0);
        LDS_BARRIER();

#pragma unroll 1
        for (int t = 0; t < NT; t += 2) {
            if (t + 2 < NT) AT_LOAD(t + 2, ka0, kb0, vv0);
            at_tile(F, lds, 0, lane, qf, o0, o1, m, l);
            AT_STORE(1, ka1, kb1, vv1);
            LDS_BARRIER();
            if (t + 3 < NT) AT_LOAD(t + 3, ka1, kb1, vv1);
            at_tile(F, lds, 1, lane, qf, o0, o1, m, l);
            if (t + 2 < NT) AT_STORE(0, ka0, kb0, vv0);
            LDS_BARRIER();
        }
#undef AT_LOAD
#undef AT_STORE
        l += shx(l, lane, 32);
        const float il = 1.f / l;
        bf16* op = AO + (size_t)(q0 + wave * 32 + r32) * 1024 + head * 64 + 4 * hi;
#pragma unroll
        for (int g4 = 0; g4 < 4; ++g4) {
            v2u w0; w0.x = a_cvtpk(o0[4 * g4] * il, o0[4 * g4 + 1] * il); w0.y = a_cvtpk(o0[4 * g4 + 2] * il, o0[4 * g4 + 3] * il); *(GAS v2u*)(op + 8 * g4) = w0;
            v2u w1; w1.x = a_cvtpk(o1[4 * g4] * il, o1[4 * g4 + 1] * il); w1.y = a_cvtpk(o1[4 * g4 + 2] * il, o1[4 * g4 + 3] * il); *(GAS v2u*)(op + 32 + 8 * g4) = w1; }

    }
}
constexpr int SC_ST = 272, SC_XS = 144;
constexpr int SC_C = 0, SC_B = 128 * SC_ST, SC_M = 2 * 128 * SC_ST, SC_H = 3 * 128 * SC_ST, SC_X = SC_H + 64 * SC_ST, SC_XW = SC_X + 128 * SC_XS, SC_ARR = SC_XW + 128 * SC_XS;
static_assert(SC_ARR + 4 * 128 * 4 + 16 <= PTAB_OFF_C, "scan LDS map");
__device__ __forceinline__ int a_crow(int r, int hi) { return (r & 3) + 8 * (r >> 2) + 4 * hi; }
__device__ __forceinline__ void ph_scan(Frame& F, const bf16* xbc, const float* dt, const float* acg, const float* dsk, const float* st0, bf16* y, float* out) {
    const int lane = F.lane, r32 = lane & 31, hi = lane >> 5, wave = F.wave, tid = F.tid;
    LAS unsigned char* lds = F.lds;
    LAS float* acum = (LAS float*)(lds + SC_ARR); LAS float* wj = acum + 128; LAS float* ei = acum + 256; LAS float* dtj = acum + 384; LAS float* misc = acum + 512;
    const int q4 = (lane & 15) >> 2, gg = (lane >> 4) & 1, p4 = lane & 3;
    const int ib = wave >> 1, pb = wave & 1, nb = wave >> 1;
    for (int slot = F.vcu; slot < 256; slot += F.G) {
        const int nitem = slot < 128 ? 1 : 4;
#pragma unroll 1
        for (int ii = 0; ii < nitem; ++ii) {
            int seq, hd;
            if (slot < 128) { seq = 16 + (slot >> 5); hd = slot & 31; } else { const int pi = 4 * (slot - 128) + ii; seq = pi >> 5; hd = pi & 31; }
            const int g = hd >> 3, r0 = seq < 16 ? seq * 256 : TP + (seq - 16) * 1024, nc = seq < 16 ? 2 : 8;
#pragma unroll 1
            for (int dir = 0; dir < 2; ++dir) {
                const float dd = dsk[dir * 32 + hd];
                a_f32x16 hacc;
                if (seq < 16) {
#pragma unroll
                    for (int r = 0; r < 16; ++r) hacc[r] = 0.f;
                } else { const float* s0 = st0 + ((((size_t)(seq - 16) * 2 + dir) * 32 + hd) * 64 + 32 * pb + r32) * 128 + 32 * nb + 4 * hi;
#pragma unroll
                    for (int g4 = 0; g4 < 4; ++g4) { const v4f t4 = *(const GAS v4f*)(s0 + 8 * g4); hacc[4 * g4] = t4.x; hacc[4 * g4 + 1] = t4.y; hacc[4 * g4 + 2] = t4.z; hacc[4 * g4 + 3] = t4.w; } }
#pragma unroll
                for (int g4 = 0; g4 < 4; ++g4) { v2u w; w.x = a_cvtpk(hacc[4 * g4], hacc[4 * g4 + 1]); w.y = a_cvtpk(hacc[4 * g4 + 2], hacc[4 * g4 + 3]);
                    *(LAS v2u*)(lds + SC_H + (32 * pb + r32) * SC_ST + (32 * nb + 8 * g4 + 4 * hi) * 2) = w; }
                v4u cr[4], br[4], xr[2];
#define SC_GLOAD(c_) do { const int row0_ = r0 + (c_) * 128; \
                    _Pragma("unroll") for (int k = 0; k < 4; ++k) { const int q = tid + 512 * k, rr = q >> 4, pp = q & 15; \
                        cr[k] = *(const GAS v4u*)(xbc + (size_t)(row0_ + rr) * 3072 + 2560 + g * 128 + pp * 8); br[k] = *(const GAS v4u*)(xbc + (size_t)(row0_ + rr) * 3072 + 2048 + g * 128 + pp * 8); } \
                    _Pragma("unroll") for (int k = 0; k < 2; ++k) { const int q = tid + 512 * k, rr = q >> 3, pp = q & 7; xr[k] = *(const GAS v4u*)(xbc + (size_t)(row0_ + rr) * 3072 + hd * 64 + pp * 8); } } while (0)
                SC_GLOAD(dir == 0 ? 0 : nc - 1);
#pragma unroll 1
                for (int cc = 0; cc < nc; ++cc) {
                    const int c = dir == 0 ? cc : nc - 1 - cc, row0 = r0 + c * 128;
                    const int e = dir * 32 + hd;
                    const float last = acg[(size_t)(row0 + (dir == 0 ? 127 : 0)) * 64 + e];
                    LDS_BARRIER();
                    if (tid < 128) { const float ac = acg[(size_t)(row0 + tid) * 64 + e], dv = dt[(size_t)(row0 + tid) * 64 + e];
                        acum[tid] = ac; dtj[tid] = dv; ei[tid] = __expf(ac); if (tid == 0) misc[0] = __expf(last); }
#pragma unroll
                    for (int k = 0; k < 4; ++k) { const int q = tid + 512 * k, rr = q >> 4, pp = q & 15; *(LAS v4u*)(lds + SC_C + rr * SC_ST + pp * 16) = cr[k]; *(LAS v4u*)(lds + SC_B + rr * SC_ST + pp * 16) = br[k]; }
#pragma unroll
                    for (int k = 0; k < 2; ++k) { const int q = tid + 512 * k, rr = q >> 3, pp = q & 7; *(LAS v4u*)(lds + SC_X + rr * SC_XS + pp * 16) = xr[k];
                        const float w = dt[(size_t)(row0 + rr) * 64 + e] * __expf(last - acg[(size_t)(row0 + rr) * 64 + e]);
                        v4u s; s.x = a_cvtpk(bflo(xr[k].x) * w, bfhi(xr[k].x) * w); s.y = a_cvtpk(bflo(xr[k].y) * w, bfhi(xr[k].y) * w); s.z = a_cvtpk(bflo(xr[k].z) * w, bfhi(xr[k].z) * w); s.w = a_cvtpk(bflo(xr[k].w) * w, bfhi(xr[k].w) * w);
                        *(LAS v4u*)(lds + SC_XW + rr * SC_XS + pp * 16) = s; }
                    if (cc + 1 < nc) SC_GLOAD(dir == 0 ? cc + 1 : nc - 2 - cc);
                    LDS_BARRIER();
#pragma unroll 1
                    for (int tt = 0; tt < 2; ++tt) {
                        int lt = tt == 0 ? wave : (wave < 2 ? 8 + wave : 10 + (wave - 2));
                        const int ta = lt == 0 ? 0 : lt == 1 ? 0 : lt == 2 ? 0 : lt == 3 ? 0 : lt == 4 ? 1 : lt == 5 ? 1 : lt == 6 ? 1 : lt == 7 ? 2 : lt == 8 ? 2 : lt == 9 ? 3 : lt == 10 ? 1 : lt == 11 ? 2 : lt == 12 ? 2 : lt == 13 ? 3 : lt == 14 ? 3 : 3;
                        const int tb = lt == 0 ? 0 : lt == 1 ? 1 : lt == 2 ? 2 : lt == 3 ? 3 : lt == 4 ? 1 : lt == 5 ? 2 : lt == 6 ? 3 : lt == 7 ? 2 : lt == 8 ? 3 : lt == 9 ? 3 : lt == 10 ? 0 : lt == 11 ? 0 : lt == 12 ? 1 : lt == 13 ? 0 : lt == 14 ? 1 : 2;
                        const int jb = dir == 0 ? ta : tb, ibg = dir == 0 ? tb : ta;
                        const bool dead = lt >= 10;
                        a_f32x16 gt;
#pragma unroll
                        for (int r = 0; r < 16; ++r) gt[r] = 0.f;
                        if (!dead) {
                            const LAS unsigned char* ap = lds + SC_B + (32 * jb + r32) * SC_ST + hi * 16; const LAS unsigned char* bp = lds + SC_C + (32 * ibg + r32) * SC_ST + hi * 16;
#pragma unroll
                            for (int s = 0; s < 8; ++s) gt = __builtin_amdgcn_mfma_f32_32x32x16_bf16(*(const LAS a_bf16x8*)(ap + 32 * s), *(const LAS a_bf16x8*)(bp + 32 * s), gt, 0, 0, 0);
                            const int i = 32 * ibg + r32; const float ai = acum[i];
                            v4f aj[4], dj[4];
#pragma unroll
                            for (int g4 = 0; g4 < 4; ++g4) { aj[g4] = *(const LAS v4f*)(acum + 32 * jb + 8 * g4 + 4 * hi); dj[g4] = *(const LAS v4f*)(dtj + 32 * jb + 8 * g4 + 4 * hi); }
#pragma unroll
                            for (int r = 0; r < 16; ++r) { const int j = 32 * jb + a_crow(r, hi); const bool keep = dir == 0 ? j <= i : j >= i;
                                const float e = __builtin_amdgcn_exp2f(fminf(ai - aj[r >> 2][r & 3], 0.f) * 1.4426950408889634f) * dj[r >> 2][r & 3];
                                gt[r] = keep ? gt[r] * e + (j == i ? dd : 0.f) : 0.f; }
                        }
#pragma unroll
                        for (int g4 = 0; g4 < 4; ++g4) { v2u w; w.x = a_cvtpk(gt[4 * g4], gt[4 * g4 + 1]); w.y = a_cvtpk(gt[4 * g4 + 2], gt[4 * g4 + 3]);
                            *(LAS v2u*)(lds + SC_M + (32 * ibg + r32) * SC_ST + (32 * jb + 8 * g4 + 4 * hi) * 2) = w; }
                    }
                    a_f32x16 yo;
#pragma unroll
                    for (int r = 0; r < 16; ++r) yo[r] = 0.f;
                    { const LAS unsigned char* ap = lds + SC_C + (32 * ib + r32) * SC_ST + hi * 16; const LAS unsigned char* bp = lds + SC_H + (32 * pb + r32) * SC_ST + hi * 16;
#pragma unroll
                      for (int s = 0; s < 8; ++s) yo = __builtin_amdgcn_mfma_f32_32x32x16_bf16(*(const LAS a_bf16x8*)(ap + 32 * s), *(const LAS a_bf16x8*)(bp + 32 * s), yo, 0, 0, 0); }
                    LDS_BARRIER();
                    a_f32x16 yd;
#pragma unroll
                    for (int r = 0; r < 16; ++r) yd[r] = 0.f;
                    { const LAS unsigned char* ap = lds + SC_M + (32 * ib + r32) * SC_ST + hi * 16; const LAS unsigned char* xp = lds + SC_X + (8 * hi + q4) * SC_XS + (32 * pb + 16 * gg + 4 * p4) * 2;
#pragma unroll
                      for (int s = 0; s < 8; ++s) { const a_s16x4 l0 = a_vtr(xp + (16 * s) * SC_XS), h0 = a_vtr(xp + (16 * s + 4) * SC_XS);
                          const a_bf16x8 xb = (a_bf16x8){l0[0], l0[1], l0[2], l0[3], h0[0], h0[1], h0[2], h0[3]};
                          yd = __builtin_amdgcn_mfma_f32_32x32x16_bf16(*(const LAS a_bf16x8*)(ap + 32 * s), xb, yd, 0, 0, 0); } }
                    { bf16* yp = y + (size_t)dir * T * 2048 + (size_t)(row0 + 32 * ib) * 2048 + hd * 64 + 32 * pb + r32;
                      v4f e4[4];
#pragma unroll
                      for (int g4 = 0; g4 < 4; ++g4) e4[g4] = *(const LAS v4f*)(ei + 32 * ib + 8 * g4 + 4 * hi);
#pragma unroll
                      for (int r = 0; r < 16; ++r) { const int i = a_crow(r, hi); const float v = yd[r] + e4[r >> 2][r & 3] * yo[r]; yp[(size_t)i * 2048] = (bf16)f2bf(v); } }
                    { const float dec = misc[0];
#pragma unroll
                      for (int r = 0; r < 16; ++r) hacc[r] *= dec;
                      const LAS unsigned char* bq = lds + SC_B + (8 * hi + q4) * SC_ST + (32 * nb + 16 * gg + 4 * p4) * 2; const LAS unsigned char* xq = lds + SC_XW + (8 * hi + q4) * SC_XS + (32 * pb + 16 * gg + 4 * p4) * 2;
#pragma unroll
                      for (int s = 0; s < 8; ++s) { const a_s16x4 bl = a_vtr(bq + (16 * s) * SC_ST), bh = a_vtr(bq + (16 * s + 4) * SC_ST), xl = a_vtr(xq + (16 * s) * SC_XS), xh = a_vtr(xq + (16 * s + 4) * SC_XS);
                          const a_bf16x8 av = (a_bf16x8){bl[0], bl[1], bl[2], bl[3], bh[0], bh[1], bh[2], bh[3]}, bv = (a_bf16x8){xl[0], xl[1], xl[2], xl[3], xh[0], xh[1], xh[2], xh[3]};
                          hacc = __builtin_amdgcn_mfma_f32_32x32x16_bf16(av, bv, hacc, 0, 0, 0); } }
#pragma unroll
                    for (int g4 = 0; g4 < 4; ++g4) { v2u w; w.x = a_cvtpk(hacc[4 * g4], hacc[4 * g4 + 1]); w.y = a_cvtpk(hacc[4 * g4 + 2], hacc[4 * g4 + 3]);
                        *(LAS v2u*)(lds + SC_H + (32 * pb + r32) * SC_ST + (32 * nb + 8 * g4 + 4 * hi) * 2) = w; }
                }
                if (seq < 16) { float* o = out + OUT_SSM + ((((size_t)seq * 2 + dir) * 32 + hd) * 64 + 32 * pb + r32) * 128 + 32 * nb + 4 * hi;
#pragma unroll
                    for (int g4 = 0; g4 < 4; ++g4) { v4f t4; t4.x = hacc[4 * g4]; t4.y = hacc[4 * g4 + 1]; t4.z = hacc[4 * g4 + 2]; t4.w = hacc[4 * g4 + 3]; *(GAS v4f*)(o + 8 * g4) = t4; } }
            }
        }
    }
#undef SC_GLOAD
    LDS_BARRIER();
}

constexpr int NPHASE = 30;
enum Op { OP_P0, OP_NORM1, OP_G_LAT, OP_FIN1, OP_G_QKV, OP_FIN2, OP_ATTN, OP_G_WO, OP_NORM2, OP_G_FF1, OP_G_FF2, OP_G_PW1, OP_DWCONV, OP_G_PW2, OP_G_SSI, OP_SSCONV, OP_SCAN, OP_GATE, OP_G_SSO };
__device__ __forceinline__ void phase_decode(int ph, int& layer, int& op) {
    if (ph == 0) { layer = 0; op = OP_P0; return; }
    if (ph <= 9) { layer = 0; const int r = ph - 1; op = r == 0 ? OP_NORM1 : r == 1 ? OP_G_LAT : r == 2 ? OP_FIN1 : r == 3 ? OP_G_QKV : r == 4 ? OP_FIN2 : r == 5 ? OP_ATTN : r == 6 ? OP_G_WO : r == 7 ? OP_G_FF1 : OP_G_FF2; }
    else if (ph <= 14) { layer = 1; const int r = ph - 10; op = r == 0 ? OP_G_PW1 : r == 1 ? OP_DWCONV : r == 2 ? OP_G_PW2 : r == 3 ? OP_G_FF1 : OP_G_FF2; }
    else if (ph <= 21) { layer = 2; const int r = ph - 15; op = r == 0 ? OP_G_SSI : r == 1 ? OP_SSCONV : r == 2 ? OP_SCAN : r == 3 ? OP_GATE : r == 4 ? OP_G_SSO : r == 5 ? OP_G_FF1 : OP_G_FF2; }
    else { layer = 3; const int r = ph - 22; op = r == 0 ? OP_G_LAT : r == 1 ? OP_FIN1 : r == 2 ? OP_G_QKV : r == 3 ? OP_FIN2 : r == 4 ? OP_ATTN : r == 5 ? OP_G_WO : r == 6 ? OP_G_FF1 : OP_G_FF2; }
}
struct MArgs { const float* in[38]; float* out; unsigned char* ws; int ph_lo, ph_hi; };
constexpr int PTAB_OFF = PTAB_OFF_C;
__global__ void __launch_bounds__(NTHR, 2) mega_fwd(MArgs args) {
    extern __shared__ __attribute__((aligned(16))) unsigned char lds_raw[];
    LAS unsigned char* lds = (LAS unsigned char*)lds_raw;
    volatile LAS unsigned* PT0 = (volatile LAS unsigned*)(lds + PTAB_OFF);
    volatile LAS unsigned* MISC = (volatile LAS unsigned*)(lds + MISC_OFF);
    { const int t0 = threadIdx.x;
      if (t0 < 40) { const unsigned long long p = t0 < 38 ? (unsigned long long)args.in[t0] : t0 == 38 ? (unsigned long long)args.out : (unsigned long long)args.ws;
          PT0[2 * t0] = (unsigned)p; PT0[2 * t0 + 1] = (unsigned)(p >> 32); }
      if (t0 < 64) MISC[t0] = 0u; }
    __syncthreads();
    XcdBarrier bar = xcd_barrier_post((unsigned*)((unsigned char*)ldp(PT0, PT_WS) + WS_CTL) + CW_BAR, MISC + 8);
    const int wave0 = __builtin_amdgcn_readfirstlane(threadIdx.x >> 6);
    const int ph_hi = args.ph_hi;
    for (int ph = args.ph_lo; ph < ph_hi; ++ph) {
        Frame F;
        { int w = wave0; asm volatile("" : "+s"(w)); F.wave = w; }
        F.lds = lds; F.lane = olane(); F.tid = F.wave * 64 + F.lane;
        const int bx = obid();
        F.G = gridDim.x; F.vcu = (F.G % 8 == 0) ? (bx % 8) * (F.G / 8) + bx / 8 : bx;
        F.gw = F.vcu * NWAVES + F.wave; F.NGW = F.G * NWAVES; F.PT = PT0; F.bx = bx;
        int layer, op; phase_decode(ph, layer, op);
        const int j = layer / 3;
        switch (op) {
        case OP_P0: p0_prologue(F); break;
        case OP_NORM1: { unsigned char* ws = WSP; float* x = OUTP; const float* xlo = layer == 0 ? INP(I_XP) : x; const float* xhi = layer == 0 ? INP(I_XS) - (size_t)TP * 1024 : x;
            rp_normmod(F, xlo, xhi, INP(I_GN1) + layer * 1024, (const float*)(ws + WS_MODS) + (size_t)layer * 5 * 6144, 0, 1024, (bf16*)(ws + WS_H)); rp_tables(F); } break;
        case OP_NORM2: { unsigned char* ws = WSP; float* x = OUTP;
            rp_normmod(F, x, x, INP(I_GN2) + layer * 1024, (const float*)(ws + WS_MODS) + (size_t)layer * 5 * 6144, 3072, 4096, (bf16*)(ws + WS_H)); } break;
        case OP_G_LAT: { unsigned char* ws = WSP; pg8::Gemm g{(const bf16*)(ws + WS_H), (const bf16*)(ws + W_MLA + j * MLA_WB + MW_CAT), T, 768, 1024}; pg8::StaticOrder S; S.init(T, 2 * 768, F.G, F.bx);
            const int s_ = 2 * layer; pg8::EpiF32<1> E{(float*)(ws + A_LAT), 768, layer == 0 ? nullptr : (const float*)(ws + WS_STAT) + s_ * 8192, layer == 0 ? nullptr : (const float*)(ws + WS_SW) + (size_t)s_ * 5 * 5632}; pg8::gemm_phase<pg8::EpiF32<1>, pg8::StaticOrder, true, true, true>(F.lds, g, S, E, F.wave); } break;
        case OP_FIN1: { unsigned char* ws = WSP; rp_mla_fin1(F, (const float*)(ws + A_LAT), INP(I_GQ) + j * 384, INP(I_GKV) + j * 256, (bf16*)(ws + A_QN), (bf16*)(ws + WS_CKV + j * CKV_B), OUTP, j); } break;
        case OP_G_QKV: {
#pragma unroll 1
            for (int w = 0; w < 2; ++w) {
                unsigned char* ws = WSP; unsigned char* wm = ws + W_MLA + j * MLA_WB;
                pg8::Gemm g = w == 0 ? pg8::Gemm{(const bf16*)(ws + A_QN), (const bf16*)(wm + MW_UQ), T, 1536, 384} : pg8::Gemm{(const bf16*)(ws + WS_CKV + j * CKV_B), (const bf16*)(wm + MW_UKV), T + NCTX, 2048, 256};
                pg8::StaticOrder S; S.init(g.M, g.N, F.G, w == 0 ? F.bx : (int)((F.bx + 64) % F.G));
                pg8::EpiBf16P E{w == 0 ? (bf16*)(ws + A_QRAW) : (bf16*)(ws + A_KVRAW), g.N};
                pg8::gemm_phase<pg8::EpiBf16P, pg8::StaticOrder, true, true>(F.lds, g, S, E, F.wave);
            } } break;
        case OP_FIN2: { unsigned char* ws = WSP; rp_mla_fin2(F, (const bf16*)(ws + A_QRAW), (const bf16*)(ws + A_KVRAW), (const float*)(ws + A_LAT), INP(I_CKPE) + (size_t)j * 8192, INP(I_GQN) + j * 96, INP(I_GKN) + j * 96,
                                                        (const float*)(ws + WS_ROPE), (bf16*)(ws + A_QB), (bf16*)(ws + A_KB)); } break;
        case OP_ATTN: { unsigned char* ws = WSP; ph_attn(F, (const bf16*)(ws + A_QB), (const bf16*)(ws + A_KB), (const bf16*)(ws + A_KVRAW), (bf16*)(ws + A_AO)); } break;
        case OP_G_WO: case OP_G_PW2: case OP_G_SSO: case OP_G_FF2: {
            unsigned char* ws = WSP; float* x = OUTP;
            const float* rlo = (layer == 0 && op != OP_G_FF2) ? INP(I_XP) : x; const float* rhi = (layer == 0 && op != OP_G_FF2) ? INP(I_XS) - (size_t)TP * 1024 : x;
            pg8::Gemm g; const float* bias = nullptr; int goff = 2048;
            if (op == OP_G_WO) g = pg8::Gemm{(const bf16*)(ws + A_AO), (const bf16*)(ws + W_MLA + j * MLA_WB + MW_O), T, 1024, 1024};
            else if (op == OP_G_PW2) { g = pg8::Gemm{(const bf16*)(ws + A_V), (const bf16*)(ws + W_CV2), T, 1024, 1024}; bias = INP(I_CVB2); }
            else if (op == OP_G_SSO) g = pg8::Gemm{(const bf16*)(ws + A_YN), (const bf16*)(ws + W_SSO), T, 1024, 2048};
            else { g = pg8::Gemm{(const bf16*)(ws + A_ACT), (const bf16*)(ws + W_FF + layer * FF_WB + FW_OUT), T, 1024, 2816}; goff = 5120; }
            pg8::StaticOrder S; S.init(T, 2 * 1024, F.G, F.bx);
            float* xdst = x;
            const int sn_ = 2 * layer + (op == OP_G_FF2 ? 2 : 1);
            pg8::EpiResid<1> E{rlo, rhi, xdst, (const float*)(ws + WS_MODS) + (size_t)layer * 5 * 6144, goff, bias,
                               sn_ < 8 ? (bf16*)(ws + WS_H) : nullptr, (const float*)(ws + WS_GT) + (size_t)(sn_ & 7) * 5 * 1024, (float*)(ws + WS_STAT) + (sn_ & 7) * 8192};
            pg8::gemm_phase<pg8::EpiResid<1>, pg8::StaticOrder, true, true, true>(F.lds, g, S, E, F.wave); } break;
        case OP_G_FF1: { unsigned char* ws = WSP; pg8::Gemm g{(const bf16*)(ws + WS_H), (const bf16*)(ws + W_FF + layer * FF_WB + FW_IN), T, 5632, 1024}; pg8::StaticOrder S; S.init(T, 5632, F.G, F.bx);
            const int s_ = 2 * layer + 1; pg8::EpiGlu<0> E{(bf16*)(ws + A_ACT), 2816, nullptr, 2816, (const float*)(ws + WS_STAT) + s_ * 8192, (const float*)(ws + WS_SW) + (size_t)s_ * 5 * 5632}; pg8::gemm_phase<pg8::EpiGlu<0>, pg8::StaticOrder, true, true>(F.lds, g, S, E, F.wave); } break;
        case OP_G_PW1: { unsigned char* ws = WSP; pg8::Gemm g{(const bf16*)(ws + WS_H), (const bf16*)(ws + W_CV1), T, 2048, 1024}; pg8::StaticOrder S; S.init(T, 2048, F.G, F.bx);
            const int s_ = 2 * layer; pg8::EpiGlu<1> E{(bf16*)(ws + A_U), 1024, INP(I_CVB1), 1024, (const float*)(ws + WS_STAT) + s_ * 8192, (const float*)(ws + WS_SW) + (size_t)s_ * 5 * 5632}; pg8::gemm_phase<pg8::EpiGlu<1>, pg8::StaticOrder, true, true>(F.lds, g, S, E, F.wave); } break;
        case OP_DWCONV: { unsigned char* ws = WSP; rp_dwconv(F, (const bf16*)(ws + A_U), INP(I_CVWD), INP(I_CVBD), INP(I_CVGL), INP(I_CVBL), (bf16*)(ws + A_V)); } break;
        case OP_G_SSI: { unsigned char* ws = WSP; pg8::Gemm g{(const bf16*)(ws + WS_H), (const bf16*)(ws + W_SSI), T, 5376, 1024}; pg8::StaticOrder S; S.init(T, 5376, F.G, F.bx);
            const int s_ = 2 * layer; pg8::EpiSsdIn E{(bf16*)(ws + A_Z), (bf16*)(ws + A_XPRE), (float*)(ws + A_DTRAW), (const float*)(ws + WS_STAT) + s_ * 8192, (const float*)(ws + WS_SW) + (size_t)s_ * 5 * 5632}; pg8::gemm_phase<pg8::EpiSsdIn, pg8::StaticOrder, true, true>(F.lds, g, S, E, F.wave); } break;
        case OP_SSCONV: { unsigned char* ws = WSP; rp_ssd_conv(F, (const bf16*)(ws + A_XPRE), (const float*)(ws + A_DTRAW), INP(I_SSWC), INP(I_SSBC), INP(I_SSDTB), INP(I_SSAL), (bf16*)(ws + A_XBC), (float*)(ws + A_DT), (float*)(ws + A_ACUM)); } break;
        case OP_SCAN: { unsigned char* ws = WSP; ph_scan(F, (const bf16*)(ws + A_XBC), (const float*)(ws + A_DT), (const float*)(ws + A_ACUM), INP(I_SSD), INP(I_SSM), (bf16*)(ws + A_Y), OUTP); } break;
        case OP_GATE: { unsigned char* ws = WSP; rp_ssd_gate(F, (const bf16*)(ws + A_Y), (const bf16*)(ws + A_Z), INP(I_SSGN), (bf16*)(ws + A_YN)); } break;
        default: break;
        }

        if (ph + 1 < ph_hi) xcd_barrier(bar);

    }
}

extern "C" void kernel_launch(void* const* d_in, const int* in_sizes, int n_in, void* d_out, int out_size, void* d_ws, size_t ws_size, hipStream_t stream) {
    static int grid = 0;
    if (grid == 0) {
        int dev = 0, cus = 0;
        if (hipGetDevice(&dev) != hipSuccess || hipDeviceGetAttribute(&cus, hipDeviceAttributeMultiprocessorCount, dev) != hipSuccess) { fprintf(stderr, "kernel_launch: device query failed\n"); grid = -1; return; }
        if (hipFuncSetAttribute((const void*)mega_fwd, hipFuncAttributeMaxDynamicSharedMemorySize, LDS_BYTES) != hipSuccess) { fprintf(stderr, "kernel_launch: hipFuncSetAttribute failed\n"); grid = -1; return; }
        (void)hipGetLastError();
        grid = cus;
    }
    if (grid < 0) return;
    (void)hipMemsetAsync((char*)d_ws + WS_CTL, 0, CTL_ZERO_BYTES, stream);
    MArgs a{};
    for (int i = 0; i < 38; ++i) a.in[i] = (const float*)d_in[i];
    a.out = (float*)d_out; a.ws = (unsigned char*)d_ws;
    a.ph_lo = 0; a.ph_hi = NPHASE;
    hipLaunchKernelGGL(mega_fwd, dim3(grid), dim3(NTHR), LDS_BYTES, stream, a);
}
```

```cpp
#include <hip/hip_runtime.h>
#include <cstdint>
#include <cstdio>

constexpr int DM = 1024, T = 8192, TP = 4096;
constexpr int NCTX = 1024;
constexpr int QL = 384, KVL = 256, ROPE = 32, NOPE = 64, QKD = 96, VH = 64, NH = 16;
constexpr int FFH = 2816;
constexpr int SSI = 2048, SSH = 32, SSP = 64, SSN = 128, SSG = 4, SSCD = 3072, SSIN = 5184;
constexpr float EPS = 1e-6f;
constexpr size_t OUT_YP = 0, OUT_CKV = 8388608, OUT_KPE = 10485760, OUT_SSM = 10747904;

__device__ __forceinline__ int cond_of_row(int r) { return r < TP ? 0 : 1 + ((r - TP) >> 10); }
__device__ __forceinline__ void row_pos(int r, int& t, int& L) { if (r < TP) { t = r & 255; L = 256; } else { t = (r - TP) & 1023; L = 1024; } }
__device__ __forceinline__ float softplus_f(float x) { return fmaxf(x, 0.f) + log1pf(expf(-fabsf(x))); }

__device__ __forceinline__ float rope_inv(int i) { return i == 0 ? 1.f : i == 1 ? 0.31622776601683794f : i == 2 ? 0.1f : i == 3 ? 0.031622776601683794f : i == 4 ? 0.01f : i == 5 ? 0.0031622776601683794f : i == 6 ? 0.001f : 0.00031622776601683794f; }

__device__ __forceinline__ int olane() { int l; asm volatile("v_mbcnt_lo_u32_b32 %0, -1, 0\n\tv_mbcnt_hi_u32_b32 %0, -1, %0" : "=v"(l)); return l; }
__device__ __forceinline__ int obid() { int b = blockIdx.x; asm volatile("" : "+s"(b)); return b; }
namespace pg8 {
#define PG8_LAS __attribute__((address_space(3)))
typedef unsigned short bf16_t;
typedef short bf16x8 __attribute__((ext_vector_type(8)));
typedef float f32x4 __attribute__((ext_vector_type(4)));
typedef unsigned u32x4 __attribute__((ext_vector_type(4)));
constexpr int BM = 256, BK = 64, HALF = 128, HTB = HALF * BK * 2  , STAGE_BYTES = 8 * HTB, NXCD = 8, WGM = 8;

__host__ __device__ __forceinline__ int lds_byte(int r, int c) { const int st = (r >> 4) * 2 + (c >> 5), rr = r & 15, cc = c & 31, ob = rr * 64 + cc * 2; return st * 1024 + (ob ^ (((ob >> 9) & 1) << 5)); }
__host__ __device__ __forceinline__ void stage_rc(int b, int& R, int& C) { const int st = b / 1024, sb = b % 1024, swz = sb ^ (((sb >> 9) & 1) << 5); R = (st >> 1) * 16 + swz / 64; C = (st & 1) * 32 + (swz % 64) / 2; }
__host__ __device__ __forceinline__ int perm32(int rho) { const int n = rho >> 4, i = rho & 15; return 8 * (i >> 2) + 4 * n + (i & 3); }

struct Unit { int pm, pn; };
struct Gemm { const bf16_t* A; const bf16_t* Bt; int M, N, K; };

struct StaticOrder {
    int nM, nN, nwg, G, c;
    __host__ __device__ void init(int M, int N, int G_, int c_) { nM = M / BM; nN = N / BM; nwg = nM * nN; G = G_; c = c_; }
    __host__ __device__ bool next(int i, Unit& u) const {
        const long L = (long)i * G + c; if (L >= nwg) return false;
        int wgid = (int)L; { const int q = nwg / NXCD, r = nwg % NXCD, xcd = wgid % NXCD, off = wgid / NXCD; wgid = (xcd < r ? xcd * (q + 1) : r * (q + 1) + (xcd - r) * q) + off; }
        const int nig = WGM * nN, gid = wgid / nig, fm = gid * WGM, gsz = (nM - fm) < WGM ? (nM - fm) : WGM;
        u.pm = fm + ((wgid % nig) % gsz); u.pn = (wgid % nig) / gsz; return true;
    }
    __device__ __forceinline__ void a_ready(const Unit&) const {}
    __device__ __forceinline__ void done(const Unit&) const {}
};
__device__ __forceinline__ unsigned cvt_pk_bf16(float lo, float hi) { unsigned r; asm volatile("v_cvt_pk_bf16_f32 %0, %1, %2" : "=v"(r) : "v"(lo), "v"(hi)); return r; }
typedef unsigned u32x2 __attribute__((ext_vector_type(2)));
#define PG8_GAS __attribute__((address_space(1)))
__device__ __forceinline__ void st16(void* p, u32x4 v) { *(PG8_GAS u32x4*)p = v; }
__device__ __forceinline__ void st16f(void* p, f32x4 v) { *(PG8_GAS f32x4*)p = v; }
__device__ __forceinline__ void st8(void* p, u32x2 v) { *(PG8_GAS u32x2*)p = v; }
__device__ __forceinline__ f32x4 ld16f(const float* p) { return *(const PG8_GAS f32x4*)p; }
__device__ __forceinline__ float ld4f(const float* p) { return *(const PG8_GAS float*)p; }
__device__ __forceinline__ float fast_sigmoid(float x) { return __builtin_amdgcn_rcpf(1.f + __builtin_amdgcn_exp2f(-1.4426950408889634f * x)); }

constexpr int SW_LD = 5632;
__device__ __forceinline__ int cond_of_pm(int pm) { return pm < 16 ? 0 : 1 + ((pm - 16) >> 2); }
template <int NBJ> struct EpiF32 {
    static constexpr bool PERM = false, AFTER_DRAIN = false;
    float* C; int ldc; const float* rstat; const float* sw;
    __device__ __forceinline__ void operator()(const f32x4 (&acc)[2][2][4][2], const Unit& u, int wr_, int wc_, int fr_, int fq_) const {
        const int t_ = olane(), wr = wr_, wc = wc_, fr = t_ & 15, fq = t_ >> 4; (void)fr_; (void)fq_;
        const int row0 = u.pm * BM + wr * 64 + fr, col0 = u.pn * (HALF * NBJ) + wc * 32 + 4 * fq;
#pragma unroll
        for (int ai = 0; ai < 2; ++ai)
#pragma unroll
            for (int m = 0; m < 4; ++m) { float* rowp = C + (size_t)(row0 + ai * HALF + m * 16) * ldc + col0;
                const float rs = rstat ? __builtin_amdgcn_rsqf(ld4f(rstat + row0 + ai * HALF + m * 16) * (1.f / 1024) + 1e-6f) : 1.f; const float* swp = sw ? sw + (size_t)cond_of_pm(u.pm) * SW_LD + col0 : nullptr;
#pragma unroll
                for (int bj = 0; bj < NBJ; ++bj)
#pragma unroll
                    for (int n = 0; n < 2; ++n) { f32x4 v = acc[ai][bj][m][n] * rs; if (swp) v += ld16f(swp + bj * HALF + n * 16); st16f(rowp + bj * HALF + n * 16, v); } }
    }
};
struct EpiBf16P {
    static constexpr bool PERM = true, AFTER_DRAIN = false;
    bf16_t* O; int ldc;
    __device__ __forceinline__ void operator()(const f32x4 (&acc)[2][2][4][2], const Unit& u, int wr_, int wc_, int fr_, int fq_) const {
        const int t_ = olane(), wr = wr_, wc = wc_, fr = t_ & 15, fq = t_ >> 4; (void)fr_; (void)fq_;
        const int row0 = u.pm * BM + wr * 64 + fr, col0 = u.pn * BM + wc * 32 + 8 * fq;
#pragma unroll
        for (int ai = 0; ai < 2; ++ai)
#pragma unroll
            for (int m = 0; m < 4; ++m) { bf16_t* rowp = O + (size_t)(row0 + ai * HALF + m * 16) * ldc + col0;
#pragma unroll
                for (int bj = 0; bj < 2; ++bj) { const f32x4 v0 = acc[ai][bj][m][0], v1 = acc[ai][bj][m][1]; u32x4 w;
                    w.x = cvt_pk_bf16(v0[0], v0[1]); w.y = cvt_pk_bf16(v0[2], v0[3]); w.z = cvt_pk_bf16(v1[0], v1[1]); w.w = cvt_pk_bf16(v1[2], v1[3]);
                    st16(rowp + bj * HALF, w); } }
    }
};
struct EpiSsdIn {
    static constexpr bool PERM = true, AFTER_DRAIN = false;
    bf16_t* Z; bf16_t* XP; float* DT; const float* rstat; const float* sw;
    __device__ __forceinline__ void operator()(const f32x4 (&acc)[2][2][4][2], const Unit& u, int wr_, int wc_, int fr_, int fq_) const {
        const int t_ = olane(), wr = wr_, wc = wc_, fr = t_ & 15, fq = t_ >> 4; (void)fr_; (void)fq_;
        const int row0 = u.pm * BM + wr * 64 + fr;
        const float* swp = sw + (size_t)cond_of_pm(u.pm) * SW_LD + u.pn * BM + wc * 32 + 8 * fq;
        if (u.pn < 20) {
            bf16_t* base = u.pn < 8 ? Z : XP; const int ld = u.pn < 8 ? 2048 : 3072, colt = (u.pn < 8 ? u.pn : u.pn - 8) * BM, col0 = colt + wc * 32 + 8 * fq;
#pragma unroll
            for (int ai = 0; ai < 2; ++ai)
#pragma unroll
                for (int m = 0; m < 4; ++m) { bf16_t* rowp = base + (size_t)(row0 + ai * HALF + m * 16) * ld + col0;
                    const float rs = __builtin_amdgcn_rsqf(ld4f(rstat + row0 + ai * HALF + m * 16) * (1.f / 1024) + 1e-6f);
#pragma unroll
                    for (int bj = 0; bj < 2; ++bj) { const f32x4 v0 = acc[ai][bj][m][0] * rs + ld16f(swp + bj * HALF), v1 = acc[ai][bj][m][1] * rs + ld16f(swp + bj * HALF + 4); u32x4 w;
                        w.x = cvt_pk_bf16(v0[0], v0[1]); w.y = cvt_pk_bf16(v0[2], v0[3]); w.z = cvt_pk_bf16(v1[0], v1[1]); w.w = cvt_pk_bf16(v1[2], v1[3]);
                        st16(rowp + bj * HALF, w); } }
        } else if (wc < 2) {
#pragma unroll
            for (int ai = 0; ai < 2; ++ai)
#pragma unroll
                for (int m = 0; m < 4; ++m) { float* rp = DT + (size_t)(row0 + ai * HALF + m * 16) * 64 + wc * 32 + 8 * fq;
                    const float rs = __builtin_amdgcn_rsqf(ld4f(rstat + row0 + ai * HALF + m * 16) * (1.f / 1024) + 1e-6f);
                    st16f(rp, acc[ai][0][m][0] * rs + ld16f(swp)); st16f(rp + 4, acc[ai][0][m][1] * rs + ld16f(swp + 4)); }
        }
    }
};
template <int MODE> struct EpiGlu {
    static constexpr bool PERM = false, AFTER_DRAIN = false;
    bf16_t* O; int ldo; const float* bias; int H; const float* rstat; const float* sw;
    __device__ __forceinline__ void operator()(const f32x4 (&acc)[2][2][4][2], const Unit& u, int wr_, int wc_, int fr_, int fq_) const {
        const int t_ = olane(), wr = wr_, wc = wc_, fr = t_ & 15, fq = t_ >> 4; (void)fr_; (void)fq_;
        const int row0 = u.pm * BM + wr * 64 + fr;
#pragma unroll
        for (int bj = 0; bj < 2; ++bj) {
            const int f0 = 16 * (8 * u.pn + 4 * bj + wc) + 4 * fq;
            f32x4 ba = (f32x4){0.f, 0.f, 0.f, 0.f}, bu = ba;
            if (MODE == 1) { ba = ld16f(bias + f0); bu = ld16f(bias + H + f0); }
            { const float* swp = sw + (size_t)cond_of_pm(u.pm) * SW_LD + u.pn * BM + bj * HALF + wc * 32 + 4 * fq; ba += ld16f(swp); bu += ld16f(swp + 16); }
#pragma unroll
            for (int ai = 0; ai < 2; ++ai)
#pragma unroll
                for (int m = 0; m < 4; ++m) { const float rs = __builtin_amdgcn_rsqf(ld4f(rstat + row0 + ai * HALF + m * 16) * (1.f / 1024) + 1e-6f);
                    const f32x4 a = acc[ai][bj][m][0] * rs + ba, g = acc[ai][bj][m][1] * rs + bu; float o[4];
#pragma unroll
                    for (int j = 0; j < 4; ++j) o[j] = MODE == 0 ? a[j] * fast_sigmoid(a[j]) * g[j] : a[j] * fast_sigmoid(g[j]);
                    u32x2 w; w.x = cvt_pk_bf16(o[0], o[1]); w.y = cvt_pk_bf16(o[2], o[3]);
                    st8(O + (size_t)(row0 + ai * HALF + m * 16) * ldo + f0, w); }
        }
    }
};
template <int NBJ> struct EpiResid {
    static constexpr bool PERM = false, AFTER_DRAIN = false;
    const float* xlo; const float* xhi; float* xout; const float* mods_l; int g_off; const float* bias;
    bf16_t* XG; const float* GT; float* stat;
    __device__ __forceinline__ void operator()(const f32x4 (&acc)[2][2][4][2], const Unit& u, int wr_, int wc_, int fr_, int fq_) const {
        const int t_ = olane(), wr = wr_, wc = wc_, fr = t_ & 15, fq = t_ >> 4; (void)fr_; (void)fq_;
        const int cond = u.pm < 16 ? 0 : 1 + ((u.pm - 16) >> 2);
        const float* gate = mods_l + (size_t)cond * 6144 + g_off; const float* xin = u.pm < 16 ? xlo : xhi;
        const int row0 = u.pm * BM + wr * 64 + fr, col0 = u.pn * (HALF * NBJ) + wc * 32 + 4 * fq;
        float ss[2][4];
#pragma unroll
        for (int ai = 0; ai < 2; ++ai)
#pragma unroll
            for (int m = 0; m < 4; ++m) ss[ai][m] = 0.f;
        const float* gt = XG ? GT + (size_t)cond * 1024 : nullptr;
#pragma unroll
        for (int bj = 0; bj < NBJ; ++bj)
#pragma unroll
            for (int n = 0; n < 2; ++n) { const int c = col0 + bj * HALF + n * 16; const f32x4 g4 = ld16f(gate + c);
                const f32x4 b4 = bias ? ld16f(bias + c) : (f32x4){0.f, 0.f, 0.f, 0.f};
                f32x4 G4 = (f32x4){0.f, 0.f, 0.f, 0.f}; if (XG) G4 = ld16f(gt + c);
#pragma unroll
                for (int ai = 0; ai < 2; ++ai)
#pragma unroll
                    for (int m = 0; m < 4; ++m) { const size_t off = (size_t)(row0 + ai * HALF + m * 16) * 1024 + c;
                        const f32x4 xo = ld16f(xin + off); const f32x4 xn = xo + g4 * (acc[ai][bj][m][n] + b4); st16f(xout + off, xn);
                        if (XG) { const f32x4 xg = xn * G4; u32x2 w; w.x = cvt_pk_bf16(xg[0], xg[1]); w.y = cvt_pk_bf16(xg[2], xg[3]); st8(XG + off, w);
                            ss[ai][m] += (xn[0] * xn[0] + xn[1] * xn[1]) + (xn[2] * xn[2] + xn[3] * xn[3]); } } }
        if (XG) {
#pragma unroll
            for (int ai = 0; ai < 2; ++ai)
#pragma unroll
                for (int m = 0; m < 4; ++m) { float s = ss[ai][m];
                    s += __builtin_bit_cast(float, __builtin_amdgcn_ds_bpermute((t_ ^ 16) << 2, __builtin_bit_cast(int, s)));
                    s += __builtin_bit_cast(float, __builtin_amdgcn_ds_bpermute((t_ ^ 32) << 2, __builtin_bit_cast(int, s)));
                    if (fq == 0) atomicAdd(stat + row0 + ai * HALF + m * 16, s); }
        }
    }
};
template <class Epi, class Sched, bool ALIGN_EPI = false, bool SP2 = false, bool HALFN = false>
__device__ __forceinline__ void gemm_phase(PG8_LAS unsigned char* lds, const Gemm g, const Sched& S, const Epi& E, const int wave_in) {
    const int tid = wave_in * 64 + olane(), wid = __builtin_amdgcn_readfirstlane(tid >> 6), lane = tid & 63, wr = wid >> 2, wc = wid & 3, fr = lane & 15, fq = lane >> 4;
    const int K = g.K, nt = K / BK;
    unsigned voffA[2], voffB[2];
#pragma unroll
    for (int i = 0; i < 2; ++i) { int R, C; stage_rc(tid * 16 + i * 8192, R, C); const int Rb = Epi::PERM ? ((R & ~31) + perm32(R & 31)) : R;
        voffA[i] = (unsigned)(R * K + C) * 2u; voffB[i] = (unsigned)(Rb * K + C) * 2u; }
    const size_t kstep = (size_t)(BK * 2);
    const size_t hstep = (size_t)HALF * K * 2;
    const size_t tstep = 2 * hstep;
    const size_t bstep = HALFN ? hstep : tstep;
    static_assert(!HALFN || SP2, "HALFN is written for the SP2 loop only");
    const unsigned ldsw = (unsigned)wid * 1024u;
    const int aoff = lds_byte(wr * 64 + fr, fq * 8), boff = lds_byte(wc * 32 + fr, fq * 8);
#define PG8_SA(b, h) (((b) * 2 + (h)) * HTB)
#define PG8_SB(b, h) ((4 + (b) * 2 + (h)) * HTB)
#define PG8_STAGE(bufoff, gbase, voff) do { _Pragma("unroll") for (int _i = 0; _i < 2; ++_i) \
        __builtin_amdgcn_global_load_lds((const unsigned*)((const char*)(gbase) + (voff)[_i]), (PG8_LAS unsigned*)(lds + (bufoff) + ldsw + _i * 8192), 16, 0, 0); } while (0)
#define PG8_LDA(dst, b, h) do { _Pragma("unroll") for (int m = 0; m < 4; ++m) _Pragma("unroll") for (int k = 0; k < 2; ++k) dst[m][k] = *(const PG8_LAS bf16x8*)(lds + PG8_SA(b, h) + aoff + m * 2048 + k * 1024); } while (0)
#define PG8_LDB(dst, b, h) do { _Pragma("unroll") for (int n = 0; n < 2; ++n) _Pragma("unroll") for (int k = 0; k < 2; ++k) dst[n][k] = *(const PG8_LAS bf16x8*)(lds + PG8_SB(b, h) + boff + n * 2048 + k * 1024); } while (0)
#define PG8_MMA(ai, bj, At, Bt) do { __builtin_amdgcn_s_setprio(1); _Pragma("unroll") for (int m = 0; m < 4; ++m) _Pragma("unroll") for (int n = 0; n < 2; ++n) _Pragma("unroll") for (int k = 0; k < 2; ++k) \
        acc[ai][bj][m][n] = __builtin_amdgcn_mfma_f32_16x16x32_bf16(Bt[n][k], At[m][k], acc[ai][bj][m][n], 0, 0, 0); __builtin_amdgcn_s_setprio(0); } while (0)
#define PG8_WAIT_V(n) asm volatile("s_waitcnt vmcnt(" #n ")" ::: "memory")
#define PG8_WAIT_L(n) asm volatile("s_waitcnt lgkmcnt(" #n ")" ::: "memory")
#define PG8_BAR __builtin_amdgcn_s_barrier()
#define PG8_SCHED __builtin_amdgcn_sched_barrier(0)
    Unit cur, nxt; int ui = 0;
    if (!S.next(0, cur)) return;
    f32x4 acc[2][2][4][2];
#pragma unroll
    for (int a = 0; a < 2; ++a)
#pragma unroll
        for (int b = 0; b < 2; ++b)
#pragma unroll
            for (int m = 0; m < 4; ++m)
#pragma unroll
                for (int n = 0; n < 2; ++n) acc[a][b][m][n] = (f32x4){0.f, 0.f, 0.f, 0.f};
    bf16x8 At[4][2], B0[2][2], B1[2][2];
    const char* cA = (const char*)g.A + (size_t)cur.pm * tstep; const char* cB = (const char*)g.Bt + (size_t)cur.pn * bstep;
    S.a_ready(cur);
    if constexpr (HALFN) {
        PG8_STAGE(PG8_SB(0, 0), cB, voffB); PG8_STAGE(PG8_SA(0, 0), cA, voffA); PG8_STAGE(PG8_SA(0, 1), cA + hstep, voffA);
        if (wr == 1) PG8_BAR;
        PG8_WAIT_V(2); PG8_BAR;
        PG8_STAGE(PG8_SB(1, 0), cB + kstep, voffB); PG8_STAGE(PG8_SA(1, 0), cA + kstep, voffA);
        PG8_WAIT_V(4); PG8_BAR;
    } else if constexpr (SP2) {
        PG8_STAGE(PG8_SB(0, 0), cB, voffB); PG8_STAGE(PG8_SB(0, 1), cB + hstep, voffB); PG8_STAGE(PG8_SA(0, 0), cA, voffA); PG8_STAGE(PG8_SA(0, 1), cA + hstep, voffA);
        if (wr == 1) PG8_BAR;
        PG8_WAIT_V(2); PG8_BAR;
        PG8_STAGE(PG8_SB(1, 0), cB + kstep, voffB); PG8_STAGE(PG8_SA(1, 0), cA + kstep, voffA); PG8_STAGE(PG8_SB(1, 1), cB + hstep + kstep, voffB);
        PG8_WAIT_V(6); PG8_BAR;
    } else {
        PG8_STAGE(PG8_SB(0, 0), cB, voffB); PG8_STAGE(PG8_SA(0, 0), cA, voffA); PG8_STAGE(PG8_SB(0, 1), cB + hstep, voffB); PG8_STAGE(PG8_SA(0, 1), cA + hstep, voffA);
        if (wr == 1) PG8_BAR;
        PG8_WAIT_V(4); PG8_BAR;
        PG8_STAGE(PG8_SB(1, 0), cB + kstep, voffB); PG8_STAGE(PG8_SA(1, 0), cA + kstep, voffA); PG8_STAGE(PG8_SB(1, 1), cB + hstep + kstep, voffB);
        PG8_WAIT_V(6); PG8_BAR;
    }
    for (;;) {
        const bool has_next = S.next(ui + 1, nxt);
        const char* nA = has_next ? (const char*)g.A + (size_t)nxt.pm * tstep : cA; const char* nB = has_next ? (const char*)g.Bt + (size_t)nxt.pn * bstep : cB;
        for (int t = 0; t < nt; t += 2) {
            const bool last = (t == nt - 2);
            const char* a1 = cA + (size_t)(t + 1) * kstep;
            const char* a2 = last ? nA : cA + (size_t)(t + 2) * kstep; const char* b2 = last ? nB : cB + (size_t)(t + 2) * kstep;
            const char* a3 = a2 + kstep; const char* b3 = b2 + kstep;
            if (last && has_next) S.a_ready(nxt);
            if constexpr (HALFN) {
            PG8_LDB(B0, 0, 0); PG8_SCHED; PG8_LDA(At, 0, 0); PG8_STAGE(PG8_SA(1, 1), a1 + hstep, voffA);
            PG8_WAIT_V(6); PG8_WAIT_L(0); PG8_BAR; PG8_MMA(0, 0, At, B0); PG8_BAR; PG8_SCHED;
            PG8_LDA(At, 0, 1); PG8_STAGE(PG8_SB(0, 0), b2, voffB); PG8_STAGE(PG8_SA(0, 0), a2, voffA);
            PG8_WAIT_V(6); PG8_WAIT_L(0); PG8_BAR; PG8_MMA(1, 0, At, B0); PG8_BAR; PG8_SCHED;
            PG8_LDB(B0, 1, 0); PG8_SCHED; PG8_LDA(At, 1, 0); PG8_STAGE(PG8_SA(0, 1), a2 + hstep, voffA);
            PG8_WAIT_V(6); PG8_WAIT_L(0); PG8_BAR; PG8_MMA(0, 0, At, B0); PG8_BAR; PG8_SCHED;
            PG8_LDA(At, 1, 1); PG8_STAGE(PG8_SB(1, 0), b3, voffB); PG8_STAGE(PG8_SA(1, 0), a3, voffA);
            PG8_WAIT_V(6); PG8_WAIT_L(0); PG8_BAR; PG8_MMA(1, 0, At, B0); PG8_BAR; PG8_SCHED;
            } else if constexpr (SP2) {
            PG8_LDB(B0, 0, 0); PG8_LDB(B1, 0, 1); PG8_SCHED; PG8_LDA(At, 0, 0); PG8_STAGE(PG8_SA(1, 1), a1 + hstep, voffA);
            PG8_WAIT_V(8); PG8_WAIT_L(0); PG8_BAR; PG8_MMA(0, 0, At, B0); PG8_MMA(0, 1, At, B1); PG8_BAR; PG8_SCHED;
            PG8_LDA(At, 0, 1); PG8_STAGE(PG8_SB(0, 0), b2, voffB); PG8_STAGE(PG8_SB(0, 1), b2 + hstep, voffB); PG8_STAGE(PG8_SA(0, 0), a2, voffA);
            PG8_WAIT_V(8); PG8_WAIT_L(0); PG8_BAR; PG8_MMA(1, 0, At, B0); PG8_MMA(1, 1, At, B1); PG8_BAR; PG8_SCHED;
            PG8_LDB(B0, 1, 0); PG8_LDB(B1, 1, 1); PG8_SCHED; PG8_LDA(At, 1, 0); PG8_STAGE(PG8_SA(0, 1), a2 + hstep, voffA);
            PG8_WAIT_V(8); PG8_WAIT_L(0); PG8_BAR; PG8_MMA(0, 0, At, B0); PG8_MMA(0, 1, At, B1); PG8_BAR; PG8_SCHED;
            PG8_LDA(At, 1, 1); PG8_STAGE(PG8_SB(1, 0), b3, voffB); PG8_STAGE(PG8_SB(1, 1), b3 + hstep, voffB); PG8_STAGE(PG8_SA(1, 0), a3, voffA);
            PG8_WAIT_V(8); PG8_WAIT_L(0); PG8_BAR; PG8_MMA(1, 0, At, B0); PG8_MMA(1, 1, At, B1); PG8_BAR; PG8_SCHED;
            } else {
            PG8_LDB(B0, 0, 0); PG8_SCHED; PG8_LDA(At, 0, 0); PG8_STAGE(PG8_SA(1, 1), a1 + hstep, voffA);
            PG8_WAIT_L(8); PG8_BAR; PG8_WAIT_L(0); PG8_MMA(0, 0, At, B0); PG8_BAR; PG8_SCHED;
            PG8_LDB(B1, 0, 1); PG8_STAGE(PG8_SB(0, 0), b2, voffB);
            PG8_BAR; PG8_WAIT_L(0); PG8_MMA(0, 1, At, B1); PG8_BAR;
            PG8_LDA(At, 0, 1); PG8_STAGE(PG8_SA(0, 0), a2, voffA);
            PG8_BAR; PG8_WAIT_L(0); PG8_MMA(1, 0, At, B0); PG8_BAR; PG8_SCHED;
            PG8_STAGE(PG8_SB(0, 1), b2 + hstep, voffB);
            PG8_WAIT_V(6); PG8_BAR; PG8_MMA(1, 1, At, B1); PG8_BAR;
            PG8_LDB(B0, 1, 0); PG8_SCHED; PG8_LDA(At, 1, 0); PG8_STAGE(PG8_SA(0, 1), a2 + hstep, voffA);
            PG8_WAIT_L(8); PG8_BAR; PG8_WAIT_L(0); PG8_MMA(0, 0, At, B0); PG8_BAR; PG8_SCHED;
            PG8_LDB(B1, 1, 1); PG8_STAGE(PG8_SB(1, 0), b3, voffB);
            PG8_BAR; PG8_WAIT_L(0); PG8_MMA(0, 1, At, B1); PG8_BAR;
            PG8_LDA(At, 1, 1); PG8_STAGE(PG8_SA(1, 0), a3, voffA);
            PG8_BAR; PG8_WAIT_L(0); PG8_MMA(1, 0, At, B0); PG8_BAR; PG8_SCHED;
            PG8_STAGE(PG8_SB(1, 1), b3 + hstep, voffB);
            PG8_WAIT_V(6); PG8_BAR; PG8_MMA(1, 1, At, B1); PG8_BAR;
            }
        }
        if constexpr (ALIGN_EPI) { if (wr == 0) PG8_BAR; }
        if constexpr (!Epi::AFTER_DRAIN) { E(acc, cur, wr, wc, fr, fq); S.done(cur); }
        if (!has_next) break;
#pragma unroll
        for (int a = 0; a < 2; ++a)
#pragma unroll
            for (int b = 0; b < 2; ++b)
#pragma unroll
                for (int m = 0; m < 4; ++m)
#pragma unroll
                    for (int n = 0; n < 2; ++n) acc[a][b][m][n] = (f32x4){0.f, 0.f, 0.f, 0.f};
        cur = nxt; cA = nA; cB = nB; ++ui;
        if constexpr (ALIGN_EPI) { if (wr == 1) PG8_BAR; }
    }
    PG8_WAIT_V(0);
    if constexpr (!ALIGN_EPI) { if (wr == 0) PG8_BAR; }
    PG8_BAR;
    if constexpr (Epi::AFTER_DRAIN) { E.fused(acc, cur, wr, wc, fr, fq, lds, wid, lane); S.done(cur); }
#undef PG8_SA
#undef PG8_SB
#undef PG8_STAGE
#undef PG8_LDA
#undef PG8_LDB
#undef PG8_MMA
#undef PG8_WAIT_V
#undef PG8_WAIT_L
#undef PG8_BAR
#undef PG8_SCHED
}
}
constexpr int NWAVES = 8, NTHR = 512;
constexpr size_t MiB = 1u << 20;
constexpr size_t WS_CTL = 0, CTL_ZERO_BYTES = 1 * MiB;
constexpr size_t WS_MODS = 256 * 1024;
constexpr size_t WS_STAT = 768 * 1024;
constexpr size_t WS_SW = 372 * MiB, WS_GT = 374 * MiB;
constexpr size_t WS_ROPE = 1 * MiB;
constexpr size_t WS_W = 2 * MiB;
constexpr size_t W_MLA = WS_W, MLA_WB = 5898240;
constexpr size_t MW_CAT = 0, MW_UQ = 1572864, MW_UKV = 2752512, MW_O = 3801088;
constexpr size_t W_CV1 = WS_W + 2 * MLA_WB, W_CV2 = W_CV1 + 4 * MiB;
constexpr size_t W_SSI = W_CV2 + 2 * MiB, W_SSO = W_SSI + 11010048;
constexpr size_t W_FF = W_SSO + 4 * MiB, FF_WB = 17301504, FW_IN = 0, FW_OUT = 11534336;
static_assert(W_FF + 4 * FF_WB <= 102 * MiB, "weights region");
constexpr size_t WS_H = 102 * MiB;
constexpr size_t WS_CKV = 118 * MiB, CKV_B = (size_t)(T + NCTX) * KVL * 2;
constexpr size_t WS_AR = 128 * MiB;
constexpr size_t A_LAT = WS_AR, A_QN = A_LAT + 24 * MiB, A_QRAW = A_QN + 6 * MiB, A_KVRAW = A_QRAW + 24 * MiB, A_QB = A_KVRAW + 36 * MiB, A_KB = A_QB + 24 * MiB, A_AO = A_KB + 27 * MiB;
constexpr size_t A_U = WS_AR, A_V = A_U + 16 * MiB;
constexpr size_t A_Z = WS_AR, A_XPRE = A_Z + 32 * MiB, A_DTRAW = A_XPRE + 48 * MiB, A_XBC = A_DTRAW + 2 * MiB, A_DT = A_XBC + 48 * MiB, A_Y = A_DT + 2 * MiB, A_YN = A_XPRE, A_ACUM = A_Y + 64 * MiB;
constexpr size_t A_ACT = WS_AR + 200 * MiB;
static_assert(A_AO + 16 * MiB <= A_ACT && A_ACUM + 2 * MiB <= A_ACT && A_ACT + 44 * MiB <= 384 * MiB, "arena map");
constexpr int CW_BAR = 4096;
constexpr int LDS_BYTES = 163840, RING_BYTES = 131072, MISC_OFF = 163840 - 256, PTAB_OFF_C = MISC_OFF - 512;

#define GAS __attribute__((address_space(1)))
#define LAS __attribute__((address_space(3)))
typedef unsigned short bf16;
typedef unsigned v4u __attribute__((ext_vector_type(4)));
typedef unsigned v2u __attribute__((ext_vector_type(2)));
typedef float v4f __attribute__((ext_vector_type(4)));
typedef float v2f __attribute__((ext_vector_type(2)));
typedef GAS unsigned gu32;
#define LDS_WAIT() asm volatile("s_waitcnt lgkmcnt(0)" ::: "memory")
#define LDS_BARRIER() do { asm volatile("s_waitcnt lgkmcnt(0)" ::: "memory"); __builtin_amdgcn_s_barrier(); asm volatile("" ::: "memory"); } while (0)
#define VM_WAIT() asm volatile("s_waitcnt vmcnt(0)" ::: "memory")
__device__ __forceinline__ unsigned f2bf(float f) { unsigned u = __builtin_bit_cast(unsigned, f); return (u + 0x7fffu + ((u >> 16) & 1u)) >> 16; }
__device__ __forceinline__ unsigned pk2(float lo, float hi) { return f2bf(lo) | (f2bf(hi) << 16); }
__device__ __forceinline__ float bflo(unsigned u) { return __builtin_bit_cast(float, u << 16); }
__device__ __forceinline__ float bfhi(unsigned u) { return __builtin_bit_cast(float, u & 0xffff0000u); }
__device__ __forceinline__ float bf2f(bf16 b) { return __builtin_bit_cast(float, (unsigned)b << 16); }

#define XB_TMO      128
#define XB_XCNT(j)  (256  + 64 * (j))
#define XB_XSUB(j)  (1280 + 64 * (j))
#define XB_XGEN(j)  (2304 + 64 * (j))
#define XB_TOP      3328
#define XB_TOPGEN   3392
#define XCD_BAR_WORDS 3456
#define XB_SPIN_CAP (1u << 18)

__device__ __forceinline__ unsigned xb_ld(unsigned* p)              { return __hip_atomic_load(p, __ATOMIC_RELAXED, __HIP_MEMORY_SCOPE_AGENT); }
__device__ __forceinline__ unsigned xb_add(unsigned* p, unsigned v) { return __hip_atomic_fetch_add(p, v, __ATOMIC_RELAXED, __HIP_MEMORY_SCOPE_AGENT); }
__device__ __forceinline__ unsigned xb_xcc_id() { return (unsigned)__builtin_amdgcn_s_getreg((3 << 11) | 20) & 0xFu; }
#define XB_SPIN(cond, bar) do { unsigned _sp = 0; while (cond) { __builtin_amdgcn_s_sleep(1); \
    if ((++_sp & 255u) == 0u) { if (xb_ld(&(bar)[XB_TMO])) break; if (_sp > XB_SPIN_CAP) { atomicAdd(&(bar)[XB_TMO], 1u); break; } } } } while (0)

struct XcdBarrier {
    unsigned* bar; unsigned x;
    volatile LAS unsigned* st;
};

__device__ __forceinline__ XcdBarrier xcd_barrier_post(unsigned* bar, volatile LAS unsigned* st) {
    XcdBarrier b; b.bar = bar; b.x = xb_xcc_id(); b.st = st;
    if (threadIdx.x == 0) (void)xb_add(&bar[XB_XCNT(b.x)], 1u);
    return b;
}
__device__ __forceinline__ void xcd_barrier_complete(unsigned* bar, unsigned x, unsigned& nloc, unsigned& nx) {
    const unsigned G = gridDim.x * gridDim.y * gridDim.z;
    unsigned sum, cnt, mine, sp = 0u;
    for (;;) {
        sum = 0u; cnt = 0u; mine = 0u;
#pragma unroll
        for (unsigned j = 0; j < 16; ++j) { const unsigned c = xb_ld(&bar[XB_XCNT(j)]); sum += c; cnt += (c > 0u) ? 1u : 0u; mine = (j == x) ? c : mine; }
        if (sum == G) break;
        __builtin_amdgcn_s_sleep(1);
        if ((++sp & 255u) == 0u) { if (xb_ld(&bar[XB_TMO])) break; if (sp > XB_SPIN_CAP) { atomicAdd(&bar[XB_TMO], 1u); break; } }
    }
    nloc = mine > 0u ? mine : 1u; nx = cnt > 0u ? cnt : 1u;
}

__device__ __forceinline__ void xcd_barrier(const XcdBarrier& b) {
    asm volatile("s_waitcnt vmcnt(0)" ::: "memory");
    __syncthreads();
    if (threadIdx.x == 0) {
        unsigned* bar = b.bar;
        __builtin_amdgcn_s_waitcnt(0);
        unsigned nloc = b.st[0], nx = b.st[1];
        if (nloc == 0u) { xcd_barrier_complete(bar, b.x, nloc, nx); b.st[0] = nloc; b.st[1] = nx; }
        const unsigned old = xb_add(&bar[XB_XSUB(b.x)], 1u);
        const unsigned gen = old / nloc;
        if (old + 1u == (gen + 1u) * nloc) {
            __builtin_amdgcn_fence(__ATOMIC_RELEASE, "agent");
            asm volatile("s_waitcnt vmcnt(0)" ::: "memory");
            const unsigned og = xb_add(&bar[XB_TOP], 1u);
            const unsigned tg = og / nx;
            if (og + 1u == (tg + 1u) * nx) xb_add(&bar[XB_TOPGEN], 1u);
            else XB_SPIN(xb_ld(&bar[XB_TOPGEN]) == tg, bar);
            __builtin_amdgcn_fence(__ATOMIC_ACQUIRE, "agent");
            xb_add(&bar[XB_XGEN(b.x)], 1u);
            asm volatile("s_waitcnt vmcnt(0)" ::: "memory");
        } else {
            XB_SPIN(xb_ld(&bar[XB_XGEN(b.x)]) == gen, bar);
            __builtin_amdgcn_fence(__ATOMIC_ACQUIRE, "agent");
            asm volatile("s_waitcnt vmcnt(0)" ::: "memory");
        }
    }
    __syncthreads();
}

struct Frame {
    LAS unsigned char* lds; int tid, lane, wave, vcu, G, gw, NGW, bx;
    volatile LAS unsigned* PT;
};
constexpr int PT_OUT = 38, PT_WS = 39;
__device__ __forceinline__ const float* ldp(volatile LAS unsigned* PT, int k) {
    const unsigned lo = __builtin_amdgcn_readfirstlane(PT[2 * k]), hi = __builtin_amdgcn_readfirstlane(PT[2 * k + 1]);
    return (const float*)(((unsigned long long)hi << 32) | lo);
}
#define INP(k) ldp(F.PT, (k))
#define WSP ((unsigned char*)ldp(F.PT, PT_WS))
#define OUTP ((float*)ldp(F.PT, PT_OUT))
enum InIdx { I_XP = 0, I_XS, I_CCKV, I_CKPE, I_SSM, I_C, I_CCTX, I_WADA, I_BADA, I_GN1, I_GN2, I_WDQ, I_GQ, I_WUQ, I_WDKV, I_GKV, I_WUKV, I_GQN, I_GKN, I_WO,
             I_CVW1, I_CVB1, I_CVWD, I_CVBD, I_CVGL, I_CVBL, I_CVW2, I_CVB2, I_SSWI, I_SSWC, I_SSBC, I_SSDTB, I_SSAL, I_SSD, I_SSGN, I_SSWO, I_FFWI, I_FFWO };
__device__ __forceinline__ float shx(float v, int lane, int o) { return __builtin_bit_cast(float, __builtin_amdgcn_ds_bpermute((lane ^ o) << 2, __builtin_bit_cast(int, v))); }
__device__ __forceinline__ float wsum(float v, int lane) {
#pragma unroll
    for (int o = 1; o < 64; o <<= 1) v += shx(v, lane, o);
    return v;
}
constexpr float QSCALE = 0.10206207261596577f * 1.4426950408889634f;

struct P0Item { const float* W; bf16* WT; int K, N, mode, H, roff, k0, n0; };
__device__ __forceinline__ void p0_item_load(const P0Item& J, int lane, v4f (&t)[8]) {
#pragma unroll
    for (int i = 0; i < 8; ++i) t[i] = *(const GAS v4f*)(J.W + (size_t)(J.k0 + 8 * i + (lane >> 3)) * J.N + J.n0 + 4 * (lane & 7));
}
__device__ __forceinline__ void p0_item_finish(const P0Item& J, int lane, const v4f (&t)[8], LAS float* scr) {
#pragma unroll
    for (int i = 0; i < 8; ++i) { LAS float* d = scr + (8 * i + (lane >> 3)) * 33 + 4 * (lane & 7); d[0] = t[i].x; d[1] = t[i].y; d[2] = t[i].z; d[3] = t[i].w; }
    LDS_WAIT(); asm volatile("" ::: "memory");
    const int c = lane & 7;
#pragma unroll
    for (int j = 0; j < 4; ++j) { const int n = (lane >> 3) + 8 * j, col = J.n0 + n; const LAS float* s = scr + (8 * c) * 33 + n;
        int drow;
        if (J.mode == 0) drow = J.roff + col;
        else { const int f = col < J.H ? col : col - J.H; drow = 32 * (f >> 4) + (f & 15) + (col < J.H ? 0 : 16); }
        v4u o; o.x = pk2(s[0 * 33], s[1 * 33]); o.y = pk2(s[2 * 33], s[3 * 33]); o.z = pk2(s[4 * 33], s[5 * 33]); o.w = pk2(s[6 * 33], s[7 * 33]);
        *(GAS v4u*)(J.WT + (size_t)drow * J.K + J.k0 + 8 * c) = o; }
    LDS_WAIT(); asm volatile("" ::: "memory");
}
__device__ __forceinline__ void p0_job(int q, int& inp, size_t& soff, int& K, int& N, size_t& doff, int& mode, int& H, int& roff) {
    mode = 0; H = 0; roff = 0; soff = 0;
    if (q < 10) { const int j = q / 5, t = q % 5; const size_t wb = W_MLA + (size_t)j * MLA_WB;
        if (t == 0) { inp = I_WDQ; soff = (size_t)j * 1024 * 384; K = 1024; N = 384; doff = wb + MW_CAT; }
        else if (t == 1) { inp = I_WDKV; soff = (size_t)j * 1024 * 288; K = 1024; N = 288; doff = wb + MW_CAT; roff = 384; }
        else if (t == 2) { inp = I_WUQ; soff = (size_t)j * 384 * 1536; K = 384; N = 1536; doff = wb + MW_UQ; }
        else if (t == 3) { inp = I_WUKV; soff = (size_t)j * 256 * 2048; K = 256; N = 2048; doff = wb + MW_UKV; }
        else { inp = I_WO; soff = (size_t)j * 1024 * 1024; K = 1024; N = 1024; doff = wb + MW_O; } }
    else if (q == 10) { inp = I_CVW1; K = 1024; N = 2048; doff = W_CV1; mode = 1; H = 1024; }
    else if (q == 11) { inp = I_CVW2; K = 1024; N = 1024; doff = W_CV2; }
    else if (q == 12) { inp = I_SSWI; K = 1024; N = 5184; doff = W_SSI; }
    else if (q == 13) { inp = I_SSWO; K = 2048; N = 1024; doff = W_SSO; }
    else { const int l = (q - 14) >> 1, t = (q - 14) & 1;
        if (t == 0) { inp = I_FFWI; soff = (size_t)l * 1024 * 5632; K = 1024; N = 5632; doff = W_FF + (size_t)l * FF_WB + FW_IN; mode = 1; H = 2816; }
        else { inp = I_FFWO; soff = (size_t)l * 2816 * 1024; K = 2816; N = 1024; doff = W_FF + (size_t)l * FF_WB + FW_OUT; } }
}
constexpr int P0_NITEMS = 2 * ((1024 / 64) * (384 / 32) + (1024 / 64) * (288 / 32) + (384 / 64) * (1536 / 32) + (256 / 64) * (2048 / 32) + (1024 / 64) * (1024 / 32))
                        + (1024 / 64) * (2048 / 32) + (1024 / 64) * (1024 / 32) + (1024 / 64) * (5184 / 32) + (2048 / 64) * (1024 / 32)
                        + 4 * ((1024 / 64) * (5632 / 32) + (2816 / 64) * (1024 / 32));
__device__ __forceinline__ void p0_prologue(Frame& F) {
    unsigned char* ws = WSP;
    LAS float* s = (LAS float*)F.lds;
    for (int i = F.tid; i < 5 * 1024; i += NTHR) { const int cc = i >> 10, k = i & 1023; const float v = cc == 0 ? INP(I_CCTX)[k] : INP(I_C)[(cc - 1) * 1024 + k]; s[i] = v / (1.f + expf(-v)); }
    __syncthreads();
    float* mods = (float*)(ws + WS_MODS);
    for (int it = F.bx; it < 192; it += F.G) {
        const int l = it / 48, r = it % 48, cb = r / 16, ks = r % 16, n = cb * 2048 + 4 * F.tid;
        const float* W = INP(I_WADA) + (size_t)l * 1024 * 6144 + (size_t)(ks * 64) * 6144 + n;
        v4f acc[5];
#pragma unroll
        for (int cc = 0; cc < 5; ++cc) acc[cc] = (v4f){0.f, 0.f, 0.f, 0.f};
#pragma unroll 1
        for (int kb = 0; kb < 64; kb += 16) {
            v4f wv[16];
#pragma unroll
            for (int k = 0; k < 16; ++k) wv[k] = *(const GAS v4f*)(W + (size_t)(kb + k) * 6144);
#pragma unroll
            for (int k = 0; k < 16; ++k)
#pragma unroll
                for (int cc = 0; cc < 5; ++cc) acc[cc] += wv[k] * s[cc * 1024 + ks * 64 + kb + k];
        }
        LAS float* tbl = s + 5 * 1024;
        __syncthreads();
#pragma unroll
        for (int cc = 0; cc < 5; ++cc) *(LAS v4f*)(tbl + cc * 2048 + 4 * F.tid) = acc[cc];
        __syncthreads();
        const float* bp = INP(I_BADA) + l * 6144 + cb * 2048;
#pragma unroll
        for (int q = 0; q < 4; ++q) { const int col = q * 512 + F.tid; const float bb = ks == 0 ? bp[col] : 0.f;
#pragma unroll
            for (int cc = 0; cc < 5; ++cc) atomicAdd(&mods[((size_t)l * 5 + cc) * 6144 + cb * 2048 + col], tbl[cc * 2048 + col] + bb); }
    }
    __syncthreads();
    LAS float* scr = (LAS float*)(F.lds + F.wave * 8448);
    for (int it = F.gw; it < P0_NITEMS; it += 2 * F.NGW) {
        P0Item J[2]; bool have1 = it + F.NGW < P0_NITEMS;
#pragma unroll
        for (int e = 0; e < 2; ++e) {
            int r = e == 0 ? it : (have1 ? it + F.NGW : it), inp = 0, K = 64, N = 32, mode = 0, H = 0, roff = 0; size_t soff = 0, doff = 0;
#pragma unroll 1
            for (int q = 0; q < 22; ++q) { p0_job(q, inp, soff, K, N, doff, mode, H, roff); const int ni = (K / 64) * (N / 32); if (r < ni) break; r -= ni; }
            const int nblk = N / 32;
            J[e].W = INP(inp) + soff; J[e].WT = (bf16*)(ws + doff); J[e].K = K; J[e].N = N; J[e].mode = mode; J[e].H = H; J[e].roff = roff; J[e].k0 = 64 * (r / nblk); J[e].n0 = 32 * (r % nblk);
        }
        v4f t0[8], t1[8];
        p0_item_load(J[0], F.lane, t0); p0_item_load(J[1], F.lane, t1);
        p0_item_finish(J[0], F.lane, t0, scr);
        if (have1) p0_item_finish(J[1], F.lane, t1, scr);
    }
    for (int it = F.gw; it < 384; it += F.NGW) {
        bf16* rowp = it < 192 ? (bf16*)(ws + W_MLA + (it / 96) * MLA_WB + MW_CAT) + (size_t)(672 + it % 96) * 1024 : (bf16*)(ws + W_SSI) + (size_t)(5184 + it - 192) * 1024;
        const v4u z = {0u, 0u, 0u, 0u}; ((GAS v4u*)rowp)[F.lane] = z; ((GAS v4u*)rowp)[64 + F.lane] = z;
    }
    for (int it = F.gw; it < 2048; it += F.NGW) {
        const int j = it >> 10, rr = it & 1023, b = rr >> 8, sq = rr & 255;
        const v4f v = ((const GAS v4f*)(INP(I_CCKV) + (((size_t)b * 2 + j) * 256 + sq) * 256))[F.lane];
        v2u o; o.x = pk2(v.x, v.y); o.y = pk2(v.z, v.w);
        ((GAS v2u*)((bf16*)(ws + WS_CKV + j * CKV_B) + (size_t)(T + rr) * 256))[F.lane] = o;
    }
    if (F.bx == 0) for (int i = F.tid; i < 640; i += NTHR) { const int pos = i >> 3, fi = i & 7; const float p = (float)(pos < 16 ? pos : pos - 16);
        const float a = p * rope_inv(fi); float* tab = (float*)(ws + WS_ROPE); tab[2 * i] = cosf(a); tab[2 * i + 1] = sinf(a); }
}

__device__ __forceinline__ void rp_normmod(Frame& F, const float* xlo, const float* xhi, const float* g, const float* mods_l, int sh_off, int sc_off, bf16* h) {
    for (int base = F.gw; base < T; base += 4 * F.NGW) {
        v4f v[4][4]; float ss[4]; int rows[4];
#pragma unroll
        for (int k = 0; k < 4; ++k) { const int row = base + k * F.NGW; rows[k] = row < T ? row : base;
            const GAS v4f* xr = (const GAS v4f*)((rows[k] < TP ? xlo : xhi) + (size_t)rows[k] * 1024) + F.lane;
#pragma unroll
            for (int j = 0; j < 4; ++j) v[k][j] = xr[64 * j]; }
#pragma unroll
        for (int k = 0; k < 4; ++k) { float s = 0.f;
#pragma unroll
            for (int j = 0; j < 4; ++j) s += (v[k][j].x * v[k][j].x + v[k][j].y * v[k][j].y) + (v[k][j].z * v[k][j].z + v[k][j].w * v[k][j].w);
            ss[k] = s; }
#pragma unroll
        for (int o = 1; o < 64; o <<= 1) {
#pragma unroll
            for (int k = 0; k < 4; ++k) ss[k] += shx(ss[k], F.lane, o); }
#pragma unroll
        for (int j = 0; j < 4; ++j) { const int c = 4 * F.lane + 256 * j; const v4f g4 = *(const GAS v4f*)(g + c);
#pragma unroll
            for (int k = 0; k < 4; ++k) { const float r = rsqrtf(ss[k] * (1.f / 1024) + EPS); const float* m = mods_l + (size_t)cond_of_row(rows[k]) * 6144;
                const v4f sc = *(const GAS v4f*)(m + sc_off + c), sh = *(const GAS v4f*)(m + sh_off + c);
                const v4f o = v[k][j] * r * g4 * (sc + 1.f) + sh; v2u w; w.x = pk2(o.x, o.y); w.y = pk2(o.z, o.w);
                *(GAS v2u*)(h + (size_t)rows[k] * 1024 + c) = w; } }
    }
}
__device__ __forceinline__ void rp_mla_fin1(Frame& F, const float* lat, const float* gq, const float* gkv, bf16* qn, bf16* ckv, float* out, int j) {
    for (int row = F.gw; row < T; row += F.NGW) {
        const float* lr = lat + (size_t)row * 768;
        v2f q[3]; float ss = 0.f;
#pragma unroll
        for (int i = 0; i < 3; ++i) { q[i] = *(const GAS v2f*)(lr + 2 * F.lane + 128 * i); ss += q[i].x * q[i].x + q[i].y * q[i].y; }
        float r = rsqrtf(wsum(ss, F.lane) * (1.f / 384) + EPS);
#pragma unroll
        for (int i = 0; i < 3; ++i) { const int c = 2 * F.lane + 128 * i; *(GAS unsigned*)(qn + (size_t)row * 384 + c) = pk2(q[i].x * r * gq[c], q[i].y * r * gq[c + 1]); }
        v2f k[2]; ss = 0.f;
#pragma unroll
        for (int i = 0; i < 2; ++i) { k[i] = *(const GAS v2f*)(lr + 384 + 2 * F.lane + 128 * i); ss += k[i].x * k[i].x + k[i].y * k[i].y; }
        r = rsqrtf(wsum(ss, F.lane) * (1.f / 256) + EPS);
#pragma unroll
        for (int i = 0; i < 2; ++i) { const int c = 2 * F.lane + 128 * i; const float c0 = k[i].x * r * gkv[c], c1 = k[i].y * r * gkv[c + 1];
            *(GAS unsigned*)(ckv + (size_t)row * 256 + c) = pk2(c0, c1);
            if (row < TP) { v2f o; o.x = c0; o.y = c1; *(GAS v2f*)(out + OUT_CKV + (((size_t)(row >> 8) * 2 + j) * 256 + (row & 255)) * 256 + c) = o; } }
        if (row < TP && F.lane < 32) out[OUT_KPE + (((size_t)(row >> 8) * 2 + j) * 256 + (row & 255)) * 32 + F.lane] = lr[640 + F.lane];
    }
}
__device__ __forceinline__ void rope32_tab(float* pe, int t, const float* tab) {
    const v2f* tr = (const v2f*)tab + (t >> 6) * 8; const v2f* tc = (const v2f*)tab + (16 + (t & 63)) * 8;
#pragma unroll
    for (int i = 0; i < 8; ++i) {
        v2f cs = tr[i]; float x1 = pe[i], x2 = pe[i + 8]; pe[i] = x1 * cs.x - x2 * cs.y; pe[i + 8] = x2 * cs.x + x1 * cs.y;
        cs = tc[i]; x1 = pe[16 + i]; x2 = pe[24 + i]; pe[16 + i] = x1 * cs.x - x2 * cs.y; pe[24 + i] = x2 * cs.x + x1 * cs.y;
    }
}
__device__ __forceinline__ void ld8(const bf16* p, float* d) { const v4u w = *(const GAS v4u*)p; d[0] = bflo(w.x); d[1] = bfhi(w.x); d[2] = bflo(w.y); d[3] = bfhi(w.y); d[4] = bflo(w.z); d[5] = bfhi(w.z); d[6] = bflo(w.w); d[7] = bfhi(w.w); }
__device__ __forceinline__ void st8(bf16* p, const float* d) { v4u w; w.x = pk2(d[0], d[1]); w.y = pk2(d[2], d[3]); w.z = pk2(d[4], d[5]); w.w = pk2(d[6], d[7]); *(GAS v4u*)p = w; }
__device__ __forceinline__ void rp_tables(Frame& F) {
    unsigned char* ws = WSP; const float* mods = (const float*)(ws + WS_MODS); float* GTb = (float*)(ws + WS_GT); float* SWb = (float*)(ws + WS_SW);
    for (int idx = F.bx * NTHR + F.tid; idx < 8 * 5 * 1024; idx += F.G * NTHR) {
        const int s = idx / 5120, r = idx % 5120, c = r >> 10, k = r & 1023, layer = s >> 1;
        const float g = (s & 1) ? INP(I_GN2)[layer * 1024 + k] : INP(I_GN1)[layer * 1024 + k];
        GTb[idx] = g * (1.f + mods[((size_t)layer * 5 + c) * 6144 + ((s & 1) ? 4096 : 1024) + k]);
    }
    constexpr int NR1 = 5632, NR2 = 2048, NR4 = 5376, NR6 = 768;
    constexpr int TOT = 4 * NR1 + NR2 + NR4 + NR6;
    for (int it = F.gw; it < TOT / 4; it += F.NGW) {
        int s, n; const bf16* Wt; const int i4 = 4 * it;
        if (i4 < 4 * NR1) { const int l = i4 / NR1; n = i4 % NR1; s = 2 * l + 1; Wt = (const bf16*)(ws + W_FF + (size_t)l * FF_WB + FW_IN); }
        else if (i4 < 4 * NR1 + NR2) { n = i4 - 4 * NR1; s = 2; Wt = (const bf16*)(ws + W_CV1); }
        else if (i4 < 4 * NR1 + NR2 + NR4) { n = i4 - 4 * NR1 - NR2; s = 4; Wt = (const bf16*)(ws + W_SSI); }
        else { n = i4 - 4 * NR1 - NR2 - NR4; s = 6; Wt = (const bf16*)(ws + W_MLA + MLA_WB + MW_CAT); }
        const int layer = s >> 1, shoff = (s & 1) ? 3072 : 0;
        v4u wr[4][2];
#pragma unroll
        for (int r = 0; r < 4; ++r) { wr[r][0] = *(const GAS v4u*)(Wt + (size_t)(n + r) * 1024 + 16 * F.lane); wr[r][1] = *(const GAS v4u*)(Wt + (size_t)(n + r) * 1024 + 16 * F.lane + 8); }
        float acc[4][5];
#pragma unroll
        for (int r = 0; r < 4; ++r)
#pragma unroll
            for (int c = 0; c < 5; ++c) acc[r][c] = 0.f;
#pragma unroll
        for (int c = 0; c < 5; ++c) { const float* sp = mods + ((size_t)layer * 5 + c) * 6144 + shoff + 16 * F.lane;
            const v4f s0 = *(const GAS v4f*)sp, s1 = *(const GAS v4f*)(sp + 4), s2 = *(const GAS v4f*)(sp + 8), s3 = *(const GAS v4f*)(sp + 12);
#pragma unroll
            for (int r = 0; r < 4; ++r) { const v4u a = wr[r][0], b2 = wr[r][1];
                acc[r][c] = (s0.x * bflo(a.x) + s0.y * bfhi(a.x) + s0.z * bflo(a.y) + s0.w * bfhi(a.y)) + (s1.x * bflo(a.z) + s1.y * bfhi(a.z) + s1.z * bflo(a.w) + s1.w * bfhi(a.w))
                          + (s2.x * bflo(b2.x) + s2.y * bfhi(b2.x) + s2.z * bflo(b2.y) + s2.w * bfhi(b2.y)) + (s3.x * bflo(b2.z) + s3.y * bfhi(b2.z) + s3.z * bflo(b2.w) + s3.w * bfhi(b2.w)); } }
#pragma unroll
        for (int o = 1; o < 64; o <<= 1) {
#pragma unroll
            for (int r = 0; r < 4; ++r)
#pragma unroll
                for (int c = 0; c < 5; ++c) acc[r][c] += shx(acc[r][c], F.lane, o); }
        if (F.lane < 20) { const int r = F.lane / 5, c = F.lane % 5; float v = 0.f;
#pragma unroll
            for (int rr = 0; rr < 4; ++rr)
#pragma unroll
                for (int cc = 0; cc < 5; ++cc) v = (rr == r && cc == c) ? acc[rr][cc] : v;
            SWb[((size_t)s * 5 + c) * 5632 + n + r] = v; }
    }
}
__device__ __forceinline__ void rp_mla_fin2(Frame& F, const bf16* qraw, const bf16* kvraw, const float* lat, const float* ckpe_j, const float* gqn, const float* gkn, const float* tab, bf16* Q, bf16* K) {
    for (int idx = F.bx * NTHR + F.tid; idx < T * 32; idx += F.G * NTHR) {
        const int row = idx >> 5, hd = (idx >> 1) & 15, hf = idx & 1; const bool latent = row >= TP; const int tl = (row - TP) & 1023;
        float v[48]; float ss = 0.f;
#pragma unroll
        for (int i = 0; i < 6; ++i) ld8(qraw + (size_t)row * 1536 + hd * 96 + hf * 48 + 8 * i, v + 8 * i);
#pragma unroll
        for (int d = 0; d < 48; ++d) ss += v[d] * v[d];
        ss += shx(ss, F.lane, 1);
        const float r = rsqrtf(ss * (1.f / 96) + EPS) * QSCALE;
#pragma unroll
        for (int d = 0; d < 48; ++d) v[d] = v[d] * r * gqn[hf * 48 + d];
        if (latent && hf) rope32_tab(v + 16, tl, tab);
#pragma unroll
        for (int i = 0; i < 6; ++i) st8(Q + ((size_t)row * 16 + hd) * 96 + hf * 48 + 8 * i, v + 8 * i);
    }
    asm volatile("" ::: "memory");
    for (int idx = F.bx * NTHR + F.tid; idx < (T + NCTX) * 32; idx += F.G * NTHR) {
        const int row = idx >> 5, hd = (idx >> 1) & 15, hf = idx & 1; const bool latent = row >= TP && row < T; const int tl = (row - TP) & 1023;
        float v[48]; float ss = 0.f;
        if (hf == 0) {
#pragma unroll
            for (int i = 0; i < 6; ++i) ld8(kvraw + (size_t)row * 2048 + hd * 128 + 8 * i, v + 8 * i);
        } else {
#pragma unroll
            for (int i = 0; i < 2; ++i) ld8(kvraw + (size_t)row * 2048 + hd * 128 + 48 + 8 * i, v + 8 * i);
            const float* kp = row < T ? lat + (size_t)row * 768 + 640 : ckpe_j + ((size_t)((row - T) >> 8) * 2 * 256 + ((row - T) & 255)) * 32;
#pragma unroll
            for (int i = 0; i < 8; ++i) { const v4f p4 = *(const GAS v4f*)(kp + 4 * i); v[16 + 4 * i] = p4.x; v[17 + 4 * i] = p4.y; v[18 + 4 * i] = p4.z; v[19 + 4 * i] = p4.w; }
        }
#pragma unroll
        for (int d = 0; d < 48; ++d) ss += v[d] * v[d];
        ss += shx(ss, F.lane, 1);
        const float r = rsqrtf(ss * (1.f / 96) + EPS);
#pragma unroll
        for (int d = 0; d < 48; ++d) v[d] = v[d] * r * gkn[hf * 48 + d];
        if (latent && hf) rope32_tab(v + 16, tl, tab);
#pragma unroll
        for (int i = 0; i < 6; ++i) st8(K + ((size_t)row * 16 + hd) * 96 + hf * 48 + 8 * i, v + 8 * i);
    }
}
__device__ __forceinline__ void rp_dwconv(Frame& F, const bf16* u, const float* wdw, const float* bdw, const float* gln, const float* bln, bf16* vout) {
    LAS float* red = (LAS float*)F.lds;
    const int c = 2 * F.tid;
    for (int it = F.vcu; it < T / 16; it += F.G) {
        const int row0 = 16 * it; int t0, L; row_pos(row0, t0, L);
        v2f w[31];
#pragma unroll
        for (int k = 0; k < 31; ++k) w[k] = *(const GAS v2f*)(wdw + k * 1024 + c);
        const v2f bb = *(const GAS v2f*)(bdw + c);
        float y0[16], y1[16];
#pragma unroll
        for (int r = 0; r < 16; ++r) { y0[r] = bb.x; y1[r] = bb.y; }
#pragma unroll
        for (int rr = 0; rr < 46; ++rr) {
            const int tt = t0 - 15 + rr; unsigned pk = 0u;
            if (tt >= 0 && tt < L) pk = *(const GAS unsigned*)(u + (size_t)(row0 - 15 + rr) * 1024 + c);
            const float u0 = bflo(pk), u1 = bfhi(pk);
#pragma unroll
            for (int k = 0; k < 31; ++k) { const int r = rr - k; if (r >= 0 && r < 16) { y0[r] += u0 * w[k].x; y1[r] += u1 * w[k].y; } }
        }
        float s[16];
#pragma unroll
        for (int r = 0; r < 16; ++r) s[r] = y0[r] + y1[r];
#pragma unroll
        for (int o = 1; o < 64; o <<= 1) {
#pragma unroll
            for (int r = 0; r < 16; ++r) s[r] += shx(s[r], F.lane, o); }
        __syncthreads();
        if (F.lane < 16) { float v = s[0];
#pragma unroll
            for (int r = 1; r < 16; ++r) v = F.lane == r ? s[r] : v;
            red[F.wave * 16 + F.lane] = v; }
        __syncthreads();
        float mean[16];
#pragma unroll
        for (int r = 0; r < 16; ++r) { float m = 0.f;
#pragma unroll
            for (int wv = 0; wv < 8; ++wv) m += red[wv * 16 + r];
            mean[r] = m * (1.f / 1024); }
#pragma unroll
        for (int r = 0; r < 16; ++r) { y0[r] -= mean[r]; y1[r] -= mean[r]; s[r] = y0[r] * y0[r] + y1[r] * y1[r]; }
#pragma unroll
        for (int o = 1; o < 64; o <<= 1) {
#pragma unroll
            for (int r = 0; r < 16; ++r) s[r] += shx(s[r], F.lane, o); }
        __syncthreads();
        if (F.lane < 16) { float v = s[0];
#pragma unroll
            for (int r = 1; r < 16; ++r) v = F.lane == r ? s[r] : v;
            red[F.wave * 16 + F.lane] = v; }
        __syncthreads();
        const v2f gg = *(const GAS v2f*)(gln + c), bl = *(const GAS v2f*)(bln + c);
#pragma unroll
        for (int r = 0; r < 16; ++r) { float q = 0.f;
#pragma unroll
            for (int wv = 0; wv < 8; ++wv) q += red[wv * 16 + r];
            const float rs = rsqrtf(q * (1.f / 1024) + EPS);
            const float z0 = y0[r] * rs * gg.x + bl.x, z1 = y1[r] * rs * gg.y + bl.y;
            *(GAS unsigned*)(vout + (size_t)(row0 + r) * 1024 + c) = pk2(z0 / (1.f + __expf(-z0)), z1 / (1.f + __expf(-z1))); }
    }
    __syncthreads();
}
__device__ __forceinline__ void rp_ssd_conv(Frame& F, const bf16* xpre, const float* dtraw, const float* wc, const float* bc, const float* dtb, const float* alog, bf16* xbc, float* dt, float* acum) {
    for (int idx = F.bx * NTHR + F.tid; idx < (T / 32) * 384; idx += F.G * NTHR) {
        const int seg = idx / 384, cg = idx - seg * 384, c0 = 8 * cg, row0 = 32 * seg; int t0, L; row_pos(row0, t0, L);
        float w[5][8], bias[8];
#pragma unroll
        for (int k = 0; k < 5; ++k) { const v4f a = *(const GAS v4f*)(wc + k * 3072 + c0), b2 = *(const GAS v4f*)(wc + k * 3072 + c0 + 4);
            w[k][0] = a.x; w[k][1] = a.y; w[k][2] = a.z; w[k][3] = a.w; w[k][4] = b2.x; w[k][5] = b2.y; w[k][6] = b2.z; w[k][7] = b2.w; }
        { const v4f a = *(const GAS v4f*)(bc + c0), b2 = *(const GAS v4f*)(bc + c0 + 4); bias[0] = a.x; bias[1] = a.y; bias[2] = a.z; bias[3] = a.w; bias[4] = b2.x; bias[5] = b2.y; bias[6] = b2.z; bias[7] = b2.w; }
        float win[5][8];
#pragma unroll
        for (int k = 0; k < 4; ++k) { const int tt = t0 + k - 2;
            if (tt >= 0 && tt < L) ld8(xpre + (size_t)(row0 + k - 2) * 3072 + c0, win[k + 1]);
            else {
#pragma unroll
                for (int i = 0; i < 8; ++i) win[k + 1][i] = 0.f; } }
#pragma unroll 4
        for (int r = 0; r < 32; ++r) {
#pragma unroll
            for (int k = 0; k < 4; ++k)
#pragma unroll
                for (int i = 0; i < 8; ++i) win[k][i] = win[k + 1][i];
            const int tt = t0 + r + 2;
            if (tt < L) ld8(xpre + (size_t)(row0 + r + 2) * 3072 + c0, win[4]);
            else {
#pragma unroll
                for (int i = 0; i < 8; ++i) win[4][i] = 0.f; }
            float a[8];
#pragma unroll
            for (int i = 0; i < 8; ++i) { float v = bias[i];
#pragma unroll
                for (int k = 0; k < 5; ++k) v += win[k][i] * w[k][i];
                a[i] = v / (1.f + __expf(-v)); }
            st8(xbc + (size_t)(row0 + r) * 3072 + c0, a);
        }
    }
    for (int it = F.gw; it < 64 * 64; it += F.NGW) {
        const int ch = it >> 6, e = it & 63, dir = e >> 5, row0 = 128 * ch, lane = F.lane;
        const float aa = -expf(alog[e]), bb = dtb[e];
        const int i0 = dir == 0 ? lane : 127 - lane, i1 = dir == 0 ? lane + 64 : 63 - lane;
        const float d0 = softplus_f(dtraw[(size_t)(row0 + i0) * 64 + e] + bb), d1 = softplus_f(dtraw[(size_t)(row0 + i1) * 64 + e] + bb);
        float s0 = d0 * aa, s1 = d1 * aa;
#pragma unroll
        for (int o = 1; o < 64; o <<= 1) { const float u0 = __builtin_bit_cast(float, __builtin_amdgcn_ds_bpermute((lane - o) << 2, __builtin_bit_cast(int, s0))), u1 = __builtin_bit_cast(float, __builtin_amdgcn_ds_bpermute((lane - o) << 2, __builtin_bit_cast(int, s1)));
            if (lane >= o) { s0 += u0; s1 += u1; } }
        s1 += __builtin_bit_cast(float, __builtin_amdgcn_readlane(__builtin_bit_cast(int, s0), 63));
        dt[(size_t)(row0 + i0) * 64 + e] = d0; dt[(size_t)(row0 + i1) * 64 + e] = d1;
        acum[(size_t)(row0 + i0) * 64 + e] = s0; acum[(size_t)(row0 + i1) * 64 + e] = s1;
    }
}
__device__ __forceinline__ void rp_ssd_gate(Frame& F, const bf16* y, const bf16* z, const float* gn, bf16* yn) {
    for (int row = F.gw; row < T; row += F.NGW) {
#pragma unroll
        for (int g = 0; g < 4; ++g) { const int c0 = g * 512 + 8 * F.lane; float zz[8], v[8]; ld8(z + (size_t)row * 2048 + c0, zz);
            float yb[8]; ld8(y + (size_t)row * 2048 + c0, v); ld8(y + (size_t)(T + row) * 2048 + c0, yb);
#pragma unroll
            for (int i = 0; i < 8; ++i) v[i] += yb[i];
            float ss = 0.f;
#pragma unroll
            for (int i = 0; i < 8; ++i) { v[i] = v[i] * zz[i] / (1.f + __expf(-zz[i])); ss += v[i] * v[i]; }
            const float r = rsqrtf(wsum(ss, F.lane) * (1.f / 512) + EPS);
#pragma unroll
            for (int i = 0; i < 8; ++i) v[i] = v[i] * r * gn[c0 + i];
            st8(yn + (size_t)row * 2048 + c0, v); }
    }
}

typedef short a_bf16x8 __attribute__((ext_vector_type(8)));
typedef short a_s16x4 __attribute__((ext_vector_type(4)));
typedef float a_f32x16 __attribute__((ext_vector_type(16)));
typedef float a_f32x2 __attribute__((ext_vector_type(2))); typedef __bf16 a_bf16x2 __attribute__((ext_vector_type(2)));
__device__ __forceinline__ unsigned a_cvtpk(float lo, float hi) { a_f32x2 v = {lo, hi}; a_bf16x2 b = __builtin_convertvector(v, a_bf16x2); return __builtin_bit_cast(unsigned, b); }
__device__ __forceinline__ a_s16x4 a_vtr(const LAS unsigned char* p) { return __builtin_bit_cast(a_s16x4, __builtin_amdgcn_ds_read_tr16_b64_v4i16((LAS a_s16x4*)p)); }
constexpr int AT_KS = 208, AT_VS = 192, AT_KB = 64 * AT_KS, AT_VB = 64 * AT_VS, AT_VOFF = 2 * AT_KB;
__device__ __forceinline__ void at_tile(Frame& F, LAS unsigned char* lds, int buf, int lane, const a_bf16x8 (&qf)[6], a_f32x16& o0, a_f32x16& o1, float& m, float& l) {
    const int r32 = lane & 31, hi = lane >> 5;
    a_f32x16 p0, p1;
#pragma unroll
    for (int r = 0; r < 16; ++r) { p0[r] = 0.f; p1[r] = 0.f; }
    { const LAS unsigned char* kp = lds + buf * AT_KB + r32 * AT_KS + hi * 16;
#pragma unroll
      for (int s = 0; s < 6; ++s) { const a_bf16x8 a0 = *(const LAS a_bf16x8*)(kp + 32 * s), a1 = *(const LAS a_bf16x8*)(kp + 32 * AT_KS + 32 * s);
          p0 = __builtin_amdgcn_mfma_f32_32x32x16_bf16(a0, qf[s], p0, 0, 0, 0); p1 = __builtin_amdgcn_mfma_f32_32x32x16_bf16(a1, qf[s], p1, 0, 0, 0); } }

    float mx = fmaxf(p0[0], p1[0]);
#pragma unroll
    for (int r = 1; r < 16; ++r) mx = fmaxf(mx, fmaxf(p0[r], p1[r]));
    mx = fmaxf(mx, shx(mx, lane, 32));
    const float mn = fmaxf(m, mx), alpha = __builtin_amdgcn_exp2f(m - mn); m = mn;
    float ps = 0.f;
#pragma unroll
    for (int r = 0; r < 16; ++r) { p0[r] = __builtin_amdgcn_exp2f(p0[r] - mn); p1[r] = __builtin_amdgcn_exp2f(p1[r] - mn); ps += p0[r] + p1[r]; }
    l = l * alpha + ps;
#pragma unroll
    for (int r = 0; r < 16; ++r) { o0[r] *= alpha; o1[r] *= alpha; }
    v4u pw[4];
    pw[0] = (v4u){a_cvtpk(p0[0], p0[1]), a_cvtpk(p0[2], p0[3]), a_cvtpk(p0[4], p0[5]), a_cvtpk(p0[6], p0[7])};
    pw[1] = (v4u){a_cvtpk(p0[8], p0[9]), a_cvtpk(p0[10], p0[11]), a_cvtpk(p0[12], p0[13]), a_cvtpk(p0[14], p0[15])};
    pw[2] = (v4u){a_cvtpk(p1[0], p1[1]), a_cvtpk(p1[2], p1[3]), a_cvtpk(p1[4], p1[5]), a_cvtpk(p1[6], p1[7])};
    pw[3] = (v4u){a_cvtpk(p1[8], p1[9]), a_cvtpk(p1[10], p1[11]), a_cvtpk(p1[12], p1[13]), a_cvtpk(p1[14], p1[15])};

    const LAS unsigned char* vp0 = lds + AT_VOFF + buf * AT_VB + (4 * hi + ((lane & 15) >> 2)) * AT_VS + (16 * ((lane >> 4) & 1) + 4 * (lane & 3)) * 2;
    a_s16x4 vl0[4], vh0[4], vl1[4], vh1[4];
#pragma unroll
    for (int bs = 0; bs < 4; ++bs) { const LAS unsigned char* vq = vp0 + (16 * bs) * AT_VS; vl0[bs] = a_vtr(vq); vh0[bs] = a_vtr(vq + 8 * AT_VS); vl1[bs] = a_vtr(vq + 64); vh1[bs] = a_vtr(vq + 8 * AT_VS + 64); }
#pragma unroll
    for (int bs = 0; bs < 4; ++bs) {
        const a_bf16x8 v0 = (a_bf16x8){vl0[bs][0], vl0[bs][1], vl0[bs][2], vl0[bs][3], vh0[bs][0], vh0[bs][1], vh0[bs][2], vh0[bs][3]}, v1 = (a_bf16x8){vl1[bs][0], vl1[bs][1], vl1[bs][2], vl1[bs][3], vh1[bs][0], vh1[bs][1], vh1[bs][2], vh1[bs][3]};
        const a_bf16x8 pb = __builtin_bit_cast(a_bf16x8, pw[bs]);
        o0 = __builtin_amdgcn_mfma_f32_32x32x16_bf16(v0, pb, o0, 0, 0, 0); o1 = __builtin_amdgcn_mfma_f32_32x32x16_bf16(v1, pb, o1, 0, 0, 0); }
}
__device__ __forceinline__ void ph_attn(Frame& F, const bf16* Q, const bf16* K, const bf16* KV, bf16* AO) {
    const int lane = F.lane, r32 = lane & 31, hi = lane >> 5, wave = F.wave, tid = F.tid;
    LAS unsigned char* lds = F.lds;
    const int kr_a = tid / 12, kp_a = tid % 12, kr_b = (tid + 512) / 12, kp_b = (tid + 512) % 12, vr = tid >> 3, vp = tid & 7;
    const bool has_b = tid < 256;
    for (int uu = F.vcu; uu < 512; uu += F.G) {
        int head, q0, NT, kbase_ctx, kbase_lat;
        if (uu < 256) { const int seq = uu >> 4; head = uu & 15; q0 = seq * 256; NT = 4; kbase_ctx = seq * 256; kbase_lat = 0; }
        else { const int u2 = uu - 256, b = u2 >> 6, qb = u2 & 3; head = (u2 >> 2) & 15; q0 = TP + b * 1024 + qb * 256; NT = 20; kbase_ctx = T + b * 256; kbase_lat = TP + b * 1024; }
        a_bf16x8 qf[6];
        { const bf16* qp = Q + ((size_t)(q0 + wave * 32 + r32) * 16 + head) * 96 + hi * 8;
#pragma unroll
          for (int s = 0; s < 6; ++s) qf[s] = *(const GAS a_bf16x8*)(qp + 16 * s); }
        a_f32x16 o0, o1;
#pragma unroll
        for (int r = 0; r < 16; ++r) { o0[r] = 0.f; o1[r] = 0.f; }
        float m = -INFINITY, l = 0.f;
        v4u ka0, kb0, vv0, ka1, kb1, vv1, ka2, kb2_, vv2;
#define AT_LOAD(t, KA, KB2, VV) do { const int kr0_ = (t) < 4 ? kbase_ctx + 64 * (t) : kbase_lat + 64 * ((t) - 4); \
            KA = *(const GAS v4u*)(K + ((size_t)(kr0_ + kr_a) * 16 + head) * 96 + kp_a * 8); \
            if (has_b) KB2 = *(const GAS v4u*)(K + ((size_t)(kr0_ + kr_b) * 16 + head) * 96 + kp_b * 8); \
            VV = *(const GAS v4u*)(KV + (size_t)(kr0_ + vr) * 2048 + head * 128 + 64 + vp * 8); } while (0)
#define AT_STORE(buf, KA, KB2, VV) do { *(LAS v4u*)(lds + (buf) * AT_KB + kr_a * AT_KS + kp_a * 16) = KA; \
            if (has_b) *(LAS v4u*)(lds + (buf) * AT_KB + kr_b * AT_KS + kp_b * 16) = KB2; \
            *(LAS v4u*)(lds + AT_VOFF + (buf) * AT_VB + vr * AT_VS + vp * 16) = VV; } while (0)
#define AT_STEP(k, SA, SB, SC, SD_, SE_, SF_, SG, SH, SI) if (t + (k) < NT) { \
            if (t + (k) + 3 < NT) AT_LOAD(t + (k) + 3, SA, SB, SC);            \
            at_tile(F, lds, (k) & 1, lane, qf, o0, o1, m, l); \
            if (t + (k) + 1 < NT) AT_STORE(((k) + 1) & 1, SD_, SE_, SF_);       \
            LDS_BARRIER(); }
        AT_LOAD(0, ka0, kb0, vv0); AT_LOAD(1, ka1, kb1, vv1); AT_LOAD(2, ka2, kb2_, vv2);
        AT_STORE(0, ka0, kb0, vv0);
        LDS_BARRIER();
#pragma unroll 1
        for (int t = 0; t < NT; t += 6) {
            AT_STEP(0, ka0, kb0, vv0, ka1, kb1, vv1, 0, 0, 0)
            AT_STEP(1, ka1, kb1, vv1, ka2, kb2_, vv2, 0, 0, 0)
            AT_STEP(2, ka2, kb2_, vv2, ka0, kb0, vv0, 0, 0, 0)
            AT_STEP(3, ka0, kb0, vv0, ka1, kb1, vv1, 0, 0, 0)
            AT_STEP(4, ka1, kb1, vv1, ka2, kb2_, vv2, 0, 0, 0)
            AT_STEP(5, ka2, kb2_, vv2, ka0, kb0, vv0, 0, 0, 0)
        }
#undef AT_STEP
#undef AT_LOAD
#undef AT_STORE
        l += shx(l, lane, 32);
        const float il = 1.f / l;
        bf16* op = AO + (size_t)(q0 + wave * 32 + r32) * 1024 + head * 64 + 4 * hi;
#pragma unroll
        for (int g4 = 0; g4 < 4; ++g4) {
            v2u w0; w0.x = a_cvtpk(o0[4 * g4] * il, o0[4 * g4 + 1] * il); w0.y = a_cvtpk(o0[4 * g4 + 2] * il, o0[4 * g4 + 3] * il); *(GAS v2u*)(op + 8 * g4) = w0;
            v2u w1; w1.x = a_cvtpk(o1[4 * g4] * il, o1[4 * g4 + 1] * il); w1.y = a_cvtpk(o1[4 * g4 + 2] * il, o1[4 * g4 + 3] * il); *(GAS v2u*)(op + 32 + 8 * g4) = w1; }

    }
}
constexpr int SC_ST = 272, SC_XS = 144;
constexpr int SC_C = 0, SC_B = 128 * SC_ST, SC_M = 2 * 128 * SC_ST, SC_H = 3 * 128 * SC_ST, SC_X = SC_H + 64 * SC_ST, SC_XW = SC_X + 128 * SC_XS, SC_ARR = SC_XW + 128 * SC_XS;
static_assert(SC_ARR + 4 * 128 * 4 + 16 <= PTAB_OFF_C, "scan LDS map");
__device__ __forceinline__ int a_crow(int r, int hi) { return (r & 3) + 8 * (r >> 2) + 4 * hi; }
__device__ __forceinline__ void ph_scan(Frame& F, const bf16* xbc, const float* dt, const float* acg, const float* dsk, const float* st0, bf16* y, float* out) {
    const int lane = F.lane, r32 = lane & 31, hi = lane >> 5, wave = F.wave, tid = F.tid;
    LAS unsigned char* lds = F.lds;
    LAS float* acum = (LAS float*)(lds + SC_ARR); LAS float* wj = acum + 128; LAS float* ei = acum + 256; LAS float* dtj = acum + 384; LAS float* misc = acum + 512;
    const int q4 = (lane & 15) >> 2, gg = (lane >> 4) & 1, p4 = lane & 3;
    const int ib = wave >> 1, pb = wave & 1, nb = wave >> 1;
    v4u cr[4], br[4], xr[2];
    float pdt[2], pac[2], plast, pac_t, pdt_t;
#define SC_GLOADP(rowb_, g_, hd_, dir_) do { const int row0_ = (rowb_); \
        _Pragma("unroll") for (int k = 0; k < 4; ++k) { const int q = tid + 512 * k, rr = q >> 4, pp = q & 15; \
            cr[k] = *(const GAS v4u*)(xbc + (size_t)(row0_ + rr) * 3072 + 2560 + (g_) * 128 + pp * 8); br[k] = *(const GAS v4u*)(xbc + (size_t)(row0_ + rr) * 3072 + 2048 + (g_) * 128 + pp * 8); } \
        _Pragma("unroll") for (int k = 0; k < 2; ++k) { const int q = tid + 512 * k, rr = q >> 3, pp = q & 7; xr[k] = *(const GAS v4u*)(xbc + (size_t)(row0_ + rr) * 3072 + (hd_) * 64 + pp * 8); \
            pdt[k] = dt[(size_t)(row0_ + rr) * 64 + (dir_) * 32 + (hd_)]; pac[k] = acg[(size_t)(row0_ + rr) * 64 + (dir_) * 32 + (hd_)]; } \
        plast = acg[(size_t)(row0_ + ((dir_) == 0 ? 127 : 0)) * 64 + (dir_) * 32 + (hd_)]; \
        pac_t = acg[(size_t)(row0_ + (tid & 127)) * 64 + (dir_) * 32 + (hd_)]; pdt_t = dt[(size_t)(row0_ + (tid & 127)) * 64 + (dir_) * 32 + (hd_)]; } while (0)
#define SC_ITEM(slot_, ii_, seq_, hd_) do { if ((slot_) < 128) { seq_ = 16 + ((slot_) >> 5); hd_ = (slot_) & 31; } else { const int pi_ = 4 * ((slot_) - 128) + (ii_); seq_ = pi_ >> 5; hd_ = pi_ & 31; } } while (0)
    for (int slot = F.vcu; slot < 256; slot += F.G) {
        const int nitem = slot < 128 ? 1 : 4;
        { int seq0, hd0; SC_ITEM(slot, 0, seq0, hd0); SC_GLOADP(seq0 < 16 ? seq0 * 256 : TP + (seq0 - 16) * 1024, hd0 >> 3, hd0, 0); }
#pragma unroll 1
        for (int ii = 0; ii < nitem; ++ii) {
            int seq, hd;
            if (slot < 128) { seq = 16 + (slot >> 5); hd = slot & 31; } else { const int pi = 4 * (slot - 128) + ii; seq = pi >> 5; hd = pi & 31; }
            const int g = hd >> 3, r0 = seq < 16 ? seq * 256 : TP + (seq - 16) * 1024, nc = seq < 16 ? 2 : 8;
#pragma unroll 1
            for (int dir = 0; dir < 2; ++dir) {
                const float dd = dsk[dir * 32 + hd];
                a_f32x16 hacc;
                if (seq < 16) {
#pragma unroll
                    for (int r = 0; r < 16; ++r) hacc[r] = 0.f;
                } else { const float* s0 = st0 + ((((size_t)(seq - 16) * 2 + dir) * 32 + hd) * 64 + 32 * pb + r32) * 128 + 32 * nb + 4 * hi;
#pragma unroll
                    for (int g4 = 0; g4 < 4; ++g4) { const v4f t4 = *(const GAS v4f*)(s0 + 8 * g4); hacc[4 * g4] = t4.x; hacc[4 * g4 + 1] = t4.y; hacc[4 * g4 + 2] = t4.z; hacc[4 * g4 + 3] = t4.w; } }
#pragma unroll
                for (int g4 = 0; g4 < 4; ++g4) { v2u w; w.x = a_cvtpk(hacc[4 * g4], hacc[4 * g4 + 1]); w.y = a_cvtpk(hacc[4 * g4 + 2], hacc[4 * g4 + 3]);
                    *(LAS v2u*)(lds + SC_H + (32 * pb + r32) * SC_ST + (32 * nb + 8 * g4 + 4 * hi) * 2) = w; }
#pragma unroll 1
                for (int cc = 0; cc < nc; ++cc) {
                    const int c = dir == 0 ? cc : nc - 1 - cc, row0 = r0 + c * 128;
                    const int e = dir * 32 + hd;
                    const float last = plast;
                    LDS_BARRIER();
                    if (tid < 128) { const float ac = pac_t, dv = pdt_t;
                        acum[tid] = ac; dtj[tid] = dv; ei[tid] = __expf(ac); if (tid == 0) misc[0] = __expf(last); }
#pragma unroll
                    for (int k = 0; k < 4; ++k) { const int q = tid + 512 * k, rr = q >> 4, pp = q & 15; *(LAS v4u*)(lds + SC_C + rr * SC_ST + pp * 16) = cr[k]; *(LAS v4u*)(lds + SC_B + rr * SC_ST + pp * 16) = br[k]; }
#pragma unroll
                    for (int k = 0; k < 2; ++k) { const int q = tid + 512 * k, rr = q >> 3, pp = q & 7; *(LAS v4u*)(lds + SC_X + rr * SC_XS + pp * 16) = xr[k];
                        const float w = pdt[k] * __expf(last - pac[k]);
                        v4u s; s.x = a_cvtpk(bflo(xr[k].x) * w, bfhi(xr[k].x) * w); s.y = a_cvtpk(bflo(xr[k].y) * w, bfhi(xr[k].y) * w); s.z = a_cvtpk(bflo(xr[k].z) * w, bfhi(xr[k].z) * w); s.w = a_cvtpk(bflo(xr[k].w) * w, bfhi(xr[k].w) * w);
                        *(LAS v4u*)(lds + SC_XW + rr * SC_XS + pp * 16) = s; }
                    { int nrow = 0, nhd = hd, ndir = dir; bool hn = true;
                      if (cc + 1 < nc) nrow = r0 + (dir == 0 ? cc + 1 : nc - 2 - cc) * 128;
                      else if (dir == 0) { nrow = r0 + (nc - 1) * 128; ndir = 1; }
                      else if (ii + 1 < nitem) { int seqn; SC_ITEM(slot, ii + 1, seqn, nhd); nrow = seqn < 16 ? seqn * 256 : TP + (seqn - 16) * 1024; ndir = 0; }
                      else hn = false;
                      if (hn) SC_GLOADP(nrow, nhd >> 3, nhd, ndir); }
                    LDS_BARRIER();
#pragma unroll 1
                    for (int tt = 0; tt < 2; ++tt) {
                        int lt = tt == 0 ? wave : (wave < 2 ? 8 + wave : 10 + (wave - 2));
                        const int ta = lt == 0 ? 0 : lt == 1 ? 0 : lt == 2 ? 0 : lt == 3 ? 0 : lt == 4 ? 1 : lt == 5 ? 1 : lt == 6 ? 1 : lt == 7 ? 2 : lt == 8 ? 2 : lt == 9 ? 3 : lt == 10 ? 1 : lt == 11 ? 2 : lt == 12 ? 2 : lt == 13 ? 3 : lt == 14 ? 3 : 3;
                        const int tb = lt == 0 ? 0 : lt == 1 ? 1 : lt == 2 ? 2 : lt == 3 ? 3 : lt == 4 ? 1 : lt == 5 ? 2 : lt == 6 ? 3 : lt == 7 ? 2 : lt == 8 ? 3 : lt == 9 ? 3 : lt == 10 ? 0 : lt == 11 ? 0 : lt == 12 ? 1 : lt == 13 ? 0 : lt == 14 ? 1 : 2;
                        const int jb = dir == 0 ? ta : tb, ibg = dir == 0 ? tb : ta;
                        const bool dead = lt >= 10;
                        a_f32x16 gt;
#pragma unroll
                        for (int r = 0; r < 16; ++r) gt[r] = 0.f;
                        if (!dead) {
                            const LAS unsigned char* ap = lds + SC_B + (32 * jb + r32) * SC_ST + hi * 16; const LAS unsigned char* bp = lds + SC_C + (32 * ibg + r32) * SC_ST + hi * 16;
#pragma unroll
                            for (int s = 0; s < 8; ++s) gt = __builtin_amdgcn_mfma_f32_32x32x16_bf16(*(const LAS a_bf16x8*)(ap + 32 * s), *(const LAS a_bf16x8*)(bp + 32 * s), gt, 0, 0, 0);
                            const int i = 32 * ibg + r32; const float ai = acum[i];
                            v4f aj[4], dj[4];
#pragma unroll
                            for (int g4 = 0; g4 < 4; ++g4) { aj[g4] = *(const LAS v4f*)(acum + 32 * jb + 8 * g4 + 4 * hi); dj[g4] = *(const LAS v4f*)(dtj + 32 * jb + 8 * g4 + 4 * hi); }
#pragma unroll
                            for (int r = 0; r < 16; ++r) { const int j = 32 * jb + a_crow(r, hi); const bool keep = dir == 0 ? j <= i : j >= i;
                                const float e = __builtin_amdgcn_exp2f(fminf(ai - aj[r >> 2][r & 3], 0.f) * 1.4426950408889634f) * dj[r >> 2][r & 3];
                                gt[r] = keep ? gt[r] * e + (j == i ? dd : 0.f) : 0.f; }
                        }
#pragma unroll
                        for (int g4 = 0; g4 < 4; ++g4) { v2u w; w.x = a_cvtpk(gt[4 * g4], gt[4 * g4 + 1]); w.y = a_cvtpk(gt[4 * g4 + 2], gt[4 * g4 + 3]);
                            *(LAS v2u*)(lds + SC_M + (32 * ibg + r32) * SC_ST + (32 * jb + 8 * g4 + 4 * hi) * 2) = w; }
                    }
                    a_f32x16 yo;
#pragma unroll
                    for (int r = 0; r < 16; ++r) yo[r] = 0.f;
                    { const LAS unsigned char* ap = lds + SC_C + (32 * ib + r32) * SC_ST + hi * 16; const LAS unsigned char* bp = lds + SC_H + (32 * pb + r32) * SC_ST + hi * 16;
#pragma unroll
                      for (int s = 0; s < 8; ++s) yo = __builtin_amdgcn_mfma_f32_32x32x16_bf16(*(const LAS a_bf16x8*)(ap + 32 * s), *(const LAS a_bf16x8*)(bp + 32 * s), yo, 0, 0, 0); }
                    LDS_BARRIER();
                    a_f32x16 yd;
#pragma unroll
                    for (int r = 0; r < 16; ++r) yd[r] = 0.f;
                    { const LAS unsigned char* ap = lds + SC_M + (32 * ib + r32) * SC_ST + hi * 16; const LAS unsigned char* xp = lds + SC_X + (8 * hi + q4) * SC_XS + (32 * pb + 16 * gg + 4 * p4) * 2;
#pragma unroll
                      for (int s = 0; s < 8; ++s) { const a_s16x4 l0 = a_vtr(xp + (16 * s) * SC_XS), h0 = a_vtr(xp + (16 * s + 4) * SC_XS);
                          const a_bf16x8 xb = (a_bf16x8){l0[0], l0[1], l0[2], l0[3], h0[0], h0[1], h0[2], h0[3]};
                          yd = __builtin_amdgcn_mfma_f32_32x32x16_bf16(*(const LAS a_bf16x8*)(ap + 32 * s), xb, yd, 0, 0, 0); } }
                    { bf16* yp = y + (size_t)dir * T * 2048 + (size_t)(row0 + 32 * ib) * 2048 + hd * 64 + 32 * pb + r32;
                      v4f e4[4];
#pragma unroll
                      for (int g4 = 0; g4 < 4; ++g4) e4[g4] = *(const LAS v4f*)(ei + 32 * ib + 8 * g4 + 4 * hi);
#pragma unroll
                      for (int r = 0; r < 16; ++r) { const int i = a_crow(r, hi); const float v = yd[r] + e4[r >> 2][r & 3] * yo[r]; yp[(size_t)i * 2048] = (bf16)f2bf(v); } }
                    { const float dec = misc[0];
#pragma unroll
                      for (int r = 0; r < 16; ++r) hacc[r] *= dec;
                      const LAS unsigned char* bq = lds + SC_B + (8 * hi + q4) * SC_ST + (32 * nb + 16 * gg + 4 * p4) * 2; const LAS unsigned char* xq = lds + SC_XW + (8 * hi + q4) * SC_XS + (32 * pb + 16 * gg + 4 * p4) * 2;
#pragma unroll
                      for (int s = 0; s < 8; ++s) { const a_s16x4 bl = a_vtr(bq + (16 * s) * SC_ST), bh = a_vtr(bq + (16 * s + 4) * SC_ST), xl = a_vtr(xq + (16 * s) * SC_XS), xh = a_vtr(xq + (16 * s + 4) * SC_XS);
                          const a_bf16x8 av = (a_bf16x8){bl[0], bl[1], bl[2], bl[3], bh[0], bh[1], bh[2], bh[3]}, bv = (a_bf16x8){xl[0], xl[1], xl[2], xl[3], xh[0], xh[1], xh[2], xh[3]};
                          hacc = __builtin_amdgcn_mfma_f32_32x32x16_bf16(av, bv, hacc, 0, 0, 0); } }
#pragma unroll
                    for (int g4 = 0; g4 < 4; ++g4) { v2u w; w.x = a_cvtpk(hacc[4 * g4], hacc[4 * g4 + 1]); w.y = a_cvtpk(hacc[4 * g4 + 2], hacc[4 * g4 + 3]);
                        *(LAS v2u*)(lds + SC_H + (32 * pb + r32) * SC_ST + (32 * nb + 8 * g4 + 4 * hi) * 2) = w; }
                }
                if (seq < 16) { float* o = out + OUT_SSM + ((((size_t)seq * 2 + dir) * 32 + hd) * 64 + 32 * pb + r32) * 128 + 32 * nb + 4 * hi;
#pragma unroll
                    for (int g4 = 0; g4 < 4; ++g4) { v4f t4; t4.x = hacc[4 * g4]; t4.y = hacc[4 * g4 + 1]; t4.z = hacc[4 * g4 + 2]; t4.w = hacc[4 * g4 + 3]; *(GAS v4f*)(o + 8 * g4) = t4; } }
            }
        }
    }
#undef SC_GLOADP
#undef SC_ITEM
    LDS_BARRIER();
}

constexpr int NPHASE = 30;
enum Op { OP_P0, OP_NORM1, OP_G_LAT, OP_FIN1, OP_G_QKV, OP_FIN2, OP_ATTN, OP_G_WO, OP_NORM2, OP_G_FF1, OP_G_FF2, OP_G_PW1, OP_DWCONV, OP_G_PW2, OP_G_SSI, OP_SSCONV, OP_SCAN, OP_GATE, OP_G_SSO };
__device__ __forceinline__ void phase_decode(int ph, int& layer, int& op) {
    if (ph == 0) { layer = 0; op = OP_P0; return; }
    if (ph <= 9) { layer = 0; const int r = ph - 1; op = r == 0 ? OP_NORM1 : r == 1 ? OP_G_LAT : r == 2 ? OP_FIN1 : r == 3 ? OP_G_QKV : r == 4 ? OP_FIN2 : r == 5 ? OP_ATTN : r == 6 ? OP_G_WO : r == 7 ? OP_G_FF1 : OP_G_FF2; }
    else if (ph <= 14) { layer = 1; const int r = ph - 10; op = r == 0 ? OP_G_PW1 : r == 1 ? OP_DWCONV : r == 2 ? OP_G_PW2 : r == 3 ? OP_G_FF1 : OP_G_FF2; }
    else if (ph <= 21) { layer = 2; const int r = ph - 15; op = r == 0 ? OP_G_SSI : r == 1 ? OP_SSCONV : r == 2 ? OP_SCAN : r == 3 ? OP_GATE : r == 4 ? OP_G_SSO : r == 5 ? OP_G_FF1 : OP_G_FF2; }
    else { layer = 3; const int r = ph - 22; op = r == 0 ? OP_G_LAT : r == 1 ? OP_FIN1 : r == 2 ? OP_G_QKV : r == 3 ? OP_FIN2 : r == 4 ? OP_ATTN : r == 5 ? OP_G_WO : r == 6 ? OP_G_FF1 : OP_G_FF2; }
}
struct MArgs { const float* in[38]; float* out; unsigned char* ws; int ph_lo, ph_hi; };
constexpr int PTAB_OFF = PTAB_OFF_C;
__global__ void __launch_bounds__(NTHR, 2) mega_fwd(MArgs args) {
    extern __shared__ __attribute__((aligned(16))) unsigned char lds_raw[];
    LAS unsigned char* lds = (LAS unsigned char*)lds_raw;
    volatile LAS unsigned* PT0 = (volatile LAS unsigned*)(lds + PTAB_OFF);
    volatile LAS unsigned* MISC = (volatile LAS unsigned*)(lds + MISC_OFF);
    { const int t0 = threadIdx.x;
      if (t0 < 40) { const unsigned long long p = t0 < 38 ? (unsigned long long)args.in[t0] : t0 == 38 ? (unsigned long long)args.out : (unsigned long long)args.ws;
          PT0[2 * t0] = (unsigned)p; PT0[2 * t0 + 1] = (unsigned)(p >> 32); }
      if (t0 < 64) MISC[t0] = 0u; }
    __syncthreads();
    XcdBarrier bar = xcd_barrier_post((unsigned*)((unsigned char*)ldp(PT0, PT_WS) + WS_CTL) + CW_BAR, MISC + 8);
    const int wave0 = __builtin_amdgcn_readfirstlane(threadIdx.x >> 6);
    const int ph_hi = args.ph_hi;
    for (int ph = args.ph_lo; ph < ph_hi; ++ph) {
        Frame F;
        { int w = wave0; asm volatile("" : "+s"(w)); F.wave = w; }
        F.lds = lds; F.lane = olane(); F.tid = F.wave * 64 + F.lane;
        const int bx = obid();
        F.G = gridDim.x; F.vcu = (F.G % 8 == 0) ? (bx % 8) * (F.G / 8) + bx / 8 : bx;
        F.gw = F.vcu * NWAVES + F.wave; F.NGW = F.G * NWAVES; F.PT = PT0; F.bx = bx;
        int layer, op; phase_decode(ph, layer, op);
        const int j = layer / 3;
        switch (op) {
        case OP_P0: p0_prologue(F); break;
        case OP_NORM1: { unsigned char* ws = WSP; float* x = OUTP; const float* xlo = layer == 0 ? INP(I_XP) : x; const float* xhi = layer == 0 ? INP(I_XS) - (size_t)TP * 1024 : x;
            rp_normmod(F, xlo, xhi, INP(I_GN1) + layer * 1024, (const float*)(ws + WS_MODS) + (size_t)layer * 5 * 6144, 0, 1024, (bf16*)(ws + WS_H)); rp_tables(F); } break;
        case OP_NORM2: { unsigned char* ws = WSP; float* x = OUTP;
            rp_normmod(F, x, x, INP(I_GN2) + layer * 1024, (const float*)(ws + WS_MODS) + (size_t)layer * 5 * 6144, 3072, 4096, (bf16*)(ws + WS_H)); } break;
        case OP_G_LAT: { unsigned char* ws = WSP; pg8::Gemm g{(const bf16*)(ws + WS_H), (const bf16*)(ws + W_MLA + j * MLA_WB + MW_CAT), T, 768, 1024}; pg8::StaticOrder S; S.init(T, 2 * 768, F.G, F.bx);
            const int s_ = 2 * layer; pg8::EpiF32<1> E{(float*)(ws + A_LAT), 768, layer == 0 ? nullptr : (const float*)(ws + WS_STAT) + s_ * 8192, layer == 0 ? nullptr : (const float*)(ws + WS_SW) + (size_t)s_ * 5 * 5632}; pg8::gemm_phase<pg8::EpiF32<1>, pg8::StaticOrder, true, true, true>(F.lds, g, S, E, F.wave); } break;
        case OP_FIN1: { unsigned char* ws = WSP; rp_mla_fin1(F, (const float*)(ws + A_LAT), INP(I_GQ) + j * 384, INP(I_GKV) + j * 256, (bf16*)(ws + A_QN), (bf16*)(ws + WS_CKV + j * CKV_B), OUTP, j); } break;
        case OP_G_QKV: {
#pragma unroll 1
            for (int w = 0; w < 2; ++w) {
                unsigned char* ws = WSP; unsigned char* wm = ws + W_MLA + j * MLA_WB;
                pg8::Gemm g = w == 0 ? pg8::Gemm{(const bf16*)(ws + A_QN), (const bf16*)(wm + MW_UQ), T, 1536, 384} : pg8::Gemm{(const bf16*)(ws + WS_CKV + j * CKV_B), (const bf16*)(wm + MW_UKV), T + NCTX, 2048, 256};
                pg8::StaticOrder S; S.init(g.M, g.N, F.G, w == 0 ? F.bx : (int)((F.bx + 64) % F.G));
                pg8::EpiBf16P E{w == 0 ? (bf16*)(ws + A_QRAW) : (bf16*)(ws + A_KVRAW), g.N};
                pg8::gemm_phase<pg8::EpiBf16P, pg8::StaticOrder, true, true>(F.lds, g, S, E, F.wave);
            } } break;
        case OP_FIN2: { unsigned char* ws = WSP; rp_mla_fin2(F, (const bf16*)(ws + A_QRAW), (const bf16*)(ws + A_KVRAW), (const float*)(ws + A_LAT), INP(I_CKPE) + (size_t)j * 8192, INP(I_GQN) + j * 96, INP(I_GKN) + j * 96,
                                                        (const float*)(ws + WS_ROPE), (bf16*)(ws + A_QB), (bf16*)(ws + A_KB)); } break;
        case OP_ATTN: { unsigned char* ws = WSP; ph_attn(F, (const bf16*)(ws + A_QB), (const bf16*)(ws + A_KB), (const bf16*)(ws + A_KVRAW), (bf16*)(ws + A_AO)); } break;
        case OP_G_WO: case OP_G_PW2: case OP_G_SSO: case OP_G_FF2: {
            unsigned char* ws = WSP; float* x = OUTP;
            const float* rlo = (layer == 0 && op != OP_G_FF2) ? INP(I_XP) : x; const float* rhi = (layer == 0 && op != OP_G_FF2) ? INP(I_XS) - (size_t)TP * 1024 : x;
            pg8::Gemm g; const float* bias = nullptr; int goff = 2048;
            if (op == OP_G_WO) g = pg8::Gemm{(const bf16*)(ws + A_AO), (const bf16*)(ws + W_MLA + j * MLA_WB + MW_O), T, 1024, 1024};
            else if (op == OP_G_PW2) { g = pg8::Gemm{(const bf16*)(ws + A_V), (const bf16*)(ws + W_CV2), T, 1024, 1024}; bias = INP(I_CVB2); }
            else if (op == OP_G_SSO) g = pg8::Gemm{(const bf16*)(ws + A_YN), (const bf16*)(ws + W_SSO), T, 1024, 2048};
            else { g = pg8::Gemm{(const bf16*)(ws + A_ACT), (const bf16*)(ws + W_FF + layer * FF_WB + FW_OUT), T, 1024, 2816}; goff = 5120; }
            pg8::StaticOrder S; S.init(T, 2 * 1024, F.G, F.bx);
            float* xdst = x;
            const int sn_ = 2 * layer + (op == OP_G_FF2 ? 2 : 1);
            pg8::EpiResid<1> E{rlo, rhi, xdst, (const float*)(ws + WS_MODS) + (size_t)layer * 5 * 6144, goff, bias,
                               sn_ < 8 ? (bf16*)(ws + WS_H) : nullptr, (const float*)(ws + WS_GT) + (size_t)(sn_ & 7) * 5 * 1024, (float*)(ws + WS_STAT) + (sn_ & 7) * 8192};
            pg8::gemm_phase<pg8::EpiResid<1>, pg8::StaticOrder, true, true, true>(F.lds, g, S, E, F.wave); } break;
        case OP_G_FF1: { unsigned char* ws = WSP; pg8::Gemm g{(const bf16*)(ws + WS_H), (const bf16*)(ws + W_FF + layer * FF_WB + FW_IN), T, 5632, 1024}; pg8::StaticOrder S; S.init(T, 5632, F.G, F.bx);
            const int s_ = 2 * layer + 1; pg8::EpiGlu<0> E{(bf16*)(ws + A_ACT), 2816, nullptr, 2816, (const float*)(ws + WS_STAT) + s_ * 8192, (const float*)(ws + WS_SW) + (size_t)s_ * 5 * 5632}; pg8::gemm_phase<pg8::EpiGlu<0>, pg8::StaticOrder, true, true>(F.lds, g, S, E, F.wave); } break;
        case OP_G_PW1: { unsigned char* ws = WSP; pg8::Gemm g{(const bf16*)(ws + WS_H), (const bf16*)(ws + W_CV1), T, 2048, 1024}; pg8::StaticOrder S; S.init(T, 2048, F.G, F.bx);
            const int s_ = 2 * layer; pg8::EpiGlu<1> E{(bf16*)(ws + A_U), 1024, INP(I_CVB1), 1024, (const float*)(ws + WS_STAT) + s_ * 8192, (const float*)(ws + WS_SW) + (size_t)s_ * 5 * 5632}; pg8::gemm_phase<pg8::EpiGlu<1>, pg8::StaticOrder, true, true>(F.lds, g, S, E, F.wave); } break;
        case OP_DWCONV: { unsigned char* ws = WSP; rp_dwconv(F, (const bf16*)(ws + A_U), INP(I_CVWD), INP(I_CVBD), INP(I_CVGL), INP(I_CVBL), (bf16*)(ws + A_V)); } break;
        case OP_G_SSI: { unsigned char* ws = WSP; pg8::Gemm g{(const bf16*)(ws + WS_H), (const bf16*)(ws + W_SSI), T, 5376, 1024}; pg8::StaticOrder S; S.init(T, 5376, F.G, F.bx);
            const int s_ = 2 * layer; pg8::EpiSsdIn E{(bf16*)(ws + A_Z), (bf16*)(ws + A_XPRE), (float*)(ws + A_DTRAW), (const float*)(ws + WS_STAT) + s_ * 8192, (const float*)(ws + WS_SW) + (size_t)s_ * 5 * 5632}; pg8::gemm_phase<pg8::EpiSsdIn, pg8::StaticOrder, true, true>(F.lds, g, S, E, F.wave); } break;
        case OP_SSCONV: { unsigned char* ws = WSP; rp_ssd_conv(F, (const bf16*)(ws + A_XPRE), (const float*)(ws + A_DTRAW), INP(I_SSWC), INP(I_SSBC), INP(I_SSDTB), INP(I_SSAL), (bf16*)(ws + A_XBC), (float*)(ws + A_DT), (float*)(ws + A_ACUM)); } break;
        case OP_SCAN: { unsigned char* ws = WSP; ph_scan(F, (const bf16*)(ws + A_XBC), (const float*)(ws + A_DT), (const float*)(ws + A_ACUM), INP(I_SSD), INP(I_SSM), (bf16*)(ws + A_Y), OUTP); } break;
        case OP_GATE: { unsigned char* ws = WSP; rp_ssd_gate(F, (const bf16*)(ws + A_Y), (const bf16*)(ws + A_Z), INP(I_SSGN), (bf16*)(ws + A_YN)); } break;
        default: break;
        }

        if (ph + 1 < ph_hi) xcd_barrier(bar);

    }
}

extern "C" void kernel_launch(void* const* d_in, const int* in_sizes, int n_in, void* d_out, int out_size, void* d_ws, size_t ws_size, hipStream_t stream) {
    static int grid = 0;
    if (grid == 0) {
        int dev = 0, cus = 0;
        if (hipGetDevice(&dev) != hipSuccess || hipDeviceGetAttribute(&cus, hipDeviceAttributeMultiprocessorCount, dev) != hipSuccess) { fprintf(stderr, "kernel_launch: device query failed\n"); grid = -1; return; }
        if (hipFuncSetAttribute((const void*)mega_fwd, hipFuncAttributeMaxDynamicSharedMemorySize, LDS_BYTES) != hipSuccess) { fprintf(stderr, "kernel_launch: hipFuncSetAttribute failed\n"); grid = -1; return; }
        (void)hipGetLastError();
        grid = cus;
    }
    if (grid < 0) return;
    (void)hipMemsetAsync((char*)d_ws + WS_CTL, 0, CTL_ZERO_BYTES, stream);
    MArgs a{};
    for (int i = 0; i < 38; ++i) a.in[i] = (const float*)d_in[i];
    a.out = (float*)d_out; a.ws = (unsigned char*)d_ws;
    a.ph_lo = 0; a.ph_hi = NPHASE;
    hipLaunchKernelGGL(mega_fwd, dim3(grid), dim3(NTHR), LDS_BYTES, stream, a);
}
```

```cpp
#include <hip/hip_runtime.h>
#include <cstdint>
#include <cstdio>

constexpr int DM = 1024, T = 8192, TP = 4096;
constexpr int NCTX = 1024;
constexpr int QL = 384, KVL = 256, ROPE = 32, NOPE = 64, QKD = 96, VH = 64, NH = 16;
constexpr int FFH = 2816;
constexpr int SSI = 2048, SSH = 32, SSP = 64, SSN = 128, SSG = 4, SSCD = 3072, SSIN = 5184;
constexpr float EPS = 1e-6f;
constexpr size_t OUT_YP = 0, OUT_CKV = 8388608, OUT_KPE = 10485760, OUT_SSM = 10747904;

__device__ __forceinline__ int cond_of_row(int r) { return r < TP ? 0 : 1 + ((r - TP) >> 10); }
__device__ __forceinline__ void row_pos(int r, int& t, int& L) { if (r < TP) { t = r & 255; L = 256; } else { t = (r - TP) & 1023; L = 1024; } }
__device__ __forceinline__ float softplus_f(float x) { return fmaxf(x, 0.f) + log1pf(expf(-fabsf(x))); }

__device__ __forceinline__ float rope_inv(int i) { return i == 0 ? 1.f : i == 1 ? 0.31622776601683794f : i == 2 ? 0.1f : i == 3 ? 0.031622776601683794f : i == 4 ? 0.01f : i == 5 ? 0.0031622776601683794f : i == 6 ? 0.001f : 0.00031622776601683794f; }

__device__ __forceinline__ int olane() { int l; asm volatile("v_mbcnt_lo_u32_b32 %0, -1, 0\n\tv_mbcnt_hi_u32_b32 %0, -1, %0" : "=v"(l)); return l; }
__device__ __forceinline__ int obid() { int b = blockIdx.x; asm volatile("" : "+s"(b)); return b; }
namespace pg8 {
#define PG8_LAS __attribute__((address_space(3)))
typedef unsigned short bf16_t;
typedef short bf16x8 __attribute__((ext_vector_type(8)));
typedef float f32x4 __attribute__((ext_vector_type(4)));
typedef unsigned u32x4 __attribute__((ext_vector_type(4)));
constexpr int BM = 256, BK = 64, HALF = 128, HTB = HALF * BK * 2  , STAGE_BYTES = 8 * HTB, NXCD = 8, WGM = 8;

__host__ __device__ __forceinline__ int lds_byte(int r, int c) { const int st = (r >> 4) * 2 + (c >> 5), rr = r & 15, cc = c & 31, ob = rr * 64 + cc * 2; return st * 1024 + (ob ^ (((ob >> 9) & 1) << 5)); }
__host__ __device__ __forceinline__ void stage_rc(int b, int& R, int& C) { const int st = b / 1024, sb = b % 1024, swz = sb ^ (((sb >> 9) & 1) << 5); R = (st >> 1) * 16 + swz / 64; C = (st & 1) * 32 + (swz % 64) / 2; }
__host__ __device__ __forceinline__ int perm32(int rho) { const int n = rho >> 4, i = rho & 15; return 8 * (i >> 2) + 4 * n + (i & 3); }

struct Unit { int pm, pn; };
struct Gemm { const bf16_t* A; const bf16_t* Bt; int M, N, K; };

struct StaticOrder {
    int nM, nN, nwg, G, c;
    __host__ __device__ void init(int M, int N, int G_, int c_) { nM = M / BM; nN = N / BM; nwg = nM * nN; G = G_; c = c_; }
    __host__ __device__ bool next(int i, Unit& u) const {
        const long L = (long)i * G + c; if (L >= nwg) return false;
        int wgid = (int)L; { const int q = nwg / NXCD, r = nwg % NXCD, xcd = wgid % NXCD, off = wgid / NXCD; wgid = (xcd < r ? xcd * (q + 1) : r * (q + 1) + (xcd - r) * q) + off; }
        const int nig = WGM * nN, gid = wgid / nig, fm = gid * WGM, gsz = (nM - fm) < WGM ? (nM - fm) : WGM;
        u.pm = fm + ((wgid % nig) % gsz); u.pn = (wgid % nig) / gsz; return true;
    }
    __device__ __forceinline__ void a_ready(const Unit&) const {}
    __device__ __forceinline__ void done(const Unit&) const {}
};
__device__ __forceinline__ unsigned cvt_pk_bf16(float lo, float hi) { unsigned r; asm volatile("v_cvt_pk_bf16_f32 %0, %1, %2" : "=v"(r) : "v"(lo), "v"(hi)); return r; }
typedef unsigned u32x2 __attribute__((ext_vector_type(2)));
#define PG8_GAS __attribute__((address_space(1)))
__device__ __forceinline__ void st16(void* p, u32x4 v) { *(PG8_GAS u32x4*)p = v; }
__device__ __forceinline__ void st16f(void* p, f32x4 v) { *(PG8_GAS f32x4*)p = v; }
__device__ __forceinline__ void st8(void* p, u32x2 v) { *(PG8_GAS u32x2*)p = v; }
__device__ __forceinline__ f32x4 ld16f(const float* p) { return *(const PG8_GAS f32x4*)p; }
__device__ __forceinline__ float ld4f(const float* p) { return *(const PG8_GAS float*)p; }
__device__ __forceinline__ float fast_sigmoid(float x) { return __builtin_amdgcn_rcpf(1.f + __builtin_amdgcn_exp2f(-1.4426950408889634f * x)); }

constexpr int SW_LD = 5632;
__device__ __forceinline__ int cond_of_pm(int pm) { return pm < 16 ? 0 : 1 + ((pm - 16) >> 2); }
__device__ __forceinline__ void stage_rstat_sw(const float* rstat, const float* sw, const Unit& u, int slot, int wid, int lane, PG8_LAS unsigned char* tabs) {
    PG8_LAS unsigned char* tab = tabs + slot * 2048;
    if (wid < 4) __builtin_amdgcn_global_load_lds((const unsigned*)(rstat + u.pm * BM + wid * 64 + lane), (PG8_LAS unsigned*)(tab + wid * 256), 4, 0, 0);
    else __builtin_amdgcn_global_load_lds((const unsigned*)(sw + (size_t)cond_of_pm(u.pm) * SW_LD + u.pn * BM + (wid - 4) * 64 + lane), (PG8_LAS unsigned*)(tab + 1024 + (wid - 4) * 256), 4, 0, 0);
}
template <int NBJ> struct EpiF32 {
    static constexpr bool PERM = false, AFTER_DRAIN = false, STAGE_IN = false;
    float* C; int ldc; const float* rstat; const float* sw;
    __device__ __forceinline__ void operator()(const f32x4 (&acc)[2][2][4][2], const Unit& u, int wr_, int wc_, int fr_, int fq_, const PG8_LAS unsigned char* tab) const {
        const int t_ = olane(), wr = wr_, wc = wc_, fr = t_ & 15, fq = t_ >> 4; (void)fr_; (void)fq_; (void)tab;
        const int row0 = u.pm * BM + wr * 64 + fr, col0 = u.pn * (HALF * NBJ) + wc * 32 + 4 * fq;
#pragma unroll
        for (int ai = 0; ai < 2; ++ai)
#pragma unroll
            for (int m = 0; m < 4; ++m) { float* rowp = C + (size_t)(row0 + ai * HALF + m * 16) * ldc + col0;
                const float rs = rstat ? __builtin_amdgcn_rsqf(ld4f(rstat + row0 + ai * HALF + m * 16) * (1.f / 1024) + 1e-6f) : 1.f; const float* swp = sw ? sw + (size_t)cond_of_pm(u.pm) * SW_LD + col0 : nullptr;
#pragma unroll
                for (int bj = 0; bj < NBJ; ++bj)
#pragma unroll
                    for (int n = 0; n < 2; ++n) { f32x4 v = acc[ai][bj][m][n] * rs; if (swp) v += ld16f(swp + bj * HALF + n * 16); st16f(rowp + bj * HALF + n * 16, v); } }
    }
};
struct EpiBf16P {
    static constexpr bool PERM = true, AFTER_DRAIN = false, STAGE_IN = false;
    bf16_t* O; int ldc;
    __device__ __forceinline__ void operator()(const f32x4 (&acc)[2][2][4][2], const Unit& u, int wr_, int wc_, int fr_, int fq_, const PG8_LAS unsigned char* tab) const {
        const int t_ = olane(), wr = wr_, wc = wc_, fr = t_ & 15, fq = t_ >> 4; (void)fr_; (void)fq_; (void)tab;
        const int row0 = u.pm * BM + wr * 64 + fr, col0 = u.pn * BM + wc * 32 + 8 * fq;
#pragma unroll
        for (int ai = 0; ai < 2; ++ai)
#pragma unroll
            for (int m = 0; m < 4; ++m) { bf16_t* rowp = O + (size_t)(row0 + ai * HALF + m * 16) * ldc + col0;
#pragma unroll
                for (int bj = 0; bj < 2; ++bj) { const f32x4 v0 = acc[ai][bj][m][0], v1 = acc[ai][bj][m][1]; u32x4 w;
                    w.x = cvt_pk_bf16(v0[0], v0[1]); w.y = cvt_pk_bf16(v0[2], v0[3]); w.z = cvt_pk_bf16(v1[0], v1[1]); w.w = cvt_pk_bf16(v1[2], v1[3]);
                    st16(rowp + bj * HALF, w); } }
    }
};
struct EpiSsdIn {
    static constexpr bool PERM = true, AFTER_DRAIN = false, STAGE_IN = true;
    bf16_t* Z; bf16_t* XP; float* DT; const float* rstat; const float* sw;
    __device__ __forceinline__ void stage_in(const Unit& u, int slot, int wid, int lane, PG8_LAS unsigned char* tabs) const { stage_rstat_sw(rstat, sw, u, slot, wid, lane, tabs); }
    __device__ __forceinline__ void operator()(const f32x4 (&acc)[2][2][4][2], const Unit& u, int wr_, int wc_, int fr_, int fq_, const PG8_LAS unsigned char* tab) const {
        const int t_ = olane(), wr = wr_, wc = wc_, fr = t_ & 15, fq = t_ >> 4; (void)fr_; (void)fq_;
        const int row0 = u.pm * BM + wr * 64 + fr;
        const PG8_LAS float* trs = (const PG8_LAS float*)tab + wr * 64 + fr; const PG8_LAS float* swp = (const PG8_LAS float*)(tab + 1024) + wc * 32 + 8 * fq;
        if (u.pn < 20) {
            bf16_t* base = u.pn < 8 ? Z : XP; const int ld = u.pn < 8 ? 2048 : 3072, colt = (u.pn < 8 ? u.pn : u.pn - 8) * BM, col0 = colt + wc * 32 + 8 * fq;
#pragma unroll
            for (int ai = 0; ai < 2; ++ai)
#pragma unroll
                for (int m = 0; m < 4; ++m) { bf16_t* rowp = base + (size_t)(row0 + ai * HALF + m * 16) * ld + col0;
                    const float rs = __builtin_amdgcn_rsqf(trs[ai * HALF + m * 16] * (1.f / 1024) + 1e-6f);
#pragma unroll
                    for (int bj = 0; bj < 2; ++bj) { const f32x4 v0 = acc[ai][bj][m][0] * rs + *(const PG8_LAS f32x4*)(swp + bj * HALF), v1 = acc[ai][bj][m][1] * rs + *(const PG8_LAS f32x4*)(swp + bj * HALF + 4); u32x4 w;
                        w.x = cvt_pk_bf16(v0[0], v0[1]); w.y = cvt_pk_bf16(v0[2], v0[3]); w.z = cvt_pk_bf16(v1[0], v1[1]); w.w = cvt_pk_bf16(v1[2], v1[3]);
                        st16(rowp + bj * HALF, w); } }
        } else if (wc < 2) {
#pragma unroll
            for (int ai = 0; ai < 2; ++ai)
#pragma unroll
                for (int m = 0; m < 4; ++m) { float* rp = DT + (size_t)(row0 + ai * HALF + m * 16) * 64 + wc * 32 + 8 * fq;
                    const float rs = __builtin_amdgcn_rsqf(trs[ai * HALF + m * 16] * (1.f / 1024) + 1e-6f);
                    st16f(rp, acc[ai][0][m][0] * rs + *(const PG8_LAS f32x4*)swp); st16f(rp + 4, acc[ai][0][m][1] * rs + *(const PG8_LAS f32x4*)(swp + 4)); }
        }
    }
};
template <int MODE> struct EpiGlu {
    static constexpr bool PERM = false, AFTER_DRAIN = false, STAGE_IN = true;
    bf16_t* O; int ldo; const float* bias; int H; const float* rstat; const float* sw;
    __device__ __forceinline__ void stage_in(const Unit& u, int slot, int wid, int lane, PG8_LAS unsigned char* tabs) const { stage_rstat_sw(rstat, sw, u, slot, wid, lane, tabs); }
    __device__ __forceinline__ void operator()(const f32x4 (&acc)[2][2][4][2], const Unit& u, int wr_, int wc_, int fr_, int fq_, const PG8_LAS unsigned char* tab) const {
        const int t_ = olane(), wr = wr_, wc = wc_, fr = t_ & 15, fq = t_ >> 4; (void)fr_; (void)fq_;
        const int row0 = u.pm * BM + wr * 64 + fr;
#pragma unroll
        for (int bj = 0; bj < 2; ++bj) {
            const int f0 = 16 * (8 * u.pn + 4 * bj + wc) + 4 * fq;
            f32x4 ba = (f32x4){0.f, 0.f, 0.f, 0.f}, bu = ba;
            if (MODE == 1) { ba = ld16f(bias + f0); bu = ld16f(bias + H + f0); }
            { const PG8_LAS float* swp = (const PG8_LAS float*)(tab + 1024) + bj * HALF + wc * 32 + 4 * fq; ba += *(const PG8_LAS f32x4*)swp; bu += *(const PG8_LAS f32x4*)(swp + 16); }
#pragma unroll
            for (int ai = 0; ai < 2; ++ai)
#pragma unroll
                for (int m = 0; m < 4; ++m) { const float rs = __builtin_amdgcn_rsqf(((const PG8_LAS float*)tab)[ai * HALF + wr * 64 + m * 16 + fr] * (1.f / 1024) + 1e-6f);
                    const f32x4 a = acc[ai][bj][m][0] * rs + ba, g = acc[ai][bj][m][1] * rs + bu; float o[4];
#pragma unroll
                    for (int j = 0; j < 4; ++j) o[j] = MODE == 0 ? a[j] * fast_sigmoid(a[j]) * g[j] : a[j] * fast_sigmoid(g[j]);
                    u32x2 w; w.x = cvt_pk_bf16(o[0], o[1]); w.y = cvt_pk_bf16(o[2], o[3]);
                    st8(O + (size_t)(row0 + ai * HALF + m * 16) * ldo + f0, w); }
        }
    }
};
template <int NBJ> struct EpiResid {
    static constexpr bool PERM = false, AFTER_DRAIN = false, STAGE_IN = false;
    const float* xlo; const float* xhi; float* xout; const float* mods_l; int g_off; const float* bias;
    bf16_t* XG; const float* GT; float* stat;
    __device__ __forceinline__ void operator()(const f32x4 (&acc)[2][2][4][2], const Unit& u, int wr_, int wc_, int fr_, int fq_, const PG8_LAS unsigned char* tab) const {
        const int t_ = olane(), wr = wr_, wc = wc_, fr = t_ & 15, fq = t_ >> 4; (void)fr_; (void)fq_; (void)tab;
        const int cond = u.pm < 16 ? 0 : 1 + ((u.pm - 16) >> 2);
        const float* gate = mods_l + (size_t)cond * 6144 + g_off; const float* xin = u.pm < 16 ? xlo : xhi;
        const int row0 = u.pm * BM + wr * 64 + fr, col0 = u.pn * (HALF * NBJ) + wc * 32 + 4 * fq;
        float ss[2][4];
#pragma unroll
        for (int ai = 0; ai < 2; ++ai)
#pragma unroll
            for (int m = 0; m < 4; ++m) ss[ai][m] = 0.f;
        const float* gt = XG ? GT + (size_t)cond * 1024 : nullptr;
#pragma unroll
        for (int bj = 0; bj < NBJ; ++bj)
#pragma unroll
            for (int n = 0; n < 2; ++n) { const int c = col0 + bj * HALF + n * 16; const f32x4 g4 = ld16f(gate + c);
                const f32x4 b4 = bias ? ld16f(bias + c) : (f32x4){0.f, 0.f, 0.f, 0.f};
                f32x4 G4 = (f32x4){0.f, 0.f, 0.f, 0.f}; if (XG) G4 = ld16f(gt + c);
#pragma unroll
                for (int ai = 0; ai < 2; ++ai)
#pragma unroll
                    for (int m = 0; m < 4; ++m) { const size_t off = (size_t)(row0 + ai * HALF + m * 16) * 1024 + c;
                        const f32x4 xo = ld16f(xin + off); const f32x4 xn = xo + g4 * (acc[ai][bj][m][n] + b4); st16f(xout + off, xn);
                        if (XG) { const f32x4 xg = xn * G4; u32x2 w; w.x = cvt_pk_bf16(xg[0], xg[1]); w.y = cvt_pk_bf16(xg[2], xg[3]); st8(XG + off, w);
                            ss[ai][m] += (xn[0] * xn[0] + xn[1] * xn[1]) + (xn[2] * xn[2] + xn[3] * xn[3]); } } }
        if (XG) {
#pragma unroll
            for (int ai = 0; ai < 2; ++ai)
#pragma unroll
                for (int m = 0; m < 4; ++m) { float s = ss[ai][m];
                    s += __builtin_bit_cast(float, __builtin_amdgcn_ds_bpermute((t_ ^ 16) << 2, __builtin_bit_cast(int, s)));
                    s += __builtin_bit_cast(float, __builtin_amdgcn_ds_bpermute((t_ ^ 32) << 2, __builtin_bit_cast(int, s)));
                    if (fq == 0) atomicAdd(stat + row0 + ai * HALF + m * 16, s); }
        }
    }
};
template <class Epi, class Sched, bool ALIGN_EPI = false, bool SP2 = false, bool HALFN = false>
__device__ __forceinline__ void gemm_phase(PG8_LAS unsigned char* lds, const Gemm g, const Sched& S, const Epi& E, const int wave_in) {
    const int tid = wave_in * 64 + olane(), wid = __builtin_amdgcn_readfirstlane(tid >> 6), lane = tid & 63, wr = wid >> 2, wc = wid & 3, fr = lane & 15, fq = lane >> 4;
    const int K = g.K, nt = K / BK;
    unsigned voffA[2], voffB[2];
#pragma unroll
    for (int i = 0; i < 2; ++i) { int R, C; stage_rc(tid * 16 + i * 8192, R, C); const int Rb = Epi::PERM ? ((R & ~31) + perm32(R & 31)) : R;
        voffA[i] = (unsigned)(R * K + C) * 2u; voffB[i] = (unsigned)(Rb * K + C) * 2u; }
    const size_t kstep = (size_t)(BK * 2);
    const size_t hstep = (size_t)HALF * K * 2;
    const size_t tstep = 2 * hstep;
    const size_t bstep = HALFN ? hstep : tstep;
    static_assert(!HALFN || SP2, "HALFN is written for the SP2 loop only");
    const unsigned ldsw = (unsigned)wid * 1024u;
    const int aoff = lds_byte(wr * 64 + fr, fq * 8), boff = lds_byte(wc * 32 + fr, fq * 8);
#define PG8_SA(b, h) (((b) * 2 + (h)) * HTB)
#define PG8_SB(b, h) ((4 + (b) * 2 + (h)) * HTB)
#define PG8_STAGE(bufoff, gbase, voff) do { _Pragma("unroll") for (int _i = 0; _i < 2; ++_i) \
        __builtin_amdgcn_global_load_lds((const unsigned*)((const char*)(gbase) + (voff)[_i]), (PG8_LAS unsigned*)(lds + (bufoff) + ldsw + _i * 8192), 16, 0, 0); } while (0)
#define PG8_LDA(dst, b, h) do { _Pragma("unroll") for (int m = 0; m < 4; ++m) _Pragma("unroll") for (int k = 0; k < 2; ++k) dst[m][k] = *(const PG8_LAS bf16x8*)(lds + PG8_SA(b, h) + aoff + m * 2048 + k * 1024); } while (0)
#define PG8_LDB(dst, b, h) do { _Pragma("unroll") for (int n = 0; n < 2; ++n) _Pragma("unroll") for (int k = 0; k < 2; ++k) dst[n][k] = *(const PG8_LAS bf16x8*)(lds + PG8_SB(b, h) + boff + n * 2048 + k * 1024); } while (0)
#define PG8_MMA(ai, bj, At, Bt) do { __builtin_amdgcn_s_setprio(1); _Pragma("unroll") for (int m = 0; m < 4; ++m) _Pragma("unroll") for (int n = 0; n < 2; ++n) _Pragma("unroll") for (int k = 0; k < 2; ++k) \
        acc[ai][bj][m][n] = __builtin_amdgcn_mfma_f32_16x16x32_bf16(Bt[n][k], At[m][k], acc[ai][bj][m][n], 0, 0, 0); __builtin_amdgcn_s_setprio(0); } while (0)
#define PG8_WAIT_V(n) asm volatile("s_waitcnt vmcnt(" #n ")" ::: "memory")
#define PG8_WAIT_L(n) asm volatile("s_waitcnt lgkmcnt(" #n ")" ::: "memory")
#define PG8_BAR __builtin_amdgcn_s_barrier()
#define PG8_SCHED __builtin_amdgcn_sched_barrier(0)
    Unit cur, nxt; int ui = 0;
    if (!S.next(0, cur)) return;
    f32x4 acc[2][2][4][2];
#pragma unroll
    for (int a = 0; a < 2; ++a)
#pragma unroll
        for (int b = 0; b < 2; ++b)
#pragma unroll
            for (int m = 0; m < 4; ++m)
#pragma unroll
                for (int n = 0; n < 2; ++n) acc[a][b][m][n] = (f32x4){0.f, 0.f, 0.f, 0.f};
    bf16x8 At[4][2], B0[2][2], B1[2][2];
    const char* cA = (const char*)g.A + (size_t)cur.pm * tstep; const char* cB = (const char*)g.Bt + (size_t)cur.pn * bstep;
    S.a_ready(cur);
    if constexpr (Epi::STAGE_IN) E.stage_in(cur, 0, wid, lane, lds + STAGE_BYTES);
    if constexpr (HALFN) {
        PG8_STAGE(PG8_SB(0, 0), cB, voffB); PG8_STAGE(PG8_SA(0, 0), cA, voffA); PG8_STAGE(PG8_SA(0, 1), cA + hstep, voffA);
        if (wr == 1) PG8_BAR;
        PG8_WAIT_V(2); PG8_BAR;
        PG8_STAGE(PG8_SB(1, 0), cB + kstep, voffB); PG8_STAGE(PG8_SA(1, 0), cA + kstep, voffA);
        PG8_WAIT_V(4); PG8_BAR;
    } else if constexpr (SP2) {
        PG8_STAGE(PG8_SB(0, 0), cB, voffB); PG8_STAGE(PG8_SB(0, 1), cB + hstep, voffB); PG8_STAGE(PG8_SA(0, 0), cA, voffA); PG8_STAGE(PG8_SA(0, 1), cA + hstep, voffA);
        if (wr == 1) PG8_BAR;
        PG8_WAIT_V(2); PG8_BAR;
        PG8_STAGE(PG8_SB(1, 0), cB + kstep, voffB); PG8_STAGE(PG8_SA(1, 0), cA + kstep, voffA); PG8_STAGE(PG8_SB(1, 1), cB + hstep + kstep, voffB);
        PG8_WAIT_V(6); PG8_BAR;
    } else {
        PG8_STAGE(PG8_SB(0, 0), cB, voffB); PG8_STAGE(PG8_SA(0, 0), cA, voffA); PG8_STAGE(PG8_SB(0, 1), cB + hstep, voffB); PG8_STAGE(PG8_SA(0, 1), cA + hstep, voffA);
        if (wr == 1) PG8_BAR;
        PG8_WAIT_V(4); PG8_BAR;
        PG8_STAGE(PG8_SB(1, 0), cB + kstep, voffB); PG8_STAGE(PG8_SA(1, 0), cA + kstep, voffA); PG8_STAGE(PG8_SB(1, 1), cB + hstep + kstep, voffB);
        PG8_WAIT_V(6); PG8_BAR;
    }
    for (;;) {
        const bool has_next = S.next(ui + 1, nxt);
        const char* nA = has_next ? (const char*)g.A + (size_t)nxt.pm * tstep : cA; const char* nB = has_next ? (const char*)g.Bt + (size_t)nxt.pn * bstep : cB;
        for (int t = 0; t < nt; t += 2) {
            const bool last = (t == nt - 2);
            const char* a1 = cA + (size_t)(t + 1) * kstep;
            const char* a2 = last ? nA : cA + (size_t)(t + 2) * kstep; const char* b2 = last ? nB : cB + (size_t)(t + 2) * kstep;
            const char* a3 = a2 + kstep; const char* b3 = b2 + kstep;
            if (last && has_next) S.a_ready(nxt);
            if constexpr (Epi::STAGE_IN) { if (last && has_next) E.stage_in(nxt, (ui + 1) & 1, wid, lane, lds + STAGE_BYTES); }
            if constexpr (HALFN) {
            PG8_LDB(B0, 0, 0); PG8_SCHED; PG8_LDA(At, 0, 0); PG8_STAGE(PG8_SA(1, 1), a1 + hstep, voffA);
            PG8_WAIT_V(6); PG8_WAIT_L(0); PG8_BAR; PG8_MMA(0, 0, At, B0); PG8_BAR; PG8_SCHED;
            PG8_LDA(At, 0, 1); PG8_STAGE(PG8_SB(0, 0), b2, voffB); PG8_STAGE(PG8_SA(0, 0), a2, voffA);
            PG8_WAIT_V(6); PG8_WAIT_L(0); PG8_BAR; PG8_MMA(1, 0, At, B0); PG8_BAR; PG8_SCHED;
            PG8_LDB(B0, 1, 0); PG8_SCHED; PG8_LDA(At, 1, 0); PG8_STAGE(PG8_SA(0, 1), a2 + hstep, voffA);
            PG8_WAIT_V(6); PG8_WAIT_L(0); PG8_BAR; PG8_MMA(0, 0, At, B0); PG8_BAR; PG8_SCHED;
            PG8_LDA(At, 1, 1); PG8_STAGE(PG8_SB(1, 0), b3, voffB); PG8_STAGE(PG8_SA(1, 0), a3, voffA);
            PG8_WAIT_V(6); PG8_WAIT_L(0); PG8_BAR; PG8_MMA(1, 0, At, B0); PG8_BAR; PG8_SCHED;
            } else if constexpr (SP2) {
            PG8_LDB(B0, 0, 0); PG8_LDB(B1, 0, 1); PG8_SCHED; PG8_LDA(At, 0, 0); PG8_STAGE(PG8_SA(1, 1), a1 + hstep, voffA);
            PG8_WAIT_V(8); PG8_WAIT_L(0); PG8_BAR; PG8_MMA(0, 0, At, B0); PG8_MMA(0, 1, At, B1); PG8_BAR; PG8_SCHED;
            PG8_LDA(At, 0, 1); PG8_STAGE(PG8_SB(0, 0), b2, voffB); PG8_STAGE(PG8_SB(0, 1), b2 + hstep, voffB); PG8_STAGE(PG8_SA(0, 0), a2, voffA);
            PG8_WAIT_V(8); PG8_WAIT_L(0); PG8_BAR; PG8_MMA(1, 0, At, B0); PG8_MMA(1, 1, At, B1); PG8_BAR; PG8_SCHED;
            PG8_LDB(B0, 1, 0); PG8_LDB(B1, 1, 1); PG8_SCHED; PG8_LDA(At, 1, 0); PG8_STAGE(PG8_SA(0, 1), a2 + hstep, voffA);
            PG8_WAIT_V(8); PG8_WAIT_L(0); PG8_BAR; PG8_MMA(0, 0, At, B0); PG8_MMA(0, 1, At, B1); PG8_BAR; PG8_SCHED;
            PG8_LDA(At, 1, 1); PG8_STAGE(PG8_SB(1, 0), b3, voffB); PG8_STAGE(PG8_SB(1, 1), b3 + hstep, voffB); PG8_STAGE(PG8_SA(1, 0), a3, voffA);
            PG8_WAIT_V(8); PG8_WAIT_L(0); PG8_BAR; PG8_MMA(1, 0, At, B0); PG8_MMA(1, 1, At, B1); PG8_BAR; PG8_SCHED;
            } else {
            PG8_LDB(B0, 0, 0); PG8_SCHED; PG8_LDA(At, 0, 0); PG8_STAGE(PG8_SA(1, 1), a1 + hstep, voffA);
            PG8_WAIT_L(8); PG8_BAR; PG8_WAIT_L(0); PG8_MMA(0, 0, At, B0); PG8_BAR; PG8_SCHED;
            PG8_LDB(B1, 0, 1); PG8_STAGE(PG8_SB(0, 0), b2, voffB);
            PG8_BAR; PG8_WAIT_L(0); PG8_MMA(0, 1, At, B1); PG8_BAR;
            PG8_LDA(At, 0, 1); PG8_STAGE(PG8_SA(0, 0), a2, voffA);
            PG8_BAR; PG8_WAIT_L(0); PG8_MMA(1, 0, At, B0); PG8_BAR; PG8_SCHED;
            PG8_STAGE(PG8_SB(0, 1), b2 + hstep, voffB);
            PG8_WAIT_V(6); PG8_BAR; PG8_MMA(1, 1, At, B1); PG8_BAR;
            PG8_LDB(B0, 1, 0); PG8_SCHED; PG8_LDA(At, 1, 0); PG8_STAGE(PG8_SA(0, 1), a2 + hstep, voffA);
            PG8_WAIT_L(8); PG8_BAR; PG8_WAIT_L(0); PG8_MMA(0, 0, At, B0); PG8_BAR; PG8_SCHED;
            PG8_LDB(B1, 1, 1); PG8_STAGE(PG8_SB(1, 0), b3, voffB);
            PG8_BAR; PG8_WAIT_L(0); PG8_MMA(0, 1, At, B1); PG8_BAR;
            PG8_LDA(At, 1, 1); PG8_STAGE(PG8_SA(1, 0), a3, voffA);
            PG8_BAR; PG8_WAIT_L(0); PG8_MMA(1, 0, At, B0); PG8_BAR; PG8_SCHED;
            PG8_STAGE(PG8_SB(1, 1), b3 + hstep, voffB);
            PG8_WAIT_V(6); PG8_BAR; PG8_MMA(1, 1, At, B1); PG8_BAR;
            }
        }
        if constexpr (ALIGN_EPI) { if (wr == 0) PG8_BAR; }
        if constexpr (!Epi::AFTER_DRAIN) { E(acc, cur, wr, wc, fr, fq, lds + STAGE_BYTES + (ui & 1) * 2048); S.done(cur); }
        if (!has_next) break;
#pragma unroll
        for (int a = 0; a < 2; ++a)
#pragma unroll
            for (int b = 0; b < 2; ++b)
#pragma unroll
                for (int m = 0; m < 4; ++m)
#pragma unroll
                    for (int n = 0; n < 2; ++n) acc[a][b][m][n] = (f32x4){0.f, 0.f, 0.f, 0.f};
        cur = nxt; cA = nA; cB = nB; ++ui;
        if constexpr (ALIGN_EPI) { if (wr == 1) PG8_BAR; }
    }
    PG8_WAIT_V(0);
    if constexpr (!ALIGN_EPI) { if (wr == 0) PG8_BAR; }
    PG8_BAR;
    if constexpr (Epi::AFTER_DRAIN) { E.fused(acc, cur, wr, wc, fr, fq, lds, wid, lane); S.done(cur); }
#undef PG8_SA
#undef PG8_SB
#undef PG8_STAGE
#undef PG8_LDA
#undef PG8_LDB
#undef PG8_MMA
#undef PG8_WAIT_V
#undef PG8_WAIT_L
#undef PG8_BAR
#undef PG8_SCHED
}
}
constexpr int NWAVES = 8, NTHR = 512;
constexpr size_t MiB = 1u << 20;
constexpr size_t WS_CTL = 0, CTL_ZERO_BYTES = 1 * MiB;
constexpr size_t WS_MODS = 256 * 1024;
constexpr size_t WS_STAT = 768 * 1024;
constexpr size_t WS_SW = 372 * MiB, WS_GT = 374 * MiB;
constexpr size_t WS_ROPE = 1 * MiB;
constexpr size_t WS_W = 2 * MiB;
constexpr size_t W_MLA = WS_W, MLA_WB = 5898240;
constexpr size_t MW_CAT = 0, MW_UQ = 1572864, MW_UKV = 2752512, MW_O = 3801088;
constexpr size_t W_CV1 = WS_W + 2 * MLA_WB, W_CV2 = W_CV1 + 4 * MiB;
constexpr size_t W_SSI = W_CV2 + 2 * MiB, W_SSO = W_SSI + 11010048;
constexpr size_t W_FF = W_SSO + 4 * MiB, FF_WB = 17301504, FW_IN = 0, FW_OUT = 11534336;
static_assert(W_FF + 4 * FF_WB <= 102 * MiB, "weights region");
constexpr size_t WS_H = 102 * MiB;
constexpr size_t WS_CKV = 118 * MiB, CKV_B = (size_t)(T + NCTX) * KVL * 2;
constexpr size_t WS_AR = 128 * MiB;
constexpr size_t A_LAT = WS_AR, A_QN = A_LAT + 24 * MiB, A_QRAW = A_QN + 6 * MiB, A_KVRAW = A_QRAW + 24 * MiB, A_QB = A_KVRAW + 36 * MiB, A_KB = A_QB + 24 * MiB, A_AO = A_KB + 27 * MiB;
constexpr size_t A_U = WS_AR, A_V = A_U + 16 * MiB;
constexpr size_t A_Z = WS_AR, A_XPRE = A_Z + 32 * MiB, A_DTRAW = A_XPRE + 48 * MiB, A_XBC = A_DTRAW + 2 * MiB, A_DT = A_XBC + 48 * MiB, A_Y = A_DT + 2 * MiB, A_YN = A_XPRE, A_ACUM = A_Y + 64 * MiB;
constexpr size_t A_ACT = WS_AR + 200 * MiB;
static_assert(A_AO + 16 * MiB <= A_ACT && A_ACUM + 2 * MiB <= A_ACT && A_ACT + 44 * MiB <= 384 * MiB, "arena map");
constexpr int CW_BAR = 4096;
constexpr int LDS_BYTES = 163840, RING_BYTES = 131072, MISC_OFF = 163840 - 256, PTAB_OFF_C = MISC_OFF - 512;

#define GAS __attribute__((address_space(1)))
#define LAS __attribute__((address_space(3)))
typedef unsigned short bf16;
typedef unsigned v4u __attribute__((ext_vector_type(4)));
typedef unsigned v2u __attribute__((ext_vector_type(2)));
typedef float v4f __attribute__((ext_vector_type(4)));
typedef float v2f __attribute__((ext_vector_type(2)));
typedef GAS unsigned gu32;
#define LDS_WAIT() asm volatile("s_waitcnt lgkmcnt(0)" ::: "memory")
#define LDS_BARRIER() do { asm volatile("s_waitcnt lgkmcnt(0)" ::: "memory"); __builtin_amdgcn_s_barrier(); asm volatile("" ::: "memory"); } while (0)
#define VM_WAIT() asm volatile("s_waitcnt vmcnt(0)" ::: "memory")
__device__ __forceinline__ unsigned f2bf(float f) { unsigned u = __builtin_bit_cast(unsigned, f); return (u + 0x7fffu + ((u >> 16) & 1u)) >> 16; }
__device__ __forceinline__ unsigned pk2(float lo, float hi) { return f2bf(lo) | (f2bf(hi) << 16); }
__device__ __forceinline__ float bflo(unsigned u) { return __builtin_bit_cast(float, u << 16); }
__device__ __forceinline__ float bfhi(unsigned u) { return __builtin_bit_cast(float, u & 0xffff0000u); }
__device__ __forceinline__ float bf2f(bf16 b) { return __builtin_bit_cast(float, (unsigned)b << 16); }

#define XB_TMO      128
#define XB_XCNT(j)  (256  + 64 * (j))
#define XB_XSUB(j)  (1280 + 64 * (j))
#define XB_XGEN(j)  (2304 + 64 * (j))
#define XB_TOP      3328
#define XB_TOPGEN   3392
#define XCD_BAR_WORDS 3456
#define XB_SPIN_CAP (1u << 18)

__device__ __forceinline__ unsigned xb_ld(unsigned* p)              { return __hip_atomic_load(p, __ATOMIC_RELAXED, __HIP_MEMORY_SCOPE_AGENT); }
__device__ __forceinline__ unsigned xb_add(unsigned* p, unsigned v) { return __hip_atomic_fetch_add(p, v, __ATOMIC_RELAXED, __HIP_MEMORY_SCOPE_AGENT); }
__device__ __forceinline__ unsigned xb_xcc_id() { return (unsigned)__builtin_amdgcn_s_getreg((3 << 11) | 20) & 0xFu; }
#define XB_SPIN(cond, bar) do { unsigned _sp = 0; while (cond) { __builtin_amdgcn_s_sleep(1); \
    if ((++_sp & 255u) == 0u) { if (xb_ld(&(bar)[XB_TMO])) break; if (_sp > XB_SPIN_CAP) { atomicAdd(&(bar)[XB_TMO], 1u); break; } } } } while (0)

struct XcdBarrier {
    unsigned* bar; unsigned x;
    volatile LAS unsigned* st;
};

__device__ __forceinline__ XcdBarrier xcd_barrier_post(unsigned* bar, volatile LAS unsigned* st) {
    XcdBarrier b; b.bar = bar; b.x = xb_xcc_id(); b.st = st;
    if (threadIdx.x == 0) (void)xb_add(&bar[XB_XCNT(b.x)], 1u);
    return b;
}
__device__ __forceinline__ void xcd_barrier_complete(unsigned* bar, unsigned x, unsigned& nloc, unsigned& nx) {
    const unsigned G = gridDim.x * gridDim.y * gridDim.z;
    unsigned sum, cnt, mine, sp = 0u;
    for (;;) {
        sum = 0u; cnt = 0u; mine = 0u;
#pragma unroll
        for (unsigned j = 0; j < 16; ++j) { const unsigned c = xb_ld(&bar[XB_XCNT(j)]); sum += c; cnt += (c > 0u) ? 1u : 0u; mine = (j == x) ? c : mine; }
        if (sum == G) break;
        __builtin_amdgcn_s_sleep(1);
        if ((++sp & 255u) == 0u) { if (xb_ld(&bar[XB_TMO])) break; if (sp > XB_SPIN_CAP) { atomicAdd(&bar[XB_TMO], 1u); break; } }
    }
    nloc = mine > 0u ? mine : 1u; nx = cnt > 0u ? cnt : 1u;
}

__device__ __forceinline__ void xcd_barrier(const XcdBarrier& b) {
    asm volatile("s_waitcnt vmcnt(0)" ::: "memory");
    __syncthreads();
    if (threadIdx.x == 0) {
        unsigned* bar = b.bar;
        __builtin_amdgcn_s_waitcnt(0);
        unsigned nloc = b.st[0], nx = b.st[1];
        if (nloc == 0u) { xcd_barrier_complete(bar, b.x, nloc, nx); b.st[0] = nloc; b.st[1] = nx; }
        const unsigned old = xb_add(&bar[XB_XSUB(b.x)], 1u);
        const unsigned gen = old / nloc;
        if (old + 1u == (gen + 1u) * nloc) {
            __builtin_amdgcn_fence(__ATOMIC_RELEASE, "agent");
            asm volatile("s_waitcnt vmcnt(0)" ::: "memory");
            const unsigned og = xb_add(&bar[XB_TOP], 1u);
            const unsigned tg = og / nx;
            if (og + 1u == (tg + 1u) * nx) xb_add(&bar[XB_TOPGEN], 1u);
            else XB_SPIN(xb_ld(&bar[XB_TOPGEN]) == tg, bar);
            __builtin_amdgcn_fence(__ATOMIC_ACQUIRE, "agent");
            xb_add(&bar[XB_XGEN(b.x)], 1u);
            asm volatile("s_waitcnt vmcnt(0)" ::: "memory");
        } else {
            XB_SPIN(xb_ld(&bar[XB_XGEN(b.x)]) == gen, bar);
            __builtin_amdgcn_fence(__ATOMIC_ACQUIRE, "agent");
            asm volatile("s_waitcnt vmcnt(0)" ::: "memory");
        }
    }
    __syncthreads();
}

struct Frame {
    LAS unsigned char* lds; int tid, lane, wave, vcu, G, gw, NGW, bx;
    volatile LAS unsigned* PT;
};
constexpr int PT_OUT = 38, PT_WS = 39;
__device__ __forceinline__ const float* ldp(volatile LAS unsigned* PT, int k) {
    const unsigned lo = __builtin_amdgcn_readfirstlane(PT[2 * k]), hi = __builtin_amdgcn_readfirstlane(PT[2 * k + 1]);
    return (const float*)(((unsigned long long)hi << 32) | lo);
}
#define INP(k) ldp(F.PT, (k))
#define WSP ((unsigned char*)ldp(F.PT, PT_WS))
#define OUTP ((float*)ldp(F.PT, PT_OUT))
enum InIdx { I_XP = 0, I_XS, I_CCKV, I_CKPE, I_SSM, I_C, I_CCTX, I_WADA, I_BADA, I_GN1, I_GN2, I_WDQ, I_GQ, I_WUQ, I_WDKV, I_GKV, I_WUKV, I_GQN, I_GKN, I_WO,
             I_CVW1, I_CVB1, I_CVWD, I_CVBD, I_CVGL, I_CVBL, I_CVW2, I_CVB2, I_SSWI, I_SSWC, I_SSBC, I_SSDTB, I_SSAL, I_SSD, I_SSGN, I_SSWO, I_FFWI, I_FFWO };
__device__ __forceinline__ float shx(float v, int lane, int o) { return __builtin_bit_cast(float, __builtin_amdgcn_ds_bpermute((lane ^ o) << 2, __builtin_bit_cast(int, v))); }
__device__ __forceinline__ float wsum(float v, int lane) {
#pragma unroll
    for (int o = 1; o < 64; o <<= 1) v += shx(v, lane, o);
    return v;
}
constexpr float QSCALE = 0.10206207261596577f * 1.4426950408889634f;

struct P0Item { const float* W; bf16* WT; int K, N, mode, H, roff, k0, n0; };
__device__ __forceinline__ void p0_item_load(const P0Item& J, int lane, v4f (&t)[8]) {
#pragma unroll
    for (int i = 0; i < 8; ++i) t[i] = *(const GAS v4f*)(J.W + (size_t)(J.k0 + 8 * i + (lane >> 3)) * J.N + J.n0 + 4 * (lane & 7));
}
__device__ __forceinline__ void p0_item_finish(const P0Item& J, int lane, const v4f (&t)[8], LAS float* scr) {
#pragma unroll
    for (int i = 0; i < 8; ++i) { LAS float* d = scr + (8 * i + (lane >> 3)) * 33 + 4 * (lane & 7); d[0] = t[i].x; d[1] = t[i].y; d[2] = t[i].z; d[3] = t[i].w; }
    LDS_WAIT(); asm volatile("" ::: "memory");
    const int c = lane & 7;
#pragma unroll
    for (int j = 0; j < 4; ++j) { const int n = (lane >> 3) + 8 * j, col = J.n0 + n; const LAS float* s = scr + (8 * c) * 33 + n;
        int drow;
        if (J.mode == 0) drow = J.roff + col;
        else { const int f = col < J.H ? col : col - J.H; drow = 32 * (f >> 4) + (f & 15) + (col < J.H ? 0 : 16); }
        v4u o; o.x = pk2(s[0 * 33], s[1 * 33]); o.y = pk2(s[2 * 33], s[3 * 33]); o.z = pk2(s[4 * 33], s[5 * 33]); o.w = pk2(s[6 * 33], s[7 * 33]);
        *(GAS v4u*)(J.WT + (size_t)drow * J.K + J.k0 + 8 * c) = o; }
    LDS_WAIT(); asm volatile("" ::: "memory");
}
__device__ __forceinline__ void p0_job(int q, int& inp, size_t& soff, int& K, int& N, size_t& doff, int& mode, int& H, int& roff) {
    mode = 0; H = 0; roff = 0; soff = 0;
    if (q < 10) { const int j = q / 5, t = q % 5; const size_t wb = W_MLA + (size_t)j * MLA_WB;
        if (t == 0) { inp = I_WDQ; soff = (size_t)j * 1024 * 384; K = 1024; N = 384; doff = wb + MW_CAT; }
        else if (t == 1) { inp = I_WDKV; soff = (size_t)j * 1024 * 288; K = 1024; N = 288; doff = wb + MW_CAT; roff = 384; }
        else if (t == 2) { inp = I_WUQ; soff = (size_t)j * 384 * 1536; K = 384; N = 1536; doff = wb + MW_UQ; }
        else if (t == 3) { inp = I_WUKV; soff = (size_t)j * 256 * 2048; K = 256; N = 2048; doff = wb + MW_UKV; }
        else { inp = I_WO; soff = (size_t)j * 1024 * 1024; K = 1024; N = 1024; doff = wb + MW_O; } }
    else if (q == 10) { inp = I_CVW1; K = 1024; N = 2048; doff = W_CV1; mode = 1; H = 1024; }
    else if (q == 11) { inp = I_CVW2; K = 1024; N = 1024; doff = W_CV2; }
    else if (q == 12) { inp = I_SSWI; K = 1024; N = 5184; doff = W_SSI; }
    else if (q == 13) { inp = I_SSWO; K = 2048; N = 1024; doff = W_SSO; }
    else { const int l = (q - 14) >> 1, t = (q - 14) & 1;
        if (t == 0) { inp = I_FFWI; soff = (size_t)l * 1024 * 5632; K = 1024; N = 5632; doff = W_FF + (size_t)l * FF_WB + FW_IN; mode = 1; H = 2816; }
        else { inp = I_FFWO; soff = (size_t)l * 2816 * 1024; K = 2816; N = 1024; doff = W_FF + (size_t)l * FF_WB + FW_OUT; } }
}
constexpr int P0_NITEMS = 2 * ((1024 / 64) * (384 / 32) + (1024 / 64) * (288 / 32) + (384 / 64) * (1536 / 32) + (256 / 64) * (2048 / 32) + (1024 / 64) * (1024 / 32))
                        + (1024 / 64) * (2048 / 32) + (1024 / 64) * (1024 / 32) + (1024 / 64) * (5184 / 32) + (2048 / 64) * (1024 / 32)
                        + 4 * ((1024 / 64) * (5632 / 32) + (2816 / 64) * (1024 / 32));
__device__ __forceinline__ void p0_prologue(Frame& F) {
    unsigned char* ws = WSP;
    LAS float* s = (LAS float*)F.lds;
    for (int i = F.tid; i < 5 * 1024; i += NTHR) { const int cc = i >> 10, k = i & 1023; const float v = cc == 0 ? INP(I_CCTX)[k] : INP(I_C)[(cc - 1) * 1024 + k]; s[i] = v / (1.f + expf(-v)); }
    __syncthreads();
    float* mods = (float*)(ws + WS_MODS);
    for (int it = F.bx; it < 192; it += F.G) {
        const int l = it / 48, r = it % 48, cb = r / 16, ks = r % 16, n = cb * 2048 + 4 * F.tid;
        const float* W = INP(I_WADA) + (size_t)l * 1024 * 6144 + (size_t)(ks * 64) * 6144 + n;
        v4f acc[5];
#pragma unroll
        for (int cc = 0; cc < 5; ++cc) acc[cc] = (v4f){0.f, 0.f, 0.f, 0.f};
#pragma unroll 1
        for (int kb = 0; kb < 64; kb += 16) {
            v4f wv[16];
#pragma unroll
            for (int k = 0; k < 16; ++k) wv[k] = *(const GAS v4f*)(W + (size_t)(kb + k) * 6144);
#pragma unroll
            for (int k = 0; k < 16; ++k)
#pragma unroll
                for (int cc = 0; cc < 5; ++cc) acc[cc] += wv[k] * s[cc * 1024 + ks * 64 + kb + k];
        }
        LAS float* tbl = s + 5 * 1024;
        __syncthreads();
#pragma unroll
        for (int cc = 0; cc < 5; ++cc) *(LAS v4f*)(tbl + cc * 2048 + 4 * F.tid) = acc[cc];
        __syncthreads();
        const float* bp = INP(I_BADA) + l * 6144 + cb * 2048;
#pragma unroll
        for (int q = 0; q < 4; ++q) { const int col = q * 512 + F.tid; const float bb = ks == 0 ? bp[col] : 0.f;
#pragma unroll
            for (int cc = 0; cc < 5; ++cc) atomicAdd(&mods[((size_t)l * 5 + cc) * 6144 + cb * 2048 + col], tbl[cc * 2048 + col] + bb); }
    }
    __syncthreads();
    LAS float* scr = (LAS float*)(F.lds + F.wave * 8448);
    for (int it = F.gw; it < P0_NITEMS; it += 2 * F.NGW) {
        P0Item J[2]; bool have1 = it + F.NGW < P0_NITEMS;
#pragma unroll
        for (int e = 0; e < 2; ++e) {
            int r = e == 0 ? it : (have1 ? it + F.NGW : it), inp = 0, K = 64, N = 32, mode = 0, H = 0, roff = 0; size_t soff = 0, doff = 0;
#pragma unroll 1
            for (int q = 0; q < 22; ++q) { p0_job(q, inp, soff, K, N, doff, mode, H, roff); const int ni = (K / 64) * (N / 32); if (r < ni) break; r -= ni; }
            const int nblk = N / 32;
            J[e].W = INP(inp) + soff; J[e].WT = (bf16*)(ws + doff); J[e].K = K; J[e].N = N; J[e].mode = mode; J[e].H = H; J[e].roff = roff; J[e].k0 = 64 * (r / nblk); J[e].n0 = 32 * (r % nblk);
        }
        v4f t0[8], t1[8];
        p0_item_load(J[0], F.lane, t0); p0_item_load(J[1], F.lane, t1);
        p0_item_finish(J[0], F.lane, t0, scr);
        if (have1) p0_item_finish(J[1], F.lane, t1, scr);
    }
    for (int it = F.gw; it < 384; it += F.NGW) {
        bf16* rowp = it < 192 ? (bf16*)(ws + W_MLA + (it / 96) * MLA_WB + MW_CAT) + (size_t)(672 + it % 96) * 1024 : (bf16*)(ws + W_SSI) + (size_t)(5184 + it - 192) * 1024;
        const v4u z = {0u, 0u, 0u, 0u}; ((GAS v4u*)rowp)[F.lane] = z; ((GAS v4u*)rowp)[64 + F.lane] = z;
    }
    for (int it = F.gw; it < 2048; it += F.NGW) {
        const int j = it >> 10, rr = it & 1023, b = rr >> 8, sq = rr & 255;
        const v4f v = ((const GAS v4f*)(INP(I_CCKV) + (((size_t)b * 2 + j) * 256 + sq) * 256))[F.lane];
        v2u o; o.x = pk2(v.x, v.y); o.y = pk2(v.z, v.w);
        ((GAS v2u*)((bf16*)(ws + WS_CKV + j * CKV_B) + (size_t)(T + rr) * 256))[F.lane] = o;
    }
    if (F.bx == 0) for (int i = F.tid; i < 640; i += NTHR) { const int pos = i >> 3, fi = i & 7; const float p = (float)(pos < 16 ? pos : pos - 16);
        const float a = p * rope_inv(fi); float* tab = (float*)(ws + WS_ROPE); tab[2 * i] = cosf(a); tab[2 * i + 1] = sinf(a); }
}

__device__ __forceinline__ void rp_normmod(Frame& F, const float* xlo, const float* xhi, const float* g, const float* mods_l, int sh_off, int sc_off, bf16* h) {
    for (int base = F.gw; base < T; base += 4 * F.NGW) {
        v4f v[4][4]; float ss[4]; int rows[4];
#pragma unroll
        for (int k = 0; k < 4; ++k) { const int row = base + k * F.NGW; rows[k] = row < T ? row : base;
            const GAS v4f* xr = (const GAS v4f*)((rows[k] < TP ? xlo : xhi) + (size_t)rows[k] * 1024) + F.lane;
#pragma unroll
            for (int j = 0; j < 4; ++j) v[k][j] = xr[64 * j]; }
#pragma unroll
        for (int k = 0; k < 4; ++k) { float s = 0.f;
#pragma unroll
            for (int j = 0; j < 4; ++j) s += (v[k][j].x * v[k][j].x + v[k][j].y * v[k][j].y) + (v[k][j].z * v[k][j].z + v[k][j].w * v[k][j].w);
            ss[k] = s; }
#pragma unroll
        for (int o = 1; o < 64; o <<= 1) {
#pragma unroll
            for (int k = 0; k < 4; ++k) ss[k] += shx(ss[k], F.lane, o); }
#pragma unroll
        for (int j = 0; j < 4; ++j) { const int c = 4 * F.lane + 256 * j; const v4f g4 = *(const GAS v4f*)(g + c);
#pragma unroll
            for (int k = 0; k < 4; ++k) { const float r = rsqrtf(ss[k] * (1.f / 1024) + EPS); const float* m = mods_l + (size_t)cond_of_row(rows[k]) * 6144;
                const v4f sc = *(const GAS v4f*)(m + sc_off + c), sh = *(const GAS v4f*)(m + sh_off + c);
                const v4f o = v[k][j] * r * g4 * (sc + 1.f) + sh; v2u w; w.x = pk2(o.x, o.y); w.y = pk2(o.z, o.w);
                *(GAS v2u*)(h + (size_t)rows[k] * 1024 + c) = w; } }
    }
}
__device__ __forceinline__ void rp_mla_fin1(Frame& F, const float* lat, const float* gq, const float* gkv, bf16* qn, bf16* ckv, float* out, int j) {
    for (int row = F.gw; row < T; row += F.NGW) {
        const float* lr = lat + (size_t)row * 768;
        v2f q[3]; float ss = 0.f;
#pragma unroll
        for (int i = 0; i < 3; ++i) { q[i] = *(const GAS v2f*)(lr + 2 * F.lane + 128 * i); ss += q[i].x * q[i].x + q[i].y * q[i].y; }
        float r = rsqrtf(wsum(ss, F.lane) * (1.f / 384) + EPS);
#pragma unroll
        for (int i = 0; i < 3; ++i) { const int c = 2 * F.lane + 128 * i; *(GAS unsigned*)(qn + (size_t)row * 384 + c) = pk2(q[i].x * r * gq[c], q[i].y * r * gq[c + 1]); }
        v2f k[2]; ss = 0.f;
#pragma unroll
        for (int i = 0; i < 2; ++i) { k[i] = *(const GAS v2f*)(lr + 384 + 2 * F.lane + 128 * i); ss += k[i].x * k[i].x + k[i].y * k[i].y; }
        r = rsqrtf(wsum(ss, F.lane) * (1.f / 256) + EPS);
#pragma unroll
        for (int i = 0; i < 2; ++i) { const int c = 2 * F.lane + 128 * i; const float c0 = k[i].x * r * gkv[c], c1 = k[i].y * r * gkv[c + 1];
            *(GAS unsigned*)(ckv + (size_t)row * 256 + c) = pk2(c0, c1);
            if (row < TP) { v2f o; o.x = c0; o.y = c1; *(GAS v2f*)(out + OUT_CKV + (((size_t)(row >> 8) * 2 + j) * 256 + (row & 255)) * 256 + c) = o; } }
        if (row < TP && F.lane < 32) out[OUT_KPE + (((size_t)(row >> 8) * 2 + j) * 256 + (row & 255)) * 32 + F.lane] = lr[640 + F.lane];
    }
}
__device__ __forceinline__ void rope32_tab(float* pe, int t, const float* tab) {
    const v2f* tr = (const v2f*)tab + (t >> 6) * 8; const v2f* tc = (const v2f*)tab + (16 + (t & 63)) * 8;
#pragma unroll
    for (int i = 0; i < 8; ++i) {
        v2f cs = tr[i]; float x1 = pe[i], x2 = pe[i + 8]; pe[i] = x1 * cs.x - x2 * cs.y; pe[i + 8] = x2 * cs.x + x1 * cs.y;
        cs = tc[i]; x1 = pe[16 + i]; x2 = pe[24 + i]; pe[16 + i] = x1 * cs.x - x2 * cs.y; pe[24 + i] = x2 * cs.x + x1 * cs.y;
    }
}
__device__ __forceinline__ void ld8(const bf16* p, float* d) { const v4u w = *(const GAS v4u*)p; d[0] = bflo(w.x); d[1] = bfhi(w.x); d[2] = bflo(w.y); d[3] = bfhi(w.y); d[4] = bflo(w.z); d[5] = bfhi(w.z); d[6] = bflo(w.w); d[7] = bfhi(w.w); }
__device__ __forceinline__ void st8(bf16* p, const float* d) { v4u w; w.x = pk2(d[0], d[1]); w.y = pk2(d[2], d[3]); w.z = pk2(d[4], d[5]); w.w = pk2(d[6], d[7]); *(GAS v4u*)p = w; }
__device__ __forceinline__ void rp_tables(Frame& F) {
    unsigned char* ws = WSP; const float* mods = (const float*)(ws + WS_MODS); float* GTb = (float*)(ws + WS_GT); float* SWb = (float*)(ws + WS_SW);
    for (int idx = F.bx * NTHR + F.tid; idx < 8 * 5 * 1024; idx += F.G * NTHR) {
        const int s = idx / 5120, r = idx % 5120, c = r >> 10, k = r & 1023, layer = s >> 1;
        const float g = (s & 1) ? INP(I_GN2)[layer * 1024 + k] : INP(I_GN1)[layer * 1024 + k];
        GTb[idx] = g * (1.f + mods[((size_t)layer * 5 + c) * 6144 + ((s & 1) ? 4096 : 1024) + k]);
    }
    constexpr int NR1 = 5632, NR2 = 2048, NR4 = 5376, NR6 = 768;
    constexpr int TOT = 4 * NR1 + NR2 + NR4 + NR6;
    for (int it = F.gw; it < TOT / 4; it += F.NGW) {
        int s, n; const bf16* Wt; const int i4 = 4 * it;
        if (i4 < 4 * NR1) { const int l = i4 / NR1; n = i4 % NR1; s = 2 * l + 1; Wt = (const bf16*)(ws + W_FF + (size_t)l * FF_WB + FW_IN); }
        else if (i4 < 4 * NR1 + NR2) { n = i4 - 4 * NR1; s = 2; Wt = (const bf16*)(ws + W_CV1); }
        else if (i4 < 4 * NR1 + NR2 + NR4) { n = i4 - 4 * NR1 - NR2; s = 4; Wt = (const bf16*)(ws + W_SSI); }
        else { n = i4 - 4 * NR1 - NR2 - NR4; s = 6; Wt = (const bf16*)(ws + W_MLA + MLA_WB + MW_CAT); }
        const int layer = s >> 1, shoff = (s & 1) ? 3072 : 0;
        v4u wr[4][2];
#pragma unroll
        for (int r = 0; r < 4; ++r) { wr[r][0] = *(const GAS v4u*)(Wt + (size_t)(n + r) * 1024 + 16 * F.lane); wr[r][1] = *(const GAS v4u*)(Wt + (size_t)(n + r) * 1024 + 16 * F.lane + 8); }
        float acc[4][5];
#pragma unroll
        for (int r = 0; r < 4; ++r)
#pragma unroll
            for (int c = 0; c < 5; ++c) acc[r][c] = 0.f;
#pragma unroll
        for (int c = 0; c < 5; ++c) { const float* sp = mods + ((size_t)layer * 5 + c) * 6144 + shoff + 16 * F.lane;
            const v4f s0 = *(const GAS v4f*)sp, s1 = *(const GAS v4f*)(sp + 4), s2 = *(const GAS v4f*)(sp + 8), s3 = *(const GAS v4f*)(sp + 12);
#pragma unroll
            for (int r = 0; r < 4; ++r) { const v4u a = wr[r][0], b2 = wr[r][1];
                acc[r][c] = (s0.x * bflo(a.x) + s0.y * bfhi(a.x) + s0.z * bflo(a.y) + s0.w * bfhi(a.y)) + (s1.x * bflo(a.z) + s1.y * bfhi(a.z) + s1.z * bflo(a.w) + s1.w * bfhi(a.w))
                          + (s2.x * bflo(b2.x) + s2.y * bfhi(b2.x) + s2.z * bflo(b2.y) + s2.w * bfhi(b2.y)) + (s3.x * bflo(b2.z) + s3.y * bfhi(b2.z) + s3.z * bflo(b2.w) + s3.w * bfhi(b2.w)); } }
#pragma unroll
        for (int o = 1; o < 64; o <<= 1) {
#pragma unroll
            for (int r = 0; r < 4; ++r)
#pragma unroll
                for (int c = 0; c < 5; ++c) acc[r][c] += shx(acc[r][c], F.lane, o); }
        if (F.lane < 20) { const int r = F.lane / 5, c = F.lane % 5; float v = 0.f;
#pragma unroll
            for (int rr = 0; rr < 4; ++rr)
#pragma unroll
                for (int cc = 0; cc < 5; ++cc) v = (rr == r && cc == c) ? acc[rr][cc] : v;
            SWb[((size_t)s * 5 + c) * 5632 + n + r] = v; }
    }
}
__device__ __forceinline__ void rp_mla_fin2(Frame& F, const bf16* qraw, const bf16* kvraw, const float* lat, const float* ckpe_j, const float* gqn, const float* gkn, const float* tab, bf16* Q, bf16* K) {
    for (int idx = F.bx * NTHR + F.tid; idx < T * 32; idx += F.G * NTHR) {
        const int row = idx >> 5, hd = (idx >> 1) & 15, hf = idx & 1; const bool latent = row >= TP; const int tl = (row - TP) & 1023;
        float v[48]; float ss = 0.f;
#pragma unroll
        for (int i = 0; i < 6; ++i) ld8(qraw + (size_t)row * 1536 + hd * 96 + hf * 48 + 8 * i, v + 8 * i);
#pragma unroll
        for (int d = 0; d < 48; ++d) ss += v[d] * v[d];
        ss += shx(ss, F.lane, 1);
        const float r = rsqrtf(ss * (1.f / 96) + EPS) * QSCALE;
#pragma unroll
        for (int d = 0; d < 48; ++d) v[d] = v[d] * r * gqn[hf * 48 + d];
        if (latent && hf) rope32_tab(v + 16, tl, tab);
#pragma unroll
        for (int i = 0; i < 6; ++i) st8(Q + ((size_t)row * 16 + hd) * 96 + hf * 48 + 8 * i, v + 8 * i);
    }
    asm volatile("" ::: "memory");
    for (int idx = F.bx * NTHR + F.tid; idx < (T + NCTX) * 32; idx += F.G * NTHR) {
        const int row = idx >> 5, hd = (idx >> 1) & 15, hf = idx & 1; const bool latent = row >= TP && row < T; const int tl = (row - TP) & 1023;
        float v[48]; float ss = 0.f;
        if (hf == 0) {
#pragma unroll
            for (int i = 0; i < 6; ++i) ld8(kvraw + (size_t)row * 2048 + hd * 128 + 8 * i, v + 8 * i);
        } else {
#pragma unroll
            for (int i = 0; i < 2; ++i) ld8(kvraw + (size_t)row * 2048 + hd * 128 + 48 + 8 * i, v + 8 * i);
            const float* kp = row < T ? lat + (size_t)row * 768 + 640 : ckpe_j + ((size_t)((row - T) >> 8) * 2 * 256 + ((row - T) & 255)) * 32;
#pragma unroll
            for (int i = 0; i < 8; ++i) { const v4f p4 = *(const GAS v4f*)(kp + 4 * i); v[16 + 4 * i] = p4.x; v[17 + 4 * i] = p4.y; v[18 + 4 * i] = p4.z; v[19 + 4 * i] = p4.w; }
        }
#pragma unroll
        for (int d = 0; d < 48; ++d) ss += v[d] * v[d];
        ss += shx(ss, F.lane, 1);
        const float r = rsqrtf(ss * (1.f / 96) + EPS);
#pragma unroll
        for (int d = 0; d < 48; ++d) v[d] = v[d] * r * gkn[hf * 48 + d];
        if (latent && hf) rope32_tab(v + 16, tl, tab);
#pragma unroll
        for (int i = 0; i < 6; ++i) st8(K + ((size_t)row * 16 + hd) * 96 + hf * 48 + 8 * i, v + 8 * i);
    }
}
__device__ __forceinline__ void rp_dwconv(Frame& F, const bf16* u, const float* wdw, const float* bdw, const float* gln, const float* bln, bf16* vout) {
    LAS float* red = (LAS float*)F.lds;
    const int c = 2 * F.tid;
    for (int it = F.vcu; it < T / 16; it += F.G) {
        const int row0 = 16 * it; int t0, L; row_pos(row0, t0, L);
        v2f w[31];
#pragma unroll
        for (int k = 0; k < 31; ++k) w[k] = *(const GAS v2f*)(wdw + k * 1024 + c);
        const v2f bb = *(const GAS v2f*)(bdw + c);
        float y0[16], y1[16];
#pragma unroll
        for (int r = 0; r < 16; ++r) { y0[r] = bb.x; y1[r] = bb.y; }
#pragma unroll
        for (int rr = 0; rr < 46; ++rr) {
            const int tt = t0 - 15 + rr; unsigned pk = 0u;
            if (tt >= 0 && tt < L) pk = *(const GAS unsigned*)(u + (size_t)(row0 - 15 + rr) * 1024 + c);
            const float u0 = bflo(pk), u1 = bfhi(pk);
#pragma unroll
            for (int k = 0; k < 31; ++k) { const int r = rr - k; if (r >= 0 && r < 16) { y0[r] += u0 * w[k].x; y1[r] += u1 * w[k].y; } }
        }
        float s[16];
#pragma unroll
        for (int r = 0; r < 16; ++r) s[r] = y0[r] + y1[r];
#pragma unroll
        for (int o = 1; o < 64; o <<= 1) {
#pragma unroll
            for (int r = 0; r < 16; ++r) s[r] += shx(s[r], F.lane, o); }
        __syncthreads();
        if (F.lane < 16) { float v = s[0];
#pragma unroll
            for (int r = 1; r < 16; ++r) v = F.lane == r ? s[r] : v;
            red[F.wave * 16 + F.lane] = v; }
        __syncthreads();
        float mean[16];
#pragma unroll
        for (int r = 0; r < 16; ++r) { float m = 0.f;
#pragma unroll
            for (int wv = 0; wv < 8; ++wv) m += red[wv * 16 + r];
            mean[r] = m * (1.f / 1024); }
#pragma unroll
        for (int r = 0; r < 16; ++r) { y0[r] -= mean[r]; y1[r] -= mean[r]; s[r] = y0[r] * y0[r] + y1[r] * y1[r]; }
#pragma unroll
        for (int o = 1; o < 64; o <<= 1) {
#pragma unroll
            for (int r = 0; r < 16; ++r) s[r] += shx(s[r], F.lane, o); }
        __syncthreads();
        if (F.lane < 16) { float v = s[0];
#pragma unroll
            for (int r = 1; r < 16; ++r) v = F.lane == r ? s[r] : v;
            red[F.wave * 16 + F.lane] = v; }
        __syncthreads();
        const v2f gg = *(const GAS v2f*)(gln + c), bl = *(const GAS v2f*)(bln + c);
#pragma unroll
        for (int r = 0; r < 16; ++r) { float q = 0.f;
#pragma unroll
            for (int wv = 0; wv < 8; ++wv) q += red[wv * 16 + r];
            const float rs = rsqrtf(q * (1.f / 1024) + EPS);
            const float z0 = y0[r] * rs * gg.x + bl.x, z1 = y1[r] * rs * gg.y + bl.y;
            *(GAS unsigned*)(vout + (size_t)(row0 + r) * 1024 + c) = pk2(z0 / (1.f + __expf(-z0)), z1 / (1.f + __expf(-z1))); }
    }
    __syncthreads();
}
__device__ __forceinline__ void rp_ssd_conv(Frame& F, const bf16* xpre, const float* dtraw, const float* wc, const float* bc, const float* dtb, const float* alog, bf16* xbc, float* dt, float* acum) {
    for (int idx = F.bx * NTHR + F.tid; idx < (T / 32) * 384; idx += F.G * NTHR) {
        const int seg = idx / 384, cg = idx - seg * 384, c0 = 8 * cg, row0 = 32 * seg; int t0, L; row_pos(row0, t0, L);
        float w[5][8], bias[8];
#pragma unroll
        for (int k = 0; k < 5; ++k) { const v4f a = *(const GAS v4f*)(wc + k * 3072 + c0), b2 = *(const GAS v4f*)(wc + k * 3072 + c0 + 4);
            w[k][0] = a.x; w[k][1] = a.y; w[k][2] = a.z; w[k][3] = a.w; w[k][4] = b2.x; w[k][5] = b2.y; w[k][6] = b2.z; w[k][7] = b2.w; }
        { const v4f a = *(const GAS v4f*)(bc + c0), b2 = *(const GAS v4f*)(bc + c0 + 4); bias[0] = a.x; bias[1] = a.y; bias[2] = a.z; bias[3] = a.w; bias[4] = b2.x; bias[5] = b2.y; bias[6] = b2.z; bias[7] = b2.w; }
        float win[5][8];
#pragma unroll
        for (int k = 0; k < 4; ++k) { const int tt = t0 + k - 2;
            if (tt >= 0 && tt < L) ld8(xpre + (size_t)(row0 + k - 2) * 3072 + c0, win[k + 1]);
            else {
#pragma unroll
                for (int i = 0; i < 8; ++i) win[k + 1][i] = 0.f; } }
#pragma unroll 4
        for (int r = 0; r < 32; ++r) {
#pragma unroll
            for (int k = 0; k < 4; ++k)
#pragma unroll
                for (int i = 0; i < 8; ++i) win[k][i] = win[k + 1][i];
            const int tt = t0 + r + 2;
            if (tt < L) ld8(xpre + (size_t)(row0 + r + 2) * 3072 + c0, win[4]);
            else {
#pragma unroll
                for (int i = 0; i < 8; ++i) win[4][i] = 0.f; }
            float a[8];
#pragma unroll
            for (int i = 0; i < 8; ++i) { float v = bias[i];
#pragma unroll
                for (int k = 0; k < 5; ++k) v += win[k][i] * w[k][i];
                a[i] = v / (1.f + __expf(-v)); }
            st8(xbc + (size_t)(row0 + r) * 3072 + c0, a);
        }
    }
    for (int it = F.gw; it < 64 * 64; it += F.NGW) {
        const int ch = it >> 6, e = it & 63, dir = e >> 5, row0 = 128 * ch, lane = F.lane;
        const float aa = -expf(alog[e]), bb = dtb[e];
        const int i0 = dir == 0 ? lane : 127 - lane, i1 = dir == 0 ? lane + 64 : 63 - lane;
        const float d0 = softplus_f(dtraw[(size_t)(row0 + i0) * 64 + e] + bb), d1 = softplus_f(dtraw[(size_t)(row0 + i1) * 64 + e] + bb);
        float s0 = d0 * aa, s1 = d1 * aa;
#pragma unroll
        for (int o = 1; o < 64; o <<= 1) { const float u0 = __builtin_bit_cast(float, __builtin_amdgcn_ds_bpermute((lane - o) << 2, __builtin_bit_cast(int, s0))), u1 = __builtin_bit_cast(float, __builtin_amdgcn_ds_bpermute((lane - o) << 2, __builtin_bit_cast(int, s1)));
            if (lane >= o) { s0 += u0; s1 += u1; } }
        s1 += __builtin_bit_cast(float, __builtin_amdgcn_readlane(__builtin_bit_cast(int, s0), 63));
        dt[(size_t)(row0 + i0) * 64 + e] = d0; dt[(size_t)(row0 + i1) * 64 + e] = d1;
        acum[(size_t)(row0 + i0) * 64 + e] = s0; acum[(size_t)(row0 + i1) * 64 + e] = s1;
    }
}
__device__ __forceinline__ void rp_ssd_gate(Frame& F, const bf16* y, const bf16* z, const float* gn, bf16* yn) {
    for (int row = F.gw; row < T; row += F.NGW) {
#pragma unroll
        for (int g = 0; g < 4; ++g) { const int c0 = g * 512 + 8 * F.lane; float zz[8], v[8]; ld8(z + (size_t)row * 2048 + c0, zz);
            float yb[8]; ld8(y + (size_t)row * 2048 + c0, v); ld8(y + (size_t)(T + row) * 2048 + c0, yb);
#pragma unroll
            for (int i = 0; i < 8; ++i) v[i] += yb[i];
            float ss = 0.f;
#pragma unroll
            for (int i = 0; i < 8; ++i) { v[i] = v[i] * zz[i] / (1.f + __expf(-zz[i])); ss += v[i] * v[i]; }
            const float r = rsqrtf(wsum(ss, F.lane) * (1.f / 512) + EPS);
#pragma unroll
            for (int i = 0; i < 8; ++i) v[i] = v[i] * r * gn[c0 + i];
            st8(yn + (size_t)row * 2048 + c0, v); }
    }
}

typedef short a_bf16x8 __attribute__((ext_vector_type(8)));
typedef short a_s16x4 __attribute__((ext_vector_type(4)));
typedef float a_f32x16 __attribute__((ext_vector_type(16)));
typedef float a_f32x2 __attribute__((ext_vector_type(2))); typedef __bf16 a_bf16x2 __attribute__((ext_vector_type(2)));
__device__ __forceinline__ unsigned a_cvtpk(float lo, float hi) { a_f32x2 v = {lo, hi}; a_bf16x2 b = __builtin_convertvector(v, a_bf16x2); return __builtin_bit_cast(unsigned, b); }
__device__ __forceinline__ a_s16x4 a_vtr(const LAS unsigned char* p) { return __builtin_bit_cast(a_s16x4, __builtin_amdgcn_ds_read_tr16_b64_v4i16((LAS a_s16x4*)p)); }
constexpr int AT_KS = 208, AT_VS = 192, AT_KB = 64 * AT_KS, AT_VB = 64 * AT_VS, AT_VOFF = 2 * AT_KB;
__device__ __forceinline__ void at_tile(Frame& F, LAS unsigned char* lds, int buf, int lane, const a_bf16x8 (&qf)[6], a_f32x16& o0, a_f32x16& o1, float& m, float& l) {
    const int r32 = lane & 31, hi = lane >> 5;
    a_f32x16 p0, p1;
#pragma unroll
    for (int r = 0; r < 16; ++r) { p0[r] = 0.f; p1[r] = 0.f; }
    { const LAS unsigned char* kp = lds + buf * AT_KB + r32 * AT_KS + hi * 16;
#pragma unroll
      for (int s = 0; s < 6; ++s) { const a_bf16x8 a0 = *(const LAS a_bf16x8*)(kp + 32 * s), a1 = *(const LAS a_bf16x8*)(kp + 32 * AT_KS + 32 * s);
          p0 = __builtin_amdgcn_mfma_f32_32x32x16_bf16(a0, qf[s], p0, 0, 0, 0); p1 = __builtin_amdgcn_mfma_f32_32x32x16_bf16(a1, qf[s], p1, 0, 0, 0); } }

    float mx = fmaxf(p0[0], p1[0]);
#pragma unroll
    for (int r = 1; r < 16; ++r) mx = fmaxf(mx, fmaxf(p0[r], p1[r]));
    mx = fmaxf(mx, shx(mx, lane, 32));
    const float mn = fmaxf(m, mx), alpha = __builtin_amdgcn_exp2f(m - mn); m = mn;
    float ps = 0.f;
#pragma unroll
    for (int r = 0; r < 16; ++r) { p0[r] = __builtin_amdgcn_exp2f(p0[r] - mn); p1[r] = __builtin_amdgcn_exp2f(p1[r] - mn); ps += p0[r] + p1[r]; }
    l = l * alpha + ps;
#pragma unroll
    for (int r = 0; r < 16; ++r) { o0[r] *= alpha; o1[r] *= alpha; }
    v4u pw[4];
    pw[0] = (v4u){a_cvtpk(p0[0], p0[1]), a_cvtpk(p0[2], p0[3]), a_cvtpk(p0[4], p0[5]), a_cvtpk(p0[6], p0[7])};
    pw[1] = (v4u){a_cvtpk(p0[8], p0[9]), a_cvtpk(p0[10], p0[11]), a_cvtpk(p0[12], p0[13]), a_cvtpk(p0[14], p0[15])};
    pw[2] = (v4u){a_cvtpk(p1[0], p1[1]), a_cvtpk(p1[2], p1[3]), a_cvtpk(p1[4], p1[5]), a_cvtpk(p1[6], p1[7])};
    pw[3] = (v4u){a_cvtpk(p1[8], p1[9]), a_cvtpk(p1[10], p1[11]), a_cvtpk(p1[12], p1[13]), a_cvtpk(p1[14], p1[15])};

    const LAS unsigned char* vp0 = lds + AT_VOFF + buf * AT_VB + (4 * hi + ((lane & 15) >> 2)) * AT_VS + (16 * ((lane >> 4) & 1) + 4 * (lane & 3)) * 2;
    a_s16x4 vl0[4], vh0[4], vl1[4], vh1[4];
#pragma unroll
    for (int bs = 0; bs < 4; ++bs) { const LAS unsigned char* vq = vp0 + (16 * bs) * AT_VS; vl0[bs] = a_vtr(vq); vh0[bs] = a_vtr(vq + 8 * AT_VS); vl1[bs] = a_vtr(vq + 64); vh1[bs] = a_vtr(vq + 8 * AT_VS + 64); }
#pragma unroll
    for (int bs = 0; bs < 4; ++bs) {
        const a_bf16x8 v0 = (a_bf16x8){vl0[bs][0], vl0[bs][1], vl0[bs][2], vl0[bs][3], vh0[bs][0], vh0[bs][1], vh0[bs][2], vh0[bs][3]}, v1 = (a_bf16x8){vl1[bs][0], vl1[bs][1], vl1[bs][2], vl1[bs][3], vh1[bs][0], vh1[bs][1], vh1[bs][2], vh1[bs][3]};
        const a_bf16x8 pb = __builtin_bit_cast(a_bf16x8, pw[bs]);
        o0 = __builtin_amdgcn_mfma_f32_32x32x16_bf16(v0, pb, o0, 0, 0, 0); o1 = __builtin_amdgcn_mfma_f32_32x32x16_bf16(v1, pb, o1, 0, 0, 0); }
}
__device__ __forceinline__ void ph_attn(Frame& F, const bf16* Q, const bf16* K, const bf16* KV, bf16* AO) {
    const int lane = F.lane, r32 = lane & 31, hi = lane >> 5, wave = F.wave, tid = F.tid;
    LAS unsigned char* lds = F.lds;
    const int kr_a = tid / 12, kp_a = tid % 12, kr_b = (tid + 512) / 12, kp_b = (tid + 512) % 12, vr = tid >> 3, vp = tid & 7;
    const bool has_b = tid < 256;
    for (int uu = F.vcu; uu < 512; uu += F.G) {
        int head, q0, NT, kbase_ctx, kbase_lat;
        if (uu < 256) { const int seq = uu >> 4; head = uu & 15; q0 = seq * 256; NT = 4; kbase_ctx = seq * 256; kbase_lat = 0; }
        else { const int u2 = uu - 256, b = u2 >> 6, qb = u2 & 3; head = (u2 >> 2) & 15; q0 = TP + b * 1024 + qb * 256; NT = 20; kbase_ctx = T + b * 256; kbase_lat = TP + b * 1024; }
        a_bf16x8 qf[6];
        { const bf16* qp = Q + ((size_t)(q0 + wave * 32 + r32) * 16 + head) * 96 + hi * 8;
#pragma unroll
          for (int s = 0; s < 6; ++s) qf[s] = *(const GAS a_bf16x8*)(qp + 16 * s); }
        a_f32x16 o0, o1;
#pragma unroll
        for (int r = 0; r < 16; ++r) { o0[r] = 0.f; o1[r] = 0.f; }
        float m = -INFINITY, l = 0.f;
        v4u ka0, kb0, vv0, ka1, kb1, vv1, ka2, kb2_, vv2;
#define AT_LOAD(t, KA, KB2, VV) do { const int kr0_ = (t) < 4 ? kbase_ctx + 64 * (t) : kbase_lat + 64 * ((t) - 4); \
            KA = *(const GAS v4u*)(K + ((size_t)(kr0_ + kr_a) * 16 + head) * 96 + kp_a * 8); \
            if (has_b) KB2 = *(const GAS v4u*)(K + ((size_t)(kr0_ + kr_b) * 16 + head) * 96 + kp_b * 8); \
            VV = *(const GAS v4u*)(KV + (size_t)(kr0_ + vr) * 2048 + head * 128 + 64 + vp * 8); } while (0)
#define AT_STORE(buf, KA, KB2, VV) do { *(LAS v4u*)(lds + (buf) * AT_KB + kr_a * AT_KS + kp_a * 16) = KA; \
            if (has_b) *(LAS v4u*)(lds + (buf) * AT_KB + kr_b * AT_KS + kp_b * 16) = KB2; \
            *(LAS v4u*)(lds + AT_VOFF + (buf) * AT_VB + vr * AT_VS + vp * 16) = VV; } while (0)
#define AT_STEP(k, SA, SB, SC, SD_, SE_, SF_, SG, SH, SI) if (t + (k) < NT) { \
            if (t + (k) + 3 < NT) AT_LOAD(t + (k) + 3, SA, SB, SC);            \
            at_tile(F, lds, (k) & 1, lane, qf, o0, o1, m, l); \
            if (t + (k) + 1 < NT) AT_STORE(((k) + 1) & 1, SD_, SE_, SF_);       \
            LDS_BARRIER(); }
        AT_LOAD(0, ka0, kb0, vv0); AT_LOAD(1, ka1, kb1, vv1); AT_LOAD(2, ka2, kb2_, vv2);
        AT_STORE(0, ka0, kb0, vv0);
        LDS_BARRIER();
#pragma unroll 1
        for (int t = 0; t < NT; t += 6) {
            AT_STEP(0, ka0, kb0, vv0, ka1, kb1, vv1, 0, 0, 0)
            AT_STEP(1, ka1, kb1, vv1, ka2, kb2_, vv2, 0, 0, 0)
            AT_STEP(2, ka2, kb2_, vv2, ka0, kb0, vv0, 0, 0, 0)
            AT_STEP(3, ka0, kb0, vv0, ka1, kb1, vv1, 0, 0, 0)
            AT_STEP(4, ka1, kb1, vv1, ka2, kb2_, vv2, 0, 0, 0)
            AT_STEP(5, ka2, kb2_, vv2, ka0, kb0, vv0, 0, 0, 0)
        }
#undef AT_STEP
#undef AT_LOAD
#undef AT_STORE
        l += shx(l, lane, 32);
        const float il = 1.f / l;
        bf16* op = AO + (size_t)(q0 + wave * 32 + r32) * 1024 + head * 64 + 4 * hi;
#pragma unroll
        for (int g4 = 0; g4 < 4; ++g4) {
            v2u w0; w0.x = a_cvtpk(o0[4 * g4] * il, o0[4 * g4 + 1] * il); w0.y = a_cvtpk(o0[4 * g4 + 2] * il, o0[4 * g4 + 3] * il); *(GAS v2u*)(op + 8 * g4) = w0;
            v2u w1; w1.x = a_cvtpk(o1[4 * g4] * il, o1[4 * g4 + 1] * il); w1.y = a_cvtpk(o1[4 * g4 + 2] * il, o1[4 * g4 + 3] * il); *(GAS v2u*)(op + 32 + 8 * g4) = w1; }

    }
}
constexpr int SC_ST = 272, SC_XS = 144;
constexpr int SC_C = 0, SC_B = 128 * SC_ST, SC_M = 2 * 128 * SC_ST, SC_H = 3 * 128 * SC_ST, SC_X = SC_H + 64 * SC_ST, SC_XW = SC_X + 128 * SC_XS, SC_ARR = SC_XW + 128 * SC_XS;
static_assert(SC_ARR + 4 * 128 * 4 + 16 <= PTAB_OFF_C, "scan LDS map");
__device__ __forceinline__ int a_crow(int r, int hi) { return (r & 3) + 8 * (r >> 2) + 4 * hi; }
__device__ __forceinline__ void ph_scan(Frame& F, const bf16* xbc, const float* dt, const float* acg, const float* dsk, const float* st0, bf16* y, float* out) {
    const int lane = F.lane, r32 = lane & 31, hi = lane >> 5, wave = F.wave, tid = F.tid;
    LAS unsigned char* lds = F.lds;
    LAS float* acum = (LAS float*)(lds + SC_ARR); LAS float* wj = acum + 128; LAS float* ei = acum + 256; LAS float* dtj = acum + 384; LAS float* misc = acum + 512;
    const int q4 = (lane & 15) >> 2, gg = (lane >> 4) & 1, p4 = lane & 3;
    const int ib = wave >> 1, pb = wave & 1, nb = wave >> 1;
    v4u cr[4], br[4], xr[2];
    float pdt[2], pac[2], plast, pac_t, pdt_t;
#define SC_GLOADP(rowb_, g_, hd_, dir_) do { const int row0_ = (rowb_); \
        _Pragma("unroll") for (int k = 0; k < 4; ++k) { const int q = tid + 512 * k, rr = q >> 4, pp = q & 15; \
            cr[k] = *(const GAS v4u*)(xbc + (size_t)(row0_ + rr) * 3072 + 2560 + (g_) * 128 + pp * 8); br[k] = *(const GAS v4u*)(xbc + (size_t)(row0_ + rr) * 3072 + 2048 + (g_) * 128 + pp * 8); } \
        _Pragma("unroll") for (int k = 0; k < 2; ++k) { const int q = tid + 512 * k, rr = q >> 3, pp = q & 7; xr[k] = *(const GAS v4u*)(xbc + (size_t)(row0_ + rr) * 3072 + (hd_) * 64 + pp * 8); \
            pdt[k] = dt[(size_t)(row0_ + rr) * 64 + (dir_) * 32 + (hd_)]; pac[k] = acg[(size_t)(row0_ + rr) * 64 + (dir_) * 32 + (hd_)]; } \
        plast = acg[(size_t)(row0_ + ((dir_) == 0 ? 127 : 0)) * 64 + (dir_) * 32 + (hd_)]; \
        pac_t = acg[(size_t)(row0_ + (tid & 127)) * 64 + (dir_) * 32 + (hd_)]; pdt_t = dt[(size_t)(row0_ + (tid & 127)) * 64 + (dir_) * 32 + (hd_)]; } while (0)
#define SC_ITEM(slot_, ii_, seq_, hd_) do { if ((slot_) < 128) { seq_ = 16 + ((slot_) >> 5); hd_ = (slot_) & 31; } else { const int pi_ = 4 * ((slot_) - 128) + (ii_); seq_ = pi_ >> 5; hd_ = pi_ & 31; } } while (0)
    for (int slot = F.vcu; slot < 256; slot += F.G) {
        const int nitem = slot < 128 ? 1 : 4;
        { int seq0, hd0; SC_ITEM(slot, 0, seq0, hd0); SC_GLOADP(seq0 < 16 ? seq0 * 256 : TP + (seq0 - 16) * 1024, hd0 >> 3, hd0, 0); }
#pragma unroll 1
        for (int ii = 0; ii < nitem; ++ii) {
            int seq, hd;
            if (slot < 128) { seq = 16 + (slot >> 5); hd = slot & 31; } else { const int pi = 4 * (slot - 128) + ii; seq = pi >> 5; hd = pi & 31; }
            const int g = hd >> 3, r0 = seq < 16 ? seq * 256 : TP + (seq - 16) * 1024, nc = seq < 16 ? 2 : 8;
#pragma unroll 1
            for (int dir = 0; dir < 2; ++dir) {
                const float dd = dsk[dir * 32 + hd];
                a_f32x16 hacc;
                if (seq < 16) {
#pragma unroll
                    for (int r = 0; r < 16; ++r) hacc[r] = 0.f;
                } else { const float* s0 = st0 + ((((size_t)(seq - 16) * 2 + dir) * 32 + hd) * 64 + 32 * pb + r32) * 128 + 32 * nb + 4 * hi;
#pragma unroll
                    for (int g4 = 0; g4 < 4; ++g4) { const v4f t4 = *(const GAS v4f*)(s0 + 8 * g4); hacc[4 * g4] = t4.x; hacc[4 * g4 + 1] = t4.y; hacc[4 * g4 + 2] = t4.z; hacc[4 * g4 + 3] = t4.w; } }
#pragma unroll
                for (int g4 = 0; g4 < 4; ++g4) { v2u w; w.x = a_cvtpk(hacc[4 * g4], hacc[4 * g4 + 1]); w.y = a_cvtpk(hacc[4 * g4 + 2], hacc[4 * g4 + 3]);
                    *(LAS v2u*)(lds + SC_H + (32 * pb + r32) * SC_ST + (32 * nb + 8 * g4 + 4 * hi) * 2) = w; }
#pragma unroll 1
                for (int cc = 0; cc < nc; ++cc) {
                    const int c = dir == 0 ? cc : nc - 1 - cc, row0 = r0 + c * 128;
                    const int e = dir * 32 + hd;
                    const float last = plast;
                    LDS_BARRIER();
                    if (tid < 128) { const float ac = pac_t, dv = pdt_t;
                        acum[tid] = ac; dtj[tid] = dv; ei[tid] = __expf(ac); if (tid == 0) misc[0] = __expf(last); }
#pragma unroll
                    for (int k = 0; k < 4; ++k) { const int q = tid + 512 * k, rr = q >> 4, pp = q & 15; *(LAS v4u*)(lds + SC_C + rr * SC_ST + pp * 16) = cr[k]; *(LAS v4u*)(lds + SC_B + rr * SC_ST + pp * 16) = br[k]; }
#pragma unroll
                    for (int k = 0; k < 2; ++k) { const int q = tid + 512 * k, rr = q >> 3, pp = q & 7; *(LAS v4u*)(lds + SC_X + rr * SC_XS + pp * 16) = xr[k];
                        const float w = pdt[k] * __expf(last - pac[k]);
                        v4u s; s.x = a_cvtpk(bflo(xr[k].x) * w, bfhi(xr[k].x) * w); s.y = a_cvtpk(bflo(xr[k].y) * w, bfhi(xr[k].y) * w); s.z = a_cvtpk(bflo(xr[k].z) * w, bfhi(xr[k].z) * w); s.w = a_cvtpk(bflo(xr[k].w) * w, bfhi(xr[k].w) * w);
                        *(LAS v4u*)(lds + SC_XW + rr * SC_XS + pp * 16) = s; }
                    { int nrow = 0, nhd = hd, ndir = dir; bool hn = true;
                      if (cc + 1 < nc) nrow = r0 + (dir == 0 ? cc + 1 : nc - 2 - cc) * 128;
                      else if (dir == 0) { nrow = r0 + (nc - 1) * 128; ndir = 1; }
                      else if (ii + 1 < nitem) { int seqn; SC_ITEM(slot, ii + 1, seqn, nhd); nrow = seqn < 16 ? seqn * 256 : TP + (seqn - 16) * 1024; ndir = 0; }
                      else hn = false;
                      if (hn) SC_GLOADP(nrow, nhd >> 3, nhd, ndir); }
                    LDS_BARRIER();
#pragma unroll 1
                    for (int tt = 0; tt < 2; ++tt) {
                        int lt = tt == 0 ? wave : (wave < 2 ? 8 + wave : 10 + (wave - 2));
                        const int ta = lt == 0 ? 0 : lt == 1 ? 0 : lt == 2 ? 0 : lt == 3 ? 0 : lt == 4 ? 1 : lt == 5 ? 1 : lt == 6 ? 1 : lt == 7 ? 2 : lt == 8 ? 2 : lt == 9 ? 3 : lt == 10 ? 1 : lt == 11 ? 2 : lt == 12 ? 2 : lt == 13 ? 3 : lt == 14 ? 3 : 3;
                        const int tb = lt == 0 ? 0 : lt == 1 ? 1 : lt == 2 ? 2 : lt == 3 ? 3 : lt == 4 ? 1 : lt == 5 ? 2 : lt == 6 ? 3 : lt == 7 ? 2 : lt == 8 ? 3 : lt == 9 ? 3 : lt == 10 ? 0 : lt == 11 ? 0 : lt == 12 ? 1 : lt == 13 ? 0 : lt == 14 ? 1 : 2;
                        const int jb = dir == 0 ? ta : tb, ibg = dir == 0 ? tb : ta;
                        const bool dead = lt >= 10;
                        a_f32x16 gt;
#pragma unroll
                        for (int r = 0; r < 16; ++r) gt[r] = 0.f;
                        if (!dead) {
                            const LAS unsigned char* ap = lds + SC_B + (32 * jb + r32) * SC_ST + hi * 16; const LAS unsigned char* bp = lds + SC_C + (32 * ibg + r32) * SC_ST + hi * 16;
#pragma unroll
                            for (int s = 0; s < 8; ++s) gt = __builtin_amdgcn_mfma_f32_32x32x16_bf16(*(const LAS a_bf16x8*)(ap + 32 * s), *(const LAS a_bf16x8*)(bp + 32 * s), gt, 0, 0, 0);
                            const int i = 32 * ibg + r32; const float ai = acum[i];
                            v4f aj[4], dj[4];
#pragma unroll
                            for (int g4 = 0; g4 < 4; ++g4) { aj[g4] = *(const LAS v4f*)(acum + 32 * jb + 8 * g4 + 4 * hi); dj[g4] = *(const LAS v4f*)(dtj + 32 * jb + 8 * g4 + 4 * hi); }
#pragma unroll
                            for (int r = 0; r < 16; ++r) { const int j = 32 * jb + a_crow(r, hi); const bool keep = dir == 0 ? j <= i : j >= i;
                                const float e = __builtin_amdgcn_exp2f(fminf(ai - aj[r >> 2][r & 3], 0.f) * 1.4426950408889634f) * dj[r >> 2][r & 3];
                                gt[r] = keep ? gt[r] * e + (j == i ? dd : 0.f) : 0.f; }
                        }
#pragma unroll
                        for (int g4 = 0; g4 < 4; ++g4) { v2u w; w.x = a_cvtpk(gt[4 * g4], gt[4 * g4 + 1]); w.y = a_cvtpk(gt[4 * g4 + 2], gt[4 * g4 + 3]);
                            *(LAS v2u*)(lds + SC_M + (32 * ibg + r32) * SC_ST + (32 * jb + 8 * g4 + 4 * hi) * 2) = w; }
                    }
                    a_f32x16 yo;
#pragma unroll
                    for (int r = 0; r < 16; ++r) yo[r] = 0.f;
                    { const LAS unsigned char* ap = lds + SC_C + (32 * ib + r32) * SC_ST + hi * 16; const LAS unsigned char* bp = lds + SC_H + (32 * pb + r32) * SC_ST + hi * 16;
#pragma unroll
                      for (int s = 0; s < 8; ++s) yo = __builtin_amdgcn_mfma_f32_32x32x16_bf16(*(const LAS a_bf16x8*)(ap + 32 * s), *(const LAS a_bf16x8*)(bp + 32 * s), yo, 0, 0, 0); }
                    LDS_BARRIER();
                    a_f32x16 yd;
#pragma unroll
                    for (int r = 0; r < 16; ++r) yd[r] = 0.f;
                    { const LAS unsigned char* ap = lds + SC_M + (32 * ib + r32) * SC_ST + hi * 16; const LAS unsigned char* xp = lds + SC_X + (8 * hi + q4) * SC_XS + (32 * pb + 16 * gg + 4 * p4) * 2;
#pragma unroll
                      for (int s = 0; s < 8; ++s) { const a_s16x4 l0 = a_vtr(xp + (16 * s) * SC_XS), h0 = a_vtr(xp + (16 * s + 4) * SC_XS);
                          const a_bf16x8 xb = (a_bf16x8){l0[0], l0[1], l0[2], l0[3], h0[0], h0[1], h0[2], h0[3]};
                          yd = __builtin_amdgcn_mfma_f32_32x32x16_bf16(*(const LAS a_bf16x8*)(ap + 32 * s), xb, yd, 0, 0, 0); } }
                    { bf16* yp = y + (size_t)dir * T * 2048 + (size_t)(row0 + 32 * ib) * 2048 + hd * 64 + 32 * pb + r32;
                      v4f e4[4];
#pragma unroll
                      for (int g4 = 0; g4 < 4; ++g4) e4[g4] = *(const LAS v4f*)(ei + 32 * ib + 8 * g4 + 4 * hi);
#pragma unroll
                      for (int r = 0; r < 16; ++r) { const int i = a_crow(r, hi); const float v = yd[r] + e4[r >> 2][r & 3] * yo[r]; yp[(size_t)i * 2048] = (bf16)f2bf(v); } }
                    { const float dec = misc[0];
#pragma unroll
                      for (int r = 0; r < 16; ++r) hacc[r] *= dec;
                      const LAS unsigned char* bq = lds + SC_B + (8 * hi + q4) * SC_ST + (32 * nb + 16 * gg + 4 * p4) * 2; const LAS unsigned char* xq = lds + SC_XW + (8 * hi + q4) * SC_XS + (32 * pb + 16 * gg + 4 * p4) * 2;
#pragma unroll
                      for (int s = 0; s < 8; ++s) { const a_s16x4 bl = a_vtr(bq + (16 * s) * SC_ST), bh = a_vtr(bq + (16 * s + 4) * SC_ST), xl = a_vtr(xq + (16 * s) * SC_XS), xh = a_vtr(xq + (16 * s + 4) * SC_XS);
                          const a_bf16x8 av = (a_bf16x8){bl[0], bl[1], bl[2], bl[3], bh[0], bh[1], bh[2], bh[3]}, bv = (a_bf16x8){xl[0], xl[1], xl[2], xl[3], xh[0], xh[1], xh[2], xh[3]};
                          hacc = __builtin_amdgcn_mfma_f32_32x32x16_bf16(av, bv, hacc, 0, 0, 0); } }
#pragma unroll
                    for (int g4 = 0; g4 < 4; ++g4) { v2u w; w.x = a_cvtpk(hacc[4 * g4], hacc[4 * g4 + 1]); w.y = a_cvtpk(hacc[4 * g4 + 2], hacc[4 * g4 + 3]);
                        *(LAS v2u*)(lds + SC_H + (32 * pb + r32) * SC_ST + (32 * nb + 8 * g4 + 4 * hi) * 2) = w; }
                }
                if (seq < 16) { float* o = out + OUT_SSM + ((((size_t)seq * 2 + dir) * 32 + hd) * 64 + 32 * pb + r32) * 128 + 32 * nb + 4 * hi;
#pragma unroll
                    for (int g4 = 0; g4 < 4; ++g4) { v4f t4; t4.x = hacc[4 * g4]; t4.y = hacc[4 * g4 + 1]; t4.z = hacc[4 * g4 + 2]; t4.w = hacc[4 * g4 + 3]; *(GAS v4f*)(o + 8 * g4) = t4; } }
            }
        }
    }
#undef SC_GLOADP
#undef SC_ITEM
    LDS_BARRIER();
}

constexpr int NPHASE = 30;
enum Op { OP_P0, OP_NORM1, OP_G_LAT, OP_FIN1, OP_G_QKV, OP_FIN2, OP_ATTN, OP_G_WO, OP_NORM2, OP_G_FF1, OP_G_FF2, OP_G_PW1, OP_DWCONV, OP_G_PW2, OP_G_SSI, OP_SSCONV, OP_SCAN, OP_GATE, OP_G_SSO };
__device__ __forceinline__ void phase_decode(int ph, int& layer, int& op) {
    if (ph == 0) { layer = 0; op = OP_P0; return; }
    if (ph <= 9) { layer = 0; const int r = ph - 1; op = r == 0 ? OP_NORM1 : r == 1 ? OP_G_LAT : r == 2 ? OP_FIN1 : r == 3 ? OP_G_QKV : r == 4 ? OP_FIN2 : r == 5 ? OP_ATTN : r == 6 ? OP_G_WO : r == 7 ? OP_G_FF1 : OP_G_FF2; }
    else if (ph <= 14) { layer = 1; const int r = ph - 10; op = r == 0 ? OP_G_PW1 : r == 1 ? OP_DWCONV : r == 2 ? OP_G_PW2 : r == 3 ? OP_G_FF1 : OP_G_FF2; }
    else if (ph <= 21) { layer = 2; const int r = ph - 15; op = r == 0 ? OP_G_SSI : r == 1 ? OP_SSCONV : r == 2 ? OP_SCAN : r == 3 ? OP_GATE : r == 4 ? OP_G_SSO : r == 5 ? OP_G_FF1 : OP_G_FF2; }
    else { layer = 3; const int r = ph - 22; op = r == 0 ? OP_G_LAT : r == 1 ? OP_FIN1 : r == 2 ? OP_G_QKV : r == 3 ? OP_FIN2 : r == 4 ? OP_ATTN : r == 5 ? OP_G_WO : r == 6 ? OP_G_FF1 : OP_G_FF2; }
}
struct MArgs { const float* in[38]; float* out; unsigned char* ws; int ph_lo, ph_hi; };
constexpr int PTAB_OFF = PTAB_OFF_C;
__global__ void __launch_bounds__(NTHR, 2) mega_fwd(MArgs args) {
    extern __shared__ __attribute__((aligned(16))) unsigned char lds_raw[];
    LAS unsigned char* lds = (LAS unsigned char*)lds_raw;
    volatile LAS unsigned* PT0 = (volatile LAS unsigned*)(lds + PTAB_OFF);
    volatile LAS unsigned* MISC = (volatile LAS unsigned*)(lds + MISC_OFF);
    { const int t0 = threadIdx.x;
      if (t0 < 40) { const unsigned long long p = t0 < 38 ? (unsigned long long)args.in[t0] : t0 == 38 ? (unsigned long long)args.out : (unsigned long long)args.ws;
          PT0[2 * t0] = (unsigned)p; PT0[2 * t0 + 1] = (unsigned)(p >> 32); }
      if (t0 < 64) MISC[t0] = 0u; }
    __syncthreads();
    XcdBarrier bar = xcd_barrier_post((unsigned*)((unsigned char*)ldp(PT0, PT_WS) + WS_CTL) + CW_BAR, MISC + 8);
    const int wave0 = __builtin_amdgcn_readfirstlane(threadIdx.x >> 6);
    const int ph_hi = args.ph_hi;
    for (int ph = args.ph_lo; ph < ph_hi; ++ph) {
        Frame F;
        { int w = wave0; asm volatile("" : "+s"(w)); F.wave = w; }
        F.lds = lds; F.lane = olane(); F.tid = F.wave * 64 + F.lane;
        const int bx = obid();
        F.G = gridDim.x; F.vcu = (F.G % 8 == 0) ? (bx % 8) * (F.G / 8) + bx / 8 : bx;
        F.gw = F.vcu * NWAVES + F.wave; F.NGW = F.G * NWAVES; F.PT = PT0; F.bx = bx;
        int layer, op; phase_decode(ph, layer, op);
        const int j = layer / 3;
        switch (op) {
        case OP_P0: p0_prologue(F); break;
        case OP_NORM1: { unsigned char* ws = WSP; float* x = OUTP; const float* xlo = layer == 0 ? INP(I_XP) : x; const float* xhi = layer == 0 ? INP(I_XS) - (size_t)TP * 1024 : x;
            rp_normmod(F, xlo, xhi, INP(I_GN1) + layer * 1024, (const float*)(ws + WS_MODS) + (size_t)layer * 5 * 6144, 0, 1024, (bf16*)(ws + WS_H)); rp_tables(F); } break;
        case OP_NORM2: { unsigned char* ws = WSP; float* x = OUTP;
            rp_normmod(F, x, x, INP(I_GN2) + layer * 1024, (const float*)(ws + WS_MODS) + (size_t)layer * 5 * 6144, 3072, 4096, (bf16*)(ws + WS_H)); } break;
        case OP_G_LAT: { unsigned char* ws = WSP; pg8::Gemm g{(const bf16*)(ws + WS_H), (const bf16*)(ws + W_MLA + j * MLA_WB + MW_CAT), T, 768, 1024}; pg8::StaticOrder S; S.init(T, 2 * 768, F.G, F.bx);
            const int s_ = 2 * layer; pg8::EpiF32<1> E{(float*)(ws + A_LAT), 768, layer == 0 ? nullptr : (const float*)(ws + WS_STAT) + s_ * 8192, layer == 0 ? nullptr : (const float*)(ws + WS_SW) + (size_t)s_ * 5 * 5632}; pg8::gemm_phase<pg8::EpiF32<1>, pg8::StaticOrder, true, true, true>(F.lds, g, S, E, F.wave); } break;
        case OP_FIN1: { unsigned char* ws = WSP; rp_mla_fin1(F, (const float*)(ws + A_LAT), INP(I_GQ) + j * 384, INP(I_GKV) + j * 256, (bf16*)(ws + A_QN), (bf16*)(ws + WS_CKV + j * CKV_B), OUTP, j); } break;
        case OP_G_QKV: {
#pragma unroll 1
            for (int w = 0; w < 2; ++w) {
                unsigned char* ws = WSP; unsigned char* wm = ws + W_MLA + j * MLA_WB;
                pg8::Gemm g = w == 0 ? pg8::Gemm{(const bf16*)(ws + A_QN), (const bf16*)(wm + MW_UQ), T, 1536, 384} : pg8::Gemm{(const bf16*)(ws + WS_CKV + j * CKV_B), (const bf16*)(wm + MW_UKV), T + NCTX, 2048, 256};
                pg8::StaticOrder S; S.init(g.M, g.N, F.G, w == 0 ? F.bx : (int)((F.bx + 64) % F.G));
                pg8::EpiBf16P E{w == 0 ? (bf16*)(ws + A_QRAW) : (bf16*)(ws + A_KVRAW), g.N};
                pg8::gemm_phase<pg8::EpiBf16P, pg8::StaticOrder, true, true>(F.lds, g, S, E, F.wave);
            } } break;
        case OP_FIN2: { unsigned char* ws = WSP; rp_mla_fin2(F, (const bf16*)(ws + A_QRAW), (const bf16*)(ws + A_KVRAW), (const float*)(ws + A_LAT), INP(I_CKPE) + (size_t)j * 8192, INP(I_GQN) + j * 96, INP(I_GKN) + j * 96,
                                                        (const float*)(ws + WS_ROPE), (bf16*)(ws + A_QB), (bf16*)(ws + A_KB)); } break;
        case OP_ATTN: { unsigned char* ws = WSP; ph_attn(F, (const bf16*)(ws + A_QB), (const bf16*)(ws + A_KB), (const bf16*)(ws + A_KVRAW), (bf16*)(ws + A_AO)); } break;
        case OP_G_WO: case OP_G_PW2: case OP_G_SSO: case OP_G_FF2: {
            unsigned char* ws = WSP; float* x = OUTP;
            const float* rlo = (layer == 0 && op != OP_G_FF2) ? INP(I_XP) : x; const float* rhi = (layer == 0 && op != OP_G_FF2) ? INP(I_XS) - (size_t)TP * 1024 : x;
            pg8::Gemm g; const float* bias = nullptr; int goff = 2048;
            if (op == OP_G_WO) g = pg8::Gemm{(const bf16*)(ws + A_AO), (const bf16*)(ws + W_MLA + j * MLA_WB + MW_O), T, 1024, 1024};
            else if (op == OP_G_PW2) { g = pg8::Gemm{(const bf16*)(ws + A_V), (const bf16*)(ws + W_CV2), T, 1024, 1024}; bias = INP(I_CVB2); }
            else if (op == OP_G_SSO) g = pg8::Gemm{(const bf16*)(ws + A_YN), (const bf16*)(ws + W_SSO), T, 1024, 2048};
            else { g = pg8::Gemm{(const bf16*)(ws + A_ACT), (const bf16*)(ws + W_FF + layer * FF_WB + FW_OUT), T, 1024, 2816}; goff = 5120; }
            pg8::StaticOrder S; S.init(T, 2 * 1024, F.G, F.bx);
            float* xdst = x;
            const int sn_ = 2 * layer + (op == OP_G_FF2 ? 2 : 1);
            pg8::EpiResid<1> E{rlo, rhi, xdst, (const float*)(ws + WS_MODS) + (size_t)layer * 5 * 6144, goff, bias,
                               sn_ < 8 ? (bf16*)(ws + WS_H) : nullptr, (const float*)(ws + WS_GT) + (size_t)(sn_ & 7) * 5 * 1024, (float*)(ws + WS_STAT) + (sn_ & 7) * 8192};
            pg8::gemm_phase<pg8::EpiResid<1>, pg8::StaticOrder, true, true, true>(F.lds, g, S, E, F.wave); } break;
        case OP_G_FF1: { unsigned char* ws = WSP; pg8::Gemm g{(const bf16*)(ws + WS_H), (const bf16*)(ws + W_FF + layer * FF_WB + FW_IN), T, 5632, 1024}; pg8::StaticOrder S; S.init(T, 5632, F.G, F.bx);
            const int s_ = 2 * layer + 1; pg8::EpiGlu<0> E{(bf16*)(ws + A_ACT), 2816, nullptr, 2816, (const float*)(ws + WS_STAT) + s_ * 8192, (const float*)(ws + WS_SW) + (size_t)s_ * 5 * 5632}; pg8::gemm_phase<pg8::EpiGlu<0>, pg8::StaticOrder, true, true>(F.lds, g, S, E, F.wave); } break;
        case OP_G_PW1: { unsigned char* ws = WSP; pg8::Gemm g{(const bf16*)(ws + WS_H), (const bf16*)(ws + W_CV1), T, 2048, 1024}; pg8::StaticOrder S; S.init(T, 2048, F.G, F.bx);
            const int s_ = 2 * layer; pg8::EpiGlu<1> E{(bf16*)(ws + A_U), 1024, INP(I_CVB1), 1024, (const float*)(ws + WS_STAT) + s_ * 8192, (const float*)(ws + WS_SW) + (size_t)s_ * 5 * 5632}; pg8::gemm_phase<pg8::EpiGlu<1>, pg8::StaticOrder, true, true>(F.lds, g, S, E, F.wave); } break;
        case OP_DWCONV: { unsigned char* ws = WSP; rp_dwconv(F, (const bf16*)(ws + A_U), INP(I_CVWD), INP(I_CVBD), INP(I_CVGL), INP(I_CVBL), (bf16*)(ws + A_V)); } break;
        case OP_G_SSI: { unsigned char* ws = WSP; pg8::Gemm g{(const bf16*)(ws + WS_H), (const bf16*)(ws + W_SSI), T, 5376, 1024}; pg8::StaticOrder S; S.init(T, 5376, F.G, F.bx);
            const int s_ = 2 * layer; pg8::EpiSsdIn E{(bf16*)(ws + A_Z), (bf16*)(ws + A_XPRE), (float*)(ws + A_DTRAW), (const float*)(ws + WS_STAT) + s_ * 8192, (const float*)(ws + WS_SW) + (size_t)s_ * 5 * 5632}; pg8::gemm_phase<pg8::EpiSsdIn, pg8::StaticOrder, true, true>(F.lds, g, S, E, F.wave); } break;
        case OP_SSCONV: { unsigned char* ws = WSP; rp_ssd_conv(F, (const bf16*)(ws + A_XPRE), (const float*)(ws + A_DTRAW), INP(I_SSWC), INP(I_SSBC), INP(I_SSDTB), INP(I_SSAL), (bf16*)(ws + A_XBC), (float*)(ws + A_DT), (float*)(ws + A_ACUM)); } break;
        case OP_SCAN: { unsigned char* ws = WSP; ph_scan(F, (const bf16*)(ws + A_XBC), (const float*)(ws + A_DT), (const float*)(ws + A_ACUM), INP(I_SSD), INP(I_SSM), (bf16*)(ws + A_Y), OUTP); } break;
        case OP_GATE: { unsigned char* ws = WSP; rp_ssd_gate(F, (const bf16*)(ws + A_Y), (const bf16*)(ws + A_Z), INP(I_SSGN), (bf16*)(ws + A_YN)); } break;
        default: break;
        }

        if (ph + 1 < ph_hi) xcd_barrier(bar);

    }
}

extern "C" void kernel_launch(void* const* d_in, const int* in_sizes, int n_in, void* d_out, int out_size, void* d_ws, size_t ws_size, hipStream_t stream) {
    static int grid = 0;
    if (grid == 0) {
        int dev = 0, cus = 0;
        if (hipGetDevice(&dev) != hipSuccess || hipDeviceGetAttribute(&cus, hipDeviceAttributeMultiprocessorCount, dev) != hipSuccess) { fprintf(stderr, "kernel_launch: device query failed\n"); grid = -1; return; }
        if (hipFuncSetAttribute((const void*)mega_fwd, hipFuncAttributeMaxDynamicSharedMemorySize, LDS_BYTES) != hipSuccess) { fprintf(stderr, "kernel_launch: hipFuncSetAttribute failed\n"); grid = -1; return; }
        (void)hipGetLastError();
        grid = cus;
    }
    if (grid < 0) return;
    (void)hipMemsetAsync((char*)d_ws + WS_CTL, 0, CTL_ZERO_BYTES, stream);
    MArgs a{};
    for (int i = 0; i < 38; ++i) a.in[i] = (const float*)d_in[i];
    a.out = (float*)d_out; a.ws = (unsigned char*)d_ws;
    a.ph_lo = 0; a.ph_hi = NPHASE;
    hipLaunchKernelGGL(mega_fwd, dim3(grid), dim3(NTHR), LDS_BYTES, stream, a);
}
```

```cpp
#include <hip/hip_runtime.h>
#include <cstdint>
#include <cstdio>

constexpr int DM = 1024, T = 8192, TP = 4096;
constexpr int NCTX = 1024;
constexpr int QL = 384, KVL = 256, ROPE = 32, NOPE = 64, QKD = 96, VH = 64, NH = 16;
constexpr int FFH = 2816;
constexpr int SSI = 2048, SSH = 32, SSP = 64, SSN = 128, SSG = 4, SSCD = 3072, SSIN = 5184;
constexpr float EPS = 1e-6f;
constexpr size_t OUT_YP = 0, OUT_CKV = 8388608, OUT_KPE = 10485760, OUT_SSM = 10747904;

__device__ __forceinline__ int cond_of_row(int r) { return r < TP ? 0 : 1 + ((r - TP) >> 10); }
__device__ __forceinline__ void row_pos(int r, int& t, int& L) { if (r < TP) { t = r & 255; L = 256; } else { t = (r - TP) & 1023; L = 1024; } }
__device__ __forceinline__ float softplus_f(float x) { return fmaxf(x, 0.f) + log1pf(expf(-fabsf(x))); }

__device__ __forceinline__ float rope_inv(int i) { return i == 0 ? 1.f : i == 1 ? 0.31622776601683794f : i == 2 ? 0.1f : i == 3 ? 0.031622776601683794f : i == 4 ? 0.01f : i == 5 ? 0.0031622776601683794f : i == 6 ? 0.001f : 0.00031622776601683794f; }

__device__ __forceinline__ int olane() { int l; asm volatile("v_mbcnt_lo_u32_b32 %0, -1, 0\n\tv_mbcnt_hi_u32_b32 %0, -1, %0" : "=v"(l)); return l; }
__device__ __forceinline__ int obid() { int b = blockIdx.x; asm volatile("" : "+s"(b)); return b; }
namespace pg8 {
#define PG8_LAS __attribute__((address_space(3)))
typedef unsigned short bf16_t;
typedef short bf16x8 __attribute__((ext_vector_type(8)));
typedef float f32x4 __attribute__((ext_vector_type(4)));
typedef unsigned u32x4 __attribute__((ext_vector_type(4)));
constexpr int BM = 256, BK = 64, HALF = 128, HTB = HALF * BK * 2  , STAGE_BYTES = 8 * HTB, NXCD = 8, WGM = 8;

__host__ __device__ __forceinline__ int lds_byte(int r, int c) { const int st = (r >> 4) * 2 + (c >> 5), rr = r & 15, cc = c & 31, ob = rr * 64 + cc * 2; return st * 1024 + (ob ^ (((ob >> 9) & 1) << 5)); }
__host__ __device__ __forceinline__ void stage_rc(int b, int& R, int& C) { const int st = b / 1024, sb = b % 1024, swz = sb ^ (((sb >> 9) & 1) << 5); R = (st >> 1) * 16 + swz / 64; C = (st & 1) * 32 + (swz % 64) / 2; }
__host__ __device__ __forceinline__ int perm32(int rho) { const int n = rho >> 4, i = rho & 15; return 8 * (i >> 2) + 4 * n + (i & 3); }

struct Unit { int pm, pn; };
struct Gemm { const bf16_t* A; const bf16_t* Bt; int M, N, K; };

struct StaticOrder {
    int nM, nN, nwg, G, c;
    __host__ __device__ void init(int M, int N, int G_, int c_) { nM = M / BM; nN = N / BM; nwg = nM * nN; G = G_; c = c_; }
    __host__ __device__ bool next(int i, Unit& u) const {
        const long L = (long)i * G + c; if (L >= nwg) return false;
        int wgid = (int)L; { const int q = nwg / NXCD, r = nwg % NXCD, xcd = wgid % NXCD, off = wgid / NXCD; wgid = (xcd < r ? xcd * (q + 1) : r * (q + 1) + (xcd - r) * q) + off; }
        const int nig = WGM * nN, gid = wgid / nig, fm = gid * WGM, gsz = (nM - fm) < WGM ? (nM - fm) : WGM;
        u.pm = fm + ((wgid % nig) % gsz); u.pn = (wgid % nig) / gsz; return true;
    }
    __device__ __forceinline__ void a_ready(const Unit&) const {}
    __device__ __forceinline__ void done(const Unit&) const {}
};
__device__ __forceinline__ unsigned cvt_pk_bf16(float lo, float hi) { unsigned r; asm volatile("v_cvt_pk_bf16_f32 %0, %1, %2" : "=v"(r) : "v"(lo), "v"(hi)); return r; }
typedef unsigned u32x2 __attribute__((ext_vector_type(2)));
#define PG8_GAS __attribute__((address_space(1)))
__device__ __forceinline__ void st16(void* p, u32x4 v) { *(PG8_GAS u32x4*)p = v; }
__device__ __forceinline__ void st16f(void* p, f32x4 v) { *(PG8_GAS f32x4*)p = v; }
__device__ __forceinline__ void st8(void* p, u32x2 v) { *(PG8_GAS u32x2*)p = v; }
__device__ __forceinline__ f32x4 ld16f(const float* p) { return *(const PG8_GAS f32x4*)p; }
__device__ __forceinline__ float ld4f(const float* p) { return *(const PG8_GAS float*)p; }
__device__ __forceinline__ float fast_sigmoid(float x) { return __builtin_amdgcn_rcpf(1.f + __builtin_amdgcn_exp2f(-1.4426950408889634f * x)); }
__device__ __forceinline__ unsigned cvt_pk_bf16_p(float lo, float hi) { unsigned r; asm("v_cvt_pk_bf16_f32 %0, %1, %2" : "=v"(r) : "v"(lo), "v"(hi)); return r; }
template <int MODE> __device__ __forceinline__ void glu8(const f32x4 a0, const f32x4 g0, const f32x4 a1, const f32x4 g1, f32x4& o0, f32x4& o1) {
    const f32x4 t0 = (MODE == 0 ? a0 : g0) * -1.4426950408889634f, t1 = (MODE == 0 ? a1 : g1) * -1.4426950408889634f;
    f32x4 e0, e1, r0, r1;
#pragma unroll
    for (int j = 0; j < 4; ++j) { e0[j] = __builtin_amdgcn_exp2f(t0[j]); e1[j] = __builtin_amdgcn_exp2f(t1[j]); }
    const f32x4 d0 = e0 + 1.f, d1 = e1 + 1.f;
#pragma unroll
    for (int j = 0; j < 4; ++j) { r0[j] = __builtin_amdgcn_rcpf(d0[j]); r1[j] = __builtin_amdgcn_rcpf(d1[j]); }
    if (MODE == 0) { o0 = a0 * g0 * r0; o1 = a1 * g1 * r1; } else { o0 = a0 * r0; o1 = a1 * r1; }
}

constexpr int SW_LD = 5632;
__device__ __forceinline__ int cond_of_pm(int pm) { return pm < 16 ? 0 : 1 + ((pm - 16) >> 2); }
__device__ __forceinline__ void stage_rstat_sw(const float* rstat, const float* sw, const Unit& u, int slot, int wid, int lane, PG8_LAS unsigned char* tabs) {
    PG8_LAS unsigned char* tab = tabs + slot * 2048;
    if (wid < 4) __builtin_amdgcn_global_load_lds((const unsigned*)(rstat + u.pm * BM + wid * 64 + lane), (PG8_LAS unsigned*)(tab + wid * 256), 4, 0, 0);
    else __builtin_amdgcn_global_load_lds((const unsigned*)(sw + (size_t)cond_of_pm(u.pm) * SW_LD + u.pn * BM + (wid - 4) * 64 + lane), (PG8_LAS unsigned*)(tab + 1024 + (wid - 4) * 256), 4, 0, 0);
}
template <int NBJ> struct EpiF32 {
    static constexpr bool PERM = false, AFTER_DRAIN = false, STAGE_IN = false;
    float* C; int ldc; const float* rstat; const float* sw;
    __device__ __forceinline__ void operator()(const f32x4 (&acc)[2][2][4][2], const Unit& u, int wr_, int wc_, int fr_, int fq_, const PG8_LAS unsigned char* tab) const {
        const int t_ = olane(), wr = wr_, wc = wc_, fr = t_ & 15, fq = t_ >> 4; (void)fr_; (void)fq_; (void)tab;
        const int row0 = u.pm * BM + wr * 64 + fr, col0 = u.pn * (HALF * NBJ) + wc * 32 + 4 * fq;
#pragma unroll
        for (int ai = 0; ai < 2; ++ai)
#pragma unroll
            for (int m = 0; m < 4; ++m) { float* rowp = C + (size_t)(row0 + ai * HALF + m * 16) * ldc + col0;
                const float rs = rstat ? __builtin_amdgcn_rsqf(ld4f(rstat + row0 + ai * HALF + m * 16) * (1.f / 1024) + 1e-6f) : 1.f; const float* swp = sw ? sw + (size_t)cond_of_pm(u.pm) * SW_LD + col0 : nullptr;
#pragma unroll
                for (int bj = 0; bj < NBJ; ++bj)
#pragma unroll
                    for (int n = 0; n < 2; ++n) { f32x4 v = acc[ai][bj][m][n] * rs; if (swp) v += ld16f(swp + bj * HALF + n * 16); st16f(rowp + bj * HALF + n * 16, v); } }
    }
};
struct EpiBf16P {
    static constexpr bool PERM = true, AFTER_DRAIN = false, STAGE_IN = false;
    bf16_t* O; int ldc;
    __device__ __forceinline__ void operator()(const f32x4 (&acc)[2][2][4][2], const Unit& u, int wr_, int wc_, int fr_, int fq_, const PG8_LAS unsigned char* tab) const {
        const int t_ = olane(), wr = wr_, wc = wc_, fr = t_ & 15, fq = t_ >> 4; (void)fr_; (void)fq_; (void)tab;
        const int row0 = u.pm * BM + wr * 64 + fr, col0 = u.pn * BM + wc * 32 + 8 * fq;
#pragma unroll
        for (int ai = 0; ai < 2; ++ai)
#pragma unroll
            for (int m = 0; m < 4; ++m) { bf16_t* rowp = O + (size_t)(row0 + ai * HALF + m * 16) * ldc + col0;
#pragma unroll
                for (int bj = 0; bj < 2; ++bj) { const f32x4 v0 = acc[ai][bj][m][0], v1 = acc[ai][bj][m][1]; u32x4 w;
                    w.x = cvt_pk_bf16(v0[0], v0[1]); w.y = cvt_pk_bf16(v0[2], v0[3]); w.z = cvt_pk_bf16(v1[0], v1[1]); w.w = cvt_pk_bf16(v1[2], v1[3]);
                    st16(rowp + bj * HALF, w); } }
    }
};
struct EpiSsdIn {
    static constexpr bool PERM = true, AFTER_DRAIN = false, STAGE_IN = true;
    bf16_t* Z; bf16_t* XP; float* DT; const float* rstat; const float* sw;
    __device__ __forceinline__ void stage_in(const Unit& u, int slot, int wid, int lane, PG8_LAS unsigned char* tabs) const { stage_rstat_sw(rstat, sw, u, slot, wid, lane, tabs); }
    __device__ __forceinline__ void operator()(const f32x4 (&acc)[2][2][4][2], const Unit& u, int wr_, int wc_, int fr_, int fq_, const PG8_LAS unsigned char* tab) const {
        const int t_ = olane(), wr = wr_, wc = wc_, fr = t_ & 15, fq = t_ >> 4; (void)fr_; (void)fq_;
        const int row0 = u.pm * BM + wr * 64 + fr;
        const PG8_LAS float* trs = (const PG8_LAS float*)tab + wr * 64 + fr; const PG8_LAS float* swp = (const PG8_LAS float*)(tab + 1024) + wc * 32 + 8 * fq;
        if (u.pn < 20) {
            bf16_t* base = u.pn < 8 ? Z : XP; const int ld = u.pn < 8 ? 2048 : 3072, colt = (u.pn < 8 ? u.pn : u.pn - 8) * BM, col0 = colt + wc * 32 + 8 * fq;
#pragma unroll
            for (int ai = 0; ai < 2; ++ai)
#pragma unroll
                for (int m = 0; m < 4; ++m) { bf16_t* rowp = base + (size_t)(row0 + ai * HALF + m * 16) * ld + col0;
                    const float rs = __builtin_amdgcn_rsqf(trs[ai * HALF + m * 16] * (1.f / 1024) + 1e-6f);
#pragma unroll
                    for (int bj = 0; bj < 2; ++bj) { const f32x4 v0 = acc[ai][bj][m][0] * rs + *(const PG8_LAS f32x4*)(swp + bj * HALF), v1 = acc[ai][bj][m][1] * rs + *(const PG8_LAS f32x4*)(swp + bj * HALF + 4); u32x4 w;
                        w.x = cvt_pk_bf16(v0[0], v0[1]); w.y = cvt_pk_bf16(v0[2], v0[3]); w.z = cvt_pk_bf16(v1[0], v1[1]); w.w = cvt_pk_bf16(v1[2], v1[3]);
                        st16(rowp + bj * HALF, w); } }
        } else if (wc < 2) {
#pragma unroll
            for (int ai = 0; ai < 2; ++ai)
#pragma unroll
                for (int m = 0; m < 4; ++m) { float* rp = DT + (size_t)(row0 + ai * HALF + m * 16) * 64 + wc * 32 + 8 * fq;
                    const float rs = __builtin_amdgcn_rsqf(trs[ai * HALF + m * 16] * (1.f / 1024) + 1e-6f);
                    st16f(rp, acc[ai][0][m][0] * rs + *(const PG8_LAS f32x4*)swp); st16f(rp + 4, acc[ai][0][m][1] * rs + *(const PG8_LAS f32x4*)(swp + 4)); }
        }
    }
};
template <int MODE> struct EpiGlu {
    static constexpr bool PERM = false, AFTER_DRAIN = false, STAGE_IN = true;
    bf16_t* O; int ldo; const float* bias; int H; const float* rstat; const float* sw;
    __device__ __forceinline__ void stage_in(const Unit& u, int slot, int wid, int lane, PG8_LAS unsigned char* tabs) const { stage_rstat_sw(rstat, sw, u, slot, wid, lane, tabs); }
    __device__ __forceinline__ void operator()(const f32x4 (&acc)[2][2][4][2], const Unit& u, int wr_, int wc_, int fr_, int fq_, const PG8_LAS unsigned char* tab) const {
        const int t_ = olane(), wr = wr_, wc = wc_, fr = t_ & 15, fq = t_ >> 4; (void)fr_; (void)fq_;
        const int row0 = u.pm * BM + wr * 64 + fr;
        float rs[2][4];
#pragma unroll
        for (int ai = 0; ai < 2; ++ai)
#pragma unroll
            for (int m = 0; m < 4; ++m) rs[ai][m] = ((const PG8_LAS float*)tab)[ai * HALF + wr * 64 + m * 16 + fr];
#pragma unroll
        for (int ai = 0; ai < 2; ++ai)
#pragma unroll
            for (int m = 0; m < 4; ++m) rs[ai][m] = __builtin_amdgcn_rsqf(rs[ai][m] * (1.f / 1024) + 1e-6f);
        const unsigned ldb = (unsigned)ldo * 2u;
        unsigned char* Ob = (unsigned char*)O;
        const int f0 = 128 * u.pn + 32 * wc + 8 * fq;
        f32x4 ba[2], bu[2];
#pragma unroll
        for (int bj = 0; bj < 2; ++bj) {
            ba[bj] = (f32x4){0.f, 0.f, 0.f, 0.f}; bu[bj] = ba[bj];
            if (MODE == 1) { ba[bj] = ld16f(bias + f0 + 4 * bj); bu[bj] = ld16f(bias + H + f0 + 4 * bj); }
            const PG8_LAS float* swp = (const PG8_LAS float*)(tab + 1024) + bj * HALF + wc * 32 + 4 * fq; ba[bj] += *(const PG8_LAS f32x4*)swp; bu[bj] += *(const PG8_LAS f32x4*)(swp + 16);
        }
        const unsigned ob = (unsigned)row0 * ldb + (unsigned)f0 * 2u;
#pragma unroll
        for (int ai = 0; ai < 2; ++ai)
#pragma unroll
            for (int m = 0; m < 4; ++m) {
                const f32x4 a0 = acc[ai][0][m][0] * rs[ai][m] + ba[0], g0 = acc[ai][0][m][1] * rs[ai][m] + bu[0];
                const f32x4 a1 = acc[ai][1][m][0] * rs[ai][m] + ba[1], g1 = acc[ai][1][m][1] * rs[ai][m] + bu[1];
                f32x4 o0, o1; glu8<MODE>(a0, g0, a1, g1, o0, o1);
                u32x4 w; w.x = cvt_pk_bf16_p(o0[0], o0[1]); w.y = cvt_pk_bf16_p(o0[2], o0[3]); w.z = cvt_pk_bf16_p(o1[0], o1[1]); w.w = cvt_pk_bf16_p(o1[2], o1[3]);
                st16(Ob + (size_t)(ob + (unsigned)(ai * HALF + m * 16) * ldb), w); }
    }
};
template <int NBJ> struct EpiResid {
    static constexpr bool PERM = false, AFTER_DRAIN = false, STAGE_IN = false;
    const float* xlo; const float* xhi; float* xout; const float* mods_l; int g_off; const float* bias;
    bf16_t* XG; const float* GT; float* stat;
    __device__ __forceinline__ void operator()(const f32x4 (&acc)[2][2][4][2], const Unit& u, int wr_, int wc_, int fr_, int fq_, const PG8_LAS unsigned char* tab) const {
        const int t_ = olane(), wr = wr_, wc = wc_, fr = t_ & 15, fq = t_ >> 4; (void)fr_; (void)fq_; (void)tab;
        const int cond = u.pm < 16 ? 0 : 1 + ((u.pm - 16) >> 2);
        const float* gate = mods_l + (size_t)cond * 6144 + g_off; const float* xin = u.pm < 16 ? xlo : xhi;
        const int row0 = u.pm * BM + wr * 64 + fr, col0 = u.pn * (HALF * NBJ) + wc * 32 + 4 * fq;
        float ss[2][4];
#pragma unroll
        for (int ai = 0; ai < 2; ++ai)
#pragma unroll
            for (int m = 0; m < 4; ++m) ss[ai][m] = 0.f;
        const float* gt = XG ? GT + (size_t)cond * 1024 : nullptr;
#pragma unroll
        for (int bj = 0; bj < NBJ; ++bj)
#pragma unroll
            for (int n = 0; n < 2; ++n) { const int c = col0 + bj * HALF + n * 16; const f32x4 g4 = ld16f(gate + c);
                const f32x4 b4 = bias ? ld16f(bias + c) : (f32x4){0.f, 0.f, 0.f, 0.f};
                f32x4 G4 = (f32x4){0.f, 0.f, 0.f, 0.f}; if (XG) G4 = ld16f(gt + c);
#pragma unroll
                for (int ai = 0; ai < 2; ++ai)
#pragma unroll
                    for (int m = 0; m < 4; ++m) { const size_t off = (size_t)(row0 + ai * HALF + m * 16) * 1024 + c;
                        const f32x4 xo = ld16f(xin + off); const f32x4 xn = xo + g4 * (acc[ai][bj][m][n] + b4); st16f(xout + off, xn);
                        if (XG) { const f32x4 xg = xn * G4; u32x2 w; w.x = cvt_pk_bf16(xg[0], xg[1]); w.y = cvt_pk_bf16(xg[2], xg[3]); st8(XG + off, w);
                            ss[ai][m] += (xn[0] * xn[0] + xn[1] * xn[1]) + (xn[2] * xn[2] + xn[3] * xn[3]); } } }
        if (XG) {
#pragma unroll
            for (int ai = 0; ai < 2; ++ai)
#pragma unroll
                for (int m = 0; m < 4; ++m) { float s = ss[ai][m];
                    s += __builtin_bit_cast(float, __builtin_amdgcn_ds_bpermute((t_ ^ 16) << 2, __builtin_bit_cast(int, s)));
                    s += __builtin_bit_cast(float, __builtin_amdgcn_ds_bpermute((t_ ^ 32) << 2, __builtin_bit_cast(int, s)));
                    if (fq == 0) atomicAdd(stat + row0 + ai * HALF + m * 16, s); }
        }
    }
};
template <class Epi, class Sched, bool ALIGN_EPI = false, bool SP2 = false, bool HALFN = false>
__device__ __forceinline__ void gemm_phase(PG8_LAS unsigned char* lds, const Gemm g, const Sched& S, const Epi& E, const int wave_in) {
    const int tid = wave_in * 64 + olane(), wid = __builtin_amdgcn_readfirstlane(tid >> 6), lane = tid & 63, wr = wid >> 2, wc = wid & 3, fr = lane & 15, fq = lane >> 4;
    const int K = g.K, nt = K / BK;
    unsigned voffA[2], voffB[2];
#pragma unroll
    for (int i = 0; i < 2; ++i) { int R, C; stage_rc(tid * 16 + i * 8192, R, C); const int Rb = Epi::PERM ? ((R & ~31) + perm32(R & 31)) : R;
        voffA[i] = (unsigned)(R * K + C) * 2u; voffB[i] = (unsigned)(Rb * K + C) * 2u; }
    const size_t kstep = (size_t)(BK * 2);
    const size_t hstep = (size_t)HALF * K * 2;
    const size_t tstep = 2 * hstep;
    const size_t bstep = HALFN ? hstep : tstep;
    static_assert(!HALFN || SP2, "HALFN is written for the SP2 loop only");
    const unsigned ldsw = (unsigned)wid * 1024u;
    const int aoff = lds_byte(wr * 64 + fr, fq * 8), boff = lds_byte(wc * 32 + fr, fq * 8);
#define PG8_SA(b, h) (((b) * 2 + (h)) * HTB)
#define PG8_SB(b, h) ((4 + (b) * 2 + (h)) * HTB)
#define PG8_STAGE(bufoff, gbase, voff) do { _Pragma("unroll") for (int _i = 0; _i < 2; ++_i) \
        __builtin_amdgcn_global_load_lds((const unsigned*)((const char*)(gbase) + (voff)[_i]), (PG8_LAS unsigned*)(lds + (bufoff) + ldsw + _i * 8192), 16, 0, 0); } while (0)
#define PG8_LDA(dst, b, h) do { _Pragma("unroll") for (int m = 0; m < 4; ++m) _Pragma("unroll") for (int k = 0; k < 2; ++k) dst[m][k] = *(const PG8_LAS bf16x8*)(lds + PG8_SA(b, h) + aoff + m * 2048 + k * 1024); } while (0)
#define PG8_LDB(dst, b, h) do { _Pragma("unroll") for (int n = 0; n < 2; ++n) _Pragma("unroll") for (int k = 0; k < 2; ++k) dst[n][k] = *(const PG8_LAS bf16x8*)(lds + PG8_SB(b, h) + boff + n * 2048 + k * 1024); } while (0)
#define PG8_MMA(ai, bj, At, Bt) do { __builtin_amdgcn_s_setprio(1); _Pragma("unroll") for (int m = 0; m < 4; ++m) _Pragma("unroll") for (int n = 0; n < 2; ++n) _Pragma("unroll") for (int k = 0; k < 2; ++k) \
        acc[ai][bj][m][n] = __builtin_amdgcn_mfma_f32_16x16x32_bf16(Bt[n][k], At[m][k], acc[ai][bj][m][n], 0, 0, 0); __builtin_amdgcn_s_setprio(0); } while (0)
#define PG8_WAIT_V(n) asm volatile("s_waitcnt vmcnt(" #n ")" ::: "memory")
#define PG8_WAIT_L(n) asm volatile("s_waitcnt lgkmcnt(" #n ")" ::: "memory")
#define PG8_BAR __builtin_amdgcn_s_barrier()
#define PG8_SCHED __builtin_amdgcn_sched_barrier(0)
    Unit cur, nxt; int ui = 0;
    if (!S.next(0, cur)) return;
    f32x4 acc[2][2][4][2];
#pragma unroll
    for (int a = 0; a < 2; ++a)
#pragma unroll
        for (int b = 0; b < 2; ++b)
#pragma unroll
            for (int m = 0; m < 4; ++m)
#pragma unroll
                for (int n = 0; n < 2; ++n) acc[a][b][m][n] = (f32x4){0.f, 0.f, 0.f, 0.f};
    bf16x8 At[4][2], B0[2][2], B1[2][2];
    const char* cA = (const char*)g.A + (size_t)cur.pm * tstep; const char* cB = (const char*)g.Bt + (size_t)cur.pn * bstep;
    S.a_ready(cur);
    if constexpr (Epi::STAGE_IN) E.stage_in(cur, 0, wid, lane, lds + STAGE_BYTES);
    if constexpr (HALFN) {
        PG8_STAGE(PG8_SB(0, 0), cB, voffB); PG8_STAGE(PG8_SA(0, 0), cA, voffA); PG8_STAGE(PG8_SA(0, 1), cA + hstep, voffA);
        if (wr == 1) PG8_BAR;
        PG8_WAIT_V(2); PG8_BAR;
        PG8_STAGE(PG8_SB(1, 0), cB + kstep, voffB); PG8_STAGE(PG8_SA(1, 0), cA + kstep, voffA);
        PG8_WAIT_V(4); PG8_BAR;
    } else if constexpr (SP2) {
        PG8_STAGE(PG8_SB(0, 0), cB, voffB); PG8_STAGE(PG8_SB(0, 1), cB + hstep, voffB); PG8_STAGE(PG8_SA(0, 0), cA, voffA); PG8_STAGE(PG8_SA(0, 1), cA + hstep, voffA);
        if (wr == 1) PG8_BAR;
        PG8_WAIT_V(2); PG8_BAR;
        PG8_STAGE(PG8_SB(1, 0), cB + kstep, voffB); PG8_STAGE(PG8_SA(1, 0), cA + kstep, voffA); PG8_STAGE(PG8_SB(1, 1), cB + hstep + kstep, voffB);
        PG8_WAIT_V(6); PG8_BAR;
    } else {
        PG8_STAGE(PG8_SB(0, 0), cB, voffB); PG8_STAGE(PG8_SA(0, 0), cA, voffA); PG8_STAGE(PG8_SB(0, 1), cB + hstep, voffB); PG8_STAGE(PG8_SA(0, 1), cA + hstep, voffA);
        if (wr == 1) PG8_BAR;
        PG8_WAIT_V(4); PG8_BAR;
        PG8_STAGE(PG8_SB(1, 0), cB + kstep, voffB); PG8_STAGE(PG8_SA(1, 0), cA + kstep, voffA); PG8_STAGE(PG8_SB(1, 1), cB + hstep + kstep, voffB);
        PG8_WAIT_V(6); PG8_BAR;
    }
    for (;;) {
        const bool has_next = S.next(ui + 1, nxt);
        const char* nA = has_next ? (const char*)g.A + (size_t)nxt.pm * tstep : cA; const char* nB = has_next ? (const char*)g.Bt + (size_t)nxt.pn * bstep : cB;
        for (int t = 0; t < nt; t += 2) {
            const bool last = (t == nt - 2);
            const char* a1 = cA + (size_t)(t + 1) * kstep;
            const char* a2 = last ? nA : cA + (size_t)(t + 2) * kstep; const char* b2 = last ? nB : cB + (size_t)(t + 2) * kstep;
            const char* a3 = a2 + kstep; const char* b3 = b2 + kstep;
            if (last && has_next) S.a_ready(nxt);
            if constexpr (Epi::STAGE_IN) { if (last && has_next) E.stage_in(nxt, (ui + 1) & 1, wid, lane, lds + STAGE_BYTES); }
            if constexpr (HALFN) {
            PG8_LDB(B0, 0, 0); PG8_SCHED; PG8_LDA(At, 0, 0); PG8_STAGE(PG8_SA(1, 1), a1 + hstep, voffA);
            PG8_WAIT_V(6); PG8_WAIT_L(0); PG8_BAR; PG8_MMA(0, 0, At, B0); PG8_BAR; PG8_SCHED;
            PG8_LDA(At, 0, 1); PG8_STAGE(PG8_SB(0, 0), b2, voffB); PG8_STAGE(PG8_SA(0, 0), a2, voffA);
            PG8_WAIT_V(6); PG8_WAIT_L(0); PG8_BAR; PG8_MMA(1, 0, At, B0); PG8_BAR; PG8_SCHED;
            PG8_LDB(B0, 1, 0); PG8_SCHED; PG8_LDA(At, 1, 0); PG8_STAGE(PG8_SA(0, 1), a2 + hstep, voffA);
            PG8_WAIT_V(6); PG8_WAIT_L(0); PG8_BAR; PG8_MMA(0, 0, At, B0); PG8_BAR; PG8_SCHED;
            PG8_LDA(At, 1, 1); PG8_STAGE(PG8_SB(1, 0), b3, voffB); PG8_STAGE(PG8_SA(1, 0), a3, voffA);
            PG8_WAIT_V(6); PG8_WAIT_L(0); PG8_BAR; PG8_MMA(1, 0, At, B0); PG8_BAR; PG8_SCHED;
            } else if constexpr (SP2) {
            PG8_LDB(B0, 0, 0); PG8_LDB(B1, 0, 1); PG8_SCHED; PG8_LDA(At, 0, 0); PG8_STAGE(PG8_SA(1, 1), a1 + hstep, voffA);
            PG8_WAIT_V(8); PG8_WAIT_L(0); PG8_BAR; PG8_MMA(0, 0, At, B0); PG8_MMA(0, 1, At, B1); PG8_BAR; PG8_SCHED;
            PG8_LDA(At, 0, 1); PG8_STAGE(PG8_SB(0, 0), b2, voffB); PG8_STAGE(PG8_SB(0, 1), b2 + hstep, voffB); PG8_STAGE(PG8_SA(0, 0), a2, voffA);
            PG8_WAIT_V(8); PG8_WAIT_L(0); PG8_BAR; PG8_MMA(1, 0, At, B0); PG8_MMA(1, 1, At, B1); PG8_BAR; PG8_SCHED;
            PG8_LDB(B0, 1, 0); PG8_LDB(B1, 1, 1); PG8_SCHED; PG8_LDA(At, 1, 0); PG8_STAGE(PG8_SA(0, 1), a2 + hstep, voffA);
            PG8_WAIT_V(8); PG8_WAIT_L(0); PG8_BAR; PG8_MMA(0, 0, At, B0); PG8_MMA(0, 1, At, B1); PG8_BAR; PG8_SCHED;
            PG8_LDA(At, 1, 1); PG8_STAGE(PG8_SB(1, 0), b3, voffB); PG8_STAGE(PG8_SB(1, 1), b3 + hstep, voffB); PG8_STAGE(PG8_SA(1, 0), a3, voffA);
            PG8_WAIT_V(8); PG8_WAIT_L(0); PG8_BAR; PG8_MMA(1, 0, At, B0); PG8_MMA(1, 1, At, B1); PG8_BAR; PG8_SCHED;
            } else {
            PG8_LDB(B0, 0, 0); PG8_SCHED; PG8_LDA(At, 0, 0); PG8_STAGE(PG8_SA(1, 1), a1 + hstep, voffA);
            PG8_WAIT_L(8); PG8_BAR; PG8_WAIT_L(0); PG8_MMA(0, 0, At, B0); PG8_BAR; PG8_SCHED;
            PG8_LDB(B1, 0, 1); PG8_STAGE(PG8_SB(0, 0), b2, voffB);
            PG8_BAR; PG8_WAIT_L(0); PG8_MMA(0, 1, At, B1); PG8_BAR;
            PG8_LDA(At, 0, 1); PG8_STAGE(PG8_SA(0, 0), a2, voffA);
            PG8_BAR; PG8_WAIT_L(0); PG8_MMA(1, 0, At, B0); PG8_BAR; PG8_SCHED;
            PG8_STAGE(PG8_SB(0, 1), b2 + hstep, voffB);
            PG8_WAIT_V(6); PG8_BAR; PG8_MMA(1, 1, At, B1); PG8_BAR;
            PG8_LDB(B0, 1, 0); PG8_SCHED; PG8_LDA(At, 1, 0); PG8_STAGE(PG8_SA(0, 1), a2 + hstep, voffA);
            PG8_WAIT_L(8); PG8_BAR; PG8_WAIT_L(0); PG8_MMA(0, 0, At, B0); PG8_BAR; PG8_SCHED;
            PG8_LDB(B1, 1, 1); PG8_STAGE(PG8_SB(1, 0), b3, voffB);
            PG8_BAR; PG8_WAIT_L(0); PG8_MMA(0, 1, At, B1); PG8_BAR;
            PG8_LDA(At, 1, 1); PG8_STAGE(PG8_SA(1, 0), a3, voffA);
            PG8_BAR; PG8_WAIT_L(0); PG8_MMA(1, 0, At, B0); PG8_BAR; PG8_SCHED;
            PG8_STAGE(PG8_SB(1, 1), b3 + hstep, voffB);
            PG8_WAIT_V(6); PG8_BAR; PG8_MMA(1, 1, At, B1); PG8_BAR;
            }
        }
        if constexpr (ALIGN_EPI) { if (wr == 0) PG8_BAR; }
        if constexpr (!Epi::AFTER_DRAIN) { E(acc, cur, wr, wc, fr, fq, lds + STAGE_BYTES + (ui & 1) * 2048); S.done(cur); }
        if (!has_next) break;
#pragma unroll
        for (int a = 0; a < 2; ++a)
#pragma unroll
            for (int b = 0; b < 2; ++b)
#pragma unroll
                for (int m = 0; m < 4; ++m)
#pragma unroll
                    for (int n = 0; n < 2; ++n) acc[a][b][m][n] = (f32x4){0.f, 0.f, 0.f, 0.f};
        cur = nxt; cA = nA; cB = nB; ++ui;
        if constexpr (ALIGN_EPI) { if (wr == 1) PG8_BAR; }
    }
    PG8_WAIT_V(0);
    if constexpr (!ALIGN_EPI) { if (wr == 0) PG8_BAR; }
    PG8_BAR;
    if constexpr (Epi::AFTER_DRAIN) { E.fused(acc, cur, wr, wc, fr, fq, lds, wid, lane); S.done(cur); }
#undef PG8_SA
#undef PG8_SB
#undef PG8_STAGE
#undef PG8_LDA
#undef PG8_LDB
#undef PG8_MMA
#undef PG8_WAIT_V
#undef PG8_WAIT_L
#undef PG8_BAR
#undef PG8_SCHED
}
}
constexpr int NWAVES = 8, NTHR = 512;
constexpr size_t MiB = 1u << 20;
constexpr size_t WS_CTL = 0, CTL_ZERO_BYTES = 1 * MiB;
constexpr size_t WS_MODS = 256 * 1024;
constexpr size_t WS_STAT = 768 * 1024;
constexpr size_t WS_SW = 372 * MiB, WS_GT = 374 * MiB;
constexpr size_t WS_ROPE = 1 * MiB;
constexpr size_t WS_W = 2 * MiB;
constexpr size_t W_MLA = WS_W, MLA_WB = 5898240;
constexpr size_t MW_CAT = 0, MW_UQ = 1572864, MW_UKV = 2752512, MW_O = 3801088;
constexpr size_t W_CV1 = WS_W + 2 * MLA_WB, W_CV2 = W_CV1 + 4 * MiB;
constexpr size_t W_SSI = W_CV2 + 2 * MiB, W_SSO = W_SSI + 11010048;
constexpr size_t W_FF = W_SSO + 4 * MiB, FF_WB = 17301504, FW_IN = 0, FW_OUT = 11534336;
static_assert(W_FF + 4 * FF_WB <= 102 * MiB, "weights region");
constexpr size_t WS_H = 102 * MiB;
constexpr size_t WS_CKV = 118 * MiB, CKV_B = (size_t)(T + NCTX) * KVL * 2;
constexpr size_t WS_AR = 128 * MiB;
constexpr size_t A_LAT = WS_AR, A_QN = A_LAT + 24 * MiB, A_QRAW = A_QN + 6 * MiB, A_KVRAW = A_QRAW + 24 * MiB, A_QB = A_KVRAW + 36 * MiB, A_KB = A_QB + 24 * MiB, A_AO = A_KB + 27 * MiB;
constexpr size_t A_U = WS_AR, A_V = A_U + 16 * MiB;
constexpr size_t A_Z = WS_AR, A_XPRE = A_Z + 32 * MiB, A_DTRAW = A_XPRE + 48 * MiB, A_XBC = A_DTRAW + 2 * MiB, A_DT = A_XBC + 48 * MiB, A_Y = A_DT + 2 * MiB, A_YN = A_XPRE, A_ACUM = A_Y + 64 * MiB;
constexpr size_t A_ACT = WS_AR + 200 * MiB;
static_assert(A_AO + 16 * MiB <= A_ACT && A_ACUM + 2 * MiB <= A_ACT && A_ACT + 44 * MiB <= 384 * MiB, "arena map");
constexpr int CW_BAR = 4096;
constexpr int LDS_BYTES = 163840, RING_BYTES = 131072, MISC_OFF = 163840 - 256, PTAB_OFF_C = MISC_OFF - 512;

#define GAS __attribute__((address_space(1)))
#define LAS __attribute__((address_space(3)))
typedef unsigned short bf16;
typedef unsigned v4u __attribute__((ext_vector_type(4)));
typedef unsigned v2u __attribute__((ext_vector_type(2)));
typedef float v4f __attribute__((ext_vector_type(4)));
typedef float v2f __attribute__((ext_vector_type(2)));
typedef GAS unsigned gu32;
#define LDS_WAIT() asm volatile("s_waitcnt lgkmcnt(0)" ::: "memory")
#define LDS_BARRIER() do { asm volatile("s_waitcnt lgkmcnt(0)" ::: "memory"); __builtin_amdgcn_s_barrier(); asm volatile("" ::: "memory"); } while (0)
#define VM_WAIT() asm volatile("s_waitcnt vmcnt(0)" ::: "memory")
__device__ __forceinline__ unsigned f2bf(float f) { unsigned u = __builtin_bit_cast(unsigned, f); return (u + 0x7fffu + ((u >> 16) & 1u)) >> 16; }
__device__ __forceinline__ unsigned pk2(float lo, float hi) { return f2bf(lo) | (f2bf(hi) << 16); }
__device__ __forceinline__ float bflo(unsigned u) { return __builtin_bit_cast(float, u << 16); }
__device__ __forceinline__ float bfhi(unsigned u) { return __builtin_bit_cast(float, u & 0xffff0000u); }
__device__ __forceinline__ float bf2f(bf16 b) { return __builtin_bit_cast(float, (unsigned)b << 16); }

#define XB_TMO      128
#define XB_XCNT(j)  (256  + 64 * (j))
#define XB_XSUB(j)  (1280 + 64 * (j))
#define XB_XGEN(j)  (2304 + 64 * (j))
#define XB_TOP      3328
#define XB_TOPGEN   3392
#define XCD_BAR_WORDS 3456
#define XB_SPIN_CAP (1u << 18)

__device__ __forceinline__ unsigned xb_ld(unsigned* p)              { return __hip_atomic_load(p, __ATOMIC_RELAXED, __HIP_MEMORY_SCOPE_AGENT); }
__device__ __forceinline__ unsigned xb_add(unsigned* p, unsigned v) { return __hip_atomic_fetch_add(p, v, __ATOMIC_RELAXED, __HIP_MEMORY_SCOPE_AGENT); }
__device__ __forceinline__ unsigned xb_xcc_id() { return (unsigned)__builtin_amdgcn_s_getreg((3 << 11) | 20) & 0xFu; }
#define XB_SPIN(cond, bar) do { unsigned _sp = 0; while (cond) { __builtin_amdgcn_s_sleep(1); \
    if ((++_sp & 255u) == 0u) { if (xb_ld(&(bar)[XB_TMO])) break; if (_sp > XB_SPIN_CAP) { atomicAdd(&(bar)[XB_TMO], 1u); break; } } } } while (0)

struct XcdBarrier {
    unsigned* bar; unsigned x;
    volatile LAS unsigned* st;
};

__device__ __forceinline__ XcdBarrier xcd_barrier_post(unsigned* bar, volatile LAS unsigned* st) {
    XcdBarrier b; b.bar = bar; b.x = xb_xcc_id(); b.st = st;
    if (threadIdx.x == 0) (void)xb_add(&bar[XB_XCNT(b.x)], 1u);
    return b;
}
__device__ __forceinline__ void xcd_barrier_complete(unsigned* bar, unsigned x, unsigned& nloc, unsigned& nx) {
    const unsigned G = gridDim.x * gridDim.y * gridDim.z;
    unsigned sum, cnt, mine, sp = 0u;
    for (;;) {
        sum = 0u; cnt = 0u; mine = 0u;
#pragma unroll
        for (unsigned j = 0; j < 16; ++j) { const unsigned c = xb_ld(&bar[XB_XCNT(j)]); sum += c; cnt += (c > 0u) ? 1u : 0u; mine = (j == x) ? c : mine; }
        if (sum == G) break;
        __builtin_amdgcn_s_sleep(1);
        if ((++sp & 255u) == 0u) { if (xb_ld(&bar[XB_TMO])) break; if (sp > XB_SPIN_CAP) { atomicAdd(&bar[XB_TMO], 1u); break; } }
    }
    nloc = mine > 0u ? mine : 1u; nx = cnt > 0u ? cnt : 1u;
}

__device__ __forceinline__ void xcd_barrier(const XcdBarrier& b) {
    asm volatile("s_waitcnt vmcnt(0)" ::: "memory");
    __syncthreads();
    if (threadIdx.x == 0) {
        unsigned* bar = b.bar;
        __builtin_amdgcn_s_waitcnt(0);
        unsigned nloc = b.st[0], nx = b.st[1];
        if (nloc == 0u) { xcd_barrier_complete(bar, b.x, nloc, nx); b.st[0] = nloc; b.st[1] = nx; }
        const unsigned old = xb_add(&bar[XB_XSUB(b.x)], 1u);
        const unsigned gen = old / nloc;
        if (old + 1u == (gen + 1u) * nloc) {
            __builtin_amdgcn_fence(__ATOMIC_RELEASE, "agent");
            asm volatile("s_waitcnt vmcnt(0)" ::: "memory");
            const unsigned og = xb_add(&bar[XB_TOP], 1u);
            const unsigned tg = og / nx;
            if (og + 1u == (tg + 1u) * nx) xb_add(&bar[XB_TOPGEN], 1u);
            else XB_SPIN(xb_ld(&bar[XB_TOPGEN]) == tg, bar);
            __builtin_amdgcn_fence(__ATOMIC_ACQUIRE, "agent");
            xb_add(&bar[XB_XGEN(b.x)], 1u);
            asm volatile("s_waitcnt vmcnt(0)" ::: "memory");
        } else {
            XB_SPIN(xb_ld(&bar[XB_XGEN(b.x)]) == gen, bar);
            __builtin_amdgcn_fence(__ATOMIC_ACQUIRE, "agent");
            asm volatile("s_waitcnt vmcnt(0)" ::: "memory");
        }
    }
    __syncthreads();
}

struct Frame {
    LAS unsigned char* lds; int tid, lane, wave, vcu, G, gw, NGW, bx;
    volatile LAS unsigned* PT;
};
constexpr int PT_OUT = 38, PT_WS = 39;
__device__ __forceinline__ const float* ldp(volatile LAS unsigned* PT, int k) {
    const unsigned lo = __builtin_amdgcn_readfirstlane(PT[2 * k]), hi = __builtin_amdgcn_readfirstlane(PT[2 * k + 1]);
    return (const float*)(((unsigned long long)hi << 32) | lo);
}
#define INP(k) ldp(F.PT, (k))
#define WSP ((unsigned char*)ldp(F.PT, PT_WS))
#define OUTP ((float*)ldp(F.PT, PT_OUT))
enum InIdx { I_XP = 0, I_XS, I_CCKV, I_CKPE, I_SSM, I_C, I_CCTX, I_WADA, I_BADA, I_GN1, I_GN2, I_WDQ, I_GQ, I_WUQ, I_WDKV, I_GKV, I_WUKV, I_GQN, I_GKN, I_WO,
             I_CVW1, I_CVB1, I_CVWD, I_CVBD, I_CVGL, I_CVBL, I_CVW2, I_CVB2, I_SSWI, I_SSWC, I_SSBC, I_SSDTB, I_SSAL, I_SSD, I_SSGN, I_SSWO, I_FFWI, I_FFWO };
__device__ __forceinline__ float shx(float v, int lane, int o) { return __builtin_bit_cast(float, __builtin_amdgcn_ds_bpermute((lane ^ o) << 2, __builtin_bit_cast(int, v))); }
__device__ __forceinline__ float wsum(float v, int lane) {
#pragma unroll
    for (int o = 1; o < 64; o <<= 1) v += shx(v, lane, o);
    return v;
}
constexpr float QSCALE = 0.10206207261596577f * 1.4426950408889634f;

struct P0Item { const float* W; bf16* WT; int K, N, mode, H, roff, k0, n0; };
__device__ __forceinline__ void p0_item_load(const P0Item& J, int lane, v4f (&t)[8]) {
#pragma unroll
    for (int i = 0; i < 8; ++i) t[i] = *(const GAS v4f*)(J.W + (size_t)(J.k0 + 8 * i + (lane >> 3)) * J.N + J.n0 + 4 * (lane & 7));
}
__device__ __forceinline__ void p0_item_finish(const P0Item& J, int lane, const v4f (&t)[8], LAS float* scr) {
#pragma unroll
    for (int i = 0; i < 8; ++i) { LAS float* d = scr + (8 * i + (lane >> 3)) * 33 + 4 * (lane & 7); d[0] = t[i].x; d[1] = t[i].y; d[2] = t[i].z; d[3] = t[i].w; }
    LDS_WAIT(); asm volatile("" ::: "memory");
    const int c = lane & 7;
#pragma unroll
    for (int j = 0; j < 4; ++j) { const int n = (lane >> 3) + 8 * j, col = J.n0 + n; const LAS float* s = scr + (8 * c) * 33 + n;
        int drow;
        if (J.mode == 0) drow = J.roff + col;
        else { const int f = col < J.H ? col : col - J.H; drow = 256 * (f >> 7) + 128 * ((f >> 2) & 1) + 32 * ((f >> 5) & 3) + (col < J.H ? 0 : 16) + 4 * ((f >> 3) & 3) + (f & 3); }
        v4u o; o.x = pk2(s[0 * 33], s[1 * 33]); o.y = pk2(s[2 * 33], s[3 * 33]); o.z = pk2(s[4 * 33], s[5 * 33]); o.w = pk2(s[6 * 33], s[7 * 33]);
        *(GAS v4u*)(J.WT + (size_t)drow * J.K + J.k0 + 8 * c) = o; }
    LDS_WAIT(); asm volatile("" ::: "memory");
}
__device__ __forceinline__ void p0_job(int q, int& inp, size_t& soff, int& K, int& N, size_t& doff, int& mode, int& H, int& roff) {
    mode = 0; H = 0; roff = 0; soff = 0;
    if (q < 10) { const int j = q / 5, t = q % 5; const size_t wb = W_MLA + (size_t)j * MLA_WB;
        if (t == 0) { inp = I_WDQ; soff = (size_t)j * 1024 * 384; K = 1024; N = 384; doff = wb + MW_CAT; }
        else if (t == 1) { inp = I_WDKV; soff = (size_t)j * 1024 * 288; K = 1024; N = 288; doff = wb + MW_CAT; roff = 384; }
        else if (t == 2) { inp = I_WUQ; soff = (size_t)j * 384 * 1536; K = 384; N = 1536; doff = wb + MW_UQ; }
        else if (t == 3) { inp = I_WUKV; soff = (size_t)j * 256 * 2048; K = 256; N = 2048; doff = wb + MW_UKV; }
        else { inp = I_WO; soff = (size_t)j * 1024 * 1024; K = 1024; N = 1024; doff = wb + MW_O; } }
    else if (q == 10) { inp = I_CVW1; K = 1024; N = 2048; doff = W_CV1; mode = 1; H = 1024; }
    else if (q == 11) { inp = I_CVW2; K = 1024; N = 1024; doff = W_CV2; }
    else if (q == 12) { inp = I_SSWI; K = 1024; N = 5184; doff = W_SSI; }
    else if (q == 13) { inp = I_SSWO; K = 2048; N = 1024; doff = W_SSO; }
    else { const int l = (q - 14) >> 1, t = (q - 14) & 1;
        if (t == 0) { inp = I_FFWI; soff = (size_t)l * 1024 * 5632; K = 1024; N = 5632; doff = W_FF + (size_t)l * FF_WB + FW_IN; mode = 1; H = 2816; }
        else { inp = I_FFWO; soff = (size_t)l * 2816 * 1024; K = 2816; N = 1024; doff = W_FF + (size_t)l * FF_WB + FW_OUT; } }
}
constexpr int P0_NITEMS = 2 * ((1024 / 64) * (384 / 32) + (1024 / 64) * (288 / 32) + (384 / 64) * (1536 / 32) + (256 / 64) * (2048 / 32) + (1024 / 64) * (1024 / 32))
                        + (1024 / 64) * (2048 / 32) + (1024 / 64) * (1024 / 32) + (1024 / 64) * (5184 / 32) + (2048 / 64) * (1024 / 32)
                        + 4 * ((1024 / 64) * (5632 / 32) + (2816 / 64) * (1024 / 32));
__device__ __forceinline__ void p0_prologue(Frame& F) {
    unsigned char* ws = WSP;
    LAS float* s = (LAS float*)F.lds;
    for (int i = F.tid; i < 5 * 1024; i += NTHR) { const int cc = i >> 10, k = i & 1023; const float v = cc == 0 ? INP(I_CCTX)[k] : INP(I_C)[(cc - 1) * 1024 + k]; s[i] = v / (1.f + expf(-v)); }
    __syncthreads();
    float* mods = (float*)(ws + WS_MODS);
    for (int it = F.bx; it < 192; it += F.G) {
        const int l = it / 48, r = it % 48, cb = r / 16, ks = r % 16, n = cb * 2048 + 4 * F.tid;
        const float* W = INP(I_WADA) + (size_t)l * 1024 * 6144 + (size_t)(ks * 64) * 6144 + n;
        v4f acc[5];
#pragma unroll
        for (int cc = 0; cc < 5; ++cc) acc[cc] = (v4f){0.f, 0.f, 0.f, 0.f};
#pragma unroll 1
        for (int kb = 0; kb < 64; kb += 16) {
            v4f wv[16];
#pragma unroll
            for (int k = 0; k < 16; ++k) wv[k] = *(const GAS v4f*)(W + (size_t)(kb + k) * 6144);
#pragma unroll
            for (int k = 0; k < 16; ++k)
#pragma unroll
                for (int cc = 0; cc < 5; ++cc) acc[cc] += wv[k] * s[cc * 1024 + ks * 64 + kb + k];
        }
        LAS float* tbl = s + 5 * 1024;
        __syncthreads();
#pragma unroll
        for (int cc = 0; cc < 5; ++cc) *(LAS v4f*)(tbl + cc * 2048 + 4 * F.tid) = acc[cc];
        __syncthreads();
        const float* bp = INP(I_BADA) + l * 6144 + cb * 2048;
#pragma unroll
        for (int q = 0; q < 4; ++q) { const int col = q * 512 + F.tid; const float bb = ks == 0 ? bp[col] : 0.f;
#pragma unroll
            for (int cc = 0; cc < 5; ++cc) atomicAdd(&mods[((size_t)l * 5 + cc) * 6144 + cb * 2048 + col], tbl[cc * 2048 + col] + bb); }
    }
    __syncthreads();
    LAS float* scr = (LAS float*)(F.lds + F.wave * 8448);
    for (int it = F.gw; it < P0_NITEMS; it += 2 * F.NGW) {
        P0Item J[2]; bool have1 = it + F.NGW < P0_NITEMS;
#pragma unroll
        for (int e = 0; e < 2; ++e) {
            int r = e == 0 ? it : (have1 ? it + F.NGW : it), inp = 0, K = 64, N = 32, mode = 0, H = 0, roff = 0; size_t soff = 0, doff = 0;
#pragma unroll 1
            for (int q = 0; q < 22; ++q) { p0_job(q, inp, soff, K, N, doff, mode, H, roff); const int ni = (K / 64) * (N / 32); if (r < ni) break; r -= ni; }
            const int nblk = N / 32;
            J[e].W = INP(inp) + soff; J[e].WT = (bf16*)(ws + doff); J[e].K = K; J[e].N = N; J[e].mode = mode; J[e].H = H; J[e].roff = roff; J[e].k0 = 64 * (r / nblk); J[e].n0 = 32 * (r % nblk);
        }
        v4f t0[8], t1[8];
        p0_item_load(J[0], F.lane, t0); p0_item_load(J[1], F.lane, t1);
        p0_item_finish(J[0], F.lane, t0, scr);
        if (have1) p0_item_finish(J[1], F.lane, t1, scr);
    }
    for (int it = F.gw; it < 384; it += F.NGW) {
        bf16* rowp = it < 192 ? (bf16*)(ws + W_MLA + (it / 96) * MLA_WB + MW_CAT) + (size_t)(672 + it % 96) * 1024 : (bf16*)(ws + W_SSI) + (size_t)(5184 + it - 192) * 1024;
        const v4u z = {0u, 0u, 0u, 0u}; ((GAS v4u*)rowp)[F.lane] = z; ((GAS v4u*)rowp)[64 + F.lane] = z;
    }
    for (int it = F.gw; it < 2048; it += F.NGW) {
        const int j = it >> 10, rr = it & 1023, b = rr >> 8, sq = rr & 255;
        const v4f v = ((const GAS v4f*)(INP(I_CCKV) + (((size_t)b * 2 + j) * 256 + sq) * 256))[F.lane];
        v2u o; o.x = pk2(v.x, v.y); o.y = pk2(v.z, v.w);
        ((GAS v2u*)((bf16*)(ws + WS_CKV + j * CKV_B) + (size_t)(T + rr) * 256))[F.lane] = o;
    }
    if (F.bx == 0) for (int i = F.tid; i < 640; i += NTHR) { const int pos = i >> 3, fi = i & 7; const float p = (float)(pos < 16 ? pos : pos - 16);
        const float a = p * rope_inv(fi); float* tab = (float*)(ws + WS_ROPE); tab[2 * i] = cosf(a); tab[2 * i + 1] = sinf(a); }
}

__device__ __forceinline__ void rp_normmod(Frame& F, const float* xlo, const float* xhi, const float* g, const float* mods_l, int sh_off, int sc_off, bf16* h) {
    for (int base = F.gw; base < T; base += 4 * F.NGW) {
        v4f v[4][4]; float ss[4]; int rows[4];
#pragma unroll
        for (int k = 0; k < 4; ++k) { const int row = base + k * F.NGW; rows[k] = row < T ? row : base;
            const GAS v4f* xr = (const GAS v4f*)((rows[k] < TP ? xlo : xhi) + (size_t)rows[k] * 1024) + F.lane;
#pragma unroll
            for (int j = 0; j < 4; ++j) v[k][j] = xr[64 * j]; }
#pragma unroll
        for (int k = 0; k < 4; ++k) { float s = 0.f;
#pragma unroll
            for (int j = 0; j < 4; ++j) s += (v[k][j].x * v[k][j].x + v[k][j].y * v[k][j].y) + (v[k][j].z * v[k][j].z + v[k][j].w * v[k][j].w);
            ss[k] = s; }
#pragma unroll
        for (int o = 1; o < 64; o <<= 1) {
#pragma unroll
            for (int k = 0; k < 4; ++k) ss[k] += shx(ss[k], F.lane, o); }
#pragma unroll
        for (int j = 0; j < 4; ++j) { const int c = 4 * F.lane + 256 * j; const v4f g4 = *(const GAS v4f*)(g + c);
#pragma unroll
            for (int k = 0; k < 4; ++k) { const float r = rsqrtf(ss[k] * (1.f / 1024) + EPS); const float* m = mods_l + (size_t)cond_of_row(rows[k]) * 6144;
                const v4f sc = *(const GAS v4f*)(m + sc_off + c), sh = *(const GAS v4f*)(m + sh_off + c);
                const v4f o = v[k][j] * r * g4 * (sc + 1.f) + sh; v2u w; w.x = pk2(o.x, o.y); w.y = pk2(o.z, o.w);
                *(GAS v2u*)(h + (size_t)rows[k] * 1024 + c) = w; } }
    }
}
__device__ __forceinline__ void rp_mla_fin1(Frame& F, const float* lat, const float* gq, const float* gkv, bf16* qn, bf16* ckv, float* out, int j) {
    for (int row = F.gw; row < T; row += F.NGW) {
        const float* lr = lat + (size_t)row * 768;
        v2f q[3]; float ss = 0.f;
#pragma unroll
        for (int i = 0; i < 3; ++i) { q[i] = *(const GAS v2f*)(lr + 2 * F.lane + 128 * i); ss += q[i].x * q[i].x + q[i].y * q[i].y; }
        float r = rsqrtf(wsum(ss, F.lane) * (1.f / 384) + EPS);
#pragma unroll
        for (int i = 0; i < 3; ++i) { const int c = 2 * F.lane + 128 * i; *(GAS unsigned*)(qn + (size_t)row * 384 + c) = pk2(q[i].x * r * gq[c], q[i].y * r * gq[c + 1]); }
        v2f k[2]; ss = 0.f;
#pragma unroll
        for (int i = 0; i < 2; ++i) { k[i] = *(const GAS v2f*)(lr + 384 + 2 * F.lane + 128 * i); ss += k[i].x * k[i].x + k[i].y * k[i].y; }
        r = rsqrtf(wsum(ss, F.lane) * (1.f / 256) + EPS);
#pragma unroll
        for (int i = 0; i < 2; ++i) { const int c = 2 * F.lane + 128 * i; const float c0 = k[i].x * r * gkv[c], c1 = k[i].y * r * gkv[c + 1];
            *(GAS unsigned*)(ckv + (size_t)row * 256 + c) = pk2(c0, c1);
            if (row < TP) { v2f o; o.x = c0; o.y = c1; *(GAS v2f*)(out + OUT_CKV + (((size_t)(row >> 8) * 2 + j) * 256 + (row & 255)) * 256 + c) = o; } }
        if (row < TP && F.lane < 32) out[OUT_KPE + (((size_t)(row >> 8) * 2 + j) * 256 + (row & 255)) * 32 + F.lane] = lr[640 + F.lane];
    }
}
__device__ __forceinline__ void rope32_tab(float* pe, int t, const float* tab) {
    const v2f* tr = (const v2f*)tab + (t >> 6) * 8; const v2f* tc = (const v2f*)tab + (16 + (t & 63)) * 8;
#pragma unroll
    for (int i = 0; i < 8; ++i) {
        v2f cs = tr[i]; float x1 = pe[i], x2 = pe[i + 8]; pe[i] = x1 * cs.x - x2 * cs.y; pe[i + 8] = x2 * cs.x + x1 * cs.y;
        cs = tc[i]; x1 = pe[16 + i]; x2 = pe[24 + i]; pe[16 + i] = x1 * cs.x - x2 * cs.y; pe[24 + i] = x2 * cs.x + x1 * cs.y;
    }
}
__device__ __forceinline__ void ld8(const bf16* p, float* d) { const v4u w = *(const GAS v4u*)p; d[0] = bflo(w.x); d[1] = bfhi(w.x); d[2] = bflo(w.y); d[3] = bfhi(w.y); d[4] = bflo(w.z); d[5] = bfhi(w.z); d[6] = bflo(w.w); d[7] = bfhi(w.w); }
__device__ __forceinline__ void st8(bf16* p, const float* d) { v4u w; w.x = pk2(d[0], d[1]); w.y = pk2(d[2], d[3]); w.z = pk2(d[4], d[5]); w.w = pk2(d[6], d[7]); *(GAS v4u*)p = w; }
__device__ __forceinline__ void rp_tables(Frame& F) {
    unsigned char* ws = WSP; const float* mods = (const float*)(ws + WS_MODS); float* GTb = (float*)(ws + WS_GT); float* SWb = (float*)(ws + WS_SW);
    for (int idx = F.bx * NTHR + F.tid; idx < 8 * 5 * 1024; idx += F.G * NTHR) {
        const int s = idx / 5120, r = idx % 5120, c = r >> 10, k = r & 1023, layer = s >> 1;
        const float g = (s & 1) ? INP(I_GN2)[layer * 1024 + k] : INP(I_GN1)[layer * 1024 + k];
        GTb[idx] = g * (1.f + mods[((size_t)layer * 5 + c) * 6144 + ((s & 1) ? 4096 : 1024) + k]);
    }
    constexpr int NR1 = 5632, NR2 = 2048, NR4 = 5376, NR6 = 768;
    constexpr int TOT = 4 * NR1 + NR2 + NR4 + NR6;
    for (int it = F.gw; it < TOT / 4; it += F.NGW) {
        int s, n; const bf16* Wt; const int i4 = 4 * it;
        if (i4 < 4 * NR1) { const int l = i4 / NR1; n = i4 % NR1; s = 2 * l + 1; Wt = (const bf16*)(ws + W_FF + (size_t)l * FF_WB + FW_IN); }
        else if (i4 < 4 * NR1 + NR2) { n = i4 - 4 * NR1; s = 2; Wt = (const bf16*)(ws + W_CV1); }
        else if (i4 < 4 * NR1 + NR2 + NR4) { n = i4 - 4 * NR1 - NR2; s = 4; Wt = (const bf16*)(ws + W_SSI); }
        else { n = i4 - 4 * NR1 - NR2 - NR4; s = 6; Wt = (const bf16*)(ws + W_MLA + MLA_WB + MW_CAT); }
        const int layer = s >> 1, shoff = (s & 1) ? 3072 : 0;
        v4u wr[4][2];
#pragma unroll
        for (int r = 0; r < 4; ++r) { wr[r][0] = *(const GAS v4u*)(Wt + (size_t)(n + r) * 1024 + 16 * F.lane); wr[r][1] = *(const GAS v4u*)(Wt + (size_t)(n + r) * 1024 + 16 * F.lane + 8); }
        float acc[4][5];
#pragma unroll
        for (int r = 0; r < 4; ++r)
#pragma unroll
            for (int c = 0; c < 5; ++c) acc[r][c] = 0.f;
#pragma unroll
        for (int c = 0; c < 5; ++c) { const float* sp = mods + ((size_t)layer * 5 + c) * 6144 + shoff + 16 * F.lane;
            const v4f s0 = *(const GAS v4f*)sp, s1 = *(const GAS v4f*)(sp + 4), s2 = *(const GAS v4f*)(sp + 8), s3 = *(const GAS v4f*)(sp + 12);
#pragma unroll
            for (int r = 0; r < 4; ++r) { const v4u a = wr[r][0], b2 = wr[r][1];
                acc[r][c] = (s0.x * bflo(a.x) + s0.y * bfhi(a.x) + s0.z * bflo(a.y) + s0.w * bfhi(a.y)) + (s1.x * bflo(a.z) + s1.y * bfhi(a.z) + s1.z * bflo(a.w) + s1.w * bfhi(a.w))
                          + (s2.x * bflo(b2.x) + s2.y * bfhi(b2.x) + s2.z * bflo(b2.y) + s2.w * bfhi(b2.y)) + (s3.x * bflo(b2.z) + s3.y * bfhi(b2.z) + s3.z * bflo(b2.w) + s3.w * bfhi(b2.w)); } }
#pragma unroll
        for (int o = 1; o < 64; o <<= 1) {
#pragma unroll
            for (int r = 0; r < 4; ++r)
#pragma unroll
                for (int c = 0; c < 5; ++c) acc[r][c] += shx(acc[r][c], F.lane, o); }
        if (F.lane < 20) { const int r = F.lane / 5, c = F.lane % 5; float v = 0.f;
#pragma unroll
            for (int rr = 0; rr < 4; ++rr)
#pragma unroll
                for (int cc = 0; cc < 5; ++cc) v = (rr == r && cc == c) ? acc[rr][cc] : v;
            SWb[((size_t)s * 5 + c) * 5632 + n + r] = v; }
    }
}
__device__ __forceinline__ void rp_mla_fin2(Frame& F, const bf16* qraw, const bf16* kvraw, const float* lat, const float* ckpe_j, const float* gqn, const float* gkn, const float* tab, bf16* Q, bf16* K) {
    for (int idx = F.bx * NTHR + F.tid; idx < T * 32; idx += F.G * NTHR) {
        const int row = idx >> 5, hd = (idx >> 1) & 15, hf = idx & 1; const bool latent = row >= TP; const int tl = (row - TP) & 1023;
        float v[48]; float ss = 0.f;
#pragma unroll
        for (int i = 0; i < 6; ++i) ld8(qraw + (size_t)row * 1536 + hd * 96 + hf * 48 + 8 * i, v + 8 * i);
#pragma unroll
        for (int d = 0; d < 48; ++d) ss += v[d] * v[d];
        ss += shx(ss, F.lane, 1);
        const float r = rsqrtf(ss * (1.f / 96) + EPS) * QSCALE;
#pragma unroll
        for (int d = 0; d < 48; ++d) v[d] = v[d] * r * gqn[hf * 48 + d];
        if (latent && hf) rope32_tab(v + 16, tl, tab);
#pragma unroll
        for (int i = 0; i < 6; ++i) st8(Q + ((size_t)row * 16 + hd) * 96 + hf * 48 + 8 * i, v + 8 * i);
    }
    asm volatile("" ::: "memory");
    for (int idx = F.bx * NTHR + F.tid; idx < (T + NCTX) * 32; idx += F.G * NTHR) {
        const int row = idx >> 5, hd = (idx >> 1) & 15, hf = idx & 1; const bool latent = row >= TP && row < T; const int tl = (row - TP) & 1023;
        float v[48]; float ss = 0.f;
        if (hf == 0) {
#pragma unroll
            for (int i = 0; i < 6; ++i) ld8(kvraw + (size_t)row * 2048 + hd * 128 + 8 * i, v + 8 * i);
        } else {
#pragma unroll
            for (int i = 0; i < 2; ++i) ld8(kvraw + (size_t)row * 2048 + hd * 128 + 48 + 8 * i, v + 8 * i);
            const float* kp = row < T ? lat + (size_t)row * 768 + 640 : ckpe_j + ((size_t)((row - T) >> 8) * 2 * 256 + ((row - T) & 255)) * 32;
#pragma unroll
            for (int i = 0; i < 8; ++i) { const v4f p4 = *(const GAS v4f*)(kp + 4 * i); v[16 + 4 * i] = p4.x; v[17 + 4 * i] = p4.y; v[18 + 4 * i] = p4.z; v[19 + 4 * i] = p4.w; }
        }
#pragma unroll
        for (int d = 0; d < 48; ++d) ss += v[d] * v[d];
        ss += shx(ss, F.lane, 1);
        const float r = rsqrtf(ss * (1.f / 96) + EPS);
#pragma unroll
        for (int d = 0; d < 48; ++d) v[d] = v[d] * r * gkn[hf * 48 + d];
        if (latent && hf) rope32_tab(v + 16, tl, tab);
#pragma unroll
        for (int i = 0; i < 6; ++i) st8(K + ((size_t)row * 16 + hd) * 96 + hf * 48 + 8 * i, v + 8 * i);
    }
}
__device__ __forceinline__ void rp_dwconv(Frame& F, const bf16* u, const float* wdw, const float* bdw, const float* gln, const float* bln, bf16* vout) {
    LAS float* red = (LAS float*)F.lds;
    const int c = 2 * F.tid;
    for (int it = F.vcu; it < T / 16; it += F.G) {
        const int row0 = 16 * it; int t0, L; row_pos(row0, t0, L);
        v2f w[31];
#pragma unroll
        for (int k = 0; k < 31; ++k) w[k] = *(const GAS v2f*)(wdw + k * 1024 + c);
        const v2f bb = *(const GAS v2f*)(bdw + c);
        float y0[16], y1[16];
#pragma unroll
        for (int r = 0; r < 16; ++r) { y0[r] = bb.x; y1[r] = bb.y; }
#pragma unroll
        for (int rr = 0; rr < 46; ++rr) {
            const int tt = t0 - 15 + rr; unsigned pk = 0u;
            if (tt >= 0 && tt < L) pk = *(const GAS unsigned*)(u + (size_t)(row0 - 15 + rr) * 1024 + c);
            const float u0 = bflo(pk), u1 = bfhi(pk);
#pragma unroll
            for (int k = 0; k < 31; ++k) { const int r = rr - k; if (r >= 0 && r < 16) { y0[r] += u0 * w[k].x; y1[r] += u1 * w[k].y; } }
        }
        float s[16];
#pragma unroll
        for (int r = 0; r < 16; ++r) s[r] = y0[r] + y1[r];
#pragma unroll
        for (int o = 1; o < 64; o <<= 1) {
#pragma unroll
            for (int r = 0; r < 16; ++r) s[r] += shx(s[r], F.lane, o); }
        __syncthreads();
        if (F.lane < 16) { float v = s[0];
#pragma unroll
            for (int r = 1; r < 16; ++r) v = F.lane == r ? s[r] : v;
            red[F.wave * 16 + F.lane] = v; }
        __syncthreads();
        float mean[16];
#pragma unroll
        for (int r = 0; r < 16; ++r) { float m = 0.f;
#pragma unroll
            for (int wv = 0; wv < 8; ++wv) m += red[wv * 16 + r];
            mean[r] = m * (1.f / 1024); }
#pragma unroll
        for (int r = 0; r < 16; ++r) { y0[r] -= mean[r]; y1[r] -= mean[r]; s[r] = y0[r] * y0[r] + y1[r] * y1[r]; }
#pragma unroll
        for (int o = 1; o < 64; o <<= 1) {
#pragma unroll
            for (int r = 0; r < 16; ++r) s[r] += shx(s[r], F.lane, o); }
        __syncthreads();
        if (F.lane < 16) { float v = s[0];
#pragma unroll
            for (int r = 1; r < 16; ++r) v = F.lane == r ? s[r] : v;
            red[F.wave * 16 + F.lane] = v; }
        __syncthreads();
        const v2f gg = *(const GAS v2f*)(gln + c), bl = *(const GAS v2f*)(bln + c);
#pragma unroll
        for (int r = 0; r < 16; ++r) { float q = 0.f;
#pragma unroll
            for (int wv = 0; wv < 8; ++wv) q += red[wv * 16 + r];
            const float rs = rsqrtf(q * (1.f / 1024) + EPS);
            const float z0 = y0[r] * rs * gg.x + bl.x, z1 = y1[r] * rs * gg.y + bl.y;
            *(GAS unsigned*)(vout + (size_t)(row0 + r) * 1024 + c) = pk2(z0 / (1.f + __expf(-z0)), z1 / (1.f + __expf(-z1))); }
    }
    __syncthreads();
}
__device__ __forceinline__ void rp_ssd_conv(Frame& F, const bf16* xpre, const float* dtraw, const float* wc, const float* bc, const float* dtb, const float* alog, bf16* xbc, float* dt, float* acum) {
    for (int idx = F.bx * NTHR + F.tid; idx < (T / 32) * 384; idx += F.G * NTHR) {
        const int seg = idx / 384, cg = idx - seg * 384, c0 = 8 * cg, row0 = 32 * seg; int t0, L; row_pos(row0, t0, L);
        float w[5][8], bias[8];
#pragma unroll
        for (int k = 0; k < 5; ++k) { const v4f a = *(const GAS v4f*)(wc + k * 3072 + c0), b2 = *(const GAS v4f*)(wc + k * 3072 + c0 + 4);
            w[k][0] = a.x; w[k][1] = a.y; w[k][2] = a.z; w[k][3] = a.w; w[k][4] = b2.x; w[k][5] = b2.y; w[k][6] = b2.z; w[k][7] = b2.w; }
        { const v4f a = *(const GAS v4f*)(bc + c0), b2 = *(const GAS v4f*)(bc + c0 + 4); bias[0] = a.x; bias[1] = a.y; bias[2] = a.z; bias[3] = a.w; bias[4] = b2.x; bias[5] = b2.y; bias[6] = b2.z; bias[7] = b2.w; }
        float win[5][8];
#pragma unroll
        for (int k = 0; k < 4; ++k) { const int tt = t0 + k - 2;
            if (tt >= 0 && tt < L) ld8(xpre + (size_t)(row0 + k - 2) * 3072 + c0, win[k + 1]);
            else {
#pragma unroll
                for (int i = 0; i < 8; ++i) win[k + 1][i] = 0.f; } }
#pragma unroll 4
        for (int r = 0; r < 32; ++r) {
#pragma unroll
            for (int k = 0; k < 4; ++k)
#pragma unroll
                for (int i = 0; i < 8; ++i) win[k][i] = win[k + 1][i];
            const int tt = t0 + r + 2;
            if (tt < L) ld8(xpre + (size_t)(row0 + r + 2) * 3072 + c0, win[4]);
            else {
#pragma unroll
                for (int i = 0; i < 8; ++i) win[4][i] = 0.f; }
            float a[8];
#pragma unroll
            for (int i = 0; i < 8; ++i) { float v = bias[i];
#pragma unroll
                for (int k = 0; k < 5; ++k) v += win[k][i] * w[k][i];
                a[i] = v / (1.f + __expf(-v)); }
            st8(xbc + (size_t)(row0 + r) * 3072 + c0, a);
        }
    }
    for (int it = F.gw; it < 64 * 64; it += F.NGW) {
        const int ch = it >> 6, e = it & 63, dir = e >> 5, row0 = 128 * ch, lane = F.lane;
        const float aa = -expf(alog[e]), bb = dtb[e];
        const int i0 = dir == 0 ? lane : 127 - lane, i1 = dir == 0 ? lane + 64 : 63 - lane;
        const float d0 = softplus_f(dtraw[(size_t)(row0 + i0) * 64 + e] + bb), d1 = softplus_f(dtraw[(size_t)(row0 + i1) * 64 + e] + bb);
        float s0 = d0 * aa, s1 = d1 * aa;
#pragma unroll
        for (int o = 1; o < 64; o <<= 1) { const float u0 = __builtin_bit_cast(float, __builtin_amdgcn_ds_bpermute((lane - o) << 2, __builtin_bit_cast(int, s0))), u1 = __builtin_bit_cast(float, __builtin_amdgcn_ds_bpermute((lane - o) << 2, __builtin_bit_cast(int, s1)));
            if (lane >= o) { s0 += u0; s1 += u1; } }
        s1 += __builtin_bit_cast(float, __builtin_amdgcn_readlane(__builtin_bit_cast(int, s0), 63));
        dt[(size_t)(row0 + i0) * 64 + e] = d0; dt[(size_t)(row0 + i1) * 64 + e] = d1;
        acum[(size_t)(row0 + i0) * 64 + e] = s0; acum[(size_t)(row0 + i1) * 64 + e] = s1;
    }
}
__device__ __forceinline__ void rp_ssd_gate(Frame& F, const bf16* y, const bf16* z, const float* gn, bf16* yn) {
    for (int row = F.gw; row < T; row += F.NGW) {
#pragma unroll
        for (int g = 0; g < 4; ++g) { const int c0 = g * 512 + 8 * F.lane; float zz[8], v[8]; ld8(z + (size_t)row * 2048 + c0, zz);
            float yb[8]; ld8(y + (size_t)row * 2048 + c0, v); ld8(y + (size_t)(T + row) * 2048 + c0, yb);
#pragma unroll
            for (int i = 0; i < 8; ++i) v[i] += yb[i];
            float ss = 0.f;
#pragma unroll
            for (int i = 0; i < 8; ++i) { v[i] = v[i] * zz[i] / (1.f + __expf(-zz[i])); ss += v[i] * v[i]; }
            const float r = rsqrtf(wsum(ss, F.lane) * (1.f / 512) + EPS);
#pragma unroll
            for (int i = 0; i < 8; ++i) v[i] = v[i] * r * gn[c0 + i];
            st8(yn + (size_t)row * 2048 + c0, v); }
    }
}

typedef short a_bf16x8 __attribute__((ext_vector_type(8)));
typedef short a_s16x4 __attribute__((ext_vector_type(4)));
typedef float a_f32x16 __attribute__((ext_vector_type(16)));
typedef float a_f32x2 __attribute__((ext_vector_type(2))); typedef __bf16 a_bf16x2 __attribute__((ext_vector_type(2)));
__device__ __forceinline__ unsigned a_cvtpk(float lo, float hi) { a_f32x2 v = {lo, hi}; a_bf16x2 b = __builtin_convertvector(v, a_bf16x2); return __builtin_bit_cast(unsigned, b); }
__device__ __forceinline__ a_s16x4 a_vtr(const LAS unsigned char* p) { return __builtin_bit_cast(a_s16x4, __builtin_amdgcn_ds_read_tr16_b64_v4i16((LAS a_s16x4*)p)); }
constexpr int AT_KS = 208, AT_VS = 192, AT_KB = 64 * AT_KS, AT_VB = 64 * AT_VS, AT_VOFF = 2 * AT_KB;
__device__ __forceinline__ void at_tile(Frame& F, LAS unsigned char* lds, int buf, int lane, const a_bf16x8 (&qf)[6], a_f32x16& o0, a_f32x16& o1, float& m, float& l) {
    const int r32 = lane & 31, hi = lane >> 5;
    a_f32x16 p0, p1;
#pragma unroll
    for (int r = 0; r < 16; ++r) { p0[r] = 0.f; p1[r] = 0.f; }
    { const LAS unsigned char* kp = lds + buf * AT_KB + r32 * AT_KS + hi * 16;
#pragma unroll
      for (int s = 0; s < 6; ++s) { const a_bf16x8 a0 = *(const LAS a_bf16x8*)(kp + 32 * s), a1 = *(const LAS a_bf16x8*)(kp + 32 * AT_KS + 32 * s);
          p0 = __builtin_amdgcn_mfma_f32_32x32x16_bf16(a0, qf[s], p0, 0, 0, 0); p1 = __builtin_amdgcn_mfma_f32_32x32x16_bf16(a1, qf[s], p1, 0, 0, 0); } }

    float mx = fmaxf(p0[0], p1[0]);
#pragma unroll
    for (int r = 1; r < 16; ++r) mx = fmaxf(mx, fmaxf(p0[r], p1[r]));
    mx = fmaxf(mx, shx(mx, lane, 32));
    const float mn = fmaxf(m, mx), alpha = __builtin_amdgcn_exp2f(m - mn); m = mn;
    float ps = 0.f;
#pragma unroll
    for (int r = 0; r < 16; ++r) { p0[r] = __builtin_amdgcn_exp2f(p0[r] - mn); p1[r] = __builtin_amdgcn_exp2f(p1[r] - mn); ps += p0[r] + p1[r]; }
    l = l * alpha + ps;
#pragma unroll
    for (int r = 0; r < 16; ++r) { o0[r] *= alpha; o1[r] *= alpha; }
    v4u pw[4];
    pw[0] = (v4u){a_cvtpk(p0[0], p0[1]), a_cvtpk(p0[2], p0[3]), a_cvtpk(p0[4], p0[5]), a_cvtpk(p0[6], p0[7])};
    pw[1] = (v4u){a_cvtpk(p0[8], p0[9]), a_cvtpk(p0[10], p0[11]), a_cvtpk(p0[12], p0[13]), a_cvtpk(p0[14], p0[15])};
    pw[2] = (v4u){a_cvtpk(p1[0], p1[1]), a_cvtpk(p1[2], p1[3]), a_cvtpk(p1[4], p1[5]), a_cvtpk(p1[6], p1[7])};
    pw[3] = (v4u){a_cvtpk(p1[8], p1[9]), a_cvtpk(p1[10], p1[11]), a_cvtpk(p1[12], p1[13]), a_cvtpk(p1[14], p1[15])};

    const LAS unsigned char* vp0 = lds + AT_VOFF + buf * AT_VB + (4 * hi + ((lane & 15) >> 2)) * AT_VS + (16 * ((lane >> 4) & 1) + 4 * (lane & 3)) * 2;
    a_s16x4 vl0[4], vh0[4], vl1[4], vh1[4];
#pragma unroll
    for (int bs = 0; bs < 4; ++bs) { const LAS unsigned char* vq = vp0 + (16 * bs) * AT_VS; vl0[bs] = a_vtr(vq); vh0[bs] = a_vtr(vq + 8 * AT_VS); vl1[bs] = a_vtr(vq + 64); vh1[bs] = a_vtr(vq + 8 * AT_VS + 64); }
#pragma unroll
    for (int bs = 0; bs < 4; ++bs) {
        const a_bf16x8 v0 = (a_bf16x8){vl0[bs][0], vl0[bs][1], vl0[bs][2], vl0[bs][3], vh0[bs][0], vh0[bs][1], vh0[bs][2], vh0[bs][3]}, v1 = (a_bf16x8){vl1[bs][0], vl1[bs][1], vl1[bs][2], vl1[bs][3], vh1[bs][0], vh1[bs][1], vh1[bs][2], vh1[bs][3]};
        const a_bf16x8 pb = __builtin_bit_cast(a_bf16x8, pw[bs]);
        o0 = __builtin_amdgcn_mfma_f32_32x32x16_bf16(v0, pb, o0, 0, 0, 0); o1 = __builtin_amdgcn_mfma_f32_32x32x16_bf16(v1, pb, o1, 0, 0, 0); }
}
__device__ __forceinline__ void ph_attn(Frame& F, const bf16* Q, const bf16* K, const bf16* KV, bf16* AO) {
    const int lane = F.lane, r32 = lane & 31, hi = lane >> 5, wave = F.wave, tid = F.tid;
    LAS unsigned char* lds = F.lds;
    const int kr_a = tid / 12, kp_a = tid % 12, kr_b = (tid + 512) / 12, kp_b = (tid + 512) % 12, vr = tid >> 3, vp = tid & 7;
    const bool has_b = tid < 256;
    for (int uu = F.vcu; uu < 512; uu += F.G) {
        int head, q0, NT, kbase_ctx, kbase_lat;
        if (uu < 256) { const int seq = uu >> 4; head = uu & 15; q0 = seq * 256; NT = 4; kbase_ctx = seq * 256; kbase_lat = 0; }
        else { const int u2 = uu - 256, b = u2 >> 6, qb = u2 & 3; head = (u2 >> 2) & 15; q0 = TP + b * 1024 + qb * 256; NT = 20; kbase_ctx = T + b * 256; kbase_lat = TP + b * 1024; }
        a_bf16x8 qf[6];
        { const bf16* qp = Q + ((size_t)(q0 + wave * 32 + r32) * 16 + head) * 96 + hi * 8;
#pragma unroll
          for (int s = 0; s < 6; ++s) qf[s] = *(const GAS a_bf16x8*)(qp + 16 * s); }
        a_f32x16 o0, o1;
#pragma unroll
        for (int r = 0; r < 16; ++r) { o0[r] = 0.f; o1[r] = 0.f; }
        float m = -INFINITY, l = 0.f;
        v4u ka0, kb0, vv0, ka1, kb1, vv1, ka2, kb2_, vv2;
#define AT_LOAD(t, KA, KB2, VV) do { const int kr0_ = (t) < 4 ? kbase_ctx + 64 * (t) : kbase_lat + 64 * ((t) - 4); \
            KA = *(const GAS v4u*)(K + ((size_t)(kr0_ + kr_a) * 16 + head) * 96 + kp_a * 8); \
            if (has_b) KB2 = *(const GAS v4u*)(K + ((size_t)(kr0_ + kr_b) * 16 + head) * 96 + kp_b * 8); \
            VV = *(const GAS v4u*)(KV + (size_t)(kr0_ + vr) * 2048 + head * 128 + 64 + vp * 8); } while (0)
#define AT_STORE(buf, KA, KB2, VV) do { *(LAS v4u*)(lds + (buf) * AT_KB + kr_a * AT_KS + kp_a * 16) = KA; \
            if (has_b) *(LAS v4u*)(lds + (buf) * AT_KB + kr_b * AT_KS + kp_b * 16) = KB2; \
            *(LAS v4u*)(lds + AT_VOFF + (buf) * AT_VB + vr * AT_VS + vp * 16) = VV; } while (0)
#define AT_STEP(k, SA, SB, SC, SD_, SE_, SF_, SG, SH, SI) if (t + (k) < NT) { \
            if (t + (k) + 3 < NT) AT_LOAD(t + (k) + 3, SA, SB, SC);            \
            at_tile(F, lds, (k) & 1, lane, qf, o0, o1, m, l); \
            if (t + (k) + 1 < NT) AT_STORE(((k) + 1) & 1, SD_, SE_, SF_);       \
            LDS_BARRIER(); }
        AT_LOAD(0, ka0, kb0, vv0); AT_LOAD(1, ka1, kb1, vv1); AT_LOAD(2, ka2, kb2_, vv2);
        AT_STORE(0, ka0, kb0, vv0);
        LDS_BARRIER();
#pragma unroll 1
        for (int t = 0; t < NT; t += 6) {
            AT_STEP(0, ka0, kb0, vv0, ka1, kb1, vv1, 0, 0, 0)
            AT_STEP(1, ka1, kb1, vv1, ka2, kb2_, vv2, 0, 0, 0)
            AT_STEP(2, ka2, kb2_, vv2, ka0, kb0, vv0, 0, 0, 0)
            AT_STEP(3, ka0, kb0, vv0, ka1, kb1, vv1, 0, 0, 0)
            AT_STEP(4, ka1, kb1, vv1, ka2, kb2_, vv2, 0, 0, 0)
            AT_STEP(5, ka2, kb2_, vv2, ka0, kb0, vv0, 0, 0, 0)
        }
#undef AT_STEP
#undef AT_LOAD
#undef AT_STORE
        l += shx(l, lane, 32);
        const float il = 1.f / l;
        bf16* op = AO + (size_t)(q0 + wave * 32 + r32) * 1024 + head * 64 + 4 * hi;
#pragma unroll
        for (int g4 = 0; g4 < 4; ++g4) {
            v2u w0; w0.x = a_cvtpk(o0[4 * g4] * il, o0[4 * g4 + 1] * il); w0.y = a_cvtpk(o0[4 * g4 + 2] * il, o0[4 * g4 + 3] * il); *(GAS v2u*)(op + 8 * g4) = w0;
            v2u w1; w1.x = a_cvtpk(o1[4 * g4] * il, o1[4 * g4 + 1] * il); w1.y = a_cvtpk(o1[4 * g4 + 2] * il, o1[4 * g4 + 3] * il); *(GAS v2u*)(op + 32 + 8 * g4) = w1; }

    }
}
constexpr int SC_ST = 272, SC_XS = 144;
constexpr int SC_C = 0, SC_B = 128 * SC_ST, SC_M = 2 * 128 * SC_ST, SC_H = 3 * 128 * SC_ST, SC_X = SC_H + 64 * SC_ST, SC_XW = SC_X + 128 * SC_XS, SC_ARR = SC_XW + 128 * SC_XS;
static_assert(SC_ARR + 4 * 128 * 4 + 16 <= PTAB_OFF_C, "scan LDS map");
__device__ __forceinline__ int a_crow(int r, int hi) { return (r & 3) + 8 * (r >> 2) + 4 * hi; }
__device__ __forceinline__ void ph_scan(Frame& F, const bf16* xbc, const float* dt, const float* acg, const float* dsk, const float* st0, bf16* y, float* out) {
    const int lane = F.lane, r32 = lane & 31, hi = lane >> 5, wave = F.wave, tid = F.tid;
    LAS unsigned char* lds = F.lds;
    LAS float* acum = (LAS float*)(lds + SC_ARR); LAS float* wj = acum + 128; LAS float* ei = acum + 256; LAS float* dtj = acum + 384; LAS float* misc = acum + 512;
    const int q4 = (lane & 15) >> 2, gg = (lane >> 4) & 1, p4 = lane & 3;
    const int ib = wave >> 1, pb = wave & 1, nb = wave >> 1;
    v4u cr[4], br[4], xr[2];
    float pdt[2], pac[2], plast, pac_t, pdt_t;
#define SC_GLOADP(rowb_, g_, hd_, dir_) do { const int row0_ = (rowb_); \
        _Pragma("unroll") for (int k = 0; k < 4; ++k) { const int q = tid + 512 * k, rr = q >> 4, pp = q & 15; \
            cr[k] = *(const GAS v4u*)(xbc + (size_t)(row0_ + rr) * 3072 + 2560 + (g_) * 128 + pp * 8); br[k] = *(const GAS v4u*)(xbc + (size_t)(row0_ + rr) * 3072 + 2048 + (g_) * 128 + pp * 8); } \
        _Pragma("unroll") for (int k = 0; k < 2; ++k) { const int q = tid + 512 * k, rr = q >> 3, pp = q & 7; xr[k] = *(const GAS v4u*)(xbc + (size_t)(row0_ + rr) * 3072 + (hd_) * 64 + pp * 8); \
            pdt[k] = dt[(size_t)(row0_ + rr) * 64 + (dir_) * 32 + (hd_)]; pac[k] = acg[(size_t)(row0_ + rr) * 64 + (dir_) * 32 + (hd_)]; } \
        plast = acg[(size_t)(row0_ + ((dir_) == 0 ? 127 : 0)) * 64 + (dir_) * 32 + (hd_)]; \
        pac_t = acg[(size_t)(row0_ + (tid & 127)) * 64 + (dir_) * 32 + (hd_)]; pdt_t = dt[(size_t)(row0_ + (tid & 127)) * 64 + (dir_) * 32 + (hd_)]; } while (0)
#define SC_ITEM(slot_, ii_, seq_, hd_) do { if ((slot_) < 128) { seq_ = 16 + ((slot_) >> 5); hd_ = (slot_) & 31; } else { const int pi_ = 4 * ((slot_) - 128) + (ii_); seq_ = pi_ >> 5; hd_ = pi_ & 31; } } while (0)
    for (int slot = F.vcu; slot < 256; slot += F.G) {
        const int nitem = slot < 128 ? 1 : 4;
        { int seq0, hd0; SC_ITEM(slot, 0, seq0, hd0); SC_GLOADP(seq0 < 16 ? seq0 * 256 : TP + (seq0 - 16) * 1024, hd0 >> 3, hd0, 0); }
#pragma unroll 1
        for (int ii = 0; ii < nitem; ++ii) {
            int seq, hd;
            if (slot < 128) { seq = 16 + (slot >> 5); hd = slot & 31; } else { const int pi = 4 * (slot - 128) + ii; seq = pi >> 5; hd = pi & 31; }
            const int g = hd >> 3, r0 = seq < 16 ? seq * 256 : TP + (seq - 16) * 1024, nc = seq < 16 ? 2 : 8;
#pragma unroll 1
            for (int dir = 0; dir < 2; ++dir) {
                const float dd = dsk[dir * 32 + hd];
                a_f32x16 hacc;
                if (seq < 16) {
#pragma unroll
                    for (int r = 0; r < 16; ++r) hacc[r] = 0.f;
                } else { const float* s0 = st0 + ((((size_t)(seq - 16) * 2 + dir) * 32 + hd) * 64 + 32 * pb + r32) * 128 + 32 * nb + 4 * hi;
#pragma unroll
                    for (int g4 = 0; g4 < 4; ++g4) { const v4f t4 = *(const GAS v4f*)(s0 + 8 * g4); hacc[4 * g4] = t4.x; hacc[4 * g4 + 1] = t4.y; hacc[4 * g4 + 2] = t4.z; hacc[4 * g4 + 3] = t4.w; } }
#pragma unroll
                for (int g4 = 0; g4 < 4; ++g4) { v2u w; w.x = a_cvtpk(hacc[4 * g4], hacc[4 * g4 + 1]); w.y = a_cvtpk(hacc[4 * g4 + 2], hacc[4 * g4 + 3]);
                    *(LAS v2u*)(lds + SC_H + (32 * pb + r32) * SC_ST + (32 * nb + 8 * g4 + 4 * hi) * 2) = w; }
#pragma unroll 1
                for (int cc = 0; cc < nc; ++cc) {
                    const int c = dir == 0 ? cc : nc - 1 - cc, row0 = r0 + c * 128;
                    const int e = dir * 32 + hd;
                    const float last = plast;
                    LDS_BARRIER();
                    if (tid < 128) { const float ac = pac_t, dv = pdt_t;
                        acum[tid] = ac; dtj[tid] = dv; ei[tid] = __expf(ac); if (tid == 0) misc[0] = __expf(last); }
#pragma unroll
                    for (int k = 0; k < 4; ++k) { const int q = tid + 512 * k, rr = q >> 4, pp = q & 15; *(LAS v4u*)(lds + SC_C + rr * SC_ST + pp * 16) = cr[k]; *(LAS v4u*)(lds + SC_B + rr * SC_ST + pp * 16) = br[k]; }
#pragma unroll
                    for (int k = 0; k < 2; ++k) { const int q = tid + 512 * k, rr = q >> 3, pp = q & 7; *(LAS v4u*)(lds + SC_X + rr * SC_XS + pp * 16) = xr[k];
                        const float w = pdt[k] * __expf(last - pac[k]);
                        v4u s; s.x = a_cvtpk(bflo(xr[k].x) * w, bfhi(xr[k].x) * w); s.y = a_cvtpk(bflo(xr[k].y) * w, bfhi(xr[k].y) * w); s.z = a_cvtpk(bflo(xr[k].z) * w, bfhi(xr[k].z) * w); s.w = a_cvtpk(bflo(xr[k].w) * w, bfhi(xr[k].w) * w);
                        *(LAS v4u*)(lds + SC_XW + rr * SC_XS + pp * 16) = s; }
                    { int nrow = 0, nhd = hd, ndir = dir; bool hn = true;
                      if (cc + 1 < nc) nrow = r0 + (dir == 0 ? cc + 1 : nc - 2 - cc) * 128;
                      else if (dir == 0) { nrow = r0 + (nc - 1) * 128; ndir = 1; }
                      else if (ii + 1 < nitem) { int seqn; SC_ITEM(slot, ii + 1, seqn, nhd); nrow = seqn < 16 ? seqn * 256 : TP + (seqn - 16) * 1024; ndir = 0; }
                      else hn = false;
                      if (hn) SC_GLOADP(nrow, nhd >> 3, nhd, ndir); }
                    LDS_BARRIER();
#pragma unroll 1
                    for (int tt = 0; tt < 2; ++tt) {
                        int lt = tt == 0 ? wave : (wave < 2 ? 8 + wave : 10 + (wave - 2));
                        const int ta = lt == 0 ? 0 : lt == 1 ? 0 : lt == 2 ? 0 : lt == 3 ? 0 : lt == 4 ? 1 : lt == 5 ? 1 : lt == 6 ? 1 : lt == 7 ? 2 : lt == 8 ? 2 : lt == 9 ? 3 : lt == 10 ? 1 : lt == 11 ? 2 : lt == 12 ? 2 : lt == 13 ? 3 : lt == 14 ? 3 : 3;
                        const int tb = lt == 0 ? 0 : lt == 1 ? 1 : lt == 2 ? 2 : lt == 3 ? 3 : lt == 4 ? 1 : lt == 5 ? 2 : lt == 6 ? 3 : lt == 7 ? 2 : lt == 8 ? 3 : lt == 9 ? 3 : lt == 10 ? 0 : lt == 11 ? 0 : lt == 12 ? 1 : lt == 13 ? 0 : lt == 14 ? 1 : 2;
                        const int jb = dir == 0 ? ta : tb, ibg = dir == 0 ? tb : ta;
                        const bool dead = lt >= 10;
                        a_f32x16 gt;
#pragma unroll
                        for (int r = 0; r < 16; ++r) gt[r] = 0.f;
                        if (!dead) {
                            const LAS unsigned char* ap = lds + SC_B + (32 * jb + r32) * SC_ST + hi * 16; const LAS unsigned char* bp = lds + SC_C + (32 * ibg + r32) * SC_ST + hi * 16;
#pragma unroll
                            for (int s = 0; s < 8; ++s) gt = __builtin_amdgcn_mfma_f32_32x32x16_bf16(*(const LAS a_bf16x8*)(ap + 32 * s), *(const LAS a_bf16x8*)(bp + 32 * s), gt, 0, 0, 0);
                            const int i = 32 * ibg + r32; const float ai = acum[i];
                            v4f aj[4], dj[4];
#pragma unroll
                            for (int g4 = 0; g4 < 4; ++g4) { aj[g4] = *(const LAS v4f*)(acum + 32 * jb + 8 * g4 + 4 * hi); dj[g4] = *(const LAS v4f*)(dtj + 32 * jb + 8 * g4 + 4 * hi); }
#pragma unroll
                            for (int r = 0; r < 16; ++r) { const int j = 32 * jb + a_crow(r, hi); const bool keep = dir == 0 ? j <= i : j >= i;
                                const float e = __builtin_amdgcn_exp2f(fminf(ai - aj[r >> 2][r & 3], 0.f) * 1.4426950408889634f) * dj[r >> 2][r & 3];
                                gt[r] = keep ? gt[r] * e + (j == i ? dd : 0.f) : 0.f; }
                        }
#pragma unroll
                        for (int g4 = 0; g4 < 4; ++g4) { v2u w; w.x = a_cvtpk(gt[4 * g4], gt[4 * g4 + 1]); w.y = a_cvtpk(gt[4 * g4 + 2], gt[4 * g4 + 3]);
                            *(LAS v2u*)(lds + SC_M + (32 * ibg + r32) * SC_ST + (32 * jb + 8 * g4 + 4 * hi) * 2) = w; }
                    }
                    a_f32x16 yo;
#pragma unroll
                    for (int r = 0; r < 16; ++r) yo[r] = 0.f;
                    { const LAS unsigned char* ap = lds + SC_C + (32 * ib + r32) * SC_ST + hi * 16; const LAS unsigned char* bp = lds + SC_H + (32 * pb + r32) * SC_ST + hi * 16;
#pragma unroll
                      for (int s = 0; s < 8; ++s) yo = __builtin_amdgcn_mfma_f32_32x32x16_bf16(*(const LAS a_bf16x8*)(ap + 32 * s), *(const LAS a_bf16x8*)(bp + 32 * s), yo, 0, 0, 0); }
                    LDS_BARRIER();
                    a_f32x16 yd;
#pragma unroll
                    for (int r = 0; r < 16; ++r) yd[r] = 0.f;
                    { const LAS unsigned char* ap = lds + SC_M + (32 * ib + r32) * SC_ST + hi * 16; const LAS unsigned char* xp = lds + SC_X + (8 * hi + q4) * SC_XS + (32 * pb + 16 * gg + 4 * p4) * 2;
#pragma unroll
                      for (int s = 0; s < 8; ++s) { const a_s16x4 l0 = a_vtr(xp + (16 * s) * SC_XS), h0 = a_vtr(xp + (16 * s + 4) * SC_XS);
                          const a_bf16x8 xb = (a_bf16x8){l0[0], l0[1], l0[2], l0[3], h0[0], h0[1], h0[2], h0[3]};
                          yd = __builtin_amdgcn_mfma_f32_32x32x16_bf16(*(const LAS a_bf16x8*)(ap + 32 * s), xb, yd, 0, 0, 0); } }
                    { bf16* yp = y + (size_t)dir * T * 2048 + (size_t)(row0 + 32 * ib) * 2048 + hd * 64 + 32 * pb + r32;
                      v4f e4[4];
#pragma unroll
                      for (int g4 = 0; g4 < 4; ++g4) e4[g4] = *(const LAS v4f*)(ei + 32 * ib + 8 * g4 + 4 * hi);
#pragma unroll
                      for (int r = 0; r < 16; ++r) { const int i = a_crow(r, hi); const float v = yd[r] + e4[r >> 2][r & 3] * yo[r]; yp[(size_t)i * 2048] = (bf16)f2bf(v); } }
                    { const float dec = misc[0];
#pragma unroll
                      for (int r = 0; r < 16; ++r) hacc[r] *= dec;
                      const LAS unsigned char* bq = lds + SC_B + (8 * hi + q4) * SC_ST + (32 * nb + 16 * gg + 4 * p4) * 2; const LAS unsigned char* xq = lds + SC_XW + (8 * hi + q4) * SC_XS + (32 * pb + 16 * gg + 4 * p4) * 2;
#pragma unroll
                      for (int s = 0; s < 8; ++s) { const a_s16x4 bl = a_vtr(bq + (16 * s) * SC_ST), bh = a_vtr(bq + (16 * s + 4) * SC_ST), xl = a_vtr(xq + (16 * s) * SC_XS), xh = a_vtr(xq + (16 * s + 4) * SC_XS);
                          const a_bf16x8 av = (a_bf16x8){bl[0], bl[1], bl[2], bl[3], bh[0], bh[1], bh[2], bh[3]}, bv = (a_bf16x8){xl[0], xl[1], xl[2], xl[3], xh[0], xh[1], xh[2], xh[3]};
                          hacc = __builtin_amdgcn_mfma_f32_32x32x16_bf16(av, bv, hacc, 0, 0, 0); } }
#pragma unroll
                    for (int g4 = 0; g4 < 4; ++g4) { v2u w; w.x = a_cvtpk(hacc[4 * g4], hacc[4 * g4 + 1]); w.y = a_cvtpk(hacc[4 * g4 + 2], hacc[4 * g4 + 3]);
                        *(LAS v2u*)(lds + SC_H + (32 * pb + r32) * SC_ST + (32 * nb + 8 * g4 + 4 * hi) * 2) = w; }
                }
                if (seq < 16) { float* o = out + OUT_SSM + ((((size_t)seq * 2 + dir) * 32 + hd) * 64 + 32 * pb + r32) * 128 + 32 * nb + 4 * hi;
#pragma unroll
                    for (int g4 = 0; g4 < 4; ++g4) { v4f t4; t4.x = hacc[4 * g4]; t4.y = hacc[4 * g4 + 1]; t4.z = hacc[4 * g4 + 2]; t4.w = hacc[4 * g4 + 3]; *(GAS v4f*)(o + 8 * g4) = t4; } }
            }
        }
    }
#undef SC_GLOADP
#undef SC_ITEM
    LDS_BARRIER();
}

constexpr int NPHASE = 30;
enum Op { OP_P0, OP_NORM1, OP_G_LAT, OP_FIN1, OP_G_QKV, OP_FIN2, OP_ATTN, OP_G_WO, OP_NORM2, OP_G_FF1, OP_G_FF2, OP_G_PW1, OP_DWCONV, OP_G_PW2, OP_G_SSI, OP_SSCONV, OP_SCAN, OP_GATE, OP_G_SSO };
__device__ __forceinline__ void phase_decode(int ph, int& layer, int& op) {
    if (ph == 0) { layer = 0; op = OP_P0; return; }
    if (ph <= 9) { layer = 0; const int r = ph - 1; op = r == 0 ? OP_NORM1 : r == 1 ? OP_G_LAT : r == 2 ? OP_FIN1 : r == 3 ? OP_G_QKV : r == 4 ? OP_FIN2 : r == 5 ? OP_ATTN : r == 6 ? OP_G_WO : r == 7 ? OP_G_FF1 : OP_G_FF2; }
    else if (ph <= 14) { layer = 1; const int r = ph - 10; op = r == 0 ? OP_G_PW1 : r == 1 ? OP_DWCONV : r == 2 ? OP_G_PW2 : r == 3 ? OP_G_FF1 : OP_G_FF2; }
    else if (ph <= 21) { layer = 2; const int r = ph - 15; op = r == 0 ? OP_G_SSI : r == 1 ? OP_SSCONV : r == 2 ? OP_SCAN : r == 3 ? OP_GATE : r == 4 ? OP_G_SSO : r == 5 ? OP_G_FF1 : OP_G_FF2; }
    else { layer = 3; const int r = ph - 22; op = r == 0 ? OP_G_LAT : r == 1 ? OP_FIN1 : r == 2 ? OP_G_QKV : r == 3 ? OP_FIN2 : r == 4 ? OP_ATTN : r == 5 ? OP_G_WO : r == 6 ? OP_G_FF1 : OP_G_FF2; }
}
struct MArgs { const float* in[38]; float* out; unsigned char* ws; int ph_lo, ph_hi; };
constexpr int PTAB_OFF = PTAB_OFF_C;
__global__ void __launch_bounds__(NTHR, 2) mega_fwd(MArgs args) {
    extern __shared__ __attribute__((aligned(16))) unsigned char lds_raw[];
    LAS unsigned char* lds = (LAS unsigned char*)lds_raw;
    volatile LAS unsigned* PT0 = (volatile LAS unsigned*)(lds + PTAB_OFF);
    volatile LAS unsigned* MISC = (volatile LAS unsigned*)(lds + MISC_OFF);
    { const int t0 = threadIdx.x;
      if (t0 < 40) { const unsigned long long p = t0 < 38 ? (unsigned long long)args.in[t0] : t0 == 38 ? (unsigned long long)args.out : (unsigned long long)args.ws;
          PT0[2 * t0] = (unsigned)p; PT0[2 * t0 + 1] = (unsigned)(p >> 32); }
      if (t0 < 64) MISC[t0] = 0u; }
    __syncthreads();
    XcdBarrier bar = xcd_barrier_post((unsigned*)((unsigned char*)ldp(PT0, PT_WS) + WS_CTL) + CW_BAR, MISC + 8);
    const int wave0 = __builtin_amdgcn_readfirstlane(threadIdx.x >> 6);
    const int ph_hi = args.ph_hi;
    for (int ph = args.ph_lo; ph < ph_hi; ++ph) {
        Frame F;
        { int w = wave0; asm volatile("" : "+s"(w)); F.wave = w; }
        F.lds = lds; F.lane = olane(); F.tid = F.wave * 64 + F.lane;
        const int bx = obid();
        F.G = gridDim.x; F.vcu = (F.G % 8 == 0) ? (bx % 8) * (F.G / 8) + bx / 8 : bx;
        F.gw = F.vcu * NWAVES + F.wave; F.NGW = F.G * NWAVES; F.PT = PT0; F.bx = bx;
        int layer, op; phase_decode(ph, layer, op);
        const int j = layer / 3;
        switch (op) {
        case OP_P0: p0_prologue(F); break;
        case OP_NORM1: { unsigned char* ws = WSP; float* x = OUTP; const float* xlo = layer == 0 ? INP(I_XP) : x; const float* xhi = layer == 0 ? INP(I_XS) - (size_t)TP * 1024 : x;
            rp_normmod(F, xlo, xhi, INP(I_GN1) + layer * 1024, (const float*)(ws + WS_MODS) + (size_t)layer * 5 * 6144, 0, 1024, (bf16*)(ws + WS_H)); rp_tables(F); } break;
        case OP_NORM2: { unsigned char* ws = WSP; float* x = OUTP;
            rp_normmod(F, x, x, INP(I_GN2) + layer * 1024, (const float*)(ws + WS_MODS) + (size_t)layer * 5 * 6144, 3072, 4096, (bf16*)(ws + WS_H)); } break;
        case OP_G_LAT: { unsigned char* ws = WSP; pg8::Gemm g{(const bf16*)(ws + WS_H), (const bf16*)(ws + W_MLA + j * MLA_WB + MW_CAT), T, 768, 1024}; pg8::StaticOrder S; S.init(T, 2 * 768, F.G, F.bx);
            const int s_ = 2 * layer; pg8::EpiF32<1> E{(float*)(ws + A_LAT), 768, layer == 0 ? nullptr : (const float*)(ws + WS_STAT) + s_ * 8192, layer == 0 ? nullptr : (const float*)(ws + WS_SW) + (size_t)s_ * 5 * 5632}; pg8::gemm_phase<pg8::EpiF32<1>, pg8::StaticOrder, true, true, true>(F.lds, g, S, E, F.wave); } break;
        case OP_FIN1: { unsigned char* ws = WSP; rp_mla_fin1(F, (const float*)(ws + A_LAT), INP(I_GQ) + j * 384, INP(I_GKV) + j * 256, (bf16*)(ws + A_QN), (bf16*)(ws + WS_CKV + j * CKV_B), OUTP, j); } break;
        case OP_G_QKV: {
#pragma unroll 1
            for (int w = 0; w < 2; ++w) {
                unsigned char* ws = WSP; unsigned char* wm = ws + W_MLA + j * MLA_WB;
                pg8::Gemm g = w == 0 ? pg8::Gemm{(const bf16*)(ws + A_QN), (const bf16*)(wm + MW_UQ), T, 1536, 384} : pg8::Gemm{(const bf16*)(ws + WS_CKV + j * CKV_B), (const bf16*)(wm + MW_UKV), T + NCTX, 2048, 256};
                pg8::StaticOrder S; S.init(g.M, g.N, F.G, w == 0 ? F.bx : (int)((F.bx + 64) % F.G));
                pg8::EpiBf16P E{w == 0 ? (bf16*)(ws + A_QRAW) : (bf16*)(ws + A_KVRAW), g.N};
                pg8::gemm_phase<pg8::EpiBf16P, pg8::StaticOrder, true, true>(F.lds, g, S, E, F.wave);
            } } break;
        case OP_FIN2: { unsigned char* ws = WSP; rp_mla_fin2(F, (const bf16*)(ws + A_QRAW), (const bf16*)(ws + A_KVRAW), (const float*)(ws + A_LAT), INP(I_CKPE) + (size_t)j * 8192, INP(I_GQN) + j * 96, INP(I_GKN) + j * 96,
                                                        (const float*)(ws + WS_ROPE), (bf16*)(ws + A_QB), (bf16*)(ws + A_KB)); } break;
        case OP_ATTN: { unsigned char* ws = WSP; ph_attn(F, (const bf16*)(ws + A_QB), (const bf16*)(ws + A_KB), (const bf16*)(ws + A_KVRAW), (bf16*)(ws + A_AO)); } break;
        case OP_G_WO: case OP_G_PW2: case OP_G_SSO: case OP_G_FF2: {
            unsigned char* ws = WSP; float* x = OUTP;
            const float* rlo = (layer == 0 && op != OP_G_FF2) ? INP(I_XP) : x; const float* rhi = (layer == 0 && op != OP_G_FF2) ? INP(I_XS) - (size_t)TP * 1024 : x;
            pg8::Gemm g; const float* bias = nullptr; int goff = 2048;
            if (op == OP_G_WO) g = pg8::Gemm{(const bf16*)(ws + A_AO), (const bf16*)(ws + W_MLA + j * MLA_WB + MW_O), T, 1024, 1024};
            else if (op == OP_G_PW2) { g = pg8::Gemm{(const bf16*)(ws + A_V), (const bf16*)(ws + W_CV2), T, 1024, 1024}; bias = INP(I_CVB2); }
            else if (op == OP_G_SSO) g = pg8::Gemm{(const bf16*)(ws + A_YN), (const bf16*)(ws + W_SSO), T, 1024, 2048};
            else { g = pg8::Gemm{(const bf16*)(ws + A_ACT), (const bf16*)(ws + W_FF + layer * FF_WB + FW_OUT), T, 1024, 2816}; goff = 5120; }
            pg8::StaticOrder S; S.init(T, 2 * 1024, F.G, F.bx);
            float* xdst = x;
            const int sn_ = 2 * layer + (op == OP_G_FF2 ? 2 : 1);
            pg8::EpiResid<1> E{rlo, rhi, xdst, (const float*)(ws + WS_MODS) + (size_t)layer * 5 * 6144, goff, bias,
                               sn_ < 8 ? (bf16*)(ws + WS_H) : nullptr, (const float*)(ws + WS_GT) + (size_t)(sn_ & 7) * 5 * 1024, (float*)(ws + WS_STAT) + (sn_ & 7) * 8192};
            pg8::gemm_phase<pg8::EpiResid<1>, pg8::StaticOrder, true, true, true>(F.lds, g, S, E, F.wave); } break;
        case OP_G_FF1: { unsigned char* ws = WSP; pg8::Gemm g{(const bf16*)(ws + WS_H), (const bf16*)(ws + W_FF + layer * FF_WB + FW_IN), T, 5632, 1024}; pg8::StaticOrder S; S.init(T, 5632, F.G, F.bx);
            const int s_ = 2 * layer + 1; pg8::EpiGlu<0> E{(bf16*)(ws + A_ACT), 2816, nullptr, 2816, (const float*)(ws + WS_STAT) + s_ * 8192, (const float*)(ws + WS_SW) + (size_t)s_ * 5 * 5632}; pg8::gemm_phase<pg8::EpiGlu<0>, pg8::StaticOrder, true, true>(F.lds, g, S, E, F.wave); } break;
        case OP_G_PW1: { unsigned char* ws = WSP; pg8::Gemm g{(const bf16*)(ws + WS_H), (const bf16*)(ws + W_CV1), T, 2048, 1024}; pg8::StaticOrder S; S.init(T, 2048, F.G, F.bx);
            const int s_ = 2 * layer; pg8::EpiGlu<1> E{(bf16*)(ws + A_U), 1024, INP(I_CVB1), 1024, (const float*)(ws + WS_STAT) + s_ * 8192, (const float*)(ws + WS_SW) + (size_t)s_ * 5 * 5632}; pg8::gemm_phase<pg8::EpiGlu<1>, pg8::StaticOrder, true, true>(F.lds, g, S, E, F.wave); } break;
        case OP_DWCONV: { unsigned char* ws = WSP; rp_dwconv(F, (const bf16*)(ws + A_U), INP(I_CVWD), INP(I_CVBD), INP(I_CVGL), INP(I_CVBL), (bf16*)(ws + A_V)); } break;
        case OP_G_SSI: { unsigned char* ws = WSP; pg8::Gemm g{(const bf16*)(ws + WS_H), (const bf16*)(ws + W_SSI), T, 5376, 1024}; pg8::StaticOrder S; S.init(T, 5376, F.G, F.bx);
            const int s_ = 2 * layer; pg8::EpiSsdIn E{(bf16*)(ws + A_Z), (bf16*)(ws + A_XPRE), (float*)(ws + A_DTRAW), (const float*)(ws + WS_STAT) + s_ * 8192, (const float*)(ws + WS_SW) + (size_t)s_ * 5 * 5632}; pg8::gemm_phase<pg8::EpiSsdIn, pg8::StaticOrder, true, true>(F.lds, g, S, E, F.wave); } break;
        case OP_SSCONV: { unsigned char* ws = WSP; rp_ssd_conv(F, (const bf16*)(ws + A_XPRE), (const float*)(ws + A_DTRAW), INP(I_SSWC), INP(I_SSBC), INP(I_SSDTB), INP(I_SSAL), (bf16*)(ws + A_XBC), (float*)(ws + A_DT), (float*)(ws + A_ACUM)); } break;
        case OP_SCAN: { unsigned char* ws = WSP; ph_scan(F, (const bf16*)(ws + A_XBC), (const float*)(ws + A_DT), (const float*)(ws + A_ACUM), INP(I_SSD), INP(I_SSM), (bf16*)(ws + A_Y), OUTP); } break;
        case OP_GATE: { unsigned char* ws = WSP; rp_ssd_gate(F, (const bf16*)(ws + A_Y), (const bf16*)(ws + A_Z), INP(I_SSGN), (bf16*)(ws + A_YN)); } break;
        default: break;
        }

        if (ph + 1 < ph_hi) xcd_barrier(bar);

    }
}

extern "C" void kernel_launch(void* const* d_in, const int* in_sizes, int n_in, void* d_out, int out_size, void* d_ws, size_t ws_size, hipStream_t stream) {
    static int grid = 0;
    if (grid == 0) {
        int dev = 0, cus = 0;
        if (hipGetDevice(&dev) != hipSuccess || hipDeviceGetAttribute(&cus, hipDeviceAttributeMultiprocessorCount, dev) != hipSuccess) { fprintf(stderr, "kernel_launch: device query failed\n"); grid = -1; return; }
        if (hipFuncSetAttribute((const void*)mega_fwd, hipFuncAttributeMaxDynamicSharedMemorySize, LDS_BYTES) != hipSuccess) { fprintf(stderr, "kernel_launch: hipFuncSetAttribute failed\n"); grid = -1; return; }
        (void)hipGetLastError();
        grid = cus;
    }
    if (grid < 0) return;
    (void)hipMemsetAsync((char*)d_ws + WS_CTL, 0, CTL_ZERO_BYTES, stream);
    MArgs a{};
    for (int i = 0; i < 38; ++i) a.in[i] = (const float*)d_in[i];
    a.out = (float*)d_out; a.ws = (unsigned char*)d_ws;
    a.ph_lo = 0; a.ph_hi = NPHASE;
    hipLaunchKernelGGL(mega_fwd, dim3(grid), dim3(NTHR), LDS_BYTES, stream, a);
}
```

```cpp
#include <hip/hip_runtime.h>
#include <cstdint>
#include <cstdio>

constexpr int DM = 1024, T = 8192, TP = 4096;
constexpr int NCTX = 1024;
constexpr int QL = 384, KVL = 256, ROPE = 32, NOPE = 64, QKD = 96, VH = 64, NH = 16;
constexpr int FFH = 2816;
constexpr int SSI = 2048, SSH = 32, SSP = 64, SSN = 128, SSG = 4, SSCD = 3072, SSIN = 5184;
constexpr float EPS = 1e-6f;
constexpr size_t OUT_YP = 0, OUT_CKV = 8388608, OUT_KPE = 10485760, OUT_SSM = 10747904;

__device__ __forceinline__ int cond_of_row(int r) { return r < TP ? 0 : 1 + ((r - TP) >> 10); }
__device__ __forceinline__ void row_pos(int r, int& t, int& L) { if (r < TP) { t = r & 255; L = 256; } else { t = (r - TP) & 1023; L = 1024; } }
__device__ __forceinline__ float softplus_f(float x) { return fmaxf(x, 0.f) + log1pf(expf(-fabsf(x))); }

__device__ __forceinline__ float rope_inv(int i) { return i == 0 ? 1.f : i == 1 ? 0.31622776601683794f : i == 2 ? 0.1f : i == 3 ? 0.031622776601683794f : i == 4 ? 0.01f : i == 5 ? 0.0031622776601683794f : i == 6 ? 0.001f : 0.00031622776601683794f; }

__device__ __forceinline__ int olane() { int l; asm volatile("v_mbcnt_lo_u32_b32 %0, -1, 0\n\tv_mbcnt_hi_u32_b32 %0, -1, %0" : "=v"(l)); return l; }
__device__ __forceinline__ int obid() { int b = blockIdx.x; asm volatile("" : "+s"(b)); return b; }
namespace pg8 {
#define PG8_LAS __attribute__((address_space(3)))
typedef unsigned short bf16_t;
typedef short bf16x8 __attribute__((ext_vector_type(8)));
typedef float f32x4 __attribute__((ext_vector_type(4)));
typedef unsigned u32x4 __attribute__((ext_vector_type(4)));
constexpr int BM = 256, BK = 64, HALF = 128, HTB = HALF * BK * 2  , STAGE_BYTES = 8 * HTB, NXCD = 8, WGM = 8;

__host__ __device__ __forceinline__ int lds_byte(int r, int c) { const int st = (r >> 4) * 2 + (c >> 5), rr = r & 15, cc = c & 31, ob = rr * 64 + cc * 2; return st * 1024 + (ob ^ (((ob >> 9) & 1) << 5)); }
__host__ __device__ __forceinline__ void stage_rc(int b, int& R, int& C) { const int st = b / 1024, sb = b % 1024, swz = sb ^ (((sb >> 9) & 1) << 5); R = (st >> 1) * 16 + swz / 64; C = (st & 1) * 32 + (swz % 64) / 2; }
__host__ __device__ __forceinline__ int perm32(int rho) { const int n = rho >> 4, i = rho & 15; return 8 * (i >> 2) + 4 * n + (i & 3); }

struct Unit { int pm, pn; };
struct Gemm { const bf16_t* A; const bf16_t* Bt; int M, N, K; };

struct StaticOrder {
    int nM, nN, nwg, G, c;
    __host__ __device__ void init(int M, int N, int G_, int c_) { nM = M / BM; nN = N / BM; nwg = nM * nN; G = G_; c = c_; }
    __host__ __device__ bool next(int i, Unit& u) const {
        const long L = (long)i * G + c; if (L >= nwg) return false;
        int wgid = (int)L; { const int q = nwg / NXCD, r = nwg % NXCD, xcd = wgid % NXCD, off = wgid / NXCD; wgid = (xcd < r ? xcd * (q + 1) : r * (q + 1) + (xcd - r) * q) + off; }
        const int nig = WGM * nN, gid = wgid / nig, fm = gid * WGM, gsz = (nM - fm) < WGM ? (nM - fm) : WGM;
        u.pm = fm + ((wgid % nig) % gsz); u.pn = (wgid % nig) / gsz; return true;
    }
    __device__ __forceinline__ void a_ready(const Unit&) const {}
    __device__ __forceinline__ void done(const Unit&) const {}
};
__device__ __forceinline__ unsigned cvt_pk_bf16(float lo, float hi) { unsigned r; asm volatile("v_cvt_pk_bf16_f32 %0, %1, %2" : "=v"(r) : "v"(lo), "v"(hi)); return r; }
typedef unsigned u32x2 __attribute__((ext_vector_type(2)));
#define PG8_GAS __attribute__((address_space(1)))
__device__ __forceinline__ void st16(void* p, u32x4 v) { *(PG8_GAS u32x4*)p = v; }
__device__ __forceinline__ void st16f(void* p, f32x4 v) { *(PG8_GAS f32x4*)p = v; }
__device__ __forceinline__ void st8(void* p, u32x2 v) { *(PG8_GAS u32x2*)p = v; }
__device__ __forceinline__ f32x4 ld16f(const float* p) { return *(const PG8_GAS f32x4*)p; }
__device__ __forceinline__ float ld4f(const float* p) { return *(const PG8_GAS float*)p; }
__device__ __forceinline__ float fast_sigmoid(float x) { return __builtin_amdgcn_rcpf(1.f + __builtin_amdgcn_exp2f(-1.4426950408889634f * x)); }
__device__ __forceinline__ unsigned cvt_pk_bf16_p(float lo, float hi) { unsigned r; asm("v_cvt_pk_bf16_f32 %0, %1, %2" : "=v"(r) : "v"(lo), "v"(hi)); return r; }
template <int MODE> __device__ __forceinline__ void glu8(const f32x4 a0, const f32x4 g0, const f32x4 a1, const f32x4 g1, f32x4& o0, f32x4& o1) {
    const f32x4 t0 = (MODE == 0 ? a0 : g0) * -1.4426950408889634f, t1 = (MODE == 0 ? a1 : g1) * -1.4426950408889634f;
    f32x4 e0, e1, r0, r1;
#pragma unroll
    for (int j = 0; j < 4; ++j) { e0[j] = __builtin_amdgcn_exp2f(t0[j]); e1[j] = __builtin_amdgcn_exp2f(t1[j]); }
    const f32x4 d0 = e0 + 1.f, d1 = e1 + 1.f;
#pragma unroll
    for (int j = 0; j < 4; ++j) { r0[j] = __builtin_amdgcn_rcpf(d0[j]); r1[j] = __builtin_amdgcn_rcpf(d1[j]); }
    if (MODE == 0) { o0 = a0 * g0 * r0; o1 = a1 * g1 * r1; } else { o0 = a0 * r0; o1 = a1 * r1; }
}

constexpr int SW_LD = 5632;
__device__ __forceinline__ int cond_of_pm(int pm) { return pm < 16 ? 0 : 1 + ((pm - 16) >> 2); }
__device__ __forceinline__ void stage_rstat_sw(const float* rstat, const float* sw, const Unit& u, int slot, int wid, int lane, PG8_LAS unsigned char* tabs) {
    PG8_LAS unsigned char* tab = tabs + slot * 2048;
    if (wid < 4) __builtin_amdgcn_global_load_lds((const unsigned*)(rstat + u.pm * BM + wid * 64 + lane), (PG8_LAS unsigned*)(tab + wid * 256), 4, 0, 0);
    else __builtin_amdgcn_global_load_lds((const unsigned*)(sw + (size_t)cond_of_pm(u.pm) * SW_LD + u.pn * BM + (wid - 4) * 64 + lane), (PG8_LAS unsigned*)(tab + 1024 + (wid - 4) * 256), 4, 0, 0);
}
template <int NBJ> struct EpiF32 {
    static constexpr bool PERM = false, AFTER_DRAIN = false, STAGE_IN = false;
    float* C; int ldc; const float* rstat; const float* sw;
    __device__ __forceinline__ void operator()(const f32x4 (&acc)[2][2][4][2], const Unit& u, int wr_, int wc_, int fr_, int fq_, const PG8_LAS unsigned char* tab) const {
        const int t_ = olane(), wr = wr_, wc = wc_, fr = t_ & 15, fq = t_ >> 4; (void)fr_; (void)fq_; (void)tab;
        const int row0 = u.pm * BM + wr * 64 + fr, col0 = u.pn * (HALF * NBJ) + wc * 32 + 4 * fq;
#pragma unroll
        for (int ai = 0; ai < 2; ++ai)
#pragma unroll
            for (int m = 0; m < 4; ++m) { float* rowp = C + (size_t)(row0 + ai * HALF + m * 16) * ldc + col0;
                const float rs = rstat ? __builtin_amdgcn_rsqf(ld4f(rstat + row0 + ai * HALF + m * 16) * (1.f / 1024) + 1e-6f) : 1.f; const float* swp = sw ? sw + (size_t)cond_of_pm(u.pm) * SW_LD + col0 : nullptr;
#pragma unroll
                for (int bj = 0; bj < NBJ; ++bj)
#pragma unroll
                    for (int n = 0; n < 2; ++n) { f32x4 v = acc[ai][bj][m][n] * rs; if (swp) v += ld16f(swp + bj * HALF + n * 16); st16f(rowp + bj * HALF + n * 16, v); } }
    }
};
struct EpiBf16P {
    static constexpr bool PERM = true, AFTER_DRAIN = false, STAGE_IN = false;
    bf16_t* O; int ldc;
    __device__ __forceinline__ void operator()(const f32x4 (&acc)[2][2][4][2], const Unit& u, int wr_, int wc_, int fr_, int fq_, const PG8_LAS unsigned char* tab) const {
        const int t_ = olane(), wr = wr_, wc = wc_, fr = t_ & 15, fq = t_ >> 4; (void)fr_; (void)fq_; (void)tab;
        const int row0 = u.pm * BM + wr * 64 + fr, col0 = u.pn * BM + wc * 32 + 8 * fq;
#pragma unroll
        for (int ai = 0; ai < 2; ++ai)
#pragma unroll
            for (int m = 0; m < 4; ++m) { bf16_t* rowp = O + (size_t)(row0 + ai * HALF + m * 16) * ldc + col0;
#pragma unroll
                for (int bj = 0; bj < 2; ++bj) { const f32x4 v0 = acc[ai][bj][m][0], v1 = acc[ai][bj][m][1]; u32x4 w;
                    w.x = cvt_pk_bf16(v0[0], v0[1]); w.y = cvt_pk_bf16(v0[2], v0[3]); w.z = cvt_pk_bf16(v1[0], v1[1]); w.w = cvt_pk_bf16(v1[2], v1[3]);
                    st16(rowp + bj * HALF, w); } }
    }
};
struct EpiSsdIn {
    static constexpr bool PERM = true, AFTER_DRAIN = false, STAGE_IN = true;
    bf16_t* Z; bf16_t* XP; float* DT; const float* rstat; const float* sw;
    __device__ __forceinline__ void stage_in(const Unit& u, int slot, int wid, int lane, PG8_LAS unsigned char* tabs) const { stage_rstat_sw(rstat, sw, u, slot, wid, lane, tabs); }
    __device__ __forceinline__ void operator()(const f32x4 (&acc)[2][2][4][2], const Unit& u, int wr_, int wc_, int fr_, int fq_, const PG8_LAS unsigned char* tab) const {
        const int t_ = olane(), wr = wr_, wc = wc_, fr = t_ & 15, fq = t_ >> 4; (void)fr_; (void)fq_;
        const int row0 = u.pm * BM + wr * 64 + fr;
        const PG8_LAS float* trs = (const PG8_LAS float*)tab + wr * 64 + fr; const PG8_LAS float* swp = (const PG8_LAS float*)(tab + 1024) + wc * 32 + 8 * fq;
        if (u.pn < 20) {
            bf16_t* base = u.pn < 8 ? Z : XP; const int ld = u.pn < 8 ? 2048 : 3072, colt = (u.pn < 8 ? u.pn : u.pn - 8) * BM, col0 = colt + wc * 32 + 8 * fq;
#pragma unroll
            for (int ai = 0; ai < 2; ++ai)
#pragma unroll
                for (int m = 0; m < 4; ++m) { bf16_t* rowp = base + (size_t)(row0 + ai * HALF + m * 16) * ld + col0;
                    const float rs = __builtin_amdgcn_rsqf(trs[ai * HALF + m * 16] * (1.f / 1024) + 1e-6f);
#pragma unroll
                    for (int bj = 0; bj < 2; ++bj) { const f32x4 v0 = acc[ai][bj][m][0] * rs + *(const PG8_LAS f32x4*)(swp + bj * HALF), v1 = acc[ai][bj][m][1] * rs + *(const PG8_LAS f32x4*)(swp + bj * HALF + 4); u32x4 w;
                        w.x = cvt_pk_bf16(v0[0], v0[1]); w.y = cvt_pk_bf16(v0[2], v0[3]); w.z = cvt_pk_bf16(v1[0], v1[1]); w.w = cvt_pk_bf16(v1[2], v1[3]);
                        st16(rowp + bj * HALF, w); } }
        } else if (wc < 2) {
#pragma unroll
            for (int ai = 0; ai < 2; ++ai)
#pragma unroll
                for (int m = 0; m < 4; ++m) { float* rp = DT + (size_t)(row0 + ai * HALF + m * 16) * 64 + wc * 32 + 8 * fq;
                    const float rs = __builtin_amdgcn_rsqf(trs[ai * HALF + m * 16] * (1.f / 1024) + 1e-6f);
                    st16f(rp, acc[ai][0][m][0] * rs + *(const PG8_LAS f32x4*)swp); st16f(rp + 4, acc[ai][0][m][1] * rs + *(const PG8_LAS f32x4*)(swp + 4)); }
        }
    }
};
template <int MODE> struct EpiGlu {
    static constexpr bool PERM = false, AFTER_DRAIN = false, STAGE_IN = true;
    bf16_t* O; int ldo; const float* bias; int H; const float* rstat; const float* sw;
    __device__ __forceinline__ void stage_in(const Unit& u, int slot, int wid, int lane, PG8_LAS unsigned char* tabs) const { stage_rstat_sw(rstat, sw, u, slot, wid, lane, tabs); }
    __device__ __forceinline__ void operator()(const f32x4 (&acc)[2][2][4][2], const Unit& u, int wr_, int wc_, int fr_, int fq_, const PG8_LAS unsigned char* tab) const {
        const int t_ = olane(), wr = wr_, wc = wc_, fr = t_ & 15, fq = t_ >> 4; (void)fr_; (void)fq_;
        const int row0 = u.pm * BM + wr * 64 + fr;
        float rs[2][4];
#pragma unroll
        for (int ai = 0; ai < 2; ++ai)
#pragma unroll
            for (int m = 0; m < 4; ++m) rs[ai][m] = ((const PG8_LAS float*)tab)[ai * HALF + wr * 64 + m * 16 + fr];
#pragma unroll
        for (int ai = 0; ai < 2; ++ai)
#pragma unroll
            for (int m = 0; m < 4; ++m) rs[ai][m] = __builtin_amdgcn_rsqf(rs[ai][m] * (1.f / 1024) + 1e-6f);
        const unsigned ldb = (unsigned)ldo * 2u;
        unsigned char* Ob = (unsigned char*)O;
        const int f0 = 128 * u.pn + 32 * wc + 8 * fq;
        f32x4 ba[2], bu[2];
#pragma unroll
        for (int bj = 0; bj < 2; ++bj) {
            ba[bj] = (f32x4){0.f, 0.f, 0.f, 0.f}; bu[bj] = ba[bj];
            if (MODE == 1) { ba[bj] = ld16f(bias + f0 + 4 * bj); bu[bj] = ld16f(bias + H + f0 + 4 * bj); }
            const PG8_LAS float* swp = (const PG8_LAS float*)(tab + 1024) + bj * HALF + wc * 32 + 4 * fq; ba[bj] += *(const PG8_LAS f32x4*)swp; bu[bj] += *(const PG8_LAS f32x4*)(swp + 16);
        }
        const unsigned ob = (unsigned)row0 * ldb + (unsigned)f0 * 2u;
#pragma unroll
        for (int ai = 0; ai < 2; ++ai)
#pragma unroll
            for (int m = 0; m < 4; ++m) {
                const f32x4 a0 = acc[ai][0][m][0] * rs[ai][m] + ba[0], g0 = acc[ai][0][m][1] * rs[ai][m] + bu[0];
                const f32x4 a1 = acc[ai][1][m][0] * rs[ai][m] + ba[1], g1 = acc[ai][1][m][1] * rs[ai][m] + bu[1];
                f32x4 o0, o1; glu8<MODE>(a0, g0, a1, g1, o0, o1);
                u32x4 w; w.x = cvt_pk_bf16_p(o0[0], o0[1]); w.y = cvt_pk_bf16_p(o0[2], o0[3]); w.z = cvt_pk_bf16_p(o1[0], o1[1]); w.w = cvt_pk_bf16_p(o1[2], o1[3]);
                st16(Ob + (size_t)(ob + (unsigned)(ai * HALF + m * 16) * ldb), w); }
    }
};
template <int NBJ> struct EpiResid {
    static constexpr bool PERM = true, AFTER_DRAIN = false, STAGE_IN = false;
    const float* xlo; const float* xhi; float* xout; const float* mods_l; int g_off; const float* bias;
    bf16_t* XG; const float* GT; float* stat;
    template <bool HX> __device__ __forceinline__ void body(const f32x4 (&acc)[2][2][4][2], const Unit& u, int wr, int wc) const {
        const int t_ = olane(), fr = t_ & 15, fq = t_ >> 4;
        const int cond = u.pm < 16 ? 0 : 1 + ((u.pm - 16) >> 2);
        const float* gate = mods_l + (size_t)cond * 6144 + g_off; const unsigned char* xin = (const unsigned char*)(u.pm < 16 ? xlo : xhi);
        const int row0 = u.pm * BM + wr * 64 + fr, col0 = u.pn * (HALF * NBJ) + wc * 32 + 8 * fq;
        const unsigned ob = (unsigned)row0 * 4096u + (unsigned)col0 * 4u;
        f32x4 xo[NBJ][2][2][4];
#pragma unroll
        for (int bj = 0; bj < NBJ; ++bj)
#pragma unroll
            for (int n = 0; n < 2; ++n)
#pragma unroll
                for (int ai = 0; ai < 2; ++ai)
#pragma unroll
                    for (int m = 0; m < 4; ++m) xo[bj][n][ai][m] = ld16f((const float*)(xin + (size_t)(ob + (unsigned)((bj * HALF + n * 4) * 4 + (ai * HALF + m * 16) * 4096))));
        const float* gt = HX ? GT + (size_t)cond * 1024 : nullptr;
        f32x4 g4[NBJ][2], b4[NBJ][2], G4[NBJ][2];
#pragma unroll
        for (int bj = 0; bj < NBJ; ++bj)
#pragma unroll
            for (int n = 0; n < 2; ++n) { const int c = col0 + bj * HALF + n * 4; g4[bj][n] = ld16f(gate + c);
                b4[bj][n] = (f32x4){0.f, 0.f, 0.f, 0.f}; if (bias) b4[bj][n] = ld16f(bias + c);
                G4[bj][n] = (f32x4){0.f, 0.f, 0.f, 0.f}; if (HX) G4[bj][n] = ld16f(gt + c); }
        float ss[2][4];
#pragma unroll
        for (int ai = 0; ai < 2; ++ai)
#pragma unroll
            for (int m = 0; m < 4; ++m) ss[ai][m] = 0.f;
        unsigned char* xo_ = (unsigned char*)xout; unsigned char* xg_ = (unsigned char*)XG;
#pragma unroll
        for (int bj = 0; bj < NBJ; ++bj)
#pragma unroll
            for (int ai = 0; ai < 2; ++ai)
#pragma unroll
                for (int m = 0; m < 4; ++m) { const unsigned off = ob + (unsigned)(bj * HALF * 4 + (ai * HALF + m * 16) * 4096);
                    const f32x4 x0 = xo[bj][0][ai][m] + g4[bj][0] * (acc[ai][bj][m][0] + b4[bj][0]), x1 = xo[bj][1][ai][m] + g4[bj][1] * (acc[ai][bj][m][1] + b4[bj][1]);
                    st16f(xo_ + (size_t)off, x0); st16f(xo_ + (size_t)(off + 16u), x1);
                    if (HX) { const f32x4 y0 = x0 * G4[bj][0], y1 = x1 * G4[bj][1]; u32x4 w;
                        w.x = cvt_pk_bf16_p(y0[0], y0[1]); w.y = cvt_pk_bf16_p(y0[2], y0[3]); w.z = cvt_pk_bf16_p(y1[0], y1[1]); w.w = cvt_pk_bf16_p(y1[2], y1[3]); st16(xg_ + (size_t)(off >> 1), w);
                        const f32x4 q = x0 * x0 + x1 * x1; ss[ai][m] += (q[0] + q[1]) + (q[2] + q[3]); } }
        if (HX) {
#pragma unroll
            for (int ai = 0; ai < 2; ++ai)
#pragma unroll
                for (int m = 0; m < 4; ++m) { float s = ss[ai][m];
                    s += __builtin_bit_cast(float, __builtin_amdgcn_ds_bpermute((t_ ^ 16) << 2, __builtin_bit_cast(int, s)));
                    s += __builtin_bit_cast(float, __builtin_amdgcn_ds_bpermute((t_ ^ 32) << 2, __builtin_bit_cast(int, s)));
                    if (fq == 0) atomicAdd(stat + row0 + ai * HALF + m * 16, s); }
        }
    }
    __device__ __forceinline__ void operator()(const f32x4 (&acc)[2][2][4][2], const Unit& u, int wr_, int wc_, int fr_, int fq_, const PG8_LAS unsigned char* tab) const {
        (void)fr_; (void)fq_; (void)tab;
        if (XG) body<true>(acc, u, wr_, wc_); else body<false>(acc, u, wr_, wc_);
    }
};
template <class Epi, class Sched, bool ALIGN_EPI = false, bool SP2 = false, bool HALFN = false>
__device__ __forceinline__ void gemm_phase(PG8_LAS unsigned char* lds, const Gemm g, const Sched& S, const Epi& E, const int wave_in) {
    const int tid = wave_in * 64 + olane(), wid = __builtin_amdgcn_readfirstlane(tid >> 6), lane = tid & 63, wr = wid >> 2, wc = wid & 3, fr = lane & 15, fq = lane >> 4;
    const int K = g.K, nt = K / BK;
    unsigned voffA[2], voffB[2];
#pragma unroll
    for (int i = 0; i < 2; ++i) { int R, C; stage_rc(tid * 16 + i * 8192, R, C); const int Rb = Epi::PERM ? ((R & ~31) + perm32(R & 31)) : R;
        voffA[i] = (unsigned)(R * K + C) * 2u; voffB[i] = (unsigned)(Rb * K + C) * 2u; }
    const size_t kstep = (size_t)(BK * 2);
    const size_t hstep = (size_t)HALF * K * 2;
    const size_t tstep = 2 * hstep;
    const size_t bstep = HALFN ? hstep : tstep;
    static_assert(!HALFN || SP2, "HALFN is written for the SP2 loop only");
    const unsigned ldsw = (unsigned)wid * 1024u;
    const int aoff = lds_byte(wr * 64 + fr, fq * 8), boff = lds_byte(wc * 32 + fr, fq * 8);
#define PG8_SA(b, h) (((b) * 2 + (h)) * HTB)
#define PG8_SB(b, h) ((4 + (b) * 2 + (h)) * HTB)
#define PG8_STAGE(bufoff, gbase, voff) do { _Pragma("unroll") for (int _i = 0; _i < 2; ++_i) \
        __builtin_amdgcn_global_load_lds((const unsigned*)((const char*)(gbase) + (voff)[_i]), (PG8_LAS unsigned*)(lds + (bufoff) + ldsw + _i * 8192), 16, 0, 0); } while (0)
#define PG8_LDA(dst, b, h) do { _Pragma("unroll") for (int m = 0; m < 4; ++m) _Pragma("unroll") for (int k = 0; k < 2; ++k) dst[m][k] = *(const PG8_LAS bf16x8*)(lds + PG8_SA(b, h) + aoff + m * 2048 + k * 1024); } while (0)
#define PG8_LDB(dst, b, h) do { _Pragma("unroll") for (int n = 0; n < 2; ++n) _Pragma("unroll") for (int k = 0; k < 2; ++k) dst[n][k] = *(const PG8_LAS bf16x8*)(lds + PG8_SB(b, h) + boff + n * 2048 + k * 1024); } while (0)
#define PG8_MMA(ai, bj, At, Bt) do { __builtin_amdgcn_s_setprio(1); _Pragma("unroll") for (int m = 0; m < 4; ++m) _Pragma("unroll") for (int n = 0; n < 2; ++n) _Pragma("unroll") for (int k = 0; k < 2; ++k) \
        acc[ai][bj][m][n] = __builtin_amdgcn_mfma_f32_16x16x32_bf16(Bt[n][k], At[m][k], acc[ai][bj][m][n], 0, 0, 0); __builtin_amdgcn_s_setprio(0); } while (0)
#define PG8_WAIT_V(n) asm volatile("s_waitcnt vmcnt(" #n ")" ::: "memory")
#define PG8_WAIT_L(n) asm volatile("s_waitcnt lgkmcnt(" #n ")" ::: "memory")
#define PG8_BAR __builtin_amdgcn_s_barrier()
#define PG8_SCHED __builtin_amdgcn_sched_barrier(0)
    Unit cur, nxt; int ui = 0;
    if (!S.next(0, cur)) return;
    f32x4 acc[2][2][4][2];
#pragma unroll
    for (int a = 0; a < 2; ++a)
#pragma unroll
        for (int b = 0; b < 2; ++b)
#pragma unroll
            for (int m = 0; m < 4; ++m)
#pragma unroll
                for (int n = 0; n < 2; ++n) acc[a][b][m][n] = (f32x4){0.f, 0.f, 0.f, 0.f};
    bf16x8 At[4][2], B0[2][2], B1[2][2];
    const char* cA = (const char*)g.A + (size_t)cur.pm * tstep; const char* cB = (const char*)g.Bt + (size_t)cur.pn * bstep;
    S.a_ready(cur);
    if constexpr (Epi::STAGE_IN) E.stage_in(cur, 0, wid, lane, lds + STAGE_BYTES);
    if constexpr (HALFN) {
        PG8_STAGE(PG8_SB(0, 0), cB, voffB); PG8_STAGE(PG8_SA(0, 0), cA, voffA); PG8_STAGE(PG8_SA(0, 1), cA + hstep, voffA);
        if (wr == 1) PG8_BAR;
        PG8_WAIT_V(2); PG8_BAR;
        PG8_STAGE(PG8_SB(1, 0), cB + kstep, voffB); PG8_STAGE(PG8_SA(1, 0), cA + kstep, voffA);
        PG8_WAIT_V(4); PG8_BAR;
    } else if constexpr (SP2) {
        PG8_STAGE(PG8_SB(0, 0), cB, voffB); PG8_STAGE(PG8_SB(0, 1), cB + hstep, voffB); PG8_STAGE(PG8_SA(0, 0), cA, voffA); PG8_STAGE(PG8_SA(0, 1), cA + hstep, voffA);
        if (wr == 1) PG8_BAR;
        PG8_WAIT_V(2); PG8_BAR;
        PG8_STAGE(PG8_SB(1, 0), cB + kstep, voffB); PG8_STAGE(PG8_SA(1, 0), cA + kstep, voffA); PG8_STAGE(PG8_SB(1, 1), cB + hstep + kstep, voffB);
        PG8_WAIT_V(6); PG8_BAR;
    } else {
        PG8_STAGE(PG8_SB(0, 0), cB, voffB); PG8_STAGE(PG8_SA(0, 0), cA, voffA); PG8_STAGE(PG8_SB(0, 1), cB + hstep, voffB); PG8_STAGE(PG8_SA(0, 1), cA + hstep, voffA);
        if (wr == 1) PG8_BAR;
        PG8_WAIT_V(4); PG8_BAR;
        PG8_STAGE(PG8_SB(1, 0), cB + kstep, voffB); PG8_STAGE(PG8_SA(1, 0), cA + kstep, voffA); PG8_STAGE(PG8_SB(1, 1), cB + hstep + kstep, voffB);
        PG8_WAIT_V(6); PG8_BAR;
    }
    for (;;) {
        const bool has_next = S.next(ui + 1, nxt);
        const char* nA = has_next ? (const char*)g.A + (size_t)nxt.pm * tstep : cA; const char* nB = has_next ? (const char*)g.Bt + (size_t)nxt.pn * bstep : cB;
        for (int t = 0; t < nt; t += 2) {
            const bool last = (t == nt - 2);
            const char* a1 = cA + (size_t)(t + 1) * kstep;
            const char* a2 = last ? nA : cA + (size_t)(t + 2) * kstep; const char* b2 = last ? nB : cB + (size_t)(t + 2) * kstep;
            const char* a3 = a2 + kstep; const char* b3 = b2 + kstep;
            if (last && has_next) S.a_ready(nxt);
            if constexpr (Epi::STAGE_IN) { if (last && has_next) E.stage_in(nxt, (ui + 1) & 1, wid, lane, lds + STAGE_BYTES); }
            if constexpr (HALFN) {
            PG8_LDB(B0, 0, 0); PG8_SCHED; PG8_LDA(At, 0, 0); PG8_STAGE(PG8_SA(1, 1), a1 + hstep, voffA);
            PG8_WAIT_V(6); PG8_WAIT_L(0); PG8_BAR; PG8_MMA(0, 0, At, B0); PG8_BAR; PG8_SCHED;
            PG8_LDA(At, 0, 1); PG8_STAGE(PG8_SB(0, 0), b2, voffB); PG8_STAGE(PG8_SA(0, 0), a2, voffA);
            PG8_WAIT_V(6); PG8_WAIT_L(0); PG8_BAR; PG8_MMA(1, 0, At, B0); PG8_BAR; PG8_SCHED;
            PG8_LDB(B0, 1, 0); PG8_SCHED; PG8_LDA(At, 1, 0); PG8_STAGE(PG8_SA(0, 1), a2 + hstep, voffA);
            PG8_WAIT_V(6); PG8_WAIT_L(0); PG8_BAR; PG8_MMA(0, 0, At, B0); PG8_BAR; PG8_SCHED;
            PG8_LDA(At, 1, 1); PG8_STAGE(PG8_SB(1, 0), b3, voffB); PG8_STAGE(PG8_SA(1, 0), a3, voffA);
            PG8_WAIT_V(6); PG8_WAIT_L(0); PG8_BAR; PG8_MMA(1, 0, At, B0); PG8_BAR; PG8_SCHED;
            } else if constexpr (SP2) {
            PG8_LDB(B0, 0, 0); PG8_LDB(B1, 0, 1); PG8_SCHED; PG8_LDA(At, 0, 0); PG8_STAGE(PG8_SA(1, 1), a1 + hstep, voffA);
            PG8_WAIT_V(8); PG8_WAIT_L(0); PG8_BAR; PG8_MMA(0, 0, At, B0); PG8_MMA(0, 1, At, B1); PG8_BAR; PG8_SCHED;
            PG8_LDA(At, 0, 1); PG8_STAGE(PG8_SB(0, 0), b2, voffB); PG8_STAGE(PG8_SB(0, 1), b2 + hstep, voffB); PG8_STAGE(PG8_SA(0, 0), a2, voffA);
            PG8_WAIT_V(8); PG8_WAIT_L(0); PG8_BAR; PG8_MMA(1, 0, At, B0); PG8_MMA(1, 1, At, B1); PG8_BAR; PG8_SCHED;
            PG8_LDB(B0, 1, 0); PG8_LDB(B1, 1, 1); PG8_SCHED; PG8_LDA(At, 1, 0); PG8_STAGE(PG8_SA(0, 1), a2 + hstep, voffA);
            PG8_WAIT_V(8); PG8_WAIT_L(0); PG8_BAR; PG8_MMA(0, 0, At, B0); PG8_MMA(0, 1, At, B1); PG8_BAR; PG8_SCHED;
            PG8_LDA(At, 1, 1); PG8_STAGE(PG8_SB(1, 0), b3, voffB); PG8_STAGE(PG8_SB(1, 1), b3 + hstep, voffB); PG8_STAGE(PG8_SA(1, 0), a3, voffA);
            PG8_WAIT_V(8); PG8_WAIT_L(0); PG8_BAR; PG8_MMA(1, 0, At, B0); PG8_MMA(1, 1, At, B1); PG8_BAR; PG8_SCHED;
            } else {
            PG8_LDB(B0, 0, 0); PG8_SCHED; PG8_LDA(At, 0, 0); PG8_STAGE(PG8_SA(1, 1), a1 + hstep, voffA);
            PG8_WAIT_L(8); PG8_BAR; PG8_WAIT_L(0); PG8_MMA(0, 0, At, B0); PG8_BAR; PG8_SCHED;
            PG8_LDB(B1, 0, 1); PG8_STAGE(PG8_SB(0, 0), b2, voffB);
            PG8_BAR; PG8_WAIT_L(0); PG8_MMA(0, 1, At, B1); PG8_BAR;
            PG8_LDA(At, 0, 1); PG8_STAGE(PG8_SA(0, 0), a2, voffA);
            PG8_BAR; PG8_WAIT_L(0); PG8_MMA(1, 0, At, B0); PG8_BAR; PG8_SCHED;
            PG8_STAGE(PG8_SB(0, 1), b2 + hstep, voffB);
            PG8_WAIT_V(6); PG8_BAR; PG8_MMA(1, 1, At, B1); PG8_BAR;
            PG8_LDB(B0, 1, 0); PG8_SCHED; PG8_LDA(At, 1, 0); PG8_STAGE(PG8_SA(0, 1), a2 + hstep, voffA);
            PG8_WAIT_L(8); PG8_BAR; PG8_WAIT_L(0); PG8_MMA(0, 0, At, B0); PG8_BAR; PG8_SCHED;
            PG8_LDB(B1, 1, 1); PG8_STAGE(PG8_SB(1, 0), b3, voffB);
            PG8_BAR; PG8_WAIT_L(0); PG8_MMA(0, 1, At, B1); PG8_BAR;
            PG8_LDA(At, 1, 1); PG8_STAGE(PG8_SA(1, 0), a3, voffA);
            PG8_BAR; PG8_WAIT_L(0); PG8_MMA(1, 0, At, B0); PG8_BAR; PG8_SCHED;
            PG8_STAGE(PG8_SB(1, 1), b3 + hstep, voffB);
            PG8_WAIT_V(6); PG8_BAR; PG8_MMA(1, 1, At, B1); PG8_BAR;
            }
        }
        if constexpr (ALIGN_EPI) { if (wr == 0) PG8_BAR; }
        if constexpr (!Epi::AFTER_DRAIN) { E(acc, cur, wr, wc, fr, fq, lds + STAGE_BYTES + (ui & 1) * 2048); S.done(cur); }
        if (!has_next) break;
#pragma unroll
        for (int a = 0; a < 2; ++a)
#pragma unroll
            for (int b = 0; b < 2; ++b)
#pragma unroll
                for (int m = 0; m < 4; ++m)
#pragma unroll
                    for (int n = 0; n < 2; ++n) acc[a][b][m][n] = (f32x4){0.f, 0.f, 0.f, 0.f};
        cur = nxt; cA = nA; cB = nB; ++ui;
        if constexpr (ALIGN_EPI) { if (wr == 1) PG8_BAR; }
    }
    PG8_WAIT_V(0);
    if constexpr (!ALIGN_EPI) { if (wr == 0) PG8_BAR; }
    PG8_BAR;
    if constexpr (Epi::AFTER_DRAIN) { E.fused(acc, cur, wr, wc, fr, fq, lds, wid, lane); S.done(cur); }
#undef PG8_SA
#undef PG8_SB
#undef PG8_STAGE
#undef PG8_LDA
#undef PG8_LDB
#undef PG8_MMA
#undef PG8_WAIT_V
#undef PG8_WAIT_L
#undef PG8_BAR
#undef PG8_SCHED
}
}
constexpr int NWAVES = 8, NTHR = 512;
constexpr size_t MiB = 1u << 20;
constexpr size_t WS_CTL = 0, CTL_ZERO_BYTES = 1 * MiB;
constexpr size_t WS_MODS = 256 * 1024;
constexpr size_t WS_STAT = 768 * 1024;
constexpr size_t WS_SW = 372 * MiB, WS_GT = 374 * MiB;
constexpr size_t WS_ROPE = 1 * MiB;
constexpr size_t WS_W = 2 * MiB;
constexpr size_t W_MLA = WS_W, MLA_WB = 5898240;
constexpr size_t MW_CAT = 0, MW_UQ = 1572864, MW_UKV = 2752512, MW_O = 3801088;
constexpr size_t W_CV1 = WS_W + 2 * MLA_WB, W_CV2 = W_CV1 + 4 * MiB;
constexpr size_t W_SSI = W_CV2 + 2 * MiB, W_SSO = W_SSI + 11010048;
constexpr size_t W_FF = W_SSO + 4 * MiB, FF_WB = 17301504, FW_IN = 0, FW_OUT = 11534336;
static_assert(W_FF + 4 * FF_WB <= 102 * MiB, "weights region");
constexpr size_t WS_H = 102 * MiB;
constexpr size_t WS_CKV = 118 * MiB, CKV_B = (size_t)(T + NCTX) * KVL * 2;
constexpr size_t WS_AR = 128 * MiB;
constexpr size_t A_LAT = WS_AR, A_QN = A_LAT + 24 * MiB, A_QRAW = A_QN + 6 * MiB, A_KVRAW = A_QRAW + 24 * MiB, A_QB = A_KVRAW + 36 * MiB, A_KB = A_QB + 24 * MiB, A_AO = A_KB + 27 * MiB;
constexpr size_t A_U = WS_AR, A_V = A_U + 16 * MiB;
constexpr size_t A_Z = WS_AR, A_XPRE = A_Z + 32 * MiB, A_DTRAW = A_XPRE + 48 * MiB, A_XBC = A_DTRAW + 2 * MiB, A_DT = A_XBC + 48 * MiB, A_Y = A_DT + 2 * MiB, A_YN = A_XPRE, A_ACUM = A_Y + 64 * MiB;
constexpr size_t A_ACT = WS_AR + 200 * MiB;
static_assert(A_AO + 16 * MiB <= A_ACT && A_ACUM + 2 * MiB <= A_ACT && A_ACT + 44 * MiB <= 384 * MiB, "arena map");
constexpr int CW_BAR = 4096;
constexpr int LDS_BYTES = 163840, RING_BYTES = 131072, MISC_OFF = 163840 - 256, PTAB_OFF_C = MISC_OFF - 512;

#define GAS __attribute__((address_space(1)))
#define LAS __attribute__((address_space(3)))
typedef unsigned short bf16;
typedef unsigned v4u __attribute__((ext_vector_type(4)));
typedef unsigned v2u __attribute__((ext_vector_type(2)));
typedef float v4f __attribute__((ext_vector_type(4)));
typedef float v2f __attribute__((ext_vector_type(2)));
typedef GAS unsigned gu32;
#define LDS_WAIT() asm volatile("s_waitcnt lgkmcnt(0)" ::: "memory")
#define LDS_BARRIER() do { asm volatile("s_waitcnt lgkmcnt(0)" ::: "memory"); __builtin_amdgcn_s_barrier(); asm volatile("" ::: "memory"); } while (0)
#define VM_WAIT() asm volatile("s_waitcnt vmcnt(0)" ::: "memory")
__device__ __forceinline__ unsigned f2bf(float f) { unsigned u = __builtin_bit_cast(unsigned, f); return (u + 0x7fffu + ((u >> 16) & 1u)) >> 16; }
__device__ __forceinline__ unsigned pk2(float lo, float hi) { return f2bf(lo) | (f2bf(hi) << 16); }
__device__ __forceinline__ float bflo(unsigned u) { return __builtin_bit_cast(float, u << 16); }
__device__ __forceinline__ float bfhi(unsigned u) { return __builtin_bit_cast(float, u & 0xffff0000u); }
__device__ __forceinline__ float bf2f(bf16 b) { return __builtin_bit_cast(float, (unsigned)b << 16); }

#define XB_TMO      128
#define XB_XCNT(j)  (256  + 64 * (j))
#define XB_XSUB(j)  (1280 + 64 * (j))
#define XB_XGEN(j)  (2304 + 64 * (j))
#define XB_TOP      3328
#define XB_TOPGEN   3392
#define XCD_BAR_WORDS 3456
#define XB_SPIN_CAP (1u << 18)

__device__ __forceinline__ unsigned xb_ld(unsigned* p)              { return __hip_atomic_load(p, __ATOMIC_RELAXED, __HIP_MEMORY_SCOPE_AGENT); }
__device__ __forceinline__ unsigned xb_add(unsigned* p, unsigned v) { return __hip_atomic_fetch_add(p, v, __ATOMIC_RELAXED, __HIP_MEMORY_SCOPE_AGENT); }
__device__ __forceinline__ unsigned xb_xcc_id() { return (unsigned)__builtin_amdgcn_s_getreg((3 << 11) | 20) & 0xFu; }
#define XB_SPIN(cond, bar) do { unsigned _sp = 0; while (cond) { __builtin_amdgcn_s_sleep(1); \
    if ((++_sp & 255u) == 0u) { if (xb_ld(&(bar)[XB_TMO])) break; if (_sp > XB_SPIN_CAP) { atomicAdd(&(bar)[XB_TMO], 1u); break; } } } } while (0)

struct XcdBarrier {
    unsigned* bar; unsigned x;
    volatile LAS unsigned* st;
};

__device__ __forceinline__ XcdBarrier xcd_barrier_post(unsigned* bar, volatile LAS unsigned* st) {
    XcdBarrier b; b.bar = bar; b.x = xb_xcc_id(); b.st = st;
    if (threadIdx.x == 0) (void)xb_add(&bar[XB_XCNT(b.x)], 1u);
    return b;
}
__device__ __forceinline__ void xcd_barrier_complete(unsigned* bar, unsigned x, unsigned& nloc, unsigned& nx) {
    const unsigned G = gridDim.x * gridDim.y * gridDim.z;
    unsigned sum, cnt, mine, sp = 0u;
    for (;;) {
        sum = 0u; cnt = 0u; mine = 0u;
#pragma unroll
        for (unsigned j = 0; j < 16; ++j) { const unsigned c = xb_ld(&bar[XB_XCNT(j)]); sum += c; cnt += (c > 0u) ? 1u : 0u; mine = (j == x) ? c : mine; }
        if (sum == G) break;
        __builtin_amdgcn_s_sleep(1);
        if ((++sp & 255u) == 0u) { if (xb_ld(&bar[XB_TMO])) break; if (sp > XB_SPIN_CAP) { atomicAdd(&bar[XB_TMO], 1u); break; } }
    }
    nloc = mine > 0u ? mine : 1u; nx = cnt > 0u ? cnt : 1u;
}

__device__ __forceinline__ void xcd_barrier(const XcdBarrier& b) {
    asm volatile("s_waitcnt vmcnt(0)" ::: "memory");
    __syncthreads();
    if (threadIdx.x == 0) {
        unsigned* bar = b.bar;
        __builtin_amdgcn_s_waitcnt(0);
        unsigned nloc = b.st[0], nx = b.st[1];
        if (nloc == 0u) { xcd_barrier_complete(bar, b.x, nloc, nx); b.st[0] = nloc; b.st[1] = nx; }
        const unsigned old = xb_add(&bar[XB_XSUB(b.x)], 1u);
        const unsigned gen = old / nloc;
        if (old + 1u == (gen + 1u) * nloc) {
            __builtin_amdgcn_fence(__ATOMIC_RELEASE, "agent");
            asm volatile("s_waitcnt vmcnt(0)" ::: "memory");
            const unsigned og = xb_add(&bar[XB_TOP], 1u);
            const unsigned tg = og / nx;
            if (og + 1u == (tg + 1u) * nx) xb_add(&bar[XB_TOPGEN], 1u);
            else XB_SPIN(xb_ld(&bar[XB_TOPGEN]) == tg, bar);
            __builtin_amdgcn_fence(__ATOMIC_ACQUIRE, "agent");
            xb_add(&bar[XB_XGEN(b.x)], 1u);
            asm volatile("s_waitcnt vmcnt(0)" ::: "memory");
        } else {
            XB_SPIN(xb_ld(&bar[XB_XGEN(b.x)]) == gen, bar);
            __builtin_amdgcn_fence(__ATOMIC_ACQUIRE, "agent");
            asm volatile("s_waitcnt vmcnt(0)" ::: "memory");
        }
    }
    __syncthreads();
}

struct Frame {
    LAS unsigned char* lds; int tid, lane, wave, vcu, G, gw, NGW, bx;
    volatile LAS unsigned* PT;
};
constexpr int PT_OUT = 38, PT_WS = 39;
__device__ __forceinline__ const float* ldp(volatile LAS unsigned* PT, int k) {
    const unsigned lo = __builtin_amdgcn_readfirstlane(PT[2 * k]), hi = __builtin_amdgcn_readfirstlane(PT[2 * k + 1]);
    return (const float*)(((unsigned long long)hi << 32) | lo);
}
#define INP(k) ldp(F.PT, (k))
#define WSP ((unsigned char*)ldp(F.PT, PT_WS))
#define OUTP ((float*)ldp(F.PT, PT_OUT))
enum InIdx { I_XP = 0, I_XS, I_CCKV, I_CKPE, I_SSM, I_C, I_CCTX, I_WADA, I_BADA, I_GN1, I_GN2, I_WDQ, I_GQ, I_WUQ, I_WDKV, I_GKV, I_WUKV, I_GQN, I_GKN, I_WO,
             I_CVW1, I_CVB1, I_CVWD, I_CVBD, I_CVGL, I_CVBL, I_CVW2, I_CVB2, I_SSWI, I_SSWC, I_SSBC, I_SSDTB, I_SSAL, I_SSD, I_SSGN, I_SSWO, I_FFWI, I_FFWO };
__device__ __forceinline__ float shx(float v, int lane, int o) { return __builtin_bit_cast(float, __builtin_amdgcn_ds_bpermute((lane ^ o) << 2, __builtin_bit_cast(int, v))); }
__device__ __forceinline__ float wsum(float v, int lane) {
#pragma unroll
    for (int o = 1; o < 64; o <<= 1) v += shx(v, lane, o);
    return v;
}
constexpr float QSCALE = 0.10206207261596577f * 1.4426950408889634f;

struct P0Item { const float* W; bf16* WT; int K, N, mode, H, roff, k0, n0; };
__device__ __forceinline__ void p0_item_load(const P0Item& J, int lane, v4f (&t)[8]) {
#pragma unroll
    for (int i = 0; i < 8; ++i) t[i] = *(const GAS v4f*)(J.W + (size_t)(J.k0 + 8 * i + (lane >> 3)) * J.N + J.n0 + 4 * (lane & 7));
}
__device__ __forceinline__ void p0_item_finish(const P0Item& J, int lane, const v4f (&t)[8], LAS float* scr) {
#pragma unroll
    for (int i = 0; i < 8; ++i) { LAS float* d = scr + (8 * i + (lane >> 3)) * 33 + 4 * (lane & 7); d[0] = t[i].x; d[1] = t[i].y; d[2] = t[i].z; d[3] = t[i].w; }
    LDS_WAIT(); asm volatile("" ::: "memory");
    const int c = lane & 7;
#pragma unroll
    for (int j = 0; j < 4; ++j) { const int n = (lane >> 3) + 8 * j, col = J.n0 + n; const LAS float* s = scr + (8 * c) * 33 + n;
        int drow;
        if (J.mode == 0) drow = J.roff + col;
        else { const int f = col < J.H ? col : col - J.H; drow = 256 * (f >> 7) + 128 * ((f >> 2) & 1) + 32 * ((f >> 5) & 3) + (col < J.H ? 0 : 16) + 4 * ((f >> 3) & 3) + (f & 3); }
        v4u o; o.x = pk2(s[0 * 33], s[1 * 33]); o.y = pk2(s[2 * 33], s[3 * 33]); o.z = pk2(s[4 * 33], s[5 * 33]); o.w = pk2(s[6 * 33], s[7 * 33]);
        *(GAS v4u*)(J.WT + (size_t)drow * J.K + J.k0 + 8 * c) = o; }
    LDS_WAIT(); asm volatile("" ::: "memory");
}
__device__ __forceinline__ void p0_job(int q, int& inp, size_t& soff, int& K, int& N, size_t& doff, int& mode, int& H, int& roff) {
    mode = 0; H = 0; roff = 0; soff = 0;
    if (q < 10) { const int j = q / 5, t = q % 5; const size_t wb = W_MLA + (size_t)j * MLA_WB;
        if (t == 0) { inp = I_WDQ; soff = (size_t)j * 1024 * 384; K = 1024; N = 384; doff = wb + MW_CAT; }
        else if (t == 1) { inp = I_WDKV; soff = (size_t)j * 1024 * 288; K = 1024; N = 288; doff = wb + MW_CAT; roff = 384; }
        else if (t == 2) { inp = I_WUQ; soff = (size_t)j * 384 * 1536; K = 384; N = 1536; doff = wb + MW_UQ; }
        else if (t == 3) { inp = I_WUKV; soff = (size_t)j * 256 * 2048; K = 256; N = 2048; doff = wb + MW_UKV; }
        else { inp = I_WO; soff = (size_t)j * 1024 * 1024; K = 1024; N = 1024; doff = wb + MW_O; } }
    else if (q == 10) { inp = I_CVW1; K = 1024; N = 2048; doff = W_CV1; mode = 1; H = 1024; }
    else if (q == 11) { inp = I_CVW2; K = 1024; N = 1024; doff = W_CV2; }
    else if (q == 12) { inp = I_SSWI; K = 1024; N = 5184; doff = W_SSI; }
    else if (q == 13) { inp = I_SSWO; K = 2048; N = 1024; doff = W_SSO; }
    else { const int l = (q - 14) >> 1, t = (q - 14) & 1;
        if (t == 0) { inp = I_FFWI; soff = (size_t)l * 1024 * 5632; K = 1024; N = 5632; doff = W_FF + (size_t)l * FF_WB + FW_IN; mode = 1; H = 2816; }
        else { inp = I_FFWO; soff = (size_t)l * 2816 * 1024; K = 2816; N = 1024; doff = W_FF + (size_t)l * FF_WB + FW_OUT; } }
}
constexpr int P0_NITEMS = 2 * ((1024 / 64) * (384 / 32) + (1024 / 64) * (288 / 32) + (384 / 64) * (1536 / 32) + (256 / 64) * (2048 / 32) + (1024 / 64) * (1024 / 32))
                        + (1024 / 64) * (2048 / 32) + (1024 / 64) * (1024 / 32) + (1024 / 64) * (5184 / 32) + (2048 / 64) * (1024 / 32)
                        + 4 * ((1024 / 64) * (5632 / 32) + (2816 / 64) * (1024 / 32));
__device__ __forceinline__ void p0_prologue(Frame& F) {
    unsigned char* ws = WSP;
    LAS float* s = (LAS float*)F.lds;
    for (int i = F.tid; i < 5 * 1024; i += NTHR) { const int cc = i >> 10, k = i & 1023; const float v = cc == 0 ? INP(I_CCTX)[k] : INP(I_C)[(cc - 1) * 1024 + k]; s[i] = v / (1.f + expf(-v)); }
    __syncthreads();
    float* mods = (float*)(ws + WS_MODS);
    for (int it = F.bx; it < 192; it += F.G) {
        const int l = it / 48, r = it % 48, cb = r / 16, ks = r % 16, n = cb * 2048 + 4 * F.tid;
        const float* W = INP(I_WADA) + (size_t)l * 1024 * 6144 + (size_t)(ks * 64) * 6144 + n;
        v4f acc[5];
#pragma unroll
        for (int cc = 0; cc < 5; ++cc) acc[cc] = (v4f){0.f, 0.f, 0.f, 0.f};
#pragma unroll 1
        for (int kb = 0; kb < 64; kb += 16) {
            v4f wv[16];
#pragma unroll
            for (int k = 0; k < 16; ++k) wv[k] = *(const GAS v4f*)(W + (size_t)(kb + k) * 6144);
#pragma unroll
            for (int k = 0; k < 16; ++k)
#pragma unroll
                for (int cc = 0; cc < 5; ++cc) acc[cc] += wv[k] * s[cc * 1024 + ks * 64 + kb + k];
        }
        LAS float* tbl = s + 5 * 1024;
        __syncthreads();
#pragma unroll
        for (int cc = 0; cc < 5; ++cc) *(LAS v4f*)(tbl + cc * 2048 + 4 * F.tid) = acc[cc];
        __syncthreads();
        const float* bp = INP(I_BADA) + l * 6144 + cb * 2048;
#pragma unroll
        for (int q = 0; q < 4; ++q) { const int col = q * 512 + F.tid; const float bb = ks == 0 ? bp[col] : 0.f;
#pragma unroll
            for (int cc = 0; cc < 5; ++cc) atomicAdd(&mods[((size_t)l * 5 + cc) * 6144 + cb * 2048 + col], tbl[cc * 2048 + col] + bb); }
    }
    __syncthreads();
    LAS float* scr = (LAS float*)(F.lds + F.wave * 8448);
    for (int it = F.gw; it < P0_NITEMS; it += 2 * F.NGW) {
        P0Item J[2]; bool have1 = it + F.NGW < P0_NITEMS;
#pragma unroll
        for (int e = 0; e < 2; ++e) {
            int r = e == 0 ? it : (have1 ? it + F.NGW : it), inp = 0, K = 64, N = 32, mode = 0, H = 0, roff = 0; size_t soff = 0, doff = 0;
#pragma unroll 1
            for (int q = 0; q < 22; ++q) { p0_job(q, inp, soff, K, N, doff, mode, H, roff); const int ni = (K / 64) * (N / 32); if (r < ni) break; r -= ni; }
            const int nblk = N / 32;
            J[e].W = INP(inp) + soff; J[e].WT = (bf16*)(ws + doff); J[e].K = K; J[e].N = N; J[e].mode = mode; J[e].H = H; J[e].roff = roff; J[e].k0 = 64 * (r / nblk); J[e].n0 = 32 * (r % nblk);
        }
        v4f t0[8], t1[8];
        p0_item_load(J[0], F.lane, t0); p0_item_load(J[1], F.lane, t1);
        p0_item_finish(J[0], F.lane, t0, scr);
        if (have1) p0_item_finish(J[1], F.lane, t1, scr);
    }
    for (int it = F.gw; it < 384; it += F.NGW) {
        bf16* rowp = it < 192 ? (bf16*)(ws + W_MLA + (it / 96) * MLA_WB + MW_CAT) + (size_t)(672 + it % 96) * 1024 : (bf16*)(ws + W_SSI) + (size_t)(5184 + it - 192) * 1024;
        const v4u z = {0u, 0u, 0u, 0u}; ((GAS v4u*)rowp)[F.lane] = z; ((GAS v4u*)rowp)[64 + F.lane] = z;
    }
    for (int it = F.gw; it < 2048; it += F.NGW) {
        const int j = it >> 10, rr = it & 1023, b = rr >> 8, sq = rr & 255;
        const v4f v = ((const GAS v4f*)(INP(I_CCKV) + (((size_t)b * 2 + j) * 256 + sq) * 256))[F.lane];
        v2u o; o.x = pk2(v.x, v.y); o.y = pk2(v.z, v.w);
        ((GAS v2u*)((bf16*)(ws + WS_CKV + j * CKV_B) + (size_t)(T + rr) * 256))[F.lane] = o;
    }
    if (F.bx == 0) for (int i = F.tid; i < 640; i += NTHR) { const int pos = i >> 3, fi = i & 7; const float p = (float)(pos < 16 ? pos : pos - 16);
        const float a = p * rope_inv(fi); float* tab = (float*)(ws + WS_ROPE); tab[2 * i] = cosf(a); tab[2 * i + 1] = sinf(a); }
}

__device__ __forceinline__ void rp_normmod(Frame& F, const float* xlo, const float* xhi, const float* g, const float* mods_l, int sh_off, int sc_off, bf16* h) {
    for (int base = F.gw; base < T; base += 4 * F.NGW) {
        v4f v[4][4]; float ss[4]; int rows[4];
#pragma unroll
        for (int k = 0; k < 4; ++k) { const int row = base + k * F.NGW; rows[k] = row < T ? row : base;
            const GAS v4f* xr = (const GAS v4f*)((rows[k] < TP ? xlo : xhi) + (size_t)rows[k] * 1024) + F.lane;
#pragma unroll
            for (int j = 0; j < 4; ++j) v[k][j] = xr[64 * j]; }
#pragma unroll
        for (int k = 0; k < 4; ++k) { float s = 0.f;
#pragma unroll
            for (int j = 0; j < 4; ++j) s += (v[k][j].x * v[k][j].x + v[k][j].y * v[k][j].y) + (v[k][j].z * v[k][j].z + v[k][j].w * v[k][j].w);
            ss[k] = s; }
#pragma unroll
        for (int o = 1; o < 64; o <<= 1) {
#pragma unroll
            for (int k = 0; k < 4; ++k) ss[k] += shx(ss[k], F.lane, o); }
#pragma unroll
        for (int j = 0; j < 4; ++j) { const int c = 4 * F.lane + 256 * j; const v4f g4 = *(const GAS v4f*)(g + c);
#pragma unroll
            for (int k = 0; k < 4; ++k) { const float r = rsqrtf(ss[k] * (1.f / 1024) + EPS); const float* m = mods_l + (size_t)cond_of_row(rows[k]) * 6144;
                const v4f sc = *(const GAS v4f*)(m + sc_off + c), sh = *(const GAS v4f*)(m + sh_off + c);
                const v4f o = v[k][j] * r * g4 * (sc + 1.f) + sh; v2u w; w.x = pk2(o.x, o.y); w.y = pk2(o.z, o.w);
                *(GAS v2u*)(h + (size_t)rows[k] * 1024 + c) = w; } }
    }
}
__device__ __forceinline__ void rp_mla_fin1(Frame& F, const float* lat, const float* gq, const float* gkv, bf16* qn, bf16* ckv, float* out, int j) {
    for (int row = F.gw; row < T; row += F.NGW) {
        const float* lr = lat + (size_t)row * 768;
        v2f q[3]; float ss = 0.f;
#pragma unroll
        for (int i = 0; i < 3; ++i) { q[i] = *(const GAS v2f*)(lr + 2 * F.lane + 128 * i); ss += q[i].x * q[i].x + q[i].y * q[i].y; }
        float r = rsqrtf(wsum(ss, F.lane) * (1.f / 384) + EPS);
#pragma unroll
        for (int i = 0; i < 3; ++i) { const int c = 2 * F.lane + 128 * i; *(GAS unsigned*)(qn + (size_t)row * 384 + c) = pk2(q[i].x * r * gq[c], q[i].y * r * gq[c + 1]); }
        v2f k[2]; ss = 0.f;
#pragma unroll
        for (int i = 0; i < 2; ++i) { k[i] = *(const GAS v2f*)(lr + 384 + 2 * F.lane + 128 * i); ss += k[i].x * k[i].x + k[i].y * k[i].y; }
        r = rsqrtf(wsum(ss, F.lane) * (1.f / 256) + EPS);
#pragma unroll
        for (int i = 0; i < 2; ++i) { const int c = 2 * F.lane + 128 * i; const float c0 = k[i].x * r * gkv[c], c1 = k[i].y * r * gkv[c + 1];
            *(GAS unsigned*)(ckv + (size_t)row * 256 + c) = pk2(c0, c1);
            if (row < TP) { v2f o; o.x = c0; o.y = c1; *(GAS v2f*)(out + OUT_CKV + (((size_t)(row >> 8) * 2 + j) * 256 + (row & 255)) * 256 + c) = o; } }
        if (row < TP && F.lane < 32) out[OUT_KPE + (((size_t)(row >> 8) * 2 + j) * 256 + (row & 255)) * 32 + F.lane] = lr[640 + F.lane];
    }
}
__device__ __forceinline__ void rope32_tab(float* pe, int t, const float* tab) {
    const v2f* tr = (const v2f*)tab + (t >> 6) * 8; const v2f* tc = (const v2f*)tab + (16 + (t & 63)) * 8;
#pragma unroll
    for (int i = 0; i < 8; ++i) {
        v2f cs = tr[i]; float x1 = pe[i], x2 = pe[i + 8]; pe[i] = x1 * cs.x - x2 * cs.y; pe[i + 8] = x2 * cs.x + x1 * cs.y;
        cs = tc[i]; x1 = pe[16 + i]; x2 = pe[24 + i]; pe[16 + i] = x1 * cs.x - x2 * cs.y; pe[24 + i] = x2 * cs.x + x1 * cs.y;
    }
}
__device__ __forceinline__ void ld8(const bf16* p, float* d) { const v4u w = *(const GAS v4u*)p; d[0] = bflo(w.x); d[1] = bfhi(w.x); d[2] = bflo(w.y); d[3] = bfhi(w.y); d[4] = bflo(w.z); d[5] = bfhi(w.z); d[6] = bflo(w.w); d[7] = bfhi(w.w); }
__device__ __forceinline__ void st8(bf16* p, const float* d) { v4u w; w.x = pk2(d[0], d[1]); w.y = pk2(d[2], d[3]); w.z = pk2(d[4], d[5]); w.w = pk2(d[6], d[7]); *(GAS v4u*)p = w; }
__device__ __forceinline__ void rp_tables(Frame& F) {
    unsigned char* ws = WSP; const float* mods = (const float*)(ws + WS_MODS); float* GTb = (float*)(ws + WS_GT); float* SWb = (float*)(ws + WS_SW);
    for (int idx = F.bx * NTHR + F.tid; idx < 8 * 5 * 1024; idx += F.G * NTHR) {
        const int s = idx / 5120, r = idx % 5120, c = r >> 10, k = r & 1023, layer = s >> 1;
        const float g = (s & 1) ? INP(I_GN2)[layer * 1024 + k] : INP(I_GN1)[layer * 1024 + k];
        GTb[idx] = g * (1.f + mods[((size_t)layer * 5 + c) * 6144 + ((s & 1) ? 4096 : 1024) + k]);
    }
    constexpr int NR1 = 5632, NR2 = 2048, NR4 = 5376, NR6 = 768;
    constexpr int TOT = 4 * NR1 + NR2 + NR4 + NR6;
    for (int it = F.gw; it < TOT / 4; it += F.NGW) {
        int s, n; const bf16* Wt; const int i4 = 4 * it;
        if (i4 < 4 * NR1) { const int l = i4 / NR1; n = i4 % NR1; s = 2 * l + 1; Wt = (const bf16*)(ws + W_FF + (size_t)l * FF_WB + FW_IN); }
        else if (i4 < 4 * NR1 + NR2) { n = i4 - 4 * NR1; s = 2; Wt = (const bf16*)(ws + W_CV1); }
        else if (i4 < 4 * NR1 + NR2 + NR4) { n = i4 - 4 * NR1 - NR2; s = 4; Wt = (const bf16*)(ws + W_SSI); }
        else { n = i4 - 4 * NR1 - NR2 - NR4; s = 6; Wt = (const bf16*)(ws + W_MLA + MLA_WB + MW_CAT); }
        const int layer = s >> 1, shoff = (s & 1) ? 3072 : 0;
        v4u wr[4][2];
#pragma unroll
        for (int r = 0; r < 4; ++r) { wr[r][0] = *(const GAS v4u*)(Wt + (size_t)(n + r) * 1024 + 16 * F.lane); wr[r][1] = *(const GAS v4u*)(Wt + (size_t)(n + r) * 1024 + 16 * F.lane + 8); }
        float acc[4][5];
#pragma unroll
        for (int r = 0; r < 4; ++r)
#pragma unroll
            for (int c = 0; c < 5; ++c) acc[r][c] = 0.f;
#pragma unroll
        for (int c = 0; c < 5; ++c) { const float* sp = mods + ((size_t)layer * 5 + c) * 6144 + shoff + 16 * F.lane;
            const v4f s0 = *(const GAS v4f*)sp, s1 = *(const GAS v4f*)(sp + 4), s2 = *(const GAS v4f*)(sp + 8), s3 = *(const GAS v4f*)(sp + 12);
#pragma unroll
            for (int r = 0; r < 4; ++r) { const v4u a = wr[r][0], b2 = wr[r][1];
                acc[r][c] = (s0.x * bflo(a.x) + s0.y * bfhi(a.x) + s0.z * bflo(a.y) + s0.w * bfhi(a.y)) + (s1.x * bflo(a.z) + s1.y * bfhi(a.z) + s1.z * bflo(a.w) + s1.w * bfhi(a.w))
                          + (s2.x * bflo(b2.x) + s2.y * bfhi(b2.x) + s2.z * bflo(b2.y) + s2.w * bfhi(b2.y)) + (s3.x * bflo(b2.z) + s3.y * bfhi(b2.z) + s3.z * bflo(b2.w) + s3.w * bfhi(b2.w)); } }
#pragma unroll
        for (int o = 1; o < 64; o <<= 1) {
#pragma unroll
            for (int r = 0; r < 4; ++r)
#pragma unroll
                for (int c = 0; c < 5; ++c) acc[r][c] += shx(acc[r][c], F.lane, o); }
        if (F.lane < 20) { const int r = F.lane / 5, c = F.lane % 5; float v = 0.f;
#pragma unroll
            for (int rr = 0; rr < 4; ++rr)
#pragma unroll
                for (int cc = 0; cc < 5; ++cc) v = (rr == r && cc == c) ? acc[rr][cc] : v;
            SWb[((size_t)s * 5 + c) * 5632 + n + r] = v; }
    }
}
__device__ __forceinline__ void rp_mla_fin2(Frame& F, const bf16* qraw, const bf16* kvraw, const float* lat, const float* ckpe_j, const float* gqn, const float* gkn, const float* tab, bf16* Q, bf16* K) {
    for (int idx = F.bx * NTHR + F.tid; idx < T * 32; idx += F.G * NTHR) {
        const int row = idx >> 5, hd = (idx >> 1) & 15, hf = idx & 1; const bool latent = row >= TP; const int tl = (row - TP) & 1023;
        float v[48]; float ss = 0.f;
#pragma unroll
        for (int i = 0; i < 6; ++i) ld8(qraw + (size_t)row * 1536 + hd * 96 + hf * 48 + 8 * i, v + 8 * i);
#pragma unroll
        for (int d = 0; d < 48; ++d) ss += v[d] * v[d];
        ss += shx(ss, F.lane, 1);
        const float r = rsqrtf(ss * (1.f / 96) + EPS) * QSCALE;
#pragma unroll
        for (int d = 0; d < 48; ++d) v[d] = v[d] * r * gqn[hf * 48 + d];
        if (latent && hf) rope32_tab(v + 16, tl, tab);
#pragma unroll
        for (int i = 0; i < 6; ++i) st8(Q + ((size_t)row * 16 + hd) * 96 + hf * 48 + 8 * i, v + 8 * i);
    }
    asm volatile("" ::: "memory");
    for (int idx = F.bx * NTHR + F.tid; idx < (T + NCTX) * 32; idx += F.G * NTHR) {
        const int row = idx >> 5, hd = (idx >> 1) & 15, hf = idx & 1; const bool latent = row >= TP && row < T; const int tl = (row - TP) & 1023;
        float v[48]; float ss = 0.f;
        if (hf == 0) {
#pragma unroll
            for (int i = 0; i < 6; ++i) ld8(kvraw + (size_t)row * 2048 + hd * 128 + 8 * i, v + 8 * i);
        } else {
#pragma unroll
            for (int i = 0; i < 2; ++i) ld8(kvraw + (size_t)row * 2048 + hd * 128 + 48 + 8 * i, v + 8 * i);
            const float* kp = row < T ? lat + (size_t)row * 768 + 640 : ckpe_j + ((size_t)((row - T) >> 8) * 2 * 256 + ((row - T) & 255)) * 32;
#pragma unroll
            for (int i = 0; i < 8; ++i) { const v4f p4 = *(const GAS v4f*)(kp + 4 * i); v[16 + 4 * i] = p4.x; v[17 + 4 * i] = p4.y; v[18 + 4 * i] = p4.z; v[19 + 4 * i] = p4.w; }
        }
#pragma unroll
        for (int d = 0; d < 48; ++d) ss += v[d] * v[d];
        ss += shx(ss, F.lane, 1);
        const float r = rsqrtf(ss * (1.f / 96) + EPS);
#pragma unroll
        for (int d = 0; d < 48; ++d) v[d] = v[d] * r * gkn[hf * 48 + d];
        if (latent && hf) rope32_tab(v + 16, tl, tab);
#pragma unroll
        for (int i = 0; i < 6; ++i) st8(K + ((size_t)row * 16 + hd) * 96 + hf * 48 + 8 * i, v + 8 * i);
    }
}
__device__ __forceinline__ void rp_dwconv(Frame& F, const bf16* u, const float* wdw, const float* bdw, const float* gln, const float* bln, bf16* vout) {
    LAS float* red = (LAS float*)F.lds;
    const int c = 2 * F.tid;
    for (int it = F.vcu; it < T / 16; it += F.G) {
        const int row0 = 16 * it; int t0, L; row_pos(row0, t0, L);
        v2f w[31];
#pragma unroll
        for (int k = 0; k < 31; ++k) w[k] = *(const GAS v2f*)(wdw + k * 1024 + c);
        const v2f bb = *(const GAS v2f*)(bdw + c);
        float y0[16], y1[16];
#pragma unroll
        for (int r = 0; r < 16; ++r) { y0[r] = bb.x; y1[r] = bb.y; }
#pragma unroll
        for (int rr = 0; rr < 46; ++rr) {
            const int tt = t0 - 15 + rr; unsigned pk = 0u;
            if (tt >= 0 && tt < L) pk = *(const GAS unsigned*)(u + (size_t)(row0 - 15 + rr) * 1024 + c);
            const float u0 = bflo(pk), u1 = bfhi(pk);
#pragma unroll
            for (int k = 0; k < 31; ++k) { const int r = rr - k; if (r >= 0 && r < 16) { y0[r] += u0 * w[k].x; y1[r] += u1 * w[k].y; } }
        }
        float s[16];
#pragma unroll
        for (int r = 0; r < 16; ++r) s[r] = y0[r] + y1[r];
#pragma unroll
        for (int o = 1; o < 64; o <<= 1) {
#pragma unroll
            for (int r = 0; r < 16; ++r) s[r] += shx(s[r], F.lane, o); }
        __syncthreads();
        if (F.lane < 16) { float v = s[0];
#pragma unroll
            for (int r = 1; r < 16; ++r) v = F.lane == r ? s[r] : v;
            red[F.wave * 16 + F.lane] = v; }
        __syncthreads();
        float mean[16];
#pragma unroll
        for (int r = 0; r < 16; ++r) { float m = 0.f;
#pragma unroll
            for (int wv = 0; wv < 8; ++wv) m += red[wv * 16 + r];
            mean[r] = m * (1.f / 1024); }
#pragma unroll
        for (int r = 0; r < 16; ++r) { y0[r] -= mean[r]; y1[r] -= mean[r]; s[r] = y0[r] * y0[r] + y1[r] * y1[r]; }
#pragma unroll
        for (int o = 1; o < 64; o <<= 1) {
#pragma unroll
            for (int r = 0; r < 16; ++r) s[r] += shx(s[r], F.lane, o); }
        __syncthreads();
        if (F.lane < 16) { float v = s[0];
#pragma unroll
            for (int r = 1; r < 16; ++r) v = F.lane == r ? s[r] : v;
            red[F.wave * 16 + F.lane] = v; }
        __syncthreads();
        const v2f gg = *(const GAS v2f*)(gln + c), bl = *(const GAS v2f*)(bln + c);
#pragma unroll
        for (int r = 0; r < 16; ++r) { float q = 0.f;
#pragma unroll
            for (int wv = 0; wv < 8; ++wv) q += red[wv * 16 + r];
            const float rs = rsqrtf(q * (1.f / 1024) + EPS);
            const float z0 = y0[r] * rs * gg.x + bl.x, z1 = y1[r] * rs * gg.y + bl.y;
            *(GAS unsigned*)(vout + (size_t)(row0 + r) * 1024 + c) = pk2(z0 / (1.f + __expf(-z0)), z1 / (1.f + __expf(-z1))); }
    }
    __syncthreads();
}
__device__ __forceinline__ void rp_ssd_conv(Frame& F, const bf16* xpre, const float* dtraw, const float* wc, const float* bc, const float* dtb, const float* alog, bf16* xbc, float* dt, float* acum) {
    for (int idx = F.bx * NTHR + F.tid; idx < (T / 32) * 384; idx += F.G * NTHR) {
        const int seg = idx / 384, cg = idx - seg * 384, c0 = 8 * cg, row0 = 32 * seg; int t0, L; row_pos(row0, t0, L);
        float w[5][8], bias[8];
#pragma unroll
        for (int k = 0; k < 5; ++k) { const v4f a = *(const GAS v4f*)(wc + k * 3072 + c0), b2 = *(const GAS v4f*)(wc + k * 3072 + c0 + 4);
            w[k][0] = a.x; w[k][1] = a.y; w[k][2] = a.z; w[k][3] = a.w; w[k][4] = b2.x; w[k][5] = b2.y; w[k][6] = b2.z; w[k][7] = b2.w; }
        { const v4f a = *(const GAS v4f*)(bc + c0), b2 = *(const GAS v4f*)(bc + c0 + 4); bias[0] = a.x; bias[1] = a.y; bias[2] = a.z; bias[3] = a.w; bias[4] = b2.x; bias[5] = b2.y; bias[6] = b2.z; bias[7] = b2.w; }
        float win[5][8];
#pragma unroll
        for (int k = 0; k < 4; ++k) { const int tt = t0 + k - 2;
            if (tt >= 0 && tt < L) ld8(xpre + (size_t)(row0 + k - 2) * 3072 + c0, win[k + 1]);
            else {
#pragma unroll
                for (int i = 0; i < 8; ++i) win[k + 1][i] = 0.f; } }
#pragma unroll 4
        for (int r = 0; r < 32; ++r) {
#pragma unroll
            for (int k = 0; k < 4; ++k)
#pragma unroll
                for (int i = 0; i < 8; ++i) win[k][i] = win[k + 1][i];
            const int tt = t0 + r + 2;
            if (tt < L) ld8(xpre + (size_t)(row0 + r + 2) * 3072 + c0, win[4]);
            else {
#pragma unroll
                for (int i = 0; i < 8; ++i) win[4][i] = 0.f; }
            float a[8];
#pragma unroll
            for (int i = 0; i < 8; ++i) { float v = bias[i];
#pragma unroll
                for (int k = 0; k < 5; ++k) v += win[k][i] * w[k][i];
                a[i] = v / (1.f + __expf(-v)); }
            st8(xbc + (size_t)(row0 + r) * 3072 + c0, a);
        }
    }
    for (int it = F.gw; it < 64 * 64; it += F.NGW) {
        const int ch = it >> 6, e = it & 63, dir = e >> 5, row0 = 128 * ch, lane = F.lane;
        const float aa = -expf(alog[e]), bb = dtb[e];
        const int i0 = dir == 0 ? lane : 127 - lane, i1 = dir == 0 ? lane + 64 : 63 - lane;
        const float d0 = softplus_f(dtraw[(size_t)(row0 + i0) * 64 + e] + bb), d1 = softplus_f(dtraw[(size_t)(row0 + i1) * 64 + e] + bb);
        float s0 = d0 * aa, s1 = d1 * aa;
#pragma unroll
        for (int o = 1; o < 64; o <<= 1) { const float u0 = __builtin_bit_cast(float, __builtin_amdgcn_ds_bpermute((lane - o) << 2, __builtin_bit_cast(int, s0))), u1 = __builtin_bit_cast(float, __builtin_amdgcn_ds_bpermute((lane - o) << 2, __builtin_bit_cast(int, s1)));
            if (lane >= o) { s0 += u0; s1 += u1; } }
        s1 += __builtin_bit_cast(float, __builtin_amdgcn_readlane(__builtin_bit_cast(int, s0), 63));
        dt[(size_t)(row0 + i0) * 64 + e] = d0; dt[(size_t)(row0 + i1) * 64 + e] = d1;
        acum[(size_t)(row0 + i0) * 64 + e] = s0; acum[(size_t)(row0 + i1) * 64 + e] = s1;
    }
}
__device__ __forceinline__ void rp_ssd_gate(Frame& F, const bf16* y, const bf16* z, const float* gn, bf16* yn) {
    for (int row = F.gw; row < T; row += F.NGW) {
#pragma unroll
        for (int g = 0; g < 4; ++g) { const int c0 = g * 512 + 8 * F.lane; float zz[8], v[8]; ld8(z + (size_t)row * 2048 + c0, zz);
            float yb[8]; ld8(y + (size_t)row * 2048 + c0, v); ld8(y + (size_t)(T + row) * 2048 + c0, yb);
#pragma unroll
            for (int i = 0; i < 8; ++i) v[i] += yb[i];
            float ss = 0.f;
#pragma unroll
            for (int i = 0; i < 8; ++i) { v[i] = v[i] * zz[i] / (1.f + __expf(-zz[i])); ss += v[i] * v[i]; }
            const float r = rsqrtf(wsum(ss, F.lane) * (1.f / 512) + EPS);
#pragma unroll
            for (int i = 0; i < 8; ++i) v[i] = v[i] * r * gn[c0 + i];
            st8(yn + (size_t)row * 2048 + c0, v); }
    }
}

typedef short a_bf16x8 __attribute__((ext_vector_type(8)));
typedef short a_s16x4 __attribute__((ext_vector_type(4)));
typedef float a_f32x16 __attribute__((ext_vector_type(16)));
typedef float a_f32x2 __attribute__((ext_vector_type(2))); typedef __bf16 a_bf16x2 __attribute__((ext_vector_type(2)));
__device__ __forceinline__ unsigned a_cvtpk(float lo, float hi) { a_f32x2 v = {lo, hi}; a_bf16x2 b = __builtin_convertvector(v, a_bf16x2); return __builtin_bit_cast(unsigned, b); }
__device__ __forceinline__ a_s16x4 a_vtr(const LAS unsigned char* p) { return __builtin_bit_cast(a_s16x4, __builtin_amdgcn_ds_read_tr16_b64_v4i16((LAS a_s16x4*)p)); }
constexpr int AT_KS = 208, AT_VS = 192, AT_KB = 64 * AT_KS, AT_VB = 64 * AT_VS, AT_VOFF = 2 * AT_KB;
__device__ __forceinline__ void at_tile(Frame& F, LAS unsigned char* lds, int buf, int lane, const a_bf16x8 (&qf)[6], a_f32x16& o0, a_f32x16& o1, float& m, float& l) {
    const int r32 = lane & 31, hi = lane >> 5;
    a_f32x16 p0, p1;
#pragma unroll
    for (int r = 0; r < 16; ++r) { p0[r] = 0.f; p1[r] = 0.f; }
    { const LAS unsigned char* kp = lds + buf * AT_KB + r32 * AT_KS + hi * 16;
#pragma unroll
      for (int s = 0; s < 6; ++s) { const a_bf16x8 a0 = *(const LAS a_bf16x8*)(kp + 32 * s), a1 = *(const LAS a_bf16x8*)(kp + 32 * AT_KS + 32 * s);
          p0 = __builtin_amdgcn_mfma_f32_32x32x16_bf16(a0, qf[s], p0, 0, 0, 0); p1 = __builtin_amdgcn_mfma_f32_32x32x16_bf16(a1, qf[s], p1, 0, 0, 0); } }

    float mx = fmaxf(p0[0], p1[0]);
#pragma unroll
    for (int r = 1; r < 16; ++r) mx = fmaxf(mx, fmaxf(p0[r], p1[r]));
    mx = fmaxf(mx, shx(mx, lane, 32));
    const float mn = fmaxf(m, mx), alpha = __builtin_amdgcn_exp2f(m - mn); m = mn;
    float ps = 0.f;
#pragma unroll
    for (int r = 0; r < 16; ++r) { p0[r] = __builtin_amdgcn_exp2f(p0[r] - mn); p1[r] = __builtin_amdgcn_exp2f(p1[r] - mn); ps += p0[r] + p1[r]; }
    l = l * alpha + ps;
#pragma unroll
    for (int r = 0; r < 16; ++r) { o0[r] *= alpha; o1[r] *= alpha; }
    v4u pw[4];
    pw[0] = (v4u){a_cvtpk(p0[0], p0[1]), a_cvtpk(p0[2], p0[3]), a_cvtpk(p0[4], p0[5]), a_cvtpk(p0[6], p0[7])};
    pw[1] = (v4u){a_cvtpk(p0[8], p0[9]), a_cvtpk(p0[10], p0[11]), a_cvtpk(p0[12], p0[13]), a_cvtpk(p0[14], p0[15])};
    pw[2] = (v4u){a_cvtpk(p1[0], p1[1]), a_cvtpk(p1[2], p1[3]), a_cvtpk(p1[4], p1[5]), a_cvtpk(p1[6], p1[7])};
    pw[3] = (v4u){a_cvtpk(p1[8], p1[9]), a_cvtpk(p1[10], p1[11]), a_cvtpk(p1[12], p1[13]), a_cvtpk(p1[14], p1[15])};

    const LAS unsigned char* vp0 = lds + AT_VOFF + buf * AT_VB + (4 * hi + ((lane & 15) >> 2)) * AT_VS + (16 * ((lane >> 4) & 1) + 4 * (lane & 3)) * 2;
    a_s16x4 vl0[4], vh0[4], vl1[4], vh1[4];
#pragma unroll
    for (int bs = 0; bs < 4; ++bs) { const LAS unsigned char* vq = vp0 + (16 * bs) * AT_VS; vl0[bs] = a_vtr(vq); vh0[bs] = a_vtr(vq + 8 * AT_VS); vl1[bs] = a_vtr(vq + 64); vh1[bs] = a_vtr(vq + 8 * AT_VS + 64); }
#pragma unroll
    for (int bs = 0; bs < 4; ++bs) {
        const a_bf16x8 v0 = (a_bf16x8){vl0[bs][0], vl0[bs][1], vl0[bs][2], vl0[bs][3], vh0[bs][0], vh0[bs][1], vh0[bs][2], vh0[bs][3]}, v1 = (a_bf16x8){vl1[bs][0], vl1[bs][1], vl1[bs][2], vl1[bs][3], vh1[bs][0], vh1[bs][1], vh1[bs][2], vh1[bs][3]};
        const a_bf16x8 pb = __builtin_bit_cast(a_bf16x8, pw[bs]);
        o0 = __builtin_amdgcn_mfma_f32_32x32x16_bf16(v0, pb, o0, 0, 0, 0); o1 = __builtin_amdgcn_mfma_f32_32x32x16_bf16(v1, pb, o1, 0, 0, 0); }
}
__device__ __forceinline__ void ph_attn(Frame& F, const bf16* Q, const bf16* K, const bf16* KV, bf16* AO) {
    const int lane = F.lane, r32 = lane & 31, hi = lane >> 5, wave = F.wave, tid = F.tid;
    LAS unsigned char* lds = F.lds;
    const int kr_a = tid / 12, kp_a = tid % 12, kr_b = (tid + 512) / 12, kp_b = (tid + 512) % 12, vr = tid >> 3, vp = tid & 7;
    const bool has_b = tid < 256;
    for (int uu = F.vcu; uu < 512; uu += F.G) {
        int head, q0, NT, kbase_ctx, kbase_lat;
        if (uu < 256) { const int seq = uu >> 4; head = uu & 15; q0 = seq * 256; NT = 4; kbase_ctx = seq * 256; kbase_lat = 0; }
        else { const int u2 = uu - 256, b = u2 >> 6, qb = u2 & 3; head = (u2 >> 2) & 15; q0 = TP + b * 1024 + qb * 256; NT = 20; kbase_ctx = T + b * 256; kbase_lat = TP + b * 1024; }
        a_bf16x8 qf[6];
        { const bf16* qp = Q + ((size_t)(q0 + wave * 32 + r32) * 16 + head) * 96 + hi * 8;
#pragma unroll
          for (int s = 0; s < 6; ++s) qf[s] = *(const GAS a_bf16x8*)(qp + 16 * s); }
        a_f32x16 o0, o1;
#pragma unroll
        for (int r = 0; r < 16; ++r) { o0[r] = 0.f; o1[r] = 0.f; }
        float m = -INFINITY, l = 0.f;
        v4u ka0, kb0, vv0, ka1, kb1, vv1, ka2, kb2_, vv2;
#define AT_LOAD(t, KA, KB2, VV) do { const int kr0_ = (t) < 4 ? kbase_ctx + 64 * (t) : kbase_lat + 64 * ((t) - 4); \
            KA = *(const GAS v4u*)(K + ((size_t)(kr0_ + kr_a) * 16 + head) * 96 + kp_a * 8); \
            if (has_b) KB2 = *(const GAS v4u*)(K + ((size_t)(kr0_ + kr_b) * 16 + head) * 96 + kp_b * 8); \
            VV = *(const GAS v4u*)(KV + (size_t)(kr0_ + vr) * 2048 + head * 128 + 64 + vp * 8); } while (0)
#define AT_STORE(buf, KA, KB2, VV) do { *(LAS v4u*)(lds + (buf) * AT_KB + kr_a * AT_KS + kp_a * 16) = KA; \
            if (has_b) *(LAS v4u*)(lds + (buf) * AT_KB + kr_b * AT_KS + kp_b * 16) = KB2; \
            *(LAS v4u*)(lds + AT_VOFF + (buf) * AT_VB + vr * AT_VS + vp * 16) = VV; } while (0)
#define AT_STEP(k, SA, SB, SC, SD_, SE_, SF_, SG, SH, SI) if (t + (k) < NT) { \
            if (t + (k) + 3 < NT) AT_LOAD(t + (k) + 3, SA, SB, SC);            \
            at_tile(F, lds, (k) & 1, lane, qf, o0, o1, m, l); \
            if (t + (k) + 1 < NT) AT_STORE(((k) + 1) & 1, SD_, SE_, SF_);       \
            LDS_BARRIER(); }
        AT_LOAD(0, ka0, kb0, vv0); AT_LOAD(1, ka1, kb1, vv1); AT_LOAD(2, ka2, kb2_, vv2);
        AT_STORE(0, ka0, kb0, vv0);
        LDS_BARRIER();
#pragma unroll 1
        for (int t = 0; t < NT; t += 6) {
            AT_STEP(0, ka0, kb0, vv0, ka1, kb1, vv1, 0, 0, 0)
            AT_STEP(1, ka1, kb1, vv1, ka2, kb2_, vv2, 0, 0, 0)
            AT_STEP(2, ka2, kb2_, vv2, ka0, kb0, vv0, 0, 0, 0)
            AT_STEP(3, ka0, kb0, vv0, ka1, kb1, vv1, 0, 0, 0)
            AT_STEP(4, ka1, kb1, vv1, ka2, kb2_, vv2, 0, 0, 0)
            AT_STEP(5, ka2, kb2_, vv2, ka0, kb0, vv0, 0, 0, 0)
        }
#undef AT_STEP
#undef AT_LOAD
#undef AT_STORE
        l += shx(l, lane, 32);
        const float il = 1.f / l;
        bf16* op = AO + (size_t)(q0 + wave * 32 + r32) * 1024 + head * 64 + 4 * hi;
#pragma unroll
        for (int g4 = 0; g4 < 4; ++g4) {
            v2u w0; w0.x = a_cvtpk(o0[4 * g4] * il, o0[4 * g4 + 1] * il); w0.y = a_cvtpk(o0[4 * g4 + 2] * il, o0[4 * g4 + 3] * il); *(GAS v2u*)(op + 8 * g4) = w0;
            v2u w1; w1.x = a_cvtpk(o1[4 * g4] * il, o1[4 * g4 + 1] * il); w1.y = a_cvtpk(o1[4 * g4 + 2] * il, o1[4 * g4 + 3] * il); *(GAS v2u*)(op + 32 + 8 * g4) = w1; }

    }
}
constexpr int SC_ST = 272, SC_XS = 144;
constexpr int SC_C = 0, SC_B = 128 * SC_ST, SC_M = 2 * 128 * SC_ST, SC_H = 3 * 128 * SC_ST, SC_X = SC_H + 64 * SC_ST, SC_XW = SC_X + 128 * SC_XS, SC_ARR = SC_XW + 128 * SC_XS;
static_assert(SC_ARR + 4 * 128 * 4 + 16 <= PTAB_OFF_C, "scan LDS map");
__device__ __forceinline__ int a_crow(int r, int hi) { return (r & 3) + 8 * (r >> 2) + 4 * hi; }
__device__ __forceinline__ void ph_scan(Frame& F, const bf16* xbc, const float* dt, const float* acg, const float* dsk, const float* st0, bf16* y, float* out) {
    const int lane = F.lane, r32 = lane & 31, hi = lane >> 5, wave = F.wave, tid = F.tid;
    LAS unsigned char* lds = F.lds;
    LAS float* acum = (LAS float*)(lds + SC_ARR); LAS float* wj = acum + 128; LAS float* ei = acum + 256; LAS float* dtj = acum + 384; LAS float* misc = acum + 512;
    const int q4 = (lane & 15) >> 2, gg = (lane >> 4) & 1, p4 = lane & 3;
    const int ib = wave >> 1, pb = wave & 1, nb = wave >> 1;
    v4u cr[4], br[4], xr[2];
    float pdt[2], pac[2], plast, pac_t, pdt_t;
#define SC_GLOADP(rowb_, g_, hd_, dir_) do { const int row0_ = (rowb_); \
        _Pragma("unroll") for (int k = 0; k < 4; ++k) { const int q = tid + 512 * k, rr = q >> 4, pp = q & 15; \
            cr[k] = *(const GAS v4u*)(xbc + (size_t)(row0_ + rr) * 3072 + 2560 + (g_) * 128 + pp * 8); br[k] = *(const GAS v4u*)(xbc + (size_t)(row0_ + rr) * 3072 + 2048 + (g_) * 128 + pp * 8); } \
        _Pragma("unroll") for (int k = 0; k < 2; ++k) { const int q = tid + 512 * k, rr = q >> 3, pp = q & 7; xr[k] = *(const GAS v4u*)(xbc + (size_t)(row0_ + rr) * 3072 + (hd_) * 64 + pp * 8); \
            pdt[k] = dt[(size_t)(row0_ + rr) * 64 + (dir_) * 32 + (hd_)]; pac[k] = acg[(size_t)(row0_ + rr) * 64 + (dir_) * 32 + (hd_)]; } \
        plast = acg[(size_t)(row0_ + ((dir_) == 0 ? 127 : 0)) * 64 + (dir_) * 32 + (hd_)]; \
        pac_t = acg[(size_t)(row0_ + (tid & 127)) * 64 + (dir_) * 32 + (hd_)]; pdt_t = dt[(size_t)(row0_ + (tid & 127)) * 64 + (dir_) * 32 + (hd_)]; } while (0)
#define SC_ITEM(slot_, ii_, seq_, hd_) do { if ((slot_) < 128) { seq_ = 16 + ((slot_) >> 5); hd_ = (slot_) & 31; } else { const int pi_ = 4 * ((slot_) - 128) + (ii_); seq_ = pi_ >> 5; hd_ = pi_ & 31; } } while (0)
    for (int slot = F.vcu; slot < 256; slot += F.G) {
        const int nitem = slot < 128 ? 1 : 4;
        { int seq0, hd0; SC_ITEM(slot, 0, seq0, hd0); SC_GLOADP(seq0 < 16 ? seq0 * 256 : TP + (seq0 - 16) * 1024, hd0 >> 3, hd0, 0); }
#pragma unroll 1
        for (int ii = 0; ii < nitem; ++ii) {
            int seq, hd;
            if (slot < 128) { seq = 16 + (slot >> 5); hd = slot & 31; } else { const int pi = 4 * (slot - 128) + ii; seq = pi >> 5; hd = pi & 31; }
            const int g = hd >> 3, r0 = seq < 16 ? seq * 256 : TP + (seq - 16) * 1024, nc = seq < 16 ? 2 : 8;
#pragma unroll 1
            for (int dir = 0; dir < 2; ++dir) {
                const float dd = dsk[dir * 32 + hd];
                a_f32x16 hacc;
                if (seq < 16) {
#pragma unroll
                    for (int r = 0; r < 16; ++r) hacc[r] = 0.f;
                } else { const float* s0 = st0 + ((((size_t)(seq - 16) * 2 + dir) * 32 + hd) * 64 + 32 * pb + r32) * 128 + 32 * nb + 4 * hi;
#pragma unroll
                    for (int g4 = 0; g4 < 4; ++g4) { const v4f t4 = *(const GAS v4f*)(s0 + 8 * g4); hacc[4 * g4] = t4.x; hacc[4 * g4 + 1] = t4.y; hacc[4 * g4 + 2] = t4.z; hacc[4 * g4 + 3] = t4.w; } }
#pragma unroll
                for (int g4 = 0; g4 < 4; ++g4) { v2u w; w.x = a_cvtpk(hacc[4 * g4], hacc[4 * g4 + 1]); w.y = a_cvtpk(hacc[4 * g4 + 2], hacc[4 * g4 + 3]);
                    *(LAS v2u*)(lds + SC_H + (32 * pb + r32) * SC_ST + (32 * nb + 8 * g4 + 4 * hi) * 2) = w; }
#pragma unroll 1
                for (int cc = 0; cc < nc; ++cc) {
                    const int c = dir == 0 ? cc : nc - 1 - cc, row0 = r0 + c * 128;
                    const int e = dir * 32 + hd;
                    const float last = plast;
                    LDS_BARRIER();
                    if (tid < 128) { const float ac = pac_t, dv = pdt_t;
                        acum[tid] = ac; dtj[tid] = dv; ei[tid] = __expf(ac); if (tid == 0) misc[0] = __expf(last); }
#pragma unroll
                    for (int k = 0; k < 4; ++k) { const int q = tid + 512 * k, rr = q >> 4, pp = q & 15; *(LAS v4u*)(lds + SC_C + rr * SC_ST + pp * 16) = cr[k]; *(LAS v4u*)(lds + SC_B + rr * SC_ST + pp * 16) = br[k]; }
#pragma unroll
                    for (int k = 0; k < 2; ++k) { const int q = tid + 512 * k, rr = q >> 3, pp = q & 7; *(LAS v4u*)(lds + SC_X + rr * SC_XS + pp * 16) = xr[k];
                        const float w = pdt[k] * __expf(last - pac[k]);
                        v4u s; s.x = a_cvtpk(bflo(xr[k].x) * w, bfhi(xr[k].x) * w); s.y = a_cvtpk(bflo(xr[k].y) * w, bfhi(xr[k].y) * w); s.z = a_cvtpk(bflo(xr[k].z) * w, bfhi(xr[k].z) * w); s.w = a_cvtpk(bflo(xr[k].w) * w, bfhi(xr[k].w) * w);
                        *(LAS v4u*)(lds + SC_XW + rr * SC_XS + pp * 16) = s; }
                    { int nrow = 0, nhd = hd, ndir = dir; bool hn = true;
                      if (cc + 1 < nc) nrow = r0 + (dir == 0 ? cc + 1 : nc - 2 - cc) * 128;
                      else if (dir == 0) { nrow = r0 + (nc - 1) * 128; ndir = 1; }
                      else if (ii + 1 < nitem) { int seqn; SC_ITEM(slot, ii + 1, seqn, nhd); nrow = seqn < 16 ? seqn * 256 : TP + (seqn - 16) * 1024; ndir = 0; }
                      else hn = false;
                      if (hn) SC_GLOADP(nrow, nhd >> 3, nhd, ndir); }
                    LDS_BARRIER();
#pragma unroll 1
                    for (int tt = 0; tt < 2; ++tt) {
                        int lt = tt == 0 ? wave : (wave < 2 ? 8 + wave : 10 + (wave - 2));
                        const int ta = lt == 0 ? 0 : lt == 1 ? 0 : lt == 2 ? 0 : lt == 3 ? 0 : lt == 4 ? 1 : lt == 5 ? 1 : lt == 6 ? 1 : lt == 7 ? 2 : lt == 8 ? 2 : lt == 9 ? 3 : lt == 10 ? 1 : lt == 11 ? 2 : lt == 12 ? 2 : lt == 13 ? 3 : lt == 14 ? 3 : 3;
                        const int tb = lt == 0 ? 0 : lt == 1 ? 1 : lt == 2 ? 2 : lt == 3 ? 3 : lt == 4 ? 1 : lt == 5 ? 2 : lt == 6 ? 3 : lt == 7 ? 2 : lt == 8 ? 3 : lt == 9 ? 3 : lt == 10 ? 0 : lt == 11 ? 0 : lt == 12 ? 1 : lt == 13 ? 0 : lt == 14 ? 1 : 2;
                        const int jb = dir == 0 ? ta : tb, ibg = dir == 0 ? tb : ta;
                        const bool dead = lt >= 10;
                        a_f32x16 gt;
#pragma unroll
                        for (int r = 0; r < 16; ++r) gt[r] = 0.f;
                        if (!dead) {
                            const LAS unsigned char* ap = lds + SC_B + (32 * jb + r32) * SC_ST + hi * 16; const LAS unsigned char* bp = lds + SC_C + (32 * ibg + r32) * SC_ST + hi * 16;
#pragma unroll
                            for (int s = 0; s < 8; ++s) gt = __builtin_amdgcn_mfma_f32_32x32x16_bf16(*(const LAS a_bf16x8*)(ap + 32 * s), *(const LAS a_bf16x8*)(bp + 32 * s), gt, 0, 0, 0);
                            const int i = 32 * ibg + r32; const float ai = acum[i];
                            v4f aj[4], dj[4];
#pragma unroll
                            for (int g4 = 0; g4 < 4; ++g4) { aj[g4] = *(const LAS v4f*)(acum + 32 * jb + 8 * g4 + 4 * hi); dj[g4] = *(const LAS v4f*)(dtj + 32 * jb + 8 * g4 + 4 * hi); }
#pragma unroll
                            for (int r = 0; r < 16; ++r) { const int j = 32 * jb + a_crow(r, hi); const bool keep = dir == 0 ? j <= i : j >= i;
                                const float e = __builtin_amdgcn_exp2f(fminf(ai - aj[r >> 2][r & 3], 0.f) * 1.4426950408889634f) * dj[r >> 2][r & 3];
                                gt[r] = keep ? gt[r] * e + (j == i ? dd : 0.f) : 0.f; }
                        }
#pragma unroll
                        for (int g4 = 0; g4 < 4; ++g4) { v2u w; w.x = a_cvtpk(gt[4 * g4], gt[4 * g4 + 1]); w.y = a_cvtpk(gt[4 * g4 + 2], gt[4 * g4 + 3]);
                            *(LAS v2u*)(lds + SC_M + (32 * ibg + r32) * SC_ST + (32 * jb + 8 * g4 + 4 * hi) * 2) = w; }
                    }
                    a_f32x16 yo;
#pragma unroll
                    for (int r = 0; r < 16; ++r) yo[r] = 0.f;
                    { const LAS unsigned char* ap = lds + SC_C + (32 * ib + r32) * SC_ST + hi * 16; const LAS unsigned char* bp = lds + SC_H + (32 * pb + r32) * SC_ST + hi * 16;
#pragma unroll
                      for (int s = 0; s < 8; ++s) yo = __builtin_amdgcn_mfma_f32_32x32x16_bf16(*(const LAS a_bf16x8*)(ap + 32 * s), *(const LAS a_bf16x8*)(bp + 32 * s), yo, 0, 0, 0); }
                    LDS_BARRIER();
                    a_f32x16 yd;
#pragma unroll
                    for (int r = 0; r < 16; ++r) yd[r] = 0.f;
                    { const LAS unsigned char* ap = lds + SC_M + (32 * ib + r32) * SC_ST + hi * 16; const LAS unsigned char* xp = lds + SC_X + (8 * hi + q4) * SC_XS + (32 * pb + 16 * gg + 4 * p4) * 2;
#pragma unroll
                      for (int s = 0; s < 8; ++s) { const a_s16x4 l0 = a_vtr(xp + (16 * s) * SC_XS), h0 = a_vtr(xp + (16 * s + 4) * SC_XS);
                          const a_bf16x8 xb = (a_bf16x8){l0[0], l0[1], l0[2], l0[3], h0[0], h0[1], h0[2], h0[3]};
                          yd = __builtin_amdgcn_mfma_f32_32x32x16_bf16(*(const LAS a_bf16x8*)(ap + 32 * s), xb, yd, 0, 0, 0); } }
                    { bf16* yp = y + (size_t)dir * T * 2048 + (size_t)(row0 + 32 * ib) * 2048 + hd * 64 + 32 * pb + r32;
                      v4f e4[4];
#pragma unroll
                      for (int g4 = 0; g4 < 4; ++g4) e4[g4] = *(const LAS v4f*)(ei + 32 * ib + 8 * g4 + 4 * hi);
#pragma unroll
                      for (int r = 0; r < 16; ++r) { const int i = a_crow(r, hi); const float v = yd[r] + e4[r >> 2][r & 3] * yo[r]; yp[(size_t)i * 2048] = (bf16)f2bf(v); } }
                    { const float dec = misc[0];
#pragma unroll
                      for (int r = 0; r < 16; ++r) hacc[r] *= dec;
                      const LAS unsigned char* bq = lds + SC_B + (8 * hi + q4) * SC_ST + (32 * nb + 16 * gg + 4 * p4) * 2; const LAS unsigned char* xq = lds + SC_XW + (8 * hi + q4) * SC_XS + (32 * pb + 16 * gg + 4 * p4) * 2;
#pragma unroll
                      for (int s = 0; s < 8; ++s) { const a_s16x4 bl = a_vtr(bq + (16 * s) * SC_ST), bh = a_vtr(bq + (16 * s + 4) * SC_ST), xl = a_vtr(xq + (16 * s) * SC_XS), xh = a_vtr(xq + (16 * s + 4) * SC_XS);
                          const a_bf16x8 av = (a_bf16x8){bl[0], bl[1], bl[2], bl[3], bh[0], bh[1], bh[2], bh[3]}, bv = (a_bf16x8){xl[0], xl[1], xl[2], xl[3], xh[0], xh[1], xh[2], xh[3]};
                          hacc = __builtin_amdgcn_mfma_f32_32x32x16_bf16(av, bv, hacc, 0, 0, 0); } }
#pragma unroll
                    for (int g4 = 0; g4 < 4; ++g4) { v2u w; w.x = a_cvtpk(hacc[4 * g4], hacc[4 * g4 + 1]); w.y = a_cvtpk(hacc[4 * g4 + 2], hacc[4 * g4 + 3]);
                        *(LAS v2u*)(lds + SC_H + (32 * pb + r32) * SC_ST + (32 * nb + 8 * g4 + 4 * hi) * 2) = w; }
                }
                if (seq < 16) { float* o = out + OUT_SSM + ((((size_t)seq * 2 + dir) * 32 + hd) * 64 + 32 * pb + r32) * 128 + 32 * nb + 4 * hi;
#pragma unroll
                    for (int g4 = 0; g4 < 4; ++g4) { v4f t4; t4.x = hacc[4 * g4]; t4.y = hacc[4 * g4 + 1]; t4.z = hacc[4 * g4 + 2]; t4.w = hacc[4 * g4 + 3]; *(GAS v4f*)(o + 8 * g4) = t4; } }
            }
        }
    }
#undef SC_GLOADP
#undef SC_ITEM
    LDS_BARRIER();
}

constexpr int NPHASE = 30;
enum Op { OP_P0, OP_NORM1, OP_G_LAT, OP_FIN1, OP_G_QKV, OP_FIN2, OP_ATTN, OP_G_WO, OP_NORM2, OP_G_FF1, OP_G_FF2, OP_G_PW1, OP_DWCONV, OP_G_PW2, OP_G_SSI, OP_SSCONV, OP_SCAN, OP_GATE, OP_G_SSO };
__device__ __forceinline__ void phase_decode(int ph, int& layer, int& op) {
    if (ph == 0) { layer = 0; op = OP_P0; return; }
    if (ph <= 9) { layer = 0; const int r = ph - 1; op = r == 0 ? OP_NORM1 : r == 1 ? OP_G_LAT : r == 2 ? OP_FIN1 : r == 3 ? OP_G_QKV : r == 4 ? OP_FIN2 : r == 5 ? OP_ATTN : r == 6 ? OP_G_WO : r == 7 ? OP_G_FF1 : OP_G_FF2; }
    else if (ph <= 14) { layer = 1; const int r = ph - 10; op = r == 0 ? OP_G_PW1 : r == 1 ? OP_DWCONV : r == 2 ? OP_G_PW2 : r == 3 ? OP_G_FF1 : OP_G_FF2; }
    else if (ph <= 21) { layer = 2; const int r = ph - 15; op = r == 0 ? OP_G_SSI : r == 1 ? OP_SSCONV : r == 2 ? OP_SCAN : r == 3 ? OP_GATE : r == 4 ? OP_G_SSO : r == 5 ? OP_G_FF1 : OP_G_FF2; }
    else { layer = 3; const int r = ph - 22; op = r == 0 ? OP_G_LAT : r == 1 ? OP_FIN1 : r == 2 ? OP_G_QKV : r == 3 ? OP_FIN2 : r == 4 ? OP_ATTN : r == 5 ? OP_G_WO : r == 6 ? OP_G_FF1 : OP_G_FF2; }
}
struct MArgs { const float* in[38]; float* out; unsigned char* ws; int ph_lo, ph_hi; };
constexpr int PTAB_OFF = PTAB_OFF_C;
__global__ void __launch_bounds__(NTHR, 2) mega_fwd(MArgs args) {
    extern __shared__ __attribute__((aligned(16))) unsigned char lds_raw[];
    LAS unsigned char* lds = (LAS unsigned char*)lds_raw;
    volatile LAS unsigned* PT0 = (volatile LAS unsigned*)(lds + PTAB_OFF);
    volatile LAS unsigned* MISC = (volatile LAS unsigned*)(lds + MISC_OFF);
    { const int t0 = threadIdx.x;
      if (t0 < 40) { const unsigned long long p = t0 < 38 ? (unsigned long long)args.in[t0] : t0 == 38 ? (unsigned long long)args.out : (unsigned long long)args.ws;
          PT0[2 * t0] = (unsigned)p; PT0[2 * t0 + 1] = (unsigned)(p >> 32); }
      if (t0 < 64) MISC[t0] = 0u; }
    __syncthreads();
    XcdBarrier bar = xcd_barrier_post((unsigned*)((unsigned char*)ldp(PT0, PT_WS) + WS_CTL) + CW_BAR, MISC + 8);
    const int wave0 = __builtin_amdgcn_readfirstlane(threadIdx.x >> 6);
    const int ph_hi = args.ph_hi;
    for (int ph = args.ph_lo; ph < ph_hi; ++ph) {
        Frame F;
        { int w = wave0; asm volatile("" : "+s"(w)); F.wave = w; }
        F.lds = lds; F.lane = olane(); F.tid = F.wave * 64 + F.lane;
        const int bx = obid();
        F.G = gridDim.x; F.vcu = (F.G % 8 == 0) ? (bx % 8) * (F.G / 8) + bx / 8 : bx;
        F.gw = F.vcu * NWAVES + F.wave; F.NGW = F.G * NWAVES; F.PT = PT0; F.bx = bx;
        int layer, op; phase_decode(ph, layer, op);
        const int j = layer / 3;
        switch (op) {
        case OP_P0: p0_prologue(F); break;
        case OP_NORM1: { unsigned char* ws = WSP; float* x = OUTP; const float* xlo = layer == 0 ? INP(I_XP) : x; const float* xhi = layer == 0 ? INP(I_XS) - (size_t)TP * 1024 : x;
            rp_normmod(F, xlo, xhi, INP(I_GN1) + layer * 1024, (const float*)(ws + WS_MODS) + (size_t)layer * 5 * 6144, 0, 1024, (bf16*)(ws + WS_H)); rp_tables(F); } break;
        case OP_NORM2: { unsigned char* ws = WSP; float* x = OUTP;
            rp_normmod(F, x, x, INP(I_GN2) + layer * 1024, (const float*)(ws + WS_MODS) + (size_t)layer * 5 * 6144, 3072, 4096, (bf16*)(ws + WS_H)); } break;
        case OP_G_LAT: { unsigned char* ws = WSP; pg8::Gemm g{(const bf16*)(ws + WS_H), (const bf16*)(ws + W_MLA + j * MLA_WB + MW_CAT), T, 768, 1024}; pg8::StaticOrder S; S.init(T, 2 * 768, F.G, F.bx);
            const int s_ = 2 * layer; pg8::EpiF32<1> E{(float*)(ws + A_LAT), 768, layer == 0 ? nullptr : (const float*)(ws + WS_STAT) + s_ * 8192, layer == 0 ? nullptr : (const float*)(ws + WS_SW) + (size_t)s_ * 5 * 5632}; pg8::gemm_phase<pg8::EpiF32<1>, pg8::StaticOrder, true, true, true>(F.lds, g, S, E, F.wave); } break;
        case OP_FIN1: { unsigned char* ws = WSP; rp_mla_fin1(F, (const float*)(ws + A_LAT), INP(I_GQ) + j * 384, INP(I_GKV) + j * 256, (bf16*)(ws + A_QN), (bf16*)(ws + WS_CKV + j * CKV_B), OUTP, j); } break;
        case OP_G_QKV: {
#pragma unroll 1
            for (int w = 0; w < 2; ++w) {
                unsigned char* ws = WSP; unsigned char* wm = ws + W_MLA + j * MLA_WB;
                pg8::Gemm g = w == 0 ? pg8::Gemm{(const bf16*)(ws + A_QN), (const bf16*)(wm + MW_UQ), T, 1536, 384} : pg8::Gemm{(const bf16*)(ws + WS_CKV + j * CKV_B), (const bf16*)(wm + MW_UKV), T + NCTX, 2048, 256};
                pg8::StaticOrder S; S.init(g.M, g.N, F.G, w == 0 ? F.bx : (int)((F.bx + 64) % F.G));
                pg8::EpiBf16P E{w == 0 ? (bf16*)(ws + A_QRAW) : (bf16*)(ws + A_KVRAW), g.N};
                pg8::gemm_phase<pg8::EpiBf16P, pg8::StaticOrder, true, true>(F.lds, g, S, E, F.wave);
            } } break;
        case OP_FIN2: { unsigned char* ws = WSP; rp_mla_fin2(F, (const bf16*)(ws + A_QRAW), (const bf16*)(ws + A_KVRAW), (const float*)(ws + A_LAT), INP(I_CKPE) + (size_t)j * 8192, INP(I_GQN) + j * 96, INP(I_GKN) + j * 96,
                                                        (const float*)(ws + WS_ROPE), (bf16*)(ws + A_QB), (bf16*)(ws + A_KB)); } break;
        case OP_ATTN: { unsigned char* ws = WSP; ph_attn(F, (const bf16*)(ws + A_QB), (const bf16*)(ws + A_KB), (const bf16*)(ws + A_KVRAW), (bf16*)(ws + A_AO)); } break;
        case OP_G_WO: case OP_G_PW2: case OP_G_SSO: case OP_G_FF2: {
            unsigned char* ws = WSP; float* x = OUTP;
            const float* rlo = (layer == 0 && op != OP_G_FF2) ? INP(I_XP) : x; const float* rhi = (layer == 0 && op != OP_G_FF2) ? INP(I_XS) - (size_t)TP * 1024 : x;
            pg8::Gemm g; const float* bias = nullptr; int goff = 2048;
            if (op == OP_G_WO) g = pg8::Gemm{(const bf16*)(ws + A_AO), (const bf16*)(ws + W_MLA + j * MLA_WB + MW_O), T, 1024, 1024};
            else if (op == OP_G_PW2) { g = pg8::Gemm{(const bf16*)(ws + A_V), (const bf16*)(ws + W_CV2), T, 1024, 1024}; bias = INP(I_CVB2); }
            else if (op == OP_G_SSO) g = pg8::Gemm{(const bf16*)(ws + A_YN), (const bf16*)(ws + W_SSO), T, 1024, 2048};
            else { g = pg8::Gemm{(const bf16*)(ws + A_ACT), (const bf16*)(ws + W_FF + layer * FF_WB + FW_OUT), T, 1024, 2816}; goff = 5120; }
            pg8::StaticOrder S; S.init(T, 2 * 1024, F.G, F.bx);
            float* xdst = x;
            const int sn_ = 2 * layer + (op == OP_G_FF2 ? 2 : 1);
            pg8::EpiResid<1> E{rlo, rhi, xdst, (const float*)(ws + WS_MODS) + (size_t)layer * 5 * 6144, goff, bias,
                               sn_ < 8 ? (bf16*)(ws + WS_H) : nullptr, (const float*)(ws + WS_GT) + (size_t)(sn_ & 7) * 5 * 1024, (float*)(ws + WS_STAT) + (sn_ & 7) * 8192};
            pg8::gemm_phase<pg8::EpiResid<1>, pg8::StaticOrder, true, true, true>(F.lds, g, S, E, F.wave); } break;
        case OP_G_FF1: { unsigned char* ws = WSP; pg8::Gemm g{(const bf16*)(ws + WS_H), (const bf16*)(ws + W_FF + layer * FF_WB + FW_IN), T, 5632, 1024}; pg8::StaticOrder S; S.init(T, 5632, F.G, F.bx);
            const int s_ = 2 * layer + 1; pg8::EpiGlu<0> E{(bf16*)(ws + A_ACT), 2816, nullptr, 2816, (const float*)(ws + WS_STAT) + s_ * 8192, (const float*)(ws + WS_SW) + (size_t)s_ * 5 * 5632}; pg8::gemm_phase<pg8::EpiGlu<0>, pg8::StaticOrder, true, true>(F.lds, g, S, E, F.wave); } break;
        case OP_G_PW1: { unsigned char* ws = WSP; pg8::Gemm g{(const bf16*)(ws + WS_H), (const bf16*)(ws + W_CV1), T, 2048, 1024}; pg8::StaticOrder S; S.init(T, 2048, F.G, F.bx);
            const int s_ = 2 * layer; pg8::EpiGlu<1> E{(bf16*)(ws + A_U), 1024, INP(I_CVB1), 1024, (const float*)(ws + WS_STAT) + s_ * 8192, (const float*)(ws + WS_SW) + (size_t)s_ * 5 * 5632}; pg8::gemm_phase<pg8::EpiGlu<1>, pg8::StaticOrder, true, true>(F.lds, g, S, E, F.wave); } break;
        case OP_DWCONV: { unsigned char* ws = WSP; rp_dwconv(F, (const bf16*)(ws + A_U), INP(I_CVWD), INP(I_CVBD), INP(I_CVGL), INP(I_CVBL), (bf16*)(ws + A_V)); } break;
        case OP_G_SSI: { unsigned char* ws = WSP; pg8::Gemm g{(const bf16*)(ws + WS_H), (const bf16*)(ws + W_SSI), T, 5376, 1024}; pg8::StaticOrder S; S.init(T, 5376, F.G, F.bx);
            const int s_ = 2 * layer; pg8::EpiSsdIn E{(bf16*)(ws + A_Z), (bf16*)(ws + A_XPRE), (float*)(ws + A_DTRAW), (const float*)(ws + WS_STAT) + s_ * 8192, (const float*)(ws + WS_SW) + (size_t)s_ * 5 * 5632}; pg8::gemm_phase<pg8::EpiSsdIn, pg8::StaticOrder, true, true>(F.lds, g, S, E, F.wave); } break;
        case OP_SSCONV: { unsigned char* ws = WSP; rp_ssd_conv(F, (const bf16*)(ws + A_XPRE), (const float*)(ws + A_DTRAW), INP(I_SSWC), INP(I_SSBC), INP(I_SSDTB), INP(I_SSAL), (bf16*)(ws + A_XBC), (float*)(ws + A_DT), (float*)(ws + A_ACUM)); } break;
        case OP_SCAN: { unsigned char* ws = WSP; ph_scan(F, (const bf16*)(ws + A_XBC), (const float*)(ws + A_DT), (const float*)(ws + A_ACUM), INP(I_SSD), INP(I_SSM), (bf16*)(ws + A_Y), OUTP); } break;
        case OP_GATE: { unsigned char* ws = WSP; rp_ssd_gate(F, (const bf16*)(ws + A_Y), (const bf16*)(ws + A_Z), INP(I_SSGN), (bf16*)(ws + A_YN)); } break;
        default: break;
        }

        if (ph + 1 < ph_hi) xcd_barrier(bar);

    }
}

extern "C" void kernel_launch(void* const* d_in, const int* in_sizes, int n_in, void* d_out, int out_size, void* d_ws, size_t ws_size, hipStream_t stream) {
    static int grid = 0;
    if (grid == 0) {
        int dev = 0, cus = 0;
        if (hipGetDevice(&dev) != hipSuccess || hipDeviceGetAttribute(&cus, hipDeviceAttributeMultiprocessorCount, dev) != hipSuccess) { fprintf(stderr, "kernel_launch: device query failed\n"); grid = -1; return; }
        if (hipFuncSetAttribute((const void*)mega_fwd, hipFuncAttributeMaxDynamicSharedMemorySize, LDS_BYTES) != hipSuccess) { fprintf(stderr, "kernel_launch: hipFuncSetAttribute failed\n"); grid = -1; return; }
        (void)hipGetLastError();
        grid = cus;
    }
    if (grid < 0) return;
    (void)hipMemsetAsync((char*)d_ws + WS_CTL, 0, CTL_ZERO_BYTES, stream);
    MArgs a{};
    for (int i = 0; i < 38; ++i) a.in[i] = (const float*)d_in[i];
    a.out = (float*)d_out; a.ws = (unsigned char*)d_ws;
    a.ph_lo = 0; a.ph_hi = NPHASE;
    hipLaunchKernelGGL(mega_fwd, dim3(grid), dim3(NTHR), LDS_BYTES, stream, a);
}
```

```cpp
#include <hip/hip_runtime.h>
#include <cstdint>
#include <cstdio>

constexpr int DM = 1024, T = 8192, TP = 4096;
constexpr int NCTX = 1024;
constexpr int QL = 384, KVL = 256, ROPE = 32, NOPE = 64, QKD = 96, VH = 64, NH = 16;
constexpr int FFH = 2816;
constexpr int SSI = 2048, SSH = 32, SSP = 64, SSN = 128, SSG = 4, SSCD = 3072, SSIN = 5184;
constexpr float EPS = 1e-6f;
constexpr size_t OUT_YP = 0, OUT_CKV = 8388608, OUT_KPE = 10485760, OUT_SSM = 10747904;

__device__ __forceinline__ int cond_of_row(int r) { return r < TP ? 0 : 1 + ((r - TP) >> 10); }
__device__ __forceinline__ void row_pos(int r, int& t, int& L) { if (r < TP) { t = r & 255; L = 256; } else { t = (r - TP) & 1023; L = 1024; } }
__device__ __forceinline__ float softplus_f(float x) { return fmaxf(x, 0.f) + log1pf(expf(-fabsf(x))); }

__device__ __forceinline__ float rope_inv(int i) { return i == 0 ? 1.f : i == 1 ? 0.31622776601683794f : i == 2 ? 0.1f : i == 3 ? 0.031622776601683794f : i == 4 ? 0.01f : i == 5 ? 0.0031622776601683794f : i == 6 ? 0.001f : 0.00031622776601683794f; }

__device__ __forceinline__ int olane() { int l; asm volatile("v_mbcnt_lo_u32_b32 %0, -1, 0\n\tv_mbcnt_hi_u32_b32 %0, -1, %0" : "=v"(l)); return l; }
__device__ __forceinline__ int obid() { int b = blockIdx.x; asm volatile("" : "+s"(b)); return b; }
namespace pg8 {
#define PG8_LAS __attribute__((address_space(3)))
typedef unsigned short bf16_t;
typedef short bf16x8 __attribute__((ext_vector_type(8)));
typedef float f32x4 __attribute__((ext_vector_type(4)));
typedef unsigned u32x4 __attribute__((ext_vector_type(4)));
constexpr int BM = 256, BK = 64, HALF = 128, HTB = HALF * BK * 2  , STAGE_BYTES = 8 * HTB, NXCD = 8, WGM = 8;

__host__ __device__ __forceinline__ int lds_byte(int r, int c) { const int st = (r >> 4) * 2 + (c >> 5), rr = r & 15, cc = c & 31, ob = rr * 64 + cc * 2; return st * 1024 + (ob ^ (((ob >> 9) & 1) << 5)); }
__host__ __device__ __forceinline__ void stage_rc(int b, int& R, int& C) { const int st = b / 1024, sb = b % 1024, swz = sb ^ (((sb >> 9) & 1) << 5); R = (st >> 1) * 16 + swz / 64; C = (st & 1) * 32 + (swz % 64) / 2; }
__host__ __device__ __forceinline__ int perm32(int rho) { const int n = rho >> 4, i = rho & 15; return 8 * (i >> 2) + 4 * n + (i & 3); }

struct Unit { int pm, pn; };
struct Gemm { const bf16_t* A; const bf16_t* Bt; int M, N, K; };

struct StaticOrder {
    int nM, nN, nwg, G, c;
    __host__ __device__ void init(int M, int N, int G_, int c_) { nM = M / BM; nN = N / BM; nwg = nM * nN; G = G_; c = c_; }
    __host__ __device__ bool next(int i, Unit& u) const {
        const long L = (long)i * G + c; if (L >= nwg) return false;
        int wgid = (int)L; { const int q = nwg / NXCD, r = nwg % NXCD, xcd = wgid % NXCD, off = wgid / NXCD; wgid = (xcd < r ? xcd * (q + 1) : r * (q + 1) + (xcd - r) * q) + off; }
        const int nig = WGM * nN, gid = wgid / nig, fm = gid * WGM, gsz = (nM - fm) < WGM ? (nM - fm) : WGM;
        u.pm = fm + ((wgid % nig) % gsz); u.pn = (wgid % nig) / gsz; return true;
    }
    __device__ __forceinline__ void a_ready(const Unit&) const {}
    __device__ __forceinline__ void done(const Unit&) const {}
};
__device__ __forceinline__ unsigned cvt_pk_bf16(float lo, float hi) { unsigned r; asm("v_cvt_pk_bf16_f32 %0, %1, %2" : "=v"(r) : "v"(lo), "v"(hi)); return r; }
typedef unsigned u32x2 __attribute__((ext_vector_type(2)));
#define PG8_GAS __attribute__((address_space(1)))
__device__ __forceinline__ void st16(void* p, u32x4 v) { *(PG8_GAS u32x4*)p = v; }
__device__ __forceinline__ void st16f(void* p, f32x4 v) { *(PG8_GAS f32x4*)p = v; }
__device__ __forceinline__ void st8(void* p, u32x2 v) { *(PG8_GAS u32x2*)p = v; }
__device__ __forceinline__ f32x4 ld16f(const float* p) { return *(const PG8_GAS f32x4*)p; }
__device__ __forceinline__ float ld4f(const float* p) { return *(const PG8_GAS float*)p; }
__device__ __forceinline__ float fast_sigmoid(float x) { return __builtin_amdgcn_rcpf(1.f + __builtin_amdgcn_exp2f(-1.4426950408889634f * x)); }
__device__ __forceinline__ unsigned cvt_pk_bf16_p(float lo, float hi) { unsigned r; asm("v_cvt_pk_bf16_f32 %0, %1, %2" : "=v"(r) : "v"(lo), "v"(hi)); return r; }
template <int MODE> __device__ __forceinline__ void glu8(const f32x4 a0, const f32x4 g0, const f32x4 a1, const f32x4 g1, f32x4& o0, f32x4& o1) {
    const f32x4 t0 = (MODE == 0 ? a0 : g0) * -1.4426950408889634f, t1 = (MODE == 0 ? a1 : g1) * -1.4426950408889634f;
    f32x4 e0, e1, r0, r1;
#pragma unroll
    for (int j = 0; j < 4; ++j) { e0[j] = __builtin_amdgcn_exp2f(t0[j]); e1[j] = __builtin_amdgcn_exp2f(t1[j]); }
    const f32x4 d0 = e0 + 1.f, d1 = e1 + 1.f;
#pragma unroll
    for (int j = 0; j < 4; ++j) { r0[j] = __builtin_amdgcn_rcpf(d0[j]); r1[j] = __builtin_amdgcn_rcpf(d1[j]); }
    if (MODE == 0) { o0 = a0 * g0 * r0; o1 = a1 * g1 * r1; } else { o0 = a0 * r0; o1 = a1 * r1; }
}

constexpr int SW_LD = 5632;
__device__ __forceinline__ int cond_of_pm(int pm) { return pm < 16 ? 0 : 1 + ((pm - 16) >> 2); }
__device__ __forceinline__ void stage_rstat_sw(const float* rstat, const float* sw, const Unit& u, int slot, int wid, int lane, PG8_LAS unsigned char* tabs) {
    PG8_LAS unsigned char* tab = tabs + slot * 2048;
    if (wid < 4) __builtin_amdgcn_global_load_lds((const unsigned*)(rstat + u.pm * BM + wid * 64 + lane), (PG8_LAS unsigned*)(tab + wid * 256), 4, 0, 0);
    else __builtin_amdgcn_global_load_lds((const unsigned*)(sw + (size_t)cond_of_pm(u.pm) * SW_LD + u.pn * BM + (wid - 4) * 64 + lane), (PG8_LAS unsigned*)(tab + 1024 + (wid - 4) * 256), 4, 0, 0);
}
template <int NBJ> struct EpiF32 {
    static constexpr bool PERM = false, AFTER_DRAIN = false, STAGE_IN = false;
    float* C; int ldc; const float* rstat; const float* sw;
    template <bool HN> __device__ __forceinline__ void body(const f32x4 (&acc)[2][2][4][2], const Unit& u, int wr, int wc) const {
        const int t_ = olane(), fr = t_ & 15, fq = t_ >> 4;
        const int row0 = u.pm * BM + wr * 64 + fr, col0 = u.pn * (HALF * NBJ) + wc * 32 + 4 * fq;
        float rs[2][4]; f32x4 s4[NBJ][2];
#pragma unroll
        for (int ai = 0; ai < 2; ++ai)
#pragma unroll
            for (int m = 0; m < 4; ++m) rs[ai][m] = HN ? ld4f(rstat + row0 + ai * HALF + m * 16) : 1.f;
#pragma unroll
        for (int bj = 0; bj < NBJ; ++bj)
#pragma unroll
            for (int n = 0; n < 2; ++n) s4[bj][n] = HN ? ld16f(sw + (size_t)cond_of_pm(u.pm) * SW_LD + col0 + bj * HALF + n * 16) : (f32x4){0.f, 0.f, 0.f, 0.f};
        if (HN) {
#pragma unroll
            for (int ai = 0; ai < 2; ++ai)
#pragma unroll
                for (int m = 0; m < 4; ++m) rs[ai][m] = __builtin_amdgcn_rsqf(rs[ai][m] * (1.f / 1024) + 1e-6f);
        }
#pragma unroll
        for (int ai = 0; ai < 2; ++ai)
#pragma unroll
            for (int m = 0; m < 4; ++m) { float* rowp = C + (size_t)(row0 + ai * HALF + m * 16) * ldc + col0;
#pragma unroll
                for (int bj = 0; bj < NBJ; ++bj)
#pragma unroll
                    for (int n = 0; n < 2; ++n) { f32x4 v = acc[ai][bj][m][n]; if (HN) v = v * rs[ai][m] + s4[bj][n]; st16f(rowp + bj * HALF + n * 16, v); } }
    }
    __device__ __forceinline__ void operator()(const f32x4 (&acc)[2][2][4][2], const Unit& u, int wr_, int wc_, int fr_, int fq_, const PG8_LAS unsigned char* tab) const {
        (void)fr_; (void)fq_; (void)tab;
        if (rstat) body<true>(acc, u, wr_, wc_); else body<false>(acc, u, wr_, wc_);
    }
};
struct EpiBf16P {
    static constexpr bool PERM = true, AFTER_DRAIN = false, STAGE_IN = false;
    bf16_t* O; int ldc;
    __device__ __forceinline__ void operator()(const f32x4 (&acc)[2][2][4][2], const Unit& u, int wr_, int wc_, int fr_, int fq_, const PG8_LAS unsigned char* tab) const {
        const int t_ = olane(), wr = wr_, wc = wc_, fr = t_ & 15, fq = t_ >> 4; (void)fr_; (void)fq_; (void)tab;
        const int row0 = u.pm * BM + wr * 64 + fr, col0 = u.pn * BM + wc * 32 + 8 * fq;
#pragma unroll
        for (int ai = 0; ai < 2; ++ai)
#pragma unroll
            for (int m = 0; m < 4; ++m) { bf16_t* rowp = O + (size_t)(row0 + ai * HALF + m * 16) * ldc + col0;
#pragma unroll
                for (int bj = 0; bj < 2; ++bj) { const f32x4 v0 = acc[ai][bj][m][0], v1 = acc[ai][bj][m][1]; u32x4 w;
                    w.x = cvt_pk_bf16(v0[0], v0[1]); w.y = cvt_pk_bf16(v0[2], v0[3]); w.z = cvt_pk_bf16(v1[0], v1[1]); w.w = cvt_pk_bf16(v1[2], v1[3]);
                    st16(rowp + bj * HALF, w); } }
    }
};
struct EpiSsdIn {
    static constexpr bool PERM = true, AFTER_DRAIN = false, STAGE_IN = true;
    bf16_t* Z; bf16_t* XP; float* DT; const float* rstat; const float* sw;
    __device__ __forceinline__ void stage_in(const Unit& u, int slot, int wid, int lane, PG8_LAS unsigned char* tabs) const { stage_rstat_sw(rstat, sw, u, slot, wid, lane, tabs); }
    __device__ __forceinline__ void operator()(const f32x4 (&acc)[2][2][4][2], const Unit& u, int wr_, int wc_, int fr_, int fq_, const PG8_LAS unsigned char* tab) const {
        const int t_ = olane(), wr = wr_, wc = wc_, fr = t_ & 15, fq = t_ >> 4; (void)fr_; (void)fq_;
        const int row0 = u.pm * BM + wr * 64 + fr;
        const PG8_LAS float* trs = (const PG8_LAS float*)tab + wr * 64 + fr; const PG8_LAS float* swp = (const PG8_LAS float*)(tab + 1024) + wc * 32 + 8 * fq;
        if (u.pn < 20) {
            bf16_t* base = u.pn < 8 ? Z : XP; const int ld = u.pn < 8 ? 2048 : 3072, colt = (u.pn < 8 ? u.pn : u.pn - 8) * BM, col0 = colt + wc * 32 + 8 * fq;
#pragma unroll
            for (int ai = 0; ai < 2; ++ai)
#pragma unroll
                for (int m = 0; m < 4; ++m) { bf16_t* rowp = base + (size_t)(row0 + ai * HALF + m * 16) * ld + col0;
                    const float rs = __builtin_amdgcn_rsqf(trs[ai * HALF + m * 16] * (1.f / 1024) + 1e-6f);
#pragma unroll
                    for (int bj = 0; bj < 2; ++bj) { const f32x4 v0 = acc[ai][bj][m][0] * rs + *(const PG8_LAS f32x4*)(swp + bj * HALF), v1 = acc[ai][bj][m][1] * rs + *(const PG8_LAS f32x4*)(swp + bj * HALF + 4); u32x4 w;
                        w.x = cvt_pk_bf16(v0[0], v0[1]); w.y = cvt_pk_bf16(v0[2], v0[3]); w.z = cvt_pk_bf16(v1[0], v1[1]); w.w = cvt_pk_bf16(v1[2], v1[3]);
                        st16(rowp + bj * HALF, w); } }
        } else if (wc < 2) {
#pragma unroll
            for (int ai = 0; ai < 2; ++ai)
#pragma unroll
                for (int m = 0; m < 4; ++m) { float* rp = DT + (size_t)(row0 + ai * HALF + m * 16) * 64 + wc * 32 + 8 * fq;
                    const float rs = __builtin_amdgcn_rsqf(trs[ai * HALF + m * 16] * (1.f / 1024) + 1e-6f);
                    st16f(rp, acc[ai][0][m][0] * rs + *(const PG8_LAS f32x4*)swp); st16f(rp + 4, acc[ai][0][m][1] * rs + *(const PG8_LAS f32x4*)(swp + 4)); }
        }
    }
};
template <int MODE> struct EpiGlu {
    static constexpr bool PERM = false, AFTER_DRAIN = false, STAGE_IN = true;
    bf16_t* O; int ldo; const float* bias; int H; const float* rstat; const float* sw;
    __device__ __forceinline__ void stage_in(const Unit& u, int slot, int wid, int lane, PG8_LAS unsigned char* tabs) const { stage_rstat_sw(rstat, sw, u, slot, wid, lane, tabs); }
    __device__ __forceinline__ void operator()(const f32x4 (&acc)[2][2][4][2], const Unit& u, int wr_, int wc_, int fr_, int fq_, const PG8_LAS unsigned char* tab) const {
        const int t_ = olane(), wr = wr_, wc = wc_, fr = t_ & 15, fq = t_ >> 4; (void)fr_; (void)fq_;
        const int row0 = u.pm * BM + wr * 64 + fr;
        float rs[2][4];
#pragma unroll
        for (int ai = 0; ai < 2; ++ai)
#pragma unroll
            for (int m = 0; m < 4; ++m) rs[ai][m] = ((const PG8_LAS float*)tab)[ai * HALF + wr * 64 + m * 16 + fr];
#pragma unroll
        for (int ai = 0; ai < 2; ++ai)
#pragma unroll
            for (int m = 0; m < 4; ++m) rs[ai][m] = __builtin_amdgcn_rsqf(rs[ai][m] * (1.f / 1024) + 1e-6f);
        const unsigned ldb = (unsigned)ldo * 2u;
        unsigned char* Ob = (unsigned char*)O;
        const int f0 = 128 * u.pn + 32 * wc + 8 * fq;
        f32x4 ba[2], bu[2];
#pragma unroll
        for (int bj = 0; bj < 2; ++bj) {
            ba[bj] = (f32x4){0.f, 0.f, 0.f, 0.f}; bu[bj] = ba[bj];
            if (MODE == 1) { ba[bj] = ld16f(bias + f0 + 4 * bj); bu[bj] = ld16f(bias + H + f0 + 4 * bj); }
            const PG8_LAS float* swp = (const PG8_LAS float*)(tab + 1024) + bj * HALF + wc * 32 + 4 * fq; ba[bj] += *(const PG8_LAS f32x4*)swp; bu[bj] += *(const PG8_LAS f32x4*)(swp + 16);
        }
        const unsigned ob = (unsigned)row0 * ldb + (unsigned)f0 * 2u;
#pragma unroll
        for (int ai = 0; ai < 2; ++ai)
#pragma unroll
            for (int m = 0; m < 4; ++m) {
                const f32x4 a0 = acc[ai][0][m][0] * rs[ai][m] + ba[0], g0 = acc[ai][0][m][1] * rs[ai][m] + bu[0];
                const f32x4 a1 = acc[ai][1][m][0] * rs[ai][m] + ba[1], g1 = acc[ai][1][m][1] * rs[ai][m] + bu[1];
                f32x4 o0, o1; glu8<MODE>(a0, g0, a1, g1, o0, o1);
                u32x4 w; w.x = cvt_pk_bf16_p(o0[0], o0[1]); w.y = cvt_pk_bf16_p(o0[2], o0[3]); w.z = cvt_pk_bf16_p(o1[0], o1[1]); w.w = cvt_pk_bf16_p(o1[2], o1[3]);
                st16(Ob + (size_t)(ob + (unsigned)(ai * HALF + m * 16) * ldb), w); }
    }
};
template <int NBJ> struct EpiResid {
    static constexpr bool PERM = true, AFTER_DRAIN = false, STAGE_IN = false;
    const float* xlo; const float* xhi; float* xout; const float* mods_l; int g_off; const float* bias;
    bf16_t* XG; const float* GT; float* stat;
    template <bool HX> __device__ __forceinline__ void body(const f32x4 (&acc)[2][2][4][2], const Unit& u, int wr, int wc) const {
        const int t_ = olane(), fr = t_ & 15, fq = t_ >> 4;
        const int cond = u.pm < 16 ? 0 : 1 + ((u.pm - 16) >> 2);
        const float* gate = mods_l + (size_t)cond * 6144 + g_off; const unsigned char* xin = (const unsigned char*)(u.pm < 16 ? xlo : xhi);
        const int row0 = u.pm * BM + wr * 64 + fr, col0 = u.pn * (HALF * NBJ) + wc * 32 + 8 * fq;
        const unsigned ob = (unsigned)row0 * 4096u + (unsigned)col0 * 4u;
        f32x4 xo[NBJ][2][2][4];
#pragma unroll
        for (int bj = 0; bj < NBJ; ++bj)
#pragma unroll
            for (int n = 0; n < 2; ++n)
#pragma unroll
                for (int ai = 0; ai < 2; ++ai)
#pragma unroll
                    for (int m = 0; m < 4; ++m) xo[bj][n][ai][m] = ld16f((const float*)(xin + (size_t)(ob + (unsigned)((bj * HALF + n * 4) * 4 + (ai * HALF + m * 16) * 4096))));
        const float* gt = HX ? GT + (size_t)cond * 1024 : nullptr;
        f32x4 g4[NBJ][2], b4[NBJ][2], G4[NBJ][2];
#pragma unroll
        for (int bj = 0; bj < NBJ; ++bj)
#pragma unroll
            for (int n = 0; n < 2; ++n) { const int c = col0 + bj * HALF + n * 4; g4[bj][n] = ld16f(gate + c);
                b4[bj][n] = (f32x4){0.f, 0.f, 0.f, 0.f}; if (bias) b4[bj][n] = ld16f(bias + c);
                G4[bj][n] = (f32x4){0.f, 0.f, 0.f, 0.f}; if (HX) G4[bj][n] = ld16f(gt + c); }
        float ss[2][4];
#pragma unroll
        for (int ai = 0; ai < 2; ++ai)
#pragma unroll
            for (int m = 0; m < 4; ++m) ss[ai][m] = 0.f;
        unsigned char* xo_ = (unsigned char*)xout; unsigned char* xg_ = (unsigned char*)XG;
#pragma unroll
        for (int bj = 0; bj < NBJ; ++bj)
#pragma unroll
            for (int ai = 0; ai < 2; ++ai)
#pragma unroll
                for (int m = 0; m < 4; ++m) { const unsigned off = ob + (unsigned)(bj * HALF * 4 + (ai * HALF + m * 16) * 4096);
                    const f32x4 x0 = xo[bj][0][ai][m] + g4[bj][0] * (acc[ai][bj][m][0] + b4[bj][0]), x1 = xo[bj][1][ai][m] + g4[bj][1] * (acc[ai][bj][m][1] + b4[bj][1]);
                    st16f(xo_ + (size_t)off, x0); st16f(xo_ + (size_t)(off + 16u), x1);
                    if (HX) { const f32x4 y0 = x0 * G4[bj][0], y1 = x1 * G4[bj][1]; u32x4 w;
                        w.x = cvt_pk_bf16_p(y0[0], y0[1]); w.y = cvt_pk_bf16_p(y0[2], y0[3]); w.z = cvt_pk_bf16_p(y1[0], y1[1]); w.w = cvt_pk_bf16_p(y1[2], y1[3]); st16(xg_ + (size_t)(off >> 1), w);
                        const f32x4 q = x0 * x0 + x1 * x1; ss[ai][m] += (q[0] + q[1]) + (q[2] + q[3]); } }
        if (HX) {
#pragma unroll
            for (int ai = 0; ai < 2; ++ai)
#pragma unroll
                for (int m = 0; m < 4; ++m) { float s = ss[ai][m];
                    s += __builtin_bit_cast(float, __builtin_amdgcn_ds_bpermute((t_ ^ 16) << 2, __builtin_bit_cast(int, s)));
                    s += __builtin_bit_cast(float, __builtin_amdgcn_ds_bpermute((t_ ^ 32) << 2, __builtin_bit_cast(int, s)));
                    if (fq == 0) atomicAdd(stat + row0 + ai * HALF + m * 16, s); }
        }
    }
    __device__ __forceinline__ void operator()(const f32x4 (&acc)[2][2][4][2], const Unit& u, int wr_, int wc_, int fr_, int fq_, const PG8_LAS unsigned char* tab) const {
        (void)fr_; (void)fq_; (void)tab;
        if (XG) body<true>(acc, u, wr_, wc_); else body<false>(acc, u, wr_, wc_);
    }
};
template <class Epi, class Sched, bool ALIGN_EPI = false, bool SP2 = false, bool HALFN = false>
__device__ __forceinline__ void gemm_phase(PG8_LAS unsigned char* lds, const Gemm g, const Sched& S, const Epi& E, const int wave_in) {
    const int tid = wave_in * 64 + olane(), wid = __builtin_amdgcn_readfirstlane(tid >> 6), lane = tid & 63, wr = wid >> 2, wc = wid & 3, fr = lane & 15, fq = lane >> 4;
    const int K = g.K, nt = K / BK;
    unsigned voffA[2], voffB[2];
#pragma unroll
    for (int i = 0; i < 2; ++i) { int R, C; stage_rc(tid * 16 + i * 8192, R, C); const int Rb = Epi::PERM ? ((R & ~31) + perm32(R & 31)) : R;
        voffA[i] = (unsigned)(R * K + C) * 2u; voffB[i] = (unsigned)(Rb * K + C) * 2u; }
    const size_t kstep = (size_t)(BK * 2);
    const size_t hstep = (size_t)HALF * K * 2;
    const size_t tstep = 2 * hstep;
    const size_t bstep = HALFN ? hstep : tstep;
    static_assert(!HALFN || SP2, "HALFN is written for the SP2 loop only");
    const unsigned ldsw = (unsigned)wid * 1024u;
    const int aoff = lds_byte(wr * 64 + fr, fq * 8), boff = lds_byte(wc * 32 + fr, fq * 8);
#define PG8_SA(b, h) (((b) * 2 + (h)) * HTB)
#define PG8_SB(b, h) ((4 + (b) * 2 + (h)) * HTB)
#define PG8_STAGE(bufoff, gbase, voff) do { _Pragma("unroll") for (int _i = 0; _i < 2; ++_i) \
        __builtin_amdgcn_global_load_lds((const unsigned*)((const char*)(gbase) + (voff)[_i]), (PG8_LAS unsigned*)(lds + (bufoff) + ldsw + _i * 8192), 16, 0, 0); } while (0)
#define PG8_LDA(dst, b, h) do { _Pragma("unroll") for (int m = 0; m < 4; ++m) _Pragma("unroll") for (int k = 0; k < 2; ++k) dst[m][k] = *(const PG8_LAS bf16x8*)(lds + PG8_SA(b, h) + aoff + m * 2048 + k * 1024); } while (0)
#define PG8_LDB(dst, b, h) do { _Pragma("unroll") for (int n = 0; n < 2; ++n) _Pragma("unroll") for (int k = 0; k < 2; ++k) dst[n][k] = *(const PG8_LAS bf16x8*)(lds + PG8_SB(b, h) + boff + n * 2048 + k * 1024); } while (0)
#define PG8_MMA(ai, bj, At, Bt) do { __builtin_amdgcn_s_setprio(1); _Pragma("unroll") for (int m = 0; m < 4; ++m) _Pragma("unroll") for (int n = 0; n < 2; ++n) _Pragma("unroll") for (int k = 0; k < 2; ++k) \
        acc[ai][bj][m][n] = __builtin_amdgcn_mfma_f32_16x16x32_bf16(Bt[n][k], At[m][k], acc[ai][bj][m][n], 0, 0, 0); __builtin_amdgcn_s_setprio(0); } while (0)
#define PG8_WAIT_V(n) asm volatile("s_waitcnt vmcnt(" #n ")" ::: "memory")
#define PG8_WAIT_L(n) asm volatile("s_waitcnt lgkmcnt(" #n ")" ::: "memory")
#define PG8_BAR __builtin_amdgcn_s_barrier()
#define PG8_SCHED __builtin_amdgcn_sched_barrier(0)
    Unit cur, nxt; int ui = 0;
    if (!S.next(0, cur)) return;
    f32x4 acc[2][2][4][2];
#pragma unroll
    for (int a = 0; a < 2; ++a)
#pragma unroll
        for (int b = 0; b < 2; ++b)
#pragma unroll
            for (int m = 0; m < 4; ++m)
#pragma unroll
                for (int n = 0; n < 2; ++n) acc[a][b][m][n] = (f32x4){0.f, 0.f, 0.f, 0.f};
    bf16x8 At[4][2], B0[2][2], B1[2][2];
    const char* cA = (const char*)g.A + (size_t)cur.pm * tstep; const char* cB = (const char*)g.Bt + (size_t)cur.pn * bstep;
    S.a_ready(cur);
    if constexpr (Epi::STAGE_IN) E.stage_in(cur, 0, wid, lane, lds + STAGE_BYTES);
    if constexpr (HALFN) {
        PG8_STAGE(PG8_SB(0, 0), cB, voffB); PG8_STAGE(PG8_SA(0, 0), cA, voffA); PG8_STAGE(PG8_SA(0, 1), cA + hstep, voffA);
        if (wr == 1) PG8_BAR;
        PG8_WAIT_V(2); PG8_BAR;
        PG8_STAGE(PG8_SB(1, 0), cB + kstep, voffB); PG8_STAGE(PG8_SA(1, 0), cA + kstep, voffA);
        PG8_WAIT_V(4); PG8_BAR;
    } else if constexpr (SP2) {
        PG8_STAGE(PG8_SB(0, 0), cB, voffB); PG8_STAGE(PG8_SB(0, 1), cB + hstep, voffB); PG8_STAGE(PG8_SA(0, 0), cA, voffA); PG8_STAGE(PG8_SA(0, 1), cA + hstep, voffA);
        if (wr == 1) PG8_BAR;
        PG8_WAIT_V(2); PG8_BAR;
        PG8_STAGE(PG8_SB(1, 0), cB + kstep, voffB); PG8_STAGE(PG8_SA(1, 0), cA + kstep, voffA); PG8_STAGE(PG8_SB(1, 1), cB + hstep + kstep, voffB);
        PG8_WAIT_V(6); PG8_BAR;
    } else {
        PG8_STAGE(PG8_SB(0, 0), cB, voffB); PG8_STAGE(PG8_SA(0, 0), cA, voffA); PG8_STAGE(PG8_SB(0, 1), cB + hstep, voffB); PG8_STAGE(PG8_SA(0, 1), cA + hstep, voffA);
        if (wr == 1) PG8_BAR;
        PG8_WAIT_V(4); PG8_BAR;
        PG8_STAGE(PG8_SB(1, 0), cB + kstep, voffB); PG8_STAGE(PG8_SA(1, 0), cA + kstep, voffA); PG8_STAGE(PG8_SB(1, 1), cB + hstep + kstep, voffB);
        PG8_WAIT_V(6); PG8_BAR;
    }
    for (;;) {
        const bool has_next = S.next(ui + 1, nxt);
        const char* nA = has_next ? (const char*)g.A + (size_t)nxt.pm * tstep : cA; const char* nB = has_next ? (const char*)g.Bt + (size_t)nxt.pn * bstep : cB;
        for (int t = 0; t < nt; t += 2) {
            const bool last = (t == nt - 2);
            const char* a1 = cA + (size_t)(t + 1) * kstep;
            const char* a2 = last ? nA : cA + (size_t)(t + 2) * kstep; const char* b2 = last ? nB : cB + (size_t)(t + 2) * kstep;
            const char* a3 = a2 + kstep; const char* b3 = b2 + kstep;
            if (last && has_next) S.a_ready(nxt);
            if constexpr (Epi::STAGE_IN) { if (last && has_next) E.stage_in(nxt, (ui + 1) & 1, wid, lane, lds + STAGE_BYTES); }
            if constexpr (HALFN) {
            PG8_LDB(B0, 0, 0); PG8_SCHED; PG8_LDA(At, 0, 0); PG8_STAGE(PG8_SA(1, 1), a1 + hstep, voffA);
            PG8_WAIT_V(6); PG8_WAIT_L(0); PG8_BAR; PG8_MMA(0, 0, At, B0); PG8_BAR; PG8_SCHED;
            PG8_LDA(At, 0, 1); PG8_STAGE(PG8_SB(0, 0), b2, voffB); PG8_STAGE(PG8_SA(0, 0), a2, voffA);
            PG8_WAIT_V(6); PG8_WAIT_L(0); PG8_BAR; PG8_MMA(1, 0, At, B0); PG8_BAR; PG8_SCHED;
            PG8_LDB(B0, 1, 0); PG8_SCHED; PG8_LDA(At, 1, 0); PG8_STAGE(PG8_SA(0, 1), a2 + hstep, voffA);
            PG8_WAIT_V(6); PG8_WAIT_L(0); PG8_BAR; PG8_MMA(0, 0, At, B0); PG8_BAR; PG8_SCHED;
            PG8_LDA(At, 1, 1); PG8_STAGE(PG8_SB(1, 0), b3, voffB); PG8_STAGE(PG8_SA(1, 0), a3, voffA);
            PG8_WAIT_V(6); PG8_WAIT_L(0); PG8_BAR; PG8_MMA(1, 0, At, B0); PG8_BAR; PG8_SCHED;
            } else if constexpr (SP2) {
            PG8_LDB(B0, 0, 0); PG8_LDB(B1, 0, 1); PG8_SCHED; PG8_LDA(At, 0, 0); PG8_STAGE(PG8_SA(1, 1), a1 + hstep, voffA);
            PG8_WAIT_V(8); PG8_WAIT_L(0); PG8_BAR; PG8_MMA(0, 0, At, B0); PG8_MMA(0, 1, At, B1); PG8_BAR; PG8_SCHED;
            PG8_LDA(At, 0, 1); PG8_STAGE(PG8_SB(0, 0), b2, voffB); PG8_STAGE(PG8_SB(0, 1), b2 + hstep, voffB); PG8_STAGE(PG8_SA(0, 0), a2, voffA);
            PG8_WAIT_V(8); PG8_WAIT_L(0); PG8_BAR; PG8_MMA(1, 0, At, B0); PG8_MMA(1, 1, At, B1); PG8_BAR; PG8_SCHED;
            PG8_LDB(B0, 1, 0); PG8_LDB(B1, 1, 1); PG8_SCHED; PG8_LDA(At, 1, 0); PG8_STAGE(PG8_SA(0, 1), a2 + hstep, voffA);
            PG8_WAIT_V(8); PG8_WAIT_L(0); PG8_BAR; PG8_MMA(0, 0, At, B0); PG8_MMA(0, 1, At, B1); PG8_BAR; PG8_SCHED;
            PG8_LDA(At, 1, 1); PG8_STAGE(PG8_SB(1, 0), b3, voffB); PG8_STAGE(PG8_SB(1, 1), b3 + hstep, voffB); PG8_STAGE(PG8_SA(1, 0), a3, voffA);
            PG8_WAIT_V(8); PG8_WAIT_L(0); PG8_BAR; PG8_MMA(1, 0, At, B0); PG8_MMA(1, 1, At, B1); PG8_BAR; PG8_SCHED;
            } else {
            PG8_LDB(B0, 0, 0); PG8_SCHED; PG8_LDA(At, 0, 0); PG8_STAGE(PG8_SA(1, 1), a1 + hstep, voffA);
            PG8_WAIT_L(8); PG8_BAR; PG8_WAIT_L(0); PG8_MMA(0, 0, At, B0); PG8_BAR; PG8_SCHED;
            PG8_LDB(B1, 0, 1); PG8_STAGE(PG8_SB(0, 0), b2, voffB);
            PG8_BAR; PG8_WAIT_L(0); PG8_MMA(0, 1, At, B1); PG8_BAR;
            PG8_LDA(At, 0, 1); PG8_STAGE(PG8_SA(0, 0), a2, voffA);
            PG8_BAR; PG8_WAIT_L(0); PG8_MMA(1, 0, At, B0); PG8_BAR; PG8_SCHED;
            PG8_STAGE(PG8_SB(0, 1), b2 + hstep, voffB);
            PG8_WAIT_V(6); PG8_BAR; PG8_MMA(1, 1, At, B1); PG8_BAR;
            PG8_LDB(B0, 1, 0); PG8_SCHED; PG8_LDA(At, 1, 0); PG8_STAGE(PG8_SA(0, 1), a2 + hstep, voffA);
            PG8_WAIT_L(8); PG8_BAR; PG8_WAIT_L(0); PG8_MMA(0, 0, At, B0); PG8_BAR; PG8_SCHED;
            PG8_LDB(B1, 1, 1); PG8_STAGE(PG8_SB(1, 0), b3, voffB);
            PG8_BAR; PG8_WAIT_L(0); PG8_MMA(0, 1, At, B1); PG8_BAR;
            PG8_LDA(At, 1, 1); PG8_STAGE(PG8_SA(1, 0), a3, voffA);
            PG8_BAR; PG8_WAIT_L(0); PG8_MMA(1, 0, At, B0); PG8_BAR; PG8_SCHED;
            PG8_STAGE(PG8_SB(1, 1), b3 + hstep, voffB);
            PG8_WAIT_V(6); PG8_BAR; PG8_MMA(1, 1, At, B1); PG8_BAR;
            }
        }
        if constexpr (ALIGN_EPI) { if (wr == 0) PG8_BAR; }
        if constexpr (!Epi::AFTER_DRAIN) { E(acc, cur, wr, wc, fr, fq, lds + STAGE_BYTES + (ui & 1) * 2048); S.done(cur); }
        if (!has_next) break;
#pragma unroll
        for (int a = 0; a < 2; ++a)
#pragma unroll
            for (int b = 0; b < 2; ++b)
#pragma unroll
                for (int m = 0; m < 4; ++m)
#pragma unroll
                    for (int n = 0; n < 2; ++n) acc[a][b][m][n] = (f32x4){0.f, 0.f, 0.f, 0.f};
        cur = nxt; cA = nA; cB = nB; ++ui;
        if constexpr (ALIGN_EPI) { if (wr == 1) PG8_BAR; }
    }
    PG8_WAIT_V(0);
    if constexpr (!ALIGN_EPI) { if (wr == 0) PG8_BAR; }
    PG8_BAR;
    if constexpr (Epi::AFTER_DRAIN) { E.fused(acc, cur, wr, wc, fr, fq, lds, wid, lane); S.done(cur); }
#undef PG8_SA
#undef PG8_SB
#undef PG8_STAGE
#undef PG8_LDA
#undef PG8_LDB
#undef PG8_MMA
#undef PG8_WAIT_V
#undef PG8_WAIT_L
#undef PG8_BAR
#undef PG8_SCHED
}
}
constexpr int NWAVES = 8, NTHR = 512;
constexpr size_t MiB = 1u << 20;
constexpr size_t WS_CTL = 0, CTL_ZERO_BYTES = 1 * MiB;
constexpr size_t WS_MODS = 256 * 1024;
constexpr size_t WS_STAT = 768 * 1024;
constexpr size_t WS_SW = 372 * MiB, WS_GT = 374 * MiB;
constexpr size_t WS_ROPE = 1 * MiB;
constexpr size_t WS_W = 2 * MiB;
constexpr size_t W_MLA = WS_W, MLA_WB = 5898240;
constexpr size_t MW_CAT = 0, MW_UQ = 1572864, MW_UKV = 2752512, MW_O = 3801088;
constexpr size_t W_CV1 = WS_W + 2 * MLA_WB, W_CV2 = W_CV1 + 4 * MiB;
constexpr size_t W_SSI = W_CV2 + 2 * MiB, W_SSO = W_SSI + 11010048;
constexpr size_t W_FF = W_SSO + 4 * MiB, FF_WB = 17301504, FW_IN = 0, FW_OUT = 11534336;
static_assert(W_FF + 4 * FF_WB <= 102 * MiB, "weights region");
constexpr size_t WS_H = 102 * MiB;
constexpr size_t WS_CKV = 118 * MiB, CKV_B = (size_t)(T + NCTX) * KVL * 2;
constexpr size_t WS_AR = 128 * MiB;
constexpr size_t A_LAT = WS_AR, A_QN = A_LAT + 24 * MiB, A_QRAW = A_QN + 6 * MiB, A_KVRAW = A_QRAW + 24 * MiB, A_QB = A_KVRAW + 36 * MiB, A_KB = A_QB + 24 * MiB, A_AO = A_KB + 27 * MiB;
constexpr size_t A_U = WS_AR, A_V = A_U + 16 * MiB;
constexpr size_t A_Z = WS_AR, A_XPRE = A_Z + 32 * MiB, A_DTRAW = A_XPRE + 48 * MiB, A_XBC = A_DTRAW + 2 * MiB, A_DT = A_XBC + 48 * MiB, A_Y = A_DT + 2 * MiB, A_YN = A_XPRE, A_ACUM = A_Y + 64 * MiB;
constexpr size_t A_ACT = WS_AR + 200 * MiB;
static_assert(A_AO + 16 * MiB <= A_ACT && A_ACUM + 2 * MiB <= A_ACT && A_ACT + 44 * MiB <= 384 * MiB, "arena map");
constexpr int CW_BAR = 4096;
constexpr int LDS_BYTES = 163840, RING_BYTES = 131072, MISC_OFF = 163840 - 256, PTAB_OFF_C = MISC_OFF - 512;

#define GAS __attribute__((address_space(1)))
#define LAS __attribute__((address_space(3)))
typedef unsigned short bf16;
typedef unsigned v4u __attribute__((ext_vector_type(4)));
typedef unsigned v2u __attribute__((ext_vector_type(2)));
typedef float v4f __attribute__((ext_vector_type(4)));
typedef float v2f __attribute__((ext_vector_type(2)));
typedef GAS unsigned gu32;
#define LDS_WAIT() asm volatile("s_waitcnt lgkmcnt(0)" ::: "memory")
#define LDS_BARRIER() do { asm volatile("s_waitcnt lgkmcnt(0)" ::: "memory"); __builtin_amdgcn_s_barrier(); asm volatile("" ::: "memory"); } while (0)
#define VM_WAIT() asm volatile("s_waitcnt vmcnt(0)" ::: "memory")
__device__ __forceinline__ unsigned f2bf(float f) { unsigned u = __builtin_bit_cast(unsigned, f); return (u + 0x7fffu + ((u >> 16) & 1u)) >> 16; }
__device__ __forceinline__ unsigned pk2(float lo, float hi) { unsigned r; asm("v_cvt_pk_bf16_f32 %0, %1, %2" : "=v"(r) : "v"(lo), "v"(hi)); return r; }
__device__ __forceinline__ float bflo(unsigned u) { return __builtin_bit_cast(float, u << 16); }
__device__ __forceinline__ float bfhi(unsigned u) { return __builtin_bit_cast(float, u & 0xffff0000u); }
__device__ __forceinline__ float bf2f(bf16 b) { return __builtin_bit_cast(float, (unsigned)b << 16); }

#define XB_TMO      128
#define XB_XCNT(j)  (256  + 64 * (j))
#define XB_XSUB(j)  (1280 + 64 * (j))
#define XB_XGEN(j)  (2304 + 64 * (j))
#define XB_TOP      3328
#define XB_TOPGEN   3392
#define XCD_BAR_WORDS 3456
#define XB_SPIN_CAP (1u << 18)

__device__ __forceinline__ unsigned xb_ld(unsigned* p)              { return __hip_atomic_load(p, __ATOMIC_RELAXED, __HIP_MEMORY_SCOPE_AGENT); }
__device__ __forceinline__ unsigned xb_add(unsigned* p, unsigned v) { return __hip_atomic_fetch_add(p, v, __ATOMIC_RELAXED, __HIP_MEMORY_SCOPE_AGENT); }
__device__ __forceinline__ unsigned xb_xcc_id() { return (unsigned)__builtin_amdgcn_s_getreg((3 << 11) | 20) & 0xFu; }
#define XB_SPIN(cond, bar) do { unsigned _sp = 0; while (cond) { __builtin_amdgcn_s_sleep(1); \
    if ((++_sp & 255u) == 0u) { if (xb_ld(&(bar)[XB_TMO])) break; if (_sp > XB_SPIN_CAP) { atomicAdd(&(bar)[XB_TMO], 1u); break; } } } } while (0)

struct XcdBarrier {
    unsigned* bar; unsigned x;
    volatile LAS unsigned* st;
};

__device__ __forceinline__ XcdBarrier xcd_barrier_post(unsigned* bar, volatile LAS unsigned* st) {
    XcdBarrier b; b.bar = bar; b.x = xb_xcc_id(); b.st = st;
    if (threadIdx.x == 0) (void)xb_add(&bar[XB_XCNT(b.x)], 1u);
    return b;
}
__device__ __forceinline__ void xcd_barrier_complete(unsigned* bar, unsigned x, unsigned& nloc, unsigned& nx) {
    const unsigned G = gridDim.x * gridDim.y * gridDim.z;
    unsigned sum, cnt, mine, sp = 0u;
    for (;;) {
        sum = 0u; cnt = 0u; mine = 0u;
#pragma unroll
        for (unsigned j = 0; j < 16; ++j) { const unsigned c = xb_ld(&bar[XB_XCNT(j)]); sum += c; cnt += (c > 0u) ? 1u : 0u; mine = (j == x) ? c : mine; }
        if (sum == G) break;
        __builtin_amdgcn_s_sleep(1);
        if ((++sp & 255u) == 0u) { if (xb_ld(&bar[XB_TMO])) break; if (sp > XB_SPIN_CAP) { atomicAdd(&bar[XB_TMO], 1u); break; } }
    }
    nloc = mine > 0u ? mine : 1u; nx = cnt > 0u ? cnt : 1u;
}

__device__ __forceinline__ void xcd_barrier(const XcdBarrier& b) {
    asm volatile("s_waitcnt vmcnt(0)" ::: "memory");
    __syncthreads();
    if (threadIdx.x == 0) {
        unsigned* bar = b.bar;
        __builtin_amdgcn_s_waitcnt(0);
        unsigned nloc = b.st[0], nx = b.st[1];
        if (nloc == 0u) { xcd_barrier_complete(bar, b.x, nloc, nx); b.st[0] = nloc; b.st[1] = nx; }
        const unsigned old = xb_add(&bar[XB_XSUB(b.x)], 1u);
        const unsigned gen = old / nloc;
        if (old + 1u == (gen + 1u) * nloc) {
            __builtin_amdgcn_fence(__ATOMIC_RELEASE, "agent");
            asm volatile("s_waitcnt vmcnt(0)" ::: "memory");
            const unsigned og = xb_add(&bar[XB_TOP], 1u);
            const unsigned tg = og / nx;
            if (og + 1u == (tg + 1u) * nx) xb_add(&bar[XB_TOPGEN], 1u);
            else XB_SPIN(xb_ld(&bar[XB_TOPGEN]) == tg, bar);
            __builtin_amdgcn_fence(__ATOMIC_ACQUIRE, "agent");
            xb_add(&bar[XB_XGEN(b.x)], 1u);
            asm volatile("s_waitcnt vmcnt(0)" ::: "memory");
        } else {
            XB_SPIN(xb_ld(&bar[XB_XGEN(b.x)]) == gen, bar);
            __builtin_amdgcn_fence(__ATOMIC_ACQUIRE, "agent");
            asm volatile("s_waitcnt vmcnt(0)" ::: "memory");
        }
    }
    __syncthreads();
}

struct Frame {
    LAS unsigned char* lds; int tid, lane, wave, vcu, G, gw, NGW, bx;
    volatile LAS unsigned* PT;
};
constexpr int PT_OUT = 38, PT_WS = 39;
__device__ __forceinline__ const float* ldp(volatile LAS unsigned* PT, int k) {
    const unsigned lo = __builtin_amdgcn_readfirstlane(PT[2 * k]), hi = __builtin_amdgcn_readfirstlane(PT[2 * k + 1]);
    return (const float*)(((unsigned long long)hi << 32) | lo);
}
#define INP(k) ldp(F.PT, (k))
#define WSP ((unsigned char*)ldp(F.PT, PT_WS))
#define OUTP ((float*)ldp(F.PT, PT_OUT))
enum InIdx { I_XP = 0, I_XS, I_CCKV, I_CKPE, I_SSM, I_C, I_CCTX, I_WADA, I_BADA, I_GN1, I_GN2, I_WDQ, I_GQ, I_WUQ, I_WDKV, I_GKV, I_WUKV, I_GQN, I_GKN, I_WO,
             I_CVW1, I_CVB1, I_CVWD, I_CVBD, I_CVGL, I_CVBL, I_CVW2, I_CVB2, I_SSWI, I_SSWC, I_SSBC, I_SSDTB, I_SSAL, I_SSD, I_SSGN, I_SSWO, I_FFWI, I_FFWO };
__device__ __forceinline__ float shx(float v, int lane, int o) { return __builtin_bit_cast(float, __builtin_amdgcn_ds_bpermute((lane ^ o) << 2, __builtin_bit_cast(int, v))); }
__device__ __forceinline__ float wsum(float v, int lane) {
#pragma unroll
    for (int o = 1; o < 64; o <<= 1) v += shx(v, lane, o);
    return v;
}
constexpr float QSCALE = 0.10206207261596577f * 1.4426950408889634f;

struct P0Item { const float* W; bf16* WT; int K, N, mode, H, roff, k0, n0; };
__device__ __forceinline__ void p0_item_load(const P0Item& J, int lane, v4f (&t)[8]) {
#pragma unroll
    for (int i = 0; i < 8; ++i) t[i] = *(const GAS v4f*)(J.W + (size_t)(J.k0 + 8 * i + (lane >> 3)) * J.N + J.n0 + 4 * (lane & 7));
}
__device__ __forceinline__ void p0_item_finish(const P0Item& J, int lane, const v4f (&t)[8], LAS float* scr) {
#pragma unroll
    for (int i = 0; i < 8; ++i) { LAS float* d = scr + (8 * i + (lane >> 3)) * 33 + 4 * (lane & 7); d[0] = t[i].x; d[1] = t[i].y; d[2] = t[i].z; d[3] = t[i].w; }
    LDS_WAIT(); asm volatile("" ::: "memory");
    const int c = lane & 7;
#pragma unroll
    for (int j = 0; j < 4; ++j) { const int n = (lane >> 3) + 8 * j, col = J.n0 + n; const LAS float* s = scr + (8 * c) * 33 + n;
        int drow;
        if (J.mode == 0) drow = J.roff + col;
        else { const int f = col < J.H ? col : col - J.H; drow = 256 * (f >> 7) + 128 * ((f >> 2) & 1) + 32 * ((f >> 5) & 3) + (col < J.H ? 0 : 16) + 4 * ((f >> 3) & 3) + (f & 3); }
        v4u o; o.x = pk2(s[0 * 33], s[1 * 33]); o.y = pk2(s[2 * 33], s[3 * 33]); o.z = pk2(s[4 * 33], s[5 * 33]); o.w = pk2(s[6 * 33], s[7 * 33]);
        *(GAS v4u*)(J.WT + (size_t)drow * J.K + J.k0 + 8 * c) = o; }
    LDS_WAIT(); asm volatile("" ::: "memory");
}
__device__ __forceinline__ void p0_job(int q, int& inp, size_t& soff, int& K, int& N, size_t& doff, int& mode, int& H, int& roff) {
    mode = 0; H = 0; roff = 0; soff = 0;
    if (q < 10) { const int j = q / 5, t = q % 5; const size_t wb = W_MLA + (size_t)j * MLA_WB;
        if (t == 0) { inp = I_WDQ; soff = (size_t)j * 1024 * 384; K = 1024; N = 384; doff = wb + MW_CAT; }
        else if (t == 1) { inp = I_WDKV; soff = (size_t)j * 1024 * 288; K = 1024; N = 288; doff = wb + MW_CAT; roff = 384; }
        else if (t == 2) { inp = I_WUQ; soff = (size_t)j * 384 * 1536; K = 384; N = 1536; doff = wb + MW_UQ; }
        else if (t == 3) { inp = I_WUKV; soff = (size_t)j * 256 * 2048; K = 256; N = 2048; doff = wb + MW_UKV; }
        else { inp = I_WO; soff = (size_t)j * 1024 * 1024; K = 1024; N = 1024; doff = wb + MW_O; } }
    else if (q == 10) { inp = I_CVW1; K = 1024; N = 2048; doff = W_CV1; mode = 1; H = 1024; }
    else if (q == 11) { inp = I_CVW2; K = 1024; N = 1024; doff = W_CV2; }
    else if (q == 12) { inp = I_SSWI; K = 1024; N = 5184; doff = W_SSI; }
    else if (q == 13) { inp = I_SSWO; K = 2048; N = 1024; doff = W_SSO; }
    else { const int l = (q - 14) >> 1, t = (q - 14) & 1;
        if (t == 0) { inp = I_FFWI; soff = (size_t)l * 1024 * 5632; K = 1024; N = 5632; doff = W_FF + (size_t)l * FF_WB + FW_IN; mode = 1; H = 2816; }
        else { inp = I_FFWO; soff = (size_t)l * 2816 * 1024; K = 2816; N = 1024; doff = W_FF + (size_t)l * FF_WB + FW_OUT; } }
}
constexpr int P0_NITEMS = 2 * ((1024 / 64) * (384 / 32) + (1024 / 64) * (288 / 32) + (384 / 64) * (1536 / 32) + (256 / 64) * (2048 / 32) + (1024 / 64) * (1024 / 32))
                        + (1024 / 64) * (2048 / 32) + (1024 / 64) * (1024 / 32) + (1024 / 64) * (5184 / 32) + (2048 / 64) * (1024 / 32)
                        + 4 * ((1024 / 64) * (5632 / 32) + (2816 / 64) * (1024 / 32));
__device__ __forceinline__ void p0_prologue(Frame& F) {
    unsigned char* ws = WSP;
    LAS float* s = (LAS float*)F.lds;
    for (int i = F.tid; i < 5 * 1024; i += NTHR) { const int cc = i >> 10, k = i & 1023; const float v = cc == 0 ? INP(I_CCTX)[k] : INP(I_C)[(cc - 1) * 1024 + k]; s[i] = v / (1.f + expf(-v)); }
    __syncthreads();
    float* mods = (float*)(ws + WS_MODS);
    for (int it = F.bx; it < 192; it += F.G) {
        const int l = it / 48, r = it % 48, cb = r / 16, ks = r % 16, n = cb * 2048 + 4 * F.tid;
        const float* W = INP(I_WADA) + (size_t)l * 1024 * 6144 + (size_t)(ks * 64) * 6144 + n;
        v4f acc[5];
#pragma unroll
        for (int cc = 0; cc < 5; ++cc) acc[cc] = (v4f){0.f, 0.f, 0.f, 0.f};
#pragma unroll 1
        for (int kb = 0; kb < 64; kb += 16) {
            v4f wv[16];
#pragma unroll
            for (int k = 0; k < 16; ++k) wv[k] = *(const GAS v4f*)(W + (size_t)(kb + k) * 6144);
#pragma unroll
            for (int k = 0; k < 16; ++k)
#pragma unroll
                for (int cc = 0; cc < 5; ++cc) acc[cc] += wv[k] * s[cc * 1024 + ks * 64 + kb + k];
        }
        LAS float* tbl = s + 5 * 1024;
        __syncthreads();
#pragma unroll
        for (int cc = 0; cc < 5; ++cc) *(LAS v4f*)(tbl + cc * 2048 + 4 * F.tid) = acc[cc];
        __syncthreads();
        const float* bp = INP(I_BADA) + l * 6144 + cb * 2048;
#pragma unroll
        for (int q = 0; q < 4; ++q) { const int col = q * 512 + F.tid; const float bb = ks == 0 ? bp[col] : 0.f;
#pragma unroll
            for (int cc = 0; cc < 5; ++cc) atomicAdd(&mods[((size_t)l * 5 + cc) * 6144 + cb * 2048 + col], tbl[cc * 2048 + col] + bb); }
    }
    __syncthreads();
    LAS float* scr = (LAS float*)(F.lds + F.wave * 8448);
    for (int it = F.gw; it < P0_NITEMS; it += 2 * F.NGW) {
        P0Item J[2]; bool have1 = it + F.NGW < P0_NITEMS;
#pragma unroll
        for (int e = 0; e < 2; ++e) {
            int r = e == 0 ? it : (have1 ? it + F.NGW : it), inp = 0, K = 64, N = 32, mode = 0, H = 0, roff = 0; size_t soff = 0, doff = 0;
#pragma unroll 1
            for (int q = 0; q < 22; ++q) { p0_job(q, inp, soff, K, N, doff, mode, H, roff); const int ni = (K / 64) * (N / 32); if (r < ni) break; r -= ni; }
            const int nblk = N / 32;
            J[e].W = INP(inp) + soff; J[e].WT = (bf16*)(ws + doff); J[e].K = K; J[e].N = N; J[e].mode = mode; J[e].H = H; J[e].roff = roff; J[e].k0 = 64 * (r / nblk); J[e].n0 = 32 * (r % nblk);
        }
        v4f t0[8], t1[8];
        p0_item_load(J[0], F.lane, t0); p0_item_load(J[1], F.lane, t1);
        p0_item_finish(J[0], F.lane, t0, scr);
        if (have1) p0_item_finish(J[1], F.lane, t1, scr);
    }
    for (int it = F.gw; it < 384; it += F.NGW) {
        bf16* rowp = it < 192 ? (bf16*)(ws + W_MLA + (it / 96) * MLA_WB + MW_CAT) + (size_t)(672 + it % 96) * 1024 : (bf16*)(ws + W_SSI) + (size_t)(5184 + it - 192) * 1024;
        const v4u z = {0u, 0u, 0u, 0u}; ((GAS v4u*)rowp)[F.lane] = z; ((GAS v4u*)rowp)[64 + F.lane] = z;
    }
    for (int it = F.gw; it < 2048; it += F.NGW) {
        const int j = it >> 10, rr = it & 1023, b = rr >> 8, sq = rr & 255;
        const v4f v = ((const GAS v4f*)(INP(I_CCKV) + (((size_t)b * 2 + j) * 256 + sq) * 256))[F.lane];
        v2u o; o.x = pk2(v.x, v.y); o.y = pk2(v.z, v.w);
        ((GAS v2u*)((bf16*)(ws + WS_CKV + j * CKV_B) + (size_t)(T + rr) * 256))[F.lane] = o;
    }
    if (F.bx == 0) for (int i = F.tid; i < 640; i += NTHR) { const int pos = i >> 3, fi = i & 7; const float p = (float)(pos < 16 ? pos : pos - 16);
        const float a = p * rope_inv(fi); float* tab = (float*)(ws + WS_ROPE); tab[2 * i] = cosf(a); tab[2 * i + 1] = sinf(a); }
}

__device__ __forceinline__ void rp_normmod(Frame& F, const float* xlo, const float* xhi, const float* g, const float* mods_l, int sh_off, int sc_off, bf16* h) {
    for (int base = F.gw; base < T; base += 4 * F.NGW) {
        v4f v[4][4]; float ss[4]; int rows[4];
#pragma unroll
        for (int k = 0; k < 4; ++k) { const int row = base + k * F.NGW; rows[k] = row < T ? row : base;
            const GAS v4f* xr = (const GAS v4f*)((rows[k] < TP ? xlo : xhi) + (size_t)rows[k] * 1024) + F.lane;
#pragma unroll
            for (int j = 0; j < 4; ++j) v[k][j] = xr[64 * j]; }
#pragma unroll
        for (int k = 0; k < 4; ++k) { float s = 0.f;
#pragma unroll
            for (int j = 0; j < 4; ++j) s += (v[k][j].x * v[k][j].x + v[k][j].y * v[k][j].y) + (v[k][j].z * v[k][j].z + v[k][j].w * v[k][j].w);
            ss[k] = s; }
#pragma unroll
        for (int o = 1; o < 64; o <<= 1) {
#pragma unroll
            for (int k = 0; k < 4; ++k) ss[k] += shx(ss[k], F.lane, o); }
#pragma unroll
        for (int j = 0; j < 4; ++j) { const int c = 4 * F.lane + 256 * j; const v4f g4 = *(const GAS v4f*)(g + c);
#pragma unroll
            for (int k = 0; k < 4; ++k) { const float r = rsqrtf(ss[k] * (1.f / 1024) + EPS); const float* m = mods_l + (size_t)cond_of_row(rows[k]) * 6144;
                const v4f sc = *(const GAS v4f*)(m + sc_off + c), sh = *(const GAS v4f*)(m + sh_off + c);
                const v4f o = v[k][j] * r * g4 * (sc + 1.f) + sh; v2u w; w.x = pk2(o.x, o.y); w.y = pk2(o.z, o.w);
                *(GAS v2u*)(h + (size_t)rows[k] * 1024 + c) = w; } }
    }
}
__device__ __forceinline__ void rp_mla_fin1(Frame& F, const float* lat, const float* gq, const float* gkv, bf16* qn, bf16* ckv, float* out, int j) {
    for (int row = F.gw; row < T; row += F.NGW) {
        const float* lr = lat + (size_t)row * 768;
        v2f q[3]; float ss = 0.f;
#pragma unroll
        for (int i = 0; i < 3; ++i) { q[i] = *(const GAS v2f*)(lr + 2 * F.lane + 128 * i); ss += q[i].x * q[i].x + q[i].y * q[i].y; }
        float r = rsqrtf(wsum(ss, F.lane) * (1.f / 384) + EPS);
#pragma unroll
        for (int i = 0; i < 3; ++i) { const int c = 2 * F.lane + 128 * i; *(GAS unsigned*)(qn + (size_t)row * 384 + c) = pk2(q[i].x * r * gq[c], q[i].y * r * gq[c + 1]); }
        v2f k[2]; ss = 0.f;
#pragma unroll
        for (int i = 0; i < 2; ++i) { k[i] = *(const GAS v2f*)(lr + 384 + 2 * F.lane + 128 * i); ss += k[i].x * k[i].x + k[i].y * k[i].y; }
        r = rsqrtf(wsum(ss, F.lane) * (1.f / 256) + EPS);
#pragma unroll
        for (int i = 0; i < 2; ++i) { const int c = 2 * F.lane + 128 * i; const float c0 = k[i].x * r * gkv[c], c1 = k[i].y * r * gkv[c + 1];
            *(GAS unsigned*)(ckv + (size_t)row * 256 + c) = pk2(c0, c1);
            if (row < TP) { v2f o; o.x = c0; o.y = c1; *(GAS v2f*)(out + OUT_CKV + (((size_t)(row >> 8) * 2 + j) * 256 + (row & 255)) * 256 + c) = o; } }
        if (row < TP && F.lane < 32) out[OUT_KPE + (((size_t)(row >> 8) * 2 + j) * 256 + (row & 255)) * 32 + F.lane] = lr[640 + F.lane];
    }
}
__device__ __forceinline__ void rope32_tab(float* pe, int t, const float* tab) {
    const v2f* tr = (const v2f*)tab + (t >> 6) * 8; const v2f* tc = (const v2f*)tab + (16 + (t & 63)) * 8;
#pragma unroll
    for (int i = 0; i < 8; ++i) {
        v2f cs = tr[i]; float x1 = pe[i], x2 = pe[i + 8]; pe[i] = x1 * cs.x - x2 * cs.y; pe[i + 8] = x2 * cs.x + x1 * cs.y;
        cs = tc[i]; x1 = pe[16 + i]; x2 = pe[24 + i]; pe[16 + i] = x1 * cs.x - x2 * cs.y; pe[24 + i] = x2 * cs.x + x1 * cs.y;
    }
}
__device__ __forceinline__ void ld8(const bf16* p, float* d) { const v4u w = *(const GAS v4u*)p; d[0] = bflo(w.x); d[1] = bfhi(w.x); d[2] = bflo(w.y); d[3] = bfhi(w.y); d[4] = bflo(w.z); d[5] = bfhi(w.z); d[6] = bflo(w.w); d[7] = bfhi(w.w); }
__device__ __forceinline__ void st8(bf16* p, const float* d) { v4u w; w.x = pk2(d[0], d[1]); w.y = pk2(d[2], d[3]); w.z = pk2(d[4], d[5]); w.w = pk2(d[6], d[7]); *(GAS v4u*)p = w; }
__device__ __forceinline__ void rp_tables(Frame& F) {
    unsigned char* ws = WSP; const float* mods = (const float*)(ws + WS_MODS); float* GTb = (float*)(ws + WS_GT); float* SWb = (float*)(ws + WS_SW);
    for (int idx = F.bx * NTHR + F.tid; idx < 8 * 5 * 1024; idx += F.G * NTHR) {
        const int s = idx / 5120, r = idx % 5120, c = r >> 10, k = r & 1023, layer = s >> 1;
        const float g = (s & 1) ? INP(I_GN2)[layer * 1024 + k] : INP(I_GN1)[layer * 1024 + k];
        GTb[idx] = g * (1.f + mods[((size_t)layer * 5 + c) * 6144 + ((s & 1) ? 4096 : 1024) + k]);
    }
    constexpr int NR1 = 5632, NR2 = 2048, NR4 = 5376, NR6 = 768;
    constexpr int TOT = 4 * NR1 + NR2 + NR4 + NR6;
    for (int it = F.gw; it < TOT / 4; it += F.NGW) {
        int s, n; const bf16* Wt; const int i4 = 4 * it;
        if (i4 < 4 * NR1) { const int l = i4 / NR1; n = i4 % NR1; s = 2 * l + 1; Wt = (const bf16*)(ws + W_FF + (size_t)l * FF_WB + FW_IN); }
        else if (i4 < 4 * NR1 + NR2) { n = i4 - 4 * NR1; s = 2; Wt = (const bf16*)(ws + W_CV1); }
        else if (i4 < 4 * NR1 + NR2 + NR4) { n = i4 - 4 * NR1 - NR2; s = 4; Wt = (const bf16*)(ws + W_SSI); }
        else { n = i4 - 4 * NR1 - NR2 - NR4; s = 6; Wt = (const bf16*)(ws + W_MLA + MLA_WB + MW_CAT); }
        const int layer = s >> 1, shoff = (s & 1) ? 3072 : 0;
        v4u wr[4][2];
#pragma unroll
        for (int r = 0; r < 4; ++r) { wr[r][0] = *(const GAS v4u*)(Wt + (size_t)(n + r) * 1024 + 16 * F.lane); wr[r][1] = *(const GAS v4u*)(Wt + (size_t)(n + r) * 1024 + 16 * F.lane + 8); }
        float acc[4][5];
#pragma unroll
        for (int r = 0; r < 4; ++r)
#pragma unroll
            for (int c = 0; c < 5; ++c) acc[r][c] = 0.f;
#pragma unroll
        for (int c = 0; c < 5; ++c) { const float* sp = mods + ((size_t)layer * 5 + c) * 6144 + shoff + 16 * F.lane;
            const v4f s0 = *(const GAS v4f*)sp, s1 = *(const GAS v4f*)(sp + 4), s2 = *(const GAS v4f*)(sp + 8), s3 = *(const GAS v4f*)(sp + 12);
#pragma unroll
            for (int r = 0; r < 4; ++r) { const v4u a = wr[r][0], b2 = wr[r][1];
                acc[r][c] = (s0.x * bflo(a.x) + s0.y * bfhi(a.x) + s0.z * bflo(a.y) + s0.w * bfhi(a.y)) + (s1.x * bflo(a.z) + s1.y * bfhi(a.z) + s1.z * bflo(a.w) + s1.w * bfhi(a.w))
                          + (s2.x * bflo(b2.x) + s2.y * bfhi(b2.x) + s2.z * bflo(b2.y) + s2.w * bfhi(b2.y)) + (s3.x * bflo(b2.z) + s3.y * bfhi(b2.z) + s3.z * bflo(b2.w) + s3.w * bfhi(b2.w)); } }
#pragma unroll
        for (int o = 1; o < 64; o <<= 1) {
#pragma unroll
            for (int r = 0; r < 4; ++r)
#pragma unroll
                for (int c = 0; c < 5; ++c) acc[r][c] += shx(acc[r][c], F.lane, o); }
        if (F.lane < 20) { const int r = F.lane / 5, c = F.lane % 5; float v = 0.f;
#pragma unroll
            for (int rr = 0; rr < 4; ++rr)
#pragma unroll
                for (int cc = 0; cc < 5; ++cc) v = (rr == r && cc == c) ? acc[rr][cc] : v;
            SWb[((size_t)s * 5 + c) * 5632 + n + r] = v; }
    }
}
__device__ __forceinline__ void rp_mla_fin2(Frame& F, const bf16* qraw, const bf16* kvraw, const float* lat, const float* ckpe_j, const float* gqn, const float* gkn, const float* tab, bf16* Q, bf16* K) {
    for (int idx = F.bx * NTHR + F.tid; idx < T * 32; idx += F.G * NTHR) {
        const int row = idx >> 5, hd = (idx >> 1) & 15, hf = idx & 1; const bool latent = row >= TP; const int tl = (row - TP) & 1023;
        float v[48]; float ss = 0.f;
#pragma unroll
        for (int i = 0; i < 6; ++i) ld8(qraw + (size_t)row * 1536 + hd * 96 + hf * 48 + 8 * i, v + 8 * i);
#pragma unroll
        for (int d = 0; d < 48; ++d) ss += v[d] * v[d];
        ss += shx(ss, F.lane, 1);
        const float r = rsqrtf(ss * (1.f / 96) + EPS) * QSCALE;
#pragma unroll
        for (int d = 0; d < 48; ++d) v[d] = v[d] * r * gqn[hf * 48 + d];
        if (latent && hf) rope32_tab(v + 16, tl, tab);
#pragma unroll
        for (int i = 0; i < 6; ++i) st8(Q + ((size_t)row * 16 + hd) * 96 + hf * 48 + 8 * i, v + 8 * i);
    }
    asm volatile("" ::: "memory");
    for (int idx = F.bx * NTHR + F.tid; idx < (T + NCTX) * 32; idx += F.G * NTHR) {
        const int row = idx >> 5, hd = (idx >> 1) & 15, hf = idx & 1; const bool latent = row >= TP && row < T; const int tl = (row - TP) & 1023;
        float v[48]; float ss = 0.f;
        if (hf == 0) {
#pragma unroll
            for (int i = 0; i < 6; ++i) ld8(kvraw + (size_t)row * 2048 + hd * 128 + 8 * i, v + 8 * i);
        } else {
#pragma unroll
            for (int i = 0; i < 2; ++i) ld8(kvraw + (size_t)row * 2048 + hd * 128 + 48 + 8 * i, v + 8 * i);
            const float* kp = row < T ? lat + (size_t)row * 768 + 640 : ckpe_j + ((size_t)((row - T) >> 8) * 2 * 256 + ((row - T) & 255)) * 32;
#pragma unroll
            for (int i = 0; i < 8; ++i) { const v4f p4 = *(const GAS v4f*)(kp + 4 * i); v[16 + 4 * i] = p4.x; v[17 + 4 * i] = p4.y; v[18 + 4 * i] = p4.z; v[19 + 4 * i] = p4.w; }
        }
#pragma unroll
        for (int d = 0; d < 48; ++d) ss += v[d] * v[d];
        ss += shx(ss, F.lane, 1);
        const float r = rsqrtf(ss * (1.f / 96) + EPS);
#pragma unroll
        for (int d = 0; d < 48; ++d) v[d] = v[d] * r * gkn[hf * 48 + d];
        if (latent && hf) rope32_tab(v + 16, tl, tab);
#pragma unroll
        for (int i = 0; i < 6; ++i) st8(K + ((size_t)row * 16 + hd) * 96 + hf * 48 + 8 * i, v + 8 * i);
    }
}
__device__ __forceinline__ void rp_dwconv(Frame& F, const bf16* u, const float* wdw, const float* bdw, const float* gln, const float* bln, bf16* vout) {
    LAS float* red = (LAS float*)F.lds;
    const int c = 2 * F.tid;
    for (int it = F.vcu; it < T / 16; it += F.G) {
        const int row0 = 16 * it; int t0, L; row_pos(row0, t0, L);
        v2f w[31];
#pragma unroll
        for (int k = 0; k < 31; ++k) w[k] = *(const GAS v2f*)(wdw + k * 1024 + c);
        const v2f bb = *(const GAS v2f*)(bdw + c);
        unsigned pk[46];
#pragma unroll
        for (int rr = 0; rr < 46; ++rr) { const int tt = t0 - 15 + rr; const bool ok = tt >= 0 && tt < L;
            pk[rr] = *(const GAS unsigned*)(u + (size_t)(ok ? row0 - 15 + rr : row0) * 1024 + c); pk[rr] = ok ? pk[rr] : 0u; }
        v2f yy[16];
#pragma unroll
        for (int r = 0; r < 16; ++r) yy[r] = bb;
#pragma unroll
        for (int rr = 0; rr < 46; ++rr) {
            const v2f x = (v2f){bflo(pk[rr]), bfhi(pk[rr])};
#pragma unroll
            for (int r = 0; r < 16; ++r) { const int k = rr - r; if (k >= 0 && k < 31) yy[r] += x * w[k]; }
        }
        float y0[16], y1[16];
#pragma unroll
        for (int r = 0; r < 16; ++r) { y0[r] = yy[r].x; y1[r] = yy[r].y; }
        float s[16];
#pragma unroll
        for (int r = 0; r < 16; ++r) s[r] = y0[r] + y1[r];
#pragma unroll
        for (int o = 1; o < 64; o <<= 1) {
#pragma unroll
            for (int r = 0; r < 16; ++r) s[r] += shx(s[r], F.lane, o); }
        __syncthreads();
        if (F.lane < 16) { float v = s[0];
#pragma unroll
            for (int r = 1; r < 16; ++r) v = F.lane == r ? s[r] : v;
            red[F.wave * 16 + F.lane] = v; }
        __syncthreads();
        float mean[16];
#pragma unroll
        for (int r = 0; r < 16; ++r) { float m = 0.f;
#pragma unroll
            for (int wv = 0; wv < 8; ++wv) m += red[wv * 16 + r];
            mean[r] = m * (1.f / 1024); }
#pragma unroll
        for (int r = 0; r < 16; ++r) { y0[r] -= mean[r]; y1[r] -= mean[r]; s[r] = y0[r] * y0[r] + y1[r] * y1[r]; }
#pragma unroll
        for (int o = 1; o < 64; o <<= 1) {
#pragma unroll
            for (int r = 0; r < 16; ++r) s[r] += shx(s[r], F.lane, o); }
        __syncthreads();
        if (F.lane < 16) { float v = s[0];
#pragma unroll
            for (int r = 1; r < 16; ++r) v = F.lane == r ? s[r] : v;
            red[F.wave * 16 + F.lane] = v; }
        __syncthreads();
        const v2f gg = *(const GAS v2f*)(gln + c), bl = *(const GAS v2f*)(bln + c);
#pragma unroll
        for (int r = 0; r < 16; ++r) { float q = 0.f;
#pragma unroll
            for (int wv = 0; wv < 8; ++wv) q += red[wv * 16 + r];
            const float rs = rsqrtf(q * (1.f / 1024) + EPS);
            const float z0 = y0[r] * rs * gg.x + bl.x, z1 = y1[r] * rs * gg.y + bl.y;
            *(GAS unsigned*)(vout + (size_t)(row0 + r) * 1024 + c) = pk2(z0 / (1.f + __expf(-z0)), z1 / (1.f + __expf(-z1))); }
    }
    __syncthreads();
}
__device__ __forceinline__ void rp_ssd_conv(Frame& F, const bf16* xpre, const float* dtraw, const float* wc, const float* bc, const float* dtb, const float* alog, bf16* xbc, float* dt, float* acum) {
    for (int idx = F.bx * NTHR + F.tid; idx < (T / 32) * 384; idx += F.G * NTHR) {
        const int seg = idx / 384, cg = idx - seg * 384, c0 = 8 * cg, row0 = 32 * seg; int t0, L; row_pos(row0, t0, L);
        float w[5][8], bias[8];
#pragma unroll
        for (int k = 0; k < 5; ++k) { const v4f a = *(const GAS v4f*)(wc + k * 3072 + c0), b2 = *(const GAS v4f*)(wc + k * 3072 + c0 + 4);
            w[k][0] = a.x; w[k][1] = a.y; w[k][2] = a.z; w[k][3] = a.w; w[k][4] = b2.x; w[k][5] = b2.y; w[k][6] = b2.z; w[k][7] = b2.w; }
        { const v4f a = *(const GAS v4f*)(bc + c0), b2 = *(const GAS v4f*)(bc + c0 + 4); bias[0] = a.x; bias[1] = a.y; bias[2] = a.z; bias[3] = a.w; bias[4] = b2.x; bias[5] = b2.y; bias[6] = b2.z; bias[7] = b2.w; }
        float win[5][8];
#pragma unroll
        for (int k = 0; k < 4; ++k) { const int tt = t0 + k - 2;
            if (tt >= 0 && tt < L) ld8(xpre + (size_t)(row0 + k - 2) * 3072 + c0, win[k + 1]);
            else {
#pragma unroll
                for (int i = 0; i < 8; ++i) win[k + 1][i] = 0.f; } }
#pragma unroll 4
        for (int r = 0; r < 32; ++r) {
#pragma unroll
            for (int k = 0; k < 4; ++k)
#pragma unroll
                for (int i = 0; i < 8; ++i) win[k][i] = win[k + 1][i];
            const int tt = t0 + r + 2;
            if (tt < L) ld8(xpre + (size_t)(row0 + r + 2) * 3072 + c0, win[4]);
            else {
#pragma unroll
                for (int i = 0; i < 8; ++i) win[4][i] = 0.f; }
            float a[8];
#pragma unroll
            for (int i = 0; i < 8; ++i) { float v = bias[i];
#pragma unroll
                for (int k = 0; k < 5; ++k) v += win[k][i] * w[k][i];
                a[i] = v / (1.f + __expf(-v)); }
            st8(xbc + (size_t)(row0 + r) * 3072 + c0, a);
        }
    }
    for (int it = F.gw; it < 64 * 64; it += F.NGW) {
        const int ch = it >> 6, e = it & 63, dir = e >> 5, row0 = 128 * ch, lane = F.lane;
        const float aa = -expf(alog[e]), bb = dtb[e];
        const int i0 = dir == 0 ? lane : 127 - lane, i1 = dir == 0 ? lane + 64 : 63 - lane;
        const float d0 = softplus_f(dtraw[(size_t)(row0 + i0) * 64 + e] + bb), d1 = softplus_f(dtraw[(size_t)(row0 + i1) * 64 + e] + bb);
        float s0 = d0 * aa, s1 = d1 * aa;
#pragma unroll
        for (int o = 1; o < 64; o <<= 1) { const float u0 = __builtin_bit_cast(float, __builtin_amdgcn_ds_bpermute((lane - o) << 2, __builtin_bit_cast(int, s0))), u1 = __builtin_bit_cast(float, __builtin_amdgcn_ds_bpermute((lane - o) << 2, __builtin_bit_cast(int, s1)));
            if (lane >= o) { s0 += u0; s1 += u1; } }
        s1 += __builtin_bit_cast(float, __builtin_amdgcn_readlane(__builtin_bit_cast(int, s0), 63));
        dt[(size_t)(row0 + i0) * 64 + e] = d0; dt[(size_t)(row0 + i1) * 64 + e] = d1;
        acum[(size_t)(row0 + i0) * 64 + e] = s0; acum[(size_t)(row0 + i1) * 64 + e] = s1;
    }
}
__device__ __forceinline__ void rp_ssd_gate(Frame& F, const bf16* y, const bf16* z, const float* gn, bf16* yn) {
    for (int row = F.gw; row < T; row += F.NGW) {
#pragma unroll
        for (int g = 0; g < 4; ++g) { const int c0 = g * 512 + 8 * F.lane; float zz[8], v[8]; ld8(z + (size_t)row * 2048 + c0, zz);
            float yb[8]; ld8(y + (size_t)row * 2048 + c0, v); ld8(y + (size_t)(T + row) * 2048 + c0, yb);
#pragma unroll
            for (int i = 0; i < 8; ++i) v[i] += yb[i];
            float ss = 0.f;
#pragma unroll
            for (int i = 0; i < 8; ++i) { v[i] = v[i] * zz[i] / (1.f + __expf(-zz[i])); ss += v[i] * v[i]; }
            const float r = rsqrtf(wsum(ss, F.lane) * (1.f / 512) + EPS);
#pragma unroll
            for (int i = 0; i < 8; ++i) v[i] = v[i] * r * gn[c0 + i];
            st8(yn + (size_t)row * 2048 + c0, v); }
    }
}

typedef short a_bf16x8 __attribute__((ext_vector_type(8)));
typedef short a_s16x4 __attribute__((ext_vector_type(4)));
typedef float a_f32x16 __attribute__((ext_vector_type(16)));
typedef float a_f32x2 __attribute__((ext_vector_type(2))); typedef __bf16 a_bf16x2 __attribute__((ext_vector_type(2)));
__device__ __forceinline__ unsigned a_cvtpk(float lo, float hi) { a_f32x2 v = {lo, hi}; a_bf16x2 b = __builtin_convertvector(v, a_bf16x2); return __builtin_bit_cast(unsigned, b); }
__device__ __forceinline__ a_s16x4 a_vtr(const LAS unsigned char* p) { return __builtin_bit_cast(a_s16x4, __builtin_amdgcn_ds_read_tr16_b64_v4i16((LAS a_s16x4*)p)); }
constexpr int AT_KS = 208, AT_VS = 192, AT_KB = 64 * AT_KS, AT_VB = 64 * AT_VS, AT_VOFF = 2 * AT_KB;
__device__ __forceinline__ void at_tile(Frame& F, LAS unsigned char* lds, int buf, int lane, const a_bf16x8 (&qf)[6], a_f32x16& o0, a_f32x16& o1, float& m, float& l) {
    const int r32 = lane & 31, hi = lane >> 5;
    a_f32x16 p0, p1;
#pragma unroll
    for (int r = 0; r < 16; ++r) { p0[r] = 0.f; p1[r] = 0.f; }
    { const LAS unsigned char* kp = lds + buf * AT_KB + r32 * AT_KS + hi * 16;
#pragma unroll
      for (int s = 0; s < 6; ++s) { const a_bf16x8 a0 = *(const LAS a_bf16x8*)(kp + 32 * s), a1 = *(const LAS a_bf16x8*)(kp + 32 * AT_KS + 32 * s);
          p0 = __builtin_amdgcn_mfma_f32_32x32x16_bf16(a0, qf[s], p0, 0, 0, 0); p1 = __builtin_amdgcn_mfma_f32_32x32x16_bf16(a1, qf[s], p1, 0, 0, 0); } }

    float mx = fmaxf(p0[0], p1[0]);
#pragma unroll
    for (int r = 1; r < 16; ++r) mx = fmaxf(mx, fmaxf(p0[r], p1[r]));
    mx = fmaxf(mx, shx(mx, lane, 32));
    const float mn = fmaxf(m, mx), alpha = __builtin_amdgcn_exp2f(m - mn); m = mn;
    float ps = 0.f;
#pragma unroll
    for (int r = 0; r < 16; ++r) { p0[r] = __builtin_amdgcn_exp2f(p0[r] - mn); p1[r] = __builtin_amdgcn_exp2f(p1[r] - mn); ps += p0[r] + p1[r]; }
    l = l * alpha + ps;
#pragma unroll
    for (int r = 0; r < 16; ++r) { o0[r] *= alpha; o1[r] *= alpha; }
    v4u pw[4];
    pw[0] = (v4u){a_cvtpk(p0[0], p0[1]), a_cvtpk(p0[2], p0[3]), a_cvtpk(p0[4], p0[5]), a_cvtpk(p0[6], p0[7])};
    pw[1] = (v4u){a_cvtpk(p0[8], p0[9]), a_cvtpk(p0[10], p0[11]), a_cvtpk(p0[12], p0[13]), a_cvtpk(p0[14], p0[15])};
    pw[2] = (v4u){a_cvtpk(p1[0], p1[1]), a_cvtpk(p1[2], p1[3]), a_cvtpk(p1[4], p1[5]), a_cvtpk(p1[6], p1[7])};
    pw[3] = (v4u){a_cvtpk(p1[8], p1[9]), a_cvtpk(p1[10], p1[11]), a_cvtpk(p1[12], p1[13]), a_cvtpk(p1[14], p1[15])};

    const LAS unsigned char* vp0 = lds + AT_VOFF + buf * AT_VB + (4 * hi + ((lane & 15) >> 2)) * AT_VS + (16 * ((lane >> 4) & 1) + 4 * (lane & 3)) * 2;
    a_s16x4 vl0[4], vh0[4], vl1[4], vh1[4];
#pragma unroll
    for (int bs = 0; bs < 4; ++bs) { const LAS unsigned char* vq = vp0 + (16 * bs) * AT_VS; vl0[bs] = a_vtr(vq); vh0[bs] = a_vtr(vq + 8 * AT_VS); vl1[bs] = a_vtr(vq + 64); vh1[bs] = a_vtr(vq + 8 * AT_VS + 64); }
#pragma unroll
    for (int bs = 0; bs < 4; ++bs) {
        const a_bf16x8 v0 = (a_bf16x8){vl0[bs][0], vl0[bs][1], vl0[bs][2], vl0[bs][3], vh0[bs][0], vh0[bs][1], vh0[bs][2], vh0[bs][3]}, v1 = (a_bf16x8){vl1[bs][0], vl1[bs][1], vl1[bs][2], vl1[bs][3], vh1[bs][0], vh1[bs][1], vh1[bs][2], vh1[bs][3]};
        const a_bf16x8 pb = __builtin_bit_cast(a_bf16x8, pw[bs]);
        o0 = __builtin_amdgcn_mfma_f32_32x32x16_bf16(v0, pb, o0, 0, 0, 0); o1 = __builtin_amdgcn_mfma_f32_32x32x16_bf16(v1, pb, o1, 0, 0, 0); }
}
__device__ __forceinline__ void ph_attn(Frame& F, const bf16* Q, const bf16* K, const bf16* KV, bf16* AO) {
    const int lane = F.lane, r32 = lane & 31, hi = lane >> 5, wave = F.wave, tid = F.tid;
    LAS unsigned char* lds = F.lds;
    const int kr_a = tid / 12, kp_a = tid % 12, kr_b = (tid + 512) / 12, kp_b = (tid + 512) % 12, vr = tid >> 3, vp = tid & 7;
    const bool has_b = tid < 256;
    for (int uu = F.vcu; uu < 512; uu += F.G) {
        int head, q0, NT, kbase_ctx, kbase_lat;
        if (uu < 256) { const int seq = uu >> 4; head = uu & 15; q0 = seq * 256; NT = 4; kbase_ctx = seq * 256; kbase_lat = 0; }
        else { const int u2 = uu - 256, b = u2 >> 6, qb = u2 & 3; head = (u2 >> 2) & 15; q0 = TP + b * 1024 + qb * 256; NT = 20; kbase_ctx = T + b * 256; kbase_lat = TP + b * 1024; }
        a_bf16x8 qf[6];
        { const bf16* qp = Q + ((size_t)(q0 + wave * 32 + r32) * 16 + head) * 96 + hi * 8;
#pragma unroll
          for (int s = 0; s < 6; ++s) qf[s] = *(const GAS a_bf16x8*)(qp + 16 * s); }
        a_f32x16 o0, o1;
#pragma unroll
        for (int r = 0; r < 16; ++r) { o0[r] = 0.f; o1[r] = 0.f; }
        float m = -INFINITY, l = 0.f;
        v4u ka0, kb0, vv0, ka1, kb1, vv1, ka2, kb2_, vv2;
#define AT_LOAD(t, KA, KB2, VV) do { const int kr0_ = (t) < 4 ? kbase_ctx + 64 * (t) : kbase_lat + 64 * ((t) - 4); \
            KA = *(const GAS v4u*)(K + ((size_t)(kr0_ + kr_a) * 16 + head) * 96 + kp_a * 8); \
            if (has_b) KB2 = *(const GAS v4u*)(K + ((size_t)(kr0_ + kr_b) * 16 + head) * 96 + kp_b * 8); \
            VV = *(const GAS v4u*)(KV + (size_t)(kr0_ + vr) * 2048 + head * 128 + 64 + vp * 8); } while (0)
#define AT_STORE(buf, KA, KB2, VV) do { *(LAS v4u*)(lds + (buf) * AT_KB + kr_a * AT_KS + kp_a * 16) = KA; \
            if (has_b) *(LAS v4u*)(lds + (buf) * AT_KB + kr_b * AT_KS + kp_b * 16) = KB2; \
            *(LAS v4u*)(lds + AT_VOFF + (buf) * AT_VB + vr * AT_VS + vp * 16) = VV; } while (0)
#define AT_STEP(k, SA, SB, SC, SD_, SE_, SF_, SG, SH, SI) if (t + (k) < NT) { \
            if (t + (k) + 3 < NT) AT_LOAD(t + (k) + 3, SA, SB, SC);            \
            at_tile(F, lds, (k) & 1, lane, qf, o0, o1, m, l); \
            if (t + (k) + 1 < NT) AT_STORE(((k) + 1) & 1, SD_, SE_, SF_);       \
            LDS_BARRIER(); }
        AT_LOAD(0, ka0, kb0, vv0); AT_LOAD(1, ka1, kb1, vv1); AT_LOAD(2, ka2, kb2_, vv2);
        AT_STORE(0, ka0, kb0, vv0);
        LDS_BARRIER();
#pragma unroll 1
        for (int t = 0; t < NT; t += 6) {
            AT_STEP(0, ka0, kb0, vv0, ka1, kb1, vv1, 0, 0, 0)
            AT_STEP(1, ka1, kb1, vv1, ka2, kb2_, vv2, 0, 0, 0)
            AT_STEP(2, ka2, kb2_, vv2, ka0, kb0, vv0, 0, 0, 0)
            AT_STEP(3, ka0, kb0, vv0, ka1, kb1, vv1, 0, 0, 0)
            AT_STEP(4, ka1, kb1, vv1, ka2, kb2_, vv2, 0, 0, 0)
            AT_STEP(5, ka2, kb2_, vv2, ka0, kb0, vv0, 0, 0, 0)
        }
#undef AT_STEP
#undef AT_LOAD
#undef AT_STORE
        l += shx(l, lane, 32);
        const float il = 1.f / l;
        bf16* op = AO + (size_t)(q0 + wave * 32 + r32) * 1024 + head * 64 + 4 * hi;
#pragma unroll
        for (int g4 = 0; g4 < 4; ++g4) {
            v2u w0; w0.x = a_cvtpk(o0[4 * g4] * il, o0[4 * g4 + 1] * il); w0.y = a_cvtpk(o0[4 * g4 + 2] * il, o0[4 * g4 + 3] * il); *(GAS v2u*)(op + 8 * g4) = w0;
            v2u w1; w1.x = a_cvtpk(o1[4 * g4] * il, o1[4 * g4 + 1] * il); w1.y = a_cvtpk(o1[4 * g4 + 2] * il, o1[4 * g4 + 3] * il); *(GAS v2u*)(op + 32 + 8 * g4) = w1; }

    }
}
constexpr int SC_ST = 272, SC_XS = 144;
constexpr int SC_C = 0, SC_B = 128 * SC_ST, SC_M = 2 * 128 * SC_ST, SC_H = 3 * 128 * SC_ST, SC_X = SC_H + 64 * SC_ST, SC_XW = SC_X + 128 * SC_XS, SC_ARR = SC_XW + 128 * SC_XS;
static_assert(SC_ARR + 4 * 128 * 4 + 16 <= PTAB_OFF_C, "scan LDS map");
__device__ __forceinline__ int a_crow(int r, int hi) { return (r & 3) + 8 * (r >> 2) + 4 * hi; }
__device__ __forceinline__ void ph_scan(Frame& F, const bf16* xbc, const float* dt, const float* acg, const float* dsk, const float* st0, bf16* y, float* out) {
    const int lane = F.lane, r32 = lane & 31, hi = lane >> 5, wave = F.wave, tid = F.tid;
    LAS unsigned char* lds = F.lds;
    LAS float* acum = (LAS float*)(lds + SC_ARR); LAS float* wj = acum + 128; LAS float* ei = acum + 256; LAS float* dtj = acum + 384; LAS float* misc = acum + 512;
    const int q4 = (lane & 15) >> 2, gg = (lane >> 4) & 1, p4 = lane & 3;
    const int ib = wave >> 1, pb = wave & 1, nb = wave >> 1;
    v4u cr[4], br[4], xr[2];
    float pdt[2], pac[2], plast, pac_t, pdt_t;
#define SC_GLOADP(rowb_, g_, hd_, dir_) do { const int row0_ = (rowb_); \
        _Pragma("unroll") for (int k = 0; k < 4; ++k) { const int q = tid + 512 * k, rr = q >> 4, pp = q & 15; \
            cr[k] = *(const GAS v4u*)(xbc + (size_t)(row0_ + rr) * 3072 + 2560 + (g_) * 128 + pp * 8); br[k] = *(const GAS v4u*)(xbc + (size_t)(row0_ + rr) * 3072 + 2048 + (g_) * 128 + pp * 8); } \
        _Pragma("unroll") for (int k = 0; k < 2; ++k) { const int q = tid + 512 * k, rr = q >> 3, pp = q & 7; xr[k] = *(const GAS v4u*)(xbc + (size_t)(row0_ + rr) * 3072 + (hd_) * 64 + pp * 8); \
            pdt[k] = dt[(size_t)(row0_ + rr) * 64 + (dir_) * 32 + (hd_)]; pac[k] = acg[(size_t)(row0_ + rr) * 64 + (dir_) * 32 + (hd_)]; } \
        plast = acg[(size_t)(row0_ + ((dir_) == 0 ? 127 : 0)) * 64 + (dir_) * 32 + (hd_)]; \
        pac_t = acg[(size_t)(row0_ + (tid & 127)) * 64 + (dir_) * 32 + (hd_)]; pdt_t = dt[(size_t)(row0_ + (tid & 127)) * 64 + (dir_) * 32 + (hd_)]; } while (0)
#define SC_ITEM(slot_, ii_, seq_, hd_) do { if ((slot_) < 128) { seq_ = 16 + ((slot_) >> 5); hd_ = (slot_) & 31; } else { const int pi_ = 4 * ((slot_) - 128) + (ii_); seq_ = pi_ >> 5; hd_ = pi_ & 31; } } while (0)
    for (int slot = F.vcu; slot < 256; slot += F.G) {
        const int nitem = slot < 128 ? 1 : 4;
        { int seq0, hd0; SC_ITEM(slot, 0, seq0, hd0); SC_GLOADP(seq0 < 16 ? seq0 * 256 : TP + (seq0 - 16) * 1024, hd0 >> 3, hd0, 0); }
#pragma unroll 1
        for (int ii = 0; ii < nitem; ++ii) {
            int seq, hd;
            if (slot < 128) { seq = 16 + (slot >> 5); hd = slot & 31; } else { const int pi = 4 * (slot - 128) + ii; seq = pi >> 5; hd = pi & 31; }
            const int g = hd >> 3, r0 = seq < 16 ? seq * 256 : TP + (seq - 16) * 1024, nc = seq < 16 ? 2 : 8;
#pragma unroll 1
            for (int dir = 0; dir < 2; ++dir) {
                const float dd = dsk[dir * 32 + hd];
                a_f32x16 hacc;
                if (seq < 16) {
#pragma unroll
                    for (int r = 0; r < 16; ++r) hacc[r] = 0.f;
                } else { const float* s0 = st0 + ((((size_t)(seq - 16) * 2 + dir) * 32 + hd) * 64 + 32 * pb + r32) * 128 + 32 * nb + 4 * hi;
#pragma unroll
                    for (int g4 = 0; g4 < 4; ++g4) { const v4f t4 = *(const GAS v4f*)(s0 + 8 * g4); hacc[4 * g4] = t4.x; hacc[4 * g4 + 1] = t4.y; hacc[4 * g4 + 2] = t4.z; hacc[4 * g4 + 3] = t4.w; } }
#pragma unroll
                for (int g4 = 0; g4 < 4; ++g4) { v2u w; w.x = a_cvtpk(hacc[4 * g4], hacc[4 * g4 + 1]); w.y = a_cvtpk(hacc[4 * g4 + 2], hacc[4 * g4 + 3]);
                    *(LAS v2u*)(lds + SC_H + (32 * pb + r32) * SC_ST + (32 * nb + 8 * g4 + 4 * hi) * 2) = w; }
#pragma unroll 1
                for (int cc = 0; cc < nc; ++cc) {
                    const int c = dir == 0 ? cc : nc - 1 - cc, row0 = r0 + c * 128;
                    const int e = dir * 32 + hd;
                    const float last = plast;
                    LDS_BARRIER();
                    if (tid < 128) { const float ac = pac_t, dv = pdt_t;
                        acum[tid] = ac; dtj[tid] = dv; ei[tid] = __expf(ac); if (tid == 0) misc[0] = __expf(last); }
#pragma unroll
                    for (int k = 0; k < 4; ++k) { const int q = tid + 512 * k, rr = q >> 4, pp = q & 15; *(LAS v4u*)(lds + SC_C + rr * SC_ST + pp * 16) = cr[k]; *(LAS v4u*)(lds + SC_B + rr * SC_ST + pp * 16) = br[k]; }
#pragma unroll
                    for (int k = 0; k < 2; ++k) { const int q = tid + 512 * k, rr = q >> 3, pp = q & 7; *(LAS v4u*)(lds + SC_X + rr * SC_XS + pp * 16) = xr[k];
                        const float w = pdt[k] * __expf(last - pac[k]);
                        v4u s; s.x = a_cvtpk(bflo(xr[k].x) * w, bfhi(xr[k].x) * w); s.y = a_cvtpk(bflo(xr[k].y) * w, bfhi(xr[k].y) * w); s.z = a_cvtpk(bflo(xr[k].z) * w, bfhi(xr[k].z) * w); s.w = a_cvtpk(bflo(xr[k].w) * w, bfhi(xr[k].w) * w);
                        *(LAS v4u*)(lds + SC_XW + rr * SC_XS + pp * 16) = s; }
                    { int nrow = 0, nhd = hd, ndir = dir; bool hn = true;
                      if (cc + 1 < nc) nrow = r0 + (dir == 0 ? cc + 1 : nc - 2 - cc) * 128;
                      else if (dir == 0) { nrow = r0 + (nc - 1) * 128; ndir = 1; }
                      else if (ii + 1 < nitem) { int seqn; SC_ITEM(slot, ii + 1, seqn, nhd); nrow = seqn < 16 ? seqn * 256 : TP + (seqn - 16) * 1024; ndir = 0; }
                      else hn = false;
                      if (hn) SC_GLOADP(nrow, nhd >> 3, nhd, ndir); }
                    LDS_BARRIER();
#pragma unroll 1
                    for (int tt = 0; tt < 2; ++tt) {
                        int lt = tt == 0 ? wave : (wave < 2 ? 8 + wave : 10 + (wave - 2));
                        const int ta = lt == 0 ? 0 : lt == 1 ? 0 : lt == 2 ? 0 : lt == 3 ? 0 : lt == 4 ? 1 : lt == 5 ? 1 : lt == 6 ? 1 : lt == 7 ? 2 : lt == 8 ? 2 : lt == 9 ? 3 : lt == 10 ? 1 : lt == 11 ? 2 : lt == 12 ? 2 : lt == 13 ? 3 : lt == 14 ? 3 : 3;
                        const int tb = lt == 0 ? 0 : lt == 1 ? 1 : lt == 2 ? 2 : lt == 3 ? 3 : lt == 4 ? 1 : lt == 5 ? 2 : lt == 6 ? 3 : lt == 7 ? 2 : lt == 8 ? 3 : lt == 9 ? 3 : lt == 10 ? 0 : lt == 11 ? 0 : lt == 12 ? 1 : lt == 13 ? 0 : lt == 14 ? 1 : 2;
                        const int jb = dir == 0 ? ta : tb, ibg = dir == 0 ? tb : ta;
                        const bool dead = lt >= 10;
                        a_f32x16 gt;
#pragma unroll
                        for (int r = 0; r < 16; ++r) gt[r] = 0.f;
                        if (!dead) {
                            const LAS unsigned char* ap = lds + SC_B + (32 * jb + r32) * SC_ST + hi * 16; const LAS unsigned char* bp = lds + SC_C + (32 * ibg + r32) * SC_ST + hi * 16;
#pragma unroll
                            for (int s = 0; s < 8; ++s) gt = __builtin_amdgcn_mfma_f32_32x32x16_bf16(*(const LAS a_bf16x8*)(ap + 32 * s), *(const LAS a_bf16x8*)(bp + 32 * s), gt, 0, 0, 0);
                            const int i = 32 * ibg + r32; const float ai = acum[i];
                            v4f aj[4], dj[4];
#pragma unroll
                            for (int g4 = 0; g4 < 4; ++g4) { aj[g4] = *(const LAS v4f*)(acum + 32 * jb + 8 * g4 + 4 * hi); dj[g4] = *(const LAS v4f*)(dtj + 32 * jb + 8 * g4 + 4 * hi); }
#pragma unroll
                            for (int r = 0; r < 16; ++r) { const int j = 32 * jb + a_crow(r, hi); const bool keep = dir == 0 ? j <= i : j >= i;
                                const float e = __builtin_amdgcn_exp2f(fminf(ai - aj[r >> 2][r & 3], 0.f) * 1.4426950408889634f) * dj[r >> 2][r & 3];
                                gt[r] = keep ? gt[r] * e + (j == i ? dd : 0.f) : 0.f; }
                        }
#pragma unroll
                        for (int g4 = 0; g4 < 4; ++g4) { v2u w; w.x = a_cvtpk(gt[4 * g4], gt[4 * g4 + 1]); w.y = a_cvtpk(gt[4 * g4 + 2], gt[4 * g4 + 3]);
                            *(LAS v2u*)(lds + SC_M + (32 * ibg + r32) * SC_ST + (32 * jb + 8 * g4 + 4 * hi) * 2) = w; }
                    }
                    a_f32x16 yo;
#pragma unroll
                    for (int r = 0; r < 16; ++r) yo[r] = 0.f;
                    { const LAS unsigned char* ap = lds + SC_C + (32 * ib + r32) * SC_ST + hi * 16; const LAS unsigned char* bp = lds + SC_H + (32 * pb + r32) * SC_ST + hi * 16;
#pragma unroll
                      for (int s = 0; s < 8; ++s) yo = __builtin_amdgcn_mfma_f32_32x32x16_bf16(*(const LAS a_bf16x8*)(ap + 32 * s), *(const LAS a_bf16x8*)(bp + 32 * s), yo, 0, 0, 0); }
                    LDS_BARRIER();
                    a_f32x16 yd;
#pragma unroll
                    for (int r = 0; r < 16; ++r) yd[r] = 0.f;
                    { const LAS unsigned char* ap = lds + SC_M + (32 * ib + r32) * SC_ST + hi * 16; const LAS unsigned char* xp = lds + SC_X + (8 * hi + q4) * SC_XS + (32 * pb + 16 * gg + 4 * p4) * 2;
#pragma unroll
                      for (int s = 0; s < 8; ++s) { const a_s16x4 l0 = a_vtr(xp + (16 * s) * SC_XS), h0 = a_vtr(xp + (16 * s + 4) * SC_XS);
                          const a_bf16x8 xb = (a_bf16x8){l0[0], l0[1], l0[2], l0[3], h0[0], h0[1], h0[2], h0[3]};
                          yd = __builtin_amdgcn_mfma_f32_32x32x16_bf16(*(const LAS a_bf16x8*)(ap + 32 * s), xb, yd, 0, 0, 0); } }
                    { bf16* yp = y + (size_t)dir * T * 2048 + (size_t)(row0 + 32 * ib) * 2048 + hd * 64 + 32 * pb + r32;
                      v4f e4[4];
#pragma unroll
                      for (int g4 = 0; g4 < 4; ++g4) e4[g4] = *(const LAS v4f*)(ei + 32 * ib + 8 * g4 + 4 * hi);
#pragma unroll
                      for (int r = 0; r < 16; ++r) { const int i = a_crow(r, hi); const float v = yd[r] + e4[r >> 2][r & 3] * yo[r]; yp[(size_t)i * 2048] = (bf16)f2bf(v); } }
                    { const float dec = misc[0];
#pragma unroll
                      for (int r = 0; r < 16; ++r) hacc[r] *= dec;
                      const LAS unsigned char* bq = lds + SC_B + (8 * hi + q4) * SC_ST + (32 * nb + 16 * gg + 4 * p4) * 2; const LAS unsigned char* xq = lds + SC_XW + (8 * hi + q4) * SC_XS + (32 * pb + 16 * gg + 4 * p4) * 2;
#pragma unroll
                      for (int s = 0; s < 8; ++s) { const a_s16x4 bl = a_vtr(bq + (16 * s) * SC_ST), bh = a_vtr(bq + (16 * s + 4) * SC_ST), xl = a_vtr(xq + (16 * s) * SC_XS), xh = a_vtr(xq + (16 * s + 4) * SC_XS);
                          const a_bf16x8 av = (a_bf16x8){bl[0], bl[1], bl[2], bl[3], bh[0], bh[1], bh[2], bh[3]}, bv = (a_bf16x8){xl[0], xl[1], xl[2], xl[3], xh[0], xh[1], xh[2], xh[3]};
                          hacc = __builtin_amdgcn_mfma_f32_32x32x16_bf16(av, bv, hacc, 0, 0, 0); } }
#pragma unroll
                    for (int g4 = 0; g4 < 4; ++g4) { v2u w; w.x = a_cvtpk(hacc[4 * g4], hacc[4 * g4 + 1]); w.y = a_cvtpk(hacc[4 * g4 + 2], hacc[4 * g4 + 3]);
                        *(LAS v2u*)(lds + SC_H + (32 * pb + r32) * SC_ST + (32 * nb + 8 * g4 + 4 * hi) * 2) = w; }
                }
                if (seq < 16) { float* o = out + OUT_SSM + ((((size_t)seq * 2 + dir) * 32 + hd) * 64 + 32 * pb + r32) * 128 + 32 * nb + 4 * hi;
#pragma unroll
                    for (int g4 = 0; g4 < 4; ++g4) { v4f t4; t4.x = hacc[4 * g4]; t4.y = hacc[4 * g4 + 1]; t4.z = hacc[4 * g4 + 2]; t4.w = hacc[4 * g4 + 3]; *(GAS v4f*)(o + 8 * g4) = t4; } }
            }
        }
    }
#undef SC_GLOADP
#undef SC_ITEM
    LDS_BARRIER();
}

constexpr int NPHASE = 30;
enum Op { OP_P0, OP_NORM1, OP_G_LAT, OP_FIN1, OP_G_QKV, OP_FIN2, OP_ATTN, OP_G_WO, OP_NORM2, OP_G_FF1, OP_G_FF2, OP_G_PW1, OP_DWCONV, OP_G_PW2, OP_G_SSI, OP_SSCONV, OP_SCAN, OP_GATE, OP_G_SSO };
__device__ __forceinline__ void phase_decode(int ph, int& layer, int& op) {
    if (ph == 0) { layer = 0; op = OP_P0; return; }
    if (ph <= 9) { layer = 0; const int r = ph - 1; op = r == 0 ? OP_NORM1 : r == 1 ? OP_G_LAT : r == 2 ? OP_FIN1 : r == 3 ? OP_G_QKV : r == 4 ? OP_FIN2 : r == 5 ? OP_ATTN : r == 6 ? OP_G_WO : r == 7 ? OP_G_FF1 : OP_G_FF2; }
    else if (ph <= 14) { layer = 1; const int r = ph - 10; op = r == 0 ? OP_G_PW1 : r == 1 ? OP_DWCONV : r == 2 ? OP_G_PW2 : r == 3 ? OP_G_FF1 : OP_G_FF2; }
    else if (ph <= 21) { layer = 2; const int r = ph - 15; op = r == 0 ? OP_G_SSI : r == 1 ? OP_SSCONV : r == 2 ? OP_SCAN : r == 3 ? OP_GATE : r == 4 ? OP_G_SSO : r == 5 ? OP_G_FF1 : OP_G_FF2; }
    else { layer = 3; const int r = ph - 22; op = r == 0 ? OP_G_LAT : r == 1 ? OP_FIN1 : r == 2 ? OP_G_QKV : r == 3 ? OP_FIN2 : r == 4 ? OP_ATTN : r == 5 ? OP_G_WO : r == 6 ? OP_G_FF1 : OP_G_FF2; }
}
struct MArgs { const float* in[38]; float* out; unsigned char* ws; int ph_lo, ph_hi; };
constexpr int PTAB_OFF = PTAB_OFF_C;
__global__ void __launch_bounds__(NTHR, 2) mega_fwd(MArgs args) {
    extern __shared__ __attribute__((aligned(16))) unsigned char lds_raw[];
    LAS unsigned char* lds = (LAS unsigned char*)lds_raw;
    volatile LAS unsigned* PT0 = (volatile LAS unsigned*)(lds + PTAB_OFF);
    volatile LAS unsigned* MISC = (volatile LAS unsigned*)(lds + MISC_OFF);
    { const int t0 = threadIdx.x;
      if (t0 < 40) { const unsigned long long p = t0 < 38 ? (unsigned long long)args.in[t0] : t0 == 38 ? (unsigned long long)args.out : (unsigned long long)args.ws;
          PT0[2 * t0] = (unsigned)p; PT0[2 * t0 + 1] = (unsigned)(p >> 32); }
      if (t0 < 64) MISC[t0] = 0u; }
    __syncthreads();
    XcdBarrier bar = xcd_barrier_post((unsigned*)((unsigned char*)ldp(PT0, PT_WS) + WS_CTL) + CW_BAR, MISC + 8);
    const int wave0 = __builtin_amdgcn_readfirstlane(threadIdx.x >> 6);
    const int ph_hi = args.ph_hi;
    for (int ph = args.ph_lo; ph < ph_hi; ++ph) {
        Frame F;
        { int w = wave0; asm volatile("" : "+s"(w)); F.wave = w; }
        F.lds = lds; F.lane = olane(); F.tid = F.wave * 64 + F.lane;
        const int bx = obid();
        F.G = gridDim.x; F.vcu = (F.G % 8 == 0) ? (bx % 8) * (F.G / 8) + bx / 8 : bx;
        F.gw = F.vcu * NWAVES + F.wave; F.NGW = F.G * NWAVES; F.PT = PT0; F.bx = bx;
        int layer, op; phase_decode(ph, layer, op);
        const int j = layer / 3;
        switch (op) {
        case OP_P0: p0_prologue(F); break;
        case OP_NORM1: { unsigned char* ws = WSP; float* x = OUTP; const float* xlo = layer == 0 ? INP(I_XP) : x; const float* xhi = layer == 0 ? INP(I_XS) - (size_t)TP * 1024 : x;
            rp_normmod(F, xlo, xhi, INP(I_GN1) + layer * 1024, (const float*)(ws + WS_MODS) + (size_t)layer * 5 * 6144, 0, 1024, (bf16*)(ws + WS_H)); rp_tables(F); } break;
        case OP_NORM2: { unsigned char* ws = WSP; float* x = OUTP;
            rp_normmod(F, x, x, INP(I_GN2) + layer * 1024, (const float*)(ws + WS_MODS) + (size_t)layer * 5 * 6144, 3072, 4096, (bf16*)(ws + WS_H)); } break;
        case OP_G_LAT: { unsigned char* ws = WSP; pg8::Gemm g{(const bf16*)(ws + WS_H), (const bf16*)(ws + W_MLA + j * MLA_WB + MW_CAT), T, 768, 1024}; pg8::StaticOrder S; S.init(T, 2 * 768, F.G, F.bx);
            const int s_ = 2 * layer; pg8::EpiF32<1> E{(float*)(ws + A_LAT), 768, layer == 0 ? nullptr : (const float*)(ws + WS_STAT) + s_ * 8192, layer == 0 ? nullptr : (const float*)(ws + WS_SW) + (size_t)s_ * 5 * 5632}; pg8::gemm_phase<pg8::EpiF32<1>, pg8::StaticOrder, true, true, true>(F.lds, g, S, E, F.wave); } break;
        case OP_FIN1: { unsigned char* ws = WSP; rp_mla_fin1(F, (const float*)(ws + A_LAT), INP(I_GQ) + j * 384, INP(I_GKV) + j * 256, (bf16*)(ws + A_QN), (bf16*)(ws + WS_CKV + j * CKV_B), OUTP, j); } break;
        case OP_G_QKV: {
#pragma unroll 1
            for (int w = 0; w < 2; ++w) {
                unsigned char* ws = WSP; unsigned char* wm = ws + W_MLA + j * MLA_WB;
                pg8::Gemm g = w == 0 ? pg8::Gemm{(const bf16*)(ws + A_QN), (const bf16*)(wm + MW_UQ), T, 1536, 384} : pg8::Gemm{(const bf16*)(ws + WS_CKV + j * CKV_B), (const bf16*)(wm + MW_UKV), T + NCTX, 2048, 256};
                pg8::StaticOrder S; S.init(g.M, g.N, F.G, w == 0 ? F.bx : (int)((F.bx + 64) % F.G));
                pg8::EpiBf16P E{w == 0 ? (bf16*)(ws + A_QRAW) : (bf16*)(ws + A_KVRAW), g.N};
                pg8::gemm_phase<pg8::EpiBf16P, pg8::StaticOrder, true, true>(F.lds, g, S, E, F.wave);
            } } break;
        case OP_FIN2: { unsigned char* ws = WSP; rp_mla_fin2(F, (const bf16*)(ws + A_QRAW), (const bf16*)(ws + A_KVRAW), (const float*)(ws + A_LAT), INP(I_CKPE) + (size_t)j * 8192, INP(I_GQN) + j * 96, INP(I_GKN) + j * 96,
                                                        (const float*)(ws + WS_ROPE), (bf16*)(ws + A_QB), (bf16*)(ws + A_KB)); } break;
        case OP_ATTN: { unsigned char* ws = WSP; ph_attn(F, (const bf16*)(ws + A_QB), (const bf16*)(ws + A_KB), (const bf16*)(ws + A_KVRAW), (bf16*)(ws + A_AO)); } break;
        case OP_G_WO: case OP_G_PW2: case OP_G_SSO: case OP_G_FF2: {
            unsigned char* ws = WSP; float* x = OUTP;
            const float* rlo = (layer == 0 && op != OP_G_FF2) ? INP(I_XP) : x; const float* rhi = (layer == 0 && op != OP_G_FF2) ? INP(I_XS) - (size_t)TP * 1024 : x;
            pg8::Gemm g; const float* bias = nullptr; int goff = 2048;
            if (op == OP_G_WO) g = pg8::Gemm{(const bf16*)(ws + A_AO), (const bf16*)(ws + W_MLA + j * MLA_WB + MW_O), T, 1024, 1024};
            else if (op == OP_G_PW2) { g = pg8::Gemm{(const bf16*)(ws + A_V), (const bf16*)(ws + W_CV2), T, 1024, 1024}; bias = INP(I_CVB2); }
            else if (op == OP_G_SSO) g = pg8::Gemm{(const bf16*)(ws + A_YN), (const bf16*)(ws + W_SSO), T, 1024, 2048};
            else { g = pg8::Gemm{(const bf16*)(ws + A_ACT), (const bf16*)(ws + W_FF + layer * FF_WB + FW_OUT), T, 1024, 2816}; goff = 5120; }
            pg8::StaticOrder S; S.init(T, 2 * 1024, F.G, F.bx);
            float* xdst = x;
            const int sn_ = 2 * layer + (op == OP_G_FF2 ? 2 : 1);
            pg8::EpiResid<1> E{rlo, rhi, xdst, (const float*)(ws + WS_MODS) + (size_t)layer * 5 * 6144, goff, bias,
                               sn_ < 8 ? (bf16*)(ws + WS_H) : nullptr, (const float*)(ws + WS_GT) + (size_t)(sn_ & 7) * 5 * 1024, (float*)(ws + WS_STAT) + (sn_ & 7) * 8192};
            pg8::gemm_phase<pg8::EpiResid<1>, pg8::StaticOrder, true, true, true>(F.lds, g, S, E, F.wave); } break;
        case OP_G_FF1: { unsigned char* ws = WSP; pg8::Gemm g{(const bf16*)(ws + WS_H), (const bf16*)(ws + W_FF + layer * FF_WB + FW_IN), T, 5632, 1024}; pg8::StaticOrder S; S.init(T, 5632, F.G, F.bx);
            const int s_ = 2 * layer + 1; pg8::EpiGlu<0> E{(bf16*)(ws + A_ACT), 2816, nullptr, 2816, (const float*)(ws + WS_STAT) + s_ * 8192, (const float*)(ws + WS_SW) + (size_t)s_ * 5 * 5632}; pg8::gemm_phase<pg8::EpiGlu<0>, pg8::StaticOrder, true, true>(F.lds, g, S, E, F.wave); } break;
        case OP_G_PW1: { unsigned char* ws = WSP; pg8::Gemm g{(const bf16*)(ws + WS_H), (const bf16*)(ws + W_CV1), T, 2048, 1024}; pg8::StaticOrder S; S.init(T, 2048, F.G, F.bx);
            const int s_ = 2 * layer; pg8::EpiGlu<1> E{(bf16*)(ws + A_U), 1024, INP(I_CVB1), 1024, (const float*)(ws + WS_STAT) + s_ * 8192, (const float*)(ws + WS_SW) + (size_t)s_ * 5 * 5632}; pg8::gemm_phase<pg8::EpiGlu<1>, pg8::StaticOrder, true, true>(F.lds, g, S, E, F.wave); } break;
        case OP_DWCONV: { unsigned char* ws = WSP; rp_dwconv(F, (const bf16*)(ws + A_U), INP(I_CVWD), INP(I_CVBD), INP(I_CVGL), INP(I_CVBL), (bf16*)(ws + A_V)); } break;
        case OP_G_SSI: { unsigned char* ws = WSP; pg8::Gemm g{(const bf16*)(ws + WS_H), (const bf16*)(ws + W_SSI), T, 5376, 1024}; pg8::StaticOrder S; S.init(T, 5376, F.G, F.bx);
            const int s_ = 2 * layer; pg8::EpiSsdIn E{(bf16*)(ws + A_Z), (bf16*)(ws + A_XPRE), (float*)(ws + A_DTRAW), (const float*)(ws + WS_STAT) + s_ * 8192, (const float*)(ws + WS_SW) + (size_t)s_ * 5 * 5632}; pg8::gemm_phase<pg8::EpiSsdIn, pg8::StaticOrder, true, true>(F.lds, g, S, E, F.wave); } break;
        case OP_SSCONV: { unsigned char* ws = WSP; rp_ssd_conv(F, (const bf16*)(ws + A_XPRE), (const float*)(ws + A_DTRAW), INP(I_SSWC), INP(I_SSBC), INP(I_SSDTB), INP(I_SSAL), (bf16*)(ws + A_XBC), (float*)(ws + A_DT), (float*)(ws + A_ACUM)); } break;
        case OP_SCAN: { unsigned char* ws = WSP; ph_scan(F, (const bf16*)(ws + A_XBC), (const float*)(ws + A_DT), (const float*)(ws + A_ACUM), INP(I_SSD), INP(I_SSM), (bf16*)(ws + A_Y), OUTP); } break;
        case OP_GATE: { unsigned char* ws = WSP; rp_ssd_gate(F, (const bf16*)(ws + A_Y), (const bf16*)(ws + A_Z), INP(I_SSGN), (bf16*)(ws + A_YN)); } break;
        default: break;
        }

        if (ph + 1 < ph_hi) xcd_barrier(bar);

    }
}

extern "C" void kernel_launch(void* const* d_in, const int* in_sizes, int n_in, void* d_out, int out_size, void* d_ws, size_t ws_size, hipStream_t stream) {
    static int grid = 0;
    if (grid == 0) {
        int dev = 0, cus = 0;
        if (hipGetDevice(&dev) != hipSuccess || hipDeviceGetAttribute(&cus, hipDeviceAttributeMultiprocessorCount, dev) != hipSuccess) { fprintf(stderr, "kernel_launch: device query failed\n"); grid = -1; return; }
        if (hipFuncSetAttribute((const void*)mega_fwd, hipFuncAttributeMaxDynamicSharedMemorySize, LDS_BYTES) != hipSuccess) { fprintf(stderr, "kernel_launch: hipFuncSetAttribute failed\n"); grid = -1; return; }
        (void)hipGetLastError();
        grid = cus;
    }
    if (grid < 0) return;
    (void)hipMemsetAsync((char*)d_ws + WS_CTL, 0, CTL_ZERO_BYTES, stream);
    MArgs a{};
    for (int i = 0; i < 38; ++i) a.in[i] = (const float*)d_in[i];
    a.out = (float*)d_out; a.ws = (unsigned char*)d_ws;
    a.ph_lo = 0; a.ph_hi = NPHASE;
    hipLaunchKernelGGL(mega_fwd, dim3(grid), dim3(NTHR), LDS_BYTES, stream, a);
}
```

```cpp
#include <hip/hip_runtime.h>
#include <cstdint>
#include <cstdio>

constexpr int DM = 1024, T = 8192, TP = 4096;
constexpr int NCTX = 1024;
constexpr int QL = 384, KVL = 256, ROPE = 32, NOPE = 64, QKD = 96, VH = 64, NH = 16;
constexpr int FFH = 2816;
constexpr int SSI = 2048, SSH = 32, SSP = 64, SSN = 128, SSG = 4, SSCD = 3072, SSIN = 5184;
constexpr float EPS = 1e-6f;
constexpr size_t OUT_YP = 0, OUT_CKV = 8388608, OUT_KPE = 10485760, OUT_SSM = 10747904;

__device__ __forceinline__ int cond_of_row(int r) { return r < TP ? 0 : 1 + ((r - TP) >> 10); }
__device__ __forceinline__ void row_pos(int r, int& t, int& L) { if (r < TP) { t = r & 255; L = 256; } else { t = (r - TP) & 1023; L = 1024; } }
__device__ __forceinline__ float softplus_f(float x) { return fmaxf(x, 0.f) + log1pf(expf(-fabsf(x))); }

__device__ __forceinline__ float rope_inv(int i) { return i == 0 ? 1.f : i == 1 ? 0.31622776601683794f : i == 2 ? 0.1f : i == 3 ? 0.031622776601683794f : i == 4 ? 0.01f : i == 5 ? 0.0031622776601683794f : i == 6 ? 0.001f : 0.00031622776601683794f; }

__device__ __forceinline__ int olane() { int l; asm volatile("v_mbcnt_lo_u32_b32 %0, -1, 0\n\tv_mbcnt_hi_u32_b32 %0, -1, %0" : "=v"(l)); return l; }
__device__ __forceinline__ int obid() { int b = blockIdx.x; asm volatile("" : "+s"(b)); return b; }
namespace pg8 {
#define PG8_LAS __attribute__((address_space(3)))
typedef unsigned short bf16_t;
typedef short bf16x8 __attribute__((ext_vector_type(8)));
typedef float f32x4 __attribute__((ext_vector_type(4)));
typedef unsigned u32x4 __attribute__((ext_vector_type(4)));
constexpr int BM = 256, BK = 64, HALF = 128, HTB = HALF * BK * 2  , STAGE_BYTES = 8 * HTB, NXCD = 8, WGM = 8;

__host__ __device__ __forceinline__ int lds_byte(int r, int c) { const int st = (r >> 4) * 2 + (c >> 5), rr = r & 15, cc = c & 31, ob = rr * 64 + cc * 2; return st * 1024 + (ob ^ (((ob >> 9) & 1) << 5)); }
__host__ __device__ __forceinline__ void stage_rc(int b, int& R, int& C) { const int st = b / 1024, sb = b % 1024, swz = sb ^ (((sb >> 9) & 1) << 5); R = (st >> 1) * 16 + swz / 64; C = (st & 1) * 32 + (swz % 64) / 2; }
__host__ __device__ __forceinline__ int perm32(int rho) { const int n = rho >> 4, i = rho & 15; return 8 * (i >> 2) + 4 * n + (i & 3); }

struct Unit { int pm, pn; };
struct Gemm { const bf16_t* A; const bf16_t* Bt; int M, N, K; };

struct StaticOrder {
    int nM, nN, nwg, G, c;
    __host__ __device__ void init(int M, int N, int G_, int c_) { nM = M / BM; nN = N / BM; nwg = nM * nN; G = G_; c = c_; }
    __host__ __device__ bool next(int i, Unit& u) const {
        const long L = (long)i * G + c; if (L >= nwg) return false;
        int wgid = (int)L; { const int q = nwg / NXCD, r = nwg % NXCD, xcd = wgid % NXCD, off = wgid / NXCD; wgid = (xcd < r ? xcd * (q + 1) : r * (q + 1) + (xcd - r) * q) + off; }
        const int nig = WGM * nN, gid = wgid / nig, fm = gid * WGM, gsz = (nM - fm) < WGM ? (nM - fm) : WGM;
        u.pm = fm + ((wgid % nig) % gsz); u.pn = (wgid % nig) / gsz; return true;
    }
    __device__ __forceinline__ void a_ready(const Unit&) const {}
    __device__ __forceinline__ void done(const Unit&) const {}
};
__device__ __forceinline__ unsigned cvt_pk_bf16(float lo, float hi) { unsigned r; asm("v_cvt_pk_bf16_f32 %0, %1, %2" : "=v"(r) : "v"(lo), "v"(hi)); return r; }
typedef unsigned u32x2 __attribute__((ext_vector_type(2)));
#define PG8_GAS __attribute__((address_space(1)))
__device__ __forceinline__ void st16(void* p, u32x4 v) { *(PG8_GAS u32x4*)p = v; }
__device__ __forceinline__ void st16f(void* p, f32x4 v) { *(PG8_GAS f32x4*)p = v; }
__device__ __forceinline__ void st8(void* p, u32x2 v) { *(PG8_GAS u32x2*)p = v; }
__device__ __forceinline__ f32x4 ld16f(const float* p) { return *(const PG8_GAS f32x4*)p; }
__device__ __forceinline__ float ld4f(const float* p) { return *(const PG8_GAS float*)p; }
__device__ __forceinline__ float fast_sigmoid(float x) { return __builtin_amdgcn_rcpf(1.f + __builtin_amdgcn_exp2f(-1.4426950408889634f * x)); }
__device__ __forceinline__ unsigned cvt_pk_bf16_p(float lo, float hi) { unsigned r; asm("v_cvt_pk_bf16_f32 %0, %1, %2" : "=v"(r) : "v"(lo), "v"(hi)); return r; }
template <int MODE> __device__ __forceinline__ void glu8(const f32x4 a0, const f32x4 g0, const f32x4 a1, const f32x4 g1, f32x4& o0, f32x4& o1) {
    const f32x4 t0 = (MODE == 0 ? a0 : g0) * -1.4426950408889634f, t1 = (MODE == 0 ? a1 : g1) * -1.4426950408889634f;
    f32x4 e0, e1, r0, r1;
#pragma unroll
    for (int j = 0; j < 4; ++j) { e0[j] = __builtin_amdgcn_exp2f(t0[j]); e1[j] = __builtin_amdgcn_exp2f(t1[j]); }
    const f32x4 d0 = e0 + 1.f, d1 = e1 + 1.f;
#pragma unroll
    for (int j = 0; j < 4; ++j) { r0[j] = __builtin_amdgcn_rcpf(d0[j]); r1[j] = __builtin_amdgcn_rcpf(d1[j]); }
    if (MODE == 0) { o0 = a0 * g0 * r0; o1 = a1 * g1 * r1; } else { o0 = a0 * r0; o1 = a1 * r1; }
}

constexpr int SW_LD = 5632;
__device__ __forceinline__ int cond_of_pm(int pm) { return pm < 16 ? 0 : 1 + ((pm - 16) >> 2); }
__device__ __forceinline__ void stage_rstat_sw(const float* rstat, const float* sw, const Unit& u, int slot, int wid, int lane, PG8_LAS unsigned char* tabs) {
    PG8_LAS unsigned char* tab = tabs + slot * 2048;
    if (wid < 4) __builtin_amdgcn_global_load_lds((const unsigned*)(rstat + u.pm * BM + wid * 64 + lane), (PG8_LAS unsigned*)(tab + wid * 256), 4, 0, 0);
    else __builtin_amdgcn_global_load_lds((const unsigned*)(sw + (size_t)cond_of_pm(u.pm) * SW_LD + u.pn * BM + (wid - 4) * 64 + lane), (PG8_LAS unsigned*)(tab + 1024 + (wid - 4) * 256), 4, 0, 0);
}
template <int NBJ> struct EpiF32 {
    static constexpr bool PERM = false, AFTER_DRAIN = false, STAGE_IN = false;
    float* C; int ldc; const float* rstat; const float* sw;
    template <bool HN> __device__ __forceinline__ void body(const f32x4 (&acc)[2][2][4][2], const Unit& u, int wr, int wc) const {
        const int t_ = olane(), fr = t_ & 15, fq = t_ >> 4;
        const int row0 = u.pm * BM + wr * 64 + fr, col0 = u.pn * (HALF * NBJ) + wc * 32 + 4 * fq;
        float rs[2][4]; f32x4 s4[NBJ][2];
#pragma unroll
        for (int ai = 0; ai < 2; ++ai)
#pragma unroll
            for (int m = 0; m < 4; ++m) rs[ai][m] = HN ? ld4f(rstat + row0 + ai * HALF + m * 16) : 1.f;
#pragma unroll
        for (int bj = 0; bj < NBJ; ++bj)
#pragma unroll
            for (int n = 0; n < 2; ++n) s4[bj][n] = HN ? ld16f(sw + (size_t)cond_of_pm(u.pm) * SW_LD + col0 + bj * HALF + n * 16) : (f32x4){0.f, 0.f, 0.f, 0.f};
        if (HN) {
#pragma unroll
            for (int ai = 0; ai < 2; ++ai)
#pragma unroll
                for (int m = 0; m < 4; ++m) rs[ai][m] = __builtin_amdgcn_rsqf(rs[ai][m] * (1.f / 1024) + 1e-6f);
        }
#pragma unroll
        for (int ai = 0; ai < 2; ++ai)
#pragma unroll
            for (int m = 0; m < 4; ++m) { float* rowp = C + (size_t)(row0 + ai * HALF + m * 16) * ldc + col0;
#pragma unroll
                for (int bj = 0; bj < NBJ; ++bj)
#pragma unroll
                    for (int n = 0; n < 2; ++n) { f32x4 v = acc[ai][bj][m][n]; if (HN) v = v * rs[ai][m] + s4[bj][n]; st16f(rowp + bj * HALF + n * 16, v); } }
    }
    __device__ __forceinline__ void operator()(const f32x4 (&acc)[2][2][4][2], const Unit& u, int wr_, int wc_, int fr_, int fq_, const PG8_LAS unsigned char* tab) const {
        (void)fr_; (void)fq_; (void)tab;
        if (rstat) body<true>(acc, u, wr_, wc_); else body<false>(acc, u, wr_, wc_);
    }
};
struct EpiBf16P {
    static constexpr bool PERM = true, AFTER_DRAIN = false, STAGE_IN = false;
    bf16_t* O; int ldc;
    __device__ __forceinline__ void operator()(const f32x4 (&acc)[2][2][4][2], const Unit& u, int wr_, int wc_, int fr_, int fq_, const PG8_LAS unsigned char* tab) const {
        const int t_ = olane(), wr = wr_, wc = wc_, fr = t_ & 15, fq = t_ >> 4; (void)fr_; (void)fq_; (void)tab;
        const int row0 = u.pm * BM + wr * 64 + fr, col0 = u.pn * BM + wc * 32 + 8 * fq;
#pragma unroll
        for (int ai = 0; ai < 2; ++ai)
#pragma unroll
            for (int m = 0; m < 4; ++m) { bf16_t* rowp = O + (size_t)(row0 + ai * HALF + m * 16) * ldc + col0;
#pragma unroll
                for (int bj = 0; bj < 2; ++bj) { const f32x4 v0 = acc[ai][bj][m][0], v1 = acc[ai][bj][m][1]; u32x4 w;
                    w.x = cvt_pk_bf16(v0[0], v0[1]); w.y = cvt_pk_bf16(v0[2], v0[3]); w.z = cvt_pk_bf16(v1[0], v1[1]); w.w = cvt_pk_bf16(v1[2], v1[3]);
                    st16(rowp + bj * HALF, w); } }
    }
};
struct EpiSsdIn {
    static constexpr bool PERM = true, AFTER_DRAIN = false, STAGE_IN = true;
    bf16_t* Z; bf16_t* XP; float* DT; const float* rstat; const float* sw;
    __device__ __forceinline__ void stage_in(const Unit& u, int slot, int wid, int lane, PG8_LAS unsigned char* tabs) const { stage_rstat_sw(rstat, sw, u, slot, wid, lane, tabs); }
    __device__ __forceinline__ void operator()(const f32x4 (&acc)[2][2][4][2], const Unit& u, int wr_, int wc_, int fr_, int fq_, const PG8_LAS unsigned char* tab) const {
        const int t_ = olane(), wr = wr_, wc = wc_, fr = t_ & 15, fq = t_ >> 4; (void)fr_; (void)fq_;
        const int row0 = u.pm * BM + wr * 64 + fr;
        const PG8_LAS float* trs = (const PG8_LAS float*)tab + wr * 64 + fr; const PG8_LAS float* swp = (const PG8_LAS float*)(tab + 1024) + wc * 32 + 8 * fq;
        if (u.pn < 20) {
            bf16_t* base = u.pn < 8 ? Z : XP; const int ld = u.pn < 8 ? 2048 : 3072, colt = (u.pn < 8 ? u.pn : u.pn - 8) * BM, col0 = colt + wc * 32 + 8 * fq;
#pragma unroll
            for (int ai = 0; ai < 2; ++ai)
#pragma unroll
                for (int m = 0; m < 4; ++m) { bf16_t* rowp = base + (size_t)(row0 + ai * HALF + m * 16) * ld + col0;
                    const float rs = __builtin_amdgcn_rsqf(trs[ai * HALF + m * 16] * (1.f / 1024) + 1e-6f);
#pragma unroll
                    for (int bj = 0; bj < 2; ++bj) { const f32x4 v0 = acc[ai][bj][m][0] * rs + *(const PG8_LAS f32x4*)(swp + bj * HALF), v1 = acc[ai][bj][m][1] * rs + *(const PG8_LAS f32x4*)(swp + bj * HALF + 4); u32x4 w;
                        w.x = cvt_pk_bf16(v0[0], v0[1]); w.y = cvt_pk_bf16(v0[2], v0[3]); w.z = cvt_pk_bf16(v1[0], v1[1]); w.w = cvt_pk_bf16(v1[2], v1[3]);
                        st16(rowp + bj * HALF, w); } }
        } else if (wc < 2) {
#pragma unroll
            for (int ai = 0; ai < 2; ++ai)
#pragma unroll
                for (int m = 0; m < 4; ++m) { float* rp = DT + (size_t)(row0 + ai * HALF + m * 16) * 64 + wc * 32 + 8 * fq;
                    const float rs = __builtin_amdgcn_rsqf(trs[ai * HALF + m * 16] * (1.f / 1024) + 1e-6f);
                    st16f(rp, acc[ai][0][m][0] * rs + *(const PG8_LAS f32x4*)swp); st16f(rp + 4, acc[ai][0][m][1] * rs + *(const PG8_LAS f32x4*)(swp + 4)); }
        }
    }
};
template <int MODE> struct EpiGlu {
    static constexpr bool PERM = false, AFTER_DRAIN = false, STAGE_IN = true;
    bf16_t* O; int ldo; const float* bias; int H; const float* rstat; const float* sw;
    __device__ __forceinline__ void stage_in(const Unit& u, int slot, int wid, int lane, PG8_LAS unsigned char* tabs) const { stage_rstat_sw(rstat, sw, u, slot, wid, lane, tabs); }
    __device__ __forceinline__ void operator()(const f32x4 (&acc)[2][2][4][2], const Unit& u, int wr_, int wc_, int fr_, int fq_, const PG8_LAS unsigned char* tab) const {
        const int t_ = olane(), wr = wr_, wc = wc_, fr = t_ & 15, fq = t_ >> 4; (void)fr_; (void)fq_;
        const int row0 = u.pm * BM + wr * 64 + fr;
        float rs[2][4];
#pragma unroll
        for (int ai = 0; ai < 2; ++ai)
#pragma unroll
            for (int m = 0; m < 4; ++m) rs[ai][m] = ((const PG8_LAS float*)tab)[ai * HALF + wr * 64 + m * 16 + fr];
#pragma unroll
        for (int ai = 0; ai < 2; ++ai)
#pragma unroll
            for (int m = 0; m < 4; ++m) rs[ai][m] = __builtin_amdgcn_rsqf(rs[ai][m] * (1.f / 1024) + 1e-6f);
        const unsigned ldb = (unsigned)ldo * 2u;
        unsigned char* Ob = (unsigned char*)O;
        const int f0 = 128 * u.pn + 32 * wc + 8 * fq;
        f32x4 ba[2], bu[2];
#pragma unroll
        for (int bj = 0; bj < 2; ++bj) {
            ba[bj] = (f32x4){0.f, 0.f, 0.f, 0.f}; bu[bj] = ba[bj];
            if (MODE == 1) { ba[bj] = ld16f(bias + f0 + 4 * bj); bu[bj] = ld16f(bias + H + f0 + 4 * bj); }
            const PG8_LAS float* swp = (const PG8_LAS float*)(tab + 1024) + bj * HALF + wc * 32 + 4 * fq; ba[bj] += *(const PG8_LAS f32x4*)swp; bu[bj] += *(const PG8_LAS f32x4*)(swp + 16);
        }
        const unsigned ob = (unsigned)row0 * ldb + (unsigned)f0 * 2u;
#pragma unroll
        for (int ai = 0; ai < 2; ++ai)
#pragma unroll
            for (int m = 0; m < 4; ++m) {
                const f32x4 a0 = acc[ai][0][m][0] * rs[ai][m] + ba[0], g0 = acc[ai][0][m][1] * rs[ai][m] + bu[0];
                const f32x4 a1 = acc[ai][1][m][0] * rs[ai][m] + ba[1], g1 = acc[ai][1][m][1] * rs[ai][m] + bu[1];
                f32x4 o0, o1; glu8<MODE>(a0, g0, a1, g1, o0, o1);
                u32x4 w; w.x = cvt_pk_bf16_p(o0[0], o0[1]); w.y = cvt_pk_bf16_p(o0[2], o0[3]); w.z = cvt_pk_bf16_p(o1[0], o1[1]); w.w = cvt_pk_bf16_p(o1[2], o1[3]);
                st16(Ob + (size_t)(ob + (unsigned)(ai * HALF + m * 16) * ldb), w); }
    }
};
template <int NBJ> struct EpiResid {
    static constexpr bool PERM = true, AFTER_DRAIN = false, STAGE_IN = false;
    const float* xlo; const float* xhi; float* xout; const float* mods_l; int g_off; const float* bias;
    bf16_t* XG; const float* GT; float* stat;
    template <bool HX> __device__ __forceinline__ void body(const f32x4 (&acc)[2][2][4][2], const Unit& u, int wr, int wc) const {
        const int t_ = olane(), fr = t_ & 15, fq = t_ >> 4;
        const int cond = u.pm < 16 ? 0 : 1 + ((u.pm - 16) >> 2);
        const float* gate = mods_l + (size_t)cond * 6144 + g_off; const unsigned char* xin = (const unsigned char*)(u.pm < 16 ? xlo : xhi);
        const int row0 = u.pm * BM + wr * 64 + fr, col0 = u.pn * (HALF * NBJ) + wc * 32 + 8 * fq;
        const unsigned ob = (unsigned)row0 * 4096u + (unsigned)col0 * 4u;
        f32x4 xo[NBJ][2][2][4];
#pragma unroll
        for (int bj = 0; bj < NBJ; ++bj)
#pragma unroll
            for (int n = 0; n < 2; ++n)
#pragma unroll
                for (int ai = 0; ai < 2; ++ai)
#pragma unroll
                    for (int m = 0; m < 4; ++m) xo[bj][n][ai][m] = ld16f((const float*)(xin + (size_t)(ob + (unsigned)((bj * HALF + n * 4) * 4 + (ai * HALF + m * 16) * 4096))));
        const float* gt = HX ? GT + (size_t)cond * 1024 : nullptr;
        f32x4 g4[NBJ][2], b4[NBJ][2], G4[NBJ][2];
#pragma unroll
        for (int bj = 0; bj < NBJ; ++bj)
#pragma unroll
            for (int n = 0; n < 2; ++n) { const int c = col0 + bj * HALF + n * 4; g4[bj][n] = ld16f(gate + c);
                b4[bj][n] = (f32x4){0.f, 0.f, 0.f, 0.f}; if (bias) b4[bj][n] = ld16f(bias + c);
                G4[bj][n] = (f32x4){0.f, 0.f, 0.f, 0.f}; if (HX) G4[bj][n] = ld16f(gt + c); }
        float ss[2][4];
#pragma unroll
        for (int ai = 0; ai < 2; ++ai)
#pragma unroll
            for (int m = 0; m < 4; ++m) ss[ai][m] = 0.f;
        unsigned char* xo_ = (unsigned char*)xout; unsigned char* xg_ = (unsigned char*)XG;
#pragma unroll
        for (int bj = 0; bj < NBJ; ++bj)
#pragma unroll
            for (int ai = 0; ai < 2; ++ai)
#pragma unroll
                for (int m = 0; m < 4; ++m) { const unsigned off = ob + (unsigned)(bj * HALF * 4 + (ai * HALF + m * 16) * 4096);
                    const f32x4 x0 = xo[bj][0][ai][m] + g4[bj][0] * (acc[ai][bj][m][0] + b4[bj][0]), x1 = xo[bj][1][ai][m] + g4[bj][1] * (acc[ai][bj][m][1] + b4[bj][1]);
                    st16f(xo_ + (size_t)off, x0); st16f(xo_ + (size_t)(off + 16u), x1);
                    if (HX) { const f32x4 y0 = x0 * G4[bj][0], y1 = x1 * G4[bj][1]; u32x4 w;
                        w.x = cvt_pk_bf16_p(y0[0], y0[1]); w.y = cvt_pk_bf16_p(y0[2], y0[3]); w.z = cvt_pk_bf16_p(y1[0], y1[1]); w.w = cvt_pk_bf16_p(y1[2], y1[3]); st16(xg_ + (size_t)(off >> 1), w);
                        const f32x4 q = x0 * x0 + x1 * x1; ss[ai][m] += (q[0] + q[1]) + (q[2] + q[3]); } }
        if (HX) {
#pragma unroll
            for (int ai = 0; ai < 2; ++ai)
#pragma unroll
                for (int m = 0; m < 4; ++m) { float s = ss[ai][m];
                    s += __builtin_bit_cast(float, __builtin_amdgcn_ds_bpermute((t_ ^ 16) << 2, __builtin_bit_cast(int, s)));
                    s += __builtin_bit_cast(float, __builtin_amdgcn_ds_bpermute((t_ ^ 32) << 2, __builtin_bit_cast(int, s)));
                    if (fq == 0) atomicAdd(stat + row0 + ai * HALF + m * 16, s); }
        }
    }
    __device__ __forceinline__ void operator()(const f32x4 (&acc)[2][2][4][2], const Unit& u, int wr_, int wc_, int fr_, int fq_, const PG8_LAS unsigned char* tab) const {
        (void)fr_; (void)fq_; (void)tab;
        if (XG) body<true>(acc, u, wr_, wc_); else body<false>(acc, u, wr_, wc_);
    }
};
template <class Epi, class Sched, bool ALIGN_EPI = false, bool SP2 = false, bool HALFN = false>
__device__ __forceinline__ void gemm_phase(PG8_LAS unsigned char* lds, const Gemm g, const Sched& S, const Epi& E, const int wave_in) {
    const int tid = wave_in * 64 + olane(), wid = __builtin_amdgcn_readfirstlane(tid >> 6), lane = tid & 63, wr = wid >> 2, wc = wid & 3, fr = lane & 15, fq = lane >> 4;
    const int K = g.K, nt = K / BK;
    unsigned voffA[2], voffB[2];
#pragma unroll
    for (int i = 0; i < 2; ++i) { int R, C; stage_rc(tid * 16 + i * 8192, R, C); const int Rb = Epi::PERM ? ((R & ~31) + perm32(R & 31)) : R;
        voffA[i] = (unsigned)(R * K + C) * 2u; voffB[i] = (unsigned)(Rb * K + C) * 2u; }
    const size_t kstep = (size_t)(BK * 2);
    const size_t hstep = (size_t)HALF * K * 2;
    const size_t tstep = 2 * hstep;
    const size_t bstep = HALFN ? hstep : tstep;
    static_assert(!HALFN || SP2, "HALFN is written for the SP2 loop only");
    const unsigned ldsw = (unsigned)wid * 1024u;
    const int aoff = lds_byte(wr * 64 + fr, fq * 8), boff = lds_byte(wc * 32 + fr, fq * 8);
#define PG8_SA(b, h) (((b) * 2 + (h)) * HTB)
#define PG8_SB(b, h) ((4 + (b) * 2 + (h)) * HTB)
#define PG8_STAGE(bufoff, gbase, voff) do { _Pragma("unroll") for (int _i = 0; _i < 2; ++_i) \
        __builtin_amdgcn_global_load_lds((const unsigned*)((const char*)(gbase) + (voff)[_i]), (PG8_LAS unsigned*)(lds + (bufoff) + ldsw + _i * 8192), 16, 0, 0); } while (0)
#define PG8_LDA(dst, b, h) do { _Pragma("unroll") for (int m = 0; m < 4; ++m) _Pragma("unroll") for (int k = 0; k < 2; ++k) dst[m][k] = *(const PG8_LAS bf16x8*)(lds + PG8_SA(b, h) + aoff + m * 2048 + k * 1024); } while (0)
#define PG8_LDB(dst, b, h) do { _Pragma("unroll") for (int n = 0; n < 2; ++n) _Pragma("unroll") for (int k = 0; k < 2; ++k) dst[n][k] = *(const PG8_LAS bf16x8*)(lds + PG8_SB(b, h) + boff + n * 2048 + k * 1024); } while (0)
#define PG8_MMA(ai, bj, At, Bt) do { __builtin_amdgcn_s_setprio(1); _Pragma("unroll") for (int m = 0; m < 4; ++m) _Pragma("unroll") for (int n = 0; n < 2; ++n) _Pragma("unroll") for (int k = 0; k < 2; ++k) \
        acc[ai][bj][m][n] = __builtin_amdgcn_mfma_f32_16x16x32_bf16(Bt[n][k], At[m][k], acc[ai][bj][m][n], 0, 0, 0); __builtin_amdgcn_s_setprio(0); } while (0)
#define PG8_WAIT_V(n) asm volatile("s_waitcnt vmcnt(" #n ")" ::: "memory")
#define PG8_WAIT_L(n) asm volatile("s_waitcnt lgkmcnt(" #n ")" ::: "memory")
#define PG8_BAR __builtin_amdgcn_s_barrier()
#define PG8_SCHED __builtin_amdgcn_sched_barrier(0)
    Unit cur, nxt; int ui = 0;
    if (!S.next(0, cur)) return;
    f32x4 acc[2][2][4][2];
#pragma unroll
    for (int a = 0; a < 2; ++a)
#pragma unroll
        for (int b = 0; b < 2; ++b)
#pragma unroll
            for (int m = 0; m < 4; ++m)
#pragma unroll
                for (int n = 0; n < 2; ++n) acc[a][b][m][n] = (f32x4){0.f, 0.f, 0.f, 0.f};
    bf16x8 At[4][2], B0[2][2], B1[2][2];
    const char* cA = (const char*)g.A + (size_t)cur.pm * tstep; const char* cB = (const char*)g.Bt + (size_t)cur.pn * bstep;
    S.a_ready(cur);
    if constexpr (Epi::STAGE_IN) E.stage_in(cur, 0, wid, lane, lds + STAGE_BYTES);
    if constexpr (HALFN) {
        PG8_STAGE(PG8_SB(0, 0), cB, voffB); PG8_STAGE(PG8_SA(0, 0), cA, voffA); PG8_STAGE(PG8_SA(0, 1), cA + hstep, voffA);
        if (wr == 1) PG8_BAR;
        PG8_WAIT_V(2); PG8_BAR;
        PG8_STAGE(PG8_SB(1, 0), cB + kstep, voffB); PG8_STAGE(PG8_SA(1, 0), cA + kstep, voffA);
        PG8_WAIT_V(4); PG8_BAR;
    } else if constexpr (SP2) {
        PG8_STAGE(PG8_SB(0, 0), cB, voffB); PG8_STAGE(PG8_SB(0, 1), cB + hstep, voffB); PG8_STAGE(PG8_SA(0, 0), cA, voffA); PG8_STAGE(PG8_SA(0, 1), cA + hstep, voffA);
        if (wr == 1) PG8_BAR;
        PG8_WAIT_V(2); PG8_BAR;
        PG8_STAGE(PG8_SB(1, 0), cB + kstep, voffB); PG8_STAGE(PG8_SA(1, 0), cA + kstep, voffA); PG8_STAGE(PG8_SB(1, 1), cB + hstep + kstep, voffB);
        PG8_WAIT_V(6); PG8_BAR;
    } else {
        PG8_STAGE(PG8_SB(0, 0), cB, voffB); PG8_STAGE(PG8_SA(0, 0), cA, voffA); PG8_STAGE(PG8_SB(0, 1), cB + hstep, voffB); PG8_STAGE(PG8_SA(0, 1), cA + hstep, voffA);
        if (wr == 1) PG8_BAR;
        PG8_WAIT_V(4); PG8_BAR;
        PG8_STAGE(PG8_SB(1, 0), cB + kstep, voffB); PG8_STAGE(PG8_SA(1, 0), cA + kstep, voffA); PG8_STAGE(PG8_SB(1, 1), cB + hstep + kstep, voffB);
        PG8_WAIT_V(6); PG8_BAR;
    }
    for (;;) {
        const bool has_next = S.next(ui + 1, nxt);
        const char* nA = has_next ? (const char*)g.A + (size_t)nxt.pm * tstep : cA; const char* nB = has_next ? (const char*)g.Bt + (size_t)nxt.pn * bstep : cB;
        for (int t = 0; t < nt; t += 2) {
            const bool last = (t == nt - 2);
            const char* a1 = cA + (size_t)(t + 1) * kstep;
            const char* a2 = last ? nA : cA + (size_t)(t + 2) * kstep; const char* b2 = last ? nB : cB + (size_t)(t + 2) * kstep;
            const char* a3 = a2 + kstep; const char* b3 = b2 + kstep;
            if (last && has_next) S.a_ready(nxt);
            if constexpr (Epi::STAGE_IN) { if (last && has_next) E.stage_in(nxt, (ui + 1) & 1, wid, lane, lds + STAGE_BYTES); }
            if constexpr (HALFN) {
            PG8_LDB(B0, 0, 0); PG8_SCHED; PG8_LDA(At, 0, 0); PG8_STAGE(PG8_SA(1, 1), a1 + hstep, voffA);
            PG8_WAIT_V(6); PG8_WAIT_L(0); PG8_BAR; PG8_MMA(0, 0, At, B0); PG8_BAR; PG8_SCHED;
            PG8_LDA(At, 0, 1); PG8_STAGE(PG8_SB(0, 0), b2, voffB); PG8_STAGE(PG8_SA(0, 0), a2, voffA);
            PG8_WAIT_V(6); PG8_WAIT_L(0); PG8_BAR; PG8_MMA(1, 0, At, B0); PG8_BAR; PG8_SCHED;
            PG8_LDB(B0, 1, 0); PG8_SCHED; PG8_LDA(At, 1, 0); PG8_STAGE(PG8_SA(0, 1), a2 + hstep, voffA);
            PG8_WAIT_V(6); PG8_WAIT_L(0); PG8_BAR; PG8_MMA(0, 0, At, B0); PG8_BAR; PG8_SCHED;
            PG8_LDA(At, 1, 1); PG8_STAGE(PG8_SB(1, 0), b3, voffB); PG8_STAGE(PG8_SA(1, 0), a3, voffA);
            PG8_WAIT_V(6); PG8_WAIT_L(0); PG8_BAR; PG8_MMA(1, 0, At, B0); PG8_BAR; PG8_SCHED;
            } else if constexpr (SP2) {
            PG8_LDB(B0, 0, 0); PG8_LDB(B1, 0, 1); PG8_SCHED; PG8_LDA(At, 0, 0); PG8_STAGE(PG8_SA(1, 1), a1 + hstep, voffA);
            PG8_WAIT_V(8); PG8_WAIT_L(0); PG8_BAR; PG8_MMA(0, 0, At, B0); PG8_MMA(0, 1, At, B1); PG8_BAR; PG8_SCHED;
            PG8_LDA(At, 0, 1); PG8_STAGE(PG8_SB(0, 0), b2, voffB); PG8_STAGE(PG8_SB(0, 1), b2 + hstep, voffB); PG8_STAGE(PG8_SA(0, 0), a2, voffA);
            PG8_WAIT_V(8); PG8_WAIT_L(0); PG8_BAR; PG8_MMA(1, 0, At, B0); PG8_MMA(1, 1, At, B1); PG8_BAR; PG8_SCHED;
            PG8_LDB(B0, 1, 0); PG8_LDB(B1, 1, 1); PG8_SCHED; PG8_LDA(At, 1, 0); PG8_STAGE(PG8_SA(0, 1), a2 + hstep, voffA);
            PG8_WAIT_V(8); PG8_WAIT_L(0); PG8_BAR; PG8_MMA(0, 0, At, B0); PG8_MMA(0, 1, At, B1); PG8_BAR; PG8_SCHED;
            PG8_LDA(At, 1, 1); PG8_STAGE(PG8_SB(1, 0), b3, voffB); PG8_STAGE(PG8_SB(1, 1), b3 + hstep, voffB); PG8_STAGE(PG8_SA(1, 0), a3, voffA);
            PG8_WAIT_V(8); PG8_WAIT_L(0); PG8_BAR; PG8_MMA(1, 0, At, B0); PG8_MMA(1, 1, At, B1); PG8_BAR; PG8_SCHED;
            } else {
            PG8_LDB(B0, 0, 0); PG8_SCHED; PG8_LDA(At, 0, 0); PG8_STAGE(PG8_SA(1, 1), a1 + hstep, voffA);
            PG8_WAIT_L(8); PG8_BAR; PG8_WAIT_L(0); PG8_MMA(0, 0, At, B0); PG8_BAR; PG8_SCHED;
            PG8_LDB(B1, 0, 1); PG8_STAGE(PG8_SB(0, 0), b2, voffB);
            PG8_BAR; PG8_WAIT_L(0); PG8_MMA(0, 1, At, B1); PG8_BAR;
            PG8_LDA(At, 0, 1); PG8_STAGE(PG8_SA(0, 0), a2, voffA);
            PG8_BAR; PG8_WAIT_L(0); PG8_MMA(1, 0, At, B0); PG8_BAR; PG8_SCHED;
            PG8_STAGE(PG8_SB(0, 1), b2 + hstep, voffB);
            PG8_WAIT_V(6); PG8_BAR; PG8_MMA(1, 1, At, B1); PG8_BAR;
            PG8_LDB(B0, 1, 0); PG8_SCHED; PG8_LDA(At, 1, 0); PG8_STAGE(PG8_SA(0, 1), a2 + hstep, voffA);
            PG8_WAIT_L(8); PG8_BAR; PG8_WAIT_L(0); PG8_MMA(0, 0, At, B0); PG8_BAR; PG8_SCHED;
            PG8_LDB(B1, 1, 1); PG8_STAGE(PG8_SB(1, 0), b3, voffB);
            PG8_BAR; PG8_WAIT_L(0); PG8_MMA(0, 1, At, B1); PG8_BAR;
            PG8_LDA(At, 1, 1); PG8_STAGE(PG8_SA(1, 0), a3, voffA);
            PG8_BAR; PG8_WAIT_L(0); PG8_MMA(1, 0, At, B0); PG8_BAR; PG8_SCHED;
            PG8_STAGE(PG8_SB(1, 1), b3 + hstep, voffB);
            PG8_WAIT_V(6); PG8_BAR; PG8_MMA(1, 1, At, B1); PG8_BAR;
            }
        }
        if constexpr (ALIGN_EPI) { if (wr == 0) PG8_BAR; }
        if constexpr (!Epi::AFTER_DRAIN) { E(acc, cur, wr, wc, fr, fq, lds + STAGE_BYTES + (ui & 1) * 2048); S.done(cur); }
        if (!has_next) break;
#pragma unroll
        for (int a = 0; a < 2; ++a)
#pragma unroll
            for (int b = 0; b < 2; ++b)
#pragma unroll
                for (int m = 0; m < 4; ++m)
#pragma unroll
                    for (int n = 0; n < 2; ++n) acc[a][b][m][n] = (f32x4){0.f, 0.f, 0.f, 0.f};
        cur = nxt; cA = nA; cB = nB; ++ui;
        if constexpr (ALIGN_EPI) { if (wr == 1) PG8_BAR; }
    }
    PG8_WAIT_V(0);
    if constexpr (!ALIGN_EPI) { if (wr == 0) PG8_BAR; }
    PG8_BAR;
    if constexpr (Epi::AFTER_DRAIN) { E.fused(acc, cur, wr, wc, fr, fq, lds, wid, lane); S.done(cur); }
#undef PG8_SA
#undef PG8_SB
#undef PG8_STAGE
#undef PG8_LDA
#undef PG8_LDB
#undef PG8_MMA
#undef PG8_WAIT_V
#undef PG8_WAIT_L
#undef PG8_BAR
#undef PG8_SCHED
}
}
constexpr int NWAVES = 8, NTHR = 512;
constexpr size_t MiB = 1u << 20;
constexpr size_t WS_CTL = 0, CTL_ZERO_BYTES = 1 * MiB;
constexpr size_t WS_MODS = 256 * 1024;
constexpr size_t WS_STAT = 768 * 1024;
constexpr size_t WS_SW = 372 * MiB, WS_GT = 374 * MiB;
constexpr size_t WS_ROPE = 1 * MiB;
constexpr size_t WS_W = 2 * MiB;
constexpr size_t W_MLA = WS_W, MLA_WB = 5898240;
constexpr size_t MW_CAT = 0, MW_UQ = 1572864, MW_UKV = 2752512, MW_O = 3801088;
constexpr size_t W_CV1 = WS_W + 2 * MLA_WB, W_CV2 = W_CV1 + 4 * MiB;
constexpr size_t W_SSI = W_CV2 + 2 * MiB, W_SSO = W_SSI + 11010048;
constexpr size_t W_FF = W_SSO + 4 * MiB, FF_WB = 17301504, FW_IN = 0, FW_OUT = 11534336;
static_assert(W_FF + 4 * FF_WB <= 102 * MiB, "weights region");
constexpr size_t WS_H = 102 * MiB;
constexpr size_t WS_CKV = 118 * MiB, CKV_B = (size_t)(T + NCTX) * KVL * 2;
constexpr size_t WS_AR = 128 * MiB;
constexpr size_t A_LAT = WS_AR, A_QN = A_LAT + 24 * MiB, A_QRAW = A_QN + 6 * MiB, A_KVRAW = A_QRAW + 24 * MiB, A_QB = A_KVRAW + 36 * MiB, A_KB = A_QB + 24 * MiB, A_AO = A_KB + 27 * MiB;
constexpr size_t A_U = WS_AR, A_V = A_U + 16 * MiB;
constexpr size_t A_Z = WS_AR, A_XPRE = A_Z + 32 * MiB, A_DTRAW = A_XPRE + 48 * MiB, A_XBC = A_DTRAW + 2 * MiB, A_DT = A_XBC + 48 * MiB, A_Y = A_DT + 2 * MiB, A_YN = A_XPRE, A_ACUM = A_Y + 64 * MiB;
constexpr size_t A_ACT = WS_AR + 200 * MiB;
static_assert(A_AO + 16 * MiB <= A_ACT && A_ACUM + 2 * MiB <= A_ACT && A_ACT + 44 * MiB <= 384 * MiB, "arena map");
constexpr int CW_BAR = 4096;
constexpr int LDS_BYTES = 163840, RING_BYTES = 131072, MISC_OFF = 163840 - 256, PTAB_OFF_C = MISC_OFF - 512;

#define GAS __attribute__((address_space(1)))
#define LAS __attribute__((address_space(3)))
typedef unsigned short bf16;
typedef unsigned v4u __attribute__((ext_vector_type(4)));
typedef unsigned v2u __attribute__((ext_vector_type(2)));
typedef float v4f __attribute__((ext_vector_type(4)));
typedef float v2f __attribute__((ext_vector_type(2)));
typedef GAS unsigned gu32;
#define LDS_WAIT() asm volatile("s_waitcnt lgkmcnt(0)" ::: "memory")
#define LDS_BARRIER() do { asm volatile("s_waitcnt lgkmcnt(0)" ::: "memory"); __builtin_amdgcn_s_barrier(); asm volatile("" ::: "memory"); } while (0)
#define VM_WAIT() asm volatile("s_waitcnt vmcnt(0)" ::: "memory")
__device__ __forceinline__ unsigned f2bf(float f) { unsigned u = __builtin_bit_cast(unsigned, f); return (u + 0x7fffu + ((u >> 16) & 1u)) >> 16; }
__device__ __forceinline__ unsigned pk2(float lo, float hi) { unsigned r; asm("v_cvt_pk_bf16_f32 %0, %1, %2" : "=v"(r) : "v"(lo), "v"(hi)); return r; }
__device__ __forceinline__ float fast_sig(float x) { return __builtin_amdgcn_rcpf(1.f + __builtin_amdgcn_exp2f(-1.4426950408889634f * x)); }
__device__ __forceinline__ float bflo(unsigned u) { return __builtin_bit_cast(float, u << 16); }
__device__ __forceinline__ float bfhi(unsigned u) { return __builtin_bit_cast(float, u & 0xffff0000u); }
__device__ __forceinline__ float bf2f(bf16 b) { return __builtin_bit_cast(float, (unsigned)b << 16); }

#define XB_TMO      128
#define XB_XCNT(j)  (256  + 64 * (j))
#define XB_XSUB(j)  (1280 + 64 * (j))
#define XB_XGEN(j)  (2304 + 64 * (j))
#define XB_TOP      3328
#define XB_TOPGEN   3392
#define XCD_BAR_WORDS 3456
#define XB_SPIN_CAP (1u << 18)

__device__ __forceinline__ unsigned xb_ld(unsigned* p)              { return __hip_atomic_load(p, __ATOMIC_RELAXED, __HIP_MEMORY_SCOPE_AGENT); }
__device__ __forceinline__ unsigned xb_add(unsigned* p, unsigned v) { return __hip_atomic_fetch_add(p, v, __ATOMIC_RELAXED, __HIP_MEMORY_SCOPE_AGENT); }
__device__ __forceinline__ unsigned xb_xcc_id() { return (unsigned)__builtin_amdgcn_s_getreg((3 << 11) | 20) & 0xFu; }
#define XB_SPIN(cond, bar) do { unsigned _sp = 0; while (cond) { __builtin_amdgcn_s_sleep(1); \
    if ((++_sp & 255u) == 0u) { if (xb_ld(&(bar)[XB_TMO])) break; if (_sp > XB_SPIN_CAP) { atomicAdd(&(bar)[XB_TMO], 1u); break; } } } } while (0)

struct XcdBarrier {
    unsigned* bar; unsigned x;
    volatile LAS unsigned* st;
};

__device__ __forceinline__ XcdBarrier xcd_barrier_post(unsigned* bar, volatile LAS unsigned* st) {
    XcdBarrier b; b.bar = bar; b.x = xb_xcc_id(); b.st = st;
    if (threadIdx.x == 0) (void)xb_add(&bar[XB_XCNT(b.x)], 1u);
    return b;
}
__device__ __forceinline__ void xcd_barrier_complete(unsigned* bar, unsigned x, unsigned& nloc, unsigned& nx) {
    const unsigned G = gridDim.x * gridDim.y * gridDim.z;
    unsigned sum, cnt, mine, sp = 0u;
    for (;;) {
        sum = 0u; cnt = 0u; mine = 0u;
#pragma unroll
        for (unsigned j = 0; j < 16; j += 8) {
            unsigned c[8]; const unsigned* p = bar + XB_XCNT(j);
            asm volatile("global_load_dword %0, %8, off sc1\n\tglobal_load_dword %1, %8, off offset:256 sc1\n\tglobal_load_dword %2, %8, off offset:512 sc1\n\tglobal_load_dword %3, %8, off offset:768 sc1\n\t"
                         "global_load_dword %4, %8, off offset:1024 sc1\n\tglobal_load_dword %5, %8, off offset:1280 sc1\n\tglobal_load_dword %6, %8, off offset:1536 sc1\n\tglobal_load_dword %7, %8, off offset:1792 sc1\n\t"
                         "s_waitcnt vmcnt(0)"
                         : "=&v"(c[0]), "=&v"(c[1]), "=&v"(c[2]), "=&v"(c[3]), "=&v"(c[4]), "=&v"(c[5]), "=&v"(c[6]), "=&v"(c[7]) : "v"(p) : "memory");
#pragma unroll
            for (unsigned i = 0; i < 8; ++i) { sum += c[i]; cnt += (c[i] > 0u) ? 1u : 0u; mine = (j + i == x) ? c[i] : mine; } }
        if (sum == G) break;
        __builtin_amdgcn_s_sleep(1);
        if ((++sp & 255u) == 0u) { if (xb_ld(&bar[XB_TMO])) break; if (sp > XB_SPIN_CAP) { atomicAdd(&bar[XB_TMO], 1u); break; } }
    }
    nloc = mine > 0u ? mine : 1u; nx = cnt > 0u ? cnt : 1u;
}

__device__ __forceinline__ void xcd_barrier(const XcdBarrier& b) {
    asm volatile("s_waitcnt vmcnt(0)" ::: "memory");
    __syncthreads();
    if (threadIdx.x == 0) {
        unsigned* bar = b.bar;
        __builtin_amdgcn_s_waitcnt(0);
        unsigned nloc = b.st[0], nx = b.st[1];
        if (nloc == 0u) { xcd_barrier_complete(bar, b.x, nloc, nx); b.st[0] = nloc; b.st[1] = nx; }
        const unsigned old = xb_add(&bar[XB_XSUB(b.x)], 1u);
        const unsigned gen = old / nloc;
        if (old + 1u == (gen + 1u) * nloc) {
            __builtin_amdgcn_fence(__ATOMIC_RELEASE, "agent");
            asm volatile("s_waitcnt vmcnt(0)" ::: "memory");
            const unsigned og = xb_add(&bar[XB_TOP], 1u);
            const unsigned tg = og / nx;
            if (og + 1u == (tg + 1u) * nx) xb_add(&bar[XB_TOPGEN], 1u);
            else XB_SPIN(xb_ld(&bar[XB_TOPGEN]) == tg, bar);
            __builtin_amdgcn_fence(__ATOMIC_ACQUIRE, "agent");
            xb_add(&bar[XB_XGEN(b.x)], 1u);
            asm volatile("s_waitcnt vmcnt(0)" ::: "memory");
        } else {
            XB_SPIN(xb_ld(&bar[XB_XGEN(b.x)]) == gen, bar);
            __builtin_amdgcn_fence(__ATOMIC_ACQUIRE, "agent");
            asm volatile("s_waitcnt vmcnt(0)" ::: "memory");
        }
    }
    __syncthreads();
}

struct Frame {
    LAS unsigned char* lds; int tid, lane, wave, vcu, G, gw, NGW, bx;
    volatile LAS unsigned* PT;
};
constexpr int PT_OUT = 38, PT_WS = 39;
__device__ __forceinline__ const float* ldp(volatile LAS unsigned* PT, int k) {
    const unsigned lo = __builtin_amdgcn_readfirstlane(PT[2 * k]), hi = __builtin_amdgcn_readfirstlane(PT[2 * k + 1]);
    return (const float*)(((unsigned long long)hi << 32) | lo);
}
#define INP(k) ldp(F.PT, (k))
#define WSP ((unsigned char*)ldp(F.PT, PT_WS))
#define OUTP ((float*)ldp(F.PT, PT_OUT))
enum InIdx { I_XP = 0, I_XS, I_CCKV, I_CKPE, I_SSM, I_C, I_CCTX, I_WADA, I_BADA, I_GN1, I_GN2, I_WDQ, I_GQ, I_WUQ, I_WDKV, I_GKV, I_WUKV, I_GQN, I_GKN, I_WO,
             I_CVW1, I_CVB1, I_CVWD, I_CVBD, I_CVGL, I_CVBL, I_CVW2, I_CVB2, I_SSWI, I_SSWC, I_SSBC, I_SSDTB, I_SSAL, I_SSD, I_SSGN, I_SSWO, I_FFWI, I_FFWO };
__device__ __forceinline__ float shx(float v, int lane, int o) { return __builtin_bit_cast(float, __builtin_amdgcn_ds_bpermute((lane ^ o) << 2, __builtin_bit_cast(int, v))); }
__device__ __forceinline__ float wsum(float v, int lane) {
#pragma unroll
    for (int o = 1; o < 64; o <<= 1) v += shx(v, lane, o);
    return v;
}
constexpr float QSCALE = 0.10206207261596577f * 1.4426950408889634f;

struct P0Item { const float* W; bf16* WT; int K, N, mode, H, roff, k0, n0; };
__device__ __forceinline__ void p0_item_load(const P0Item& J, int lane, v4f (&t)[8]) {
#pragma unroll
    for (int i = 0; i < 8; ++i) t[i] = *(const GAS v4f*)(J.W + (size_t)(J.k0 + 8 * i + (lane >> 3)) * J.N + J.n0 + 4 * (lane & 7));
}
__device__ __forceinline__ void p0_item_finish(const P0Item& J, int lane, const v4f (&t)[8], LAS float* scr) {
#pragma unroll
    for (int i = 0; i < 8; ++i) { LAS float* d = scr + (8 * i + (lane >> 3)) * 33 + 4 * (lane & 7); d[0] = t[i].x; d[1] = t[i].y; d[2] = t[i].z; d[3] = t[i].w; }
    LDS_WAIT(); asm volatile("" ::: "memory");
    const int c = lane & 7;
#pragma unroll
    for (int j = 0; j < 4; ++j) { const int n = (lane >> 3) + 8 * j, col = J.n0 + n; const LAS float* s = scr + (8 * c) * 33 + n;
        int drow;
        if (J.mode == 0) drow = J.roff + col;
        else { const int f = col < J.H ? col : col - J.H; drow = 256 * (f >> 7) + 128 * ((f >> 2) & 1) + 32 * ((f >> 5) & 3) + (col < J.H ? 0 : 16) + 4 * ((f >> 3) & 3) + (f & 3); }
        v4u o; o.x = pk2(s[0 * 33], s[1 * 33]); o.y = pk2(s[2 * 33], s[3 * 33]); o.z = pk2(s[4 * 33], s[5 * 33]); o.w = pk2(s[6 * 33], s[7 * 33]);
        *(GAS v4u*)(J.WT + (size_t)drow * J.K + J.k0 + 8 * c) = o; }
    LDS_WAIT(); asm volatile("" ::: "memory");
}
__device__ __forceinline__ void p0_job(int q, int& inp, size_t& soff, int& K, int& N, size_t& doff, int& mode, int& H, int& roff) {
    mode = 0; H = 0; roff = 0; soff = 0;
    if (q < 10) { const int j = q / 5, t = q % 5; const size_t wb = W_MLA + (size_t)j * MLA_WB;
        if (t == 0) { inp = I_WDQ; soff = (size_t)j * 1024 * 384; K = 1024; N = 384; doff = wb + MW_CAT; }
        else if (t == 1) { inp = I_WDKV; soff = (size_t)j * 1024 * 288; K = 1024; N = 288; doff = wb + MW_CAT; roff = 384; }
        else if (t == 2) { inp = I_WUQ; soff = (size_t)j * 384 * 1536; K = 384; N = 1536; doff = wb + MW_UQ; }
        else if (t == 3) { inp = I_WUKV; soff = (size_t)j * 256 * 2048; K = 256; N = 2048; doff = wb + MW_UKV; }
        else { inp = I_WO; soff = (size_t)j * 1024 * 1024; K = 1024; N = 1024; doff = wb + MW_O; } }
    else if (q == 10) { inp = I_CVW1; K = 1024; N = 2048; doff = W_CV1; mode = 1; H = 1024; }
    else if (q == 11) { inp = I_CVW2; K = 1024; N = 1024; doff = W_CV2; }
    else if (q == 12) { inp = I_SSWI; K = 1024; N = 5184; doff = W_SSI; }
    else if (q == 13) { inp = I_SSWO; K = 2048; N = 1024; doff = W_SSO; }
    else { const int l = (q - 14) >> 1, t = (q - 14) & 1;
        if (t == 0) { inp = I_FFWI; soff = (size_t)l * 1024 * 5632; K = 1024; N = 5632; doff = W_FF + (size_t)l * FF_WB + FW_IN; mode = 1; H = 2816; }
        else { inp = I_FFWO; soff = (size_t)l * 2816 * 1024; K = 2816; N = 1024; doff = W_FF + (size_t)l * FF_WB + FW_OUT; } }
}
constexpr int P0_NITEMS = 2 * ((1024 / 64) * (384 / 32) + (1024 / 64) * (288 / 32) + (384 / 64) * (1536 / 32) + (256 / 64) * (2048 / 32) + (1024 / 64) * (1024 / 32))
                        + (1024 / 64) * (2048 / 32) + (1024 / 64) * (1024 / 32) + (1024 / 64) * (5184 / 32) + (2048 / 64) * (1024 / 32)
                        + 4 * ((1024 / 64) * (5632 / 32) + (2816 / 64) * (1024 / 32));
__device__ __forceinline__ void p0_prologue(Frame& F) {
    unsigned char* ws = WSP;
    LAS float* s = (LAS float*)F.lds;
    for (int i = F.tid; i < 5 * 1024; i += NTHR) { const int cc = i >> 10, k = i & 1023; const float v = cc == 0 ? INP(I_CCTX)[k] : INP(I_C)[(cc - 1) * 1024 + k]; s[i] = v / (1.f + expf(-v)); }
    __syncthreads();
    float* mods = (float*)(ws + WS_MODS);
    for (int it = F.bx; it < 192; it += F.G) {
        const int l = it / 48, r = it % 48, cb = r / 16, ks = r % 16, n = cb * 2048 + 4 * F.tid;
        const float* W = INP(I_WADA) + (size_t)l * 1024 * 6144 + (size_t)(ks * 64) * 6144 + n;
        v4f acc[5];
#pragma unroll
        for (int cc = 0; cc < 5; ++cc) acc[cc] = (v4f){0.f, 0.f, 0.f, 0.f};
#pragma unroll 1
        for (int kb = 0; kb < 64; kb += 16) {
            v4f wv[16];
#pragma unroll
            for (int k = 0; k < 16; ++k) wv[k] = *(const GAS v4f*)(W + (size_t)(kb + k) * 6144);
#pragma unroll
            for (int k = 0; k < 16; ++k)
#pragma unroll
                for (int cc = 0; cc < 5; ++cc) acc[cc] += wv[k] * s[cc * 1024 + ks * 64 + kb + k];
        }
        LAS float* tbl = s + 5 * 1024;
        __syncthreads();
#pragma unroll
        for (int cc = 0; cc < 5; ++cc) *(LAS v4f*)(tbl + cc * 2048 + 4 * F.tid) = acc[cc];
        __syncthreads();
        const float* bp = INP(I_BADA) + l * 6144 + cb * 2048;
#pragma unroll
        for (int q = 0; q < 4; ++q) { const int col = q * 512 + F.tid; const float bb = ks == 0 ? bp[col] : 0.f;
#pragma unroll
            for (int cc = 0; cc < 5; ++cc) atomicAdd(&mods[((size_t)l * 5 + cc) * 6144 + cb * 2048 + col], tbl[cc * 2048 + col] + bb); }
    }
    __syncthreads();
    LAS float* scr = (LAS float*)(F.lds + F.wave * 8448);
    for (int it = F.gw; it < P0_NITEMS; it += 2 * F.NGW) {
        P0Item J[2]; bool have1 = it + F.NGW < P0_NITEMS;
#pragma unroll
        for (int e = 0; e < 2; ++e) {
            int r = e == 0 ? it : (have1 ? it + F.NGW : it), inp = 0, K = 64, N = 32, mode = 0, H = 0, roff = 0; size_t soff = 0, doff = 0;
#pragma unroll 1
            for (int q = 0; q < 22; ++q) { p0_job(q, inp, soff, K, N, doff, mode, H, roff); const int ni = (K / 64) * (N / 32); if (r < ni) break; r -= ni; }
            const int nblk = N / 32;
            J[e].W = INP(inp) + soff; J[e].WT = (bf16*)(ws + doff); J[e].K = K; J[e].N = N; J[e].mode = mode; J[e].H = H; J[e].roff = roff; J[e].k0 = 64 * (r / nblk); J[e].n0 = 32 * (r % nblk);
        }
        v4f t0[8], t1[8];
        p0_item_load(J[0], F.lane, t0); p0_item_load(J[1], F.lane, t1);
        p0_item_finish(J[0], F.lane, t0, scr);
        if (have1) p0_item_finish(J[1], F.lane, t1, scr);
    }
    for (int it = F.gw; it < 384; it += F.NGW) {
        bf16* rowp = it < 192 ? (bf16*)(ws + W_MLA + (it / 96) * MLA_WB + MW_CAT) + (size_t)(672 + it % 96) * 1024 : (bf16*)(ws + W_SSI) + (size_t)(5184 + it - 192) * 1024;
        const v4u z = {0u, 0u, 0u, 0u}; ((GAS v4u*)rowp)[F.lane] = z; ((GAS v4u*)rowp)[64 + F.lane] = z;
    }
    for (int it = F.gw; it < 2048; it += F.NGW) {
        const int j = it >> 10, rr = it & 1023, b = rr >> 8, sq = rr & 255;
        const v4f v = ((const GAS v4f*)(INP(I_CCKV) + (((size_t)b * 2 + j) * 256 + sq) * 256))[F.lane];
        v2u o; o.x = pk2(v.x, v.y); o.y = pk2(v.z, v.w);
        ((GAS v2u*)((bf16*)(ws + WS_CKV + j * CKV_B) + (size_t)(T + rr) * 256))[F.lane] = o;
    }
    if (F.bx == 0) for (int i = F.tid; i < 640; i += NTHR) { const int pos = i >> 3, fi = i & 7; const float p = (float)(pos < 16 ? pos : pos - 16);
        const float a = p * rope_inv(fi); float* tab = (float*)(ws + WS_ROPE); tab[2 * i] = cosf(a); tab[2 * i + 1] = sinf(a); }
}

__device__ __forceinline__ void rp_normmod(Frame& F, const float* xlo, const float* xhi, const float* g, const float* mods_l, int sh_off, int sc_off, bf16* h) {
    for (int base = F.gw; base < T; base += 4 * F.NGW) {
        v4f v[4][4]; float ss[4]; int rows[4];
#pragma unroll
        for (int k = 0; k < 4; ++k) { const int row = base + k * F.NGW; rows[k] = row < T ? row : base;
            const GAS v4f* xr = (const GAS v4f*)((rows[k] < TP ? xlo : xhi) + (size_t)rows[k] * 1024) + F.lane;
#pragma unroll
            for (int j = 0; j < 4; ++j) v[k][j] = xr[64 * j]; }
#pragma unroll
        for (int k = 0; k < 4; ++k) { float s = 0.f;
#pragma unroll
            for (int j = 0; j < 4; ++j) s += (v[k][j].x * v[k][j].x + v[k][j].y * v[k][j].y) + (v[k][j].z * v[k][j].z + v[k][j].w * v[k][j].w);
            ss[k] = s; }
#pragma unroll
        for (int o = 1; o < 64; o <<= 1) {
#pragma unroll
            for (int k = 0; k < 4; ++k) ss[k] += shx(ss[k], F.lane, o); }
#pragma unroll
        for (int j = 0; j < 4; ++j) { const int c = 4 * F.lane + 256 * j; const v4f g4 = *(const GAS v4f*)(g + c);
#pragma unroll
            for (int k = 0; k < 4; ++k) { const float r = rsqrtf(ss[k] * (1.f / 1024) + EPS); const float* m = mods_l + (size_t)cond_of_row(rows[k]) * 6144;
                const v4f sc = *(const GAS v4f*)(m + sc_off + c), sh = *(const GAS v4f*)(m + sh_off + c);
                const v4f o = v[k][j] * r * g4 * (sc + 1.f) + sh; v2u w; w.x = pk2(o.x, o.y); w.y = pk2(o.z, o.w);
                *(GAS v2u*)(h + (size_t)rows[k] * 1024 + c) = w; } }
    }
}
__device__ __forceinline__ void rp_mla_fin1(Frame& F, const float* lat, const float* gq, const float* gkv, bf16* qn, bf16* ckv, float* out, int j) {
    for (int row = F.gw; row < T; row += F.NGW) {
        const float* lr = lat + (size_t)row * 768;
        v2f q[3]; float ss = 0.f;
#pragma unroll
        for (int i = 0; i < 3; ++i) { q[i] = *(const GAS v2f*)(lr + 2 * F.lane + 128 * i); ss += q[i].x * q[i].x + q[i].y * q[i].y; }
        float r = rsqrtf(wsum(ss, F.lane) * (1.f / 384) + EPS);
#pragma unroll
        for (int i = 0; i < 3; ++i) { const int c = 2 * F.lane + 128 * i; *(GAS unsigned*)(qn + (size_t)row * 384 + c) = pk2(q[i].x * r * gq[c], q[i].y * r * gq[c + 1]); }
        v2f k[2]; ss = 0.f;
#pragma unroll
        for (int i = 0; i < 2; ++i) { k[i] = *(const GAS v2f*)(lr + 384 + 2 * F.lane + 128 * i); ss += k[i].x * k[i].x + k[i].y * k[i].y; }
        r = rsqrtf(wsum(ss, F.lane) * (1.f / 256) + EPS);
#pragma unroll
        for (int i = 0; i < 2; ++i) { const int c = 2 * F.lane + 128 * i; const float c0 = k[i].x * r * gkv[c], c1 = k[i].y * r * gkv[c + 1];
            *(GAS unsigned*)(ckv + (size_t)row * 256 + c) = pk2(c0, c1);
            if (row < TP) { v2f o; o.x = c0; o.y = c1; *(GAS v2f*)(out + OUT_CKV + (((size_t)(row >> 8) * 2 + j) * 256 + (row & 255)) * 256 + c) = o; } }
        if (row < TP && F.lane < 32) out[OUT_KPE + (((size_t)(row >> 8) * 2 + j) * 256 + (row & 255)) * 32 + F.lane] = lr[640 + F.lane];
    }
}
__device__ __forceinline__ void rope32_tab(float* pe, int t, const float* tab) {
    const v2f* tr = (const v2f*)tab + (t >> 6) * 8; const v2f* tc = (const v2f*)tab + (16 + (t & 63)) * 8;
#pragma unroll
    for (int i = 0; i < 8; ++i) {
        v2f cs = tr[i]; float x1 = pe[i], x2 = pe[i + 8]; pe[i] = x1 * cs.x - x2 * cs.y; pe[i + 8] = x2 * cs.x + x1 * cs.y;
        cs = tc[i]; x1 = pe[16 + i]; x2 = pe[24 + i]; pe[16 + i] = x1 * cs.x - x2 * cs.y; pe[24 + i] = x2 * cs.x + x1 * cs.y;
    }
}
__device__ __forceinline__ void ld8(const bf16* p, float* d) { const v4u w = *(const GAS v4u*)p; d[0] = bflo(w.x); d[1] = bfhi(w.x); d[2] = bflo(w.y); d[3] = bfhi(w.y); d[4] = bflo(w.z); d[5] = bfhi(w.z); d[6] = bflo(w.w); d[7] = bfhi(w.w); }
__device__ __forceinline__ void st8(bf16* p, const float* d) { v4u w; w.x = pk2(d[0], d[1]); w.y = pk2(d[2], d[3]); w.z = pk2(d[4], d[5]); w.w = pk2(d[6], d[7]); *(GAS v4u*)p = w; }
__device__ __forceinline__ void rp_tables(Frame& F) {
    unsigned char* ws = WSP; const float* mods = (const float*)(ws + WS_MODS); float* GTb = (float*)(ws + WS_GT); float* SWb = (float*)(ws + WS_SW);
    for (int idx = F.bx * NTHR + F.tid; idx < 8 * 5 * 1024; idx += F.G * NTHR) {
        const int s = idx / 5120, r = idx % 5120, c = r >> 10, k = r & 1023, layer = s >> 1;
        const float g = (s & 1) ? INP(I_GN2)[layer * 1024 + k] : INP(I_GN1)[layer * 1024 + k];
        GTb[idx] = g * (1.f + mods[((size_t)layer * 5 + c) * 6144 + ((s & 1) ? 4096 : 1024) + k]);
    }
    constexpr int NR1 = 5632, NR2 = 2048, NR4 = 5376, NR6 = 768;
    constexpr int TOT = 4 * NR1 + NR2 + NR4 + NR6;
    for (int it = F.gw; it < TOT / 4; it += F.NGW) {
        int s, n; const bf16* Wt; const int i4 = 4 * it;
        if (i4 < 4 * NR1) { const int l = i4 / NR1; n = i4 % NR1; s = 2 * l + 1; Wt = (const bf16*)(ws + W_FF + (size_t)l * FF_WB + FW_IN); }
        else if (i4 < 4 * NR1 + NR2) { n = i4 - 4 * NR1; s = 2; Wt = (const bf16*)(ws + W_CV1); }
        else if (i4 < 4 * NR1 + NR2 + NR4) { n = i4 - 4 * NR1 - NR2; s = 4; Wt = (const bf16*)(ws + W_SSI); }
        else { n = i4 - 4 * NR1 - NR2 - NR4; s = 6; Wt = (const bf16*)(ws + W_MLA + MLA_WB + MW_CAT); }
        const int layer = s >> 1, shoff = (s & 1) ? 3072 : 0;
        v4u wr[4][2];
#pragma unroll
        for (int r = 0; r < 4; ++r) { wr[r][0] = *(const GAS v4u*)(Wt + (size_t)(n + r) * 1024 + 16 * F.lane); wr[r][1] = *(const GAS v4u*)(Wt + (size_t)(n + r) * 1024 + 16 * F.lane + 8); }
        float acc[4][5];
#pragma unroll
        for (int r = 0; r < 4; ++r)
#pragma unroll
            for (int c = 0; c < 5; ++c) acc[r][c] = 0.f;
#pragma unroll
        for (int c = 0; c < 5; ++c) { const float* sp = mods + ((size_t)layer * 5 + c) * 6144 + shoff + 16 * F.lane;
            const v4f s0 = *(const GAS v4f*)sp, s1 = *(const GAS v4f*)(sp + 4), s2 = *(const GAS v4f*)(sp + 8), s3 = *(const GAS v4f*)(sp + 12);
#pragma unroll
            for (int r = 0; r < 4; ++r) { const v4u a = wr[r][0], b2 = wr[r][1];
                acc[r][c] = (s0.x * bflo(a.x) + s0.y * bfhi(a.x) + s0.z * bflo(a.y) + s0.w * bfhi(a.y)) + (s1.x * bflo(a.z) + s1.y * bfhi(a.z) + s1.z * bflo(a.w) + s1.w * bfhi(a.w))
                          + (s2.x * bflo(b2.x) + s2.y * bfhi(b2.x) + s2.z * bflo(b2.y) + s2.w * bfhi(b2.y)) + (s3.x * bflo(b2.z) + s3.y * bfhi(b2.z) + s3.z * bflo(b2.w) + s3.w * bfhi(b2.w)); } }
#pragma unroll
        for (int o = 1; o < 64; o <<= 1) {
#pragma unroll
            for (int r = 0; r < 4; ++r)
#pragma unroll
                for (int c = 0; c < 5; ++c) acc[r][c] += shx(acc[r][c], F.lane, o); }
        if (F.lane < 20) { const int r = F.lane / 5, c = F.lane % 5; float v = 0.f;
#pragma unroll
            for (int rr = 0; rr < 4; ++rr)
#pragma unroll
                for (int cc = 0; cc < 5; ++cc) v = (rr == r && cc == c) ? acc[rr][cc] : v;
            SWb[((size_t)s * 5 + c) * 5632 + n + r] = v; }
    }
}
__device__ __forceinline__ void rp_mla_fin2(Frame& F, const bf16* qraw, const bf16* kvraw, const float* lat, const float* ckpe_j, const float* gqn, const float* gkn, const float* tab, bf16* Q, bf16* K) {
    for (int idx = F.bx * NTHR + F.tid; idx < T * 32; idx += F.G * NTHR) {
        const int row = idx >> 5, hd = (idx >> 1) & 15, hf = idx & 1; const bool latent = row >= TP; const int tl = (row - TP) & 1023;
        float v[48]; float ss = 0.f;
#pragma unroll
        for (int i = 0; i < 6; ++i) ld8(qraw + (size_t)row * 1536 + hd * 96 + hf * 48 + 8 * i, v + 8 * i);
#pragma unroll
        for (int d = 0; d < 48; ++d) ss += v[d] * v[d];
        ss += shx(ss, F.lane, 1);
        const float r = rsqrtf(ss * (1.f / 96) + EPS) * QSCALE;
#pragma unroll
        for (int d = 0; d < 48; ++d) v[d] = v[d] * r * gqn[hf * 48 + d];
        if (latent && hf) rope32_tab(v + 16, tl, tab);
#pragma unroll
        for (int i = 0; i < 6; ++i) st8(Q + ((size_t)row * 16 + hd) * 96 + hf * 48 + 8 * i, v + 8 * i);
    }
    asm volatile("" ::: "memory");
    for (int idx = F.bx * NTHR + F.tid; idx < (T + NCTX) * 32; idx += F.G * NTHR) {
        const int row = idx >> 5, hd = (idx >> 1) & 15, hf = idx & 1; const bool latent = row >= TP && row < T; const int tl = (row - TP) & 1023;
        float v[48]; float ss = 0.f;
        if (hf == 0) {
#pragma unroll
            for (int i = 0; i < 6; ++i) ld8(kvraw + (size_t)row * 2048 + hd * 128 + 8 * i, v + 8 * i);
        } else {
#pragma unroll
            for (int i = 0; i < 2; ++i) ld8(kvraw + (size_t)row * 2048 + hd * 128 + 48 + 8 * i, v + 8 * i);
            const float* kp = row < T ? lat + (size_t)row * 768 + 640 : ckpe_j + ((size_t)((row - T) >> 8) * 2 * 256 + ((row - T) & 255)) * 32;
#pragma unroll
            for (int i = 0; i < 8; ++i) { const v4f p4 = *(const GAS v4f*)(kp + 4 * i); v[16 + 4 * i] = p4.x; v[17 + 4 * i] = p4.y; v[18 + 4 * i] = p4.z; v[19 + 4 * i] = p4.w; }
        }
#pragma unroll
        for (int d = 0; d < 48; ++d) ss += v[d] * v[d];
        ss += shx(ss, F.lane, 1);
        const float r = rsqrtf(ss * (1.f / 96) + EPS);
#pragma unroll
        for (int d = 0; d < 48; ++d) v[d] = v[d] * r * gkn[hf * 48 + d];
        if (latent && hf) rope32_tab(v + 16, tl, tab);
#pragma unroll
        for (int i = 0; i < 6; ++i) st8(K + ((size_t)row * 16 + hd) * 96 + hf * 48 + 8 * i, v + 8 * i);
    }
}
__device__ __forceinline__ void rp_dwconv(Frame& F, const bf16* u, const float* wdw, const float* bdw, const float* gln, const float* bln, bf16* vout) {
    LAS float* red = (LAS float*)F.lds;
    const int c = 2 * F.tid;
    for (int it = F.vcu; it < T / 16; it += F.G) {
        const int row0 = 16 * it; int t0, L; row_pos(row0, t0, L);
        v2f w[31];
#pragma unroll
        for (int k = 0; k < 31; ++k) w[k] = *(const GAS v2f*)(wdw + k * 1024 + c);
        const v2f bb = *(const GAS v2f*)(bdw + c);
        unsigned pk[46];
#pragma unroll
        for (int rr = 0; rr < 46; ++rr) { const int tt = t0 - 15 + rr; const bool ok = tt >= 0 && tt < L;
            pk[rr] = *(const GAS unsigned*)(u + (size_t)(ok ? row0 - 15 + rr : row0) * 1024 + c); }
        __builtin_amdgcn_sched_barrier(0);
#pragma unroll
        for (int rr = 0; rr < 46; ++rr) { const int tt = t0 - 15 + rr; pk[rr] = (tt >= 0 && tt < L) ? pk[rr] : 0u; }
        v2f yy[16];
#pragma unroll
        for (int r = 0; r < 16; ++r) yy[r] = bb;
#pragma unroll
        for (int rr = 0; rr < 46; ++rr) {
            const v2f x = (v2f){bflo(pk[rr]), bfhi(pk[rr])};
#pragma unroll
            for (int r = 0; r < 16; ++r) { const int k = rr - r; if (k >= 0 && k < 31) yy[r] += x * w[k]; }
        }
        float y0[16], y1[16];
#pragma unroll
        for (int r = 0; r < 16; ++r) { y0[r] = yy[r].x; y1[r] = yy[r].y; }
        float s[16];
#pragma unroll
        for (int r = 0; r < 16; ++r) s[r] = y0[r] + y1[r];
#pragma unroll
        for (int o = 1; o < 64; o <<= 1) {
#pragma unroll
            for (int r = 0; r < 16; ++r) s[r] += shx(s[r], F.lane, o); }
        __syncthreads();
        if (F.lane < 16) { float v = s[0];
#pragma unroll
            for (int r = 1; r < 16; ++r) v = F.lane == r ? s[r] : v;
            red[F.wave * 16 + F.lane] = v; }
        __syncthreads();
        float mean[16];
#pragma unroll
        for (int r = 0; r < 16; ++r) { float m = 0.f;
#pragma unroll
            for (int wv = 0; wv < 8; ++wv) m += red[wv * 16 + r];
            mean[r] = m * (1.f / 1024); }
#pragma unroll
        for (int r = 0; r < 16; ++r) { y0[r] -= mean[r]; y1[r] -= mean[r]; s[r] = y0[r] * y0[r] + y1[r] * y1[r]; }
#pragma unroll
        for (int o = 1; o < 64; o <<= 1) {
#pragma unroll
            for (int r = 0; r < 16; ++r) s[r] += shx(s[r], F.lane, o); }
        __syncthreads();
        if (F.lane < 16) { float v = s[0];
#pragma unroll
            for (int r = 1; r < 16; ++r) v = F.lane == r ? s[r] : v;
            red[F.wave * 16 + F.lane] = v; }
        __syncthreads();
        const v2f gg = *(const GAS v2f*)(gln + c), bl = *(const GAS v2f*)(bln + c);
#pragma unroll
        for (int r = 0; r < 16; ++r) { float q = 0.f;
#pragma unroll
            for (int wv = 0; wv < 8; ++wv) q += red[wv * 16 + r];
            const float rs = rsqrtf(q * (1.f / 1024) + EPS);
            const float z0 = y0[r] * rs * gg.x + bl.x, z1 = y1[r] * rs * gg.y + bl.y;
            *(GAS unsigned*)(vout + (size_t)(row0 + r) * 1024 + c) = pk2(z0 * fast_sig(z0), z1 * fast_sig(z1)); }
    }
    __syncthreads();
}
__device__ __forceinline__ void rp_ssd_conv(Frame& F, const bf16* xpre, const float* dtraw, const float* wc, const float* bc, const float* dtb, const float* alog, bf16* xbc, float* dt, float* acum) {
    for (int idx = F.bx * NTHR + F.tid; idx < (T / 32) * 384; idx += F.G * NTHR) {
        const int seg = idx / 384, cg = idx - seg * 384, c0 = 8 * cg, row0 = 32 * seg; int t0, L; row_pos(row0, t0, L);
        v2f w2[5][4], b2[4];
#pragma unroll
        for (int k = 0; k < 5; ++k) { const v4f a = *(const GAS v4f*)(wc + k * 3072 + c0), b = *(const GAS v4f*)(wc + k * 3072 + c0 + 4);
            w2[k][0] = (v2f){a.x, a.y}; w2[k][1] = (v2f){a.z, a.w}; w2[k][2] = (v2f){b.x, b.y}; w2[k][3] = (v2f){b.z, b.w}; }
        { const v4f a = *(const GAS v4f*)(bc + c0), b = *(const GAS v4f*)(bc + c0 + 4); b2[0] = (v2f){a.x, a.y}; b2[1] = (v2f){a.z, a.w}; b2[2] = (v2f){b.x, b.y}; b2[3] = (v2f){b.z, b.w}; }
        const bf16* base = xpre + (size_t)row0 * 3072 + c0;
#define SSC_OK(j) ((t0 + (j)) >= 0 && (t0 + (j)) < L)
#define SSC_LD(j) (*(const GAS v4u*)(base + (ptrdiff_t)(SSC_OK(j) ? (j) : 0) * 3072))
        v4u carry[4], cur[8], nxt[8];
#pragma unroll
        for (int k = 0; k < 4; ++k) carry[k] = SSC_LD(k - 2);
#pragma unroll
        for (int k = 0; k < 8; ++k) cur[k] = SSC_LD(k + 2);
        __builtin_amdgcn_sched_barrier(0);
#pragma unroll
        for (int k = 0; k < 4; ++k) if (!SSC_OK(k - 2)) carry[k] = (v4u){0u, 0u, 0u, 0u};
#pragma unroll
        for (int k = 0; k < 8; ++k) if (!SSC_OK(k + 2)) cur[k] = (v4u){0u, 0u, 0u, 0u};
#pragma unroll
        for (int c = 0; c < 4; ++c) {
            if (c < 3) {
#pragma unroll
                for (int k = 0; k < 8; ++k) nxt[k] = SSC_LD(8 * c + 10 + k); }
            __builtin_amdgcn_sched_barrier(0);
            v2f acc[8][4];
#pragma unroll
            for (int o = 0; o < 8; ++o)
#pragma unroll
                for (int p2 = 0; p2 < 4; ++p2) acc[o][p2] = b2[p2];
#pragma unroll
            for (int q = 0; q < 12; ++q) { const v4u rw = q < 4 ? carry[q] : cur[q - 4];
                const v2f x0 = (v2f){bflo(rw.x), bfhi(rw.x)}, x1 = (v2f){bflo(rw.y), bfhi(rw.y)}, x2 = (v2f){bflo(rw.z), bfhi(rw.z)}, x3 = (v2f){bflo(rw.w), bfhi(rw.w)};
#pragma unroll
                for (int o = 0; o < 8; ++o) { const int k = q - o; if (k >= 0 && k < 5) { acc[o][0] += x0 * w2[k][0]; acc[o][1] += x1 * w2[k][1]; acc[o][2] += x2 * w2[k][2]; acc[o][3] += x3 * w2[k][3]; } } }
#pragma unroll
            for (int o = 0; o < 8; ++o) { v4u ow;
                { const v2f v = acc[o][0]; ow.x = pk2(v.x * fast_sig(v.x), v.y * fast_sig(v.y)); } { const v2f v = acc[o][1]; ow.y = pk2(v.x * fast_sig(v.x), v.y * fast_sig(v.y)); }
                { const v2f v = acc[o][2]; ow.z = pk2(v.x * fast_sig(v.x), v.y * fast_sig(v.y)); } { const v2f v = acc[o][3]; ow.w = pk2(v.x * fast_sig(v.x), v.y * fast_sig(v.y)); }
                *(GAS v4u*)(xbc + (size_t)(row0 + 8 * c + o) * 3072 + c0) = ow; }
#pragma unroll
            for (int k = 0; k < 4; ++k) carry[k] = cur[4 + k];
            if (c < 3) {
#pragma unroll
                for (int k = 0; k < 8; ++k) cur[k] = SSC_OK(8 * c + 10 + k) ? nxt[k] : (v4u){0u, 0u, 0u, 0u}; }
        }
#undef SSC_OK
#undef SSC_LD
    }
    for (int it = F.gw; it < 64 * 64; it += F.NGW) {
        const int ch = it >> 6, e = it & 63, dir = e >> 5, row0 = 128 * ch, lane = F.lane;
        const float aa = -expf(alog[e]), bb = dtb[e];
        const int i0 = dir == 0 ? lane : 127 - lane, i1 = dir == 0 ? lane + 64 : 63 - lane;
        const float d0 = softplus_f(dtraw[(size_t)(row0 + i0) * 64 + e] + bb), d1 = softplus_f(dtraw[(size_t)(row0 + i1) * 64 + e] + bb);
        float s0 = d0 * aa, s1 = d1 * aa;
#pragma unroll
        for (int o = 1; o < 64; o <<= 1) { const float u0 = __builtin_bit_cast(float, __builtin_amdgcn_ds_bpermute((lane - o) << 2, __builtin_bit_cast(int, s0))), u1 = __builtin_bit_cast(float, __builtin_amdgcn_ds_bpermute((lane - o) << 2, __builtin_bit_cast(int, s1)));
            if (lane >= o) { s0 += u0; s1 += u1; } }
        s1 += __builtin_bit_cast(float, __builtin_amdgcn_readlane(__builtin_bit_cast(int, s0), 63));
        dt[(size_t)(row0 + i0) * 64 + e] = d0; dt[(size_t)(row0 + i1) * 64 + e] = d1;
        acum[(size_t)(row0 + i0) * 64 + e] = s0; acum[(size_t)(row0 + i1) * 64 + e] = s1;
    }
}
__device__ __forceinline__ void rp_ssd_gate(Frame& F, const bf16* y, const bf16* z, const float* gn, bf16* yn) {
    for (int row = F.gw; row < T; row += F.NGW) {
#pragma unroll
        for (int g = 0; g < 4; ++g) { const int c0 = g * 512 + 8 * F.lane; float zz[8], v[8]; ld8(z + (size_t)row * 2048 + c0, zz);
            float yb[8]; ld8(y + (size_t)row * 2048 + c0, v); ld8(y + (size_t)(T + row) * 2048 + c0, yb);
#pragma unroll
            for (int i = 0; i < 8; ++i) v[i] += yb[i];
            float ss = 0.f;
#pragma unroll
            for (int i = 0; i < 8; ++i) { v[i] = v[i] * zz[i] * fast_sig(zz[i]); ss += v[i] * v[i]; }
            const float r = rsqrtf(wsum(ss, F.lane) * (1.f / 512) + EPS);
#pragma unroll
            for (int i = 0; i < 8; ++i) v[i] = v[i] * r * gn[c0 + i];
            st8(yn + (size_t)row * 2048 + c0, v); }
    }
}

typedef short a_bf16x8 __attribute__((ext_vector_type(8)));
typedef short a_s16x4 __attribute__((ext_vector_type(4)));
typedef float a_f32x16 __attribute__((ext_vector_type(16)));
typedef float a_f32x2 __attribute__((ext_vector_type(2))); typedef __bf16 a_bf16x2 __attribute__((ext_vector_type(2)));
__device__ __forceinline__ unsigned a_cvtpk(float lo, float hi) { a_f32x2 v = {lo, hi}; a_bf16x2 b = __builtin_convertvector(v, a_bf16x2); return __builtin_bit_cast(unsigned, b); }
__device__ __forceinline__ a_s16x4 a_vtr(const LAS unsigned char* p) { return __builtin_bit_cast(a_s16x4, __builtin_amdgcn_ds_read_tr16_b64_v4i16((LAS a_s16x4*)p)); }
constexpr int AT_KS = 208, AT_VS = 192, AT_KB = 64 * AT_KS, AT_VB = 64 * AT_VS, AT_VOFF = 2 * AT_KB;
__device__ __forceinline__ void at_tile(Frame& F, LAS unsigned char* lds, int buf, int lane, const a_bf16x8 (&qf)[6], a_f32x16& o0, a_f32x16& o1, float& m, float& l) {
    const int r32 = lane & 31, hi = lane >> 5;
    a_f32x16 p0, p1;
#pragma unroll
    for (int r = 0; r < 16; ++r) { p0[r] = 0.f; p1[r] = 0.f; }
    { const LAS unsigned char* kp = lds + buf * AT_KB + r32 * AT_KS + hi * 16;
#pragma unroll
      for (int s = 0; s < 6; ++s) { const a_bf16x8 a0 = *(const LAS a_bf16x8*)(kp + 32 * s), a1 = *(const LAS a_bf16x8*)(kp + 32 * AT_KS + 32 * s);
          p0 = __builtin_amdgcn_mfma_f32_32x32x16_bf16(a0, qf[s], p0, 0, 0, 0); p1 = __builtin_amdgcn_mfma_f32_32x32x16_bf16(a1, qf[s], p1, 0, 0, 0); } }

    float mx = fmaxf(p0[0], p1[0]);
#pragma unroll
    for (int r = 1; r < 16; ++r) mx = fmaxf(mx, fmaxf(p0[r], p1[r]));
    mx = fmaxf(mx, shx(mx, lane, 32));
    const float mn = fmaxf(m, mx), alpha = __builtin_amdgcn_exp2f(m - mn); m = mn;
    float ps = 0.f;
#pragma unroll
    for (int r = 0; r < 16; ++r) { p0[r] = __builtin_amdgcn_exp2f(p0[r] - mn); p1[r] = __builtin_amdgcn_exp2f(p1[r] - mn); ps += p0[r] + p1[r]; }
    l = l * alpha + ps;
#pragma unroll
    for (int r = 0; r < 16; ++r) { o0[r] *= alpha; o1[r] *= alpha; }
    v4u pw[4];
    pw[0] = (v4u){a_cvtpk(p0[0], p0[1]), a_cvtpk(p0[2], p0[3]), a_cvtpk(p0[4], p0[5]), a_cvtpk(p0[6], p0[7])};
    pw[1] = (v4u){a_cvtpk(p0[8], p0[9]), a_cvtpk(p0[10], p0[11]), a_cvtpk(p0[12], p0[13]), a_cvtpk(p0[14], p0[15])};
    pw[2] = (v4u){a_cvtpk(p1[0], p1[1]), a_cvtpk(p1[2], p1[3]), a_cvtpk(p1[4], p1[5]), a_cvtpk(p1[6], p1[7])};
    pw[3] = (v4u){a_cvtpk(p1[8], p1[9]), a_cvtpk(p1[10], p1[11]), a_cvtpk(p1[12], p1[13]), a_cvtpk(p1[14], p1[15])};

    const LAS unsigned char* vp0 = lds + AT_VOFF + buf * AT_VB + (4 * hi + ((lane & 15) >> 2)) * AT_VS + (16 * ((lane >> 4) & 1) + 4 * (lane & 3)) * 2;
    a_s16x4 vl0[4], vh0[4], vl1[4], vh1[4];
#pragma unroll
    for (int bs = 0; bs < 4; ++bs) { const LAS unsigned char* vq = vp0 + (16 * bs) * AT_VS; vl0[bs] = a_vtr(vq); vh0[bs] = a_vtr(vq + 8 * AT_VS); vl1[bs] = a_vtr(vq + 64); vh1[bs] = a_vtr(vq + 8 * AT_VS + 64); }
#pragma unroll
    for (int bs = 0; bs < 4; ++bs) {
        const a_bf16x8 v0 = (a_bf16x8){vl0[bs][0], vl0[bs][1], vl0[bs][2], vl0[bs][3], vh0[bs][0], vh0[bs][1], vh0[bs][2], vh0[bs][3]}, v1 = (a_bf16x8){vl1[bs][0], vl1[bs][1], vl1[bs][2], vl1[bs][3], vh1[bs][0], vh1[bs][1], vh1[bs][2], vh1[bs][3]};
        const a_bf16x8 pb = __builtin_bit_cast(a_bf16x8, pw[bs]);
        o0 = __builtin_amdgcn_mfma_f32_32x32x16_bf16(v0, pb, o0, 0, 0, 0); o1 = __builtin_amdgcn_mfma_f32_32x32x16_bf16(v1, pb, o1, 0, 0, 0); }
}
__device__ __forceinline__ void ph_attn(Frame& F, const bf16* Q, const bf16* K, const bf16* KV, bf16* AO) {
    const int lane = F.lane, r32 = lane & 31, hi = lane >> 5, wave = F.wave, tid = F.tid;
    LAS unsigned char* lds = F.lds;
    const int kr_a = tid / 12, kp_a = tid % 12, kr_b = (tid + 512) / 12, kp_b = (tid + 512) % 12, vr = tid >> 3, vp = tid & 7;
    const bool has_b = tid < 256;
    for (int uu = F.vcu; uu < 512; uu += F.G) {
        int head, q0, NT, kbase_ctx, kbase_lat;
        if (uu < 256) { const int seq = uu >> 4; head = uu & 15; q0 = seq * 256; NT = 4; kbase_ctx = seq * 256; kbase_lat = 0; }
        else { const int u2 = uu - 256, b = u2 >> 6, qb = u2 & 3; head = (u2 >> 2) & 15; q0 = TP + b * 1024 + qb * 256; NT = 20; kbase_ctx = T + b * 256; kbase_lat = TP + b * 1024; }
        a_bf16x8 qf[6];
        { const bf16* qp = Q + ((size_t)(q0 + wave * 32 + r32) * 16 + head) * 96 + hi * 8;
#pragma unroll
          for (int s = 0; s < 6; ++s) qf[s] = *(const GAS a_bf16x8*)(qp + 16 * s); }
        a_f32x16 o0, o1;
#pragma unroll
        for (int r = 0; r < 16; ++r) { o0[r] = 0.f; o1[r] = 0.f; }
        float m = -INFINITY, l = 0.f;
        v4u ka0, kb0, vv0, ka1, kb1, vv1, ka2, kb2_, vv2;
#define AT_LOAD(t, KA, KB2, VV) do { const int kr0_ = (t) < 4 ? kbase_ctx + 64 * (t) : kbase_lat + 64 * ((t) - 4); \
            KA = *(const GAS v4u*)(K + ((size_t)(kr0_ + kr_a) * 16 + head) * 96 + kp_a * 8); \
            if (has_b) KB2 = *(const GAS v4u*)(K + ((size_t)(kr0_ + kr_b) * 16 + head) * 96 + kp_b * 8); \
            VV = *(const GAS v4u*)(KV + (size_t)(kr0_ + vr) * 2048 + head * 128 + 64 + vp * 8); } while (0)
#define AT_STORE(buf, KA, KB2, VV) do { *(LAS v4u*)(lds + (buf) * AT_KB + kr_a * AT_KS + kp_a * 16) = KA; \
            if (has_b) *(LAS v4u*)(lds + (buf) * AT_KB + kr_b * AT_KS + kp_b * 16) = KB2; \
            *(LAS v4u*)(lds + AT_VOFF + (buf) * AT_VB + vr * AT_VS + vp * 16) = VV; } while (0)
#define AT_STEP(k, SA, SB, SC, SD_, SE_, SF_, SG, SH, SI) if (t + (k) < NT) { \
            if (t + (k) + 3 < NT) AT_LOAD(t + (k) + 3, SA, SB, SC);            \
            at_tile(F, lds, (k) & 1, lane, qf, o0, o1, m, l); \
            if (t + (k) + 1 < NT) AT_STORE(((k) + 1) & 1, SD_, SE_, SF_);       \
            LDS_BARRIER(); }
        AT_LOAD(0, ka0, kb0, vv0); AT_LOAD(1, ka1, kb1, vv1); AT_LOAD(2, ka2, kb2_, vv2);
        AT_STORE(0, ka0, kb0, vv0);
        LDS_BARRIER();
#pragma unroll 1
        for (int t = 0; t < NT; t += 6) {
            AT_STEP(0, ka0, kb0, vv0, ka1, kb1, vv1, 0, 0, 0)
            AT_STEP(1, ka1, kb1, vv1, ka2, kb2_, vv2, 0, 0, 0)
            AT_STEP(2, ka2, kb2_, vv2, ka0, kb0, vv0, 0, 0, 0)
            AT_STEP(3, ka0, kb0, vv0, ka1, kb1, vv1, 0, 0, 0)
            AT_STEP(4, ka1, kb1, vv1, ka2, kb2_, vv2, 0, 0, 0)
            AT_STEP(5, ka2, kb2_, vv2, ka0, kb0, vv0, 0, 0, 0)
        }
#undef AT_STEP
#undef AT_LOAD
#undef AT_STORE
        l += shx(l, lane, 32);
        const float il = __builtin_amdgcn_rcpf(l);
        bf16* op = AO + (size_t)(q0 + wave * 32 + r32) * 1024 + head * 64 + 4 * hi;
#pragma unroll
        for (int g4 = 0; g4 < 4; ++g4) {
            v2u w0; w0.x = a_cvtpk(o0[4 * g4] * il, o0[4 * g4 + 1] * il); w0.y = a_cvtpk(o0[4 * g4 + 2] * il, o0[4 * g4 + 3] * il); *(GAS v2u*)(op + 8 * g4) = w0;
            v2u w1; w1.x = a_cvtpk(o1[4 * g4] * il, o1[4 * g4 + 1] * il); w1.y = a_cvtpk(o1[4 * g4 + 2] * il, o1[4 * g4 + 3] * il); *(GAS v2u*)(op + 32 + 8 * g4) = w1; }

    }
}
constexpr int SC_ST = 272, SC_XS = 144;
constexpr int SC_C = 0, SC_B = 128 * SC_ST, SC_M = 2 * 128 * SC_ST, SC_H = 3 * 128 * SC_ST, SC_X = SC_H + 64 * SC_ST, SC_XW = SC_X + 128 * SC_XS, SC_ARR = SC_XW + 128 * SC_XS;
static_assert(SC_ARR + 4 * 128 * 4 + 16 <= PTAB_OFF_C, "scan LDS map");
__device__ __forceinline__ int a_crow(int r, int hi) { return (r & 3) + 8 * (r >> 2) + 4 * hi; }
__device__ __forceinline__ void ph_scan(Frame& F, const bf16* xbc, const float* dt, const float* acg, const float* dsk, const float* st0, bf16* y, float* out) {
    const int lane = F.lane, r32 = lane & 31, hi = lane >> 5, wave = F.wave, tid = F.tid;
    LAS unsigned char* lds = F.lds;
    LAS float* acum = (LAS float*)(lds + SC_ARR); LAS float* wj = acum + 128; LAS float* ei = acum + 256; LAS float* dtj = acum + 384; LAS float* misc = acum + 512;
    const int q4 = (lane & 15) >> 2, gg = (lane >> 4) & 1, p4 = lane & 3;
    const int ib = wave >> 1, pb = wave & 1, nb = wave >> 1;
    v4u cr[4], br[4], xr[2];
    float pdt[2], pac[2], plast, pac_t, pdt_t;
#define SC_GLOADP(rowb_, g_, hd_, dir_) do { const int row0_ = (rowb_); \
        _Pragma("unroll") for (int k = 0; k < 4; ++k) { const int q = tid + 512 * k, rr = q >> 4, pp = q & 15; \
            cr[k] = *(const GAS v4u*)(xbc + (size_t)(row0_ + rr) * 3072 + 2560 + (g_) * 128 + pp * 8); br[k] = *(const GAS v4u*)(xbc + (size_t)(row0_ + rr) * 3072 + 2048 + (g_) * 128 + pp * 8); } \
        _Pragma("unroll") for (int k = 0; k < 2; ++k) { const int q = tid + 512 * k, rr = q >> 3, pp = q & 7; xr[k] = *(const GAS v4u*)(xbc + (size_t)(row0_ + rr) * 3072 + (hd_) * 64 + pp * 8); \
            pdt[k] = dt[(size_t)(row0_ + rr) * 64 + (dir_) * 32 + (hd_)]; pac[k] = acg[(size_t)(row0_ + rr) * 64 + (dir_) * 32 + (hd_)]; } \
        plast = acg[(size_t)(row0_ + ((dir_) == 0 ? 127 : 0)) * 64 + (dir_) * 32 + (hd_)]; \
        pac_t = acg[(size_t)(row0_ + (tid & 127)) * 64 + (dir_) * 32 + (hd_)]; pdt_t = dt[(size_t)(row0_ + (tid & 127)) * 64 + (dir_) * 32 + (hd_)]; } while (0)
#define SC_ITEM(slot_, ii_, seq_, hd_) do { if ((slot_) < 128) { seq_ = 16 + ((slot_) >> 5); hd_ = (slot_) & 31; } else { const int pi_ = 4 * ((slot_) - 128) + (ii_); seq_ = pi_ >> 5; hd_ = pi_ & 31; } } while (0)
    for (int slot = F.vcu; slot < 256; slot += F.G) {
        const int nitem = slot < 128 ? 1 : 4;
        { int seq0, hd0; SC_ITEM(slot, 0, seq0, hd0); SC_GLOADP(seq0 < 16 ? seq0 * 256 : TP + (seq0 - 16) * 1024, hd0 >> 3, hd0, 0); }
#pragma unroll 1
        for (int ii = 0; ii < nitem; ++ii) {
            int seq, hd;
            if (slot < 128) { seq = 16 + (slot >> 5); hd = slot & 31; } else { const int pi = 4 * (slot - 128) + ii; seq = pi >> 5; hd = pi & 31; }
            const int g = hd >> 3, r0 = seq < 16 ? seq * 256 : TP + (seq - 16) * 1024, nc = seq < 16 ? 2 : 8;
#pragma unroll 1
            for (int dir = 0; dir < 2; ++dir) {
                const float dd = dsk[dir * 32 + hd];
                a_f32x16 hacc;
                if (seq < 16) {
#pragma unroll
                    for (int r = 0; r < 16; ++r) hacc[r] = 0.f;
                } else { const float* s0 = st0 + ((((size_t)(seq - 16) * 2 + dir) * 32 + hd) * 64 + 32 * pb + r32) * 128 + 32 * nb + 4 * hi;
#pragma unroll
                    for (int g4 = 0; g4 < 4; ++g4) { const v4f t4 = *(const GAS v4f*)(s0 + 8 * g4); hacc[4 * g4] = t4.x; hacc[4 * g4 + 1] = t4.y; hacc[4 * g4 + 2] = t4.z; hacc[4 * g4 + 3] = t4.w; } }
#pragma unroll
                for (int g4 = 0; g4 < 4; ++g4) { v2u w; w.x = a_cvtpk(hacc[4 * g4], hacc[4 * g4 + 1]); w.y = a_cvtpk(hacc[4 * g4 + 2], hacc[4 * g4 + 3]);
                    *(LAS v2u*)(lds + SC_H + (32 * pb + r32) * SC_ST + (32 * nb + 8 * g4 + 4 * hi) * 2) = w; }
#pragma unroll 1
                for (int cc = 0; cc < nc; ++cc) {
                    const int c = dir == 0 ? cc : nc - 1 - cc, row0 = r0 + c * 128;
                    const int e = dir * 32 + hd;
                    const float last = plast;
                    LDS_BARRIER();
                    if (tid < 128) { const float ac = pac_t, dv = pdt_t;
                        acum[tid] = ac; dtj[tid] = dv; ei[tid] = __expf(ac); if (tid == 0) misc[0] = __expf(last); }
#pragma unroll
                    for (int k = 0; k < 4; ++k) { const int q = tid + 512 * k, rr = q >> 4, pp = q & 15; *(LAS v4u*)(lds + SC_C + rr * SC_ST + pp * 16) = cr[k]; *(LAS v4u*)(lds + SC_B + rr * SC_ST + pp * 16) = br[k]; }
#pragma unroll
                    for (int k = 0; k < 2; ++k) { const int q = tid + 512 * k, rr = q >> 3, pp = q & 7; *(LAS v4u*)(lds + SC_X + rr * SC_XS + pp * 16) = xr[k];
                        const float w = pdt[k] * __expf(last - pac[k]);
                        v4u s; s.x = a_cvtpk(bflo(xr[k].x) * w, bfhi(xr[k].x) * w); s.y = a_cvtpk(bflo(xr[k].y) * w, bfhi(xr[k].y) * w); s.z = a_cvtpk(bflo(xr[k].z) * w, bfhi(xr[k].z) * w); s.w = a_cvtpk(bflo(xr[k].w) * w, bfhi(xr[k].w) * w);
                        *(LAS v4u*)(lds + SC_XW + rr * SC_XS + pp * 16) = s; }
                    { int nrow = 0, nhd = hd, ndir = dir; bool hn = true;
                      if (cc + 1 < nc) nrow = r0 + (dir == 0 ? cc + 1 : nc - 2 - cc) * 128;
                      else if (dir == 0) { nrow = r0 + (nc - 1) * 128; ndir = 1; }
                      else if (ii + 1 < nitem) { int seqn; SC_ITEM(slot, ii + 1, seqn, nhd); nrow = seqn < 16 ? seqn * 256 : TP + (seqn - 16) * 1024; ndir = 0; }
                      else hn = false;
                      if (hn) SC_GLOADP(nrow, nhd >> 3, nhd, ndir); }
                    LDS_BARRIER();
#pragma unroll 1
                    for (int tt = 0; tt < 2; ++tt) {
                        int lt = tt == 0 ? wave : (wave < 2 ? 8 + wave : 10 + (wave - 2));
                        const int ta = lt == 0 ? 0 : lt == 1 ? 0 : lt == 2 ? 0 : lt == 3 ? 0 : lt == 4 ? 1 : lt == 5 ? 1 : lt == 6 ? 1 : lt == 7 ? 2 : lt == 8 ? 2 : lt == 9 ? 3 : lt == 10 ? 1 : lt == 11 ? 2 : lt == 12 ? 2 : lt == 13 ? 3 : lt == 14 ? 3 : 3;
                        const int tb = lt == 0 ? 0 : lt == 1 ? 1 : lt == 2 ? 2 : lt == 3 ? 3 : lt == 4 ? 1 : lt == 5 ? 2 : lt == 6 ? 3 : lt == 7 ? 2 : lt == 8 ? 3 : lt == 9 ? 3 : lt == 10 ? 0 : lt == 11 ? 0 : lt == 12 ? 1 : lt == 13 ? 0 : lt == 14 ? 1 : 2;
                        const int jb = dir == 0 ? ta : tb, ibg = dir == 0 ? tb : ta;
                        const bool dead = lt >= 10;
                        a_f32x16 gt;
#pragma unroll
                        for (int r = 0; r < 16; ++r) gt[r] = 0.f;
                        if (!dead) {
                            const LAS unsigned char* ap = lds + SC_B + (32 * jb + r32) * SC_ST + hi * 16; const LAS unsigned char* bp = lds + SC_C + (32 * ibg + r32) * SC_ST + hi * 16;
#pragma unroll
                            for (int s = 0; s < 8; ++s) gt = __builtin_amdgcn_mfma_f32_32x32x16_bf16(*(const LAS a_bf16x8*)(ap + 32 * s), *(const LAS a_bf16x8*)(bp + 32 * s), gt, 0, 0, 0);
                            const int i = 32 * ibg + r32; const float ai = acum[i];
                            v4f aj[4], dj[4];
#pragma unroll
                            for (int g4 = 0; g4 < 4; ++g4) { aj[g4] = *(const LAS v4f*)(acum + 32 * jb + 8 * g4 + 4 * hi); dj[g4] = *(const LAS v4f*)(dtj + 32 * jb + 8 * g4 + 4 * hi); }
#pragma unroll
                            for (int r = 0; r < 16; ++r) { const int j = 32 * jb + a_crow(r, hi); const bool keep = dir == 0 ? j <= i : j >= i;
                                const float e = __builtin_amdgcn_exp2f(fminf(ai - aj[r >> 2][r & 3], 0.f) * 1.4426950408889634f) * dj[r >> 2][r & 3];
                                gt[r] = keep ? gt[r] * e + (j == i ? dd : 0.f) : 0.f; }
                        }
#pragma unroll
                        for (int g4 = 0; g4 < 4; ++g4) { v2u w; w.x = a_cvtpk(gt[4 * g4], gt[4 * g4 + 1]); w.y = a_cvtpk(gt[4 * g4 + 2], gt[4 * g4 + 3]);
                            *(LAS v2u*)(lds + SC_M + (32 * ibg + r32) * SC_ST + (32 * jb + 8 * g4 + 4 * hi) * 2) = w; }
                    }
                    a_f32x16 yo;
#pragma unroll
                    for (int r = 0; r < 16; ++r) yo[r] = 0.f;
                    { const LAS unsigned char* ap = lds + SC_C + (32 * ib + r32) * SC_ST + hi * 16; const LAS unsigned char* bp = lds + SC_H + (32 * pb + r32) * SC_ST + hi * 16;
#pragma unroll
                      for (int s = 0; s < 8; ++s) yo = __builtin_amdgcn_mfma_f32_32x32x16_bf16(*(const LAS a_bf16x8*)(ap + 32 * s), *(const LAS a_bf16x8*)(bp + 32 * s), yo, 0, 0, 0); }
                    LDS_BARRIER();
                    a_f32x16 yd;
#pragma unroll
                    for (int r = 0; r < 16; ++r) yd[r] = 0.f;
                    { const LAS unsigned char* ap = lds + SC_M + (32 * ib + r32) * SC_ST + hi * 16; const LAS unsigned char* xp = lds + SC_X + (8 * hi + q4) * SC_XS + (32 * pb + 16 * gg + 4 * p4) * 2;
#pragma unroll
                      for (int s = 0; s < 8; ++s) { const a_s16x4 l0 = a_vtr(xp + (16 * s) * SC_XS), h0 = a_vtr(xp + (16 * s + 4) * SC_XS);
                          const a_bf16x8 xb = (a_bf16x8){l0[0], l0[1], l0[2], l0[3], h0[0], h0[1], h0[2], h0[3]};
                          yd = __builtin_amdgcn_mfma_f32_32x32x16_bf16(*(const LAS a_bf16x8*)(ap + 32 * s), xb, yd, 0, 0, 0); } }
                    { bf16* yp = y + (size_t)dir * T * 2048 + (size_t)(row0 + 32 * ib) * 2048 + hd * 64 + 32 * pb + r32;
                      v4f e4[4];
#pragma unroll
                      for (int g4 = 0; g4 < 4; ++g4) e4[g4] = *(const LAS v4f*)(ei + 32 * ib + 8 * g4 + 4 * hi);
#pragma unroll
                      for (int r = 0; r < 16; ++r) { const int i = a_crow(r, hi); const float v = yd[r] + e4[r >> 2][r & 3] * yo[r]; yp[(size_t)i * 2048] = (bf16)f2bf(v); } }
                    { const float dec = misc[0];
#pragma unroll
                      for (int r = 0; r < 16; ++r) hacc[r] *= dec;
                      const LAS unsigned char* bq = lds + SC_B + (8 * hi + q4) * SC_ST + (32 * nb + 16 * gg + 4 * p4) * 2; const LAS unsigned char* xq = lds + SC_XW + (8 * hi + q4) * SC_XS + (32 * pb + 16 * gg + 4 * p4) * 2;
#pragma unroll
                      for (int s = 0; s < 8; ++s) { const a_s16x4 bl = a_vtr(bq + (16 * s) * SC_ST), bh = a_vtr(bq + (16 * s + 4) * SC_ST), xl = a_vtr(xq + (16 * s) * SC_XS), xh = a_vtr(xq + (16 * s + 4) * SC_XS);
                          const a_bf16x8 av = (a_bf16x8){bl[0], bl[1], bl[2], bl[3], bh[0], bh[1], bh[2], bh[3]}, bv = (a_bf16x8){xl[0], xl[1], xl[2], xl[3], xh[0], xh[1], xh[2], xh[3]};
                          hacc = __builtin_amdgcn_mfma_f32_32x32x16_bf16(av, bv, hacc, 0, 0, 0); } }
#pragma unroll
                    for (int g4 = 0; g4 < 4; ++g4) { v2u w; w.x = a_cvtpk(hacc[4 * g4], hacc[4 * g4 + 1]); w.y = a_cvtpk(hacc[4 * g4 + 2], hacc[4 * g4 + 3]);
                        *(LAS v2u*)(lds + SC_H + (32 * pb + r32) * SC_ST + (32 * nb + 8 * g4 + 4 * hi) * 2) = w; }
                }
                if (seq < 16) { float* o = out + OUT_SSM + ((((size_t)seq * 2 + dir) * 32 + hd) * 64 + 32 * pb + r32) * 128 + 32 * nb + 4 * hi;
#pragma unroll
                    for (int g4 = 0; g4 < 4; ++g4) { v4f t4; t4.x = hacc[4 * g4]; t4.y = hacc[4 * g4 + 1]; t4.z = hacc[4 * g4 + 2]; t4.w = hacc[4 * g4 + 3]; *(GAS v4f*)(o + 8 * g4) = t4; } }
            }
        }
    }
#undef SC_GLOADP
#undef SC_ITEM
    LDS_BARRIER();
}

constexpr int NPHASE = 30;
enum Op { OP_P0, OP_NORM1, OP_G_LAT, OP_FIN1, OP_G_QKV, OP_FIN2, OP_ATTN, OP_G_WO, OP_NORM2, OP_G_FF1, OP_G_FF2, OP_G_PW1, OP_DWCONV, OP_G_PW2, OP_G_SSI, OP_SSCONV, OP_SCAN, OP_GATE, OP_G_SSO };
__device__ __forceinline__ void phase_decode(int ph, int& layer, int& op) {
    if (ph == 0) { layer = 0; op = OP_P0; return; }
    if (ph <= 9) { layer = 0; const int r = ph - 1; op = r == 0 ? OP_NORM1 : r == 1 ? OP_G_LAT : r == 2 ? OP_FIN1 : r == 3 ? OP_G_QKV : r == 4 ? OP_FIN2 : r == 5 ? OP_ATTN : r == 6 ? OP_G_WO : r == 7 ? OP_G_FF1 : OP_G_FF2; }
    else if (ph <= 14) { layer = 1; const int r = ph - 10; op = r == 0 ? OP_G_PW1 : r == 1 ? OP_DWCONV : r == 2 ? OP_G_PW2 : r == 3 ? OP_G_FF1 : OP_G_FF2; }
    else if (ph <= 21) { layer = 2; const int r = ph - 15; op = r == 0 ? OP_G_SSI : r == 1 ? OP_SSCONV : r == 2 ? OP_SCAN : r == 3 ? OP_GATE : r == 4 ? OP_G_SSO : r == 5 ? OP_G_FF1 : OP_G_FF2; }
    else { layer = 3; const int r = ph - 22; op = r == 0 ? OP_G_LAT : r == 1 ? OP_FIN1 : r == 2 ? OP_G_QKV : r == 3 ? OP_FIN2 : r == 4 ? OP_ATTN : r == 5 ? OP_G_WO : r == 6 ? OP_G_FF1 : OP_G_FF2; }
}
struct MArgs { const float* in[38]; float* out; unsigned char* ws; int ph_lo, ph_hi; };
constexpr int PTAB_OFF = PTAB_OFF_C;
__global__ void __launch_bounds__(NTHR, 2) mega_fwd(MArgs args) {
    extern __shared__ __attribute__((aligned(16))) unsigned char lds_raw[];
    LAS unsigned char* lds = (LAS unsigned char*)lds_raw;
    volatile LAS unsigned* PT0 = (volatile LAS unsigned*)(lds + PTAB_OFF);
    volatile LAS unsigned* MISC = (volatile LAS unsigned*)(lds + MISC_OFF);
    { const int t0 = threadIdx.x;
      if (t0 < 40) { const unsigned long long p = t0 < 38 ? (unsigned long long)args.in[t0] : t0 == 38 ? (unsigned long long)args.out : (unsigned long long)args.ws;
          PT0[2 * t0] = (unsigned)p; PT0[2 * t0 + 1] = (unsigned)(p >> 32); }
      if (t0 < 64) MISC[t0] = 0u; }
    __syncthreads();
    XcdBarrier bar = xcd_barrier_post((unsigned*)((unsigned char*)ldp(PT0, PT_WS) + WS_CTL) + CW_BAR, MISC + 8);
    const int wave0 = __builtin_amdgcn_readfirstlane(threadIdx.x >> 6);
    const int ph_hi = args.ph_hi;
    for (int ph = args.ph_lo; ph < ph_hi; ++ph) {
        Frame F;
        { int w = wave0; asm volatile("" : "+s"(w)); F.wave = w; }
        F.lds = lds; F.lane = olane(); F.tid = F.wave * 64 + F.lane;
        const int bx = obid();
        F.G = gridDim.x; F.vcu = (F.G % 8 == 0) ? (bx % 8) * (F.G / 8) + bx / 8 : bx;
        F.gw = F.vcu * NWAVES + F.wave; F.NGW = F.G * NWAVES; F.PT = PT0; F.bx = bx;
        int layer, op; phase_decode(ph, layer, op);
        const int j = layer / 3;
        switch (op) {
        case OP_P0: p0_prologue(F); break;
        case OP_NORM1: { unsigned char* ws = WSP; float* x = OUTP; const float* xlo = layer == 0 ? INP(I_XP) : x; const float* xhi = layer == 0 ? INP(I_XS) - (size_t)TP * 1024 : x;
            rp_normmod(F, xlo, xhi, INP(I_GN1) + layer * 1024, (const float*)(ws + WS_MODS) + (size_t)layer * 5 * 6144, 0, 1024, (bf16*)(ws + WS_H)); rp_tables(F); } break;
        case OP_NORM2: { unsigned char* ws = WSP; float* x = OUTP;
            rp_normmod(F, x, x, INP(I_GN2) + layer * 1024, (const float*)(ws + WS_MODS) + (size_t)layer * 5 * 6144, 3072, 4096, (bf16*)(ws + WS_H)); } break;
        case OP_G_LAT: { unsigned char* ws = WSP; pg8::Gemm g{(const bf16*)(ws + WS_H), (const bf16*)(ws + W_MLA + j * MLA_WB + MW_CAT), T, 768, 1024}; pg8::StaticOrder S; S.init(T, 2 * 768, F.G, F.bx);
            const int s_ = 2 * layer; pg8::EpiF32<1> E{(float*)(ws + A_LAT), 768, layer == 0 ? nullptr : (const float*)(ws + WS_STAT) + s_ * 8192, layer == 0 ? nullptr : (const float*)(ws + WS_SW) + (size_t)s_ * 5 * 5632}; pg8::gemm_phase<pg8::EpiF32<1>, pg8::StaticOrder, true, true, true>(F.lds, g, S, E, F.wave); } break;
        case OP_FIN1: { unsigned char* ws = WSP; rp_mla_fin1(F, (const float*)(ws + A_LAT), INP(I_GQ) + j * 384, INP(I_GKV) + j * 256, (bf16*)(ws + A_QN), (bf16*)(ws + WS_CKV + j * CKV_B), OUTP, j); } break;
        case OP_G_QKV: {
#pragma unroll 1
            for (int w = 0; w < 2; ++w) {
                unsigned char* ws = WSP; unsigned char* wm = ws + W_MLA + j * MLA_WB;
                pg8::Gemm g = w == 0 ? pg8::Gemm{(const bf16*)(ws + A_QN), (const bf16*)(wm + MW_UQ), T, 1536, 384} : pg8::Gemm{(const bf16*)(ws + WS_CKV + j * CKV_B), (const bf16*)(wm + MW_UKV), T + NCTX, 2048, 256};
                pg8::StaticOrder S; S.init(g.M, g.N, F.G, w == 0 ? F.bx : (int)((F.bx + 64) % F.G));
                pg8::EpiBf16P E{w == 0 ? (bf16*)(ws + A_QRAW) : (bf16*)(ws + A_KVRAW), g.N};
                pg8::gemm_phase<pg8::EpiBf16P, pg8::StaticOrder, true, true>(F.lds, g, S, E, F.wave);
            } } break;
        case OP_FIN2: { unsigned char* ws = WSP; rp_mla_fin2(F, (const bf16*)(ws + A_QRAW), (const bf16*)(ws + A_KVRAW), (const float*)(ws + A_LAT), INP(I_CKPE) + (size_t)j * 8192, INP(I_GQN) + j * 96, INP(I_GKN) + j * 96,
                                                        (const float*)(ws + WS_ROPE), (bf16*)(ws + A_QB), (bf16*)(ws + A_KB)); } break;
        case OP_ATTN: { unsigned char* ws = WSP; ph_attn(F, (const bf16*)(ws + A_QB), (const bf16*)(ws + A_KB), (const bf16*)(ws + A_KVRAW), (bf16*)(ws + A_AO)); } break;
        case OP_G_WO: case OP_G_PW2: case OP_G_SSO: case OP_G_FF2: {
            unsigned char* ws = WSP; float* x = OUTP;
            const float* rlo = (layer == 0 && op != OP_G_FF2) ? INP(I_XP) : x; const float* rhi = (layer == 0 && op != OP_G_FF2) ? INP(I_XS) - (size_t)TP * 1024 : x;
            pg8::Gemm g; const float* bias = nullptr; int goff = 2048;
            if (op == OP_G_WO) g = pg8::Gemm{(const bf16*)(ws + A_AO), (const bf16*)(ws + W_MLA + j * MLA_WB + MW_O), T, 1024, 1024};
            else if (op == OP_G_PW2) { g = pg8::Gemm{(const bf16*)(ws + A_V), (const bf16*)(ws + W_CV2), T, 1024, 1024}; bias = INP(I_CVB2); }
            else if (op == OP_G_SSO) g = pg8::Gemm{(const bf16*)(ws + A_YN), (const bf16*)(ws + W_SSO), T, 1024, 2048};
            else { g = pg8::Gemm{(const bf16*)(ws + A_ACT), (const bf16*)(ws + W_FF + layer * FF_WB + FW_OUT), T, 1024, 2816}; goff = 5120; }
            pg8::StaticOrder S; S.init(T, 2 * 1024, F.G, F.bx);
            float* xdst = x;
            const int sn_ = 2 * layer + (op == OP_G_FF2 ? 2 : 1);
            pg8::EpiResid<1> E{rlo, rhi, xdst, (const float*)(ws + WS_MODS) + (size_t)layer * 5 * 6144, goff, bias,
                               sn_ < 8 ? (bf16*)(ws + WS_H) : nullptr, (const float*)(ws + WS_GT) + (size_t)(sn_ & 7) * 5 * 1024, (float*)(ws + WS_STAT) + (sn_ & 7) * 8192};
            pg8::gemm_phase<pg8::EpiResid<1>, pg8::StaticOrder, true, true, true>(F.lds, g, S, E, F.wave); } break;
        case OP_G_FF1: { unsigned char* ws = WSP; pg8::Gemm g{(const bf16*)(ws + WS_H), (const bf16*)(ws + W_FF + layer * FF_WB + FW_IN), T, 5632, 1024}; pg8::StaticOrder S; S.init(T, 5632, F.G, F.bx);
            const int s_ = 2 * layer + 1; pg8::EpiGlu<0> E{(bf16*)(ws + A_ACT), 2816, nullptr, 2816, (const float*)(ws + WS_STAT) + s_ * 8192, (const float*)(ws + WS_SW) + (size_t)s_ * 5 * 5632}; pg8::gemm_phase<pg8::EpiGlu<0>, pg8::StaticOrder, true, true>(F.lds, g, S, E, F.wave); } break;
        case OP_G_PW1: { unsigned char* ws = WSP; pg8::Gemm g{(const bf16*)(ws + WS_H), (const bf16*)(ws + W_CV1), T, 2048, 1024}; pg8::StaticOrder S; S.init(T, 2048, F.G, F.bx);
            const int s_ = 2 * layer; pg8::EpiGlu<1> E{(bf16*)(ws + A_U), 1024, INP(I_CVB1), 1024, (const float*)(ws + WS_STAT) + s_ * 8192, (const float*)(ws + WS_SW) + (size_t)s_ * 5 * 5632}; pg8::gemm_phase<pg8::EpiGlu<1>, pg8::StaticOrder, true, true>(F.lds, g, S, E, F.wave); } break;
        case OP_DWCONV: { unsigned char* ws = WSP; rp_dwconv(F, (const bf16*)(ws + A_U), INP(I_CVWD), INP(I_CVBD), INP(I_CVGL), INP(I_CVBL), (bf16*)(ws + A_V)); } break;
        case OP_G_SSI: { unsigned char* ws = WSP; pg8::Gemm g{(const bf16*)(ws + WS_H), (const bf16*)(ws + W_SSI), T, 5376, 1024}; pg8::StaticOrder S; S.init(T, 5376, F.G, F.bx);
            const int s_ = 2 * layer; pg8::EpiSsdIn E{(bf16*)(ws + A_Z), (bf16*)(ws + A_XPRE), (float*)(ws + A_DTRAW), (const float*)(ws + WS_STAT) + s_ * 8192, (const float*)(ws + WS_SW) + (size_t)s_ * 5 * 5632}; pg8::gemm_phase<pg8::EpiSsdIn, pg8::StaticOrder, true, true>(F.lds, g, S, E, F.wave); } break;
        case OP_SSCONV: { unsigned char* ws = WSP; rp_ssd_conv(F, (const bf16*)(ws + A_XPRE), (const float*)(ws + A_DTRAW), INP(I_SSWC), INP(I_SSBC), INP(I_SSDTB), INP(I_SSAL), (bf16*)(ws + A_XBC), (float*)(ws + A_DT), (float*)(ws + A_ACUM)); } break;
        case OP_SCAN: { unsigned char* ws = WSP; ph_scan(F, (const bf16*)(ws + A_XBC), (const float*)(ws + A_DT), (const float*)(ws + A_ACUM), INP(I_SSD), INP(I_SSM), (bf16*)(ws + A_Y), OUTP); } break;
        case OP_GATE: { unsigned char* ws = WSP; rp_ssd_gate(F, (const bf16*)(ws + A_Y), (const bf16*)(ws + A_Z), INP(I_SSGN), (bf16*)(ws + A_YN)); } break;
        default: break;
        }

        if (ph + 1 < ph_hi) xcd_barrier(bar);

    }
}

extern "C" void kernel_launch(void* const* d_in, const int* in_sizes, int n_in, void* d_out, int out_size, void* d_ws, size_t ws_size, hipStream_t stream) {
    static int grid = 0;
    if (grid == 0) {
        int dev = 0, cus = 0;
        if (hipGetDevice(&dev) != hipSuccess || hipDeviceGetAttribute(&cus, hipDeviceAttributeMultiprocessorCount, dev) != hipSuccess) { fprintf(stderr, "kernel_launch: device query failed\n"); grid = -1; return; }
        if (hipFuncSetAttribute((const void*)mega_fwd, hipFuncAttributeMaxDynamicSharedMemorySize, LDS_BYTES) != hipSuccess) { fprintf(stderr, "kernel_launch: hipFuncSetAttribute failed\n"); grid = -1; return; }
        (void)hipGetLastError();
        grid = cus;
    }
    if (grid < 0) return;
    (void)hipMemsetAsync((char*)d_ws + WS_CTL, 0, CTL_ZERO_BYTES, stream);
    MArgs a{};
    for (int i = 0; i < 38; ++i) a.in[i] = (const float*)d_in[i];
    a.out = (float*)d_out; a.ws = (unsigned char*)d_ws;
    a.ph_lo = 0; a.ph_hi = NPHASE;
    hipLaunchKernelGGL(mega_fwd, dim3(grid), dim3(NTHR), LDS_BYTES, stream, a);
}
```

```cpp
#include <hip/hip_runtime.h>
#include <cstdint>
#include <cstdio>

constexpr int DM = 1024, T = 8192, TP = 4096;
constexpr int NCTX = 1024;
constexpr int QL = 384, KVL = 256, ROPE = 32, NOPE = 64, QKD = 96, VH = 64, NH = 16;
constexpr int FFH = 2816;
constexpr int SSI = 2048, SSH = 32, SSP = 64, SSN = 128, SSG = 4, SSCD = 3072, SSIN = 5184;
constexpr float EPS = 1e-6f;
constexpr size_t OUT_YP = 0, OUT_CKV = 8388608, OUT_KPE = 10485760, OUT_SSM = 10747904;

__device__ __forceinline__ int cond_of_row(int r) { return r < TP ? 0 : 1 + ((r - TP) >> 10); }
__device__ __forceinline__ void row_pos(int r, int& t, int& L) { if (r < TP) { t = r & 255; L = 256; } else { t = (r - TP) & 1023; L = 1024; } }
__device__ __forceinline__ float softplus_f(float x) { return fmaxf(x, 0.f) + log1pf(expf(-fabsf(x))); }

__device__ __forceinline__ float rope_inv(int i) { return i == 0 ? 1.f : i == 1 ? 0.31622776601683794f : i == 2 ? 0.1f : i == 3 ? 0.031622776601683794f : i == 4 ? 0.01f : i == 5 ? 0.0031622776601683794f : i == 6 ? 0.001f : 0.00031622776601683794f; }

__device__ __forceinline__ int olane() { int l; asm volatile("v_mbcnt_lo_u32_b32 %0, -1, 0\n\tv_mbcnt_hi_u32_b32 %0, -1, %0" : "=v"(l)); return l; }
__device__ __forceinline__ int obid() { int b = blockIdx.x; asm volatile("" : "+s"(b)); return b; }
namespace pg8 {
#define PG8_LAS __attribute__((address_space(3)))
typedef unsigned short bf16_t;
typedef short bf16x8 __attribute__((ext_vector_type(8)));
typedef float f32x4 __attribute__((ext_vector_type(4)));
typedef unsigned u32x4 __attribute__((ext_vector_type(4)));
constexpr int BM = 256, BK = 64, HALF = 128, HTB = HALF * BK * 2  , STAGE_BYTES = 8 * HTB, NXCD = 8, WGM = 8;

__host__ __device__ __forceinline__ int lds_byte(int r, int c) { const int st = (r >> 4) * 2 + (c >> 5), rr = r & 15, cc = c & 31, ob = rr * 64 + cc * 2; return st * 1024 + (ob ^ (((ob >> 9) & 1) << 5)); }
__host__ __device__ __forceinline__ void stage_rc(int b, int& R, int& C) { const int st = b / 1024, sb = b % 1024, swz = sb ^ (((sb >> 9) & 1) << 5); R = (st >> 1) * 16 + swz / 64; C = (st & 1) * 32 + (swz % 64) / 2; }
__host__ __device__ __forceinline__ int perm32(int rho) { const int n = rho >> 4, i = rho & 15; return 8 * (i >> 2) + 4 * n + (i & 3); }

struct Unit { int pm, pn; };
struct Gemm { const bf16_t* A; const bf16_t* Bt; int M, N, K; };

struct StaticOrder {
    int nM, nN, nwg, G, c;
    __host__ __device__ void init(int M, int N, int G_, int c_) { nM = M / BM; nN = N / BM; nwg = nM * nN; G = G_; c = c_; }
    __host__ __device__ bool next(int i, Unit& u) const {
        const long L = (long)i * G + c; if (L >= nwg) return false;
        int wgid = (int)L; { const int q = nwg / NXCD, r = nwg % NXCD, xcd = wgid % NXCD, off = wgid / NXCD; wgid = (xcd < r ? xcd * (q + 1) : r * (q + 1) + (xcd - r) * q) + off; }
        const int nig = WGM * nN, gid = wgid / nig, fm = gid * WGM, gsz = (nM - fm) < WGM ? (nM - fm) : WGM;
        u.pm = fm + ((wgid % nig) % gsz); u.pn = (wgid % nig) / gsz; return true;
    }
    __device__ __forceinline__ void a_ready(const Unit&) const {}
    __device__ __forceinline__ void done(const Unit&) const {}
};
__device__ __forceinline__ unsigned cvt_pk_bf16(float lo, float hi) { unsigned r; asm("v_cvt_pk_bf16_f32 %0, %1, %2" : "=v"(r) : "v"(lo), "v"(hi)); return r; }
typedef unsigned u32x2 __attribute__((ext_vector_type(2)));
#define PG8_GAS __attribute__((address_space(1)))
__device__ __forceinline__ void st16(void* p, u32x4 v) { *(PG8_GAS u32x4*)p = v; }
__device__ __forceinline__ void st16f(void* p, f32x4 v) { *(PG8_GAS f32x4*)p = v; }
__device__ __forceinline__ void st8(void* p, u32x2 v) { *(PG8_GAS u32x2*)p = v; }
__device__ __forceinline__ f32x4 ld16f(const float* p) { return *(const PG8_GAS f32x4*)p; }
__device__ __forceinline__ float ld4f(const float* p) { return *(const PG8_GAS float*)p; }
__device__ __forceinline__ float fast_sigmoid(float x) { return __builtin_amdgcn_rcpf(1.f + __builtin_amdgcn_exp2f(-1.4426950408889634f * x)); }
__device__ __forceinline__ unsigned cvt_pk_bf16_p(float lo, float hi) { unsigned r; asm("v_cvt_pk_bf16_f32 %0, %1, %2" : "=v"(r) : "v"(lo), "v"(hi)); return r; }
template <int MODE> __device__ __forceinline__ void glu8(const f32x4 a0, const f32x4 g0, const f32x4 a1, const f32x4 g1, f32x4& o0, f32x4& o1) {
    const f32x4 t0 = (MODE == 0 ? a0 : g0) * -1.4426950408889634f, t1 = (MODE == 0 ? a1 : g1) * -1.4426950408889634f;
    f32x4 e0, e1, r0, r1;
#pragma unroll
    for (int j = 0; j < 4; ++j) { e0[j] = __builtin_amdgcn_exp2f(t0[j]); e1[j] = __builtin_amdgcn_exp2f(t1[j]); }
    const f32x4 d0 = e0 + 1.f, d1 = e1 + 1.f;
#pragma unroll
    for (int j = 0; j < 4; ++j) { r0[j] = __builtin_amdgcn_rcpf(d0[j]); r1[j] = __builtin_amdgcn_rcpf(d1[j]); }
    if (MODE == 0) { o0 = a0 * g0 * r0; o1 = a1 * g1 * r1; } else { o0 = a0 * r0; o1 = a1 * r1; }
}

constexpr int SW_LD = 5632;
__device__ __forceinline__ int cond_of_pm(int pm) { return pm < 16 ? 0 : 1 + ((pm - 16) >> 2); }
__device__ __forceinline__ void stage_rstat_sw(const float* rstat, const float* sw, const Unit& u, int slot, int wid, int lane, PG8_LAS unsigned char* tabs) {
    PG8_LAS unsigned char* tab = tabs + slot * 2048;
    if (wid < 4) __builtin_amdgcn_global_load_lds((const unsigned*)(rstat + u.pm * BM + wid * 64 + lane), (PG8_LAS unsigned*)(tab + wid * 256), 4, 0, 0);
    else __builtin_amdgcn_global_load_lds((const unsigned*)(sw + (size_t)cond_of_pm(u.pm) * SW_LD + u.pn * BM + (wid - 4) * 64 + lane), (PG8_LAS unsigned*)(tab + 1024 + (wid - 4) * 256), 4, 0, 0);
}
template <int NBJ> struct EpiF32 {
    static constexpr bool PERM = false, AFTER_DRAIN = false, STAGE_IN = false;
    float* C; int ldc; const float* rstat; const float* sw;
    template <bool HN> __device__ __forceinline__ void body(const f32x4 (&acc)[2][2][4][2], const Unit& u, int wr, int wc) const {
        const int t_ = olane(), fr = t_ & 15, fq = t_ >> 4;
        const int row0 = u.pm * BM + wr * 64 + fr, col0 = u.pn * (HALF * NBJ) + wc * 32 + 4 * fq;
        float rs[2][4]; f32x4 s4[NBJ][2];
#pragma unroll
        for (int ai = 0; ai < 2; ++ai)
#pragma unroll
            for (int m = 0; m < 4; ++m) rs[ai][m] = HN ? ld4f(rstat + row0 + ai * HALF + m * 16) : 1.f;
#pragma unroll
        for (int bj = 0; bj < NBJ; ++bj)
#pragma unroll
            for (int n = 0; n < 2; ++n) s4[bj][n] = HN ? ld16f(sw + (size_t)cond_of_pm(u.pm) * SW_LD + col0 + bj * HALF + n * 16) : (f32x4){0.f, 0.f, 0.f, 0.f};
        if (HN) {
#pragma unroll
            for (int ai = 0; ai < 2; ++ai)
#pragma unroll
                for (int m = 0; m < 4; ++m) rs[ai][m] = __builtin_amdgcn_rsqf(rs[ai][m] * (1.f / 1024) + 1e-6f);
        }
#pragma unroll
        for (int ai = 0; ai < 2; ++ai)
#pragma unroll
            for (int m = 0; m < 4; ++m) { float* rowp = C + (size_t)(row0 + ai * HALF + m * 16) * ldc + col0;
#pragma unroll
                for (int bj = 0; bj < NBJ; ++bj)
#pragma unroll
                    for (int n = 0; n < 2; ++n) { f32x4 v = acc[ai][bj][m][n]; if (HN) v = v * rs[ai][m] + s4[bj][n]; st16f(rowp + bj * HALF + n * 16, v); } }
    }
    __device__ __forceinline__ void operator()(const f32x4 (&acc)[2][2][4][2], const Unit& u, int wr_, int wc_, int fr_, int fq_, const PG8_LAS unsigned char* tab) const {
        (void)fr_; (void)fq_; (void)tab;
        if (rstat) body<true>(acc, u, wr_, wc_); else body<false>(acc, u, wr_, wc_);
    }
};
struct EpiLat {
    static constexpr bool PERM = false, AFTER_DRAIN = false, STAGE_IN = false;
    float* C; const float* rstat; const float* sw; bf16_t* QN; bf16_t* CKV; const float* gq; const float* gkv; float* stq; float* stkv;
    template <bool HN> __device__ __forceinline__ void body(const f32x4 (&acc)[2][2][4][2], const Unit& u, int wr, int wc) const {
        const int t_ = olane(), fr = t_ & 15, fq = t_ >> 4;
        const int row0 = u.pm * BM + wr * 64 + fr, col0 = u.pn * HALF + wc * 32 + 4 * fq;
        float rs[2][4]; f32x4 s4[2], g4[2];
#pragma unroll
        for (int ai = 0; ai < 2; ++ai)
#pragma unroll
            for (int m = 0; m < 4; ++m) rs[ai][m] = HN ? ld4f(rstat + row0 + ai * HALF + m * 16) : 1.f;
        const bool isq = u.pn < 3, isn = u.pn < 5;
#pragma unroll
        for (int n = 0; n < 2; ++n) { s4[n] = HN ? ld16f(sw + (size_t)cond_of_pm(u.pm) * SW_LD + col0 + n * 16) : (f32x4){0.f, 0.f, 0.f, 0.f};
            g4[n] = (f32x4){0.f, 0.f, 0.f, 0.f}; if (isn) g4[n] = ld16f(isq ? gq + col0 + n * 16 : gkv + (col0 - 384) + n * 16); }
        if (HN) {
#pragma unroll
            for (int ai = 0; ai < 2; ++ai)
#pragma unroll
                for (int m = 0; m < 4; ++m) rs[ai][m] = __builtin_amdgcn_rsqf(rs[ai][m] * (1.f / 1024) + 1e-6f);
        }
        bf16_t* nb = isq ? QN + col0 : CKV + (col0 - 384); const int nld = isq ? 384 : 256;
        const bool wf = u.pn >= 5 || (u.pn >= 3 && u.pm < 16);
        float ss[2][4];
#pragma unroll
        for (int ai = 0; ai < 2; ++ai)
#pragma unroll
            for (int m = 0; m < 4; ++m) { const int row = row0 + ai * HALF + m * 16; float* rowp = C + (size_t)row * 768 + col0; float q = 0.f;
#pragma unroll
                for (int n = 0; n < 2; ++n) { f32x4 v = acc[ai][0][m][n]; if (HN) v = v * rs[ai][m] + s4[n]; if (wf) st16f(rowp + n * 16, v);
                    if (isn) { const f32x4 y = v * g4[n]; u32x2 w; w.x = cvt_pk_bf16(y[0], y[1]); w.y = cvt_pk_bf16(y[2], y[3]); st8(nb + (size_t)row * nld + n * 16, w);
                        q += (v[0] * v[0] + v[1] * v[1]) + (v[2] * v[2] + v[3] * v[3]); } }
                ss[ai][m] = q; }
        if (isn) { float* st = isq ? stq : stkv;
#pragma unroll
            for (int ai = 0; ai < 2; ++ai)
#pragma unroll
                for (int m = 0; m < 4; ++m) { float q = ss[ai][m];
                    q += __builtin_bit_cast(float, __builtin_amdgcn_ds_bpermute((t_ ^ 16) << 2, __builtin_bit_cast(int, q)));
                    q += __builtin_bit_cast(float, __builtin_amdgcn_ds_bpermute((t_ ^ 32) << 2, __builtin_bit_cast(int, q)));
                    if (fq == 0) atomicAdd(st + row0 + ai * HALF + m * 16, q); } }
    }
    __device__ __forceinline__ void operator()(const f32x4 (&acc)[2][2][4][2], const Unit& u, int wr_, int wc_, int fr_, int fq_, const PG8_LAS unsigned char* tab) const {
        (void)fr_; (void)fq_; (void)tab;
        if (rstat) body<true>(acc, u, wr_, wc_); else body<false>(acc, u, wr_, wc_);
    }
};
struct EpiBf16P {
    static constexpr bool PERM = true, AFTER_DRAIN = false, STAGE_IN = true;
    bf16_t* O; int ldc; const float* rstat; float inv_n;
    __device__ __forceinline__ void stage_in(const Unit& u, int slot, int wid, int lane, PG8_LAS unsigned char* tabs) const { stage_rstat_sw(rstat, rstat, u, slot, wid, lane, tabs); }
    __device__ __forceinline__ void operator()(const f32x4 (&acc)[2][2][4][2], const Unit& u, int wr_, int wc_, int fr_, int fq_, const PG8_LAS unsigned char* tab) const {
        const int t_ = olane(), wr = wr_, wc = wc_, fr = t_ & 15, fq = t_ >> 4; (void)fr_; (void)fq_;
        const int row0 = u.pm * BM + wr * 64 + fr, col0 = u.pn * BM + wc * 32 + 8 * fq;
        float rs[2][4];
#pragma unroll
        for (int ai = 0; ai < 2; ++ai)
#pragma unroll
            for (int m = 0; m < 4; ++m) rs[ai][m] = ((const PG8_LAS float*)tab)[ai * HALF + wr * 64 + m * 16 + fr];
#pragma unroll
        for (int ai = 0; ai < 2; ++ai)
#pragma unroll
            for (int m = 0; m < 4; ++m) rs[ai][m] = __builtin_amdgcn_rsqf(rs[ai][m] * inv_n + 1e-6f);
#pragma unroll
        for (int ai = 0; ai < 2; ++ai)
#pragma unroll
            for (int m = 0; m < 4; ++m) { bf16_t* rowp = O + (size_t)(row0 + ai * HALF + m * 16) * ldc + col0;
#pragma unroll
                for (int bj = 0; bj < 2; ++bj) { const f32x4 v0 = acc[ai][bj][m][0] * rs[ai][m], v1 = acc[ai][bj][m][1] * rs[ai][m]; u32x4 w;
                    w.x = cvt_pk_bf16(v0[0], v0[1]); w.y = cvt_pk_bf16(v0[2], v0[3]); w.z = cvt_pk_bf16(v1[0], v1[1]); w.w = cvt_pk_bf16(v1[2], v1[3]);
                    st16(rowp + bj * HALF, w); } }
    }
};
struct EpiSsdIn {
    static constexpr bool PERM = true, AFTER_DRAIN = false, STAGE_IN = true;
    bf16_t* Z; bf16_t* XP; float* DT; const float* rstat; const float* sw;
    __device__ __forceinline__ void stage_in(const Unit& u, int slot, int wid, int lane, PG8_LAS unsigned char* tabs) const { stage_rstat_sw(rstat, sw, u, slot, wid, lane, tabs); }
    __device__ __forceinline__ void operator()(const f32x4 (&acc)[2][2][4][2], const Unit& u, int wr_, int wc_, int fr_, int fq_, const PG8_LAS unsigned char* tab) const {
        const int t_ = olane(), wr = wr_, wc = wc_, fr = t_ & 15, fq = t_ >> 4; (void)fr_; (void)fq_;
        const int row0 = u.pm * BM + wr * 64 + fr;
        const PG8_LAS float* trs = (const PG8_LAS float*)tab + wr * 64 + fr; const PG8_LAS float* swp = (const PG8_LAS float*)(tab + 1024) + wc * 32 + 8 * fq;
        if (u.pn < 20) {
            bf16_t* base = u.pn < 8 ? Z : XP; const int ld = u.pn < 8 ? 2048 : 3072, colt = (u.pn < 8 ? u.pn : u.pn - 8) * BM, col0 = colt + wc * 32 + 8 * fq;
#pragma unroll
            for (int ai = 0; ai < 2; ++ai)
#pragma unroll
                for (int m = 0; m < 4; ++m) { bf16_t* rowp = base + (size_t)(row0 + ai * HALF + m * 16) * ld + col0;
                    const float rs = __builtin_amdgcn_rsqf(trs[ai * HALF + m * 16] * (1.f / 1024) + 1e-6f);
#pragma unroll
                    for (int bj = 0; bj < 2; ++bj) { const f32x4 v0 = acc[ai][bj][m][0] * rs + *(const PG8_LAS f32x4*)(swp + bj * HALF), v1 = acc[ai][bj][m][1] * rs + *(const PG8_LAS f32x4*)(swp + bj * HALF + 4); u32x4 w;
                        w.x = cvt_pk_bf16(v0[0], v0[1]); w.y = cvt_pk_bf16(v0[2], v0[3]); w.z = cvt_pk_bf16(v1[0], v1[1]); w.w = cvt_pk_bf16(v1[2], v1[3]);
                        st16(rowp + bj * HALF, w); } }
        } else if (wc < 2) {
#pragma unroll
            for (int ai = 0; ai < 2; ++ai)
#pragma unroll
                for (int m = 0; m < 4; ++m) { float* rp = DT + (size_t)(row0 + ai * HALF + m * 16) * 64 + wc * 32 + 8 * fq;
                    const float rs = __builtin_amdgcn_rsqf(trs[ai * HALF + m * 16] * (1.f / 1024) + 1e-6f);
                    st16f(rp, acc[ai][0][m][0] * rs + *(const PG8_LAS f32x4*)swp); st16f(rp + 4, acc[ai][0][m][1] * rs + *(const PG8_LAS f32x4*)(swp + 4)); }
        }
    }
};
template <int MODE> struct EpiGlu {
    static constexpr bool PERM = false, AFTER_DRAIN = false, STAGE_IN = true;
    bf16_t* O; int ldo; const float* bias; int H; const float* rstat; const float* sw;
    __device__ __forceinline__ void stage_in(const Unit& u, int slot, int wid, int lane, PG8_LAS unsigned char* tabs) const { stage_rstat_sw(rstat, sw, u, slot, wid, lane, tabs); }
    __device__ __forceinline__ void operator()(const f32x4 (&acc)[2][2][4][2], const Unit& u, int wr_, int wc_, int fr_, int fq_, const PG8_LAS unsigned char* tab) const {
        const int t_ = olane(), wr = wr_, wc = wc_, fr = t_ & 15, fq = t_ >> 4; (void)fr_; (void)fq_;
        const int row0 = u.pm * BM + wr * 64 + fr;
        float rs[2][4];
#pragma unroll
        for (int ai = 0; ai < 2; ++ai)
#pragma unroll
            for (int m = 0; m < 4; ++m) rs[ai][m] = ((const PG8_LAS float*)tab)[ai * HALF + wr * 64 + m * 16 + fr];
#pragma unroll
        for (int ai = 0; ai < 2; ++ai)
#pragma unroll
            for (int m = 0; m < 4; ++m) rs[ai][m] = __builtin_amdgcn_rsqf(rs[ai][m] * (1.f / 1024) + 1e-6f);
        const unsigned ldb = (unsigned)ldo * 2u;
        unsigned char* Ob = (unsigned char*)O;
        const int f0 = 128 * u.pn + 32 * wc + 8 * fq;
        f32x4 ba[2], bu[2];
#pragma unroll
        for (int bj = 0; bj < 2; ++bj) {
            ba[bj] = (f32x4){0.f, 0.f, 0.f, 0.f}; bu[bj] = ba[bj];
            if (MODE == 1) { ba[bj] = ld16f(bias + f0 + 4 * bj); bu[bj] = ld16f(bias + H + f0 + 4 * bj); }
            const PG8_LAS float* swp = (const PG8_LAS float*)(tab + 1024) + bj * HALF + wc * 32 + 4 * fq; ba[bj] += *(const PG8_LAS f32x4*)swp; bu[bj] += *(const PG8_LAS f32x4*)(swp + 16);
        }
        const unsigned ob = (unsigned)row0 * ldb + (unsigned)f0 * 2u;
#pragma unroll
        for (int ai = 0; ai < 2; ++ai)
#pragma unroll
            for (int m = 0; m < 4; ++m) {
                const f32x4 a0 = acc[ai][0][m][0] * rs[ai][m] + ba[0], g0 = acc[ai][0][m][1] * rs[ai][m] + bu[0];
                const f32x4 a1 = acc[ai][1][m][0] * rs[ai][m] + ba[1], g1 = acc[ai][1][m][1] * rs[ai][m] + bu[1];
                f32x4 o0, o1; glu8<MODE>(a0, g0, a1, g1, o0, o1);
                u32x4 w; w.x = cvt_pk_bf16_p(o0[0], o0[1]); w.y = cvt_pk_bf16_p(o0[2], o0[3]); w.z = cvt_pk_bf16_p(o1[0], o1[1]); w.w = cvt_pk_bf16_p(o1[2], o1[3]);
                st16(Ob + (size_t)(ob + (unsigned)(ai * HALF + m * 16) * ldb), w); }
    }
};
template <int NBJ> struct EpiResid {
    static constexpr bool PERM = true, AFTER_DRAIN = false, STAGE_IN = false;
    const float* xlo; const float* xhi; float* xout; const float* mods_l; int g_off; const float* bias;
    bf16_t* XG; const float* GT; float* stat;
    template <bool HX> __device__ __forceinline__ void body(const f32x4 (&acc)[2][2][4][2], const Unit& u, int wr, int wc) const {
        const int t_ = olane(), fr = t_ & 15, fq = t_ >> 4;
        const int cond = u.pm < 16 ? 0 : 1 + ((u.pm - 16) >> 2);
        const float* gate = mods_l + (size_t)cond * 6144 + g_off; const unsigned char* xin = (const unsigned char*)(u.pm < 16 ? xlo : xhi);
        const int row0 = u.pm * BM + wr * 64 + fr, col0 = u.pn * (HALF * NBJ) + wc * 32 + 8 * fq;
        const unsigned ob = (unsigned)row0 * 4096u + (unsigned)col0 * 4u;
        f32x4 xo[NBJ][2][2][4];
#pragma unroll
        for (int bj = 0; bj < NBJ; ++bj)
#pragma unroll
            for (int n = 0; n < 2; ++n)
#pragma unroll
                for (int ai = 0; ai < 2; ++ai)
#pragma unroll
                    for (int m = 0; m < 4; ++m) xo[bj][n][ai][m] = ld16f((const float*)(xin + (size_t)(ob + (unsigned)((bj * HALF + n * 4) * 4 + (ai * HALF + m * 16) * 4096))));
        const float* gt = HX ? GT + (size_t)cond * 1024 : nullptr;
        f32x4 g4[NBJ][2], b4[NBJ][2], G4[NBJ][2];
#pragma unroll
        for (int bj = 0; bj < NBJ; ++bj)
#pragma unroll
            for (int n = 0; n < 2; ++n) { const int c = col0 + bj * HALF + n * 4; g4[bj][n] = ld16f(gate + c);
                b4[bj][n] = (f32x4){0.f, 0.f, 0.f, 0.f}; if (bias) b4[bj][n] = ld16f(bias + c);
                G4[bj][n] = (f32x4){0.f, 0.f, 0.f, 0.f}; if (HX) G4[bj][n] = ld16f(gt + c); }
        float ss[2][4];
#pragma unroll
        for (int ai = 0; ai < 2; ++ai)
#pragma unroll
            for (int m = 0; m < 4; ++m) ss[ai][m] = 0.f;
        unsigned char* xo_ = (unsigned char*)xout; unsigned char* xg_ = (unsigned char*)XG;
#pragma unroll
        for (int bj = 0; bj < NBJ; ++bj)
#pragma unroll
            for (int ai = 0; ai < 2; ++ai)
#pragma unroll
                for (int m = 0; m < 4; ++m) { const unsigned off = ob + (unsigned)(bj * HALF * 4 + (ai * HALF + m * 16) * 4096);
                    const f32x4 x0 = xo[bj][0][ai][m] + g4[bj][0] * (acc[ai][bj][m][0] + b4[bj][0]), x1 = xo[bj][1][ai][m] + g4[bj][1] * (acc[ai][bj][m][1] + b4[bj][1]);
                    st16f(xo_ + (size_t)off, x0); st16f(xo_ + (size_t)(off + 16u), x1);
                    if (HX) { const f32x4 y0 = x0 * G4[bj][0], y1 = x1 * G4[bj][1]; u32x4 w;
                        w.x = cvt_pk_bf16_p(y0[0], y0[1]); w.y = cvt_pk_bf16_p(y0[2], y0[3]); w.z = cvt_pk_bf16_p(y1[0], y1[1]); w.w = cvt_pk_bf16_p(y1[2], y1[3]); st16(xg_ + (size_t)(off >> 1), w);
                        const f32x4 q = x0 * x0 + x1 * x1; ss[ai][m] += (q[0] + q[1]) + (q[2] + q[3]); } }
        if (HX) {
#pragma unroll
            for (int ai = 0; ai < 2; ++ai)
#pragma unroll
                for (int m = 0; m < 4; ++m) { float s = ss[ai][m];
                    s += __builtin_bit_cast(float, __builtin_amdgcn_ds_bpermute((t_ ^ 16) << 2, __builtin_bit_cast(int, s)));
                    s += __builtin_bit_cast(float, __builtin_amdgcn_ds_bpermute((t_ ^ 32) << 2, __builtin_bit_cast(int, s)));
                    if (fq == 0) atomicAdd(stat + row0 + ai * HALF + m * 16, s); }
        }
    }
    __device__ __forceinline__ void operator()(const f32x4 (&acc)[2][2][4][2], const Unit& u, int wr_, int wc_, int fr_, int fq_, const PG8_LAS unsigned char* tab) const {
        (void)fr_; (void)fq_; (void)tab;
        if (XG) body<true>(acc, u, wr_, wc_); else body<false>(acc, u, wr_, wc_);
    }
};
template <class Epi, class Sched, bool ALIGN_EPI = false, bool SP2 = false, bool HALFN = false>
__device__ __forceinline__ void gemm_phase(PG8_LAS unsigned char* lds, const Gemm g, const Sched& S, const Epi& E, const int wave_in) {
    const int tid = wave_in * 64 + olane(), wid = __builtin_amdgcn_readfirstlane(tid >> 6), lane = tid & 63, wr = wid >> 2, wc = wid & 3, fr = lane & 15, fq = lane >> 4;
    const int K = g.K, nt = K / BK;
    unsigned voffA[2], voffB[2];
#pragma unroll
    for (int i = 0; i < 2; ++i) { int R, C; stage_rc(tid * 16 + i * 8192, R, C); const int Rb = Epi::PERM ? ((R & ~31) + perm32(R & 31)) : R;
        voffA[i] = (unsigned)(R * K + C) * 2u; voffB[i] = (unsigned)(Rb * K + C) * 2u; }
    const size_t kstep = (size_t)(BK * 2);
    const size_t hstep = (size_t)HALF * K * 2;
    const size_t tstep = 2 * hstep;
    const size_t bstep = HALFN ? hstep : tstep;
    static_assert(!HALFN || SP2, "HALFN is written for the SP2 loop only");
    const unsigned ldsw = (unsigned)wid * 1024u;
    const int aoff = lds_byte(wr * 64 + fr, fq * 8), boff = lds_byte(wc * 32 + fr, fq * 8);
#define PG8_SA(b, h) (((b) * 2 + (h)) * HTB)
#define PG8_SB(b, h) ((4 + (b) * 2 + (h)) * HTB)
#define PG8_STAGE(bufoff, gbase, voff) do { _Pragma("unroll") for (int _i = 0; _i < 2; ++_i) \
        __builtin_amdgcn_global_load_lds((const unsigned*)((const char*)(gbase) + (voff)[_i]), (PG8_LAS unsigned*)(lds + (bufoff) + ldsw + _i * 8192), 16, 0, 0); } while (0)
#define PG8_LDA(dst, b, h) do { _Pragma("unroll") for (int m = 0; m < 4; ++m) _Pragma("unroll") for (int k = 0; k < 2; ++k) dst[m][k] = *(const PG8_LAS bf16x8*)(lds + PG8_SA(b, h) + aoff + m * 2048 + k * 1024); } while (0)
#define PG8_LDB(dst, b, h) do { _Pragma("unroll") for (int n = 0; n < 2; ++n) _Pragma("unroll") for (int k = 0; k < 2; ++k) dst[n][k] = *(const PG8_LAS bf16x8*)(lds + PG8_SB(b, h) + boff + n * 2048 + k * 1024); } while (0)
#define PG8_MMA(ai, bj, At, Bt) do { __builtin_amdgcn_s_setprio(1); _Pragma("unroll") for (int m = 0; m < 4; ++m) _Pragma("unroll") for (int n = 0; n < 2; ++n) _Pragma("unroll") for (int k = 0; k < 2; ++k) \
        acc[ai][bj][m][n] = __builtin_amdgcn_mfma_f32_16x16x32_bf16(Bt[n][k], At[m][k], acc[ai][bj][m][n], 0, 0, 0); __builtin_amdgcn_s_setprio(0); } while (0)
#define PG8_WAIT_V(n) asm volatile("s_waitcnt vmcnt(" #n ")" ::: "memory")
#define PG8_WAIT_L(n) asm volatile("s_waitcnt lgkmcnt(" #n ")" ::: "memory")
#define PG8_BAR __builtin_amdgcn_s_barrier()
#define PG8_SCHED __builtin_amdgcn_sched_barrier(0)
    Unit cur, nxt; int ui = 0;
    if (!S.next(0, cur)) return;
    f32x4 acc[2][2][4][2];
#pragma unroll
    for (int a = 0; a < 2; ++a)
#pragma unroll
        for (int b = 0; b < 2; ++b)
#pragma unroll
            for (int m = 0; m < 4; ++m)
#pragma unroll
                for (int n = 0; n < 2; ++n) acc[a][b][m][n] = (f32x4){0.f, 0.f, 0.f, 0.f};
    bf16x8 At[4][2], B0[2][2], B1[2][2];
    const char* cA = (const char*)g.A + (size_t)cur.pm * tstep; const char* cB = (const char*)g.Bt + (size_t)cur.pn * bstep;
    S.a_ready(cur);
    if constexpr (Epi::STAGE_IN) E.stage_in(cur, 0, wid, lane, lds + STAGE_BYTES);
    if constexpr (HALFN) {
        PG8_STAGE(PG8_SB(0, 0), cB, voffB); PG8_STAGE(PG8_SA(0, 0), cA, voffA); PG8_STAGE(PG8_SA(0, 1), cA + hstep, voffA);
        if (wr == 1) PG8_BAR;
        PG8_WAIT_V(2); PG8_BAR;
        PG8_STAGE(PG8_SB(1, 0), cB + kstep, voffB); PG8_STAGE(PG8_SA(1, 0), cA + kstep, voffA);
        PG8_WAIT_V(4); PG8_BAR;
    } else if constexpr (SP2) {
        PG8_STAGE(PG8_SB(0, 0), cB, voffB); PG8_STAGE(PG8_SB(0, 1), cB + hstep, voffB); PG8_STAGE(PG8_SA(0, 0), cA, voffA); PG8_STAGE(PG8_SA(0, 1), cA + hstep, voffA);
        if (wr == 1) PG8_BAR;
        PG8_WAIT_V(2); PG8_BAR;
        PG8_STAGE(PG8_SB(1, 0), cB + kstep, voffB); PG8_STAGE(PG8_SA(1, 0), cA + kstep, voffA); PG8_STAGE(PG8_SB(1, 1), cB + hstep + kstep, voffB);
        PG8_WAIT_V(6); PG8_BAR;
    } else {
        PG8_STAGE(PG8_SB(0, 0), cB, voffB); PG8_STAGE(PG8_SA(0, 0), cA, voffA); PG8_STAGE(PG8_SB(0, 1), cB + hstep, voffB); PG8_STAGE(PG8_SA(0, 1), cA + hstep, voffA);
        if (wr == 1) PG8_BAR;
        PG8_WAIT_V(4); PG8_BAR;
        PG8_STAGE(PG8_SB(1, 0), cB + kstep, voffB); PG8_STAGE(PG8_SA(1, 0), cA + kstep, voffA); PG8_STAGE(PG8_SB(1, 1), cB + hstep + kstep, voffB);
        PG8_WAIT_V(6); PG8_BAR;
    }
    for (;;) {
        const bool has_next = S.next(ui + 1, nxt);
        const char* nA = has_next ? (const char*)g.A + (size_t)nxt.pm * tstep : cA; const char* nB = has_next ? (const char*)g.Bt + (size_t)nxt.pn * bstep : cB;
        for (int t = 0; t < nt; t += 2) {
            const bool last = (t == nt - 2);
            const char* a1 = cA + (size_t)(t + 1) * kstep;
            const char* a2 = last ? nA : cA + (size_t)(t + 2) * kstep; const char* b2 = last ? nB : cB + (size_t)(t + 2) * kstep;
            const char* a3 = a2 + kstep; const char* b3 = b2 + kstep;
            if (last && has_next) S.a_ready(nxt);
            if constexpr (Epi::STAGE_IN) { if (last && has_next) E.stage_in(nxt, (ui + 1) & 1, wid, lane, lds + STAGE_BYTES); }
            if constexpr (HALFN) {
            PG8_LDB(B0, 0, 0); PG8_SCHED; PG8_LDA(At, 0, 0); PG8_STAGE(PG8_SA(1, 1), a1 + hstep, voffA);
            PG8_WAIT_V(6); PG8_WAIT_L(0); PG8_BAR; PG8_MMA(0, 0, At, B0); PG8_BAR; PG8_SCHED;
            PG8_LDA(At, 0, 1); PG8_STAGE(PG8_SB(0, 0), b2, voffB); PG8_STAGE(PG8_SA(0, 0), a2, voffA);
            PG8_WAIT_V(6); PG8_WAIT_L(0); PG8_BAR; PG8_MMA(1, 0, At, B0); PG8_BAR; PG8_SCHED;
            PG8_LDB(B0, 1, 0); PG8_SCHED; PG8_LDA(At, 1, 0); PG8_STAGE(PG8_SA(0, 1), a2 + hstep, voffA);
            PG8_WAIT_V(6); PG8_WAIT_L(0); PG8_BAR; PG8_MMA(0, 0, At, B0); PG8_BAR; PG8_SCHED;
            PG8_LDA(At, 1, 1); PG8_STAGE(PG8_SB(1, 0), b3, voffB); PG8_STAGE(PG8_SA(1, 0), a3, voffA);
            PG8_WAIT_V(6); PG8_WAIT_L(0); PG8_BAR; PG8_MMA(1, 0, At, B0); PG8_BAR; PG8_SCHED;
            } else if constexpr (SP2) {
            PG8_LDB(B0, 0, 0); PG8_LDB(B1, 0, 1); PG8_SCHED; PG8_LDA(At, 0, 0); PG8_STAGE(PG8_SA(1, 1), a1 + hstep, voffA);
            PG8_WAIT_V(8); PG8_WAIT_L(0); PG8_BAR; PG8_MMA(0, 0, At, B0); PG8_MMA(0, 1, At, B1); PG8_BAR; PG8_SCHED;
            PG8_LDA(At, 0, 1); PG8_STAGE(PG8_SB(0, 0), b2, voffB); PG8_STAGE(PG8_SB(0, 1), b2 + hstep, voffB); PG8_STAGE(PG8_SA(0, 0), a2, voffA);
            PG8_WAIT_V(8); PG8_WAIT_L(0); PG8_BAR; PG8_MMA(1, 0, At, B0); PG8_MMA(1, 1, At, B1); PG8_BAR; PG8_SCHED;
            PG8_LDB(B0, 1, 0); PG8_LDB(B1, 1, 1); PG8_SCHED; PG8_LDA(At, 1, 0); PG8_STAGE(PG8_SA(0, 1), a2 + hstep, voffA);
            PG8_WAIT_V(8); PG8_WAIT_L(0); PG8_BAR; PG8_MMA(0, 0, At, B0); PG8_MMA(0, 1, At, B1); PG8_BAR; PG8_SCHED;
            PG8_LDA(At, 1, 1); PG8_STAGE(PG8_SB(1, 0), b3, voffB); PG8_STAGE(PG8_SB(1, 1), b3 + hstep, voffB); PG8_STAGE(PG8_SA(1, 0), a3, voffA);
            PG8_WAIT_V(8); PG8_WAIT_L(0); PG8_BAR; PG8_MMA(1, 0, At, B0); PG8_MMA(1, 1, At, B1); PG8_BAR; PG8_SCHED;
            } else {
            PG8_LDB(B0, 0, 0); PG8_SCHED; PG8_LDA(At, 0, 0); PG8_STAGE(PG8_SA(1, 1), a1 + hstep, voffA);
            PG8_WAIT_L(8); PG8_BAR; PG8_WAIT_L(0); PG8_MMA(0, 0, At, B0); PG8_BAR; PG8_SCHED;
            PG8_LDB(B1, 0, 1); PG8_STAGE(PG8_SB(0, 0), b2, voffB);
            PG8_BAR; PG8_WAIT_L(0); PG8_MMA(0, 1, At, B1); PG8_BAR;
            PG8_LDA(At, 0, 1); PG8_STAGE(PG8_SA(0, 0), a2, voffA);
            PG8_BAR; PG8_WAIT_L(0); PG8_MMA(1, 0, At, B0); PG8_BAR; PG8_SCHED;
            PG8_STAGE(PG8_SB(0, 1), b2 + hstep, voffB);
            PG8_WAIT_V(6); PG8_BAR; PG8_MMA(1, 1, At, B1); PG8_BAR;
            PG8_LDB(B0, 1, 0); PG8_SCHED; PG8_LDA(At, 1, 0); PG8_STAGE(PG8_SA(0, 1), a2 + hstep, voffA);
            PG8_WAIT_L(8); PG8_BAR; PG8_WAIT_L(0); PG8_MMA(0, 0, At, B0); PG8_BAR; PG8_SCHED;
            PG8_LDB(B1, 1, 1); PG8_STAGE(PG8_SB(1, 0), b3, voffB);
            PG8_BAR; PG8_WAIT_L(0); PG8_MMA(0, 1, At, B1); PG8_BAR;
            PG8_LDA(At, 1, 1); PG8_STAGE(PG8_SA(1, 0), a3, voffA);
            PG8_BAR; PG8_WAIT_L(0); PG8_MMA(1, 0, At, B0); PG8_BAR; PG8_SCHED;
            PG8_STAGE(PG8_SB(1, 1), b3 + hstep, voffB);
            PG8_WAIT_V(6); PG8_BAR; PG8_MMA(1, 1, At, B1); PG8_BAR;
            }
        }
        if constexpr (ALIGN_EPI) { if (wr == 0) PG8_BAR; }
        if constexpr (!Epi::AFTER_DRAIN) { E(acc, cur, wr, wc, fr, fq, lds + STAGE_BYTES + (ui & 1) * 2048); S.done(cur); }
        if (!has_next) break;
#pragma unroll
        for (int a = 0; a < 2; ++a)
#pragma unroll
            for (int b = 0; b < 2; ++b)
#pragma unroll
                for (int m = 0; m < 4; ++m)
#pragma unroll
                    for (int n = 0; n < 2; ++n) acc[a][b][m][n] = (f32x4){0.f, 0.f, 0.f, 0.f};
        cur = nxt; cA = nA; cB = nB; ++ui;
        if constexpr (ALIGN_EPI) { if (wr == 1) PG8_BAR; }
    }
    PG8_WAIT_V(0);
    if constexpr (!ALIGN_EPI) { if (wr == 0) PG8_BAR; }
    PG8_BAR;
    if constexpr (Epi::AFTER_DRAIN) { E.fused(acc, cur, wr, wc, fr, fq, lds, wid, lane); S.done(cur); }
#undef PG8_SA
#undef PG8_SB
#undef PG8_STAGE
#undef PG8_LDA
#undef PG8_LDB
#undef PG8_MMA
#undef PG8_WAIT_V
#undef PG8_WAIT_L
#undef PG8_BAR
#undef PG8_SCHED
}
}
constexpr int NWAVES = 8, NTHR = 512;
constexpr size_t MiB = 1u << 20;
constexpr size_t WS_CTL = 0, CTL_ZERO_BYTES = 1 * MiB;
constexpr size_t WS_MODS = 256 * 1024;
constexpr size_t WS_STAT = 768 * 1024;
constexpr size_t WS_SW = 372 * MiB, WS_GT = 374 * MiB;
constexpr size_t WS_ROPE = 1 * MiB;
constexpr size_t WS_W = 2 * MiB;
constexpr size_t W_MLA = WS_W, MLA_WB = 5898240;
constexpr size_t MW_CAT = 0, MW_UQ = 1572864, MW_UKV = 2752512, MW_O = 3801088;
constexpr size_t W_CV1 = WS_W + 2 * MLA_WB, W_CV2 = W_CV1 + 4 * MiB;
constexpr size_t W_SSI = W_CV2 + 2 * MiB, W_SSO = W_SSI + 11010048;
constexpr size_t W_FF = W_SSO + 4 * MiB, FF_WB = 17301504, FW_IN = 0, FW_OUT = 11534336;
static_assert(W_FF + 4 * FF_WB <= 102 * MiB, "weights region");
constexpr size_t WS_H = 102 * MiB;
constexpr size_t WS_CKV = 118 * MiB, CKV_B = (size_t)(T + NCTX) * KVL * 2;
constexpr size_t WS_AR = 128 * MiB;
constexpr size_t A_LAT = WS_AR, A_QN = A_LAT + 24 * MiB, A_QRAW = A_QN + 6 * MiB, A_KVRAW = A_QRAW + 24 * MiB, A_QB = A_KVRAW + 36 * MiB, A_KB = A_QB + 24 * MiB, A_AO = A_KB + 27 * MiB;
constexpr size_t A_U = WS_AR, A_V = A_U + 16 * MiB;
constexpr size_t A_Z = WS_AR, A_XPRE = A_Z + 32 * MiB, A_DTRAW = A_XPRE + 48 * MiB, A_XBC = A_DTRAW + 2 * MiB, A_DT = A_XBC + 48 * MiB, A_Y = A_DT + 2 * MiB, A_YN = A_XPRE, A_ACUM = A_Y + 64 * MiB;
constexpr size_t A_ACT = WS_AR + 200 * MiB;
static_assert(A_AO + 16 * MiB <= A_ACT && A_ACUM + 2 * MiB <= A_ACT && A_ACT + 44 * MiB <= 384 * MiB, "arena map");
constexpr size_t WS_STQ = 64 * 1024, WS_STKV = 128 * 1024;
constexpr int CW_BAR = 4096;
constexpr int LDS_BYTES = 163840, RING_BYTES = 131072, MISC_OFF = 163840 - 256, PTAB_OFF_C = MISC_OFF - 512;

#define GAS __attribute__((address_space(1)))
#define LAS __attribute__((address_space(3)))
typedef unsigned short bf16;
typedef unsigned v4u __attribute__((ext_vector_type(4)));
typedef unsigned v2u __attribute__((ext_vector_type(2)));
typedef float v4f __attribute__((ext_vector_type(4)));
typedef float v2f __attribute__((ext_vector_type(2)));
typedef GAS unsigned gu32;
#define LDS_WAIT() asm volatile("s_waitcnt lgkmcnt(0)" ::: "memory")
#define LDS_BARRIER() do { asm volatile("s_waitcnt lgkmcnt(0)" ::: "memory"); __builtin_amdgcn_s_barrier(); asm volatile("" ::: "memory"); } while (0)
#define VM_WAIT() asm volatile("s_waitcnt vmcnt(0)" ::: "memory")
__device__ __forceinline__ unsigned f2bf(float f) { unsigned u = __builtin_bit_cast(unsigned, f); return (u + 0x7fffu + ((u >> 16) & 1u)) >> 16; }
__device__ __forceinline__ unsigned pk2(float lo, float hi) { unsigned r; asm("v_cvt_pk_bf16_f32 %0, %1, %2" : "=v"(r) : "v"(lo), "v"(hi)); return r; }
__device__ __forceinline__ float fast_sig(float x) { return __builtin_amdgcn_rcpf(1.f + __builtin_amdgcn_exp2f(-1.4426950408889634f * x)); }
__device__ __forceinline__ float bflo(unsigned u) { return __builtin_bit_cast(float, u << 16); }
__device__ __forceinline__ float bfhi(unsigned u) { return __builtin_bit_cast(float, u & 0xffff0000u); }
__device__ __forceinline__ float bf2f(bf16 b) { return __builtin_bit_cast(float, (unsigned)b << 16); }

#define XB_TMO      128
#define XB_XCNT(j)  (256  + 64 * (j))
#define XB_XSUB(j)  (1280 + 64 * (j))
#define XB_XGEN(j)  (2304 + 64 * (j))
#define XB_TOP      3328
#define XB_TOPGEN   3392
#define XCD_BAR_WORDS 3456
#define XB_SPIN_CAP (1u << 18)

__device__ __forceinline__ unsigned xb_ld(unsigned* p)              { return __hip_atomic_load(p, __ATOMIC_RELAXED, __HIP_MEMORY_SCOPE_AGENT); }
__device__ __forceinline__ unsigned xb_add(unsigned* p, unsigned v) { return __hip_atomic_fetch_add(p, v, __ATOMIC_RELAXED, __HIP_MEMORY_SCOPE_AGENT); }
__device__ __forceinline__ unsigned xb_xcc_id() { return (unsigned)__builtin_amdgcn_s_getreg((3 << 11) | 20) & 0xFu; }
#define XB_SPIN(cond, bar) do { unsigned _sp = 0; while (cond) { __builtin_amdgcn_s_sleep(1); \
    if ((++_sp & 255u) == 0u) { if (xb_ld(&(bar)[XB_TMO])) break; if (_sp > XB_SPIN_CAP) { atomicAdd(&(bar)[XB_TMO], 1u); break; } } } } while (0)

struct XcdBarrier {
    unsigned* bar; unsigned x;
    volatile LAS unsigned* st;
};

__device__ __forceinline__ XcdBarrier xcd_barrier_post(unsigned* bar, volatile LAS unsigned* st) {
    XcdBarrier b; b.bar = bar; b.x = xb_xcc_id(); b.st = st;
    if (threadIdx.x == 0) (void)xb_add(&bar[XB_XCNT(b.x)], 1u);
    return b;
}
__device__ __forceinline__ void xcd_barrier_complete(unsigned* bar, unsigned x, unsigned& nloc, unsigned& nx) {
    const unsigned G = gridDim.x * gridDim.y * gridDim.z;
    unsigned sum, cnt, mine, sp = 0u;
    for (;;) {
        sum = 0u; cnt = 0u; mine = 0u;
#pragma unroll
        for (unsigned j = 0; j < 16; j += 8) {
            unsigned c[8]; const unsigned* p = bar + XB_XCNT(j);
            asm volatile("global_load_dword %0, %8, off sc1\n\tglobal_load_dword %1, %8, off offset:256 sc1\n\tglobal_load_dword %2, %8, off offset:512 sc1\n\tglobal_load_dword %3, %8, off offset:768 sc1\n\t"
                         "global_load_dword %4, %8, off offset:1024 sc1\n\tglobal_load_dword %5, %8, off offset:1280 sc1\n\tglobal_load_dword %6, %8, off offset:1536 sc1\n\tglobal_load_dword %7, %8, off offset:1792 sc1\n\t"
                         "s_waitcnt vmcnt(0)"
                         : "=&v"(c[0]), "=&v"(c[1]), "=&v"(c[2]), "=&v"(c[3]), "=&v"(c[4]), "=&v"(c[5]), "=&v"(c[6]), "=&v"(c[7]) : "v"(p) : "memory");
#pragma unroll
            for (unsigned i = 0; i < 8; ++i) { sum += c[i]; cnt += (c[i] > 0u) ? 1u : 0u; mine = (j + i == x) ? c[i] : mine; } }
        if (sum == G) break;
        __builtin_amdgcn_s_sleep(1);
        if ((++sp & 255u) == 0u) { if (xb_ld(&bar[XB_TMO])) break; if (sp > XB_SPIN_CAP) { atomicAdd(&bar[XB_TMO], 1u); break; } }
    }
    nloc = mine > 0u ? mine : 1u; nx = cnt > 0u ? cnt : 1u;
}

__device__ __forceinline__ void xcd_barrier_protocol(const XcdBarrier& b) {
    {
        unsigned* bar = b.bar;
        __builtin_amdgcn_s_waitcnt(0);
        unsigned nloc = b.st[0], nx = b.st[1];
        if (nloc == 0u) { xcd_barrier_complete(bar, b.x, nloc, nx); b.st[0] = nloc; b.st[1] = nx; }
        const unsigned old = xb_add(&bar[XB_XSUB(b.x)], 1u);
        const unsigned gen = old / nloc;
        if (old + 1u == (gen + 1u) * nloc) {
            __builtin_amdgcn_fence(__ATOMIC_RELEASE, "agent");
            asm volatile("s_waitcnt vmcnt(0)" ::: "memory");
            const unsigned og = xb_add(&bar[XB_TOP], 1u);
            const unsigned tg = og / nx;
            if (og + 1u == (tg + 1u) * nx) xb_add(&bar[XB_TOPGEN], 1u);
            else XB_SPIN(xb_ld(&bar[XB_TOPGEN]) == tg, bar);
            __builtin_amdgcn_fence(__ATOMIC_ACQUIRE, "agent");
            xb_add(&bar[XB_XGEN(b.x)], 1u);
            asm volatile("s_waitcnt vmcnt(0)" ::: "memory");
        } else {
            XB_SPIN(xb_ld(&bar[XB_XGEN(b.x)]) == gen, bar);
            __builtin_amdgcn_fence(__ATOMIC_ACQUIRE, "agent");
            asm volatile("s_waitcnt vmcnt(0)" ::: "memory");
        }
    }
}
__device__ __forceinline__ void xcd_barrier(const XcdBarrier& b) {
    asm volatile("s_waitcnt vmcnt(0)" ::: "memory");
    __syncthreads();
    if (threadIdx.x == 0) xcd_barrier_protocol(b);
    __syncthreads();
}
struct Frame {
    LAS unsigned char* lds; int tid, lane, wave, vcu, G, gw, NGW, bx;
    volatile LAS unsigned* PT;
};
constexpr int PT_OUT = 38, PT_WS = 39;
__device__ __forceinline__ const float* ldp(volatile LAS unsigned* PT, int k) {
    const unsigned lo = __builtin_amdgcn_readfirstlane(PT[2 * k]), hi = __builtin_amdgcn_readfirstlane(PT[2 * k + 1]);
    return (const float*)(((unsigned long long)hi << 32) | lo);
}
#define INP(k) ldp(F.PT, (k))
#define WSP ((unsigned char*)ldp(F.PT, PT_WS))
#define OUTP ((float*)ldp(F.PT, PT_OUT))
enum InIdx { I_XP = 0, I_XS, I_CCKV, I_CKPE, I_SSM, I_C, I_CCTX, I_WADA, I_BADA, I_GN1, I_GN2, I_WDQ, I_GQ, I_WUQ, I_WDKV, I_GKV, I_WUKV, I_GQN, I_GKN, I_WO,
             I_CVW1, I_CVB1, I_CVWD, I_CVBD, I_CVGL, I_CVBL, I_CVW2, I_CVB2, I_SSWI, I_SSWC, I_SSBC, I_SSDTB, I_SSAL, I_SSD, I_SSGN, I_SSWO, I_FFWI, I_FFWO };
__device__ __forceinline__ float shx(float v, int lane, int o) { return __builtin_bit_cast(float, __builtin_amdgcn_ds_bpermute((lane ^ o) << 2, __builtin_bit_cast(int, v))); }
__device__ __forceinline__ float wsum(float v, int lane) {
#pragma unroll
    for (int o = 1; o < 64; o <<= 1) v += shx(v, lane, o);
    return v;
}
constexpr float QSCALE = 0.10206207261596577f * 1.4426950408889634f;

struct P0Item { const float* W; bf16* WT; int K, N, mode, H, roff, k0, n0; const float* sh; float* sw; };
__device__ __forceinline__ void p0_item_load(const P0Item& J, int lane, v4f (&t)[8]) {
#pragma unroll
    for (int i = 0; i < 8; ++i) t[i] = *(const GAS v4f*)(J.W + (size_t)(J.k0 + 8 * i + (lane >> 3)) * J.N + J.n0 + 4 * (lane & 7));
}
__device__ __forceinline__ void p0_item_shift(const P0Item& J, int lane, v4f (&sv)[5][2]) {
#pragma unroll
    for (int cc = 0; cc < 5; ++cc) { const float* sp = J.sh + (size_t)cc * 6144 + J.k0 + 8 * (lane & 7); sv[cc][0] = *(const GAS v4f*)sp; sv[cc][1] = *(const GAS v4f*)(sp + 4); }
}
__device__ __forceinline__ void p0_item_finish(const P0Item& J, int lane, const v4f (&t)[8], LAS float* scr, const v4f (&sv)[5][2]) {
#pragma unroll
    for (int i = 0; i < 8; ++i) { LAS float* d = scr + (8 * i + (lane >> 3)) * 33 + 4 * (lane & 7); d[0] = t[i].x; d[1] = t[i].y; d[2] = t[i].z; d[3] = t[i].w; }
    LDS_WAIT(); asm volatile("" ::: "memory");
    const int c = lane & 7;
#pragma unroll
    for (int j = 0; j < 4; ++j) { const int n = (lane >> 3) + 8 * j, col = J.n0 + n; const LAS float* s = scr + (8 * c) * 33 + n;
        int drow;
        if (J.mode == 0) drow = J.roff + col;
        else { const int f = col < J.H ? col : col - J.H; drow = 256 * (f >> 7) + 128 * ((f >> 2) & 1) + 32 * ((f >> 5) & 3) + (col < J.H ? 0 : 16) + 4 * ((f >> 3) & 3) + (f & 3); }
        v4u o; o.x = pk2(s[0 * 33], s[1 * 33]); o.y = pk2(s[2 * 33], s[3 * 33]); o.z = pk2(s[4 * 33], s[5 * 33]); o.w = pk2(s[6 * 33], s[7 * 33]);
        *(GAS v4u*)(J.WT + (size_t)drow * J.K + J.k0 + 8 * c) = o; }
    if (J.sw) {
        float pw[4][5];
#pragma unroll
        for (int cc = 0; cc < 5; ++cc) { const v4f s0 = sv[cc][0], s1 = sv[cc][1];
#pragma unroll
            for (int j = 0; j < 4; ++j) { const LAS float* q = scr + (8 * c) * 33 + (lane >> 3) + 8 * j;
                pw[j][cc] = (s0.x * q[0 * 33] + s0.y * q[1 * 33] + s0.z * q[2 * 33] + s0.w * q[3 * 33]) + (s1.x * q[4 * 33] + s1.y * q[5 * 33] + s1.z * q[6 * 33] + s1.w * q[7 * 33]); } }
#pragma unroll
        for (int o = 1; o < 8; o <<= 1) {
#pragma unroll
            for (int j = 0; j < 4; ++j)
#pragma unroll
                for (int cc = 0; cc < 5; ++cc) pw[j][cc] += shx(pw[j][cc], lane, o); }
        if (c == 0) {
#pragma unroll
            for (int j = 0; j < 4; ++j) { const int col = J.n0 + (lane >> 3) + 8 * j; int drow;
                if (J.mode == 0) drow = J.roff + col;
                else { const int f = col < J.H ? col : col - J.H; drow = 256 * (f >> 7) + 128 * ((f >> 2) & 1) + 32 * ((f >> 5) & 3) + (col < J.H ? 0 : 16) + 4 * ((f >> 3) & 3) + (f & 3); }
#pragma unroll
                for (int cc = 0; cc < 5; ++cc) atomicAdd(J.sw + (size_t)cc * pg8::SW_LD + drow, pw[j][cc]); } }
    }
    LDS_WAIT(); asm volatile("" ::: "memory");
}
__device__ __forceinline__ void p0_job(int q, int& inp, size_t& soff, int& K, int& N, size_t& doff, int& mode, int& H, int& roff) {
    mode = 0; H = 0; roff = 0; soff = 0;
    if (q < 10) { const int j = q / 5, t = q % 5; const size_t wb = W_MLA + (size_t)j * MLA_WB;
        if (t == 0) { inp = I_WDQ; soff = (size_t)j * 1024 * 384; K = 1024; N = 384; doff = wb + MW_CAT; }
        else if (t == 1) { inp = I_WDKV; soff = (size_t)j * 1024 * 288; K = 1024; N = 288; doff = wb + MW_CAT; roff = 384; }
        else if (t == 2) { inp = I_WUQ; soff = (size_t)j * 384 * 1536; K = 384; N = 1536; doff = wb + MW_UQ; }
        else if (t == 3) { inp = I_WUKV; soff = (size_t)j * 256 * 2048; K = 256; N = 2048; doff = wb + MW_UKV; }
        else { inp = I_WO; soff = (size_t)j * 1024 * 1024; K = 1024; N = 1024; doff = wb + MW_O; } }
    else if (q == 10) { inp = I_CVW1; K = 1024; N = 2048; doff = W_CV1; mode = 1; H = 1024; }
    else if (q == 11) { inp = I_CVW2; K = 1024; N = 1024; doff = W_CV2; }
    else if (q == 12) { inp = I_SSWI; K = 1024; N = 5184; doff = W_SSI; }
    else if (q == 13) { inp = I_SSWO; K = 2048; N = 1024; doff = W_SSO; }
    else { const int l = (q - 14) >> 1, t = (q - 14) & 1;
        if (t == 0) { inp = I_FFWI; soff = (size_t)l * 1024 * 5632; K = 1024; N = 5632; doff = W_FF + (size_t)l * FF_WB + FW_IN; mode = 1; H = 2816; }
        else { inp = I_FFWO; soff = (size_t)l * 2816 * 1024; K = 2816; N = 1024; doff = W_FF + (size_t)l * FF_WB + FW_OUT; } }
}
__device__ __forceinline__ int p0_sw_of_job(int q) { return q == 10 ? 2 : q == 12 ? 4 : (q == 5 || q == 6) ? 6 : (q >= 16 && !((q - 14) & 1)) ? 2 * ((q - 14) >> 1) + 1 : -1; }
constexpr int P0_NITEMS = 2 * ((1024 / 64) * (384 / 32) + (1024 / 64) * (288 / 32) + (384 / 64) * (1536 / 32) + (256 / 64) * (2048 / 32) + (1024 / 64) * (1024 / 32))
                        + (1024 / 64) * (2048 / 32) + (1024 / 64) * (1024 / 32) + (1024 / 64) * (5184 / 32) + (2048 / 64) * (1024 / 32)
                        + 4 * ((1024 / 64) * (5632 / 32) + (2816 / 64) * (1024 / 32));
__device__ __forceinline__ void p0_convert(Frame& F, unsigned qmask, int ww, int nww, bool fuse) {
    unsigned char* ws = WSP;
    LAS float* scr = (LAS float*)(F.lds + F.wave * 8448);
    int total = 0;
#pragma unroll 1
    for (int q = 0; q < 22; ++q) if ((qmask >> q) & 1u) { int inp, K, N, mode, H, roff; size_t soff, doff; p0_job(q, inp, soff, K, N, doff, mode, H, roff); total += (K / 64) * (N / 32); }
    for (int it = ww; it < total; it += 2 * nww) {
        P0Item J[2]; bool have1 = it + nww < total;
#pragma unroll
        for (int e = 0; e < 2; ++e) {
            int r = e == 0 ? it : (have1 ? it + nww : it), inp = 0, K = 64, N = 32, mode = 0, H = 0, roff = 0, qq = 0; size_t soff = 0, doff = 0;
#pragma unroll 1
            for (int q = 0; q < 22; ++q) { if (!((qmask >> q) & 1u)) continue; p0_job(q, inp, soff, K, N, doff, mode, H, roff); qq = q; const int ni = (K / 64) * (N / 32); if (r < ni) break; r -= ni; }
            const int nblk = N / 32;
            J[e].W = INP(inp) + soff; J[e].WT = (bf16*)(ws + doff); J[e].K = K; J[e].N = N; J[e].mode = mode; J[e].H = H; J[e].roff = roff; J[e].k0 = 64 * (r / nblk); J[e].n0 = 32 * (r % nblk);
            const int sidx = fuse ? p0_sw_of_job(qq) : -1;
            J[e].sh = nullptr; J[e].sw = nullptr;
            if (sidx >= 0) { J[e].sh = (const float*)(ws + WS_MODS) + (size_t)(sidx >> 1) * 5 * 6144 + ((sidx & 1) ? 3072 : 0); J[e].sw = (float*)(ws + WS_SW) + (size_t)sidx * 5 * pg8::SW_LD; }
        }
        v4f t0[8], t1[8];
        p0_item_load(J[0], F.lane, t0); p0_item_load(J[1], F.lane, t1);
        v4f sv0[5][2], sv1[5][2];
#pragma unroll
        for (int cc = 0; cc < 5; ++cc) { sv0[cc][0] = sv0[cc][1] = sv1[cc][0] = sv1[cc][1] = (v4f){0.f, 0.f, 0.f, 0.f}; }
        if (J[0].sw) p0_item_shift(J[0], F.lane, sv0);
        if (J[1].sw) p0_item_shift(J[1], F.lane, sv1);
        p0_item_finish(J[0], F.lane, t0, scr, sv0);
        if (have1) p0_item_finish(J[1], F.lane, t1, scr, sv1);
    }
}
constexpr unsigned P0_Q_NOW = 0x1fu | (1u << 14);
constexpr int P0_WIN_LAST = 12;
__device__ __forceinline__ int p0_def_job(int i) { return i == 0 ? 15 : i == 1 ? 10 : i == 2 ? 11 : i == 3 ? 16 : i == 4 ? 17 : i == 5 ? 12 : i == 6 ? 13 : i == 7 ? 18 : i == 8 ? 19 : i < 14 ? i - 4 : i == 14 ? 20 : 21; }
constexpr int P0_WIN_CAP = 1792;
static_assert(P0_WIN_CAP * P0_WIN_LAST >= 20624, "deferred items fit the windows");
__device__ __forceinline__ bool p0_def_item(Frame& F, int r, P0Item& J) {
    unsigned char* ws = WSP;
    int inp = 0, K = 64, N = 32, mode = 0, H = 0, roff = 0, qq = 0; size_t soff = 0, doff = 0; bool found = false;
#pragma unroll 1
    for (int i = 0; i < 16; ++i) { qq = p0_def_job(i); p0_job(qq, inp, soff, K, N, doff, mode, H, roff); const int ni = (K / 64) * (N / 32); if (r < ni) { found = true; break; } r -= ni; }
    if (!found) return false;
    const int nblk = N / 32;
    J.W = INP(inp) + soff; J.WT = (bf16*)(ws + doff); J.K = K; J.N = N; J.mode = mode; J.H = H; J.roff = roff; J.k0 = 64 * (r / nblk); J.n0 = 32 * (r % nblk);
    const int sidx = p0_sw_of_job(qq); J.sh = nullptr; J.sw = nullptr;
    if (sidx >= 0) { J.sh = (const float*)(ws + WS_MODS) + (size_t)(sidx >> 1) * 5 * 6144 + ((sidx & 1) ? 3072 : 0); J.sw = (float*)(ws + WS_SW) + (size_t)sidx * 5 * pg8::SW_LD; }
    return true;
}
constexpr int P0_DUMP = 161792;
static_assert(P0_DUMP + 1024 <= PTAB_OFF_C, "prefetch dump area");
__device__ __forceinline__ void p0_window(Frame& F, int w) {
    for (int e = F.bx * (NWAVES - 1) + (F.wave - 1); e < P0_WIN_CAP; e += F.G * (NWAVES - 1)) {
        P0Item J;
        if (!p0_def_item(F, (w - 1) * P0_WIN_CAP + e, J)) return;
        v4f t0[8], sv[5][2];
        p0_item_load(J, F.lane, t0);
#pragma unroll
        for (int cc = 0; cc < 5; ++cc) { sv[cc][0] = sv[cc][1] = (v4f){0.f, 0.f, 0.f, 0.f}; }
        if (J.sw) p0_item_shift(J, F.lane, sv);
        p0_item_finish(J, F.lane, t0, (LAS float*)(F.lds + F.wave * 8448), sv);
    }
}
__device__ __forceinline__ void xcd_barrier_work(const XcdBarrier& b, Frame& F, int w) {
    asm volatile("s_waitcnt vmcnt(0)" ::: "memory");
    __syncthreads();
    if (threadIdx.x == 0) xcd_barrier_protocol(b);
    if (F.wave != 0 && w >= 1 && w <= P0_WIN_LAST) p0_window(F, w);
    __syncthreads();
}
__device__ __forceinline__ void p0_prologue(Frame& F) {
    unsigned char* ws = WSP;
    LAS float* s = (LAS float*)F.lds;
    for (int i = F.tid; i < 5 * 1024; i += NTHR) { const int cc = i >> 10, k = i & 1023; const float v = cc == 0 ? INP(I_CCTX)[k] : INP(I_C)[(cc - 1) * 1024 + k]; s[i] = v / (1.f + expf(-v)); }
    __syncthreads();
    float* mods = (float*)(ws + WS_MODS);
    for (int it = F.bx; it < 192; it += F.G) {
        const int l = it / 48, r = it % 48, cb = r / 16, ks = r % 16, n = cb * 2048 + 4 * F.tid;
        const float* W = INP(I_WADA) + (size_t)l * 1024 * 6144 + (size_t)(ks * 64) * 6144 + n;
        v4f acc[5];
#pragma unroll
        for (int cc = 0; cc < 5; ++cc) acc[cc] = (v4f){0.f, 0.f, 0.f, 0.f};
#pragma unroll 1
        for (int kb = 0; kb < 64; kb += 32) {
            v4f wv[32];
#pragma unroll
            for (int k = 0; k < 32; ++k) wv[k] = *(const GAS v4f*)(W + (size_t)(kb + k) * 6144);
            __builtin_amdgcn_sched_barrier(0);
#pragma unroll
            for (int k = 0; k < 32; ++k)
#pragma unroll
                for (int cc = 0; cc < 5; ++cc) acc[cc] += wv[k] * s[cc * 1024 + ks * 64 + kb + k];
        }
        LAS float* tbl = s + 5 * 1024;
        __syncthreads();
#pragma unroll
        for (int cc = 0; cc < 5; ++cc) *(LAS v4f*)(tbl + cc * 2048 + 4 * F.tid) = acc[cc];
        __syncthreads();
        const float* bp = INP(I_BADA) + l * 6144 + cb * 2048;
#pragma unroll
        for (int q = 0; q < 4; ++q) { const int col = q * 512 + F.tid; const float bb = ks == 0 ? bp[col] : 0.f;
#pragma unroll
            for (int cc = 0; cc < 5; ++cc) atomicAdd(&mods[((size_t)l * 5 + cc) * 6144 + cb * 2048 + col], tbl[cc * 2048 + col] + bb); }
    }
    __syncthreads();
    p0_convert(F, P0_Q_NOW, F.gw, F.NGW, false);
    { float* SWz = (float*)(ws + WS_SW) + 2 * 5 * 5632; for (int idx = F.bx * NTHR + F.tid; idx < 6 * 5 * 5632; idx += F.G * NTHR) SWz[idx] = 0.f; }
    for (int it = F.gw; it < 384; it += F.NGW) {
        bf16* rowp = it < 192 ? (bf16*)(ws + W_MLA + (it / 96) * MLA_WB + MW_CAT) + (size_t)(672 + it % 96) * 1024 : (bf16*)(ws + W_SSI) + (size_t)(5184 + it - 192) * 1024;
        const v4u z = {0u, 0u, 0u, 0u}; ((GAS v4u*)rowp)[F.lane] = z; ((GAS v4u*)rowp)[64 + F.lane] = z;
    }
    for (int it = F.gw; it < 2048; it += F.NGW) {
        const int j = it >> 10, rr = it & 1023, b = rr >> 8, sq = rr & 255;
        const v4f v = ((const GAS v4f*)(INP(I_CCKV) + (((size_t)b * 2 + j) * 256 + sq) * 256))[F.lane];
        v2u o; o.x = pk2(v.x, v.y); o.y = pk2(v.z, v.w);
        ((GAS v2u*)((bf16*)(ws + WS_CKV + j * CKV_B) + (size_t)(T + rr) * 256))[F.lane] = o;
    }
    for (int i = F.bx * NTHR + F.tid; i < 2 * NCTX; i += F.G * NTHR) ((float*)(ws + WS_STKV))[(i >> 10) * (T + NCTX) + T + (i & 1023)] = 256.f * (1.f - 1e-6f);
    if (F.bx == 0) for (int i = F.tid; i < 640; i += NTHR) { const int pos = i >> 3, fi = i & 7; const float p = (float)(pos < 16 ? pos : pos - 16);
        const float a = p * rope_inv(fi); float* tab = (float*)(ws + WS_ROPE); tab[2 * i] = cosf(a); tab[2 * i + 1] = sinf(a); }
}

__device__ __forceinline__ void rp_normmod(Frame& F, const float* xlo, const float* xhi, const float* g, const float* mods_l, int sh_off, int sc_off, bf16* h) {
    for (int base = F.gw; base < T; base += 4 * F.NGW) {
        v4f v[4][4]; float ss[4]; int rows[4];
#pragma unroll
        for (int k = 0; k < 4; ++k) { const int row = base + k * F.NGW; rows[k] = row < T ? row : base;
            const GAS v4f* xr = (const GAS v4f*)((rows[k] < TP ? xlo : xhi) + (size_t)rows[k] * 1024) + F.lane;
#pragma unroll
            for (int j = 0; j < 4; ++j) v[k][j] = xr[64 * j]; }
#pragma unroll
        for (int k = 0; k < 4; ++k) { float s = 0.f;
#pragma unroll
            for (int j = 0; j < 4; ++j) s += (v[k][j].x * v[k][j].x + v[k][j].y * v[k][j].y) + (v[k][j].z * v[k][j].z + v[k][j].w * v[k][j].w);
            ss[k] = s; }
#pragma unroll
        for (int o = 1; o < 64; o <<= 1) {
#pragma unroll
            for (int k = 0; k < 4; ++k) ss[k] += shx(ss[k], F.lane, o); }
#pragma unroll
        for (int j = 0; j < 4; ++j) { const int c = 4 * F.lane + 256 * j; const v4f g4 = *(const GAS v4f*)(g + c);
#pragma unroll
            for (int k = 0; k < 4; ++k) { const float r = rsqrtf(ss[k] * (1.f / 1024) + EPS); const float* m = mods_l + (size_t)cond_of_row(rows[k]) * 6144;
                const v4f sc = *(const GAS v4f*)(m + sc_off + c), sh = *(const GAS v4f*)(m + sh_off + c);
                const v4f o = v[k][j] * r * g4 * (sc + 1.f) + sh; v2u w; w.x = pk2(o.x, o.y); w.y = pk2(o.z, o.w);
                *(GAS v2u*)(h + (size_t)rows[k] * 1024 + c) = w; } }
    }
}
__device__ __forceinline__ void rope32_tab(float* pe, int t, const float* tab) {
    const v2f* tr = (const v2f*)tab + (t >> 6) * 8; const v2f* tc = (const v2f*)tab + (16 + (t & 63)) * 8;
#pragma unroll
    for (int i = 0; i < 8; ++i) {
        v2f cs = tr[i]; float x1 = pe[i], x2 = pe[i + 8]; pe[i] = x1 * cs.x - x2 * cs.y; pe[i + 8] = x2 * cs.x + x1 * cs.y;
        cs = tc[i]; x1 = pe[16 + i]; x2 = pe[24 + i]; pe[16 + i] = x1 * cs.x - x2 * cs.y; pe[24 + i] = x2 * cs.x + x1 * cs.y;
    }
}
struct RopeCS { v4f r[4], c[4]; };
__device__ __forceinline__ void rope_load(RopeCS& R, int t, const float* tab) {
    const float* tr = tab + (t >> 6) * 16; const float* tc = tab + (16 + (t & 63)) * 16;
#pragma unroll
    for (int i = 0; i < 4; ++i) { R.r[i] = *(const GAS v4f*)(tr + 4 * i); R.c[i] = *(const GAS v4f*)(tc + 4 * i); }
}
__device__ __forceinline__ void rope_apply(float* pe, const RopeCS& R) {
#pragma unroll
    for (int i = 0; i < 8; ++i) {
        float cx = (i & 1) ? R.r[i >> 1].z : R.r[i >> 1].x, sy = (i & 1) ? R.r[i >> 1].w : R.r[i >> 1].y; float x1 = pe[i], x2 = pe[i + 8]; pe[i] = x1 * cx - x2 * sy; pe[i + 8] = x2 * cx + x1 * sy;
        cx = (i & 1) ? R.c[i >> 1].z : R.c[i >> 1].x; sy = (i & 1) ? R.c[i >> 1].w : R.c[i >> 1].y; x1 = pe[16 + i]; x2 = pe[24 + i]; pe[16 + i] = x1 * cx - x2 * sy; pe[24 + i] = x2 * cx + x1 * sy;
    }
}
__device__ __forceinline__ void ld8(const bf16* p, float* d) { const v4u w = *(const GAS v4u*)p; d[0] = bflo(w.x); d[1] = bfhi(w.x); d[2] = bflo(w.y); d[3] = bfhi(w.y); d[4] = bflo(w.z); d[5] = bfhi(w.z); d[6] = bflo(w.w); d[7] = bfhi(w.w); }
__device__ __forceinline__ void up8(const v4u w, float* d) { d[0] = bflo(w.x); d[1] = bfhi(w.x); d[2] = bflo(w.y); d[3] = bfhi(w.y); d[4] = bflo(w.z); d[5] = bfhi(w.z); d[6] = bflo(w.w); d[7] = bfhi(w.w); }
__device__ __forceinline__ void st8(bf16* p, const float* d) { v4u w; w.x = pk2(d[0], d[1]); w.y = pk2(d[2], d[3]); w.z = pk2(d[4], d[5]); w.w = pk2(d[6], d[7]); *(GAS v4u*)p = w; }
__device__ __forceinline__ void rp_tables(Frame& F) {
    unsigned char* ws = WSP; const float* mods = (const float*)(ws + WS_MODS); float* GTb = (float*)(ws + WS_GT); float* SWb = (float*)(ws + WS_SW);
    for (int idx = F.bx * NTHR + F.tid; idx < 8 * 5 * 1024; idx += F.G * NTHR) {
        const int s = idx / 5120, r = idx % 5120, c = r >> 10, k = r & 1023, layer = s >> 1;
        const float g = (s & 1) ? INP(I_GN2)[layer * 1024 + k] : INP(I_GN1)[layer * 1024 + k];
        GTb[idx] = g * (1.f + mods[((size_t)layer * 5 + c) * 6144 + ((s & 1) ? 4096 : 1024) + k]);
    }
    constexpr int NR1 = 5632;
    for (int it = F.gw; it < NR1 / 4; it += F.NGW) {
        const int s = 1, n = 4 * it; const bf16* Wt = (const bf16*)(ws + W_FF + FW_IN);
        const int layer = s >> 1, shoff = (s & 1) ? 3072 : 0;
        v4u wr[4][2];
#pragma unroll
        for (int r = 0; r < 4; ++r) { wr[r][0] = *(const GAS v4u*)(Wt + (size_t)(n + r) * 1024 + 16 * F.lane); wr[r][1] = *(const GAS v4u*)(Wt + (size_t)(n + r) * 1024 + 16 * F.lane + 8); }
        float acc[4][5];
#pragma unroll
        for (int r = 0; r < 4; ++r)
#pragma unroll
            for (int c = 0; c < 5; ++c) acc[r][c] = 0.f;
#pragma unroll
        for (int c = 0; c < 5; ++c) { const float* sp = mods + ((size_t)layer * 5 + c) * 6144 + shoff + 16 * F.lane;
            const v4f s0 = *(const GAS v4f*)sp, s1 = *(const GAS v4f*)(sp + 4), s2 = *(const GAS v4f*)(sp + 8), s3 = *(const GAS v4f*)(sp + 12);
#pragma unroll
            for (int r = 0; r < 4; ++r) { const v4u a = wr[r][0], b2 = wr[r][1];
                acc[r][c] = (s0.x * bflo(a.x) + s0.y * bfhi(a.x) + s0.z * bflo(a.y) + s0.w * bfhi(a.y)) + (s1.x * bflo(a.z) + s1.y * bfhi(a.z) + s1.z * bflo(a.w) + s1.w * bfhi(a.w))
                          + (s2.x * bflo(b2.x) + s2.y * bfhi(b2.x) + s2.z * bflo(b2.y) + s2.w * bfhi(b2.y)) + (s3.x * bflo(b2.z) + s3.y * bfhi(b2.z) + s3.z * bflo(b2.w) + s3.w * bfhi(b2.w)); } }
#pragma unroll
        for (int o = 1; o < 64; o <<= 1) {
#pragma unroll
            for (int r = 0; r < 4; ++r)
#pragma unroll
                for (int c = 0; c < 5; ++c) acc[r][c] += shx(acc[r][c], F.lane, o); }
        if (F.lane < 20) { const int r = F.lane / 5, c = F.lane % 5; float v = 0.f;
#pragma unroll
            for (int rr = 0; rr < 4; ++rr)
#pragma unroll
                for (int cc = 0; cc < 5; ++cc) v = (rr == r && cc == c) ? acc[rr][cc] : v;
            SWb[((size_t)s * 5 + c) * 5632 + n + r] = v; }
    }
}
__device__ __forceinline__ void rp_mla_fin2(Frame& F, const bf16* qraw, const bf16* kvraw, const float* lat, const float* ckpe_j, const float* gqn, const float* gkn, const float* tab, bf16* Q, bf16* K,
                                            const float* stkv, const float* gkv, float* out, int j) {
    for (int row = F.gw; row < TP; row += F.NGW) {
        const float* lr = lat + (size_t)row * 768; const float r = __builtin_amdgcn_rsqf(stkv[row] * (1.f / 256) + EPS);
        const v4f v = *(const GAS v4f*)(lr + 384 + 4 * F.lane), g = *(const GAS v4f*)(gkv + 4 * F.lane);
        *(GAS v4f*)(out + OUT_CKV + (((size_t)(row >> 8) * 2 + j) * 256 + (row & 255)) * 256 + 4 * F.lane) = v * r * g;
        if (F.lane < 32) *(GAS float*)(out + OUT_KPE + (((size_t)(row >> 8) * 2 + j) * 256 + (row & 255)) * 32 + F.lane) = *(const GAS float*)(lr + 640 + F.lane);
    }
    for (int idx = F.bx * NTHR + F.tid; idx < T * 32; idx += F.G * NTHR) {
        const int row = idx >> 5, hd = (idx >> 1) & 15, hf = idx & 1; const bool latent = row >= TP; const int tl = (row - TP) & 1023;
        float v[48]; float ss = 0.f; RopeCS R; v4f gq[12];
#pragma unroll
        for (int i = 0; i < 6; ++i) ld8(qraw + (size_t)row * 1536 + hd * 96 + hf * 48 + 8 * i, v + 8 * i);
#pragma unroll
        for (int i = 0; i < 12; ++i) gq[i] = *(const GAS v4f*)(gqn + hf * 48 + 4 * i);
        if (latent && hf) rope_load(R, tl, tab);
#pragma unroll
        for (int d = 0; d < 48; ++d) ss += v[d] * v[d];
        ss += shx(ss, F.lane, 1);
        const float r = rsqrtf(ss * (1.f / 96) + EPS) * QSCALE;
#pragma unroll
        for (int d = 0; d < 48; ++d) v[d] = v[d] * r * gq[d >> 2][d & 3];
        if (latent && hf) rope_apply(v + 16, R);
#pragma unroll
        for (int i = 0; i < 6; ++i) st8(Q + ((size_t)row * 16 + hd) * 96 + hf * 48 + 8 * i, v + 8 * i);
    }
    asm volatile("" ::: "memory");
    for (int idx = F.bx * NTHR + F.tid; idx < (T + NCTX) * 32; idx += F.G * NTHR) {
        const int row = idx >> 5, hd = (idx >> 1) & 15, hf = idx & 1; const bool latent = row >= TP && row < T; const int tl = (row - TP) & 1023;
        float v[48]; float ss = 0.f; RopeCS R; v4f gk[12];
#pragma unroll
        for (int i = 0; i < 12; ++i) gk[i] = *(const GAS v4f*)(gkn + hf * 48 + 4 * i);
        if (latent && hf) rope_load(R, tl, tab);
        if (hf == 0) {
#pragma unroll
            for (int i = 0; i < 6; ++i) ld8(kvraw + (size_t)row * 2048 + hd * 128 + 8 * i, v + 8 * i);
        } else {
#pragma unroll
            for (int i = 0; i < 2; ++i) ld8(kvraw + (size_t)row * 2048 + hd * 128 + 48 + 8 * i, v + 8 * i);
            const float* kp = row < T ? lat + (size_t)row * 768 + 640 : ckpe_j + ((size_t)((row - T) >> 8) * 2 * 256 + ((row - T) & 255)) * 32;
#pragma unroll
            for (int i = 0; i < 8; ++i) { const v4f p4 = *(const GAS v4f*)(kp + 4 * i); v[16 + 4 * i] = p4.x; v[17 + 4 * i] = p4.y; v[18 + 4 * i] = p4.z; v[19 + 4 * i] = p4.w; }
        }
#pragma unroll
        for (int d = 0; d < 48; ++d) ss += v[d] * v[d];
        ss += shx(ss, F.lane, 1);
        const float r = rsqrtf(ss * (1.f / 96) + EPS);
#pragma unroll
        for (int d = 0; d < 48; ++d) v[d] = v[d] * r * gk[d >> 2][d & 3];
        if (latent && hf) rope_apply(v + 16, R);
#pragma unroll
        for (int i = 0; i < 6; ++i) st8(K + ((size_t)row * 16 + hd) * 96 + hf * 48 + 8 * i, v + 8 * i);
    }
}
__device__ __forceinline__ void rp_dwconv(Frame& F, const bf16* u, const float* wdw, const float* bdw, const float* gln, const float* bln, bf16* vout) {
    LAS float* red = (LAS float*)F.lds;
    const int c = 2 * F.tid;
    for (int it = F.vcu; it < T / 16; it += F.G) {
        const int row0 = 16 * it; int t0, L; row_pos(row0, t0, L);
        v2f w[31];
#pragma unroll
        for (int k = 0; k < 31; ++k) w[k] = *(const GAS v2f*)(wdw + k * 1024 + c);
        const v2f bb = *(const GAS v2f*)(bdw + c);
        unsigned pk[46];
#pragma unroll
        for (int rr = 0; rr < 46; ++rr) { const int tt = t0 - 15 + rr; const bool ok = tt >= 0 && tt < L;
            pk[rr] = *(const GAS unsigned*)(u + (size_t)(ok ? row0 - 15 + rr : row0) * 1024 + c); }
        __builtin_amdgcn_sched_barrier(0);
#pragma unroll
        for (int rr = 0; rr < 46; ++rr) { const int tt = t0 - 15 + rr; pk[rr] = (tt >= 0 && tt < L) ? pk[rr] : 0u; }
        v2f yy[16];
#pragma unroll
        for (int r = 0; r < 16; ++r) yy[r] = bb;
#pragma unroll
        for (int rr = 0; rr < 46; ++rr) {
            const v2f x = (v2f){bflo(pk[rr]), bfhi(pk[rr])};
#pragma unroll
            for (int r = 0; r < 16; ++r) { const int k = rr - r; if (k >= 0 && k < 31) yy[r] += x * w[k]; }
        }
        float y0[16], y1[16];
#pragma unroll
        for (int r = 0; r < 16; ++r) { y0[r] = yy[r].x; y1[r] = yy[r].y; }
        float s[16];
#pragma unroll
        for (int r = 0; r < 16; ++r) s[r] = y0[r] + y1[r];
#pragma unroll
        for (int o = 1; o < 64; o <<= 1) {
#pragma unroll
            for (int r = 0; r < 16; ++r) s[r] += shx(s[r], F.lane, o); }
        __syncthreads();
        if (F.lane < 16) { float v = s[0];
#pragma unroll
            for (int r = 1; r < 16; ++r) v = F.lane == r ? s[r] : v;
            red[F.wave * 16 + F.lane] = v; }
        __syncthreads();
        float mean[16];
#pragma unroll
        for (int r = 0; r < 16; ++r) { float m = 0.f;
#pragma unroll
            for (int wv = 0; wv < 8; ++wv) m += red[wv * 16 + r];
            mean[r] = m * (1.f / 1024); }
#pragma unroll
        for (int r = 0; r < 16; ++r) { y0[r] -= mean[r]; y1[r] -= mean[r]; s[r] = y0[r] * y0[r] + y1[r] * y1[r]; }
#pragma unroll
        for (int o = 1; o < 64; o <<= 1) {
#pragma unroll
            for (int r = 0; r < 16; ++r) s[r] += shx(s[r], F.lane, o); }
        __syncthreads();
        if (F.lane < 16) { float v = s[0];
#pragma unroll
            for (int r = 1; r < 16; ++r) v = F.lane == r ? s[r] : v;
            red[F.wave * 16 + F.lane] = v; }
        __syncthreads();
        const v2f gg = *(const GAS v2f*)(gln + c), bl = *(const GAS v2f*)(bln + c);
#pragma unroll
        for (int r = 0; r < 16; ++r) { float q = 0.f;
#pragma unroll
            for (int wv = 0; wv < 8; ++wv) q += red[wv * 16 + r];
            const float rs = rsqrtf(q * (1.f / 1024) + EPS);
            const float z0 = y0[r] * rs * gg.x + bl.x, z1 = y1[r] * rs * gg.y + bl.y;
            *(GAS unsigned*)(vout + (size_t)(row0 + r) * 1024 + c) = pk2(z0 * fast_sig(z0), z1 * fast_sig(z1)); }
    }
    __syncthreads();
}
__device__ __forceinline__ void rp_ssd_conv(Frame& F, const bf16* xpre, const float* dtraw, const float* wc, const float* bc, const float* dtb, const float* alog, bf16* xbc, float* dt, float* acum) {
    for (int idx = F.bx * NTHR + F.tid; idx < (T / 32) * 384; idx += F.G * NTHR) {
        const int seg = idx / 384, cg = idx - seg * 384, c0 = 8 * cg, row0 = 32 * seg; int t0, L; row_pos(row0, t0, L);
        v2f w2[5][4], b2[4];
#pragma unroll
        for (int k = 0; k < 5; ++k) { const v4f a = *(const GAS v4f*)(wc + k * 3072 + c0), b = *(const GAS v4f*)(wc + k * 3072 + c0 + 4);
            w2[k][0] = (v2f){a.x, a.y}; w2[k][1] = (v2f){a.z, a.w}; w2[k][2] = (v2f){b.x, b.y}; w2[k][3] = (v2f){b.z, b.w}; }
        { const v4f a = *(const GAS v4f*)(bc + c0), b = *(const GAS v4f*)(bc + c0 + 4); b2[0] = (v2f){a.x, a.y}; b2[1] = (v2f){a.z, a.w}; b2[2] = (v2f){b.x, b.y}; b2[3] = (v2f){b.z, b.w}; }
        const bf16* base = xpre + (size_t)row0 * 3072 + c0;
#define SSC_OK(j) ((t0 + (j)) >= 0 && (t0 + (j)) < L)
#define SSC_LD(j) (*(const GAS v4u*)(base + (ptrdiff_t)(SSC_OK(j) ? (j) : 0) * 3072))
        v4u carry[4], cur[8], nxt[8];
#pragma unroll
        for (int k = 0; k < 4; ++k) carry[k] = SSC_LD(k - 2);
#pragma unroll
        for (int k = 0; k < 8; ++k) cur[k] = SSC_LD(k + 2);
        __builtin_amdgcn_sched_barrier(0);
#pragma unroll
        for (int k = 0; k < 4; ++k) if (!SSC_OK(k - 2)) carry[k] = (v4u){0u, 0u, 0u, 0u};
#pragma unroll
        for (int k = 0; k < 8; ++k) if (!SSC_OK(k + 2)) cur[k] = (v4u){0u, 0u, 0u, 0u};
#pragma unroll
        for (int c = 0; c < 4; ++c) {
            if (c < 3) {
#pragma unroll
                for (int k = 0; k < 8; ++k) nxt[k] = SSC_LD(8 * c + 10 + k); }
            __builtin_amdgcn_sched_barrier(0);
            v2f acc[8][4];
#pragma unroll
            for (int o = 0; o < 8; ++o)
#pragma unroll
                for (int p2 = 0; p2 < 4; ++p2) acc[o][p2] = b2[p2];
#pragma unroll
            for (int q = 0; q < 12; ++q) { const v4u rw = q < 4 ? carry[q] : cur[q - 4];
                const v2f x0 = (v2f){bflo(rw.x), bfhi(rw.x)}, x1 = (v2f){bflo(rw.y), bfhi(rw.y)}, x2 = (v2f){bflo(rw.z), bfhi(rw.z)}, x3 = (v2f){bflo(rw.w), bfhi(rw.w)};
#pragma unroll
                for (int o = 0; o < 8; ++o) { const int k = q - o; if (k >= 0 && k < 5) { acc[o][0] += x0 * w2[k][0]; acc[o][1] += x1 * w2[k][1]; acc[o][2] += x2 * w2[k][2]; acc[o][3] += x3 * w2[k][3]; } } }
#pragma unroll
            for (int o = 0; o < 8; ++o) { v4u ow;
                { const v2f v = acc[o][0]; ow.x = pk2(v.x * fast_sig(v.x), v.y * fast_sig(v.y)); } { const v2f v = acc[o][1]; ow.y = pk2(v.x * fast_sig(v.x), v.y * fast_sig(v.y)); }
                { const v2f v = acc[o][2]; ow.z = pk2(v.x * fast_sig(v.x), v.y * fast_sig(v.y)); } { const v2f v = acc[o][3]; ow.w = pk2(v.x * fast_sig(v.x), v.y * fast_sig(v.y)); }
                *(GAS v4u*)(xbc + (size_t)(row0 + 8 * c + o) * 3072 + c0) = ow; }
#pragma unroll
            for (int k = 0; k < 4; ++k) carry[k] = cur[4 + k];
            if (c < 3) {
#pragma unroll
                for (int k = 0; k < 8; ++k) cur[k] = SSC_OK(8 * c + 10 + k) ? nxt[k] : (v4u){0u, 0u, 0u, 0u}; }
        }
#undef SSC_OK
#undef SSC_LD
    }
    for (int it = F.gw; it < 64 * 64; it += F.NGW) {
        const int ch = it >> 6, e = it & 63, dir = e >> 5, row0 = 128 * ch, lane = F.lane;
        const float aa = -expf(alog[e]), bb = dtb[e];
        const int i0 = dir == 0 ? lane : 127 - lane, i1 = dir == 0 ? lane + 64 : 63 - lane;
        const float d0 = softplus_f(dtraw[(size_t)(row0 + i0) * 64 + e] + bb), d1 = softplus_f(dtraw[(size_t)(row0 + i1) * 64 + e] + bb);
        float s0 = d0 * aa, s1 = d1 * aa;
#pragma unroll
        for (int o = 1; o < 64; o <<= 1) { const float u0 = __builtin_bit_cast(float, __builtin_amdgcn_ds_bpermute((lane - o) << 2, __builtin_bit_cast(int, s0))), u1 = __builtin_bit_cast(float, __builtin_amdgcn_ds_bpermute((lane - o) << 2, __builtin_bit_cast(int, s1)));
            if (lane >= o) { s0 += u0; s1 += u1; } }
        s1 += __builtin_bit_cast(float, __builtin_amdgcn_readlane(__builtin_bit_cast(int, s0), 63));
        dt[(size_t)(row0 + i0) * 64 + e] = d0; dt[(size_t)(row0 + i1) * 64 + e] = d1;
        acum[(size_t)(row0 + i0) * 64 + e] = s0; acum[(size_t)(row0 + i1) * 64 + e] = s1;
    }
}
__device__ __forceinline__ void rp_ssd_gate(Frame& F, const bf16* y, const bf16* z, const float* gn, bf16* yn) {
    v4f gv[4][2];
#pragma unroll
    for (int g = 0; g < 4; ++g) { gv[g][0] = *(const GAS v4f*)(gn + g * 512 + 8 * F.lane); gv[g][1] = *(const GAS v4f*)(gn + g * 512 + 8 * F.lane + 4); }
    v4u cz[4], ca[4], cb[4], nz[4], na[4], nb[4];
    int row = F.gw;
    if (row < T) {
#pragma unroll
        for (int g = 0; g < 4; ++g) { const size_t o = (size_t)row * 2048 + g * 512 + 8 * F.lane; cz[g] = *(const GAS v4u*)(z + o); ca[g] = *(const GAS v4u*)(y + o); cb[g] = *(const GAS v4u*)(y + (size_t)T * 2048 + o); } }
    for (; row < T; row += F.NGW) {
        const int nrow = row + F.NGW;
        if (nrow < T) {
#pragma unroll
            for (int g = 0; g < 4; ++g) { const size_t o = (size_t)nrow * 2048 + g * 512 + 8 * F.lane; nz[g] = *(const GAS v4u*)(z + o); na[g] = *(const GAS v4u*)(y + o); nb[g] = *(const GAS v4u*)(y + (size_t)T * 2048 + o); } }
        __builtin_amdgcn_sched_barrier(0);
#pragma unroll
        for (int g = 0; g < 4; ++g) { const int c0 = g * 512 + 8 * F.lane; float zz[8], v[8], yb[8];
            up8(cz[g], zz); up8(ca[g], v); up8(cb[g], yb);
            float ss = 0.f;
#pragma unroll
            for (int i = 0; i < 8; ++i) { v[i] = (v[i] + yb[i]) * zz[i] * fast_sig(zz[i]); ss += v[i] * v[i]; }
            const float r = __builtin_amdgcn_rsqf(wsum(ss, F.lane) * (1.f / 512) + EPS);
#pragma unroll
            for (int i = 0; i < 8; ++i) v[i] = v[i] * r * gv[g][i >> 2][i & 3];
            st8(yn + (size_t)row * 2048 + c0, v); }
#pragma unroll
        for (int g = 0; g < 4; ++g) { cz[g] = nz[g]; ca[g] = na[g]; cb[g] = nb[g]; }
    }
}

typedef short a_bf16x8 __attribute__((ext_vector_type(8)));
typedef short a_s16x4 __attribute__((ext_vector_type(4)));
typedef float a_f32x16 __attribute__((ext_vector_type(16)));
typedef float a_f32x2 __attribute__((ext_vector_type(2))); typedef __bf16 a_bf16x2 __attribute__((ext_vector_type(2)));
__device__ __forceinline__ unsigned a_cvtpk(float lo, float hi) { a_f32x2 v = {lo, hi}; a_bf16x2 b = __builtin_convertvector(v, a_bf16x2); return __builtin_bit_cast(unsigned, b); }
__device__ __forceinline__ a_s16x4 a_vtr(const LAS unsigned char* p) { return __builtin_bit_cast(a_s16x4, __builtin_amdgcn_ds_read_tr16_b64_v4i16((LAS a_s16x4*)p)); }
constexpr int AT_KS = 208, AT_VS = 192, AT_KB = 64 * AT_KS, AT_VB = 64 * AT_VS, AT_VOFF = 2 * AT_KB;
__device__ __forceinline__ void at_tile(Frame& F, LAS unsigned char* lds, int buf, int lane, const a_bf16x8 (&qf)[6], a_f32x16& o0, a_f32x16& o1, float& m, float& l) {
    const int r32 = lane & 31, hi = lane >> 5;
    a_f32x16 p0, p1;
#pragma unroll
    for (int r = 0; r < 16; ++r) { p0[r] = 0.f; p1[r] = 0.f; }
    { const LAS unsigned char* kp = lds + buf * AT_KB + r32 * AT_KS + hi * 16;
#pragma unroll
      for (int s = 0; s < 6; ++s) { const a_bf16x8 a0 = *(const LAS a_bf16x8*)(kp + 32 * s), a1 = *(const LAS a_bf16x8*)(kp + 32 * AT_KS + 32 * s);
          p0 = __builtin_amdgcn_mfma_f32_32x32x16_bf16(a0, qf[s], p0, 0, 0, 0); p1 = __builtin_amdgcn_mfma_f32_32x32x16_bf16(a1, qf[s], p1, 0, 0, 0); } }

    float mx = fmaxf(p0[0], p1[0]);
#pragma unroll
    for (int r = 1; r < 16; ++r) mx = fmaxf(mx, fmaxf(p0[r], p1[r]));
    mx = fmaxf(mx, shx(mx, lane, 32));
    const float mn = fmaxf(m, mx), alpha = __builtin_amdgcn_exp2f(m - mn); m = mn;
    float ps = 0.f;
#pragma unroll
    for (int r = 0; r < 16; ++r) { p0[r] = __builtin_amdgcn_exp2f(p0[r] - mn); p1[r] = __builtin_amdgcn_exp2f(p1[r] - mn); ps += p0[r] + p1[r]; }
    l = l * alpha + ps;
#pragma unroll
    for (int r = 0; r < 16; ++r) { o0[r] *= alpha; o1[r] *= alpha; }
    v4u pw[4];
    pw[0] = (v4u){a_cvtpk(p0[0], p0[1]), a_cvtpk(p0[2], p0[3]), a_cvtpk(p0[4], p0[5]), a_cvtpk(p0[6], p0[7])};
    pw[1] = (v4u){a_cvtpk(p0[8], p0[9]), a_cvtpk(p0[10], p0[11]), a_cvtpk(p0[12], p0[13]), a_cvtpk(p0[14], p0[15])};
    pw[2] = (v4u){a_cvtpk(p1[0], p1[1]), a_cvtpk(p1[2], p1[3]), a_cvtpk(p1[4], p1[5]), a_cvtpk(p1[6], p1[7])};
    pw[3] = (v4u){a_cvtpk(p1[8], p1[9]), a_cvtpk(p1[10], p1[11]), a_cvtpk(p1[12], p1[13]), a_cvtpk(p1[14], p1[15])};

    const LAS unsigned char* vp0 = lds + AT_VOFF + buf * AT_VB + (4 * hi + ((lane & 15) >> 2)) * AT_VS + (16 * ((lane >> 4) & 1) + 4 * (lane & 3)) * 2;
    a_s16x4 vl0[4], vh0[4], vl1[4], vh1[4];
#pragma unroll
    for (int bs = 0; bs < 4; ++bs) { const LAS unsigned char* vq = vp0 + (16 * bs) * AT_VS; vl0[bs] = a_vtr(vq); vh0[bs] = a_vtr(vq + 8 * AT_VS); vl1[bs] = a_vtr(vq + 64); vh1[bs] = a_vtr(vq + 8 * AT_VS + 64); }
#pragma unroll
    for (int bs = 0; bs < 4; ++bs) {
        const a_bf16x8 v0 = (a_bf16x8){vl0[bs][0], vl0[bs][1], vl0[bs][2], vl0[bs][3], vh0[bs][0], vh0[bs][1], vh0[bs][2], vh0[bs][3]}, v1 = (a_bf16x8){vl1[bs][0], vl1[bs][1], vl1[bs][2], vl1[bs][3], vh1[bs][0], vh1[bs][1], vh1[bs][2], vh1[bs][3]};
        const a_bf16x8 pb = __builtin_bit_cast(a_bf16x8, pw[bs]);
        o0 = __builtin_amdgcn_mfma_f32_32x32x16_bf16(v0, pb, o0, 0, 0, 0); o1 = __builtin_amdgcn_mfma_f32_32x32x16_bf16(v1, pb, o1, 0, 0, 0); }
}
__device__ __forceinline__ void ph_attn(Frame& F, const bf16* Q, const bf16* K, const bf16* KV, bf16* AO) {
    const int lane = F.lane, r32 = lane & 31, hi = lane >> 5, wave = F.wave, tid = F.tid;
    LAS unsigned char* lds = F.lds;
    const int kr_a = tid / 12, kp_a = tid % 12, kr_b = (tid + 512) / 12, kp_b = (tid + 512) % 12, vr = tid >> 3, vp = tid & 7;
    const bool has_b = tid < 256;
    for (int uu = F.vcu; uu < 512; uu += F.G) {
        int head, q0, NT, kbase_ctx, kbase_lat;
        if (uu < 256) { const int seq = uu >> 4; head = uu & 15; q0 = seq * 256; NT = 4; kbase_ctx = seq * 256; kbase_lat = 0; }
        else { const int u2 = uu - 256, b = u2 >> 6, qb = u2 & 3; head = (u2 >> 2) & 15; q0 = TP + b * 1024 + qb * 256; NT = 20; kbase_ctx = T + b * 256; kbase_lat = TP + b * 1024; }
        a_bf16x8 qf[6];
        { const bf16* qp = Q + ((size_t)(q0 + wave * 32 + r32) * 16 + head) * 96 + hi * 8;
#pragma unroll
          for (int s = 0; s < 6; ++s) qf[s] = *(const GAS a_bf16x8*)(qp + 16 * s); }
        a_f32x16 o0, o1;
#pragma unroll
        for (int r = 0; r < 16; ++r) { o0[r] = 0.f; o1[r] = 0.f; }
        float m = -INFINITY, l = 0.f;
        v4u ka0, kb0, vv0, ka1, kb1, vv1, ka2, kb2_, vv2;
#define AT_LOAD(t, KA, KB2, VV) do { const int kr0_ = (t) < 4 ? kbase_ctx + 64 * (t) : kbase_lat + 64 * ((t) - 4); \
            KA = *(const GAS v4u*)(K + ((size_t)(kr0_ + kr_a) * 16 + head) * 96 + kp_a * 8); \
            if (has_b) KB2 = *(const GAS v4u*)(K + ((size_t)(kr0_ + kr_b) * 16 + head) * 96 + kp_b * 8); \
            VV = *(const GAS v4u*)(KV + (size_t)(kr0_ + vr) * 2048 + head * 128 + 64 + vp * 8); } while (0)
#define AT_STORE(buf, KA, KB2, VV) do { *(LAS v4u*)(lds + (buf) * AT_KB + kr_a * AT_KS + kp_a * 16) = KA; \
            if (has_b) *(LAS v4u*)(lds + (buf) * AT_KB + kr_b * AT_KS + kp_b * 16) = KB2; \
            *(LAS v4u*)(lds + AT_VOFF + (buf) * AT_VB + vr * AT_VS + vp * 16) = VV; } while (0)
#define AT_STEP(k, SA, SB, SC, SD_, SE_, SF_, SG, SH, SI) if (t + (k) < NT) { \
            if (t + (k) + 3 < NT) AT_LOAD(t + (k) + 3, SA, SB, SC);            \
            at_tile(F, lds, (k) & 1, lane, qf, o0, o1, m, l); \
            if (t + (k) + 1 < NT) AT_STORE(((k) + 1) & 1, SD_, SE_, SF_);       \
            LDS_BARRIER(); }
        AT_LOAD(0, ka0, kb0, vv0); AT_LOAD(1, ka1, kb1, vv1); AT_LOAD(2, ka2, kb2_, vv2);
        AT_STORE(0, ka0, kb0, vv0);
        LDS_BARRIER();
#pragma unroll 1
        for (int t = 0; t < NT; t += 6) {
            AT_STEP(0, ka0, kb0, vv0, ka1, kb1, vv1, 0, 0, 0)
            AT_STEP(1, ka1, kb1, vv1, ka2, kb2_, vv2, 0, 0, 0)
            AT_STEP(2, ka2, kb2_, vv2, ka0, kb0, vv0, 0, 0, 0)
            AT_STEP(3, ka0, kb0, vv0, ka1, kb1, vv1, 0, 0, 0)
            AT_STEP(4, ka1, kb1, vv1, ka2, kb2_, vv2, 0, 0, 0)
            AT_STEP(5, ka2, kb2_, vv2, ka0, kb0, vv0, 0, 0, 0)
        }
#undef AT_STEP
#undef AT_LOAD
#undef AT_STORE
        l += shx(l, lane, 32);
        const float il = __builtin_amdgcn_rcpf(l);
        bf16* op = AO + (size_t)(q0 + wave * 32 + r32) * 1024 + head * 64 + 4 * hi;
#pragma unroll
        for (int g4 = 0; g4 < 4; ++g4) {
            v2u w0; w0.x = a_cvtpk(o0[4 * g4] * il, o0[4 * g4 + 1] * il); w0.y = a_cvtpk(o0[4 * g4 + 2] * il, o0[4 * g4 + 3] * il); *(GAS v2u*)(op + 8 * g4) = w0;
            v2u w1; w1.x = a_cvtpk(o1[4 * g4] * il, o1[4 * g4 + 1] * il); w1.y = a_cvtpk(o1[4 * g4 + 2] * il, o1[4 * g4 + 3] * il); *(GAS v2u*)(op + 32 + 8 * g4) = w1; }

    }
}
constexpr int SC_ST = 272, SC_XS = 144;
constexpr int SC_C = 0, SC_B = 128 * SC_ST, SC_M = 2 * 128 * SC_ST, SC_H = 3 * 128 * SC_ST, SC_X = SC_H + 64 * SC_ST, SC_XW = SC_X + 128 * SC_XS, SC_ARR = SC_XW + 128 * SC_XS;
static_assert(SC_ARR + 4 * 128 * 4 + 16 <= PTAB_OFF_C && SC_ARR + 4 * 128 * 4 + 16 <= P0_DUMP, "scan LDS map (the weight prefetch's dump area lies above it)");
__device__ __forceinline__ int a_crow(int r, int hi) { return (r & 3) + 8 * (r >> 2) + 4 * hi; }
__device__ __forceinline__ void ph_scan(Frame& F, const bf16* xbc, const float* dt, const float* acg, const float* dsk, const float* st0, bf16* y, float* out) {
    const int lane = F.lane, r32 = lane & 31, hi = lane >> 5, wave = F.wave, tid = F.tid;
    LAS unsigned char* lds = F.lds;
    LAS float* acum = (LAS float*)(lds + SC_ARR); LAS float* wj = acum + 128; LAS float* ei = acum + 256; LAS float* dtj = acum + 384; LAS float* misc = acum + 512;
    const int q4 = (lane & 15) >> 2, gg = (lane >> 4) & 1, p4 = lane & 3;
    const int ib = wave >> 1, pb = wave & 1, nb = wave >> 1;
    v4u cr[4], br[4], xr[2];
    float pdt[2], pac[2], plast, pac_t, pdt_t;
#define SC_GLOADP(rowb_, g_, hd_, dir_) do { const int row0_ = (rowb_); \
        _Pragma("unroll") for (int k = 0; k < 4; ++k) { const int q = tid + 512 * k, rr = q >> 4, pp = q & 15; \
            cr[k] = *(const GAS v4u*)(xbc + (size_t)(row0_ + rr) * 3072 + 2560 + (g_) * 128 + pp * 8); br[k] = *(const GAS v4u*)(xbc + (size_t)(row0_ + rr) * 3072 + 2048 + (g_) * 128 + pp * 8); } \
        _Pragma("unroll") for (int k = 0; k < 2; ++k) { const int q = tid + 512 * k, rr = q >> 3, pp = q & 7; xr[k] = *(const GAS v4u*)(xbc + (size_t)(row0_ + rr) * 3072 + (hd_) * 64 + pp * 8); \
            pdt[k] = dt[(size_t)(row0_ + rr) * 64 + (dir_) * 32 + (hd_)]; pac[k] = acg[(size_t)(row0_ + rr) * 64 + (dir_) * 32 + (hd_)]; } \
        plast = acg[(size_t)(row0_ + ((dir_) == 0 ? 127 : 0)) * 64 + (dir_) * 32 + (hd_)]; \
        pac_t = acg[(size_t)(row0_ + (tid & 127)) * 64 + (dir_) * 32 + (hd_)]; pdt_t = dt[(size_t)(row0_ + (tid & 127)) * 64 + (dir_) * 32 + (hd_)]; } while (0)
#define SC_ITEM(slot_, ii_, seq_, hd_) do { if ((slot_) < 128) { seq_ = 16 + ((slot_) >> 5); hd_ = (slot_) & 31; } else { const int pi_ = 4 * ((slot_) - 128) + (ii_); seq_ = pi_ >> 5; hd_ = pi_ & 31; } } while (0)
    for (int slot = F.vcu; slot < 256; slot += F.G) {
        const int nitem = slot < 128 ? 1 : 4;
        { int seq0, hd0; SC_ITEM(slot, 0, seq0, hd0); SC_GLOADP(seq0 < 16 ? seq0 * 256 : TP + (seq0 - 16) * 1024, hd0 >> 3, hd0, 0); }
#pragma unroll 1
        for (int ii = 0; ii < nitem; ++ii) {
            int seq, hd;
            if (slot < 128) { seq = 16 + (slot >> 5); hd = slot & 31; } else { const int pi = 4 * (slot - 128) + ii; seq = pi >> 5; hd = pi & 31; }
            const int g = hd >> 3, r0 = seq < 16 ? seq * 256 : TP + (seq - 16) * 1024, nc = seq < 16 ? 2 : 8;
#pragma unroll 1
            for (int dir = 0; dir < 2; ++dir) {
                const float dd = dsk[dir * 32 + hd];
                a_f32x16 hacc;
                if (seq < 16) {
#pragma unroll
                    for (int r = 0; r < 16; ++r) hacc[r] = 0.f;
                } else { const float* s0 = st0 + ((((size_t)(seq - 16) * 2 + dir) * 32 + hd) * 64 + 32 * pb + r32) * 128 + 32 * nb + 4 * hi;
#pragma unroll
                    for (int g4 = 0; g4 < 4; ++g4) { const v4f t4 = *(const GAS v4f*)(s0 + 8 * g4); hacc[4 * g4] = t4.x; hacc[4 * g4 + 1] = t4.y; hacc[4 * g4 + 2] = t4.z; hacc[4 * g4 + 3] = t4.w; } }
#pragma unroll
                for (int g4 = 0; g4 < 4; ++g4) { v2u w; w.x = a_cvtpk(hacc[4 * g4], hacc[4 * g4 + 1]); w.y = a_cvtpk(hacc[4 * g4 + 2], hacc[4 * g4 + 3]);
                    *(LAS v2u*)(lds + SC_H + (32 * pb + r32) * SC_ST + (32 * nb + 8 * g4 + 4 * hi) * 2) = w; }
#pragma unroll 1
                for (int cc = 0; cc < nc; ++cc) {
                    const int c = dir == 0 ? cc : nc - 1 - cc, row0 = r0 + c * 128;
                    const int e = dir * 32 + hd;
                    const float last = plast;
                    LDS_BARRIER();
                    if (tid < 128) { const float ac = pac_t, dv = pdt_t;
                        acum[tid] = ac; dtj[tid] = dv; ei[tid] = __expf(ac); if (tid == 0) misc[0] = __expf(last); }
#pragma unroll
                    for (int k = 0; k < 4; ++k) { const int q = tid + 512 * k, rr = q >> 4, pp = q & 15; *(LAS v4u*)(lds + SC_C + rr * SC_ST + pp * 16) = cr[k]; *(LAS v4u*)(lds + SC_B + rr * SC_ST + pp * 16) = br[k]; }
#pragma unroll
                    for (int k = 0; k < 2; ++k) { const int q = tid + 512 * k, rr = q >> 3, pp = q & 7; *(LAS v4u*)(lds + SC_X + rr * SC_XS + pp * 16) = xr[k];
                        const float w = pdt[k] * __expf(last - pac[k]);
                        v4u s; s.x = a_cvtpk(bflo(xr[k].x) * w, bfhi(xr[k].x) * w); s.y = a_cvtpk(bflo(xr[k].y) * w, bfhi(xr[k].y) * w); s.z = a_cvtpk(bflo(xr[k].z) * w, bfhi(xr[k].z) * w); s.w = a_cvtpk(bflo(xr[k].w) * w, bfhi(xr[k].w) * w);
                        *(LAS v4u*)(lds + SC_XW + rr * SC_XS + pp * 16) = s; }
                    { int nrow = 0, nhd = hd, ndir = dir; bool hn = true;
                      if (cc + 1 < nc) nrow = r0 + (dir == 0 ? cc + 1 : nc - 2 - cc) * 128;
                      else if (dir == 0) { nrow = r0 + (nc - 1) * 128; ndir = 1; }
                      else if (ii + 1 < nitem) { int seqn; SC_ITEM(slot, ii + 1, seqn, nhd); nrow = seqn < 16 ? seqn * 256 : TP + (seqn - 16) * 1024; ndir = 0; }
                      else hn = false;
                      if (hn) SC_GLOADP(nrow, nhd >> 3, nhd, ndir); }
                    LDS_BARRIER();
#pragma unroll 1
                    for (int tt = 0; tt < 2; ++tt) {
                        int lt = tt == 0 ? wave : (wave < 2 ? 8 + wave : 10 + (wave - 2));
                        const int ta = lt == 0 ? 0 : lt == 1 ? 0 : lt == 2 ? 0 : lt == 3 ? 0 : lt == 4 ? 1 : lt == 5 ? 1 : lt == 6 ? 1 : lt == 7 ? 2 : lt == 8 ? 2 : lt == 9 ? 3 : lt == 10 ? 1 : lt == 11 ? 2 : lt == 12 ? 2 : lt == 13 ? 3 : lt == 14 ? 3 : 3;
                        const int tb = lt == 0 ? 0 : lt == 1 ? 1 : lt == 2 ? 2 : lt == 3 ? 3 : lt == 4 ? 1 : lt == 5 ? 2 : lt == 6 ? 3 : lt == 7 ? 2 : lt == 8 ? 3 : lt == 9 ? 3 : lt == 10 ? 0 : lt == 11 ? 0 : lt == 12 ? 1 : lt == 13 ? 0 : lt == 14 ? 1 : 2;
                        const int jb = dir == 0 ? ta : tb, ibg = dir == 0 ? tb : ta;
                        const bool dead = lt >= 10;
                        a_f32x16 gt;
#pragma unroll
                        for (int r = 0; r < 16; ++r) gt[r] = 0.f;
                        if (!dead) {
                            const LAS unsigned char* ap = lds + SC_B + (32 * jb + r32) * SC_ST + hi * 16; const LAS unsigned char* bp = lds + SC_C + (32 * ibg + r32) * SC_ST + hi * 16;
#pragma unroll
                            for (int s = 0; s < 8; ++s) gt = __builtin_amdgcn_mfma_f32_32x32x16_bf16(*(const LAS a_bf16x8*)(ap + 32 * s), *(const LAS a_bf16x8*)(bp + 32 * s), gt, 0, 0, 0);
                            const int i = 32 * ibg + r32; const float ai = acum[i];
                            v4f aj[4], dj[4];
#pragma unroll
                            for (int g4 = 0; g4 < 4; ++g4) { aj[g4] = *(const LAS v4f*)(acum + 32 * jb + 8 * g4 + 4 * hi); dj[g4] = *(const LAS v4f*)(dtj + 32 * jb + 8 * g4 + 4 * hi); }
#pragma unroll
                            for (int r = 0; r < 16; ++r) { const int j = 32 * jb + a_crow(r, hi); const bool keep = dir == 0 ? j <= i : j >= i;
                                const float e = __builtin_amdgcn_exp2f(fminf(ai - aj[r >> 2][r & 3], 0.f) * 1.4426950408889634f) * dj[r >> 2][r & 3];
                                gt[r] = keep ? gt[r] * e + (j == i ? dd : 0.f) : 0.f; }
                        }
#pragma unroll
                        for (int g4 = 0; g4 < 4; ++g4) { v2u w; w.x = a_cvtpk(gt[4 * g4], gt[4 * g4 + 1]); w.y = a_cvtpk(gt[4 * g4 + 2], gt[4 * g4 + 3]);
                            *(LAS v2u*)(lds + SC_M + (32 * ibg + r32) * SC_ST + (32 * jb + 8 * g4 + 4 * hi) * 2) = w; }
                    }
                    a_f32x16 yo;
#pragma unroll
                    for (int r = 0; r < 16; ++r) yo[r] = 0.f;
                    { const LAS unsigned char* ap = lds + SC_C + (32 * ib + r32) * SC_ST + hi * 16; const LAS unsigned char* bp = lds + SC_H + (32 * pb + r32) * SC_ST + hi * 16;
#pragma unroll
                      for (int s = 0; s < 8; ++s) yo = __builtin_amdgcn_mfma_f32_32x32x16_bf16(*(const LAS a_bf16x8*)(ap + 32 * s), *(const LAS a_bf16x8*)(bp + 32 * s), yo, 0, 0, 0); }
                    LDS_BARRIER();
                    a_f32x16 yd;
#pragma unroll
                    for (int r = 0; r < 16; ++r) yd[r] = 0.f;
                    { const LAS unsigned char* ap = lds + SC_M + (32 * ib + r32) * SC_ST + hi * 16; const LAS unsigned char* xp = lds + SC_X + (8 * hi + q4) * SC_XS + (32 * pb + 16 * gg + 4 * p4) * 2;
#pragma unroll
                      for (int s = 0; s < 8; ++s) { const a_s16x4 l0 = a_vtr(xp + (16 * s) * SC_XS), h0 = a_vtr(xp + (16 * s + 4) * SC_XS);
                          const a_bf16x8 xb = (a_bf16x8){l0[0], l0[1], l0[2], l0[3], h0[0], h0[1], h0[2], h0[3]};
                          yd = __builtin_amdgcn_mfma_f32_32x32x16_bf16(*(const LAS a_bf16x8*)(ap + 32 * s), xb, yd, 0, 0, 0); } }
                    { bf16* yp = y + (size_t)dir * T * 2048 + (size_t)(row0 + 32 * ib) * 2048 + hd * 64 + 32 * pb + r32;
                      v4f e4[4];
#pragma unroll
                      for (int g4 = 0; g4 < 4; ++g4) e4[g4] = *(const LAS v4f*)(ei + 32 * ib + 8 * g4 + 4 * hi);
#pragma unroll
                      for (int r = 0; r < 16; ++r) { const int i = a_crow(r, hi); const float v = yd[r] + e4[r >> 2][r & 3] * yo[r]; yp[(size_t)i * 2048] = (bf16)f2bf(v); } }
                    { const float dec = misc[0];
#pragma unroll
                      for (int r = 0; r < 16; ++r) hacc[r] *= dec;
                      const LAS unsigned char* bq = lds + SC_B + (8 * hi + q4) * SC_ST + (32 * nb + 16 * gg + 4 * p4) * 2; const LAS unsigned char* xq = lds + SC_XW + (8 * hi + q4) * SC_XS + (32 * pb + 16 * gg + 4 * p4) * 2;
#pragma unroll
                      for (int s = 0; s < 8; ++s) { const a_s16x4 bl = a_vtr(bq + (16 * s) * SC_ST), bh = a_vtr(bq + (16 * s + 4) * SC_ST), xl = a_vtr(xq + (16 * s) * SC_XS), xh = a_vtr(xq + (16 * s + 4) * SC_XS);
                          const a_bf16x8 av = (a_bf16x8){bl[0], bl[1], bl[2], bl[3], bh[0], bh[1], bh[2], bh[3]}, bv = (a_bf16x8){xl[0], xl[1], xl[2], xl[3], xh[0], xh[1], xh[2], xh[3]};
                          hacc = __builtin_amdgcn_mfma_f32_32x32x16_bf16(av, bv, hacc, 0, 0, 0); } }
#pragma unroll
                    for (int g4 = 0; g4 < 4; ++g4) { v2u w; w.x = a_cvtpk(hacc[4 * g4], hacc[4 * g4 + 1]); w.y = a_cvtpk(hacc[4 * g4 + 2], hacc[4 * g4 + 3]);
                        *(LAS v2u*)(lds + SC_H + (32 * pb + r32) * SC_ST + (32 * nb + 8 * g4 + 4 * hi) * 2) = w; }
                }
                if (seq < 16) { float* o = out + OUT_SSM + ((((size_t)seq * 2 + dir) * 32 + hd) * 64 + 32 * pb + r32) * 128 + 32 * nb + 4 * hi;
#pragma unroll
                    for (int g4 = 0; g4 < 4; ++g4) { v4f t4; t4.x = hacc[4 * g4]; t4.y = hacc[4 * g4 + 1]; t4.z = hacc[4 * g4 + 2]; t4.w = hacc[4 * g4 + 3]; *(GAS v4f*)(o + 8 * g4) = t4; } }
            }
        }
    }
#undef SC_GLOADP
#undef SC_ITEM
    LDS_BARRIER();
}

constexpr int NPHASE = 28;
enum Op { OP_P0, OP_NORM1, OP_G_LAT, OP_G_QKV, OP_FIN2, OP_ATTN, OP_G_WO, OP_NORM2, OP_G_FF1, OP_G_FF2, OP_G_PW1, OP_DWCONV, OP_G_PW2, OP_G_SSI, OP_SSCONV, OP_SCAN, OP_GATE, OP_G_SSO };
__device__ __forceinline__ void phase_decode(int ph, int& layer, int& op) {
    if (ph == 0) { layer = 0; op = OP_P0; return; }
    if (ph <= 8) { layer = 0; const int r = ph - 1; op = r == 0 ? OP_NORM1 : r == 1 ? OP_G_LAT : r == 2 ? OP_G_QKV : r == 3 ? OP_FIN2 : r == 4 ? OP_ATTN : r == 5 ? OP_G_WO : r == 6 ? OP_G_FF1 : OP_G_FF2; }
    else if (ph <= 13) { layer = 1; const int r = ph - 9; op = r == 0 ? OP_G_PW1 : r == 1 ? OP_DWCONV : r == 2 ? OP_G_PW2 : r == 3 ? OP_G_FF1 : OP_G_FF2; }
    else if (ph <= 20) { layer = 2; const int r = ph - 14; op = r == 0 ? OP_G_SSI : r == 1 ? OP_SSCONV : r == 2 ? OP_SCAN : r == 3 ? OP_GATE : r == 4 ? OP_G_SSO : r == 5 ? OP_G_FF1 : OP_G_FF2; }
    else { layer = 3; const int r = ph - 21; op = r == 0 ? OP_G_LAT : r == 1 ? OP_G_QKV : r == 2 ? OP_FIN2 : r == 3 ? OP_ATTN : r == 4 ? OP_G_WO : r == 5 ? OP_G_FF1 : OP_G_FF2; }
}
struct MArgs { const float* in[38]; float* out; unsigned char* ws; int ph_lo, ph_hi; };
constexpr int PTAB_OFF = PTAB_OFF_C;
__global__ void __launch_bounds__(NTHR, 2) mega_fwd(MArgs args) {
    extern __shared__ __attribute__((aligned(16))) unsigned char lds_raw[];
    LAS unsigned char* lds = (LAS unsigned char*)lds_raw;
    volatile LAS unsigned* PT0 = (volatile LAS unsigned*)(lds + PTAB_OFF);
    volatile LAS unsigned* MISC = (volatile LAS unsigned*)(lds + MISC_OFF);
    { const int t0 = threadIdx.x;
      if (t0 < 40) { const unsigned long long p = t0 < 38 ? (unsigned long long)args.in[t0] : t0 == 38 ? (unsigned long long)args.out : (unsigned long long)args.ws;
          PT0[2 * t0] = (unsigned)p; PT0[2 * t0 + 1] = (unsigned)(p >> 32); }
      if (t0 < 64) MISC[t0] = 0u; }
    __syncthreads();
    XcdBarrier bar = xcd_barrier_post((unsigned*)((unsigned char*)ldp(PT0, PT_WS) + WS_CTL) + CW_BAR, MISC + 8);
    const int wave0 = __builtin_amdgcn_readfirstlane(threadIdx.x >> 6);
    const int ph_hi = args.ph_hi;
    for (int ph = args.ph_lo; ph < ph_hi; ++ph) {
        Frame F;
        { int w = wave0; asm volatile("" : "+s"(w)); F.wave = w; }
        F.lds = lds; F.lane = olane(); F.tid = F.wave * 64 + F.lane;
        const int bx = obid();
        F.G = gridDim.x; F.vcu = (F.G % 8 == 0) ? (bx % 8) * (F.G / 8) + bx / 8 : bx;
        F.gw = F.vcu * NWAVES + F.wave; F.NGW = F.G * NWAVES; F.PT = PT0; F.bx = bx;
        int layer, op; phase_decode(ph, layer, op);
        const int j = layer / 3;
        switch (op) {
        case OP_P0: p0_prologue(F); break;
        case OP_NORM1: { unsigned char* ws = WSP; float* x = OUTP; const float* xlo = layer == 0 ? INP(I_XP) : x; const float* xhi = layer == 0 ? INP(I_XS) - (size_t)TP * 1024 : x;
            rp_normmod(F, xlo, xhi, INP(I_GN1) + layer * 1024, (const float*)(ws + WS_MODS) + (size_t)layer * 5 * 6144, 0, 1024, (bf16*)(ws + WS_H)); rp_tables(F); } break;
        case OP_NORM2: { unsigned char* ws = WSP; float* x = OUTP;
            rp_normmod(F, x, x, INP(I_GN2) + layer * 1024, (const float*)(ws + WS_MODS) + (size_t)layer * 5 * 6144, 3072, 4096, (bf16*)(ws + WS_H)); } break;
        case OP_G_LAT: { unsigned char* ws = WSP; pg8::Gemm g{(const bf16*)(ws + WS_H), (const bf16*)(ws + W_MLA + j * MLA_WB + MW_CAT), T, 768, 1024}; pg8::StaticOrder S; S.init(T, 2 * 768, F.G, F.bx);
            const int s_ = 2 * layer; pg8::EpiLat E{(float*)(ws + A_LAT), layer == 0 ? nullptr : (const float*)(ws + WS_STAT) + s_ * 8192, layer == 0 ? nullptr : (const float*)(ws + WS_SW) + (size_t)s_ * 5 * 5632,
                (bf16*)(ws + A_QN), (bf16*)(ws + WS_CKV + j * CKV_B), INP(I_GQ) + j * 384, INP(I_GKV) + j * 256, (float*)(ws + WS_STQ) + j * T, (float*)(ws + WS_STKV) + j * (T + NCTX)};
            pg8::gemm_phase<pg8::EpiLat, pg8::StaticOrder, true, true, true>(F.lds, g, S, E, F.wave); } break;
        case OP_G_QKV: {
#pragma unroll 1
            for (int w = 0; w < 2; ++w) {
                unsigned char* ws = WSP; unsigned char* wm = ws + W_MLA + j * MLA_WB;
                pg8::Gemm g = w == 0 ? pg8::Gemm{(const bf16*)(ws + A_QN), (const bf16*)(wm + MW_UQ), T, 1536, 384} : pg8::Gemm{(const bf16*)(ws + WS_CKV + j * CKV_B), (const bf16*)(wm + MW_UKV), T + NCTX, 2048, 256};
                pg8::StaticOrder S; S.init(g.M, g.N, F.G, w == 0 ? F.bx : (int)((F.bx + 64) % F.G));
                pg8::EpiBf16P E{w == 0 ? (bf16*)(ws + A_QRAW) : (bf16*)(ws + A_KVRAW), g.N, w == 0 ? (const float*)(ws + WS_STQ) + j * T : (const float*)(ws + WS_STKV) + j * (T + NCTX), w == 0 ? 1.f / 384 : 1.f / 256};
                pg8::gemm_phase<pg8::EpiBf16P, pg8::StaticOrder, true, true>(F.lds, g, S, E, F.wave);
            } } break;
        case OP_FIN2: { unsigned char* ws = WSP; rp_mla_fin2(F, (const bf16*)(ws + A_QRAW), (const bf16*)(ws + A_KVRAW), (const float*)(ws + A_LAT), INP(I_CKPE) + (size_t)j * 8192, INP(I_GQN) + j * 96, INP(I_GKN) + j * 96,
                                                        (const float*)(ws + WS_ROPE), (bf16*)(ws + A_QB), (bf16*)(ws + A_KB), (const float*)(ws + WS_STKV) + j * (T + NCTX), INP(I_GKV) + j * 256, OUTP, j); } break;
        case OP_ATTN: { unsigned char* ws = WSP; ph_attn(F, (const bf16*)(ws + A_QB), (const bf16*)(ws + A_KB), (const bf16*)(ws + A_KVRAW), (bf16*)(ws + A_AO)); } break;
        case OP_G_WO: case OP_G_PW2: case OP_G_SSO: case OP_G_FF2: {
            unsigned char* ws = WSP; float* x = OUTP;
            const float* rlo = (layer == 0 && op != OP_G_FF2) ? INP(I_XP) : x; const float* rhi = (layer == 0 && op != OP_G_FF2) ? INP(I_XS) - (size_t)TP * 1024 : x;
            pg8::Gemm g; const float* bias = nullptr; int goff = 2048;
            if (op == OP_G_WO) g = pg8::Gemm{(const bf16*)(ws + A_AO), (const bf16*)(ws + W_MLA + j * MLA_WB + MW_O), T, 1024, 1024};
            else if (op == OP_G_PW2) { g = pg8::Gemm{(const bf16*)(ws + A_V), (const bf16*)(ws + W_CV2), T, 1024, 1024}; bias = INP(I_CVB2); }
            else if (op == OP_G_SSO) g = pg8::Gemm{(const bf16*)(ws + A_YN), (const bf16*)(ws + W_SSO), T, 1024, 2048};
            else { g = pg8::Gemm{(const bf16*)(ws + A_ACT), (const bf16*)(ws + W_FF + layer * FF_WB + FW_OUT), T, 1024, 2816}; goff = 5120; }
            pg8::StaticOrder S; S.init(T, 2 * 1024, F.G, F.bx);
            float* xdst = x;
            const int sn_ = 2 * layer + (op == OP_G_FF2 ? 2 : 1);
            pg8::EpiResid<1> E{rlo, rhi, xdst, (const float*)(ws + WS_MODS) + (size_t)layer * 5 * 6144, goff, bias,
                               sn_ < 8 ? (bf16*)(ws + WS_H) : nullptr, (const float*)(ws + WS_GT) + (size_t)(sn_ & 7) * 5 * 1024, (float*)(ws + WS_STAT) + (sn_ & 7) * 8192};
            pg8::gemm_phase<pg8::EpiResid<1>, pg8::StaticOrder, true, true, true>(F.lds, g, S, E, F.wave); } break;
        case OP_G_FF1: { unsigned char* ws = WSP; pg8::Gemm g{(const bf16*)(ws + WS_H), (const bf16*)(ws + W_FF + layer * FF_WB + FW_IN), T, 5632, 1024}; pg8::StaticOrder S; S.init(T, 5632, F.G, F.bx);
            const int s_ = 2 * layer + 1; pg8::EpiGlu<0> E{(bf16*)(ws + A_ACT), 2816, nullptr, 2816, (const float*)(ws + WS_STAT) + s_ * 8192, (const float*)(ws + WS_SW) + (size_t)s_ * 5 * 5632}; pg8::gemm_phase<pg8::EpiGlu<0>, pg8::StaticOrder, true, true>(F.lds, g, S, E, F.wave); } break;
        case OP_G_PW1: { unsigned char* ws = WSP; pg8::Gemm g{(const bf16*)(ws + WS_H), (const bf16*)(ws + W_CV1), T, 2048, 1024}; pg8::StaticOrder S; S.init(T, 2048, F.G, F.bx);
            const int s_ = 2 * layer; pg8::EpiGlu<1> E{(bf16*)(ws + A_U), 1024, INP(I_CVB1), 1024, (const float*)(ws + WS_STAT) + s_ * 8192, (const float*)(ws + WS_SW) + (size_t)s_ * 5 * 5632}; pg8::gemm_phase<pg8::EpiGlu<1>, pg8::StaticOrder, true, true>(F.lds, g, S, E, F.wave); } break;
        case OP_DWCONV: { unsigned char* ws = WSP; rp_dwconv(F, (const bf16*)(ws + A_U), INP(I_CVWD), INP(I_CVBD), INP(I_CVGL), INP(I_CVBL), (bf16*)(ws + A_V)); } break;
        case OP_G_SSI: { unsigned char* ws = WSP; pg8::Gemm g{(const bf16*)(ws + WS_H), (const bf16*)(ws + W_SSI), T, 5376, 1024}; pg8::StaticOrder S; S.init(T, 5376, F.G, F.bx);
            const int s_ = 2 * layer; pg8::EpiSsdIn E{(bf16*)(ws + A_Z), (bf16*)(ws + A_XPRE), (float*)(ws + A_DTRAW), (const float*)(ws + WS_STAT) + s_ * 8192, (const float*)(ws + WS_SW) + (size_t)s_ * 5 * 5632}; pg8::gemm_phase<pg8::EpiSsdIn, pg8::StaticOrder, true, true>(F.lds, g, S, E, F.wave); } break;
        case OP_SSCONV: { unsigned char* ws = WSP; rp_ssd_conv(F, (const bf16*)(ws + A_XPRE), (const float*)(ws + A_DTRAW), INP(I_SSWC), INP(I_SSBC), INP(I_SSDTB), INP(I_SSAL), (bf16*)(ws + A_XBC), (float*)(ws + A_DT), (float*)(ws + A_ACUM)); } break;
        case OP_SCAN: { unsigned char* ws = WSP; ph_scan(F, (const bf16*)(ws + A_XBC), (const float*)(ws + A_DT), (const float*)(ws + A_ACUM), INP(I_SSD), INP(I_SSM), (bf16*)(ws + A_Y), OUTP); } break;
        case OP_GATE: { unsigned char* ws = WSP; rp_ssd_gate(F, (const bf16*)(ws + A_Y), (const bf16*)(ws + A_Z), INP(I_SSGN), (bf16*)(ws + A_YN)); } break;
        default: break;
        }

        if (ph + 1 < ph_hi) { F.lane = olane(); xcd_barrier_work(bar, F, ph); }

    }
}

extern "C" void kernel_launch(void* const* d_in, const int* in_sizes, int n_in, void* d_out, int out_size, void* d_ws, size_t ws_size, hipStream_t stream) {
    static int grid = 0;
    if (grid == 0) {
        int dev = 0, cus = 0;
        if (hipGetDevice(&dev) != hipSuccess || hipDeviceGetAttribute(&cus, hipDeviceAttributeMultiprocessorCount, dev) != hipSuccess) { fprintf(stderr, "kernel_launch: device query failed\n"); grid = -1; return; }
        if (hipFuncSetAttribute((const void*)mega_fwd, hipFuncAttributeMaxDynamicSharedMemorySize, LDS_BYTES) != hipSuccess) { fprintf(stderr, "kernel_launch: hipFuncSetAttribute failed\n"); grid = -1; return; }
        (void)hipGetLastError();
        grid = cus;
    }
    if (grid < 0) return;
    (void)hipMemsetAsync((char*)d_ws + WS_CTL, 0, CTL_ZERO_BYTES, stream);
    MArgs a{};
    for (int i = 0; i < 38; ++i) a.in[i] = (const float*)d_in[i];
    a.out = (float*)d_out; a.ws = (unsigned char*)d_ws;
    a.ph_lo = 0; a.ph_hi = NPHASE;
    hipLaunchKernelGGL(mega_fwd, dim3(grid), dim3(NTHR), LDS_BYTES, stream, a);
}
```

```cpp
#include <hip/hip_runtime.h>
#include <cstdint>
#include <cstdio>

constexpr int DM = 1024, T = 8192, TP = 4096;
constexpr int NCTX = 1024;
constexpr int QL = 384, KVL = 256, ROPE = 32, NOPE = 64, QKD = 96, VH = 64, NH = 16;
constexpr int FFH = 2816;
constexpr int SSI = 2048, SSH = 32, SSP = 64, SSN = 128, SSG = 4, SSCD = 3072, SSIN = 5184;
constexpr float EPS = 1e-6f;
constexpr size_t OUT_YP = 0, OUT_CKV = 8388608, OUT_KPE = 10485760, OUT_SSM = 10747904;

__device__ __forceinline__ int cond_of_row(int r) { return r < TP ? 0 : 1 + ((r - TP) >> 10); }
__device__ __forceinline__ void row_pos(int r, int& t, int& L) { if (r < TP) { t = r & 255; L = 256; } else { t = (r - TP) & 1023; L = 1024; } }
__device__ __forceinline__ float softplus_f(float x) { return fmaxf(x, 0.f) + log1pf(expf(-fabsf(x))); }

__device__ __forceinline__ float rope_inv(int i) { return i == 0 ? 1.f : i == 1 ? 0.31622776601683794f : i == 2 ? 0.1f : i == 3 ? 0.031622776601683794f : i == 4 ? 0.01f : i == 5 ? 0.0031622776601683794f : i == 6 ? 0.001f : 0.00031622776601683794f; }

__device__ __forceinline__ int olane() { int l; asm volatile("v_mbcnt_lo_u32_b32 %0, -1, 0\n\tv_mbcnt_hi_u32_b32 %0, -1, %0" : "=v"(l)); return l; }
__device__ __forceinline__ int obid() { int b = blockIdx.x; asm volatile("" : "+s"(b)); return b; }
namespace pg8 {
#define PG8_LAS __attribute__((address_space(3)))
typedef unsigned short bf16_t;
typedef short bf16x8 __attribute__((ext_vector_type(8)));
typedef float f32x4 __attribute__((ext_vector_type(4)));
typedef unsigned u32x4 __attribute__((ext_vector_type(4)));
constexpr int BM = 256, BK = 64, HALF = 128, HTB = HALF * BK * 2  , STAGE_BYTES = 8 * HTB, NXCD = 8, WGM = 8;

__host__ __device__ __forceinline__ int lds_byte(int r, int c) { const int st = (r >> 4) * 2 + (c >> 5), rr = r & 15, cc = c & 31, ob = rr * 64 + cc * 2; return st * 1024 + (ob ^ (((ob >> 9) & 1) << 5)); }
__host__ __device__ __forceinline__ void stage_rc(int b, int& R, int& C) { const int st = b / 1024, sb = b % 1024, swz = sb ^ (((sb >> 9) & 1) << 5); R = (st >> 1) * 16 + swz / 64; C = (st & 1) * 32 + (swz % 64) / 2; }
__host__ __device__ __forceinline__ int perm32(int rho) { const int n = rho >> 4, i = rho & 15; return 8 * (i >> 2) + 4 * n + (i & 3); }

struct Unit { int pm, pn; };
struct Gemm { const bf16_t* A; const bf16_t* Bt; int M, N, K; };

struct StaticOrder {
    int nM, nN, nwg, G, c;
    __host__ __device__ void init(int M, int N, int G_, int c_) { nM = M / BM; nN = N / BM; nwg = nM * nN; G = G_; c = c_; }
    __host__ __device__ bool next(int i, Unit& u) const {
        const long L = (long)i * G + c; if (L >= nwg) return false;
        int wgid = (int)L; { const int q = nwg / NXCD, r = nwg % NXCD, xcd = wgid % NXCD, off = wgid / NXCD; wgid = (xcd < r ? xcd * (q + 1) : r * (q + 1) + (xcd - r) * q) + off; }
        const int nig = WGM * nN, gid = wgid / nig, fm = gid * WGM, gsz = (nM - fm) < WGM ? (nM - fm) : WGM;
        u.pm = fm + ((wgid % nig) % gsz); u.pn = (wgid % nig) / gsz; return true;
    }
    __device__ __forceinline__ void a_ready(const Unit&) const {}
    __device__ __forceinline__ void done(const Unit&) const {}
};
__device__ __forceinline__ unsigned cvt_pk_bf16(float lo, float hi) { unsigned r; asm("v_cvt_pk_bf16_f32 %0, %1, %2" : "=v"(r) : "v"(lo), "v"(hi)); return r; }
typedef unsigned u32x2 __attribute__((ext_vector_type(2)));
#define PG8_GAS __attribute__((address_space(1)))
__device__ __forceinline__ void st16(void* p, u32x4 v) { *(PG8_GAS u32x4*)p = v; }
__device__ __forceinline__ void st16f(void* p, f32x4 v) { *(PG8_GAS f32x4*)p = v; }
__device__ __forceinline__ void st8(void* p, u32x2 v) { *(PG8_GAS u32x2*)p = v; }
__device__ __forceinline__ f32x4 ld16f(const float* p) { return *(const PG8_GAS f32x4*)p; }
__device__ __forceinline__ float ld4f(const float* p) { return *(const PG8_GAS float*)p; }
__device__ __forceinline__ float fast_sigmoid(float x) { return __builtin_amdgcn_rcpf(1.f + __builtin_amdgcn_exp2f(-1.4426950408889634f * x)); }
__device__ __forceinline__ unsigned cvt_pk_bf16_p(float lo, float hi) { unsigned r; asm("v_cvt_pk_bf16_f32 %0, %1, %2" : "=v"(r) : "v"(lo), "v"(hi)); return r; }
template <int MODE> __device__ __forceinline__ void glu8(const f32x4 a0, const f32x4 g0, const f32x4 a1, const f32x4 g1, f32x4& o0, f32x4& o1) {
    const f32x4 t0 = (MODE == 0 ? a0 : g0) * -1.4426950408889634f, t1 = (MODE == 0 ? a1 : g1) * -1.4426950408889634f;
    f32x4 e0, e1, r0, r1;
#pragma unroll
    for (int j = 0; j < 4; ++j) { e0[j] = __builtin_amdgcn_exp2f(t0[j]); e1[j] = __builtin_amdgcn_exp2f(t1[j]); }
    const f32x4 d0 = e0 + 1.f, d1 = e1 + 1.f;
#pragma unroll
    for (int j = 0; j < 4; ++j) { r0[j] = __builtin_amdgcn_rcpf(d0[j]); r1[j] = __builtin_amdgcn_rcpf(d1[j]); }
    if (MODE == 0) { o0 = a0 * g0 * r0; o1 = a1 * g1 * r1; } else { o0 = a0 * r0; o1 = a1 * r1; }
}

constexpr int SW_LD = 5632;
__device__ __forceinline__ int cond_of_pm(int pm) { return pm < 16 ? 0 : 1 + ((pm - 16) >> 2); }
__device__ __forceinline__ void stage_rstat_sw(const float* rstat, const float* sw, const Unit& u, int slot, int wid, int lane, PG8_LAS unsigned char* tabs) {
    PG8_LAS unsigned char* tab = tabs + slot * 2048;
    if (wid < 4) __builtin_amdgcn_global_load_lds((const unsigned*)(rstat + u.pm * BM + wid * 64 + lane), (PG8_LAS unsigned*)(tab + wid * 256), 4, 0, 0);
    else __builtin_amdgcn_global_load_lds((const unsigned*)(sw + (size_t)cond_of_pm(u.pm) * SW_LD + u.pn * BM + (wid - 4) * 64 + lane), (PG8_LAS unsigned*)(tab + 1024 + (wid - 4) * 256), 4, 0, 0);
}
template <int NBJ> struct EpiF32 {
    static constexpr bool PERM = false, AFTER_DRAIN = false, STAGE_IN = false;
    float* C; int ldc; const float* rstat; const float* sw;
    template <bool HN> __device__ __forceinline__ void body(const f32x4 (&acc)[2][2][4][2], const Unit& u, int wr, int wc) const {
        const int t_ = olane(), fr = t_ & 15, fq = t_ >> 4;
        const int row0 = u.pm * BM + wr * 64 + fr, col0 = u.pn * (HALF * NBJ) + wc * 32 + 4 * fq;
        float rs[2][4]; f32x4 s4[NBJ][2];
#pragma unroll
        for (int ai = 0; ai < 2; ++ai)
#pragma unroll
            for (int m = 0; m < 4; ++m) rs[ai][m] = HN ? ld4f(rstat + row0 + ai * HALF + m * 16) : 1.f;
#pragma unroll
        for (int bj = 0; bj < NBJ; ++bj)
#pragma unroll
            for (int n = 0; n < 2; ++n) s4[bj][n] = HN ? ld16f(sw + (size_t)cond_of_pm(u.pm) * SW_LD + col0 + bj * HALF + n * 16) : (f32x4){0.f, 0.f, 0.f, 0.f};
        if (HN) {
#pragma unroll
            for (int ai = 0; ai < 2; ++ai)
#pragma unroll
                for (int m = 0; m < 4; ++m) rs[ai][m] = __builtin_amdgcn_rsqf(rs[ai][m] * (1.f / 1024) + 1e-6f);
        }
#pragma unroll
        for (int ai = 0; ai < 2; ++ai)
#pragma unroll
            for (int m = 0; m < 4; ++m) { float* rowp = C + (size_t)(row0 + ai * HALF + m * 16) * ldc + col0;
#pragma unroll
                for (int bj = 0; bj < NBJ; ++bj)
#pragma unroll
                    for (int n = 0; n < 2; ++n) { f32x4 v = acc[ai][bj][m][n]; if (HN) v = v * rs[ai][m] + s4[bj][n]; st16f(rowp + bj * HALF + n * 16, v); } }
    }
    __device__ __forceinline__ void operator()(const f32x4 (&acc)[2][2][4][2], const Unit& u, int wr_, int wc_, int fr_, int fq_, const PG8_LAS unsigned char* tab) const {
        (void)fr_; (void)fq_; (void)tab;
        if (rstat) body<true>(acc, u, wr_, wc_); else body<false>(acc, u, wr_, wc_);
    }
};
struct EpiBf16P {
    static constexpr bool PERM = true, AFTER_DRAIN = false, STAGE_IN = false;
    bf16_t* O; int ldc;
    __device__ __forceinline__ void operator()(const f32x4 (&acc)[2][2][4][2], const Unit& u, int wr_, int wc_, int fr_, int fq_, const PG8_LAS unsigned char* tab) const {
        const int t_ = olane(), wr = wr_, wc = wc_, fr = t_ & 15, fq = t_ >> 4; (void)fr_; (void)fq_; (void)tab;
        const int row0 = u.pm * BM + wr * 64 + fr, col0 = u.pn * BM + wc * 32 + 8 * fq;
#pragma unroll
        for (int ai = 0; ai < 2; ++ai)
#pragma unroll
            for (int m = 0; m < 4; ++m) { bf16_t* rowp = O + (size_t)(row0 + ai * HALF + m * 16) * ldc + col0;
#pragma unroll
                for (int bj = 0; bj < 2; ++bj) { const f32x4 v0 = acc[ai][bj][m][0], v1 = acc[ai][bj][m][1]; u32x4 w;
                    w.x = cvt_pk_bf16(v0[0], v0[1]); w.y = cvt_pk_bf16(v0[2], v0[3]); w.z = cvt_pk_bf16(v1[0], v1[1]); w.w = cvt_pk_bf16(v1[2], v1[3]);
                    st16(rowp + bj * HALF, w); } }
    }
};
struct EpiSsdIn {
    static constexpr bool PERM = true, AFTER_DRAIN = false, STAGE_IN = true;
    bf16_t* Z; bf16_t* XP; float* DT; const float* rstat; const float* sw;
    __device__ __forceinline__ void stage_in(const Unit& u, int slot, int wid, int lane, PG8_LAS unsigned char* tabs) const { stage_rstat_sw(rstat, sw, u, slot, wid, lane, tabs); }
    __device__ __forceinline__ void operator()(const f32x4 (&acc)[2][2][4][2], const Unit& u, int wr_, int wc_, int fr_, int fq_, const PG8_LAS unsigned char* tab) const {
        const int t_ = olane(), wr = wr_, wc = wc_, fr = t_ & 15, fq = t_ >> 4; (void)fr_; (void)fq_;
        const int row0 = u.pm * BM + wr * 64 + fr;
        const PG8_LAS float* trs = (const PG8_LAS float*)tab + wr * 64 + fr; const PG8_LAS float* swp = (const PG8_LAS float*)(tab + 1024) + wc * 32 + 8 * fq;
        if (u.pn < 20) {
            bf16_t* base = u.pn < 8 ? Z : XP; const int ld = u.pn < 8 ? 2048 : 3072, colt = (u.pn < 8 ? u.pn : u.pn - 8) * BM, col0 = colt + wc * 32 + 8 * fq;
#pragma unroll
            for (int ai = 0; ai < 2; ++ai)
#pragma unroll
                for (int m = 0; m < 4; ++m) { bf16_t* rowp = base + (size_t)(row0 + ai * HALF + m * 16) * ld + col0;
                    const float rs = __builtin_amdgcn_rsqf(trs[ai * HALF + m * 16] * (1.f / 1024) + 1e-6f);
#pragma unroll
                    for (int bj = 0; bj < 2; ++bj) { const f32x4 v0 = acc[ai][bj][m][0] * rs + *(const PG8_LAS f32x4*)(swp + bj * HALF), v1 = acc[ai][bj][m][1] * rs + *(const PG8_LAS f32x4*)(swp + bj * HALF + 4); u32x4 w;
                        w.x = cvt_pk_bf16(v0[0], v0[1]); w.y = cvt_pk_bf16(v0[2], v0[3]); w.z = cvt_pk_bf16(v1[0], v1[1]); w.w = cvt_pk_bf16(v1[2], v1[3]);
                        st16(rowp + bj * HALF, w); } }
        } else if (wc < 2) {
#pragma unroll
            for (int ai = 0; ai < 2; ++ai)
#pragma unroll
                for (int m = 0; m < 4; ++m) { float* rp = DT + (size_t)(row0 + ai * HALF + m * 16) * 64 + wc * 32 + 8 * fq;
                    const float rs = __builtin_amdgcn_rsqf(trs[ai * HALF + m * 16] * (1.f / 1024) + 1e-6f);
                    st16f(rp, acc[ai][0][m][0] * rs + *(const PG8_LAS f32x4*)swp); st16f(rp + 4, acc[ai][0][m][1] * rs + *(const PG8_LAS f32x4*)(swp + 4)); }
        }
    }
};
template <int MODE> struct EpiGlu {
    static constexpr bool PERM = false, AFTER_DRAIN = false, STAGE_IN = true;
    bf16_t* O; int ldo; const float* bias; int H; const float* rstat; const float* sw;
    __device__ __forceinline__ void stage_in(const Unit& u, int slot, int wid, int lane, PG8_LAS unsigned char* tabs) const { stage_rstat_sw(rstat, sw, u, slot, wid, lane, tabs); }
    __device__ __forceinline__ void operator()(const f32x4 (&acc)[2][2][4][2], const Unit& u, int wr_, int wc_, int fr_, int fq_, const PG8_LAS unsigned char* tab) const {
        const int t_ = olane(), wr = wr_, wc = wc_, fr = t_ & 15, fq = t_ >> 4; (void)fr_; (void)fq_;
        const int row0 = u.pm * BM + wr * 64 + fr;
        float rs[2][4];
#pragma unroll
        for (int ai = 0; ai < 2; ++ai)
#pragma unroll
            for (int m = 0; m < 4; ++m) rs[ai][m] = ((const PG8_LAS float*)tab)[ai * HALF + wr * 64 + m * 16 + fr];
#pragma unroll
        for (int ai = 0; ai < 2; ++ai)
#pragma unroll
            for (int m = 0; m < 4; ++m) rs[ai][m] = __builtin_amdgcn_rsqf(rs[ai][m] * (1.f / 1024) + 1e-6f);
        const unsigned ldb = (unsigned)ldo * 2u;
        unsigned char* Ob = (unsigned char*)O;
        const int f0 = 128 * u.pn + 32 * wc + 8 * fq;
        f32x4 ba[2], bu[2];
#pragma unroll
        for (int bj = 0; bj < 2; ++bj) {
            ba[bj] = (f32x4){0.f, 0.f, 0.f, 0.f}; bu[bj] = ba[bj];
            if (MODE == 1) { ba[bj] = ld16f(bias + f0 + 4 * bj); bu[bj] = ld16f(bias + H + f0 + 4 * bj); }
            const PG8_LAS float* swp = (const PG8_LAS float*)(tab + 1024) + bj * HALF + wc * 32 + 4 * fq; ba[bj] += *(const PG8_LAS f32x4*)swp; bu[bj] += *(const PG8_LAS f32x4*)(swp + 16);
        }
        const unsigned ob = (unsigned)row0 * ldb + (unsigned)f0 * 2u;
#pragma unroll
        for (int ai = 0; ai < 2; ++ai)
#pragma unroll
            for (int m = 0; m < 4; ++m) {
                const f32x4 a0 = acc[ai][0][m][0] * rs[ai][m] + ba[0], g0 = acc[ai][0][m][1] * rs[ai][m] + bu[0];
                const f32x4 a1 = acc[ai][1][m][0] * rs[ai][m] + ba[1], g1 = acc[ai][1][m][1] * rs[ai][m] + bu[1];
                f32x4 o0, o1; glu8<MODE>(a0, g0, a1, g1, o0, o1);
                u32x4 w; w.x = cvt_pk_bf16_p(o0[0], o0[1]); w.y = cvt_pk_bf16_p(o0[2], o0[3]); w.z = cvt_pk_bf16_p(o1[0], o1[1]); w.w = cvt_pk_bf16_p(o1[2], o1[3]);
                st16(Ob + (size_t)(ob + (unsigned)(ai * HALF + m * 16) * ldb), w); }
    }
};
template <int NBJ> struct EpiResid {
    static constexpr bool PERM = true, AFTER_DRAIN = false, STAGE_IN = false;
    const float* xlo; const float* xhi; float* xout; const float* mods_l; int g_off; const float* bias;
    bf16_t* XG; const float* GT; float* stat;
    template <bool HX> __device__ __forceinline__ void body(const f32x4 (&acc)[2][2][4][2], const Unit& u, int wr, int wc) const {
        const int t_ = olane(), fr = t_ & 15, fq = t_ >> 4;
        const int cond = u.pm < 16 ? 0 : 1 + ((u.pm - 16) >> 2);
        const float* gate = mods_l + (size_t)cond * 6144 + g_off; const unsigned char* xin = (const unsigned char*)(u.pm < 16 ? xlo : xhi);
        const int row0 = u.pm * BM + wr * 64 + fr, col0 = u.pn * (HALF * NBJ) + wc * 32 + 8 * fq;
        const unsigned ob = (unsigned)row0 * 4096u + (unsigned)col0 * 4u;
        f32x4 xo[NBJ][2][2][4];
#pragma unroll
        for (int bj = 0; bj < NBJ; ++bj)
#pragma unroll
            for (int n = 0; n < 2; ++n)
#pragma unroll
                for (int ai = 0; ai < 2; ++ai)
#pragma unroll
                    for (int m = 0; m < 4; ++m) xo[bj][n][ai][m] = ld16f((const float*)(xin + (size_t)(ob + (unsigned)((bj * HALF + n * 4) * 4 + (ai * HALF + m * 16) * 4096))));
        const float* gt = HX ? GT + (size_t)cond * 1024 : nullptr;
        f32x4 g4[NBJ][2], b4[NBJ][2], G4[NBJ][2];
#pragma unroll
        for (int bj = 0; bj < NBJ; ++bj)
#pragma unroll
            for (int n = 0; n < 2; ++n) { const int c = col0 + bj * HALF + n * 4; g4[bj][n] = ld16f(gate + c);
                b4[bj][n] = (f32x4){0.f, 0.f, 0.f, 0.f}; if (bias) b4[bj][n] = ld16f(bias + c);
                G4[bj][n] = (f32x4){0.f, 0.f, 0.f, 0.f}; if (HX) G4[bj][n] = ld16f(gt + c); }
        float ss[2][4];
#pragma unroll
        for (int ai = 0; ai < 2; ++ai)
#pragma unroll
            for (int m = 0; m < 4; ++m) ss[ai][m] = 0.f;
        unsigned char* xo_ = (unsigned char*)xout; unsigned char* xg_ = (unsigned char*)XG;
#pragma unroll
        for (int bj = 0; bj < NBJ; ++bj)
#pragma unroll
            for (int ai = 0; ai < 2; ++ai)
#pragma unroll
                for (int m = 0; m < 4; ++m) { const unsigned off = ob + (unsigned)(bj * HALF * 4 + (ai * HALF + m * 16) * 4096);
                    const f32x4 x0 = xo[bj][0][ai][m] + g4[bj][0] * (acc[ai][bj][m][0] + b4[bj][0]), x1 = xo[bj][1][ai][m] + g4[bj][1] * (acc[ai][bj][m][1] + b4[bj][1]);
                    st16f(xo_ + (size_t)off, x0); st16f(xo_ + (size_t)(off + 16u), x1);
                    if (HX) { const f32x4 y0 = x0 * G4[bj][0], y1 = x1 * G4[bj][1]; u32x4 w;
                        w.x = cvt_pk_bf16_p(y0[0], y0[1]); w.y = cvt_pk_bf16_p(y0[2], y0[3]); w.z = cvt_pk_bf16_p(y1[0], y1[1]); w.w = cvt_pk_bf16_p(y1[2], y1[3]); st16(xg_ + (size_t)(off >> 1), w);
                        const f32x4 q = x0 * x0 + x1 * x1; ss[ai][m] += (q[0] + q[1]) + (q[2] + q[3]); } }
        if (HX) {
#pragma unroll
            for (int ai = 0; ai < 2; ++ai)
#pragma unroll
                for (int m = 0; m < 4; ++m) { float s = ss[ai][m];
                    s += __builtin_bit_cast(float, __builtin_amdgcn_ds_bpermute((t_ ^ 16) << 2, __builtin_bit_cast(int, s)));
                    s += __builtin_bit_cast(float, __builtin_amdgcn_ds_bpermute((t_ ^ 32) << 2, __builtin_bit_cast(int, s)));
                    if (fq == 0) atomicAdd(stat + row0 + ai * HALF + m * 16, s); }
        }
    }
    __device__ __forceinline__ void operator()(const f32x4 (&acc)[2][2][4][2], const Unit& u, int wr_, int wc_, int fr_, int fq_, const PG8_LAS unsigned char* tab) const {
        (void)fr_; (void)fq_; (void)tab;
        if (XG) body<true>(acc, u, wr_, wc_); else body<false>(acc, u, wr_, wc_);
    }
};
template <class Epi, class Sched, bool ALIGN_EPI = false, bool SP2 = false, bool HALFN = false>
__device__ __forceinline__ void gemm_phase(PG8_LAS unsigned char* lds, const Gemm g, const Sched& S, const Epi& E, const int wave_in) {
    const int tid = wave_in * 64 + olane(), wid = __builtin_amdgcn_readfirstlane(tid >> 6), lane = tid & 63, wr = wid >> 2, wc = wid & 3, fr = lane & 15, fq = lane >> 4;
    const int K = g.K, nt = K / BK;
    unsigned voffA[2], voffB[2];
#pragma unroll
    for (int i = 0; i < 2; ++i) { int R, C; stage_rc(tid * 16 + i * 8192, R, C); const int Rb = Epi::PERM ? ((R & ~31) + perm32(R & 31)) : R;
        voffA[i] = (unsigned)(R * K + C) * 2u; voffB[i] = (unsigned)(Rb * K + C) * 2u; }
    const size_t kstep = (size_t)(BK * 2);
    const size_t hstep = (size_t)HALF * K * 2;
    const size_t tstep = 2 * hstep;
    const size_t bstep = HALFN ? hstep : tstep;
    static_assert(!HALFN || SP2, "HALFN is written for the SP2 loop only");
    const unsigned ldsw = (unsigned)wid * 1024u;
    const int aoff = lds_byte(wr * 64 + fr, fq * 8), boff = lds_byte(wc * 32 + fr, fq * 8);
#define PG8_SA(b, h) (((b) * 2 + (h)) * HTB)
#define PG8_SB(b, h) ((4 + (b) * 2 + (h)) * HTB)
#define PG8_STAGE(bufoff, gbase, voff) do { _Pragma("unroll") for (int _i = 0; _i < 2; ++_i) \
        __builtin_amdgcn_global_load_lds((const unsigned*)((const char*)(gbase) + (voff)[_i]), (PG8_LAS unsigned*)(lds + (bufoff) + ldsw + _i * 8192), 16, 0, 0); } while (0)
#define PG8_LDA(dst, b, h) do { _Pragma("unroll") for (int m = 0; m < 4; ++m) _Pragma("unroll") for (int k = 0; k < 2; ++k) dst[m][k] = *(const PG8_LAS bf16x8*)(lds + PG8_SA(b, h) + aoff + m * 2048 + k * 1024); } while (0)
#define PG8_LDB(dst, b, h) do { _Pragma("unroll") for (int n = 0; n < 2; ++n) _Pragma("unroll") for (int k = 0; k < 2; ++k) dst[n][k] = *(const PG8_LAS bf16x8*)(lds + PG8_SB(b, h) + boff + n * 2048 + k * 1024); } while (0)
#define PG8_MMA(ai, bj, At, Bt) do { __builtin_amdgcn_s_setprio(1); _Pragma("unroll") for (int m = 0; m < 4; ++m) _Pragma("unroll") for (int n = 0; n < 2; ++n) _Pragma("unroll") for (int k = 0; k < 2; ++k) \
        acc[ai][bj][m][n] = __builtin_amdgcn_mfma_f32_16x16x32_bf16(Bt[n][k], At[m][k], acc[ai][bj][m][n], 0, 0, 0); __builtin_amdgcn_s_setprio(0); } while (0)
#define PG8_WAIT_V(n) asm volatile("s_waitcnt vmcnt(" #n ")" ::: "memory")
#define PG8_WAIT_L(n) asm volatile("s_waitcnt lgkmcnt(" #n ")" ::: "memory")
#define PG8_BAR __builtin_amdgcn_s_barrier()
#define PG8_SCHED __builtin_amdgcn_sched_barrier(0)
    Unit cur, nxt; int ui = 0;
    if (!S.next(0, cur)) return;
    f32x4 acc[2][2][4][2];
#pragma unroll
    for (int a = 0; a < 2; ++a)
#pragma unroll
        for (int b = 0; b < 2; ++b)
#pragma unroll
            for (int m = 0; m < 4; ++m)
#pragma unroll
                for (int n = 0; n < 2; ++n) acc[a][b][m][n] = (f32x4){0.f, 0.f, 0.f, 0.f};
    bf16x8 At[4][2], B0[2][2], B1[2][2];
    const char* cA = (const char*)g.A + (size_t)cur.pm * tstep; const char* cB = (const char*)g.Bt + (size_t)cur.pn * bstep;
    S.a_ready(cur);
    if constexpr (Epi::STAGE_IN) E.stage_in(cur, 0, wid, lane, lds + STAGE_BYTES);
    if constexpr (HALFN) {
        PG8_STAGE(PG8_SB(0, 0), cB, voffB); PG8_STAGE(PG8_SA(0, 0), cA, voffA); PG8_STAGE(PG8_SA(0, 1), cA + hstep, voffA);
        if (wr == 1) PG8_BAR;
        PG8_WAIT_V(2); PG8_BAR;
        PG8_STAGE(PG8_SB(1, 0), cB + kstep, voffB); PG8_STAGE(PG8_SA(1, 0), cA + kstep, voffA);
        PG8_WAIT_V(4); PG8_BAR;
    } else if constexpr (SP2) {
        PG8_STAGE(PG8_SB(0, 0), cB, voffB); PG8_STAGE(PG8_SB(0, 1), cB + hstep, voffB); PG8_STAGE(PG8_SA(0, 0), cA, voffA); PG8_STAGE(PG8_SA(0, 1), cA + hstep, voffA);
        if (wr == 1) PG8_BAR;
        PG8_WAIT_V(2); PG8_BAR;
        PG8_STAGE(PG8_SB(1, 0), cB + kstep, voffB); PG8_STAGE(PG8_SA(1, 0), cA + kstep, voffA); PG8_STAGE(PG8_SB(1, 1), cB + hstep + kstep, voffB);
        PG8_WAIT_V(6); PG8_BAR;
    } else {
        PG8_STAGE(PG8_SB(0, 0), cB, voffB); PG8_STAGE(PG8_SA(0, 0), cA, voffA); PG8_STAGE(PG8_SB(0, 1), cB + hstep, voffB); PG8_STAGE(PG8_SA(0, 1), cA + hstep, voffA);
        if (wr == 1) PG8_BAR;
        PG8_WAIT_V(4); PG8_BAR;
        PG8_STAGE(PG8_SB(1, 0), cB + kstep, voffB); PG8_STAGE(PG8_SA(1, 0), cA + kstep, voffA); PG8_STAGE(PG8_SB(1, 1), cB + hstep + kstep, voffB);
        PG8_WAIT_V(6); PG8_BAR;
    }
    for (;;) {
        const bool has_next = S.next(ui + 1, nxt);
        const char* nA = has_next ? (const char*)g.A + (size_t)nxt.pm * tstep : cA; const char* nB = has_next ? (const char*)g.Bt + (size_t)nxt.pn * bstep : cB;
        for (int t = 0; t < nt; t += 2) {
            const bool last = (t == nt - 2);
            const char* a1 = cA + (size_t)(t + 1) * kstep;
            const char* a2 = last ? nA : cA + (size_t)(t + 2) * kstep; const char* b2 = last ? nB : cB + (size_t)(t + 2) * kstep;
            const char* a3 = a2 + kstep; const char* b3 = b2 + kstep;
            if (last && has_next) S.a_ready(nxt);
            if constexpr (Epi::STAGE_IN) { if (last && has_next) E.stage_in(nxt, (ui + 1) & 1, wid, lane, lds + STAGE_BYTES); }
            if constexpr (HALFN) {
            PG8_LDB(B0, 0, 0); PG8_SCHED; PG8_LDA(At, 0, 0); PG8_STAGE(PG8_SA(1, 1), a1 + hstep, voffA);
            PG8_WAIT_V(6); PG8_WAIT_L(0); PG8_BAR; PG8_MMA(0, 0, At, B0); PG8_BAR; PG8_SCHED;
            PG8_LDA(At, 0, 1); PG8_STAGE(PG8_SB(0, 0), b2, voffB); PG8_STAGE(PG8_SA(0, 0), a2, voffA);
            PG8_WAIT_V(6); PG8_WAIT_L(0); PG8_BAR; PG8_MMA(1, 0, At, B0); PG8_BAR; PG8_SCHED;
            PG8_LDB(B0, 1, 0); PG8_SCHED; PG8_LDA(At, 1, 0); PG8_STAGE(PG8_SA(0, 1), a2 + hstep, voffA);
            PG8_WAIT_V(6); PG8_WAIT_L(0); PG8_BAR; PG8_MMA(0, 0, At, B0); PG8_BAR; PG8_SCHED;
            PG8_LDA(At, 1, 1); PG8_STAGE(PG8_SB(1, 0), b3, voffB); PG8_STAGE(PG8_SA(1, 0), a3, voffA);
            PG8_WAIT_V(6); PG8_WAIT_L(0); PG8_BAR; PG8_MMA(1, 0, At, B0); PG8_BAR; PG8_SCHED;
            } else if constexpr (SP2) {
            PG8_LDB(B0, 0, 0); PG8_LDB(B1, 0, 1); PG8_SCHED; PG8_LDA(At, 0, 0); PG8_STAGE(PG8_SA(1, 1), a1 + hstep, voffA);
            PG8_WAIT_V(8); PG8_WAIT_L(0); PG8_BAR; PG8_MMA(0, 0, At, B0); PG8_MMA(0, 1, At, B1); PG8_BAR; PG8_SCHED;
            PG8_LDA(At, 0, 1); PG8_STAGE(PG8_SB(0, 0), b2, voffB); PG8_STAGE(PG8_SB(0, 1), b2 + hstep, voffB); PG8_STAGE(PG8_SA(0, 0), a2, voffA);
            PG8_WAIT_V(8); PG8_WAIT_L(0); PG8_BAR; PG8_MMA(1, 0, At, B0); PG8_MMA(1, 1, At, B1); PG8_BAR; PG8_SCHED;
            PG8_LDB(B0, 1, 0); PG8_LDB(B1, 1, 1); PG8_SCHED; PG8_LDA(At, 1, 0); PG8_STAGE(PG8_SA(0, 1), a2 + hstep, voffA);
            PG8_WAIT_V(8); PG8_WAIT_L(0); PG8_BAR; PG8_MMA(0, 0, At, B0); PG8_MMA(0, 1, At, B1); PG8_BAR; PG8_SCHED;
            PG8_LDA(At, 1, 1); PG8_STAGE(PG8_SB(1, 0), b3, voffB); PG8_STAGE(PG8_SB(1, 1), b3 + hstep, voffB); PG8_STAGE(PG8_SA(1, 0), a3, voffA);
            PG8_WAIT_V(8); PG8_WAIT_L(0); PG8_BAR; PG8_MMA(1, 0, At, B0); PG8_MMA(1, 1, At, B1); PG8_BAR; PG8_SCHED;
            } else {
            PG8_LDB(B0, 0, 0); PG8_SCHED; PG8_LDA(At, 0, 0); PG8_STAGE(PG8_SA(1, 1), a1 + hstep, voffA);
            PG8_WAIT_L(8); PG8_BAR; PG8_WAIT_L(0); PG8_MMA(0, 0, At, B0); PG8_BAR; PG8_SCHED;
            PG8_LDB(B1, 0, 1); PG8_STAGE(PG8_SB(0, 0), b2, voffB);
            PG8_BAR; PG8_WAIT_L(0); PG8_MMA(0, 1, At, B1); PG8_BAR;
            PG8_LDA(At, 0, 1); PG8_STAGE(PG8_SA(0, 0), a2, voffA);
            PG8_BAR; PG8_WAIT_L(0); PG8_MMA(1, 0, At, B0); PG8_BAR; PG8_SCHED;
            PG8_STAGE(PG8_SB(0, 1), b2 + hstep, voffB);
            PG8_WAIT_V(6); PG8_BAR; PG8_MMA(1, 1, At, B1); PG8_BAR;
            PG8_LDB(B0, 1, 0); PG8_SCHED; PG8_LDA(At, 1, 0); PG8_STAGE(PG8_SA(0, 1), a2 + hstep, voffA);
            PG8_WAIT_L(8); PG8_BAR; PG8_WAIT_L(0); PG8_MMA(0, 0, At, B0); PG8_BAR; PG8_SCHED;
            PG8_LDB(B1, 1, 1); PG8_STAGE(PG8_SB(1, 0), b3, voffB);
            PG8_BAR; PG8_WAIT_L(0); PG8_MMA(0, 1, At, B1); PG8_BAR;
            PG8_LDA(At, 1, 1); PG8_STAGE(PG8_SA(1, 0), a3, voffA);
            PG8_BAR; PG8_WAIT_L(0); PG8_MMA(1, 0, At, B0); PG8_BAR; PG8_SCHED;
            PG8_STAGE(PG8_SB(1, 1), b3 + hstep, voffB);
            PG8_WAIT_V(6); PG8_BAR; PG8_MMA(1, 1, At, B1); PG8_BAR;
            }
        }
        if constexpr (ALIGN_EPI) { if (wr == 0) PG8_BAR; }
        if constexpr (!Epi::AFTER_DRAIN) { E(acc, cur, wr, wc, fr, fq, lds + STAGE_BYTES + (ui & 1) * 2048); S.done(cur); }
        if (!has_next) break;
#pragma unroll
        for (int a = 0; a < 2; ++a)
#pragma unroll
            for (int b = 0; b < 2; ++b)
#pragma unroll
                for (int m = 0; m < 4; ++m)
#pragma unroll
                    for (int n = 0; n < 2; ++n) acc[a][b][m][n] = (f32x4){0.f, 0.f, 0.f, 0.f};
        cur = nxt; cA = nA; cB = nB; ++ui;
        if constexpr (ALIGN_EPI) { if (wr == 1) PG8_BAR; }
    }
    PG8_WAIT_V(0);
    if constexpr (!ALIGN_EPI) { if (wr == 0) PG8_BAR; }
    PG8_BAR;
    if constexpr (Epi::AFTER_DRAIN) { E.fused(acc, cur, wr, wc, fr, fq, lds, wid, lane); S.done(cur); }
#undef PG8_SA
#undef PG8_SB
#undef PG8_STAGE
#undef PG8_LDA
#undef PG8_LDB
#undef PG8_MMA
#undef PG8_WAIT_V
#undef PG8_WAIT_L
#undef PG8_BAR
#undef PG8_SCHED
}
}
constexpr int NWAVES = 8, NTHR = 512;
constexpr size_t MiB = 1u << 20;
constexpr size_t WS_CTL = 0, CTL_ZERO_BYTES = 2 * MiB;
constexpr size_t WS_MODS = 256 * 1024;
constexpr size_t WS_STAT = 768 * 1024;
constexpr size_t WS_SW = 1 * MiB + 64 * 1024, WS_GT = 374 * MiB;
static_assert(WS_SW + 8 * 5 * 5632 * 4 <= 2 * MiB, "shift @ W rows inside the zeroed region");
constexpr size_t WS_ROPE = 1 * MiB;
constexpr size_t WS_W = 2 * MiB;
constexpr size_t W_MLA = WS_W, MLA_WB = 5898240;
constexpr size_t MW_CAT = 0, MW_UQ = 1572864, MW_UKV = 2752512, MW_O = 3801088;
constexpr size_t W_CV1 = WS_W + 2 * MLA_WB, W_CV2 = W_CV1 + 4 * MiB;
constexpr size_t W_SSI = W_CV2 + 2 * MiB, W_SSO = W_SSI + 11010048;
constexpr size_t W_FF = W_SSO + 4 * MiB, FF_WB = 17301504, FW_IN = 0, FW_OUT = 11534336;
static_assert(W_FF + 4 * FF_WB <= 102 * MiB, "weights region");
constexpr size_t WS_H = 102 * MiB;
constexpr size_t WS_CKV = 118 * MiB, CKV_B = (size_t)(T + NCTX) * KVL * 2;
constexpr size_t WS_AR = 128 * MiB;
constexpr size_t A_LAT = WS_AR, A_QN = A_LAT + 24 * MiB, A_QRAW = A_QN + 6 * MiB, A_KVRAW = A_QRAW + 24 * MiB, A_QB = A_KVRAW + 36 * MiB, A_KB = A_QB + 24 * MiB, A_AO = A_KB + 27 * MiB;
constexpr size_t A_U = WS_AR, A_V = A_U + 16 * MiB;
constexpr size_t A_Z = WS_AR, A_XPRE = A_Z + 32 * MiB, A_DTRAW = A_XPRE + 48 * MiB, A_XBC = A_DTRAW + 2 * MiB, A_DT = A_XBC + 48 * MiB, A_Y = A_DT + 2 * MiB, A_YN = A_XPRE, A_ACUM = A_Y + 64 * MiB;
constexpr size_t A_ACT = WS_AR + 200 * MiB;
static_assert(A_AO + 16 * MiB <= A_ACT && A_ACUM + 2 * MiB <= A_ACT && A_ACT + 44 * MiB <= 384 * MiB, "arena map");
constexpr int CW_BAR = 4096;
constexpr int LDS_BYTES = 163840, RING_BYTES = 131072, MISC_OFF = 163840 - 256, PTAB_OFF_C = MISC_OFF - 512;

#define GAS __attribute__((address_space(1)))
#define LAS __attribute__((address_space(3)))
typedef unsigned short bf16;
typedef unsigned v4u __attribute__((ext_vector_type(4)));
typedef unsigned v2u __attribute__((ext_vector_type(2)));
typedef float v4f __attribute__((ext_vector_type(4)));
typedef float v2f __attribute__((ext_vector_type(2)));
typedef GAS unsigned gu32;
#define LDS_WAIT() asm volatile("s_waitcnt lgkmcnt(0)" ::: "memory")
#define LDS_BARRIER() do { asm volatile("s_waitcnt lgkmcnt(0)" ::: "memory"); __builtin_amdgcn_s_barrier(); asm volatile("" ::: "memory"); } while (0)
#define VM_WAIT() asm volatile("s_waitcnt vmcnt(0)" ::: "memory")
__device__ __forceinline__ unsigned f2bf(float f) { unsigned u = __builtin_bit_cast(unsigned, f); return (u + 0x7fffu + ((u >> 16) & 1u)) >> 16; }
__device__ __forceinline__ unsigned pk2(float lo, float hi) { unsigned r; asm("v_cvt_pk_bf16_f32 %0, %1, %2" : "=v"(r) : "v"(lo), "v"(hi)); return r; }
__device__ __forceinline__ float fast_sig(float x) { return __builtin_amdgcn_rcpf(1.f + __builtin_amdgcn_exp2f(-1.4426950408889634f * x)); }
__device__ __forceinline__ float bflo(unsigned u) { return __builtin_bit_cast(float, u << 16); }
__device__ __forceinline__ float bfhi(unsigned u) { return __builtin_bit_cast(float, u & 0xffff0000u); }
__device__ __forceinline__ float bf2f(bf16 b) { return __builtin_bit_cast(float, (unsigned)b << 16); }

#define XB_TMO      128
#define XB_XCNT(j)  (256  + 64 * (j))
#define XB_XSUB(j)  (1280 + 64 * (j))
#define XB_XGEN(j)  (2304 + 64 * (j))
#define XB_TOP      3328
#define XB_TOPGEN   3392
#define XCD_BAR_WORDS 3456
#define XB_SPIN_CAP (1u << 18)

__device__ __forceinline__ unsigned xb_ld(unsigned* p)              { return __hip_atomic_load(p, __ATOMIC_RELAXED, __HIP_MEMORY_SCOPE_AGENT); }
__device__ __forceinline__ unsigned xb_add(unsigned* p, unsigned v) { return __hip_atomic_fetch_add(p, v, __ATOMIC_RELAXED, __HIP_MEMORY_SCOPE_AGENT); }
__device__ __forceinline__ unsigned xb_xcc_id() { return (unsigned)__builtin_amdgcn_s_getreg((3 << 11) | 20) & 0xFu; }
#define XB_SPIN(cond, bar) do { unsigned _sp = 0; while (cond) { __builtin_amdgcn_s_sleep(1); \
    if ((++_sp & 255u) == 0u) { if (xb_ld(&(bar)[XB_TMO])) break; if (_sp > XB_SPIN_CAP) { atomicAdd(&(bar)[XB_TMO], 1u); break; } } } } while (0)

struct XcdBarrier {
    unsigned* bar; unsigned x;
    volatile LAS unsigned* st;
};

__device__ __forceinline__ XcdBarrier xcd_barrier_post(unsigned* bar, volatile LAS unsigned* st) {
    XcdBarrier b; b.bar = bar; b.x = xb_xcc_id(); b.st = st;
    if (threadIdx.x == 0) (void)xb_add(&bar[XB_XCNT(b.x)], 1u);
    return b;
}
__device__ __forceinline__ void xcd_barrier_complete(unsigned* bar, unsigned x, unsigned& nloc, unsigned& nx) {
    const unsigned G = gridDim.x * gridDim.y * gridDim.z;
    unsigned sum, cnt, mine, sp = 0u;
    for (;;) {
        sum = 0u; cnt = 0u; mine = 0u;
#pragma unroll
        for (unsigned j = 0; j < 16; j += 8) {
            unsigned c[8]; const unsigned* p = bar + XB_XCNT(j);
            asm volatile("global_load_dword %0, %8, off sc1\n\tglobal_load_dword %1, %8, off offset:256 sc1\n\tglobal_load_dword %2, %8, off offset:512 sc1\n\tglobal_load_dword %3, %8, off offset:768 sc1\n\t"
                         "global_load_dword %4, %8, off offset:1024 sc1\n\tglobal_load_dword %5, %8, off offset:1280 sc1\n\tglobal_load_dword %6, %8, off offset:1536 sc1\n\tglobal_load_dword %7, %8, off offset:1792 sc1\n\t"
                         "s_waitcnt vmcnt(0)"
                         : "=&v"(c[0]), "=&v"(c[1]), "=&v"(c[2]), "=&v"(c[3]), "=&v"(c[4]), "=&v"(c[5]), "=&v"(c[6]), "=&v"(c[7]) : "v"(p) : "memory");
#pragma unroll
            for (unsigned i = 0; i < 8; ++i) { sum += c[i]; cnt += (c[i] > 0u) ? 1u : 0u; mine = (j + i == x) ? c[i] : mine; } }
        if (sum == G) break;
        __builtin_amdgcn_s_sleep(1);
        if ((++sp & 255u) == 0u) { if (xb_ld(&bar[XB_TMO])) break; if (sp > XB_SPIN_CAP) { atomicAdd(&bar[XB_TMO], 1u); break; } }
    }
    nloc = mine > 0u ? mine : 1u; nx = cnt > 0u ? cnt : 1u;
}

__device__ __forceinline__ void xcd_barrier_protocol(const XcdBarrier& b) {
    {
        unsigned* bar = b.bar;
        __builtin_amdgcn_s_waitcnt(0);
        unsigned nloc = b.st[0], nx = b.st[1];
        if (nloc == 0u) { xcd_barrier_complete(bar, b.x, nloc, nx); b.st[0] = nloc; b.st[1] = nx; }
        const unsigned old = xb_add(&bar[XB_XSUB(b.x)], 1u);
        const unsigned gen = old / nloc;
        if (old + 1u == (gen + 1u) * nloc) {
            __builtin_amdgcn_fence(__ATOMIC_RELEASE, "agent");
            asm volatile("s_waitcnt vmcnt(0)" ::: "memory");
            const unsigned og = xb_add(&bar[XB_TOP], 1u);
            const unsigned tg = og / nx;
            if (og + 1u == (tg + 1u) * nx) xb_add(&bar[XB_TOPGEN], 1u);
            else XB_SPIN(xb_ld(&bar[XB_TOPGEN]) == tg, bar);
            __builtin_amdgcn_fence(__ATOMIC_ACQUIRE, "agent");
            xb_add(&bar[XB_XGEN(b.x)], 1u);
            asm volatile("s_waitcnt vmcnt(0)" ::: "memory");
        } else {
            XB_SPIN(xb_ld(&bar[XB_XGEN(b.x)]) == gen, bar);
            __builtin_amdgcn_fence(__ATOMIC_ACQUIRE, "agent");
            asm volatile("s_waitcnt vmcnt(0)" ::: "memory");
        }
    }
}
__device__ __forceinline__ void xcd_barrier(const XcdBarrier& b) {
    asm volatile("s_waitcnt vmcnt(0)" ::: "memory");
    __syncthreads();
    if (threadIdx.x == 0) xcd_barrier_protocol(b);
    __syncthreads();
}
struct Frame {
    LAS unsigned char* lds; int tid, lane, wave, vcu, G, gw, NGW, bx;
    volatile LAS unsigned* PT;
};
constexpr int PT_OUT = 38, PT_WS = 39;
__device__ __forceinline__ const float* ldp(volatile LAS unsigned* PT, int k) {
    const unsigned lo = __builtin_amdgcn_readfirstlane(PT[2 * k]), hi = __builtin_amdgcn_readfirstlane(PT[2 * k + 1]);
    return (const float*)(((unsigned long long)hi << 32) | lo);
}
#define INP(k) ldp(F.PT, (k))
#define WSP ((unsigned char*)ldp(F.PT, PT_WS))
#define OUTP ((float*)ldp(F.PT, PT_OUT))
enum InIdx { I_XP = 0, I_XS, I_CCKV, I_CKPE, I_SSM, I_C, I_CCTX, I_WADA, I_BADA, I_GN1, I_GN2, I_WDQ, I_GQ, I_WUQ, I_WDKV, I_GKV, I_WUKV, I_GQN, I_GKN, I_WO,
             I_CVW1, I_CVB1, I_CVWD, I_CVBD, I_CVGL, I_CVBL, I_CVW2, I_CVB2, I_SSWI, I_SSWC, I_SSBC, I_SSDTB, I_SSAL, I_SSD, I_SSGN, I_SSWO, I_FFWI, I_FFWO };
__device__ __forceinline__ float shx(float v, int lane, int o) { return __builtin_bit_cast(float, __builtin_amdgcn_ds_bpermute((lane ^ o) << 2, __builtin_bit_cast(int, v))); }
__device__ __forceinline__ float wsum(float v, int lane) {
#pragma unroll
    for (int o = 1; o < 64; o <<= 1) v += shx(v, lane, o);
    return v;
}
constexpr float QSCALE = 0.10206207261596577f * 1.4426950408889634f;

struct P0Item { const float* W; bf16* WT; int K, N, mode, H, roff, k0, n0; const float* sh; float* sw; };
__device__ __forceinline__ void p0_item_load(const P0Item& J, int lane, v4f (&t)[8]) {
#pragma unroll
    for (int i = 0; i < 8; ++i) t[i] = *(const GAS v4f*)(J.W + (size_t)(J.k0 + 8 * i + (lane >> 3)) * J.N + J.n0 + 4 * (lane & 7));
}
__device__ __forceinline__ void p0_item_shift(const P0Item& J, int lane, v4f (&sv)[5][2]) {
#pragma unroll
    for (int cc = 0; cc < 5; ++cc) { const float* sp = J.sh + (size_t)cc * 6144 + J.k0 + 8 * (lane & 7); sv[cc][0] = *(const GAS v4f*)sp; sv[cc][1] = *(const GAS v4f*)(sp + 4); }
}
__device__ __forceinline__ void p0_item_finish(const P0Item& J, int lane, const v4f (&t)[8], LAS float* scr, const v4f (&sv)[5][2]) {
#pragma unroll
    for (int i = 0; i < 8; ++i) { LAS float* d = scr + (8 * i + (lane >> 3)) * 33 + 4 * (lane & 7); d[0] = t[i].x; d[1] = t[i].y; d[2] = t[i].z; d[3] = t[i].w; }
    LDS_WAIT(); asm volatile("" ::: "memory");
    const int c = lane & 7;
#pragma unroll
    for (int j = 0; j < 4; ++j) { const int n = (lane >> 3) + 8 * j, col = J.n0 + n; const LAS float* s = scr + (8 * c) * 33 + n;
        int drow;
        if (J.mode == 0) drow = J.roff + col;
        else { const int f = col < J.H ? col : col - J.H; drow = 256 * (f >> 7) + 128 * ((f >> 2) & 1) + 32 * ((f >> 5) & 3) + (col < J.H ? 0 : 16) + 4 * ((f >> 3) & 3) + (f & 3); }
        v4u o; o.x = pk2(s[0 * 33], s[1 * 33]); o.y = pk2(s[2 * 33], s[3 * 33]); o.z = pk2(s[4 * 33], s[5 * 33]); o.w = pk2(s[6 * 33], s[7 * 33]);
        *(GAS v4u*)(J.WT + (size_t)drow * J.K + J.k0 + 8 * c) = o; }
    if (J.sw) {
        float pw[4][5];
#pragma unroll
        for (int cc = 0; cc < 5; ++cc) { const v4f s0 = sv[cc][0], s1 = sv[cc][1];
#pragma unroll
            for (int j = 0; j < 4; ++j) { const LAS float* q = scr + (8 * c) * 33 + (lane >> 3) + 8 * j;
                pw[j][cc] = (s0.x * q[0 * 33] + s0.y * q[1 * 33] + s0.z * q[2 * 33] + s0.w * q[3 * 33]) + (s1.x * q[4 * 33] + s1.y * q[5 * 33] + s1.z * q[6 * 33] + s1.w * q[7 * 33]); } }
#pragma unroll
        for (int o = 1; o < 8; o <<= 1) {
#pragma unroll
            for (int j = 0; j < 4; ++j)
#pragma unroll
                for (int cc = 0; cc < 5; ++cc) pw[j][cc] += shx(pw[j][cc], lane, o); }
        if (c == 0) {
#pragma unroll
            for (int j = 0; j < 4; ++j) { const int col = J.n0 + (lane >> 3) + 8 * j; int drow;
                if (J.mode == 0) drow = J.roff + col;
                else { const int f = col < J.H ? col : col - J.H; drow = 256 * (f >> 7) + 128 * ((f >> 2) & 1) + 32 * ((f >> 5) & 3) + (col < J.H ? 0 : 16) + 4 * ((f >> 3) & 3) + (f & 3); }
#pragma unroll
                for (int cc = 0; cc < 5; ++cc) atomicAdd(J.sw + (size_t)cc * pg8::SW_LD + drow, pw[j][cc]); } }
    }
    LDS_WAIT(); asm volatile("" ::: "memory");
}
__device__ __forceinline__ void p0_job(int q, int& inp, size_t& soff, int& K, int& N, size_t& doff, int& mode, int& H, int& roff) {
    mode = 0; H = 0; roff = 0; soff = 0;
    if (q < 10) { const int j = q / 5, t = q % 5; const size_t wb = W_MLA + (size_t)j * MLA_WB;
        if (t == 0) { inp = I_WDQ; soff = (size_t)j * 1024 * 384; K = 1024; N = 384; doff = wb + MW_CAT; }
        else if (t == 1) { inp = I_WDKV; soff = (size_t)j * 1024 * 288; K = 1024; N = 288; doff = wb + MW_CAT; roff = 384; }
        else if (t == 2) { inp = I_WUQ; soff = (size_t)j * 384 * 1536; K = 384; N = 1536; doff = wb + MW_UQ; }
        else if (t == 3) { inp = I_WUKV; soff = (size_t)j * 256 * 2048; K = 256; N = 2048; doff = wb + MW_UKV; }
        else { inp = I_WO; soff = (size_t)j * 1024 * 1024; K = 1024; N = 1024; doff = wb + MW_O; } }
    else if (q == 10) { inp = I_CVW1; K = 1024; N = 2048; doff = W_CV1; mode = 1; H = 1024; }
    else if (q == 11) { inp = I_CVW2; K = 1024; N = 1024; doff = W_CV2; }
    else if (q == 12) { inp = I_SSWI; K = 1024; N = 5184; doff = W_SSI; }
    else if (q == 13) { inp = I_SSWO; K = 2048; N = 1024; doff = W_SSO; }
    else { const int l = (q - 14) >> 1, t = (q - 14) & 1;
        if (t == 0) { inp = I_FFWI; soff = (size_t)l * 1024 * 5632; K = 1024; N = 5632; doff = W_FF + (size_t)l * FF_WB + FW_IN; mode = 1; H = 2816; }
        else { inp = I_FFWO; soff = (size_t)l * 2816 * 1024; K = 2816; N = 1024; doff = W_FF + (size_t)l * FF_WB + FW_OUT; } }
}
__device__ __forceinline__ int p0_sw_of_job(int q) { return q == 10 ? 2 : q == 12 ? 4 : (q == 5 || q == 6) ? 6 : (q >= 16 && !((q - 14) & 1)) ? 2 * ((q - 14) >> 1) + 1 : -1; }
constexpr int P0_NITEMS = 2 * ((1024 / 64) * (384 / 32) + (1024 / 64) * (288 / 32) + (384 / 64) * (1536 / 32) + (256 / 64) * (2048 / 32) + (1024 / 64) * (1024 / 32))
                        + (1024 / 64) * (2048 / 32) + (1024 / 64) * (1024 / 32) + (1024 / 64) * (5184 / 32) + (2048 / 64) * (1024 / 32)
                        + 4 * ((1024 / 64) * (5632 / 32) + (2816 / 64) * (1024 / 32));
__device__ __forceinline__ void p0_convert(Frame& F, unsigned qmask, int ww, int nww, bool fuse) {
    unsigned char* ws = WSP;
    LAS float* scr = (LAS float*)(F.lds + F.wave * 8448);
    int total = 0;
#pragma unroll 1
    for (int q = 0; q < 22; ++q) if ((qmask >> q) & 1u) { int inp, K, N, mode, H, roff; size_t soff, doff; p0_job(q, inp, soff, K, N, doff, mode, H, roff); total += (K / 64) * (N / 32); }
    for (int it = ww; it < total; it += 2 * nww) {
        P0Item J[2]; bool have1 = it + nww < total;
#pragma unroll
        for (int e = 0; e < 2; ++e) {
            int r = e == 0 ? it : (have1 ? it + nww : it), inp = 0, K = 64, N = 32, mode = 0, H = 0, roff = 0, qq = 0; size_t soff = 0, doff = 0;
#pragma unroll 1
            for (int q = 0; q < 22; ++q) { if (!((qmask >> q) & 1u)) continue; p0_job(q, inp, soff, K, N, doff, mode, H, roff); qq = q; const int ni = (K / 64) * (N / 32); if (r < ni) break; r -= ni; }
            const int nblk = N / 32;
            J[e].W = INP(inp) + soff; J[e].WT = (bf16*)(ws + doff); J[e].K = K; J[e].N = N; J[e].mode = mode; J[e].H = H; J[e].roff = roff; J[e].k0 = 64 * (r / nblk); J[e].n0 = 32 * (r % nblk);
            const int sidx = fuse ? p0_sw_of_job(qq) : -1;
            J[e].sh = nullptr; J[e].sw = nullptr;
            if (sidx >= 0) { J[e].sh = (const float*)(ws + WS_MODS) + (size_t)(sidx >> 1) * 5 * 6144 + ((sidx & 1) ? 3072 : 0); J[e].sw = (float*)(ws + WS_SW) + (size_t)sidx * 5 * pg8::SW_LD; }
        }
        v4f t0[8], t1[8];
        p0_item_load(J[0], F.lane, t0); p0_item_load(J[1], F.lane, t1);
        v4f sv0[5][2], sv1[5][2];
#pragma unroll
        for (int cc = 0; cc < 5; ++cc) { sv0[cc][0] = sv0[cc][1] = sv1[cc][0] = sv1[cc][1] = (v4f){0.f, 0.f, 0.f, 0.f}; }
        if (J[0].sw) p0_item_shift(J[0], F.lane, sv0);
        if (J[1].sw) p0_item_shift(J[1], F.lane, sv1);
        p0_item_finish(J[0], F.lane, t0, scr, sv0);
        if (have1) p0_item_finish(J[1], F.lane, t1, scr, sv1);
    }
}
constexpr unsigned P0_Q_NOW = 0x1fu | (1u << 14);
constexpr int P0_WIN_LAST = 12;
__device__ __forceinline__ int p0_def_job(int i) { return i == 0 ? 15 : i == 1 ? 10 : i == 2 ? 11 : i == 3 ? 16 : i == 4 ? 17 : i == 5 ? 12 : i == 6 ? 13 : i == 7 ? 18 : i == 8 ? 19 : i < 14 ? i - 4 : i == 14 ? 20 : 21; }
constexpr int P0_WIN_CAP = 1792;
static_assert(P0_WIN_CAP * P0_WIN_LAST >= 20624, "deferred items fit the windows");
__device__ __forceinline__ bool p0_def_item(Frame& F, int r, P0Item& J) {
    unsigned char* ws = WSP;
    int inp = 0, K = 64, N = 32, mode = 0, H = 0, roff = 0, qq = 0; size_t soff = 0, doff = 0; bool found = false;
#pragma unroll 1
    for (int i = 0; i < 16; ++i) { qq = p0_def_job(i); p0_job(qq, inp, soff, K, N, doff, mode, H, roff); const int ni = (K / 64) * (N / 32); if (r < ni) { found = true; break; } r -= ni; }
    if (!found) return false;
    const int nblk = N / 32;
    J.W = INP(inp) + soff; J.WT = (bf16*)(ws + doff); J.K = K; J.N = N; J.mode = mode; J.H = H; J.roff = roff; J.k0 = 64 * (r / nblk); J.n0 = 32 * (r % nblk);
    const int sidx = p0_sw_of_job(qq); J.sh = nullptr; J.sw = nullptr;
    if (sidx >= 0) { J.sh = (const float*)(ws + WS_MODS) + (size_t)(sidx >> 1) * 5 * 6144 + ((sidx & 1) ? 3072 : 0); J.sw = (float*)(ws + WS_SW) + (size_t)sidx * 5 * pg8::SW_LD; }
    return true;
}
constexpr int P0_DUMP = 161792;
static_assert(P0_DUMP + 1024 <= PTAB_OFF_C, "prefetch dump area");
__device__ __forceinline__ void p0_window(Frame& F, int w) {
    for (int e = F.bx * (NWAVES - 1) + (F.wave - 1); e < P0_WIN_CAP; e += F.G * (NWAVES - 1)) {
        P0Item J;
        if (!p0_def_item(F, (w - 1) * P0_WIN_CAP + e, J)) return;
        v4f t0[8], sv[5][2];
        p0_item_load(J, F.lane, t0);
#pragma unroll
        for (int cc = 0; cc < 5; ++cc) { sv[cc][0] = sv[cc][1] = (v4f){0.f, 0.f, 0.f, 0.f}; }
        if (J.sw) p0_item_shift(J, F.lane, sv);
        p0_item_finish(J, F.lane, t0, (LAS float*)(F.lds + F.wave * 8448), sv);
    }
}
__device__ __forceinline__ void xcd_barrier_work(const XcdBarrier& b, Frame& F, int w) {
    asm volatile("s_waitcnt vmcnt(0)" ::: "memory");
    __syncthreads();
    if (threadIdx.x == 0) xcd_barrier_protocol(b);
    if (F.wave != 0 && w >= 1 && w <= P0_WIN_LAST) p0_window(F, w);
    __syncthreads();
}
__device__ __forceinline__ void p0_prologue(Frame& F) {
    unsigned char* ws = WSP;
    LAS float* s = (LAS float*)F.lds;
    for (int i = F.tid; i < 5 * 1024; i += NTHR) { const int cc = i >> 10, k = i & 1023; const float v = cc == 0 ? INP(I_CCTX)[k] : INP(I_C)[(cc - 1) * 1024 + k]; s[i] = v / (1.f + expf(-v)); }
    __syncthreads();
    float* mods = (float*)(ws + WS_MODS);
    for (int it = F.bx; it < 192; it += F.G) {
        const int l = it / 48, r = it % 48, cb = r / 16, ks = r % 16, n = cb * 2048 + 4 * F.tid;
        const float* W = INP(I_WADA) + (size_t)l * 1024 * 6144 + (size_t)(ks * 64) * 6144 + n;
        v4f acc[5];
#pragma unroll
        for (int cc = 0; cc < 5; ++cc) acc[cc] = (v4f){0.f, 0.f, 0.f, 0.f};
#pragma unroll 1
        for (int kb = 0; kb < 64; kb += 16) {
            v4f wv[16];
#pragma unroll
            for (int k = 0; k < 16; ++k) wv[k] = *(const GAS v4f*)(W + (size_t)(kb + k) * 6144);
#pragma unroll
            for (int k = 0; k < 16; ++k)
#pragma unroll
                for (int cc = 0; cc < 5; ++cc) acc[cc] += wv[k] * s[cc * 1024 + ks * 64 + kb + k];
        }
        LAS float* tbl = s + 5 * 1024;
        __syncthreads();
#pragma unroll
        for (int cc = 0; cc < 5; ++cc) *(LAS v4f*)(tbl + cc * 2048 + 4 * F.tid) = acc[cc];
        __syncthreads();
        const float* bp = INP(I_BADA) + l * 6144 + cb * 2048;
#pragma unroll
        for (int q = 0; q < 4; ++q) { const int col = q * 512 + F.tid; const float bb = ks == 0 ? bp[col] : 0.f;
#pragma unroll
            for (int cc = 0; cc < 5; ++cc) atomicAdd(&mods[((size_t)l * 5 + cc) * 6144 + cb * 2048 + col], tbl[cc * 2048 + col] + bb); }
    }
    __syncthreads();
    p0_convert(F, P0_Q_NOW, F.gw, F.NGW, false);
    for (int it = F.gw; it < 384; it += F.NGW) {
        bf16* rowp = it < 192 ? (bf16*)(ws + W_MLA + (it / 96) * MLA_WB + MW_CAT) + (size_t)(672 + it % 96) * 1024 : (bf16*)(ws + W_SSI) + (size_t)(5184 + it - 192) * 1024;
        const v4u z = {0u, 0u, 0u, 0u}; ((GAS v4u*)rowp)[F.lane] = z; ((GAS v4u*)rowp)[64 + F.lane] = z;
    }
    for (int it = F.gw; it < 2048; it += F.NGW) {
        const int j = it >> 10, rr = it & 1023, b = rr >> 8, sq = rr & 255;
        const v4f v = ((const GAS v4f*)(INP(I_CCKV) + (((size_t)b * 2 + j) * 256 + sq) * 256))[F.lane];
        v2u o; o.x = pk2(v.x, v.y); o.y = pk2(v.z, v.w);
        ((GAS v2u*)((bf16*)(ws + WS_CKV + j * CKV_B) + (size_t)(T + rr) * 256))[F.lane] = o;
    }
    if (F.bx == 0) for (int i = F.tid; i < 640; i += NTHR) { const int pos = i >> 3, fi = i & 7; const float p = (float)(pos < 16 ? pos : pos - 16);
        const float a = p * rope_inv(fi); float* tab = (float*)(ws + WS_ROPE); tab[2 * i] = cosf(a); tab[2 * i + 1] = sinf(a); }
}

__device__ __forceinline__ void rp_normmod(Frame& F, const float* xlo, const float* xhi, const float* g, const float* mods_l, int sh_off, int sc_off, bf16* h) {
    for (int base = F.gw; base < T; base += 4 * F.NGW) {
        v4f v[4][4]; float ss[4]; int rows[4];
#pragma unroll
        for (int k = 0; k < 4; ++k) { const int row = base + k * F.NGW; rows[k] = row < T ? row : base;
            const GAS v4f* xr = (const GAS v4f*)((rows[k] < TP ? xlo : xhi) + (size_t)rows[k] * 1024) + F.lane;
#pragma unroll
            for (int j = 0; j < 4; ++j) v[k][j] = xr[64 * j]; }
#pragma unroll
        for (int k = 0; k < 4; ++k) { float s = 0.f;
#pragma unroll
            for (int j = 0; j < 4; ++j) s += (v[k][j].x * v[k][j].x + v[k][j].y * v[k][j].y) + (v[k][j].z * v[k][j].z + v[k][j].w * v[k][j].w);
            ss[k] = s; }
#pragma unroll
        for (int o = 1; o < 64; o <<= 1) {
#pragma unroll
            for (int k = 0; k < 4; ++k) ss[k] += shx(ss[k], F.lane, o); }
#pragma unroll
        for (int j = 0; j < 4; ++j) { const int c = 4 * F.lane + 256 * j; const v4f g4 = *(const GAS v4f*)(g + c);
#pragma unroll
            for (int k = 0; k < 4; ++k) { const float r = rsqrtf(ss[k] * (1.f / 1024) + EPS); const float* m = mods_l + (size_t)cond_of_row(rows[k]) * 6144;
                const v4f sc = *(const GAS v4f*)(m + sc_off + c), sh = *(const GAS v4f*)(m + sh_off + c);
                const v4f o = v[k][j] * r * g4 * (sc + 1.f) + sh; v2u w; w.x = pk2(o.x, o.y); w.y = pk2(o.z, o.w);
                *(GAS v2u*)(h + (size_t)rows[k] * 1024 + c) = w; } }
    }
}
__device__ __forceinline__ void rp_mla_fin1(Frame& F, const float* lat, const float* gq, const float* gkv, bf16* qn, bf16* ckv, float* out, int j) {
    v2f gqv[3], gkvv[2];
#pragma unroll
    for (int i = 0; i < 3; ++i) gqv[i] = *(const GAS v2f*)(gq + 2 * F.lane + 128 * i);
#pragma unroll
    for (int i = 0; i < 2; ++i) gkvv[i] = *(const GAS v2f*)(gkv + 2 * F.lane + 128 * i);
    for (int base = F.gw; base < T; base += 4 * F.NGW) {
        v2f q[4][3], k[4][2]; float pe[4]; int rows[4];
#pragma unroll
        for (int b = 0; b < 4; ++b) { const int row = base + b * F.NGW; rows[b] = row < T ? row : base;
            const float* lr = lat + (size_t)rows[b] * 768;
#pragma unroll
            for (int i = 0; i < 3; ++i) q[b][i] = *(const GAS v2f*)(lr + 2 * F.lane + 128 * i);
#pragma unroll
            for (int i = 0; i < 2; ++i) k[b][i] = *(const GAS v2f*)(lr + 384 + 2 * F.lane + 128 * i);
            pe[b] = *(const GAS float*)(lr + 640 + (F.lane & 31)); }
        __builtin_amdgcn_sched_barrier(0);
#pragma unroll
        for (int b = 0; b < 4; ++b) { const int row = base + b * F.NGW; if (row >= T) break;
            float ss = 0.f;
#pragma unroll
            for (int i = 0; i < 3; ++i) ss += q[b][i].x * q[b][i].x + q[b][i].y * q[b][i].y;
            float r = __builtin_amdgcn_rsqf(wsum(ss, F.lane) * (1.f / 384) + EPS);
#pragma unroll
            for (int i = 0; i < 3; ++i) { const int c = 2 * F.lane + 128 * i; *(GAS unsigned*)(qn + (size_t)row * 384 + c) = pk2(q[b][i].x * r * gqv[i].x, q[b][i].y * r * gqv[i].y); }
            ss = 0.f;
#pragma unroll
            for (int i = 0; i < 2; ++i) ss += k[b][i].x * k[b][i].x + k[b][i].y * k[b][i].y;
            r = __builtin_amdgcn_rsqf(wsum(ss, F.lane) * (1.f / 256) + EPS);
#pragma unroll
            for (int i = 0; i < 2; ++i) { const int c = 2 * F.lane + 128 * i; const float c0 = k[b][i].x * r * gkvv[i].x, c1 = k[b][i].y * r * gkvv[i].y;
                *(GAS unsigned*)(ckv + (size_t)row * 256 + c) = pk2(c0, c1);
                if (row < TP) { v2f o; o.x = c0; o.y = c1; *(GAS v2f*)(out + OUT_CKV + (((size_t)(row >> 8) * 2 + j) * 256 + (row & 255)) * 256 + c) = o; } }
            if (row < TP && F.lane < 32) *(GAS float*)(out + OUT_KPE + (((size_t)(row >> 8) * 2 + j) * 256 + (row & 255)) * 32 + F.lane) = pe[b];
        }
    }
}
__device__ __forceinline__ void rope32_tab(float* pe, int t, const float* tab) {
    const v2f* tr = (const v2f*)tab + (t >> 6) * 8; const v2f* tc = (const v2f*)tab + (16 + (t & 63)) * 8;
#pragma unroll
    for (int i = 0; i < 8; ++i) {
        v2f cs = tr[i]; float x1 = pe[i], x2 = pe[i + 8]; pe[i] = x1 * cs.x - x2 * cs.y; pe[i + 8] = x2 * cs.x + x1 * cs.y;
        cs = tc[i]; x1 = pe[16 + i]; x2 = pe[24 + i]; pe[16 + i] = x1 * cs.x - x2 * cs.y; pe[24 + i] = x2 * cs.x + x1 * cs.y;
    }
}
struct RopeCS { v4f r[4], c[4]; };
__device__ __forceinline__ void rope_load(RopeCS& R, int t, const float* tab) {
    const float* tr = tab + (t >> 6) * 16; const float* tc = tab + (16 + (t & 63)) * 16;
#pragma unroll
    for (int i = 0; i < 4; ++i) { R.r[i] = *(const GAS v4f*)(tr + 4 * i); R.c[i] = *(const GAS v4f*)(tc + 4 * i); }
}
__device__ __forceinline__ void rope_apply(float* pe, const RopeCS& R) {
#pragma unroll
    for (int i = 0; i < 8; ++i) {
        float cx = (i & 1) ? R.r[i >> 1].z : R.r[i >> 1].x, sy = (i & 1) ? R.r[i >> 1].w : R.r[i >> 1].y; float x1 = pe[i], x2 = pe[i + 8]; pe[i] = x1 * cx - x2 * sy; pe[i + 8] = x2 * cx + x1 * sy;
        cx = (i & 1) ? R.c[i >> 1].z : R.c[i >> 1].x; sy = (i & 1) ? R.c[i >> 1].w : R.c[i >> 1].y; x1 = pe[16 + i]; x2 = pe[24 + i]; pe[16 + i] = x1 * cx - x2 * sy; pe[24 + i] = x2 * cx + x1 * sy;
    }
}
__device__ __forceinline__ void ld8(const bf16* p, float* d) { const v4u w = *(const GAS v4u*)p; d[0] = bflo(w.x); d[1] = bfhi(w.x); d[2] = bflo(w.y); d[3] = bfhi(w.y); d[4] = bflo(w.z); d[5] = bfhi(w.z); d[6] = bflo(w.w); d[7] = bfhi(w.w); }
__device__ __forceinline__ void up8(const v4u w, float* d) { d[0] = bflo(w.x); d[1] = bfhi(w.x); d[2] = bflo(w.y); d[3] = bfhi(w.y); d[4] = bflo(w.z); d[5] = bfhi(w.z); d[6] = bflo(w.w); d[7] = bfhi(w.w); }
__device__ __forceinline__ void st8(bf16* p, const float* d) { v4u w; w.x = pk2(d[0], d[1]); w.y = pk2(d[2], d[3]); w.z = pk2(d[4], d[5]); w.w = pk2(d[6], d[7]); *(GAS v4u*)p = w; }
__device__ __forceinline__ void rp_tables(Frame& F) {
    unsigned char* ws = WSP; const float* mods = (const float*)(ws + WS_MODS); float* GTb = (float*)(ws + WS_GT); float* SWb = (float*)(ws + WS_SW);
    for (int idx = F.bx * NTHR + F.tid; idx < 8 * 5 * 1024; idx += F.G * NTHR) {
        const int s = idx / 5120, r = idx % 5120, c = r >> 10, k = r & 1023, layer = s >> 1;
        const float g = (s & 1) ? INP(I_GN2)[layer * 1024 + k] : INP(I_GN1)[layer * 1024 + k];
        GTb[idx] = g * (1.f + mods[((size_t)layer * 5 + c) * 6144 + ((s & 1) ? 4096 : 1024) + k]);
    }
    constexpr int NR1 = 5632;
    for (int it = F.gw; it < NR1 / 4; it += F.NGW) {
        const int s = 1, n = 4 * it; const bf16* Wt = (const bf16*)(ws + W_FF + FW_IN);
        const int layer = s >> 1, shoff = (s & 1) ? 3072 : 0;
        v4u wr[4][2];
#pragma unroll
        for (int r = 0; r < 4; ++r) { wr[r][0] = *(const GAS v4u*)(Wt + (size_t)(n + r) * 1024 + 16 * F.lane); wr[r][1] = *(const GAS v4u*)(Wt + (size_t)(n + r) * 1024 + 16 * F.lane + 8); }
        float acc[4][5];
#pragma unroll
        for (int r = 0; r < 4; ++r)
#pragma unroll
            for (int c = 0; c < 5; ++c) acc[r][c] = 0.f;
#pragma unroll
        for (int c = 0; c < 5; ++c) { const float* sp = mods + ((size_t)layer * 5 + c) * 6144 + shoff + 16 * F.lane;
            const v4f s0 = *(const GAS v4f*)sp, s1 = *(const GAS v4f*)(sp + 4), s2 = *(const GAS v4f*)(sp + 8), s3 = *(const GAS v4f*)(sp + 12);
#pragma unroll
            for (int r = 0; r < 4; ++r) { const v4u a = wr[r][0], b2 = wr[r][1];
                acc[r][c] = (s0.x * bflo(a.x) + s0.y * bfhi(a.x) + s0.z * bflo(a.y) + s0.w * bfhi(a.y)) + (s1.x * bflo(a.z) + s1.y * bfhi(a.z) + s1.z * bflo(a.w) + s1.w * bfhi(a.w))
                          + (s2.x * bflo(b2.x) + s2.y * bfhi(b2.x) + s2.z * bflo(b2.y) + s2.w * bfhi(b2.y)) + (s3.x * bflo(b2.z) + s3.y * bfhi(b2.z) + s3.z * bflo(b2.w) + s3.w * bfhi(b2.w)); } }
#pragma unroll
        for (int o = 1; o < 64; o <<= 1) {
#pragma unroll
            for (int r = 0; r < 4; ++r)
#pragma unroll
                for (int c = 0; c < 5; ++c) acc[r][c] += shx(acc[r][c], F.lane, o); }
        if (F.lane < 20) { const int r = F.lane / 5, c = F.lane % 5; float v = 0.f;
#pragma unroll
            for (int rr = 0; rr < 4; ++rr)
#pragma unroll
                for (int cc = 0; cc < 5; ++cc) v = (rr == r && cc == c) ? acc[rr][cc] : v;
            SWb[((size_t)s * 5 + c) * 5632 + n + r] = v; }
    }
}
__device__ __forceinline__ void rp_mla_fin2(Frame& F, const bf16* qraw, const bf16* kvraw, const float* lat, const float* ckpe_j, const float* gqn, const float* gkn, const float* tab, bf16* Q, bf16* K) {
    for (int idx = F.bx * NTHR + F.tid; idx < T * 32; idx += F.G * NTHR) {
        const int row = idx >> 5, hd = (idx >> 1) & 15, hf = idx & 1; const bool latent = row >= TP; const int tl = (row - TP) & 1023;
        float v[48]; float ss = 0.f; RopeCS R; v4f gq[12];
#pragma unroll
        for (int i = 0; i < 6; ++i) ld8(qraw + (size_t)row * 1536 + hd * 96 + hf * 48 + 8 * i, v + 8 * i);
#pragma unroll
        for (int i = 0; i < 12; ++i) gq[i] = *(const GAS v4f*)(gqn + hf * 48 + 4 * i);
        if (latent && hf) rope_load(R, tl, tab);
#pragma unroll
        for (int d = 0; d < 48; ++d) ss += v[d] * v[d];
        ss += shx(ss, F.lane, 1);
        const float r = rsqrtf(ss * (1.f / 96) + EPS) * QSCALE;
#pragma unroll
        for (int d = 0; d < 48; ++d) v[d] = v[d] * r * gq[d >> 2][d & 3];
        if (latent && hf) rope_apply(v + 16, R);
#pragma unroll
        for (int i = 0; i < 6; ++i) st8(Q + ((size_t)row * 16 + hd) * 96 + hf * 48 + 8 * i, v + 8 * i);
    }
    asm volatile("" ::: "memory");
    for (int idx = F.bx * NTHR + F.tid; idx < (T + NCTX) * 32; idx += F.G * NTHR) {
        const int row = idx >> 5, hd = (idx >> 1) & 15, hf = idx & 1; const bool latent = row >= TP && row < T; const int tl = (row - TP) & 1023;
        float v[48]; float ss = 0.f; RopeCS R; v4f gk[12];
#pragma unroll
        for (int i = 0; i < 12; ++i) gk[i] = *(const GAS v4f*)(gkn + hf * 48 + 4 * i);
        if (latent && hf) rope_load(R, tl, tab);
        if (hf == 0) {
#pragma unroll
            for (int i = 0; i < 6; ++i) ld8(kvraw + (size_t)row * 2048 + hd * 128 + 8 * i, v + 8 * i);
        } else {
#pragma unroll
            for (int i = 0; i < 2; ++i) ld8(kvraw + (size_t)row * 2048 + hd * 128 + 48 + 8 * i, v + 8 * i);
            const float* kp = row < T ? lat + (size_t)row * 768 + 640 : ckpe_j + ((size_t)((row - T) >> 8) * 2 * 256 + ((row - T) & 255)) * 32;
#pragma unroll
            for (int i = 0; i < 8; ++i) { const v4f p4 = *(const GAS v4f*)(kp + 4 * i); v[16 + 4 * i] = p4.x; v[17 + 4 * i] = p4.y; v[18 + 4 * i] = p4.z; v[19 + 4 * i] = p4.w; }
        }
#pragma unroll
        for (int d = 0; d < 48; ++d) ss += v[d] * v[d];
        ss += shx(ss, F.lane, 1);
        const float r = rsqrtf(ss * (1.f / 96) + EPS);
#pragma unroll
        for (int d = 0; d < 48; ++d) v[d] = v[d] * r * gk[d >> 2][d & 3];
        if (latent && hf) rope_apply(v + 16, R);
#pragma unroll
        for (int i = 0; i < 6; ++i) st8(K + ((size_t)row * 16 + hd) * 96 + hf * 48 + 8 * i, v + 8 * i);
    }
}
__device__ __forceinline__ void rp_dwconv(Frame& F, const bf16* u, const float* wdw, const float* bdw, const float* gln, const float* bln, bf16* vout) {
    LAS float* red = (LAS float*)F.lds;
    const int c = 2 * F.tid;
    for (int it = F.vcu; it < T / 16; it += F.G) {
        const int row0 = 16 * it; int t0, L; row_pos(row0, t0, L);
        v2f w[31];
#pragma unroll
        for (int k = 0; k < 31; ++k) w[k] = *(const GAS v2f*)(wdw + k * 1024 + c);
        const v2f bb = *(const GAS v2f*)(bdw + c);
        unsigned pk[46];
#pragma unroll
        for (int rr = 0; rr < 46; ++rr) { const int tt = t0 - 15 + rr; const bool ok = tt >= 0 && tt < L;
            pk[rr] = *(const GAS unsigned*)(u + (size_t)(ok ? row0 - 15 + rr : row0) * 1024 + c); }
        __builtin_amdgcn_sched_barrier(0);
#pragma unroll
        for (int rr = 0; rr < 46; ++rr) { const int tt = t0 - 15 + rr; pk[rr] = (tt >= 0 && tt < L) ? pk[rr] : 0u; }
        v2f yy[16];
#pragma unroll
        for (int r = 0; r < 16; ++r) yy[r] = bb;
#pragma unroll
        for (int rr = 0; rr < 46; ++rr) {
            const v2f x = (v2f){bflo(pk[rr]), bfhi(pk[rr])};
#pragma unroll
            for (int r = 0; r < 16; ++r) { const int k = rr - r; if (k >= 0 && k < 31) yy[r] += x * w[k]; }
        }
        float y0[16], y1[16];
#pragma unroll
        for (int r = 0; r < 16; ++r) { y0[r] = yy[r].x; y1[r] = yy[r].y; }
        float s[16];
#pragma unroll
        for (int r = 0; r < 16; ++r) s[r] = y0[r] + y1[r];
#pragma unroll
        for (int o = 1; o < 64; o <<= 1) {
#pragma unroll
            for (int r = 0; r < 16; ++r) s[r] += shx(s[r], F.lane, o); }
        __syncthreads();
        if (F.lane < 16) { float v = s[0];
#pragma unroll
            for (int r = 1; r < 16; ++r) v = F.lane == r ? s[r] : v;
            red[F.wave * 16 + F.lane] = v; }
        __syncthreads();
        float mean[16];
#pragma unroll
        for (int r = 0; r < 16; ++r) { float m = 0.f;
#pragma unroll
            for (int wv = 0; wv < 8; ++wv) m += red[wv * 16 + r];
            mean[r] = m * (1.f / 1024); }
#pragma unroll
        for (int r = 0; r < 16; ++r) { y0[r] -= mean[r]; y1[r] -= mean[r]; s[r] = y0[r] * y0[r] + y1[r] * y1[r]; }
#pragma unroll
        for (int o = 1; o < 64; o <<= 1) {
#pragma unroll
            for (int r = 0; r < 16; ++r) s[r] += shx(s[r], F.lane, o); }
        __syncthreads();
        if (F.lane < 16) { float v = s[0];
#pragma unroll
            for (int r = 1; r < 16; ++r) v = F.lane == r ? s[r] : v;
            red[F.wave * 16 + F.lane] = v; }
        __syncthreads();
        const v2f gg = *(const GAS v2f*)(gln + c), bl = *(const GAS v2f*)(bln + c);
#pragma unroll
        for (int r = 0; r < 16; ++r) { float q = 0.f;
#pragma unroll
            for (int wv = 0; wv < 8; ++wv) q += red[wv * 16 + r];
            const float rs = rsqrtf(q * (1.f / 1024) + EPS);
            const float z0 = y0[r] * rs * gg.x + bl.x, z1 = y1[r] * rs * gg.y + bl.y;
            *(GAS unsigned*)(vout + (size_t)(row0 + r) * 1024 + c) = pk2(z0 * fast_sig(z0), z1 * fast_sig(z1)); }
    }
    __syncthreads();
}
__device__ __forceinline__ void rp_ssd_conv(Frame& F, const bf16* xpre, const float* dtraw, const float* wc, const float* bc, const float* dtb, const float* alog, bf16* xbc, float* dt, float* acum) {
    for (int idx = F.bx * NTHR + F.tid; idx < (T / 32) * 384; idx += F.G * NTHR) {
        const int seg = idx / 384, cg = idx - seg * 384, c0 = 8 * cg, row0 = 32 * seg; int t0, L; row_pos(row0, t0, L);
        v2f w2[5][4], b2[4];
#pragma unroll
        for (int k = 0; k < 5; ++k) { const v4f a = *(const GAS v4f*)(wc + k * 3072 + c0), b = *(const GAS v4f*)(wc + k * 3072 + c0 + 4);
            w2[k][0] = (v2f){a.x, a.y}; w2[k][1] = (v2f){a.z, a.w}; w2[k][2] = (v2f){b.x, b.y}; w2[k][3] = (v2f){b.z, b.w}; }
        { const v4f a = *(const GAS v4f*)(bc + c0), b = *(const GAS v4f*)(bc + c0 + 4); b2[0] = (v2f){a.x, a.y}; b2[1] = (v2f){a.z, a.w}; b2[2] = (v2f){b.x, b.y}; b2[3] = (v2f){b.z, b.w}; }
        const bf16* base = xpre + (size_t)row0 * 3072 + c0;
#define SSC_OK(j) ((t0 + (j)) >= 0 && (t0 + (j)) < L)
#define SSC_LD(j) (*(const GAS v4u*)(base + (ptrdiff_t)(SSC_OK(j) ? (j) : 0) * 3072))
        v4u carry[4], cur[8], nxt[8];
#pragma unroll
        for (int k = 0; k < 4; ++k) carry[k] = SSC_LD(k - 2);
#pragma unroll
        for (int k = 0; k < 8; ++k) cur[k] = SSC_LD(k + 2);
        __builtin_amdgcn_sched_barrier(0);
#pragma unroll
        for (int k = 0; k < 4; ++k) if (!SSC_OK(k - 2)) carry[k] = (v4u){0u, 0u, 0u, 0u};
#pragma unroll
        for (int k = 0; k < 8; ++k) if (!SSC_OK(k + 2)) cur[k] = (v4u){0u, 0u, 0u, 0u};
#pragma unroll
        for (int c = 0; c < 4; ++c) {
            if (c < 3) {
#pragma unroll
                for (int k = 0; k < 8; ++k) nxt[k] = SSC_LD(8 * c + 10 + k); }
            __builtin_amdgcn_sched_barrier(0);
            v2f acc[8][4];
#pragma unroll
            for (int o = 0; o < 8; ++o)
#pragma unroll
                for (int p2 = 0; p2 < 4; ++p2) acc[o][p2] = b2[p2];
#pragma unroll
            for (int q = 0; q < 12; ++q) { const v4u rw = q < 4 ? carry[q] : cur[q - 4];
                const v2f x0 = (v2f){bflo(rw.x), bfhi(rw.x)}, x1 = (v2f){bflo(rw.y), bfhi(rw.y)}, x2 = (v2f){bflo(rw.z), bfhi(rw.z)}, x3 = (v2f){bflo(rw.w), bfhi(rw.w)};
#pragma unroll
                for (int o = 0; o < 8; ++o) { const int k = q - o; if (k >= 0 && k < 5) { acc[o][0] += x0 * w2[k][0]; acc[o][1] += x1 * w2[k][1]; acc[o][2] += x2 * w2[k][2]; acc[o][3] += x3 * w2[k][3]; } } }
#pragma unroll
            for (int o = 0; o < 8; ++o) { v4u ow;
                { const v2f v = acc[o][0]; ow.x = pk2(v.x * fast_sig(v.x), v.y * fast_sig(v.y)); } { const v2f v = acc[o][1]; ow.y = pk2(v.x * fast_sig(v.x), v.y * fast_sig(v.y)); }
                { const v2f v = acc[o][2]; ow.z = pk2(v.x * fast_sig(v.x), v.y * fast_sig(v.y)); } { const v2f v = acc[o][3]; ow.w = pk2(v.x * fast_sig(v.x), v.y * fast_sig(v.y)); }
                *(GAS v4u*)(xbc + (size_t)(row0 + 8 * c + o) * 3072 + c0) = ow; }
#pragma unroll
            for (int k = 0; k < 4; ++k) carry[k] = cur[4 + k];
            if (c < 3) {
#pragma unroll
                for (int k = 0; k < 8; ++k) cur[k] = SSC_OK(8 * c + 10 + k) ? nxt[k] : (v4u){0u, 0u, 0u, 0u}; }
        }
#undef SSC_OK
#undef SSC_LD
    }
    for (int it = F.gw; it < 64 * 64; it += F.NGW) {
        const int ch = it >> 6, e = it & 63, dir = e >> 5, row0 = 128 * ch, lane = F.lane;
        const float aa = -expf(alog[e]), bb = dtb[e];
        const int i0 = dir == 0 ? lane : 127 - lane, i1 = dir == 0 ? lane + 64 : 63 - lane;
        const float d0 = softplus_f(dtraw[(size_t)(row0 + i0) * 64 + e] + bb), d1 = softplus_f(dtraw[(size_t)(row0 + i1) * 64 + e] + bb);
        float s0 = d0 * aa, s1 = d1 * aa;
#pragma unroll
        for (int o = 1; o < 64; o <<= 1) { const float u0 = __builtin_bit_cast(float, __builtin_amdgcn_ds_bpermute((lane - o) << 2, __builtin_bit_cast(int, s0))), u1 = __builtin_bit_cast(float, __builtin_amdgcn_ds_bpermute((lane - o) << 2, __builtin_bit_cast(int, s1)));
            if (lane >= o) { s0 += u0; s1 += u1; } }
        s1 += __builtin_bit_cast(float, __builtin_amdgcn_readlane(__builtin_bit_cast(int, s0), 63));
        dt[(size_t)(row0 + i0) * 64 + e] = d0; dt[(size_t)(row0 + i1) * 64 + e] = d1;
        acum[(size_t)(row0 + i0) * 64 + e] = s0; acum[(size_t)(row0 + i1) * 64 + e] = s1;
    }
}
__device__ __forceinline__ void rp_ssd_gate(Frame& F, const bf16* y, const bf16* z, const float* gn, bf16* yn) {
    v4f gv[4][2];
#pragma unroll
    for (int g = 0; g < 4; ++g) { gv[g][0] = *(const GAS v4f*)(gn + g * 512 + 8 * F.lane); gv[g][1] = *(const GAS v4f*)(gn + g * 512 + 8 * F.lane + 4); }
    v4u cz[4], ca[4], cb[4], nz[4], na[4], nb[4];
    int row = F.gw;
    if (row < T) {
#pragma unroll
        for (int g = 0; g < 4; ++g) { const size_t o = (size_t)row * 2048 + g * 512 + 8 * F.lane; cz[g] = *(const GAS v4u*)(z + o); ca[g] = *(const GAS v4u*)(y + o); cb[g] = *(const GAS v4u*)(y + (size_t)T * 2048 + o); } }
    for (; row < T; row += F.NGW) {
        const int nrow = row + F.NGW;
        if (nrow < T) {
#pragma unroll
            for (int g = 0; g < 4; ++g) { const size_t o = (size_t)nrow * 2048 + g * 512 + 8 * F.lane; nz[g] = *(const GAS v4u*)(z + o); na[g] = *(const GAS v4u*)(y + o); nb[g] = *(const GAS v4u*)(y + (size_t)T * 2048 + o); } }
        __builtin_amdgcn_sched_barrier(0);
#pragma unroll
        for (int g = 0; g < 4; ++g) { const int c0 = g * 512 + 8 * F.lane; float zz[8], v[8], yb[8];
            up8(cz[g], zz); up8(ca[g], v); up8(cb[g], yb);
            float ss = 0.f;
#pragma unroll
            for (int i = 0; i < 8; ++i) { v[i] = (v[i] + yb[i]) * zz[i] * fast_sig(zz[i]); ss += v[i] * v[i]; }
            const float r = __builtin_amdgcn_rsqf(wsum(ss, F.lane) * (1.f / 512) + EPS);
#pragma unroll
            for (int i = 0; i < 8; ++i) v[i] = v[i] * r * gv[g][i >> 2][i & 3];
            st8(yn + (size_t)row * 2048 + c0, v); }
#pragma unroll
        for (int g = 0; g < 4; ++g) { cz[g] = nz[g]; ca[g] = na[g]; cb[g] = nb[g]; }
    }
}

typedef short a_bf16x8 __attribute__((ext_vector_type(8)));
typedef short a_s16x4 __attribute__((ext_vector_type(4)));
typedef float a_f32x16 __attribute__((ext_vector_type(16)));
typedef float a_f32x2 __attribute__((ext_vector_type(2))); typedef __bf16 a_bf16x2 __attribute__((ext_vector_type(2)));
__device__ __forceinline__ unsigned a_cvtpk(float lo, float hi) { a_f32x2 v = {lo, hi}; a_bf16x2 b = __builtin_convertvector(v, a_bf16x2); return __builtin_bit_cast(unsigned, b); }
__device__ __forceinline__ a_s16x4 a_vtr(const LAS unsigned char* p) { return __builtin_bit_cast(a_s16x4, __builtin_amdgcn_ds_read_tr16_b64_v4i16((LAS a_s16x4*)p)); }
constexpr int AT_KS = 208, AT_VS = 192, AT_KB = 64 * AT_KS, AT_VB = 64 * AT_VS, AT_VOFF = 2 * AT_KB;
__device__ __forceinline__ void at_tile(Frame& F, LAS unsigned char* lds, int buf, int lane, const a_bf16x8 (&qf)[6], a_f32x16& o0, a_f32x16& o1, float& m, float& l) {
    const int r32 = lane & 31, hi = lane >> 5;
    a_f32x16 p0, p1;
#pragma unroll
    for (int r = 0; r < 16; ++r) { p0[r] = 0.f; p1[r] = 0.f; }
    { const LAS unsigned char* kp = lds + buf * AT_KB + r32 * AT_KS + hi * 16;
#pragma unroll
      for (int s = 0; s < 6; ++s) { const a_bf16x8 a0 = *(const LAS a_bf16x8*)(kp + 32 * s), a1 = *(const LAS a_bf16x8*)(kp + 32 * AT_KS + 32 * s);
          p0 = __builtin_amdgcn_mfma_f32_32x32x16_bf16(a0, qf[s], p0, 0, 0, 0); p1 = __builtin_amdgcn_mfma_f32_32x32x16_bf16(a1, qf[s], p1, 0, 0, 0); } }

    float mx = fmaxf(p0[0], p1[0]);
#pragma unroll
    for (int r = 1; r < 16; ++r) mx = fmaxf(mx, fmaxf(p0[r], p1[r]));
    mx = fmaxf(mx, shx(mx, lane, 32));
    const float mn = fmaxf(m, mx), alpha = __builtin_amdgcn_exp2f(m - mn); m = mn;
    float ps = 0.f;
#pragma unroll
    for (int r = 0; r < 16; ++r) { p0[r] = __builtin_amdgcn_exp2f(p0[r] - mn); p1[r] = __builtin_amdgcn_exp2f(p1[r] - mn); ps += p0[r] + p1[r]; }
    l = l * alpha + ps;
#pragma unroll
    for (int r = 0; r < 16; ++r) { o0[r] *= alpha; o1[r] *= alpha; }
    v4u pw[4];
    pw[0] = (v4u){a_cvtpk(p0[0], p0[1]), a_cvtpk(p0[2], p0[3]), a_cvtpk(p0[4], p0[5]), a_cvtpk(p0[6], p0[7])};
    pw[1] = (v4u){a_cvtpk(p0[8], p0[9]), a_cvtpk(p0[10], p0[11]), a_cvtpk(p0[12], p0[13]), a_cvtpk(p0[14], p0[15])};
    pw[2] = (v4u){a_cvtpk(p1[0], p1[1]), a_cvtpk(p1[2], p1[3]), a_cvtpk(p1[4], p1[5]), a_cvtpk(p1[6], p1[7])};
    pw[3] = (v4u){a_cvtpk(p1[8], p1[9]), a_cvtpk(p1[10], p1[11]), a_cvtpk(p1[12], p1[13]), a_cvtpk(p1[14], p1[15])};

    const LAS unsigned char* vp0 = lds + AT_VOFF + buf * AT_VB + (4 * hi + ((lane & 15) >> 2)) * AT_VS + (16 * ((lane >> 4) & 1) + 4 * (lane & 3)) * 2;
    a_s16x4 vl0[4], vh0[4], vl1[4], vh1[4];
#pragma unroll
    for (int bs = 0; bs < 4; ++bs) { const LAS unsigned char* vq = vp0 + (16 * bs) * AT_VS; vl0[bs] = a_vtr(vq); vh0[bs] = a_vtr(vq + 8 * AT_VS); vl1[bs] = a_vtr(vq + 64); vh1[bs] = a_vtr(vq + 8 * AT_VS + 64); }
#pragma unroll
    for (int bs = 0; bs < 4; ++bs) {
        const a_bf16x8 v0 = (a_bf16x8){vl0[bs][0], vl0[bs][1], vl0[bs][2], vl0[bs][3], vh0[bs][0], vh0[bs][1], vh0[bs][2], vh0[bs][3]}, v1 = (a_bf16x8){vl1[bs][0], vl1[bs][1], vl1[bs][2], vl1[bs][3], vh1[bs][0], vh1[bs][1], vh1[bs][2], vh1[bs][3]};
        const a_bf16x8 pb = __builtin_bit_cast(a_bf16x8, pw[bs]);
        o0 = __builtin_amdgcn_mfma_f32_32x32x16_bf16(v0, pb, o0, 0, 0, 0); o1 = __builtin_amdgcn_mfma_f32_32x32x16_bf16(v1, pb, o1, 0, 0, 0); }
}
__device__ __forceinline__ void ph_attn(Frame& F, const bf16* Q, const bf16* K, const bf16* KV, bf16* AO) {
    const int lane = F.lane, r32 = lane & 31, hi = lane >> 5, wave = F.wave, tid = F.tid;
    LAS unsigned char* lds = F.lds;
    const int kr_a = tid / 12, kp_a = tid % 12, kr_b = (tid + 512) / 12, kp_b = (tid + 512) % 12, vr = tid >> 3, vp = tid & 7;
    const bool has_b = tid < 256;
    for (int uu = F.vcu; uu < 512; uu += F.G) {
        int head, q0, NT, kbase_ctx, kbase_lat;
        if (uu < 256) { const int seq = uu >> 4; head = uu & 15; q0 = seq * 256; NT = 4; kbase_ctx = seq * 256; kbase_lat = 0; }
        else { const int u2 = uu - 256, b = u2 >> 6, qb = u2 & 3; head = (u2 >> 2) & 15; q0 = TP + b * 1024 + qb * 256; NT = 20; kbase_ctx = T + b * 256; kbase_lat = TP + b * 1024; }
        a_bf16x8 qf[6];
        { const bf16* qp = Q + ((size_t)(q0 + wave * 32 + r32) * 16 + head) * 96 + hi * 8;
#pragma unroll
          for (int s = 0; s < 6; ++s) qf[s] = *(const GAS a_bf16x8*)(qp + 16 * s); }
        a_f32x16 o0, o1;
#pragma unroll
        for (int r = 0; r < 16; ++r) { o0[r] = 0.f; o1[r] = 0.f; }
        float m = -INFINITY, l = 0.f;
        v4u ka0, kb0, vv0, ka1, kb1, vv1, ka2, kb2_, vv2;
#define AT_LOAD(t, KA, KB2, VV) do { const int kr0_ = (t) < 4 ? kbase_ctx + 64 * (t) : kbase_lat + 64 * ((t) - 4); \
            KA = *(const GAS v4u*)(K + ((size_t)(kr0_ + kr_a) * 16 + head) * 96 + kp_a * 8); \
            if (has_b) KB2 = *(const GAS v4u*)(K + ((size_t)(kr0_ + kr_b) * 16 + head) * 96 + kp_b * 8); \
            VV = *(const GAS v4u*)(KV + (size_t)(kr0_ + vr) * 2048 + head * 128 + 64 + vp * 8); } while (0)
#define AT_STORE(buf, KA, KB2, VV) do { *(LAS v4u*)(lds + (buf) * AT_KB + kr_a * AT_KS + kp_a * 16) = KA; \
            if (has_b) *(LAS v4u*)(lds + (buf) * AT_KB + kr_b * AT_KS + kp_b * 16) = KB2; \
            *(LAS v4u*)(lds + AT_VOFF + (buf) * AT_VB + vr * AT_VS + vp * 16) = VV; } while (0)
#define AT_STEP(k, SA, SB, SC, SD_, SE_, SF_, SG, SH, SI) if (t + (k) < NT) { \
            if (t + (k) + 3 < NT) AT_LOAD(t + (k) + 3, SA, SB, SC);            \
            at_tile(F, lds, (k) & 1, lane, qf, o0, o1, m, l); \
            if (t + (k) + 1 < NT) AT_STORE(((k) + 1) & 1, SD_, SE_, SF_);       \
            LDS_BARRIER(); }
        AT_LOAD(0, ka0, kb0, vv0); AT_LOAD(1, ka1, kb1, vv1); AT_LOAD(2, ka2, kb2_, vv2);
        AT_STORE(0, ka0, kb0, vv0);
        LDS_BARRIER();
#pragma unroll 1
        for (int t = 0; t < NT; t += 6) {
            AT_STEP(0, ka0, kb0, vv0, ka1, kb1, vv1, 0, 0, 0)
            AT_STEP(1, ka1, kb1, vv1, ka2, kb2_, vv2, 0, 0, 0)
            AT_STEP(2, ka2, kb2_, vv2, ka0, kb0, vv0, 0, 0, 0)
            AT_STEP(3, ka0, kb0, vv0, ka1, kb1, vv1, 0, 0, 0)
            AT_STEP(4, ka1, kb1, vv1, ka2, kb2_, vv2, 0, 0, 0)
            AT_STEP(5, ka2, kb2_, vv2, ka0, kb0, vv0, 0, 0, 0)
        }
#undef AT_STEP
#undef AT_LOAD
#undef AT_STORE
        l += shx(l, lane, 32);
        const float il = __builtin_amdgcn_rcpf(l);
        bf16* op = AO + (size_t)(q0 + wave * 32 + r32) * 1024 + head * 64 + 4 * hi;
#pragma unroll
        for (int g4 = 0; g4 < 4; ++g4) {
            v2u w0; w0.x = a_cvtpk(o0[4 * g4] * il, o0[4 * g4 + 1] * il); w0.y = a_cvtpk(o0[4 * g4 + 2] * il, o0[4 * g4 + 3] * il); *(GAS v2u*)(op + 8 * g4) = w0;
            v2u w1; w1.x = a_cvtpk(o1[4 * g4] * il, o1[4 * g4 + 1] * il); w1.y = a_cvtpk(o1[4 * g4 + 2] * il, o1[4 * g4 + 3] * il); *(GAS v2u*)(op + 32 + 8 * g4) = w1; }

    }
}
constexpr int SC_ST = 272, SC_XS = 144;
constexpr int SC_C = 0, SC_B = 128 * SC_ST, SC_M = 2 * 128 * SC_ST, SC_H = 3 * 128 * SC_ST, SC_X = SC_H + 64 * SC_ST, SC_XW = SC_X + 128 * SC_XS, SC_ARR = SC_XW + 128 * SC_XS;
static_assert(SC_ARR + 4 * 128 * 4 + 16 <= PTAB_OFF_C && SC_ARR + 4 * 128 * 4 + 16 <= P0_DUMP, "scan LDS map (the weight prefetch's dump area lies above it)");
__device__ __forceinline__ int a_crow(int r, int hi) { return (r & 3) + 8 * (r >> 2) + 4 * hi; }
__device__ __forceinline__ void ph_scan(Frame& F, const bf16* xbc, const float* dt, const float* acg, const float* dsk, const float* st0, bf16* y, float* out) {
    const int lane = F.lane, r32 = lane & 31, hi = lane >> 5, wave = F.wave, tid = F.tid;
    LAS unsigned char* lds = F.lds;
    LAS float* acum = (LAS float*)(lds + SC_ARR); LAS float* wj = acum + 128; LAS float* ei = acum + 256; LAS float* dtj = acum + 384; LAS float* misc = acum + 512;
    const int q4 = (lane & 15) >> 2, gg = (lane >> 4) & 1, p4 = lane & 3;
    const int ib = wave >> 1, pb = wave & 1, nb = wave >> 1;
    v4u cr[4], br[4], xr[2];
    float pdt[2], pac[2], plast, pac_t, pdt_t;
#define SC_GLOADP(rowb_, g_, hd_, dir_) do { const int row0_ = (rowb_); \
        _Pragma("unroll") for (int k = 0; k < 4; ++k) { const int q = tid + 512 * k, rr = q >> 4, pp = q & 15; \
            cr[k] = *(const GAS v4u*)(xbc + (size_t)(row0_ + rr) * 3072 + 2560 + (g_) * 128 + pp * 8); br[k] = *(const GAS v4u*)(xbc + (size_t)(row0_ + rr) * 3072 + 2048 + (g_) * 128 + pp * 8); } \
        _Pragma("unroll") for (int k = 0; k < 2; ++k) { const int q = tid + 512 * k, rr = q >> 3, pp = q & 7; xr[k] = *(const GAS v4u*)(xbc + (size_t)(row0_ + rr) * 3072 + (hd_) * 64 + pp * 8); \
            pdt[k] = dt[(size_t)(row0_ + rr) * 64 + (dir_) * 32 + (hd_)]; pac[k] = acg[(size_t)(row0_ + rr) * 64 + (dir_) * 32 + (hd_)]; } \
        plast = acg[(size_t)(row0_ + ((dir_) == 0 ? 127 : 0)) * 64 + (dir_) * 32 + (hd_)]; \
        pac_t = acg[(size_t)(row0_ + (tid & 127)) * 64 + (dir_) * 32 + (hd_)]; pdt_t = dt[(size_t)(row0_ + (tid & 127)) * 64 + (dir_) * 32 + (hd_)]; } while (0)
#define SC_ITEM(slot_, ii_, seq_, hd_) do { if ((slot_) < 128) { seq_ = 16 + ((slot_) >> 5); hd_ = (slot_) & 31; } else { const int pi_ = 4 * ((slot_) - 128) + (ii_); seq_ = pi_ >> 5; hd_ = pi_ & 31; } } while (0)
    for (int slot = F.vcu; slot < 256; slot += F.G) {
        const int nitem = slot < 128 ? 1 : 4;
        { int seq0, hd0; SC_ITEM(slot, 0, seq0, hd0); SC_GLOADP(seq0 < 16 ? seq0 * 256 : TP + (seq0 - 16) * 1024, hd0 >> 3, hd0, 0); }
#pragma unroll 1
        for (int ii = 0; ii < nitem; ++ii) {
            int seq, hd;
            if (slot < 128) { seq = 16 + (slot >> 5); hd = slot & 31; } else { const int pi = 4 * (slot - 128) + ii; seq = pi >> 5; hd = pi & 31; }
            const int g = hd >> 3, r0 = seq < 16 ? seq * 256 : TP + (seq - 16) * 1024, nc = seq < 16 ? 2 : 8;
#pragma unroll 1
            for (int dir = 0; dir < 2; ++dir) {
                const float dd = dsk[dir * 32 + hd];
                a_f32x16 hacc;
                if (seq < 16) {
#pragma unroll
                    for (int r = 0; r < 16; ++r) hacc[r] = 0.f;
                } else { const float* s0 = st0 + ((((size_t)(seq - 16) * 2 + dir) * 32 + hd) * 64 + 32 * pb + r32) * 128 + 32 * nb + 4 * hi;
#pragma unroll
                    for (int g4 = 0; g4 < 4; ++g4) { const v4f t4 = *(const GAS v4f*)(s0 + 8 * g4); hacc[4 * g4] = t4.x; hacc[4 * g4 + 1] = t4.y; hacc[4 * g4 + 2] = t4.z; hacc[4 * g4 + 3] = t4.w; } }
#pragma unroll
                for (int g4 = 0; g4 < 4; ++g4) { v2u w; w.x = a_cvtpk(hacc[4 * g4], hacc[4 * g4 + 1]); w.y = a_cvtpk(hacc[4 * g4 + 2], hacc[4 * g4 + 3]);
                    *(LAS v2u*)(lds + SC_H + (32 * pb + r32) * SC_ST + (32 * nb + 8 * g4 + 4 * hi) * 2) = w; }
#pragma unroll 1
                for (int cc = 0; cc < nc; ++cc) {
                    const int c = dir == 0 ? cc : nc - 1 - cc, row0 = r0 + c * 128;
                    const int e = dir * 32 + hd;
                    const float last = plast;
                    LDS_BARRIER();
                    if (tid < 128) { const float ac = pac_t, dv = pdt_t;
                        acum[tid] = ac; dtj[tid] = dv; ei[tid] = __expf(ac); if (tid == 0) misc[0] = __expf(last); }
#pragma unroll
                    for (int k = 0; k < 4; ++k) { const int q = tid + 512 * k, rr = q >> 4, pp = q & 15; *(LAS v4u*)(lds + SC_C + rr * SC_ST + pp * 16) = cr[k]; *(LAS v4u*)(lds + SC_B + rr * SC_ST + pp * 16) = br[k]; }
#pragma unroll
                    for (int k = 0; k < 2; ++k) { const int q = tid + 512 * k, rr = q >> 3, pp = q & 7; *(LAS v4u*)(lds + SC_X + rr * SC_XS + pp * 16) = xr[k];
                        const float w = pdt[k] * __expf(last - pac[k]);
                        v4u s; s.x = a_cvtpk(bflo(xr[k].x) * w, bfhi(xr[k].x) * w); s.y = a_cvtpk(bflo(xr[k].y) * w, bfhi(xr[k].y) * w); s.z = a_cvtpk(bflo(xr[k].z) * w, bfhi(xr[k].z) * w); s.w = a_cvtpk(bflo(xr[k].w) * w, bfhi(xr[k].w) * w);
                        *(LAS v4u*)(lds + SC_XW + rr * SC_XS + pp * 16) = s; }
                    { int nrow = 0, nhd = hd, ndir = dir; bool hn = true;
                      if (cc + 1 < nc) nrow = r0 + (dir == 0 ? cc + 1 : nc - 2 - cc) * 128;
                      else if (dir == 0) { nrow = r0 + (nc - 1) * 128; ndir = 1; }
                      else if (ii + 1 < nitem) { int seqn; SC_ITEM(slot, ii + 1, seqn, nhd); nrow = seqn < 16 ? seqn * 256 : TP + (seqn - 16) * 1024; ndir = 0; }
                      else hn = false;
                      if (hn) SC_GLOADP(nrow, nhd >> 3, nhd, ndir); }
                    LDS_BARRIER();
#pragma unroll 1
                    for (int tt = 0; tt < 2; ++tt) {
                        int lt = tt == 0 ? wave : (wave < 2 ? 8 + wave : 10 + (wave - 2));
                        const int ta = lt == 0 ? 0 : lt == 1 ? 0 : lt == 2 ? 0 : lt == 3 ? 0 : lt == 4 ? 1 : lt == 5 ? 1 : lt == 6 ? 1 : lt == 7 ? 2 : lt == 8 ? 2 : lt == 9 ? 3 : lt == 10 ? 1 : lt == 11 ? 2 : lt == 12 ? 2 : lt == 13 ? 3 : lt == 14 ? 3 : 3;
                        const int tb = lt == 0 ? 0 : lt == 1 ? 1 : lt == 2 ? 2 : lt == 3 ? 3 : lt == 4 ? 1 : lt == 5 ? 2 : lt == 6 ? 3 : lt == 7 ? 2 : lt == 8 ? 3 : lt == 9 ? 3 : lt == 10 ? 0 : lt == 11 ? 0 : lt == 12 ? 1 : lt == 13 ? 0 : lt == 14 ? 1 : 2;
                        const int jb = dir == 0 ? ta : tb, ibg = dir == 0 ? tb : ta;
                        const bool dead = lt >= 10;
                        a_f32x16 gt;
#pragma unroll
                        for (int r = 0; r < 16; ++r) gt[r] = 0.f;
                        if (!dead) {
                            const LAS unsigned char* ap = lds + SC_B + (32 * jb + r32) * SC_ST + hi * 16; const LAS unsigned char* bp = lds + SC_C + (32 * ibg + r32) * SC_ST + hi * 16;
#pragma unroll
                            for (int s = 0; s < 8; ++s) gt = __builtin_amdgcn_mfma_f32_32x32x16_bf16(*(const LAS a_bf16x8*)(ap + 32 * s), *(const LAS a_bf16x8*)(bp + 32 * s), gt, 0, 0, 0);
                            const int i = 32 * ibg + r32; const float ai = acum[i];
                            v4f aj[4], dj[4];
#pragma unroll
                            for (int g4 = 0; g4 < 4; ++g4) { aj[g4] = *(const LAS v4f*)(acum + 32 * jb + 8 * g4 + 4 * hi); dj[g4] = *(const LAS v4f*)(dtj + 32 * jb + 8 * g4 + 4 * hi); }
#pragma unroll
                            for (int r = 0; r < 16; ++r) { const int j = 32 * jb + a_crow(r, hi); const bool keep = dir == 0 ? j <= i : j >= i;
                                const float e = __builtin_amdgcn_exp2f(fminf(ai - aj[r >> 2][r & 3], 0.f) * 1.4426950408889634f) * dj[r >> 2][r & 3];
                                gt[r] = keep ? gt[r] * e + (j == i ? dd : 0.f) : 0.f; }
                        }
#pragma unroll
                        for (int g4 = 0; g4 < 4; ++g4) { v2u w; w.x = a_cvtpk(gt[4 * g4], gt[4 * g4 + 1]); w.y = a_cvtpk(gt[4 * g4 + 2], gt[4 * g4 + 3]);
                            *(LAS v2u*)(lds + SC_M + (32 * ibg + r32) * SC_ST + (32 * jb + 8 * g4 + 4 * hi) * 2) = w; }
                    }
                    a_f32x16 yo;
#pragma unroll
                    for (int r = 0; r < 16; ++r) yo[r] = 0.f;
                    { const LAS unsigned char* ap = lds + SC_C + (32 * ib + r32) * SC_ST + hi * 16; const LAS unsigned char* bp = lds + SC_H + (32 * pb + r32) * SC_ST + hi * 16;
#pragma unroll
                      for (int s = 0; s < 8; ++s) yo = __builtin_amdgcn_mfma_f32_32x32x16_bf16(*(const LAS a_bf16x8*)(ap + 32 * s), *(const LAS a_bf16x8*)(bp + 32 * s), yo, 0, 0, 0); }
                    LDS_BARRIER();
                    a_f32x16 yd;
#pragma unroll
                    for (int r = 0; r < 16; ++r) yd[r] = 0.f;
                    { const LAS unsigned char* ap = lds + SC_M + (32 * ib + r32) * SC_ST + hi * 16; const LAS unsigned char* xp = lds + SC_X + (8 * hi + q4) * SC_XS + (32 * pb + 16 * gg + 4 * p4) * 2;
#pragma unroll
                      for (int s = 0; s < 8; ++s) { const a_s16x4 l0 = a_vtr(xp + (16 * s) * SC_XS), h0 = a_vtr(xp + (16 * s + 4) * SC_XS);
                          const a_bf16x8 xb = (a_bf16x8){l0[0], l0[1], l0[2], l0[3], h0[0], h0[1], h0[2], h0[3]};
                          yd = __builtin_amdgcn_mfma_f32_32x32x16_bf16(*(const LAS a_bf16x8*)(ap + 32 * s), xb, yd, 0, 0, 0); } }
                    { bf16* yp = y + (size_t)dir * T * 2048 + (size_t)(row0 + 32 * ib) * 2048 + hd * 64 + 32 * pb + r32;
                      v4f e4[4];
#pragma unroll
                      for (int g4 = 0; g4 < 4; ++g4) e4[g4] = *(const LAS v4f*)(ei + 32 * ib + 8 * g4 + 4 * hi);
#pragma unroll
                      for (int r = 0; r < 16; ++r) { const int i = a_crow(r, hi); const float v = yd[r] + e4[r >> 2][r & 3] * yo[r]; yp[(size_t)i * 2048] = (bf16)f2bf(v); } }
                    { const float dec = misc[0];
#pragma unroll
                      for (int r = 0; r < 16; ++r) hacc[r] *= dec;
                      const LAS unsigned char* bq = lds + SC_B + (8 * hi + q4) * SC_ST + (32 * nb + 16 * gg + 4 * p4) * 2; const LAS unsigned char* xq = lds + SC_XW + (8 * hi + q4) * SC_XS + (32 * pb + 16 * gg + 4 * p4) * 2;
#pragma unroll
                      for (int s = 0; s < 8; ++s) { const a_s16x4 bl = a_vtr(bq + (16 * s) * SC_ST), bh = a_vtr(bq + (16 * s + 4) * SC_ST), xl = a_vtr(xq + (16 * s) * SC_XS), xh = a_vtr(xq + (16 * s + 4) * SC_XS);
                          const a_bf16x8 av = (a_bf16x8){bl[0], bl[1], bl[2], bl[3], bh[0], bh[1], bh[2], bh[3]}, bv = (a_bf16x8){xl[0], xl[1], xl[2], xl[3], xh[0], xh[1], xh[2], xh[3]};
                          hacc = __builtin_amdgcn_mfma_f32_32x32x16_bf16(av, bv, hacc, 0, 0, 0); } }
#pragma unroll
                    for (int g4 = 0; g4 < 4; ++g4) { v2u w; w.x = a_cvtpk(hacc[4 * g4], hacc[4 * g4 + 1]); w.y = a_cvtpk(hacc[4 * g4 + 2], hacc[4 * g4 + 3]);
                        *(LAS v2u*)(lds + SC_H + (32 * pb + r32) * SC_ST + (32 * nb + 8 * g4 + 4 * hi) * 2) = w; }
                }
                if (seq < 16) { float* o = out + OUT_SSM + ((((size_t)seq * 2 + dir) * 32 + hd) * 64 + 32 * pb + r32) * 128 + 32 * nb + 4 * hi;
#pragma unroll
                    for (int g4 = 0; g4 < 4; ++g4) { v4f t4; t4.x = hacc[4 * g4]; t4.y = hacc[4 * g4 + 1]; t4.z = hacc[4 * g4 + 2]; t4.w = hacc[4 * g4 + 3]; *(GAS v4f*)(o + 8 * g4) = t4; } }
            }
        }
    }
#undef SC_GLOADP
#undef SC_ITEM
    LDS_BARRIER();
}

constexpr int NPHASE = 30;
enum Op { OP_P0, OP_NORM1, OP_G_LAT, OP_FIN1, OP_G_QKV, OP_FIN2, OP_ATTN, OP_G_WO, OP_NORM2, OP_G_FF1, OP_G_FF2, OP_G_PW1, OP_DWCONV, OP_G_PW2, OP_G_SSI, OP_SSCONV, OP_SCAN, OP_GATE, OP_G_SSO };
__device__ __forceinline__ void phase_decode(int ph, int& layer, int& op) {
    if (ph == 0) { layer = 0; op = OP_P0; return; }
    if (ph <= 9) { layer = 0; const int r = ph - 1; op = r == 0 ? OP_NORM1 : r == 1 ? OP_G_LAT : r == 2 ? OP_FIN1 : r == 3 ? OP_G_QKV : r == 4 ? OP_FIN2 : r == 5 ? OP_ATTN : r == 6 ? OP_G_WO : r == 7 ? OP_G_FF1 : OP_G_FF2; }
    else if (ph <= 14) { layer = 1; const int r = ph - 10; op = r == 0 ? OP_G_PW1 : r == 1 ? OP_DWCONV : r == 2 ? OP_G_PW2 : r == 3 ? OP_G_FF1 : OP_G_FF2; }
    else if (ph <= 21) { layer = 2; const int r = ph - 15; op = r == 0 ? OP_G_SSI : r == 1 ? OP_SSCONV : r == 2 ? OP_SCAN : r == 3 ? OP_GATE : r == 4 ? OP_G_SSO : r == 5 ? OP_G_FF1 : OP_G_FF2; }
    else { layer = 3; const int r = ph - 22; op = r == 0 ? OP_G_LAT : r == 1 ? OP_FIN1 : r == 2 ? OP_G_QKV : r == 3 ? OP_FIN2 : r == 4 ? OP_ATTN : r == 5 ? OP_G_WO : r == 6 ? OP_G_FF1 : OP_G_FF2; }
}
struct MArgs { const float* in[38]; float* out; unsigned char* ws; int ph_lo, ph_hi; };
constexpr int PTAB_OFF = PTAB_OFF_C;
__global__ void __launch_bounds__(NTHR, 2) mega_fwd(MArgs args) {
    extern __shared__ __attribute__((aligned(16))) unsigned char lds_raw[];
    LAS unsigned char* lds = (LAS unsigned char*)lds_raw;
    volatile LAS unsigned* PT0 = (volatile LAS unsigned*)(lds + PTAB_OFF);
    volatile LAS unsigned* MISC = (volatile LAS unsigned*)(lds + MISC_OFF);
    { const int t0 = threadIdx.x;
      if (t0 < 40) { const unsigned long long p = t0 < 38 ? (unsigned long long)args.in[t0] : t0 == 38 ? (unsigned long long)args.out : (unsigned long long)args.ws;
          PT0[2 * t0] = (unsigned)p; PT0[2 * t0 + 1] = (unsigned)(p >> 32); }
      if (t0 < 64) MISC[t0] = 0u; }
    __syncthreads();
    XcdBarrier bar = xcd_barrier_post((unsigned*)((unsigned char*)ldp(PT0, PT_WS) + WS_CTL) + CW_BAR, MISC + 8);
    const int wave0 = __builtin_amdgcn_readfirstlane(threadIdx.x >> 6);
    const int ph_hi = args.ph_hi;
    for (int ph = args.ph_lo; ph < ph_hi; ++ph) {
        Frame F;
        { int w = wave0; asm volatile("" : "+s"(w)); F.wave = w; }
        F.lds = lds; F.lane = olane(); F.tid = F.wave * 64 + F.lane;
        const int bx = obid();
        F.G = gridDim.x; F.vcu = (F.G % 8 == 0) ? (bx % 8) * (F.G / 8) + bx / 8 : bx;
        F.gw = F.vcu * NWAVES + F.wave; F.NGW = F.G * NWAVES; F.PT = PT0; F.bx = bx;
        int layer, op; phase_decode(ph, layer, op);
        const int j = layer / 3;
        switch (op) {
        case OP_P0: p0_prologue(F); break;
        case OP_NORM1: { unsigned char* ws = WSP; float* x = OUTP; const float* xlo = layer == 0 ? INP(I_XP) : x; const float* xhi = layer == 0 ? INP(I_XS) - (size_t)TP * 1024 : x;
            rp_normmod(F, xlo, xhi, INP(I_GN1) + layer * 1024, (const float*)(ws + WS_MODS) + (size_t)layer * 5 * 6144, 0, 1024, (bf16*)(ws + WS_H)); rp_tables(F); } break;
        case OP_NORM2: { unsigned char* ws = WSP; float* x = OUTP;
            rp_normmod(F, x, x, INP(I_GN2) + layer * 1024, (const float*)(ws + WS_MODS) + (size_t)layer * 5 * 6144, 3072, 4096, (bf16*)(ws + WS_H)); } break;
        case OP_G_LAT: { unsigned char* ws = WSP; pg8::Gemm g{(const bf16*)(ws + WS_H), (const bf16*)(ws + W_MLA + j * MLA_WB + MW_CAT), T, 768, 1024}; pg8::StaticOrder S; S.init(T, 2 * 768, F.G, F.bx);
            const int s_ = 2 * layer; pg8::EpiF32<1> E{(float*)(ws + A_LAT), 768, layer == 0 ? nullptr : (const float*)(ws + WS_STAT) + s_ * 8192, layer == 0 ? nullptr : (const float*)(ws + WS_SW) + (size_t)s_ * 5 * 5632}; pg8::gemm_phase<pg8::EpiF32<1>, pg8::StaticOrder, true, true, true>(F.lds, g, S, E, F.wave); } break;
        case OP_FIN1: { unsigned char* ws = WSP; rp_mla_fin1(F, (const float*)(ws + A_LAT), INP(I_GQ) + j * 384, INP(I_GKV) + j * 256, (bf16*)(ws + A_QN), (bf16*)(ws + WS_CKV + j * CKV_B), OUTP, j); } break;
        case OP_G_QKV: {
#pragma unroll 1
            for (int w = 0; w < 2; ++w) {
                unsigned char* ws = WSP; unsigned char* wm = ws + W_MLA + j * MLA_WB;
                pg8::Gemm g = w == 0 ? pg8::Gemm{(const bf16*)(ws + A_QN), (const bf16*)(wm + MW_UQ), T, 1536, 384} : pg8::Gemm{(const bf16*)(ws + WS_CKV + j * CKV_B), (const bf16*)(wm + MW_UKV), T + NCTX, 2048, 256};
                pg8::StaticOrder S; S.init(g.M, g.N, F.G, w == 0 ? F.bx : (int)((F.bx + 64) % F.G));
                pg8::EpiBf16P E{w == 0 ? (bf16*)(ws + A_QRAW) : (bf16*)(ws + A_KVRAW), g.N};
                pg8::gemm_phase<pg8::EpiBf16P, pg8::StaticOrder, true, true>(F.lds, g, S, E, F.wave);
            } } break;
        case OP_FIN2: { unsigned char* ws = WSP; rp_mla_fin2(F, (const bf16*)(ws + A_QRAW), (const bf16*)(ws + A_KVRAW), (const float*)(ws + A_LAT), INP(I_CKPE) + (size_t)j * 8192, INP(I_GQN) + j * 96, INP(I_GKN) + j * 96,
                                                        (const float*)(ws + WS_ROPE), (bf16*)(ws + A_QB), (bf16*)(ws + A_KB)); } break;
        case OP_ATTN: { unsigned char* ws = WSP; ph_attn(F, (const bf16*)(ws + A_QB), (const bf16*)(ws + A_KB), (const bf16*)(ws + A_KVRAW), (bf16*)(ws + A_AO)); } break;
        case OP_G_WO: case OP_G_PW2: case OP_G_SSO: case OP_G_FF2: {
            unsigned char* ws = WSP; float* x = OUTP;
            const float* rlo = (layer == 0 && op != OP_G_FF2) ? INP(I_XP) : x; const float* rhi = (layer == 0 && op != OP_G_FF2) ? INP(I_XS) - (size_t)TP * 1024 : x;
            pg8::Gemm g; const float* bias = nullptr; int goff = 2048;
            if (op == OP_G_WO) g = pg8::Gemm{(const bf16*)(ws + A_AO), (const bf16*)(ws + W_MLA + j * MLA_WB + MW_O), T, 1024, 1024};
            else if (op == OP_G_PW2) { g = pg8::Gemm{(const bf16*)(ws + A_V), (const bf16*)(ws + W_CV2), T, 1024, 1024}; bias = INP(I_CVB2); }
            else if (op == OP_G_SSO) g = pg8::Gemm{(const bf16*)(ws + A_YN), (const bf16*)(ws + W_SSO), T, 1024, 2048};
            else { g = pg8::Gemm{(const bf16*)(ws + A_ACT), (const bf16*)(ws + W_FF + layer * FF_WB + FW_OUT), T, 1024, 2816}; goff = 5120; }
            pg8::StaticOrder S; S.init(T, 2 * 1024, F.G, F.bx);
            float* xdst = x;
            const int sn_ = 2 * layer + (op == OP_G_FF2 ? 2 : 1);
            pg8::EpiResid<1> E{rlo, rhi, xdst, (const float*)(ws + WS_MODS) + (size_t)layer * 5 * 6144, goff, bias,
                               sn_ < 8 ? (bf16*)(ws + WS_H) : nullptr, (const float*)(ws + WS_GT) + (size_t)(sn_ & 7) * 5 * 1024, (float*)(ws + WS_STAT) + (sn_ & 7) * 8192};
            pg8::gemm_phase<pg8::EpiResid<1>, pg8::StaticOrder, true, true, true>(F.lds, g, S, E, F.wave); } break;
        case OP_G_FF1: { unsigned char* ws = WSP; pg8::Gemm g{(const bf16*)(ws + WS_H), (const bf16*)(ws + W_FF + layer * FF_WB + FW_IN), T, 5632, 1024}; pg8::StaticOrder S; S.init(T, 5632, F.G, F.bx);
            const int s_ = 2 * layer + 1; pg8::EpiGlu<0> E{(bf16*)(ws + A_ACT), 2816, nullptr, 2816, (const float*)(ws + WS_STAT) + s_ * 8192, (const float*)(ws + WS_SW) + (size_t)s_ * 5 * 5632}; pg8::gemm_phase<pg8::EpiGlu<0>, pg8::StaticOrder, true, true>(F.lds, g, S, E, F.wave); } break;
        case OP_G_PW1: { unsigned char* ws = WSP; pg8::Gemm g{(const bf16*)(ws + WS_H), (const bf16*)(ws + W_CV1), T, 2048, 1024}; pg8::StaticOrder S; S.init(T, 2048, F.G, F.bx);
            const int s_ = 2 * layer; pg8::EpiGlu<1> E{(bf16*)(ws + A_U), 1024, INP(I_CVB1), 1024, (const float*)(ws + WS_STAT) + s_ * 8192, (const float*)(ws + WS_SW) + (size_t)s_ * 5 * 5632}; pg8::gemm_phase<pg8::EpiGlu<1>, pg8::StaticOrder, true, true>(F.lds, g, S, E, F.wave); } break;
        case OP_DWCONV: { unsigned char* ws = WSP; rp_dwconv(F, (const bf16*)(ws + A_U), INP(I_CVWD), INP(I_CVBD), INP(I_CVGL), INP(I_CVBL), (bf16*)(ws + A_V)); } break;
        case OP_G_SSI: { unsigned char* ws = WSP; pg8::Gemm g{(const bf16*)(ws + WS_H), (const bf16*)(ws + W_SSI), T, 5376, 1024}; pg8::StaticOrder S; S.init(T, 5376, F.G, F.bx);
            const int s_ = 2 * layer; pg8::EpiSsdIn E{(bf16*)(ws + A_Z), (bf16*)(ws + A_XPRE), (float*)(ws + A_DTRAW), (const float*)(ws + WS_STAT) + s_ * 8192, (const float*)(ws + WS_SW) + (size_t)s_ * 5 * 5632}; pg8::gemm_phase<pg8::EpiSsdIn, pg8::StaticOrder, true, true>(F.lds, g, S, E, F.wave); } break;
        case OP_SSCONV: { unsigned char* ws = WSP; rp_ssd_conv(F, (const bf16*)(ws + A_XPRE), (const float*)(ws + A_DTRAW), INP(I_SSWC), INP(I_SSBC), INP(I_SSDTB), INP(I_SSAL), (bf16*)(ws + A_XBC), (float*)(ws + A_DT), (float*)(ws + A_ACUM)); } break;
        case OP_SCAN: { unsigned char* ws = WSP; ph_scan(F, (const bf16*)(ws + A_XBC), (const float*)(ws + A_DT), (const float*)(ws + A_ACUM), INP(I_SSD), INP(I_SSM), (bf16*)(ws + A_Y), OUTP); } break;
        case OP_GATE: { unsigned char* ws = WSP; rp_ssd_gate(F, (const bf16*)(ws + A_Y), (const bf16*)(ws + A_Z), INP(I_SSGN), (bf16*)(ws + A_YN)); } break;
        default: break;
        }

        if (ph + 1 < ph_hi) { F.lane = olane(); xcd_barrier_work(bar, F, ph); }

    }
}

extern "C" void kernel_launch(void* const* d_in, const int* in_sizes, int n_in, void* d_out, int out_size, void* d_ws, size_t ws_size, hipStream_t stream) {
    static int grid = 0;
    if (grid == 0) {
        int dev = 0, cus = 0;
        if (hipGetDevice(&dev) != hipSuccess || hipDeviceGetAttribute(&cus, hipDeviceAttributeMultiprocessorCount, dev) != hipSuccess) { fprintf(stderr, "kernel_launch: device query failed\n"); grid = -1; return; }
        if (hipFuncSetAttribute((const void*)mega_fwd, hipFuncAttributeMaxDynamicSharedMemorySize, LDS_BYTES) != hipSuccess) { fprintf(stderr, "kernel_launch: hipFuncSetAttribute failed\n"); grid = -1; return; }
        (void)hipGetLastError();
        grid = cus;
    }
    if (grid < 0) return;
    (void)hipMemsetAsync((char*)d_ws + WS_CTL, 0, CTL_ZERO_BYTES, stream);
    MArgs a{};
    for (int i = 0; i < 38; ++i) a.in[i] = (const float*)d_in[i];
    a.out = (float*)d_out; a.ws = (unsigned char*)d_ws;
    a.ph_lo = 0; a.ph_hi = NPHASE;
    hipLaunchKernelGGL(mega_fwd, dim3(grid), dim3(NTHR), LDS_BYTES, stream, a);
}
```

```cpp
#include <hip/hip_runtime.h>
#include <cstdint>
#include <cstdio>

constexpr int DM = 1024, T = 8192, TP = 4096;
constexpr int NCTX = 1024;
constexpr int QL = 384, KVL = 256, ROPE = 32, NOPE = 64, QKD = 96, VH = 64, NH = 16;
constexpr int FFH = 2816;
constexpr int SSI = 2048, SSH = 32, SSP = 64, SSN = 128, SSG = 4, SSCD = 3072, SSIN = 5184;
constexpr float EPS = 1e-6f;
constexpr size_t OUT_YP = 0, OUT_CKV = 8388608, OUT_KPE = 10485760, OUT_SSM = 10747904;

__device__ __forceinline__ int cond_of_row(int r) { return r < TP ? 0 : 1 + ((r - TP) >> 10); }
__device__ __forceinline__ void row_pos(int r, int& t, int& L) { if (r < TP) { t = r & 255; L = 256; } else { t = (r - TP) & 1023; L = 1024; } }
__device__ __forceinline__ float softplus_f(float x) { return fmaxf(x, 0.f) + log1pf(expf(-fabsf(x))); }

__device__ __forceinline__ float rope_inv(int i) { return i == 0 ? 1.f : i == 1 ? 0.31622776601683794f : i == 2 ? 0.1f : i == 3 ? 0.031622776601683794f : i == 4 ? 0.01f : i == 5 ? 0.0031622776601683794f : i == 6 ? 0.001f : 0.00031622776601683794f; }

__device__ __forceinline__ int olane() { int l; asm volatile("v_mbcnt_lo_u32_b32 %0, -1, 0\n\tv_mbcnt_hi_u32_b32 %0, -1, %0" : "=v"(l)); return l; }
__device__ __forceinline__ int obid() { int b = blockIdx.x; asm volatile("" : "+s"(b)); return b; }
namespace pg8 {
#define PG8_LAS __attribute__((address_space(3)))
typedef unsigned short bf16_t;
typedef short bf16x8 __attribute__((ext_vector_type(8)));
typedef float f32x4 __attribute__((ext_vector_type(4)));
typedef unsigned u32x4 __attribute__((ext_vector_type(4)));
constexpr int BM = 256, BK = 64, HALF = 128, HTB = HALF * BK * 2  , STAGE_BYTES = 8 * HTB, NXCD = 8, WGM = 8;

__host__ __device__ __forceinline__ int lds_byte(int r, int c) { const int st = (r >> 4) * 2 + (c >> 5), rr = r & 15, cc = c & 31, ob = rr * 64 + cc * 2; return st * 1024 + (ob ^ (((ob >> 9) & 1) << 5)); }
__host__ __device__ __forceinline__ void stage_rc(int b, int& R, int& C) { const int st = b / 1024, sb = b % 1024, swz = sb ^ (((sb >> 9) & 1) << 5); R = (st >> 1) * 16 + swz / 64; C = (st & 1) * 32 + (swz % 64) / 2; }
__host__ __device__ __forceinline__ int perm32(int rho) { const int n = rho >> 4, i = rho & 15; return 8 * (i >> 2) + 4 * n + (i & 3); }

struct Unit { int pm, pn; };
struct Gemm { const bf16_t* A; const bf16_t* Bt; int M, N, K; };

struct StaticOrder {
    int nM, nN, nwg, G, c;
    __host__ __device__ void init(int M, int N, int G_, int c_) { nM = M / BM; nN = N / BM; nwg = nM * nN; G = G_; c = c_; }
    __host__ __device__ bool next(int i, Unit& u) const {
        const long L = (long)i * G + c; if (L >= nwg) return false;
        int wgid = (int)L; { const int q = nwg / NXCD, r = nwg % NXCD, xcd = wgid % NXCD, off = wgid / NXCD; wgid = (xcd < r ? xcd * (q + 1) : r * (q + 1) + (xcd - r) * q) + off; }
        const int nig = WGM * nN, gid = wgid / nig, fm = gid * WGM, gsz = (nM - fm) < WGM ? (nM - fm) : WGM;
        u.pm = fm + ((wgid % nig) % gsz); u.pn = (wgid % nig) / gsz; return true;
    }
    __device__ __forceinline__ void a_ready(const Unit&) const {}
    __device__ __forceinline__ void done(const Unit&) const {}
};
__device__ __forceinline__ unsigned cvt_pk_bf16(float lo, float hi) { unsigned r; asm("v_cvt_pk_bf16_f32 %0, %1, %2" : "=v"(r) : "v"(lo), "v"(hi)); return r; }
typedef unsigned u32x2 __attribute__((ext_vector_type(2)));
#define PG8_GAS __attribute__((address_space(1)))
__device__ __forceinline__ void st16(void* p, u32x4 v) { *(PG8_GAS u32x4*)p = v; }
__device__ __forceinline__ void st16f(void* p, f32x4 v) { *(PG8_GAS f32x4*)p = v; }
__device__ __forceinline__ void st8(void* p, u32x2 v) { *(PG8_GAS u32x2*)p = v; }
__device__ __forceinline__ f32x4 ld16f(const float* p) { return *(const PG8_GAS f32x4*)p; }
__device__ __forceinline__ float ld4f(const float* p) { return *(const PG8_GAS float*)p; }
__device__ __forceinline__ float fast_sigmoid(float x) { return __builtin_amdgcn_rcpf(1.f + __builtin_amdgcn_exp2f(-1.4426950408889634f * x)); }
__device__ __forceinline__ unsigned cvt_pk_bf16_p(float lo, float hi) { unsigned r; asm("v_cvt_pk_bf16_f32 %0, %1, %2" : "=v"(r) : "v"(lo), "v"(hi)); return r; }
template <int MODE> __device__ __forceinline__ void glu8(const f32x4 a0, const f32x4 g0, const f32x4 a1, const f32x4 g1, f32x4& o0, f32x4& o1) {
    const f32x4 t0 = (MODE == 0 ? a0 : g0) * -1.4426950408889634f, t1 = (MODE == 0 ? a1 : g1) * -1.4426950408889634f;
    f32x4 e0, e1, r0, r1;
#pragma unroll
    for (int j = 0; j < 4; ++j) { e0[j] = __builtin_amdgcn_exp2f(t0[j]); e1[j] = __builtin_amdgcn_exp2f(t1[j]); }
    const f32x4 d0 = e0 + 1.f, d1 = e1 + 1.f;
#pragma unroll
    for (int j = 0; j < 4; ++j) { r0[j] = __builtin_amdgcn_rcpf(d0[j]); r1[j] = __builtin_amdgcn_rcpf(d1[j]); }
    if (MODE == 0) { o0 = a0 * g0 * r0; o1 = a1 * g1 * r1; } else { o0 = a0 * r0; o1 = a1 * r1; }
}

constexpr int SW_LD = 5632;
__device__ __forceinline__ int cond_of_pm(int pm) { return pm < 16 ? 0 : 1 + ((pm - 16) >> 2); }
__device__ __forceinline__ void stage_rstat_sw(const float* rstat, const float* sw, const Unit& u, int slot, int wid, int lane, PG8_LAS unsigned char* tabs) {
    PG8_LAS unsigned char* tab = tabs + slot * 2048;
    if (wid < 4) __builtin_amdgcn_global_load_lds((const unsigned*)(rstat + u.pm * BM + wid * 64 + lane), (PG8_LAS unsigned*)(tab + wid * 256), 4, 0, 0);
    else __builtin_amdgcn_global_load_lds((const unsigned*)(sw + (size_t)cond_of_pm(u.pm) * SW_LD + u.pn * BM + (wid - 4) * 64 + lane), (PG8_LAS unsigned*)(tab + 1024 + (wid - 4) * 256), 4, 0, 0);
}
template <int NBJ> struct EpiF32 {
    static constexpr bool PERM = false, AFTER_DRAIN = false, STAGE_IN = false;
    float* C; int ldc; const float* rstat; const float* sw;
    template <bool HN> __device__ __forceinline__ void body(const f32x4 (&acc)[2][2][4][2], const Unit& u, int wr, int wc) const {
        const int t_ = olane(), fr = t_ & 15, fq = t_ >> 4;
        const int row0 = u.pm * BM + wr * 64 + fr, col0 = u.pn * (HALF * NBJ) + wc * 32 + 4 * fq;
        float rs[2][4]; f32x4 s4[NBJ][2];
#pragma unroll
        for (int ai = 0; ai < 2; ++ai)
#pragma unroll
            for (int m = 0; m < 4; ++m) rs[ai][m] = HN ? ld4f(rstat + row0 + ai * HALF + m * 16) : 1.f;
#pragma unroll
        for (int bj = 0; bj < NBJ; ++bj)
#pragma unroll
            for (int n = 0; n < 2; ++n) s4[bj][n] = HN ? ld16f(sw + (size_t)cond_of_pm(u.pm) * SW_LD + col0 + bj * HALF + n * 16) : (f32x4){0.f, 0.f, 0.f, 0.f};
        if (HN) {
#pragma unroll
            for (int ai = 0; ai < 2; ++ai)
#pragma unroll
                for (int m = 0; m < 4; ++m) rs[ai][m] = __builtin_amdgcn_rsqf(rs[ai][m] * (1.f / 1024) + 1e-6f);
        }
#pragma unroll
        for (int ai = 0; ai < 2; ++ai)
#pragma unroll
            for (int m = 0; m < 4; ++m) { float* rowp = C + (size_t)(row0 + ai * HALF + m * 16) * ldc + col0;
#pragma unroll
                for (int bj = 0; bj < NBJ; ++bj)
#pragma unroll
                    for (int n = 0; n < 2; ++n) { f32x4 v = acc[ai][bj][m][n]; if (HN) v = v * rs[ai][m] + s4[bj][n]; st16f(rowp + bj * HALF + n * 16, v); } }
    }
    __device__ __forceinline__ void operator()(const f32x4 (&acc)[2][2][4][2], const Unit& u, int wr_, int wc_, int fr_, int fq_, const PG8_LAS unsigned char* tab) const {
        (void)fr_; (void)fq_; (void)tab;
        if (rstat) body<true>(acc, u, wr_, wc_); else body<false>(acc, u, wr_, wc_);
    }
};
struct EpiBf16P {
    static constexpr bool PERM = true, AFTER_DRAIN = false, STAGE_IN = false;
    bf16_t* O; int ldc;
    __device__ __forceinline__ void operator()(const f32x4 (&acc)[2][2][4][2], const Unit& u, int wr_, int wc_, int fr_, int fq_, const PG8_LAS unsigned char* tab) const {
        const int t_ = olane(), wr = wr_, wc = wc_, fr = t_ & 15, fq = t_ >> 4; (void)fr_; (void)fq_; (void)tab;
        const int row0 = u.pm * BM + wr * 64 + fr, col0 = u.pn * BM + wc * 32 + 8 * fq;
#pragma unroll
        for (int ai = 0; ai < 2; ++ai)
#pragma unroll
            for (int m = 0; m < 4; ++m) { bf16_t* rowp = O + (size_t)(row0 + ai * HALF + m * 16) * ldc + col0;
#pragma unroll
                for (int bj = 0; bj < 2; ++bj) { const f32x4 v0 = acc[ai][bj][m][0], v1 = acc[ai][bj][m][1]; u32x4 w;
                    w.x = cvt_pk_bf16(v0[0], v0[1]); w.y = cvt_pk_bf16(v0[2], v0[3]); w.z = cvt_pk_bf16(v1[0], v1[1]); w.w = cvt_pk_bf16(v1[2], v1[3]);
                    st16(rowp + bj * HALF, w); } }
    }
};
struct EpiSsdIn {
    static constexpr bool PERM = true, AFTER_DRAIN = false, STAGE_IN = true;
    bf16_t* Z; bf16_t* XP; float* DT; const float* rstat; const float* sw;
    __device__ __forceinline__ void stage_in(const Unit& u, int slot, int wid, int lane, PG8_LAS unsigned char* tabs) const { stage_rstat_sw(rstat, sw, u, slot, wid, lane, tabs); }
    __device__ __forceinline__ void operator()(const f32x4 (&acc)[2][2][4][2], const Unit& u, int wr_, int wc_, int fr_, int fq_, const PG8_LAS unsigned char* tab) const {
        const int t_ = olane(), wr = wr_, wc = wc_, fr = t_ & 15, fq = t_ >> 4; (void)fr_; (void)fq_;
        const int row0 = u.pm * BM + wr * 64 + fr;
        const PG8_LAS float* trs = (const PG8_LAS float*)tab + wr * 64 + fr; const PG8_LAS float* swp = (const PG8_LAS float*)(tab + 1024) + wc * 32 + 8 * fq;
        if (u.pn < 20) {
            bf16_t* base = u.pn < 8 ? Z : XP; const int ld = u.pn < 8 ? 2048 : 3072, colt = (u.pn < 8 ? u.pn : u.pn - 8) * BM, col0 = colt + wc * 32 + 8 * fq;
#pragma unroll
            for (int ai = 0; ai < 2; ++ai)
#pragma unroll
                for (int m = 0; m < 4; ++m) { bf16_t* rowp = base + (size_t)(row0 + ai * HALF + m * 16) * ld + col0;
                    const float rs = __builtin_amdgcn_rsqf(trs[ai * HALF + m * 16] * (1.f / 1024) + 1e-6f);
#pragma unroll
                    for (int bj = 0; bj < 2; ++bj) { const f32x4 v0 = acc[ai][bj][m][0] * rs + *(const PG8_LAS f32x4*)(swp + bj * HALF), v1 = acc[ai][bj][m][1] * rs + *(const PG8_LAS f32x4*)(swp + bj * HALF + 4); u32x4 w;
                        w.x = cvt_pk_bf16(v0[0], v0[1]); w.y = cvt_pk_bf16(v0[2], v0[3]); w.z = cvt_pk_bf16(v1[0], v1[1]); w.w = cvt_pk_bf16(v1[2], v1[3]);
                        st16(rowp + bj * HALF, w); } }
        } else if (wc < 2) {
#pragma unroll
            for (int ai = 0; ai < 2; ++ai)
#pragma unroll
                for (int m = 0; m < 4; ++m) { float* rp = DT + (size_t)(row0 + ai * HALF + m * 16) * 64 + wc * 32 + 8 * fq;
                    const float rs = __builtin_amdgcn_rsqf(trs[ai * HALF + m * 16] * (1.f / 1024) + 1e-6f);
                    st16f(rp, acc[ai][0][m][0] * rs + *(const PG8_LAS f32x4*)swp); st16f(rp + 4, acc[ai][0][m][1] * rs + *(const PG8_LAS f32x4*)(swp + 4)); }
        }
    }
};
template <int MODE> struct EpiGlu {
    static constexpr bool PERM = false, AFTER_DRAIN = false, STAGE_IN = true;
    bf16_t* O; int ldo; const float* bias; int H; const float* rstat; const float* sw;
    __device__ __forceinline__ void stage_in(const Unit& u, int slot, int wid, int lane, PG8_LAS unsigned char* tabs) const { stage_rstat_sw(rstat, sw, u, slot, wid, lane, tabs); }
    __device__ __forceinline__ void operator()(const f32x4 (&acc)[2][2][4][2], const Unit& u, int wr_, int wc_, int fr_, int fq_, const PG8_LAS unsigned char* tab) const {
        const int t_ = olane(), wr = wr_, wc = wc_, fr = t_ & 15, fq = t_ >> 4; (void)fr_; (void)fq_;
        const int row0 = u.pm * BM + wr * 64 + fr;
        float rs[2][4];
#pragma unroll
        for (int ai = 0; ai < 2; ++ai)
#pragma unroll
            for (int m = 0; m < 4; ++m) rs[ai][m] = ((const PG8_LAS float*)tab)[ai * HALF + wr * 64 + m * 16 + fr];
#pragma unroll
        for (int ai = 0; ai < 2; ++ai)
#pragma unroll
            for (int m = 0; m < 4; ++m) rs[ai][m] = __builtin_amdgcn_rsqf(rs[ai][m] * (1.f / 1024) + 1e-6f);
        const unsigned ldb = (unsigned)ldo * 2u;
        unsigned char* Ob = (unsigned char*)O;
        const int f0 = 128 * u.pn + 32 * wc + 8 * fq;
        f32x4 ba[2], bu[2];
#pragma unroll
        for (int bj = 0; bj < 2; ++bj) {
            ba[bj] = (f32x4){0.f, 0.f, 0.f, 0.f}; bu[bj] = ba[bj];
            if (MODE == 1) { ba[bj] = ld16f(bias + f0 + 4 * bj); bu[bj] = ld16f(bias + H + f0 + 4 * bj); }
            const PG8_LAS float* swp = (const PG8_LAS float*)(tab + 1024) + bj * HALF + wc * 32 + 4 * fq; ba[bj] += *(const PG8_LAS f32x4*)swp; bu[bj] += *(const PG8_LAS f32x4*)(swp + 16);
        }
        const unsigned ob = (unsigned)row0 * ldb + (unsigned)f0 * 2u;
#pragma unroll
        for (int ai = 0; ai < 2; ++ai)
#pragma unroll
            for (int m = 0; m < 4; ++m) {
                const f32x4 a0 = acc[ai][0][m][0] * rs[ai][m] + ba[0], g0 = acc[ai][0][m][1] * rs[ai][m] + bu[0];
                const f32x4 a1 = acc[ai][1][m][0] * rs[ai][m] + ba[1], g1 = acc[ai][1][m][1] * rs[ai][m] + bu[1];
                f32x4 o0, o1; glu8<MODE>(a0, g0, a1, g1, o0, o1);
                u32x4 w; w.x = cvt_pk_bf16_p(o0[0], o0[1]); w.y = cvt_pk_bf16_p(o0[2], o0[3]); w.z = cvt_pk_bf16_p(o1[0], o1[1]); w.w = cvt_pk_bf16_p(o1[2], o1[3]);
                st16(Ob + (size_t)(ob + (unsigned)(ai * HALF + m * 16) * ldb), w); }
    }
};
template <int NBJ> struct EpiResid {
    static constexpr bool PERM = true, AFTER_DRAIN = false, STAGE_IN = false;
    const float* xlo; const float* xhi; float* xout; const float* mods_l; int g_off; const float* bias;
    bf16_t* XG; const float* GT; float* stat;
    template <bool HX> __device__ __forceinline__ void body(const f32x4 (&acc)[2][2][4][2], const Unit& u, int wr, int wc) const {
        const int t_ = olane(), fr = t_ & 15, fq = t_ >> 4;
        const int cond = u.pm < 16 ? 0 : 1 + ((u.pm - 16) >> 2);
        const float* gate = mods_l + (size_t)cond * 6144 + g_off; const unsigned char* xin = (const unsigned char*)(u.pm < 16 ? xlo : xhi);
        const int row0 = u.pm * BM + wr * 64 + fr, col0 = u.pn * (HALF * NBJ) + wc * 32 + 8 * fq;
        const unsigned ob = (unsigned)row0 * 4096u + (unsigned)col0 * 4u;
        f32x4 xo[NBJ][2][2][4];
#pragma unroll
        for (int bj = 0; bj < NBJ; ++bj)
#pragma unroll
            for (int n = 0; n < 2; ++n)
#pragma unroll
                for (int ai = 0; ai < 2; ++ai)
#pragma unroll
                    for (int m = 0; m < 4; ++m) xo[bj][n][ai][m] = ld16f((const float*)(xin + (size_t)(ob + (unsigned)((bj * HALF + n * 4) * 4 + (ai * HALF + m * 16) * 4096))));
        const float* gt = HX ? GT + (size_t)cond * 1024 : nullptr;
        f32x4 g4[NBJ][2], b4[NBJ][2], G4[NBJ][2];
#pragma unroll
        for (int bj = 0; bj < NBJ; ++bj)
#pragma unroll
            for (int n = 0; n < 2; ++n) { const int c = col0 + bj * HALF + n * 4; g4[bj][n] = ld16f(gate + c);
                b4[bj][n] = (f32x4){0.f, 0.f, 0.f, 0.f}; if (bias) b4[bj][n] = ld16f(bias + c);
                G4[bj][n] = (f32x4){0.f, 0.f, 0.f, 0.f}; if (HX) G4[bj][n] = ld16f(gt + c); }
        float ss[2][4];
#pragma unroll
        for (int ai = 0; ai < 2; ++ai)
#pragma unroll
            for (int m = 0; m < 4; ++m) ss[ai][m] = 0.f;
        unsigned char* xo_ = (unsigned char*)xout; unsigned char* xg_ = (unsigned char*)XG;
#pragma unroll
        for (int bj = 0; bj < NBJ; ++bj)
#pragma unroll
            for (int ai = 0; ai < 2; ++ai)
#pragma unroll
                for (int m = 0; m < 4; ++m) { const unsigned off = ob + (unsigned)(bj * HALF * 4 + (ai * HALF + m * 16) * 4096);
                    const f32x4 x0 = xo[bj][0][ai][m] + g4[bj][0] * (acc[ai][bj][m][0] + b4[bj][0]), x1 = xo[bj][1][ai][m] + g4[bj][1] * (acc[ai][bj][m][1] + b4[bj][1]);
                    st16f(xo_ + (size_t)off, x0); st16f(xo_ + (size_t)(off + 16u), x1);
                    if (HX) { const f32x4 y0 = x0 * G4[bj][0], y1 = x1 * G4[bj][1]; u32x4 w;
                        w.x = cvt_pk_bf16_p(y0[0], y0[1]); w.y = cvt_pk_bf16_p(y0[2], y0[3]); w.z = cvt_pk_bf16_p(y1[0], y1[1]); w.w = cvt_pk_bf16_p(y1[2], y1[3]); st16(xg_ + (size_t)(off >> 1), w);
                        const f32x4 q = x0 * x0 + x1 * x1; ss[ai][m] += (q[0] + q[1]) + (q[2] + q[3]); } }
        if (HX) {
#pragma unroll
            for (int ai = 0; ai < 2; ++ai)
#pragma unroll
                for (int m = 0; m < 4; ++m) { float s = ss[ai][m];
                    s += __builtin_bit_cast(float, __builtin_amdgcn_ds_bpermute((t_ ^ 16) << 2, __builtin_bit_cast(int, s)));
                    s += __builtin_bit_cast(float, __builtin_amdgcn_ds_bpermute((t_ ^ 32) << 2, __builtin_bit_cast(int, s)));
                    if (fq == 0) atomicAdd(stat + row0 + ai * HALF + m * 16, s); }
        }
    }
    __device__ __forceinline__ void operator()(const f32x4 (&acc)[2][2][4][2], const Unit& u, int wr_, int wc_, int fr_, int fq_, const PG8_LAS unsigned char* tab) const {
        (void)fr_; (void)fq_; (void)tab;
        if (XG) body<true>(acc, u, wr_, wc_); else body<false>(acc, u, wr_, wc_);
    }
};
template <class Epi, class Sched, bool ALIGN_EPI = false, bool SP2 = false, bool HALFN = false>
__device__ __forceinline__ void gemm_phase(PG8_LAS unsigned char* lds, const Gemm g, const Sched& S, const Epi& E, const int wave_in) {
    const int tid = wave_in * 64 + olane(), wid = __builtin_amdgcn_readfirstlane(tid >> 6), lane = tid & 63, wr = wid >> 2, wc = wid & 3, fr = lane & 15, fq = lane >> 4;
    const int K = g.K, nt = K / BK;
    unsigned voffA[2], voffB[2];
#pragma unroll
    for (int i = 0; i < 2; ++i) { int R, C; stage_rc(tid * 16 + i * 8192, R, C); const int Rb = Epi::PERM ? ((R & ~31) + perm32(R & 31)) : R;
        voffA[i] = (unsigned)(R * K + C) * 2u; voffB[i] = (unsigned)(Rb * K + C) * 2u; }
    const size_t kstep = (size_t)(BK * 2);
    const size_t hstep = (size_t)HALF * K * 2;
    const size_t tstep = 2 * hstep;
    const size_t bstep = HALFN ? hstep : tstep;
    static_assert(!HALFN || SP2, "HALFN is written for the SP2 loop only");
    const unsigned ldsw = (unsigned)wid * 1024u;
    const int aoff = lds_byte(wr * 64 + fr, fq * 8), boff = lds_byte(wc * 32 + fr, fq * 8);
#define PG8_SA(b, h) (((b) * 2 + (h)) * HTB)
#define PG8_SB(b, h) ((4 + (b) * 2 + (h)) * HTB)
#define PG8_STAGE(bufoff, gbase, voff) do { _Pragma("unroll") for (int _i = 0; _i < 2; ++_i) \
        __builtin_amdgcn_global_load_lds((const unsigned*)((const char*)(gbase) + (voff)[_i]), (PG8_LAS unsigned*)(lds + (bufoff) + ldsw + _i * 8192), 16, 0, 0); } while (0)
#define PG8_LDA(dst, b, h) do { _Pragma("unroll") for (int m = 0; m < 4; ++m) _Pragma("unroll") for (int k = 0; k < 2; ++k) dst[m][k] = *(const PG8_LAS bf16x8*)(lds + PG8_SA(b, h) + aoff + m * 2048 + k * 1024); } while (0)
#define PG8_LDB(dst, b, h) do { _Pragma("unroll") for (int n = 0; n < 2; ++n) _Pragma("unroll") for (int k = 0; k < 2; ++k) dst[n][k] = *(const PG8_LAS bf16x8*)(lds + PG8_SB(b, h) + boff + n * 2048 + k * 1024); } while (0)
#define PG8_MMA(ai, bj, At, Bt) do { __builtin_amdgcn_s_setprio(1); _Pragma("unroll") for (int m = 0; m < 4; ++m) _Pragma("unroll") for (int n = 0; n < 2; ++n) _Pragma("unroll") for (int k = 0; k < 2; ++k) \
        acc[ai][bj][m][n] = __builtin_amdgcn_mfma_f32_16x16x32_bf16(Bt[n][k], At[m][k], acc[ai][bj][m][n], 0, 0, 0); __builtin_amdgcn_s_setprio(0); } while (0)
#define PG8_WAIT_V(n) asm volatile("s_waitcnt vmcnt(" #n ")" ::: "memory")
#define PG8_WAIT_L(n) asm volatile("s_waitcnt lgkmcnt(" #n ")" ::: "memory")
#define PG8_BAR __builtin_amdgcn_s_barrier()
#define PG8_SCHED __builtin_amdgcn_sched_barrier(0)
    Unit cur, nxt; int ui = 0;
    if (!S.next(0, cur)) return;
    f32x4 acc[2][2][4][2];
#pragma unroll
    for (int a = 0; a < 2; ++a)
#pragma unroll
        for (int b = 0; b < 2; ++b)
#pragma unroll
            for (int m = 0; m < 4; ++m)
#pragma unroll
                for (int n = 0; n < 2; ++n) acc[a][b][m][n] = (f32x4){0.f, 0.f, 0.f, 0.f};
    bf16x8 At[4][2], B0[2][2], B1[2][2];
    const char* cA = (const char*)g.A + (size_t)cur.pm * tstep; const char* cB = (const char*)g.Bt + (size_t)cur.pn * bstep;
    S.a_ready(cur);
    if constexpr (Epi::STAGE_IN) E.stage_in(cur, 0, wid, lane, lds + STAGE_BYTES);
    if constexpr (HALFN) {
        PG8_STAGE(PG8_SB(0, 0), cB, voffB); PG8_STAGE(PG8_SA(0, 0), cA, voffA); PG8_STAGE(PG8_SA(0, 1), cA + hstep, voffA);
        if (wr == 1) PG8_BAR;
        PG8_WAIT_V(2); PG8_BAR;
        PG8_STAGE(PG8_SB(1, 0), cB + kstep, voffB); PG8_STAGE(PG8_SA(1, 0), cA + kstep, voffA);
        PG8_WAIT_V(4); PG8_BAR;
    } else if constexpr (SP2) {
        PG8_STAGE(PG8_SB(0, 0), cB, voffB); PG8_STAGE(PG8_SB(0, 1), cB + hstep, voffB); PG8_STAGE(PG8_SA(0, 0), cA, voffA); PG8_STAGE(PG8_SA(0, 1), cA + hstep, voffA);
        if (wr == 1) PG8_BAR;
        PG8_WAIT_V(2); PG8_BAR;
        PG8_STAGE(PG8_SB(1, 0), cB + kstep, voffB); PG8_STAGE(PG8_SA(1, 0), cA + kstep, voffA); PG8_STAGE(PG8_SB(1, 1), cB + hstep + kstep, voffB);
        PG8_WAIT_V(6); PG8_BAR;
    } else {
        PG8_STAGE(PG8_SB(0, 0), cB, voffB); PG8_STAGE(PG8_SA(0, 0), cA, voffA); PG8_STAGE(PG8_SB(0, 1), cB + hstep, voffB); PG8_STAGE(PG8_SA(0, 1), cA + hstep, voffA);
        if (wr == 1) PG8_BAR;
        PG8_WAIT_V(4); PG8_BAR;
        PG8_STAGE(PG8_SB(1, 0), cB + kstep, voffB); PG8_STAGE(PG8_SA(1, 0), cA + kstep, voffA); PG8_STAGE(PG8_SB(1, 1), cB + hstep + kstep, voffB);
        PG8_WAIT_V(6); PG8_BAR;
    }
    for (;;) {
        const bool has_next = S.next(ui + 1, nxt);
        const char* nA = has_next ? (const char*)g.A + (size_t)nxt.pm * tstep : cA; const char* nB = has_next ? (const char*)g.Bt + (size_t)nxt.pn * bstep : cB;
        for (int t = 0; t < nt; t += 2) {
            const bool last = (t == nt - 2);
            const char* a1 = cA + (size_t)(t + 1) * kstep;
            const char* a2 = last ? nA : cA + (size_t)(t + 2) * kstep; const char* b2 = last ? nB : cB + (size_t)(t + 2) * kstep;
            const char* a3 = a2 + kstep; const char* b3 = b2 + kstep;
            if (last && has_next) S.a_ready(nxt);
            if constexpr (Epi::STAGE_IN) { if (last && has_next) E.stage_in(nxt, (ui + 1) & 1, wid, lane, lds + STAGE_BYTES); }
            if constexpr (HALFN) {
            PG8_LDB(B0, 0, 0); PG8_SCHED; PG8_LDA(At, 0, 0); PG8_STAGE(PG8_SA(1, 1), a1 + hstep, voffA);
            PG8_WAIT_V(6); PG8_WAIT_L(0); PG8_BAR; PG8_MMA(0, 0, At, B0); PG8_BAR; PG8_SCHED;
            PG8_LDA(At, 0, 1); PG8_STAGE(PG8_SB(0, 0), b2, voffB); PG8_STAGE(PG8_SA(0, 0), a2, voffA);
            PG8_WAIT_V(6); PG8_WAIT_L(0); PG8_BAR; PG8_MMA(1, 0, At, B0); PG8_BAR; PG8_SCHED;
            PG8_LDB(B0, 1, 0); PG8_SCHED; PG8_LDA(At, 1, 0); PG8_STAGE(PG8_SA(0, 1), a2 + hstep, voffA);
            PG8_WAIT_V(6); PG8_WAIT_L(0); PG8_BAR; PG8_MMA(0, 0, At, B0); PG8_BAR; PG8_SCHED;
            PG8_LDA(At, 1, 1); PG8_STAGE(PG8_SB(1, 0), b3, voffB); PG8_STAGE(PG8_SA(1, 0), a3, voffA);
            PG8_WAIT_V(6); PG8_WAIT_L(0); PG8_BAR; PG8_MMA(1, 0, At, B0); PG8_BAR; PG8_SCHED;
            } else if constexpr (SP2) {
            PG8_LDB(B0, 0, 0); PG8_LDB(B1, 0, 1); PG8_SCHED; PG8_LDA(At, 0, 0); PG8_STAGE(PG8_SA(1, 1), a1 + hstep, voffA);
            PG8_WAIT_V(8); PG8_WAIT_L(0); PG8_BAR; PG8_MMA(0, 0, At, B0); PG8_MMA(0, 1, At, B1); PG8_BAR; PG8_SCHED;
            PG8_LDA(At, 0, 1); PG8_STAGE(PG8_SB(0, 0), b2, voffB); PG8_STAGE(PG8_SB(0, 1), b2 + hstep, voffB); PG8_STAGE(PG8_SA(0, 0), a2, voffA);
            PG8_WAIT_V(8); PG8_WAIT_L(0); PG8_BAR; PG8_MMA(1, 0, At, B0); PG8_MMA(1, 1, At, B1); PG8_BAR; PG8_SCHED;
            PG8_LDB(B0, 1, 0); PG8_LDB(B1, 1, 1); PG8_SCHED; PG8_LDA(At, 1, 0); PG8_STAGE(PG8_SA(0, 1), a2 + hstep, voffA);
            PG8_WAIT_V(8); PG8_WAIT_L(0); PG8_BAR; PG8_MMA(0, 0, At, B0); PG8_MMA(0, 1, At, B1); PG8_BAR; PG8_SCHED;
            PG8_LDA(At, 1, 1); PG8_STAGE(PG8_SB(1, 0), b3, voffB); PG8_STAGE(PG8_SB(1, 1), b3 + hstep, voffB); PG8_STAGE(PG8_SA(1, 0), a3, voffA);
            PG8_WAIT_V(8); PG8_WAIT_L(0); PG8_BAR; PG8_MMA(1, 0, At, B0); PG8_MMA(1, 1, At, B1); PG8_BAR; PG8_SCHED;
            } else {
            PG8_LDB(B0, 0, 0); PG8_SCHED; PG8_LDA(At, 0, 0); PG8_STAGE(PG8_SA(1, 1), a1 + hstep, voffA);
            PG8_WAIT_L(8); PG8_BAR; PG8_WAIT_L(0); PG8_MMA(0, 0, At, B0); PG8_BAR; PG8_SCHED;
            PG8_LDB(B1, 0, 1); PG8_STAGE(PG8_SB(0, 0), b2, voffB);
            PG8_BAR; PG8_WAIT_L(0); PG8_MMA(0, 1, At, B1); PG8_BAR;
            PG8_LDA(At, 0, 1); PG8_STAGE(PG8_SA(0, 0), a2, voffA);
            PG8_BAR; PG8_WAIT_L(0); PG8_MMA(1, 0, At, B0); PG8_BAR; PG8_SCHED;
            PG8_STAGE(PG8_SB(0, 1), b2 + hstep, voffB);
            PG8_WAIT_V(6); PG8_BAR; PG8_MMA(1, 1, At, B1); PG8_BAR;
            PG8_LDB(B0, 1, 0); PG8_SCHED; PG8_LDA(At, 1, 0); PG8_STAGE(PG8_SA(0, 1), a2 + hstep, voffA);
            PG8_WAIT_L(8); PG8_BAR; PG8_WAIT_L(0); PG8_MMA(0, 0, At, B0); PG8_BAR; PG8_SCHED;
            PG8_LDB(B1, 1, 1); PG8_STAGE(PG8_SB(1, 0), b3, voffB);
            PG8_BAR; PG8_WAIT_L(0); PG8_MMA(0, 1, At, B1); PG8_BAR;
            PG8_LDA(At, 1, 1); PG8_STAGE(PG8_SA(1, 0), a3, voffA);
            PG8_BAR; PG8_WAIT_L(0); PG8_MMA(1, 0, At, B0); PG8_BAR; PG8_SCHED;
            PG8_STAGE(PG8_SB(1, 1), b3 + hstep, voffB);
            PG8_WAIT_V(6); PG8_BAR; PG8_MMA(1, 1, At, B1); PG8_BAR;
            }
        }
        if constexpr (ALIGN_EPI) { if (wr == 0) PG8_BAR; }
        if constexpr (!Epi::AFTER_DRAIN) { E(acc, cur, wr, wc, fr, fq, lds + STAGE_BYTES + (ui & 1) * 2048); S.done(cur); }
        if (!has_next) break;
#pragma unroll
        for (int a = 0; a < 2; ++a)
#pragma unroll
            for (int b = 0; b < 2; ++b)
#pragma unroll
                for (int m = 0; m < 4; ++m)
#pragma unroll
                    for (int n = 0; n < 2; ++n) acc[a][b][m][n] = (f32x4){0.f, 0.f, 0.f, 0.f};
        cur = nxt; cA = nA; cB = nB; ++ui;
        if constexpr (ALIGN_EPI) { if (wr == 1) PG8_BAR; }
    }
    PG8_WAIT_V(0);
    if constexpr (!ALIGN_EPI) { if (wr == 0) PG8_BAR; }
    PG8_BAR;
    if constexpr (Epi::AFTER_DRAIN) { E.fused(acc, cur, wr, wc, fr, fq, lds, wid, lane); S.done(cur); }
#undef PG8_SA
#undef PG8_SB
#undef PG8_STAGE
#undef PG8_LDA
#undef PG8_LDB
#undef PG8_MMA
#undef PG8_WAIT_V
#undef PG8_WAIT_L
#undef PG8_BAR
#undef PG8_SCHED
}
}
constexpr int NWAVES = 8, NTHR = 512;
constexpr size_t MiB = 1u << 20;
constexpr size_t WS_CTL = 0, CTL_ZERO_BYTES = 2 * MiB;
constexpr size_t WS_MODS = 256 * 1024;
constexpr size_t WS_STAT = 768 * 1024;
constexpr size_t WS_SW = 1 * MiB + 64 * 1024, WS_GT = 374 * MiB;
static_assert(WS_SW + 8 * 5 * 5632 * 4 <= 2 * MiB, "shift @ W rows inside the zeroed region");
constexpr size_t WS_ROPE = 1 * MiB;
constexpr size_t WS_W = 2 * MiB;
constexpr size_t W_MLA = WS_W, MLA_WB = 5898240;
constexpr size_t MW_CAT = 0, MW_UQ = 1572864, MW_UKV = 2752512, MW_O = 3801088;
constexpr size_t W_CV1 = WS_W + 2 * MLA_WB, W_CV2 = W_CV1 + 4 * MiB;
constexpr size_t W_SSI = W_CV2 + 2 * MiB, W_SSO = W_SSI + 11010048;
constexpr size_t W_FF = W_SSO + 4 * MiB, FF_WB = 17301504, FW_IN = 0, FW_OUT = 11534336;
static_assert(W_FF + 4 * FF_WB <= 102 * MiB, "weights region");
constexpr size_t WS_H = 102 * MiB;
constexpr size_t WS_CKV = 118 * MiB, CKV_B = (size_t)(T + NCTX) * KVL * 2;
constexpr size_t WS_AR = 128 * MiB;
constexpr size_t A_LAT = WS_AR, A_QN = A_LAT + 24 * MiB, A_QRAW = A_QN + 6 * MiB, A_KVRAW = A_QRAW + 24 * MiB, A_QB = A_KVRAW + 36 * MiB, A_KB = A_QB + 24 * MiB, A_AO = A_KB + 27 * MiB;
constexpr size_t A_U = WS_AR, A_V = A_U + 16 * MiB;
constexpr size_t A_Z = WS_AR, A_XPRE = A_Z + 32 * MiB, A_DTRAW = A_XPRE + 48 * MiB, A_XBC = A_DTRAW + 2 * MiB, A_DT = A_XBC + 48 * MiB, A_Y = A_DT + 2 * MiB, A_YN = A_XPRE, A_ACUM = A_Y + 64 * MiB;
constexpr size_t A_ACT = WS_AR + 200 * MiB;
static_assert(A_AO + 16 * MiB <= A_ACT && A_ACUM + 2 * MiB <= A_ACT && A_ACT + 44 * MiB <= 384 * MiB, "arena map");
constexpr int CW_BAR = 4096;
constexpr int LDS_BYTES = 163840, RING_BYTES = 131072, MISC_OFF = 163840 - 256, PTAB_OFF_C = MISC_OFF - 512;

#define GAS __attribute__((address_space(1)))
#define LAS __attribute__((address_space(3)))
typedef unsigned short bf16;
typedef unsigned v4u __attribute__((ext_vector_type(4)));
typedef unsigned v2u __attribute__((ext_vector_type(2)));
typedef float v4f __attribute__((ext_vector_type(4)));
typedef float v2f __attribute__((ext_vector_type(2)));
typedef GAS unsigned gu32;
#define LDS_WAIT() asm volatile("s_waitcnt lgkmcnt(0)" ::: "memory")
#define LDS_BARRIER() do { asm volatile("s_waitcnt lgkmcnt(0)" ::: "memory"); __builtin_amdgcn_s_barrier(); asm volatile("" ::: "memory"); } while (0)
#define VM_WAIT() asm volatile("s_waitcnt vmcnt(0)" ::: "memory")
__device__ __forceinline__ unsigned f2bf(float f) { unsigned u = __builtin_bit_cast(unsigned, f); return (u + 0x7fffu + ((u >> 16) & 1u)) >> 16; }
__device__ __forceinline__ unsigned pk2(float lo, float hi) { unsigned r; asm("v_cvt_pk_bf16_f32 %0, %1, %2" : "=v"(r) : "v"(lo), "v"(hi)); return r; }
__device__ __forceinline__ float fast_sig(float x) { return __builtin_amdgcn_rcpf(1.f + __builtin_amdgcn_exp2f(-1.4426950408889634f * x)); }
__device__ __forceinline__ float bflo(unsigned u) { return __builtin_bit_cast(float, u << 16); }
__device__ __forceinline__ float bfhi(unsigned u) { return __builtin_bit_cast(float, u & 0xffff0000u); }
__device__ __forceinline__ float bf2f(bf16 b) { return __builtin_bit_cast(float, (unsigned)b << 16); }

#define XB_TMO      128
#define XB_XCNT(j)  (256  + 64 * (j))
#define XB_XSUB(j)  (1280 + 64 * (j))
#define XB_XGEN(j)  (2304 + 64 * (j))
#define XB_TOP      3328
#define XB_TOPGEN   3392
#define XCD_BAR_WORDS 3456
#define XB_SPIN_CAP (1u << 18)

__device__ __forceinline__ unsigned xb_ld(unsigned* p)              { return __hip_atomic_load(p, __ATOMIC_RELAXED, __HIP_MEMORY_SCOPE_AGENT); }
__device__ __forceinline__ unsigned xb_add(unsigned* p, unsigned v) { return __hip_atomic_fetch_add(p, v, __ATOMIC_RELAXED, __HIP_MEMORY_SCOPE_AGENT); }
__device__ __forceinline__ unsigned xb_xcc_id() { return (unsigned)__builtin_amdgcn_s_getreg((3 << 11) | 20) & 0xFu; }
#define XB_SPIN(cond, bar) do { unsigned _sp = 0; while (cond) { __builtin_amdgcn_s_sleep(1); \
    if ((++_sp & 255u) == 0u) { if (xb_ld(&(bar)[XB_TMO])) break; if (_sp > XB_SPIN_CAP) { atomicAdd(&(bar)[XB_TMO], 1u); break; } } } } while (0)

struct XcdBarrier {
    unsigned* bar; unsigned x;
    volatile LAS unsigned* st;
};

__device__ __forceinline__ XcdBarrier xcd_barrier_post(unsigned* bar, volatile LAS unsigned* st) {
    XcdBarrier b; b.bar = bar; b.x = xb_xcc_id(); b.st = st;
    if (threadIdx.x == 0) (void)xb_add(&bar[XB_XCNT(b.x)], 1u);
    return b;
}
__device__ __forceinline__ void xcd_barrier_complete(unsigned* bar, unsigned x, unsigned& nloc, unsigned& nx) {
    const unsigned G = gridDim.x * gridDim.y * gridDim.z;
    unsigned sum, cnt, mine, sp = 0u;
    for (;;) {
        sum = 0u; cnt = 0u; mine = 0u;
#pragma unroll
        for (unsigned j = 0; j < 16; j += 8) {
            unsigned c[8]; const unsigned* p = bar + XB_XCNT(j);
            asm volatile("global_load_dword %0, %8, off sc1\n\tglobal_load_dword %1, %8, off offset:256 sc1\n\tglobal_load_dword %2, %8, off offset:512 sc1\n\tglobal_load_dword %3, %8, off offset:768 sc1\n\t"
                         "global_load_dword %4, %8, off offset:1024 sc1\n\tglobal_load_dword %5, %8, off offset:1280 sc1\n\tglobal_load_dword %6, %8, off offset:1536 sc1\n\tglobal_load_dword %7, %8, off offset:1792 sc1\n\t"
                         "s_waitcnt vmcnt(0)"
                         : "=&v"(c[0]), "=&v"(c[1]), "=&v"(c[2]), "=&v"(c[3]), "=&v"(c[4]), "=&v"(c[5]), "=&v"(c[6]), "=&v"(c[7]) : "v"(p) : "memory");
#pragma unroll
            for (unsigned i = 0; i < 8; ++i) { sum += c[i]; cnt += (c[i] > 0u) ? 1u : 0u; mine = (j + i == x) ? c[i] : mine; } }
        if (sum == G) break;
        __builtin_amdgcn_s_sleep(1);
        if ((++sp & 255u) == 0u) { if (xb_ld(&bar[XB_TMO])) break; if (sp > XB_SPIN_CAP) { atomicAdd(&bar[XB_TMO], 1u); break; } }
    }
    nloc = mine > 0u ? mine : 1u; nx = cnt > 0u ? cnt : 1u;
}

__device__ __forceinline__ void xcd_barrier_protocol(const XcdBarrier& b) {
    {
        unsigned* bar = b.bar;
        __builtin_amdgcn_s_waitcnt(0);
        unsigned nloc = b.st[0], nx = b.st[1];
        if (nloc == 0u) { xcd_barrier_complete(bar, b.x, nloc, nx); b.st[0] = nloc; b.st[1] = nx; }
        const unsigned old = xb_add(&bar[XB_XSUB(b.x)], 1u);
        const unsigned gen = old / nloc;
        if (old + 1u == (gen + 1u) * nloc) {
            __builtin_amdgcn_fence(__ATOMIC_RELEASE, "agent");
            asm volatile("s_waitcnt vmcnt(0)" ::: "memory");
            const unsigned og = xb_add(&bar[XB_TOP], 1u);
            const unsigned tg = og / nx;
            if (og + 1u == (tg + 1u) * nx) xb_add(&bar[XB_TOPGEN], 1u);
            else XB_SPIN(xb_ld(&bar[XB_TOPGEN]) == tg, bar);
            __builtin_amdgcn_fence(__ATOMIC_ACQUIRE, "agent");
            xb_add(&bar[XB_XGEN(b.x)], 1u);
            asm volatile("s_waitcnt vmcnt(0)" ::: "memory");
        } else {
            XB_SPIN(xb_ld(&bar[XB_XGEN(b.x)]) == gen, bar);
            __builtin_amdgcn_fence(__ATOMIC_ACQUIRE, "agent");
            asm volatile("s_waitcnt vmcnt(0)" ::: "memory");
        }
    }
}
__device__ __forceinline__ void xcd_barrier(const XcdBarrier& b) {
    asm volatile("s_waitcnt vmcnt(0)" ::: "memory");
    __syncthreads();
    if (threadIdx.x == 0) xcd_barrier_protocol(b);
    __syncthreads();
}
struct Frame {
    LAS unsigned char* lds; int tid, lane, wave, vcu, G, gw, NGW, bx;
    volatile LAS unsigned* PT;
};
constexpr int PT_OUT = 38, PT_WS = 39;
__device__ __forceinline__ const float* ldp(volatile LAS unsigned* PT, int k) {
    const unsigned lo = __builtin_amdgcn_readfirstlane(PT[2 * k]), hi = __builtin_amdgcn_readfirstlane(PT[2 * k + 1]);
    return (const float*)(((unsigned long long)hi << 32) | lo);
}
#define INP(k) ldp(F.PT, (k))
#define WSP ((unsigned char*)ldp(F.PT, PT_WS))
#define OUTP ((float*)ldp(F.PT, PT_OUT))
enum InIdx { I_XP = 0, I_XS, I_CCKV, I_CKPE, I_SSM, I_C, I_CCTX, I_WADA, I_BADA, I_GN1, I_GN2, I_WDQ, I_GQ, I_WUQ, I_WDKV, I_GKV, I_WUKV, I_GQN, I_GKN, I_WO,
             I_CVW1, I_CVB1, I_CVWD, I_CVBD, I_CVGL, I_CVBL, I_CVW2, I_CVB2, I_SSWI, I_SSWC, I_SSBC, I_SSDTB, I_SSAL, I_SSD, I_SSGN, I_SSWO, I_FFWI, I_FFWO };
__device__ __forceinline__ float shx(float v, int lane, int o) { return __builtin_bit_cast(float, __builtin_amdgcn_ds_bpermute((lane ^ o) << 2, __builtin_bit_cast(int, v))); }
__device__ __forceinline__ float wsum(float v, int lane) {
#pragma unroll
    for (int o = 1; o < 64; o <<= 1) v += shx(v, lane, o);
    return v;
}
constexpr float QSCALE = 0.10206207261596577f * 1.4426950408889634f;

struct P0Item { const float* W; bf16* WT; int K, N, mode, H, roff, k0, n0; const float* sh; float* sw; };
__device__ __forceinline__ void p0_item_load(const P0Item& J, int lane, v4f (&t)[8]) {
#pragma unroll
    for (int i = 0; i < 8; ++i) t[i] = *(const GAS v4f*)(J.W + (size_t)(J.k0 + 8 * i + (lane >> 3)) * J.N + J.n0 + 4 * (lane & 7));
}
__device__ __forceinline__ void p0_item_shift(const P0Item& J, int lane, v4f (&sv)[5][2]) {
#pragma unroll
    for (int cc = 0; cc < 5; ++cc) { const float* sp = J.sh + (size_t)cc * 6144 + J.k0 + 8 * (lane & 7); sv[cc][0] = *(const GAS v4f*)sp; sv[cc][1] = *(const GAS v4f*)(sp + 4); }
}
__device__ __forceinline__ void p0_item_finish(const P0Item& J, int lane, const v4f (&t)[8], LAS float* scr, const v4f (&sv)[5][2]) {
#pragma unroll
    for (int i = 0; i < 8; ++i) { LAS float* d = scr + (8 * i + (lane >> 3)) * 33 + 4 * (lane & 7); d[0] = t[i].x; d[1] = t[i].y; d[2] = t[i].z; d[3] = t[i].w; }
    LDS_WAIT(); asm volatile("" ::: "memory");
    const int c = lane & 7;
#pragma unroll
    for (int j = 0; j < 4; ++j) { const int n = (lane >> 3) + 8 * j, col = J.n0 + n; const LAS float* s = scr + (8 * c) * 33 + n;
        int drow;
        if (J.mode == 0) drow = J.roff + col;
        else { const int f = col < J.H ? col : col - J.H; drow = 256 * (f >> 7) + 128 * ((f >> 2) & 1) + 32 * ((f >> 5) & 3) + (col < J.H ? 0 : 16) + 4 * ((f >> 3) & 3) + (f & 3); }
        v4u o; o.x = pk2(s[0 * 33], s[1 * 33]); o.y = pk2(s[2 * 33], s[3 * 33]); o.z = pk2(s[4 * 33], s[5 * 33]); o.w = pk2(s[6 * 33], s[7 * 33]);
        *(GAS v4u*)(J.WT + (size_t)drow * J.K + J.k0 + 8 * c) = o; }
    if (J.sw) {
        float pw[4][5];
#pragma unroll
        for (int cc = 0; cc < 5; ++cc) { const v4f s0 = sv[cc][0], s1 = sv[cc][1];
#pragma unroll
            for (int j = 0; j < 4; ++j) { const LAS float* q = scr + (8 * c) * 33 + (lane >> 3) + 8 * j;
                pw[j][cc] = (s0.x * q[0 * 33] + s0.y * q[1 * 33] + s0.z * q[2 * 33] + s0.w * q[3 * 33]) + (s1.x * q[4 * 33] + s1.y * q[5 * 33] + s1.z * q[6 * 33] + s1.w * q[7 * 33]); } }
#pragma unroll
        for (int o = 1; o < 8; o <<= 1) {
#pragma unroll
            for (int j = 0; j < 4; ++j)
#pragma unroll
                for (int cc = 0; cc < 5; ++cc) pw[j][cc] += shx(pw[j][cc], lane, o); }
        if (c == 0) {
#pragma unroll
            for (int j = 0; j < 4; ++j) { const int col = J.n0 + (lane >> 3) + 8 * j; int drow;
                if (J.mode == 0) drow = J.roff + col;
                else { const int f = col < J.H ? col : col - J.H; drow = 256 * (f >> 7) + 128 * ((f >> 2) & 1) + 32 * ((f >> 5) & 3) + (col < J.H ? 0 : 16) + 4 * ((f >> 3) & 3) + (f & 3); }
#pragma unroll
                for (int cc = 0; cc < 5; ++cc) atomicAdd(J.sw + (size_t)cc * pg8::SW_LD + drow, pw[j][cc]); } }
    }
    LDS_WAIT(); asm volatile("" ::: "memory");
}
__device__ __forceinline__ void p0_job(int q, int& inp, size_t& soff, int& K, int& N, size_t& doff, int& mode, int& H, int& roff) {
    mode = 0; H = 0; roff = 0; soff = 0;
    if (q < 10) { const int j = q / 5, t = q % 5; const size_t wb = W_MLA + (size_t)j * MLA_WB;
        if (t == 0) { inp = I_WDQ; soff = (size_t)j * 1024 * 384; K = 1024; N = 384; doff = wb + MW_CAT; }
        else if (t == 1) { inp = I_WDKV; soff = (size_t)j * 1024 * 288; K = 1024; N = 288; doff = wb + MW_CAT; roff = 384; }
        else if (t == 2) { inp = I_WUQ; soff = (size_t)j * 384 * 1536; K = 384; N = 1536; doff = wb + MW_UQ; }
        else if (t == 3) { inp = I_WUKV; soff = (size_t)j * 256 * 2048; K = 256; N = 2048; doff = wb + MW_UKV; }
        else { inp = I_WO; soff = (size_t)j * 1024 * 1024; K = 1024; N = 1024; doff = wb + MW_O; } }
    else if (q == 10) { inp = I_CVW1; K = 1024; N = 2048; doff = W_CV1; mode = 1; H = 1024; }
    else if (q == 11) { inp = I_CVW2; K = 1024; N = 1024; doff = W_CV2; }
    else if (q == 12) { inp = I_SSWI; K = 1024; N = 5184; doff = W_SSI; }
    else if (q == 13) { inp = I_SSWO; K = 2048; N = 1024; doff = W_SSO; }
    else { const int l = (q - 14) >> 1, t = (q - 14) & 1;
        if (t == 0) { inp = I_FFWI; soff = (size_t)l * 1024 * 5632; K = 1024; N = 5632; doff = W_FF + (size_t)l * FF_WB + FW_IN; mode = 1; H = 2816; }
        else { inp = I_FFWO; soff = (size_t)l * 2816 * 1024; K = 2816; N = 1024; doff = W_FF + (size_t)l * FF_WB + FW_OUT; } }
}
__device__ __forceinline__ int p0_sw_of_job(int q) { return q == 10 ? 2 : q == 12 ? 4 : (q == 5 || q == 6) ? 6 : (q >= 16 && !((q - 14) & 1)) ? 2 * ((q - 14) >> 1) + 1 : -1; }
constexpr int P0_NITEMS = 2 * ((1024 / 64) * (384 / 32) + (1024 / 64) * (288 / 32) + (384 / 64) * (1536 / 32) + (256 / 64) * (2048 / 32) + (1024 / 64) * (1024 / 32))
                        + (1024 / 64) * (2048 / 32) + (1024 / 64) * (1024 / 32) + (1024 / 64) * (5184 / 32) + (2048 / 64) * (1024 / 32)
                        + 4 * ((1024 / 64) * (5632 / 32) + (2816 / 64) * (1024 / 32));
__device__ __forceinline__ void p0_convert(Frame& F, unsigned qmask, int ww, int nww, bool fuse) {
    unsigned char* ws = WSP;
    LAS float* scr = (LAS float*)(F.lds + F.wave * 8448);
    int total = 0;
#pragma unroll 1
    for (int q = 0; q < 22; ++q) if ((qmask >> q) & 1u) { int inp, K, N, mode, H, roff; size_t soff, doff; p0_job(q, inp, soff, K, N, doff, mode, H, roff); total += (K / 64) * (N / 32); }
    for (int it = ww; it < total; it += 2 * nww) {
        P0Item J[2]; bool have1 = it + nww < total;
#pragma unroll
        for (int e = 0; e < 2; ++e) {
            int r = e == 0 ? it : (have1 ? it + nww : it), inp = 0, K = 64, N = 32, mode = 0, H = 0, roff = 0, qq = 0; size_t soff = 0, doff = 0;
#pragma unroll 1
            for (int q = 0; q < 22; ++q) { if (!((qmask >> q) & 1u)) continue; p0_job(q, inp, soff, K, N, doff, mode, H, roff); qq = q; const int ni = (K / 64) * (N / 32); if (r < ni) break; r -= ni; }
            const int nblk = N / 32;
            J[e].W = INP(inp) + soff; J[e].WT = (bf16*)(ws + doff); J[e].K = K; J[e].N = N; J[e].mode = mode; J[e].H = H; J[e].roff = roff; J[e].k0 = 64 * (r / nblk); J[e].n0 = 32 * (r % nblk);
            const int sidx = fuse ? p0_sw_of_job(qq) : -1;
            J[e].sh = nullptr; J[e].sw = nullptr;
            if (sidx >= 0) { J[e].sh = (const float*)(ws + WS_MODS) + (size_t)(sidx >> 1) * 5 * 6144 + ((sidx & 1) ? 3072 : 0); J[e].sw = (float*)(ws + WS_SW) + (size_t)sidx * 5 * pg8::SW_LD; }
        }
        v4f t0[8], t1[8];
        p0_item_load(J[0], F.lane, t0); p0_item_load(J[1], F.lane, t1);
        v4f sv0[5][2], sv1[5][2];
#pragma unroll
        for (int cc = 0; cc < 5; ++cc) { sv0[cc][0] = sv0[cc][1] = sv1[cc][0] = sv1[cc][1] = (v4f){0.f, 0.f, 0.f, 0.f}; }
        if (J[0].sw) p0_item_shift(J[0], F.lane, sv0);
        if (J[1].sw) p0_item_shift(J[1], F.lane, sv1);
        p0_item_finish(J[0], F.lane, t0, scr, sv0);
        if (have1) p0_item_finish(J[1], F.lane, t1, scr, sv1);
    }
}
constexpr unsigned P0_Q_NOW = 0x1fu | (1u << 14);
constexpr int P0_WIN_LAST = 12;
__device__ __forceinline__ int p0_def_job(int i) { return i == 0 ? 15 : i == 1 ? 10 : i == 2 ? 11 : i == 3 ? 16 : i == 4 ? 17 : i == 5 ? 12 : i == 6 ? 13 : i == 7 ? 18 : i == 8 ? 19 : i < 14 ? i - 4 : i == 14 ? 20 : 21; }
constexpr int P0_WIN_CAP = 1792;
static_assert(P0_WIN_CAP * P0_WIN_LAST >= 20624, "deferred items fit the windows");
__device__ __forceinline__ bool p0_def_item(Frame& F, int r, P0Item& J) {
    unsigned char* ws = WSP;
    int inp = 0, K = 64, N = 32, mode = 0, H = 0, roff = 0, qq = 0; size_t soff = 0, doff = 0; bool found = false;
#pragma unroll 1
    for (int i = 0; i < 16; ++i) { qq = p0_def_job(i); p0_job(qq, inp, soff, K, N, doff, mode, H, roff); const int ni = (K / 64) * (N / 32); if (r < ni) { found = true; break; } r -= ni; }
    if (!found) return false;
    const int nblk = N / 32;
    J.W = INP(inp) + soff; J.WT = (bf16*)(ws + doff); J.K = K; J.N = N; J.mode = mode; J.H = H; J.roff = roff; J.k0 = 64 * (r / nblk); J.n0 = 32 * (r % nblk);
    const int sidx = p0_sw_of_job(qq); J.sh = nullptr; J.sw = nullptr;
    if (sidx >= 0) { J.sh = (const float*)(ws + WS_MODS) + (size_t)(sidx >> 1) * 5 * 6144 + ((sidx & 1) ? 3072 : 0); J.sw = (float*)(ws + WS_SW) + (size_t)sidx * 5 * pg8::SW_LD; }
    return true;
}
constexpr int P0_DUMP = 161792;
static_assert(P0_DUMP + 1024 <= PTAB_OFF_C, "prefetch dump area");
__device__ __forceinline__ void p0_window(Frame& F, int w) {
    for (int e = F.bx * (NWAVES - 1) + (F.wave - 1); e < P0_WIN_CAP; e += F.G * (NWAVES - 1)) {
        P0Item J;
        if (!p0_def_item(F, (w - 1) * P0_WIN_CAP + e, J)) return;
        v4f t0[8], sv[5][2];
        p0_item_load(J, F.lane, t0);
#pragma unroll
        for (int cc = 0; cc < 5; ++cc) { sv[cc][0] = sv[cc][1] = (v4f){0.f, 0.f, 0.f, 0.f}; }
        if (J.sw) p0_item_shift(J, F.lane, sv);
        p0_item_finish(J, F.lane, t0, (LAS float*)(F.lds + F.wave * 8448), sv);
    }
}
__device__ __forceinline__ void xcd_barrier_work(const XcdBarrier& b, Frame& F, int w) {
    asm volatile("s_waitcnt vmcnt(0)" ::: "memory");
    __syncthreads();
    if (threadIdx.x == 0) xcd_barrier_protocol(b);
    if (F.wave != 0 && w >= 1 && w <= P0_WIN_LAST) p0_window(F, w);
    __syncthreads();
}
__device__ __forceinline__ void p0_prologue(Frame& F) {
    unsigned char* ws = WSP;
    LAS float* s = (LAS float*)F.lds;
    for (int i = F.tid; i < 5 * 1024; i += NTHR) { const int cc = i >> 10, k = i & 1023; const float v = cc == 0 ? INP(I_CCTX)[k] : INP(I_C)[(cc - 1) * 1024 + k]; s[i] = v / (1.f + expf(-v)); }
    __syncthreads();
    float* mods = (float*)(ws + WS_MODS);
    for (int it = F.bx; it < 192; it += F.G) {
        const int l = it / 48, r = it % 48, cb = r / 16, ks = r % 16, n = cb * 2048 + 4 * F.tid;
        const float* W = INP(I_WADA) + (size_t)l * 1024 * 6144 + (size_t)(ks * 64) * 6144 + n;
        v4f acc[5];
#pragma unroll
        for (int cc = 0; cc < 5; ++cc) acc[cc] = (v4f){0.f, 0.f, 0.f, 0.f};
#pragma unroll 1
        for (int kb = 0; kb < 64; kb += 16) {
            v4f wv[16];
#pragma unroll
            for (int k = 0; k < 16; ++k) wv[k] = *(const GAS v4f*)(W + (size_t)(kb + k) * 6144);
#pragma unroll
            for (int k = 0; k < 16; ++k)
#pragma unroll
                for (int cc = 0; cc < 5; ++cc) acc[cc] += wv[k] * s[cc * 1024 + ks * 64 + kb + k];
        }
        LAS float* tbl = s + 5 * 1024;
        __syncthreads();
#pragma unroll
        for (int cc = 0; cc < 5; ++cc) *(LAS v4f*)(tbl + cc * 2048 + 4 * F.tid) = acc[cc];
        __syncthreads();
        const float* bp = INP(I_BADA) + l * 6144 + cb * 2048;
#pragma unroll
        for (int q = 0; q < 4; ++q) { const int col = q * 512 + F.tid; const float bb = ks == 0 ? bp[col] : 0.f;
#pragma unroll
            for (int cc = 0; cc < 5; ++cc) atomicAdd(&mods[((size_t)l * 5 + cc) * 6144 + cb * 2048 + col], tbl[cc * 2048 + col] + bb); }
    }
    __syncthreads();
    p0_convert(F, P0_Q_NOW, F.gw, F.NGW, false);
    for (int it = F.gw; it < 384; it += F.NGW) {
        bf16* rowp = it < 192 ? (bf16*)(ws + W_MLA + (it / 96) * MLA_WB + MW_CAT) + (size_t)(672 + it % 96) * 1024 : (bf16*)(ws + W_SSI) + (size_t)(5184 + it - 192) * 1024;
        const v4u z = {0u, 0u, 0u, 0u}; ((GAS v4u*)rowp)[F.lane] = z; ((GAS v4u*)rowp)[64 + F.lane] = z;
    }
    for (int it = F.gw; it < 2048; it += F.NGW) {
        const int j = it >> 10, rr = it & 1023, b = rr >> 8, sq = rr & 255;
        const v4f v = ((const GAS v4f*)(INP(I_CCKV) + (((size_t)b * 2 + j) * 256 + sq) * 256))[F.lane];
        v2u o; o.x = pk2(v.x, v.y); o.y = pk2(v.z, v.w);
        ((GAS v2u*)((bf16*)(ws + WS_CKV + j * CKV_B) + (size_t)(T + rr) * 256))[F.lane] = o;
    }
    if (F.bx == 0) for (int i = F.tid; i < 640; i += NTHR) { const int pos = i >> 3, fi = i & 7; const float p = (float)(pos < 16 ? pos : pos - 16);
        const float a = p * rope_inv(fi); float* tab = (float*)(ws + WS_ROPE); tab[2 * i] = cosf(a); tab[2 * i + 1] = sinf(a); }
}

__device__ __forceinline__ void rp_normmod(Frame& F, const float* xlo, const float* xhi, const float* g, const float* mods_l, int sh_off, int sc_off, bf16* h) {
    for (int base = F.gw; base < T; base += 4 * F.NGW) {
        v4f v[4][4]; float ss[4]; int rows[4];
#pragma unroll
        for (int k = 0; k < 4; ++k) { const int row = base + k * F.NGW; rows[k] = row < T ? row : base;
            const GAS v4f* xr = (const GAS v4f*)((rows[k] < TP ? xlo : xhi) + (size_t)rows[k] * 1024) + F.lane;
#pragma unroll
            for (int j = 0; j < 4; ++j) v[k][j] = xr[64 * j]; }
#pragma unroll
        for (int k = 0; k < 4; ++k) { float s = 0.f;
#pragma unroll
            for (int j = 0; j < 4; ++j) s += (v[k][j].x * v[k][j].x + v[k][j].y * v[k][j].y) + (v[k][j].z * v[k][j].z + v[k][j].w * v[k][j].w);
            ss[k] = s; }
#pragma unroll
        for (int o = 1; o < 64; o <<= 1) {
#pragma unroll
            for (int k = 0; k < 4; ++k) ss[k] += shx(ss[k], F.lane, o); }
#pragma unroll
        for (int j = 0; j < 4; ++j) { const int c = 4 * F.lane + 256 * j; const v4f g4 = *(const GAS v4f*)(g + c);
#pragma unroll
            for (int k = 0; k < 4; ++k) { const float r = rsqrtf(ss[k] * (1.f / 1024) + EPS); const float* m = mods_l + (size_t)cond_of_row(rows[k]) * 6144;
                const v4f sc = *(const GAS v4f*)(m + sc_off + c), sh = *(const GAS v4f*)(m + sh_off + c);
                const v4f o = v[k][j] * r * g4 * (sc + 1.f) + sh; v2u w; w.x = pk2(o.x, o.y); w.y = pk2(o.z, o.w);
                *(GAS v2u*)(h + (size_t)rows[k] * 1024 + c) = w; } }
    }
}
__device__ __forceinline__ void rp_mla_fin1(Frame& F, const float* lat, const float* gq, const float* gkv, bf16* qn, bf16* ckv, float* out, int j) {
    v2f gqv[3], gkvv[2];
#pragma unroll
    for (int i = 0; i < 3; ++i) gqv[i] = *(const GAS v2f*)(gq + 2 * F.lane + 128 * i);
#pragma unroll
    for (int i = 0; i < 2; ++i) gkvv[i] = *(const GAS v2f*)(gkv + 2 * F.lane + 128 * i);
    for (int base = F.gw; base < T; base += 4 * F.NGW) {
        v2f q[4][3], k[4][2]; float pe[4]; int rows[4];
#pragma unroll
        for (int b = 0; b < 4; ++b) { const int row = base + b * F.NGW; rows[b] = row < T ? row : base;
            const float* lr = lat + (size_t)rows[b] * 768;
#pragma unroll
            for (int i = 0; i < 3; ++i) q[b][i] = *(const GAS v2f*)(lr + 2 * F.lane + 128 * i);
#pragma unroll
            for (int i = 0; i < 2; ++i) k[b][i] = *(const GAS v2f*)(lr + 384 + 2 * F.lane + 128 * i);
            pe[b] = *(const GAS float*)(lr + 640 + (F.lane & 31)); }
        __builtin_amdgcn_sched_barrier(0);
#pragma unroll
        for (int b = 0; b < 4; ++b) { const int row = base + b * F.NGW; if (row >= T) break;
            float ss = 0.f;
#pragma unroll
            for (int i = 0; i < 3; ++i) ss += q[b][i].x * q[b][i].x + q[b][i].y * q[b][i].y;
            float r = __builtin_amdgcn_rsqf(wsum(ss, F.lane) * (1.f / 384) + EPS);
#pragma unroll
            for (int i = 0; i < 3; ++i) { const int c = 2 * F.lane + 128 * i; *(GAS unsigned*)(qn + (size_t)row * 384 + c) = pk2(q[b][i].x * r * gqv[i].x, q[b][i].y * r * gqv[i].y); }
            ss = 0.f;
#pragma unroll
            for (int i = 0; i < 2; ++i) ss += k[b][i].x * k[b][i].x + k[b][i].y * k[b][i].y;
            r = __builtin_amdgcn_rsqf(wsum(ss, F.lane) * (1.f / 256) + EPS);
#pragma unroll
            for (int i = 0; i < 2; ++i) { const int c = 2 * F.lane + 128 * i; const float c0 = k[b][i].x * r * gkvv[i].x, c1 = k[b][i].y * r * gkvv[i].y;
                *(GAS unsigned*)(ckv + (size_t)row * 256 + c) = pk2(c0, c1);
                if (row < TP) { v2f o; o.x = c0; o.y = c1; *(GAS v2f*)(out + OUT_CKV + (((size_t)(row >> 8) * 2 + j) * 256 + (row & 255)) * 256 + c) = o; } }
            if (row < TP && F.lane < 32) *(GAS float*)(out + OUT_KPE + (((size_t)(row >> 8) * 2 + j) * 256 + (row & 255)) * 32 + F.lane) = pe[b];
        }
    }
}
__device__ __forceinline__ void rope32_tab(float* pe, int t, const float* tab) {
    const v2f* tr = (const v2f*)tab + (t >> 6) * 8; const v2f* tc = (const v2f*)tab + (16 + (t & 63)) * 8;
#pragma unroll
    for (int i = 0; i < 8; ++i) {
        v2f cs = tr[i]; float x1 = pe[i], x2 = pe[i + 8]; pe[i] = x1 * cs.x - x2 * cs.y; pe[i + 8] = x2 * cs.x + x1 * cs.y;
        cs = tc[i]; x1 = pe[16 + i]; x2 = pe[24 + i]; pe[16 + i] = x1 * cs.x - x2 * cs.y; pe[24 + i] = x2 * cs.x + x1 * cs.y;
    }
}
struct RopeCS { v4f r[4], c[4]; };
__device__ __forceinline__ void rope_load(RopeCS& R, int t, const float* tab) {
    const float* tr = tab + (t >> 6) * 16; const float* tc = tab + (16 + (t & 63)) * 16;
#pragma unroll
    for (int i = 0; i < 4; ++i) { R.r[i] = *(const GAS v4f*)(tr + 4 * i); R.c[i] = *(const GAS v4f*)(tc + 4 * i); }
}
__device__ __forceinline__ void rope_apply(float* pe, const RopeCS& R) {
#pragma unroll
    for (int i = 0; i < 8; ++i) {
        float cx = (i & 1) ? R.r[i >> 1].z : R.r[i >> 1].x, sy = (i & 1) ? R.r[i >> 1].w : R.r[i >> 1].y; float x1 = pe[i], x2 = pe[i + 8]; pe[i] = x1 * cx - x2 * sy; pe[i + 8] = x2 * cx + x1 * sy;
        cx = (i & 1) ? R.c[i >> 1].z : R.c[i >> 1].x; sy = (i & 1) ? R.c[i >> 1].w : R.c[i >> 1].y; x1 = pe[16 + i]; x2 = pe[24 + i]; pe[16 + i] = x1 * cx - x2 * sy; pe[24 + i] = x2 * cx + x1 * sy;
    }
}
__device__ __forceinline__ void ld8(const bf16* p, float* d) { const v4u w = *(const GAS v4u*)p; d[0] = bflo(w.x); d[1] = bfhi(w.x); d[2] = bflo(w.y); d[3] = bfhi(w.y); d[4] = bflo(w.z); d[5] = bfhi(w.z); d[6] = bflo(w.w); d[7] = bfhi(w.w); }
__device__ __forceinline__ void up8(const v4u w, float* d) { d[0] = bflo(w.x); d[1] = bfhi(w.x); d[2] = bflo(w.y); d[3] = bfhi(w.y); d[4] = bflo(w.z); d[5] = bfhi(w.z); d[6] = bflo(w.w); d[7] = bfhi(w.w); }
__device__ __forceinline__ void st8(bf16* p, const float* d) { v4u w; w.x = pk2(d[0], d[1]); w.y = pk2(d[2], d[3]); w.z = pk2(d[4], d[5]); w.w = pk2(d[6], d[7]); *(GAS v4u*)p = w; }
__device__ __forceinline__ void rp_tables(Frame& F) {
    unsigned char* ws = WSP; const float* mods = (const float*)(ws + WS_MODS); float* GTb = (float*)(ws + WS_GT); float* SWb = (float*)(ws + WS_SW);
    for (int idx = F.bx * NTHR + F.tid; idx < 8 * 5 * 1024; idx += F.G * NTHR) {
        const int s = idx / 5120, r = idx % 5120, c = r >> 10, k = r & 1023, layer = s >> 1;
        const float g = (s & 1) ? INP(I_GN2)[layer * 1024 + k] : INP(I_GN1)[layer * 1024 + k];
        GTb[idx] = g * (1.f + mods[((size_t)layer * 5 + c) * 6144 + ((s & 1) ? 4096 : 1024) + k]);
    }
    constexpr int NR1 = 5632;
    for (int it = F.gw; it < NR1 / 4; it += F.NGW) {
        const int s = 1, n = 4 * it; const bf16* Wt = (const bf16*)(ws + W_FF + FW_IN);
        const int layer = s >> 1, shoff = (s & 1) ? 3072 : 0;
        v4u wr[4][2];
#pragma unroll
        for (int r = 0; r < 4; ++r) { wr[r][0] = *(const GAS v4u*)(Wt + (size_t)(n + r) * 1024 + 16 * F.lane); wr[r][1] = *(const GAS v4u*)(Wt + (size_t)(n + r) * 1024 + 16 * F.lane + 8); }
        float acc[4][5];
#pragma unroll
        for (int r = 0; r < 4; ++r)
#pragma unroll
            for (int c = 0; c < 5; ++c) acc[r][c] = 0.f;
#pragma unroll
        for (int c = 0; c < 5; ++c) { const float* sp = mods + ((size_t)layer * 5 + c) * 6144 + shoff + 16 * F.lane;
            const v4f s0 = *(const GAS v4f*)sp, s1 = *(const GAS v4f*)(sp + 4), s2 = *(const GAS v4f*)(sp + 8), s3 = *(const GAS v4f*)(sp + 12);
#pragma unroll
            for (int r = 0; r < 4; ++r) { const v4u a = wr[r][0], b2 = wr[r][1];
                acc[r][c] = (s0.x * bflo(a.x) + s0.y * bfhi(a.x) + s0.z * bflo(a.y) + s0.w * bfhi(a.y)) + (s1.x * bflo(a.z) + s1.y * bfhi(a.z) + s1.z * bflo(a.w) + s1.w * bfhi(a.w))
                          + (s2.x * bflo(b2.x) + s2.y * bfhi(b2.x) + s2.z * bflo(b2.y) + s2.w * bfhi(b2.y)) + (s3.x * bflo(b2.z) + s3.y * bfhi(b2.z) + s3.z * bflo(b2.w) + s3.w * bfhi(b2.w)); } }
#pragma unroll
        for (int o = 1; o < 64; o <<= 1) {
#pragma unroll
            for (int r = 0; r < 4; ++r)
#pragma unroll
                for (int c = 0; c < 5; ++c) acc[r][c] += shx(acc[r][c], F.lane, o); }
        if (F.lane < 20) { const int r = F.lane / 5, c = F.lane % 5; float v = 0.f;
#pragma unroll
            for (int rr = 0; rr < 4; ++rr)
#pragma unroll
                for (int cc = 0; cc < 5; ++cc) v = (rr == r && cc == c) ? acc[rr][cc] : v;
            SWb[((size_t)s * 5 + c) * 5632 + n + r] = v; }
    }
}
__device__ __forceinline__ void rp_mla_fin2(Frame& F, const bf16* qraw, const bf16* kvraw, const float* lat, const float* ckpe_j, const float* gqn, const float* gkn, const float* tab, bf16* Q, bf16* K) {
    for (int idx = F.bx * NTHR + F.tid; idx < T * 32; idx += F.G * NTHR) {
        const int row = idx >> 5, hd = (idx >> 1) & 15, hf = idx & 1; const bool latent = row >= TP; const int tl = (row - TP) & 1023;
        float v[48]; float ss = 0.f; RopeCS R; v4f gq[12];
#pragma unroll
        for (int i = 0; i < 6; ++i) ld8(qraw + (size_t)row * 1536 + hd * 96 + hf * 48 + 8 * i, v + 8 * i);
#pragma unroll
        for (int i = 0; i < 12; ++i) gq[i] = *(const GAS v4f*)(gqn + hf * 48 + 4 * i);
        if (latent && hf) rope_load(R, tl, tab);
#pragma unroll
        for (int d = 0; d < 48; ++d) ss += v[d] * v[d];
        ss += shx(ss, F.lane, 1);
        const float r = rsqrtf(ss * (1.f / 96) + EPS) * QSCALE;
#pragma unroll
        for (int d = 0; d < 48; ++d) v[d] = v[d] * r * gq[d >> 2][d & 3];
        if (latent && hf) rope_apply(v + 16, R);
#pragma unroll
        for (int i = 0; i < 6; ++i) st8(Q + ((size_t)row * 16 + hd) * 96 + hf * 48 + 8 * i, v + 8 * i);
    }
    asm volatile("" ::: "memory");
    for (int idx = F.bx * NTHR + F.tid; idx < (T + NCTX) * 32; idx += F.G * NTHR) {
        const int row = idx >> 5, hd = (idx >> 1) & 15, hf = idx & 1; const bool latent = row >= TP && row < T; const int tl = (row - TP) & 1023;
        float v[48]; float ss = 0.f; RopeCS R; v4f gk[12];
#pragma unroll
        for (int i = 0; i < 12; ++i) gk[i] = *(const GAS v4f*)(gkn + hf * 48 + 4 * i);
        if (latent && hf) rope_load(R, tl, tab);
        if (hf == 0) {
#pragma unroll
            for (int i = 0; i < 6; ++i) ld8(kvraw + (size_t)row * 2048 + hd * 128 + 8 * i, v + 8 * i);
        } else {
#pragma unroll
            for (int i = 0; i < 2; ++i) ld8(kvraw + (size_t)row * 2048 + hd * 128 + 48 + 8 * i, v + 8 * i);
            const float* kp = row < T ? lat + (size_t)row * 768 + 640 : ckpe_j + ((size_t)((row - T) >> 8) * 2 * 256 + ((row - T) & 255)) * 32;
#pragma unroll
            for (int i = 0; i < 8; ++i) { const v4f p4 = *(const GAS v4f*)(kp + 4 * i); v[16 + 4 * i] = p4.x; v[17 + 4 * i] = p4.y; v[18 + 4 * i] = p4.z; v[19 + 4 * i] = p4.w; }
        }
#pragma unroll
        for (int d = 0; d < 48; ++d) ss += v[d] * v[d];
        ss += shx(ss, F.lane, 1);
        const float r = rsqrtf(ss * (1.f / 96) + EPS);
#pragma unroll
        for (int d = 0; d < 48; ++d) v[d] = v[d] * r * gk[d >> 2][d & 3];
        if (latent && hf) rope_apply(v + 16, R);
#pragma unroll
        for (int i = 0; i < 6; ++i) st8(K + ((size_t)row * 16 + hd) * 96 + hf * 48 + 8 * i, v + 8 * i);
    }
}
__device__ __forceinline__ void rp_dwconv(Frame& F, const bf16* u, const float* wdw, const float* bdw, const float* gln, const float* bln, bf16* vout) {
    LAS float* red = (LAS float*)F.lds;
    const int c = 2 * F.tid;
    for (int it = F.vcu; it < T / 16; it += F.G) {
        const int row0 = 16 * it; int t0, L; row_pos(row0, t0, L);
        v2f w[31];
#pragma unroll
        for (int k = 0; k < 31; ++k) w[k] = *(const GAS v2f*)(wdw + k * 1024 + c);
        const v2f bb = *(const GAS v2f*)(bdw + c);
        unsigned pk[46];
#pragma unroll
        for (int rr = 0; rr < 46; ++rr) { const int tt = t0 - 15 + rr; const bool ok = tt >= 0 && tt < L;
            pk[rr] = *(const GAS unsigned*)(u + (size_t)(ok ? row0 - 15 + rr : row0) * 1024 + c); }
        __builtin_amdgcn_sched_barrier(0);
#pragma unroll
        for (int rr = 0; rr < 46; ++rr) { const int tt = t0 - 15 + rr; pk[rr] = (tt >= 0 && tt < L) ? pk[rr] : 0u; }
        v2f yy[16];
#pragma unroll
        for (int r = 0; r < 16; ++r) yy[r] = bb;
#pragma unroll
        for (int rr = 0; rr < 46; ++rr) {
            const v2f x = (v2f){bflo(pk[rr]), bfhi(pk[rr])};
#pragma unroll
            for (int r = 0; r < 16; ++r) { const int k = rr - r; if (k >= 0 && k < 31) yy[r] += x * w[k]; }
        }
        float y0[16], y1[16];
#pragma unroll
        for (int r = 0; r < 16; ++r) { y0[r] = yy[r].x; y1[r] = yy[r].y; }
        float s[16];
#pragma unroll
        for (int r = 0; r < 16; ++r) s[r] = y0[r] + y1[r];
#pragma unroll
        for (int o = 1; o < 64; o <<= 1) {
#pragma unroll
            for (int r = 0; r < 16; ++r) s[r] += shx(s[r], F.lane, o); }
        __syncthreads();
        if (F.lane < 16) { float v = s[0];
#pragma unroll
            for (int r = 1; r < 16; ++r) v = F.lane == r ? s[r] : v;
            red[F.wave * 16 + F.lane] = v; }
        __syncthreads();
        float mean[16];
#pragma unroll
        for (int r = 0; r < 16; ++r) { float m = 0.f;
#pragma unroll
            for (int wv = 0; wv < 8; ++wv) m += red[wv * 16 + r];
            mean[r] = m * (1.f / 1024); }
#pragma unroll
        for (int r = 0; r < 16; ++r) { y0[r] -= mean[r]; y1[r] -= mean[r]; s[r] = y0[r] * y0[r] + y1[r] * y1[r]; }
#pragma unroll
        for (int o = 1; o < 64; o <<= 1) {
#pragma unroll
            for (int r = 0; r < 16; ++r) s[r] += shx(s[r], F.lane, o); }
        __syncthreads();
        if (F.lane < 16) { float v = s[0];
#pragma unroll
            for (int r = 1; r < 16; ++r) v = F.lane == r ? s[r] : v;
            red[F.wave * 16 + F.lane] = v; }
        __syncthreads();
        const v2f gg = *(const GAS v2f*)(gln + c), bl = *(const GAS v2f*)(bln + c);
#pragma unroll
        for (int r = 0; r < 16; ++r) { float q = 0.f;
#pragma unroll
            for (int wv = 0; wv < 8; ++wv) q += red[wv * 16 + r];
            const float rs = rsqrtf(q * (1.f / 1024) + EPS);
            const float z0 = y0[r] * rs * gg.x + bl.x, z1 = y1[r] * rs * gg.y + bl.y;
            *(GAS unsigned*)(vout + (size_t)(row0 + r) * 1024 + c) = pk2(z0 * fast_sig(z0), z1 * fast_sig(z1)); }
    }
    __syncthreads();
}
__device__ __forceinline__ void rp_ssd_conv(Frame& F, const bf16* xpre, const float* dtraw, const float* wc, const float* bc, const float* dtb, const float* alog, bf16* xbc, float* dt, float* acum) {
    for (int idx = F.bx * NTHR + F.tid; idx < (T / 32) * 384; idx += F.G * NTHR) {
        const int seg = idx / 384, cg = idx - seg * 384, c0 = 8 * cg, row0 = 32 * seg; int t0, L; row_pos(row0, t0, L);
        v2f w2[5][4], b2[4];
#pragma unroll
        for (int k = 0; k < 5; ++k) { const v4f a = *(const GAS v4f*)(wc + k * 3072 + c0), b = *(const GAS v4f*)(wc + k * 3072 + c0 + 4);
            w2[k][0] = (v2f){a.x, a.y}; w2[k][1] = (v2f){a.z, a.w}; w2[k][2] = (v2f){b.x, b.y}; w2[k][3] = (v2f){b.z, b.w}; }
        { const v4f a = *(const GAS v4f*)(bc + c0), b = *(const GAS v4f*)(bc + c0 + 4); b2[0] = (v2f){a.x, a.y}; b2[1] = (v2f){a.z, a.w}; b2[2] = (v2f){b.x, b.y}; b2[3] = (v2f){b.z, b.w}; }
        const bf16* base = xpre + (size_t)row0 * 3072 + c0;
#define SSC_OK(j) ((t0 + (j)) >= 0 && (t0 + (j)) < L)
#define SSC_LD(j) (*(const GAS v4u*)(base + (ptrdiff_t)(SSC_OK(j) ? (j) : 0) * 3072))
        v4u carry[4], cur[8], nxt[8];
#pragma unroll
        for (int k = 0; k < 4; ++k) carry[k] = SSC_LD(k - 2);
#pragma unroll
        for (int k = 0; k < 8; ++k) cur[k] = SSC_LD(k + 2);
        __builtin_amdgcn_sched_barrier(0);
#pragma unroll
        for (int k = 0; k < 4; ++k) if (!SSC_OK(k - 2)) carry[k] = (v4u){0u, 0u, 0u, 0u};
#pragma unroll
        for (int k = 0; k < 8; ++k) if (!SSC_OK(k + 2)) cur[k] = (v4u){0u, 0u, 0u, 0u};
#pragma unroll
        for (int c = 0; c < 4; ++c) {
            if (c < 3) {
#pragma unroll
                for (int k = 0; k < 8; ++k) nxt[k] = SSC_LD(8 * c + 10 + k); }
            __builtin_amdgcn_sched_barrier(0);
            v2f acc[8][4];
#pragma unroll
            for (int o = 0; o < 8; ++o)
#pragma unroll
                for (int p2 = 0; p2 < 4; ++p2) acc[o][p2] = b2[p2];
#pragma unroll
            for (int q = 0; q < 12; ++q) { const v4u rw = q < 4 ? carry[q] : cur[q - 4];
                const v2f x0 = (v2f){bflo(rw.x), bfhi(rw.x)}, x1 = (v2f){bflo(rw.y), bfhi(rw.y)}, x2 = (v2f){bflo(rw.z), bfhi(rw.z)}, x3 = (v2f){bflo(rw.w), bfhi(rw.w)};
#pragma unroll
                for (int o = 0; o < 8; ++o) { const int k = q - o; if (k >= 0 && k < 5) { acc[o][0] += x0 * w2[k][0]; acc[o][1] += x1 * w2[k][1]; acc[o][2] += x2 * w2[k][2]; acc[o][3] += x3 * w2[k][3]; } } }
#pragma unroll
            for (int o = 0; o < 8; ++o) { v4u ow;
                { const v2f v = acc[o][0]; ow.x = pk2(v.x * fast_sig(v.x), v.y * fast_sig(v.y)); } { const v2f v = acc[o][1]; ow.y = pk2(v.x * fast_sig(v.x), v.y * fast_sig(v.y)); }
                { const v2f v = acc[o][2]; ow.z = pk2(v.x * fast_sig(v.x), v.y * fast_sig(v.y)); } { const v2f v = acc[o][3]; ow.w = pk2(v.x * fast_sig(v.x), v.y * fast_sig(v.y)); }
                *(GAS v4u*)(xbc + (size_t)(row0 + 8 * c + o) * 3072 + c0) = ow; }
#pragma unroll
            for (int k = 0; k < 4; ++k) carry[k] = cur[4 + k];
            if (c < 3) {
#pragma unroll
                for (int k = 0; k < 8; ++k) cur[k] = SSC_OK(8 * c + 10 + k) ? nxt[k] : (v4u){0u, 0u, 0u, 0u}; }
        }
#undef SSC_OK
#undef SSC_LD
    }
    for (int it = F.gw; it < 64 * 64; it += F.NGW) {
        const int ch = it >> 6, e = it & 63, dir = e >> 5, row0 = 128 * ch, lane = F.lane;
        const float aa = -expf(alog[e]), bb = dtb[e];
        const int i0 = dir == 0 ? lane : 127 - lane, i1 = dir == 0 ? lane + 64 : 63 - lane;
        const float d0 = softplus_f(dtraw[(size_t)(row0 + i0) * 64 + e] + bb), d1 = softplus_f(dtraw[(size_t)(row0 + i1) * 64 + e] + bb);
        float s0 = d0 * aa, s1 = d1 * aa;
#pragma unroll
        for (int o = 1; o < 64; o <<= 1) { const float u0 = __builtin_bit_cast(float, __builtin_amdgcn_ds_bpermute((lane - o) << 2, __builtin_bit_cast(int, s0))), u1 = __builtin_bit_cast(float, __builtin_amdgcn_ds_bpermute((lane - o) << 2, __builtin_bit_cast(int, s1)));
            if (lane >= o) { s0 += u0; s1 += u1; } }
        s1 += __builtin_bit_cast(float, __builtin_amdgcn_readlane(__builtin_bit_cast(int, s0), 63));
        dt[(size_t)(row0 + i0) * 64 + e] = d0; dt[(size_t)(row0 + i1) * 64 + e] = d1;
        acum[(size_t)(row0 + i0) * 64 + e] = s0; acum[(size_t)(row0 + i1) * 64 + e] = s1;
    }
}
__device__ __forceinline__ void rp_ssd_gate(Frame& F, const bf16* y, const bf16* z, const float* gn, bf16* yn) {
    v4f gv[4][2];
#pragma unroll
    for (int g = 0; g < 4; ++g) { gv[g][0] = *(const GAS v4f*)(gn + g * 512 + 8 * F.lane); gv[g][1] = *(const GAS v4f*)(gn + g * 512 + 8 * F.lane + 4); }
    v4u cz[4], ca[4], cb[4], nz[4], na[4], nb[4];
    int row = F.gw;
    if (row < T) {
#pragma unroll
        for (int g = 0; g < 4; ++g) { const size_t o = (size_t)row * 2048 + g * 512 + 8 * F.lane; cz[g] = *(const GAS v4u*)(z + o); ca[g] = *(const GAS v4u*)(y + o); cb[g] = *(const GAS v4u*)(y + (size_t)T * 2048 + o); } }
    for (; row < T; row += F.NGW) {
        const int nrow = row + F.NGW;
        if (nrow < T) {
#pragma unroll
            for (int g = 0; g < 4; ++g) { const size_t o = (size_t)nrow * 2048 + g * 512 + 8 * F.lane; nz[g] = *(const GAS v4u*)(z + o); na[g] = *(const GAS v4u*)(y + o); nb[g] = *(const GAS v4u*)(y + (size_t)T * 2048 + o); } }
        __builtin_amdgcn_sched_barrier(0);
#pragma unroll
        for (int g = 0; g < 4; ++g) { const int c0 = g * 512 + 8 * F.lane; float zz[8], v[8], yb[8];
            up8(cz[g], zz); up8(ca[g], v); up8(cb[g], yb);
            float ss = 0.f;
#pragma unroll
            for (int i = 0; i < 8; ++i) { v[i] = (v[i] + yb[i]) * zz[i] * fast_sig(zz[i]); ss += v[i] * v[i]; }
            const float r = __builtin_amdgcn_rsqf(wsum(ss, F.lane) * (1.f / 512) + EPS);
#pragma unroll
            for (int i = 0; i < 8; ++i) v[i] = v[i] * r * gv[g][i >> 2][i & 3];
            st8(yn + (size_t)row * 2048 + c0, v); }
#pragma unroll
        for (int g = 0; g < 4; ++g) { cz[g] = nz[g]; ca[g] = na[g]; cb[g] = nb[g]; }
    }
}

typedef short a_bf16x8 __attribute__((ext_vector_type(8)));
typedef short a_s16x4 __attribute__((ext_vector_type(4)));
typedef float a_f32x16 __attribute__((ext_vector_type(16)));
typedef float a_f32x2 __attribute__((ext_vector_type(2))); typedef __bf16 a_bf16x2 __attribute__((ext_vector_type(2)));
__device__ __forceinline__ unsigned a_cvtpk(float lo, float hi) { a_f32x2 v = {lo, hi}; a_bf16x2 b = __builtin_convertvector(v, a_bf16x2); return __builtin_bit_cast(unsigned, b); }
__device__ __forceinline__ a_s16x4 a_vtr(const LAS unsigned char* p) { return __builtin_bit_cast(a_s16x4, __builtin_amdgcn_ds_read_tr16_b64_v4i16((LAS a_s16x4*)p)); }
constexpr int AT_KS = 208, AT_VS = 192, AT_KB = 64 * AT_KS, AT_VB = 64 * AT_VS, AT_VOFF = 2 * AT_KB;
__device__ __forceinline__ void at_tile(Frame& F, LAS unsigned char* lds, int buf, int lane, const a_bf16x8 (&qf)[6], a_f32x16& o0, a_f32x16& o1, float& m, float& l) {
    const int r32 = lane & 31, hi = lane >> 5;
    a_f32x16 p0, p1;
#pragma unroll
    for (int r = 0; r < 16; ++r) { p0[r] = 0.f; p1[r] = 0.f; }
    { const LAS unsigned char* kp = lds + buf * AT_KB + r32 * AT_KS + hi * 16;
#pragma unroll
      for (int s = 0; s < 6; ++s) { const a_bf16x8 a0 = *(const LAS a_bf16x8*)(kp + 32 * s), a1 = *(const LAS a_bf16x8*)(kp + 32 * AT_KS + 32 * s);
          p0 = __builtin_amdgcn_mfma_f32_32x32x16_bf16(a0, qf[s], p0, 0, 0, 0); p1 = __builtin_amdgcn_mfma_f32_32x32x16_bf16(a1, qf[s], p1, 0, 0, 0); } }

    float mx = fmaxf(p0[0], p1[0]);
#pragma unroll
    for (int r = 1; r < 16; ++r) mx = fmaxf(mx, fmaxf(p0[r], p1[r]));
    mx = fmaxf(mx, shx(mx, lane, 32));
    const float mn = fmaxf(m, mx), alpha = __builtin_amdgcn_exp2f(m - mn); m = mn;
    float ps = 0.f;
#pragma unroll
    for (int r = 0; r < 16; ++r) { p0[r] = __builtin_amdgcn_exp2f(p0[r] - mn); p1[r] = __builtin_amdgcn_exp2f(p1[r] - mn); ps += p0[r] + p1[r]; }
    l = l * alpha + ps;
#pragma unroll
    for (int r = 0; r < 16; ++r) { o0[r] *= alpha; o1[r] *= alpha; }
    v4u pw[4];
    pw[0] = (v4u){a_cvtpk(p0[0], p0[1]), a_cvtpk(p0[2], p0[3]), a_cvtpk(p0[4], p0[5]), a_cvtpk(p0[6], p0[7])};
    pw[1] = (v4u){a_cvtpk(p0[8], p0[9]), a_cvtpk(p0[10], p0[11]), a_cvtpk(p0[12], p0[13]), a_cvtpk(p0[14], p0[15])};
    pw[2] = (v4u){a_cvtpk(p1[0], p1[1]), a_cvtpk(p1[2], p1[3]), a_cvtpk(p1[4], p1[5]), a_cvtpk(p1[6], p1[7])};
    pw[3] = (v4u){a_cvtpk(p1[8], p1[9]), a_cvtpk(p1[10], p1[11]), a_cvtpk(p1[12], p1[13]), a_cvtpk(p1[14], p1[15])};

    const LAS unsigned char* vp0 = lds + AT_VOFF + buf * AT_VB + (4 * hi + ((lane & 15) >> 2)) * AT_VS + (16 * ((lane >> 4) & 1) + 4 * (lane & 3)) * 2;
    a_s16x4 vl0[4], vh0[4], vl1[4], vh1[4];
#pragma unroll
    for (int bs = 0; bs < 4; ++bs) { const LAS unsigned char* vq = vp0 + (16 * bs) * AT_VS; vl0[bs] = a_vtr(vq); vh0[bs] = a_vtr(vq + 8 * AT_VS); vl1[bs] = a_vtr(vq + 64); vh1[bs] = a_vtr(vq + 8 * AT_VS + 64); }
#pragma unroll
    for (int bs = 0; bs < 4; ++bs) {
        const a_bf16x8 v0 = (a_bf16x8){vl0[bs][0], vl0[bs][1], vl0[bs][2], vl0[bs][3], vh0[bs][0], vh0[bs][1], vh0[bs][2], vh0[bs][3]}, v1 = (a_bf16x8){vl1[bs][0], vl1[bs][1], vl1[bs][2], vl1[bs][3], vh1[bs][0], vh1[bs][1], vh1[bs][2], vh1[bs][3]};
        const a_bf16x8 pb = __builtin_bit_cast(a_bf16x8, pw[bs]);
        o0 = __builtin_amdgcn_mfma_f32_32x32x16_bf16(v0, pb, o0, 0, 0, 0); o1 = __builtin_amdgcn_mfma_f32_32x32x16_bf16(v1, pb, o1, 0, 0, 0); }
}
__device__ __forceinline__ void ph_attn(Frame& F, const bf16* Q, const bf16* K, const bf16* KV, bf16* AO) {
    const int lane = F.lane, r32 = lane & 31, hi = lane >> 5, wave = F.wave, tid = F.tid;
    LAS unsigned char* lds = F.lds;
    const int kr_a = tid / 12, kp_a = tid % 12, kr_b = (tid + 512) / 12, kp_b = (tid + 512) % 12, vr = tid >> 3, vp = tid & 7;
    const bool has_b = tid < 256;
    for (int uu = F.vcu; uu < 512; uu += F.G) {
        int head, q0, NT, kbase_ctx, kbase_lat;
        if (uu < 256) { const int seq = uu >> 4; head = uu & 15; q0 = seq * 256; NT = 4; kbase_ctx = seq * 256; kbase_lat = 0; }
        else { const int u2 = uu - 256, b = u2 >> 6, qb = u2 & 3; head = (u2 >> 2) & 15; q0 = TP + b * 1024 + qb * 256; NT = 20; kbase_ctx = T + b * 256; kbase_lat = TP + b * 1024; }
        a_bf16x8 qf[6];
        { const bf16* qp = Q + ((size_t)(q0 + wave * 32 + r32) * 16 + head) * 96 + hi * 8;
#pragma unroll
          for (int s = 0; s < 6; ++s) qf[s] = *(const GAS a_bf16x8*)(qp + 16 * s); }
        a_f32x16 o0, o1;
#pragma unroll
        for (int r = 0; r < 16; ++r) { o0[r] = 0.f; o1[r] = 0.f; }
        float m = -INFINITY, l = 0.f;
        v4u ka0, kb0, vv0, ka1, kb1, vv1, ka2, kb2_, vv2;
#define AT_LOAD(t, KA, KB2, VV) do { const int kr0_ = (t) < 4 ? kbase_ctx + 64 * (t) : kbase_lat + 64 * ((t) - 4); \
            KA = *(const GAS v4u*)(K + ((size_t)(kr0_ + kr_a) * 16 + head) * 96 + kp_a * 8); \
            if (has_b) KB2 = *(const GAS v4u*)(K + ((size_t)(kr0_ + kr_b) * 16 + head) * 96 + kp_b * 8); \
            VV = *(const GAS v4u*)(KV + (size_t)(kr0_ + vr) * 2048 + head * 128 + 64 + vp * 8); } while (0)
#define AT_STORE(buf, KA, KB2, VV) do { *(LAS v4u*)(lds + (buf) * AT_KB + kr_a * AT_KS + kp_a * 16) = KA; \
            if (has_b) *(LAS v4u*)(lds + (buf) * AT_KB + kr_b * AT_KS + kp_b * 16) = KB2; \
            *(LAS v4u*)(lds + AT_VOFF + (buf) * AT_VB + vr * AT_VS + vp * 16) = VV; } while (0)
#define AT_STEP(k, SA, SB, SC, SD_, SE_, SF_, SG, SH, SI) if (t + (k) < NT) { \
            if (t + (k) + 3 < NT) AT_LOAD(t + (k) + 3, SA, SB, SC);            \
            at_tile(F, lds, (k) & 1, lane, qf, o0, o1, m, l); \
            if (t + (k) + 1 < NT) AT_STORE(((k) + 1) & 1, SD_, SE_, SF_);       \
            LDS_BARRIER(); }
        AT_LOAD(0, ka0, kb0, vv0); AT_LOAD(1, ka1, kb1, vv1); AT_LOAD(2, ka2, kb2_, vv2);
        AT_STORE(0, ka0, kb0, vv0);
        LDS_BARRIER();
#pragma unroll 1
        for (int t = 0; t < NT; t += 6) {
            AT_STEP(0, ka0, kb0, vv0, ka1, kb1, vv1, 0, 0, 0)
            AT_STEP(1, ka1, kb1, vv1, ka2, kb2_, vv2, 0, 0, 0)
            AT_STEP(2, ka2, kb2_, vv2, ka0, kb0, vv0, 0, 0, 0)
            AT_STEP(3, ka0, kb0, vv0, ka1, kb1, vv1, 0, 0, 0)
            AT_STEP(4, ka1, kb1, vv1, ka2, kb2_, vv2, 0, 0, 0)
            AT_STEP(5, ka2, kb2_, vv2, ka0, kb0, vv0, 0, 0, 0)
        }
#undef AT_STEP
#undef AT_LOAD
#undef AT_STORE
        l += shx(l, lane, 32);
        const float il = __builtin_amdgcn_rcpf(l);
        bf16* op = AO + (size_t)(q0 + wave * 32 + r32) * 1024 + head * 64 + 4 * hi;
#pragma unroll
        for (int g4 = 0; g4 < 4; ++g4) {
            v2u w0; w0.x = a_cvtpk(o0[4 * g4] * il, o0[4 * g4 + 1] * il); w0.y = a_cvtpk(o0[4 * g4 + 2] * il, o0[4 * g4 + 3] * il); *(GAS v2u*)(op + 8 * g4) = w0;
            v2u w1; w1.x = a_cvtpk(o1[4 * g4] * il, o1[4 * g4 + 1] * il); w1.y = a_cvtpk(o1[4 * g4 + 2] * il, o1[4 * g4 + 3] * il); *(GAS v2u*)(op + 32 + 8 * g4) = w1; }

    }
}
constexpr int SC_ST = 272, SC_XS = 144;
constexpr int SC_C = 0, SC_B = 128 * SC_ST, SC_M = 2 * 128 * SC_ST, SC_H = 3 * 128 * SC_ST, SC_X = SC_H + 64 * SC_ST, SC_XW = SC_X + 128 * SC_XS, SC_ARR = SC_XW + 128 * SC_XS;
static_assert(SC_ARR + 4 * 128 * 4 + 16 <= PTAB_OFF_C && SC_ARR + 4 * 128 * 4 + 16 <= P0_DUMP, "scan LDS map (the weight prefetch's dump area lies above it)");
__device__ __forceinline__ int a_crow(int r, int hi) { return (r & 3) + 8 * (r >> 2) + 4 * hi; }
__device__ __forceinline__ void ph_scan(Frame& F, const bf16* xbc, const float* dt, const float* acg, const float* dsk, const float* st0, bf16* y, float* out) {
    const int lane = F.lane, r32 = lane & 31, hi = lane >> 5, wave = F.wave, tid = F.tid;
    LAS unsigned char* lds = F.lds;
    LAS float* acum = (LAS float*)(lds + SC_ARR); LAS float* wj = acum + 128; LAS float* ei = acum + 256; LAS float* dtj = acum + 384; LAS float* misc = acum + 512;
    const int q4 = (lane & 15) >> 2, gg = (lane >> 4) & 1, p4 = lane & 3;
    const int ib = wave >> 1, pb = wave & 1, nb = wave >> 1;
    v4u cr[4], br[4], xr[2];
    float pdt[2], pac[2], plast, pac_t, pdt_t;
#define SC_GLOADP(rowb_, g_, hd_, dir_) do { const int row0_ = (rowb_); \
        _Pragma("unroll") for (int k = 0; k < 4; ++k) { const int q = tid + 512 * k, rr = q >> 4, pp = q & 15; \
            cr[k] = *(const GAS v4u*)(xbc + (size_t)(row0_ + rr) * 3072 + 2560 + (g_) * 128 + pp * 8); br[k] = *(const GAS v4u*)(xbc + (size_t)(row0_ + rr) * 3072 + 2048 + (g_) * 128 + pp * 8); } \
        _Pragma("unroll") for (int k = 0; k < 2; ++k) { const int q = tid + 512 * k, rr = q >> 3, pp = q & 7; xr[k] = *(const GAS v4u*)(xbc + (size_t)(row0_ + rr) * 3072 + (hd_) * 64 + pp * 8); \
            pdt[k] = dt[(size_t)(row0_ + rr) * 64 + (dir_) * 32 + (hd_)]; pac[k] = acg[(size_t)(row0_ + rr) * 64 + (dir_) * 32 + (hd_)]; } \
        plast = acg[(size_t)(row0_ + ((dir_) == 0 ? 127 : 0)) * 64 + (dir_) * 32 + (hd_)]; \
        pac_t = acg[(size_t)(row0_ + (tid & 127)) * 64 + (dir_) * 32 + (hd_)]; pdt_t = dt[(size_t)(row0_ + (tid & 127)) * 64 + (dir_) * 32 + (hd_)]; } while (0)
#define SC_ITEM(slot_, ii_, seq_, hd_) do { if ((slot_) < 128) { seq_ = 16 + ((slot_) >> 5); hd_ = (slot_) & 31; } else { const int pi_ = 4 * ((slot_) - 128) + (ii_); seq_ = pi_ >> 5; hd_ = pi_ & 31; } } while (0)
    for (int slot = F.vcu; slot < 256; slot += F.G) {
        const int nitem = slot < 128 ? 1 : 4;
        { int seq0, hd0; SC_ITEM(slot, 0, seq0, hd0); SC_GLOADP(seq0 < 16 ? seq0 * 256 : TP + (seq0 - 16) * 1024, hd0 >> 3, hd0, 0); }
#pragma unroll 1
        for (int ii = 0; ii < nitem; ++ii) {
            int seq, hd;
            if (slot < 128) { seq = 16 + (slot >> 5); hd = slot & 31; } else { const int pi = 4 * (slot - 128) + ii; seq = pi >> 5; hd = pi & 31; }
            const int g = hd >> 3, r0 = seq < 16 ? seq * 256 : TP + (seq - 16) * 1024, nc = seq < 16 ? 2 : 8;
#pragma unroll 1
            for (int dir = 0; dir < 2; ++dir) {
                const float dd = dsk[dir * 32 + hd];
                a_f32x16 hacc;
                if (seq < 16) {
#pragma unroll
                    for (int r = 0; r < 16; ++r) hacc[r] = 0.f;
                } else { const float* s0 = st0 + ((((size_t)(seq - 16) * 2 + dir) * 32 + hd) * 64 + 32 * pb + r32) * 128 + 32 * nb + 4 * hi;
#pragma unroll
                    for (int g4 = 0; g4 < 4; ++g4) { const v4f t4 = *(const GAS v4f*)(s0 + 8 * g4); hacc[4 * g4] = t4.x; hacc[4 * g4 + 1] = t4.y; hacc[4 * g4 + 2] = t4.z; hacc[4 * g4 + 3] = t4.w; } }
#pragma unroll
                for (int g4 = 0; g4 < 4; ++g4) { v2u w; w.x = a_cvtpk(hacc[4 * g4], hacc[4 * g4 + 1]); w.y = a_cvtpk(hacc[4 * g4 + 2], hacc[4 * g4 + 3]);
                    *(LAS v2u*)(lds + SC_H + (32 * pb + r32) * SC_ST + (32 * nb + 8 * g4 + 4 * hi) * 2) = w; }
#pragma unroll 1
                for (int cc = 0; cc < nc; ++cc) {
                    const int c = dir == 0 ? cc : nc - 1 - cc, row0 = r0 + c * 128;
                    const int e = dir * 32 + hd;
                    const float last = plast;
                    LDS_BARRIER();
                    if (tid < 128) { const float ac = pac_t, dv = pdt_t;
                        acum[tid] = ac; dtj[tid] = dv; ei[tid] = __expf(ac); if (tid == 0) misc[0] = __expf(last); }
#pragma unroll
                    for (int k = 0; k < 4; ++k) { const int q = tid + 512 * k, rr = q >> 4, pp = q & 15; *(LAS v4u*)(lds + SC_C + rr * SC_ST + pp * 16) = cr[k]; *(LAS v4u*)(lds + SC_B + rr * SC_ST + pp * 16) = br[k]; }
#pragma unroll
                    for (int k = 0; k < 2; ++k) { const int q = tid + 512 * k, rr = q >> 3, pp = q & 7; *(LAS v4u*)(lds + SC_X + rr * SC_XS + pp * 16) = xr[k];
                        const float w = pdt[k] * __expf(last - pac[k]);
                        v4u s; s.x = a_cvtpk(bflo(xr[k].x) * w, bfhi(xr[k].x) * w); s.y = a_cvtpk(bflo(xr[k].y) * w, bfhi(xr[k].y) * w); s.z = a_cvtpk(bflo(xr[k].z) * w, bfhi(xr[k].z) * w); s.w = a_cvtpk(bflo(xr[k].w) * w, bfhi(xr[k].w) * w);
                        *(LAS v4u*)(lds + SC_XW + rr * SC_XS + pp * 16) = s; }
                    { int nrow = 0, nhd = hd, ndir = dir; bool hn = true;
                      if (cc + 1 < nc) nrow = r0 + (dir == 0 ? cc + 1 : nc - 2 - cc) * 128;
                      else if (dir == 0) { nrow = r0 + (nc - 1) * 128; ndir = 1; }
                      else if (ii + 1 < nitem) { int seqn; SC_ITEM(slot, ii + 1, seqn, nhd); nrow = seqn < 16 ? seqn * 256 : TP + (seqn - 16) * 1024; ndir = 0; }
                      else hn = false;
                      if (hn) SC_GLOADP(nrow, nhd >> 3, nhd, ndir); }
                    LDS_BARRIER();
                    {
                        const int lt = wave;
                        const int ta = lt < 4 ? 0 : lt < 7 ? 1 : 2, tb = lt < 4 ? lt : lt < 7 ? lt - 3 : 2;
                        const int jb = dir == 0 ? ta : tb, ibg = dir == 0 ? tb : ta;
                        a_f32x16 gt;
#pragma unroll
                        for (int r = 0; r < 16; ++r) gt[r] = 0.f;
                        const LAS unsigned char* ap = lds + SC_B + (32 * jb + r32) * SC_ST + hi * 16; const LAS unsigned char* bp = lds + SC_C + (32 * ibg + r32) * SC_ST + hi * 16;
#pragma unroll
                        for (int s = 0; s < 8; ++s) gt = __builtin_amdgcn_mfma_f32_32x32x16_bf16(*(const LAS a_bf16x8*)(ap + 32 * s), *(const LAS a_bf16x8*)(bp + 32 * s), gt, 0, 0, 0);
                        const int i = 32 * ibg + r32; const float ai = acum[i];
#pragma unroll
                        for (int g4 = 0; g4 < 4; ++g4) {
                            const v4f aj = *(const LAS v4f*)(acum + 32 * jb + 8 * g4 + 4 * hi), dj = *(const LAS v4f*)(dtj + 32 * jb + 8 * g4 + 4 * hi);
#pragma unroll
                            for (int q = 0; q < 4; ++q) { const int r = 4 * g4 + q; const int j = 32 * jb + a_crow(r, hi); const bool keep = dir == 0 ? j <= i : j >= i;
                                const float e = __builtin_amdgcn_exp2f(fminf(ai - aj[q], 0.f) * 1.4426950408889634f) * dj[q];
                                gt[r] = keep ? gt[r] * e + (j == i ? dd : 0.f) : 0.f; } }
#pragma unroll
                        for (int g4 = 0; g4 < 4; ++g4) { v2u w; w.x = a_cvtpk(gt[4 * g4], gt[4 * g4 + 1]); w.y = a_cvtpk(gt[4 * g4 + 2], gt[4 * g4 + 3]);
                            *(LAS v2u*)(lds + SC_M + (32 * ibg + r32) * SC_ST + (32 * jb + 8 * g4 + 4 * hi) * 2) = w; }
                    }
                    {
                        const int ta = wave < 4 ? 2 : 3, tb = 3, jb = dir == 0 ? ta : tb, ibg = dir == 0 ? tb : ta;
                        const int ja = 2 * jb + ((wave >> 1) & 1), ia = 2 * ibg + (wave & 1), l15 = lane & 15, fq = lane >> 4;
                        pg8::f32x4 gq = (pg8::f32x4){0.f, 0.f, 0.f, 0.f};
                        const LAS unsigned char* ap = lds + SC_B + (16 * ja + l15) * SC_ST + fq * 16; const LAS unsigned char* bp = lds + SC_C + (16 * ia + l15) * SC_ST + fq * 16;
#pragma unroll
                        for (int s = 0; s < 4; ++s) gq = __builtin_amdgcn_mfma_f32_16x16x32_bf16(*(const LAS pg8::bf16x8*)(ap + 64 * s), *(const LAS pg8::bf16x8*)(bp + 64 * s), gq, 0, 0, 0);
                        const int i = 16 * ia + l15, j0 = 16 * ja + 4 * fq; const float ai = acum[i];
                        const v4f aj = *(const LAS v4f*)(acum + j0), dj = *(const LAS v4f*)(dtj + j0);
#pragma unroll
                        for (int q = 0; q < 4; ++q) { const int j = j0 + q; const bool keep = dir == 0 ? j <= i : j >= i;
                            const float e = __builtin_amdgcn_exp2f(fminf(ai - aj[q], 0.f) * 1.4426950408889634f) * dj[q];
                            gq[q] = keep ? gq[q] * e + (j == i ? dd : 0.f) : 0.f; }
                        v2u w; w.x = a_cvtpk(gq[0], gq[1]); w.y = a_cvtpk(gq[2], gq[3]);
                        *(LAS v2u*)(lds + SC_M + i * SC_ST + j0 * 2) = w;
                    }
                    if (wave >= 2) {
                        const int d = wave - 2; const int ta = d == 0 ? 1 : d < 3 ? 2 : 3, tb = d == 0 ? 0 : d == 1 ? 0 : d == 2 ? 1 : d - 3;
                        const int jb = dir == 0 ? ta : tb, ibg = dir == 0 ? tb : ta;
                        const v2u z = {0u, 0u};
#pragma unroll
                        for (int g4 = 0; g4 < 4; ++g4) *(LAS v2u*)(lds + SC_M + (32 * ibg + r32) * SC_ST + (32 * jb + 8 * g4 + 4 * hi) * 2) = z;
                    }
                    a_f32x16 yo;
#pragma unroll
                    for (int r = 0; r < 16; ++r) yo[r] = 0.f;
                    { const LAS unsigned char* ap = lds + SC_C + (32 * ib + r32) * SC_ST + hi * 16; const LAS unsigned char* bp = lds + SC_H + (32 * pb + r32) * SC_ST + hi * 16;
#pragma unroll
                      for (int s = 0; s < 8; ++s) yo = __builtin_amdgcn_mfma_f32_32x32x16_bf16(*(const LAS a_bf16x8*)(ap + 32 * s), *(const LAS a_bf16x8*)(bp + 32 * s), yo, 0, 0, 0); }
                    LDS_BARRIER();
                    a_f32x16 yd;
#pragma unroll
                    for (int r = 0; r < 16; ++r) yd[r] = 0.f;
                    { const LAS unsigned char* ap = lds + SC_M + (32 * ib + r32) * SC_ST + hi * 16; const LAS unsigned char* xp = lds + SC_X + (8 * hi + q4) * SC_XS + (32 * pb + 16 * gg + 4 * p4) * 2;
#pragma unroll
                      for (int s = 0; s < 8; ++s) { const a_s16x4 l0 = a_vtr(xp + (16 * s) * SC_XS), h0 = a_vtr(xp + (16 * s + 4) * SC_XS);
                          const a_bf16x8 xb = (a_bf16x8){l0[0], l0[1], l0[2], l0[3], h0[0], h0[1], h0[2], h0[3]};
                          yd = __builtin_amdgcn_mfma_f32_32x32x16_bf16(*(const LAS a_bf16x8*)(ap + 32 * s), xb, yd, 0, 0, 0); } }
                    { bf16* yp = y + (size_t)dir * T * 2048 + (size_t)(row0 + 32 * ib) * 2048 + hd * 64 + 32 * pb + r32;
                      v4f e4[4];
#pragma unroll
                      for (int g4 = 0; g4 < 4; ++g4) e4[g4] = *(const LAS v4f*)(ei + 32 * ib + 8 * g4 + 4 * hi);
#pragma unroll
                      for (int r = 0; r < 16; ++r) { const int i = a_crow(r, hi); const float v = yd[r] + e4[r >> 2][r & 3] * yo[r]; yp[(size_t)i * 2048] = (bf16)f2bf(v); } }
                    { const float dec = misc[0];
#pragma unroll
                      for (int r = 0; r < 16; ++r) hacc[r] *= dec;
                      const LAS unsigned char* bq = lds + SC_B + (8 * hi + q4) * SC_ST + (32 * nb + 16 * gg + 4 * p4) * 2; const LAS unsigned char* xq = lds + SC_XW + (8 * hi + q4) * SC_XS + (32 * pb + 16 * gg + 4 * p4) * 2;
#pragma unroll
                      for (int s = 0; s < 8; ++s) { const a_s16x4 bl = a_vtr(bq + (16 * s) * SC_ST), bh = a_vtr(bq + (16 * s + 4) * SC_ST), xl = a_vtr(xq + (16 * s) * SC_XS), xh = a_vtr(xq + (16 * s + 4) * SC_XS);
                          const a_bf16x8 av = (a_bf16x8){bl[0], bl[1], bl[2], bl[3], bh[0], bh[1], bh[2], bh[3]}, bv = (a_bf16x8){xl[0], xl[1], xl[2], xl[3], xh[0], xh[1], xh[2], xh[3]};
                          hacc = __builtin_amdgcn_mfma_f32_32x32x16_bf16(av, bv, hacc, 0, 0, 0); } }
#pragma unroll
                    for (int g4 = 0; g4 < 4; ++g4) { v2u w; w.x = a_cvtpk(hacc[4 * g4], hacc[4 * g4 + 1]); w.y = a_cvtpk(hacc[4 * g4 + 2], hacc[4 * g4 + 3]);
                        *(LAS v2u*)(lds + SC_H + (32 * pb + r32) * SC_ST + (32 * nb + 8 * g4 + 4 * hi) * 2) = w; }
                }
                if (seq < 16) { float* o = out + OUT_SSM + ((((size_t)seq * 2 + dir) * 32 + hd) * 64 + 32 * pb + r32) * 128 + 32 * nb + 4 * hi;
#pragma unroll
                    for (int g4 = 0; g4 < 4; ++g4) { v4f t4; t4.x = hacc[4 * g4]; t4.y = hacc[4 * g4 + 1]; t4.z = hacc[4 * g4 + 2]; t4.w = hacc[4 * g4 + 3]; *(GAS v4f*)(o + 8 * g4) = t4; } }
            }
        }
    }
#undef SC_GLOADP
#undef SC_ITEM
    LDS_BARRIER();
}

constexpr int NPHASE = 30;
enum Op { OP_P0, OP_NORM1, OP_G_LAT, OP_FIN1, OP_G_QKV, OP_FIN2, OP_ATTN, OP_G_WO, OP_NORM2, OP_G_FF1, OP_G_FF2, OP_G_PW1, OP_DWCONV, OP_G_PW2, OP_G_SSI, OP_SSCONV, OP_SCAN, OP_GATE, OP_G_SSO };
__device__ __forceinline__ void phase_decode(int ph, int& layer, int& op) {
    if (ph == 0) { layer = 0; op = OP_P0; return; }
    if (ph <= 9) { layer = 0; const int r = ph - 1; op = r == 0 ? OP_NORM1 : r == 1 ? OP_G_LAT : r == 2 ? OP_FIN1 : r == 3 ? OP_G_QKV : r == 4 ? OP_FIN2 : r == 5 ? OP_ATTN : r == 6 ? OP_G_WO : r == 7 ? OP_G_FF1 : OP_G_FF2; }
    else if (ph <= 14) { layer = 1; const int r = ph - 10; op = r == 0 ? OP_G_PW1 : r == 1 ? OP_DWCONV : r == 2 ? OP_G_PW2 : r == 3 ? OP_G_FF1 : OP_G_FF2; }
    else if (ph <= 21) { layer = 2; const int r = ph - 15; op = r == 0 ? OP_G_SSI : r == 1 ? OP_SSCONV : r == 2 ? OP_SCAN : r == 3 ? OP_GATE : r == 4 ? OP_G_SSO : r == 5 ? OP_G_FF1 : OP_G_FF2; }
    else { layer = 3; const int r = ph - 22; op = r == 0 ? OP_G_LAT : r == 1 ? OP_FIN1 : r == 2 ? OP_G_QKV : r == 3 ? OP_FIN2 : r == 4 ? OP_ATTN : r == 5 ? OP_G_WO : r == 6 ? OP_G_FF1 : OP_G_FF2; }
}
struct MArgs { const float* in[38]; float* out; unsigned char* ws; int ph_lo, ph_hi; };
constexpr int PTAB_OFF = PTAB_OFF_C;
__global__ void __launch_bounds__(NTHR, 2) mega_fwd(MArgs args) {
    extern __shared__ __attribute__((aligned(16))) unsigned char lds_raw[];
    LAS unsigned char* lds = (LAS unsigned char*)lds_raw;
    volatile LAS unsigned* PT0 = (volatile LAS unsigned*)(lds + PTAB_OFF);
    volatile LAS unsigned* MISC = (volatile LAS unsigned*)(lds + MISC_OFF);
    { const int t0 = threadIdx.x;
      if (t0 < 40) { const unsigned long long p = t0 < 38 ? (unsigned long long)args.in[t0] : t0 == 38 ? (unsigned long long)args.out : (unsigned long long)args.ws;
          PT0[2 * t0] = (unsigned)p; PT0[2 * t0 + 1] = (unsigned)(p >> 32); }
      if (t0 < 64) MISC[t0] = 0u; }
    __syncthreads();
    XcdBarrier bar = xcd_barrier_post((unsigned*)((unsigned char*)ldp(PT0, PT_WS) + WS_CTL) + CW_BAR, MISC + 8);
    const int wave0 = __builtin_amdgcn_readfirstlane(threadIdx.x >> 6);
    const int ph_hi = args.ph_hi;
    for (int ph = args.ph_lo; ph < ph_hi; ++ph) {
        Frame F;
        { int w = wave0; asm volatile("" : "+s"(w)); F.wave = w; }
        F.lds = lds; F.lane = olane(); F.tid = F.wave * 64 + F.lane;
        const int bx = obid();
        F.G = gridDim.x; F.vcu = (F.G % 8 == 0) ? (bx % 8) * (F.G / 8) + bx / 8 : bx;
        F.gw = F.vcu * NWAVES + F.wave; F.NGW = F.G * NWAVES; F.PT = PT0; F.bx = bx;
        int layer, op; phase_decode(ph, layer, op);
        const int j = layer / 3;
        switch (op) {
        case OP_P0: p0_prologue(F); break;
        case OP_NORM1: { unsigned char* ws = WSP; float* x = OUTP; const float* xlo = layer == 0 ? INP(I_XP) : x; const float* xhi = layer == 0 ? INP(I_XS) - (size_t)TP * 1024 : x;
            rp_normmod(F, xlo, xhi, INP(I_GN1) + layer * 1024, (const float*)(ws + WS_MODS) + (size_t)layer * 5 * 6144, 0, 1024, (bf16*)(ws + WS_H)); rp_tables(F); } break;
        case OP_NORM2: { unsigned char* ws = WSP; float* x = OUTP;
            rp_normmod(F, x, x, INP(I_GN2) + layer * 1024, (const float*)(ws + WS_MODS) + (size_t)layer * 5 * 6144, 3072, 4096, (bf16*)(ws + WS_H)); } break;
        case OP_G_LAT: { unsigned char* ws = WSP; pg8::Gemm g{(const bf16*)(ws + WS_H), (const bf16*)(ws + W_MLA + j * MLA_WB + MW_CAT), T, 768, 1024}; pg8::StaticOrder S; S.init(T, 2 * 768, F.G, F.bx);
            const int s_ = 2 * layer; pg8::EpiF32<1> E{(float*)(ws + A_LAT), 768, layer == 0 ? nullptr : (const float*)(ws + WS_STAT) + s_ * 8192, layer == 0 ? nullptr : (const float*)(ws + WS_SW) + (size_t)s_ * 5 * 5632}; pg8::gemm_phase<pg8::EpiF32<1>, pg8::StaticOrder, true, true, true>(F.lds, g, S, E, F.wave); } break;
        case OP_FIN1: { unsigned char* ws = WSP; rp_mla_fin1(F, (const float*)(ws + A_LAT), INP(I_GQ) + j * 384, INP(I_GKV) + j * 256, (bf16*)(ws + A_QN), (bf16*)(ws + WS_CKV + j * CKV_B), OUTP, j); } break;
        case OP_G_QKV: {
#pragma unroll 1
            for (int w = 0; w < 2; ++w) {
                unsigned char* ws = WSP; unsigned char* wm = ws + W_MLA + j * MLA_WB;
                pg8::Gemm g = w == 0 ? pg8::Gemm{(const bf16*)(ws + A_QN), (const bf16*)(wm + MW_UQ), T, 1536, 384} : pg8::Gemm{(const bf16*)(ws + WS_CKV + j * CKV_B), (const bf16*)(wm + MW_UKV), T + NCTX, 2048, 256};
                pg8::StaticOrder S; S.init(g.M, g.N, F.G, w == 0 ? F.bx : (int)((F.bx + 64) % F.G));
                pg8::EpiBf16P E{w == 0 ? (bf16*)(ws + A_QRAW) : (bf16*)(ws + A_KVRAW), g.N};
                pg8::gemm_phase<pg8::EpiBf16P, pg8::StaticOrder, true, true>(F.lds, g, S, E, F.wave);
            } } break;
        case OP_FIN2: { unsigned char* ws = WSP; rp_mla_fin2(F, (const bf16*)(ws + A_QRAW), (const bf16*)(ws + A_KVRAW), (const float*)(ws + A_LAT), INP(I_CKPE) + (size_t)j * 8192, INP(I_GQN) + j * 96, INP(I_GKN) + j * 96,
                                                        (const float*)(ws + WS_ROPE), (bf16*)(ws + A_QB), (bf16*)(ws + A_KB)); } break;
        case OP_ATTN: { unsigned char* ws = WSP; ph_attn(F, (const bf16*)(ws + A_QB), (const bf16*)(ws + A_KB), (const bf16*)(ws + A_KVRAW), (bf16*)(ws + A_AO)); } break;
        case OP_G_WO: case OP_G_PW2: case OP_G_SSO: case OP_G_FF2: {
            unsigned char* ws = WSP; float* x = OUTP;
            const float* rlo = (layer == 0 && op != OP_G_FF2) ? INP(I_XP) : x; const float* rhi = (layer == 0 && op != OP_G_FF2) ? INP(I_XS) - (size_t)TP * 1024 : x;
            pg8::Gemm g; const float* bias = nullptr; int goff = 2048;
            if (op == OP_G_WO) g = pg8::Gemm{(const bf16*)(ws + A_AO), (const bf16*)(ws + W_MLA + j * MLA_WB + MW_O), T, 1024, 1024};
            else if (op == OP_G_PW2) { g = pg8::Gemm{(const bf16*)(ws + A_V), (const bf16*)(ws + W_CV2), T, 1024, 1024}; bias = INP(I_CVB2); }
            else if (op == OP_G_SSO) g = pg8::Gemm{(const bf16*)(ws + A_YN), (const bf16*)(ws + W_SSO), T, 1024, 2048};
            else { g = pg8::Gemm{(const bf16*)(ws + A_ACT), (const bf16*)(ws + W_FF + layer * FF_WB + FW_OUT), T, 1024, 2816}; goff = 5120; }
            pg8::StaticOrder S; S.init(T, 2 * 1024, F.G, F.bx);
            float* xdst = x;
            const int sn_ = 2 * layer + (op == OP_G_FF2 ? 2 : 1);
            pg8::EpiResid<1> E{rlo, rhi, xdst, (const float*)(ws + WS_MODS) + (size_t)layer * 5 * 6144, goff, bias,
                               sn_ < 8 ? (bf16*)(ws + WS_H) : nullptr, (const float*)(ws + WS_GT) + (size_t)(sn_ & 7) * 5 * 1024, (float*)(ws + WS_STAT) + (sn_ & 7) * 8192};
            pg8::gemm_phase<pg8::EpiResid<1>, pg8::StaticOrder, true, true, true>(F.lds, g, S, E, F.wave); } break;
        case OP_G_FF1: { unsigned char* ws = WSP; pg8::Gemm g{(const bf16*)(ws + WS_H), (const bf16*)(ws + W_FF + layer * FF_WB + FW_IN), T, 5632, 1024}; pg8::StaticOrder S; S.init(T, 5632, F.G, F.bx);
            const int s_ = 2 * layer + 1; pg8::EpiGlu<0> E{(bf16*)(ws + A_ACT), 2816, nullptr, 2816, (const float*)(ws + WS_STAT) + s_ * 8192, (const float*)(ws + WS_SW) + (size_t)s_ * 5 * 5632}; pg8::gemm_phase<pg8::EpiGlu<0>, pg8::StaticOrder, true, true>(F.lds, g, S, E, F.wave); } break;
        case OP_G_PW1: { unsigned char* ws = WSP; pg8::Gemm g{(const bf16*)(ws + WS_H), (const bf16*)(ws + W_CV1), T, 2048, 1024}; pg8::StaticOrder S; S.init(T, 2048, F.G, F.bx);
            const int s_ = 2 * layer; pg8::EpiGlu<1> E{(bf16*)(ws + A_U), 1024, INP(I_CVB1), 1024, (const float*)(ws + WS_STAT) + s_ * 8192, (const float*)(ws + WS_SW) + (size_t)s_ * 5 * 5632}; pg8::gemm_phase<pg8::EpiGlu<1>, pg8::StaticOrder, true, true>(F.lds, g, S, E, F.wave); } break;
        case OP_DWCONV: { unsigned char* ws = WSP; rp_dwconv(F, (const bf16*)(ws + A_U), INP(I_CVWD), INP(I_CVBD), INP(I_CVGL), INP(I_CVBL), (bf16*)(ws + A_V)); } break;
        case OP_G_SSI: { unsigned char* ws = WSP; pg8::Gemm g{(const bf16*)(ws + WS_H), (const bf16*)(ws + W_SSI), T, 5376, 1024}; pg8::StaticOrder S; S.init(T, 5376, F.G, F.bx);
            const int s_ = 2 * layer; pg8::EpiSsdIn E{(bf16*)(ws + A_Z), (bf16*)(ws + A_XPRE), (float*)(ws + A_DTRAW), (const float*)(ws + WS_STAT) + s_ * 8192, (const float*)(ws + WS_SW) + (size_t)s_ * 5 * 5632}; pg8::gemm_phase<pg8::EpiSsdIn, pg8::StaticOrder, true, true>(F.lds, g, S, E, F.wave); } break;
        case OP_SSCONV: { unsigned char* ws = WSP; rp_ssd_conv(F, (const bf16*)(ws + A_XPRE), (const float*)(ws + A_DTRAW), INP(I_SSWC), INP(I_SSBC), INP(I_SSDTB), INP(I_SSAL), (bf16*)(ws + A_XBC), (float*)(ws + A_DT), (float*)(ws + A_ACUM)); } break;
        case OP_SCAN: { unsigned char* ws = WSP; ph_scan(F, (const bf16*)(ws + A_XBC), (const float*)(ws + A_DT), (const float*)(ws + A_ACUM), INP(I_SSD), INP(I_SSM), (bf16*)(ws + A_Y), OUTP); } break;
        case OP_GATE: { unsigned char* ws = WSP; rp_ssd_gate(F, (const bf16*)(ws + A_Y), (const bf16*)(ws + A_Z), INP(I_SSGN), (bf16*)(ws + A_YN)); } break;
        default: break;
        }

        if (ph + 1 < ph_hi) { F.lane = olane(); xcd_barrier_work(bar, F, ph); }

    }
}

extern "C" void kernel_launch(void* const* d_in, const int* in_sizes, int n_in, void* d_out, int out_size, void* d_ws, size_t ws_size, hipStream_t stream) {
    static int grid = 0;
    if (grid == 0) {
        int dev = 0, cus = 0;
        if (hipGetDevice(&dev) != hipSuccess || hipDeviceGetAttribute(&cus, hipDeviceAttributeMultiprocessorCount, dev) != hipSuccess) { fprintf(stderr, "kernel_launch: device query failed\n"); grid = -1; return; }
        if (hipFuncSetAttribute((const void*)mega_fwd, hipFuncAttributeMaxDynamicSharedMemorySize, LDS_BYTES) != hipSuccess) { fprintf(stderr, "kernel_launch: hipFuncSetAttribute failed\n"); grid = -1; return; }
        (void)hipGetLastError();
        grid = cus;
    }
    if (grid < 0) return;
    (void)hipMemsetAsync((char*)d_ws + WS_CTL, 0, CTL_ZERO_BYTES, stream);
    MArgs a{};
    for (int i = 0; i < 38; ++i) a.in[i] = (const float*)d_in[i];
    a.out = (float*)d_out; a.ws = (unsigned char*)d_ws;
    a.ph_lo = 0; a.ph_hi = NPHASE;
    hipLaunchKernelGGL(mega_fwd, dim3(grid), dim3(NTHR), LDS_BYTES, stream, a);
}
```

```cpp
#include <hip/hip_runtime.h>
#include <cstdint>
#include <cstdio>

constexpr int DM = 1024, T = 8192, TP = 4096;
constexpr int NCTX = 1024;
constexpr int QL = 384, KVL = 256, ROPE = 32, NOPE = 64, QKD = 96, VH = 64, NH = 16;
constexpr int FFH = 2816;
constexpr int SSI = 2048, SSH = 32, SSP = 64, SSN = 128, SSG = 4, SSCD = 3072, SSIN = 5184;
constexpr float EPS = 1e-6f;
constexpr size_t OUT_YP = 0, OUT_CKV = 8388608, OUT_KPE = 10485760, OUT_SSM = 10747904;

__device__ __forceinline__ int cond_of_row(int r) { return r < TP ? 0 : 1 + ((r - TP) >> 10); }
__device__ __forceinline__ void row_pos(int r, int& t, int& L) { if (r < TP) { t = r & 255; L = 256; } else { t = (r - TP) & 1023; L = 1024; } }
__device__ __forceinline__ float softplus_f(float x) { return fmaxf(x, 0.f) + log1pf(expf(-fabsf(x))); }

__device__ __forceinline__ float rope_inv(int i) { return i == 0 ? 1.f : i == 1 ? 0.31622776601683794f : i == 2 ? 0.1f : i == 3 ? 0.031622776601683794f : i == 4 ? 0.01f : i == 5 ? 0.0031622776601683794f : i == 6 ? 0.001f : 0.00031622776601683794f; }

__device__ __forceinline__ int olane() { int l; asm volatile("v_mbcnt_lo_u32_b32 %0, -1, 0\n\tv_mbcnt_hi_u32_b32 %0, -1, %0" : "=v"(l)); return l; }
__device__ __forceinline__ int obid() { int b = blockIdx.x; asm volatile("" : "+s"(b)); return b; }
namespace pg8 {
#define PG8_LAS __attribute__((address_space(3)))
typedef unsigned short bf16_t;
typedef short bf16x8 __attribute__((ext_vector_type(8)));
typedef float f32x4 __attribute__((ext_vector_type(4)));
typedef unsigned u32x4 __attribute__((ext_vector_type(4)));
constexpr int BM = 256, BK = 64, HALF = 128, HTB = HALF * BK * 2  , STAGE_BYTES = 8 * HTB, NXCD = 8, WGM = 8;

__host__ __device__ __forceinline__ int lds_byte(int r, int c) { const int st = (r >> 4) * 2 + (c >> 5), rr = r & 15, cc = c & 31, ob = rr * 64 + cc * 2; return st * 1024 + (ob ^ (((ob >> 9) & 1) << 5)); }
__host__ __device__ __forceinline__ void stage_rc(int b, int& R, int& C) { const int st = b / 1024, sb = b % 1024, swz = sb ^ (((sb >> 9) & 1) << 5); R = (st >> 1) * 16 + swz / 64; C = (st & 1) * 32 + (swz % 64) / 2; }
__host__ __device__ __forceinline__ int perm32(int rho) { const int n = rho >> 4, i = rho & 15; return 8 * (i >> 2) + 4 * n + (i & 3); }

struct Unit { int pm, pn; };
struct Gemm { const bf16_t* A; const bf16_t* Bt; int M, N, K; };

struct StaticOrder {
    int nM, nN, nwg, G, c;
    __host__ __device__ void init(int M, int N, int G_, int c_) { nM = M / BM; nN = N / BM; nwg = nM * nN; G = G_; c = c_; }
    __host__ __device__ bool next(int i, Unit& u) const {
        const long L = (long)i * G + c; if (L >= nwg) return false;
        int wgid = (int)L; { const int q = nwg / NXCD, r = nwg % NXCD, xcd = wgid % NXCD, off = wgid / NXCD; wgid = (xcd < r ? xcd * (q + 1) : r * (q + 1) + (xcd - r) * q) + off; }
        const int nig = WGM * nN, gid = wgid / nig, fm = gid * WGM, gsz = (nM - fm) < WGM ? (nM - fm) : WGM;
        u.pm = fm + ((wgid % nig) % gsz); u.pn = (wgid % nig) / gsz; return true;
    }
    __device__ __forceinline__ void a_ready(const Unit&) const {}
    __device__ __forceinline__ void done(const Unit&) const {}
};
__device__ __forceinline__ unsigned cvt_pk_bf16(float lo, float hi) { unsigned r; asm("v_cvt_pk_bf16_f32 %0, %1, %2" : "=v"(r) : "v"(lo), "v"(hi)); return r; }
typedef unsigned u32x2 __attribute__((ext_vector_type(2)));
#define PG8_GAS __attribute__((address_space(1)))
__device__ __forceinline__ void st16(void* p, u32x4 v) { *(PG8_GAS u32x4*)p = v; }
__device__ __forceinline__ void st16f(void* p, f32x4 v) { *(PG8_GAS f32x4*)p = v; }
__device__ __forceinline__ void st8(void* p, u32x2 v) { *(PG8_GAS u32x2*)p = v; }
__device__ __forceinline__ f32x4 ld16f(const float* p) { return *(const PG8_GAS f32x4*)p; }
__device__ __forceinline__ float ld4f(const float* p) { return *(const PG8_GAS float*)p; }
__device__ __forceinline__ float fast_sigmoid(float x) { return __builtin_amdgcn_rcpf(1.f + __builtin_amdgcn_exp2f(-1.4426950408889634f * x)); }
__device__ __forceinline__ unsigned cvt_pk_bf16_p(float lo, float hi) { unsigned r; asm("v_cvt_pk_bf16_f32 %0, %1, %2" : "=v"(r) : "v"(lo), "v"(hi)); return r; }
template <int MODE> __device__ __forceinline__ void glu8(const f32x4 a0, const f32x4 g0, const f32x4 a1, const f32x4 g1, f32x4& o0, f32x4& o1) {
    const f32x4 t0 = (MODE == 0 ? a0 : g0) * -1.4426950408889634f, t1 = (MODE == 0 ? a1 : g1) * -1.4426950408889634f;
    f32x4 e0, e1, r0, r1;
#pragma unroll
    for (int j = 0; j < 4; ++j) { e0[j] = __builtin_amdgcn_exp2f(t0[j]); e1[j] = __builtin_amdgcn_exp2f(t1[j]); }
    const f32x4 d0 = e0 + 1.f, d1 = e1 + 1.f;
#pragma unroll
    for (int j = 0; j < 4; ++j) { r0[j] = __builtin_amdgcn_rcpf(d0[j]); r1[j] = __builtin_amdgcn_rcpf(d1[j]); }
    if (MODE == 0) { o0 = a0 * g0 * r0; o1 = a1 * g1 * r1; } else { o0 = a0 * r0; o1 = a1 * r1; }
}

constexpr int SW_LD = 5632;
__device__ __forceinline__ int cond_of_pm(int pm) { return pm < 16 ? 0 : 1 + ((pm - 16) >> 2); }
__device__ __forceinline__ void stage_rstat_sw(const float* rstat, const float* sw, const Unit& u, int slot, int wid, int lane, PG8_LAS unsigned char* tabs) {
    PG8_LAS unsigned char* tab = tabs + slot * 2048;
    if (wid < 4) __builtin_amdgcn_global_load_lds((const unsigned*)(rstat + u.pm * BM + wid * 64 + lane), (PG8_LAS unsigned*)(tab + wid * 256), 4, 0, 0);
    else __builtin_amdgcn_global_load_lds((const unsigned*)(sw + (size_t)cond_of_pm(u.pm) * SW_LD + u.pn * BM + (wid - 4) * 64 + lane), (PG8_LAS unsigned*)(tab + 1024 + (wid - 4) * 256), 4, 0, 0);
}
template <int NBJ> struct EpiF32 {
    static constexpr bool PERM = false, AFTER_DRAIN = false, STAGE_IN = false;
    float* C; int ldc; const float* rstat; const float* sw;
    template <bool HN> __device__ __forceinline__ void body(const f32x4 (&acc)[2][2][4][2], const Unit& u, int wr, int wc) const {
        const int t_ = olane(), fr = t_ & 15, fq = t_ >> 4;
        const int row0 = u.pm * BM + wr * 64 + fr, col0 = u.pn * (HALF * NBJ) + wc * 32 + 4 * fq;
        float rs[2][4]; f32x4 s4[NBJ][2];
#pragma unroll
        for (int ai = 0; ai < 2; ++ai)
#pragma unroll
            for (int m = 0; m < 4; ++m) rs[ai][m] = HN ? ld4f(rstat + row0 + ai * HALF + m * 16) : 1.f;
#pragma unroll
        for (int bj = 0; bj < NBJ; ++bj)
#pragma unroll
            for (int n = 0; n < 2; ++n) s4[bj][n] = HN ? ld16f(sw + (size_t)cond_of_pm(u.pm) * SW_LD + col0 + bj * HALF + n * 16) : (f32x4){0.f, 0.f, 0.f, 0.f};
        if (HN) {
#pragma unroll
            for (int ai = 0; ai < 2; ++ai)
#pragma unroll
                for (int m = 0; m < 4; ++m) rs[ai][m] = __builtin_amdgcn_rsqf(rs[ai][m] * (1.f / 1024) + 1e-6f);
        }
#pragma unroll
        for (int ai = 0; ai < 2; ++ai)
#pragma unroll
            for (int m = 0; m < 4; ++m) { float* rowp = C + (size_t)(row0 + ai * HALF + m * 16) * ldc + col0;
#pragma unroll
                for (int bj = 0; bj < NBJ; ++bj)
#pragma unroll
                    for (int n = 0; n < 2; ++n) { f32x4 v = acc[ai][bj][m][n]; if (HN) v = v * rs[ai][m] + s4[bj][n]; st16f(rowp + bj * HALF + n * 16, v); } }
    }
    __device__ __forceinline__ void operator()(const f32x4 (&acc)[2][2][4][2], const Unit& u, int wr_, int wc_, int fr_, int fq_, const PG8_LAS unsigned char* tab) const {
        (void)fr_; (void)fq_; (void)tab;
        if (rstat) body<true>(acc, u, wr_, wc_); else body<false>(acc, u, wr_, wc_);
    }
};
struct EpiBf16P {
    static constexpr bool PERM = true, AFTER_DRAIN = false, STAGE_IN = false;
    bf16_t* O; int ldc;
    __device__ __forceinline__ void operator()(const f32x4 (&acc)[2][2][4][2], const Unit& u, int wr_, int wc_, int fr_, int fq_, const PG8_LAS unsigned char* tab) const {
        const int t_ = olane(), wr = wr_, wc = wc_, fr = t_ & 15, fq = t_ >> 4; (void)fr_; (void)fq_; (void)tab;
        const int row0 = u.pm * BM + wr * 64 + fr, col0 = u.pn * BM + wc * 32 + 8 * fq;
#pragma unroll
        for (int ai = 0; ai < 2; ++ai)
#pragma unroll
            for (int m = 0; m < 4; ++m) { bf16_t* rowp = O + (size_t)(row0 + ai * HALF + m * 16) * ldc + col0;
#pragma unroll
                for (int bj = 0; bj < 2; ++bj) { const f32x4 v0 = acc[ai][bj][m][0], v1 = acc[ai][bj][m][1]; u32x4 w;
                    w.x = cvt_pk_bf16(v0[0], v0[1]); w.y = cvt_pk_bf16(v0[2], v0[3]); w.z = cvt_pk_bf16(v1[0], v1[1]); w.w = cvt_pk_bf16(v1[2], v1[3]);
                    st16(rowp + bj * HALF, w); } }
    }
};
struct EpiSsdIn {
    static constexpr bool PERM = true, AFTER_DRAIN = false, STAGE_IN = true;
    bf16_t* Z; bf16_t* XP; float* DT; const float* rstat; const float* sw;
    __device__ __forceinline__ void stage_in(const Unit& u, int slot, int wid, int lane, PG8_LAS unsigned char* tabs) const { stage_rstat_sw(rstat, sw, u, slot, wid, lane, tabs); }
    __device__ __forceinline__ void operator()(const f32x4 (&acc)[2][2][4][2], const Unit& u, int wr_, int wc_, int fr_, int fq_, const PG8_LAS unsigned char* tab) const {
        const int t_ = olane(), wr = wr_, wc = wc_, fr = t_ & 15, fq = t_ >> 4; (void)fr_; (void)fq_;
        const int row0 = u.pm * BM + wr * 64 + fr;
        const PG8_LAS float* trs = (const PG8_LAS float*)tab + wr * 64 + fr; const PG8_LAS float* swp = (const PG8_LAS float*)(tab + 1024) + wc * 32 + 8 * fq;
        if (u.pn < 20) {
            bf16_t* base = u.pn < 8 ? Z : XP; const int ld = u.pn < 8 ? 2048 : 3072, colt = (u.pn < 8 ? u.pn : u.pn - 8) * BM, col0 = colt + wc * 32 + 8 * fq;
#pragma unroll
            for (int ai = 0; ai < 2; ++ai)
#pragma unroll
                for (int m = 0; m < 4; ++m) { bf16_t* rowp = base + (size_t)(row0 + ai * HALF + m * 16) * ld + col0;
                    const float rs = __builtin_amdgcn_rsqf(trs[ai * HALF + m * 16] * (1.f / 1024) + 1e-6f);
#pragma unroll
                    for (int bj = 0; bj < 2; ++bj) { const f32x4 v0 = acc[ai][bj][m][0] * rs + *(const PG8_LAS f32x4*)(swp + bj * HALF), v1 = acc[ai][bj][m][1] * rs + *(const PG8_LAS f32x4*)(swp + bj * HALF + 4); u32x4 w;
                        w.x = cvt_pk_bf16(v0[0], v0[1]); w.y = cvt_pk_bf16(v0[2], v0[3]); w.z = cvt_pk_bf16(v1[0], v1[1]); w.w = cvt_pk_bf16(v1[2], v1[3]);
                        st16(rowp + bj * HALF, w); } }
        } else if (wc < 2) {
#pragma unroll
            for (int ai = 0; ai < 2; ++ai)
#pragma unroll
                for (int m = 0; m < 4; ++m) { float* rp = DT + (size_t)(row0 + ai * HALF + m * 16) * 64 + wc * 32 + 8 * fq;
                    const float rs = __builtin_amdgcn_rsqf(trs[ai * HALF + m * 16] * (1.f / 1024) + 1e-6f);
                    st16f(rp, acc[ai][0][m][0] * rs + *(const PG8_LAS f32x4*)swp); st16f(rp + 4, acc[ai][0][m][1] * rs + *(const PG8_LAS f32x4*)(swp + 4)); }
        }
    }
};
template <int MODE> struct EpiGlu {
    static constexpr bool PERM = false, AFTER_DRAIN = false, STAGE_IN = true;
    bf16_t* O; int ldo; const float* bias; int H; const float* rstat; const float* sw;
    __device__ __forceinline__ void stage_in(const Unit& u, int slot, int wid, int lane, PG8_LAS unsigned char* tabs) const { stage_rstat_sw(rstat, sw, u, slot, wid, lane, tabs); }
    __device__ __forceinline__ void operator()(const f32x4 (&acc)[2][2][4][2], const Unit& u, int wr_, int wc_, int fr_, int fq_, const PG8_LAS unsigned char* tab) const {
        const int t_ = olane(), wr = wr_, wc = wc_, fr = t_ & 15, fq = t_ >> 4; (void)fr_; (void)fq_;
        const int row0 = u.pm * BM + wr * 64 + fr;
        float rs[2][4];
#pragma unroll
        for (int ai = 0; ai < 2; ++ai)
#pragma unroll
            for (int m = 0; m < 4; ++m) rs[ai][m] = ((const PG8_LAS float*)tab)[ai * HALF + wr * 64 + m * 16 + fr];
#pragma unroll
        for (int ai = 0; ai < 2; ++ai)
#pragma unroll
            for (int m = 0; m < 4; ++m) rs[ai][m] = __builtin_amdgcn_rsqf(rs[ai][m] * (1.f / 1024) + 1e-6f);
        const unsigned ldb = (unsigned)ldo * 2u;
        unsigned char* Ob = (unsigned char*)O;
        const int f0 = 128 * u.pn + 32 * wc + 8 * fq;
        f32x4 ba[2], bu[2];
#pragma unroll
        for (int bj = 0; bj < 2; ++bj) {
            ba[bj] = (f32x4){0.f, 0.f, 0.f, 0.f}; bu[bj] = ba[bj];
            if (MODE == 1) { ba[bj] = ld16f(bias + f0 + 4 * bj); bu[bj] = ld16f(bias + H + f0 + 4 * bj); }
            const PG8_LAS float* swp = (const PG8_LAS float*)(tab + 1024) + bj * HALF + wc * 32 + 4 * fq; ba[bj] += *(const PG8_LAS f32x4*)swp; bu[bj] += *(const PG8_LAS f32x4*)(swp + 16);
        }
        const unsigned ob = (unsigned)row0 * ldb + (unsigned)f0 * 2u;
#pragma unroll
        for (int ai = 0; ai < 2; ++ai)
#pragma unroll
            for (int m = 0; m < 4; ++m) {
                const f32x4 a0 = acc[ai][0][m][0] * rs[ai][m] + ba[0], g0 = acc[ai][0][m][1] * rs[ai][m] + bu[0];
                const f32x4 a1 = acc[ai][1][m][0] * rs[ai][m] + ba[1], g1 = acc[ai][1][m][1] * rs[ai][m] + bu[1];
                f32x4 o0, o1; glu8<MODE>(a0, g0, a1, g1, o0, o1);
                u32x4 w; w.x = cvt_pk_bf16_p(o0[0], o0[1]); w.y = cvt_pk_bf16_p(o0[2], o0[3]); w.z = cvt_pk_bf16_p(o1[0], o1[1]); w.w = cvt_pk_bf16_p(o1[2], o1[3]);
                st16(Ob + (size_t)(ob + (unsigned)(ai * HALF + m * 16) * ldb), w); }
    }
};
template <int NBJ> struct EpiResid {
    static constexpr bool PERM = true, AFTER_DRAIN = false, STAGE_IN = false;
    const float* xlo; const float* xhi; float* xout; const float* mods_l; int g_off; const float* bias;
    bf16_t* XG; const float* GT; float* stat;
    template <bool HX> __device__ __forceinline__ void body(const f32x4 (&acc)[2][2][4][2], const Unit& u, int wr, int wc) const {
        const int t_ = olane(), fr = t_ & 15, fq = t_ >> 4;
        const int cond = u.pm < 16 ? 0 : 1 + ((u.pm - 16) >> 2);
        const float* gate = mods_l + (size_t)cond * 6144 + g_off; const unsigned char* xin = (const unsigned char*)(u.pm < 16 ? xlo : xhi);
        const int row0 = u.pm * BM + wr * 64 + fr, col0 = u.pn * (HALF * NBJ) + wc * 32 + 8 * fq;
        const unsigned ob = (unsigned)row0 * 4096u + (unsigned)col0 * 4u;
        f32x4 xo[NBJ][2][2][4];
#pragma unroll
        for (int bj = 0; bj < NBJ; ++bj)
#pragma unroll
            for (int n = 0; n < 2; ++n)
#pragma unroll
                for (int ai = 0; ai < 2; ++ai)
#pragma unroll
                    for (int m = 0; m < 4; ++m) xo[bj][n][ai][m] = ld16f((const float*)(xin + (size_t)(ob + (unsigned)((bj * HALF + n * 4) * 4 + (ai * HALF + m * 16) * 4096))));
        const float* gt = HX ? GT + (size_t)cond * 1024 : nullptr;
        f32x4 g4[NBJ][2], b4[NBJ][2], G4[NBJ][2];
#pragma unroll
        for (int bj = 0; bj < NBJ; ++bj)
#pragma unroll
            for (int n = 0; n < 2; ++n) { const int c = col0 + bj * HALF + n * 4; g4[bj][n] = ld16f(gate + c);
                b4[bj][n] = (f32x4){0.f, 0.f, 0.f, 0.f}; if (bias) b4[bj][n] = ld16f(bias + c);
                G4[bj][n] = (f32x4){0.f, 0.f, 0.f, 0.f}; if (HX) G4[bj][n] = ld16f(gt + c); }
        float ss[2][4];
#pragma unroll
        for (int ai = 0; ai < 2; ++ai)
#pragma unroll
            for (int m = 0; m < 4; ++m) ss[ai][m] = 0.f;
        unsigned char* xo_ = (unsigned char*)xout; unsigned char* xg_ = (unsigned char*)XG;
#pragma unroll
        for (int bj = 0; bj < NBJ; ++bj)
#pragma unroll
            for (int ai = 0; ai < 2; ++ai)
#pragma unroll
                for (int m = 0; m < 4; ++m) { const unsigned off = ob + (unsigned)(bj * HALF * 4 + (ai * HALF + m * 16) * 4096);
                    const f32x4 x0 = xo[bj][0][ai][m] + g4[bj][0] * (acc[ai][bj][m][0] + b4[bj][0]), x1 = xo[bj][1][ai][m] + g4[bj][1] * (acc[ai][bj][m][1] + b4[bj][1]);
                    st16f(xo_ + (size_t)off, x0); st16f(xo_ + (size_t)(off + 16u), x1);
                    if (HX) { const f32x4 y0 = x0 * G4[bj][0], y1 = x1 * G4[bj][1]; u32x4 w;
                        w.x = cvt_pk_bf16_p(y0[0], y0[1]); w.y = cvt_pk_bf16_p(y0[2], y0[3]); w.z = cvt_pk_bf16_p(y1[0], y1[1]); w.w = cvt_pk_bf16_p(y1[2], y1[3]); st16(xg_ + (size_t)(off >> 1), w);
                        const f32x4 q = x0 * x0 + x1 * x1; ss[ai][m] += (q[0] + q[1]) + (q[2] + q[3]); } }
        if (HX) {
#pragma unroll
            for (int ai = 0; ai < 2; ++ai)
#pragma unroll
                for (int m = 0; m < 4; ++m) { float s = ss[ai][m];
                    s += __builtin_bit_cast(float, __builtin_amdgcn_ds_bpermute((t_ ^ 16) << 2, __builtin_bit_cast(int, s)));
                    s += __builtin_bit_cast(float, __builtin_amdgcn_ds_bpermute((t_ ^ 32) << 2, __builtin_bit_cast(int, s)));
                    if (fq == 0) atomicAdd(stat + row0 + ai * HALF + m * 16, s); }
        }
    }
    __device__ __forceinline__ void operator()(const f32x4 (&acc)[2][2][4][2], const Unit& u, int wr_, int wc_, int fr_, int fq_, const PG8_LAS unsigned char* tab) const {
        (void)fr_; (void)fq_; (void)tab;
        if (XG) body<true>(acc, u, wr_, wc_); else body<false>(acc, u, wr_, wc_);
    }
};
template <class Epi, class Sched, bool ALIGN_EPI = false, bool SP2 = false, bool HALFN = false>
__device__ __forceinline__ void gemm_phase(PG8_LAS unsigned char* lds, const Gemm g, const Sched& S, const Epi& E, const int wave_in) {
    const int tid = wave_in * 64 + olane(), wid = __builtin_amdgcn_readfirstlane(tid >> 6), lane = tid & 63, wr = wid >> 2, wc = wid & 3, fr = lane & 15, fq = lane >> 4;
    const int K = g.K, nt = K / BK;
    unsigned voffA[2], voffB[2];
#pragma unroll
    for (int i = 0; i < 2; ++i) { int R, C; stage_rc(tid * 16 + i * 8192, R, C); const int Rb = Epi::PERM ? ((R & ~31) + perm32(R & 31)) : R;
        voffA[i] = (unsigned)(R * K + C) * 2u; voffB[i] = (unsigned)(Rb * K + C) * 2u; }
    const size_t kstep = (size_t)(BK * 2);
    const size_t hstep = (size_t)HALF * K * 2;
    const size_t tstep = 2 * hstep;
    const size_t bstep = HALFN ? hstep : tstep;
    static_assert(!HALFN || SP2, "HALFN is written for the SP2 loop only");
    const unsigned ldsw = (unsigned)wid * 1024u;
    const int aoff = lds_byte(wr * 64 + fr, fq * 8), boff = lds_byte(wc * 32 + fr, fq * 8);
#define PG8_SA(b, h) (((b) * 2 + (h)) * HTB)
#define PG8_SB(b, h) ((4 + (b) * 2 + (h)) * HTB)
#define PG8_STAGE(bufoff, gbase, voff) do { _Pragma("unroll") for (int _i = 0; _i < 2; ++_i) \
        __builtin_amdgcn_global_load_lds((const unsigned*)((const char*)(gbase) + (voff)[_i]), (PG8_LAS unsigned*)(lds + (bufoff) + ldsw + _i * 8192), 16, 0, 0); } while (0)
#define PG8_LDA(dst, b, h) do { _Pragma("unroll") for (int m = 0; m < 4; ++m) _Pragma("unroll") for (int k = 0; k < 2; ++k) dst[m][k] = *(const PG8_LAS bf16x8*)(lds + PG8_SA(b, h) + aoff + m * 2048 + k * 1024); } while (0)
#define PG8_LDB(dst, b, h) do { _Pragma("unroll") for (int n = 0; n < 2; ++n) _Pragma("unroll") for (int k = 0; k < 2; ++k) dst[n][k] = *(const PG8_LAS bf16x8*)(lds + PG8_SB(b, h) + boff + n * 2048 + k * 1024); } while (0)
#define PG8_MMA(ai, bj, At, Bt) do { __builtin_amdgcn_s_setprio(1); _Pragma("unroll") for (int m = 0; m < 4; ++m) _Pragma("unroll") for (int n = 0; n < 2; ++n) _Pragma("unroll") for (int k = 0; k < 2; ++k) \
        acc[ai][bj][m][n] = __builtin_amdgcn_mfma_f32_16x16x32_bf16(Bt[n][k], At[m][k], acc[ai][bj][m][n], 0, 0, 0); __builtin_amdgcn_s_setprio(0); } while (0)
#define PG8_WAIT_V(n) asm volatile("s_waitcnt vmcnt(" #n ")" ::: "memory")
#define PG8_WAIT_L(n) asm volatile("s_waitcnt lgkmcnt(" #n ")" ::: "memory")
#define PG8_BAR __builtin_amdgcn_s_barrier()
#define PG8_SCHED __builtin_amdgcn_sched_barrier(0)
    Unit cur, nxt; int ui = 0;
    if (!S.next(0, cur)) return;
    f32x4 acc[2][2][4][2];
#pragma unroll
    for (int a = 0; a < 2; ++a)
#pragma unroll
        for (int b = 0; b < 2; ++b)
#pragma unroll
            for (int m = 0; m < 4; ++m)
#pragma unroll
                for (int n = 0; n < 2; ++n) acc[a][b][m][n] = (f32x4){0.f, 0.f, 0.f, 0.f};
    bf16x8 At[4][2], B0[2][2], B1[2][2];
    const char* cA = (const char*)g.A + (size_t)cur.pm * tstep; const char* cB = (const char*)g.Bt + (size_t)cur.pn * bstep;
    S.a_ready(cur);
    if constexpr (Epi::STAGE_IN) E.stage_in(cur, 0, wid, lane, lds + STAGE_BYTES);
    if constexpr (HALFN) {
        PG8_STAGE(PG8_SB(0, 0), cB, voffB); PG8_STAGE(PG8_SA(0, 0), cA, voffA); PG8_STAGE(PG8_SA(0, 1), cA + hstep, voffA);
        if (wr == 1) PG8_BAR;
        PG8_WAIT_V(2); PG8_BAR;
        PG8_STAGE(PG8_SB(1, 0), cB + kstep, voffB); PG8_STAGE(PG8_SA(1, 0), cA + kstep, voffA);
        PG8_WAIT_V(4); PG8_BAR;
    } else if constexpr (SP2) {
        PG8_STAGE(PG8_SB(0, 0), cB, voffB); PG8_STAGE(PG8_SB(0, 1), cB + hstep, voffB); PG8_STAGE(PG8_SA(0, 0), cA, voffA); PG8_STAGE(PG8_SA(0, 1), cA + hstep, voffA);
        if (wr == 1) PG8_BAR;
        PG8_WAIT_V(2); PG8_BAR;
        PG8_STAGE(PG8_SB(1, 0), cB + kstep, voffB); PG8_STAGE(PG8_SA(1, 0), cA + kstep, voffA); PG8_STAGE(PG8_SB(1, 1), cB + hstep + kstep, voffB);
        PG8_WAIT_V(6); PG8_BAR;
    } else {
        PG8_STAGE(PG8_SB(0, 0), cB, voffB); PG8_STAGE(PG8_SA(0, 0), cA, voffA); PG8_STAGE(PG8_SB(0, 1), cB + hstep, voffB); PG8_STAGE(PG8_SA(0, 1), cA + hstep, voffA);
        if (wr == 1) PG8_BAR;
        PG8_WAIT_V(4); PG8_BAR;
        PG8_STAGE(PG8_SB(1, 0), cB + kstep, voffB); PG8_STAGE(PG8_SA(1, 0), cA + kstep, voffA); PG8_STAGE(PG8_SB(1, 1), cB + hstep + kstep, voffB);
        PG8_WAIT_V(6); PG8_BAR;
    }
    for (;;) {
        const bool has_next = S.next(ui + 1, nxt);
        const char* nA = has_next ? (const char*)g.A + (size_t)nxt.pm * tstep : cA; const char* nB = has_next ? (const char*)g.Bt + (size_t)nxt.pn * bstep : cB;
        for (int t = 0; t < nt; t += 2) {
            const bool last = (t == nt - 2);
            const char* a1 = cA + (size_t)(t + 1) * kstep;
            const char* a2 = last ? nA : cA + (size_t)(t + 2) * kstep; const char* b2 = last ? nB : cB + (size_t)(t + 2) * kstep;
            const char* a3 = a2 + kstep; const char* b3 = b2 + kstep;
            if (last && has_next) S.a_ready(nxt);
            if constexpr (Epi::STAGE_IN) { if (last && has_next) E.stage_in(nxt, (ui + 1) & 1, wid, lane, lds + STAGE_BYTES); }
            if constexpr (HALFN) {
            PG8_LDB(B0, 0, 0); PG8_SCHED; PG8_LDA(At, 0, 0); PG8_STAGE(PG8_SA(1, 1), a1 + hstep, voffA);
            PG8_WAIT_V(6); PG8_WAIT_L(0); PG8_BAR; PG8_MMA(0, 0, At, B0); PG8_BAR; PG8_SCHED;
            PG8_LDA(At, 0, 1); PG8_STAGE(PG8_SB(0, 0), b2, voffB); PG8_STAGE(PG8_SA(0, 0), a2, voffA);
            PG8_WAIT_V(6); PG8_WAIT_L(0); PG8_BAR; PG8_MMA(1, 0, At, B0); PG8_BAR; PG8_SCHED;
            PG8_LDB(B0, 1, 0); PG8_SCHED; PG8_LDA(At, 1, 0); PG8_STAGE(PG8_SA(0, 1), a2 + hstep, voffA);
            PG8_WAIT_V(6); PG8_WAIT_L(0); PG8_BAR; PG8_MMA(0, 0, At, B0); PG8_BAR; PG8_SCHED;
            PG8_LDA(At, 1, 1); PG8_STAGE(PG8_SB(1, 0), b3, voffB); PG8_STAGE(PG8_SA(1, 0), a3, voffA);
            PG8_WAIT_V(6); PG8_WAIT_L(0); PG8_BAR; PG8_MMA(1, 0, At, B0); PG8_BAR; PG8_SCHED;
            } else if constexpr (SP2) {
            PG8_LDB(B0, 0, 0); PG8_LDB(B1, 0, 1); PG8_SCHED; PG8_LDA(At, 0, 0); PG8_STAGE(PG8_SA(1, 1), a1 + hstep, voffA);
            PG8_WAIT_V(8); PG8_WAIT_L(0); PG8_BAR; PG8_MMA(0, 0, At, B0); PG8_MMA(0, 1, At, B1); PG8_BAR; PG8_SCHED;
            PG8_LDA(At, 0, 1); PG8_STAGE(PG8_SB(0, 0), b2, voffB); PG8_STAGE(PG8_SB(0, 1), b2 + hstep, voffB); PG8_STAGE(PG8_SA(0, 0), a2, voffA);
            PG8_WAIT_V(8); PG8_WAIT_L(0); PG8_BAR; PG8_MMA(1, 0, At, B0); PG8_MMA(1, 1, At, B1); PG8_BAR; PG8_SCHED;
            PG8_LDB(B0, 1, 0); PG8_LDB(B1, 1, 1); PG8_SCHED; PG8_LDA(At, 1, 0); PG8_STAGE(PG8_SA(0, 1), a2 + hstep, voffA);
            PG8_WAIT_V(8); PG8_WAIT_L(0); PG8_BAR; PG8_MMA(0, 0, At, B0); PG8_MMA(0, 1, At, B1); PG8_BAR; PG8_SCHED;
            PG8_LDA(At, 1, 1); PG8_STAGE(PG8_SB(1, 0), b3, voffB); PG8_STAGE(PG8_SB(1, 1), b3 + hstep, voffB); PG8_STAGE(PG8_SA(1, 0), a3, voffA);
            PG8_WAIT_V(8); PG8_WAIT_L(0); PG8_BAR; PG8_MMA(1, 0, At, B0); PG8_MMA(1, 1, At, B1); PG8_BAR; PG8_SCHED;
            } else {
            PG8_LDB(B0, 0, 0); PG8_SCHED; PG8_LDA(At, 0, 0); PG8_STAGE(PG8_SA(1, 1), a1 + hstep, voffA);
            PG8_WAIT_L(8); PG8_BAR; PG8_WAIT_L(0); PG8_MMA(0, 0, At, B0); PG8_BAR; PG8_SCHED;
            PG8_LDB(B1, 0, 1); PG8_STAGE(PG8_SB(0, 0), b2, voffB);
            PG8_BAR; PG8_WAIT_L(0); PG8_MMA(0, 1, At, B1); PG8_BAR;
            PG8_LDA(At, 0, 1); PG8_STAGE(PG8_SA(0, 0), a2, voffA);
            PG8_BAR; PG8_WAIT_L(0); PG8_MMA(1, 0, At, B0); PG8_BAR; PG8_SCHED;
            PG8_STAGE(PG8_SB(0, 1), b2 + hstep, voffB);
            PG8_WAIT_V(6); PG8_BAR; PG8_MMA(1, 1, At, B1); PG8_BAR;
            PG8_LDB(B0, 1, 0); PG8_SCHED; PG8_LDA(At, 1, 0); PG8_STAGE(PG8_SA(0, 1), a2 + hstep, voffA);
            PG8_WAIT_L(8); PG8_BAR; PG8_WAIT_L(0); PG8_MMA(0, 0, At, B0); PG8_BAR; PG8_SCHED;
            PG8_LDB(B1, 1, 1); PG8_STAGE(PG8_SB(1, 0), b3, voffB);
            PG8_BAR; PG8_WAIT_L(0); PG8_MMA(0, 1, At, B1); PG8_BAR;
            PG8_LDA(At, 1, 1); PG8_STAGE(PG8_SA(1, 0), a3, voffA);
            PG8_BAR; PG8_WAIT_L(0); PG8_MMA(1, 0, At, B0); PG8_BAR; PG8_SCHED;
            PG8_STAGE(PG8_SB(1, 1), b3 + hstep, voffB);
            PG8_WAIT_V(6); PG8_BAR; PG8_MMA(1, 1, At, B1); PG8_BAR;
            }
        }
        if constexpr (ALIGN_EPI) { if (wr == 0) PG8_BAR; }
        if constexpr (!Epi::AFTER_DRAIN) { E(acc, cur, wr, wc, fr, fq, lds + STAGE_BYTES + (ui & 1) * 2048); S.done(cur); }
        if (!has_next) break;
#pragma unroll
        for (int a = 0; a < 2; ++a)
#pragma unroll
            for (int b = 0; b < 2; ++b)
#pragma unroll
                for (int m = 0; m < 4; ++m)
#pragma unroll
                    for (int n = 0; n < 2; ++n) acc[a][b][m][n] = (f32x4){0.f, 0.f, 0.f, 0.f};
        cur = nxt; cA = nA; cB = nB; ++ui;
        if constexpr (ALIGN_EPI) { if (wr == 1) PG8_BAR; }
    }
    PG8_WAIT_V(0);
    if constexpr (!ALIGN_EPI) { if (wr == 0) PG8_BAR; }
    PG8_BAR;
    if constexpr (Epi::AFTER_DRAIN) { E.fused(acc, cur, wr, wc, fr, fq, lds, wid, lane); S.done(cur); }
#undef PG8_SA
#undef PG8_SB
#undef PG8_STAGE
#undef PG8_LDA
#undef PG8_LDB
#undef PG8_MMA
#undef PG8_WAIT_V
#undef PG8_WAIT_L
#undef PG8_BAR
#undef PG8_SCHED
}
}
constexpr int NWAVES = 8, NTHR = 512;
constexpr size_t MiB = 1u << 20;
constexpr size_t WS_CTL = 0, CTL_ZERO_BYTES = 2 * MiB;
constexpr size_t WS_MODS = 256 * 1024;
constexpr size_t WS_STAT = 768 * 1024;
constexpr size_t WS_SW = 1 * MiB + 64 * 1024, WS_GT = 374 * MiB;
static_assert(WS_SW + 8 * 5 * 5632 * 4 <= 2 * MiB, "shift @ W rows inside the zeroed region");
constexpr size_t WS_ROPE = 1 * MiB;
constexpr size_t WS_W = 2 * MiB;
constexpr size_t W_MLA = WS_W, MLA_WB = 5898240;
constexpr size_t MW_CAT = 0, MW_UQ = 1572864, MW_UKV = 2752512, MW_O = 3801088;
constexpr size_t W_CV1 = WS_W + 2 * MLA_WB, W_CV2 = W_CV1 + 4 * MiB;
constexpr size_t W_SSI = W_CV2 + 2 * MiB, W_SSO = W_SSI + 11010048;
constexpr size_t W_FF = W_SSO + 4 * MiB, FF_WB = 17301504, FW_IN = 0, FW_OUT = 11534336;
static_assert(W_FF + 4 * FF_WB <= 102 * MiB, "weights region");
constexpr size_t WS_H = 102 * MiB;
constexpr size_t WS_CKV = 118 * MiB, CKV_B = (size_t)(T + NCTX) * KVL * 2;
constexpr size_t WS_AR = 128 * MiB;
constexpr size_t A_LAT = WS_AR, A_QN = A_LAT + 24 * MiB, A_QRAW = A_QN + 6 * MiB, A_KVRAW = A_QRAW + 24 * MiB, A_QB = A_KVRAW + 36 * MiB, A_KB = A_QB + 24 * MiB, A_AO = A_KB + 27 * MiB;
constexpr size_t A_U = WS_AR, A_V = A_U + 16 * MiB;
constexpr size_t A_Z = WS_AR, A_XPRE = A_Z + 32 * MiB, A_DTRAW = A_XPRE + 48 * MiB, A_XBC = A_DTRAW + 2 * MiB, A_DT = A_XBC + 48 * MiB, A_Y = A_DT + 2 * MiB, A_YN = A_XPRE, A_ACUM = A_Y + 64 * MiB;
constexpr size_t A_ACT = WS_AR + 200 * MiB;
static_assert(A_AO + 16 * MiB <= A_ACT && A_ACUM + 2 * MiB <= A_ACT && A_ACT + 44 * MiB <= 384 * MiB, "arena map");
constexpr int CW_BAR = 4096;
constexpr int LDS_BYTES = 163840, RING_BYTES = 131072, MISC_OFF = 163840 - 256, PTAB_OFF_C = MISC_OFF - 512;

#define GAS __attribute__((address_space(1)))
#define LAS __attribute__((address_space(3)))
typedef unsigned short bf16;
typedef unsigned v4u __attribute__((ext_vector_type(4)));
typedef unsigned v2u __attribute__((ext_vector_type(2)));
typedef float v4f __attribute__((ext_vector_type(4)));
typedef float v2f __attribute__((ext_vector_type(2)));
typedef GAS unsigned gu32;
#define LDS_WAIT() asm volatile("s_waitcnt lgkmcnt(0)" ::: "memory")
#define LDS_BARRIER() do { asm volatile("s_waitcnt lgkmcnt(0)" ::: "memory"); __builtin_amdgcn_s_barrier(); asm volatile("" ::: "memory"); } while (0)
#define VM_WAIT() asm volatile("s_waitcnt vmcnt(0)" ::: "memory")
__device__ __forceinline__ unsigned f2bf(float f) { unsigned u = __builtin_bit_cast(unsigned, f); return (u + 0x7fffu + ((u >> 16) & 1u)) >> 16; }
__device__ __forceinline__ unsigned pk2(float lo, float hi) { unsigned r; asm("v_cvt_pk_bf16_f32 %0, %1, %2" : "=v"(r) : "v"(lo), "v"(hi)); return r; }
__device__ __forceinline__ float fast_sig(float x) { return __builtin_amdgcn_rcpf(1.f + __builtin_amdgcn_exp2f(-1.4426950408889634f * x)); }
__device__ __forceinline__ float bflo(unsigned u) { return __builtin_bit_cast(float, u << 16); }
__device__ __forceinline__ float bfhi(unsigned u) { return __builtin_bit_cast(float, u & 0xffff0000u); }
__device__ __forceinline__ float bf2f(bf16 b) { return __builtin_bit_cast(float, (unsigned)b << 16); }

#define XB_TMO      128
#define XB_XCNT(j)  (256  + 64 * (j))
#define XB_XSUB(j)  (1280 + 64 * (j))
#define XB_XGEN(j)  (2304 + 64 * (j))
#define XB_TOP      3328
#define XB_TOPGEN   3392
#define XCD_BAR_WORDS 3456
#define XB_SPIN_CAP (1u << 18)

__device__ __forceinline__ unsigned xb_ld(unsigned* p)              { return __hip_atomic_load(p, __ATOMIC_RELAXED, __HIP_MEMORY_SCOPE_AGENT); }
__device__ __forceinline__ unsigned xb_add(unsigned* p, unsigned v) { return __hip_atomic_fetch_add(p, v, __ATOMIC_RELAXED, __HIP_MEMORY_SCOPE_AGENT); }
__device__ __forceinline__ unsigned xb_xcc_id() { return (unsigned)__builtin_amdgcn_s_getreg((3 << 11) | 20) & 0xFu; }
#define XB_SPIN(cond, bar) do { unsigned _sp = 0; while (cond) { __builtin_amdgcn_s_sleep(1); \
    if ((++_sp & 255u) == 0u) { if (xb_ld(&(bar)[XB_TMO])) break; if (_sp > XB_SPIN_CAP) { atomicAdd(&(bar)[XB_TMO], 1u); break; } } } } while (0)

struct XcdBarrier {
    unsigned* bar; unsigned x;
    volatile LAS unsigned* st;
};

__device__ __forceinline__ XcdBarrier xcd_barrier_post(unsigned* bar, volatile LAS unsigned* st) {
    XcdBarrier b; b.bar = bar; b.x = xb_xcc_id(); b.st = st;
    if (threadIdx.x == 0) (void)xb_add(&bar[XB_XCNT(b.x)], 1u);
    return b;
}
__device__ __forceinline__ void xcd_barrier_complete(unsigned* bar, unsigned x, unsigned& nloc, unsigned& nx) {
    const unsigned G = gridDim.x * gridDim.y * gridDim.z;
    unsigned sum, cnt, mine, sp = 0u;
    for (;;) {
        sum = 0u; cnt = 0u; mine = 0u;
#pragma unroll
        for (unsigned j = 0; j < 16; j += 8) {
            unsigned c[8]; const unsigned* p = bar + XB_XCNT(j);
            asm volatile("global_load_dword %0, %8, off sc1\n\tglobal_load_dword %1, %8, off offset:256 sc1\n\tglobal_load_dword %2, %8, off offset:512 sc1\n\tglobal_load_dword %3, %8, off offset:768 sc1\n\t"
                         "global_load_dword %4, %8, off offset:1024 sc1\n\tglobal_load_dword %5, %8, off offset:1280 sc1\n\tglobal_load_dword %6, %8, off offset:1536 sc1\n\tglobal_load_dword %7, %8, off offset:1792 sc1\n\t"
                         "s_waitcnt vmcnt(0)"
                         : "=&v"(c[0]), "=&v"(c[1]), "=&v"(c[2]), "=&v"(c[3]), "=&v"(c[4]), "=&v"(c[5]), "=&v"(c[6]), "=&v"(c[7]) : "v"(p) : "memory");
#pragma unroll
            for (unsigned i = 0; i < 8; ++i) { sum += c[i]; cnt += (c[i] > 0u) ? 1u : 0u; mine = (j + i == x) ? c[i] : mine; } }
        if (sum == G) break;
        __builtin_amdgcn_s_sleep(1);
        if ((++sp & 255u) == 0u) { if (xb_ld(&bar[XB_TMO])) break; if (sp > XB_SPIN_CAP) { atomicAdd(&bar[XB_TMO], 1u); break; } }
    }
    nloc = mine > 0u ? mine : 1u; nx = cnt > 0u ? cnt : 1u;
}

__device__ __forceinline__ void xcd_barrier_protocol(const XcdBarrier& b) {
    {
        unsigned* bar = b.bar;
        __builtin_amdgcn_s_waitcnt(0);
        unsigned nloc = b.st[0], nx = b.st[1];
        if (nloc == 0u) { xcd_barrier_complete(bar, b.x, nloc, nx); b.st[0] = nloc; b.st[1] = nx; }
        const unsigned old = xb_add(&bar[XB_XSUB(b.x)], 1u);
        const unsigned gen = old / nloc;
        if (old + 1u == (gen + 1u) * nloc) {
            __builtin_amdgcn_fence(__ATOMIC_RELEASE, "agent");
            asm volatile("s_waitcnt vmcnt(0)" ::: "memory");
            const unsigned og = xb_add(&bar[XB_TOP], 1u);
            const unsigned tg = og / nx;
            if (og + 1u == (tg + 1u) * nx) xb_add(&bar[XB_TOPGEN], 1u);
            else XB_SPIN(xb_ld(&bar[XB_TOPGEN]) == tg, bar);
            __builtin_amdgcn_fence(__ATOMIC_ACQUIRE, "agent");
            xb_add(&bar[XB_XGEN(b.x)], 1u);
            asm volatile("s_waitcnt vmcnt(0)" ::: "memory");
        } else {
            XB_SPIN(xb_ld(&bar[XB_XGEN(b.x)]) == gen, bar);
            __builtin_amdgcn_fence(__ATOMIC_ACQUIRE, "agent");
            asm volatile("s_waitcnt vmcnt(0)" ::: "memory");
        }
    }
}
__device__ __forceinline__ void xcd_barrier(const XcdBarrier& b) {
    asm volatile("s_waitcnt vmcnt(0)" ::: "memory");
    __syncthreads();
    if (threadIdx.x == 0) xcd_barrier_protocol(b);
    __syncthreads();
}
struct Frame {
    LAS unsigned char* lds; int tid, lane, wave, vcu, G, gw, NGW, bx;
    volatile LAS unsigned* PT;
};
constexpr int PT_OUT = 38, PT_WS = 39;
__device__ __forceinline__ const float* ldp(volatile LAS unsigned* PT, int k) {
    const unsigned lo = __builtin_amdgcn_readfirstlane(PT[2 * k]), hi = __builtin_amdgcn_readfirstlane(PT[2 * k + 1]);
    return (const float*)(((unsigned long long)hi << 32) | lo);
}
#define INP(k) ldp(F.PT, (k))
#define WSP ((unsigned char*)ldp(F.PT, PT_WS))
#define OUTP ((float*)ldp(F.PT, PT_OUT))
enum InIdx { I_XP = 0, I_XS, I_CCKV, I_CKPE, I_SSM, I_C, I_CCTX, I_WADA, I_BADA, I_GN1, I_GN2, I_WDQ, I_GQ, I_WUQ, I_WDKV, I_GKV, I_WUKV, I_GQN, I_GKN, I_WO,
             I_CVW1, I_CVB1, I_CVWD, I_CVBD, I_CVGL, I_CVBL, I_CVW2, I_CVB2, I_SSWI, I_SSWC, I_SSBC, I_SSDTB, I_SSAL, I_SSD, I_SSGN, I_SSWO, I_FFWI, I_FFWO };
__device__ __forceinline__ float shx(float v, int lane, int o) { return __builtin_bit_cast(float, __builtin_amdgcn_ds_bpermute((lane ^ o) << 2, __builtin_bit_cast(int, v))); }
__device__ __forceinline__ float wsum(float v, int lane) {
#pragma unroll
    for (int o = 1; o < 64; o <<= 1) v += shx(v, lane, o);
    return v;
}
constexpr float QSCALE = 0.10206207261596577f * 1.4426950408889634f;

struct P0Item { const float* W; bf16* WT; int K, N, mode, H, roff, k0, n0; const float* sh; float* sw; };
__device__ __forceinline__ void p0_item_load(const P0Item& J, int lane, v4f (&t)[8]) {
#pragma unroll
    for (int i = 0; i < 8; ++i) t[i] = *(const GAS v4f*)(J.W + (size_t)(J.k0 + 8 * i + (lane >> 3)) * J.N + J.n0 + 4 * (lane & 7));
}
__device__ __forceinline__ void p0_item_shift(const P0Item& J, int lane, v4f (&sv)[5][2]) {
#pragma unroll
    for (int cc = 0; cc < 5; ++cc) { const float* sp = J.sh + (size_t)cc * 6144 + J.k0 + 8 * (lane & 7); sv[cc][0] = *(const GAS v4f*)sp; sv[cc][1] = *(const GAS v4f*)(sp + 4); }
}
__device__ __forceinline__ void p0_item_finish(const P0Item& J, int lane, const v4f (&t)[8], LAS float* scr, const v4f (&sv)[5][2]) {
#pragma unroll
    for (int i = 0; i < 8; ++i) { LAS float* d = scr + (8 * i + (lane >> 3)) * 33 + 4 * (lane & 7); d[0] = t[i].x; d[1] = t[i].y; d[2] = t[i].z; d[3] = t[i].w; }
    LDS_WAIT(); asm volatile("" ::: "memory");
    const int c = lane & 7;
#pragma unroll
    for (int j = 0; j < 4; ++j) { const int n = (lane >> 3) + 8 * j, col = J.n0 + n; const LAS float* s = scr + (8 * c) * 33 + n;
        int drow;
        if (J.mode == 0) drow = J.roff + col;
        else { const int f = col < J.H ? col : col - J.H; drow = 256 * (f >> 7) + 128 * ((f >> 2) & 1) + 32 * ((f >> 5) & 3) + (col < J.H ? 0 : 16) + 4 * ((f >> 3) & 3) + (f & 3); }
        v4u o; o.x = pk2(s[0 * 33], s[1 * 33]); o.y = pk2(s[2 * 33], s[3 * 33]); o.z = pk2(s[4 * 33], s[5 * 33]); o.w = pk2(s[6 * 33], s[7 * 33]);
        *(GAS v4u*)(J.WT + (size_t)drow * J.K + J.k0 + 8 * c) = o; }
    if (J.sw) {
        float pw[4][5];
#pragma unroll
        for (int cc = 0; cc < 5; ++cc) { const v4f s0 = sv[cc][0], s1 = sv[cc][1];
#pragma unroll
            for (int j = 0; j < 4; ++j) { const LAS float* q = scr + (8 * c) * 33 + (lane >> 3) + 8 * j;
                pw[j][cc] = (s0.x * q[0 * 33] + s0.y * q[1 * 33] + s0.z * q[2 * 33] + s0.w * q[3 * 33]) + (s1.x * q[4 * 33] + s1.y * q[5 * 33] + s1.z * q[6 * 33] + s1.w * q[7 * 33]); } }
#pragma unroll
        for (int o = 1; o < 8; o <<= 1) {
#pragma unroll
            for (int j = 0; j < 4; ++j)
#pragma unroll
                for (int cc = 0; cc < 5; ++cc) pw[j][cc] += shx(pw[j][cc], lane, o); }
        if (c == 0) {
#pragma unroll
            for (int j = 0; j < 4; ++j) { const int col = J.n0 + (lane >> 3) + 8 * j; int drow;
                if (J.mode == 0) drow = J.roff + col;
                else { const int f = col < J.H ? col : col - J.H; drow = 256 * (f >> 7) + 128 * ((f >> 2) & 1) + 32 * ((f >> 5) & 3) + (col < J.H ? 0 : 16) + 4 * ((f >> 3) & 3) + (f & 3); }
#pragma unroll
                for (int cc = 0; cc < 5; ++cc) atomicAdd(J.sw + (size_t)cc * pg8::SW_LD + drow, pw[j][cc]); } }
    }
    LDS_WAIT(); asm volatile("" ::: "memory");
}
__device__ __forceinline__ void p0_job(int q, int& inp, size_t& soff, int& K, int& N, size_t& doff, int& mode, int& H, int& roff) {
    mode = 0; H = 0; roff = 0; soff = 0;
    if (q < 10) { const int j = q / 5, t = q % 5; const size_t wb = W_MLA + (size_t)j * MLA_WB;
        if (t == 0) { inp = I_WDQ; soff = (size_t)j * 1024 * 384; K = 1024; N = 384; doff = wb + MW_CAT; }
        else if (t == 1) { inp = I_WDKV; soff = (size_t)j * 1024 * 288; K = 1024; N = 288; doff = wb + MW_CAT; roff = 384; }
        else if (t == 2) { inp = I_WUQ; soff = (size_t)j * 384 * 1536; K = 384; N = 1536; doff = wb + MW_UQ; }
        else if (t == 3) { inp = I_WUKV; soff = (size_t)j * 256 * 2048; K = 256; N = 2048; doff = wb + MW_UKV; }
        else { inp = I_WO; soff = (size_t)j * 1024 * 1024; K = 1024; N = 1024; doff = wb + MW_O; } }
    else if (q == 10) { inp = I_CVW1; K = 1024; N = 2048; doff = W_CV1; mode = 1; H = 1024; }
    else if (q == 11) { inp = I_CVW2; K = 1024; N = 1024; doff = W_CV2; }
    else if (q == 12) { inp = I_SSWI; K = 1024; N = 5184; doff = W_SSI; }
    else if (q == 13) { inp = I_SSWO; K = 2048; N = 1024; doff = W_SSO; }
    else { const int l = (q - 14) >> 1, t = (q - 14) & 1;
        if (t == 0) { inp = I_FFWI; soff = (size_t)l * 1024 * 5632; K = 1024; N = 5632; doff = W_FF + (size_t)l * FF_WB + FW_IN; mode = 1; H = 2816; }
        else { inp = I_FFWO; soff = (size_t)l * 2816 * 1024; K = 2816; N = 1024; doff = W_FF + (size_t)l * FF_WB + FW_OUT; } }
}
__device__ __forceinline__ int p0_sw_of_job(int q) { return q == 10 ? 2 : q == 12 ? 4 : (q == 5 || q == 6) ? 6 : (q >= 16 && !((q - 14) & 1)) ? 2 * ((q - 14) >> 1) + 1 : -1; }
constexpr int P0_NITEMS = 2 * ((1024 / 64) * (384 / 32) + (1024 / 64) * (288 / 32) + (384 / 64) * (1536 / 32) + (256 / 64) * (2048 / 32) + (1024 / 64) * (1024 / 32))
                        + (1024 / 64) * (2048 / 32) + (1024 / 64) * (1024 / 32) + (1024 / 64) * (5184 / 32) + (2048 / 64) * (1024 / 32)
                        + 4 * ((1024 / 64) * (5632 / 32) + (2816 / 64) * (1024 / 32));
__device__ __forceinline__ void p0_convert(Frame& F, unsigned qmask, int ww, int nww, bool fuse) {
    unsigned char* ws = WSP;
    LAS float* scr = (LAS float*)(F.lds + F.wave * 8448);
    int total = 0;
#pragma unroll 1
    for (int q = 0; q < 22; ++q) if ((qmask >> q) & 1u) { int inp, K, N, mode, H, roff; size_t soff, doff; p0_job(q, inp, soff, K, N, doff, mode, H, roff); total += (K / 64) * (N / 32); }
    for (int it = ww; it < total; it += 2 * nww) {
        P0Item J[2]; bool have1 = it + nww < total;
#pragma unroll
        for (int e = 0; e < 2; ++e) {
            int r = e == 0 ? it : (have1 ? it + nww : it), inp = 0, K = 64, N = 32, mode = 0, H = 0, roff = 0, qq = 0; size_t soff = 0, doff = 0;
#pragma unroll 1
            for (int q = 0; q < 22; ++q) { if (!((qmask >> q) & 1u)) continue; p0_job(q, inp, soff, K, N, doff, mode, H, roff); qq = q; const int ni = (K / 64) * (N / 32); if (r < ni) break; r -= ni; }
            const int nblk = N / 32;
            J[e].W = INP(inp) + soff; J[e].WT = (bf16*)(ws + doff); J[e].K = K; J[e].N = N; J[e].mode = mode; J[e].H = H; J[e].roff = roff; J[e].k0 = 64 * (r / nblk); J[e].n0 = 32 * (r % nblk);
            const int sidx = fuse ? p0_sw_of_job(qq) : -1;
            J[e].sh = nullptr; J[e].sw = nullptr;
            if (sidx >= 0) { J[e].sh = (const float*)(ws + WS_MODS) + (size_t)(sidx >> 1) * 5 * 6144 + ((sidx & 1) ? 3072 : 0); J[e].sw = (float*)(ws + WS_SW) + (size_t)sidx * 5 * pg8::SW_LD; }
        }
        v4f t0[8], t1[8];
        p0_item_load(J[0], F.lane, t0); p0_item_load(J[1], F.lane, t1);
        v4f sv0[5][2], sv1[5][2];
#pragma unroll
        for (int cc = 0; cc < 5; ++cc) { sv0[cc][0] = sv0[cc][1] = sv1[cc][0] = sv1[cc][1] = (v4f){0.f, 0.f, 0.f, 0.f}; }
        if (J[0].sw) p0_item_shift(J[0], F.lane, sv0);
        if (J[1].sw) p0_item_shift(J[1], F.lane, sv1);
        p0_item_finish(J[0], F.lane, t0, scr, sv0);
        if (have1) p0_item_finish(J[1], F.lane, t1, scr, sv1);
    }
}
constexpr unsigned P0_Q_NOW = 0x1fu | (1u << 14);
constexpr int P0_WIN_LAST = 12;
__device__ __forceinline__ int p0_def_job(int i) { return i == 0 ? 15 : i == 1 ? 10 : i == 2 ? 11 : i == 3 ? 16 : i == 4 ? 17 : i == 5 ? 12 : i == 6 ? 13 : i == 7 ? 18 : i == 8 ? 19 : i < 14 ? i - 4 : i == 14 ? 20 : 21; }
constexpr int P0_WIN_CAP = 1792;
static_assert(P0_WIN_CAP * P0_WIN_LAST >= 20624, "deferred items fit the windows");
__device__ __forceinline__ bool p0_def_item(Frame& F, int r, P0Item& J) {
    unsigned char* ws = WSP;
    int inp = 0, K = 64, N = 32, mode = 0, H = 0, roff = 0, qq = 0; size_t soff = 0, doff = 0; bool found = false;
#pragma unroll 1
    for (int i = 0; i < 16; ++i) { qq = p0_def_job(i); p0_job(qq, inp, soff, K, N, doff, mode, H, roff); const int ni = (K / 64) * (N / 32); if (r < ni) { found = true; break; } r -= ni; }
    if (!found) return false;
    const int nblk = N / 32;
    J.W = INP(inp) + soff; J.WT = (bf16*)(ws + doff); J.K = K; J.N = N; J.mode = mode; J.H = H; J.roff = roff; J.k0 = 64 * (r / nblk); J.n0 = 32 * (r % nblk);
    const int sidx = p0_sw_of_job(qq); J.sh = nullptr; J.sw = nullptr;
    if (sidx >= 0) { J.sh = (const float*)(ws + WS_MODS) + (size_t)(sidx >> 1) * 5 * 6144 + ((sidx & 1) ? 3072 : 0); J.sw = (float*)(ws + WS_SW) + (size_t)sidx * 5 * pg8::SW_LD; }
    return true;
}
constexpr int P0_DUMP = 161792;
static_assert(P0_DUMP + 1024 <= PTAB_OFF_C, "prefetch dump area");
__device__ __forceinline__ void p0_window(Frame& F, int w) {
    for (int e = F.bx * (NWAVES - 1) + (F.wave - 1); e < P0_WIN_CAP; e += F.G * (NWAVES - 1)) {
        P0Item J;
        if (!p0_def_item(F, (w - 1) * P0_WIN_CAP + e, J)) return;
        v4f t0[8], sv[5][2];
        p0_item_load(J, F.lane, t0);
#pragma unroll
        for (int cc = 0; cc < 5; ++cc) { sv[cc][0] = sv[cc][1] = (v4f){0.f, 0.f, 0.f, 0.f}; }
        if (J.sw) p0_item_shift(J, F.lane, sv);
        p0_item_finish(J, F.lane, t0, (LAS float*)(F.lds + F.wave * 8448), sv);
    }
}
__device__ __forceinline__ void xcd_barrier_work(const XcdBarrier& b, Frame& F, int w) {
    asm volatile("s_waitcnt vmcnt(0)" ::: "memory");
    __syncthreads();
    if (threadIdx.x == 0) xcd_barrier_protocol(b);
    if (F.wave != 0 && w >= 1 && w <= P0_WIN_LAST) p0_window(F, w);
    __syncthreads();
}
__device__ __forceinline__ void p0_prologue(Frame& F) {
    unsigned char* ws = WSP;
    LAS float* s = (LAS float*)F.lds;
    for (int i = F.tid; i < 5 * 1024; i += NTHR) { const int cc = i >> 10, k = i & 1023; const float v = cc == 0 ? INP(I_CCTX)[k] : INP(I_C)[(cc - 1) * 1024 + k]; s[i] = v / (1.f + expf(-v)); }
    __syncthreads();
    float* mods = (float*)(ws + WS_MODS);
    for (int it = F.bx; it < 192; it += F.G) {
        const int l = it / 48, r = it % 48, cb = r / 16, ks = r % 16, n = cb * 2048 + 4 * F.tid;
        const float* W = INP(I_WADA) + (size_t)l * 1024 * 6144 + (size_t)(ks * 64) * 6144 + n;
        v4f acc[5];
#pragma unroll
        for (int cc = 0; cc < 5; ++cc) acc[cc] = (v4f){0.f, 0.f, 0.f, 0.f};
#pragma unroll 1
        for (int kb = 0; kb < 64; kb += 16) {
            v4f wv[16];
#pragma unroll
            for (int k = 0; k < 16; ++k) wv[k] = *(const GAS v4f*)(W + (size_t)(kb + k) * 6144);
#pragma unroll
            for (int k = 0; k < 16; ++k)
#pragma unroll
                for (int cc = 0; cc < 5; ++cc) acc[cc] += wv[k] * s[cc * 1024 + ks * 64 + kb + k];
        }
        LAS float* tbl = s + 5 * 1024;
        __syncthreads();
#pragma unroll
        for (int cc = 0; cc < 5; ++cc) *(LAS v4f*)(tbl + cc * 2048 + 4 * F.tid) = acc[cc];
        __syncthreads();
        const float* bp = INP(I_BADA) + l * 6144 + cb * 2048;
#pragma unroll
        for (int q = 0; q < 4; ++q) { const int col = q * 512 + F.tid; const float bb = ks == 0 ? bp[col] : 0.f;
#pragma unroll
            for (int cc = 0; cc < 5; ++cc) atomicAdd(&mods[((size_t)l * 5 + cc) * 6144 + cb * 2048 + col], tbl[cc * 2048 + col] + bb); }
    }
    __syncthreads();
    p0_convert(F, P0_Q_NOW, F.gw, F.NGW, false);
    for (int it = F.gw; it < 384; it += F.NGW) {
        bf16* rowp = it < 192 ? (bf16*)(ws + W_MLA + (it / 96) * MLA_WB + MW_CAT) + (size_t)(672 + it % 96) * 1024 : (bf16*)(ws + W_SSI) + (size_t)(5184 + it - 192) * 1024;
        const v4u z = {0u, 0u, 0u, 0u}; ((GAS v4u*)rowp)[F.lane] = z; ((GAS v4u*)rowp)[64 + F.lane] = z;
    }
    for (int it = F.gw; it < 2048; it += F.NGW) {
        const int j = it >> 10, rr = it & 1023, b = rr >> 8, sq = rr & 255;
        const v4f v = ((const GAS v4f*)(INP(I_CCKV) + (((size_t)b * 2 + j) * 256 + sq) * 256))[F.lane];
        v2u o; o.x = pk2(v.x, v.y); o.y = pk2(v.z, v.w);
        ((GAS v2u*)((bf16*)(ws + WS_CKV + j * CKV_B) + (size_t)(T + rr) * 256))[F.lane] = o;
    }
    if (F.bx == 0) for (int i = F.tid; i < 640; i += NTHR) { const int pos = i >> 3, fi = i & 7; const float p = (float)(pos < 16 ? pos : pos - 16);
        const float a = p * rope_inv(fi); float* tab = (float*)(ws + WS_ROPE); tab[2 * i] = cosf(a); tab[2 * i + 1] = sinf(a); }
}

__device__ __forceinline__ void rp_normmod(Frame& F, const float* xlo, const float* xhi, const float* g, const float* mods_l, int sh_off, int sc_off, bf16* h) {
    for (int base = F.gw; base < T; base += 4 * F.NGW) {
        v4f v[4][4]; float ss[4]; int rows[4];
#pragma unroll
        for (int k = 0; k < 4; ++k) { const int row = base + k * F.NGW; rows[k] = row < T ? row : base;
            const GAS v4f* xr = (const GAS v4f*)((rows[k] < TP ? xlo : xhi) + (size_t)rows[k] * 1024) + F.lane;
#pragma unroll
            for (int j = 0; j < 4; ++j) v[k][j] = xr[64 * j]; }
#pragma unroll
        for (int k = 0; k < 4; ++k) { float s = 0.f;
#pragma unroll
            for (int j = 0; j < 4; ++j) s += (v[k][j].x * v[k][j].x + v[k][j].y * v[k][j].y) + (v[k][j].z * v[k][j].z + v[k][j].w * v[k][j].w);
            ss[k] = s; }
#pragma unroll
        for (int o = 1; o < 64; o <<= 1) {
#pragma unroll
            for (int k = 0; k < 4; ++k) ss[k] += shx(ss[k], F.lane, o); }
#pragma unroll
        for (int j = 0; j < 4; ++j) { const int c = 4 * F.lane + 256 * j; const v4f g4 = *(const GAS v4f*)(g + c);
#pragma unroll
            for (int k = 0; k < 4; ++k) { const float r = rsqrtf(ss[k] * (1.f / 1024) + EPS); const float* m = mods_l + (size_t)cond_of_row(rows[k]) * 6144;
                const v4f sc = *(const GAS v4f*)(m + sc_off + c), sh = *(const GAS v4f*)(m + sh_off + c);
                const v4f o = v[k][j] * r * g4 * (sc + 1.f) + sh; v2u w; w.x = pk2(o.x, o.y); w.y = pk2(o.z, o.w);
                *(GAS v2u*)(h + (size_t)rows[k] * 1024 + c) = w; } }
    }
}
__device__ __forceinline__ void rp_mla_fin1(Frame& F, const float* lat, const float* gq, const float* gkv, bf16* qn, bf16* ckv, float* out, int j) {
    v2f gqv[3], gkvv[2];
#pragma unroll
    for (int i = 0; i < 3; ++i) gqv[i] = *(const GAS v2f*)(gq + 2 * F.lane + 128 * i);
#pragma unroll
    for (int i = 0; i < 2; ++i) gkvv[i] = *(const GAS v2f*)(gkv + 2 * F.lane + 128 * i);
    for (int base = F.gw; base < T; base += 4 * F.NGW) {
        v2f q[4][3], k[4][2]; float pe[4]; int rows[4];
#pragma unroll
        for (int b = 0; b < 4; ++b) { const int row = base + b * F.NGW; rows[b] = row < T ? row : base;
            const float* lr = lat + (size_t)rows[b] * 768;
#pragma unroll
            for (int i = 0; i < 3; ++i) q[b][i] = *(const GAS v2f*)(lr + 2 * F.lane + 128 * i);
#pragma unroll
            for (int i = 0; i < 2; ++i) k[b][i] = *(const GAS v2f*)(lr + 384 + 2 * F.lane + 128 * i);
            pe[b] = *(const GAS float*)(lr + 640 + (F.lane & 31)); }
        __builtin_amdgcn_sched_barrier(0);
#pragma unroll
        for (int b = 0; b < 4; ++b) { const int row = base + b * F.NGW; if (row >= T) break;
            float ss = 0.f;
#pragma unroll
            for (int i = 0; i < 3; ++i) ss += q[b][i].x * q[b][i].x + q[b][i].y * q[b][i].y;
            float r = __builtin_amdgcn_rsqf(wsum(ss, F.lane) * (1.f / 384) + EPS);
#pragma unroll
            for (int i = 0; i < 3; ++i) { const int c = 2 * F.lane + 128 * i; *(GAS unsigned*)(qn + (size_t)row * 384 + c) = pk2(q[b][i].x * r * gqv[i].x, q[b][i].y * r * gqv[i].y); }
            ss = 0.f;
#pragma unroll
            for (int i = 0; i < 2; ++i) ss += k[b][i].x * k[b][i].x + k[b][i].y * k[b][i].y;
            r = __builtin_amdgcn_rsqf(wsum(ss, F.lane) * (1.f / 256) + EPS);
#pragma unroll
            for (int i = 0; i < 2; ++i) { const int c = 2 * F.lane + 128 * i; const float c0 = k[b][i].x * r * gkvv[i].x, c1 = k[b][i].y * r * gkvv[i].y;
                *(GAS unsigned*)(ckv + (size_t)row * 256 + c) = pk2(c0, c1);
                if (row < TP) { v2f o; o.x = c0; o.y = c1; *(GAS v2f*)(out + OUT_CKV + (((size_t)(row >> 8) * 2 + j) * 256 + (row & 255)) * 256 + c) = o; } }
            if (row < TP && F.lane < 32) *(GAS float*)(out + OUT_KPE + (((size_t)(row >> 8) * 2 + j) * 256 + (row & 255)) * 32 + F.lane) = pe[b];
        }
    }
}
__device__ __forceinline__ void rope32_tab(float* pe, int t, const float* tab) {
    const v2f* tr = (const v2f*)tab + (t >> 6) * 8; const v2f* tc = (const v2f*)tab + (16 + (t & 63)) * 8;
#pragma unroll
    for (int i = 0; i < 8; ++i) {
        v2f cs = tr[i]; float x1 = pe[i], x2 = pe[i + 8]; pe[i] = x1 * cs.x - x2 * cs.y; pe[i + 8] = x2 * cs.x + x1 * cs.y;
        cs = tc[i]; x1 = pe[16 + i]; x2 = pe[24 + i]; pe[16 + i] = x1 * cs.x - x2 * cs.y; pe[24 + i] = x2 * cs.x + x1 * cs.y;
    }
}
struct RopeCS { v4f r[4], c[4]; };
__device__ __forceinline__ void rope_load(RopeCS& R, int t, const float* tab) {
    const float* tr = tab + (t >> 6) * 16; const float* tc = tab + (16 + (t & 63)) * 16;
#pragma unroll
    for (int i = 0; i < 4; ++i) { R.r[i] = *(const GAS v4f*)(tr + 4 * i); R.c[i] = *(const GAS v4f*)(tc + 4 * i); }
}
__device__ __forceinline__ void rope_apply(float* pe, const RopeCS& R) {
#pragma unroll
    for (int i = 0; i < 8; ++i) {
        float cx = (i & 1) ? R.r[i >> 1].z : R.r[i >> 1].x, sy = (i & 1) ? R.r[i >> 1].w : R.r[i >> 1].y; float x1 = pe[i], x2 = pe[i + 8]; pe[i] = x1 * cx - x2 * sy; pe[i + 8] = x2 * cx + x1 * sy;
        cx = (i & 1) ? R.c[i >> 1].z : R.c[i >> 1].x; sy = (i & 1) ? R.c[i >> 1].w : R.c[i >> 1].y; x1 = pe[16 + i]; x2 = pe[24 + i]; pe[16 + i] = x1 * cx - x2 * sy; pe[24 + i] = x2 * cx + x1 * sy;
    }
}
__device__ __forceinline__ void ld8(const bf16* p, float* d) { const v4u w = *(const GAS v4u*)p; d[0] = bflo(w.x); d[1] = bfhi(w.x); d[2] = bflo(w.y); d[3] = bfhi(w.y); d[4] = bflo(w.z); d[5] = bfhi(w.z); d[6] = bflo(w.w); d[7] = bfhi(w.w); }
__device__ __forceinline__ void up8(const v4u w, float* d) { d[0] = bflo(w.x); d[1] = bfhi(w.x); d[2] = bflo(w.y); d[3] = bfhi(w.y); d[4] = bflo(w.z); d[5] = bfhi(w.z); d[6] = bflo(w.w); d[7] = bfhi(w.w); }
__device__ __forceinline__ void st8(bf16* p, const float* d) { v4u w; w.x = pk2(d[0], d[1]); w.y = pk2(d[2], d[3]); w.z = pk2(d[4], d[5]); w.w = pk2(d[6], d[7]); *(GAS v4u*)p = w; }
__device__ __forceinline__ void rp_tables(Frame& F) {
    unsigned char* ws = WSP; const float* mods = (const float*)(ws + WS_MODS); float* GTb = (float*)(ws + WS_GT); float* SWb = (float*)(ws + WS_SW);
    for (int idx = F.bx * NTHR + F.tid; idx < 8 * 5 * 1024; idx += F.G * NTHR) {
        const int s = idx / 5120, r = idx % 5120, c = r >> 10, k = r & 1023, layer = s >> 1;
        const float g = (s & 1) ? INP(I_GN2)[layer * 1024 + k] : INP(I_GN1)[layer * 1024 + k];
        GTb[idx] = g * (1.f + mods[((size_t)layer * 5 + c) * 6144 + ((s & 1) ? 4096 : 1024) + k]);
    }
    constexpr int NR1 = 5632;
    for (int it = F.gw; it < NR1 / 4; it += F.NGW) {
        const int s = 1, n = 4 * it; const bf16* Wt = (const bf16*)(ws + W_FF + FW_IN);
        const int layer = s >> 1, shoff = (s & 1) ? 3072 : 0;
        v4u wr[4][2];
#pragma unroll
        for (int r = 0; r < 4; ++r) { wr[r][0] = *(const GAS v4u*)(Wt + (size_t)(n + r) * 1024 + 16 * F.lane); wr[r][1] = *(const GAS v4u*)(Wt + (size_t)(n + r) * 1024 + 16 * F.lane + 8); }
        float acc[4][5];
#pragma unroll
        for (int r = 0; r < 4; ++r)
#pragma unroll
            for (int c = 0; c < 5; ++c) acc[r][c] = 0.f;
#pragma unroll
        for (int c = 0; c < 5; ++c) { const float* sp = mods + ((size_t)layer * 5 + c) * 6144 + shoff + 16 * F.lane;
            const v4f s0 = *(const GAS v4f*)sp, s1 = *(const GAS v4f*)(sp + 4), s2 = *(const GAS v4f*)(sp + 8), s3 = *(const GAS v4f*)(sp + 12);
#pragma unroll
            for (int r = 0; r < 4; ++r) { const v4u a = wr[r][0], b2 = wr[r][1];
                acc[r][c] = (s0.x * bflo(a.x) + s0.y * bfhi(a.x) + s0.z * bflo(a.y) + s0.w * bfhi(a.y)) + (s1.x * bflo(a.z) + s1.y * bfhi(a.z) + s1.z * bflo(a.w) + s1.w * bfhi(a.w))
                          + (s2.x * bflo(b2.x) + s2.y * bfhi(b2.x) + s2.z * bflo(b2.y) + s2.w * bfhi(b2.y)) + (s3.x * bflo(b2.z) + s3.y * bfhi(b2.z) + s3.z * bflo(b2.w) + s3.w * bfhi(b2.w)); } }
#pragma unroll
        for (int o = 1; o < 64; o <<= 1) {
#pragma unroll
            for (int r = 0; r < 4; ++r)
#pragma unroll
                for (int c = 0; c < 5; ++c) acc[r][c] += shx(acc[r][c], F.lane, o); }
        if (F.lane < 20) { const int r = F.lane / 5, c = F.lane % 5; float v = 0.f;
#pragma unroll
            for (int rr = 0; rr < 4; ++rr)
#pragma unroll
                for (int cc = 0; cc < 5; ++cc) v = (rr == r && cc == c) ? acc[rr][cc] : v;
            SWb[((size_t)s * 5 + c) * 5632 + n + r] = v; }
    }
}
__device__ __forceinline__ void rp_mla_fin2(Frame& F, const bf16* qraw, const bf16* kvraw, const float* lat, const float* ckpe_j, const float* gqn, const float* gkn, const float* tab, bf16* Q, bf16* K) {
    for (int idx = F.bx * NTHR + F.tid; idx < T * 32; idx += F.G * NTHR) {
        const int row = idx >> 5, hd = (idx >> 1) & 15, hf = idx & 1; const bool latent = row >= TP; const int tl = (row - TP) & 1023;
        float v[48]; float ss = 0.f; RopeCS R; v4f gq[12];
#pragma unroll
        for (int i = 0; i < 6; ++i) ld8(qraw + (size_t)row * 1536 + hd * 96 + hf * 48 + 8 * i, v + 8 * i);
#pragma unroll
        for (int i = 0; i < 12; ++i) gq[i] = *(const GAS v4f*)(gqn + hf * 48 + 4 * i);
        if (latent && hf) rope_load(R, tl, tab);
#pragma unroll
        for (int d = 0; d < 48; ++d) ss += v[d] * v[d];
        ss += shx(ss, F.lane, 1);
        const float r = rsqrtf(ss * (1.f / 96) + EPS) * QSCALE;
#pragma unroll
        for (int d = 0; d < 48; ++d) v[d] = v[d] * r * gq[d >> 2][d & 3];
        if (latent && hf) rope_apply(v + 16, R);
#pragma unroll
        for (int i = 0; i < 6; ++i) st8(Q + ((size_t)row * 16 + hd) * 96 + hf * 48 + 8 * i, v + 8 * i);
    }
    asm volatile("" ::: "memory");
    for (int idx = F.bx * NTHR + F.tid; idx < (T + NCTX) * 32; idx += F.G * NTHR) {
        const int row = idx >> 5, hd = (idx >> 1) & 15, hf = idx & 1; const bool latent = row >= TP && row < T; const int tl = (row - TP) & 1023;
        float v[48]; float ss = 0.f; RopeCS R; v4f gk[12];
#pragma unroll
        for (int i = 0; i < 12; ++i) gk[i] = *(const GAS v4f*)(gkn + hf * 48 + 4 * i);
        if (latent && hf) rope_load(R, tl, tab);
        if (hf == 0) {
#pragma unroll
            for (int i = 0; i < 6; ++i) ld8(kvraw + (size_t)row * 2048 + hd * 128 + 8 * i, v + 8 * i);
        } else {
#pragma unroll
            for (int i = 0; i < 2; ++i) ld8(kvraw + (size_t)row * 2048 + hd * 128 + 48 + 8 * i, v + 8 * i);
            const float* kp = row < T ? lat + (size_t)row * 768 + 640 : ckpe_j + ((size_t)((row - T) >> 8) * 2 * 256 + ((row - T) & 255)) * 32;
#pragma unroll
            for (int i = 0; i < 8; ++i) { const v4f p4 = *(const GAS v4f*)(kp + 4 * i); v[16 + 4 * i] = p4.x; v[17 + 4 * i] = p4.y; v[18 + 4 * i] = p4.z; v[19 + 4 * i] = p4.w; }
        }
#pragma unroll
        for (int d = 0; d < 48; ++d) ss += v[d] * v[d];
        ss += shx(ss, F.lane, 1);
        const float r = rsqrtf(ss * (1.f / 96) + EPS);
#pragma unroll
        for (int d = 0; d < 48; ++d) v[d] = v[d] * r * gk[d >> 2][d & 3];
        if (latent && hf) rope_apply(v + 16, R);
#pragma unroll
        for (int i = 0; i < 6; ++i) st8(K + ((size_t)row * 16 + hd) * 96 + hf * 48 + 8 * i, v + 8 * i);
    }
}
__device__ __forceinline__ void rp_dwconv(Frame& F, const bf16* u, const float* wdw, const float* bdw, const float* gln, const float* bln, bf16* vout) {
    LAS float* red = (LAS float*)F.lds;
    const int c = 2 * F.tid;
    for (int it = F.vcu; it < T / 16; it += F.G) {
        const int row0 = 16 * it; int t0, L; row_pos(row0, t0, L);
        v2f w[31];
#pragma unroll
        for (int k = 0; k < 31; ++k) w[k] = *(const GAS v2f*)(wdw + k * 1024 + c);
        const v2f bb = *(const GAS v2f*)(bdw + c);
        unsigned pk[46];
#pragma unroll
        for (int rr = 0; rr < 46; ++rr) { const int tt = t0 - 15 + rr; const bool ok = tt >= 0 && tt < L;
            pk[rr] = *(const GAS unsigned*)(u + (size_t)(ok ? row0 - 15 + rr : row0) * 1024 + c); }
        __builtin_amdgcn_sched_barrier(0);
#pragma unroll
        for (int rr = 0; rr < 46; ++rr) { const int tt = t0 - 15 + rr; pk[rr] = (tt >= 0 && tt < L) ? pk[rr] : 0u; }
        v2f yy[16];
#pragma unroll
        for (int r = 0; r < 16; ++r) yy[r] = bb;
#pragma unroll
        for (int rr = 0; rr < 46; ++rr) {
            const v2f x = (v2f){bflo(pk[rr]), bfhi(pk[rr])};
#pragma unroll
            for (int r = 0; r < 16; ++r) { const int k = rr - r; if (k >= 0 && k < 31) yy[r] += x * w[k]; }
        }
        float y0[16], y1[16];
#pragma unroll
        for (int r = 0; r < 16; ++r) { y0[r] = yy[r].x; y1[r] = yy[r].y; }
        float s[16];
#pragma unroll
        for (int r = 0; r < 16; ++r) s[r] = y0[r] + y1[r];
#pragma unroll
        for (int o = 1; o < 64; o <<= 1) {
#pragma unroll
            for (int r = 0; r < 16; ++r) s[r] += shx(s[r], F.lane, o); }
        __syncthreads();
        if (F.lane < 16) { float v = s[0];
#pragma unroll
            for (int r = 1; r < 16; ++r) v = F.lane == r ? s[r] : v;
            red[F.wave * 16 + F.lane] = v; }
        __syncthreads();
        float mean[16];
#pragma unroll
        for (int r = 0; r < 16; ++r) { float m = 0.f;
#pragma unroll
            for (int wv = 0; wv < 8; ++wv) m += red[wv * 16 + r];
            mean[r] = m * (1.f / 1024); }
#pragma unroll
        for (int r = 0; r < 16; ++r) { y0[r] -= mean[r]; y1[r] -= mean[r]; s[r] = y0[r] * y0[r] + y1[r] * y1[r]; }
#pragma unroll
        for (int o = 1; o < 64; o <<= 1) {
#pragma unroll
            for (int r = 0; r < 16; ++r) s[r] += shx(s[r], F.lane, o); }
        __syncthreads();
        if (F.lane < 16) { float v = s[0];
#pragma unroll
            for (int r = 1; r < 16; ++r) v = F.lane == r ? s[r] : v;
            red[F.wave * 16 + F.lane] = v; }
        __syncthreads();
        const v2f gg = *(const GAS v2f*)(gln + c), bl = *(const GAS v2f*)(bln + c);
#pragma unroll
        for (int r = 0; r < 16; ++r) { float q = 0.f;
#pragma unroll
            for (int wv = 0; wv < 8; ++wv) q += red[wv * 16 + r];
            const float rs = rsqrtf(q * (1.f / 1024) + EPS);
            const float z0 = y0[r] * rs * gg.x + bl.x, z1 = y1[r] * rs * gg.y + bl.y;
            *(GAS unsigned*)(vout + (size_t)(row0 + r) * 1024 + c) = pk2(z0 * fast_sig(z0), z1 * fast_sig(z1)); }
    }
    __syncthreads();
}
__device__ __forceinline__ void rp_ssd_conv(Frame& F, const bf16* xpre, const float* dtraw, const float* wc, const float* bc, const float* dtb, const float* alog, bf16* xbc, float* dt, float* acum) {
    for (int idx = F.bx * NTHR + F.tid; idx < (T / 32) * 384; idx += F.G * NTHR) {
        const int seg = idx / 384, cg = idx - seg * 384, c0 = 8 * cg, row0 = 32 * seg; int t0, L; row_pos(row0, t0, L);
        v2f w2[5][4], b2[4];
#pragma unroll
        for (int k = 0; k < 5; ++k) { const v4f a = *(const GAS v4f*)(wc + k * 3072 + c0), b = *(const GAS v4f*)(wc + k * 3072 + c0 + 4);
            w2[k][0] = (v2f){a.x, a.y}; w2[k][1] = (v2f){a.z, a.w}; w2[k][2] = (v2f){b.x, b.y}; w2[k][3] = (v2f){b.z, b.w}; }
        { const v4f a = *(const GAS v4f*)(bc + c0), b = *(const GAS v4f*)(bc + c0 + 4); b2[0] = (v2f){a.x, a.y}; b2[1] = (v2f){a.z, a.w}; b2[2] = (v2f){b.x, b.y}; b2[3] = (v2f){b.z, b.w}; }
        const bf16* base = xpre + (size_t)row0 * 3072 + c0;
#define SSC_OK(j) ((t0 + (j)) >= 0 && (t0 + (j)) < L)
#define SSC_LD(j) (*(const GAS v4u*)(base + (ptrdiff_t)(SSC_OK(j) ? (j) : 0) * 3072))
        v4u carry[4], cur[8], nxt[8];
#pragma unroll
        for (int k = 0; k < 4; ++k) carry[k] = SSC_LD(k - 2);
#pragma unroll
        for (int k = 0; k < 8; ++k) cur[k] = SSC_LD(k + 2);
        __builtin_amdgcn_sched_barrier(0);
#pragma unroll
        for (int k = 0; k < 4; ++k) if (!SSC_OK(k - 2)) carry[k] = (v4u){0u, 0u, 0u, 0u};
#pragma unroll
        for (int k = 0; k < 8; ++k) if (!SSC_OK(k + 2)) cur[k] = (v4u){0u, 0u, 0u, 0u};
#pragma unroll
        for (int c = 0; c < 4; ++c) {
            if (c < 3) {
#pragma unroll
                for (int k = 0; k < 8; ++k) nxt[k] = SSC_LD(8 * c + 10 + k); }
            __builtin_amdgcn_sched_barrier(0);
            v2f acc[8][4];
#pragma unroll
            for (int o = 0; o < 8; ++o)
#pragma unroll
                for (int p2 = 0; p2 < 4; ++p2) acc[o][p2] = b2[p2];
#pragma unroll
            for (int q = 0; q < 12; ++q) { const v4u rw = q < 4 ? carry[q] : cur[q - 4];
                const v2f x0 = (v2f){bflo(rw.x), bfhi(rw.x)}, x1 = (v2f){bflo(rw.y), bfhi(rw.y)}, x2 = (v2f){bflo(rw.z), bfhi(rw.z)}, x3 = (v2f){bflo(rw.w), bfhi(rw.w)};
#pragma unroll
                for (int o = 0; o < 8; ++o) { const int k = q - o; if (k >= 0 && k < 5) { acc[o][0] += x0 * w2[k][0]; acc[o][1] += x1 * w2[k][1]; acc[o][2] += x2 * w2[k][2]; acc[o][3] += x3 * w2[k][3]; } } }
#pragma unroll
            for (int o = 0; o < 8; ++o) { v4u ow;
                { const v2f v = acc[o][0]; ow.x = pk2(v.x * fast_sig(v.x), v.y * fast_sig(v.y)); } { const v2f v = acc[o][1]; ow.y = pk2(v.x * fast_sig(v.x), v.y * fast_sig(v.y)); }
                { const v2f v = acc[o][2]; ow.z = pk2(v.x * fast_sig(v.x), v.y * fast_sig(v.y)); } { const v2f v = acc[o][3]; ow.w = pk2(v.x * fast_sig(v.x), v.y * fast_sig(v.y)); }
                *(GAS v4u*)(xbc + (size_t)(row0 + 8 * c + o) * 3072 + c0) = ow; }
#pragma unroll
            for (int k = 0; k < 4; ++k) carry[k] = cur[4 + k];
            if (c < 3) {
#pragma unroll
                for (int k = 0; k < 8; ++k) cur[k] = SSC_OK(8 * c + 10 + k) ? nxt[k] : (v4u){0u, 0u, 0u, 0u}; }
        }
#undef SSC_OK
#undef SSC_LD
    }
    for (int it = F.gw; it < 64 * 64; it += F.NGW) {
        const int ch = it >> 6, e = it & 63, dir = e >> 5, row0 = 128 * ch, lane = F.lane;
        const float aa = -expf(alog[e]), bb = dtb[e];
        const int i0 = dir == 0 ? lane : 127 - lane, i1 = dir == 0 ? lane + 64 : 63 - lane;
        const float d0 = softplus_f(dtraw[(size_t)(row0 + i0) * 64 + e] + bb), d1 = softplus_f(dtraw[(size_t)(row0 + i1) * 64 + e] + bb);
        float s0 = d0 * aa, s1 = d1 * aa;
#pragma unroll
        for (int o = 1; o < 64; o <<= 1) { const float u0 = __builtin_bit_cast(float, __builtin_amdgcn_ds_bpermute((lane - o) << 2, __builtin_bit_cast(int, s0))), u1 = __builtin_bit_cast(float, __builtin_amdgcn_ds_bpermute((lane - o) << 2, __builtin_bit_cast(int, s1)));
            if (lane >= o) { s0 += u0; s1 += u1; } }
        s1 += __builtin_bit_cast(float, __builtin_amdgcn_readlane(__builtin_bit_cast(int, s0), 63));
        dt[(size_t)(row0 + i0) * 64 + e] = d0; dt[(size_t)(row0 + i1) * 64 + e] = d1;
        acum[(size_t)(row0 + i0) * 64 + e] = s0; acum[(size_t)(row0 + i1) * 64 + e] = s1;
    }
}
__device__ __forceinline__ void rp_ssd_gate(Frame& F, const bf16* y, const bf16* z, const float* gn, bf16* yn) {
    v4f gv[4][2];
#pragma unroll
    for (int g = 0; g < 4; ++g) { gv[g][0] = *(const GAS v4f*)(gn + g * 512 + 8 * F.lane); gv[g][1] = *(const GAS v4f*)(gn + g * 512 + 8 * F.lane + 4); }
    v4u cz[4], ca[4], cb[4], nz[4], na[4], nb[4];
    int row = F.gw;
    if (row < T) {
#pragma unroll
        for (int g = 0; g < 4; ++g) { const size_t o = (size_t)row * 2048 + g * 512 + 8 * F.lane; cz[g] = *(const GAS v4u*)(z + o); ca[g] = *(const GAS v4u*)(y + o); cb[g] = *(const GAS v4u*)(y + (size_t)T * 2048 + o); } }
    for (; row < T; row += F.NGW) {
        const int nrow = row + F.NGW;
        if (nrow < T) {
#pragma unroll
            for (int g = 0; g < 4; ++g) { const size_t o = (size_t)nrow * 2048 + g * 512 + 8 * F.lane; nz[g] = *(const GAS v4u*)(z + o); na[g] = *(const GAS v4u*)(y + o); nb[g] = *(const GAS v4u*)(y + (size_t)T * 2048 + o); } }
        __builtin_amdgcn_sched_barrier(0);
#pragma unroll
        for (int g = 0; g < 4; ++g) { const int c0 = g * 512 + 8 * F.lane; float zz[8], v[8], yb[8];
            up8(cz[g], zz); up8(ca[g], v); up8(cb[g], yb);
            float ss = 0.f;
#pragma unroll
            for (int i = 0; i < 8; ++i) { v[i] = (v[i] + yb[i]) * zz[i] * fast_sig(zz[i]); ss += v[i] * v[i]; }
            const float r = __builtin_amdgcn_rsqf(wsum(ss, F.lane) * (1.f / 512) + EPS);
#pragma unroll
            for (int i = 0; i < 8; ++i) v[i] = v[i] * r * gv[g][i >> 2][i & 3];
            st8(yn + (size_t)row * 2048 + c0, v); }
#pragma unroll
        for (int g = 0; g < 4; ++g) { cz[g] = nz[g]; ca[g] = na[g]; cb[g] = nb[g]; }
    }
}

typedef short a_bf16x8 __attribute__((ext_vector_type(8)));
typedef short a_s16x4 __attribute__((ext_vector_type(4)));
typedef float a_f32x16 __attribute__((ext_vector_type(16)));
typedef float a_f32x2 __attribute__((ext_vector_type(2))); typedef __bf16 a_bf16x2 __attribute__((ext_vector_type(2)));
__device__ __forceinline__ unsigned a_cvtpk(float lo, float hi) { a_f32x2 v = {lo, hi}; a_bf16x2 b = __builtin_convertvector(v, a_bf16x2); return __builtin_bit_cast(unsigned, b); }
__device__ __forceinline__ a_s16x4 a_vtr(const LAS unsigned char* p) { return __builtin_bit_cast(a_s16x4, __builtin_amdgcn_ds_read_tr16_b64_v4i16((LAS a_s16x4*)p)); }
constexpr int AT_KS = 208, AT_VS = 192, AT_KB = 64 * AT_KS, AT_VB = 64 * AT_VS, AT_VOFF = 2 * AT_KB;
__device__ __forceinline__ void at_tile(Frame& F, LAS unsigned char* lds, int buf, int lane, const a_bf16x8 (&qf)[6], a_f32x16& o0, a_f32x16& o1, float& m, float& l) {
    const int r32 = lane & 31, hi = lane >> 5;
    a_f32x16 p0, p1;
#pragma unroll
    for (int r = 0; r < 16; ++r) { p0[r] = 0.f; p1[r] = 0.f; }
    { const LAS unsigned char* kp = lds + buf * AT_KB + r32 * AT_KS + hi * 16;
#pragma unroll
      for (int s = 0; s < 6; ++s) { const a_bf16x8 a0 = *(const LAS a_bf16x8*)(kp + 32 * s), a1 = *(const LAS a_bf16x8*)(kp + 32 * AT_KS + 32 * s);
          p0 = __builtin_amdgcn_mfma_f32_32x32x16_bf16(a0, qf[s], p0, 0, 0, 0); p1 = __builtin_amdgcn_mfma_f32_32x32x16_bf16(a1, qf[s], p1, 0, 0, 0); } }

    float mx = fmaxf(p0[0], p1[0]);
#pragma unroll
    for (int r = 1; r < 16; ++r) mx = fmaxf(mx, fmaxf(p0[r], p1[r]));
    mx = fmaxf(mx, shx(mx, lane, 32));
    const float mn = fmaxf(m, mx), alpha = __builtin_amdgcn_exp2f(m - mn); m = mn;
    float ps = 0.f;
#pragma unroll
    for (int r = 0; r < 16; ++r) { p0[r] = __builtin_amdgcn_exp2f(p0[r] - mn); p1[r] = __builtin_amdgcn_exp2f(p1[r] - mn); ps += p0[r] + p1[r]; }
    l = l * alpha + ps;
#pragma unroll
    for (int r = 0; r < 16; ++r) { o0[r] *= alpha; o1[r] *= alpha; }
    v4u pw[4];
    pw[0] = (v4u){a_cvtpk(p0[0], p0[1]), a_cvtpk(p0[2], p0[3]), a_cvtpk(p0[4], p0[5]), a_cvtpk(p0[6], p0[7])};
    pw[1] = (v4u){a_cvtpk(p0[8], p0[9]), a_cvtpk(p0[10], p0[11]), a_cvtpk(p0[12], p0[13]), a_cvtpk(p0[14], p0[15])};
    pw[2] = (v4u){a_cvtpk(p1[0], p1[1]), a_cvtpk(p1[2], p1[3]), a_cvtpk(p1[4], p1[5]), a_cvtpk(p1[6], p1[7])};
    pw[3] = (v4u){a_cvtpk(p1[8], p1[9]), a_cvtpk(p1[10], p1[11]), a_cvtpk(p1[12], p1[13]), a_cvtpk(p1[14], p1[15])};

    const LAS unsigned char* vp0 = lds + AT_VOFF + buf * AT_VB + (4 * hi + ((lane & 15) >> 2)) * AT_VS + (16 * ((lane >> 4) & 1) + 4 * (lane & 3)) * 2;
    a_s16x4 vl0[4], vh0[4], vl1[4], vh1[4];
#pragma unroll
    for (int bs = 0; bs < 4; ++bs) { const LAS unsigned char* vq = vp0 + (16 * bs) * AT_VS; vl0[bs] = a_vtr(vq); vh0[bs] = a_vtr(vq + 8 * AT_VS); vl1[bs] = a_vtr(vq + 64); vh1[bs] = a_vtr(vq + 8 * AT_VS + 64); }
#pragma unroll
    for (int bs = 0; bs < 4; ++bs) {
        const a_bf16x8 v0 = (a_bf16x8){vl0[bs][0], vl0[bs][1], vl0[bs][2], vl0[bs][3], vh0[bs][0], vh0[bs][1], vh0[bs][2], vh0[bs][3]}, v1 = (a_bf16x8){vl1[bs][0], vl1[bs][1], vl1[bs][2], vl1[bs][3], vh1[bs][0], vh1[bs][1], vh1[bs][2], vh1[bs][3]};
        const a_bf16x8 pb = __builtin_bit_cast(a_bf16x8, pw[bs]);
        o0 = __builtin_amdgcn_mfma_f32_32x32x16_bf16(v0, pb, o0, 0, 0, 0); o1 = __builtin_amdgcn_mfma_f32_32x32x16_bf16(v1, pb, o1, 0, 0, 0); }
}
__device__ __forceinline__ void ph_attn(Frame& F, const bf16* Q, const bf16* K, const bf16* KV, bf16* AO) {
    const int lane = F.lane, r32 = lane & 31, hi = lane >> 5, wave = F.wave, tid = F.tid;
    LAS unsigned char* lds = F.lds;
    const int kr_a = tid / 12, kp_a = tid % 12, kr_b = (tid + 512) / 12, kp_b = (tid + 512) % 12, vr = tid >> 3, vp = tid & 7;
    const bool has_b = tid < 256;
    for (int uu = F.vcu; uu < 512; uu += F.G) {
        int head, q0, NT, kbase_ctx, kbase_lat;
        if (uu < 256) { const int seq = uu >> 4; head = uu & 15; q0 = seq * 256; NT = 4; kbase_ctx = seq * 256; kbase_lat = 0; }
        else { const int u2 = uu - 256, b = u2 >> 6, qb = u2 & 3; head = (u2 >> 2) & 15; q0 = TP + b * 1024 + qb * 256; NT = 20; kbase_ctx = T + b * 256; kbase_lat = TP + b * 1024; }
        a_bf16x8 qf[6];
        { const bf16* qp = Q + ((size_t)(q0 + wave * 32 + r32) * 16 + head) * 96 + hi * 8;
#pragma unroll
          for (int s = 0; s < 6; ++s) qf[s] = *(const GAS a_bf16x8*)(qp + 16 * s); }
        a_f32x16 o0, o1;
#pragma unroll
        for (int r = 0; r < 16; ++r) { o0[r] = 0.f; o1[r] = 0.f; }
        float m = -INFINITY, l = 0.f;
        v4u ka0, kb0, vv0, ka1, kb1, vv1, ka2, kb2_, vv2;
#define AT_LOAD(t, KA, KB2, VV) do { const int kr0_ = (t) < 4 ? kbase_ctx + 64 * (t) : kbase_lat + 64 * ((t) - 4); \
            KA = *(const GAS v4u*)(K + ((size_t)(kr0_ + kr_a) * 16 + head) * 96 + kp_a * 8); \
            if (has_b) KB2 = *(const GAS v4u*)(K + ((size_t)(kr0_ + kr_b) * 16 + head) * 96 + kp_b * 8); \
            VV = *(const GAS v4u*)(KV + (size_t)(kr0_ + vr) * 2048 + head * 128 + 64 + vp * 8); } while (0)
#define AT_STORE(buf, KA, KB2, VV) do { *(LAS v4u*)(lds + (buf) * AT_KB + kr_a * AT_KS + kp_a * 16) = KA; \
            if (has_b) *(LAS v4u*)(lds + (buf) * AT_KB + kr_b * AT_KS + kp_b * 16) = KB2; \
            *(LAS v4u*)(lds + AT_VOFF + (buf) * AT_VB + vr * AT_VS + vp * 16) = VV; } while (0)
#define AT_STEP(k, SA, SB, SC, SD_, SE_, SF_, SG, SH, SI) if (t + (k) < NT) { \
            if (t + (k) + 3 < NT) AT_LOAD(t + (k) + 3, SA, SB, SC);            \
            at_tile(F, lds, (k) & 1, lane, qf, o0, o1, m, l); \
            if (t + (k) + 1 < NT) AT_STORE(((k) + 1) & 1, SD_, SE_, SF_);       \
            LDS_BARRIER(); }
        AT_LOAD(0, ka0, kb0, vv0); AT_LOAD(1, ka1, kb1, vv1); AT_LOAD(2, ka2, kb2_, vv2);
        AT_STORE(0, ka0, kb0, vv0);
        LDS_BARRIER();
#pragma unroll 1
        for (int t = 0; t < NT; t += 6) {
            AT_STEP(0, ka0, kb0, vv0, ka1, kb1, vv1, 0, 0, 0)
            AT_STEP(1, ka1, kb1, vv1, ka2, kb2_, vv2, 0, 0, 0)
            AT_STEP(2, ka2, kb2_, vv2, ka0, kb0, vv0, 0, 0, 0)
            AT_STEP(3, ka0, kb0, vv0, ka1, kb1, vv1, 0, 0, 0)
            AT_STEP(4, ka1, kb1, vv1, ka2, kb2_, vv2, 0, 0, 0)
            AT_STEP(5, ka2, kb2_, vv2, ka0, kb0, vv0, 0, 0, 0)
        }
#undef AT_STEP
#undef AT_LOAD
#undef AT_STORE
        l += shx(l, lane, 32);
        const float il = __builtin_amdgcn_rcpf(l);
        bf16* op = AO + (size_t)(q0 + wave * 32 + r32) * 1024 + head * 64 + 4 * hi;
#pragma unroll
        for (int g4 = 0; g4 < 4; ++g4) {
            v2u w0; w0.x = a_cvtpk(o0[4 * g4] * il, o0[4 * g4 + 1] * il); w0.y = a_cvtpk(o0[4 * g4 + 2] * il, o0[4 * g4 + 3] * il); *(GAS v2u*)(op + 8 * g4) = w0;
            v2u w1; w1.x = a_cvtpk(o1[4 * g4] * il, o1[4 * g4 + 1] * il); w1.y = a_cvtpk(o1[4 * g4 + 2] * il, o1[4 * g4 + 3] * il); *(GAS v2u*)(op + 32 + 8 * g4) = w1; }

    }
}
constexpr int SC_ST = 272, SC_XS = 144;
constexpr int SC_C = 0, SC_B = 128 * SC_ST, SC_M = 2 * 128 * SC_ST, SC_H = 3 * 128 * SC_ST, SC_X = SC_H + 64 * SC_ST, SC_XW = SC_X + 128 * SC_XS, SC_ARR = SC_XW + 128 * SC_XS;
static_assert(SC_ARR + 4 * 128 * 4 + 16 <= PTAB_OFF_C && SC_ARR + 4 * 128 * 4 + 16 <= P0_DUMP, "scan LDS map (the weight prefetch's dump area lies above it)");
__device__ __forceinline__ int a_crow(int r, int hi) { return (r & 3) + 8 * (r >> 2) + 4 * hi; }
__device__ __forceinline__ void ph_scan(Frame& F, const bf16* xbc, const float* dt, const float* acg, const float* dsk, const float* st0, bf16* y, float* out) {
    const int lane = F.lane, r32 = lane & 31, hi = lane >> 5, wave = F.wave, tid = F.tid;
    LAS unsigned char* lds = F.lds;
    LAS float* acum = (LAS float*)(lds + SC_ARR); LAS float* wj = acum + 128; LAS float* ei = acum + 256; LAS float* dtj = acum + 384; LAS float* misc = acum + 512;
    const int q4 = (lane & 15) >> 2, gg = (lane >> 4) & 1, p4 = lane & 3;
    const int ib = wave >> 1, pb = wave & 1, nb = wave >> 1;
    v4u cr[4], br[4], xr[2];
    float pdt[2], pac[2], plast, pac_t, pdt_t;
#define SC_GLOADP(rowb_, g_, hd_, dir_) do { const int row0_ = (rowb_); \
        _Pragma("unroll") for (int k = 0; k < 4; ++k) { const int q = tid + 512 * k, rr = q >> 4, pp = q & 15; \
            cr[k] = *(const GAS v4u*)(xbc + (size_t)(row0_ + rr) * 3072 + 2560 + (g_) * 128 + pp * 8); br[k] = *(const GAS v4u*)(xbc + (size_t)(row0_ + rr) * 3072 + 2048 + (g_) * 128 + pp * 8); } \
        _Pragma("unroll") for (int k = 0; k < 2; ++k) { const int q = tid + 512 * k, rr = q >> 3, pp = q & 7; xr[k] = *(const GAS v4u*)(xbc + (size_t)(row0_ + rr) * 3072 + (hd_) * 64 + pp * 8); \
            pdt[k] = dt[(size_t)(row0_ + rr) * 64 + (dir_) * 32 + (hd_)]; pac[k] = acg[(size_t)(row0_ + rr) * 64 + (dir_) * 32 + (hd_)]; } \
        plast = acg[(size_t)(row0_ + ((dir_) == 0 ? 127 : 0)) * 64 + (dir_) * 32 + (hd_)]; \
        pac_t = acg[(size_t)(row0_ + (tid & 127)) * 64 + (dir_) * 32 + (hd_)]; pdt_t = dt[(size_t)(row0_ + (tid & 127)) * 64 + (dir_) * 32 + (hd_)]; } while (0)
#define SC_ITEM(slot_, ii_, seq_, hd_) do { if ((slot_) < 128) { seq_ = 16 + ((slot_) >> 5); hd_ = (slot_) & 31; } else { const int pi_ = 4 * ((slot_) - 128) + (ii_); seq_ = pi_ >> 5; hd_ = pi_ & 31; } } while (0)
    for (int slot = F.vcu; slot < 256; slot += F.G) {
        const int nitem = slot < 128 ? 1 : 4;
        { int seq0, hd0; SC_ITEM(slot, 0, seq0, hd0); SC_GLOADP(seq0 < 16 ? seq0 * 256 : TP + (seq0 - 16) * 1024, hd0 >> 3, hd0, 0); }
#pragma unroll 1
        for (int ii = 0; ii < nitem; ++ii) {
            int seq, hd;
            if (slot < 128) { seq = 16 + (slot >> 5); hd = slot & 31; } else { const int pi = 4 * (slot - 128) + ii; seq = pi >> 5; hd = pi & 31; }
            const int g = hd >> 3, r0 = seq < 16 ? seq * 256 : TP + (seq - 16) * 1024, nc = seq < 16 ? 2 : 8;
#pragma unroll 1
            for (int dir = 0; dir < 2; ++dir) {
                const float dd = dsk[dir * 32 + hd];
                a_f32x16 hacc;
                if (seq < 16) {
#pragma unroll
                    for (int r = 0; r < 16; ++r) hacc[r] = 0.f;
                } else { const float* s0 = st0 + ((((size_t)(seq - 16) * 2 + dir) * 32 + hd) * 64 + 32 * pb + r32) * 128 + 32 * nb + 4 * hi;
#pragma unroll
                    for (int g4 = 0; g4 < 4; ++g4) { const v4f t4 = *(const GAS v4f*)(s0 + 8 * g4); hacc[4 * g4] = t4.x; hacc[4 * g4 + 1] = t4.y; hacc[4 * g4 + 2] = t4.z; hacc[4 * g4 + 3] = t4.w; } }
#pragma unroll
                for (int g4 = 0; g4 < 4; ++g4) { v2u w; w.x = a_cvtpk(hacc[4 * g4], hacc[4 * g4 + 1]); w.y = a_cvtpk(hacc[4 * g4 + 2], hacc[4 * g4 + 3]);
                    *(LAS v2u*)(lds + SC_H + (32 * pb + r32) * SC_ST + (32 * nb + 8 * g4 + 4 * hi) * 2) = w; }
#pragma unroll 1
                for (int cc = 0; cc < nc; ++cc) {
                    const int c = dir == 0 ? cc : nc - 1 - cc, row0 = r0 + c * 128;
                    const int e = dir * 32 + hd;
                    const float last = plast;
                    LDS_BARRIER();
                    if (tid < 128) { const float ac = pac_t, dv = pdt_t;
                        acum[tid] = ac; wj[tid] = ac * 1.4426950408889634f; dtj[tid] = dv; ei[tid] = __expf(ac); if (tid == 0) misc[0] = __expf(last); }
#pragma unroll
                    for (int k = 0; k < 4; ++k) { const int q = tid + 512 * k, rr = q >> 4, pp = q & 15; *(LAS v4u*)(lds + SC_C + rr * SC_ST + pp * 16) = cr[k]; *(LAS v4u*)(lds + SC_B + rr * SC_ST + pp * 16) = br[k]; }
#pragma unroll
                    for (int k = 0; k < 2; ++k) { const int q = tid + 512 * k, rr = q >> 3, pp = q & 7; *(LAS v4u*)(lds + SC_X + rr * SC_XS + pp * 16) = xr[k];
                        const float w = pdt[k] * __expf(last - pac[k]);
                        v4u s; s.x = a_cvtpk(bflo(xr[k].x) * w, bfhi(xr[k].x) * w); s.y = a_cvtpk(bflo(xr[k].y) * w, bfhi(xr[k].y) * w); s.z = a_cvtpk(bflo(xr[k].z) * w, bfhi(xr[k].z) * w); s.w = a_cvtpk(bflo(xr[k].w) * w, bfhi(xr[k].w) * w);
                        *(LAS v4u*)(lds + SC_XW + rr * SC_XS + pp * 16) = s; }
                    { int nrow = 0, nhd = hd, ndir = dir; bool hn = true;
                      if (cc + 1 < nc) nrow = r0 + (dir == 0 ? cc + 1 : nc - 2 - cc) * 128;
                      else if (dir == 0) { nrow = r0 + (nc - 1) * 128; ndir = 1; }
                      else if (ii + 1 < nitem) { int seqn; SC_ITEM(slot, ii + 1, seqn, nhd); nrow = seqn < 16 ? seqn * 256 : TP + (seqn - 16) * 1024; ndir = 0; }
                      else hn = false;
                      if (hn) SC_GLOADP(nrow, nhd >> 3, nhd, ndir); }
                    LDS_BARRIER();
                    {
                        const int ta = wave < 3 ? wave : wave < 6 ? 0 : 1, tb = wave < 3 ? wave : wave < 6 ? wave - 2 : wave - 4;
                        const int jb = dir == 0 ? ta : tb, ibg = dir == 0 ? tb : ta;
                        a_f32x16 gt;
#pragma unroll
                        for (int r = 0; r < 16; ++r) gt[r] = 0.f;
                        const LAS unsigned char* ap = lds + SC_B + (32 * jb + r32) * SC_ST + hi * 16; const LAS unsigned char* bp = lds + SC_C + (32 * ibg + r32) * SC_ST + hi * 16;
#pragma unroll
                        for (int s = 0; s < 8; ++s) gt = __builtin_amdgcn_mfma_f32_32x32x16_bf16(*(const LAS a_bf16x8*)(ap + 32 * s), *(const LAS a_bf16x8*)(bp + 32 * s), gt, 0, 0, 0);
                        const int i = 32 * ibg + r32; const float ai = wj[i];
                        if (ta == tb) {
#pragma unroll
                            for (int g4 = 0; g4 < 4; ++g4) {
                                const v4f aj = *(const LAS v4f*)(wj + 32 * jb + 8 * g4 + 4 * hi), dj = *(const LAS v4f*)(dtj + 32 * jb + 8 * g4 + 4 * hi);
#pragma unroll
                                for (int q = 0; q < 4; ++q) { const int r = 4 * g4 + q; const int j = 32 * jb + a_crow(r, hi); const bool keep = dir == 0 ? j <= i : j >= i;
                                    const float e = __builtin_amdgcn_exp2f(fminf(ai - aj[q], 0.f)) * dj[q];
                                    gt[r] = keep ? gt[r] * e + (j == i ? dd : 0.f) : 0.f; } }
                        } else {
#pragma unroll
                            for (int g4 = 0; g4 < 4; ++g4) {
                                const v4f aj = *(const LAS v4f*)(wj + 32 * jb + 8 * g4 + 4 * hi), dj = *(const LAS v4f*)(dtj + 32 * jb + 8 * g4 + 4 * hi);
#pragma unroll
                                for (int q = 0; q < 4; ++q) gt[4 * g4 + q] *= __builtin_amdgcn_exp2f(fminf(ai - aj[q], 0.f)) * dj[q]; }
                        }
#pragma unroll
                        for (int g4 = 0; g4 < 4; ++g4) { v2u w; w.x = a_cvtpk(gt[4 * g4], gt[4 * g4 + 1]); w.y = a_cvtpk(gt[4 * g4 + 2], gt[4 * g4 + 3]);
                            *(LAS v2u*)(lds + SC_M + (32 * ibg + r32) * SC_ST + (32 * jb + 8 * g4 + 4 * hi) * 2) = w; }
                    }
                    {
                        const int ta = wave < 4 ? 2 : 3, tb = 3, jb = dir == 0 ? ta : tb, ibg = dir == 0 ? tb : ta;
                        const int ja = 2 * jb + ((wave >> 1) & 1), ia = 2 * ibg + (wave & 1), l15 = lane & 15, fq = lane >> 4;
                        pg8::f32x4 gq = (pg8::f32x4){0.f, 0.f, 0.f, 0.f};
                        const LAS unsigned char* ap = lds + SC_B + (16 * ja + l15) * SC_ST + fq * 16; const LAS unsigned char* bp = lds + SC_C + (16 * ia + l15) * SC_ST + fq * 16;
#pragma unroll
                        for (int s = 0; s < 4; ++s) gq = __builtin_amdgcn_mfma_f32_16x16x32_bf16(*(const LAS pg8::bf16x8*)(ap + 64 * s), *(const LAS pg8::bf16x8*)(bp + 64 * s), gq, 0, 0, 0);
                        const int i = 16 * ia + l15, j0 = 16 * ja + 4 * fq; const float ai = wj[i];
                        const v4f aj = *(const LAS v4f*)(wj + j0), dj = *(const LAS v4f*)(dtj + j0);
#pragma unroll
                        for (int q = 0; q < 4; ++q) { const int j = j0 + q; const bool keep = dir == 0 ? j <= i : j >= i;
                            const float e = __builtin_amdgcn_exp2f(fminf(ai - aj[q], 0.f)) * dj[q];
                            gq[q] = keep ? gq[q] * e + (j == i ? dd : 0.f) : 0.f; }
                        v2u w; w.x = a_cvtpk(gq[0], gq[1]); w.y = a_cvtpk(gq[2], gq[3]);
                        *(LAS v2u*)(lds + SC_M + i * SC_ST + j0 * 2) = w;
                    }
                    if (wave >= 2) {
                        const int d = wave - 2; const int ta = d == 0 ? 1 : d < 3 ? 2 : 3, tb = d == 0 ? 0 : d == 1 ? 0 : d == 2 ? 1 : d - 3;
                        const int jb = dir == 0 ? ta : tb, ibg = dir == 0 ? tb : ta;
                        const v2u z = {0u, 0u};
#pragma unroll
                        for (int g4 = 0; g4 < 4; ++g4) *(LAS v2u*)(lds + SC_M + (32 * ibg + r32) * SC_ST + (32 * jb + 8 * g4 + 4 * hi) * 2) = z;
                    }
                    a_f32x16 yo;
#pragma unroll
                    for (int r = 0; r < 16; ++r) yo[r] = 0.f;
                    { const LAS unsigned char* ap = lds + SC_C + (32 * ib + r32) * SC_ST + hi * 16; const LAS unsigned char* bp = lds + SC_H + (32 * pb + r32) * SC_ST + hi * 16;
#pragma unroll
                      for (int s = 0; s < 8; ++s) yo = __builtin_amdgcn_mfma_f32_32x32x16_bf16(*(const LAS a_bf16x8*)(ap + 32 * s), *(const LAS a_bf16x8*)(bp + 32 * s), yo, 0, 0, 0); }
                    LDS_BARRIER();
                    a_f32x16 yd;
#pragma unroll
                    for (int r = 0; r < 16; ++r) yd[r] = 0.f;
                    { const LAS unsigned char* ap = lds + SC_M + (32 * ib + r32) * SC_ST + hi * 16; const LAS unsigned char* xp = lds + SC_X + (8 * hi + q4) * SC_XS + (32 * pb + 16 * gg + 4 * p4) * 2;
#pragma unroll
                      for (int s = 0; s < 8; ++s) { const a_s16x4 l0 = a_vtr(xp + (16 * s) * SC_XS), h0 = a_vtr(xp + (16 * s + 4) * SC_XS);
                          const a_bf16x8 xb = (a_bf16x8){l0[0], l0[1], l0[2], l0[3], h0[0], h0[1], h0[2], h0[3]};
                          yd = __builtin_amdgcn_mfma_f32_32x32x16_bf16(*(const LAS a_bf16x8*)(ap + 32 * s), xb, yd, 0, 0, 0); } }
                    { bf16* yp = y + (size_t)dir * T * 2048 + (size_t)(row0 + 32 * ib) * 2048 + hd * 64 + 32 * pb + r32;
                      v4f e4[4];
#pragma unroll
                      for (int g4 = 0; g4 < 4; ++g4) e4[g4] = *(const LAS v4f*)(ei + 32 * ib + 8 * g4 + 4 * hi);
#pragma unroll
                      for (int r = 0; r < 16; ++r) { const int i = a_crow(r, hi); const float v = yd[r] + e4[r >> 2][r & 3] * yo[r]; yp[(size_t)i * 2048] = (bf16)f2bf(v); } }
                    { const float dec = misc[0];
#pragma unroll
                      for (int r = 0; r < 16; ++r) hacc[r] *= dec;
                      const LAS unsigned char* bq = lds + SC_B + (8 * hi + q4) * SC_ST + (32 * nb + 16 * gg + 4 * p4) * 2; const LAS unsigned char* xq = lds + SC_XW + (8 * hi + q4) * SC_XS + (32 * pb + 16 * gg + 4 * p4) * 2;
#pragma unroll
                      for (int s = 0; s < 8; ++s) { const a_s16x4 bl = a_vtr(bq + (16 * s) * SC_ST), bh = a_vtr(bq + (16 * s + 4) * SC_ST), xl = a_vtr(xq + (16 * s) * SC_XS), xh = a_vtr(xq + (16 * s + 4) * SC_XS);
                          const a_bf16x8 av = (a_bf16x8){bl[0], bl[1], bl[2], bl[3], bh[0], bh[1], bh[2], bh[3]}, bv = (a_bf16x8){xl[0], xl[1], xl[2], xl[3], xh[0], xh[1], xh[2], xh[3]};
                          hacc = __builtin_amdgcn_mfma_f32_32x32x16_bf16(av, bv, hacc, 0, 0, 0); } }
#pragma unroll
                    for (int g4 = 0; g4 < 4; ++g4) { v2u w; w.x = a_cvtpk(hacc[4 * g4], hacc[4 * g4 + 1]); w.y = a_cvtpk(hacc[4 * g4 + 2], hacc[4 * g4 + 3]);
                        *(LAS v2u*)(lds + SC_H + (32 * pb + r32) * SC_ST + (32 * nb + 8 * g4 + 4 * hi) * 2) = w; }
                }
                if (seq < 16) { float* o = out + OUT_SSM + ((((size_t)seq * 2 + dir) * 32 + hd) * 64 + 32 * pb + r32) * 128 + 32 * nb + 4 * hi;
#pragma unroll
                    for (int g4 = 0; g4 < 4; ++g4) { v4f t4; t4.x = hacc[4 * g4]; t4.y = hacc[4 * g4 + 1]; t4.z = hacc[4 * g4 + 2]; t4.w = hacc[4 * g4 + 3]; *(GAS v4f*)(o + 8 * g4) = t4; } }
            }
        }
    }
#undef SC_GLOADP
#undef SC_ITEM
    LDS_BARRIER();
}

constexpr int NPHASE = 30;
enum Op { OP_P0, OP_NORM1, OP_G_LAT, OP_FIN1, OP_G_QKV, OP_FIN2, OP_ATTN, OP_G_WO, OP_NORM2, OP_G_FF1, OP_G_FF2, OP_G_PW1, OP_DWCONV, OP_G_PW2, OP_G_SSI, OP_SSCONV, OP_SCAN, OP_GATE, OP_G_SSO };
__device__ __forceinline__ void phase_decode(int ph, int& layer, int& op) {
    if (ph == 0) { layer = 0; op = OP_P0; return; }
    if (ph <= 9) { layer = 0; const int r = ph - 1; op = r == 0 ? OP_NORM1 : r == 1 ? OP_G_LAT : r == 2 ? OP_FIN1 : r == 3 ? OP_G_QKV : r == 4 ? OP_FIN2 : r == 5 ? OP_ATTN : r == 6 ? OP_G_WO : r == 7 ? OP_G_FF1 : OP_G_FF2; }
    else if (ph <= 14) { layer = 1; const int r = ph - 10; op = r == 0 ? OP_G_PW1 : r == 1 ? OP_DWCONV : r == 2 ? OP_G_PW2 : r == 3 ? OP_G_FF1 : OP_G_FF2; }
    else if (ph <= 21) { layer = 2; const int r = ph - 15; op = r == 0 ? OP_G_SSI : r == 1 ? OP_SSCONV : r == 2 ? OP_SCAN : r == 3 ? OP_GATE : r == 4 ? OP_G_SSO : r == 5 ? OP_G_FF1 : OP_G_FF2; }
    else { layer = 3; const int r = ph - 22; op = r == 0 ? OP_G_LAT : r == 1 ? OP_FIN1 : r == 2 ? OP_G_QKV : r == 3 ? OP_FIN2 : r == 4 ? OP_ATTN : r == 5 ? OP_G_WO : r == 6 ? OP_G_FF1 : OP_G_FF2; }
}
struct MArgs { const float* in[38]; float* out; unsigned char* ws; int ph_lo, ph_hi; };
constexpr int PTAB_OFF = PTAB_OFF_C;
__global__ void __launch_bounds__(NTHR, 2) mega_fwd(MArgs args) {
    extern __shared__ __attribute__((aligned(16))) unsigned char lds_raw[];
    LAS unsigned char* lds = (LAS unsigned char*)lds_raw;
    volatile LAS unsigned* PT0 = (volatile LAS unsigned*)(lds + PTAB_OFF);
    volatile LAS unsigned* MISC = (volatile LAS unsigned*)(lds + MISC_OFF);
    { const int t0 = threadIdx.x;
      if (t0 < 40) { const unsigned long long p = t0 < 38 ? (unsigned long long)args.in[t0] : t0 == 38 ? (unsigned long long)args.out : (unsigned long long)args.ws;
          PT0[2 * t0] = (unsigned)p; PT0[2 * t0 + 1] = (unsigned)(p >> 32); }
      if (t0 < 64) MISC[t0] = 0u; }
    __syncthreads();
    XcdBarrier bar = xcd_barrier_post((unsigned*)((unsigned char*)ldp(PT0, PT_WS) + WS_CTL) + CW_BAR, MISC + 8);
    const int wave0 = __builtin_amdgcn_readfirstlane(threadIdx.x >> 6);
    const int ph_hi = args.ph_hi;
    for (int ph = args.ph_lo; ph < ph_hi; ++ph) {
        Frame F;
        { int w = wave0; asm volatile("" : "+s"(w)); F.wave = w; }
        F.lds = lds; F.lane = olane(); F.tid = F.wave * 64 + F.lane;
        const int bx = obid();
        F.G = gridDim.x; F.vcu = (F.G % 8 == 0) ? (bx % 8) * (F.G / 8) + bx / 8 : bx;
        F.gw = F.vcu * NWAVES + F.wave; F.NGW = F.G * NWAVES; F.PT = PT0; F.bx = bx;
        int layer, op; phase_decode(ph, layer, op);
        const int j = layer / 3;
        switch (op) {
        case OP_P0: p0_prologue(F); break;
        case OP_NORM1: { unsigned char* ws = WSP; float* x = OUTP; const float* xlo = layer == 0 ? INP(I_XP) : x; const float* xhi = layer == 0 ? INP(I_XS) - (size_t)TP * 1024 : x;
            rp_normmod(F, xlo, xhi, INP(I_GN1) + layer * 1024, (const float*)(ws + WS_MODS) + (size_t)layer * 5 * 6144, 0, 1024, (bf16*)(ws + WS_H)); rp_tables(F); } break;
        case OP_NORM2: { unsigned char* ws = WSP; float* x = OUTP;
            rp_normmod(F, x, x, INP(I_GN2) + layer * 1024, (const float*)(ws + WS_MODS) + (size_t)layer * 5 * 6144, 3072, 4096, (bf16*)(ws + WS_H)); } break;
        case OP_G_LAT: { unsigned char* ws = WSP; pg8::Gemm g{(const bf16*)(ws + WS_H), (const bf16*)(ws + W_MLA + j * MLA_WB + MW_CAT), T, 768, 1024}; pg8::StaticOrder S; S.init(T, 2 * 768, F.G, F.bx);
            const int s_ = 2 * layer; pg8::EpiF32<1> E{(float*)(ws + A_LAT), 768, layer == 0 ? nullptr : (const float*)(ws + WS_STAT) + s_ * 8192, layer == 0 ? nullptr : (const float*)(ws + WS_SW) + (size_t)s_ * 5 * 5632}; pg8::gemm_phase<pg8::EpiF32<1>, pg8::StaticOrder, true, true, true>(F.lds, g, S, E, F.wave); } break;
        case OP_FIN1: { unsigned char* ws = WSP; rp_mla_fin1(F, (const float*)(ws + A_LAT), INP(I_GQ) + j * 384, INP(I_GKV) + j * 256, (bf16*)(ws + A_QN), (bf16*)(ws + WS_CKV + j * CKV_B), OUTP, j); } break;
        case OP_G_QKV: {
#pragma unroll 1
            for (int w = 0; w < 2; ++w) {
                unsigned char* ws = WSP; unsigned char* wm = ws + W_MLA + j * MLA_WB;
                pg8::Gemm g = w == 0 ? pg8::Gemm{(const bf16*)(ws + A_QN), (const bf16*)(wm + MW_UQ), T, 1536, 384} : pg8::Gemm{(const bf16*)(ws + WS_CKV + j * CKV_B), (const bf16*)(wm + MW_UKV), T + NCTX, 2048, 256};
                pg8::StaticOrder S; S.init(g.M, g.N, F.G, w == 0 ? F.bx : (int)((F.bx + 64) % F.G));
                pg8::EpiBf16P E{w == 0 ? (bf16*)(ws + A_QRAW) : (bf16*)(ws + A_KVRAW), g.N};
                pg8::gemm_phase<pg8::EpiBf16P, pg8::StaticOrder, true, true>(F.lds, g, S, E, F.wave);
            } } break;
        case OP_FIN2: { unsigned char* ws = WSP; rp_mla_fin2(F, (const bf16*)(ws + A_QRAW), (const bf16*)(ws + A_KVRAW), (const float*)(ws + A_LAT), INP(I_CKPE) + (size_t)j * 8192, INP(I_GQN) + j * 96, INP(I_GKN) + j * 96,
                                                        (const float*)(ws + WS_ROPE), (bf16*)(ws + A_QB), (bf16*)(ws + A_KB)); } break;
        case OP_ATTN: { unsigned char* ws = WSP; ph_attn(F, (const bf16*)(ws + A_QB), (const bf16*)(ws + A_KB), (const bf16*)(ws + A_KVRAW), (bf16*)(ws + A_AO)); } break;
        case OP_G_WO: case OP_G_PW2: case OP_G_SSO: case OP_G_FF2: {
            unsigned char* ws = WSP; float* x = OUTP;
            const float* rlo = (layer == 0 && op != OP_G_FF2) ? INP(I_XP) : x; const float* rhi = (layer == 0 && op != OP_G_FF2) ? INP(I_XS) - (size_t)TP * 1024 : x;
            pg8::Gemm g; const float* bias = nullptr; int goff = 2048;
            if (op == OP_G_WO) g = pg8::Gemm{(const bf16*)(ws + A_AO), (const bf16*)(ws + W_MLA + j * MLA_WB + MW_O), T, 1024, 1024};
            else if (op == OP_G_PW2) { g = pg8::Gemm{(const bf16*)(ws + A_V), (const bf16*)(ws + W_CV2), T, 1024, 1024}; bias = INP(I_CVB2); }
            else if (op == OP_G_SSO) g = pg8::Gemm{(const bf16*)(ws + A_YN), (const bf16*)(ws + W_SSO), T, 1024, 2048};
            else { g = pg8::Gemm{(const bf16*)(ws + A_ACT), (const bf16*)(ws + W_FF + layer * FF_WB + FW_OUT), T, 1024, 2816}; goff = 5120; }
            pg8::StaticOrder S; S.init(T, 2 * 1024, F.G, F.bx);
            float* xdst = x;
            const int sn_ = 2 * layer + (op == OP_G_FF2 ? 2 : 1);
            pg8::EpiResid<1> E{rlo, rhi, xdst, (const float*)(ws + WS_MODS) + (size_t)layer * 5 * 6144, goff, bias,
                               sn_ < 8 ? (bf16*)(ws + WS_H) : nullptr, (const float*)(ws + WS_GT) + (size_t)(sn_ & 7) * 5 * 1024, (float*)(ws + WS_STAT) + (sn_ & 7) * 8192};
            pg8::gemm_phase<pg8::EpiResid<1>, pg8::StaticOrder, true, true, true>(F.lds, g, S, E, F.wave); } break;
        case OP_G_FF1: { unsigned char* ws = WSP; pg8::Gemm g{(const bf16*)(ws + WS_H), (const bf16*)(ws + W_FF + layer * FF_WB + FW_IN), T, 5632, 1024}; pg8::StaticOrder S; S.init(T, 5632, F.G, F.bx);
            const int s_ = 2 * layer + 1; pg8::EpiGlu<0> E{(bf16*)(ws + A_ACT), 2816, nullptr, 2816, (const float*)(ws + WS_STAT) + s_ * 8192, (const float*)(ws + WS_SW) + (size_t)s_ * 5 * 5632}; pg8::gemm_phase<pg8::EpiGlu<0>, pg8::StaticOrder, true, true>(F.lds, g, S, E, F.wave); } break;
        case OP_G_PW1: { unsigned char* ws = WSP; pg8::Gemm g{(const bf16*)(ws + WS_H), (const bf16*)(ws + W_CV1), T, 2048, 1024}; pg8::StaticOrder S; S.init(T, 2048, F.G, F.bx);
            const int s_ = 2 * layer; pg8::EpiGlu<1> E{(bf16*)(ws + A_U), 1024, INP(I_CVB1), 1024, (const float*)(ws + WS_STAT) + s_ * 8192, (const float*)(ws + WS_SW) + (size_t)s_ * 5 * 5632}; pg8::gemm_phase<pg8::EpiGlu<1>, pg8::StaticOrder, true, true>(F.lds, g, S, E, F.wave); } break;
        case OP_DWCONV: { unsigned char* ws = WSP; rp_dwconv(F, (const bf16*)(ws + A_U), INP(I_CVWD), INP(I_CVBD), INP(I_CVGL), INP(I_CVBL), (bf16*)(ws + A_V)); } break;
        case OP_G_SSI: { unsigned char* ws = WSP; pg8::Gemm g{(const bf16*)(ws + WS_H), (const bf16*)(ws + W_SSI), T, 5376, 1024}; pg8::StaticOrder S; S.init(T, 5376, F.G, F.bx);
            const int s_ = 2 * layer; pg8::EpiSsdIn E{(bf16*)(ws + A_Z), (bf16*)(ws + A_XPRE), (float*)(ws + A_DTRAW), (const float*)(ws + WS_STAT) + s_ * 8192, (const float*)(ws + WS_SW) + (size_t)s_ * 5 * 5632}; pg8::gemm_phase<pg8::EpiSsdIn, pg8::StaticOrder, true, true>(F.lds, g, S, E, F.wave); } break;
        case OP_SSCONV: { unsigned char* ws = WSP; rp_ssd_conv(F, (const bf16*)(ws + A_XPRE), (const float*)(ws + A_DTRAW), INP(I_SSWC), INP(I_SSBC), INP(I_SSDTB), INP(I_SSAL), (bf16*)(ws + A_XBC), (float*)(ws + A_DT), (float*)(ws + A_ACUM)); } break;
        case OP_SCAN: { unsigned char* ws = WSP; ph_scan(F, (const bf16*)(ws + A_XBC), (const float*)(ws + A_DT), (const float*)(ws + A_ACUM), INP(I_SSD), INP(I_SSM), (bf16*)(ws + A_Y), OUTP); } break;
        case OP_GATE: { unsigned char* ws = WSP; rp_ssd_gate(F, (const bf16*)(ws + A_Y), (const bf16*)(ws + A_Z), INP(I_SSGN), (bf16*)(ws + A_YN)); } break;
        default: break;
        }

        if (ph + 1 < ph_hi) { F.lane = olane(); xcd_barrier_work(bar, F, ph); }

    }
}

extern "C" void kernel_launch(void* const* d_in, const int* in_sizes, int n_in, void* d_out, int out_size, void* d_ws, size_t ws_size, hipStream_t stream) {
    static int grid = 0;
    if (grid == 0) {
        int dev = 0, cus = 0;
        if (hipGetDevice(&dev) != hipSuccess || hipDeviceGetAttribute(&cus, hipDeviceAttributeMultiprocessorCount, dev) != hipSuccess) { fprintf(stderr, "kernel_launch: device query failed\n"); grid = -1; return; }
        if (hipFuncSetAttribute((const void*)mega_fwd, hipFuncAttributeMaxDynamicSharedMemorySize, LDS_BYTES) != hipSuccess) { fprintf(stderr, "kernel_launch: hipFuncSetAttribute failed\n"); grid = -1; return; }
        (void)hipGetLastError();
        grid = cus;
    }
    if (grid < 0) return;
    (void)hipMemsetAsync((char*)d_ws + WS_CTL, 0, CTL_ZERO_BYTES, stream);
    MArgs a{};
    for (int i = 0; i < 38; ++i) a.in[i] = (const float*)d_in[i];
    a.out = (float*)d_out; a.ws = (unsigned char*)d_ws;
    a.ph_lo = 0; a.ph_hi = NPHASE;
    hipLaunchKernelGGL(mega_fwd, dim3(grid), dim3(NTHR), LDS_BYTES, stream, a);
}
```
